# Optimizing an MI355X kernel written in HIP

```python
import math
import jax, jax.numpy as jnp
from jax import lax
import numpy as np

D_MODEL = 1024
BATCH = 8
SEQ = 4096
DEPTH = 4

N_MIXERS = 2
N_GDN_LAYERS = (DEPTH + 1) // 2
N_SB_LAYERS = DEPTH // 2

GDN_HEAD_DIM = 128
GDN_QK_HEADS = D_MODEL // 128
GDN_V_HEADS = 2 * GDN_QK_HEADS
GDN_KEY_DIM = GDN_QK_HEADS * GDN_HEAD_DIM
GDN_VAL_DIM = GDN_V_HEADS * GDN_HEAD_DIM
GDN_CONV_K = 4
GDN_CONV_DIM = 2 * GDN_KEY_DIM + GDN_VAL_DIM
GDN_IN_DIM = GDN_CONV_DIM + GDN_VAL_DIM + 2 * GDN_V_HEADS
GDN_CHUNK = 64

SB_HEAD_DIM = 128
SB_HEADS = D_MODEL // SB_HEAD_DIM
SB_DIM = SB_HEADS * SB_HEAD_DIM
SB_BLOCK = 128

FF_DIM = 7 * D_MODEL // 2
N_EXPERTS = 8
TOP_K = 2

DEEPNORM_ALPHA = (2.0 * DEPTH) ** 0.25
DEEPNORM_BETA = (8.0 * DEPTH) ** -0.25
LN_EPS = 1e-5
RMS_EPS = 1e-6

kernel_name = 'hybrid_gdn_stickbreak_moe_deepnorm'


def layer_norm(x, g, b):
    xf = x.astype(jnp.float32)
    mu = xf.mean(-1, keepdims=True)
    var = jnp.square(xf - mu).mean(-1, keepdims=True)
    y = (xf - mu) * lax.rsqrt(var + LN_EPS) * g.astype(jnp.float32) + b.astype(jnp.float32)
    return y.astype(x.dtype)


def l2norm(x):
    xf = x.astype(jnp.float32)
    return xf * lax.rsqrt(jnp.sum(xf * xf, -1, keepdims=True) + RMS_EPS)


def causal_short_conv(x, w):
    K = w.shape[0]
    S = x.shape[1]
    xp = jnp.pad(x, ((0, 0), (K - 1, 0), (0, 0)))
    y = w[0] * xp[:, 0:S]
    for j in range(1, K):
        y = y + w[j] * xp[:, j:j + S]
    return jax.nn.silu(y)


def chunk_gated_delta_rule(q, k, v, g, beta):
    B, H, S, dk = q.shape
    dv = v.shape[-1]
    C = GDN_CHUNK
    N = S // C
    q = q * (dk ** -0.5)
    qc = q.reshape(B, H, N, C, dk)
    kc = k.reshape(B, H, N, C, dk)
    vc = v.reshape(B, H, N, C, dv)
    bc = beta.reshape(B, H, N, C)
    gcum = jnp.cumsum(g.reshape(B, H, N, C), axis=-1)
    tri = jnp.tril(jnp.ones((C, C), dtype=bool))
    strict = jnp.tril(jnp.ones((C, C), dtype=bool), -1)
    diff = gcum[..., :, None] - gcum[..., None, :]
    decay = jnp.where(tri, jnp.exp(jnp.where(tri, diff, 0.0)), 0.0)
    kb = kc * bc[..., None]
    L = jnp.where(strict, jnp.einsum('bhnid,bhnjd->bhnij', kb, kc) * decay, 0.0)
    eye = jnp.eye(C, dtype=jnp.float32)
    T = lax.linalg.triangular_solve(eye + L, jnp.broadcast_to(eye, L.shape),
                                    left_side=True, lower=True, unit_diagonal=True)
    u = jnp.einsum('bhnij,bhnjd->bhnid', T, vc * bc[..., None])
    w = jnp.einsum('bhnij,bhnjd->bhnid', T, kb * jnp.exp(gcum)[..., None])
    intra = jnp.where(tri, jnp.einsum('bhnid,bhnjd->bhnij', qc, kc) * decay, 0.0)

    def step(state, inp):
        q_i, k_i, u_i, w_i, g_i, a_i = inp
        v_new = u_i - jnp.einsum('bhcd,bhde->bhce', w_i, state)
        o = (jnp.einsum('bhcd,bhde->bhce', q_i * jnp.exp(g_i)[..., None], state)
             + jnp.einsum('bhij,bhje->bhie', a_i, v_new))
        g_last = g_i[..., -1]
        k_dec = k_i * jnp.exp(g_last[..., None] - g_i)[..., None]
        state = state * jnp.exp(g_last)[..., None, None] + jnp.einsum('bhcd,bhce->bhde', k_dec, v_new)
        return state, o

    xs = (qc, kc, u, w, gcum, intra)
    xs = tuple(jnp.moveaxis(a, 2, 0) for a in xs)
    state0 = jnp.zeros((B, H, dk, dv), jnp.float32)
    _, o = lax.scan(step, state0, xs)
    return jnp.moveaxis(o, 0, 2).reshape(B, H, S, dv)


def gated_deltanet(x, w_in, conv_w, a_log, dt_bias, norm_w, w_out):
    B, S, _ = x.shape
    proj = x @ w_in
    o1 = GDN_CONV_DIM
    o2 = o1 + GDN_VAL_DIM
    o3 = o2 + GDN_V_HEADS
    qkv, z, b, a = proj[..., :o1], proj[..., o1:o2], proj[..., o2:o3], proj[..., o3:]
    qkv = causal_short_conv(qkv, conv_w)
    q = qkv[..., :GDN_KEY_DIM].reshape(B, S, GDN_QK_HEADS, GDN_HEAD_DIM)
    k = qkv[..., GDN_KEY_DIM:2 * GDN_KEY_DIM].reshape(B, S, GDN_QK_HEADS, GDN_HEAD_DIM)
    v = qkv[..., 2 * GDN_KEY_DIM:].reshape(B, S, GDN_V_HEADS, GDN_HEAD_DIM).astype(jnp.float32)
    rep = GDN_V_HEADS // GDN_QK_HEADS
    q = jnp.repeat(l2norm(q), rep, axis=2)
    k = jnp.repeat(l2norm(k), rep, axis=2)
    beta = jax.nn.sigmoid(b.astype(jnp.float32))
    g = -jnp.exp(a_log.astype(jnp.float32)) * jax.nn.softplus(a.astype(jnp.float32) + dt_bias.astype(jnp.float32))
    to_bhs = lambda t: jnp.swapaxes(t, 1, 2)
    o = chunk_gated_delta_rule(to_bhs(q), to_bhs(k), to_bhs(v), to_bhs(g), to_bhs(beta))
    o = jnp.swapaxes(o, 1, 2)
    o = o * lax.rsqrt(jnp.mean(o * o, -1, keepdims=True) + RMS_EPS) * norm_w.astype(jnp.float32)
    o = o * jax.nn.silu(z.reshape(B, S, GDN_V_HEADS, GDN_HEAD_DIM).astype(jnp.float32))
    return o.reshape(B, S, GDN_VAL_DIM).astype(x.dtype) @ w_out


def stick_breaking_attention(x, w_in, w_out):
    B, S, _ = x.shape
    proj = x @ w_in
    heads = lambda t: t.reshape(B, S, SB_HEADS, SB_HEAD_DIM).transpose(0, 2, 1, 3)
    q = heads(proj[..., :SB_DIM])
    k = heads(proj[..., SB_DIM:2 * SB_DIM])
    v = heads(proj[..., 2 * SB_DIM:])
    scale = SB_HEAD_DIM ** -0.5
    outs = []
    for i in range(S // SB_BLOCK):
        lo, hi = i * SB_BLOCK, (i + 1) * SB_BLOCK
        z = jnp.einsum('bhtd,bhsd->bhts', q[:, :, lo:hi], k[:, :, :hi]).astype(jnp.float32) * scale
        t_pos = lo + jnp.arange(SB_BLOCK)[:, None]
        s_pos = jnp.arange(hi)[None, :]
        causal = s_pos < t_pos
        log_keep = jnp.where(causal, jax.nn.log_sigmoid(-z), 0.0)
        later = lax.cumsum(log_keep, axis=3, reverse=True) - log_keep
        attn = jnp.where(causal, jnp.exp(jax.nn.log_sigmoid(z) + later), 0.0)
        outs.append(jnp.einsum('bhts,bhsd->bhtd', attn.astype(v.dtype), v[:, :, :hi]))
    o = jnp.concatenate(outs, axis=2)
    return o.transpose(0, 2, 1, 3).reshape(B, S, SB_DIM) @ w_out


def swiglu(x, w_gate, w_up, w_down):
    return (jax.nn.silu(x @ w_gate) * (x @ w_up)) @ w_down


def moe_swiglu(x, router, w_gate, w_up, w_down):
    B, S, D = x.shape
    xt = x.reshape(-1, D)
    logits = (xt @ router).astype(jnp.float32)
    top_val, top_idx = lax.top_k(logits, TOP_K)
    gates = jax.nn.softmax(top_val, axis=-1)
    combine = jnp.sum(jax.nn.one_hot(top_idx, N_EXPERTS, dtype=jnp.float32) * gates[..., None], axis=1)
    combine = combine.astype(x.dtype)
    y = jnp.zeros_like(xt)
    for e in range(N_EXPERTS):
        y = y + combine[:, e:e + 1] * swiglu(xt, w_gate[e], w_up[e], w_down[e])
    return y.reshape(B, S, D)


def setup_inputs(seed: int = 0) -> dict:
    key = jax.random.key(seed)
    ks = jax.random.split(key, 20)
    f32 = jnp.float32

    def nrm(k, shape, scale):
        return jax.random.normal(k, shape, f32) * scale

    x = nrm(ks[0], (BATCH, SEQ, D_MODEL), 1.0)
    gdn_cols = jnp.ones((GDN_IN_DIM,), f32).at[2 * GDN_KEY_DIM:GDN_CONV_DIM].set(DEEPNORM_BETA)
    gdn_w_in = nrm(ks[1], (N_GDN_LAYERS, D_MODEL, GDN_IN_DIM), D_MODEL ** -0.5) * gdn_cols
    gdn_conv_w = nrm(ks[2], (N_GDN_LAYERS, GDN_CONV_K, GDN_CONV_DIM), GDN_CONV_K ** -0.5)
    gdn_a_log = jnp.log(jax.random.uniform(ks[3], (N_GDN_LAYERS, GDN_V_HEADS), f32, 1.0, 16.0))
    dt = jnp.exp(jax.random.uniform(ks[4], (N_GDN_LAYERS, GDN_V_HEADS), f32, math.log(1e-3), math.log(1e-1)))
    gdn_dt_bias = dt + jnp.log(-jnp.expm1(-dt))
    gdn_norm_w = 1.0 + nrm(ks[5], (N_GDN_LAYERS, GDN_HEAD_DIM), 0.02)
    gdn_w_out = nrm(ks[6], (N_GDN_LAYERS, GDN_VAL_DIM, D_MODEL), GDN_VAL_DIM ** -0.5 * DEEPNORM_BETA)
    sb_cols = jnp.ones((3 * SB_DIM,), f32).at[2 * SB_DIM:].set(DEEPNORM_BETA)
    sb_w_in = nrm(ks[7], (N_SB_LAYERS, D_MODEL, 3 * SB_DIM), D_MODEL ** -0.5) * sb_cols
    sb_w_out = nrm(ks[8], (N_SB_LAYERS, SB_DIM, D_MODEL), SB_DIM ** -0.5 * DEEPNORM_BETA)
    ffn_w_gate = nrm(ks[9], (N_GDN_LAYERS, D_MODEL, FF_DIM), D_MODEL ** -0.5)
    ffn_w_up = nrm(ks[10], (N_GDN_LAYERS, D_MODEL, FF_DIM), D_MODEL ** -0.5)
    ffn_w_down = nrm(ks[11], (N_GDN_LAYERS, FF_DIM, D_MODEL), FF_DIM ** -0.5 * DEEPNORM_BETA)
    moe_router = nrm(ks[12], (N_SB_LAYERS, D_MODEL, N_EXPERTS), D_MODEL ** -0.5)
    moe_w_gate = nrm(ks[13], (N_SB_LAYERS, N_EXPERTS, D_MODEL, FF_DIM), D_MODEL ** -0.5)
    moe_w_up = nrm(ks[14], (N_SB_LAYERS, N_EXPERTS, D_MODEL, FF_DIM), D_MODEL ** -0.5)
    moe_w_down = nrm(ks[15], (N_SB_LAYERS, N_EXPERTS, FF_DIM, D_MODEL), FF_DIM ** -0.5 * DEEPNORM_BETA)
    ln_g = 1.0 + nrm(ks[16], (DEPTH, 2, D_MODEL), 0.02)
    ln_b = nrm(ks[17], (DEPTH, 2, D_MODEL), 0.02)
    return {'x': x, 'gdn_w_in': gdn_w_in, 'gdn_conv_w': gdn_conv_w, 'gdn_a_log': gdn_a_log,
            'gdn_dt_bias': gdn_dt_bias, 'gdn_norm_w': gdn_norm_w, 'gdn_w_out': gdn_w_out,
            'sb_w_in': sb_w_in, 'sb_w_out': sb_w_out,
            'ffn_w_gate': ffn_w_gate, 'ffn_w_up': ffn_w_up, 'ffn_w_down': ffn_w_down,
            'moe_router': moe_router, 'moe_w_gate': moe_w_gate, 'moe_w_up': moe_w_up,
            'moe_w_down': moe_w_down, 'ln_g': ln_g, 'ln_b': ln_b}


def reference(x, gdn_w_in, gdn_conv_w, gdn_a_log, gdn_dt_bias, gdn_norm_w, gdn_w_out,
              sb_w_in, sb_w_out, ffn_w_gate, ffn_w_up, ffn_w_down,
              moe_router, moe_w_gate, moe_w_up, moe_w_down, ln_g, ln_b):
    h = x
    for i in range(DEPTH):
        j = i // N_MIXERS
        if i % N_MIXERS == 0:
            mix = gated_deltanet(h, gdn_w_in[j], gdn_conv_w[j], gdn_a_log[j], gdn_dt_bias[j],
                                 gdn_norm_w[j], gdn_w_out[j])
        else:
            mix = stick_breaking_attention(h, sb_w_in[j], sb_w_out[j])
        h = layer_norm(DEEPNORM_ALPHA * h + mix, ln_g[i, 0], ln_b[i, 0])
        if i % 2 == 0:
            ff = swiglu(h, ffn_w_gate[j], ffn_w_up[j], ffn_w_down[j])
        else:
            ff = moe_swiglu(h, moe_router[j], moe_w_gate[j], moe_w_up[j], moe_w_down[j])
        h = layer_norm(DEEPNORM_ALPHA * h + ff, ln_g[i, 1], ln_b[i, 1])
    return h
```

```cpp
#include <hip/hip_runtime.h>
#include <cstdio>
#include <cstdint>
#ifndef MK_ONE_LAUNCH
#define MK_ONE_LAUNCH 0
#endif
namespace pg8 {
#define PG8_LAS __attribute__((address_space(3)))
typedef unsigned short bf16_t;
typedef short bf16x8 __attribute__((ext_vector_type(8)));
typedef float f32x4 __attribute__((ext_vector_type(4)));
typedef unsigned u32x4 __attribute__((ext_vector_type(4)));
constexpr int BM = 256, BK = 64, HALF = 128, HTB = HALF * BK * 2  , STAGE_BYTES = 8 * HTB, NXCD = 8, WGM = 8;

__host__ __device__ __forceinline__ int lds_byte(int r, int c) { const int st = (r >> 4) * 2 + (c >> 5), rr = r & 15, cc = c & 31, ob = rr * 64 + cc * 2; return st * 1024 + (ob ^ (((ob >> 9) & 1) << 5)); }
__host__ __device__ __forceinline__ void stage_rc(int b, int& R, int& C) { const int st = b / 1024, sb = b % 1024, swz = sb ^ (((sb >> 9) & 1) << 5); R = (st >> 1) * 16 + swz / 64; C = (st & 1) * 32 + (swz % 64) / 2; }
__host__ __device__ __forceinline__ int perm32(int rho) { const int n = rho >> 4, i = rho & 15; return 8 * (i >> 2) + 4 * n + (i & 3); }

struct Unit { int pm, pn; };
struct Gemm { const bf16_t* A; const bf16_t* Bt; int lda, K; };

struct StaticOrder {
    int nM, nN, nwg, G, c;
    __host__ __device__ void init(int M, int N, int G_, int c_) { nM = M / BM; nN = N / BM; nwg = nM * nN; G = G_; c = c_; }
    __host__ __device__ bool next(int i, Unit& u) const {
        const long L = (long)i * G + c; if (L >= nwg) return false;
        int wgid = (int)L; { const int q = nwg / NXCD, r = nwg % NXCD, xcd = wgid % NXCD, off = wgid / NXCD; wgid = (xcd < r ? xcd * (q + 1) : r * (q + 1) + (xcd - r) * q) + off; }
        const int nig = WGM * nN, gid = wgid / nig, fm = gid * WGM, gsz = (nM - fm) < WGM ? (nM - fm) : WGM;
        u.pm = fm + ((wgid % nig) % gsz); u.pn = (wgid % nig) / gsz; return true;
    }
    __device__ __forceinline__ void a_ready(const Unit&) const {}
    __device__ __forceinline__ void done(const Unit&) const {}
};

__device__ __forceinline__ unsigned cvt_pk_bf16(float lo, float hi) { unsigned r; asm volatile("v_cvt_pk_bf16_f32 %0, %1, %2" : "=v"(r) : "v"(lo), "v"(hi)); return r; }
struct EpiBf16 {
    static constexpr bool PERM = true, AFTER_DRAIN = false;
    bf16_t* O; int ldc; int nmod;
    __device__ __forceinline__ void operator()(const f32x4 (&acc)[2][2][4][2], const Unit& u, int wr, int wc, int fr, int fq) const {
        const int pnl = nmod ? (u.pn % nmod) : u.pn;
        const int row0 = u.pm * BM + wr * 64 + fr, col0 = pnl * BM + wc * 32 + 8 * fq;
#pragma unroll
        for (int ai = 0; ai < 2; ++ai)
#pragma unroll
            for (int m = 0; m < 4; ++m) { bf16_t* rowp = O + (size_t)(row0 + ai * HALF + m * 16) * ldc + col0;
#pragma unroll
                for (int bj = 0; bj < 2; ++bj) { const f32x4 v0 = acc[ai][bj][m][0], v1 = acc[ai][bj][m][1];
                    u32x4 w; w.x = cvt_pk_bf16(v0[0], v0[1]); w.y = cvt_pk_bf16(v0[2], v0[3]); w.z = cvt_pk_bf16(v1[0], v1[1]); w.w = cvt_pk_bf16(v1[2], v1[3]);
                    *(u32x4*)(rowp + bj * HALF) = w; } }
    }
};
__device__ __forceinline__ float silu_f(float x) { return x * __builtin_amdgcn_rcpf(1.0f + __builtin_amdgcn_exp2f(-1.4426950408889634f * x)); }
struct EpiSwiGLU {
    static constexpr bool PERM = true, AFTER_DRAIN = false;
    bf16_t* O; int ldc; int nmod;
    __device__ __forceinline__ void operator()(const f32x4 (&acc)[2][2][4][2], const Unit& u, int wr, int wc, int fr, int fq) const {
        const int pnl = nmod ? (u.pn % nmod) : u.pn;
        const int row0 = u.pm * BM + wr * 64 + fr, col0 = pnl * HALF + wc * 32 + 8 * fq;
#pragma unroll
        for (int ai = 0; ai < 2; ++ai)
#pragma unroll
            for (int m = 0; m < 4; ++m) { bf16_t* rowp = O + (size_t)(row0 + ai * HALF + m * 16) * ldc + col0;
                const f32x4 g0 = acc[ai][0][m][0], g1 = acc[ai][0][m][1], u0 = acc[ai][1][m][0], u1 = acc[ai][1][m][1];
                u32x4 w;
                w.x = cvt_pk_bf16(silu_f(g0[0]) * u0[0], silu_f(g0[1]) * u0[1]); w.y = cvt_pk_bf16(silu_f(g0[2]) * u0[2], silu_f(g0[3]) * u0[3]);
                w.z = cvt_pk_bf16(silu_f(g1[0]) * u1[0], silu_f(g1[1]) * u1[1]); w.w = cvt_pk_bf16(silu_f(g1[2]) * u1[2], silu_f(g1[3]) * u1[3]);
                *(u32x4*)rowp = w; }
    }
};
struct EpiResid {
    static constexpr bool PERM = false, AFTER_DRAIN = false;
    const float* res; float* out; int ldc; float alpha;
    __device__ __forceinline__ void operator()(const f32x4 (&acc)[2][2][4][2], const Unit& u, int wr, int wc, int fr, int fq) const {
        const int row0 = u.pm * BM + wr * 64 + fr, col0 = u.pn * BM + wc * 32 + 4 * fq;
#pragma unroll
        for (int ai = 0; ai < 2; ++ai)
#pragma unroll
            for (int m = 0; m < 4; ++m) { const size_t off = (size_t)(row0 + ai * HALF + m * 16) * ldc + col0;
#pragma unroll
                for (int bj = 0; bj < 2; ++bj)
#pragma unroll
                    for (int n = 0; n < 2; ++n) { const f32x4 r = *(const f32x4*)(res + off + bj * HALF + n * 16);
                        *(f32x4*)(out + off + bj * HALF + n * 16) = r * alpha + acc[ai][bj][m][n]; } }
    }
};
struct MoeOrder {
    int nM, nN, nwg, G, c; int ps1, ps2, ps3, ps4, ps5, ps6, ps7;
    __device__ __forceinline__ bool next(int i, Unit& u) const {
        const long L = (long)i * G + c; if (L >= nwg) return false;
        int wgid = (int)L; { const int q = nwg / NXCD, r = nwg % NXCD, xcd = wgid % NXCD, off = wgid / NXCD; wgid = (xcd < r ? xcd * (q + 1) : r * (q + 1) + (xcd - r) * q) + off; }
        const int nig = WGM * nN, gid = wgid / nig, fm = gid * WGM, gsz = (nM - fm) < WGM ? (nM - fm) : WGM;
        const int pm = fm + ((wgid % nig) % gsz), pnl = (wgid % nig) / gsz;
        const int e = (pm >= ps1) + (pm >= ps2) + (pm >= ps3) + (pm >= ps4) + (pm >= ps5) + (pm >= ps6) + (pm >= ps7);
        u.pm = pm; u.pn = e * nN + pnl; return true;
    }
    __device__ __forceinline__ void a_ready(const Unit&) const {}
    __device__ __forceinline__ void done(const Unit&) const {}
};
template <class Epi, class Sched, bool ALIGN_EPI = false, bool SP2 = false>
__device__ __forceinline__ void gemm_phase(PG8_LAS unsigned char* lds, const Gemm g, const Sched& S, const Epi& E) {
    const int tid = threadIdx.x, wid = __builtin_amdgcn_readfirstlane(tid >> 6), lane = tid & 63, wr = wid >> 2, wc = wid & 3, fr = lane & 15, fq = lane >> 4;
    const int K = g.K, nt = K / BK;
    unsigned voffA[2], voffB[2];
#pragma unroll
    for (int i = 0; i < 2; ++i) { int R, C; stage_rc(tid * 16 + i * 8192, R, C); const int Rb = Epi::PERM ? ((R & ~31) + perm32(R & 31)) : R;
        voffA[i] = (unsigned)(R * g.lda + C) * 2u; voffB[i] = (unsigned)(Rb * K + C) * 2u; }
    const size_t kstep = (size_t)(BK * 2);
    const size_t hstepA = (size_t)HALF * g.lda * 2, hstepB = (size_t)HALF * K * 2;
    const size_t tstepA = 2 * hstepA, tstepB = 2 * hstepB;
    const unsigned ldsw = (unsigned)wid * 1024u;
    const int aoff = lds_byte(wr * 64 + fr, fq * 8), boff = lds_byte(wc * 32 + fr, fq * 8);
#define PG8_SA(b, h) (((b) * 2 + (h)) * HTB)
#define PG8_SB(b, h) ((4 + (b) * 2 + (h)) * HTB)
#define PG8_STAGE(bufoff, gbase, voff) do { _Pragma("unroll") for (int _i = 0; _i < 2; ++_i) \
        __builtin_amdgcn_global_load_lds((const unsigned*)((const char*)(gbase) + (voff)[_i]), (PG8_LAS unsigned*)(lds + (bufoff) + ldsw + _i * 8192), 16, 0, 0); } while (0)
#define PG8_LDA(dst, b, h) do { _Pragma("unroll") for (int m = 0; m < 4; ++m) _Pragma("unroll") for (int k = 0; k < 2; ++k) dst[m][k] = *(const PG8_LAS bf16x8*)(lds + PG8_SA(b, h) + aoff + m * 2048 + k * 1024); } while (0)
#define PG8_LDB(dst, b, h) do { _Pragma("unroll") for (int n = 0; n < 2; ++n) _Pragma("unroll") for (int k = 0; k < 2; ++k) dst[n][k] = *(const PG8_LAS bf16x8*)(lds + PG8_SB(b, h) + boff + n * 2048 + k * 1024); } while (0)
#define PG8_MMA(ai, bj, At, Bt) do { __builtin_amdgcn_s_setprio(1); _Pragma("unroll") for (int m = 0; m < 4; ++m) _Pragma("unroll") for (int n = 0; n < 2; ++n) _Pragma("unroll") for (int k = 0; k < 2; ++k) \
        acc[ai][bj][m][n] = __builtin_amdgcn_mfma_f32_16x16x32_bf16(Bt[n][k], At[m][k], acc[ai][bj][m][n], 0, 0, 0); __builtin_amdgcn_s_setprio(0); } while (0)
#define PG8_WAIT_V(n) asm volatile("s_waitcnt vmcnt(" #n ")" ::: "memory")
#define PG8_WAIT_L(n) asm volatile("s_waitcnt lgkmcnt(" #n ")" ::: "memory")
#define PG8_BAR __builtin_amdgcn_s_barrier()
#define PG8_SCHED __builtin_amdgcn_sched_barrier(0)
    Unit cur, nxt; int ui = 0;
    if (!S.next(0, cur)) return;
    f32x4 acc[2][2][4][2];
#pragma unroll
    for (int a = 0; a < 2; ++a)
#pragma unroll
        for (int b = 0; b < 2; ++b)
#pragma unroll
            for (int m = 0; m < 4; ++m)
#pragma unroll
                for (int n = 0; n < 2; ++n) acc[a][b][m][n] = (f32x4){0.f, 0.f, 0.f, 0.f};
    bf16x8 At[4][2], B0[2][2], B1[2][2];
    const char* cA = (const char*)g.A + (size_t)cur.pm * tstepA; const char* cB = (const char*)g.Bt + (size_t)cur.pn * tstepB;
    S.a_ready(cur);
    if constexpr (SP2) {
        PG8_STAGE(PG8_SB(0, 0), cB, voffB); PG8_STAGE(PG8_SB(0, 1), cB + hstepB, voffB); PG8_STAGE(PG8_SA(0, 0), cA, voffA); PG8_STAGE(PG8_SA(0, 1), cA + hstepA, voffA);
        if (wr == 1) PG8_BAR;
        PG8_WAIT_V(2); PG8_BAR;
        PG8_STAGE(PG8_SB(1, 0), cB + kstep, voffB); PG8_STAGE(PG8_SA(1, 0), cA + kstep, voffA); PG8_STAGE(PG8_SB(1, 1), cB + hstepB + kstep, voffB);
        PG8_WAIT_V(6); PG8_BAR;
    } else {
        PG8_STAGE(PG8_SB(0, 0), cB, voffB); PG8_STAGE(PG8_SA(0, 0), cA, voffA); PG8_STAGE(PG8_SB(0, 1), cB + hstepB, voffB); PG8_STAGE(PG8_SA(0, 1), cA + hstepA, voffA);
        if (wr == 1) PG8_BAR;
        PG8_WAIT_V(4); PG8_BAR;
        PG8_STAGE(PG8_SB(1, 0), cB + kstep, voffB); PG8_STAGE(PG8_SA(1, 0), cA + kstep, voffA); PG8_STAGE(PG8_SB(1, 1), cB + hstepB + kstep, voffB);
        PG8_WAIT_V(6); PG8_BAR;
    }
    for (;;) {
        const bool has_next = S.next(ui + 1, nxt);
        const char* nA = has_next ? (const char*)g.A + (size_t)nxt.pm * tstepA : cA; const char* nB = has_next ? (const char*)g.Bt + (size_t)nxt.pn * tstepB : cB;
        for (int t = 0; t < nt; t += 2) {
            const bool last = (t == nt - 2);
            const char* a1 = cA + (size_t)(t + 1) * kstep;
            const char* a2 = last ? nA : cA + (size_t)(t + 2) * kstep; const char* b2 = last ? nB : cB + (size_t)(t + 2) * kstep;
            const char* a3 = a2 + kstep; const char* b3 = b2 + kstep;
            if (last && has_next) S.a_ready(nxt);
            if constexpr (SP2) {
            PG8_LDB(B0, 0, 0); PG8_LDB(B1, 0, 1); PG8_SCHED; PG8_LDA(At, 0, 0); PG8_STAGE(PG8_SA(1, 1), a1 + hstepA, voffA);
            PG8_WAIT_V(8); PG8_WAIT_L(0); PG8_BAR; PG8_MMA(0, 0, At, B0); PG8_MMA(0, 1, At, B1); PG8_BAR; PG8_SCHED;
            PG8_LDA(At, 0, 1); PG8_STAGE(PG8_SB(0, 0), b2, voffB); PG8_STAGE(PG8_SB(0, 1), b2 + hstepB, voffB); PG8_STAGE(PG8_SA(0, 0), a2, voffA);
            PG8_WAIT_V(8); PG8_WAIT_L(0); PG8_BAR; PG8_MMA(1, 0, At, B0); PG8_MMA(1, 1, At, B1); PG8_BAR; PG8_SCHED;
            PG8_LDB(B0, 1, 0); PG8_LDB(B1, 1, 1); PG8_SCHED; PG8_LDA(At, 1, 0); PG8_STAGE(PG8_SA(0, 1), a2 + hstepA, voffA);
            PG8_WAIT_V(8); PG8_WAIT_L(0); PG8_BAR; PG8_MMA(0, 0, At, B0); PG8_MMA(0, 1, At, B1); PG8_BAR; PG8_SCHED;
            PG8_LDA(At, 1, 1); PG8_STAGE(PG8_SB(1, 0), b3, voffB); PG8_STAGE(PG8_SB(1, 1), b3 + hstepB, voffB); PG8_STAGE(PG8_SA(1, 0), a3, voffA);
            PG8_WAIT_V(8); PG8_WAIT_L(0); PG8_BAR; PG8_MMA(1, 0, At, B0); PG8_MMA(1, 1, At, B1); PG8_BAR; PG8_SCHED;
            } else {
            PG8_LDB(B0, 0, 0); PG8_SCHED; PG8_LDA(At, 0, 0); PG8_STAGE(PG8_SA(1, 1), a1 + hstepA, voffA);
            PG8_WAIT_L(8); PG8_BAR; PG8_WAIT_L(0); PG8_MMA(0, 0, At, B0); PG8_BAR; PG8_SCHED;
            PG8_LDB(B1, 0, 1); PG8_STAGE(PG8_SB(0, 0), b2, voffB);
            PG8_BAR; PG8_WAIT_L(0); PG8_MMA(0, 1, At, B1); PG8_BAR;
            PG8_LDA(At, 0, 1); PG8_STAGE(PG8_SA(0, 0), a2, voffA);
            PG8_BAR; PG8_WAIT_L(0); PG8_MMA(1, 0, At, B0); PG8_BAR; PG8_SCHED;
            PG8_STAGE(PG8_SB(0, 1), b2 + hstepB, voffB);
            PG8_WAIT_V(6); PG8_BAR; PG8_MMA(1, 1, At, B1); PG8_BAR;
            PG8_LDB(B0, 1, 0); PG8_SCHED; PG8_LDA(At, 1, 0); PG8_STAGE(PG8_SA(0, 1), a2 + hstepA, voffA);
            PG8_WAIT_L(8); PG8_BAR; PG8_WAIT_L(0); PG8_MMA(0, 0, At, B0); PG8_BAR; PG8_SCHED;
            PG8_LDB(B1, 1, 1); PG8_STAGE(PG8_SB(1, 0), b3, voffB);
            PG8_BAR; PG8_WAIT_L(0); PG8_MMA(0, 1, At, B1); PG8_BAR;
            PG8_LDA(At, 1, 1); PG8_STAGE(PG8_SA(1, 0), a3, voffA);
            PG8_BAR; PG8_WAIT_L(0); PG8_MMA(1, 0, At, B0); PG8_BAR; PG8_SCHED;
            PG8_STAGE(PG8_SB(1, 1), b3 + hstepB, voffB);
            PG8_WAIT_V(6); PG8_BAR; PG8_MMA(1, 1, At, B1); PG8_BAR;
            }
        }
        if constexpr (ALIGN_EPI) { if (wr == 0) PG8_BAR; }
        if constexpr (!Epi::AFTER_DRAIN) { E(acc, cur, wr, wc, fr, fq); S.done(cur); }
        if (!has_next) break;
#pragma unroll
        for (int a = 0; a < 2; ++a)
#pragma unroll
            for (int b = 0; b < 2; ++b)
#pragma unroll
                for (int m = 0; m < 4; ++m)
#pragma unroll
                    for (int n = 0; n < 2; ++n) acc[a][b][m][n] = (f32x4){0.f, 0.f, 0.f, 0.f};
        cur = nxt; cA = nA; cB = nB; ++ui;
        if constexpr (ALIGN_EPI) { if (wr == 1) PG8_BAR; }
    }
    PG8_WAIT_V(0);
    if constexpr (!ALIGN_EPI) { if (wr == 0) PG8_BAR; }
    PG8_BAR;
    if constexpr (Epi::AFTER_DRAIN) { E.fused(acc, cur, wr, wc, fr, fq, lds, wid, lane); S.done(cur); }
#undef PG8_SA
#undef PG8_SB
#undef PG8_STAGE
#undef PG8_LDA
#undef PG8_LDB
#undef PG8_MMA
#undef PG8_WAIT_V
#undef PG8_WAIT_L
#undef PG8_BAR
#undef PG8_SCHED
}
}

constexpr int NWAVES = 8;
constexpr int BATCH = 8, SEQ = 4096, TT = BATCH * SEQ, D = 1024;
constexpr int HK = 8, HV = 16, HD = 128;
constexpr int GIN = 6176, GINP = 6400;
constexpr int FF = 3584, NE = 8, MOE_ROWS = 67584;
constexpr float ALPHA = 1.6817928305074290f;
constexpr float LN_EPS = 1e-5f, RMS_EPS = 1e-6f;
constexpr int NPH = 17, NPHASES = 2 * NPH;

constexpr size_t MiB = 1ull << 20;
constexpr size_t WS_CTL = 0, CTL_ZERO_BYTES = 1 * MiB;
constexpr size_t WS_E12 = 1 * MiB;
constexpr size_t WS_G12 = WS_E12 + 256 * 1024;
constexpr size_t WS_POS = WS_G12 + 256 * 1024;
constexpr size_t WS_GB = 2 * MiB;
constexpr size_t WS_W = 16 * MiB;
constexpr size_t W_IN = WS_W, W_OUT = WS_W + 13 * MiB, W_GU = WS_W + 17 * MiB, W_D = WS_W + 31 * MiB;
constexpr size_t W_QKV = WS_W, W_O = WS_W + 6 * MiB, W_MGU = WS_W + 8 * MiB, W_MD = WS_W + 120 * MiB;
constexpr size_t WS_HB = 192 * MiB;
constexpr size_t WS_BIG = 256 * MiB;
constexpr size_t WS_PROJ = WS_BIG, WS_QKVC = WS_BIG + 400 * MiB;
constexpr size_t WS_ACT = WS_BIG;
constexpr size_t WS_QKV = WS_BIG, WS_AO = WS_BIG + 192 * MiB;
constexpr size_t WS_XS = WS_BIG, WS_MACT = WS_BIG + 132 * MiB;
constexpr size_t WS_END = 912 * MiB;
static_assert(WS_QKVC + (size_t)TT * 4096 * 2 <= WS_END && WS_MACT + (size_t)MOE_ROWS * FF * 2 <= WS_END && WS_PROJ + (size_t)TT * GINP * 2 <= WS_QKVC, "d_ws map");
static_assert(W_MD + (size_t)NE * D * FF * 2 <= WS_HB && W_IN + (size_t)GINP * D * 2 <= W_OUT && W_MGU + (size_t)NE * 2 * FF * D * 2 <= W_MD, "weight map");
constexpr int CW_BAR = 4096;
constexpr int CW_CNT = 16384;

constexpr int RING_BYTES = 131072;
constexpr int MISC_OFF = RING_BYTES + 320;
constexpr int LDS_BYTES = 147456;

#define GAS __attribute__((address_space(1)))
#define LAS __attribute__((address_space(3)))
#define DI __device__ __forceinline__
typedef unsigned short bf16;
typedef unsigned v4u __attribute__((ext_vector_type(4)));
typedef unsigned v2u __attribute__((ext_vector_type(2)));
typedef float f32x4 __attribute__((ext_vector_type(4)));
typedef float f32x2 __attribute__((ext_vector_type(2)));
typedef GAS unsigned gu32;
#define RLX_AGENT __ATOMIC_RELAXED, __HIP_MEMORY_SCOPE_AGENT
#define LDS_WAIT() asm volatile("s_waitcnt lgkmcnt(0)" ::: "memory")
#define VM_WAIT() asm volatile("s_waitcnt vmcnt(0)" ::: "memory")
__device__ __forceinline__ unsigned long long rt() { return __builtin_amdgcn_s_memrealtime(); }
__device__ __forceinline__ unsigned f2bf(float f) { unsigned u = __builtin_bit_cast(unsigned, f); return (u + 0x7fffu + ((u >> 16) & 1u)) >> 16; }
__device__ __forceinline__ unsigned pk2(float lo, float hi) { return f2bf(lo) | (f2bf(hi) << 16); }

#define XB_TMO      128
#define XB_XCNT(j)  (256  + 64 * (j))
#define XB_XSUB(j)  (1280 + 64 * (j))
#define XB_XGEN(j)  (2304 + 64 * (j))
#define XB_TOP      3328
#define XB_TOPGEN   3392
#define XCD_BAR_WORDS 3456
#define XB_SPIN_CAP (1u << 22)

__device__ __forceinline__ unsigned xb_ld(unsigned* p)              { return __hip_atomic_load(p, __ATOMIC_RELAXED, __HIP_MEMORY_SCOPE_AGENT); }
__device__ __forceinline__ unsigned xb_add(unsigned* p, unsigned v) { return __hip_atomic_fetch_add(p, v, __ATOMIC_RELAXED, __HIP_MEMORY_SCOPE_AGENT); }
__device__ __forceinline__ unsigned xb_xcc_id() { return (unsigned)__builtin_amdgcn_s_getreg((3 << 11) | 20) & 0xFu; }
#define XB_SPIN(cond, bar) do { unsigned _sp = 0; while (cond) { __builtin_amdgcn_s_sleep(1); \
    if ((++_sp & 255u) == 0u) { if (xb_ld(&(bar)[XB_TMO])) break; if (_sp > XB_SPIN_CAP) { atomicAdd(&(bar)[XB_TMO], 1u); break; } } } } while (0)

struct XcdBarrier {
    unsigned* bar; unsigned x;
    volatile LAS unsigned* st;
};

__device__ __forceinline__ XcdBarrier xcd_barrier_post(unsigned* bar, volatile LAS unsigned* st) {
    XcdBarrier b; b.bar = bar; b.x = xb_xcc_id(); b.st = st;
    if (threadIdx.x == 0) (void)xb_add(&bar[XB_XCNT(b.x)], 1u);
    return b;
}
__device__ __forceinline__ void xcd_barrier_complete(unsigned* bar, unsigned x, unsigned& nloc, unsigned& nx) {
    const unsigned G = gridDim.x * gridDim.y * gridDim.z;
    unsigned sum, cnt, mine, sp = 0u;
    for (;;) {
        sum = 0u; cnt = 0u; mine = 0u;
#pragma unroll
        for (unsigned j = 0; j < 16; ++j) { const unsigned c = xb_ld(&bar[XB_XCNT(j)]); sum += c; cnt += (c > 0u) ? 1u : 0u; mine = (j == x) ? c : mine; }
        if (sum == G) break;
        __builtin_amdgcn_s_sleep(1);
        if ((++sp & 255u) == 0u) { if (xb_ld(&bar[XB_TMO])) break; if (sp > XB_SPIN_CAP) { atomicAdd(&bar[XB_TMO], 1u); break; } }
    }
    nloc = mine > 0u ? mine : 1u; nx = cnt > 0u ? cnt : 1u;
}

__device__ __forceinline__ void xcd_barrier(const XcdBarrier& b) {
    asm volatile("s_waitcnt vmcnt(0)" ::: "memory");
    __syncthreads();
    if (threadIdx.x == 0) {
        unsigned* bar = b.bar;
        __builtin_amdgcn_s_waitcnt(0);
        unsigned nloc = b.st[0], nx = b.st[1];
        if (nloc == 0u) { xcd_barrier_complete(bar, b.x, nloc, nx); b.st[0] = nloc; b.st[1] = nx; }
        const unsigned old = xb_add(&bar[XB_XSUB(b.x)], 1u);
        const unsigned gen = old / nloc;
        if (old + 1u == (gen + 1u) * nloc) {
            __builtin_amdgcn_fence(__ATOMIC_RELEASE, "agent");
            asm volatile("s_waitcnt vmcnt(0)" ::: "memory");
            const unsigned og = xb_add(&bar[XB_TOP], 1u);
            const unsigned tg = og / nx;
            if (og + 1u == (tg + 1u) * nx) xb_add(&bar[XB_TOPGEN], 1u);
            else XB_SPIN(xb_ld(&bar[XB_TOPGEN]) == tg, bar);
            __builtin_amdgcn_fence(__ATOMIC_ACQUIRE, "agent");
            xb_add(&bar[XB_XGEN(b.x)], 1u);
            asm volatile("s_waitcnt vmcnt(0)" ::: "memory");
        } else {
            XB_SPIN(xb_ld(&bar[XB_XGEN(b.x)]) == gen, bar);
            __builtin_amdgcn_fence(__ATOMIC_ACQUIRE, "agent");
            asm volatile("s_waitcnt vmcnt(0)" ::: "memory");
        }
    }
    __syncthreads();
}

DI float bf_lo(unsigned w) { return __uint_as_float(w << 16); }
DI float bf_hi(unsigned w) { return __uint_as_float(w & 0xffff0000u); }
DI float wave_sum(float v) {
#pragma unroll
    for (int o = 1; o < 64; o <<= 1) v += __shfl_xor(v, o);
    return v;
}
DI float sigmoid_f(float x) { return 1.0f / (1.0f + __expf(-x)); }

struct Args {
    const float *x, *gdn_w_in, *gdn_conv_w, *gdn_a_log, *gdn_dt_bias, *gdn_norm_w, *gdn_w_out, *sb_w_in, *sb_w_out, *ffn_w_gate, *ffn_w_up, *ffn_w_down,
                *moe_router, *moe_w_gate, *moe_w_up, *moe_w_down, *ln_g, *ln_b;
    float* out; unsigned char* ws; int ph_lo, ph_hi;
};

DI void transpose_item(const float* W, int ldw, bf16* WT, int K, int drow0, int k0, int n0, LAS float* scr, int lane) {
#pragma unroll 8
    for (int i = 0; i < 32; ++i) { const int kk = 2 * i + (lane >> 5); scr[kk * 33 + (lane & 31)] = W[(size_t)(k0 + kk) * ldw + n0 + (lane & 31)]; }
    LDS_WAIT(); asm volatile("" ::: "memory");
    const int c = lane & 7;
#pragma unroll
    for (int jj = 0; jj < 4; ++jj) { const int n = (lane >> 3) + 8 * jj; const LAS float* s = scr + (8 * c) * 33 + n;
        v4u o; o.x = pk2(s[0 * 33], s[1 * 33]); o.y = pk2(s[2 * 33], s[3 * 33]); o.z = pk2(s[4 * 33], s[5 * 33]); o.w = pk2(s[6 * 33], s[7 * 33]);
        *(v4u*)(WT + (size_t)(drow0 + n) * K + k0 + 8 * c) = o; }
    LDS_WAIT(); asm volatile("" ::: "memory");
}

DI void phase_w_gdn(const Args& a, int j, LAS unsigned char* lds, int bid, int G, int tid, int wave, int lane) {
    LAS float* scr = (LAS float*)(lds + wave * 16384);
    const int gw = bid * NWAVES + wave, NGW = G * NWAVES;
    const float* Win = a.gdn_w_in + (size_t)j * D * GIN; const float* Wout = a.gdn_w_out + (size_t)j * 2048 * D;
    const float* Wg = a.ffn_w_gate + (size_t)j * D * FF; const float* Wu = a.ffn_w_up + (size_t)j * D * FF; const float* Wd = a.ffn_w_down + (size_t)j * FF * D;
    bf16* WIN_T = (bf16*)(a.ws + W_IN); bf16* WOUT_T = (bf16*)(a.ws + W_OUT); bf16* WGU_T = (bf16*)(a.ws + W_GU); bf16* WD_T = (bf16*)(a.ws + W_D);
    constexpr int NB_IN = GIN / 32, I_IN = 16 * NB_IN, I_OUT = 32 * 32, I_G = 16 * 112, I_D = 56 * 32, NIT = I_IN + I_OUT + 2 * I_G + I_D;
    for (int it = gw; it < NIT; it += NGW) {
        int r = it;
        if (r < I_IN) { const int kb = r / NB_IN, nb = r % NB_IN; transpose_item(Win, GIN, WIN_T, D, 32 * nb, 64 * kb, 32 * nb, scr, lane); continue; } r -= I_IN;
        if (r < I_OUT) { const int kb = r / 32, nb = r % 32; transpose_item(Wout, D, WOUT_T, 2048, 32 * nb, 64 * kb, 32 * nb, scr, lane); continue; } r -= I_OUT;
        if (r < I_G) { const int kb = r / 112, nb = r % 112, n0 = 32 * nb; transpose_item(Wg, FF, WGU_T, D, 256 * (n0 >> 7) + (n0 & 127), 64 * kb, n0, scr, lane); continue; } r -= I_G;
        if (r < I_G) { const int kb = r / 112, nb = r % 112, n0 = 32 * nb; transpose_item(Wu, FF, WGU_T, D, 256 * (n0 >> 7) + 128 + (n0 & 127), 64 * kb, n0, scr, lane); continue; } r -= I_G;
        { const int kb = r / 32, nb = r % 32; transpose_item(Wd, D, WD_T, FF, 32 * nb, 64 * kb, 32 * nb, scr, lane); }
    }
    if (j == 0) {
        bf16* HB = (bf16*)(a.ws + WS_HB); const f32x4* x4 = (const f32x4*)a.x;
        for (size_t i = (size_t)bid * 512 + tid; i < (size_t)TT * D / 8; i += (size_t)G * 512) { const f32x4 p = x4[2 * i], q = x4[2 * i + 1];
            v4u o; o.x = pk2(p[0], p[1]); o.y = pk2(p[2], p[3]); o.z = pk2(q[0], q[1]); o.w = pk2(q[2], q[3]); *(v4u*)(HB + 8 * i) = o; }
    }
}
DI void phase_w_sb(const Args& a, int j, LAS unsigned char* lds, int bid, int G, int wave, int lane) {
    LAS float* scr = (LAS float*)(lds + wave * 16384);
    const int gw = bid * NWAVES + wave, NGW = G * NWAVES;
    const float* Wqkv = a.sb_w_in + (size_t)j * D * 3072; const float* Wo = a.sb_w_out + (size_t)j * D * D;
    const float* Mg = a.moe_w_gate + (size_t)j * NE * D * FF; const float* Mu = a.moe_w_up + (size_t)j * NE * D * FF; const float* Md = a.moe_w_down + (size_t)j * NE * FF * D;
    bf16* WQKV_T = (bf16*)(a.ws + W_QKV); bf16* WO_T = (bf16*)(a.ws + W_O); bf16* MGU_T = (bf16*)(a.ws + W_MGU); bf16* MD_T = (bf16*)(a.ws + W_MD);
    constexpr int I_QKV = 16 * 96, I_O = 16 * 32, I_G = 16 * 112, I_D = 56 * 32, I_E = 2 * I_G + I_D, NIT = I_QKV + I_O + NE * I_E;
    for (int it = gw; it < NIT; it += NGW) {
        int r = it;
        if (r < I_QKV) { const int kb = r / 96, nb = r % 96; transpose_item(Wqkv, 3072, WQKV_T, D, 32 * nb, 64 * kb, 32 * nb, scr, lane); continue; } r -= I_QKV;
        if (r < I_O) { const int kb = r / 32, nb = r % 32; transpose_item(Wo, D, WO_T, D, 32 * nb, 64 * kb, 32 * nb, scr, lane); continue; } r -= I_O;
        const int e = r / I_E; r -= e * I_E;
        bf16* gu = MGU_T + (size_t)e * 2 * FF * D; bf16* dn = MD_T + (size_t)e * D * FF;
        if (r < I_G) { const int kb = r / 112, nb = r % 112, n0 = 32 * nb; transpose_item(Mg + (size_t)e * D * FF, FF, gu, D, 256 * (n0 >> 7) + (n0 & 127), 64 * kb, n0, scr, lane); continue; } r -= I_G;
        if (r < I_G) { const int kb = r / 112, nb = r % 112, n0 = 32 * nb; transpose_item(Mu + (size_t)e * D * FF, FF, gu, D, 256 * (n0 >> 7) + 128 + (n0 & 127), 64 * kb, n0, scr, lane); continue; } r -= I_G;
        { const int kb = r / 32, nb = r % 32; transpose_item(Md + (size_t)e * FF * D, D, dn, FF, 32 * nb, 64 * kb, 32 * nb, scr, lane); }
    }
}

DI void phase_conv(const Args& a, int j, int bid, int G, int wave, int lane) {
    const bf16* proj = (const bf16*)(a.ws + WS_PROJ); bf16* qkvc = (bf16*)(a.ws + WS_QKVC); float* gb = (float*)(a.ws + WS_GB);
    const float* cw = a.gdn_conv_w + (size_t)j * 4 * 4096;
    const int gw = bid * NWAVES + wave, NGW = G * NWAVES;
    for (int t = gw; t < TT; t += NGW) {
        const int pos = t & (SEQ - 1);
#pragma unroll 1
        for (int grp = 0; grp < 8; ++grp) {
            const int ch = 512 * grp + 8 * lane;
            float acc[8];
#pragma unroll
            for (int i = 0; i < 8; ++i) acc[i] = 0.f;
#pragma unroll
            for (int tap = 0; tap < 4; ++tap) {
                if (pos - 3 + tap >= 0) {
                    const v4u xv = *(const v4u*)(proj + (size_t)(t - 3 + tap) * GINP + ch);
                    const f32x4 w0 = *(const f32x4*)(cw + tap * 4096 + ch), w1 = *(const f32x4*)(cw + tap * 4096 + ch + 4);
                    acc[0] += w0[0] * bf_lo(xv.x); acc[1] += w0[1] * bf_hi(xv.x); acc[2] += w0[2] * bf_lo(xv.y); acc[3] += w0[3] * bf_hi(xv.y);
                    acc[4] += w1[0] * bf_lo(xv.z); acc[5] += w1[1] * bf_hi(xv.z); acc[6] += w1[2] * bf_lo(xv.w); acc[7] += w1[3] * bf_hi(xv.w);
                }
            }
            float ss = 0.f;
#pragma unroll
            for (int i = 0; i < 8; ++i) { acc[i] = acc[i] * sigmoid_f(acc[i]); ss += acc[i] * acc[i]; }
            if (grp < 4) {
                ss += __shfl_xor(ss, 1); ss += __shfl_xor(ss, 2); ss += __shfl_xor(ss, 4); ss += __shfl_xor(ss, 8);
                float rn = 1.0f / sqrtf(ss + RMS_EPS); if (grp < 2) rn *= 0.08838834764831845f;
#pragma unroll
                for (int i = 0; i < 8; ++i) acc[i] *= rn;
            }
            v4u o; o.x = pk2(acc[0], acc[1]); o.y = pk2(acc[2], acc[3]); o.z = pk2(acc[4], acc[5]); o.w = pk2(acc[6], acc[7]);
            *(v4u*)(qkvc + (size_t)t * 4096 + ch) = o;
        }
        if (lane < 16) {
            const float bb = __uint_as_float((unsigned)proj[(size_t)t * GINP + 6144 + lane] << 16), aa = __uint_as_float((unsigned)proj[(size_t)t * GINP + 6160 + lane] << 16);
            const float xx = aa + a.gdn_dt_bias[j * 16 + lane];
            const float sp = xx > 20.f ? xx : log1pf(__expf(xx));
            gb[(size_t)t * 32 + lane] = -__expf(a.gdn_a_log[j * 16 + lane]) * sp;
            gb[(size_t)t * 32 + 16 + lane] = sigmoid_f(bb);
        }
    }
}

DI void phase_gdn_naive(const Args& a, int j, LAS unsigned char* lds, int bid, int tid) {
    if (bid >= BATCH * HV) return;
    const int b = bid / HV, hv = bid % HV, hk = hv / 2, jc = tid & 127, r = tid >> 7;
    const bf16* proj = (const bf16*)(a.ws + WS_PROJ); bf16* qkvc = (bf16*)(a.ws + WS_QKVC); const float* gb = (const float*)(a.ws + WS_GB);
    LAS float* qs = (LAS float*)lds; LAS float* ks = qs + 2048; LAS float* vs = ks + 2048; LAS float* gs = vs + 2048; LAS float* bs = gs + 16;
    LAS f32x2* red = (LAS f32x2*)(lds + 32768); LAS float* redkq = (LAS float*)(lds + 32768 + 8192); LAS float* ob = (LAS float*)(lds + 49152);
    float S[32];
#pragma unroll
    for (int i = 0; i < 32; ++i) S[i] = 0.f;
    const int lrow = tid >> 5, lcol = (tid & 31) * 4;
    for (int blk = 0; blk < SEQ / 16; ++blk) {
        const size_t t0 = (size_t)b * SEQ + blk * 16;
        __syncthreads();
        { const bf16* rowp = qkvc + (t0 + lrow) * 4096;
          const v2u qv = *(const v2u*)(rowp + hk * 128 + lcol), kv = *(const v2u*)(rowp + 1024 + hk * 128 + lcol), vv = *(const v2u*)(rowp + 2048 + hv * 128 + lcol);
          *(LAS f32x4*)(qs + lrow * 128 + lcol) = (f32x4){bf_lo(qv.x), bf_hi(qv.x), bf_lo(qv.y), bf_hi(qv.y)};
          *(LAS f32x4*)(ks + lrow * 128 + lcol) = (f32x4){bf_lo(kv.x), bf_hi(kv.x), bf_lo(kv.y), bf_hi(kv.y)};
          *(LAS f32x4*)(vs + lrow * 128 + lcol) = (f32x4){bf_lo(vv.x), bf_hi(vv.x), bf_lo(vv.y), bf_hi(vv.y)};
          if (tid < 16) { gs[tid] = __expf(gb[(t0 + tid) * 32 + hv]); bs[tid] = gb[(t0 + tid) * 32 + 16 + hv]; } }
        __syncthreads();
#pragma unroll 1
        for (int tt = 0; tt < 16; ++tt) {
            float pk = 0.f, pq = 0.f, pkq = 0.f;
#pragma unroll
            for (int i4 = 0; i4 < 8; ++i4) { const f32x4 k4 = *(const LAS f32x4*)(ks + tt * 128 + 32 * r + 4 * i4), q4 = *(const LAS f32x4*)(qs + tt * 128 + 32 * r + 4 * i4);
#pragma unroll
                for (int c = 0; c < 4; ++c) { pk += k4[c] * S[4 * i4 + c]; pq += q4[c] * S[4 * i4 + c]; pkq += k4[c] * q4[c]; } }
            const int buf = tt & 1;
            red[(buf * 4 + r) * 128 + jc] = (f32x2){pk, pq}; if (jc == 0) redkq[buf * 4 + r] = pkq;
            __syncthreads();
            float kS = 0.f, qS = 0.f, kq = 0.f;
#pragma unroll
            for (int rr = 0; rr < 4; ++rr) { const f32x2 p = red[(buf * 4 + rr) * 128 + jc]; kS += p.x; qS += p.y; kq += redkq[buf * 4 + rr]; }
            const float eg = gs[tt], vn = bs[tt] * (vs[tt * 128 + jc] - eg * kS);
#pragma unroll
            for (int i4 = 0; i4 < 8; ++i4) { const f32x4 k4 = *(const LAS f32x4*)(ks + tt * 128 + 32 * r + 4 * i4);
#pragma unroll
                for (int c = 0; c < 4; ++c) S[4 * i4 + c] = eg * S[4 * i4 + c] + k4[c] * vn; }
            if (r == 0) ob[tt * 128 + jc] = eg * qS + kq * vn;
        }
        __syncthreads();
        {
            const f32x4 o4 = *(const LAS f32x4*)(ob + lrow * 128 + lcol);
            float ss = o4[0] * o4[0] + o4[1] * o4[1] + o4[2] * o4[2] + o4[3] * o4[3];
            ss += __shfl_xor(ss, 1); ss += __shfl_xor(ss, 2); ss += __shfl_xor(ss, 4); ss += __shfl_xor(ss, 8); ss += __shfl_xor(ss, 16);
            const float rinv = 1.0f / sqrtf(ss * (1.0f / 128.0f) + RMS_EPS);
            const v2u zv = *(const v2u*)(proj + (t0 + lrow) * GINP + 4096 + hv * 128 + lcol);
            const f32x4 nw = *(const f32x4*)(a.gdn_norm_w + j * 128 + lcol);
            const float z0 = bf_lo(zv.x), z1 = bf_hi(zv.x), z2 = bf_lo(zv.y), z3 = bf_hi(zv.y);
            v2u o; o.x = pk2(o4[0] * rinv * nw[0] * z0 * sigmoid_f(z0), o4[1] * rinv * nw[1] * z1 * sigmoid_f(z1));
            o.y = pk2(o4[2] * rinv * nw[2] * z2 * sigmoid_f(z2), o4[3] * rinv * nw[3] * z3 * sigmoid_f(z3));
            *(v2u*)(qkvc + (t0 + lrow) * 4096 + 2048 + hv * 128 + lcol) = o;
        }
    }
}

template <bool ROUTER>
DI void phase_ln(const Args& a, int lnidx, int j, LAS unsigned char* lds, int bid, int G, int tid, int wave, int lane) {
    float* out = a.out; bf16* HB = (bf16*)(a.ws + WS_HB);
    const float* g = a.ln_g + (size_t)lnidx * D; const float* bta = a.ln_b + (size_t)lnidx * D;
    const int gw = bid * NWAVES + wave, NGW = G * NWAVES;
    LAS unsigned* lcnt = (LAS unsigned*)lds;
    if (ROUTER) { if (tid < 8) lcnt[tid] = 0u; __syncthreads(); }
    f32x4 gv[4], bv[4];
#pragma unroll
    for (int q = 0; q < 4; ++q) { gv[q] = *(const f32x4*)(g + 4 * (lane + 64 * q)); bv[q] = *(const f32x4*)(bta + 4 * (lane + 64 * q)); }
    for (int t = gw; t < TT; t += NGW) {
        f32x4* row = (f32x4*)(out + (size_t)t * D);
        f32x4 v[4]; float s = 0.f;
#pragma unroll
        for (int q = 0; q < 4; ++q) { v[q] = row[lane + 64 * q]; s += (v[q][0] + v[q][1]) + (v[q][2] + v[q][3]); }
        const float mean = wave_sum(s) * (1.0f / D); float s2 = 0.f;
#pragma unroll
        for (int q = 0; q < 4; ++q) { v[q] = v[q] - mean; s2 += (v[q][0] * v[q][0] + v[q][1] * v[q][1]) + (v[q][2] * v[q][2] + v[q][3] * v[q][3]); }
        const float rstd = 1.0f / sqrtf(wave_sum(s2) * (1.0f / D) + LN_EPS);
#pragma unroll
        for (int q = 0; q < 4; ++q) { v[q] = v[q] * rstd * gv[q] + bv[q]; row[lane + 64 * q] = v[q];
            v2u o; o.x = pk2(v[q][0], v[q][1]); o.y = pk2(v[q][2], v[q][3]); *(v2u*)(HB + (size_t)t * D + 4 * (lane + 64 * q)) = o; }
        if (ROUTER) {
            const float* R = a.moe_router + (size_t)j * D * NE;
            float lg[8];
#pragma unroll
            for (int e = 0; e < 8; ++e) lg[e] = 0.f;
#pragma unroll
            for (int q = 0; q < 4; ++q)
#pragma unroll
                for (int c = 0; c < 4; ++c) { const int k = 4 * (lane + 64 * q) + c; const f32x4 r0 = *(const f32x4*)(R + k * 8), r1 = *(const f32x4*)(R + k * 8 + 4); const float hv = v[q][c];
                    lg[0] += hv * r0[0]; lg[1] += hv * r0[1]; lg[2] += hv * r0[2]; lg[3] += hv * r0[3]; lg[4] += hv * r1[0]; lg[5] += hv * r1[1]; lg[6] += hv * r1[2]; lg[7] += hv * r1[3]; }
#pragma unroll
            for (int e = 0; e < 8; ++e) lg[e] = wave_sum(lg[e]);
            int i1 = 0; float v1 = lg[0];
#pragma unroll
            for (int e = 1; e < 8; ++e) if (lg[e] > v1) { v1 = lg[e]; i1 = e; }
            int i2 = -1; float v2 = -3.0e38f;
#pragma unroll
            for (int e = 0; e < 8; ++e) if (e != i1 && lg[e] > v2) { v2 = lg[e]; i2 = e; }
            if (lane == 0) {
                const float g1 = 1.0f / (1.0f + __expf(v2 - v1));
                ((unsigned*)(a.ws + WS_E12))[t] = (unsigned)i1 | ((unsigned)i2 << 8);
                ((f32x2*)(a.ws + WS_G12))[t] = (f32x2){g1, 1.0f - g1};
                __hip_atomic_fetch_add(lcnt + i1, 1u, __ATOMIC_RELAXED, __HIP_MEMORY_SCOPE_WORKGROUP); __hip_atomic_fetch_add(lcnt + i2, 1u, __ATOMIC_RELAXED, __HIP_MEMORY_SCOPE_WORKGROUP);
            }
        }
    }
    if (ROUTER) { __syncthreads(); if (tid < 8) { unsigned* cnt = (unsigned*)(a.ws + WS_CTL) + CW_CNT + 256 * j; __hip_atomic_fetch_add(cnt + tid, lcnt[tid], __ATOMIC_RELAXED, __HIP_MEMORY_SCOPE_AGENT); } }
}

DI void phase_sb_naive(const Args& a, LAS unsigned char* lds, int bid, int G, int tid) {
    const bf16* qkv = (const bf16*)(a.ws + WS_QKV); bf16* ao = (bf16*)(a.ws + WS_AO);
    LAS unsigned char* Ks = lds; LAS unsigned char* Vs = lds + 16384;
    const int qi = tid >> 2, r = tid & 3;
    for (int idx = bid; idx < 64 * 32; idx += G) {
        const int qb = 31 - idx / 64, bh = idx % 64, b = bh >> 3, h = bh & 7;
        const int t = qb * 128 + qi;
        const size_t rowq = (size_t)b * SEQ + t;
        float q[32], o[32];
        { const bf16* qp = qkv + rowq * 3072 + h * 128 + 32 * r;
#pragma unroll
          for (int c = 0; c < 4; ++c) { const v4u w = *(const v4u*)(qp + 8 * c);
              q[8 * c + 0] = bf_lo(w.x); q[8 * c + 1] = bf_hi(w.x); q[8 * c + 2] = bf_lo(w.y); q[8 * c + 3] = bf_hi(w.y);
              q[8 * c + 4] = bf_lo(w.z); q[8 * c + 5] = bf_hi(w.z); q[8 * c + 6] = bf_lo(w.w); q[8 * c + 7] = bf_hi(w.w); }
#pragma unroll
          for (int i = 0; i < 32; ++i) { q[i] *= 0.08838834764831845f; o[i] = 0.f; } }
        float P = 1.0f;
        for (int kt = 2 * qb + 1; kt >= 0; --kt) {
            __syncthreads();
#pragma unroll
            for (int i = 0; i < 2; ++i) { const int c = tid + 512 * i, row = c >> 4, part = c & 15;
                const bf16* src = qkv + ((size_t)b * SEQ + kt * 64 + row) * 3072 + h * 128 + part * 8;
                *(LAS v4u*)(Ks + c * 16) = *(const v4u*)(src + 1024); *(LAS v4u*)(Vs + c * 16) = *(const v4u*)(src + 2048); }
            __syncthreads();
#pragma unroll 1
            for (int s = 63; s >= 0; --s) {
                float z = 0.f;
#pragma unroll
                for (int c = 0; c < 4; ++c) { const v4u w = *(const LAS v4u*)(Ks + s * 256 + r * 64 + c * 16);
                    z += q[8 * c + 0] * bf_lo(w.x) + q[8 * c + 1] * bf_hi(w.x) + q[8 * c + 2] * bf_lo(w.y) + q[8 * c + 3] * bf_hi(w.y)
                       + q[8 * c + 4] * bf_lo(w.z) + q[8 * c + 5] * bf_hi(w.z) + q[8 * c + 6] * bf_lo(w.w) + q[8 * c + 7] * bf_hi(w.w); }
                z += __shfl_xor(z, 1); z += __shfl_xor(z, 2);
                const bool live = (kt * 64 + s) < t;
                const float e = __expf(fminf(z, 80.f)), rr = 1.0f / (1.0f + e);
                const float A = live ? e * rr * P : 0.f;
                P = live ? P * rr : P;
#pragma unroll
                for (int c = 0; c < 4; ++c) { const v4u w = *(const LAS v4u*)(Vs + s * 256 + r * 64 + c * 16);
                    o[8 * c + 0] += A * bf_lo(w.x); o[8 * c + 1] += A * bf_hi(w.x); o[8 * c + 2] += A * bf_lo(w.y); o[8 * c + 3] += A * bf_hi(w.y);
                    o[8 * c + 4] += A * bf_lo(w.z); o[8 * c + 5] += A * bf_hi(w.z); o[8 * c + 6] += A * bf_lo(w.w); o[8 * c + 7] += A * bf_hi(w.w); }
            }
        }
        { bf16* op = ao + rowq * 1024 + h * 128 + 32 * r;
#pragma unroll
          for (int c = 0; c < 4; ++c) { v4u w; w.x = pk2(o[8 * c + 0], o[8 * c + 1]); w.y = pk2(o[8 * c + 2], o[8 * c + 3]); w.z = pk2(o[8 * c + 4], o[8 * c + 5]); w.w = pk2(o[8 * c + 6], o[8 * c + 7]);
              *(v4u*)(op + 8 * c) = w; } }
    }
}

DI void moe_offsets(const Args& a, int j, unsigned (&off)[9]) {
    unsigned* cnt = (unsigned*)(a.ws + WS_CTL) + CW_CNT + 256 * j; unsigned acc = 0u;
#pragma unroll
    for (int e = 0; e < 8; ++e) { off[e] = acc; const unsigned c = __hip_atomic_load(cnt + e, __ATOMIC_RELAXED, __HIP_MEMORY_SCOPE_AGENT); acc += (c + 255u) & ~255u; }
    off[8] = acc;
}
DI void phase_scatter(const Args& a, int j, LAS unsigned char* lds, int bid, int G, int tid, int wave, int lane) {
    LAS unsigned* lc = (LAS unsigned*)lds; LAS unsigned* lb = lc + 8; LAS unsigned* loff = lc + 16; LAS int* lpos = (LAS int*)(lc + 32);
    const unsigned* E12 = (const unsigned*)(a.ws + WS_E12); int* POS = (int*)(a.ws + WS_POS);
    const bf16* HB = (const bf16*)(a.ws + WS_HB); bf16* XS = (bf16*)(a.ws + WS_XS);
    unsigned* fill = (unsigned*)(a.ws + WS_CTL) + CW_CNT + 256 * j + 64;
    unsigned off[9]; moe_offsets(a, j, off);
    if (tid == 0) {
#pragma unroll
        for (int e = 0; e < 8; ++e) loff[e] = off[e]; }
    for (int ci = bid; ci < TT / 128; ci += G) {
        __syncthreads();
        if (tid < 8) lc[tid] = 0u;
        __syncthreads();
        unsigned e1 = 0, e2 = 0, r1 = 0, r2 = 0;
        if (tid < 128) { const unsigned w = E12[ci * 128 + tid]; e1 = w & 255u; e2 = (w >> 8) & 255u;
            r1 = __hip_atomic_fetch_add(lc + e1, 1u, __ATOMIC_RELAXED, __HIP_MEMORY_SCOPE_WORKGROUP); r2 = __hip_atomic_fetch_add(lc + e2, 1u, __ATOMIC_RELAXED, __HIP_MEMORY_SCOPE_WORKGROUP); }
        __syncthreads();
        if (tid < 8) lb[tid] = __hip_atomic_fetch_add(fill + tid, lc[tid], __ATOMIC_RELAXED, __HIP_MEMORY_SCOPE_AGENT);
        __syncthreads();
        if (tid < 128) { const int p1 = (int)(loff[e1] + lb[e1] + r1), p2 = (int)(loff[e2] + lb[e2] + r2);
            lpos[2 * tid] = p1; lpos[2 * tid + 1] = p2; POS[2 * (ci * 128 + tid)] = p1; POS[2 * (ci * 128 + tid) + 1] = p2; }
        __syncthreads();
        for (int tk = wave; tk < 128; tk += NWAVES) {
            const int p1 = lpos[2 * tk], p2 = lpos[2 * tk + 1];
            const v4u* src = (const v4u*)(HB + (size_t)(ci * 128 + tk) * D);
            const v4u x0 = src[lane], x1 = src[lane + 64];
            v4u* d1 = (v4u*)(XS + (size_t)p1 * D); v4u* d2 = (v4u*)(XS + (size_t)p2 * D);
            d1[lane] = x0; d1[lane + 64] = x1; d2[lane] = x0; d2[lane + 64] = x1;
        }
    }
}

DI void phase_combine_ln(const Args& a, int lnidx, int bid, int G, int wave, int lane) {
    float* out = a.out; bf16* HB = (bf16*)(a.ws + WS_HB); const bf16* YE = (const bf16*)(a.ws + WS_XS);
    const int* POS = (const int*)(a.ws + WS_POS); const f32x2* G12 = (const f32x2*)(a.ws + WS_G12);
    const float* g = a.ln_g + (size_t)lnidx * D; const float* bta = a.ln_b + (size_t)lnidx * D;
    const int gw = bid * NWAVES + wave, NGW = G * NWAVES;
    f32x4 gv[4], bv[4];
#pragma unroll
    for (int q = 0; q < 4; ++q) { gv[q] = *(const f32x4*)(g + 4 * (lane + 64 * q)); bv[q] = *(const f32x4*)(bta + 4 * (lane + 64 * q)); }
    for (int t = gw; t < TT; t += NGW) {
        f32x4* row = (f32x4*)(out + (size_t)t * D);
        const int p1 = POS[2 * t], p2 = POS[2 * t + 1]; const f32x2 gg = G12[t];
        const v2u* y1 = (const v2u*)(YE + (size_t)p1 * D); const v2u* y2 = (const v2u*)(YE + (size_t)p2 * D);
        f32x4 v[4]; float s = 0.f;
#pragma unroll
        for (int q = 0; q < 4; ++q) { const v2u a1 = y1[lane + 64 * q], a2 = y2[lane + 64 * q];
            const f32x4 e1 = (f32x4){bf_lo(a1.x), bf_hi(a1.x), bf_lo(a1.y), bf_hi(a1.y)}, e2 = (f32x4){bf_lo(a2.x), bf_hi(a2.x), bf_lo(a2.y), bf_hi(a2.y)};
            v[q] = row[lane + 64 * q] * ALPHA + e1 * gg.x + e2 * gg.y; s += (v[q][0] + v[q][1]) + (v[q][2] + v[q][3]); }
        const float mean = wave_sum(s) * (1.0f / D); float s2 = 0.f;
#pragma unroll
        for (int q = 0; q < 4; ++q) { v[q] = v[q] - mean; s2 += (v[q][0] * v[q][0] + v[q][1] * v[q][1]) + (v[q][2] * v[q][2] + v[q][3] * v[q][3]); }
        const float rstd = 1.0f / sqrtf(wave_sum(s2) * (1.0f / D) + LN_EPS);
#pragma unroll
        for (int q = 0; q < 4; ++q) { v[q] = v[q] * rstd * gv[q] + bv[q]; row[lane + 64 * q] = v[q];
            v2u o; o.x = pk2(v[q][0], v[q][1]); o.y = pk2(v[q][2], v[q][3]); *(v2u*)(HB + (size_t)t * D + 4 * (lane + 64 * q)) = o; }
    }
}

constexpr int ARGS_OFF = RING_BYTES + 1024;
DI unsigned long long lds_u64(LAS unsigned char* p) { const v2u w = *(const volatile LAS v2u*)p; return ((unsigned long long)(unsigned)__builtin_amdgcn_readfirstlane((int)w.y) << 32) | (unsigned)__builtin_amdgcn_readfirstlane((int)w.x); }
DI Args load_args(LAS unsigned char* lds) {
    Args a; LAS unsigned char* p = lds + ARGS_OFF;
    a.x = (const float*)lds_u64(p + 0); a.gdn_w_in = (const float*)lds_u64(p + 8); a.gdn_conv_w = (const float*)lds_u64(p + 16); a.gdn_a_log = (const float*)lds_u64(p + 24);
    a.gdn_dt_bias = (const float*)lds_u64(p + 32); a.gdn_norm_w = (const float*)lds_u64(p + 40); a.gdn_w_out = (const float*)lds_u64(p + 48); a.sb_w_in = (const float*)lds_u64(p + 56);
    a.sb_w_out = (const float*)lds_u64(p + 64); a.ffn_w_gate = (const float*)lds_u64(p + 72); a.ffn_w_up = (const float*)lds_u64(p + 80); a.ffn_w_down = (const float*)lds_u64(p + 88);
    a.moe_router = (const float*)lds_u64(p + 96); a.moe_w_gate = (const float*)lds_u64(p + 104); a.moe_w_up = (const float*)lds_u64(p + 112); a.moe_w_down = (const float*)lds_u64(p + 120);
    a.ln_g = (const float*)lds_u64(p + 128); a.ln_b = (const float*)lds_u64(p + 136); a.out = (float*)lds_u64(p + 144); a.ws = (unsigned char*)lds_u64(p + 152);
    const v2u w = *(const volatile LAS v2u*)(p + 160); a.ph_lo = __builtin_amdgcn_readfirstlane((int)w.x); a.ph_hi = __builtin_amdgcn_readfirstlane((int)w.y);
    return a;
}
#define IN(k) (lo <= (k) && (k) < hi)
#define SEAM(k) do { if ((k) + 1 < hi) xcd_barrier(bar); } while (0)
DI int fresh_tid() { int t; asm volatile("v_mov_b32 %0, %1" : "=v"(t) : "v"(threadIdx.x)); return t; }
#define ARGS() const Args args = load_args(lds); const int lo = args.ph_lo, hi = args.ph_hi; const int tid = fresh_tid(), lane = tid & 63
template <int j>
DI void layer_pair(LAS unsigned char* lds, const XcdBarrier& bar, const int wave, const int G, const int bid) {
    constexpr int pb = j * NPH;
    { ARGS(); if (IN(pb + 0)) { phase_w_gdn(args, j, lds, bid, G, tid, wave, lane); SEAM(pb + 0); } }
    { ARGS(); if (IN(pb + 1)) {
        pg8::Gemm g{(const bf16*)(args.ws + WS_HB), (const bf16*)(args.ws + W_IN), D, D}; pg8::StaticOrder S; S.init(TT, GINP, G, bid);
        pg8::EpiBf16 E{(bf16*)(args.ws + WS_PROJ), GINP, 0};
        pg8::gemm_phase<pg8::EpiBf16, pg8::StaticOrder, true, true>(lds, g, S, E);
        SEAM(pb + 1); } }
    { ARGS(); if (IN(pb + 2)) { phase_conv(args, j, bid, G, wave, lane); SEAM(pb + 2); } }
    { ARGS(); if (IN(pb + 3)) { phase_gdn_naive(args, j, lds, bid, tid); SEAM(pb + 3); } }
    { ARGS(); if (IN(pb + 4)) {
        pg8::Gemm g{(const bf16*)(args.ws + WS_QKVC) + 2048, (const bf16*)(args.ws + W_OUT), 4096, 2048}; pg8::StaticOrder S; S.init(TT, D, G, bid);
        pg8::EpiResid E{j == 0 ? args.x : args.out, args.out, D, ALPHA};
        pg8::gemm_phase<pg8::EpiResid, pg8::StaticOrder, true, true>(lds, g, S, E);
        SEAM(pb + 4); } }
    { ARGS(); if (IN(pb + 5)) { phase_ln<false>(args, (2 * j) * 2 + 0, j, lds, bid, G, tid, wave, lane); SEAM(pb + 5); } }
    { ARGS(); if (IN(pb + 6)) {
        pg8::Gemm g{(const bf16*)(args.ws + WS_HB), (const bf16*)(args.ws + W_GU), D, D}; pg8::StaticOrder S; S.init(TT, 2 * FF, G, bid);
        pg8::EpiSwiGLU E{(bf16*)(args.ws + WS_ACT), FF, 0};
        pg8::gemm_phase<pg8::EpiSwiGLU, pg8::StaticOrder, true, true>(lds, g, S, E);
        SEAM(pb + 6); } }
    { ARGS(); if (IN(pb + 7)) {
        pg8::Gemm g{(const bf16*)(args.ws + WS_ACT), (const bf16*)(args.ws + W_D), FF, FF}; pg8::StaticOrder S; S.init(TT, D, G, bid);
        pg8::EpiResid E{args.out, args.out, D, ALPHA};
        pg8::gemm_phase<pg8::EpiResid, pg8::StaticOrder, true, true>(lds, g, S, E);
        SEAM(pb + 7); } }
    { ARGS(); if (IN(pb + 8)) { phase_ln<false>(args, (2 * j) * 2 + 1, j, lds, bid, G, tid, wave, lane); phase_w_sb(args, j, lds, bid, G, wave, lane); SEAM(pb + 8); } }
    { ARGS(); if (IN(pb + 9)) {
        pg8::Gemm g{(const bf16*)(args.ws + WS_HB), (const bf16*)(args.ws + W_QKV), D, D}; pg8::StaticOrder S; S.init(TT, 3072, G, bid);
        pg8::EpiBf16 E{(bf16*)(args.ws + WS_QKV), 3072, 0};
        pg8::gemm_phase<pg8::EpiBf16, pg8::StaticOrder, true, true>(lds, g, S, E);
        SEAM(pb + 9); } }
    { ARGS(); if (IN(pb + 10)) { phase_sb_naive(args, lds, bid, G, tid); SEAM(pb + 10); } }
    { ARGS(); if (IN(pb + 11)) {
        pg8::Gemm g{(const bf16*)(args.ws + WS_AO), (const bf16*)(args.ws + W_O), D, D}; pg8::StaticOrder S; S.init(TT, D, G, bid);
        pg8::EpiResid E{args.out, args.out, D, ALPHA};
        pg8::gemm_phase<pg8::EpiResid, pg8::StaticOrder, true, true>(lds, g, S, E);
        SEAM(pb + 11); } }
    { ARGS(); if (IN(pb + 12)) { phase_ln<true>(args, (2 * j + 1) * 2 + 0, j, lds, bid, G, tid, wave, lane); SEAM(pb + 12); } }
    { ARGS(); if (IN(pb + 13)) { phase_scatter(args, j, lds, bid, G, tid, wave, lane); SEAM(pb + 13); } }
    { ARGS(); if (IN(pb + 14)) {
        unsigned off[9]; moe_offsets(args, j, off);
        pg8::MoeOrder S; S.nM = (int)(off[8] >> 8); S.G = G; S.c = bid; S.nN = 2 * FF / 256; S.nwg = S.nM * S.nN;
        S.ps1 = (int)(off[1] >> 8); S.ps2 = (int)(off[2] >> 8); S.ps3 = (int)(off[3] >> 8); S.ps4 = (int)(off[4] >> 8); S.ps5 = (int)(off[5] >> 8); S.ps6 = (int)(off[6] >> 8); S.ps7 = (int)(off[7] >> 8);
        pg8::Gemm g{(const bf16*)(args.ws + WS_XS), (const bf16*)(args.ws + W_MGU), D, D};
        pg8::EpiSwiGLU E{(bf16*)(args.ws + WS_MACT), FF, 2 * FF / 256};
        pg8::gemm_phase<pg8::EpiSwiGLU, pg8::MoeOrder, true, true>(lds, g, S, E);
        SEAM(pb + 14); } }
    { ARGS(); if (IN(pb + 15)) {
        unsigned off[9]; moe_offsets(args, j, off);
        pg8::MoeOrder S; S.nM = (int)(off[8] >> 8); S.G = G; S.c = bid; S.nN = D / 256; S.nwg = S.nM * S.nN;
        S.ps1 = (int)(off[1] >> 8); S.ps2 = (int)(off[2] >> 8); S.ps3 = (int)(off[3] >> 8); S.ps4 = (int)(off[4] >> 8); S.ps5 = (int)(off[5] >> 8); S.ps6 = (int)(off[6] >> 8); S.ps7 = (int)(off[7] >> 8);
        pg8::Gemm g{(const bf16*)(args.ws + WS_MACT), (const bf16*)(args.ws + W_MD), FF, FF};
        pg8::EpiBf16 E{(bf16*)(args.ws + WS_XS), D, D / 256};
        pg8::gemm_phase<pg8::EpiBf16, pg8::MoeOrder, true, true>(lds, g, S, E);
        SEAM(pb + 15); } }
    { ARGS(); if (IN(pb + 16)) { phase_combine_ln(args, (2 * j + 1) * 2 + 1, bid, G, wave, lane); SEAM(pb + 16); } }
}
__global__ void __launch_bounds__(NWAVES * 64, 2) fwd(Args kargs) {
    extern __shared__ __attribute__((aligned(16))) unsigned char lds_raw[];
    LAS unsigned char* lds = (LAS unsigned char*)lds_raw;
    volatile LAS unsigned* MISC = (volatile LAS unsigned*)(lds + MISC_OFF);
    const int tid = threadIdx.x, lane = tid & 63, wave = __builtin_amdgcn_readfirstlane(tid >> 6), G = gridDim.x, bid = blockIdx.x;
    for (int u = tid; u < (LDS_BYTES - RING_BYTES) / 4; u += NWAVES * 64) ((LAS unsigned*)(lds + RING_BYTES))[u] = 0u;
    __syncthreads();
    if (tid == 0) { LAS unsigned long long* pa = (LAS unsigned long long*)(lds + ARGS_OFF);
        pa[0] = (unsigned long long)kargs.x; pa[1] = (unsigned long long)kargs.gdn_w_in; pa[2] = (unsigned long long)kargs.gdn_conv_w; pa[3] = (unsigned long long)kargs.gdn_a_log;
        pa[4] = (unsigned long long)kargs.gdn_dt_bias; pa[5] = (unsigned long long)kargs.gdn_norm_w; pa[6] = (unsigned long long)kargs.gdn_w_out; pa[7] = (unsigned long long)kargs.sb_w_in;
        pa[8] = (unsigned long long)kargs.sb_w_out; pa[9] = (unsigned long long)kargs.ffn_w_gate; pa[10] = (unsigned long long)kargs.ffn_w_up; pa[11] = (unsigned long long)kargs.ffn_w_down;
        pa[12] = (unsigned long long)kargs.moe_router; pa[13] = (unsigned long long)kargs.moe_w_gate; pa[14] = (unsigned long long)kargs.moe_w_up; pa[15] = (unsigned long long)kargs.moe_w_down;
        pa[16] = (unsigned long long)kargs.ln_g; pa[17] = (unsigned long long)kargs.ln_b; pa[18] = (unsigned long long)kargs.out; pa[19] = (unsigned long long)kargs.ws;
        pa[20] = (unsigned long long)(unsigned)kargs.ph_lo | ((unsigned long long)(unsigned)kargs.ph_hi << 32); }
    XcdBarrier bar = xcd_barrier_post((unsigned*)(kargs.ws + WS_CTL) + CW_BAR, MISC + 8);
    __syncthreads();
    layer_pair<0>(lds, bar, wave, G, bid);
    layer_pair<1>(lds, bar, wave, G, bid);
}
#undef IN
#undef SEAM
#undef ARGS

extern "C" void kernel_launch(void* const* d_in, const int* in_sizes, int n_in, void* d_out, int out_size, void* d_ws, size_t ws_size, hipStream_t stream) {
    static int grid = 0;
    if (grid == 0) {
        if (n_in != 18 || in_sizes[0] != TT * D || out_size != TT * D || ws_size < WS_END) { fprintf(stderr, "kernel_launch: unexpected shapes (n_in %d, in0 %d, out %d, ws %zu); nothing launched\n", n_in, n_in > 0 ? in_sizes[0] : -1, out_size, ws_size); grid = -1; return; }
        int dev = 0, cus = 0, per_cu = 0;
        if (hipGetDevice(&dev) != hipSuccess || hipDeviceGetAttribute(&cus, hipDeviceAttributeMultiprocessorCount, dev) != hipSuccess) { grid = -1; return; }
        if (hipFuncSetAttribute((const void*)fwd, hipFuncAttributeMaxDynamicSharedMemorySize, LDS_BYTES) != hipSuccess) { fprintf(stderr, "kernel_launch: hipFuncSetAttribute failed\n"); grid = -1; return; }
        if (hipOccupancyMaxActiveBlocksPerMultiprocessor(&per_cu, (const void*)fwd, NWAVES * 64, LDS_BYTES) != hipSuccess || per_cu < 1) { fprintf(stderr, "kernel_launch: occupancy query says %d blocks per CU\n", per_cu); (void)hipGetLastError(); grid = -1; return; }
        grid = cus;
    }
    if (grid < 0) return;
    if (hipMemsetAsync((char*)d_ws + WS_CTL, 0, CTL_ZERO_BYTES, stream) != hipSuccess) return;
    Args a{};
    a.x = (const float*)d_in[0]; a.gdn_w_in = (const float*)d_in[1]; a.gdn_conv_w = (const float*)d_in[2]; a.gdn_a_log = (const float*)d_in[3]; a.gdn_dt_bias = (const float*)d_in[4];
    a.gdn_norm_w = (const float*)d_in[5]; a.gdn_w_out = (const float*)d_in[6]; a.sb_w_in = (const float*)d_in[7]; a.sb_w_out = (const float*)d_in[8];
    a.ffn_w_gate = (const float*)d_in[9]; a.ffn_w_up = (const float*)d_in[10]; a.ffn_w_down = (const float*)d_in[11]; a.moe_router = (const float*)d_in[12];
    a.moe_w_gate = (const float*)d_in[13]; a.moe_w_up = (const float*)d_in[14]; a.moe_w_down = (const float*)d_in[15]; a.ln_g = (const float*)d_in[16]; a.ln_b = (const float*)d_in[17];
    a.out = (float*)d_out; a.ws = (unsigned char*)d_ws;
#if MK_ONE_LAUNCH
    a.ph_lo = 0; a.ph_hi = NPHASES;
    hipLaunchKernelGGL(fwd, dim3(grid), dim3(NWAVES * 64), LDS_BYTES, stream, a);
#else
    for (int p = 0; p < NPHASES; ++p) { a.ph_lo = p; a.ph_hi = p + 1; hipLaunchKernelGGL(fwd, dim3(grid), dim3(NWAVES * 64), LDS_BYTES, stream, a); }
#endif
}
```

```cpp
#include <hip/hip_runtime.h>
#include <cstdio>
#include <cstdint>
#ifndef GDN_NAIVE
#define GDN_NAIVE 0
#endif
#ifndef SB_NAIVE
#define SB_NAIVE 0
#endif
#ifndef MK_ONE_LAUNCH
#define MK_ONE_LAUNCH 1
#endif
namespace pg8 {
#define PG8_LAS __attribute__((address_space(3)))
typedef unsigned short bf16_t;
typedef short bf16x8 __attribute__((ext_vector_type(8)));
typedef float f32x4 __attribute__((ext_vector_type(4)));
typedef unsigned u32x4 __attribute__((ext_vector_type(4)));
constexpr int BM = 256, BK = 64, HALF = 128, HTB = HALF * BK * 2  , STAGE_BYTES = 8 * HTB, NXCD = 8, WGM = 8;

__host__ __device__ __forceinline__ int lds_byte(int r, int c) { const int st = (r >> 4) * 2 + (c >> 5), rr = r & 15, cc = c & 31, ob = rr * 64 + cc * 2; return st * 1024 + (ob ^ (((ob >> 9) & 1) << 5)); }
__host__ __device__ __forceinline__ void stage_rc(int b, int& R, int& C) { const int st = b / 1024, sb = b % 1024, swz = sb ^ (((sb >> 9) & 1) << 5); R = (st >> 1) * 16 + swz / 64; C = (st & 1) * 32 + (swz % 64) / 2; }
__host__ __device__ __forceinline__ int perm32(int rho) { const int n = rho >> 4, i = rho & 15; return 8 * (i >> 2) + 4 * n + (i & 3); }

struct Unit { int pm, pn; };
struct Gemm { const bf16_t* A; const bf16_t* Bt; int lda, K; };

struct StaticOrder {
    int nM, nN, nwg, G, c, rep;
    __host__ __device__ void init(int M, int N, int G_, int c_, int rep_ = 1) { nM = M / BM; nN = N / BM; nwg = nM * nN; G = G_; c = c_; rep = rep_; }
    __host__ __device__ bool next(int i, Unit& u) const {
        const long L = (long)i * G + c; if (L >= (long)rep * nwg) return false;
        int wgid = (int)(L % nwg); { const int q = nwg / NXCD, r = nwg % NXCD, xcd = wgid % NXCD, off = wgid / NXCD; wgid = (xcd < r ? xcd * (q + 1) : r * (q + 1) + (xcd - r) * q) + off; }
        const int nig = WGM * nN, gid = wgid / nig, fm = gid * WGM, gsz = (nM - fm) < WGM ? (nM - fm) : WGM;
        u.pm = fm + ((wgid % nig) % gsz); u.pn = (wgid % nig) / gsz; return true;
    }
    __device__ __forceinline__ void a_ready(const Unit&) const {}
    __device__ __forceinline__ void done(const Unit&) const {}
};

__device__ __forceinline__ unsigned cvt_pk_bf16(float lo, float hi) { unsigned r; asm volatile("v_cvt_pk_bf16_f32 %0, %1, %2" : "=v"(r) : "v"(lo), "v"(hi)); return r; }
struct EpiBf16 {
    static constexpr bool PERM = true, AFTER_DRAIN = false;
    bf16_t* O; int ldc; int nmod;
    __device__ __forceinline__ void operator()(const f32x4 (&acc)[2][2][4][2], const Unit& u, int wr, int wc, int fr, int fq) const {
        const int pnl = nmod ? (u.pn % nmod) : u.pn;
        const int row0 = u.pm * BM + wr * 64 + fr, col0 = pnl * BM + wc * 32 + 8 * fq;
#pragma unroll
        for (int ai = 0; ai < 2; ++ai)
#pragma unroll
            for (int m = 0; m < 4; ++m) { bf16_t* rowp = O + (size_t)(row0 + ai * HALF + m * 16) * ldc + col0;
#pragma unroll
                for (int bj = 0; bj < 2; ++bj) { const f32x4 v0 = acc[ai][bj][m][0], v1 = acc[ai][bj][m][1];
                    u32x4 w; w.x = cvt_pk_bf16(v0[0], v0[1]); w.y = cvt_pk_bf16(v0[2], v0[3]); w.z = cvt_pk_bf16(v1[0], v1[1]); w.w = cvt_pk_bf16(v1[2], v1[3]);
                    *(u32x4*)(rowp + bj * HALF) = w; } }
    }
};
struct EpiInProj {
    static constexpr bool PERM = true, AFTER_DRAIN = false;
    bf16_t* RAW; bf16_t* ZB;
    __device__ __forceinline__ void operator()(const f32x4 (&acc)[2][2][4][2], const Unit& u, int wr, int wc, int fr, int fq) const {
        const bool isz = (u.pn >= 16 && u.pn < 24);
        bf16_t* O = isz ? ZB : RAW; const int ldc = isz ? 2048 : 4352; const int ct = isz ? (u.pn - 16) : (u.pn < 16 ? u.pn : 16);
        const int row0 = u.pm * BM + wr * 64 + fr, col0 = ct * BM + wc * 32 + 8 * fq;
#pragma unroll
        for (int ai = 0; ai < 2; ++ai)
#pragma unroll
            for (int m = 0; m < 4; ++m) { bf16_t* rowp = O + (size_t)(row0 + ai * HALF + m * 16) * ldc + col0;
#pragma unroll
                for (int bj = 0; bj < 2; ++bj) { const f32x4 v0 = acc[ai][bj][m][0], v1 = acc[ai][bj][m][1];
                    u32x4 w; w.x = cvt_pk_bf16(v0[0], v0[1]); w.y = cvt_pk_bf16(v0[2], v0[3]); w.z = cvt_pk_bf16(v1[0], v1[1]); w.w = cvt_pk_bf16(v1[2], v1[3]);
                    *(u32x4*)(rowp + bj * HALF) = w; } }
    }
};
__device__ __forceinline__ float silu_f(float x) { return x * __builtin_amdgcn_rcpf(1.0f + __builtin_amdgcn_exp2f(-1.4426950408889634f * x)); }
struct EpiSwiGLU {
    static constexpr bool PERM = true, AFTER_DRAIN = false;
    bf16_t* O; int ldc; int nmod;
    __device__ __forceinline__ void operator()(const f32x4 (&acc)[2][2][4][2], const Unit& u, int wr, int wc, int fr, int fq) const {
        const int pnl = nmod ? (u.pn % nmod) : u.pn;
        const int row0 = u.pm * BM + wr * 64 + fr, col0 = pnl * HALF + wc * 32 + 8 * fq;
#pragma unroll
        for (int ai = 0; ai < 2; ++ai)
#pragma unroll
            for (int m = 0; m < 4; ++m) { bf16_t* rowp = O + (size_t)(row0 + ai * HALF + m * 16) * ldc + col0;
                const f32x4 g0 = acc[ai][0][m][0], g1 = acc[ai][0][m][1], u0 = acc[ai][1][m][0], u1 = acc[ai][1][m][1];
                u32x4 w;
                w.x = cvt_pk_bf16(silu_f(g0[0]) * u0[0], silu_f(g0[1]) * u0[1]); w.y = cvt_pk_bf16(silu_f(g0[2]) * u0[2], silu_f(g0[3]) * u0[3]);
                w.z = cvt_pk_bf16(silu_f(g1[0]) * u1[0], silu_f(g1[1]) * u1[1]); w.w = cvt_pk_bf16(silu_f(g1[2]) * u1[2], silu_f(g1[3]) * u1[3]);
                *(u32x4*)rowp = w; }
    }
};
struct EpiResid {
    static constexpr bool PERM = false, AFTER_DRAIN = false;
    const float* res; float* out; int ldc; float alpha;
    __device__ __forceinline__ void operator()(const f32x4 (&acc)[2][2][4][2], const Unit& u, int wr, int wc, int fr, int fq) const {
        const int row0 = u.pm * BM + wr * 64 + fr, col0 = u.pn * BM + wc * 32 + 4 * fq;
#pragma unroll
        for (int ai = 0; ai < 2; ++ai)
#pragma unroll
            for (int m = 0; m < 4; ++m) { const size_t off = (size_t)(row0 + ai * HALF + m * 16) * ldc + col0;
#pragma unroll
                for (int bj = 0; bj < 2; ++bj)
#pragma unroll
                    for (int n = 0; n < 2; ++n) { const f32x4 r = *(const f32x4*)(res + off + bj * HALF + n * 16);
                        *(f32x4*)(out + off + bj * HALF + n * 16) = r * alpha + acc[ai][bj][m][n]; } }
    }
};
struct MoeOrder {
    int nM, nN, nwg, G, c, rep; int ps1, ps2, ps3, ps4, ps5, ps6, ps7;
    __device__ __forceinline__ bool next(int i, Unit& u) const {
        const long L = (long)i * G + c; if (nwg == 0 || L >= (long)rep * nwg) return false;
        int wgid = (int)(L % nwg); { const int q = nwg / NXCD, r = nwg % NXCD, xcd = wgid % NXCD, off = wgid / NXCD; wgid = (xcd < r ? xcd * (q + 1) : r * (q + 1) + (xcd - r) * q) + off; }
        const int nig = WGM * nN, gid = wgid / nig, fm = gid * WGM, gsz = (nM - fm) < WGM ? (nM - fm) : WGM;
        const int pm = fm + ((wgid % nig) % gsz), pnl = (wgid % nig) / gsz;
        const int e = (pm >= ps1) + (pm >= ps2) + (pm >= ps3) + (pm >= ps4) + (pm >= ps5) + (pm >= ps6) + (pm >= ps7);
        u.pm = pm; u.pn = e * nN + pnl; return true;
    }
    __device__ __forceinline__ void a_ready(const Unit&) const {}
    __device__ __forceinline__ void done(const Unit&) const {}
};
template <class Epi, class Sched, bool ALIGN_EPI = false, bool SP2 = false>
__device__ __forceinline__ void gemm_phase(PG8_LAS unsigned char* lds, const Gemm g, const Sched& S, const Epi& E) {
    const int tid = threadIdx.x, wid = __builtin_amdgcn_readfirstlane(tid >> 6), lane = tid & 63, wr = wid >> 2, wc = wid & 3, fr = lane & 15, fq = lane >> 4;
    const int K = g.K, nt = K / BK;
    unsigned voffA[2], voffB[2];
#pragma unroll
    for (int i = 0; i < 2; ++i) { int R, C; stage_rc(tid * 16 + i * 8192, R, C); const int Rb = Epi::PERM ? ((R & ~31) + perm32(R & 31)) : R;
        voffA[i] = (unsigned)(R * g.lda + C) * 2u; voffB[i] = (unsigned)(Rb * K + C) * 2u; }
    const size_t kstep = (size_t)(BK * 2);
    const size_t hstepA = (size_t)HALF * g.lda * 2, hstepB = (size_t)HALF * K * 2;
    const size_t tstepA = 2 * hstepA, tstepB = 2 * hstepB;
    const unsigned ldsw = (unsigned)wid * 1024u;
    const int aoff = lds_byte(wr * 64 + fr, fq * 8), boff = lds_byte(wc * 32 + fr, fq * 8);
#define PG8_SA(b, h) (((b) * 2 + (h)) * HTB)
#define PG8_SB(b, h) ((4 + (b) * 2 + (h)) * HTB)
#define PG8_STAGE(bufoff, gbase, voff) do { _Pragma("unroll") for (int _i = 0; _i < 2; ++_i) \
        __builtin_amdgcn_global_load_lds((const unsigned*)((const char*)(gbase) + (voff)[_i]), (PG8_LAS unsigned*)(lds + (bufoff) + ldsw + _i * 8192), 16, 0, 0); } while (0)
#define PG8_LDA(dst, b, h) do { _Pragma("unroll") for (int m = 0; m < 4; ++m) _Pragma("unroll") for (int k = 0; k < 2; ++k) dst[m][k] = *(const PG8_LAS bf16x8*)(lds + PG8_SA(b, h) + aoff + m * 2048 + k * 1024); } while (0)
#define PG8_LDB(dst, b, h) do { _Pragma("unroll") for (int n = 0; n < 2; ++n) _Pragma("unroll") for (int k = 0; k < 2; ++k) dst[n][k] = *(const PG8_LAS bf16x8*)(lds + PG8_SB(b, h) + boff + n * 2048 + k * 1024); } while (0)
#define PG8_MMA(ai, bj, At, Bt) do { __builtin_amdgcn_s_setprio(1); _Pragma("unroll") for (int m = 0; m < 4; ++m) _Pragma("unroll") for (int n = 0; n < 2; ++n) _Pragma("unroll") for (int k = 0; k < 2; ++k) \
        acc[ai][bj][m][n] = __builtin_amdgcn_mfma_f32_16x16x32_bf16(Bt[n][k], At[m][k], acc[ai][bj][m][n], 0, 0, 0); __builtin_amdgcn_s_setprio(0); } while (0)
#define PG8_WAIT_V(n) asm volatile("s_waitcnt vmcnt(" #n ")" ::: "memory")
#define PG8_WAIT_L(n) asm volatile("s_waitcnt lgkmcnt(" #n ")" ::: "memory")
#define PG8_BAR __builtin_amdgcn_s_barrier()
#define PG8_SCHED __builtin_amdgcn_sched_barrier(0)
    Unit cur, nxt; int ui = 0;
    if (!S.next(0, cur)) return;
    f32x4 acc[2][2][4][2];
#pragma unroll
    for (int a = 0; a < 2; ++a)
#pragma unroll
        for (int b = 0; b < 2; ++b)
#pragma unroll
            for (int m = 0; m < 4; ++m)
#pragma unroll
                for (int n = 0; n < 2; ++n) acc[a][b][m][n] = (f32x4){0.f, 0.f, 0.f, 0.f};
    bf16x8 At[4][2], B0[2][2], B1[2][2];
    const char* cA = (const char*)g.A + (size_t)cur.pm * tstepA; const char* cB = (const char*)g.Bt + (size_t)cur.pn * tstepB;
    S.a_ready(cur);
    if constexpr (SP2) {
        PG8_STAGE(PG8_SB(0, 0), cB, voffB); PG8_STAGE(PG8_SB(0, 1), cB + hstepB, voffB); PG8_STAGE(PG8_SA(0, 0), cA, voffA); PG8_STAGE(PG8_SA(0, 1), cA + hstepA, voffA);
        if (wr == 1) PG8_BAR;
        PG8_WAIT_V(2); PG8_BAR;
        PG8_STAGE(PG8_SB(1, 0), cB + kstep, voffB); PG8_STAGE(PG8_SA(1, 0), cA + kstep, voffA); PG8_STAGE(PG8_SB(1, 1), cB + hstepB + kstep, voffB);
        PG8_WAIT_V(6); PG8_BAR;
    } else {
        PG8_STAGE(PG8_SB(0, 0), cB, voffB); PG8_STAGE(PG8_SA(0, 0), cA, voffA); PG8_STAGE(PG8_SB(0, 1), cB + hstepB, voffB); PG8_STAGE(PG8_SA(0, 1), cA + hstepA, voffA);
        if (wr == 1) PG8_BAR;
        PG8_WAIT_V(4); PG8_BAR;
        PG8_STAGE(PG8_SB(1, 0), cB + kstep, voffB); PG8_STAGE(PG8_SA(1, 0), cA + kstep, voffA); PG8_STAGE(PG8_SB(1, 1), cB + hstepB + kstep, voffB);
        PG8_WAIT_V(6); PG8_BAR;
    }
    for (;;) {
        const bool has_next = S.next(ui + 1, nxt);
        const char* nA = has_next ? (const char*)g.A + (size_t)nxt.pm * tstepA : cA; const char* nB = has_next ? (const char*)g.Bt + (size_t)nxt.pn * tstepB : cB;
        for (int t = 0; t < nt; t += 2) {
            const bool last = (t == nt - 2);
            const char* a1 = cA + (size_t)(t + 1) * kstep;
            const char* a2 = last ? nA : cA + (size_t)(t + 2) * kstep; const char* b2 = last ? nB : cB + (size_t)(t + 2) * kstep;
            const char* a3 = a2 + kstep; const char* b3 = b2 + kstep;
            if (last && has_next) S.a_ready(nxt);
            if constexpr (SP2) {
            PG8_LDB(B0, 0, 0); PG8_LDB(B1, 0, 1); PG8_SCHED; PG8_LDA(At, 0, 0); PG8_STAGE(PG8_SA(1, 1), a1 + hstepA, voffA);
            PG8_WAIT_V(8); PG8_WAIT_L(0); PG8_BAR; PG8_MMA(0, 0, At, B0); PG8_MMA(0, 1, At, B1); PG8_BAR; PG8_SCHED;
            PG8_LDA(At, 0, 1); PG8_STAGE(PG8_SB(0, 0), b2, voffB); PG8_STAGE(PG8_SB(0, 1), b2 + hstepB, voffB); PG8_STAGE(PG8_SA(0, 0), a2, voffA);
            PG8_WAIT_V(8); PG8_WAIT_L(0); PG8_BAR; PG8_MMA(1, 0, At, B0); PG8_MMA(1, 1, At, B1); PG8_BAR; PG8_SCHED;
            PG8_LDB(B0, 1, 0); PG8_LDB(B1, 1, 1); PG8_SCHED; PG8_LDA(At, 1, 0); PG8_STAGE(PG8_SA(0, 1), a2 + hstepA, voffA);
            PG8_WAIT_V(8); PG8_WAIT_L(0); PG8_BAR; PG8_MMA(0, 0, At, B0); PG8_MMA(0, 1, At, B1); PG8_BAR; PG8_SCHED;
            PG8_LDA(At, 1, 1); PG8_STAGE(PG8_SB(1, 0), b3, voffB); PG8_STAGE(PG8_SB(1, 1), b3 + hstepB, voffB); PG8_STAGE(PG8_SA(1, 0), a3, voffA);
            PG8_WAIT_V(8); PG8_WAIT_L(0); PG8_BAR; PG8_MMA(1, 0, At, B0); PG8_MMA(1, 1, At, B1); PG8_BAR; PG8_SCHED;
            } else {
            PG8_LDB(B0, 0, 0); PG8_SCHED; PG8_LDA(At, 0, 0); PG8_STAGE(PG8_SA(1, 1), a1 + hstepA, voffA);
            PG8_WAIT_L(8); PG8_BAR; PG8_WAIT_L(0); PG8_MMA(0, 0, At, B0); PG8_BAR; PG8_SCHED;
            PG8_LDB(B1, 0, 1); PG8_STAGE(PG8_SB(0, 0), b2, voffB);
            PG8_BAR; PG8_WAIT_L(0); PG8_MMA(0, 1, At, B1); PG8_BAR;
            PG8_LDA(At, 0, 1); PG8_STAGE(PG8_SA(0, 0), a2, voffA);
            PG8_BAR; PG8_WAIT_L(0); PG8_MMA(1, 0, At, B0); PG8_BAR; PG8_SCHED;
            PG8_STAGE(PG8_SB(0, 1), b2 + hstepB, voffB);
            PG8_WAIT_V(6); PG8_BAR; PG8_MMA(1, 1, At, B1); PG8_BAR;
            PG8_LDB(B0, 1, 0); PG8_SCHED; PG8_LDA(At, 1, 0); PG8_STAGE(PG8_SA(0, 1), a2 + hstepA, voffA);
            PG8_WAIT_L(8); PG8_BAR; PG8_WAIT_L(0); PG8_MMA(0, 0, At, B0); PG8_BAR; PG8_SCHED;
            PG8_LDB(B1, 1, 1); PG8_STAGE(PG8_SB(1, 0), b3, voffB);
            PG8_BAR; PG8_WAIT_L(0); PG8_MMA(0, 1, At, B1); PG8_BAR;
            PG8_LDA(At, 1, 1); PG8_STAGE(PG8_SA(1, 0), a3, voffA);
            PG8_BAR; PG8_WAIT_L(0); PG8_MMA(1, 0, At, B0); PG8_BAR; PG8_SCHED;
            PG8_STAGE(PG8_SB(1, 1), b3 + hstepB, voffB);
            PG8_WAIT_V(6); PG8_BAR; PG8_MMA(1, 1, At, B1); PG8_BAR;
            }
        }
        if constexpr (ALIGN_EPI) { if (wr == 0) PG8_BAR; }
        if constexpr (!Epi::AFTER_DRAIN) { E(acc, cur, wr, wc, fr, fq); S.done(cur); }
        if (!has_next) break;
#pragma unroll
        for (int a = 0; a < 2; ++a)
#pragma unroll
            for (int b = 0; b < 2; ++b)
#pragma unroll
                for (int m = 0; m < 4; ++m)
#pragma unroll
                    for (int n = 0; n < 2; ++n) acc[a][b][m][n] = (f32x4){0.f, 0.f, 0.f, 0.f};
        cur = nxt; cA = nA; cB = nB; ++ui;
        if constexpr (ALIGN_EPI) { if (wr == 1) PG8_BAR; }
    }
    PG8_WAIT_V(0);
    if constexpr (!ALIGN_EPI) { if (wr == 0) PG8_BAR; }
    PG8_BAR;
    if constexpr (Epi::AFTER_DRAIN) { E.fused(acc, cur, wr, wc, fr, fq, lds, wid, lane); S.done(cur); }
#undef PG8_SA
#undef PG8_SB
#undef PG8_STAGE
#undef PG8_LDA
#undef PG8_LDB
#undef PG8_MMA
#undef PG8_WAIT_V
#undef PG8_WAIT_L
#undef PG8_BAR
#undef PG8_SCHED
}
}

constexpr int NWAVES = 8;
constexpr int BATCH = 8, SEQ = 4096, TT = BATCH * SEQ, D = 1024;
constexpr int HK = 8, HV = 16, HD = 128;
constexpr int GIN = 6176, GINP = 6400;
constexpr int FF = 3584, NE = 8, MOE_ROWS = 67584;
constexpr float ALPHA = 1.6817928305074290f;
constexpr float LN_EPS = 1e-5f, RMS_EPS = 1e-6f;
constexpr int NPH = 18, NPHASES = 2 * NPH;

constexpr size_t MiB = 1ull << 20;
constexpr size_t WS_CTL = 0, CTL_ZERO_BYTES = 1 * MiB;
constexpr size_t WS_E12 = 1 * MiB;
constexpr size_t WS_G12 = WS_E12 + 256 * 1024;
constexpr size_t WS_POS = WS_G12 + 256 * 1024;
constexpr size_t WS_GB = 2 * MiB;
constexpr size_t WS_W = 16 * MiB;
constexpr size_t W_IN = WS_W, W_OUT = WS_W + 13 * MiB, W_GU = WS_W + 17 * MiB, W_D = WS_W + 31 * MiB;
constexpr size_t W_QKV = WS_W, W_O = WS_W + 6 * MiB, W_MGU = WS_W + 8 * MiB, W_MD = WS_W + 120 * MiB;
constexpr size_t WS_HB = 192 * MiB;
constexpr size_t WS_BIG = 256 * MiB;
constexpr size_t WS_ZB = WS_BIG, WS_RAW = WS_BIG + 128 * MiB, WS_QKVC = WS_BIG + 400 * MiB;
constexpr int RAWLD = 4352;
constexpr size_t WS_WMEM = WS_RAW, WS_IMEM = WS_RAW + 128 * MiB, WS_KTMEM = WS_RAW + 192 * MiB;
constexpr size_t WS_GTAB = 6 * MiB;
constexpr size_t WS_ACT = WS_BIG;
constexpr size_t WS_QKV = WS_BIG, WS_AO = WS_BIG + 192 * MiB;
constexpr size_t WS_XS = WS_BIG, WS_MACT = WS_BIG + 132 * MiB;
constexpr size_t WS_END = 912 * MiB;
static_assert(WS_QKVC + (size_t)TT * 4096 * 2 <= WS_END && WS_MACT + (size_t)MOE_ROWS * FF * 2 <= WS_END && WS_RAW + (size_t)TT * RAWLD * 2 <= WS_QKVC && WS_KTMEM + (size_t)4096 * 8192 * 2 <= WS_QKVC && WS_GTAB + (size_t)8192 * 192 * 4 <= WS_W, "d_ws map");
static_assert(W_MD + (size_t)NE * D * FF * 2 <= WS_HB && W_IN + (size_t)GINP * D * 2 <= W_OUT && W_MGU + (size_t)NE * 2 * FF * D * 2 <= W_MD, "weight map");
constexpr int CW_BAR = 4096;
constexpr int CW_CNT = 16384;

constexpr int RING_BYTES = 131072;
constexpr int MISC_OFF = RING_BYTES + 320;
constexpr int OGST_OFF = 147456;
constexpr int LDS_BYTES = 163840;

#define GAS __attribute__((address_space(1)))
#define LAS __attribute__((address_space(3)))
#define DI __device__ __forceinline__
typedef unsigned short bf16;
typedef unsigned v4u __attribute__((ext_vector_type(4)));
typedef unsigned v2u __attribute__((ext_vector_type(2)));
typedef float f32x4 __attribute__((ext_vector_type(4)));
typedef float f32x2 __attribute__((ext_vector_type(2)));
typedef GAS unsigned gu32;
#define RLX_AGENT __ATOMIC_RELAXED, __HIP_MEMORY_SCOPE_AGENT
#define LDS_WAIT() asm volatile("s_waitcnt lgkmcnt(0)" ::: "memory")
#define VM_WAIT() asm volatile("s_waitcnt vmcnt(0)" ::: "memory")
__device__ __forceinline__ unsigned long long rt() { return __builtin_amdgcn_s_memrealtime(); }
__device__ __forceinline__ unsigned f2bf(float f) { unsigned u = __builtin_bit_cast(unsigned, f); return (u + 0x7fffu + ((u >> 16) & 1u)) >> 16; }
__device__ __forceinline__ unsigned pk2(float lo, float hi) { return f2bf(lo) | (f2bf(hi) << 16); }

#define XB_TMO      128
#define XB_XCNT(j)  (256  + 64 * (j))
#define XB_XSUB(j)  (1280 + 64 * (j))
#define XB_XGEN(j)  (2304 + 64 * (j))
#define XB_TOP      3328
#define XB_TOPGEN   3392
#define XCD_BAR_WORDS 3456
#define XB_SPIN_CAP (1u << 22)

__device__ __forceinline__ unsigned xb_ld(unsigned* p)              { return __hip_atomic_load(p, __ATOMIC_RELAXED, __HIP_MEMORY_SCOPE_AGENT); }
__device__ __forceinline__ unsigned xb_add(unsigned* p, unsigned v) { return __hip_atomic_fetch_add(p, v, __ATOMIC_RELAXED, __HIP_MEMORY_SCOPE_AGENT); }
__device__ __forceinline__ unsigned xb_xcc_id() { return (unsigned)__builtin_amdgcn_s_getreg((3 << 11) | 20) & 0xFu; }
#define XB_SPIN(cond, bar) do { unsigned _sp = 0; while (cond) { __builtin_amdgcn_s_sleep(1); \
    if ((++_sp & 255u) == 0u) { if (xb_ld(&(bar)[XB_TMO])) break; if (_sp > XB_SPIN_CAP) { atomicAdd(&(bar)[XB_TMO], 1u); break; } } } } while (0)

struct XcdBarrier {
    unsigned* bar; unsigned x;
    volatile LAS unsigned* st;
};

__device__ __forceinline__ XcdBarrier xcd_barrier_post(unsigned* bar, volatile LAS unsigned* st) {
    XcdBarrier b; b.bar = bar; b.x = xb_xcc_id(); b.st = st;
    if (threadIdx.x == 0) (void)xb_add(&bar[XB_XCNT(b.x)], 1u);
    return b;
}
__device__ __forceinline__ void xcd_barrier_complete(unsigned* bar, unsigned x, unsigned& nloc, unsigned& nx) {
    const unsigned G = gridDim.x * gridDim.y * gridDim.z;
    unsigned sum, cnt, mine, sp = 0u;
    for (;;) {
        sum = 0u; cnt = 0u; mine = 0u;
#pragma unroll
        for (unsigned j = 0; j < 16; ++j) { const unsigned c = xb_ld(&bar[XB_XCNT(j)]); sum += c; cnt += (c > 0u) ? 1u : 0u; mine = (j == x) ? c : mine; }
        if (sum == G) break;
        __builtin_amdgcn_s_sleep(1);
        if ((++sp & 255u) == 0u) { if (xb_ld(&bar[XB_TMO])) break; if (sp > XB_SPIN_CAP) { atomicAdd(&bar[XB_TMO], 1u); break; } }
    }
    nloc = mine > 0u ? mine : 1u; nx = cnt > 0u ? cnt : 1u;
}

__device__ __forceinline__ void xcd_barrier(const XcdBarrier& b) {
    asm volatile("s_waitcnt vmcnt(0)" ::: "memory");
    __syncthreads();
    if (threadIdx.x == 0) {
        unsigned* bar = b.bar;
        __builtin_amdgcn_s_waitcnt(0);
        unsigned nloc = b.st[0], nx = b.st[1];
        if (nloc == 0u) { xcd_barrier_complete(bar, b.x, nloc, nx); b.st[0] = nloc; b.st[1] = nx; }
        const unsigned old = xb_add(&bar[XB_XSUB(b.x)], 1u);
        const unsigned gen = old / nloc;
        if (old + 1u == (gen + 1u) * nloc) {
            __builtin_amdgcn_fence(__ATOMIC_RELEASE, "agent");
            asm volatile("s_waitcnt vmcnt(0)" ::: "memory");
            const unsigned og = xb_add(&bar[XB_TOP], 1u);
            const unsigned tg = og / nx;
            if (og + 1u == (tg + 1u) * nx) xb_add(&bar[XB_TOPGEN], 1u);
            else XB_SPIN(xb_ld(&bar[XB_TOPGEN]) == tg, bar);
            __builtin_amdgcn_fence(__ATOMIC_ACQUIRE, "agent");
            xb_add(&bar[XB_XGEN(b.x)], 1u);
            asm volatile("s_waitcnt vmcnt(0)" ::: "memory");
        } else {
            XB_SPIN(xb_ld(&bar[XB_XGEN(b.x)]) == gen, bar);
            __builtin_amdgcn_fence(__ATOMIC_ACQUIRE, "agent");
            asm volatile("s_waitcnt vmcnt(0)" ::: "memory");
        }
    }
    __syncthreads();
}

DI float bf_lo(unsigned w) { return __uint_as_float(w << 16); }
DI float bf_hi(unsigned w) { return __uint_as_float(w & 0xffff0000u); }
DI float wave_sum(float v) {
#pragma unroll
    for (int o = 1; o < 64; o <<= 1) v += __shfl_xor(v, o);
    return v;
}
DI float sigmoid_f(float x) { return 1.0f / (1.0f + __expf(-x)); }

struct Args {
    const float *x, *gdn_w_in, *gdn_conv_w, *gdn_a_log, *gdn_dt_bias, *gdn_norm_w, *gdn_w_out, *sb_w_in, *sb_w_out, *ffn_w_gate, *ffn_w_up, *ffn_w_down,
                *moe_router, *moe_w_gate, *moe_w_up, *moe_w_down, *ln_g, *ln_b;
    float* out; unsigned char* ws; int ph_lo, ph_hi;
};

DI void transpose_item(const float* W, int ldw, bf16* WT, int K, int drow0, int k0, int n0, LAS float* scr, int lane) {
#pragma unroll 8
    for (int i = 0; i < 32; ++i) { const int kk = 2 * i + (lane >> 5); scr[kk * 33 + (lane & 31)] = W[(size_t)(k0 + kk) * ldw + n0 + (lane & 31)]; }
    LDS_WAIT(); asm volatile("" ::: "memory");
    const int c = lane & 7;
#pragma unroll
    for (int jj = 0; jj < 4; ++jj) { const int n = (lane >> 3) + 8 * jj; const LAS float* s = scr + (8 * c) * 33 + n;
        v4u o; o.x = pk2(s[0 * 33], s[1 * 33]); o.y = pk2(s[2 * 33], s[3 * 33]); o.z = pk2(s[4 * 33], s[5 * 33]); o.w = pk2(s[6 * 33], s[7 * 33]);
        *(v4u*)(WT + (size_t)(drow0 + n) * K + k0 + 8 * c) = o; }
    LDS_WAIT(); asm volatile("" ::: "memory");
}

DI void phase_w_gdn(const Args& a, int j, LAS unsigned char* lds, int bid, int G, int tid, int wave, int lane) {
    LAS float* scr = (LAS float*)(lds + wave * 16384);
    const int gw = bid * NWAVES + wave, NGW = G * NWAVES;
    const float* Win = a.gdn_w_in + (size_t)j * D * GIN; const float* Wout = a.gdn_w_out + (size_t)j * 2048 * D;
    const float* Wg = a.ffn_w_gate + (size_t)j * D * FF; const float* Wu = a.ffn_w_up + (size_t)j * D * FF; const float* Wd = a.ffn_w_down + (size_t)j * FF * D;
    bf16* WIN_T = (bf16*)(a.ws + W_IN); bf16* WOUT_T = (bf16*)(a.ws + W_OUT); bf16* WGU_T = (bf16*)(a.ws + W_GU); bf16* WD_T = (bf16*)(a.ws + W_D);
    constexpr int NB_IN = GIN / 32, I_IN = 16 * NB_IN, I_OUT = 32 * 32, I_G = 16 * 112, I_D = 56 * 32, NIT = I_IN + I_OUT + 2 * I_G + I_D;
    for (int it = gw; it < NIT; it += NGW) {
        int r = it;
        if (r < I_IN) { const int kb = r / NB_IN, nb = r % NB_IN; transpose_item(Win, GIN, WIN_T, D, 32 * nb, 64 * kb, 32 * nb, scr, lane); continue; } r -= I_IN;
        if (r < I_OUT) { const int kb = r / 32, nb = r % 32; transpose_item(Wout, D, WOUT_T, 2048, 32 * nb, 64 * kb, 32 * nb, scr, lane); continue; } r -= I_OUT;
        if (r < I_G) { const int kb = r / 112, nb = r % 112, n0 = 32 * nb; transpose_item(Wg, FF, WGU_T, D, 256 * (n0 >> 7) + (n0 & 127), 64 * kb, n0, scr, lane); continue; } r -= I_G;
        if (r < I_G) { const int kb = r / 112, nb = r % 112, n0 = 32 * nb; transpose_item(Wu, FF, WGU_T, D, 256 * (n0 >> 7) + 128 + (n0 & 127), 64 * kb, n0, scr, lane); continue; } r -= I_G;
        { const int kb = r / 32, nb = r % 32; transpose_item(Wd, D, WD_T, FF, 32 * nb, 64 * kb, 32 * nb, scr, lane); }
    }
    if (j == 0) {
        bf16* HB = (bf16*)(a.ws + WS_HB); const f32x4* x4 = (const f32x4*)a.x;
        for (size_t i = (size_t)bid * 512 + tid; i < (size_t)TT * D / 8; i += (size_t)G * 512) { const f32x4 p = x4[2 * i], q = x4[2 * i + 1];
            v4u o; o.x = pk2(p[0], p[1]); o.y = pk2(p[2], p[3]); o.z = pk2(q[0], q[1]); o.w = pk2(q[2], q[3]); *(v4u*)(HB + 8 * i) = o; }
    }
}
DI void phase_w_sb(const Args& a, int j, LAS unsigned char* lds, int bid, int G, int wave, int lane) {
    LAS float* scr = (LAS float*)(lds + wave * 16384);
    const int gw = bid * NWAVES + wave, NGW = G * NWAVES;
    const float* Wqkv = a.sb_w_in + (size_t)j * D * 3072; const float* Wo = a.sb_w_out + (size_t)j * D * D;
    const float* Mg = a.moe_w_gate + (size_t)j * NE * D * FF; const float* Mu = a.moe_w_up + (size_t)j * NE * D * FF; const float* Md = a.moe_w_down + (size_t)j * NE * FF * D;
    bf16* WQKV_T = (bf16*)(a.ws + W_QKV); bf16* WO_T = (bf16*)(a.ws + W_O); bf16* MGU_T = (bf16*)(a.ws + W_MGU); bf16* MD_T = (bf16*)(a.ws + W_MD);
    constexpr int I_QKV = 16 * 96, I_O = 16 * 32, I_G = 16 * 112, I_D = 56 * 32, I_E = 2 * I_G + I_D, NIT = I_QKV + I_O + NE * I_E;
    for (int it = gw; it < NIT; it += NGW) {
        int r = it;
        if (r < I_QKV) { const int kb = r / 96, nb = r % 96; transpose_item(Wqkv, 3072, WQKV_T, D, 32 * nb, 64 * kb, 32 * nb, scr, lane); continue; } r -= I_QKV;
        if (r < I_O) { const int kb = r / 32, nb = r % 32; transpose_item(Wo, D, WO_T, D, 32 * nb, 64 * kb, 32 * nb, scr, lane); continue; } r -= I_O;
        const int e = r / I_E; r -= e * I_E;
        bf16* gu = MGU_T + (size_t)e * 2 * FF * D; bf16* dn = MD_T + (size_t)e * D * FF;
        if (r < I_G) { const int kb = r / 112, nb = r % 112, n0 = 32 * nb; transpose_item(Mg + (size_t)e * D * FF, FF, gu, D, 256 * (n0 >> 7) + (n0 & 127), 64 * kb, n0, scr, lane); continue; } r -= I_G;
        if (r < I_G) { const int kb = r / 112, nb = r % 112, n0 = 32 * nb; transpose_item(Mu + (size_t)e * D * FF, FF, gu, D, 256 * (n0 >> 7) + 128 + (n0 & 127), 64 * kb, n0, scr, lane); continue; } r -= I_G;
        { const int kb = r / 32, nb = r % 32; transpose_item(Md + (size_t)e * FF * D, D, dn, FF, 32 * nb, 64 * kb, 32 * nb, scr, lane); }
    }
}

DI void phase_conv(const Args& a, int j, int bid, int G, int wave, int lane) {
    const bf16* proj = (const bf16*)(a.ws + WS_RAW); bf16* qkvc = (bf16*)(a.ws + WS_QKVC); float* gb = (float*)(a.ws + WS_GB);
    const float* cw = a.gdn_conv_w + (size_t)j * 4 * 4096;
    const int gw = bid * NWAVES + wave, NGW = G * NWAVES;
    for (int t = gw; t < TT; t += NGW) {
        const int pos = t & (SEQ - 1);
#pragma unroll 1
        for (int grp = 0; grp < 8; ++grp) {
            const int ch = 512 * grp + 8 * lane;
            float acc[8];
#pragma unroll
            for (int i = 0; i < 8; ++i) acc[i] = 0.f;
#pragma unroll
            for (int tap = 0; tap < 4; ++tap) {
                if (pos - 3 + tap >= 0) {
                    const v4u xv = *(const v4u*)(proj + (size_t)(t - 3 + tap) * RAWLD + ch);
                    const f32x4 w0 = *(const f32x4*)(cw + tap * 4096 + ch), w1 = *(const f32x4*)(cw + tap * 4096 + ch + 4);
                    acc[0] += w0[0] * bf_lo(xv.x); acc[1] += w0[1] * bf_hi(xv.x); acc[2] += w0[2] * bf_lo(xv.y); acc[3] += w0[3] * bf_hi(xv.y);
                    acc[4] += w1[0] * bf_lo(xv.z); acc[5] += w1[1] * bf_hi(xv.z); acc[6] += w1[2] * bf_lo(xv.w); acc[7] += w1[3] * bf_hi(xv.w);
                }
            }
            float ss = 0.f;
#pragma unroll
            for (int i = 0; i < 8; ++i) { acc[i] = acc[i] * sigmoid_f(acc[i]); ss += acc[i] * acc[i]; }
            if (grp < 4) {
                ss += __shfl_xor(ss, 1); ss += __shfl_xor(ss, 2); ss += __shfl_xor(ss, 4); ss += __shfl_xor(ss, 8);
                float rn = 1.0f / sqrtf(ss + RMS_EPS); if (grp < 2) rn *= 0.08838834764831845f;
#pragma unroll
                for (int i = 0; i < 8; ++i) acc[i] *= rn;
            }
            v4u o; o.x = pk2(acc[0], acc[1]); o.y = pk2(acc[2], acc[3]); o.z = pk2(acc[4], acc[5]); o.w = pk2(acc[6], acc[7]);
            *(v4u*)(qkvc + (size_t)t * 4096 + ch) = o;
        }
        if (lane < 16) {
            const float bb = __uint_as_float((unsigned)proj[(size_t)t * RAWLD + 4096 + lane] << 16), aa = __uint_as_float((unsigned)proj[(size_t)t * RAWLD + 4112 + lane] << 16);
            const float xx = aa + a.gdn_dt_bias[j * 16 + lane];
            const float sp = xx > 20.f ? xx : log1pf(__expf(xx));
            gb[(size_t)t * 32 + lane] = -__expf(a.gdn_a_log[j * 16 + lane]) * sp;
            gb[(size_t)t * 32 + 16 + lane] = sigmoid_f(bb);
        }
    }
}

DI void phase_gdn_naive(const Args& a, int j, LAS unsigned char* lds, int bid, int tid) {
    if (bid >= BATCH * HV) return;
    const int b = bid / HV, hv = bid % HV, hk = hv / 2, jc = tid & 127, r = tid >> 7;
    const bf16* zb = (const bf16*)(a.ws + WS_ZB); bf16* qkvc = (bf16*)(a.ws + WS_QKVC); const float* gb = (const float*)(a.ws + WS_GB);
    LAS float* qs = (LAS float*)lds; LAS float* ks = qs + 2048; LAS float* vs = ks + 2048; LAS float* gs = vs + 2048; LAS float* bs = gs + 16;
    LAS f32x2* red = (LAS f32x2*)(lds + 32768); LAS float* redkq = (LAS float*)(lds + 32768 + 8192); LAS float* ob = (LAS float*)(lds + 49152);
    float S[32];
#pragma unroll
    for (int i = 0; i < 32; ++i) S[i] = 0.f;
    const int lrow = tid >> 5, lcol = (tid & 31) * 4;
    for (int blk = 0; blk < SEQ / 16; ++blk) {
        const size_t t0 = (size_t)b * SEQ + blk * 16;
        __syncthreads();
        { const bf16* rowp = qkvc + (t0 + lrow) * 4096;
          const v2u qv = *(const v2u*)(rowp + hk * 128 + lcol), kv = *(const v2u*)(rowp + 1024 + hk * 128 + lcol), vv = *(const v2u*)(rowp + 2048 + hv * 128 + lcol);
          *(LAS f32x4*)(qs + lrow * 128 + lcol) = (f32x4){bf_lo(qv.x), bf_hi(qv.x), bf_lo(qv.y), bf_hi(qv.y)};
          *(LAS f32x4*)(ks + lrow * 128 + lcol) = (f32x4){bf_lo(kv.x), bf_hi(kv.x), bf_lo(kv.y), bf_hi(kv.y)};
          *(LAS f32x4*)(vs + lrow * 128 + lcol) = (f32x4){bf_lo(vv.x), bf_hi(vv.x), bf_lo(vv.y), bf_hi(vv.y)};
          if (tid < 16) { gs[tid] = __expf(gb[(t0 + tid) * 32 + hv]); bs[tid] = gb[(t0 + tid) * 32 + 16 + hv]; } }
        __syncthreads();
#pragma unroll 1
        for (int tt = 0; tt < 16; ++tt) {
            float pk = 0.f, pq = 0.f, pkq = 0.f;
#pragma unroll
            for (int i4 = 0; i4 < 8; ++i4) { const f32x4 k4 = *(const LAS f32x4*)(ks + tt * 128 + 32 * r + 4 * i4), q4 = *(const LAS f32x4*)(qs + tt * 128 + 32 * r + 4 * i4);
#pragma unroll
                for (int c = 0; c < 4; ++c) { pk += k4[c] * S[4 * i4 + c]; pq += q4[c] * S[4 * i4 + c]; pkq += k4[c] * q4[c]; } }
            const int buf = tt & 1;
            red[(buf * 4 + r) * 128 + jc] = (f32x2){pk, pq}; if (jc == 0) redkq[buf * 4 + r] = pkq;
            __syncthreads();
            float kS = 0.f, qS = 0.f, kq = 0.f;
#pragma unroll
            for (int rr = 0; rr < 4; ++rr) { const f32x2 p = red[(buf * 4 + rr) * 128 + jc]; kS += p.x; qS += p.y; kq += redkq[buf * 4 + rr]; }
            const float eg = gs[tt], vn = bs[tt] * (vs[tt * 128 + jc] - eg * kS);
#pragma unroll
            for (int i4 = 0; i4 < 8; ++i4) { const f32x4 k4 = *(const LAS f32x4*)(ks + tt * 128 + 32 * r + 4 * i4);
#pragma unroll
                for (int c = 0; c < 4; ++c) S[4 * i4 + c] = eg * S[4 * i4 + c] + k4[c] * vn; }
            if (r == 0) ob[tt * 128 + jc] = eg * qS + kq * vn;
        }
        __syncthreads();
        {
            const f32x4 o4 = *(const LAS f32x4*)(ob + lrow * 128 + lcol);
            float ss = o4[0] * o4[0] + o4[1] * o4[1] + o4[2] * o4[2] + o4[3] * o4[3];
            ss += __shfl_xor(ss, 1); ss += __shfl_xor(ss, 2); ss += __shfl_xor(ss, 4); ss += __shfl_xor(ss, 8); ss += __shfl_xor(ss, 16);
            const float rinv = 1.0f / sqrtf(ss * (1.0f / 128.0f) + RMS_EPS);
            const v2u zv = *(const v2u*)(zb + (t0 + lrow) * 2048 + hv * 128 + lcol);
            const f32x4 nw = *(const f32x4*)(a.gdn_norm_w + j * 128 + lcol);
            const float z0 = bf_lo(zv.x), z1 = bf_hi(zv.x), z2 = bf_lo(zv.y), z3 = bf_hi(zv.y);
            v2u o; o.x = pk2(o4[0] * rinv * nw[0] * z0 * sigmoid_f(z0), o4[1] * rinv * nw[1] * z1 * sigmoid_f(z1));
            o.y = pk2(o4[2] * rinv * nw[2] * z2 * sigmoid_f(z2), o4[3] * rinv * nw[3] * z3 * sigmoid_f(z3));
            *(v2u*)(qkvc + (t0 + lrow) * 4096 + 2048 + hv * 128 + lcol) = o;
        }
    }
}

template <bool ROUTER>
DI void phase_ln(const Args& a, int lnidx, int j, LAS unsigned char* lds, int bid, int G, int tid, int wave, int lane) {
    float* out = a.out; bf16* HB = (bf16*)(a.ws + WS_HB);
    const float* g = a.ln_g + (size_t)lnidx * D; const float* bta = a.ln_b + (size_t)lnidx * D;
    const int gw = bid * NWAVES + wave, NGW = G * NWAVES;
    LAS unsigned* lcnt = (LAS unsigned*)lds;
    if (ROUTER) { if (tid < 8) lcnt[tid] = 0u; __syncthreads(); }
    f32x4 gv[4], bv[4];
#pragma unroll
    for (int q = 0; q < 4; ++q) { gv[q] = *(const f32x4*)(g + 4 * (lane + 64 * q)); bv[q] = *(const f32x4*)(bta + 4 * (lane + 64 * q)); }
    for (int t = gw; t < TT; t += NGW) {
        f32x4* row = (f32x4*)(out + (size_t)t * D);
        f32x4 v[4]; float s = 0.f;
#pragma unroll
        for (int q = 0; q < 4; ++q) { v[q] = row[lane + 64 * q]; s += (v[q][0] + v[q][1]) + (v[q][2] + v[q][3]); }
        const float mean = wave_sum(s) * (1.0f / D); float s2 = 0.f;
#pragma unroll
        for (int q = 0; q < 4; ++q) { v[q] = v[q] - mean; s2 += (v[q][0] * v[q][0] + v[q][1] * v[q][1]) + (v[q][2] * v[q][2] + v[q][3] * v[q][3]); }
        const float rstd = 1.0f / sqrtf(wave_sum(s2) * (1.0f / D) + LN_EPS);
#pragma unroll
        for (int q = 0; q < 4; ++q) { v[q] = v[q] * rstd * gv[q] + bv[q]; row[lane + 64 * q] = v[q];
            v2u o; o.x = pk2(v[q][0], v[q][1]); o.y = pk2(v[q][2], v[q][3]); *(v2u*)(HB + (size_t)t * D + 4 * (lane + 64 * q)) = o; }
        if (ROUTER) {
            const float* R = a.moe_router + (size_t)j * D * NE;
            float lg[8];
#pragma unroll
            for (int e = 0; e < 8; ++e) lg[e] = 0.f;
#pragma unroll
            for (int q = 0; q < 4; ++q)
#pragma unroll
                for (int c = 0; c < 4; ++c) { const int k = 4 * (lane + 64 * q) + c; const f32x4 r0 = *(const f32x4*)(R + k * 8), r1 = *(const f32x4*)(R + k * 8 + 4); const float hv = v[q][c];
                    lg[0] += hv * r0[0]; lg[1] += hv * r0[1]; lg[2] += hv * r0[2]; lg[3] += hv * r0[3]; lg[4] += hv * r1[0]; lg[5] += hv * r1[1]; lg[6] += hv * r1[2]; lg[7] += hv * r1[3]; }
#pragma unroll
            for (int e = 0; e < 8; ++e) lg[e] = wave_sum(lg[e]);
            int i1 = 0; float v1 = lg[0];
#pragma unroll
            for (int e = 1; e < 8; ++e) if (lg[e] > v1) { v1 = lg[e]; i1 = e; }
            int i2 = -1; float v2 = -3.0e38f;
#pragma unroll
            for (int e = 0; e < 8; ++e) if (e != i1 && lg[e] > v2) { v2 = lg[e]; i2 = e; }
            if (lane == 0) {
                const float g1 = 1.0f / (1.0f + __expf(v2 - v1));
                ((unsigned*)(a.ws + WS_E12))[t] = (unsigned)i1 | ((unsigned)i2 << 8);
                ((f32x2*)(a.ws + WS_G12))[t] = (f32x2){g1, 1.0f - g1};
                __hip_atomic_fetch_add(lcnt + i1, 1u, __ATOMIC_RELAXED, __HIP_MEMORY_SCOPE_WORKGROUP); __hip_atomic_fetch_add(lcnt + i2, 1u, __ATOMIC_RELAXED, __HIP_MEMORY_SCOPE_WORKGROUP);
            }
        }
    }
    if (ROUTER) { __syncthreads(); if (tid < 8) { unsigned* cnt = (unsigned*)(a.ws + WS_CTL) + CW_CNT + 256 * j; __hip_atomic_fetch_add(cnt + tid, lcnt[tid], __ATOMIC_RELAXED, __HIP_MEMORY_SCOPE_AGENT); } }
}

DI void phase_sb_naive(const Args& a, LAS unsigned char* lds, int bid, int G, int tid) {
    const bf16* qkv = (const bf16*)(a.ws + WS_QKV); bf16* ao = (bf16*)(a.ws + WS_AO);
    LAS unsigned char* Ks = lds; LAS unsigned char* Vs = lds + 16384;
    const int qi = tid >> 2, r = tid & 3;
    for (int idx = bid; idx < 64 * 32; idx += G) {
        const int qb = 31 - idx / 64, bh = idx % 64, b = bh >> 3, h = bh & 7;
        const int t = qb * 128 + qi;
        const size_t rowq = (size_t)b * SEQ + t;
        float q[32], o[32];
        { const bf16* qp = qkv + rowq * 3072 + h * 128 + 32 * r;
#pragma unroll
          for (int c = 0; c < 4; ++c) { const v4u w = *(const v4u*)(qp + 8 * c);
              q[8 * c + 0] = bf_lo(w.x); q[8 * c + 1] = bf_hi(w.x); q[8 * c + 2] = bf_lo(w.y); q[8 * c + 3] = bf_hi(w.y);
              q[8 * c + 4] = bf_lo(w.z); q[8 * c + 5] = bf_hi(w.z); q[8 * c + 6] = bf_lo(w.w); q[8 * c + 7] = bf_hi(w.w); }
#pragma unroll
          for (int i = 0; i < 32; ++i) { q[i] *= 0.08838834764831845f; o[i] = 0.f; } }
        float P = 1.0f;
        for (int kt = 2 * qb + 1; kt >= 0; --kt) {
            __syncthreads();
#pragma unroll
            for (int i = 0; i < 2; ++i) { const int c = tid + 512 * i, row = c >> 4, part = c & 15;
                const bf16* src = qkv + ((size_t)b * SEQ + kt * 64 + row) * 3072 + h * 128 + part * 8;
                *(LAS v4u*)(Ks + c * 16) = *(const v4u*)(src + 1024); *(LAS v4u*)(Vs + c * 16) = *(const v4u*)(src + 2048); }
            __syncthreads();
#pragma unroll 1
            for (int s = 63; s >= 0; --s) {
                float z = 0.f;
#pragma unroll
                for (int c = 0; c < 4; ++c) { const v4u w = *(const LAS v4u*)(Ks + s * 256 + r * 64 + c * 16);
                    z += q[8 * c + 0] * bf_lo(w.x) + q[8 * c + 1] * bf_hi(w.x) + q[8 * c + 2] * bf_lo(w.y) + q[8 * c + 3] * bf_hi(w.y)
                       + q[8 * c + 4] * bf_lo(w.z) + q[8 * c + 5] * bf_hi(w.z) + q[8 * c + 6] * bf_lo(w.w) + q[8 * c + 7] * bf_hi(w.w); }
                z += __shfl_xor(z, 1); z += __shfl_xor(z, 2);
                const bool live = (kt * 64 + s) < t;
                const float e = __expf(fminf(z, 80.f)), rr = 1.0f / (1.0f + e);
                const float A = live ? e * rr * P : 0.f;
                P = live ? P * rr : P;
#pragma unroll
                for (int c = 0; c < 4; ++c) { const v4u w = *(const LAS v4u*)(Vs + s * 256 + r * 64 + c * 16);
                    o[8 * c + 0] += A * bf_lo(w.x); o[8 * c + 1] += A * bf_hi(w.x); o[8 * c + 2] += A * bf_lo(w.y); o[8 * c + 3] += A * bf_hi(w.y);
                    o[8 * c + 4] += A * bf_lo(w.z); o[8 * c + 5] += A * bf_hi(w.z); o[8 * c + 6] += A * bf_lo(w.w); o[8 * c + 7] += A * bf_hi(w.w); }
            }
        }
        { bf16* op = ao + rowq * 1024 + h * 128 + 32 * r;
#pragma unroll
          for (int c = 0; c < 4; ++c) { v4u w; w.x = pk2(o[8 * c + 0], o[8 * c + 1]); w.y = pk2(o[8 * c + 2], o[8 * c + 3]); w.z = pk2(o[8 * c + 4], o[8 * c + 5]); w.w = pk2(o[8 * c + 6], o[8 * c + 7]);
              *(v4u*)(op + 8 * c) = w; } }
    }
}


namespace sba {
using bf16x8 = __attribute__((ext_vector_type(8))) short;
using s16x4  = __attribute__((ext_vector_type(4))) short;
using f32x16 = __attribute__((ext_vector_type(16))) float;
constexpr int SHM_V = 16384, SHM_K = 16384, LDQ = 3072;
#define KSWZ(row, colB) ((row) * 256 + ((colB) ^ (((row) & 7) << 4)))
#define SBAR() __builtin_amdgcn_sched_barrier(0)
DI int crow(int r, int hi) { return (r & 3) + 8 * (r >> 2) + 4 * hi; }
DI int v_st(int k, int c) { const int kk = (k & ~0xC) | ((k & 4) << 1) | ((k & 8) >> 1); return ((kk >> 3) * 4 + (c >> 5)) * 512 + ((kk & 7) * 32 + (c & 31)) * 2; }
DI int v_rd_base(int lane) { return ((lane & 3) << 3) | (((lane >> 2) & 3) << 6) | (((lane >> 4) & 1) << 5) | (((lane >> 5) & 1) << 8); }
constexpr int v_rd_off(int d0, int ks, int half) { return d0 * 512 + ks * 4096 + half * 2048; }
template <int OFF> DI s16x4 tr_read(int vb) { s16x4 r; asm volatile("ds_read_b64_tr_b16 %0, %1 offset:%2" : "=&v"(r) : "v"(vb), "i"(OFF) : "memory"); return r; }
template <int D0> DI void pv_one(f32x16& od, int vb, bf16x8 pa0, bf16x8 pa1, bf16x8 pa2, bf16x8 pa3) {
  const s16x4 l0 = tr_read<v_rd_off(D0, 0, 0)>(vb), h0 = tr_read<v_rd_off(D0, 0, 1)>(vb), l1 = tr_read<v_rd_off(D0, 1, 0)>(vb), h1 = tr_read<v_rd_off(D0, 1, 1)>(vb);
  const s16x4 l2 = tr_read<v_rd_off(D0, 2, 0)>(vb), h2 = tr_read<v_rd_off(D0, 2, 1)>(vb), l3 = tr_read<v_rd_off(D0, 3, 0)>(vb), h3 = tr_read<v_rd_off(D0, 3, 1)>(vb);
  asm volatile("s_waitcnt lgkmcnt(0)" ::: "memory"); SBAR();
#define PK(L, H) (bf16x8){L[0], L[1], L[2], L[3], H[0], H[1], H[2], H[3]}
  od = __builtin_amdgcn_mfma_f32_32x32x16_bf16(pa0, PK(l0, h0), od, 0, 0, 0);
  od = __builtin_amdgcn_mfma_f32_32x32x16_bf16(pa1, PK(l1, h1), od, 0, 0, 0);
  od = __builtin_amdgcn_mfma_f32_32x32x16_bf16(pa2, PK(l2, h2), od, 0, 0, 0);
  od = __builtin_amdgcn_mfma_f32_32x32x16_bf16(pa3, PK(l3, h3), od, 0, 0, 0);
#undef PK
}
DI void qkt(f32x16& p0, f32x16& p1, const LAS unsigned char* Ks, const bf16x8 (&qr)[8], int r32, int hi) {
  p0 = f32x16{}; p1 = f32x16{};
#pragma unroll
  for (int d0 = 0; d0 < 8; ++d0) { const int cb = (d0 * 16 + hi * 8) * 2;
    const bf16x8 b0 = *(const LAS bf16x8*)(Ks + KSWZ(r32, cb));
    const bf16x8 b1 = *(const LAS bf16x8*)(Ks + KSWZ(32 + r32, cb));
    p0 = __builtin_amdgcn_mfma_f32_32x32x16_bf16(b0, qr[d0], p0, 0, 0, 0);
    p1 = __builtin_amdgcn_mfma_f32_32x32x16_bf16(b1, qr[d0], p1, 0, 0, 0); }
}
template <bool MASK> DI void sb_half(f32x16& p, float& Pc, int hi, int kbase, int trow) {
  constexpr float C = 0.08838834764831845f * 1.4426950408889634f;
  float rr[16];
#pragma unroll
  for (int r = 0; r < 16; ++r) {
    float z = p[r] * C;
    if (MASK) z = (kbase + crow(r, hi) < trow) ? z : -__builtin_inff();
    const float k = __builtin_amdgcn_rcpf(1.0f + __builtin_amdgcn_exp2f(z));
    rr[r] = k; p[r] = 1.0f - k;
  }
  float R0[4], R1[4];
#pragma unroll
  for (int g = 0; g < 4; ++g) {
    const float c2 = rr[4 * g + 3], c1 = c2 * rr[4 * g + 2], c0 = c1 * rr[4 * g + 1], R = c0 * rr[4 * g];
    rr[4 * g + 2] = c2; rr[4 * g + 1] = c1; rr[4 * g] = c0;
    const auto sw = __builtin_amdgcn_permlane32_swap(__float_as_uint(R), __float_as_uint(R), false, false);
    R0[g] = __uint_as_float(sw[0]); R1[g] = __uint_as_float(sw[1]);
  }
#pragma unroll
  for (int g = 3; g >= 0; --g) {
    const float Pin = hi ? Pc : Pc * R1[g];
    p[4 * g + 3] *= Pin; p[4 * g + 2] *= Pin * rr[4 * g + 2]; p[4 * g + 1] *= Pin * rr[4 * g + 1]; p[4 * g] *= Pin * rr[4 * g];
    Pc *= R0[g] * R1[g];
  }
}
DI unsigned cvtpk(float lo, float hi) { unsigned r; asm volatile("v_cvt_pk_bf16_f32 %0, %1, %2" : "=v"(r) : "v"(lo), "v"(hi)); return r; }
#define PK4(P, BASE, OUT) do { const unsigned a0 = cvtpk(P[BASE + 0], P[BASE + 1]), a1 = cvtpk(P[BASE + 2], P[BASE + 3]);   \
    const unsigned b0 = cvtpk(P[BASE + 4], P[BASE + 5]), b1 = cvtpk(P[BASE + 6], P[BASE + 7]);                              \
    const auto r0 = __builtin_amdgcn_permlane32_swap(a0, b0, false, false); const auto r1 = __builtin_amdgcn_permlane32_swap(a1, b1, false, false); \
    const v4u w = {r0[0], r1[0], r0[1], r1[1]}; OUT = __builtin_bit_cast(bf16x8, w); } while (0)

DI void unit(const bf16* qkv, bf16* ao, int b, int h, int qb, LAS unsigned char* lds, int tid) {
  const int wid = __builtin_amdgcn_readfirstlane(tid >> 6), lane = tid & 63, r32 = lane & 31, hi = lane >> 5;
  LAS unsigned char* V_lds = lds; LAS unsigned char* K_lds = lds + 2 * SHM_V;
  const size_t rowbase = (size_t)b * SEQ; const int q0 = qb * 256, t_lo = q0 + wid * 32, trow = t_lo + r32;
  bf16x8 qr[8];
  { const bf16* Qw = qkv + (rowbase + trow) * LDQ + h * 128 + hi * 8;
#pragma unroll
    for (int d0 = 0; d0 < 8; ++d0) qr[d0] = *(const bf16x8*)(Qw + d0 * 16); }
  const bf16* Kh = qkv + rowbase * LDQ + 1024 + h * 128; const bf16* Vh = Kh + 1024;
  const int sr = tid >> 4, sc = (tid & 15) * 8, vst0 = v_st(sr, sc), vst1 = v_st(32 + sr, sc);
  const int vb0 = (int)(unsigned)(size_t)V_lds + v_rd_base(lane);
  bf16x8 vs0, vs1, ks0, ks1;
#define SLOAD(k0) do { vs0 = *(const bf16x8*)(Vh + (size_t)((k0) + sr) * LDQ + sc); vs1 = *(const bf16x8*)(Vh + (size_t)((k0) + 32 + sr) * LDQ + sc); \
    ks0 = *(const bf16x8*)(Kh + (size_t)((k0) + sr) * LDQ + sc); ks1 = *(const bf16x8*)(Kh + (size_t)((k0) + 32 + sr) * LDQ + sc); } while (0)
#define SWRITE(bb) do { *(LAS bf16x8*)(V_lds + (bb) * SHM_V + vst0) = vs0; *(LAS bf16x8*)(V_lds + (bb) * SHM_V + vst1) = vs1; const int kc = sc * 2; \
    *(LAS bf16x8*)(K_lds + (bb) * SHM_K + KSWZ(sr, kc)) = ks0; *(LAS bf16x8*)(K_lds + (bb) * SHM_K + KSWZ(32 + sr, kc)) = ks1; } while (0)
  f32x16 o[4] = {}; float Pc = 1.0f;
  const int kt_max = qb * 4 + 3;
  SLOAD(kt_max * 64);
  for (int kt = kt_max; kt >= 0; --kt) {
    const int buf = kt & 1, k0 = kt * 64;
    asm volatile("s_waitcnt vmcnt(0)" ::: "memory");
    SWRITE(buf);
    if (kt > 0) SLOAD(k0 - 64);
    __syncthreads();
    if (k0 < t_lo + 31) {
      f32x16 p0, p1;
      qkt(p0, p1, K_lds + buf * SHM_K, qr, r32, hi);
      if (k0 + 63 >= t_lo) { sb_half<true>(p1, Pc, hi, k0 + 32, trow); sb_half<true>(p0, Pc, hi, k0, trow); }
      else { sb_half<false>(p1, Pc, hi, k0 + 32, trow); sb_half<false>(p0, Pc, hi, k0, trow); }
      bf16x8 pa0, pa1, pa2, pa3;
      PK4(p0, 0, pa0); PK4(p0, 8, pa1); PK4(p1, 0, pa2); PK4(p1, 8, pa3);
      const int vb = vb0 + buf * SHM_V;
      pv_one<0>(o[0], vb, pa0, pa1, pa2, pa3); pv_one<1>(o[1], vb, pa0, pa1, pa2, pa3); pv_one<2>(o[2], vb, pa0, pa1, pa2, pa3); pv_one<3>(o[3], vb, pa0, pa1, pa2, pa3);
    }
  }
  bf16* Ow = ao + (rowbase + t_lo) * 1024 + h * 128 + r32;
#pragma unroll
  for (int r = 0; r < 16; ++r) { const int orow = crow(r, hi);
#pragma unroll
    for (int d0 = 0; d0 < 4; ++d0) Ow[(size_t)orow * 1024 + d0 * 32] = (bf16)(cvtpk(o[d0][r], 0.f) & 0xffffu); }
#undef SLOAD
#undef SWRITE
}
#undef PK4
#undef KSWZ
#undef SBAR
}
DI void phase_sb_mfma(const Args& a, LAS unsigned char* lds, int bid, int G, int tid) {
    const bf16* qkv = (const bf16*)(a.ws + WS_QKV); bf16* ao = (bf16*)(a.ws + WS_AO);
    const int vcu = (G % 8 == 0) ? (bid % 8) * (G / 8) + bid / 8 : bid;
    for (int pi = vcu; pi < 512; pi += G) {
        const int bh = pi >> 3, p = pi & 7, b = bh >> 3, h = bh & 7;
        sba::unit(qkv, ao, b, h, 15 - p, lds, tid);
        sba::unit(qkv, ao, b, h, p, lds, tid);
    }
}


namespace gdn {
using bf16x8 = __attribute__((ext_vector_type(8))) short;
using s16x4  = __attribute__((ext_vector_type(4))) short;
using f32x16 = __attribute__((ext_vector_type(16))) float;
typedef float f2v __attribute__((ext_vector_type(2)));
typedef __bf16 b2v __attribute__((ext_vector_type(2)));
DI unsigned pk(float a, float b) { const f2v v = {a, b}; const b2v r = __builtin_convertvector(v, b2v); return __builtin_bit_cast(unsigned, r); }
DI int crow(int r, int hi) { return (r & 3) + 8 * (r >> 2) + 4 * hi; }
DI int pi_slot(int x) { return 8 * ((x >> 2) & 3) + 4 * ((x >> 4) & 1) + (x & 3); }
DI bf16x8 pack_step(const f32x16& x, int s) {
    v4u w; w.x = pk(x[8 * s + 0], x[8 * s + 1]); w.y = pk(x[8 * s + 2], x[8 * s + 3]); w.z = pk(x[8 * s + 4], x[8 * s + 5]); w.w = pk(x[8 * s + 6], x[8 * s + 7]);
    return __builtin_bit_cast(bf16x8, w);
}
DI f32x16 mm(const f32x16& P, const f32x16& Q, f32x16 acc) {
    acc = __builtin_amdgcn_mfma_f32_32x32x16_bf16(pack_step(P, 0), pack_step(Q, 0), acc, 0, 0, 0);
    acc = __builtin_amdgcn_mfma_f32_32x32x16_bf16(pack_step(P, 1), pack_step(Q, 1), acc, 0, 0, 0);
    return acc;
}
#define GPK4(P, BASE, OUT) do { const unsigned a0 = pk(P[BASE + 0], P[BASE + 1]), a1 = pk(P[BASE + 2], P[BASE + 3]);   \
    const unsigned b0 = pk(P[BASE + 4], P[BASE + 5]), b1 = pk(P[BASE + 6], P[BASE + 7]);                              \
    const auto r0 = __builtin_amdgcn_permlane32_swap(a0, b0, false, false); const auto r1 = __builtin_amdgcn_permlane32_swap(a1, b1, false, false); \
    const v4u w_ = {r0[0], r1[0], r0[1], r1[1]}; OUT = __builtin_bit_cast(bf16x8, w_); } while (0)

DI void local_unit(const Args& a, int unit, LAS unsigned char* img, LAS float* tab, int lane, bool dry) {
    const int r32 = lane & 31, hi = lane >> 5;
    const int chunk = unit & 63, bh = unit >> 6, hv = bh & 15, b = bh >> 4, hk = hv >> 1;
    const size_t t0 = (size_t)b * SEQ + chunk * 64;
    bf16* qkvc = (bf16*)(a.ws + WS_QKVC); const float* gb = (const float*)(a.ws + WS_GB);
    bf16* wmem = (bf16*)(a.ws + WS_WMEM) + (size_t)unit * 8192; bf16* imem = (bf16*)(a.ws + WS_IMEM) + (size_t)unit * 4096;
    bf16* ktmem = (bf16*)(a.ws + WS_KTMEM) + (size_t)((b * HK + hk) * 64 + chunk) * 8192; float* gtab = (float*)(a.ws + WS_GTAB) + (size_t)unit * 192;
    float gc = gb[(t0 + lane) * 32 + hv]; const float be = gb[(t0 + lane) * 32 + 16 + hv];
#pragma unroll
    for (int off = 1; off < 64; off <<= 1) { const float y = __shfl_up(gc, off); if (lane >= off) gc += y; }
    const float glast = __shfl(gc, 63);
    tab[lane] = gc; tab[64 + lane] = be; tab[128 + lane] = -be * __expf(gc);
    gtab[lane] = __expf(gc); gtab[64 + lane] = __expf(glast - gc); if (lane == 0) gtab[128] = __expf(glast);
    const bf16* kbase = qkvc + t0 * 4096 + 1024 + hk * 128; const bf16* qbase = qkvc + t0 * 4096 + hk * 128; bf16* vbase = qkvc + t0 * 4096 + 2048 + hv * 128;
    if ((hv & 1) == 0) {
        const int slot = 32 * (lane >> 5) + pi_slot(lane & 31);
#pragma unroll 4
        for (int c8 = 0; c8 < 16; ++c8) { const v4u kv = *(const v4u*)(kbase + (size_t)lane * 4096 + 8 * c8);
            bf16* dst = ktmem + (size_t)(8 * c8) * 64 + slot;
            dst[0 * 64] = (bf16)(kv.x & 0xffffu); dst[1 * 64] = (bf16)(kv.x >> 16); dst[2 * 64] = (bf16)(kv.y & 0xffffu); dst[3 * 64] = (bf16)(kv.y >> 16);
            dst[4 * 64] = (bf16)(kv.z & 0xffffu); dst[5 * 64] = (bf16)(kv.z >> 16); dst[6 * 64] = (bf16)(kv.w & 0xffffu); dst[7 * 64] = (bf16)(kv.w >> 16); }
    }
#define GSB() __builtin_amdgcn_sched_barrier(0)
    {
        f32x16 IT00 = {}, IT11 = {}, IT01 = {};
#pragma unroll
        for (int s = 0; s < 8; ++s) {
            const bf16x8 k0 = *(const bf16x8*)(kbase + (size_t)r32 * 4096 + 16 * s + 8 * hi), k1 = *(const bf16x8*)(kbase + (size_t)(32 + r32) * 4096 + 16 * s + 8 * hi);
            const bf16x8 q0 = *(const bf16x8*)(qbase + (size_t)r32 * 4096 + 16 * s + 8 * hi), q1 = *(const bf16x8*)(qbase + (size_t)(32 + r32) * 4096 + 16 * s + 8 * hi);
            IT00 = __builtin_amdgcn_mfma_f32_32x32x16_bf16(k0, q0, IT00, 0, 0, 0); IT11 = __builtin_amdgcn_mfma_f32_32x32x16_bf16(k1, q1, IT11, 0, 0, 0);
            IT01 = __builtin_amdgcn_mfma_f32_32x32x16_bf16(k0, q1, IT01, 0, 0, 0);
        }
#pragma unroll
        for (int I = 0; I < 2; ++I) { const int c = 32 * I + r32; const float gcc = tab[c];
#pragma unroll
            for (int J = 0; J < 2; ++J)
#pragma unroll
                for (int g = 0; g < 4; ++g) { float v[4];
#pragma unroll
                    for (int i = 0; i < 4; ++i) { const int r = 4 * g + i, cp = 32 * J + crow(r, hi);
                        const float raw = (I == 0) ? (J == 0 ? IT00[r] : 0.f) : (J == 0 ? IT01[r] : IT11[r]);
                        const float val = raw * __expf(-fabsf(gcc - tab[cp])); v[i] = (c >= cp) ? val : 0.f; }
                    v2u o; o.x = pk(v[0], v[1]); o.y = pk(v[2], v[3]);
                    *(v2u*)(imem + (size_t)c * 64 + 32 * J + 16 * (g & 1) + 8 * hi + 4 * (g >> 1)) = o; } }
    }
    GSB();
    f32x16 T1, T1T, T2T, T21T;
    {
        f32x16 KK = {};
#pragma unroll
        for (int s = 0; s < 8; ++s) { const bf16x8 k0 = *(const bf16x8*)(kbase + (size_t)r32 * 4096 + 16 * s + 8 * hi); KK = __builtin_amdgcn_mfma_f32_32x32x16_bf16(k0, k0, KK, 0, 0, 0); }
        f32x16 M, MT;
        { const float gb0 = tab[r32], bb0 = tab[64 + r32];
#pragma unroll
        for (int r = 0; r < 16; ++r) { const int a0 = crow(r, hi), b0 = r32; const float ke = -KK[r] * __expf(-fabsf(tab[a0] - gb0));
            const float nv = ke * tab[64 + a0], ntv = ke * bb0;
            const float n = (a0 > b0) ? nv : 0.f, nt = (b0 > a0) ? ntv : 0.f, id = (a0 == b0) ? 1.f : 0.f;
            M[r] = n; MT[r] = nt; T1[r] = id + n; T1T[r] = id + nt; } }
#pragma unroll
        for (int it = 0; it < 4; ++it) { const f32x16 z = {};
            const f32x16 Mn = mm(MT, M, z), MTn = mm(M, MT, z);
            const f32x16 Tn = mm(T1T, Mn, T1);
            T1T = mm(Mn, T1T, T1T);
            T1 = Tn; M = Mn; MT = MTn; }
    }
    GSB();
    {
        f32x16 KK = {};
#pragma unroll
        for (int s = 0; s < 8; ++s) { const bf16x8 k1 = *(const bf16x8*)(kbase + (size_t)(32 + r32) * 4096 + 16 * s + 8 * hi); KK = __builtin_amdgcn_mfma_f32_32x32x16_bf16(k1, k1, KK, 0, 0, 0); }
        f32x16 M, MT;
        { const float gb0 = tab[32 + r32], bb0 = tab[96 + r32];
#pragma unroll
        for (int r = 0; r < 16; ++r) { const int a0 = crow(r, hi), b0 = r32; const float ke = -KK[r] * __expf(-fabsf(tab[32 + a0] - gb0));
            const float nv = ke * tab[96 + a0], ntv = ke * bb0;
            const float n = (a0 > b0) ? nv : 0.f, nt = (b0 > a0) ? ntv : 0.f, id = (a0 == b0) ? 1.f : 0.f;
            M[r] = n; MT[r] = nt; T2T[r] = id + nt; } }
#pragma unroll
        for (int it = 0; it < 4; ++it) { const f32x16 z = {};
            const f32x16 Mn = mm(MT, M, z), MTn = mm(M, MT, z);
            T2T = mm(Mn, T2T, T2T);
            M = Mn; MT = MTn; }
    }
    GSB();
    {
        f32x16 L21 = {};
#pragma unroll
        for (int s = 0; s < 8; ++s) { const bf16x8 k0 = *(const bf16x8*)(kbase + (size_t)r32 * 4096 + 16 * s + 8 * hi), k1 = *(const bf16x8*)(kbase + (size_t)(32 + r32) * 4096 + 16 * s + 8 * hi);
            L21 = __builtin_amdgcn_mfma_f32_32x32x16_bf16(k1, k0, L21, 0, 0, 0); }
#pragma unroll
        for (int r = 0; r < 16; ++r) { const int a0 = crow(r, hi); L21[r] = L21[r] * tab[96 + a0] * __expf(tab[32 + a0] - tab[r32]); }
        const f32x16 z = {}; const f32x16 Y = mm(L21, T2T, z); T21T = mm(T1, Y, z);
#pragma unroll
        for (int r = 0; r < 16; ++r) T21T[r] = -T21T[r];
    }
    GSB();
    const int vb = (int)(unsigned)(size_t)img + sba::v_rd_base(lane);
    bf16* ubl = dry ? (bf16*)(a.ws + WS_END) + (size_t)(unit & 63) * 64 * 4096 : vbase;
#pragma unroll 1
    for (int mode = 0; mode < 2; ++mode) {
        const bf16* src = mode == 0 ? (const bf16*)vbase : kbase;
#pragma unroll 4
        for (int it = 0; it < 16; ++it) { const int row = (lane >> 4) + 4 * it, col = (lane & 15) * 8;
            *(LAS v4u*)(img + sba::v_st(row, col)) = *(const v4u*)(src + (size_t)row * 4096 + col); }
        LAS float* sc = tab + (mode == 0 ? 64 : 128);
#pragma unroll 1
        for (int I = 0; I < 2; ++I) {
            bf16x8 pa0, pa1, pa2, pa3;
            { f32x16 X;
#pragma unroll
              for (int r = 0; r < 16; ++r) X[r] = (I ? T21T[r] : T1T[r]) * sc[crow(r, hi)];
              GPK4(X, 0, pa0); GPK4(X, 8, pa1);
#pragma unroll
              for (int r = 0; r < 16; ++r) X[r] = I ? T2T[r] * sc[32 + crow(r, hi)] : 0.f;
              GPK4(X, 0, pa2); GPK4(X, 8, pa3); }
            const int ubase = ((((r32 >> 4) * 64 + hi * 16 + (r32 & 15)) * 16) + 8 * I);
            const int wbase = (32 * I + 4 * hi) * 128 + pi_slot(r32);
#define GDN_OUT(D0) do { f32x16 od = {}; sba::pv_one<D0>(od, vb, pa0, pa1, pa2, pa3); \
            if (mode == 0) { _Pragma("unroll") for (int g = 0; g < 4; ++g) { const int f = ubase + D0 * 2048 + (g & 1) * 512 + (g >> 1) * 4; \
                    v2u w; w.x = pk(od[4 * g + 0], od[4 * g + 1]); w.y = pk(od[4 * g + 2], od[4 * g + 3]); *(v2u*)(ubl + (unsigned)((f >> 7) * 4096 + (f & 127))) = w; } } \
            else { _Pragma("unroll") for (int r = 0; r < 16; ++r) wmem[(unsigned)(wbase + ((r & 3) + 8 * (r >> 2)) * 128 + 32 * D0)] = (bf16)(pk(od[r], 0.f) & 0xffffu); } \
            GSB(); } while (0)
            GDN_OUT(0); GDN_OUT(1); GDN_OUT(2); GDN_OUT(3);
#undef GDN_OUT
        }
    }
#undef GSB
}
#undef GPK4
}
DI void phase_gdn_local(const Args& a, LAS unsigned char* lds, int bid, int G, int wave, int lane, bool dry) {
    LAS unsigned char* img = lds + wave * 16384; LAS float* tab = (LAS float*)(lds + RING_BYTES + 4096 + wave * 1024);
    const int gw = bid * NWAVES + wave, NGW = G * NWAVES;
    for (int unit = gw; unit < BATCH * HV * 64; unit += NGW) gdn::local_unit(a, unit, img, tab, lane, dry);
}
namespace gdn {
constexpr int PW = 272, PI = 144;
constexpr int L_W = 0, L_Q = 64 * PW, L_I = 2 * 64 * PW, L_K = L_I + 64 * PI, L_G = L_K + 128 * PI, L_BUF = L_G + 768;
constexpr int L_PART = 2 * L_BUF;
static_assert(L_PART + 4096 <= RING_BYTES, "scan LDS map");
}
DI void phase_gdn_scan(const Args& a, int j, LAS unsigned char* lds, int bid, int tid, bool dry) {
    if (bid >= BATCH * HV) return;
    using gdn::bf16x8; using gdn::pk; using namespace gdn;
    typedef float f4v __attribute__((ext_vector_type(4)));
    const int wave = __builtin_amdgcn_readfirstlane(tid >> 6), lane = tid & 63, n = lane & 15, kq = lane >> 4;
    const int b = bid / HV, hv = bid % HV, hk = hv >> 1;
    bf16* qkvc = (bf16*)(a.ws + WS_QKVC); const bf16* zb = (const bf16*)(a.ws + WS_ZB);
    LAS float* part = (LAS float*)(lds + L_PART);
    const float nw = a.gdn_norm_w[j * 128 + 16 * wave + n];
    const int unit0 = (b * HV + hv) * 64, hku0 = (b * HK + hk) * 64; const size_t tb0 = (size_t)b * SEQ;
    const int c0 = tid, c1 = tid + 512;
    v4u rw0, rw1, rq0, rq1, ri0, rk0, rk1, ru0, ru1; float rg = 0.f;
#define SCAN_LOAD(ch) do { const int u_ = unit0 + (ch); const size_t t_ = tb0 + (size_t)(ch) * 64; \
        const bf16* wm_ = (const bf16*)(a.ws + WS_WMEM) + (size_t)u_ * 8192; const bf16* im_ = (const bf16*)(a.ws + WS_IMEM) + (size_t)u_ * 4096; \
        const bf16* kt_ = (const bf16*)(a.ws + WS_KTMEM) + (size_t)(hku0 + (ch)) * 8192; const bf16* qb_ = qkvc + t_ * 4096 + hk * 128; const bf16* vb_ = qkvc + t_ * 4096 + 2048 + hv * 128; \
        rw0 = *(const v4u*)(wm_ + c0 * 8); rw1 = *(const v4u*)(wm_ + c1 * 8); \
        rq0 = *(const v4u*)(qb_ + (size_t)(c0 >> 4) * 4096 + (c0 & 15) * 8); rq1 = *(const v4u*)(qb_ + (size_t)(c1 >> 4) * 4096 + (c1 & 15) * 8); \
        ri0 = *(const v4u*)(im_ + c0 * 8); rk0 = *(const v4u*)(kt_ + c0 * 8); rk1 = *(const v4u*)(kt_ + c1 * 8); \
        { const int f = (wave * 64 + lane) * 16; ru0 = *(const v4u*)(vb_ + (size_t)(f >> 7) * 4096 + (f & 127)); ru1 = *(const v4u*)(vb_ + (size_t)(f >> 7) * 4096 + (f & 127) + 8); } \
        if (tid < 192) rg = ((const float*)(a.ws + WS_GTAB))[(size_t)u_ * 192 + tid]; } while (0)
#define SCAN_WRITE(bf) do { LAS unsigned char* B_ = lds + (bf) * L_BUF; \
        *(LAS v4u*)(B_ + L_W + (c0 >> 4) * PW + (c0 & 15) * 16) = rw0; *(LAS v4u*)(B_ + L_W + (c1 >> 4) * PW + (c1 & 15) * 16) = rw1; \
        *(LAS v4u*)(B_ + L_Q + (c0 >> 4) * PW + (c0 & 15) * 16) = rq0; *(LAS v4u*)(B_ + L_Q + (c1 >> 4) * PW + (c1 & 15) * 16) = rq1; \
        *(LAS v4u*)(B_ + L_I + (c0 >> 3) * PI + (c0 & 7) * 16) = ri0; \
        *(LAS v4u*)(B_ + L_K + (c0 >> 3) * PI + (c0 & 7) * 16) = rk0; *(LAS v4u*)(B_ + L_K + (c1 >> 3) * PI + (c1 & 7) * 16) = rk1; \
        if (tid < 192) *(LAS float*)(B_ + L_G + tid * 4) = rg; } while (0)
    f4v S[8];
#pragma unroll
    for (int m = 0; m < 8; ++m) S[m] = (f4v){0.f, 0.f, 0.f, 0.f};
    SCAN_LOAD(0);
    SCAN_WRITE(0);
    v4u u0 = ru0, u1 = ru1;
    __syncthreads();
#pragma unroll 1
    for (int chunk = 0; chunk < 64; ++chunk) {
        const size_t t0 = tb0 + (size_t)chunk * 64; bf16* vbase = qkvc + t0 * 4096 + 2048 + hv * 128;
        const LAS unsigned char* B = lds + (chunk & 1) * L_BUF; const LAS float* gt = (const LAS float*)(B + L_G);
        if (chunk + 1 < 64) SCAN_LOAD(chunk + 1);
        float zz[16];
#pragma unroll
        for (int mt = 0; mt < 4; ++mt)
#pragma unroll
            for (int i = 0; i < 4; ++i) zz[4 * mt + i] = __uint_as_float((unsigned)zb[(t0 + 16 * mt + 4 * kq + i) * 2048 + hv * 128 + 16 * wave + n] << 16);
        f4v av[4], ao[4];
        av[0] = (f4v){bf_lo(u0.x), bf_hi(u0.x), bf_lo(u0.y), bf_hi(u0.y)}; av[1] = (f4v){bf_lo(u0.z), bf_hi(u0.z), bf_lo(u0.w), bf_hi(u0.w)};
        av[2] = (f4v){bf_lo(u1.x), bf_hi(u1.x), bf_lo(u1.y), bf_hi(u1.y)}; av[3] = (f4v){bf_lo(u1.z), bf_hi(u1.z), bf_lo(u1.w), bf_hi(u1.w)};
        bf16x8 Sb[4];
#pragma unroll
        for (int p = 0; p < 4; ++p) { v4u w; w.x = pk(S[2 * p][0], S[2 * p][1]); w.y = pk(S[2 * p][2], S[2 * p][3]); w.z = pk(S[2 * p + 1][0], S[2 * p + 1][1]); w.w = pk(S[2 * p + 1][2], S[2 * p + 1][3]);
            Sb[p] = __builtin_bit_cast(bf16x8, w); }
#pragma unroll
        for (int mt = 0; mt < 4; ++mt) { ao[mt] = (f4v){0.f, 0.f, 0.f, 0.f};
#pragma unroll
            for (int p = 0; p < 4; ++p) {
                const bf16x8 aw = *(const LAS bf16x8*)(B + L_W + (16 * mt + n) * PW + 64 * p + 16 * kq);
                const v2u q0 = *(const LAS v2u*)(B + L_Q + (16 * mt + n) * PW + 64 * p + 8 * kq), q1 = *(const LAS v2u*)(B + L_Q + (16 * mt + n) * PW + 64 * p + 32 + 8 * kq);
                const v4u qq = {q0.x, q0.y, q1.x, q1.y};
                av[mt] = __builtin_amdgcn_mfma_f32_16x16x32_bf16(aw, Sb[p], av[mt], 0, 0, 0);
                ao[mt] = __builtin_amdgcn_mfma_f32_16x16x32_bf16(__builtin_bit_cast(bf16x8, qq), Sb[p], ao[mt], 0, 0, 0); } }
        bf16x8 vbf[2], vbd[2];
#pragma unroll
        for (int pp = 0; pp < 2; ++pp) {
            const f4v d0 = *(const LAS f4v*)(gt + 64 + 32 * pp + 4 * kq), d1 = *(const LAS f4v*)(gt + 64 + 32 * pp + 16 + 4 * kq);
            const f4v x0 = av[2 * pp], x1 = av[2 * pp + 1];
            v4u w; w.x = pk(x0[0], x0[1]); w.y = pk(x0[2], x0[3]); w.z = pk(x1[0], x1[1]); w.w = pk(x1[2], x1[3]); vbf[pp] = __builtin_bit_cast(bf16x8, w);
            v4u y; y.x = pk(x0[0] * d0[0], x0[1] * d0[1]); y.y = pk(x0[2] * d0[2], x0[3] * d0[3]); y.z = pk(x1[0] * d1[0], x1[1] * d1[1]); y.w = pk(x1[2] * d1[2], x1[3] * d1[3]); vbd[pp] = __builtin_bit_cast(bf16x8, y);
        }
#pragma unroll
        for (int mt = 0; mt < 4; ++mt) { const f4v eg = *(const LAS f4v*)(gt + 16 * mt + 4 * kq); ao[mt] = ao[mt] * eg;
#pragma unroll
            for (int pp = 0; pp < 2; ++pp) { const bf16x8 ai = *(const LAS bf16x8*)(B + L_I + (16 * mt + n) * PI + 64 * pp + 16 * kq);
                ao[mt] = __builtin_amdgcn_mfma_f32_16x16x32_bf16(ai, vbf[pp], ao[mt], 0, 0, 0); } }
        { const float egl = gt[128];
#pragma unroll
          for (int m8 = 0; m8 < 8; ++m8) { S[m8] = S[m8] * egl;
#pragma unroll
              for (int pp = 0; pp < 2; ++pp) { const bf16x8 ak = *(const LAS bf16x8*)(B + L_K + (16 * m8 + n) * PI + 64 * pp + 16 * kq);
                  S[m8] = __builtin_amdgcn_mfma_f32_16x16x32_bf16(ak, vbd[pp], S[m8], 0, 0, 0); } } }
        if (chunk + 1 < 64) { SCAN_WRITE((chunk + 1) & 1); u0 = ru0; u1 = ru1; }
        LAS float* pb = part + (chunk & 1) * 512;
#pragma unroll
        for (int mt = 0; mt < 4; ++mt)
#pragma unroll
            for (int i = 0; i < 4; ++i) { float ss = ao[mt][i] * ao[mt][i];
                ss += __shfl_xor(ss, 1); ss += __shfl_xor(ss, 2); ss += __shfl_xor(ss, 4); ss += __shfl_xor(ss, 8);
                if (n == 0) pb[(16 * mt + 4 * kq + i) * 8 + wave] = ss; }
        __syncthreads();
        LAS unsigned char* ogs = lds + OGST_OFF;
#pragma unroll
        for (int mt = 0; mt < 4; ++mt)
#pragma unroll
            for (int i = 0; i < 4; ++i) { const int c = 16 * mt + 4 * kq + i;
                const f4v s0 = *(const LAS f4v*)(pb + c * 8), s1 = *(const LAS f4v*)(pb + c * 8 + 4);
                const float tot = (s0[0] + s0[1]) + (s0[2] + s0[3]) + (s1[0] + s1[1]) + (s1[2] + s1[3]);
                const float rinv = 1.0f / sqrtf(tot * (1.0f / 128.0f) + RMS_EPS);
                const float z = zz[4 * mt + i];
                *(LAS bf16*)(ogs + c * 256 + (16 * wave + n) * 2) = (bf16)(pk(ao[mt][i] * rinv * nw * z * sigmoid_f(z), 0.f) & 0xffffu); }
        __syncthreads();
        { bf16* ob = dry ? (bf16*)(a.ws + WS_END) + (size_t)bid * 64 * 128 : vbase; const int opitch = dry ? 128 : 4096;
          *(v4u*)(ob + (size_t)(c0 >> 4) * opitch + (c0 & 15) * 8) = *(const LAS v4u*)(ogs + (c0 >> 4) * 256 + (c0 & 15) * 16);
          *(v4u*)(ob + (size_t)(c1 >> 4) * opitch + (c1 & 15) * 8) = *(const LAS v4u*)(ogs + (c1 >> 4) * 256 + (c1 & 15) * 16); }
    }
#undef SCAN_LOAD
#undef SCAN_WRITE
}

DI void moe_offsets(const Args& a, int j, unsigned (&off)[9]) {
    unsigned* cnt = (unsigned*)(a.ws + WS_CTL) + CW_CNT + 256 * j; unsigned acc = 0u;
#pragma unroll
    for (int e = 0; e < 8; ++e) { off[e] = acc; const unsigned c = __hip_atomic_load(cnt + e, __ATOMIC_RELAXED, __HIP_MEMORY_SCOPE_AGENT); acc += (c + 255u) & ~255u; }
    off[8] = acc;
}
DI void phase_scatter(const Args& a, int j, LAS unsigned char* lds, int bid, int G, int tid, int wave, int lane) {
    LAS unsigned* lc = (LAS unsigned*)lds; LAS unsigned* lb = lc + 8; LAS unsigned* loff = lc + 16; LAS int* lpos = (LAS int*)(lc + 32);
    const unsigned* E12 = (const unsigned*)(a.ws + WS_E12); int* POS = (int*)(a.ws + WS_POS);
    const bf16* HB = (const bf16*)(a.ws + WS_HB); bf16* XS = (bf16*)(a.ws + WS_XS);
    unsigned* fill = (unsigned*)(a.ws + WS_CTL) + CW_CNT + 256 * j + 64;
    unsigned off[9]; moe_offsets(a, j, off);
    if (tid == 0) {
#pragma unroll
        for (int e = 0; e < 8; ++e) loff[e] = off[e]; }
    for (int ci = bid; ci < TT / 128; ci += G) {
        __syncthreads();
        if (tid < 8) lc[tid] = 0u;
        __syncthreads();
        unsigned e1 = 0, e2 = 0, r1 = 0, r2 = 0;
        if (tid < 128) { const unsigned w = E12[ci * 128 + tid]; e1 = w & 255u; e2 = (w >> 8) & 255u;
            r1 = __hip_atomic_fetch_add(lc + e1, 1u, __ATOMIC_RELAXED, __HIP_MEMORY_SCOPE_WORKGROUP); r2 = __hip_atomic_fetch_add(lc + e2, 1u, __ATOMIC_RELAXED, __HIP_MEMORY_SCOPE_WORKGROUP); }
        __syncthreads();
        if (tid < 8) lb[tid] = __hip_atomic_fetch_add(fill + tid, lc[tid], __ATOMIC_RELAXED, __HIP_MEMORY_SCOPE_AGENT);
        __syncthreads();
        if (tid < 128) { const int p1 = (int)(loff[e1] + lb[e1] + r1), p2 = (int)(loff[e2] + lb[e2] + r2);
            lpos[2 * tid] = p1; lpos[2 * tid + 1] = p2; POS[2 * (ci * 128 + tid)] = p1; POS[2 * (ci * 128 + tid) + 1] = p2; }
        __syncthreads();
        for (int tk = wave; tk < 128; tk += NWAVES) {
            const int p1 = lpos[2 * tk], p2 = lpos[2 * tk + 1];
            const v4u* src = (const v4u*)(HB + (size_t)(ci * 128 + tk) * D);
            const v4u x0 = src[lane], x1 = src[lane + 64];
            v4u* d1 = (v4u*)(XS + (size_t)p1 * D); v4u* d2 = (v4u*)(XS + (size_t)p2 * D);
            d1[lane] = x0; d1[lane + 64] = x1; d2[lane] = x0; d2[lane + 64] = x1;
        }
    }
}

DI void phase_combine_ln(const Args& a, int lnidx, int bid, int G, int wave, int lane) {
    float* out = a.out; bf16* HB = (bf16*)(a.ws + WS_HB); const bf16* YE = (const bf16*)(a.ws + WS_XS);
    const int* POS = (const int*)(a.ws + WS_POS); const f32x2* G12 = (const f32x2*)(a.ws + WS_G12);
    const float* g = a.ln_g + (size_t)lnidx * D; const float* bta = a.ln_b + (size_t)lnidx * D;
    const int gw = bid * NWAVES + wave, NGW = G * NWAVES;
    f32x4 gv[4], bv[4];
#pragma unroll
    for (int q = 0; q < 4; ++q) { gv[q] = *(const f32x4*)(g + 4 * (lane + 64 * q)); bv[q] = *(const f32x4*)(bta + 4 * (lane + 64 * q)); }
    for (int t = gw; t < TT; t += NGW) {
        f32x4* row = (f32x4*)(out + (size_t)t * D);
        const int p1 = POS[2 * t], p2 = POS[2 * t + 1]; const f32x2 gg = G12[t];
        const v2u* y1 = (const v2u*)(YE + (size_t)p1 * D); const v2u* y2 = (const v2u*)(YE + (size_t)p2 * D);
        f32x4 v[4]; float s = 0.f;
#pragma unroll
        for (int q = 0; q < 4; ++q) { const v2u a1 = y1[lane + 64 * q], a2 = y2[lane + 64 * q];
            const f32x4 e1 = (f32x4){bf_lo(a1.x), bf_hi(a1.x), bf_lo(a1.y), bf_hi(a1.y)}, e2 = (f32x4){bf_lo(a2.x), bf_hi(a2.x), bf_lo(a2.y), bf_hi(a2.y)};
            v[q] = row[lane + 64 * q] * ALPHA + e1 * gg.x + e2 * gg.y; s += (v[q][0] + v[q][1]) + (v[q][2] + v[q][3]); }
        const float mean = wave_sum(s) * (1.0f / D); float s2 = 0.f;
#pragma unroll
        for (int q = 0; q < 4; ++q) { v[q] = v[q] - mean; s2 += (v[q][0] * v[q][0] + v[q][1] * v[q][1]) + (v[q][2] * v[q][2] + v[q][3] * v[q][3]); }
        const float rstd = 1.0f / sqrtf(wave_sum(s2) * (1.0f / D) + LN_EPS);
#pragma unroll
        for (int q = 0; q < 4; ++q) { v[q] = v[q] * rstd * gv[q] + bv[q]; row[lane + 64 * q] = v[q];
            v2u o; o.x = pk2(v[q][0], v[q][1]); o.y = pk2(v[q][2], v[q][3]); *(v2u*)(HB + (size_t)t * D + 4 * (lane + 64 * q)) = o; }
    }
}

constexpr int ARGS_OFF = RING_BYTES + 1024;
DI unsigned long long lds_u64(LAS unsigned char* p) { const v2u w = *(const volatile LAS v2u*)p; return ((unsigned long long)(unsigned)__builtin_amdgcn_readfirstlane((int)w.y) << 32) | (unsigned)__builtin_amdgcn_readfirstlane((int)w.x); }
DI Args load_args(LAS unsigned char* lds) {
    Args a; LAS unsigned char* p = lds + ARGS_OFF;
    a.x = (const float*)(const GAS float*)lds_u64(p + 0); a.gdn_w_in = (const float*)(const GAS float*)lds_u64(p + 8); a.gdn_conv_w = (const float*)(const GAS float*)lds_u64(p + 16); a.gdn_a_log = (const float*)(const GAS float*)lds_u64(p + 24);
    a.gdn_dt_bias = (const float*)(const GAS float*)lds_u64(p + 32); a.gdn_norm_w = (const float*)(const GAS float*)lds_u64(p + 40); a.gdn_w_out = (const float*)(const GAS float*)lds_u64(p + 48); a.sb_w_in = (const float*)(const GAS float*)lds_u64(p + 56);
    a.sb_w_out = (const float*)(const GAS float*)lds_u64(p + 64); a.ffn_w_gate = (const float*)(const GAS float*)lds_u64(p + 72); a.ffn_w_up = (const float*)(const GAS float*)lds_u64(p + 80); a.ffn_w_down = (const float*)(const GAS float*)lds_u64(p + 88);
    a.moe_router = (const float*)(const GAS float*)lds_u64(p + 96); a.moe_w_gate = (const float*)(const GAS float*)lds_u64(p + 104); a.moe_w_up = (const float*)(const GAS float*)lds_u64(p + 112); a.moe_w_down = (const float*)(const GAS float*)lds_u64(p + 120);
    a.ln_g = (const float*)(const GAS float*)lds_u64(p + 128); a.ln_b = (const float*)(const GAS float*)lds_u64(p + 136); a.out = (float*)(GAS float*)lds_u64(p + 144); a.ws = (unsigned char*)(GAS unsigned char*)lds_u64(p + 152);
    const v2u w = *(const volatile LAS v2u*)(p + 160); a.ph_lo = __builtin_amdgcn_readfirstlane((int)w.x); a.ph_hi = __builtin_amdgcn_readfirstlane((int)w.y);
    return a;
}
#ifdef PH_ONLY
#define IN(k) (((k) % NPH) == PH_ONLY && lo <= (k) && (k) < hi)
#else
#define IN(k) (lo <= (k) && (k) < hi)
#endif
#define SEAM(k) do { if ((k) + 1 < hi) xcd_barrier(bar); } while (0)
DI int fresh_lane() { int l; asm volatile("v_mbcnt_lo_u32_b32 %0, -1, 0\n\tv_mbcnt_hi_u32_b32 %0, -1, %0" : "=v"(l)); return l; }
#define ARGS() const Args args = load_args(lds); const int lo = args.ph_lo, hi = args.ph_hi; const int lane = fresh_lane(), tid = wave * 64 + lane
#ifndef PROBE_REP_MASK
#define PROBE_REP_MASK 0
#endif
#ifndef PROBE_DELAY_MASK
#define PROBE_DELAY_MASK 0
#endif
#define PROBE_DELAY_MULT 4u
#define TICK_IN(k) do { if (((PROBE_DELAY_MASK) >> (k)) & 1) { if (bid == 0 && tid == 0) ((volatile LAS unsigned*)(lds + MISC_OFF))[20] -= (unsigned)__builtin_amdgcn_s_memrealtime(); } } while (0)
#define TICK_OUT(k) do { if (((PROBE_DELAY_MASK) >> (k)) & 1) { if (bid == 0 && tid == 0) ((volatile LAS unsigned*)(lds + MISC_OFF))[20] += (unsigned)__builtin_amdgcn_s_memrealtime(); } } while (0)
#define NREP(k) ((((PROBE_REP_MASK) >> (k)) & 1) ? 2 : 1)
template <int j>
DI void layer_pair(LAS unsigned char* lds, const XcdBarrier& bar, const int wave, const int G, const int bid) {
    constexpr int pb = j * NPH;
    { ARGS(); if (IN(pb + 0)) { TICK_IN(0); _Pragma("unroll 1") for (int rep_ = 0; rep_ < NREP(0); ++rep_) { phase_w_gdn(args, j, lds, bid, G, tid, wave, lane); } SEAM(pb + 0); TICK_OUT(0); } }
    { ARGS(); if (IN(pb + 1)) { TICK_IN(1); {
        pg8::Gemm g{(const bf16*)(args.ws + WS_HB), (const bf16*)(args.ws + W_IN), D, D}; pg8::StaticOrder S; S.init(TT, GINP, G, bid, NREP(1));
        pg8::EpiInProj E{(bf16*)(args.ws + WS_RAW), (bf16*)(args.ws + WS_ZB)};
        pg8::gemm_phase<pg8::EpiInProj, pg8::StaticOrder, true, true>(lds, g, S, E);
        } SEAM(pb + 1); TICK_OUT(1); } }
    { ARGS(); if (IN(pb + 2)) { TICK_IN(2); _Pragma("unroll 1") for (int rep_ = 0; rep_ < NREP(2); ++rep_) { phase_conv(args, j, bid, G, wave, lane); } SEAM(pb + 2); TICK_OUT(2); } }
#if GDN_NAIVE
    { ARGS(); if (IN(pb + 4)) { TICK_IN(4); _Pragma("unroll 1") for (int rep_ = 0; rep_ < NREP(4); ++rep_) { phase_gdn_naive(args, j, lds, bid, tid); } SEAM(pb + 4); TICK_OUT(4); } }
#else
    { ARGS(); if (IN(pb + 3)) { TICK_IN(3); _Pragma("unroll 1") for (int rep_ = 0; rep_ < NREP(3); ++rep_) { phase_gdn_local(args, lds, bid, G, wave, lane, rep_ + 1 < NREP(3)); } SEAM(pb + 3); TICK_OUT(3); } }
    { ARGS(); if (IN(pb + 4)) { TICK_IN(4); _Pragma("unroll 1") for (int rep_ = 0; rep_ < NREP(4); ++rep_) { phase_gdn_scan(args, j, lds, bid, tid, rep_ + 1 < NREP(4)); } SEAM(pb + 4); TICK_OUT(4); } }
#endif
    { ARGS(); if (IN(pb + 5)) { TICK_IN(5); {
        pg8::Gemm g{(const bf16*)(args.ws + WS_QKVC) + 2048, (const bf16*)(args.ws + W_OUT), 4096, 2048}; pg8::StaticOrder S; S.init(TT, D, G, bid);
        pg8::EpiResid E{j == 0 ? args.x : args.out, args.out, D, ALPHA};
        pg8::gemm_phase<pg8::EpiResid, pg8::StaticOrder, true, true>(lds, g, S, E);
        } SEAM(pb + 5); TICK_OUT(5); } }
    { ARGS(); if (IN(pb + 6)) { TICK_IN(6); _Pragma("unroll 1") for (int rep_ = 0; rep_ < NREP(6); ++rep_) { phase_ln<false>(args, (2 * j) * 2 + 0, j, lds, bid, G, tid, wave, lane); } SEAM(pb + 6); TICK_OUT(6); } }
    { ARGS(); if (IN(pb + 7)) { TICK_IN(7); {
        pg8::Gemm g{(const bf16*)(args.ws + WS_HB), (const bf16*)(args.ws + W_GU), D, D}; pg8::StaticOrder S; S.init(TT, 2 * FF, G, bid, NREP(7));
        pg8::EpiSwiGLU E{(bf16*)(args.ws + WS_ACT), FF, 0};
        pg8::gemm_phase<pg8::EpiSwiGLU, pg8::StaticOrder, true, true>(lds, g, S, E);
        } SEAM(pb + 7); TICK_OUT(7); } }
    { ARGS(); if (IN(pb + 8)) { TICK_IN(8); {
        pg8::Gemm g{(const bf16*)(args.ws + WS_ACT), (const bf16*)(args.ws + W_D), FF, FF}; pg8::StaticOrder S; S.init(TT, D, G, bid);
        pg8::EpiResid E{args.out, args.out, D, ALPHA};
        pg8::gemm_phase<pg8::EpiResid, pg8::StaticOrder, true, true>(lds, g, S, E);
        } SEAM(pb + 8); TICK_OUT(8); } }
    { ARGS(); if (IN(pb + 9)) { TICK_IN(9); _Pragma("unroll 1") for (int rep_ = 0; rep_ < NREP(9); ++rep_) { phase_ln<false>(args, (2 * j) * 2 + 1, j, lds, bid, G, tid, wave, lane); _Pragma("unroll 1") for (int r2_ = 0; r2_ < NREP(18); ++r2_) phase_w_sb(args, j, lds, bid, G, wave, lane); } SEAM(pb + 9); TICK_OUT(9); } }
    { ARGS(); if (IN(pb + 10)) { TICK_IN(10); {
        pg8::Gemm g{(const bf16*)(args.ws + WS_HB), (const bf16*)(args.ws + W_QKV), D, D}; pg8::StaticOrder S; S.init(TT, 3072, G, bid, NREP(10));
        pg8::EpiBf16 E{(bf16*)(args.ws + WS_QKV), 3072, 0};
        pg8::gemm_phase<pg8::EpiBf16, pg8::StaticOrder, true, true>(lds, g, S, E);
        } SEAM(pb + 10); TICK_OUT(10); } }
    #if SB_NAIVE
    { ARGS(); if (IN(pb + 11)) { TICK_IN(11); _Pragma("unroll 1") for (int rep_ = 0; rep_ < NREP(11); ++rep_) { phase_sb_naive(args, lds, bid, G, tid); } SEAM(pb + 11); TICK_OUT(11); } }
#else
    { ARGS(); if (IN(pb + 11)) { TICK_IN(11); _Pragma("unroll 1") for (int rep_ = 0; rep_ < NREP(11); ++rep_) { phase_sb_mfma(args, lds, bid, G, tid); } SEAM(pb + 11); TICK_OUT(11); } }
#endif
    { ARGS(); if (IN(pb + 12)) { TICK_IN(12); {
        pg8::Gemm g{(const bf16*)(args.ws + WS_AO), (const bf16*)(args.ws + W_O), D, D}; pg8::StaticOrder S; S.init(TT, D, G, bid);
        pg8::EpiResid E{args.out, args.out, D, ALPHA};
        pg8::gemm_phase<pg8::EpiResid, pg8::StaticOrder, true, true>(lds, g, S, E);
        } SEAM(pb + 12); TICK_OUT(12); } }
    { ARGS(); if (IN(pb + 13)) { TICK_IN(13); _Pragma("unroll 1") for (int rep_ = 0; rep_ < NREP(13); ++rep_) { phase_ln<true>(args, (2 * j + 1) * 2 + 0, j, lds, bid, G, tid, wave, lane); } SEAM(pb + 13); TICK_OUT(13); } }
    { ARGS(); if (IN(pb + 14)) { TICK_IN(14); _Pragma("unroll 1") for (int rep_ = 0; rep_ < NREP(14); ++rep_) { phase_scatter(args, j, lds, bid, G, tid, wave, lane); } SEAM(pb + 14); TICK_OUT(14); } }
    { ARGS(); if (IN(pb + 15)) { TICK_IN(15); {
        unsigned off[9]; moe_offsets(args, j, off);
        pg8::MoeOrder S; S.nM = (int)(off[8] >> 8); S.G = G; S.c = bid; S.nN = 2 * FF / 256; S.nwg = S.nM * S.nN; S.rep = NREP(15);
        S.ps1 = (int)(off[1] >> 8); S.ps2 = (int)(off[2] >> 8); S.ps3 = (int)(off[3] >> 8); S.ps4 = (int)(off[4] >> 8); S.ps5 = (int)(off[5] >> 8); S.ps6 = (int)(off[6] >> 8); S.ps7 = (int)(off[7] >> 8);
        pg8::Gemm g{(const bf16*)(args.ws + WS_XS), (const bf16*)(args.ws + W_MGU), D, D};
        pg8::EpiSwiGLU E{(bf16*)(args.ws + WS_MACT), FF, 2 * FF / 256};
        pg8::gemm_phase<pg8::EpiSwiGLU, pg8::MoeOrder, true, true>(lds, g, S, E);
        } SEAM(pb + 15); TICK_OUT(15); } }
    { ARGS(); if (IN(pb + 16)) { TICK_IN(16); {
        unsigned off[9]; moe_offsets(args, j, off);
        pg8::MoeOrder S; S.nM = (int)(off[8] >> 8); S.G = G; S.c = bid; S.nN = D / 256; S.nwg = S.nM * S.nN; S.rep = NREP(16);
        S.ps1 = (int)(off[1] >> 8); S.ps2 = (int)(off[2] >> 8); S.ps3 = (int)(off[3] >> 8); S.ps4 = (int)(off[4] >> 8); S.ps5 = (int)(off[5] >> 8); S.ps6 = (int)(off[6] >> 8); S.ps7 = (int)(off[7] >> 8);
        pg8::Gemm g{(const bf16*)(args.ws + WS_MACT), (const bf16*)(args.ws + W_MD), FF, FF};
        pg8::EpiBf16 E{(bf16*)(args.ws + WS_XS), D, D / 256};
        pg8::gemm_phase<pg8::EpiBf16, pg8::MoeOrder, true, true>(lds, g, S, E);
        } SEAM(pb + 16); TICK_OUT(16); } }
    { ARGS(); if (IN(pb + 17)) { TICK_IN(17); _Pragma("unroll 1") for (int rep_ = 0; rep_ < NREP(17); ++rep_) { phase_combine_ln(args, (2 * j + 1) * 2 + 1, bid, G, wave, lane); } SEAM(pb + 17); TICK_OUT(17); } }
}
__global__ void __launch_bounds__(NWAVES * 64, 2) fwd(Args kargs) {
    extern __shared__ __attribute__((aligned(16))) unsigned char lds_raw[];
    LAS unsigned char* lds = (LAS unsigned char*)lds_raw;
    volatile LAS unsigned* MISC = (volatile LAS unsigned*)(lds + MISC_OFF);
    const int tid = threadIdx.x, lane = tid & 63, wave = __builtin_amdgcn_readfirstlane(tid >> 6), G = gridDim.x, bid = blockIdx.x;
    for (int u = tid; u < (LDS_BYTES - RING_BYTES) / 4; u += NWAVES * 64) ((LAS unsigned*)(lds + RING_BYTES))[u] = 0u;
    __syncthreads();
    if (tid == 0) { LAS unsigned long long* pa = (LAS unsigned long long*)(lds + ARGS_OFF);
        pa[0] = (unsigned long long)kargs.x; pa[1] = (unsigned long long)kargs.gdn_w_in; pa[2] = (unsigned long long)kargs.gdn_conv_w; pa[3] = (unsigned long long)kargs.gdn_a_log;
        pa[4] = (unsigned long long)kargs.gdn_dt_bias; pa[5] = (unsigned long long)kargs.gdn_norm_w; pa[6] = (unsigned long long)kargs.gdn_w_out; pa[7] = (unsigned long long)kargs.sb_w_in;
        pa[8] = (unsigned long long)kargs.sb_w_out; pa[9] = (unsigned long long)kargs.ffn_w_gate; pa[10] = (unsigned long long)kargs.ffn_w_up; pa[11] = (unsigned long long)kargs.ffn_w_down;
        pa[12] = (unsigned long long)kargs.moe_router; pa[13] = (unsigned long long)kargs.moe_w_gate; pa[14] = (unsigned long long)kargs.moe_w_up; pa[15] = (unsigned long long)kargs.moe_w_down;
        pa[16] = (unsigned long long)kargs.ln_g; pa[17] = (unsigned long long)kargs.ln_b; pa[18] = (unsigned long long)kargs.out; pa[19] = (unsigned long long)kargs.ws;
        pa[20] = (unsigned long long)(unsigned)kargs.ph_lo | ((unsigned long long)(unsigned)kargs.ph_hi << 32); }
    XcdBarrier bar = xcd_barrier_post((unsigned*)(kargs.ws + WS_CTL) + CW_BAR, MISC + 8);
    __syncthreads();
    layer_pair<0>(lds, bar, wave, G, bid);
    layer_pair<1>(lds, bar, wave, G, bid);
    if (PROBE_DELAY_MASK) { if (bid == 0 && threadIdx.x == 0) { const unsigned acc = ((volatile LAS unsigned*)(lds + MISC_OFF))[20] * PROBE_DELAY_MULT; const unsigned long long t0 = __builtin_amdgcn_s_memrealtime(); while ((unsigned)(__builtin_amdgcn_s_memrealtime() - t0) < acc) __builtin_amdgcn_s_sleep(8); } }
}
#undef IN
#undef SEAM
#undef ARGS

extern "C" void kernel_launch(void* const* d_in, const int* in_sizes, int n_in, void* d_out, int out_size, void* d_ws, size_t ws_size, hipStream_t stream) {
    static int grid = 0;
    if (grid == 0) {
        if (n_in != 18 || in_sizes[0] != TT * D || out_size != TT * D || ws_size < WS_END + 32 * MiB) { fprintf(stderr, "kernel_launch: unexpected shapes (n_in %d, in0 %d, out %d, ws %zu); nothing launched\n", n_in, n_in > 0 ? in_sizes[0] : -1, out_size, ws_size); grid = -1; return; }
        int dev = 0, cus = 0, per_cu = 0;
        if (hipGetDevice(&dev) != hipSuccess || hipDeviceGetAttribute(&cus, hipDeviceAttributeMultiprocessorCount, dev) != hipSuccess) { grid = -1; return; }
        if (hipFuncSetAttribute((const void*)fwd, hipFuncAttributeMaxDynamicSharedMemorySize, LDS_BYTES) != hipSuccess) { fprintf(stderr, "kernel_launch: hipFuncSetAttribute failed\n"); grid = -1; return; }
        if (hipOccupancyMaxActiveBlocksPerMultiprocessor(&per_cu, (const void*)fwd, NWAVES * 64, LDS_BYTES) != hipSuccess || per_cu < 1) { fprintf(stderr, "kernel_launch: occupancy query says %d blocks per CU\n", per_cu); (void)hipGetLastError(); grid = -1; return; }
        grid = cus;
    }
    if (grid < 0) return;
    if (hipMemsetAsync((char*)d_ws + WS_CTL, 0, CTL_ZERO_BYTES, stream) != hipSuccess) return;
    Args a{};
    a.x = (const float*)d_in[0]; a.gdn_w_in = (const float*)d_in[1]; a.gdn_conv_w = (const float*)d_in[2]; a.gdn_a_log = (const float*)d_in[3]; a.gdn_dt_bias = (const float*)d_in[4];
    a.gdn_norm_w = (const float*)d_in[5]; a.gdn_w_out = (const float*)d_in[6]; a.sb_w_in = (const float*)d_in[7]; a.sb_w_out = (const float*)d_in[8];
    a.ffn_w_gate = (const float*)d_in[9]; a.ffn_w_up = (const float*)d_in[10]; a.ffn_w_down = (const float*)d_in[11]; a.moe_router = (const float*)d_in[12];
    a.moe_w_gate = (const float*)d_in[13]; a.moe_w_up = (const float*)d_in[14]; a.moe_w_down = (const float*)d_in[15]; a.ln_g = (const float*)d_in[16]; a.ln_b = (const float*)d_in[17];
    a.out = (float*)d_out; a.ws = (unsigned char*)d_ws;
#if MK_ONE_LAUNCH
    a.ph_lo = 0; a.ph_hi = NPHASES;
    hipLaunchKernelGGL(fwd, dim3(grid), dim3(NWAVES * 64), LDS_BYTES, stream, a);
#else
    for (int p = 0; p < NPHASES; ++p) { a.ph_lo = p; a.ph_hi = p + 1; hipLaunchKernelGGL(fwd, dim3(grid), dim3(NWAVES * 64), LDS_BYTES, stream, a); }
#endif
}
```

```cpp
#include <hip/hip_runtime.h>
#include <cstdio>
#include <cstdint>
#ifndef GDN_NAIVE
#define GDN_NAIVE 0
#endif
#ifndef SB_NAIVE
#define SB_NAIVE 0
#endif
#ifndef MK_ONE_LAUNCH
#define MK_ONE_LAUNCH 1
#endif
namespace pg8 {
#define PG8_LAS __attribute__((address_space(3)))
typedef unsigned short bf16_t;
typedef short bf16x8 __attribute__((ext_vector_type(8)));
typedef float f32x4 __attribute__((ext_vector_type(4)));
typedef unsigned u32x4 __attribute__((ext_vector_type(4)));
constexpr int BM = 256, BK = 64, HALF = 128, HTB = HALF * BK * 2  , STAGE_BYTES = 8 * HTB, NXCD = 8, WGM = 8;

__host__ __device__ __forceinline__ int lds_byte(int r, int c) { const int st = (r >> 4) * 2 + (c >> 5), rr = r & 15, cc = c & 31, ob = rr * 64 + cc * 2; return st * 1024 + (ob ^ (((ob >> 9) & 1) << 5)); }
__host__ __device__ __forceinline__ void stage_rc(int b, int& R, int& C) { const int st = b / 1024, sb = b % 1024, swz = sb ^ (((sb >> 9) & 1) << 5); R = (st >> 1) * 16 + swz / 64; C = (st & 1) * 32 + (swz % 64) / 2; }
__host__ __device__ __forceinline__ int perm32(int rho) { const int n = rho >> 4, i = rho & 15; return 8 * (i >> 2) + 4 * n + (i & 3); }

struct Unit { int pm, pn; };
struct Gemm { const bf16_t* A; const bf16_t* Bt; int lda, K; };

struct StaticOrder {
    int nM, nN, nwg, G, c, rep;
    __host__ __device__ void init(int M, int N, int G_, int c_, int rep_ = 1) { nM = M / BM; nN = N / BM; nwg = nM * nN; G = G_; c = c_; rep = rep_; }
    __host__ __device__ bool next(int i, Unit& u) const {
        const long L = (long)i * G + c; if (L >= (long)rep * nwg) return false;
        int wgid = (int)(L % nwg); { const int q = nwg / NXCD, r = nwg % NXCD, xcd = wgid % NXCD, off = wgid / NXCD; wgid = (xcd < r ? xcd * (q + 1) : r * (q + 1) + (xcd - r) * q) + off; }
        const int nig = WGM * nN, gid = wgid / nig, fm = gid * WGM, gsz = (nM - fm) < WGM ? (nM - fm) : WGM;
        u.pm = fm + ((wgid % nig) % gsz); u.pn = (wgid % nig) / gsz; return true;
    }
    __device__ __forceinline__ void a_ready(const Unit&) const {}
    __device__ __forceinline__ void done(const Unit&) const {}
};

__device__ __forceinline__ unsigned cvt_pk_bf16(float lo, float hi) { unsigned r; asm volatile("v_cvt_pk_bf16_f32 %0, %1, %2" : "=v"(r) : "v"(lo), "v"(hi)); return r; }
struct EpiBf16 {
    static constexpr bool PERM = true, AFTER_DRAIN = false;
    bf16_t* O; int ldc; int nmod;
    __device__ __forceinline__ void operator()(const f32x4 (&acc)[2][2][4][2], const Unit& u, int wr, int wc, int fr, int fq) const {
        const int pnl = nmod ? (u.pn % nmod) : u.pn;
        const int row0 = u.pm * BM + wr * 64 + fr, col0 = pnl * BM + wc * 32 + 8 * fq;
#pragma unroll
        for (int ai = 0; ai < 2; ++ai)
#pragma unroll
            for (int m = 0; m < 4; ++m) { bf16_t* rowp = O + (size_t)(row0 + ai * HALF + m * 16) * ldc + col0;
#pragma unroll
                for (int bj = 0; bj < 2; ++bj) { const f32x4 v0 = acc[ai][bj][m][0], v1 = acc[ai][bj][m][1];
                    u32x4 w; w.x = cvt_pk_bf16(v0[0], v0[1]); w.y = cvt_pk_bf16(v0[2], v0[3]); w.z = cvt_pk_bf16(v1[0], v1[1]); w.w = cvt_pk_bf16(v1[2], v1[3]);
                    *(u32x4*)(rowp + bj * HALF) = w; } }
    }
};
struct EpiInProj {
    static constexpr bool PERM = true, AFTER_DRAIN = false;
    bf16_t* RAW; bf16_t* ZB;
    __device__ __forceinline__ void operator()(const f32x4 (&acc)[2][2][4][2], const Unit& u, int wr, int wc, int fr, int fq) const {
        const bool isz = (u.pn >= 16 && u.pn < 24);
        bf16_t* O = isz ? ZB : RAW; const int ldc = isz ? 2048 : 4352; const int ct = isz ? (u.pn - 16) : (u.pn < 16 ? u.pn : 16);
        const int row0 = u.pm * BM + wr * 64 + fr, col0 = ct * BM + wc * 32 + 8 * fq;
#pragma unroll
        for (int ai = 0; ai < 2; ++ai)
#pragma unroll
            for (int m = 0; m < 4; ++m) { bf16_t* rowp = O + (size_t)(row0 + ai * HALF + m * 16) * ldc + col0;
#pragma unroll
                for (int bj = 0; bj < 2; ++bj) { const f32x4 v0 = acc[ai][bj][m][0], v1 = acc[ai][bj][m][1];
                    u32x4 w; w.x = cvt_pk_bf16(v0[0], v0[1]); w.y = cvt_pk_bf16(v0[2], v0[3]); w.z = cvt_pk_bf16(v1[0], v1[1]); w.w = cvt_pk_bf16(v1[2], v1[3]);
                    *(u32x4*)(rowp + bj * HALF) = w; } }
    }
};
__device__ __forceinline__ float silu_f(float x) { return x * __builtin_amdgcn_rcpf(1.0f + __builtin_amdgcn_exp2f(-1.4426950408889634f * x)); }
struct EpiSwiGLU {
    static constexpr bool PERM = true, AFTER_DRAIN = false;
    bf16_t* O; int ldc; int nmod;
    __device__ __forceinline__ void operator()(const f32x4 (&acc)[2][2][4][2], const Unit& u, int wr, int wc, int fr, int fq) const {
        const int pnl = nmod ? (u.pn % nmod) : u.pn;
        const int row0 = u.pm * BM + wr * 64 + fr, col0 = pnl * HALF + wc * 32 + 8 * fq;
#pragma unroll
        for (int ai = 0; ai < 2; ++ai)
#pragma unroll
            for (int m = 0; m < 4; ++m) { bf16_t* rowp = O + (size_t)(row0 + ai * HALF + m * 16) * ldc + col0;
                const f32x4 g0 = acc[ai][0][m][0], g1 = acc[ai][0][m][1], u0 = acc[ai][1][m][0], u1 = acc[ai][1][m][1];
                u32x4 w;
                w.x = cvt_pk_bf16(silu_f(g0[0]) * u0[0], silu_f(g0[1]) * u0[1]); w.y = cvt_pk_bf16(silu_f(g0[2]) * u0[2], silu_f(g0[3]) * u0[3]);
                w.z = cvt_pk_bf16(silu_f(g1[0]) * u1[0], silu_f(g1[1]) * u1[1]); w.w = cvt_pk_bf16(silu_f(g1[2]) * u1[2], silu_f(g1[3]) * u1[3]);
                *(u32x4*)rowp = w; }
    }
};
struct EpiResid {
    static constexpr bool PERM = false, AFTER_DRAIN = false;
    const float* res; float* out; int ldc; float alpha;
    __device__ __forceinline__ void operator()(const f32x4 (&acc)[2][2][4][2], const Unit& u, int wr, int wc, int fr, int fq) const {
        const int row0 = u.pm * BM + wr * 64 + fr, col0 = u.pn * BM + wc * 32 + 4 * fq;
#pragma unroll
        for (int ai = 0; ai < 2; ++ai)
#pragma unroll
            for (int m = 0; m < 4; ++m) { const size_t off = (size_t)(row0 + ai * HALF + m * 16) * ldc + col0;
#pragma unroll
                for (int bj = 0; bj < 2; ++bj)
#pragma unroll
                    for (int n = 0; n < 2; ++n) { const f32x4 r = *(const f32x4*)(res + off + bj * HALF + n * 16);
                        *(f32x4*)(out + off + bj * HALF + n * 16) = r * alpha + acc[ai][bj][m][n]; } }
    }
};
struct MoeOrder {
    int nM, nN, nwg, G, c, rep; int ps1, ps2, ps3, ps4, ps5, ps6, ps7;
    __device__ __forceinline__ bool next(int i, Unit& u) const {
        const long L = (long)i * G + c; if (nwg == 0 || L >= (long)rep * nwg) return false;
        int wgid = (int)(L % nwg); { const int q = nwg / NXCD, r = nwg % NXCD, xcd = wgid % NXCD, off = wgid / NXCD; wgid = (xcd < r ? xcd * (q + 1) : r * (q + 1) + (xcd - r) * q) + off; }
        const int nig = WGM * nN, gid = wgid / nig, fm = gid * WGM, gsz = (nM - fm) < WGM ? (nM - fm) : WGM;
        const int pm = fm + ((wgid % nig) % gsz), pnl = (wgid % nig) / gsz;
        const int e = (pm >= ps1) + (pm >= ps2) + (pm >= ps3) + (pm >= ps4) + (pm >= ps5) + (pm >= ps6) + (pm >= ps7);
        u.pm = pm; u.pn = e * nN + pnl; return true;
    }
    __device__ __forceinline__ void a_ready(const Unit&) const {}
    __device__ __forceinline__ void done(const Unit&) const {}
};
template <class Epi, class Sched, bool ALIGN_EPI = false, bool SP2 = false>
__device__ __forceinline__ void gemm_phase(PG8_LAS unsigned char* lds, const Gemm g, const Sched& S, const Epi& E) {
    const int tid = threadIdx.x, wid = __builtin_amdgcn_readfirstlane(tid >> 6), lane = tid & 63, wr = wid >> 2, wc = wid & 3, fr = lane & 15, fq = lane >> 4;
    const int K = g.K, nt = K / BK;
    unsigned voffA[2], voffB[2];
#pragma unroll
    for (int i = 0; i < 2; ++i) { int R, C; stage_rc(tid * 16 + i * 8192, R, C); const int Rb = Epi::PERM ? ((R & ~31) + perm32(R & 31)) : R;
        voffA[i] = (unsigned)(R * g.lda + C) * 2u; voffB[i] = (unsigned)(Rb * K + C) * 2u; }
    const size_t kstep = (size_t)(BK * 2);
    const size_t hstepA = (size_t)HALF * g.lda * 2, hstepB = (size_t)HALF * K * 2;
    const size_t tstepA = 2 * hstepA, tstepB = 2 * hstepB;
    const unsigned ldsw = (unsigned)wid * 1024u;
    const int aoff = lds_byte(wr * 64 + fr, fq * 8), boff = lds_byte(wc * 32 + fr, fq * 8);
#define PG8_SA(b, h) (((b) * 2 + (h)) * HTB)
#define PG8_SB(b, h) ((4 + (b) * 2 + (h)) * HTB)
#define PG8_STAGE(bufoff, gbase, voff) do { _Pragma("unroll") for (int _i = 0; _i < 2; ++_i) \
        __builtin_amdgcn_global_load_lds((const unsigned*)((const char*)(gbase) + (voff)[_i]), (PG8_LAS unsigned*)(lds + (bufoff) + ldsw + _i * 8192), 16, 0, 0); } while (0)
#define PG8_LDA(dst, b, h) do { _Pragma("unroll") for (int m = 0; m < 4; ++m) _Pragma("unroll") for (int k = 0; k < 2; ++k) dst[m][k] = *(const PG8_LAS bf16x8*)(lds + PG8_SA(b, h) + aoff + m * 2048 + k * 1024); } while (0)
#define PG8_LDB(dst, b, h) do { _Pragma("unroll") for (int n = 0; n < 2; ++n) _Pragma("unroll") for (int k = 0; k < 2; ++k) dst[n][k] = *(const PG8_LAS bf16x8*)(lds + PG8_SB(b, h) + boff + n * 2048 + k * 1024); } while (0)
#define PG8_MMA(ai, bj, At, Bt) do { __builtin_amdgcn_s_setprio(1); _Pragma("unroll") for (int m = 0; m < 4; ++m) _Pragma("unroll") for (int n = 0; n < 2; ++n) _Pragma("unroll") for (int k = 0; k < 2; ++k) \
        acc[ai][bj][m][n] = __builtin_amdgcn_mfma_f32_16x16x32_bf16(Bt[n][k], At[m][k], acc[ai][bj][m][n], 0, 0, 0); __builtin_amdgcn_s_setprio(0); } while (0)
#define PG8_WAIT_V(n) asm volatile("s_waitcnt vmcnt(" #n ")" ::: "memory")
#define PG8_WAIT_L(n) asm volatile("s_waitcnt lgkmcnt(" #n ")" ::: "memory")
#define PG8_BAR __builtin_amdgcn_s_barrier()
#define PG8_SCHED __builtin_amdgcn_sched_barrier(0)
    Unit cur, nxt; int ui = 0;
    if (!S.next(0, cur)) return;
    f32x4 acc[2][2][4][2];
#pragma unroll
    for (int a = 0; a < 2; ++a)
#pragma unroll
        for (int b = 0; b < 2; ++b)
#pragma unroll
            for (int m = 0; m < 4; ++m)
#pragma unroll
                for (int n = 0; n < 2; ++n) acc[a][b][m][n] = (f32x4){0.f, 0.f, 0.f, 0.f};
    bf16x8 At[4][2], B0[2][2], B1[2][2];
    const char* cA = (const char*)g.A + (size_t)cur.pm * tstepA; const char* cB = (const char*)g.Bt + (size_t)cur.pn * tstepB;
    S.a_ready(cur);
    if constexpr (SP2) {
        PG8_STAGE(PG8_SB(0, 0), cB, voffB); PG8_STAGE(PG8_SB(0, 1), cB + hstepB, voffB); PG8_STAGE(PG8_SA(0, 0), cA, voffA); PG8_STAGE(PG8_SA(0, 1), cA + hstepA, voffA);
        if (wr == 1) PG8_BAR;
        PG8_WAIT_V(2); PG8_BAR;
        PG8_STAGE(PG8_SB(1, 0), cB + kstep, voffB); PG8_STAGE(PG8_SA(1, 0), cA + kstep, voffA); PG8_STAGE(PG8_SB(1, 1), cB + hstepB + kstep, voffB);
        PG8_WAIT_V(6); PG8_BAR;
    } else {
        PG8_STAGE(PG8_SB(0, 0), cB, voffB); PG8_STAGE(PG8_SA(0, 0), cA, voffA); PG8_STAGE(PG8_SB(0, 1), cB + hstepB, voffB); PG8_STAGE(PG8_SA(0, 1), cA + hstepA, voffA);
        if (wr == 1) PG8_BAR;
        PG8_WAIT_V(4); PG8_BAR;
        PG8_STAGE(PG8_SB(1, 0), cB + kstep, voffB); PG8_STAGE(PG8_SA(1, 0), cA + kstep, voffA); PG8_STAGE(PG8_SB(1, 1), cB + hstepB + kstep, voffB);
        PG8_WAIT_V(6); PG8_BAR;
    }
    for (;;) {
        const bool has_next = S.next(ui + 1, nxt);
        const char* nA = has_next ? (const char*)g.A + (size_t)nxt.pm * tstepA : cA; const char* nB = has_next ? (const char*)g.Bt + (size_t)nxt.pn * tstepB : cB;
        for (int t = 0; t < nt; t += 2) {
            const bool last = (t == nt - 2);
            const char* a1 = cA + (size_t)(t + 1) * kstep;
            const char* a2 = last ? nA : cA + (size_t)(t + 2) * kstep; const char* b2 = last ? nB : cB + (size_t)(t + 2) * kstep;
            const char* a3 = a2 + kstep; const char* b3 = b2 + kstep;
            if (last && has_next) S.a_ready(nxt);
            if constexpr (SP2) {
            PG8_LDB(B0, 0, 0); PG8_LDB(B1, 0, 1); PG8_SCHED; PG8_LDA(At, 0, 0); PG8_STAGE(PG8_SA(1, 1), a1 + hstepA, voffA);
            PG8_WAIT_V(8); PG8_WAIT_L(0); PG8_BAR; PG8_MMA(0, 0, At, B0); PG8_MMA(0, 1, At, B1); PG8_BAR; PG8_SCHED;
            PG8_LDA(At, 0, 1); PG8_STAGE(PG8_SB(0, 0), b2, voffB); PG8_STAGE(PG8_SB(0, 1), b2 + hstepB, voffB); PG8_STAGE(PG8_SA(0, 0), a2, voffA);
            PG8_WAIT_V(8); PG8_WAIT_L(0); PG8_BAR; PG8_MMA(1, 0, At, B0); PG8_MMA(1, 1, At, B1); PG8_BAR; PG8_SCHED;
            PG8_LDB(B0, 1, 0); PG8_LDB(B1, 1, 1); PG8_SCHED; PG8_LDA(At, 1, 0); PG8_STAGE(PG8_SA(0, 1), a2 + hstepA, voffA);
            PG8_WAIT_V(8); PG8_WAIT_L(0); PG8_BAR; PG8_MMA(0, 0, At, B0); PG8_MMA(0, 1, At, B1); PG8_BAR; PG8_SCHED;
            PG8_LDA(At, 1, 1); PG8_STAGE(PG8_SB(1, 0), b3, voffB); PG8_STAGE(PG8_SB(1, 1), b3 + hstepB, voffB); PG8_STAGE(PG8_SA(1, 0), a3, voffA);
            PG8_WAIT_V(8); PG8_WAIT_L(0); PG8_BAR; PG8_MMA(1, 0, At, B0); PG8_MMA(1, 1, At, B1); PG8_BAR; PG8_SCHED;
            } else {
            PG8_LDB(B0, 0, 0); PG8_SCHED; PG8_LDA(At, 0, 0); PG8_STAGE(PG8_SA(1, 1), a1 + hstepA, voffA);
            PG8_WAIT_L(8); PG8_BAR; PG8_WAIT_L(0); PG8_MMA(0, 0, At, B0); PG8_BAR; PG8_SCHED;
            PG8_LDB(B1, 0, 1); PG8_STAGE(PG8_SB(0, 0), b2, voffB);
            PG8_BAR; PG8_WAIT_L(0); PG8_MMA(0, 1, At, B1); PG8_BAR;
            PG8_LDA(At, 0, 1); PG8_STAGE(PG8_SA(0, 0), a2, voffA);
            PG8_BAR; PG8_WAIT_L(0); PG8_MMA(1, 0, At, B0); PG8_BAR; PG8_SCHED;
            PG8_STAGE(PG8_SB(0, 1), b2 + hstepB, voffB);
            PG8_WAIT_V(6); PG8_BAR; PG8_MMA(1, 1, At, B1); PG8_BAR;
            PG8_LDB(B0, 1, 0); PG8_SCHED; PG8_LDA(At, 1, 0); PG8_STAGE(PG8_SA(0, 1), a2 + hstepA, voffA);
            PG8_WAIT_L(8); PG8_BAR; PG8_WAIT_L(0); PG8_MMA(0, 0, At, B0); PG8_BAR; PG8_SCHED;
            PG8_LDB(B1, 1, 1); PG8_STAGE(PG8_SB(1, 0), b3, voffB);
            PG8_BAR; PG8_WAIT_L(0); PG8_MMA(0, 1, At, B1); PG8_BAR;
            PG8_LDA(At, 1, 1); PG8_STAGE(PG8_SA(1, 0), a3, voffA);
            PG8_BAR; PG8_WAIT_L(0); PG8_MMA(1, 0, At, B0); PG8_BAR; PG8_SCHED;
            PG8_STAGE(PG8_SB(1, 1), b3 + hstepB, voffB);
            PG8_WAIT_V(6); PG8_BAR; PG8_MMA(1, 1, At, B1); PG8_BAR;
            }
        }
        if constexpr (ALIGN_EPI) { if (wr == 0) PG8_BAR; }
        if constexpr (!Epi::AFTER_DRAIN) { E(acc, cur, wr, wc, fr, fq); S.done(cur); }
        if (!has_next) break;
#pragma unroll
        for (int a = 0; a < 2; ++a)
#pragma unroll
            for (int b = 0; b < 2; ++b)
#pragma unroll
                for (int m = 0; m < 4; ++m)
#pragma unroll
                    for (int n = 0; n < 2; ++n) acc[a][b][m][n] = (f32x4){0.f, 0.f, 0.f, 0.f};
        cur = nxt; cA = nA; cB = nB; ++ui;
        if constexpr (ALIGN_EPI) { if (wr == 1) PG8_BAR; }
    }
    PG8_WAIT_V(0);
    if constexpr (!ALIGN_EPI) { if (wr == 0) PG8_BAR; }
    PG8_BAR;
    if constexpr (Epi::AFTER_DRAIN) { E.fused(acc, cur, wr, wc, fr, fq, lds, wid, lane); S.done(cur); }
#undef PG8_SA
#undef PG8_SB
#undef PG8_STAGE
#undef PG8_LDA
#undef PG8_LDB
#undef PG8_MMA
#undef PG8_WAIT_V
#undef PG8_WAIT_L
#undef PG8_BAR
#undef PG8_SCHED
}
}

constexpr int NWAVES = 8;
constexpr int BATCH = 8, SEQ = 4096, TT = BATCH * SEQ, D = 1024;
constexpr int HK = 8, HV = 16, HD = 128;
constexpr int GIN = 6176, GINP = 6400;
constexpr int FF = 3584, NE = 8, MOE_ROWS = 67584;
constexpr float ALPHA = 1.6817928305074290f;
constexpr float LN_EPS = 1e-5f, RMS_EPS = 1e-6f;
constexpr int NPH = 18, NPHASES = 2 * NPH;

constexpr size_t MiB = 1ull << 20;
constexpr size_t WS_CTL = 0, CTL_ZERO_BYTES = 1 * MiB;
constexpr size_t WS_E12 = 1 * MiB;
constexpr size_t WS_G12 = WS_E12 + 256 * 1024;
constexpr size_t WS_POS = WS_G12 + 256 * 1024;
constexpr size_t WS_GB = 2 * MiB;
constexpr size_t WS_W = 16 * MiB;
constexpr size_t W_IN = WS_W, W_OUT = WS_W + 13 * MiB, W_GU = WS_W + 17 * MiB, W_D = WS_W + 31 * MiB;
constexpr size_t W_QKV = WS_W, W_O = WS_W + 6 * MiB, W_MGU = WS_W + 8 * MiB, W_MD = WS_W + 120 * MiB;
constexpr size_t WS_HB = 192 * MiB;
constexpr size_t WS_BIG = 256 * MiB;
constexpr size_t WS_ZB = WS_BIG, WS_RAW = WS_BIG + 128 * MiB, WS_QKVC = WS_BIG + 400 * MiB;
constexpr int RAWLD = 4352;
constexpr size_t WS_WMEM = WS_RAW, WS_IMEM = WS_RAW + 128 * MiB, WS_KTMEM = WS_RAW + 192 * MiB;
constexpr size_t WS_GTAB = 6 * MiB;
constexpr size_t WS_ACT = WS_BIG;
constexpr size_t WS_QKV = WS_BIG, WS_AO = WS_BIG + 192 * MiB;
constexpr size_t WS_XS = WS_BIG, WS_MACT = WS_BIG + 132 * MiB;
constexpr size_t WS_END = 912 * MiB;
static_assert(WS_QKVC + (size_t)TT * 4096 * 2 <= WS_END && WS_MACT + (size_t)MOE_ROWS * FF * 2 <= WS_END && WS_RAW + (size_t)TT * RAWLD * 2 <= WS_QKVC && WS_KTMEM + (size_t)4096 * 8192 * 2 <= WS_QKVC && WS_GTAB + (size_t)8192 * 192 * 4 <= WS_W, "d_ws map");
static_assert(W_MD + (size_t)NE * D * FF * 2 <= WS_HB && W_IN + (size_t)GINP * D * 2 <= W_OUT && W_MGU + (size_t)NE * 2 * FF * D * 2 <= W_MD, "weight map");
constexpr int CW_BAR = 4096;
constexpr int CW_CNT = 16384;

constexpr int RING_BYTES = 131072;
constexpr int MISC_OFF = RING_BYTES + 320;
constexpr int OGST_OFF = 147456;
constexpr int LDS_BYTES = 163840;

#define GAS __attribute__((address_space(1)))
#define LAS __attribute__((address_space(3)))
#define DI __device__ __forceinline__
typedef unsigned short bf16;
typedef unsigned v4u __attribute__((ext_vector_type(4)));
typedef unsigned v2u __attribute__((ext_vector_type(2)));
typedef float f32x4 __attribute__((ext_vector_type(4)));
typedef float f32x2 __attribute__((ext_vector_type(2)));
typedef GAS unsigned gu32;
#define RLX_AGENT __ATOMIC_RELAXED, __HIP_MEMORY_SCOPE_AGENT
#define LDS_WAIT() asm volatile("s_waitcnt lgkmcnt(0)" ::: "memory")
#define VM_WAIT() asm volatile("s_waitcnt vmcnt(0)" ::: "memory")
__device__ __forceinline__ unsigned long long rt() { return __builtin_amdgcn_s_memrealtime(); }
__device__ __forceinline__ unsigned f2bf(float f) { unsigned u = __builtin_bit_cast(unsigned, f); return (u + 0x7fffu + ((u >> 16) & 1u)) >> 16; }
__device__ __forceinline__ unsigned pk2(float lo, float hi) { return f2bf(lo) | (f2bf(hi) << 16); }

#define XB_TMO      128
#define XB_XCNT(j)  (256  + 64 * (j))
#define XB_XSUB(j)  (1280 + 64 * (j))
#define XB_XGEN(j)  (2304 + 64 * (j))
#define XB_TOP      3328
#define XB_TOPGEN   3392
#define XCD_BAR_WORDS 3456
#define XB_SPIN_CAP (1u << 22)

__device__ __forceinline__ unsigned xb_ld(unsigned* p)              { return __hip_atomic_load(p, __ATOMIC_RELAXED, __HIP_MEMORY_SCOPE_AGENT); }
__device__ __forceinline__ unsigned xb_add(unsigned* p, unsigned v) { return __hip_atomic_fetch_add(p, v, __ATOMIC_RELAXED, __HIP_MEMORY_SCOPE_AGENT); }
__device__ __forceinline__ unsigned xb_xcc_id() { return (unsigned)__builtin_amdgcn_s_getreg((3 << 11) | 20) & 0xFu; }
#define XB_SPIN(cond, bar) do { unsigned _sp = 0; while (cond) { __builtin_amdgcn_s_sleep(1); \
    if ((++_sp & 255u) == 0u) { if (xb_ld(&(bar)[XB_TMO])) break; if (_sp > XB_SPIN_CAP) { atomicAdd(&(bar)[XB_TMO], 1u); break; } } } } while (0)

struct XcdBarrier {
    unsigned* bar; unsigned x;
    volatile LAS unsigned* st;
};

__device__ __forceinline__ XcdBarrier xcd_barrier_post(unsigned* bar, volatile LAS unsigned* st) {
    XcdBarrier b; b.bar = bar; b.x = xb_xcc_id(); b.st = st;
    if (threadIdx.x == 0) (void)xb_add(&bar[XB_XCNT(b.x)], 1u);
    return b;
}
__device__ __forceinline__ void xcd_barrier_complete(unsigned* bar, unsigned x, unsigned& nloc, unsigned& nx) {
    const unsigned G = gridDim.x * gridDim.y * gridDim.z;
    unsigned sum, cnt, mine, sp = 0u;
    for (;;) {
        sum = 0u; cnt = 0u; mine = 0u;
#pragma unroll
        for (unsigned j = 0; j < 16; ++j) { const unsigned c = xb_ld(&bar[XB_XCNT(j)]); sum += c; cnt += (c > 0u) ? 1u : 0u; mine = (j == x) ? c : mine; }
        if (sum == G) break;
        __builtin_amdgcn_s_sleep(1);
        if ((++sp & 255u) == 0u) { if (xb_ld(&bar[XB_TMO])) break; if (sp > XB_SPIN_CAP) { atomicAdd(&bar[XB_TMO], 1u); break; } }
    }
    nloc = mine > 0u ? mine : 1u; nx = cnt > 0u ? cnt : 1u;
}

__device__ __forceinline__ void xcd_barrier(const XcdBarrier& b) {
    asm volatile("s_waitcnt vmcnt(0)" ::: "memory");
    __syncthreads();
    if (threadIdx.x == 0) {
        unsigned* bar = b.bar;
        __builtin_amdgcn_s_waitcnt(0);
        unsigned nloc = b.st[0], nx = b.st[1];
        if (nloc == 0u) { xcd_barrier_complete(bar, b.x, nloc, nx); b.st[0] = nloc; b.st[1] = nx; }
        const unsigned old = xb_add(&bar[XB_XSUB(b.x)], 1u);
        const unsigned gen = old / nloc;
        if (old + 1u == (gen + 1u) * nloc) {
            __builtin_amdgcn_fence(__ATOMIC_RELEASE, "agent");
            asm volatile("s_waitcnt vmcnt(0)" ::: "memory");
            const unsigned og = xb_add(&bar[XB_TOP], 1u);
            const unsigned tg = og / nx;
            if (og + 1u == (tg + 1u) * nx) xb_add(&bar[XB_TOPGEN], 1u);
            else XB_SPIN(xb_ld(&bar[XB_TOPGEN]) == tg, bar);
            __builtin_amdgcn_fence(__ATOMIC_ACQUIRE, "agent");
            xb_add(&bar[XB_XGEN(b.x)], 1u);
            asm volatile("s_waitcnt vmcnt(0)" ::: "memory");
        } else {
            XB_SPIN(xb_ld(&bar[XB_XGEN(b.x)]) == gen, bar);
            __builtin_amdgcn_fence(__ATOMIC_ACQUIRE, "agent");
            asm volatile("s_waitcnt vmcnt(0)" ::: "memory");
        }
    }
    __syncthreads();
}

DI float bf_lo(unsigned w) { return __uint_as_float(w << 16); }
DI float bf_hi(unsigned w) { return __uint_as_float(w & 0xffff0000u); }
DI float wave_sum(float v) {
#pragma unroll
    for (int o = 1; o < 64; o <<= 1) v += __shfl_xor(v, o);
    return v;
}
DI float sigmoid_f(float x) { return 1.0f / (1.0f + __expf(-x)); }

struct Args {
    const float *x, *gdn_w_in, *gdn_conv_w, *gdn_a_log, *gdn_dt_bias, *gdn_norm_w, *gdn_w_out, *sb_w_in, *sb_w_out, *ffn_w_gate, *ffn_w_up, *ffn_w_down,
                *moe_router, *moe_w_gate, *moe_w_up, *moe_w_down, *ln_g, *ln_b;
    float* out; unsigned char* ws; int ph_lo, ph_hi;
};

DI void transpose_item(const float* W, int ldw, bf16* WT, int K, int drow0, int k0, int n0, LAS float* scr, int lane) {
#pragma unroll 8
    for (int i = 0; i < 32; ++i) { const int kk = 2 * i + (lane >> 5); scr[kk * 33 + (lane & 31)] = W[(size_t)(k0 + kk) * ldw + n0 + (lane & 31)]; }
    LDS_WAIT(); asm volatile("" ::: "memory");
    const int c = lane & 7;
#pragma unroll
    for (int jj = 0; jj < 4; ++jj) { const int n = (lane >> 3) + 8 * jj; const LAS float* s = scr + (8 * c) * 33 + n;
        v4u o; o.x = pk2(s[0 * 33], s[1 * 33]); o.y = pk2(s[2 * 33], s[3 * 33]); o.z = pk2(s[4 * 33], s[5 * 33]); o.w = pk2(s[6 * 33], s[7 * 33]);
        *(v4u*)(WT + (size_t)(drow0 + n) * K + k0 + 8 * c) = o; }
    LDS_WAIT(); asm volatile("" ::: "memory");
}

DI void phase_w_gdn(const Args& a, int j, LAS unsigned char* lds, int bid, int G, int tid, int wave, int lane) {
    LAS float* scr = (LAS float*)(lds + wave * 16384);
    const int gw = bid * NWAVES + wave, NGW = G * NWAVES;
    const float* Win = a.gdn_w_in + (size_t)j * D * GIN; const float* Wout = a.gdn_w_out + (size_t)j * 2048 * D;
    const float* Wg = a.ffn_w_gate + (size_t)j * D * FF; const float* Wu = a.ffn_w_up + (size_t)j * D * FF; const float* Wd = a.ffn_w_down + (size_t)j * FF * D;
    bf16* WIN_T = (bf16*)(a.ws + W_IN); bf16* WOUT_T = (bf16*)(a.ws + W_OUT); bf16* WGU_T = (bf16*)(a.ws + W_GU); bf16* WD_T = (bf16*)(a.ws + W_D);
    constexpr int NB_IN = GIN / 32, I_IN = 16 * NB_IN, I_OUT = 32 * 32, I_G = 16 * 112, I_D = 56 * 32, NIT = I_IN + I_OUT + 2 * I_G + I_D;
    for (int it = gw; it < NIT; it += NGW) {
        int r = it;
        if (r < I_IN) { const int kb = r / NB_IN, nb = r % NB_IN; transpose_item(Win, GIN, WIN_T, D, 32 * nb, 64 * kb, 32 * nb, scr, lane); continue; } r -= I_IN;
        if (r < I_OUT) { const int kb = r / 32, nb = r % 32; transpose_item(Wout, D, WOUT_T, 2048, 32 * nb, 64 * kb, 32 * nb, scr, lane); continue; } r -= I_OUT;
        if (r < I_G) { const int kb = r / 112, nb = r % 112, n0 = 32 * nb; transpose_item(Wg, FF, WGU_T, D, 256 * (n0 >> 7) + (n0 & 127), 64 * kb, n0, scr, lane); continue; } r -= I_G;
        if (r < I_G) { const int kb = r / 112, nb = r % 112, n0 = 32 * nb; transpose_item(Wu, FF, WGU_T, D, 256 * (n0 >> 7) + 128 + (n0 & 127), 64 * kb, n0, scr, lane); continue; } r -= I_G;
        { const int kb = r / 32, nb = r % 32; transpose_item(Wd, D, WD_T, FF, 32 * nb, 64 * kb, 32 * nb, scr, lane); }
    }
    if (j == 0) {
        bf16* HB = (bf16*)(a.ws + WS_HB); const f32x4* x4 = (const f32x4*)a.x;
        for (size_t i = (size_t)bid * 512 + tid; i < (size_t)TT * D / 8; i += (size_t)G * 512) { const f32x4 p = x4[2 * i], q = x4[2 * i + 1];
            v4u o; o.x = pk2(p[0], p[1]); o.y = pk2(p[2], p[3]); o.z = pk2(q[0], q[1]); o.w = pk2(q[2], q[3]); *(v4u*)(HB + 8 * i) = o; }
    }
}
DI void phase_w_sb(const Args& a, int j, LAS unsigned char* lds, int bid, int G, int wave, int lane) {
    LAS float* scr = (LAS float*)(lds + wave * 16384);
    const int gw = bid * NWAVES + wave, NGW = G * NWAVES;
    const float* Wqkv = a.sb_w_in + (size_t)j * D * 3072; const float* Wo = a.sb_w_out + (size_t)j * D * D;
    const float* Mg = a.moe_w_gate + (size_t)j * NE * D * FF; const float* Mu = a.moe_w_up + (size_t)j * NE * D * FF; const float* Md = a.moe_w_down + (size_t)j * NE * FF * D;
    bf16* WQKV_T = (bf16*)(a.ws + W_QKV); bf16* WO_T = (bf16*)(a.ws + W_O); bf16* MGU_T = (bf16*)(a.ws + W_MGU); bf16* MD_T = (bf16*)(a.ws + W_MD);
    constexpr int I_QKV = 16 * 96, I_O = 16 * 32, I_G = 16 * 112, I_D = 56 * 32, I_E = 2 * I_G + I_D, NIT = I_QKV + I_O + NE * I_E;
    for (int it = gw; it < NIT; it += NGW) {
        int r = it;
        if (r < I_QKV) { const int kb = r / 96, nb = r % 96; transpose_item(Wqkv, 3072, WQKV_T, D, 32 * nb, 64 * kb, 32 * nb, scr, lane); continue; } r -= I_QKV;
        if (r < I_O) { const int kb = r / 32, nb = r % 32; transpose_item(Wo, D, WO_T, D, 32 * nb, 64 * kb, 32 * nb, scr, lane); continue; } r -= I_O;
        const int e = r / I_E; r -= e * I_E;
        bf16* gu = MGU_T + (size_t)e * 2 * FF * D; bf16* dn = MD_T + (size_t)e * D * FF;
        if (r < I_G) { const int kb = r / 112, nb = r % 112, n0 = 32 * nb; transpose_item(Mg + (size_t)e * D * FF, FF, gu, D, 256 * (n0 >> 7) + (n0 & 127), 64 * kb, n0, scr, lane); continue; } r -= I_G;
        if (r < I_G) { const int kb = r / 112, nb = r % 112, n0 = 32 * nb; transpose_item(Mu + (size_t)e * D * FF, FF, gu, D, 256 * (n0 >> 7) + 128 + (n0 & 127), 64 * kb, n0, scr, lane); continue; } r -= I_G;
        { const int kb = r / 32, nb = r % 32; transpose_item(Md + (size_t)e * FF * D, D, dn, FF, 32 * nb, 64 * kb, 32 * nb, scr, lane); }
    }
}

DI void phase_conv(const Args& a, int j, int bid, int G, int wave, int lane) {
    const bf16* proj = (const bf16*)(a.ws + WS_RAW); bf16* qkvc = (bf16*)(a.ws + WS_QKVC); float* gb = (float*)(a.ws + WS_GB);
    const float* cw = a.gdn_conv_w + (size_t)j * 4 * 4096;
    const int gw = bid * NWAVES + wave, NGW = G * NWAVES;
    for (int t = gw; t < TT; t += NGW) {
        const int pos = t & (SEQ - 1);
#pragma unroll 1
        for (int grp = 0; grp < 8; ++grp) {
            const int ch = 512 * grp + 8 * lane;
            float acc[8];
#pragma unroll
            for (int i = 0; i < 8; ++i) acc[i] = 0.f;
#pragma unroll
            for (int tap = 0; tap < 4; ++tap) {
                if (pos - 3 + tap >= 0) {
                    const v4u xv = *(const v4u*)(proj + (size_t)(t - 3 + tap) * RAWLD + ch);
                    const f32x4 w0 = *(const f32x4*)(cw + tap * 4096 + ch), w1 = *(const f32x4*)(cw + tap * 4096 + ch + 4);
                    acc[0] += w0[0] * bf_lo(xv.x); acc[1] += w0[1] * bf_hi(xv.x); acc[2] += w0[2] * bf_lo(xv.y); acc[3] += w0[3] * bf_hi(xv.y);
                    acc[4] += w1[0] * bf_lo(xv.z); acc[5] += w1[1] * bf_hi(xv.z); acc[6] += w1[2] * bf_lo(xv.w); acc[7] += w1[3] * bf_hi(xv.w);
                }
            }
            float ss = 0.f;
#pragma unroll
            for (int i = 0; i < 8; ++i) { acc[i] = acc[i] * sigmoid_f(acc[i]); ss += acc[i] * acc[i]; }
            if (grp < 4) {
                ss += __shfl_xor(ss, 1); ss += __shfl_xor(ss, 2); ss += __shfl_xor(ss, 4); ss += __shfl_xor(ss, 8);
                float rn = 1.0f / sqrtf(ss + RMS_EPS); if (grp < 2) rn *= 0.08838834764831845f;
#pragma unroll
                for (int i = 0; i < 8; ++i) acc[i] *= rn;
            }
            v4u o; o.x = pk2(acc[0], acc[1]); o.y = pk2(acc[2], acc[3]); o.z = pk2(acc[4], acc[5]); o.w = pk2(acc[6], acc[7]);
            *(v4u*)(qkvc + (size_t)t * 4096 + ch) = o;
        }
        if (lane < 16) {
            const float bb = __uint_as_float((unsigned)proj[(size_t)t * RAWLD + 4096 + lane] << 16), aa = __uint_as_float((unsigned)proj[(size_t)t * RAWLD + 4112 + lane] << 16);
            const float xx = aa + a.gdn_dt_bias[j * 16 + lane];
            const float sp = xx > 20.f ? xx : log1pf(__expf(xx));
            gb[(size_t)t * 32 + lane] = -__expf(a.gdn_a_log[j * 16 + lane]) * sp;
            gb[(size_t)t * 32 + 16 + lane] = sigmoid_f(bb);
        }
    }
}

DI void phase_gdn_naive(const Args& a, int j, LAS unsigned char* lds, int bid, int tid) {
    if (bid >= BATCH * HV) return;
    const int b = bid / HV, hv = bid % HV, hk = hv / 2, jc = tid & 127, r = tid >> 7;
    const bf16* zb = (const bf16*)(a.ws + WS_ZB); bf16* qkvc = (bf16*)(a.ws + WS_QKVC); const float* gb = (const float*)(a.ws + WS_GB);
    LAS float* qs = (LAS float*)lds; LAS float* ks = qs + 2048; LAS float* vs = ks + 2048; LAS float* gs = vs + 2048; LAS float* bs = gs + 16;
    LAS f32x2* red = (LAS f32x2*)(lds + 32768); LAS float* redkq = (LAS float*)(lds + 32768 + 8192); LAS float* ob = (LAS float*)(lds + 49152);
    float S[32];
#pragma unroll
    for (int i = 0; i < 32; ++i) S[i] = 0.f;
    const int lrow = tid >> 5, lcol = (tid & 31) * 4;
    for (int blk = 0; blk < SEQ / 16; ++blk) {
        const size_t t0 = (size_t)b * SEQ + blk * 16;
        __syncthreads();
        { const bf16* rowp = qkvc + (t0 + lrow) * 4096;
          const v2u qv = *(const v2u*)(rowp + hk * 128 + lcol), kv = *(const v2u*)(rowp + 1024 + hk * 128 + lcol), vv = *(const v2u*)(rowp + 2048 + hv * 128 + lcol);
          *(LAS f32x4*)(qs + lrow * 128 + lcol) = (f32x4){bf_lo(qv.x), bf_hi(qv.x), bf_lo(qv.y), bf_hi(qv.y)};
          *(LAS f32x4*)(ks + lrow * 128 + lcol) = (f32x4){bf_lo(kv.x), bf_hi(kv.x), bf_lo(kv.y), bf_hi(kv.y)};
          *(LAS f32x4*)(vs + lrow * 128 + lcol) = (f32x4){bf_lo(vv.x), bf_hi(vv.x), bf_lo(vv.y), bf_hi(vv.y)};
          if (tid < 16) { gs[tid] = __expf(gb[(t0 + tid) * 32 + hv]); bs[tid] = gb[(t0 + tid) * 32 + 16 + hv]; } }
        __syncthreads();
#pragma unroll 1
        for (int tt = 0; tt < 16; ++tt) {
            float pk = 0.f, pq = 0.f, pkq = 0.f;
#pragma unroll
            for (int i4 = 0; i4 < 8; ++i4) { const f32x4 k4 = *(const LAS f32x4*)(ks + tt * 128 + 32 * r + 4 * i4), q4 = *(const LAS f32x4*)(qs + tt * 128 + 32 * r + 4 * i4);
#pragma unroll
                for (int c = 0; c < 4; ++c) { pk += k4[c] * S[4 * i4 + c]; pq += q4[c] * S[4 * i4 + c]; pkq += k4[c] * q4[c]; } }
            const int buf = tt & 1;
            red[(buf * 4 + r) * 128 + jc] = (f32x2){pk, pq}; if (jc == 0) redkq[buf * 4 + r] = pkq;
            __syncthreads();
            float kS = 0.f, qS = 0.f, kq = 0.f;
#pragma unroll
            for (int rr = 0; rr < 4; ++rr) { const f32x2 p = red[(buf * 4 + rr) * 128 + jc]; kS += p.x; qS += p.y; kq += redkq[buf * 4 + rr]; }
            const float eg = gs[tt], vn = bs[tt] * (vs[tt * 128 + jc] - eg * kS);
#pragma unroll
            for (int i4 = 0; i4 < 8; ++i4) { const f32x4 k4 = *(const LAS f32x4*)(ks + tt * 128 + 32 * r + 4 * i4);
#pragma unroll
                for (int c = 0; c < 4; ++c) S[4 * i4 + c] = eg * S[4 * i4 + c] + k4[c] * vn; }
            if (r == 0) ob[tt * 128 + jc] = eg * qS + kq * vn;
        }
        __syncthreads();
        {
            const f32x4 o4 = *(const LAS f32x4*)(ob + lrow * 128 + lcol);
            float ss = o4[0] * o4[0] + o4[1] * o4[1] + o4[2] * o4[2] + o4[3] * o4[3];
            ss += __shfl_xor(ss, 1); ss += __shfl_xor(ss, 2); ss += __shfl_xor(ss, 4); ss += __shfl_xor(ss, 8); ss += __shfl_xor(ss, 16);
            const float rinv = 1.0f / sqrtf(ss * (1.0f / 128.0f) + RMS_EPS);
            const v2u zv = *(const v2u*)(zb + (t0 + lrow) * 2048 + hv * 128 + lcol);
            const f32x4 nw = *(const f32x4*)(a.gdn_norm_w + j * 128 + lcol);
            const float z0 = bf_lo(zv.x), z1 = bf_hi(zv.x), z2 = bf_lo(zv.y), z3 = bf_hi(zv.y);
            v2u o; o.x = pk2(o4[0] * rinv * nw[0] * z0 * sigmoid_f(z0), o4[1] * rinv * nw[1] * z1 * sigmoid_f(z1));
            o.y = pk2(o4[2] * rinv * nw[2] * z2 * sigmoid_f(z2), o4[3] * rinv * nw[3] * z3 * sigmoid_f(z3));
            *(v2u*)(qkvc + (t0 + lrow) * 4096 + 2048 + hv * 128 + lcol) = o;
        }
    }
}

template <bool ROUTER>
DI void phase_ln(const Args& a, int lnidx, int j, LAS unsigned char* lds, int bid, int G, int tid, int wave, int lane) {
    float* out = a.out; bf16* HB = (bf16*)(a.ws + WS_HB);
    const float* g = a.ln_g + (size_t)lnidx * D; const float* bta = a.ln_b + (size_t)lnidx * D;
    const int gw = bid * NWAVES + wave, NGW = G * NWAVES;
    LAS unsigned* lcnt = (LAS unsigned*)lds;
    if (ROUTER) { if (tid < 8) lcnt[tid] = 0u; __syncthreads(); }
    f32x4 gv[4], bv[4];
#pragma unroll
    for (int q = 0; q < 4; ++q) { gv[q] = *(const f32x4*)(g + 4 * (lane + 64 * q)); bv[q] = *(const f32x4*)(bta + 4 * (lane + 64 * q)); }
    for (int t = gw; t < TT; t += NGW) {
        f32x4* row = (f32x4*)(out + (size_t)t * D);
        f32x4 v[4]; float s = 0.f;
#pragma unroll
        for (int q = 0; q < 4; ++q) { v[q] = row[lane + 64 * q]; s += (v[q][0] + v[q][1]) + (v[q][2] + v[q][3]); }
        const float mean = wave_sum(s) * (1.0f / D); float s2 = 0.f;
#pragma unroll
        for (int q = 0; q < 4; ++q) { v[q] = v[q] - mean; s2 += (v[q][0] * v[q][0] + v[q][1] * v[q][1]) + (v[q][2] * v[q][2] + v[q][3] * v[q][3]); }
        const float rstd = 1.0f / sqrtf(wave_sum(s2) * (1.0f / D) + LN_EPS);
#pragma unroll
        for (int q = 0; q < 4; ++q) { v[q] = v[q] * rstd * gv[q] + bv[q]; row[lane + 64 * q] = v[q];
            v2u o; o.x = pk2(v[q][0], v[q][1]); o.y = pk2(v[q][2], v[q][3]); *(v2u*)(HB + (size_t)t * D + 4 * (lane + 64 * q)) = o; }
        if (ROUTER) {
            const float* R = a.moe_router + (size_t)j * D * NE;
            float lg[8];
#pragma unroll
            for (int e = 0; e < 8; ++e) lg[e] = 0.f;
#pragma unroll
            for (int q = 0; q < 4; ++q)
#pragma unroll
                for (int c = 0; c < 4; ++c) { const int k = 4 * (lane + 64 * q) + c; const f32x4 r0 = *(const f32x4*)(R + k * 8), r1 = *(const f32x4*)(R + k * 8 + 4); const float hv = v[q][c];
                    lg[0] += hv * r0[0]; lg[1] += hv * r0[1]; lg[2] += hv * r0[2]; lg[3] += hv * r0[3]; lg[4] += hv * r1[0]; lg[5] += hv * r1[1]; lg[6] += hv * r1[2]; lg[7] += hv * r1[3]; }
#pragma unroll
            for (int e = 0; e < 8; ++e) lg[e] = wave_sum(lg[e]);
            int i1 = 0; float v1 = lg[0];
#pragma unroll
            for (int e = 1; e < 8; ++e) if (lg[e] > v1) { v1 = lg[e]; i1 = e; }
            int i2 = -1; float v2 = -3.0e38f;
#pragma unroll
            for (int e = 0; e < 8; ++e) if (e != i1 && lg[e] > v2) { v2 = lg[e]; i2 = e; }
            if (lane == 0) {
                const float g1 = 1.0f / (1.0f + __expf(v2 - v1));
                ((unsigned*)(a.ws + WS_E12))[t] = (unsigned)i1 | ((unsigned)i2 << 8);
                ((f32x2*)(a.ws + WS_G12))[t] = (f32x2){g1, 1.0f - g1};
                __hip_atomic_fetch_add(lcnt + i1, 1u, __ATOMIC_RELAXED, __HIP_MEMORY_SCOPE_WORKGROUP); __hip_atomic_fetch_add(lcnt + i2, 1u, __ATOMIC_RELAXED, __HIP_MEMORY_SCOPE_WORKGROUP);
            }
        }
    }
    if (ROUTER) { __syncthreads(); if (tid < 8) { unsigned* cnt = (unsigned*)(a.ws + WS_CTL) + CW_CNT + 256 * j; __hip_atomic_fetch_add(cnt + tid, lcnt[tid], __ATOMIC_RELAXED, __HIP_MEMORY_SCOPE_AGENT); } }
}

DI void phase_sb_naive(const Args& a, LAS unsigned char* lds, int bid, int G, int tid) {
    const bf16* qkv = (const bf16*)(a.ws + WS_QKV); bf16* ao = (bf16*)(a.ws + WS_AO);
    LAS unsigned char* Ks = lds; LAS unsigned char* Vs = lds + 16384;
    const int qi = tid >> 2, r = tid & 3;
    for (int idx = bid; idx < 64 * 32; idx += G) {
        const int qb = 31 - idx / 64, bh = idx % 64, b = bh >> 3, h = bh & 7;
        const int t = qb * 128 + qi;
        const size_t rowq = (size_t)b * SEQ + t;
        float q[32], o[32];
        { const bf16* qp = qkv + rowq * 3072 + h * 128 + 32 * r;
#pragma unroll
          for (int c = 0; c < 4; ++c) { const v4u w = *(const v4u*)(qp + 8 * c);
              q[8 * c + 0] = bf_lo(w.x); q[8 * c + 1] = bf_hi(w.x); q[8 * c + 2] = bf_lo(w.y); q[8 * c + 3] = bf_hi(w.y);
              q[8 * c + 4] = bf_lo(w.z); q[8 * c + 5] = bf_hi(w.z); q[8 * c + 6] = bf_lo(w.w); q[8 * c + 7] = bf_hi(w.w); }
#pragma unroll
          for (int i = 0; i < 32; ++i) { q[i] *= 0.08838834764831845f; o[i] = 0.f; } }
        float P = 1.0f;
        for (int kt = 2 * qb + 1; kt >= 0; --kt) {
            __syncthreads();
#pragma unroll
            for (int i = 0; i < 2; ++i) { const int c = tid + 512 * i, row = c >> 4, part = c & 15;
                const bf16* src = qkv + ((size_t)b * SEQ + kt * 64 + row) * 3072 + h * 128 + part * 8;
                *(LAS v4u*)(Ks + c * 16) = *(const v4u*)(src + 1024); *(LAS v4u*)(Vs + c * 16) = *(const v4u*)(src + 2048); }
            __syncthreads();
#pragma unroll 1
            for (int s = 63; s >= 0; --s) {
                float z = 0.f;
#pragma unroll
                for (int c = 0; c < 4; ++c) { const v4u w = *(const LAS v4u*)(Ks + s * 256 + r * 64 + c * 16);
                    z += q[8 * c + 0] * bf_lo(w.x) + q[8 * c + 1] * bf_hi(w.x) + q[8 * c + 2] * bf_lo(w.y) + q[8 * c + 3] * bf_hi(w.y)
                       + q[8 * c + 4] * bf_lo(w.z) + q[8 * c + 5] * bf_hi(w.z) + q[8 * c + 6] * bf_lo(w.w) + q[8 * c + 7] * bf_hi(w.w); }
                z += __shfl_xor(z, 1); z += __shfl_xor(z, 2);
                const bool live = (kt * 64 + s) < t;
                const float e = __expf(fminf(z, 80.f)), rr = 1.0f / (1.0f + e);
                const float A = live ? e * rr * P : 0.f;
                P = live ? P * rr : P;
#pragma unroll
                for (int c = 0; c < 4; ++c) { const v4u w = *(const LAS v4u*)(Vs + s * 256 + r * 64 + c * 16);
                    o[8 * c + 0] += A * bf_lo(w.x); o[8 * c + 1] += A * bf_hi(w.x); o[8 * c + 2] += A * bf_lo(w.y); o[8 * c + 3] += A * bf_hi(w.y);
                    o[8 * c + 4] += A * bf_lo(w.z); o[8 * c + 5] += A * bf_hi(w.z); o[8 * c + 6] += A * bf_lo(w.w); o[8 * c + 7] += A * bf_hi(w.w); }
            }
        }
        { bf16* op = ao + rowq * 1024 + h * 128 + 32 * r;
#pragma unroll
          for (int c = 0; c < 4; ++c) { v4u w; w.x = pk2(o[8 * c + 0], o[8 * c + 1]); w.y = pk2(o[8 * c + 2], o[8 * c + 3]); w.z = pk2(o[8 * c + 4], o[8 * c + 5]); w.w = pk2(o[8 * c + 6], o[8 * c + 7]);
              *(v4u*)(op + 8 * c) = w; } }
    }
}


namespace sba {
using bf16x8 = __attribute__((ext_vector_type(8))) short;
using s16x4  = __attribute__((ext_vector_type(4))) short;
using f32x16 = __attribute__((ext_vector_type(16))) float;
constexpr int SHM_V = 16384, SHM_K = 16384, LDQ = 3072;
#define KSWZ(row, colB) ((row) * 256 + ((colB) ^ (((row) & 7) << 4)))
#define SBAR() __builtin_amdgcn_sched_barrier(0)
DI int crow(int r, int hi) { return (r & 3) + 8 * (r >> 2) + 4 * hi; }
DI int v_st(int k, int c) { const int kk = (k & ~0xC) | ((k & 4) << 1) | ((k & 8) >> 1); return ((kk >> 3) * 4 + (c >> 5)) * 512 + ((kk & 7) * 32 + (c & 31)) * 2; }
DI int v_rd_base(int lane) { return ((lane & 3) << 3) | (((lane >> 2) & 3) << 6) | (((lane >> 4) & 1) << 5) | (((lane >> 5) & 1) << 8); }
constexpr int v_rd_off(int d0, int ks, int half) { return d0 * 512 + ks * 4096 + half * 2048; }
template <int OFF> DI s16x4 tr_read(int vb) { s16x4 r; asm volatile("ds_read_b64_tr_b16 %0, %1 offset:%2" : "=&v"(r) : "v"(vb), "i"(OFF) : "memory"); return r; }
template <int D0> DI void pv_one(f32x16& od, int vb, bf16x8 pa0, bf16x8 pa1, bf16x8 pa2, bf16x8 pa3) {
  const s16x4 l0 = tr_read<v_rd_off(D0, 0, 0)>(vb), h0 = tr_read<v_rd_off(D0, 0, 1)>(vb), l1 = tr_read<v_rd_off(D0, 1, 0)>(vb), h1 = tr_read<v_rd_off(D0, 1, 1)>(vb);
  const s16x4 l2 = tr_read<v_rd_off(D0, 2, 0)>(vb), h2 = tr_read<v_rd_off(D0, 2, 1)>(vb), l3 = tr_read<v_rd_off(D0, 3, 0)>(vb), h3 = tr_read<v_rd_off(D0, 3, 1)>(vb);
  asm volatile("s_waitcnt lgkmcnt(0)" ::: "memory"); SBAR();
#define PK(L, H) (bf16x8){L[0], L[1], L[2], L[3], H[0], H[1], H[2], H[3]}
  od = __builtin_amdgcn_mfma_f32_32x32x16_bf16(pa0, PK(l0, h0), od, 0, 0, 0);
  od = __builtin_amdgcn_mfma_f32_32x32x16_bf16(pa1, PK(l1, h1), od, 0, 0, 0);
  od = __builtin_amdgcn_mfma_f32_32x32x16_bf16(pa2, PK(l2, h2), od, 0, 0, 0);
  od = __builtin_amdgcn_mfma_f32_32x32x16_bf16(pa3, PK(l3, h3), od, 0, 0, 0);
#undef PK
}
DI void qkt(f32x16& p0, f32x16& p1, const LAS unsigned char* Ks, const bf16x8 (&qr)[8], int r32, int hi) {
  p0 = f32x16{}; p1 = f32x16{};
#pragma unroll
  for (int d0 = 0; d0 < 8; ++d0) { const int cb = (d0 * 16 + hi * 8) * 2;
    const bf16x8 b0 = *(const LAS bf16x8*)(Ks + KSWZ(r32, cb));
    const bf16x8 b1 = *(const LAS bf16x8*)(Ks + KSWZ(32 + r32, cb));
    p0 = __builtin_amdgcn_mfma_f32_32x32x16_bf16(b0, qr[d0], p0, 0, 0, 0);
    p1 = __builtin_amdgcn_mfma_f32_32x32x16_bf16(b1, qr[d0], p1, 0, 0, 0); }
}
template <bool MASK> DI void sb_half(f32x16& p, float& Pc, int hi, int kbase, int trow) {
  constexpr float C = 0.08838834764831845f * 1.4426950408889634f;
  float rr[16];
#pragma unroll
  for (int r = 0; r < 16; ++r) {
    float z = p[r] * C;
    if (MASK) z = (kbase + crow(r, hi) < trow) ? z : -__builtin_inff();
    const float k = __builtin_amdgcn_rcpf(1.0f + __builtin_amdgcn_exp2f(z));
    rr[r] = k; p[r] = 1.0f - k;
  }
  float R0[4], R1[4];
#pragma unroll
  for (int g = 0; g < 4; ++g) {
    const float c2 = rr[4 * g + 3], c1 = c2 * rr[4 * g + 2], c0 = c1 * rr[4 * g + 1], R = c0 * rr[4 * g];
    rr[4 * g + 2] = c2; rr[4 * g + 1] = c1; rr[4 * g] = c0;
    const auto sw = __builtin_amdgcn_permlane32_swap(__float_as_uint(R), __float_as_uint(R), false, false);
    R0[g] = __uint_as_float(sw[0]); R1[g] = __uint_as_float(sw[1]);
  }
#pragma unroll
  for (int g = 3; g >= 0; --g) {
    const float Pin = hi ? Pc : Pc * R1[g];
    p[4 * g + 3] *= Pin; p[4 * g + 2] *= Pin * rr[4 * g + 2]; p[4 * g + 1] *= Pin * rr[4 * g + 1]; p[4 * g] *= Pin * rr[4 * g];
    Pc *= R0[g] * R1[g];
  }
}
DI unsigned cvtpk(float lo, float hi) { unsigned r; asm volatile("v_cvt_pk_bf16_f32 %0, %1, %2" : "=v"(r) : "v"(lo), "v"(hi)); return r; }
#define PK4(P, BASE, OUT) do { const unsigned a0 = cvtpk(P[BASE + 0], P[BASE + 1]), a1 = cvtpk(P[BASE + 2], P[BASE + 3]);   \
    const unsigned b0 = cvtpk(P[BASE + 4], P[BASE + 5]), b1 = cvtpk(P[BASE + 6], P[BASE + 7]);                              \
    const auto r0 = __builtin_amdgcn_permlane32_swap(a0, b0, false, false); const auto r1 = __builtin_amdgcn_permlane32_swap(a1, b1, false, false); \
    const v4u w = {r0[0], r1[0], r0[1], r1[1]}; OUT = __builtin_bit_cast(bf16x8, w); } while (0)

DI void unit(const bf16* qkv, bf16* ao, int b, int h, int qb, LAS unsigned char* lds, int tid) {
  const int wid = __builtin_amdgcn_readfirstlane(tid >> 6), lane = tid & 63, r32 = lane & 31, hi = lane >> 5;
  LAS unsigned char* V_lds = lds; LAS unsigned char* K_lds = lds + 2 * SHM_V;
  const size_t rowbase = (size_t)b * SEQ; const int q0 = qb * 256, t_lo = q0 + wid * 32, trow = t_lo + r32;
  bf16x8 qr[8];
  { const bf16* Qw = qkv + (rowbase + trow) * LDQ + h * 128 + hi * 8;
#pragma unroll
    for (int d0 = 0; d0 < 8; ++d0) qr[d0] = *(const bf16x8*)(Qw + d0 * 16); }
  const bf16* Kh = qkv + rowbase * LDQ + 1024 + h * 128; const bf16* Vh = Kh + 1024;
  const int sr = tid >> 4, sc = (tid & 15) * 8, vst0 = v_st(sr, sc), vst1 = v_st(32 + sr, sc);
  const int vb0 = (int)(unsigned)(size_t)V_lds + v_rd_base(lane);
  bf16x8 vs0, vs1, ks0, ks1;
#define SLOAD(k0) do { vs0 = *(const bf16x8*)(Vh + (size_t)((k0) + sr) * LDQ + sc); vs1 = *(const bf16x8*)(Vh + (size_t)((k0) + 32 + sr) * LDQ + sc); \
    ks0 = *(const bf16x8*)(Kh + (size_t)((k0) + sr) * LDQ + sc); ks1 = *(const bf16x8*)(Kh + (size_t)((k0) + 32 + sr) * LDQ + sc); } while (0)
#define SWRITE(bb) do { *(LAS bf16x8*)(V_lds + (bb) * SHM_V + vst0) = vs0; *(LAS bf16x8*)(V_lds + (bb) * SHM_V + vst1) = vs1; const int kc = sc * 2; \
    *(LAS bf16x8*)(K_lds + (bb) * SHM_K + KSWZ(sr, kc)) = ks0; *(LAS bf16x8*)(K_lds + (bb) * SHM_K + KSWZ(32 + sr, kc)) = ks1; } while (0)
  f32x16 o[4] = {}; float Pc = 1.0f;
  const int kt_max = qb * 4 + 3;
  SLOAD(kt_max * 64);
  for (int kt = kt_max; kt >= 0; --kt) {
    const int buf = kt & 1, k0 = kt * 64;
    asm volatile("s_waitcnt vmcnt(0)" ::: "memory");
    SWRITE(buf);
    if (kt > 0) SLOAD(k0 - 64);
    __syncthreads();
    if (k0 < t_lo + 31) {
      f32x16 p0, p1;
      qkt(p0, p1, K_lds + buf * SHM_K, qr, r32, hi);
      if (k0 + 63 >= t_lo) { sb_half<true>(p1, Pc, hi, k0 + 32, trow); sb_half<true>(p0, Pc, hi, k0, trow); }
      else { sb_half<false>(p1, Pc, hi, k0 + 32, trow); sb_half<false>(p0, Pc, hi, k0, trow); }
      bf16x8 pa0, pa1, pa2, pa3;
      PK4(p0, 0, pa0); PK4(p0, 8, pa1); PK4(p1, 0, pa2); PK4(p1, 8, pa3);
      const int vb = vb0 + buf * SHM_V;
      pv_one<0>(o[0], vb, pa0, pa1, pa2, pa3); pv_one<1>(o[1], vb, pa0, pa1, pa2, pa3); pv_one<2>(o[2], vb, pa0, pa1, pa2, pa3); pv_one<3>(o[3], vb, pa0, pa1, pa2, pa3);
    }
  }
  bf16* Ow = ao + (rowbase + t_lo) * 1024 + h * 128 + r32;
#pragma unroll
  for (int r = 0; r < 16; ++r) { const int orow = crow(r, hi);
#pragma unroll
    for (int d0 = 0; d0 < 4; ++d0) Ow[(size_t)orow * 1024 + d0 * 32] = (bf16)(cvtpk(o[d0][r], 0.f) & 0xffffu); }
#undef SLOAD
#undef SWRITE
}
#undef PK4
#undef KSWZ
#undef SBAR
}
DI void phase_sb_mfma(const Args& a, LAS unsigned char* lds, int bid, int G, int tid) {
    const bf16* qkv = (const bf16*)(a.ws + WS_QKV); bf16* ao = (bf16*)(a.ws + WS_AO);
    const int vcu = (G % 8 == 0) ? (bid % 8) * (G / 8) + bid / 8 : bid;
    for (int pi = vcu; pi < 512; pi += G) {
        const int bh = pi >> 3, p = pi & 7, b = bh >> 3, h = bh & 7;
        sba::unit(qkv, ao, b, h, 15 - p, lds, tid);
        sba::unit(qkv, ao, b, h, p, lds, tid);
    }
}


namespace gdn {
using bf16x8 = __attribute__((ext_vector_type(8))) short;
using s16x4  = __attribute__((ext_vector_type(4))) short;
using f32x16 = __attribute__((ext_vector_type(16))) float;
typedef float f2v __attribute__((ext_vector_type(2)));
typedef __bf16 b2v __attribute__((ext_vector_type(2)));
DI unsigned pk(float a, float b) { const f2v v = {a, b}; const b2v r = __builtin_convertvector(v, b2v); return __builtin_bit_cast(unsigned, r); }
DI int crow(int r, int hi) { return (r & 3) + 8 * (r >> 2) + 4 * hi; }
DI int pi_slot(int x) { return 8 * ((x >> 2) & 3) + 4 * ((x >> 4) & 1) + (x & 3); }
DI bf16x8 pack_step(const f32x16& x, int s) {
    v4u w; w.x = pk(x[8 * s + 0], x[8 * s + 1]); w.y = pk(x[8 * s + 2], x[8 * s + 3]); w.z = pk(x[8 * s + 4], x[8 * s + 5]); w.w = pk(x[8 * s + 6], x[8 * s + 7]);
    return __builtin_bit_cast(bf16x8, w);
}
DI f32x16 mm(const f32x16& P, const f32x16& Q, f32x16 acc) {
    acc = __builtin_amdgcn_mfma_f32_32x32x16_bf16(pack_step(P, 0), pack_step(Q, 0), acc, 0, 0, 0);
    acc = __builtin_amdgcn_mfma_f32_32x32x16_bf16(pack_step(P, 1), pack_step(Q, 1), acc, 0, 0, 0);
    return acc;
}
#define GPK4(P, BASE, OUT) do { const unsigned a0 = pk(P[BASE + 0], P[BASE + 1]), a1 = pk(P[BASE + 2], P[BASE + 3]);   \
    const unsigned b0 = pk(P[BASE + 4], P[BASE + 5]), b1 = pk(P[BASE + 6], P[BASE + 7]);                              \
    const auto r0 = __builtin_amdgcn_permlane32_swap(a0, b0, false, false); const auto r1 = __builtin_amdgcn_permlane32_swap(a1, b1, false, false); \
    const v4u w_ = {r0[0], r1[0], r0[1], r1[1]}; OUT = __builtin_bit_cast(bf16x8, w_); } while (0)

DI void local_unit(const Args& a, int unit, LAS unsigned char* img, LAS float* tab, int lane, bool dry) {
    const int r32 = lane & 31, hi = lane >> 5;
    const int chunk = unit & 63, bh = unit >> 6, hv = bh & 15, b = bh >> 4, hk = hv >> 1;
    const size_t t0 = (size_t)b * SEQ + chunk * 64;
    bf16* qkvc = (bf16*)(a.ws + WS_QKVC); const float* gb = (const float*)(a.ws + WS_GB);
    bf16* wmem = (bf16*)(a.ws + WS_WMEM) + (size_t)unit * 8192; bf16* imem = (bf16*)(a.ws + WS_IMEM) + (size_t)unit * 4096;
    bf16* ktmem = (bf16*)(a.ws + WS_KTMEM) + (size_t)((b * HK + hk) * 64 + chunk) * 8192; float* gtab = (float*)(a.ws + WS_GTAB) + (size_t)unit * 192;
    float gc = gb[(t0 + lane) * 32 + hv]; const float be = gb[(t0 + lane) * 32 + 16 + hv];
#pragma unroll
    for (int off = 1; off < 64; off <<= 1) { const float y = __shfl_up(gc, off); if (lane >= off) gc += y; }
    const float glast = __shfl(gc, 63);
    tab[lane] = gc; tab[64 + lane] = be; tab[128 + lane] = -be * __expf(gc);
    gtab[lane] = __expf(gc); gtab[64 + lane] = __expf(glast - gc); if (lane == 0) gtab[128] = __expf(glast);
    const bf16* kbase = qkvc + t0 * 4096 + 1024 + hk * 128; const bf16* qbase = qkvc + t0 * 4096 + hk * 128; bf16* vbase = qkvc + t0 * 4096 + 2048 + hv * 128;
    if ((hv & 1) == 0) {
        const int slot = 32 * (lane >> 5) + pi_slot(lane & 31);
#pragma unroll 4
        for (int c8 = 0; c8 < 16; ++c8) { const v4u kv = *(const v4u*)(kbase + (size_t)lane * 4096 + 8 * c8);
            bf16* dst = ktmem + (size_t)(8 * c8) * 64 + slot;
            dst[0 * 64] = (bf16)(kv.x & 0xffffu); dst[1 * 64] = (bf16)(kv.x >> 16); dst[2 * 64] = (bf16)(kv.y & 0xffffu); dst[3 * 64] = (bf16)(kv.y >> 16);
            dst[4 * 64] = (bf16)(kv.z & 0xffffu); dst[5 * 64] = (bf16)(kv.z >> 16); dst[6 * 64] = (bf16)(kv.w & 0xffffu); dst[7 * 64] = (bf16)(kv.w >> 16); }
    }
#define GSB() __builtin_amdgcn_sched_barrier(0)
    {
        f32x16 IT00 = {}, IT11 = {}, IT01 = {};
#pragma unroll
        for (int s = 0; s < 8; ++s) {
            const bf16x8 k0 = *(const bf16x8*)(kbase + (size_t)r32 * 4096 + 16 * s + 8 * hi), k1 = *(const bf16x8*)(kbase + (size_t)(32 + r32) * 4096 + 16 * s + 8 * hi);
            const bf16x8 q0 = *(const bf16x8*)(qbase + (size_t)r32 * 4096 + 16 * s + 8 * hi), q1 = *(const bf16x8*)(qbase + (size_t)(32 + r32) * 4096 + 16 * s + 8 * hi);
            IT00 = __builtin_amdgcn_mfma_f32_32x32x16_bf16(k0, q0, IT00, 0, 0, 0); IT11 = __builtin_amdgcn_mfma_f32_32x32x16_bf16(k1, q1, IT11, 0, 0, 0);
            IT01 = __builtin_amdgcn_mfma_f32_32x32x16_bf16(k0, q1, IT01, 0, 0, 0);
        }
#pragma unroll
        for (int I = 0; I < 2; ++I) { const int c = 32 * I + r32; const float gcc = tab[c];
#pragma unroll
            for (int J = 0; J < 2; ++J)
#pragma unroll
                for (int g = 0; g < 4; ++g) { float v[4];
#pragma unroll
                    for (int i = 0; i < 4; ++i) { const int r = 4 * g + i, cp = 32 * J + crow(r, hi);
                        const float raw = (I == 0) ? (J == 0 ? IT00[r] : 0.f) : (J == 0 ? IT01[r] : IT11[r]);
                        const float val = raw * __expf(-fabsf(gcc - tab[cp])); v[i] = (c >= cp) ? val : 0.f; }
                    v2u o; o.x = pk(v[0], v[1]); o.y = pk(v[2], v[3]);
                    *(v2u*)(imem + (size_t)c * 64 + 32 * J + 16 * (g & 1) + 8 * hi + 4 * (g >> 1)) = o; } }
    }
    GSB();
    f32x16 T1, T1T, T2T, T21T;
    {
        f32x16 KK = {};
#pragma unroll
        for (int s = 0; s < 8; ++s) { const bf16x8 k0 = *(const bf16x8*)(kbase + (size_t)r32 * 4096 + 16 * s + 8 * hi); KK = __builtin_amdgcn_mfma_f32_32x32x16_bf16(k0, k0, KK, 0, 0, 0); }
        f32x16 M, MT;
        { const float gb0 = tab[r32], bb0 = tab[64 + r32];
#pragma unroll
        for (int r = 0; r < 16; ++r) { const int a0 = crow(r, hi), b0 = r32; const float ke = -KK[r] * __expf(-fabsf(tab[a0] - gb0));
            const float nv = ke * tab[64 + a0], ntv = ke * bb0;
            const float n = (a0 > b0) ? nv : 0.f, nt = (b0 > a0) ? ntv : 0.f, id = (a0 == b0) ? 1.f : 0.f;
            M[r] = n; MT[r] = nt; T1[r] = id + n; T1T[r] = id + nt; } }
#pragma unroll
        for (int it = 0; it < 4; ++it) { const f32x16 z = {};
            const f32x16 Mn = mm(MT, M, z), MTn = mm(M, MT, z);
            const f32x16 Tn = mm(T1T, Mn, T1);
            T1T = mm(Mn, T1T, T1T);
            T1 = Tn; M = Mn; MT = MTn; }
    }
    GSB();
    {
        f32x16 KK = {};
#pragma unroll
        for (int s = 0; s < 8; ++s) { const bf16x8 k1 = *(const bf16x8*)(kbase + (size_t)(32 + r32) * 4096 + 16 * s + 8 * hi); KK = __builtin_amdgcn_mfma_f32_32x32x16_bf16(k1, k1, KK, 0, 0, 0); }
        f32x16 M, MT;
        { const float gb0 = tab[32 + r32], bb0 = tab[96 + r32];
#pragma unroll
        for (int r = 0; r < 16; ++r) { const int a0 = crow(r, hi), b0 = r32; const float ke = -KK[r] * __expf(-fabsf(tab[32 + a0] - gb0));
            const float nv = ke * tab[96 + a0], ntv = ke * bb0;
            const float n = (a0 > b0) ? nv : 0.f, nt = (b0 > a0) ? ntv : 0.f, id = (a0 == b0) ? 1.f : 0.f;
            M[r] = n; MT[r] = nt; T2T[r] = id + nt; } }
#pragma unroll
        for (int it = 0; it < 4; ++it) { const f32x16 z = {};
            const f32x16 Mn = mm(MT, M, z), MTn = mm(M, MT, z);
            T2T = mm(Mn, T2T, T2T);
            M = Mn; MT = MTn; }
    }
    GSB();
    {
        f32x16 L21 = {};
#pragma unroll
        for (int s = 0; s < 8; ++s) { const bf16x8 k0 = *(const bf16x8*)(kbase + (size_t)r32 * 4096 + 16 * s + 8 * hi), k1 = *(const bf16x8*)(kbase + (size_t)(32 + r32) * 4096 + 16 * s + 8 * hi);
            L21 = __builtin_amdgcn_mfma_f32_32x32x16_bf16(k1, k0, L21, 0, 0, 0); }
#pragma unroll
        for (int r = 0; r < 16; ++r) { const int a0 = crow(r, hi); L21[r] = L21[r] * tab[96 + a0] * __expf(tab[32 + a0] - tab[r32]); }
        const f32x16 z = {}; const f32x16 Y = mm(L21, T2T, z); T21T = mm(T1, Y, z);
#pragma unroll
        for (int r = 0; r < 16; ++r) T21T[r] = -T21T[r];
    }
    GSB();
    const int vb = (int)(unsigned)(size_t)img + sba::v_rd_base(lane);
    bf16* ubl = dry ? (bf16*)(a.ws + WS_END) + (size_t)(unit & 63) * 64 * 4096 : vbase;
#pragma unroll 1
    for (int mode = 0; mode < 2; ++mode) {
        const bf16* src = mode == 0 ? (const bf16*)vbase : kbase;
#pragma unroll 4
        for (int it = 0; it < 16; ++it) { const int row = (lane >> 4) + 4 * it, col = (lane & 15) * 8;
            *(LAS v4u*)(img + sba::v_st(row, col)) = *(const v4u*)(src + (size_t)row * 4096 + col); }
        LAS float* sc = tab + (mode == 0 ? 64 : 128);
#pragma unroll 1
        for (int I = 0; I < 2; ++I) {
            bf16x8 pa0, pa1, pa2, pa3;
            { f32x16 X;
#pragma unroll
              for (int r = 0; r < 16; ++r) X[r] = (I ? T21T[r] : T1T[r]) * sc[crow(r, hi)];
              GPK4(X, 0, pa0); GPK4(X, 8, pa1);
#pragma unroll
              for (int r = 0; r < 16; ++r) X[r] = I ? T2T[r] * sc[32 + crow(r, hi)] : 0.f;
              GPK4(X, 0, pa2); GPK4(X, 8, pa3); }
            const int ubase = ((((r32 >> 4) * 64 + hi * 16 + (r32 & 15)) * 16) + 8 * I);
            const int wbase = (32 * I + 4 * hi) * 128 + pi_slot(r32);
#define GDN_OUT(D0) do { f32x16 od = {}; sba::pv_one<D0>(od, vb, pa0, pa1, pa2, pa3); \
            if (mode == 0) { _Pragma("unroll") for (int g = 0; g < 4; ++g) { const int f = ubase + D0 * 2048 + (g & 1) * 512 + (g >> 1) * 4; \
                    v2u w; w.x = pk(od[4 * g + 0], od[4 * g + 1]); w.y = pk(od[4 * g + 2], od[4 * g + 3]); *(v2u*)(ubl + (unsigned)((f >> 7) * 4096 + (f & 127))) = w; } } \
            else { _Pragma("unroll") for (int r = 0; r < 16; ++r) wmem[(unsigned)(wbase + ((r & 3) + 8 * (r >> 2)) * 128 + 32 * D0)] = (bf16)(pk(od[r], 0.f) & 0xffffu); } \
            GSB(); } while (0)
            GDN_OUT(0); GDN_OUT(1); GDN_OUT(2); GDN_OUT(3);
#undef GDN_OUT
        }
    }
#undef GSB
}
#undef GPK4
}
DI void phase_gdn_local(const Args& a, LAS unsigned char* lds, int bid, int G, int wave, int lane, bool dry) {
    LAS unsigned char* img = lds + wave * 16384; LAS float* tab = (LAS float*)(lds + RING_BYTES + 4096 + wave * 1024);
    const int gw = bid * NWAVES + wave, NGW = G * NWAVES;
    for (int unit = gw; unit < BATCH * HV * 64; unit += NGW) gdn::local_unit(a, unit, img, tab, lane, dry);
}
namespace gdn {
constexpr int PW = 272, PI = 144;
constexpr int L_W = 0, L_Q = 64 * PW, L_I = 2 * 64 * PW, L_K = L_I + 64 * PI, L_G = L_K + 128 * PI, L_BUF = L_G + 768;
constexpr int L_PART = 2 * L_BUF;
static_assert(L_PART + 4096 <= RING_BYTES, "scan LDS map");
}
DI void phase_gdn_scan(const Args& a, int j, LAS unsigned char* lds, int bid, int tid, bool dry) {
    if (bid >= BATCH * HV) return;
    using gdn::bf16x8; using gdn::pk; using namespace gdn;
    typedef float f4v __attribute__((ext_vector_type(4)));
    const int wave = __builtin_amdgcn_readfirstlane(tid >> 6), lane = tid & 63, n = lane & 15, kq = lane >> 4;
    const int b = bid / HV, hv = bid % HV, hk = hv >> 1;
    bf16* qkvc = (bf16*)(a.ws + WS_QKVC); const bf16* zb = (const bf16*)(a.ws + WS_ZB);
    LAS float* part = (LAS float*)(lds + L_PART);
    const float nw = a.gdn_norm_w[j * 128 + 16 * wave + n];
    const int unit0 = (b * HV + hv) * 64, hku0 = (b * HK + hk) * 64; const size_t tb0 = (size_t)b * SEQ;
    const int c0 = tid, c1 = tid + 512;
    v4u rw0, rw1, rq0, rq1, ri0, rk0, rk1, ru0, ru1; float rg = 0.f;
#define SCAN_LOAD(ch) do { const int u_ = unit0 + (ch); const size_t t_ = tb0 + (size_t)(ch) * 64; \
        const bf16* wm_ = (const bf16*)(a.ws + WS_WMEM) + (size_t)u_ * 8192; const bf16* im_ = (const bf16*)(a.ws + WS_IMEM) + (size_t)u_ * 4096; \
        const bf16* kt_ = (const bf16*)(a.ws + WS_KTMEM) + (size_t)(hku0 + (ch)) * 8192; const bf16* qb_ = qkvc + t_ * 4096 + hk * 128; const bf16* vb_ = qkvc + t_ * 4096 + 2048 + hv * 128; \
        rw0 = *(const v4u*)(wm_ + c0 * 8); rw1 = *(const v4u*)(wm_ + c1 * 8); \
        rq0 = *(const v4u*)(qb_ + (size_t)(c0 >> 4) * 4096 + (c0 & 15) * 8); rq1 = *(const v4u*)(qb_ + (size_t)(c1 >> 4) * 4096 + (c1 & 15) * 8); \
        ri0 = *(const v4u*)(im_ + c0 * 8); rk0 = *(const v4u*)(kt_ + c0 * 8); rk1 = *(const v4u*)(kt_ + c1 * 8); \
        { const int f = (wave * 64 + lane) * 16; ru0 = *(const v4u*)(vb_ + (size_t)(f >> 7) * 4096 + (f & 127)); ru1 = *(const v4u*)(vb_ + (size_t)(f >> 7) * 4096 + (f & 127) + 8); } \
        if (tid < 192) rg = ((const float*)(a.ws + WS_GTAB))[(size_t)u_ * 192 + tid]; } while (0)
#define SCAN_WRITE(bf) do { LAS unsigned char* B_ = lds + (bf) * L_BUF; \
        *(LAS v4u*)(B_ + L_W + (c0 >> 4) * PW + (c0 & 15) * 16) = rw0; *(LAS v4u*)(B_ + L_W + (c1 >> 4) * PW + (c1 & 15) * 16) = rw1; \
        *(LAS v4u*)(B_ + L_Q + (c0 >> 4) * PW + (c0 & 15) * 16) = rq0; *(LAS v4u*)(B_ + L_Q + (c1 >> 4) * PW + (c1 & 15) * 16) = rq1; \
        *(LAS v4u*)(B_ + L_I + (c0 >> 3) * PI + (c0 & 7) * 16) = ri0; \
        *(LAS v4u*)(B_ + L_K + (c0 >> 3) * PI + (c0 & 7) * 16) = rk0; *(LAS v4u*)(B_ + L_K + (c1 >> 3) * PI + (c1 & 7) * 16) = rk1; \
        if (tid < 192) *(LAS float*)(B_ + L_G + tid * 4) = rg; } while (0)
    f4v S[8];
#pragma unroll
    for (int m = 0; m < 8; ++m) S[m] = (f4v){0.f, 0.f, 0.f, 0.f};
    SCAN_LOAD(0);
    SCAN_WRITE(0);
    v4u u0 = ru0, u1 = ru1;
    unsigned short zn[16];
#pragma unroll
    for (int mt = 0; mt < 4; ++mt)
#pragma unroll
        for (int i = 0; i < 4; ++i) zn[4 * mt + i] = zb[(tb0 + 16 * mt + 4 * kq + i) * 2048 + hv * 128 + 16 * wave + n];
    __syncthreads();
#pragma unroll 1
    for (int chunk = 0; chunk < 64; ++chunk) {
        const size_t t0 = tb0 + (size_t)chunk * 64; bf16* vbase = qkvc + t0 * 4096 + 2048 + hv * 128;
        const LAS unsigned char* B = lds + (chunk & 1) * L_BUF; const LAS float* gt = (const LAS float*)(B + L_G);
        if (chunk + 1 < 64) SCAN_LOAD(chunk + 1);
        unsigned short zz[16];
#pragma unroll
        for (int q = 0; q < 16; ++q) zz[q] = zn[q];
        if (chunk + 1 < 64) {
#pragma unroll
            for (int mt = 0; mt < 4; ++mt)
#pragma unroll
                for (int i = 0; i < 4; ++i) zn[4 * mt + i] = zb[(t0 + 64 + 16 * mt + 4 * kq + i) * 2048 + hv * 128 + 16 * wave + n];
        }
        __builtin_amdgcn_sched_barrier(0);
        f4v av[4], ao[4];
        av[0] = (f4v){bf_lo(u0.x), bf_hi(u0.x), bf_lo(u0.y), bf_hi(u0.y)}; av[1] = (f4v){bf_lo(u0.z), bf_hi(u0.z), bf_lo(u0.w), bf_hi(u0.w)};
        av[2] = (f4v){bf_lo(u1.x), bf_hi(u1.x), bf_lo(u1.y), bf_hi(u1.y)}; av[3] = (f4v){bf_lo(u1.z), bf_hi(u1.z), bf_lo(u1.w), bf_hi(u1.w)};
        bf16x8 Sb[4];
#pragma unroll
        for (int p = 0; p < 4; ++p) { v4u w; w.x = pk(S[2 * p][0], S[2 * p][1]); w.y = pk(S[2 * p][2], S[2 * p][3]); w.z = pk(S[2 * p + 1][0], S[2 * p + 1][1]); w.w = pk(S[2 * p + 1][2], S[2 * p + 1][3]);
            Sb[p] = __builtin_bit_cast(bf16x8, w); }
#pragma unroll
        for (int mt = 0; mt < 4; ++mt) { ao[mt] = (f4v){0.f, 0.f, 0.f, 0.f};
#pragma unroll
            for (int p = 0; p < 4; ++p) {
                const bf16x8 aw = *(const LAS bf16x8*)(B + L_W + (16 * mt + n) * PW + 64 * p + 16 * kq);
                const v2u q0 = *(const LAS v2u*)(B + L_Q + (16 * mt + n) * PW + 64 * p + 8 * kq), q1 = *(const LAS v2u*)(B + L_Q + (16 * mt + n) * PW + 64 * p + 32 + 8 * kq);
                const v4u qq = {q0.x, q0.y, q1.x, q1.y};
                av[mt] = __builtin_amdgcn_mfma_f32_16x16x32_bf16(aw, Sb[p], av[mt], 0, 0, 0);
                ao[mt] = __builtin_amdgcn_mfma_f32_16x16x32_bf16(__builtin_bit_cast(bf16x8, qq), Sb[p], ao[mt], 0, 0, 0); } }
        bf16x8 vbf[2], vbd[2];
#pragma unroll
        for (int pp = 0; pp < 2; ++pp) {
            const f4v d0 = *(const LAS f4v*)(gt + 64 + 32 * pp + 4 * kq), d1 = *(const LAS f4v*)(gt + 64 + 32 * pp + 16 + 4 * kq);
            const f4v x0 = av[2 * pp], x1 = av[2 * pp + 1];
            v4u w; w.x = pk(x0[0], x0[1]); w.y = pk(x0[2], x0[3]); w.z = pk(x1[0], x1[1]); w.w = pk(x1[2], x1[3]); vbf[pp] = __builtin_bit_cast(bf16x8, w);
            v4u y; y.x = pk(x0[0] * d0[0], x0[1] * d0[1]); y.y = pk(x0[2] * d0[2], x0[3] * d0[3]); y.z = pk(x1[0] * d1[0], x1[1] * d1[1]); y.w = pk(x1[2] * d1[2], x1[3] * d1[3]); vbd[pp] = __builtin_bit_cast(bf16x8, y);
        }
#pragma unroll
        for (int mt = 0; mt < 4; ++mt) { const f4v eg = *(const LAS f4v*)(gt + 16 * mt + 4 * kq); ao[mt] = ao[mt] * eg;
#pragma unroll
            for (int pp = 0; pp < 2; ++pp) { const bf16x8 ai = *(const LAS bf16x8*)(B + L_I + (16 * mt + n) * PI + 64 * pp + 16 * kq);
                ao[mt] = __builtin_amdgcn_mfma_f32_16x16x32_bf16(ai, vbf[pp], ao[mt], 0, 0, 0); } }
        { const float egl = gt[128];
#pragma unroll
          for (int m8 = 0; m8 < 8; ++m8) { S[m8] = S[m8] * egl;
#pragma unroll
              for (int pp = 0; pp < 2; ++pp) { const bf16x8 ak = *(const LAS bf16x8*)(B + L_K + (16 * m8 + n) * PI + 64 * pp + 16 * kq);
                  S[m8] = __builtin_amdgcn_mfma_f32_16x16x32_bf16(ak, vbd[pp], S[m8], 0, 0, 0); } } }
        if (chunk + 1 < 64) { SCAN_WRITE((chunk + 1) & 1); u0 = ru0; u1 = ru1; }
        LAS float* pb = part + (chunk & 1) * 512;
#pragma unroll
        for (int mt = 0; mt < 4; ++mt)
#pragma unroll
            for (int i = 0; i < 4; ++i) { float ss = ao[mt][i] * ao[mt][i];
                ss += __builtin_bit_cast(float, __builtin_amdgcn_update_dpp(0, __builtin_bit_cast(int, ss), 0xB1, 0xF, 0xF, false));
                ss += __builtin_bit_cast(float, __builtin_amdgcn_update_dpp(0, __builtin_bit_cast(int, ss), 0x4E, 0xF, 0xF, false));
                ss += __builtin_bit_cast(float, __builtin_amdgcn_update_dpp(0, __builtin_bit_cast(int, ss), 0x141, 0xF, 0xF, false));
                ss += __builtin_bit_cast(float, __builtin_amdgcn_update_dpp(0, __builtin_bit_cast(int, ss), 0x140, 0xF, 0xF, false));
                if (n == 0) pb[(16 * mt + 4 * kq + i) * 8 + wave] = ss; }
        __syncthreads();
        LAS unsigned char* ogs = lds + OGST_OFF;
#pragma unroll
        for (int mt = 0; mt < 4; ++mt)
#pragma unroll
            for (int i = 0; i < 4; ++i) { const int c = 16 * mt + 4 * kq + i;
                const f4v s0 = *(const LAS f4v*)(pb + c * 8), s1 = *(const LAS f4v*)(pb + c * 8 + 4);
                const float tot = (s0[0] + s0[1]) + (s0[2] + s0[3]) + (s1[0] + s1[1]) + (s1[2] + s1[3]);
                const float rinv = 1.0f / sqrtf(tot * (1.0f / 128.0f) + RMS_EPS);
                const float z = __uint_as_float((unsigned)zz[4 * mt + i] << 16);
                *(LAS bf16*)(ogs + c * 256 + (16 * wave + n) * 2) = (bf16)(pk(ao[mt][i] * rinv * nw * z * sigmoid_f(z), 0.f) & 0xffffu); }
        __syncthreads();
        { bf16* ob = dry ? (bf16*)(a.ws + WS_END) + (size_t)bid * 64 * 128 : vbase; const int opitch = dry ? 128 : 4096;
          *(v4u*)(ob + (size_t)(c0 >> 4) * opitch + (c0 & 15) * 8) = *(const LAS v4u*)(ogs + (c0 >> 4) * 256 + (c0 & 15) * 16);
          *(v4u*)(ob + (size_t)(c1 >> 4) * opitch + (c1 & 15) * 8) = *(const LAS v4u*)(ogs + (c1 >> 4) * 256 + (c1 & 15) * 16); }
    }
#undef SCAN_LOAD
#undef SCAN_WRITE
}

DI void moe_offsets(const Args& a, int j, unsigned (&off)[9]) {
    unsigned* cnt = (unsigned*)(a.ws + WS_CTL) + CW_CNT + 256 * j; unsigned acc = 0u;
#pragma unroll
    for (int e = 0; e < 8; ++e) { off[e] = acc; const unsigned c = __hip_atomic_load(cnt + e, __ATOMIC_RELAXED, __HIP_MEMORY_SCOPE_AGENT); acc += (c + 255u) & ~255u; }
    off[8] = acc;
}
DI void phase_scatter(const Args& a, int j, LAS unsigned char* lds, int bid, int G, int tid, int wave, int lane) {
    LAS unsigned* lc = (LAS unsigned*)lds; LAS unsigned* lb = lc + 8; LAS unsigned* loff = lc + 16; LAS int* lpos = (LAS int*)(lc + 32);
    const unsigned* E12 = (const unsigned*)(a.ws + WS_E12); int* POS = (int*)(a.ws + WS_POS);
    const bf16* HB = (const bf16*)(a.ws + WS_HB); bf16* XS = (bf16*)(a.ws + WS_XS);
    unsigned* fill = (unsigned*)(a.ws + WS_CTL) + CW_CNT + 256 * j + 64;
    unsigned off[9]; moe_offsets(a, j, off);
    if (tid == 0) {
#pragma unroll
        for (int e = 0; e < 8; ++e) loff[e] = off[e]; }
    for (int ci = bid; ci < TT / 128; ci += G) {
        __syncthreads();
        if (tid < 8) lc[tid] = 0u;
        __syncthreads();
        unsigned e1 = 0, e2 = 0, r1 = 0, r2 = 0;
        if (tid < 128) { const unsigned w = E12[ci * 128 + tid]; e1 = w & 255u; e2 = (w >> 8) & 255u;
            r1 = __hip_atomic_fetch_add(lc + e1, 1u, __ATOMIC_RELAXED, __HIP_MEMORY_SCOPE_WORKGROUP); r2 = __hip_atomic_fetch_add(lc + e2, 1u, __ATOMIC_RELAXED, __HIP_MEMORY_SCOPE_WORKGROUP); }
        __syncthreads();
        if (tid < 8) lb[tid] = __hip_atomic_fetch_add(fill + tid, lc[tid], __ATOMIC_RELAXED, __HIP_MEMORY_SCOPE_AGENT);
        __syncthreads();
        if (tid < 128) { const int p1 = (int)(loff[e1] + lb[e1] + r1), p2 = (int)(loff[e2] + lb[e2] + r2);
            lpos[2 * tid] = p1; lpos[2 * tid + 1] = p2; POS[2 * (ci * 128 + tid)] = p1; POS[2 * (ci * 128 + tid) + 1] = p2; }
        __syncthreads();
        for (int tk = wave; tk < 128; tk += NWAVES) {
            const int p1 = lpos[2 * tk], p2 = lpos[2 * tk + 1];
            const v4u* src = (const v4u*)(HB + (size_t)(ci * 128 + tk) * D);
            const v4u x0 = src[lane], x1 = src[lane + 64];
            v4u* d1 = (v4u*)(XS + (size_t)p1 * D); v4u* d2 = (v4u*)(XS + (size_t)p2 * D);
            d1[lane] = x0; d1[lane + 64] = x1; d2[lane] = x0; d2[lane + 64] = x1;
        }
    }
}

DI void phase_combine_ln(const Args& a, int lnidx, int bid, int G, int wave, int lane) {
    float* out = a.out; bf16* HB = (bf16*)(a.ws + WS_HB); const bf16* YE = (const bf16*)(a.ws + WS_XS);
    const int* POS = (const int*)(a.ws + WS_POS); const f32x2* G12 = (const f32x2*)(a.ws + WS_G12);
    const float* g = a.ln_g + (size_t)lnidx * D; const float* bta = a.ln_b + (size_t)lnidx * D;
    const int gw = bid * NWAVES + wave, NGW = G * NWAVES;
    f32x4 gv[4], bv[4];
#pragma unroll
    for (int q = 0; q < 4; ++q) { gv[q] = *(const f32x4*)(g + 4 * (lane + 64 * q)); bv[q] = *(const f32x4*)(bta + 4 * (lane + 64 * q)); }
    for (int t = gw; t < TT; t += NGW) {
        f32x4* row = (f32x4*)(out + (size_t)t * D);
        const int p1 = POS[2 * t], p2 = POS[2 * t + 1]; const f32x2 gg = G12[t];
        const v2u* y1 = (const v2u*)(YE + (size_t)p1 * D); const v2u* y2 = (const v2u*)(YE + (size_t)p2 * D);
        f32x4 v[4]; float s = 0.f;
#pragma unroll
        for (int q = 0; q < 4; ++q) { const v2u a1 = y1[lane + 64 * q], a2 = y2[lane + 64 * q];
            const f32x4 e1 = (f32x4){bf_lo(a1.x), bf_hi(a1.x), bf_lo(a1.y), bf_hi(a1.y)}, e2 = (f32x4){bf_lo(a2.x), bf_hi(a2.x), bf_lo(a2.y), bf_hi(a2.y)};
            v[q] = row[lane + 64 * q] * ALPHA + e1 * gg.x + e2 * gg.y; s += (v[q][0] + v[q][1]) + (v[q][2] + v[q][3]); }
        const float mean = wave_sum(s) * (1.0f / D); float s2 = 0.f;
#pragma unroll
        for (int q = 0; q < 4; ++q) { v[q] = v[q] - mean; s2 += (v[q][0] * v[q][0] + v[q][1] * v[q][1]) + (v[q][2] * v[q][2] + v[q][3] * v[q][3]); }
        const float rstd = 1.0f / sqrtf(wave_sum(s2) * (1.0f / D) + LN_EPS);
#pragma unroll
        for (int q = 0; q < 4; ++q) { v[q] = v[q] * rstd * gv[q] + bv[q]; row[lane + 64 * q] = v[q];
            v2u o; o.x = pk2(v[q][0], v[q][1]); o.y = pk2(v[q][2], v[q][3]); *(v2u*)(HB + (size_t)t * D + 4 * (lane + 64 * q)) = o; }
    }
}

constexpr int ARGS_OFF = RING_BYTES + 1024;
DI unsigned long long lds_u64(LAS unsigned char* p) { const v2u w = *(const volatile LAS v2u*)p; return ((unsigned long long)(unsigned)__builtin_amdgcn_readfirstlane((int)w.y) << 32) | (unsigned)__builtin_amdgcn_readfirstlane((int)w.x); }
DI Args load_args(LAS unsigned char* lds) {
    Args a; LAS unsigned char* p = lds + ARGS_OFF;
    a.x = (const float*)(const GAS float*)lds_u64(p + 0); a.gdn_w_in = (const float*)(const GAS float*)lds_u64(p + 8); a.gdn_conv_w = (const float*)(const GAS float*)lds_u64(p + 16); a.gdn_a_log = (const float*)(const GAS float*)lds_u64(p + 24);
    a.gdn_dt_bias = (const float*)(const GAS float*)lds_u64(p + 32); a.gdn_norm_w = (const float*)(const GAS float*)lds_u64(p + 40); a.gdn_w_out = (const float*)(const GAS float*)lds_u64(p + 48); a.sb_w_in = (const float*)(const GAS float*)lds_u64(p + 56);
    a.sb_w_out = (const float*)(const GAS float*)lds_u64(p + 64); a.ffn_w_gate = (const float*)(const GAS float*)lds_u64(p + 72); a.ffn_w_up = (const float*)(const GAS float*)lds_u64(p + 80); a.ffn_w_down = (const float*)(const GAS float*)lds_u64(p + 88);
    a.moe_router = (const float*)(const GAS float*)lds_u64(p + 96); a.moe_w_gate = (const float*)(const GAS float*)lds_u64(p + 104); a.moe_w_up = (const float*)(const GAS float*)lds_u64(p + 112); a.moe_w_down = (const float*)(const GAS float*)lds_u64(p + 120);
    a.ln_g = (const float*)(const GAS float*)lds_u64(p + 128); a.ln_b = (const float*)(const GAS float*)lds_u64(p + 136); a.out = (float*)(GAS float*)lds_u64(p + 144); a.ws = (unsigned char*)(GAS unsigned char*)lds_u64(p + 152);
    const v2u w = *(const volatile LAS v2u*)(p + 160); a.ph_lo = __builtin_amdgcn_readfirstlane((int)w.x); a.ph_hi = __builtin_amdgcn_readfirstlane((int)w.y);
    return a;
}
#ifdef PH_ONLY
#define IN(k) (((k) % NPH) == PH_ONLY && lo <= (k) && (k) < hi)
#else
#define IN(k) (lo <= (k) && (k) < hi)
#endif
#define SEAM(k) do { if ((k) + 1 < hi) xcd_barrier(bar); } while (0)
DI int fresh_lane() { int l; asm volatile("v_mbcnt_lo_u32_b32 %0, -1, 0\n\tv_mbcnt_hi_u32_b32 %0, -1, %0" : "=v"(l)); return l; }
#define ARGS() const Args args = load_args(lds); const int lo = args.ph_lo, hi = args.ph_hi; const int lane = fresh_lane(), tid = wave * 64 + lane
#ifndef PROBE_REP_MASK
#define PROBE_REP_MASK 0
#endif
#ifndef PROBE_DELAY_MASK
#define PROBE_DELAY_MASK 0
#endif
#define PROBE_DELAY_MULT 4u
#define TICK_IN(k) do { if (((PROBE_DELAY_MASK) >> (k)) & 1) { if (bid == 0 && tid == 0) ((volatile LAS unsigned*)(lds + MISC_OFF))[20] -= (unsigned)__builtin_amdgcn_s_memrealtime(); } } while (0)
#define TICK_OUT(k) do { if (((PROBE_DELAY_MASK) >> (k)) & 1) { if (bid == 0 && tid == 0) ((volatile LAS unsigned*)(lds + MISC_OFF))[20] += (unsigned)__builtin_amdgcn_s_memrealtime(); } } while (0)
#define NREP(k) ((((PROBE_REP_MASK) >> (k)) & 1) ? 2 : 1)
template <int j>
DI void layer_pair(LAS unsigned char* lds, const XcdBarrier& bar, const int wave, const int G, const int bid) {
    constexpr int pb = j * NPH;
    { ARGS(); if (IN(pb + 0)) { TICK_IN(0); _Pragma("unroll 1") for (int rep_ = 0; rep_ < NREP(0); ++rep_) { phase_w_gdn(args, j, lds, bid, G, tid, wave, lane); } SEAM(pb + 0); TICK_OUT(0); } }
    { ARGS(); if (IN(pb + 1)) { TICK_IN(1); {
        pg8::Gemm g{(const bf16*)(args.ws + WS_HB), (const bf16*)(args.ws + W_IN), D, D}; pg8::StaticOrder S; S.init(TT, GINP, G, bid, NREP(1));
        pg8::EpiInProj E{(bf16*)(args.ws + WS_RAW), (bf16*)(args.ws + WS_ZB)};
        pg8::gemm_phase<pg8::EpiInProj, pg8::StaticOrder, true, true>(lds, g, S, E);
        } SEAM(pb + 1); TICK_OUT(1); } }
    { ARGS(); if (IN(pb + 2)) { TICK_IN(2); _Pragma("unroll 1") for (int rep_ = 0; rep_ < NREP(2); ++rep_) { phase_conv(args, j, bid, G, wave, lane); } SEAM(pb + 2); TICK_OUT(2); } }
#if GDN_NAIVE
    { ARGS(); if (IN(pb + 4)) { TICK_IN(4); _Pragma("unroll 1") for (int rep_ = 0; rep_ < NREP(4); ++rep_) { phase_gdn_naive(args, j, lds, bid, tid); } SEAM(pb + 4); TICK_OUT(4); } }
#else
    { ARGS(); if (IN(pb + 3)) { TICK_IN(3); _Pragma("unroll 1") for (int rep_ = 0; rep_ < NREP(3); ++rep_) { phase_gdn_local(args, lds, bid, G, wave, lane, rep_ + 1 < NREP(3)); } SEAM(pb + 3); TICK_OUT(3); } }
    { ARGS(); if (IN(pb + 4)) { TICK_IN(4); _Pragma("unroll 1") for (int rep_ = 0; rep_ < NREP(4); ++rep_) { phase_gdn_scan(args, j, lds, bid, tid, rep_ + 1 < NREP(4)); } SEAM(pb + 4); TICK_OUT(4); } }
#endif
    { ARGS(); if (IN(pb + 5)) { TICK_IN(5); {
        pg8::Gemm g{(const bf16*)(args.ws + WS_QKVC) + 2048, (const bf16*)(args.ws + W_OUT), 4096, 2048}; pg8::StaticOrder S; S.init(TT, D, G, bid);
        pg8::EpiResid E{j == 0 ? args.x : args.out, args.out, D, ALPHA};
        pg8::gemm_phase<pg8::EpiResid, pg8::StaticOrder, true, true>(lds, g, S, E);
        } SEAM(pb + 5); TICK_OUT(5); } }
    { ARGS(); if (IN(pb + 6)) { TICK_IN(6); _Pragma("unroll 1") for (int rep_ = 0; rep_ < NREP(6); ++rep_) { phase_ln<false>(args, (2 * j) * 2 + 0, j, lds, bid, G, tid, wave, lane); } SEAM(pb + 6); TICK_OUT(6); } }
    { ARGS(); if (IN(pb + 7)) { TICK_IN(7); {
        pg8::Gemm g{(const bf16*)(args.ws + WS_HB), (const bf16*)(args.ws + W_GU), D, D}; pg8::StaticOrder S; S.init(TT, 2 * FF, G, bid, NREP(7));
        pg8::EpiSwiGLU E{(bf16*)(args.ws + WS_ACT), FF, 0};
        pg8::gemm_phase<pg8::EpiSwiGLU, pg8::StaticOrder, true, true>(lds, g, S, E);
        } SEAM(pb + 7); TICK_OUT(7); } }
    { ARGS(); if (IN(pb + 8)) { TICK_IN(8); {
        pg8::Gemm g{(const bf16*)(args.ws + WS_ACT), (const bf16*)(args.ws + W_D), FF, FF}; pg8::StaticOrder S; S.init(TT, D, G, bid);
        pg8::EpiResid E{args.out, args.out, D, ALPHA};
        pg8::gemm_phase<pg8::EpiResid, pg8::StaticOrder, true, true>(lds, g, S, E);
        } SEAM(pb + 8); TICK_OUT(8); } }
    { ARGS(); if (IN(pb + 9)) { TICK_IN(9); _Pragma("unroll 1") for (int rep_ = 0; rep_ < NREP(9); ++rep_) { phase_ln<false>(args, (2 * j) * 2 + 1, j, lds, bid, G, tid, wave, lane); _Pragma("unroll 1") for (int r2_ = 0; r2_ < NREP(18); ++r2_) phase_w_sb(args, j, lds, bid, G, wave, lane); } SEAM(pb + 9); TICK_OUT(9); } }
    { ARGS(); if (IN(pb + 10)) { TICK_IN(10); {
        pg8::Gemm g{(const bf16*)(args.ws + WS_HB), (const bf16*)(args.ws + W_QKV), D, D}; pg8::StaticOrder S; S.init(TT, 3072, G, bid, NREP(10));
        pg8::EpiBf16 E{(bf16*)(args.ws + WS_QKV), 3072, 0};
        pg8::gemm_phase<pg8::EpiBf16, pg8::StaticOrder, true, true>(lds, g, S, E);
        } SEAM(pb + 10); TICK_OUT(10); } }
    #if SB_NAIVE
    { ARGS(); if (IN(pb + 11)) { TICK_IN(11); _Pragma("unroll 1") for (int rep_ = 0; rep_ < NREP(11); ++rep_) { phase_sb_naive(args, lds, bid, G, tid); } SEAM(pb + 11); TICK_OUT(11); } }
#else
    { ARGS(); if (IN(pb + 11)) { TICK_IN(11); _Pragma("unroll 1") for (int rep_ = 0; rep_ < NREP(11); ++rep_) { phase_sb_mfma(args, lds, bid, G, tid); } SEAM(pb + 11); TICK_OUT(11); } }
#endif
    { ARGS(); if (IN(pb + 12)) { TICK_IN(12); {
        pg8::Gemm g{(const bf16*)(args.ws + WS_AO), (const bf16*)(args.ws + W_O), D, D}; pg8::StaticOrder S; S.init(TT, D, G, bid);
        pg8::EpiResid E{args.out, args.out, D, ALPHA};
        pg8::gemm_phase<pg8::EpiResid, pg8::StaticOrder, true, true>(lds, g, S, E);
        } SEAM(pb + 12); TICK_OUT(12); } }
    { ARGS(); if (IN(pb + 13)) { TICK_IN(13); _Pragma("unroll 1") for (int rep_ = 0; rep_ < NREP(13); ++rep_) { phase_ln<true>(args, (2 * j + 1) * 2 + 0, j, lds, bid, G, tid, wave, lane); } SEAM(pb + 13); TICK_OUT(13); } }
    { ARGS(); if (IN(pb + 14)) { TICK_IN(14); _Pragma("unroll 1") for (int rep_ = 0; rep_ < NREP(14); ++rep_) { phase_scatter(args, j, lds, bid, G, tid, wave, lane); } SEAM(pb + 14); TICK_OUT(14); } }
    { ARGS(); if (IN(pb + 15)) { TICK_IN(15); {
        unsigned off[9]; moe_offsets(args, j, off);
        pg8::MoeOrder S; S.nM = (int)(off[8] >> 8); S.G = G; S.c = bid; S.nN = 2 * FF / 256; S.nwg = S.nM * S.nN; S.rep = NREP(15);
        S.ps1 = (int)(off[1] >> 8); S.ps2 = (int)(off[2] >> 8); S.ps3 = (int)(off[3] >> 8); S.ps4 = (int)(off[4] >> 8); S.ps5 = (int)(off[5] >> 8); S.ps6 = (int)(off[6] >> 8); S.ps7 = (int)(off[7] >> 8);
        pg8::Gemm g{(const bf16*)(args.ws + WS_XS), (const bf16*)(args.ws + W_MGU), D, D};
        pg8::EpiSwiGLU E{(bf16*)(args.ws + WS_MACT), FF, 2 * FF / 256};
        pg8::gemm_phase<pg8::EpiSwiGLU, pg8::MoeOrder, true, true>(lds, g, S, E);
        } SEAM(pb + 15); TICK_OUT(15); } }
    { ARGS(); if (IN(pb + 16)) { TICK_IN(16); {
        unsigned off[9]; moe_offsets(args, j, off);
        pg8::MoeOrder S; S.nM = (int)(off[8] >> 8); S.G = G; S.c = bid; S.nN = D / 256; S.nwg = S.nM * S.nN; S.rep = NREP(16);
        S.ps1 = (int)(off[1] >> 8); S.ps2 = (int)(off[2] >> 8); S.ps3 = (int)(off[3] >> 8); S.ps4 = (int)(off[4] >> 8); S.ps5 = (int)(off[5] >> 8); S.ps6 = (int)(off[6] >> 8); S.ps7 = (int)(off[7] >> 8);
        pg8::Gemm g{(const bf16*)(args.ws + WS_MACT), (const bf16*)(args.ws + W_MD), FF, FF};
        pg8::EpiBf16 E{(bf16*)(args.ws + WS_XS), D, D / 256};
        pg8::gemm_phase<pg8::EpiBf16, pg8::MoeOrder, true, true>(lds, g, S, E);
        } SEAM(pb + 16); TICK_OUT(16); } }
    { ARGS(); if (IN(pb + 17)) { TICK_IN(17); _Pragma("unroll 1") for (int rep_ = 0; rep_ < NREP(17); ++rep_) { phase_combine_ln(args, (2 * j + 1) * 2 + 1, bid, G, wave, lane); } SEAM(pb + 17); TICK_OUT(17); } }
}
__global__ void __launch_bounds__(NWAVES * 64, 2) fwd(Args kargs) {
    extern __shared__ __attribute__((aligned(16))) unsigned char lds_raw[];
    LAS unsigned char* lds = (LAS unsigned char*)lds_raw;
    volatile LAS unsigned* MISC = (volatile LAS unsigned*)(lds + MISC_OFF);
    const int tid = threadIdx.x, lane = tid & 63, wave = __builtin_amdgcn_readfirstlane(tid >> 6), G = gridDim.x, bid = blockIdx.x;
    for (int u = tid; u < (LDS_BYTES - RING_BYTES) / 4; u += NWAVES * 64) ((LAS unsigned*)(lds + RING_BYTES))[u] = 0u;
    __syncthreads();
    if (tid == 0) { LAS unsigned long long* pa = (LAS unsigned long long*)(lds + ARGS_OFF);
        pa[0] = (unsigned long long)kargs.x; pa[1] = (unsigned long long)kargs.gdn_w_in; pa[2] = (unsigned long long)kargs.gdn_conv_w; pa[3] = (unsigned long long)kargs.gdn_a_log;
        pa[4] = (unsigned long long)kargs.gdn_dt_bias; pa[5] = (unsigned long long)kargs.gdn_norm_w; pa[6] = (unsigned long long)kargs.gdn_w_out; pa[7] = (unsigned long long)kargs.sb_w_in;
        pa[8] = (unsigned long long)kargs.sb_w_out; pa[9] = (unsigned long long)kargs.ffn_w_gate; pa[10] = (unsigned long long)kargs.ffn_w_up; pa[11] = (unsigned long long)kargs.ffn_w_down;
        pa[12] = (unsigned long long)kargs.moe_router; pa[13] = (unsigned long long)kargs.moe_w_gate; pa[14] = (unsigned long long)kargs.moe_w_up; pa[15] = (unsigned long long)kargs.moe_w_down;
        pa[16] = (unsigned long long)kargs.ln_g; pa[17] = (unsigned long long)kargs.ln_b; pa[18] = (unsigned long long)kargs.out; pa[19] = (unsigned long long)kargs.ws;
        pa[20] = (unsigned long long)(unsigned)kargs.ph_lo | ((unsigned long long)(unsigned)kargs.ph_hi << 32); }
    XcdBarrier bar = xcd_barrier_post((unsigned*)(kargs.ws + WS_CTL) + CW_BAR, MISC + 8);
    __syncthreads();
    layer_pair<0>(lds, bar, wave, G, bid);
    layer_pair<1>(lds, bar, wave, G, bid);
    if (PROBE_DELAY_MASK) { if (bid == 0 && threadIdx.x == 0) { const unsigned acc = ((volatile LAS unsigned*)(lds + MISC_OFF))[20] * PROBE_DELAY_MULT; const unsigned long long t0 = __builtin_amdgcn_s_memrealtime(); while ((unsigned)(__builtin_amdgcn_s_memrealtime() - t0) < acc) __builtin_amdgcn_s_sleep(8); } }
}
#undef IN
#undef SEAM
#undef ARGS

extern "C" void kernel_launch(void* const* d_in, const int* in_sizes, int n_in, void* d_out, int out_size, void* d_ws, size_t ws_size, hipStream_t stream) {
    static int grid = 0;
    if (grid == 0) {
        if (n_in != 18 || in_sizes[0] != TT * D || out_size != TT * D || ws_size < WS_END + 32 * MiB) { fprintf(stderr, "kernel_launch: unexpected shapes (n_in %d, in0 %d, out %d, ws %zu); nothing launched\n", n_in, n_in > 0 ? in_sizes[0] : -1, out_size, ws_size); grid = -1; return; }
        int dev = 0, cus = 0, per_cu = 0;
        if (hipGetDevice(&dev) != hipSuccess || hipDeviceGetAttribute(&cus, hipDeviceAttributeMultiprocessorCount, dev) != hipSuccess) { grid = -1; return; }
        if (hipFuncSetAttribute((const void*)fwd, hipFuncAttributeMaxDynamicSharedMemorySize, LDS_BYTES) != hipSuccess) { fprintf(stderr, "kernel_launch: hipFuncSetAttribute failed\n"); grid = -1; return; }
        if (hipOccupancyMaxActiveBlocksPerMultiprocessor(&per_cu, (const void*)fwd, NWAVES * 64, LDS_BYTES) != hipSuccess || per_cu < 1) { fprintf(stderr, "kernel_launch: occupancy query says %d blocks per CU\n", per_cu); (void)hipGetLastError(); grid = -1; return; }
        grid = cus;
    }
    if (grid < 0) return;
    if (hipMemsetAsync((char*)d_ws + WS_CTL, 0, CTL_ZERO_BYTES, stream) != hipSuccess) return;
    Args a{};
    a.x = (const float*)d_in[0]; a.gdn_w_in = (const float*)d_in[1]; a.gdn_conv_w = (const float*)d_in[2]; a.gdn_a_log = (const float*)d_in[3]; a.gdn_dt_bias = (const float*)d_in[4];
    a.gdn_norm_w = (const float*)d_in[5]; a.gdn_w_out = (const float*)d_in[6]; a.sb_w_in = (const float*)d_in[7]; a.sb_w_out = (const float*)d_in[8];
    a.ffn_w_gate = (const float*)d_in[9]; a.ffn_w_up = (const float*)d_in[10]; a.ffn_w_down = (const float*)d_in[11]; a.moe_router = (const float*)d_in[12];
    a.moe_w_gate = (const float*)d_in[13]; a.moe_w_up = (const float*)d_in[14]; a.moe_w_down = (const float*)d_in[15]; a.ln_g = (const float*)d_in[16]; a.ln_b = (const float*)d_in[17];
    a.out = (float*)d_out; a.ws = (unsigned char*)d_ws;
#if MK_ONE_LAUNCH
    a.ph_lo = 0; a.ph_hi = NPHASES;
    hipLaunchKernelGGL(fwd, dim3(grid), dim3(NWAVES * 64), LDS_BYTES, stream, a);
#else
    for (int p = 0; p < NPHASES; ++p) { a.ph_lo = p; a.ph_hi = p + 1; hipLaunchKernelGGL(fwd, dim3(grid), dim3(NWAVES * 64), LDS_BYTES, stream, a); }
#endif
}
```

```cpp
#include <hip/hip_runtime.h>
#include <cstdio>
#include <cstdint>
#ifndef GDN_NAIVE
#define GDN_NAIVE 0
#endif
#ifndef SB_NAIVE
#define SB_NAIVE 0
#endif
#ifndef MK_ONE_LAUNCH
#define MK_ONE_LAUNCH 1
#endif
namespace pg8 {
#define PG8_LAS __attribute__((address_space(3)))
typedef unsigned short bf16_t;
typedef short bf16x8 __attribute__((ext_vector_type(8)));
typedef float f32x4 __attribute__((ext_vector_type(4)));
typedef unsigned u32x4 __attribute__((ext_vector_type(4)));
constexpr int BM = 256, BK = 64, HALF = 128, HTB = HALF * BK * 2  , STAGE_BYTES = 8 * HTB, NXCD = 8, WGM = 8;

__host__ __device__ __forceinline__ int lds_byte(int r, int c) { const int st = (r >> 4) * 2 + (c >> 5), rr = r & 15, cc = c & 31, ob = rr * 64 + cc * 2; return st * 1024 + (ob ^ (((ob >> 9) & 1) << 5)); }
__host__ __device__ __forceinline__ void stage_rc(int b, int& R, int& C) { const int st = b / 1024, sb = b % 1024, swz = sb ^ (((sb >> 9) & 1) << 5); R = (st >> 1) * 16 + swz / 64; C = (st & 1) * 32 + (swz % 64) / 2; }
__host__ __device__ __forceinline__ int perm32(int rho) { const int n = rho >> 4, i = rho & 15; return 8 * (i >> 2) + 4 * n + (i & 3); }

struct Unit { int pm, pn; };
struct Gemm { const bf16_t* A; const bf16_t* Bt; int lda, K; };

struct StaticOrder {
    int nM, nN, nwg, G, c, rep;
    __host__ __device__ void init(int M, int N, int G_, int c_, int rep_ = 1) { nM = M / BM; nN = N / BM; nwg = nM * nN; G = G_; c = c_; rep = rep_; }
    __host__ __device__ bool next(int i, Unit& u) const {
        const long L = (long)i * G + c; if (L >= (long)rep * nwg) return false;
        int wgid = (int)(L % nwg); { const int q = nwg / NXCD, r = nwg % NXCD, xcd = wgid % NXCD, off = wgid / NXCD; wgid = (xcd < r ? xcd * (q + 1) : r * (q + 1) + (xcd - r) * q) + off; }
        const int nig = WGM * nN, gid = wgid / nig, fm = gid * WGM, gsz = (nM - fm) < WGM ? (nM - fm) : WGM;
        u.pm = fm + ((wgid % nig) % gsz); u.pn = (wgid % nig) / gsz; return true;
    }
    __device__ __forceinline__ void a_ready(const Unit&) const {}
    __device__ __forceinline__ void done(const Unit&) const {}
};

__device__ __forceinline__ unsigned cvt_pk_bf16(float lo, float hi) { unsigned r; asm volatile("v_cvt_pk_bf16_f32 %0, %1, %2" : "=v"(r) : "v"(lo), "v"(hi)); return r; }
struct EpiBf16 {
    static constexpr bool PERM = true, AFTER_DRAIN = false;
    bf16_t* O; int ldc; int nmod;
    __device__ __forceinline__ void operator()(const f32x4 (&acc)[2][2][4][2], const Unit& u, int wr, int wc, int fr, int fq) const {
        const int pnl = nmod ? (u.pn % nmod) : u.pn;
        const int row0 = u.pm * BM + wr * 64 + fr, col0 = pnl * BM + wc * 32 + 8 * fq;
#pragma unroll
        for (int ai = 0; ai < 2; ++ai)
#pragma unroll
            for (int m = 0; m < 4; ++m) { bf16_t* rowp = O + (size_t)(row0 + ai * HALF + m * 16) * ldc + col0;
#pragma unroll
                for (int bj = 0; bj < 2; ++bj) { const f32x4 v0 = acc[ai][bj][m][0], v1 = acc[ai][bj][m][1];
                    u32x4 w; w.x = cvt_pk_bf16(v0[0], v0[1]); w.y = cvt_pk_bf16(v0[2], v0[3]); w.z = cvt_pk_bf16(v1[0], v1[1]); w.w = cvt_pk_bf16(v1[2], v1[3]);
                    *(u32x4*)(rowp + bj * HALF) = w; } }
    }
};
struct EpiInProj {
    static constexpr bool PERM = true, AFTER_DRAIN = false;
    bf16_t* RAW; bf16_t* ZB;
    __device__ __forceinline__ void operator()(const f32x4 (&acc)[2][2][4][2], const Unit& u, int wr, int wc, int fr, int fq) const {
        const bool isz = (u.pn >= 16 && u.pn < 24);
        bf16_t* O = isz ? ZB : RAW; const int ldc = isz ? 2048 : 4352; const int ct = isz ? (u.pn - 16) : (u.pn < 16 ? u.pn : 16);
        const int row0 = u.pm * BM + wr * 64 + fr, col0 = ct * BM + wc * 32 + 8 * fq;
#pragma unroll
        for (int ai = 0; ai < 2; ++ai)
#pragma unroll
            for (int m = 0; m < 4; ++m) { bf16_t* rowp = O + (size_t)(row0 + ai * HALF + m * 16) * ldc + col0;
#pragma unroll
                for (int bj = 0; bj < 2; ++bj) { const f32x4 v0 = acc[ai][bj][m][0], v1 = acc[ai][bj][m][1];
                    u32x4 w; w.x = cvt_pk_bf16(v0[0], v0[1]); w.y = cvt_pk_bf16(v0[2], v0[3]); w.z = cvt_pk_bf16(v1[0], v1[1]); w.w = cvt_pk_bf16(v1[2], v1[3]);
                    *(u32x4*)(rowp + bj * HALF) = w; } }
    }
};
__device__ __forceinline__ float silu_f(float x) { return x * __builtin_amdgcn_rcpf(1.0f + __builtin_amdgcn_exp2f(-1.4426950408889634f * x)); }
struct EpiSwiGLU {
    static constexpr bool PERM = true, AFTER_DRAIN = false;
    bf16_t* O; int ldc; int nmod;
    __device__ __forceinline__ void operator()(const f32x4 (&acc)[2][2][4][2], const Unit& u, int wr, int wc, int fr, int fq) const {
        const int pnl = nmod ? (u.pn % nmod) : u.pn;
        const int row0 = u.pm * BM + wr * 64 + fr, col0 = pnl * HALF + wc * 32 + 8 * fq;
#pragma unroll
        for (int ai = 0; ai < 2; ++ai)
#pragma unroll
            for (int m = 0; m < 4; ++m) { bf16_t* rowp = O + (size_t)(row0 + ai * HALF + m * 16) * ldc + col0;
                const f32x4 g0 = acc[ai][0][m][0], g1 = acc[ai][0][m][1], u0 = acc[ai][1][m][0], u1 = acc[ai][1][m][1];
                u32x4 w;
                w.x = cvt_pk_bf16(silu_f(g0[0]) * u0[0], silu_f(g0[1]) * u0[1]); w.y = cvt_pk_bf16(silu_f(g0[2]) * u0[2], silu_f(g0[3]) * u0[3]);
                w.z = cvt_pk_bf16(silu_f(g1[0]) * u1[0], silu_f(g1[1]) * u1[1]); w.w = cvt_pk_bf16(silu_f(g1[2]) * u1[2], silu_f(g1[3]) * u1[3]);
                *(u32x4*)rowp = w; }
    }
};
struct EpiResid {
    static constexpr bool PERM = false, AFTER_DRAIN = false;
    const float* res; float* out; int ldc; float alpha;
    __device__ __forceinline__ void operator()(const f32x4 (&acc)[2][2][4][2], const Unit& u, int wr, int wc, int fr, int fq) const {
        const int row0 = u.pm * BM + wr * 64 + fr, col0 = u.pn * BM + wc * 32 + 4 * fq;
#pragma unroll
        for (int ai = 0; ai < 2; ++ai)
#pragma unroll
            for (int m = 0; m < 4; ++m) { const size_t off = (size_t)(row0 + ai * HALF + m * 16) * ldc + col0;
#pragma unroll
                for (int bj = 0; bj < 2; ++bj)
#pragma unroll
                    for (int n = 0; n < 2; ++n) { const f32x4 r = *(const f32x4*)(res + off + bj * HALF + n * 16);
                        *(f32x4*)(out + off + bj * HALF + n * 16) = r * alpha + acc[ai][bj][m][n]; } }
    }
};
struct MoeOrder {
    int nM, nN, nwg, G, c, rep; int ps1, ps2, ps3, ps4, ps5, ps6, ps7;
    __device__ __forceinline__ bool next(int i, Unit& u) const {
        const long L = (long)i * G + c; if (nwg == 0 || L >= (long)rep * nwg) return false;
        int wgid = (int)(L % nwg); { const int q = nwg / NXCD, r = nwg % NXCD, xcd = wgid % NXCD, off = wgid / NXCD; wgid = (xcd < r ? xcd * (q + 1) : r * (q + 1) + (xcd - r) * q) + off; }
        const int nig = WGM * nN, gid = wgid / nig, fm = gid * WGM, gsz = (nM - fm) < WGM ? (nM - fm) : WGM;
        const int pm = fm + ((wgid % nig) % gsz), pnl = (wgid % nig) / gsz;
        const int e = (pm >= ps1) + (pm >= ps2) + (pm >= ps3) + (pm >= ps4) + (pm >= ps5) + (pm >= ps6) + (pm >= ps7);
        u.pm = pm; u.pn = e * nN + pnl; return true;
    }
    __device__ __forceinline__ void a_ready(const Unit&) const {}
    __device__ __forceinline__ void done(const Unit&) const {}
};
template <class Epi, class Sched, bool ALIGN_EPI = false, bool SP2 = false>
__device__ __forceinline__ void gemm_phase(PG8_LAS unsigned char* lds, const Gemm g, const Sched& S, const Epi& E) {
    const int tid = threadIdx.x, wid = __builtin_amdgcn_readfirstlane(tid >> 6), lane = tid & 63, wr = wid >> 2, wc = wid & 3, fr = lane & 15, fq = lane >> 4;
    const int K = g.K, nt = K / BK;
    unsigned voffA[2], voffB[2];
#pragma unroll
    for (int i = 0; i < 2; ++i) { int R, C; stage_rc(tid * 16 + i * 8192, R, C); const int Rb = Epi::PERM ? ((R & ~31) + perm32(R & 31)) : R;
        voffA[i] = (unsigned)(R * g.lda + C) * 2u; voffB[i] = (unsigned)(Rb * K + C) * 2u; }
    const size_t kstep = (size_t)(BK * 2);
    const size_t hstepA = (size_t)HALF * g.lda * 2, hstepB = (size_t)HALF * K * 2;
    const size_t tstepA = 2 * hstepA, tstepB = 2 * hstepB;
    const unsigned ldsw = (unsigned)wid * 1024u;
    const int aoff = lds_byte(wr * 64 + fr, fq * 8), boff = lds_byte(wc * 32 + fr, fq * 8);
#define PG8_SA(b, h) (((b) * 2 + (h)) * HTB)
#define PG8_SB(b, h) ((4 + (b) * 2 + (h)) * HTB)
#define PG8_STAGE(bufoff, gbase, voff) do { _Pragma("unroll") for (int _i = 0; _i < 2; ++_i) \
        __builtin_amdgcn_global_load_lds((const unsigned*)((const char*)(gbase) + (voff)[_i]), (PG8_LAS unsigned*)(lds + (bufoff) + ldsw + _i * 8192), 16, 0, 0); } while (0)
#define PG8_LDA(dst, b, h) do { _Pragma("unroll") for (int m = 0; m < 4; ++m) _Pragma("unroll") for (int k = 0; k < 2; ++k) dst[m][k] = *(const PG8_LAS bf16x8*)(lds + PG8_SA(b, h) + aoff + m * 2048 + k * 1024); } while (0)
#define PG8_LDB(dst, b, h) do { _Pragma("unroll") for (int n = 0; n < 2; ++n) _Pragma("unroll") for (int k = 0; k < 2; ++k) dst[n][k] = *(const PG8_LAS bf16x8*)(lds + PG8_SB(b, h) + boff + n * 2048 + k * 1024); } while (0)
#define PG8_MMA(ai, bj, At, Bt) do { __builtin_amdgcn_s_setprio(1); _Pragma("unroll") for (int m = 0; m < 4; ++m) _Pragma("unroll") for (int n = 0; n < 2; ++n) _Pragma("unroll") for (int k = 0; k < 2; ++k) \
        acc[ai][bj][m][n] = __builtin_amdgcn_mfma_f32_16x16x32_bf16(Bt[n][k], At[m][k], acc[ai][bj][m][n], 0, 0, 0); __builtin_amdgcn_s_setprio(0); } while (0)
#define PG8_WAIT_V(n) asm volatile("s_waitcnt vmcnt(" #n ")" ::: "memory")
#define PG8_WAIT_L(n) asm volatile("s_waitcnt lgkmcnt(" #n ")" ::: "memory")
#define PG8_BAR __builtin_amdgcn_s_barrier()
#define PG8_SCHED __builtin_amdgcn_sched_barrier(0)
    Unit cur, nxt; int ui = 0;
    if (!S.next(0, cur)) return;
    f32x4 acc[2][2][4][2];
#pragma unroll
    for (int a = 0; a < 2; ++a)
#pragma unroll
        for (int b = 0; b < 2; ++b)
#pragma unroll
            for (int m = 0; m < 4; ++m)
#pragma unroll
                for (int n = 0; n < 2; ++n) acc[a][b][m][n] = (f32x4){0.f, 0.f, 0.f, 0.f};
    bf16x8 At[4][2], B0[2][2], B1[2][2];
    const char* cA = (const char*)g.A + (size_t)cur.pm * tstepA; const char* cB = (const char*)g.Bt + (size_t)cur.pn * tstepB;
    S.a_ready(cur);
    if constexpr (SP2) {
        PG8_STAGE(PG8_SB(0, 0), cB, voffB); PG8_STAGE(PG8_SB(0, 1), cB + hstepB, voffB); PG8_STAGE(PG8_SA(0, 0), cA, voffA); PG8_STAGE(PG8_SA(0, 1), cA + hstepA, voffA);
        if (wr == 1) PG8_BAR;
        PG8_WAIT_V(2); PG8_BAR;
        PG8_STAGE(PG8_SB(1, 0), cB + kstep, voffB); PG8_STAGE(PG8_SA(1, 0), cA + kstep, voffA); PG8_STAGE(PG8_SB(1, 1), cB + hstepB + kstep, voffB);
        PG8_WAIT_V(6); PG8_BAR;
    } else {
        PG8_STAGE(PG8_SB(0, 0), cB, voffB); PG8_STAGE(PG8_SA(0, 0), cA, voffA); PG8_STAGE(PG8_SB(0, 1), cB + hstepB, voffB); PG8_STAGE(PG8_SA(0, 1), cA + hstepA, voffA);
        if (wr == 1) PG8_BAR;
        PG8_WAIT_V(4); PG8_BAR;
        PG8_STAGE(PG8_SB(1, 0), cB + kstep, voffB); PG8_STAGE(PG8_SA(1, 0), cA + kstep, voffA); PG8_STAGE(PG8_SB(1, 1), cB + hstepB + kstep, voffB);
        PG8_WAIT_V(6); PG8_BAR;
    }
    for (;;) {
        const bool has_next = S.next(ui + 1, nxt);
        const char* nA = has_next ? (const char*)g.A + (size_t)nxt.pm * tstepA : cA; const char* nB = has_next ? (const char*)g.Bt + (size_t)nxt.pn * tstepB : cB;
        for (int t = 0; t < nt; t += 2) {
            const bool last = (t == nt - 2);
            const char* a1 = cA + (size_t)(t + 1) * kstep;
            const char* a2 = last ? nA : cA + (size_t)(t + 2) * kstep; const char* b2 = last ? nB : cB + (size_t)(t + 2) * kstep;
            const char* a3 = a2 + kstep; const char* b3 = b2 + kstep;
            if (last && has_next) S.a_ready(nxt);
            if constexpr (SP2) {
            PG8_LDB(B0, 0, 0); PG8_LDB(B1, 0, 1); PG8_SCHED; PG8_LDA(At, 0, 0); PG8_STAGE(PG8_SA(1, 1), a1 + hstepA, voffA);
            PG8_WAIT_V(8); PG8_WAIT_L(0); PG8_BAR; PG8_MMA(0, 0, At, B0); PG8_MMA(0, 1, At, B1); PG8_BAR; PG8_SCHED;
            PG8_LDA(At, 0, 1); PG8_STAGE(PG8_SB(0, 0), b2, voffB); PG8_STAGE(PG8_SB(0, 1), b2 + hstepB, voffB); PG8_STAGE(PG8_SA(0, 0), a2, voffA);
            PG8_WAIT_V(8); PG8_WAIT_L(0); PG8_BAR; PG8_MMA(1, 0, At, B0); PG8_MMA(1, 1, At, B1); PG8_BAR; PG8_SCHED;
            PG8_LDB(B0, 1, 0); PG8_LDB(B1, 1, 1); PG8_SCHED; PG8_LDA(At, 1, 0); PG8_STAGE(PG8_SA(0, 1), a2 + hstepA, voffA);
            PG8_WAIT_V(8); PG8_WAIT_L(0); PG8_BAR; PG8_MMA(0, 0, At, B0); PG8_MMA(0, 1, At, B1); PG8_BAR; PG8_SCHED;
            PG8_LDA(At, 1, 1); PG8_STAGE(PG8_SB(1, 0), b3, voffB); PG8_STAGE(PG8_SB(1, 1), b3 + hstepB, voffB); PG8_STAGE(PG8_SA(1, 0), a3, voffA);
            PG8_WAIT_V(8); PG8_WAIT_L(0); PG8_BAR; PG8_MMA(1, 0, At, B0); PG8_MMA(1, 1, At, B1); PG8_BAR; PG8_SCHED;
            } else {
            PG8_LDB(B0, 0, 0); PG8_SCHED; PG8_LDA(At, 0, 0); PG8_STAGE(PG8_SA(1, 1), a1 + hstepA, voffA);
            PG8_WAIT_L(8); PG8_BAR; PG8_WAIT_L(0); PG8_MMA(0, 0, At, B0); PG8_BAR; PG8_SCHED;
            PG8_LDB(B1, 0, 1); PG8_STAGE(PG8_SB(0, 0), b2, voffB);
            PG8_BAR; PG8_WAIT_L(0); PG8_MMA(0, 1, At, B1); PG8_BAR;
            PG8_LDA(At, 0, 1); PG8_STAGE(PG8_SA(0, 0), a2, voffA);
            PG8_BAR; PG8_WAIT_L(0); PG8_MMA(1, 0, At, B0); PG8_BAR; PG8_SCHED;
            PG8_STAGE(PG8_SB(0, 1), b2 + hstepB, voffB);
            PG8_WAIT_V(6); PG8_BAR; PG8_MMA(1, 1, At, B1); PG8_BAR;
            PG8_LDB(B0, 1, 0); PG8_SCHED; PG8_LDA(At, 1, 0); PG8_STAGE(PG8_SA(0, 1), a2 + hstepA, voffA);
            PG8_WAIT_L(8); PG8_BAR; PG8_WAIT_L(0); PG8_MMA(0, 0, At, B0); PG8_BAR; PG8_SCHED;
            PG8_LDB(B1, 1, 1); PG8_STAGE(PG8_SB(1, 0), b3, voffB);
            PG8_BAR; PG8_WAIT_L(0); PG8_MMA(0, 1, At, B1); PG8_BAR;
            PG8_LDA(At, 1, 1); PG8_STAGE(PG8_SA(1, 0), a3, voffA);
            PG8_BAR; PG8_WAIT_L(0); PG8_MMA(1, 0, At, B0); PG8_BAR; PG8_SCHED;
            PG8_STAGE(PG8_SB(1, 1), b3 + hstepB, voffB);
            PG8_WAIT_V(6); PG8_BAR; PG8_MMA(1, 1, At, B1); PG8_BAR;
            }
        }
        if constexpr (ALIGN_EPI) { if (wr == 0) PG8_BAR; }
        if constexpr (!Epi::AFTER_DRAIN) { E(acc, cur, wr, wc, fr, fq); S.done(cur); }
        if (!has_next) break;
#pragma unroll
        for (int a = 0; a < 2; ++a)
#pragma unroll
            for (int b = 0; b < 2; ++b)
#pragma unroll
                for (int m = 0; m < 4; ++m)
#pragma unroll
                    for (int n = 0; n < 2; ++n) acc[a][b][m][n] = (f32x4){0.f, 0.f, 0.f, 0.f};
        cur = nxt; cA = nA; cB = nB; ++ui;
        if constexpr (ALIGN_EPI) { if (wr == 1) PG8_BAR; }
    }
    PG8_WAIT_V(0);
    if constexpr (!ALIGN_EPI) { if (wr == 0) PG8_BAR; }
    PG8_BAR;
    if constexpr (Epi::AFTER_DRAIN) { E.fused(acc, cur, wr, wc, fr, fq, lds, wid, lane); S.done(cur); }
#undef PG8_SA
#undef PG8_SB
#undef PG8_STAGE
#undef PG8_LDA
#undef PG8_LDB
#undef PG8_MMA
#undef PG8_WAIT_V
#undef PG8_WAIT_L
#undef PG8_BAR
#undef PG8_SCHED
}
}

constexpr int NWAVES = 8;
constexpr int BATCH = 8, SEQ = 4096, TT = BATCH * SEQ, D = 1024;
constexpr int HK = 8, HV = 16, HD = 128;
constexpr int GIN = 6176, GINP = 6400;
constexpr int FF = 3584, NE = 8, MOE_ROWS = 67584;
constexpr float ALPHA = 1.6817928305074290f;
constexpr float LN_EPS = 1e-5f, RMS_EPS = 1e-6f;
constexpr int NPH = 18, NPHASES = 2 * NPH;

constexpr size_t MiB = 1ull << 20;
constexpr size_t WS_CTL = 0, CTL_ZERO_BYTES = 1 * MiB;
constexpr size_t WS_E12 = 1 * MiB;
constexpr size_t WS_G12 = WS_E12 + 256 * 1024;
constexpr size_t WS_POS = WS_G12 + 256 * 1024;
constexpr size_t WS_GB = 2 * MiB;
constexpr size_t WS_W = 16 * MiB;
constexpr size_t W_IN = WS_W, W_OUT = WS_W + 13 * MiB, W_GU = WS_W + 17 * MiB, W_D = WS_W + 31 * MiB;
constexpr size_t W_QKV = WS_W, W_O = WS_W + 6 * MiB, W_MGU = WS_W + 8 * MiB, W_MD = WS_W + 120 * MiB;
constexpr size_t WS_HB = 192 * MiB;
constexpr size_t WS_BIG = 256 * MiB;
constexpr size_t WS_ZB = WS_BIG, WS_RAW = WS_BIG + 128 * MiB, WS_QKVC = WS_BIG + 400 * MiB;
constexpr int RAWLD = 4352;
constexpr size_t WS_WMEM = WS_RAW, WS_IMEM = WS_RAW + 128 * MiB, WS_KTMEM = WS_RAW + 192 * MiB;
constexpr size_t WS_GTAB = 6 * MiB;
constexpr size_t WS_ACT = WS_BIG;
constexpr size_t WS_QKV = WS_BIG, WS_AO = WS_BIG + 192 * MiB;
constexpr size_t WS_XS = WS_BIG, WS_MACT = WS_BIG + 132 * MiB;
constexpr size_t WS_END = 912 * MiB;
static_assert(WS_QKVC + (size_t)TT * 4096 * 2 <= WS_END && WS_MACT + (size_t)MOE_ROWS * FF * 2 <= WS_END && WS_RAW + (size_t)TT * RAWLD * 2 <= WS_QKVC && WS_KTMEM + (size_t)4096 * 8192 * 2 <= WS_QKVC && WS_GTAB + (size_t)8192 * 192 * 4 <= WS_W, "d_ws map");
static_assert(W_MD + (size_t)NE * D * FF * 2 <= WS_HB && W_IN + (size_t)GINP * D * 2 <= W_OUT && W_MGU + (size_t)NE * 2 * FF * D * 2 <= W_MD, "weight map");
constexpr int CW_BAR = 4096;
constexpr int CW_CNT = 16384;

constexpr int RING_BYTES = 131072;
constexpr int MISC_OFF = RING_BYTES + 320;
constexpr int OGST_OFF = 147456;
constexpr int LDS_BYTES = 163840;

#define GAS __attribute__((address_space(1)))
#define LAS __attribute__((address_space(3)))
#define DI __device__ __forceinline__
typedef unsigned short bf16;
typedef unsigned v4u __attribute__((ext_vector_type(4)));
typedef unsigned v2u __attribute__((ext_vector_type(2)));
typedef float f32x4 __attribute__((ext_vector_type(4)));
typedef float f32x2 __attribute__((ext_vector_type(2)));
typedef GAS unsigned gu32;
#define RLX_AGENT __ATOMIC_RELAXED, __HIP_MEMORY_SCOPE_AGENT
#define LDS_WAIT() asm volatile("s_waitcnt lgkmcnt(0)" ::: "memory")
#define VM_WAIT() asm volatile("s_waitcnt vmcnt(0)" ::: "memory")
__device__ __forceinline__ unsigned long long rt() { return __builtin_amdgcn_s_memrealtime(); }
__device__ __forceinline__ unsigned f2bf(float f) { unsigned u = __builtin_bit_cast(unsigned, f); return (u + 0x7fffu + ((u >> 16) & 1u)) >> 16; }
__device__ __forceinline__ unsigned pk2(float lo, float hi) { return f2bf(lo) | (f2bf(hi) << 16); }

#define XB_TMO      128
#define XB_XCNT(j)  (256  + 64 * (j))
#define XB_XSUB(j)  (1280 + 64 * (j))
#define XB_XGEN(j)  (2304 + 64 * (j))
#define XB_TOP      3328
#define XB_TOPGEN   3392
#define XCD_BAR_WORDS 3456
#define XB_SPIN_CAP (1u << 22)

__device__ __forceinline__ unsigned xb_ld(unsigned* p)              { return __hip_atomic_load(p, __ATOMIC_RELAXED, __HIP_MEMORY_SCOPE_AGENT); }
__device__ __forceinline__ unsigned xb_add(unsigned* p, unsigned v) { return __hip_atomic_fetch_add(p, v, __ATOMIC_RELAXED, __HIP_MEMORY_SCOPE_AGENT); }
__device__ __forceinline__ unsigned xb_xcc_id() { return (unsigned)__builtin_amdgcn_s_getreg((3 << 11) | 20) & 0xFu; }
#define XB_SPIN(cond, bar) do { unsigned _sp = 0; while (cond) { __builtin_amdgcn_s_sleep(1); \
    if ((++_sp & 255u) == 0u) { if (xb_ld(&(bar)[XB_TMO])) break; if (_sp > XB_SPIN_CAP) { atomicAdd(&(bar)[XB_TMO], 1u); break; } } } } while (0)

struct XcdBarrier {
    unsigned* bar; unsigned x;
    volatile LAS unsigned* st;
};

__device__ __forceinline__ XcdBarrier xcd_barrier_post(unsigned* bar, volatile LAS unsigned* st) {
    XcdBarrier b; b.bar = bar; b.x = xb_xcc_id(); b.st = st;
    if (threadIdx.x == 0) (void)xb_add(&bar[XB_XCNT(b.x)], 1u);
    return b;
}
__device__ __forceinline__ void xcd_barrier_complete(unsigned* bar, unsigned x, unsigned& nloc, unsigned& nx) {
    const unsigned G = gridDim.x * gridDim.y * gridDim.z;
    unsigned sum, cnt, mine, sp = 0u;
    for (;;) {
        sum = 0u; cnt = 0u; mine = 0u;
#pragma unroll
        for (unsigned j = 0; j < 16; ++j) { const unsigned c = xb_ld(&bar[XB_XCNT(j)]); sum += c; cnt += (c > 0u) ? 1u : 0u; mine = (j == x) ? c : mine; }
        if (sum == G) break;
        __builtin_amdgcn_s_sleep(1);
        if ((++sp & 255u) == 0u) { if (xb_ld(&bar[XB_TMO])) break; if (sp > XB_SPIN_CAP) { atomicAdd(&bar[XB_TMO], 1u); break; } }
    }
    nloc = mine > 0u ? mine : 1u; nx = cnt > 0u ? cnt : 1u;
}

__device__ __forceinline__ void xcd_barrier(const XcdBarrier& b) {
    asm volatile("s_waitcnt vmcnt(0)" ::: "memory");
    __syncthreads();
    if (threadIdx.x == 0) {
        unsigned* bar = b.bar;
        __builtin_amdgcn_s_waitcnt(0);
        unsigned nloc = b.st[0], nx = b.st[1];
        if (nloc == 0u) { xcd_barrier_complete(bar, b.x, nloc, nx); b.st[0] = nloc; b.st[1] = nx; }
        const unsigned old = xb_add(&bar[XB_XSUB(b.x)], 1u);
        const unsigned gen = old / nloc;
        if (old + 1u == (gen + 1u) * nloc) {
            __builtin_amdgcn_fence(__ATOMIC_RELEASE, "agent");
            asm volatile("s_waitcnt vmcnt(0)" ::: "memory");
            const unsigned og = xb_add(&bar[XB_TOP], 1u);
            const unsigned tg = og / nx;
            if (og + 1u == (tg + 1u) * nx) xb_add(&bar[XB_TOPGEN], 1u);
            else XB_SPIN(xb_ld(&bar[XB_TOPGEN]) == tg, bar);
            __builtin_amdgcn_fence(__ATOMIC_ACQUIRE, "agent");
            xb_add(&bar[XB_XGEN(b.x)], 1u);
            asm volatile("s_waitcnt vmcnt(0)" ::: "memory");
        } else {
            XB_SPIN(xb_ld(&bar[XB_XGEN(b.x)]) == gen, bar);
            __builtin_amdgcn_fence(__ATOMIC_ACQUIRE, "agent");
            asm volatile("s_waitcnt vmcnt(0)" ::: "memory");
        }
    }
    __syncthreads();
}

DI float bf_lo(unsigned w) { return __uint_as_float(w << 16); }
DI float bf_hi(unsigned w) { return __uint_as_float(w & 0xffff0000u); }
DI float wave_sum(float v) {
#pragma unroll
    for (int o = 1; o < 64; o <<= 1) v += __shfl_xor(v, o);
    return v;
}
DI float sigmoid_f(float x) { return 1.0f / (1.0f + __expf(-x)); }

struct Args {
    const float *x, *gdn_w_in, *gdn_conv_w, *gdn_a_log, *gdn_dt_bias, *gdn_norm_w, *gdn_w_out, *sb_w_in, *sb_w_out, *ffn_w_gate, *ffn_w_up, *ffn_w_down,
                *moe_router, *moe_w_gate, *moe_w_up, *moe_w_down, *ln_g, *ln_b;
    float* out; unsigned char* ws; int ph_lo, ph_hi;
};

DI void transpose_item(const float* W, int ldw, bf16* WT, int K, int drow0, int k0, int n0, LAS float* scr, int lane) {
#pragma unroll 8
    for (int i = 0; i < 32; ++i) { const int kk = 2 * i + (lane >> 5); scr[kk * 33 + (lane & 31)] = W[(size_t)(k0 + kk) * ldw + n0 + (lane & 31)]; }
    LDS_WAIT(); asm volatile("" ::: "memory");
    const int c = lane & 7;
#pragma unroll
    for (int jj = 0; jj < 4; ++jj) { const int n = (lane >> 3) + 8 * jj; const LAS float* s = scr + (8 * c) * 33 + n;
        v4u o; o.x = pk2(s[0 * 33], s[1 * 33]); o.y = pk2(s[2 * 33], s[3 * 33]); o.z = pk2(s[4 * 33], s[5 * 33]); o.w = pk2(s[6 * 33], s[7 * 33]);
        *(v4u*)(WT + (size_t)(drow0 + n) * K + k0 + 8 * c) = o; }
    LDS_WAIT(); asm volatile("" ::: "memory");
}

DI void phase_w_gdn(const Args& a, int j, LAS unsigned char* lds, int bid, int G, int tid, int wave, int lane) {
    LAS float* scr = (LAS float*)(lds + wave * 16384);
    const int gw = bid * NWAVES + wave, NGW = G * NWAVES;
    const float* Win = a.gdn_w_in + (size_t)j * D * GIN; const float* Wout = a.gdn_w_out + (size_t)j * 2048 * D;
    const float* Wg = a.ffn_w_gate + (size_t)j * D * FF; const float* Wu = a.ffn_w_up + (size_t)j * D * FF; const float* Wd = a.ffn_w_down + (size_t)j * FF * D;
    bf16* WIN_T = (bf16*)(a.ws + W_IN); bf16* WOUT_T = (bf16*)(a.ws + W_OUT); bf16* WGU_T = (bf16*)(a.ws + W_GU); bf16* WD_T = (bf16*)(a.ws + W_D);
    constexpr int NB_IN = GIN / 32, I_IN = 16 * NB_IN, I_OUT = 32 * 32, I_G = 16 * 112, I_D = 56 * 32, NIT = I_IN + I_OUT + 2 * I_G + I_D;
    for (int it = gw; it < NIT; it += NGW) {
        int r = it;
        if (r < I_IN) { const int kb = r / NB_IN, nb = r % NB_IN; transpose_item(Win, GIN, WIN_T, D, 32 * nb, 64 * kb, 32 * nb, scr, lane); continue; } r -= I_IN;
        if (r < I_OUT) { const int kb = r / 32, nb = r % 32; transpose_item(Wout, D, WOUT_T, 2048, 32 * nb, 64 * kb, 32 * nb, scr, lane); continue; } r -= I_OUT;
        if (r < I_G) { const int kb = r / 112, nb = r % 112, n0 = 32 * nb; transpose_item(Wg, FF, WGU_T, D, 256 * (n0 >> 7) + (n0 & 127), 64 * kb, n0, scr, lane); continue; } r -= I_G;
        if (r < I_G) { const int kb = r / 112, nb = r % 112, n0 = 32 * nb; transpose_item(Wu, FF, WGU_T, D, 256 * (n0 >> 7) + 128 + (n0 & 127), 64 * kb, n0, scr, lane); continue; } r -= I_G;
        { const int kb = r / 32, nb = r % 32; transpose_item(Wd, D, WD_T, FF, 32 * nb, 64 * kb, 32 * nb, scr, lane); }
    }
    if (j == 0) {
        bf16* HB = (bf16*)(a.ws + WS_HB); const f32x4* x4 = (const f32x4*)a.x;
        for (size_t i = (size_t)bid * 512 + tid; i < (size_t)TT * D / 8; i += (size_t)G * 512) { const f32x4 p = x4[2 * i], q = x4[2 * i + 1];
            v4u o; o.x = pk2(p[0], p[1]); o.y = pk2(p[2], p[3]); o.z = pk2(q[0], q[1]); o.w = pk2(q[2], q[3]); *(v4u*)(HB + 8 * i) = o; }
    }
}
DI void phase_w_sb(const Args& a, int j, LAS unsigned char* lds, int bid, int G, int wave, int lane) {
    LAS float* scr = (LAS float*)(lds + wave * 16384);
    const int gw = bid * NWAVES + wave, NGW = G * NWAVES;
    const float* Wqkv = a.sb_w_in + (size_t)j * D * 3072; const float* Wo = a.sb_w_out + (size_t)j * D * D;
    const float* Mg = a.moe_w_gate + (size_t)j * NE * D * FF; const float* Mu = a.moe_w_up + (size_t)j * NE * D * FF; const float* Md = a.moe_w_down + (size_t)j * NE * FF * D;
    bf16* WQKV_T = (bf16*)(a.ws + W_QKV); bf16* WO_T = (bf16*)(a.ws + W_O); bf16* MGU_T = (bf16*)(a.ws + W_MGU); bf16* MD_T = (bf16*)(a.ws + W_MD);
    constexpr int I_QKV = 16 * 96, I_O = 16 * 32, I_G = 16 * 112, I_D = 56 * 32, I_E = 2 * I_G + I_D, NIT = I_QKV + I_O + NE * I_E;
    for (int it = gw; it < NIT; it += NGW) {
        int r = it;
        if (r < I_QKV) { const int kb = r / 96, nb = r % 96; transpose_item(Wqkv, 3072, WQKV_T, D, 32 * nb, 64 * kb, 32 * nb, scr, lane); continue; } r -= I_QKV;
        if (r < I_O) { const int kb = r / 32, nb = r % 32; transpose_item(Wo, D, WO_T, D, 32 * nb, 64 * kb, 32 * nb, scr, lane); continue; } r -= I_O;
        const int e = r / I_E; r -= e * I_E;
        bf16* gu = MGU_T + (size_t)e * 2 * FF * D; bf16* dn = MD_T + (size_t)e * D * FF;
        if (r < I_G) { const int kb = r / 112, nb = r % 112, n0 = 32 * nb; transpose_item(Mg + (size_t)e * D * FF, FF, gu, D, 256 * (n0 >> 7) + (n0 & 127), 64 * kb, n0, scr, lane); continue; } r -= I_G;
        if (r < I_G) { const int kb = r / 112, nb = r % 112, n0 = 32 * nb; transpose_item(Mu + (size_t)e * D * FF, FF, gu, D, 256 * (n0 >> 7) + 128 + (n0 & 127), 64 * kb, n0, scr, lane); continue; } r -= I_G;
        { const int kb = r / 32, nb = r % 32; transpose_item(Md + (size_t)e * FF * D, D, dn, FF, 32 * nb, 64 * kb, 32 * nb, scr, lane); }
    }
}

DI float dpp_sum16(float v) {
    v += __builtin_bit_cast(float, __builtin_amdgcn_update_dpp(0, __builtin_bit_cast(int, v), 0xB1, 0xF, 0xF, false));
    v += __builtin_bit_cast(float, __builtin_amdgcn_update_dpp(0, __builtin_bit_cast(int, v), 0x4E, 0xF, 0xF, false));
    v += __builtin_bit_cast(float, __builtin_amdgcn_update_dpp(0, __builtin_bit_cast(int, v), 0x141, 0xF, 0xF, false));
    v += __builtin_bit_cast(float, __builtin_amdgcn_update_dpp(0, __builtin_bit_cast(int, v), 0x140, 0xF, 0xF, false));
    return v;
}
DI void phase_conv(const Args& a, int j, int bid, int G, int tid) {
    const bf16* raw = (const bf16*)(a.ws + WS_RAW); bf16* qkvc = (bf16*)(a.ws + WS_QKVC); float* gb = (float*)(a.ws + WS_GB);
    const float* cw = a.gdn_conv_w + (size_t)j * 4 * 4096;
    const int ch = 8 * tid;
    float w0[8], w1[8], w2[8], w3[8];
#pragma unroll
    for (int i = 0; i < 8; ++i) { w0[i] = cw[ch + i]; w1[i] = cw[4096 + ch + i]; w2[i] = cw[2 * 4096 + ch + i]; w3[i] = cw[3 * 4096 + ch + i]; }
    const float post = tid < 128 ? 0.08838834764831845f : 1.0f;
    for (int run = bid; run < TT / 128; run += G) {
        const int t0 = run * 128; const bool first = (t0 & (SEQ - 1)) == 0;
        float xa[8], xb[8], xc[8];
        { v4u h0 = {0u, 0u, 0u, 0u}, h1 = h0, h2 = h0;
          if (!first) { h0 = *(const v4u*)(raw + (size_t)(t0 - 3) * RAWLD + ch); h1 = *(const v4u*)(raw + (size_t)(t0 - 2) * RAWLD + ch); h2 = *(const v4u*)(raw + (size_t)(t0 - 1) * RAWLD + ch); }
          xa[0] = bf_lo(h0.x); xa[1] = bf_hi(h0.x); xa[2] = bf_lo(h0.y); xa[3] = bf_hi(h0.y); xa[4] = bf_lo(h0.z); xa[5] = bf_hi(h0.z); xa[6] = bf_lo(h0.w); xa[7] = bf_hi(h0.w);
          xb[0] = bf_lo(h1.x); xb[1] = bf_hi(h1.x); xb[2] = bf_lo(h1.y); xb[3] = bf_hi(h1.y); xb[4] = bf_lo(h1.z); xb[5] = bf_hi(h1.z); xb[6] = bf_lo(h1.w); xb[7] = bf_hi(h1.w);
          xc[0] = bf_lo(h2.x); xc[1] = bf_hi(h2.x); xc[2] = bf_lo(h2.y); xc[3] = bf_hi(h2.y); xc[4] = bf_lo(h2.z); xc[5] = bf_hi(h2.z); xc[6] = bf_lo(h2.w); xc[7] = bf_hi(h2.w); }
#pragma unroll 1
        for (int tb = 0; tb < 128; tb += 8) {
            v4u xr[8];
#pragma unroll
            for (int u = 0; u < 8; ++u) xr[u] = *(const v4u*)(raw + (size_t)(t0 + tb + u) * RAWLD + ch);
#pragma unroll
            for (int u = 0; u < 8; ++u) {
                float xd[8]; xd[0] = bf_lo(xr[u].x); xd[1] = bf_hi(xr[u].x); xd[2] = bf_lo(xr[u].y); xd[3] = bf_hi(xr[u].y); xd[4] = bf_lo(xr[u].z); xd[5] = bf_hi(xr[u].z); xd[6] = bf_lo(xr[u].w); xd[7] = bf_hi(xr[u].w);
                float y[8]; float ss = 0.f;
#pragma unroll
                for (int i = 0; i < 8; ++i) { const float c = w0[i] * xa[i] + w1[i] * xb[i] + w2[i] * xc[i] + w3[i] * xd[i];
                    y[i] = c * __builtin_amdgcn_rcpf(1.0f + __builtin_amdgcn_exp2f(-1.4426950408889634f * c)); ss += y[i] * y[i];
                    xa[i] = xb[i]; xb[i] = xc[i]; xc[i] = xd[i]; }
                if (tid < 256) {
                    const float rn = post / sqrtf(dpp_sum16(ss) + RMS_EPS);
#pragma unroll
                    for (int i = 0; i < 8; ++i) y[i] *= rn;
                }
                v4u o; o.x = pk2(y[0], y[1]); o.y = pk2(y[2], y[3]); o.z = pk2(y[4], y[5]); o.w = pk2(y[6], y[7]);
                *(v4u*)(qkvc + (size_t)(t0 + tb + u) * 4096 + ch) = o;
            }
        }
#pragma unroll
        for (int k = 0; k < 4; ++k) { const int item = tid + 512 * k, tok = t0 + (item >> 4), hv = item & 15;
            const float bb = __uint_as_float((unsigned)raw[(size_t)tok * RAWLD + 4096 + hv] << 16), aa = __uint_as_float((unsigned)raw[(size_t)tok * RAWLD + 4112 + hv] << 16);
            const float xx = aa + a.gdn_dt_bias[j * 16 + hv];
            const float sp = xx > 20.f ? xx : log1pf(__expf(xx));
            gb[(size_t)tok * 32 + hv] = -__expf(a.gdn_a_log[j * 16 + hv]) * sp;
            gb[(size_t)tok * 32 + 16 + hv] = sigmoid_f(bb); }
    }
}

DI void phase_gdn_naive(const Args& a, int j, LAS unsigned char* lds, int bid, int tid) {
    if (bid >= BATCH * HV) return;
    const int b = bid / HV, hv = bid % HV, hk = hv / 2, jc = tid & 127, r = tid >> 7;
    const bf16* zb = (const bf16*)(a.ws + WS_ZB); bf16* qkvc = (bf16*)(a.ws + WS_QKVC); const float* gb = (const float*)(a.ws + WS_GB);
    LAS float* qs = (LAS float*)lds; LAS float* ks = qs + 2048; LAS float* vs = ks + 2048; LAS float* gs = vs + 2048; LAS float* bs = gs + 16;
    LAS f32x2* red = (LAS f32x2*)(lds + 32768); LAS float* redkq = (LAS float*)(lds + 32768 + 8192); LAS float* ob = (LAS float*)(lds + 49152);
    float S[32];
#pragma unroll
    for (int i = 0; i < 32; ++i) S[i] = 0.f;
    const int lrow = tid >> 5, lcol = (tid & 31) * 4;
    for (int blk = 0; blk < SEQ / 16; ++blk) {
        const size_t t0 = (size_t)b * SEQ + blk * 16;
        __syncthreads();
        { const bf16* rowp = qkvc + (t0 + lrow) * 4096;
          const v2u qv = *(const v2u*)(rowp + hk * 128 + lcol), kv = *(const v2u*)(rowp + 1024 + hk * 128 + lcol), vv = *(const v2u*)(rowp + 2048 + hv * 128 + lcol);
          *(LAS f32x4*)(qs + lrow * 128 + lcol) = (f32x4){bf_lo(qv.x), bf_hi(qv.x), bf_lo(qv.y), bf_hi(qv.y)};
          *(LAS f32x4*)(ks + lrow * 128 + lcol) = (f32x4){bf_lo(kv.x), bf_hi(kv.x), bf_lo(kv.y), bf_hi(kv.y)};
          *(LAS f32x4*)(vs + lrow * 128 + lcol) = (f32x4){bf_lo(vv.x), bf_hi(vv.x), bf_lo(vv.y), bf_hi(vv.y)};
          if (tid < 16) { gs[tid] = __expf(gb[(t0 + tid) * 32 + hv]); bs[tid] = gb[(t0 + tid) * 32 + 16 + hv]; } }
        __syncthreads();
#pragma unroll 1
        for (int tt = 0; tt < 16; ++tt) {
            float pk = 0.f, pq = 0.f, pkq = 0.f;
#pragma unroll
            for (int i4 = 0; i4 < 8; ++i4) { const f32x4 k4 = *(const LAS f32x4*)(ks + tt * 128 + 32 * r + 4 * i4), q4 = *(const LAS f32x4*)(qs + tt * 128 + 32 * r + 4 * i4);
#pragma unroll
                for (int c = 0; c < 4; ++c) { pk += k4[c] * S[4 * i4 + c]; pq += q4[c] * S[4 * i4 + c]; pkq += k4[c] * q4[c]; } }
            const int buf = tt & 1;
            red[(buf * 4 + r) * 128 + jc] = (f32x2){pk, pq}; if (jc == 0) redkq[buf * 4 + r] = pkq;
            __syncthreads();
            float kS = 0.f, qS = 0.f, kq = 0.f;
#pragma unroll
            for (int rr = 0; rr < 4; ++rr) { const f32x2 p = red[(buf * 4 + rr) * 128 + jc]; kS += p.x; qS += p.y; kq += redkq[buf * 4 + rr]; }
            const float eg = gs[tt], vn = bs[tt] * (vs[tt * 128 + jc] - eg * kS);
#pragma unroll
            for (int i4 = 0; i4 < 8; ++i4) { const f32x4 k4 = *(const LAS f32x4*)(ks + tt * 128 + 32 * r + 4 * i4);
#pragma unroll
                for (int c = 0; c < 4; ++c) S[4 * i4 + c] = eg * S[4 * i4 + c] + k4[c] * vn; }
            if (r == 0) ob[tt * 128 + jc] = eg * qS + kq * vn;
        }
        __syncthreads();
        {
            const f32x4 o4 = *(const LAS f32x4*)(ob + lrow * 128 + lcol);
            float ss = o4[0] * o4[0] + o4[1] * o4[1] + o4[2] * o4[2] + o4[3] * o4[3];
            ss += __shfl_xor(ss, 1); ss += __shfl_xor(ss, 2); ss += __shfl_xor(ss, 4); ss += __shfl_xor(ss, 8); ss += __shfl_xor(ss, 16);
            const float rinv = 1.0f / sqrtf(ss * (1.0f / 128.0f) + RMS_EPS);
            const v2u zv = *(const v2u*)(zb + (t0 + lrow) * 2048 + hv * 128 + lcol);
            const f32x4 nw = *(const f32x4*)(a.gdn_norm_w + j * 128 + lcol);
            const float z0 = bf_lo(zv.x), z1 = bf_hi(zv.x), z2 = bf_lo(zv.y), z3 = bf_hi(zv.y);
            v2u o; o.x = pk2(o4[0] * rinv * nw[0] * z0 * sigmoid_f(z0), o4[1] * rinv * nw[1] * z1 * sigmoid_f(z1));
            o.y = pk2(o4[2] * rinv * nw[2] * z2 * sigmoid_f(z2), o4[3] * rinv * nw[3] * z3 * sigmoid_f(z3));
            *(v2u*)(qkvc + (t0 + lrow) * 4096 + 2048 + hv * 128 + lcol) = o;
        }
    }
}

template <bool ROUTER>
DI void phase_ln(const Args& a, int lnidx, int j, LAS unsigned char* lds, int bid, int G, int tid, int wave, int lane) {
    float* out = a.out; bf16* HB = (bf16*)(a.ws + WS_HB);
    const float* g = a.ln_g + (size_t)lnidx * D; const float* bta = a.ln_b + (size_t)lnidx * D;
    const int gw = bid * NWAVES + wave, NGW = G * NWAVES;
    LAS unsigned* lcnt = (LAS unsigned*)lds;
    if (ROUTER) { if (tid < 8) lcnt[tid] = 0u; __syncthreads(); }
    f32x4 gv[4], bv[4];
#pragma unroll
    for (int q = 0; q < 4; ++q) { gv[q] = *(const f32x4*)(g + 4 * (lane + 64 * q)); bv[q] = *(const f32x4*)(bta + 4 * (lane + 64 * q)); }
    for (int t = gw; t < TT; t += NGW) {
        f32x4* row = (f32x4*)(out + (size_t)t * D);
        f32x4 v[4]; float s = 0.f;
#pragma unroll
        for (int q = 0; q < 4; ++q) { v[q] = row[lane + 64 * q]; s += (v[q][0] + v[q][1]) + (v[q][2] + v[q][3]); }
        const float mean = wave_sum(s) * (1.0f / D); float s2 = 0.f;
#pragma unroll
        for (int q = 0; q < 4; ++q) { v[q] = v[q] - mean; s2 += (v[q][0] * v[q][0] + v[q][1] * v[q][1]) + (v[q][2] * v[q][2] + v[q][3] * v[q][3]); }
        const float rstd = 1.0f / sqrtf(wave_sum(s2) * (1.0f / D) + LN_EPS);
#pragma unroll
        for (int q = 0; q < 4; ++q) { v[q] = v[q] * rstd * gv[q] + bv[q]; row[lane + 64 * q] = v[q];
            v2u o; o.x = pk2(v[q][0], v[q][1]); o.y = pk2(v[q][2], v[q][3]); *(v2u*)(HB + (size_t)t * D + 4 * (lane + 64 * q)) = o; }
        if (ROUTER) {
            const float* R = a.moe_router + (size_t)j * D * NE;
            float lg[8];
#pragma unroll
            for (int e = 0; e < 8; ++e) lg[e] = 0.f;
#pragma unroll
            for (int q = 0; q < 4; ++q)
#pragma unroll
                for (int c = 0; c < 4; ++c) { const int k = 4 * (lane + 64 * q) + c; const f32x4 r0 = *(const f32x4*)(R + k * 8), r1 = *(const f32x4*)(R + k * 8 + 4); const float hv = v[q][c];
                    lg[0] += hv * r0[0]; lg[1] += hv * r0[1]; lg[2] += hv * r0[2]; lg[3] += hv * r0[3]; lg[4] += hv * r1[0]; lg[5] += hv * r1[1]; lg[6] += hv * r1[2]; lg[7] += hv * r1[3]; }
#pragma unroll
            for (int e = 0; e < 8; ++e) lg[e] = wave_sum(lg[e]);
            int i1 = 0; float v1 = lg[0];
#pragma unroll
            for (int e = 1; e < 8; ++e) if (lg[e] > v1) { v1 = lg[e]; i1 = e; }
            int i2 = -1; float v2 = -3.0e38f;
#pragma unroll
            for (int e = 0; e < 8; ++e) if (e != i1 && lg[e] > v2) { v2 = lg[e]; i2 = e; }
            if (lane == 0) {
                const float g1 = 1.0f / (1.0f + __expf(v2 - v1));
                ((unsigned*)(a.ws + WS_E12))[t] = (unsigned)i1 | ((unsigned)i2 << 8);
                ((f32x2*)(a.ws + WS_G12))[t] = (f32x2){g1, 1.0f - g1};
                __hip_atomic_fetch_add(lcnt + i1, 1u, __ATOMIC_RELAXED, __HIP_MEMORY_SCOPE_WORKGROUP); __hip_atomic_fetch_add(lcnt + i2, 1u, __ATOMIC_RELAXED, __HIP_MEMORY_SCOPE_WORKGROUP);
            }
        }
    }
    if (ROUTER) { __syncthreads(); if (tid < 8) { unsigned* cnt = (unsigned*)(a.ws + WS_CTL) + CW_CNT + 256 * j; __hip_atomic_fetch_add(cnt + tid, lcnt[tid], __ATOMIC_RELAXED, __HIP_MEMORY_SCOPE_AGENT); } }
}

DI void phase_sb_naive(const Args& a, LAS unsigned char* lds, int bid, int G, int tid) {
    const bf16* qkv = (const bf16*)(a.ws + WS_QKV); bf16* ao = (bf16*)(a.ws + WS_AO);
    LAS unsigned char* Ks = lds; LAS unsigned char* Vs = lds + 16384;
    const int qi = tid >> 2, r = tid & 3;
    for (int idx = bid; idx < 64 * 32; idx += G) {
        const int qb = 31 - idx / 64, bh = idx % 64, b = bh >> 3, h = bh & 7;
        const int t = qb * 128 + qi;
        const size_t rowq = (size_t)b * SEQ + t;
        float q[32], o[32];
        { const bf16* qp = qkv + rowq * 3072 + h * 128 + 32 * r;
#pragma unroll
          for (int c = 0; c < 4; ++c) { const v4u w = *(const v4u*)(qp + 8 * c);
              q[8 * c + 0] = bf_lo(w.x); q[8 * c + 1] = bf_hi(w.x); q[8 * c + 2] = bf_lo(w.y); q[8 * c + 3] = bf_hi(w.y);
              q[8 * c + 4] = bf_lo(w.z); q[8 * c + 5] = bf_hi(w.z); q[8 * c + 6] = bf_lo(w.w); q[8 * c + 7] = bf_hi(w.w); }
#pragma unroll
          for (int i = 0; i < 32; ++i) { q[i] *= 0.08838834764831845f; o[i] = 0.f; } }
        float P = 1.0f;
        for (int kt = 2 * qb + 1; kt >= 0; --kt) {
            __syncthreads();
#pragma unroll
            for (int i = 0; i < 2; ++i) { const int c = tid + 512 * i, row = c >> 4, part = c & 15;
                const bf16* src = qkv + ((size_t)b * SEQ + kt * 64 + row) * 3072 + h * 128 + part * 8;
                *(LAS v4u*)(Ks + c * 16) = *(const v4u*)(src + 1024); *(LAS v4u*)(Vs + c * 16) = *(const v4u*)(src + 2048); }
            __syncthreads();
#pragma unroll 1
            for (int s = 63; s >= 0; --s) {
                float z = 0.f;
#pragma unroll
                for (int c = 0; c < 4; ++c) { const v4u w = *(const LAS v4u*)(Ks + s * 256 + r * 64 + c * 16);
                    z += q[8 * c + 0] * bf_lo(w.x) + q[8 * c + 1] * bf_hi(w.x) + q[8 * c + 2] * bf_lo(w.y) + q[8 * c + 3] * bf_hi(w.y)
                       + q[8 * c + 4] * bf_lo(w.z) + q[8 * c + 5] * bf_hi(w.z) + q[8 * c + 6] * bf_lo(w.w) + q[8 * c + 7] * bf_hi(w.w); }
                z += __shfl_xor(z, 1); z += __shfl_xor(z, 2);
                const bool live = (kt * 64 + s) < t;
                const float e = __expf(fminf(z, 80.f)), rr = 1.0f / (1.0f + e);
                const float A = live ? e * rr * P : 0.f;
                P = live ? P * rr : P;
#pragma unroll
                for (int c = 0; c < 4; ++c) { const v4u w = *(const LAS v4u*)(Vs + s * 256 + r * 64 + c * 16);
                    o[8 * c + 0] += A * bf_lo(w.x); o[8 * c + 1] += A * bf_hi(w.x); o[8 * c + 2] += A * bf_lo(w.y); o[8 * c + 3] += A * bf_hi(w.y);
                    o[8 * c + 4] += A * bf_lo(w.z); o[8 * c + 5] += A * bf_hi(w.z); o[8 * c + 6] += A * bf_lo(w.w); o[8 * c + 7] += A * bf_hi(w.w); }
            }
        }
        { bf16* op = ao + rowq * 1024 + h * 128 + 32 * r;
#pragma unroll
          for (int c = 0; c < 4; ++c) { v4u w; w.x = pk2(o[8 * c + 0], o[8 * c + 1]); w.y = pk2(o[8 * c + 2], o[8 * c + 3]); w.z = pk2(o[8 * c + 4], o[8 * c + 5]); w.w = pk2(o[8 * c + 6], o[8 * c + 7]);
              *(v4u*)(op + 8 * c) = w; } }
    }
}


namespace sba {
using bf16x8 = __attribute__((ext_vector_type(8))) short;
using s16x4  = __attribute__((ext_vector_type(4))) short;
using f32x16 = __attribute__((ext_vector_type(16))) float;
constexpr int SHM_V = 16384, SHM_K = 16384, LDQ = 3072;
#define KSWZ(row, colB) ((row) * 256 + ((colB) ^ (((row) & 7) << 4)))
#define SBAR() __builtin_amdgcn_sched_barrier(0)
DI int crow(int r, int hi) { return (r & 3) + 8 * (r >> 2) + 4 * hi; }
DI int v_st(int k, int c) { const int kk = (k & ~0xC) | ((k & 4) << 1) | ((k & 8) >> 1); return ((kk >> 3) * 4 + (c >> 5)) * 512 + ((kk & 7) * 32 + (c & 31)) * 2; }
DI int v_rd_base(int lane) { return ((lane & 3) << 3) | (((lane >> 2) & 3) << 6) | (((lane >> 4) & 1) << 5) | (((lane >> 5) & 1) << 8); }
constexpr int v_rd_off(int d0, int ks, int half) { return d0 * 512 + ks * 4096 + half * 2048; }
template <int OFF> DI s16x4 tr_read(int vb) { s16x4 r; asm volatile("ds_read_b64_tr_b16 %0, %1 offset:%2" : "=&v"(r) : "v"(vb), "i"(OFF) : "memory"); return r; }
template <int D0> DI void pv_one(f32x16& od, int vb, bf16x8 pa0, bf16x8 pa1, bf16x8 pa2, bf16x8 pa3) {
  const s16x4 l0 = tr_read<v_rd_off(D0, 0, 0)>(vb), h0 = tr_read<v_rd_off(D0, 0, 1)>(vb), l1 = tr_read<v_rd_off(D0, 1, 0)>(vb), h1 = tr_read<v_rd_off(D0, 1, 1)>(vb);
  const s16x4 l2 = tr_read<v_rd_off(D0, 2, 0)>(vb), h2 = tr_read<v_rd_off(D0, 2, 1)>(vb), l3 = tr_read<v_rd_off(D0, 3, 0)>(vb), h3 = tr_read<v_rd_off(D0, 3, 1)>(vb);
  asm volatile("s_waitcnt lgkmcnt(0)" ::: "memory"); SBAR();
#define PK(L, H) (bf16x8){L[0], L[1], L[2], L[3], H[0], H[1], H[2], H[3]}
  od = __builtin_amdgcn_mfma_f32_32x32x16_bf16(pa0, PK(l0, h0), od, 0, 0, 0);
  od = __builtin_amdgcn_mfma_f32_32x32x16_bf16(pa1, PK(l1, h1), od, 0, 0, 0);
  od = __builtin_amdgcn_mfma_f32_32x32x16_bf16(pa2, PK(l2, h2), od, 0, 0, 0);
  od = __builtin_amdgcn_mfma_f32_32x32x16_bf16(pa3, PK(l3, h3), od, 0, 0, 0);
#undef PK
}
DI void qkt(f32x16& p0, f32x16& p1, const LAS unsigned char* Ks, const bf16x8 (&qr)[8], int r32, int hi) {
  p0 = f32x16{}; p1 = f32x16{};
#pragma unroll
  for (int d0 = 0; d0 < 8; ++d0) { const int cb = (d0 * 16 + hi * 8) * 2;
    const bf16x8 b0 = *(const LAS bf16x8*)(Ks + KSWZ(r32, cb));
    const bf16x8 b1 = *(const LAS bf16x8*)(Ks + KSWZ(32 + r32, cb));
    p0 = __builtin_amdgcn_mfma_f32_32x32x16_bf16(b0, qr[d0], p0, 0, 0, 0);
    p1 = __builtin_amdgcn_mfma_f32_32x32x16_bf16(b1, qr[d0], p1, 0, 0, 0); }
}
template <bool MASK> DI void sb_half(f32x16& p, float& Pc, int hi, int kbase, int trow) {
  constexpr float C = 0.08838834764831845f * 1.4426950408889634f;
  float rr[16];
#pragma unroll
  for (int r = 0; r < 16; ++r) {
    float z = p[r] * C;
    if (MASK) z = (kbase + crow(r, hi) < trow) ? z : -__builtin_inff();
    const float k = __builtin_amdgcn_rcpf(1.0f + __builtin_amdgcn_exp2f(z));
    rr[r] = k; p[r] = 1.0f - k;
  }
  float R0[4], R1[4];
#pragma unroll
  for (int g = 0; g < 4; ++g) {
    const float c2 = rr[4 * g + 3], c1 = c2 * rr[4 * g + 2], c0 = c1 * rr[4 * g + 1], R = c0 * rr[4 * g];
    rr[4 * g + 2] = c2; rr[4 * g + 1] = c1; rr[4 * g] = c0;
    const auto sw = __builtin_amdgcn_permlane32_swap(__float_as_uint(R), __float_as_uint(R), false, false);
    R0[g] = __uint_as_float(sw[0]); R1[g] = __uint_as_float(sw[1]);
  }
#pragma unroll
  for (int g = 3; g >= 0; --g) {
    const float Pin = hi ? Pc : Pc * R1[g];
    p[4 * g + 3] *= Pin; p[4 * g + 2] *= Pin * rr[4 * g + 2]; p[4 * g + 1] *= Pin * rr[4 * g + 1]; p[4 * g] *= Pin * rr[4 * g];
    Pc *= R0[g] * R1[g];
  }
}
DI unsigned cvtpk(float lo, float hi) { unsigned r; asm volatile("v_cvt_pk_bf16_f32 %0, %1, %2" : "=v"(r) : "v"(lo), "v"(hi)); return r; }
#define PK4(P, BASE, OUT) do { const unsigned a0 = cvtpk(P[BASE + 0], P[BASE + 1]), a1 = cvtpk(P[BASE + 2], P[BASE + 3]);   \
    const unsigned b0 = cvtpk(P[BASE + 4], P[BASE + 5]), b1 = cvtpk(P[BASE + 6], P[BASE + 7]);                              \
    const auto r0 = __builtin_amdgcn_permlane32_swap(a0, b0, false, false); const auto r1 = __builtin_amdgcn_permlane32_swap(a1, b1, false, false); \
    const v4u w = {r0[0], r1[0], r0[1], r1[1]}; OUT = __builtin_bit_cast(bf16x8, w); } while (0)

DI void unit(const bf16* qkv, bf16* ao, int b, int h, int qb, LAS unsigned char* lds, int tid) {
  const int wid = __builtin_amdgcn_readfirstlane(tid >> 6), lane = tid & 63, r32 = lane & 31, hi = lane >> 5;
  LAS unsigned char* V_lds = lds; LAS unsigned char* K_lds = lds + 2 * SHM_V;
  const size_t rowbase = (size_t)b * SEQ; const int q0 = qb * 256, t_lo = q0 + wid * 32, trow = t_lo + r32;
  bf16x8 qr[8];
  { const bf16* Qw = qkv + (rowbase + trow) * LDQ + h * 128 + hi * 8;
#pragma unroll
    for (int d0 = 0; d0 < 8; ++d0) qr[d0] = *(const bf16x8*)(Qw + d0 * 16); }
  const bf16* Kh = qkv + rowbase * LDQ + 1024 + h * 128; const bf16* Vh = Kh + 1024;
  const int sr = tid >> 4, sc = (tid & 15) * 8, vst0 = v_st(sr, sc), vst1 = v_st(32 + sr, sc);
  const int vb0 = (int)(unsigned)(size_t)V_lds + v_rd_base(lane);
  bf16x8 vs0, vs1, ks0, ks1;
#define SLOAD(k0) do { vs0 = *(const bf16x8*)(Vh + (size_t)((k0) + sr) * LDQ + sc); vs1 = *(const bf16x8*)(Vh + (size_t)((k0) + 32 + sr) * LDQ + sc); \
    ks0 = *(const bf16x8*)(Kh + (size_t)((k0) + sr) * LDQ + sc); ks1 = *(const bf16x8*)(Kh + (size_t)((k0) + 32 + sr) * LDQ + sc); } while (0)
#define SWRITE(bb) do { *(LAS bf16x8*)(V_lds + (bb) * SHM_V + vst0) = vs0; *(LAS bf16x8*)(V_lds + (bb) * SHM_V + vst1) = vs1; const int kc = sc * 2; \
    *(LAS bf16x8*)(K_lds + (bb) * SHM_K + KSWZ(sr, kc)) = ks0; *(LAS bf16x8*)(K_lds + (bb) * SHM_K + KSWZ(32 + sr, kc)) = ks1; } while (0)
  f32x16 o[4] = {}; float Pc = 1.0f;
  const int kt_max = qb * 4 + 3;
  SLOAD(kt_max * 64);
  for (int kt = kt_max; kt >= 0; --kt) {
    const int buf = kt & 1, k0 = kt * 64;
    asm volatile("s_waitcnt vmcnt(0)" ::: "memory");
    SWRITE(buf);
    if (kt > 0) SLOAD(k0 - 64);
    __syncthreads();
    if (k0 < t_lo + 31) {
      f32x16 p0, p1;
      qkt(p0, p1, K_lds + buf * SHM_K, qr, r32, hi);
      if (k0 + 63 >= t_lo) { sb_half<true>(p1, Pc, hi, k0 + 32, trow); sb_half<true>(p0, Pc, hi, k0, trow); }
      else { sb_half<false>(p1, Pc, hi, k0 + 32, trow); sb_half<false>(p0, Pc, hi, k0, trow); }
      bf16x8 pa0, pa1, pa2, pa3;
      PK4(p0, 0, pa0); PK4(p0, 8, pa1); PK4(p1, 0, pa2); PK4(p1, 8, pa3);
      const int vb = vb0 + buf * SHM_V;
      pv_one<0>(o[0], vb, pa0, pa1, pa2, pa3); pv_one<1>(o[1], vb, pa0, pa1, pa2, pa3); pv_one<2>(o[2], vb, pa0, pa1, pa2, pa3); pv_one<3>(o[3], vb, pa0, pa1, pa2, pa3);
    }
  }
  bf16* Ow = ao + (rowbase + t_lo) * 1024 + h * 128 + r32;
#pragma unroll
  for (int r = 0; r < 16; ++r) { const int orow = crow(r, hi);
#pragma unroll
    for (int d0 = 0; d0 < 4; ++d0) Ow[(size_t)orow * 1024 + d0 * 32] = (bf16)(cvtpk(o[d0][r], 0.f) & 0xffffu); }
#undef SLOAD
#undef SWRITE
}
#undef PK4
#undef KSWZ
#undef SBAR
}
DI void phase_sb_mfma(const Args& a, LAS unsigned char* lds, int bid, int G, int tid) {
    const bf16* qkv = (const bf16*)(a.ws + WS_QKV); bf16* ao = (bf16*)(a.ws + WS_AO);
    const int vcu = (G % 8 == 0) ? (bid % 8) * (G / 8) + bid / 8 : bid;
    for (int pi = vcu; pi < 512; pi += G) {
        const int bh = pi >> 3, p = pi & 7, b = bh >> 3, h = bh & 7;
        sba::unit(qkv, ao, b, h, 15 - p, lds, tid);
        sba::unit(qkv, ao, b, h, p, lds, tid);
    }
}


namespace gdn {
using bf16x8 = __attribute__((ext_vector_type(8))) short;
using s16x4  = __attribute__((ext_vector_type(4))) short;
using f32x16 = __attribute__((ext_vector_type(16))) float;
typedef float f2v __attribute__((ext_vector_type(2)));
typedef __bf16 b2v __attribute__((ext_vector_type(2)));
DI unsigned pk(float a, float b) { const f2v v = {a, b}; const b2v r = __builtin_convertvector(v, b2v); return __builtin_bit_cast(unsigned, r); }
DI int crow(int r, int hi) { return (r & 3) + 8 * (r >> 2) + 4 * hi; }
DI int pi_slot(int x) { return 8 * ((x >> 2) & 3) + 4 * ((x >> 4) & 1) + (x & 3); }
DI bf16x8 pack_step(const f32x16& x, int s) {
    v4u w; w.x = pk(x[8 * s + 0], x[8 * s + 1]); w.y = pk(x[8 * s + 2], x[8 * s + 3]); w.z = pk(x[8 * s + 4], x[8 * s + 5]); w.w = pk(x[8 * s + 6], x[8 * s + 7]);
    return __builtin_bit_cast(bf16x8, w);
}
DI f32x16 mm(const f32x16& P, const f32x16& Q, f32x16 acc) {
    acc = __builtin_amdgcn_mfma_f32_32x32x16_bf16(pack_step(P, 0), pack_step(Q, 0), acc, 0, 0, 0);
    acc = __builtin_amdgcn_mfma_f32_32x32x16_bf16(pack_step(P, 1), pack_step(Q, 1), acc, 0, 0, 0);
    return acc;
}
#define GPK4(P, BASE, OUT) do { const unsigned a0 = pk(P[BASE + 0], P[BASE + 1]), a1 = pk(P[BASE + 2], P[BASE + 3]);   \
    const unsigned b0 = pk(P[BASE + 4], P[BASE + 5]), b1 = pk(P[BASE + 6], P[BASE + 7]);                              \
    const auto r0 = __builtin_amdgcn_permlane32_swap(a0, b0, false, false); const auto r1 = __builtin_amdgcn_permlane32_swap(a1, b1, false, false); \
    const v4u w_ = {r0[0], r1[0], r0[1], r1[1]}; OUT = __builtin_bit_cast(bf16x8, w_); } while (0)

DI void local_unit(const Args& a, int unit, LAS unsigned char* img, LAS float* tab, int lane, bool dry) {
    const int r32 = lane & 31, hi = lane >> 5;
    const int chunk = unit & 63, bh = unit >> 6, hv = bh & 15, b = bh >> 4, hk = hv >> 1;
    const size_t t0 = (size_t)b * SEQ + chunk * 64;
    bf16* qkvc = (bf16*)(a.ws + WS_QKVC); const float* gb = (const float*)(a.ws + WS_GB);
    bf16* wmem = (bf16*)(a.ws + WS_WMEM) + (size_t)unit * 8192; bf16* imem = (bf16*)(a.ws + WS_IMEM) + (size_t)unit * 4096;
    bf16* ktmem = (bf16*)(a.ws + WS_KTMEM) + (size_t)((b * HK + hk) * 64 + chunk) * 8192; float* gtab = (float*)(a.ws + WS_GTAB) + (size_t)unit * 192;
    float gc = gb[(t0 + lane) * 32 + hv]; const float be = gb[(t0 + lane) * 32 + 16 + hv];
#pragma unroll
    for (int off = 1; off < 64; off <<= 1) { const float y = __shfl_up(gc, off); if (lane >= off) gc += y; }
    const float glast = __shfl(gc, 63);
    tab[lane] = gc; tab[64 + lane] = be; tab[128 + lane] = -be * __expf(gc);
    gtab[lane] = __expf(gc); gtab[64 + lane] = __expf(glast - gc); if (lane == 0) gtab[128] = __expf(glast);
    const bf16* kbase = qkvc + t0 * 4096 + 1024 + hk * 128; const bf16* qbase = qkvc + t0 * 4096 + hk * 128; bf16* vbase = qkvc + t0 * 4096 + 2048 + hv * 128;
    if ((hv & 1) == 0) {
        const int slot = 32 * (lane >> 5) + pi_slot(lane & 31);
#pragma unroll 4
        for (int c8 = 0; c8 < 16; ++c8) { const v4u kv = *(const v4u*)(kbase + (size_t)lane * 4096 + 8 * c8);
            bf16* dst = ktmem + (size_t)(8 * c8) * 64 + slot;
            dst[0 * 64] = (bf16)(kv.x & 0xffffu); dst[1 * 64] = (bf16)(kv.x >> 16); dst[2 * 64] = (bf16)(kv.y & 0xffffu); dst[3 * 64] = (bf16)(kv.y >> 16);
            dst[4 * 64] = (bf16)(kv.z & 0xffffu); dst[5 * 64] = (bf16)(kv.z >> 16); dst[6 * 64] = (bf16)(kv.w & 0xffffu); dst[7 * 64] = (bf16)(kv.w >> 16); }
    }
#define GSB() __builtin_amdgcn_sched_barrier(0)
    {
        f32x16 IT00 = {}, IT11 = {}, IT01 = {};
#pragma unroll
        for (int s = 0; s < 8; ++s) {
            const bf16x8 k0 = *(const bf16x8*)(kbase + (size_t)r32 * 4096 + 16 * s + 8 * hi), k1 = *(const bf16x8*)(kbase + (size_t)(32 + r32) * 4096 + 16 * s + 8 * hi);
            const bf16x8 q0 = *(const bf16x8*)(qbase + (size_t)r32 * 4096 + 16 * s + 8 * hi), q1 = *(const bf16x8*)(qbase + (size_t)(32 + r32) * 4096 + 16 * s + 8 * hi);
            IT00 = __builtin_amdgcn_mfma_f32_32x32x16_bf16(k0, q0, IT00, 0, 0, 0); IT11 = __builtin_amdgcn_mfma_f32_32x32x16_bf16(k1, q1, IT11, 0, 0, 0);
            IT01 = __builtin_amdgcn_mfma_f32_32x32x16_bf16(k0, q1, IT01, 0, 0, 0);
        }
#pragma unroll
        for (int I = 0; I < 2; ++I) { const int c = 32 * I + r32; const float gcc = tab[c];
#pragma unroll
            for (int J = 0; J < 2; ++J)
#pragma unroll
                for (int g = 0; g < 4; ++g) { float v[4];
#pragma unroll
                    for (int i = 0; i < 4; ++i) { const int r = 4 * g + i, cp = 32 * J + crow(r, hi);
                        const float raw = (I == 0) ? (J == 0 ? IT00[r] : 0.f) : (J == 0 ? IT01[r] : IT11[r]);
                        const float val = raw * __expf(-fabsf(gcc - tab[cp])); v[i] = (c >= cp) ? val : 0.f; }
                    v2u o; o.x = pk(v[0], v[1]); o.y = pk(v[2], v[3]);
                    *(v2u*)(imem + (size_t)c * 64 + 32 * J + 16 * (g & 1) + 8 * hi + 4 * (g >> 1)) = o; } }
    }
    GSB();
    f32x16 T1, T1T, T2T, T21T;
    {
        f32x16 KK = {};
#pragma unroll
        for (int s = 0; s < 8; ++s) { const bf16x8 k0 = *(const bf16x8*)(kbase + (size_t)r32 * 4096 + 16 * s + 8 * hi); KK = __builtin_amdgcn_mfma_f32_32x32x16_bf16(k0, k0, KK, 0, 0, 0); }
        f32x16 M, MT;
        { const float gb0 = tab[r32], bb0 = tab[64 + r32];
#pragma unroll
        for (int r = 0; r < 16; ++r) { const int a0 = crow(r, hi), b0 = r32; const float ke = -KK[r] * __expf(-fabsf(tab[a0] - gb0));
            const float nv = ke * tab[64 + a0], ntv = ke * bb0;
            const float n = (a0 > b0) ? nv : 0.f, nt = (b0 > a0) ? ntv : 0.f, id = (a0 == b0) ? 1.f : 0.f;
            M[r] = n; MT[r] = nt; T1[r] = id + n; T1T[r] = id + nt; } }
#pragma unroll
        for (int it = 0; it < 4; ++it) { const f32x16 z = {};
            const f32x16 Mn = mm(MT, M, z), MTn = mm(M, MT, z);
            const f32x16 Tn = mm(T1T, Mn, T1);
            T1T = mm(Mn, T1T, T1T);
            T1 = Tn; M = Mn; MT = MTn; }
    }
    GSB();
    {
        f32x16 KK = {};
#pragma unroll
        for (int s = 0; s < 8; ++s) { const bf16x8 k1 = *(const bf16x8*)(kbase + (size_t)(32 + r32) * 4096 + 16 * s + 8 * hi); KK = __builtin_amdgcn_mfma_f32_32x32x16_bf16(k1, k1, KK, 0, 0, 0); }
        f32x16 M, MT;
        { const float gb0 = tab[32 + r32], bb0 = tab[96 + r32];
#pragma unroll
        for (int r = 0; r < 16; ++r) { const int a0 = crow(r, hi), b0 = r32; const float ke = -KK[r] * __expf(-fabsf(tab[32 + a0] - gb0));
            const float nv = ke * tab[96 + a0], ntv = ke * bb0;
            const float n = (a0 > b0) ? nv : 0.f, nt = (b0 > a0) ? ntv : 0.f, id = (a0 == b0) ? 1.f : 0.f;
            M[r] = n; MT[r] = nt; T2T[r] = id + nt; } }
#pragma unroll
        for (int it = 0; it < 4; ++it) { const f32x16 z = {};
            const f32x16 Mn = mm(MT, M, z), MTn = mm(M, MT, z);
            T2T = mm(Mn, T2T, T2T);
            M = Mn; MT = MTn; }
    }
    GSB();
    {
        f32x16 L21 = {};
#pragma unroll
        for (int s = 0; s < 8; ++s) { const bf16x8 k0 = *(const bf16x8*)(kbase + (size_t)r32 * 4096 + 16 * s + 8 * hi), k1 = *(const bf16x8*)(kbase + (size_t)(32 + r32) * 4096 + 16 * s + 8 * hi);
            L21 = __builtin_amdgcn_mfma_f32_32x32x16_bf16(k1, k0, L21, 0, 0, 0); }
#pragma unroll
        for (int r = 0; r < 16; ++r) { const int a0 = crow(r, hi); L21[r] = L21[r] * tab[96 + a0] * __expf(tab[32 + a0] - tab[r32]); }
        const f32x16 z = {}; const f32x16 Y = mm(L21, T2T, z); T21T = mm(T1, Y, z);
#pragma unroll
        for (int r = 0; r < 16; ++r) T21T[r] = -T21T[r];
    }
    GSB();
    const int vb = (int)(unsigned)(size_t)img + sba::v_rd_base(lane);
    bf16* ubl = dry ? (bf16*)(a.ws + WS_END) + (size_t)(unit & 63) * 64 * 4096 : vbase;
#pragma unroll 1
    for (int mode = 0; mode < 2; ++mode) {
        const bf16* src = mode == 0 ? (const bf16*)vbase : kbase;
#pragma unroll 4
        for (int it = 0; it < 16; ++it) { const int row = (lane >> 4) + 4 * it, col = (lane & 15) * 8;
            *(LAS v4u*)(img + sba::v_st(row, col)) = *(const v4u*)(src + (size_t)row * 4096 + col); }
        LAS float* sc = tab + (mode == 0 ? 64 : 128);
#pragma unroll 1
        for (int I = 0; I < 2; ++I) {
            bf16x8 pa0, pa1, pa2, pa3;
            { f32x16 X;
#pragma unroll
              for (int r = 0; r < 16; ++r) X[r] = (I ? T21T[r] : T1T[r]) * sc[crow(r, hi)];
              GPK4(X, 0, pa0); GPK4(X, 8, pa1);
#pragma unroll
              for (int r = 0; r < 16; ++r) X[r] = I ? T2T[r] * sc[32 + crow(r, hi)] : 0.f;
              GPK4(X, 0, pa2); GPK4(X, 8, pa3); }
            const int ubase = ((((r32 >> 4) * 64 + hi * 16 + (r32 & 15)) * 16) + 8 * I);
            const int wbase = (32 * I + 4 * hi) * 128 + pi_slot(r32);
#define GDN_OUT(D0) do { f32x16 od = {}; sba::pv_one<D0>(od, vb, pa0, pa1, pa2, pa3); \
            if (mode == 0) { _Pragma("unroll") for (int g = 0; g < 4; ++g) { const int f = ubase + D0 * 2048 + (g & 1) * 512 + (g >> 1) * 4; \
                    v2u w; w.x = pk(od[4 * g + 0], od[4 * g + 1]); w.y = pk(od[4 * g + 2], od[4 * g + 3]); *(v2u*)(ubl + (unsigned)((f >> 7) * 4096 + (f & 127))) = w; } } \
            else { _Pragma("unroll") for (int r = 0; r < 16; ++r) wmem[(unsigned)(wbase + ((r & 3) + 8 * (r >> 2)) * 128 + 32 * D0)] = (bf16)(pk(od[r], 0.f) & 0xffffu); } \
            GSB(); } while (0)
            GDN_OUT(0); GDN_OUT(1); GDN_OUT(2); GDN_OUT(3);
#undef GDN_OUT
        }
    }
#undef GSB
}
#undef GPK4
}
DI void phase_gdn_local(const Args& a, LAS unsigned char* lds, int bid, int G, int wave, int lane, bool dry) {
    LAS unsigned char* img = lds + wave * 16384; LAS float* tab = (LAS float*)(lds + RING_BYTES + 4096 + wave * 1024);
    const int gw = bid * NWAVES + wave, NGW = G * NWAVES;
    for (int unit = gw; unit < BATCH * HV * 64; unit += NGW) gdn::local_unit(a, unit, img, tab, lane, dry);
}
namespace gdn {
constexpr int PW = 272, PI = 144;
constexpr int L_W = 0, L_Q = 64 * PW, L_I = 2 * 64 * PW, L_K = L_I + 64 * PI, L_G = L_K + 128 * PI, L_BUF = L_G + 768;
constexpr int L_PART = 2 * L_BUF;
static_assert(L_PART + 4096 <= RING_BYTES, "scan LDS map");
}
DI void phase_gdn_scan(const Args& a, int j, LAS unsigned char* lds, int bid, int tid, bool dry) {
    if (bid >= BATCH * HV) return;
    using gdn::bf16x8; using gdn::pk; using namespace gdn;
    typedef float f4v __attribute__((ext_vector_type(4)));
    const int wave = __builtin_amdgcn_readfirstlane(tid >> 6), lane = tid & 63, n = lane & 15, kq = lane >> 4;
    const int b = bid / HV, hv = bid % HV, hk = hv >> 1;
    bf16* qkvc = (bf16*)(a.ws + WS_QKVC); const bf16* zb = (const bf16*)(a.ws + WS_ZB);
    LAS float* part = (LAS float*)(lds + L_PART);
    const float nw = a.gdn_norm_w[j * 128 + 16 * wave + n];
    const int unit0 = (b * HV + hv) * 64, hku0 = (b * HK + hk) * 64; const size_t tb0 = (size_t)b * SEQ;
    const int c0 = tid, c1 = tid + 512;
    v4u rw0, rw1, rq0, rq1, ri0, rk0, rk1, ru0, ru1; float rg = 0.f;
#define SCAN_LOAD(ch) do { const int u_ = unit0 + (ch); const size_t t_ = tb0 + (size_t)(ch) * 64; \
        const bf16* wm_ = (const bf16*)(a.ws + WS_WMEM) + (size_t)u_ * 8192; const bf16* im_ = (const bf16*)(a.ws + WS_IMEM) + (size_t)u_ * 4096; \
        const bf16* kt_ = (const bf16*)(a.ws + WS_KTMEM) + (size_t)(hku0 + (ch)) * 8192; const bf16* qb_ = qkvc + t_ * 4096 + hk * 128; const bf16* vb_ = qkvc + t_ * 4096 + 2048 + hv * 128; \
        rw0 = *(const v4u*)(wm_ + c0 * 8); rw1 = *(const v4u*)(wm_ + c1 * 8); \
        rq0 = *(const v4u*)(qb_ + (size_t)(c0 >> 4) * 4096 + (c0 & 15) * 8); rq1 = *(const v4u*)(qb_ + (size_t)(c1 >> 4) * 4096 + (c1 & 15) * 8); \
        ri0 = *(const v4u*)(im_ + c0 * 8); rk0 = *(const v4u*)(kt_ + c0 * 8); rk1 = *(const v4u*)(kt_ + c1 * 8); \
        { const int f = (wave * 64 + lane) * 16; ru0 = *(const v4u*)(vb_ + (size_t)(f >> 7) * 4096 + (f & 127)); ru1 = *(const v4u*)(vb_ + (size_t)(f >> 7) * 4096 + (f & 127) + 8); } \
        if (tid < 192) rg = ((const float*)(a.ws + WS_GTAB))[(size_t)u_ * 192 + tid]; } while (0)
#define SCAN_WRITE(bf) do { LAS unsigned char* B_ = lds + (bf) * L_BUF; \
        *(LAS v4u*)(B_ + L_W + (c0 >> 4) * PW + (c0 & 15) * 16) = rw0; *(LAS v4u*)(B_ + L_W + (c1 >> 4) * PW + (c1 & 15) * 16) = rw1; \
        *(LAS v4u*)(B_ + L_Q + (c0 >> 4) * PW + (c0 & 15) * 16) = rq0; *(LAS v4u*)(B_ + L_Q + (c1 >> 4) * PW + (c1 & 15) * 16) = rq1; \
        *(LAS v4u*)(B_ + L_I + (c0 >> 3) * PI + (c0 & 7) * 16) = ri0; \
        *(LAS v4u*)(B_ + L_K + (c0 >> 3) * PI + (c0 & 7) * 16) = rk0; *(LAS v4u*)(B_ + L_K + (c1 >> 3) * PI + (c1 & 7) * 16) = rk1; \
        if (tid < 192) *(LAS float*)(B_ + L_G + tid * 4) = rg; } while (0)
    f4v S[8];
#pragma unroll
    for (int m = 0; m < 8; ++m) S[m] = (f4v){0.f, 0.f, 0.f, 0.f};
    SCAN_LOAD(0);
    SCAN_WRITE(0);
    v4u u0 = ru0, u1 = ru1;
    unsigned short zn[16];
#pragma unroll
    for (int mt = 0; mt < 4; ++mt)
#pragma unroll
        for (int i = 0; i < 4; ++i) zn[4 * mt + i] = zb[(tb0 + 16 * mt + 4 * kq + i) * 2048 + hv * 128 + 16 * wave + n];
    __syncthreads();
#pragma unroll 1
    for (int chunk = 0; chunk < 64; ++chunk) {
        const size_t t0 = tb0 + (size_t)chunk * 64; bf16* vbase = qkvc + t0 * 4096 + 2048 + hv * 128;
        const LAS unsigned char* B = lds + (chunk & 1) * L_BUF; const LAS float* gt = (const LAS float*)(B + L_G);
        if (chunk + 1 < 64) SCAN_LOAD(chunk + 1);
        unsigned short zz[16];
#pragma unroll
        for (int q = 0; q < 16; ++q) zz[q] = zn[q];
        if (chunk + 1 < 64) {
#pragma unroll
            for (int mt = 0; mt < 4; ++mt)
#pragma unroll
                for (int i = 0; i < 4; ++i) zn[4 * mt + i] = zb[(t0 + 64 + 16 * mt + 4 * kq + i) * 2048 + hv * 128 + 16 * wave + n];
        }
        __builtin_amdgcn_sched_barrier(0);
        f4v av[4], ao[4];
        av[0] = (f4v){bf_lo(u0.x), bf_hi(u0.x), bf_lo(u0.y), bf_hi(u0.y)}; av[1] = (f4v){bf_lo(u0.z), bf_hi(u0.z), bf_lo(u0.w), bf_hi(u0.w)};
        av[2] = (f4v){bf_lo(u1.x), bf_hi(u1.x), bf_lo(u1.y), bf_hi(u1.y)}; av[3] = (f4v){bf_lo(u1.z), bf_hi(u1.z), bf_lo(u1.w), bf_hi(u1.w)};
        bf16x8 Sb[4];
#pragma unroll
        for (int p = 0; p < 4; ++p) { v4u w; w.x = pk(S[2 * p][0], S[2 * p][1]); w.y = pk(S[2 * p][2], S[2 * p][3]); w.z = pk(S[2 * p + 1][0], S[2 * p + 1][1]); w.w = pk(S[2 * p + 1][2], S[2 * p + 1][3]);
            Sb[p] = __builtin_bit_cast(bf16x8, w); }
#pragma unroll
        for (int mt = 0; mt < 4; ++mt) { ao[mt] = (f4v){0.f, 0.f, 0.f, 0.f};
#pragma unroll
            for (int p = 0; p < 4; ++p) {
                const bf16x8 aw = *(const LAS bf16x8*)(B + L_W + (16 * mt + n) * PW + 64 * p + 16 * kq);
                const v2u q0 = *(const LAS v2u*)(B + L_Q + (16 * mt + n) * PW + 64 * p + 8 * kq), q1 = *(const LAS v2u*)(B + L_Q + (16 * mt + n) * PW + 64 * p + 32 + 8 * kq);
                const v4u qq = {q0.x, q0.y, q1.x, q1.y};
                av[mt] = __builtin_amdgcn_mfma_f32_16x16x32_bf16(aw, Sb[p], av[mt], 0, 0, 0);
                ao[mt] = __builtin_amdgcn_mfma_f32_16x16x32_bf16(__builtin_bit_cast(bf16x8, qq), Sb[p], ao[mt], 0, 0, 0); } }
        bf16x8 vbf[2], vbd[2];
#pragma unroll
        for (int pp = 0; pp < 2; ++pp) {
            const f4v d0 = *(const LAS f4v*)(gt + 64 + 32 * pp + 4 * kq), d1 = *(const LAS f4v*)(gt + 64 + 32 * pp + 16 + 4 * kq);
            const f4v x0 = av[2 * pp], x1 = av[2 * pp + 1];
            v4u w; w.x = pk(x0[0], x0[1]); w.y = pk(x0[2], x0[3]); w.z = pk(x1[0], x1[1]); w.w = pk(x1[2], x1[3]); vbf[pp] = __builtin_bit_cast(bf16x8, w);
            v4u y; y.x = pk(x0[0] * d0[0], x0[1] * d0[1]); y.y = pk(x0[2] * d0[2], x0[3] * d0[3]); y.z = pk(x1[0] * d1[0], x1[1] * d1[1]); y.w = pk(x1[2] * d1[2], x1[3] * d1[3]); vbd[pp] = __builtin_bit_cast(bf16x8, y);
        }
#pragma unroll
        for (int mt = 0; mt < 4; ++mt) { const f4v eg = *(const LAS f4v*)(gt + 16 * mt + 4 * kq); ao[mt] = ao[mt] * eg;
#pragma unroll
            for (int pp = 0; pp < 2; ++pp) { const bf16x8 ai = *(const LAS bf16x8*)(B + L_I + (16 * mt + n) * PI + 64 * pp + 16 * kq);
                ao[mt] = __builtin_amdgcn_mfma_f32_16x16x32_bf16(ai, vbf[pp], ao[mt], 0, 0, 0); } }
        { const float egl = gt[128];
#pragma unroll
          for (int m8 = 0; m8 < 8; ++m8) { S[m8] = S[m8] * egl;
#pragma unroll
              for (int pp = 0; pp < 2; ++pp) { const bf16x8 ak = *(const LAS bf16x8*)(B + L_K + (16 * m8 + n) * PI + 64 * pp + 16 * kq);
                  S[m8] = __builtin_amdgcn_mfma_f32_16x16x32_bf16(ak, vbd[pp], S[m8], 0, 0, 0); } } }
        if (chunk + 1 < 64) { SCAN_WRITE((chunk + 1) & 1); u0 = ru0; u1 = ru1; }
        LAS float* pb = part + (chunk & 1) * 512;
#pragma unroll
        for (int mt = 0; mt < 4; ++mt)
#pragma unroll
            for (int i = 0; i < 4; ++i) { float ss = ao[mt][i] * ao[mt][i];
                ss += __builtin_bit_cast(float, __builtin_amdgcn_update_dpp(0, __builtin_bit_cast(int, ss), 0xB1, 0xF, 0xF, false));
                ss += __builtin_bit_cast(float, __builtin_amdgcn_update_dpp(0, __builtin_bit_cast(int, ss), 0x4E, 0xF, 0xF, false));
                ss += __builtin_bit_cast(float, __builtin_amdgcn_update_dpp(0, __builtin_bit_cast(int, ss), 0x141, 0xF, 0xF, false));
                ss += __builtin_bit_cast(float, __builtin_amdgcn_update_dpp(0, __builtin_bit_cast(int, ss), 0x140, 0xF, 0xF, false));
                if (n == 0) pb[(16 * mt + 4 * kq + i) * 8 + wave] = ss; }
        __syncthreads();
        LAS unsigned char* ogs = lds + OGST_OFF;
#pragma unroll
        for (int mt = 0; mt < 4; ++mt)
#pragma unroll
            for (int i = 0; i < 4; ++i) { const int c = 16 * mt + 4 * kq + i;
                const f4v s0 = *(const LAS f4v*)(pb + c * 8), s1 = *(const LAS f4v*)(pb + c * 8 + 4);
                const float tot = (s0[0] + s0[1]) + (s0[2] + s0[3]) + (s1[0] + s1[1]) + (s1[2] + s1[3]);
                const float rinv = 1.0f / sqrtf(tot * (1.0f / 128.0f) + RMS_EPS);
                const float z = __uint_as_float((unsigned)zz[4 * mt + i] << 16);
                *(LAS bf16*)(ogs + c * 256 + (16 * wave + n) * 2) = (bf16)(pk(ao[mt][i] * rinv * nw * z * sigmoid_f(z), 0.f) & 0xffffu); }
        __syncthreads();
        { bf16* ob = dry ? (bf16*)(a.ws + WS_END) + (size_t)bid * 64 * 128 : vbase; const int opitch = dry ? 128 : 4096;
          *(v4u*)(ob + (size_t)(c0 >> 4) * opitch + (c0 & 15) * 8) = *(const LAS v4u*)(ogs + (c0 >> 4) * 256 + (c0 & 15) * 16);
          *(v4u*)(ob + (size_t)(c1 >> 4) * opitch + (c1 & 15) * 8) = *(const LAS v4u*)(ogs + (c1 >> 4) * 256 + (c1 & 15) * 16); }
    }
#undef SCAN_LOAD
#undef SCAN_WRITE
}

DI void moe_offsets(const Args& a, int j, unsigned (&off)[9]) {
    unsigned* cnt = (unsigned*)(a.ws + WS_CTL) + CW_CNT + 256 * j; unsigned acc = 0u;
#pragma unroll
    for (int e = 0; e < 8; ++e) { off[e] = acc; const unsigned c = __hip_atomic_load(cnt + e, __ATOMIC_RELAXED, __HIP_MEMORY_SCOPE_AGENT); acc += (c + 255u) & ~255u; }
    off[8] = acc;
}
DI void phase_scatter(const Args& a, int j, LAS unsigned char* lds, int bid, int G, int tid, int wave, int lane) {
    LAS unsigned* lc = (LAS unsigned*)lds; LAS unsigned* lb = lc + 8; LAS unsigned* loff = lc + 16; LAS int* lpos = (LAS int*)(lc + 32);
    const unsigned* E12 = (const unsigned*)(a.ws + WS_E12); int* POS = (int*)(a.ws + WS_POS);
    const bf16* HB = (const bf16*)(a.ws + WS_HB); bf16* XS = (bf16*)(a.ws + WS_XS);
    unsigned* fill = (unsigned*)(a.ws + WS_CTL) + CW_CNT + 256 * j + 64;
    unsigned off[9]; moe_offsets(a, j, off);
    if (tid == 0) {
#pragma unroll
        for (int e = 0; e < 8; ++e) loff[e] = off[e]; }
    for (int ci = bid; ci < TT / 128; ci += G) {
        __syncthreads();
        if (tid < 8) lc[tid] = 0u;
        __syncthreads();
        unsigned e1 = 0, e2 = 0, r1 = 0, r2 = 0;
        if (tid < 128) { const unsigned w = E12[ci * 128 + tid]; e1 = w & 255u; e2 = (w >> 8) & 255u;
            r1 = __hip_atomic_fetch_add(lc + e1, 1u, __ATOMIC_RELAXED, __HIP_MEMORY_SCOPE_WORKGROUP); r2 = __hip_atomic_fetch_add(lc + e2, 1u, __ATOMIC_RELAXED, __HIP_MEMORY_SCOPE_WORKGROUP); }
        __syncthreads();
        if (tid < 8) lb[tid] = __hip_atomic_fetch_add(fill + tid, lc[tid], __ATOMIC_RELAXED, __HIP_MEMORY_SCOPE_AGENT);
        __syncthreads();
        if (tid < 128) { const int p1 = (int)(loff[e1] + lb[e1] + r1), p2 = (int)(loff[e2] + lb[e2] + r2);
            lpos[2 * tid] = p1; lpos[2 * tid + 1] = p2; POS[2 * (ci * 128 + tid)] = p1; POS[2 * (ci * 128 + tid) + 1] = p2; }
        __syncthreads();
        for (int tk = wave; tk < 128; tk += NWAVES) {
            const int p1 = lpos[2 * tk], p2 = lpos[2 * tk + 1];
            const v4u* src = (const v4u*)(HB + (size_t)(ci * 128 + tk) * D);
            const v4u x0 = src[lane], x1 = src[lane + 64];
            v4u* d1 = (v4u*)(XS + (size_t)p1 * D); v4u* d2 = (v4u*)(XS + (size_t)p2 * D);
            d1[lane] = x0; d1[lane + 64] = x1; d2[lane] = x0; d2[lane + 64] = x1;
        }
    }
}

DI void phase_combine_ln(const Args& a, int lnidx, int bid, int G, int wave, int lane) {
    float* out = a.out; bf16* HB = (bf16*)(a.ws + WS_HB); const bf16* YE = (const bf16*)(a.ws + WS_XS);
    const int* POS = (const int*)(a.ws + WS_POS); const f32x2* G12 = (const f32x2*)(a.ws + WS_G12);
    const float* g = a.ln_g + (size_t)lnidx * D; const float* bta = a.ln_b + (size_t)lnidx * D;
    const int gw = bid * NWAVES + wave, NGW = G * NWAVES;
    f32x4 gv[4], bv[4];
#pragma unroll
    for (int q = 0; q < 4; ++q) { gv[q] = *(const f32x4*)(g + 4 * (lane + 64 * q)); bv[q] = *(const f32x4*)(bta + 4 * (lane + 64 * q)); }
    for (int t = gw; t < TT; t += NGW) {
        f32x4* row = (f32x4*)(out + (size_t)t * D);
        const int p1 = POS[2 * t], p2 = POS[2 * t + 1]; const f32x2 gg = G12[t];
        const v2u* y1 = (const v2u*)(YE + (size_t)p1 * D); const v2u* y2 = (const v2u*)(YE + (size_t)p2 * D);
        f32x4 v[4]; float s = 0.f;
#pragma unroll
        for (int q = 0; q < 4; ++q) { const v2u a1 = y1[lane + 64 * q], a2 = y2[lane + 64 * q];
            const f32x4 e1 = (f32x4){bf_lo(a1.x), bf_hi(a1.x), bf_lo(a1.y), bf_hi(a1.y)}, e2 = (f32x4){bf_lo(a2.x), bf_hi(a2.x), bf_lo(a2.y), bf_hi(a2.y)};
            v[q] = row[lane + 64 * q] * ALPHA + e1 * gg.x + e2 * gg.y; s += (v[q][0] + v[q][1]) + (v[q][2] + v[q][3]); }
        const float mean = wave_sum(s) * (1.0f / D); float s2 = 0.f;
#pragma unroll
        for (int q = 0; q < 4; ++q) { v[q] = v[q] - mean; s2 += (v[q][0] * v[q][0] + v[q][1] * v[q][1]) + (v[q][2] * v[q][2] + v[q][3] * v[q][3]); }
        const float rstd = 1.0f / sqrtf(wave_sum(s2) * (1.0f / D) + LN_EPS);
#pragma unroll
        for (int q = 0; q < 4; ++q) { v[q] = v[q] * rstd * gv[q] + bv[q]; row[lane + 64 * q] = v[q];
            v2u o; o.x = pk2(v[q][0], v[q][1]); o.y = pk2(v[q][2], v[q][3]); *(v2u*)(HB + (size_t)t * D + 4 * (lane + 64 * q)) = o; }
    }
}

constexpr int ARGS_OFF = RING_BYTES + 1024;
DI unsigned long long lds_u64(LAS unsigned char* p) { const v2u w = *(const volatile LAS v2u*)p; return ((unsigned long long)(unsigned)__builtin_amdgcn_readfirstlane((int)w.y) << 32) | (unsigned)__builtin_amdgcn_readfirstlane((int)w.x); }
DI Args load_args(LAS unsigned char* lds) {
    Args a; LAS unsigned char* p = lds + ARGS_OFF;
    a.x = (const float*)(const GAS float*)lds_u64(p + 0); a.gdn_w_in = (const float*)(const GAS float*)lds_u64(p + 8); a.gdn_conv_w = (const float*)(const GAS float*)lds_u64(p + 16); a.gdn_a_log = (const float*)(const GAS float*)lds_u64(p + 24);
    a.gdn_dt_bias = (const float*)(const GAS float*)lds_u64(p + 32); a.gdn_norm_w = (const float*)(const GAS float*)lds_u64(p + 40); a.gdn_w_out = (const float*)(const GAS float*)lds_u64(p + 48); a.sb_w_in = (const float*)(const GAS float*)lds_u64(p + 56);
    a.sb_w_out = (const float*)(const GAS float*)lds_u64(p + 64); a.ffn_w_gate = (const float*)(const GAS float*)lds_u64(p + 72); a.ffn_w_up = (const float*)(const GAS float*)lds_u64(p + 80); a.ffn_w_down = (const float*)(const GAS float*)lds_u64(p + 88);
    a.moe_router = (const float*)(const GAS float*)lds_u64(p + 96); a.moe_w_gate = (const float*)(const GAS float*)lds_u64(p + 104); a.moe_w_up = (const float*)(const GAS float*)lds_u64(p + 112); a.moe_w_down = (const float*)(const GAS float*)lds_u64(p + 120);
    a.ln_g = (const float*)(const GAS float*)lds_u64(p + 128); a.ln_b = (const float*)(const GAS float*)lds_u64(p + 136); a.out = (float*)(GAS float*)lds_u64(p + 144); a.ws = (unsigned char*)(GAS unsigned char*)lds_u64(p + 152);
    const v2u w = *(const volatile LAS v2u*)(p + 160); a.ph_lo = __builtin_amdgcn_readfirstlane((int)w.x); a.ph_hi = __builtin_amdgcn_readfirstlane((int)w.y);
    return a;
}
#ifdef PH_ONLY
#define IN(k) (((k) % NPH) == PH_ONLY && lo <= (k) && (k) < hi)
#else
#define IN(k) (lo <= (k) && (k) < hi)
#endif
#define SEAM(k) do { if ((k) + 1 < hi) xcd_barrier(bar); } while (0)
DI int fresh_lane() { int l; asm volatile("v_mbcnt_lo_u32_b32 %0, -1, 0\n\tv_mbcnt_hi_u32_b32 %0, -1, %0" : "=v"(l)); return l; }
#define ARGS() const Args args = load_args(lds); const int lo = args.ph_lo, hi = args.ph_hi; const int lane = fresh_lane(), tid = wave * 64 + lane
#ifndef PROBE_REP_MASK
#define PROBE_REP_MASK 0
#endif
#ifndef PROBE_DELAY_MASK
#define PROBE_DELAY_MASK 0
#endif
#define PROBE_DELAY_MULT 4u
#define TICK_IN(k) do { if (((PROBE_DELAY_MASK) >> (k)) & 1) { if (bid == 0 && tid == 0) ((volatile LAS unsigned*)(lds + MISC_OFF))[20] -= (unsigned)__builtin_amdgcn_s_memrealtime(); } } while (0)
#define TICK_OUT(k) do { if (((PROBE_DELAY_MASK) >> (k)) & 1) { if (bid == 0 && tid == 0) ((volatile LAS unsigned*)(lds + MISC_OFF))[20] += (unsigned)__builtin_amdgcn_s_memrealtime(); } } while (0)
#define NREP(k) ((((PROBE_REP_MASK) >> (k)) & 1) ? 2 : 1)
template <int j>
DI void layer_pair(LAS unsigned char* lds, const XcdBarrier& bar, const int wave, const int G, const int bid) {
    constexpr int pb = j * NPH;
    { ARGS(); if (IN(pb + 0)) { TICK_IN(0); _Pragma("unroll 1") for (int rep_ = 0; rep_ < NREP(0); ++rep_) { phase_w_gdn(args, j, lds, bid, G, tid, wave, lane); } SEAM(pb + 0); TICK_OUT(0); } }
    { ARGS(); if (IN(pb + 1)) { TICK_IN(1); {
        pg8::Gemm g{(const bf16*)(args.ws + WS_HB), (const bf16*)(args.ws + W_IN), D, D}; pg8::StaticOrder S; S.init(TT, GINP, G, bid, NREP(1));
        pg8::EpiInProj E{(bf16*)(args.ws + WS_RAW), (bf16*)(args.ws + WS_ZB)};
        pg8::gemm_phase<pg8::EpiInProj, pg8::StaticOrder, true, true>(lds, g, S, E);
        } SEAM(pb + 1); TICK_OUT(1); } }
    { ARGS(); if (IN(pb + 2)) { TICK_IN(2); _Pragma("unroll 1") for (int rep_ = 0; rep_ < NREP(2); ++rep_) { phase_conv(args, j, bid, G, tid); } SEAM(pb + 2); TICK_OUT(2); } }
#if GDN_NAIVE
    { ARGS(); if (IN(pb + 4)) { TICK_IN(4); _Pragma("unroll 1") for (int rep_ = 0; rep_ < NREP(4); ++rep_) { phase_gdn_naive(args, j, lds, bid, tid); } SEAM(pb + 4); TICK_OUT(4); } }
#else
    { ARGS(); if (IN(pb + 3)) { TICK_IN(3); _Pragma("unroll 1") for (int rep_ = 0; rep_ < NREP(3); ++rep_) { phase_gdn_local(args, lds, bid, G, wave, lane, rep_ + 1 < NREP(3)); } SEAM(pb + 3); TICK_OUT(3); } }
    { ARGS(); if (IN(pb + 4)) { TICK_IN(4); _Pragma("unroll 1") for (int rep_ = 0; rep_ < NREP(4); ++rep_) { phase_gdn_scan(args, j, lds, bid, tid, rep_ + 1 < NREP(4)); } SEAM(pb + 4); TICK_OUT(4); } }
#endif
    { ARGS(); if (IN(pb + 5)) { TICK_IN(5); {
        pg8::Gemm g{(const bf16*)(args.ws + WS_QKVC) + 2048, (const bf16*)(args.ws + W_OUT), 4096, 2048}; pg8::StaticOrder S; S.init(TT, D, G, bid);
        pg8::EpiResid E{j == 0 ? args.x : args.out, args.out, D, ALPHA};
        pg8::gemm_phase<pg8::EpiResid, pg8::StaticOrder, true, true>(lds, g, S, E);
        } SEAM(pb + 5); TICK_OUT(5); } }
    { ARGS(); if (IN(pb + 6)) { TICK_IN(6); _Pragma("unroll 1") for (int rep_ = 0; rep_ < NREP(6); ++rep_) { phase_ln<false>(args, (2 * j) * 2 + 0, j, lds, bid, G, tid, wave, lane); } SEAM(pb + 6); TICK_OUT(6); } }
    { ARGS(); if (IN(pb + 7)) { TICK_IN(7); {
        pg8::Gemm g{(const bf16*)(args.ws + WS_HB), (const bf16*)(args.ws + W_GU), D, D}; pg8::StaticOrder S; S.init(TT, 2 * FF, G, bid, NREP(7));
        pg8::EpiSwiGLU E{(bf16*)(args.ws + WS_ACT), FF, 0};
        pg8::gemm_phase<pg8::EpiSwiGLU, pg8::StaticOrder, true, true>(lds, g, S, E);
        } SEAM(pb + 7); TICK_OUT(7); } }
    { ARGS(); if (IN(pb + 8)) { TICK_IN(8); {
        pg8::Gemm g{(const bf16*)(args.ws + WS_ACT), (const bf16*)(args.ws + W_D), FF, FF}; pg8::StaticOrder S; S.init(TT, D, G, bid);
        pg8::EpiResid E{args.out, args.out, D, ALPHA};
        pg8::gemm_phase<pg8::EpiResid, pg8::StaticOrder, true, true>(lds, g, S, E);
        } SEAM(pb + 8); TICK_OUT(8); } }
    { ARGS(); if (IN(pb + 9)) { TICK_IN(9); _Pragma("unroll 1") for (int rep_ = 0; rep_ < NREP(9); ++rep_) { phase_ln<false>(args, (2 * j) * 2 + 1, j, lds, bid, G, tid, wave, lane); _Pragma("unroll 1") for (int r2_ = 0; r2_ < NREP(18); ++r2_) phase_w_sb(args, j, lds, bid, G, wave, lane); } SEAM(pb + 9); TICK_OUT(9); } }
    { ARGS(); if (IN(pb + 10)) { TICK_IN(10); {
        pg8::Gemm g{(const bf16*)(args.ws + WS_HB), (const bf16*)(args.ws + W_QKV), D, D}; pg8::StaticOrder S; S.init(TT, 3072, G, bid, NREP(10));
        pg8::EpiBf16 E{(bf16*)(args.ws + WS_QKV), 3072, 0};
        pg8::gemm_phase<pg8::EpiBf16, pg8::StaticOrder, true, true>(lds, g, S, E);
        } SEAM(pb + 10); TICK_OUT(10); } }
    #if SB_NAIVE
    { ARGS(); if (IN(pb + 11)) { TICK_IN(11); _Pragma("unroll 1") for (int rep_ = 0; rep_ < NREP(11); ++rep_) { phase_sb_naive(args, lds, bid, G, tid); } SEAM(pb + 11); TICK_OUT(11); } }
#else
    { ARGS(); if (IN(pb + 11)) { TICK_IN(11); _Pragma("unroll 1") for (int rep_ = 0; rep_ < NREP(11); ++rep_) { phase_sb_mfma(args, lds, bid, G, tid); } SEAM(pb + 11); TICK_OUT(11); } }
#endif
    { ARGS(); if (IN(pb + 12)) { TICK_IN(12); {
        pg8::Gemm g{(const bf16*)(args.ws + WS_AO), (const bf16*)(args.ws + W_O), D, D}; pg8::StaticOrder S; S.init(TT, D, G, bid);
        pg8::EpiResid E{args.out, args.out, D, ALPHA};
        pg8::gemm_phase<pg8::EpiResid, pg8::StaticOrder, true, true>(lds, g, S, E);
        } SEAM(pb + 12); TICK_OUT(12); } }
    { ARGS(); if (IN(pb + 13)) { TICK_IN(13); _Pragma("unroll 1") for (int rep_ = 0; rep_ < NREP(13); ++rep_) { phase_ln<true>(args, (2 * j + 1) * 2 + 0, j, lds, bid, G, tid, wave, lane); } SEAM(pb + 13); TICK_OUT(13); } }
    { ARGS(); if (IN(pb + 14)) { TICK_IN(14); _Pragma("unroll 1") for (int rep_ = 0; rep_ < NREP(14); ++rep_) { phase_scatter(args, j, lds, bid, G, tid, wave, lane); } SEAM(pb + 14); TICK_OUT(14); } }
    { ARGS(); if (IN(pb + 15)) { TICK_IN(15); {
        unsigned off[9]; moe_offsets(args, j, off);
        pg8::MoeOrder S; S.nM = (int)(off[8] >> 8); S.G = G; S.c = bid; S.nN = 2 * FF / 256; S.nwg = S.nM * S.nN; S.rep = NREP(15);
        S.ps1 = (int)(off[1] >> 8); S.ps2 = (int)(off[2] >> 8); S.ps3 = (int)(off[3] >> 8); S.ps4 = (int)(off[4] >> 8); S.ps5 = (int)(off[5] >> 8); S.ps6 = (int)(off[6] >> 8); S.ps7 = (int)(off[7] >> 8);
        pg8::Gemm g{(const bf16*)(args.ws + WS_XS), (const bf16*)(args.ws + W_MGU), D, D};
        pg8::EpiSwiGLU E{(bf16*)(args.ws + WS_MACT), FF, 2 * FF / 256};
        pg8::gemm_phase<pg8::EpiSwiGLU, pg8::MoeOrder, true, true>(lds, g, S, E);
        } SEAM(pb + 15); TICK_OUT(15); } }
    { ARGS(); if (IN(pb + 16)) { TICK_IN(16); {
        unsigned off[9]; moe_offsets(args, j, off);
        pg8::MoeOrder S; S.nM = (int)(off[8] >> 8); S.G = G; S.c = bid; S.nN = D / 256; S.nwg = S.nM * S.nN; S.rep = NREP(16);
        S.ps1 = (int)(off[1] >> 8); S.ps2 = (int)(off[2] >> 8); S.ps3 = (int)(off[3] >> 8); S.ps4 = (int)(off[4] >> 8); S.ps5 = (int)(off[5] >> 8); S.ps6 = (int)(off[6] >> 8); S.ps7 = (int)(off[7] >> 8);
        pg8::Gemm g{(const bf16*)(args.ws + WS_MACT), (const bf16*)(args.ws + W_MD), FF, FF};
        pg8::EpiBf16 E{(bf16*)(args.ws + WS_XS), D, D / 256};
        pg8::gemm_phase<pg8::EpiBf16, pg8::MoeOrder, true, true>(lds, g, S, E);
        } SEAM(pb + 16); TICK_OUT(16); } }
    { ARGS(); if (IN(pb + 17)) { TICK_IN(17); _Pragma("unroll 1") for (int rep_ = 0; rep_ < NREP(17); ++rep_) { phase_combine_ln(args, (2 * j + 1) * 2 + 1, bid, G, wave, lane); } SEAM(pb + 17); TICK_OUT(17); } }
}
__global__ void __launch_bounds__(NWAVES * 64, 2) fwd(Args kargs) {
    extern __shared__ __attribute__((aligned(16))) unsigned char lds_raw[];
    LAS unsigned char* lds = (LAS unsigned char*)lds_raw;
    volatile LAS unsigned* MISC = (volatile LAS unsigned*)(lds + MISC_OFF);
    const int tid = threadIdx.x, lane = tid & 63, wave = __builtin_amdgcn_readfirstlane(tid >> 6), G = gridDim.x, bid = blockIdx.x;
    for (int u = tid; u < (LDS_BYTES - RING_BYTES) / 4; u += NWAVES * 64) ((LAS unsigned*)(lds + RING_BYTES))[u] = 0u;
    __syncthreads();
    if (tid == 0) { LAS unsigned long long* pa = (LAS unsigned long long*)(lds + ARGS_OFF);
        pa[0] = (unsigned long long)kargs.x; pa[1] = (unsigned long long)kargs.gdn_w_in; pa[2] = (unsigned long long)kargs.gdn_conv_w; pa[3] = (unsigned long long)kargs.gdn_a_log;
        pa[4] = (unsigned long long)kargs.gdn_dt_bias; pa[5] = (unsigned long long)kargs.gdn_norm_w; pa[6] = (unsigned long long)kargs.gdn_w_out; pa[7] = (unsigned long long)kargs.sb_w_in;
        pa[8] = (unsigned long long)kargs.sb_w_out; pa[9] = (unsigned long long)kargs.ffn_w_gate; pa[10] = (unsigned long long)kargs.ffn_w_up; pa[11] = (unsigned long long)kargs.ffn_w_down;
        pa[12] = (unsigned long long)kargs.moe_router; pa[13] = (unsigned long long)kargs.moe_w_gate; pa[14] = (unsigned long long)kargs.moe_w_up; pa[15] = (unsigned long long)kargs.moe_w_down;
        pa[16] = (unsigned long long)kargs.ln_g; pa[17] = (unsigned long long)kargs.ln_b; pa[18] = (unsigned long long)kargs.out; pa[19] = (unsigned long long)kargs.ws;
        pa[20] = (unsigned long long)(unsigned)kargs.ph_lo | ((unsigned long long)(unsigned)kargs.ph_hi << 32); }
    XcdBarrier bar = xcd_barrier_post((unsigned*)(kargs.ws + WS_CTL) + CW_BAR, MISC + 8);
    __syncthreads();
    layer_pair<0>(lds, bar, wave, G, bid);
    layer_pair<1>(lds, bar, wave, G, bid);
    if (PROBE_DELAY_MASK) { if (bid == 0 && threadIdx.x == 0) { const unsigned acc = ((volatile LAS unsigned*)(lds + MISC_OFF))[20] * PROBE_DELAY_MULT; const unsigned long long t0 = __builtin_amdgcn_s_memrealtime(); while ((unsigned)(__builtin_amdgcn_s_memrealtime() - t0) < acc) __builtin_amdgcn_s_sleep(8); } }
}
#undef IN
#undef SEAM
#undef ARGS

extern "C" void kernel_launch(void* const* d_in, const int* in_sizes, int n_in, void* d_out, int out_size, void* d_ws, size_t ws_size, hipStream_t stream) {
    static int grid = 0;
    if (grid == 0) {
        if (n_in != 18 || in_sizes[0] != TT * D || out_size != TT * D || ws_size < WS_END + 32 * MiB) { fprintf(stderr, "kernel_launch: unexpected shapes (n_in %d, in0 %d, out %d, ws %zu); nothing launched\n", n_in, n_in > 0 ? in_sizes[0] : -1, out_size, ws_size); grid = -1; return; }
        int dev = 0, cus = 0, per_cu = 0;
        if (hipGetDevice(&dev) != hipSuccess || hipDeviceGetAttribute(&cus, hipDeviceAttributeMultiprocessorCount, dev) != hipSuccess) { grid = -1; return; }
        if (hipFuncSetAttribute((const void*)fwd, hipFuncAttributeMaxDynamicSharedMemorySize, LDS_BYTES) != hipSuccess) { fprintf(stderr, "kernel_launch: hipFuncSetAttribute failed\n"); grid = -1; return; }
        if (hipOccupancyMaxActiveBlocksPerMultiprocessor(&per_cu, (const void*)fwd, NWAVES * 64, LDS_BYTES) != hipSuccess || per_cu < 1) { fprintf(stderr, "kernel_launch: occupancy query says %d blocks per CU\n", per_cu); (void)hipGetLastError(); grid = -1; return; }
        grid = cus;
    }
    if (grid < 0) return;
    if (hipMemsetAsync((char*)d_ws + WS_CTL, 0, CTL_ZERO_BYTES, stream) != hipSuccess) return;
    Args a{};
    a.x = (const float*)d_in[0]; a.gdn_w_in = (const float*)d_in[1]; a.gdn_conv_w = (const float*)d_in[2]; a.gdn_a_log = (const float*)d_in[3]; a.gdn_dt_bias = (const float*)d_in[4];
    a.gdn_norm_w = (const float*)d_in[5]; a.gdn_w_out = (const float*)d_in[6]; a.sb_w_in = (const float*)d_in[7]; a.sb_w_out = (const float*)d_in[8];
    a.ffn_w_gate = (const float*)d_in[9]; a.ffn_w_up = (const float*)d_in[10]; a.ffn_w_down = (const float*)d_in[11]; a.moe_router = (const float*)d_in[12];
    a.moe_w_gate = (const float*)d_in[13]; a.moe_w_up = (const float*)d_in[14]; a.moe_w_down = (const float*)d_in[15]; a.ln_g = (const float*)d_in[16]; a.ln_b = (const float*)d_in[17];
    a.out = (float*)d_out; a.ws = (unsigned char*)d_ws;
#if MK_ONE_LAUNCH
    a.ph_lo = 0; a.ph_hi = NPHASES;
    hipLaunchKernelGGL(fwd, dim3(grid), dim3(NWAVES * 64), LDS_BYTES, stream, a);
#else
    for (int p = 0; p < NPHASES; ++p) { a.ph_lo = p; a.ph_hi = p + 1; hipLaunchKernelGGL(fwd, dim3(grid), dim3(NWAVES * 64), LDS_BYTES, stream, a); }
#endif
}
```

```cpp
#include <hip/hip_runtime.h>
#include <cstdio>
#include <cstdint>
#ifndef GDN_NAIVE
#define GDN_NAIVE 0
#endif
#ifndef SB_NAIVE
#define SB_NAIVE 0
#endif
#ifndef MK_ONE_LAUNCH
#define MK_ONE_LAUNCH 1
#endif
namespace pg8 {
#define PG8_LAS __attribute__((address_space(3)))
typedef unsigned short bf16_t;
typedef short bf16x8 __attribute__((ext_vector_type(8)));
typedef float f32x4 __attribute__((ext_vector_type(4)));
typedef unsigned u32x4 __attribute__((ext_vector_type(4)));
constexpr int BM = 256, BK = 64, HALF = 128, HTB = HALF * BK * 2  , STAGE_BYTES = 8 * HTB, NXCD = 8, WGM = 8;

__host__ __device__ __forceinline__ int lds_byte(int r, int c) { const int st = (r >> 4) * 2 + (c >> 5), rr = r & 15, cc = c & 31, ob = rr * 64 + cc * 2; return st * 1024 + (ob ^ (((ob >> 9) & 1) << 5)); }
__host__ __device__ __forceinline__ void stage_rc(int b, int& R, int& C) { const int st = b / 1024, sb = b % 1024, swz = sb ^ (((sb >> 9) & 1) << 5); R = (st >> 1) * 16 + swz / 64; C = (st & 1) * 32 + (swz % 64) / 2; }
__host__ __device__ __forceinline__ int perm32(int rho) { const int n = rho >> 4, i = rho & 15; return 8 * (i >> 2) + 4 * n + (i & 3); }

struct Unit { int pm, pn; };
struct Gemm { const bf16_t* A; const bf16_t* Bt; int lda, K; };

struct StaticOrder {
    int nM, nN, nwg, G, c, rep;
    __host__ __device__ void init(int M, int N, int G_, int c_, int rep_ = 1) { nM = M / BM; nN = N / BM; nwg = nM * nN; G = G_; c = c_; rep = rep_; }
    __host__ __device__ bool next(int i, Unit& u) const {
        const long L = (long)i * G + c; if (L >= (long)rep * nwg) return false;
        int wgid = (int)(L % nwg); { const int q = nwg / NXCD, r = nwg % NXCD, xcd = wgid % NXCD, off = wgid / NXCD; wgid = (xcd < r ? xcd * (q + 1) : r * (q + 1) + (xcd - r) * q) + off; }
        const int nig = WGM * nN, gid = wgid / nig, fm = gid * WGM, gsz = (nM - fm) < WGM ? (nM - fm) : WGM;
        u.pm = fm + ((wgid % nig) % gsz); u.pn = (wgid % nig) / gsz; return true;
    }
    __device__ __forceinline__ void a_ready(const Unit&) const {}
    __device__ __forceinline__ void done(const Unit&) const {}
};

__device__ __forceinline__ unsigned cvt_pk_bf16(float lo, float hi) { unsigned r; asm volatile("v_cvt_pk_bf16_f32 %0, %1, %2" : "=v"(r) : "v"(lo), "v"(hi)); return r; }
struct EpiBf16 {
    static constexpr bool PERM = true, AFTER_DRAIN = false;
    bf16_t* O; int ldc; int nmod;
    __device__ __forceinline__ void operator()(const f32x4 (&acc)[2][2][4][2], const Unit& u, int wr, int wc, int fr, int fq) const {
        const int pnl = nmod ? (u.pn % nmod) : u.pn;
        const int row0 = u.pm * BM + wr * 64 + fr, col0 = pnl * BM + wc * 32 + 8 * fq;
#pragma unroll
        for (int ai = 0; ai < 2; ++ai)
#pragma unroll
            for (int m = 0; m < 4; ++m) { bf16_t* rowp = O + (size_t)(row0 + ai * HALF + m * 16) * ldc + col0;
#pragma unroll
                for (int bj = 0; bj < 2; ++bj) { const f32x4 v0 = acc[ai][bj][m][0], v1 = acc[ai][bj][m][1];
                    u32x4 w; w.x = cvt_pk_bf16(v0[0], v0[1]); w.y = cvt_pk_bf16(v0[2], v0[3]); w.z = cvt_pk_bf16(v1[0], v1[1]); w.w = cvt_pk_bf16(v1[2], v1[3]);
                    *(u32x4*)(rowp + bj * HALF) = w; } }
    }
};
struct EpiInProj {
    static constexpr bool PERM = true, AFTER_DRAIN = false;
    bf16_t* RAW; bf16_t* ZB;
    __device__ __forceinline__ void operator()(const f32x4 (&acc)[2][2][4][2], const Unit& u, int wr, int wc, int fr, int fq) const {
        const bool isz = (u.pn >= 16 && u.pn < 24);
        bf16_t* O = isz ? ZB : RAW; const int ldc = isz ? 2048 : 4352; const int ct = isz ? (u.pn - 16) : (u.pn < 16 ? u.pn : 16);
        const int row0 = u.pm * BM + wr * 64 + fr, col0 = ct * BM + wc * 32 + 8 * fq;
#pragma unroll
        for (int ai = 0; ai < 2; ++ai)
#pragma unroll
            for (int m = 0; m < 4; ++m) { bf16_t* rowp = O + (size_t)(row0 + ai * HALF + m * 16) * ldc + col0;
#pragma unroll
                for (int bj = 0; bj < 2; ++bj) { const f32x4 v0 = acc[ai][bj][m][0], v1 = acc[ai][bj][m][1];
                    u32x4 w; w.x = cvt_pk_bf16(v0[0], v0[1]); w.y = cvt_pk_bf16(v0[2], v0[3]); w.z = cvt_pk_bf16(v1[0], v1[1]); w.w = cvt_pk_bf16(v1[2], v1[3]);
                    *(u32x4*)(rowp + bj * HALF) = w; } }
    }
};
__device__ __forceinline__ float silu_f(float x) { return x * __builtin_amdgcn_rcpf(1.0f + __builtin_amdgcn_exp2f(-1.4426950408889634f * x)); }
struct EpiSwiGLU {
    static constexpr bool PERM = true, AFTER_DRAIN = false;
    bf16_t* O; int ldc; int nmod;
    __device__ __forceinline__ void operator()(const f32x4 (&acc)[2][2][4][2], const Unit& u, int wr, int wc, int fr, int fq) const {
        const int pnl = nmod ? (u.pn % nmod) : u.pn;
        const int row0 = u.pm * BM + wr * 64 + fr, col0 = pnl * HALF + wc * 32 + 8 * fq;
#pragma unroll
        for (int ai = 0; ai < 2; ++ai)
#pragma unroll
            for (int m = 0; m < 4; ++m) { bf16_t* rowp = O + (size_t)(row0 + ai * HALF + m * 16) * ldc + col0;
                const f32x4 g0 = acc[ai][0][m][0], g1 = acc[ai][0][m][1], u0 = acc[ai][1][m][0], u1 = acc[ai][1][m][1];
                u32x4 w;
                w.x = cvt_pk_bf16(silu_f(g0[0]) * u0[0], silu_f(g0[1]) * u0[1]); w.y = cvt_pk_bf16(silu_f(g0[2]) * u0[2], silu_f(g0[3]) * u0[3]);
                w.z = cvt_pk_bf16(silu_f(g1[0]) * u1[0], silu_f(g1[1]) * u1[1]); w.w = cvt_pk_bf16(silu_f(g1[2]) * u1[2], silu_f(g1[3]) * u1[3]);
                *(u32x4*)rowp = w; }
    }
};
struct EpiResid {
    static constexpr bool PERM = false, AFTER_DRAIN = false;
    const float* res; float* out; int ldc; float alpha;
    __device__ __forceinline__ void operator()(const f32x4 (&acc)[2][2][4][2], const Unit& u, int wr, int wc, int fr, int fq) const {
        const int row0 = u.pm * BM + wr * 64 + fr, col0 = u.pn * BM + wc * 32 + 4 * fq;
#pragma unroll
        for (int ai = 0; ai < 2; ++ai)
#pragma unroll
            for (int m = 0; m < 4; ++m) { const size_t off = (size_t)(row0 + ai * HALF + m * 16) * ldc + col0;
#pragma unroll
                for (int bj = 0; bj < 2; ++bj)
#pragma unroll
                    for (int n = 0; n < 2; ++n) { const f32x4 r = *(const f32x4*)(res + off + bj * HALF + n * 16);
                        *(f32x4*)(out + off + bj * HALF + n * 16) = r * alpha + acc[ai][bj][m][n]; } }
    }
};
struct MoeOrder {
    int nM, nN, nwg, G, c, rep; int ps1, ps2, ps3, ps4, ps5, ps6, ps7;
    __device__ __forceinline__ bool next(int i, Unit& u) const {
        const long L = (long)i * G + c; if (nwg == 0 || L >= (long)rep * nwg) return false;
        int wgid = (int)(L % nwg); { const int q = nwg / NXCD, r = nwg % NXCD, xcd = wgid % NXCD, off = wgid / NXCD; wgid = (xcd < r ? xcd * (q + 1) : r * (q + 1) + (xcd - r) * q) + off; }
        const int nig = WGM * nN, gid = wgid / nig, fm = gid * WGM, gsz = (nM - fm) < WGM ? (nM - fm) : WGM;
        const int pm = fm + ((wgid % nig) % gsz), pnl = (wgid % nig) / gsz;
        const int e = (pm >= ps1) + (pm >= ps2) + (pm >= ps3) + (pm >= ps4) + (pm >= ps5) + (pm >= ps6) + (pm >= ps7);
        u.pm = pm; u.pn = e * nN + pnl; return true;
    }
    __device__ __forceinline__ void a_ready(const Unit&) const {}
    __device__ __forceinline__ void done(const Unit&) const {}
};
template <class Epi, class Sched, bool ALIGN_EPI = false, bool SP2 = false>
__device__ __forceinline__ void gemm_phase(PG8_LAS unsigned char* lds, const Gemm g, const Sched& S, const Epi& E) {
    const int tid = threadIdx.x, wid = __builtin_amdgcn_readfirstlane(tid >> 6), lane = tid & 63, wr = wid >> 2, wc = wid & 3, fr = lane & 15, fq = lane >> 4;
    const int K = g.K, nt = K / BK;
    unsigned voffA[2], voffB[2];
#pragma unroll
    for (int i = 0; i < 2; ++i) { int R, C; stage_rc(tid * 16 + i * 8192, R, C); const int Rb = Epi::PERM ? ((R & ~31) + perm32(R & 31)) : R;
        voffA[i] = (unsigned)(R * g.lda + C) * 2u; voffB[i] = (unsigned)(Rb * K + C) * 2u; }
    const size_t kstep = (size_t)(BK * 2);
    const size_t hstepA = (size_t)HALF * g.lda * 2, hstepB = (size_t)HALF * K * 2;
    const size_t tstepA = 2 * hstepA, tstepB = 2 * hstepB;
    const unsigned ldsw = (unsigned)wid * 1024u;
    const int aoff = lds_byte(wr * 64 + fr, fq * 8), boff = lds_byte(wc * 32 + fr, fq * 8);
#define PG8_SA(b, h) (((b) * 2 + (h)) * HTB)
#define PG8_SB(b, h) ((4 + (b) * 2 + (h)) * HTB)
#define PG8_STAGE(bufoff, gbase, voff) do { _Pragma("unroll") for (int _i = 0; _i < 2; ++_i) \
        __builtin_amdgcn_global_load_lds((const unsigned*)((const char*)(gbase) + (voff)[_i]), (PG8_LAS unsigned*)(lds + (bufoff) + ldsw + _i * 8192), 16, 0, 0); } while (0)
#define PG8_LDA(dst, b, h) do { _Pragma("unroll") for (int m = 0; m < 4; ++m) _Pragma("unroll") for (int k = 0; k < 2; ++k) dst[m][k] = *(const PG8_LAS bf16x8*)(lds + PG8_SA(b, h) + aoff + m * 2048 + k * 1024); } while (0)
#define PG8_LDB(dst, b, h) do { _Pragma("unroll") for (int n = 0; n < 2; ++n) _Pragma("unroll") for (int k = 0; k < 2; ++k) dst[n][k] = *(const PG8_LAS bf16x8*)(lds + PG8_SB(b, h) + boff + n * 2048 + k * 1024); } while (0)
#define PG8_MMA(ai, bj, At, Bt) do { __builtin_amdgcn_s_setprio(1); _Pragma("unroll") for (int m = 0; m < 4; ++m) _Pragma("unroll") for (int n = 0; n < 2; ++n) _Pragma("unroll") for (int k = 0; k < 2; ++k) \
        acc[ai][bj][m][n] = __builtin_amdgcn_mfma_f32_16x16x32_bf16(Bt[n][k], At[m][k], acc[ai][bj][m][n], 0, 0, 0); __builtin_amdgcn_s_setprio(0); } while (0)
#define PG8_WAIT_V(n) asm volatile("s_waitcnt vmcnt(" #n ")" ::: "memory")
#define PG8_WAIT_L(n) asm volatile("s_waitcnt lgkmcnt(" #n ")" ::: "memory")
#define PG8_BAR __builtin_amdgcn_s_barrier()
#define PG8_SCHED __builtin_amdgcn_sched_barrier(0)
    Unit cur, nxt; int ui = 0;
    if (!S.next(0, cur)) return;
    f32x4 acc[2][2][4][2];
#pragma unroll
    for (int a = 0; a < 2; ++a)
#pragma unroll
        for (int b = 0; b < 2; ++b)
#pragma unroll
            for (int m = 0; m < 4; ++m)
#pragma unroll
                for (int n = 0; n < 2; ++n) acc[a][b][m][n] = (f32x4){0.f, 0.f, 0.f, 0.f};
    bf16x8 At[4][2], B0[2][2], B1[2][2];
    const char* cA = (const char*)g.A + (size_t)cur.pm * tstepA; const char* cB = (const char*)g.Bt + (size_t)cur.pn * tstepB;
    S.a_ready(cur);
    if constexpr (SP2) {
        PG8_STAGE(PG8_SB(0, 0), cB, voffB); PG8_STAGE(PG8_SB(0, 1), cB + hstepB, voffB); PG8_STAGE(PG8_SA(0, 0), cA, voffA); PG8_STAGE(PG8_SA(0, 1), cA + hstepA, voffA);
        if (wr == 1) PG8_BAR;
        PG8_WAIT_V(2); PG8_BAR;
        PG8_STAGE(PG8_SB(1, 0), cB + kstep, voffB); PG8_STAGE(PG8_SA(1, 0), cA + kstep, voffA); PG8_STAGE(PG8_SB(1, 1), cB + hstepB + kstep, voffB);
        PG8_WAIT_V(6); PG8_BAR;
    } else {
        PG8_STAGE(PG8_SB(0, 0), cB, voffB); PG8_STAGE(PG8_SA(0, 0), cA, voffA); PG8_STAGE(PG8_SB(0, 1), cB + hstepB, voffB); PG8_STAGE(PG8_SA(0, 1), cA + hstepA, voffA);
        if (wr == 1) PG8_BAR;
        PG8_WAIT_V(4); PG8_BAR;
        PG8_STAGE(PG8_SB(1, 0), cB + kstep, voffB); PG8_STAGE(PG8_SA(1, 0), cA + kstep, voffA); PG8_STAGE(PG8_SB(1, 1), cB + hstepB + kstep, voffB);
        PG8_WAIT_V(6); PG8_BAR;
    }
    for (;;) {
        const bool has_next = S.next(ui + 1, nxt);
        const char* nA = has_next ? (const char*)g.A + (size_t)nxt.pm * tstepA : cA; const char* nB = has_next ? (const char*)g.Bt + (size_t)nxt.pn * tstepB : cB;
        for (int t = 0; t < nt; t += 2) {
            const bool last = (t == nt - 2);
            const char* a1 = cA + (size_t)(t + 1) * kstep;
            const char* a2 = last ? nA : cA + (size_t)(t + 2) * kstep; const char* b2 = last ? nB : cB + (size_t)(t + 2) * kstep;
            const char* a3 = a2 + kstep; const char* b3 = b2 + kstep;
            if (last && has_next) S.a_ready(nxt);
            if constexpr (SP2) {
            PG8_LDB(B0, 0, 0); PG8_LDB(B1, 0, 1); PG8_SCHED; PG8_LDA(At, 0, 0); PG8_STAGE(PG8_SA(1, 1), a1 + hstepA, voffA);
            PG8_WAIT_V(8); PG8_WAIT_L(0); PG8_BAR; PG8_MMA(0, 0, At, B0); PG8_MMA(0, 1, At, B1); PG8_BAR; PG8_SCHED;
            PG8_LDA(At, 0, 1); PG8_STAGE(PG8_SB(0, 0), b2, voffB); PG8_STAGE(PG8_SB(0, 1), b2 + hstepB, voffB); PG8_STAGE(PG8_SA(0, 0), a2, voffA);
            PG8_WAIT_V(8); PG8_WAIT_L(0); PG8_BAR; PG8_MMA(1, 0, At, B0); PG8_MMA(1, 1, At, B1); PG8_BAR; PG8_SCHED;
            PG8_LDB(B0, 1, 0); PG8_LDB(B1, 1, 1); PG8_SCHED; PG8_LDA(At, 1, 0); PG8_STAGE(PG8_SA(0, 1), a2 + hstepA, voffA);
            PG8_WAIT_V(8); PG8_WAIT_L(0); PG8_BAR; PG8_MMA(0, 0, At, B0); PG8_MMA(0, 1, At, B1); PG8_BAR; PG8_SCHED;
            PG8_LDA(At, 1, 1); PG8_STAGE(PG8_SB(1, 0), b3, voffB); PG8_STAGE(PG8_SB(1, 1), b3 + hstepB, voffB); PG8_STAGE(PG8_SA(1, 0), a3, voffA);
            PG8_WAIT_V(8); PG8_WAIT_L(0); PG8_BAR; PG8_MMA(1, 0, At, B0); PG8_MMA(1, 1, At, B1); PG8_BAR; PG8_SCHED;
            } else {
            PG8_LDB(B0, 0, 0); PG8_SCHED; PG8_LDA(At, 0, 0); PG8_STAGE(PG8_SA(1, 1), a1 + hstepA, voffA);
            PG8_WAIT_L(8); PG8_BAR; PG8_WAIT_L(0); PG8_MMA(0, 0, At, B0); PG8_BAR; PG8_SCHED;
            PG8_LDB(B1, 0, 1); PG8_STAGE(PG8_SB(0, 0), b2, voffB);
            PG8_BAR; PG8_WAIT_L(0); PG8_MMA(0, 1, At, B1); PG8_BAR;
            PG8_LDA(At, 0, 1); PG8_STAGE(PG8_SA(0, 0), a2, voffA);
            PG8_BAR; PG8_WAIT_L(0); PG8_MMA(1, 0, At, B0); PG8_BAR; PG8_SCHED;
            PG8_STAGE(PG8_SB(0, 1), b2 + hstepB, voffB);
            PG8_WAIT_V(6); PG8_BAR; PG8_MMA(1, 1, At, B1); PG8_BAR;
            PG8_LDB(B0, 1, 0); PG8_SCHED; PG8_LDA(At, 1, 0); PG8_STAGE(PG8_SA(0, 1), a2 + hstepA, voffA);
            PG8_WAIT_L(8); PG8_BAR; PG8_WAIT_L(0); PG8_MMA(0, 0, At, B0); PG8_BAR; PG8_SCHED;
            PG8_LDB(B1, 1, 1); PG8_STAGE(PG8_SB(1, 0), b3, voffB);
            PG8_BAR; PG8_WAIT_L(0); PG8_MMA(0, 1, At, B1); PG8_BAR;
            PG8_LDA(At, 1, 1); PG8_STAGE(PG8_SA(1, 0), a3, voffA);
            PG8_BAR; PG8_WAIT_L(0); PG8_MMA(1, 0, At, B0); PG8_BAR; PG8_SCHED;
            PG8_STAGE(PG8_SB(1, 1), b3 + hstepB, voffB);
            PG8_WAIT_V(6); PG8_BAR; PG8_MMA(1, 1, At, B1); PG8_BAR;
            }
        }
        if constexpr (ALIGN_EPI) { if (wr == 0) PG8_BAR; }
        if constexpr (!Epi::AFTER_DRAIN) { E(acc, cur, wr, wc, fr, fq); S.done(cur); }
        if (!has_next) break;
#pragma unroll
        for (int a = 0; a < 2; ++a)
#pragma unroll
            for (int b = 0; b < 2; ++b)
#pragma unroll
                for (int m = 0; m < 4; ++m)
#pragma unroll
                    for (int n = 0; n < 2; ++n) acc[a][b][m][n] = (f32x4){0.f, 0.f, 0.f, 0.f};
        cur = nxt; cA = nA; cB = nB; ++ui;
        if constexpr (ALIGN_EPI) { if (wr == 1) PG8_BAR; }
    }
    PG8_WAIT_V(0);
    if constexpr (!ALIGN_EPI) { if (wr == 0) PG8_BAR; }
    PG8_BAR;
    if constexpr (Epi::AFTER_DRAIN) { E.fused(acc, cur, wr, wc, fr, fq, lds, wid, lane); S.done(cur); }
#undef PG8_SA
#undef PG8_SB
#undef PG8_STAGE
#undef PG8_LDA
#undef PG8_LDB
#undef PG8_MMA
#undef PG8_WAIT_V
#undef PG8_WAIT_L
#undef PG8_BAR
#undef PG8_SCHED
}
}

constexpr int NWAVES = 8;
constexpr int BATCH = 8, SEQ = 4096, TT = BATCH * SEQ, D = 1024;
constexpr int HK = 8, HV = 16, HD = 128;
constexpr int GIN = 6176, GINP = 6400;
constexpr int FF = 3584, NE = 8, MOE_ROWS = 67584;
constexpr float ALPHA = 1.6817928305074290f;
constexpr float LN_EPS = 1e-5f, RMS_EPS = 1e-6f;
constexpr int NPH = 18, NPHASES = 2 * NPH;

constexpr size_t MiB = 1ull << 20;
constexpr size_t WS_CTL = 0, CTL_ZERO_BYTES = 1 * MiB;
constexpr size_t WS_E12 = 1 * MiB;
constexpr size_t WS_G12 = WS_E12 + 256 * 1024;
constexpr size_t WS_POS = WS_G12 + 256 * 1024;
constexpr size_t WS_GB = 2 * MiB;
constexpr size_t WS_W = 16 * MiB;
constexpr size_t W_IN = WS_W, W_OUT = WS_W + 13 * MiB, W_GU = WS_W + 17 * MiB, W_D = WS_W + 31 * MiB;
constexpr size_t W_QKV = WS_W, W_O = WS_W + 6 * MiB, W_MGU = WS_W + 8 * MiB, W_MD = WS_W + 120 * MiB;
constexpr size_t WS_HB = 192 * MiB;
constexpr size_t WS_BIG = 256 * MiB;
constexpr size_t WS_ZB = WS_BIG, WS_RAW = WS_BIG + 128 * MiB, WS_QKVC = WS_BIG + 400 * MiB;
constexpr int RAWLD = 4352;
constexpr size_t WS_WMEM = WS_RAW, WS_IMEM = WS_RAW + 128 * MiB, WS_KTMEM = WS_RAW + 192 * MiB;
constexpr size_t WS_GTAB = 6 * MiB;
constexpr size_t WS_ACT = WS_BIG;
constexpr size_t WS_QKV = WS_BIG, WS_AO = WS_BIG + 192 * MiB;
constexpr size_t WS_XS = WS_BIG, WS_MACT = WS_BIG + 132 * MiB;
constexpr size_t WS_END = 912 * MiB;
static_assert(WS_QKVC + (size_t)TT * 4096 * 2 <= WS_END && WS_MACT + (size_t)MOE_ROWS * FF * 2 <= WS_END && WS_RAW + (size_t)TT * RAWLD * 2 <= WS_QKVC && WS_KTMEM + (size_t)4096 * 8192 * 2 <= WS_QKVC && WS_GTAB + (size_t)8192 * 192 * 4 <= WS_W, "d_ws map");
static_assert(W_MD + (size_t)NE * D * FF * 2 <= WS_HB && W_IN + (size_t)GINP * D * 2 <= W_OUT && W_MGU + (size_t)NE * 2 * FF * D * 2 <= W_MD, "weight map");
constexpr int CW_BAR = 4096;
constexpr int CW_CNT = 16384;

constexpr int RING_BYTES = 131072;
constexpr int MISC_OFF = RING_BYTES + 320;
constexpr int OGST_OFF = 147456;
constexpr int LDS_BYTES = 163840;

#define GAS __attribute__((address_space(1)))
#define LAS __attribute__((address_space(3)))
#define DI __device__ __forceinline__
typedef unsigned short bf16;
typedef unsigned v4u __attribute__((ext_vector_type(4)));
typedef unsigned v2u __attribute__((ext_vector_type(2)));
typedef float f32x4 __attribute__((ext_vector_type(4)));
typedef float f32x2 __attribute__((ext_vector_type(2)));
typedef GAS unsigned gu32;
#define RLX_AGENT __ATOMIC_RELAXED, __HIP_MEMORY_SCOPE_AGENT
#define LDS_WAIT() asm volatile("s_waitcnt lgkmcnt(0)" ::: "memory")
#define VM_WAIT() asm volatile("s_waitcnt vmcnt(0)" ::: "memory")
__device__ __forceinline__ unsigned long long rt() { return __builtin_amdgcn_s_memrealtime(); }
__device__ __forceinline__ unsigned f2bf(float f) { unsigned u = __builtin_bit_cast(unsigned, f); return (u + 0x7fffu + ((u >> 16) & 1u)) >> 16; }
__device__ __forceinline__ unsigned pk2(float lo, float hi) { return f2bf(lo) | (f2bf(hi) << 16); }

#define XB_TMO      128
#define XB_XCNT(j)  (256  + 64 * (j))
#define XB_XSUB(j)  (1280 + 64 * (j))
#define XB_XGEN(j)  (2304 + 64 * (j))
#define XB_TOP      3328
#define XB_TOPGEN   3392
#define XCD_BAR_WORDS 3456
#define XB_SPIN_CAP (1u << 22)

__device__ __forceinline__ unsigned xb_ld(unsigned* p)              { return __hip_atomic_load(p, __ATOMIC_RELAXED, __HIP_MEMORY_SCOPE_AGENT); }
__device__ __forceinline__ unsigned xb_add(unsigned* p, unsigned v) { return __hip_atomic_fetch_add(p, v, __ATOMIC_RELAXED, __HIP_MEMORY_SCOPE_AGENT); }
__device__ __forceinline__ unsigned xb_xcc_id() { return (unsigned)__builtin_amdgcn_s_getreg((3 << 11) | 20) & 0xFu; }
#define XB_SPIN(cond, bar) do { unsigned _sp = 0; while (cond) { __builtin_amdgcn_s_sleep(1); \
    if ((++_sp & 255u) == 0u) { if (xb_ld(&(bar)[XB_TMO])) break; if (_sp > XB_SPIN_CAP) { atomicAdd(&(bar)[XB_TMO], 1u); break; } } } } while (0)

struct XcdBarrier {
    unsigned* bar; unsigned x;
    volatile LAS unsigned* st;
};

__device__ __forceinline__ XcdBarrier xcd_barrier_post(unsigned* bar, volatile LAS unsigned* st) {
    XcdBarrier b; b.bar = bar; b.x = xb_xcc_id(); b.st = st;
    if (threadIdx.x == 0) (void)xb_add(&bar[XB_XCNT(b.x)], 1u);
    return b;
}
__device__ __forceinline__ void xcd_barrier_complete(unsigned* bar, unsigned x, unsigned& nloc, unsigned& nx) {
    const unsigned G = gridDim.x * gridDim.y * gridDim.z;
    unsigned sum, cnt, mine, sp = 0u;
    for (;;) {
        sum = 0u; cnt = 0u; mine = 0u;
#pragma unroll
        for (unsigned j = 0; j < 16; ++j) { const unsigned c = xb_ld(&bar[XB_XCNT(j)]); sum += c; cnt += (c > 0u) ? 1u : 0u; mine = (j == x) ? c : mine; }
        if (sum == G) break;
        __builtin_amdgcn_s_sleep(1);
        if ((++sp & 255u) == 0u) { if (xb_ld(&bar[XB_TMO])) break; if (sp > XB_SPIN_CAP) { atomicAdd(&bar[XB_TMO], 1u); break; } }
    }
    nloc = mine > 0u ? mine : 1u; nx = cnt > 0u ? cnt : 1u;
}

__device__ __forceinline__ void xcd_barrier(const XcdBarrier& b) {
    asm volatile("s_waitcnt vmcnt(0)" ::: "memory");
    __syncthreads();
    if (threadIdx.x == 0) {
        unsigned* bar = b.bar;
        __builtin_amdgcn_s_waitcnt(0);
        unsigned nloc = b.st[0], nx = b.st[1];
        if (nloc == 0u) { xcd_barrier_complete(bar, b.x, nloc, nx); b.st[0] = nloc; b.st[1] = nx; }
        const unsigned old = xb_add(&bar[XB_XSUB(b.x)], 1u);
        const unsigned gen = old / nloc;
        if (old + 1u == (gen + 1u) * nloc) {
            __builtin_amdgcn_fence(__ATOMIC_RELEASE, "agent");
            asm volatile("s_waitcnt vmcnt(0)" ::: "memory");
            const unsigned og = xb_add(&bar[XB_TOP], 1u);
            const unsigned tg = og / nx;
            if (og + 1u == (tg + 1u) * nx) xb_add(&bar[XB_TOPGEN], 1u);
            else XB_SPIN(xb_ld(&bar[XB_TOPGEN]) == tg, bar);
            __builtin_amdgcn_fence(__ATOMIC_ACQUIRE, "agent");
            xb_add(&bar[XB_XGEN(b.x)], 1u);
            asm volatile("s_waitcnt vmcnt(0)" ::: "memory");
        } else {
            XB_SPIN(xb_ld(&bar[XB_XGEN(b.x)]) == gen, bar);
            __builtin_amdgcn_fence(__ATOMIC_ACQUIRE, "agent");
            asm volatile("s_waitcnt vmcnt(0)" ::: "memory");
        }
    }
    __syncthreads();
}

DI float bf_lo(unsigned w) { return __uint_as_float(w << 16); }
DI float bf_hi(unsigned w) { return __uint_as_float(w & 0xffff0000u); }
DI float wave_sum(float v) {
#pragma unroll
    for (int o = 1; o < 64; o <<= 1) v += __shfl_xor(v, o);
    return v;
}
DI float sigmoid_f(float x) { return 1.0f / (1.0f + __expf(-x)); }

struct Args {
    const float *x, *gdn_w_in, *gdn_conv_w, *gdn_a_log, *gdn_dt_bias, *gdn_norm_w, *gdn_w_out, *sb_w_in, *sb_w_out, *ffn_w_gate, *ffn_w_up, *ffn_w_down,
                *moe_router, *moe_w_gate, *moe_w_up, *moe_w_down, *ln_g, *ln_b;
    float* out; unsigned char* ws; int ph_lo, ph_hi;
};

DI void transpose_item(const float* W, int ldw, bf16* WT, int K, int drow0, int k0, int n0, LAS float* scr, int lane) {
#pragma unroll 8
    for (int i = 0; i < 32; ++i) { const int kk = 2 * i + (lane >> 5); scr[kk * 33 + (lane & 31)] = W[(size_t)(k0 + kk) * ldw + n0 + (lane & 31)]; }
    LDS_WAIT(); asm volatile("" ::: "memory");
    const int c = lane & 7;
#pragma unroll
    for (int jj = 0; jj < 4; ++jj) { const int n = (lane >> 3) + 8 * jj; const LAS float* s = scr + (8 * c) * 33 + n;
        v4u o; o.x = pk2(s[0 * 33], s[1 * 33]); o.y = pk2(s[2 * 33], s[3 * 33]); o.z = pk2(s[4 * 33], s[5 * 33]); o.w = pk2(s[6 * 33], s[7 * 33]);
        *(v4u*)(WT + (size_t)(drow0 + n) * K + k0 + 8 * c) = o; }
    LDS_WAIT(); asm volatile("" ::: "memory");
}

DI void phase_w_gdn(const Args& a, int j, LAS unsigned char* lds, int bid, int G, int tid, int wave, int lane) {
    LAS float* scr = (LAS float*)(lds + wave * 16384);
    const int gw = bid * NWAVES + wave, NGW = G * NWAVES;
    const float* Win = a.gdn_w_in + (size_t)j * D * GIN; const float* Wout = a.gdn_w_out + (size_t)j * 2048 * D;
    const float* Wg = a.ffn_w_gate + (size_t)j * D * FF; const float* Wu = a.ffn_w_up + (size_t)j * D * FF; const float* Wd = a.ffn_w_down + (size_t)j * FF * D;
    bf16* WIN_T = (bf16*)(a.ws + W_IN); bf16* WOUT_T = (bf16*)(a.ws + W_OUT); bf16* WGU_T = (bf16*)(a.ws + W_GU); bf16* WD_T = (bf16*)(a.ws + W_D);
    constexpr int NB_IN = GIN / 32, I_IN = 16 * NB_IN, I_OUT = 32 * 32, I_G = 16 * 112, I_D = 56 * 32, NIT = I_IN + I_OUT + 2 * I_G + I_D;
    for (int it = gw; it < NIT; it += NGW) {
        int r = it;
        if (r < I_IN) { const int kb = r / NB_IN, nb = r % NB_IN; transpose_item(Win, GIN, WIN_T, D, 32 * nb, 64 * kb, 32 * nb, scr, lane); continue; } r -= I_IN;
        if (r < I_OUT) { const int kb = r / 32, nb = r % 32; transpose_item(Wout, D, WOUT_T, 2048, 32 * nb, 64 * kb, 32 * nb, scr, lane); continue; } r -= I_OUT;
        if (r < I_G) { const int kb = r / 112, nb = r % 112, n0 = 32 * nb; transpose_item(Wg, FF, WGU_T, D, 256 * (n0 >> 7) + (n0 & 127), 64 * kb, n0, scr, lane); continue; } r -= I_G;
        if (r < I_G) { const int kb = r / 112, nb = r % 112, n0 = 32 * nb; transpose_item(Wu, FF, WGU_T, D, 256 * (n0 >> 7) + 128 + (n0 & 127), 64 * kb, n0, scr, lane); continue; } r -= I_G;
        { const int kb = r / 32, nb = r % 32; transpose_item(Wd, D, WD_T, FF, 32 * nb, 64 * kb, 32 * nb, scr, lane); }
    }
    if (j == 0) {
        bf16* HB = (bf16*)(a.ws + WS_HB); const f32x4* x4 = (const f32x4*)a.x;
        for (size_t i = (size_t)bid * 512 + tid; i < (size_t)TT * D / 8; i += (size_t)G * 512) { const f32x4 p = x4[2 * i], q = x4[2 * i + 1];
            v4u o; o.x = pk2(p[0], p[1]); o.y = pk2(p[2], p[3]); o.z = pk2(q[0], q[1]); o.w = pk2(q[2], q[3]); *(v4u*)(HB + 8 * i) = o; }
    }
}
DI void phase_w_sb(const Args& a, int j, LAS unsigned char* lds, int bid, int G, int wave, int lane) {
    LAS float* scr = (LAS float*)(lds + wave * 16384);
    const int gw = bid * NWAVES + wave, NGW = G * NWAVES;
    const float* Wqkv = a.sb_w_in + (size_t)j * D * 3072; const float* Wo = a.sb_w_out + (size_t)j * D * D;
    const float* Mg = a.moe_w_gate + (size_t)j * NE * D * FF; const float* Mu = a.moe_w_up + (size_t)j * NE * D * FF; const float* Md = a.moe_w_down + (size_t)j * NE * FF * D;
    bf16* WQKV_T = (bf16*)(a.ws + W_QKV); bf16* WO_T = (bf16*)(a.ws + W_O); bf16* MGU_T = (bf16*)(a.ws + W_MGU); bf16* MD_T = (bf16*)(a.ws + W_MD);
    constexpr int I_QKV = 16 * 96, I_O = 16 * 32, I_G = 16 * 112, I_D = 56 * 32, I_E = 2 * I_G + I_D, NIT = I_QKV + I_O + NE * I_E;
    for (int it = gw; it < NIT; it += NGW) {
        int r = it;
        if (r < I_QKV) { const int kb = r / 96, nb = r % 96; transpose_item(Wqkv, 3072, WQKV_T, D, 32 * nb, 64 * kb, 32 * nb, scr, lane); continue; } r -= I_QKV;
        if (r < I_O) { const int kb = r / 32, nb = r % 32; transpose_item(Wo, D, WO_T, D, 32 * nb, 64 * kb, 32 * nb, scr, lane); continue; } r -= I_O;
        const int e = r / I_E; r -= e * I_E;
        bf16* gu = MGU_T + (size_t)e * 2 * FF * D; bf16* dn = MD_T + (size_t)e * D * FF;
        if (r < I_G) { const int kb = r / 112, nb = r % 112, n0 = 32 * nb; transpose_item(Mg + (size_t)e * D * FF, FF, gu, D, 256 * (n0 >> 7) + (n0 & 127), 64 * kb, n0, scr, lane); continue; } r -= I_G;
        if (r < I_G) { const int kb = r / 112, nb = r % 112, n0 = 32 * nb; transpose_item(Mu + (size_t)e * D * FF, FF, gu, D, 256 * (n0 >> 7) + 128 + (n0 & 127), 64 * kb, n0, scr, lane); continue; } r -= I_G;
        { const int kb = r / 32, nb = r % 32; transpose_item(Md + (size_t)e * FF * D, D, dn, FF, 32 * nb, 64 * kb, 32 * nb, scr, lane); }
    }
}

DI float dpp_sum16(float v) {
    v += __builtin_bit_cast(float, __builtin_amdgcn_update_dpp(0, __builtin_bit_cast(int, v), 0xB1, 0xF, 0xF, false));
    v += __builtin_bit_cast(float, __builtin_amdgcn_update_dpp(0, __builtin_bit_cast(int, v), 0x4E, 0xF, 0xF, false));
    v += __builtin_bit_cast(float, __builtin_amdgcn_update_dpp(0, __builtin_bit_cast(int, v), 0x141, 0xF, 0xF, false));
    v += __builtin_bit_cast(float, __builtin_amdgcn_update_dpp(0, __builtin_bit_cast(int, v), 0x140, 0xF, 0xF, false));
    return v;
}
DI void phase_conv(const Args& a, int j, int bid, int G, int tid) {
    const bf16* raw = (const bf16*)(a.ws + WS_RAW); bf16* qkvc = (bf16*)(a.ws + WS_QKVC); float* gb = (float*)(a.ws + WS_GB);
    const float* cw = a.gdn_conv_w + (size_t)j * 4 * 4096;
    const int ch = 8 * tid;
    float w0[8], w1[8], w2[8], w3[8];
#pragma unroll
    for (int i = 0; i < 8; ++i) { w0[i] = cw[ch + i]; w1[i] = cw[4096 + ch + i]; w2[i] = cw[2 * 4096 + ch + i]; w3[i] = cw[3 * 4096 + ch + i]; }
    const float post = tid < 128 ? 0.08838834764831845f : 1.0f;
    for (int run = bid; run < TT / 128; run += G) {
        const int t0 = run * 128; const bool first = (t0 & (SEQ - 1)) == 0;
        float xa[8], xb[8], xc[8];
        { v4u h0 = {0u, 0u, 0u, 0u}, h1 = h0, h2 = h0;
          if (!first) { h0 = *(const v4u*)(raw + (size_t)(t0 - 3) * RAWLD + ch); h1 = *(const v4u*)(raw + (size_t)(t0 - 2) * RAWLD + ch); h2 = *(const v4u*)(raw + (size_t)(t0 - 1) * RAWLD + ch); }
          xa[0] = bf_lo(h0.x); xa[1] = bf_hi(h0.x); xa[2] = bf_lo(h0.y); xa[3] = bf_hi(h0.y); xa[4] = bf_lo(h0.z); xa[5] = bf_hi(h0.z); xa[6] = bf_lo(h0.w); xa[7] = bf_hi(h0.w);
          xb[0] = bf_lo(h1.x); xb[1] = bf_hi(h1.x); xb[2] = bf_lo(h1.y); xb[3] = bf_hi(h1.y); xb[4] = bf_lo(h1.z); xb[5] = bf_hi(h1.z); xb[6] = bf_lo(h1.w); xb[7] = bf_hi(h1.w);
          xc[0] = bf_lo(h2.x); xc[1] = bf_hi(h2.x); xc[2] = bf_lo(h2.y); xc[3] = bf_hi(h2.y); xc[4] = bf_lo(h2.z); xc[5] = bf_hi(h2.z); xc[6] = bf_lo(h2.w); xc[7] = bf_hi(h2.w); }
#pragma unroll 1
        for (int tb = 0; tb < 128; tb += 8) {
            v4u xr[8];
#pragma unroll
            for (int u = 0; u < 8; ++u) xr[u] = *(const v4u*)(raw + (size_t)(t0 + tb + u) * RAWLD + ch);
#pragma unroll
            for (int u = 0; u < 8; ++u) {
                float xd[8]; xd[0] = bf_lo(xr[u].x); xd[1] = bf_hi(xr[u].x); xd[2] = bf_lo(xr[u].y); xd[3] = bf_hi(xr[u].y); xd[4] = bf_lo(xr[u].z); xd[5] = bf_hi(xr[u].z); xd[6] = bf_lo(xr[u].w); xd[7] = bf_hi(xr[u].w);
                float y[8]; float ss = 0.f;
#pragma unroll
                for (int i = 0; i < 8; ++i) { const float c = w0[i] * xa[i] + w1[i] * xb[i] + w2[i] * xc[i] + w3[i] * xd[i];
                    y[i] = c * __builtin_amdgcn_rcpf(1.0f + __builtin_amdgcn_exp2f(-1.4426950408889634f * c)); ss += y[i] * y[i];
                    xa[i] = xb[i]; xb[i] = xc[i]; xc[i] = xd[i]; }
                if (tid < 256) {
                    const float rn = post / sqrtf(dpp_sum16(ss) + RMS_EPS);
#pragma unroll
                    for (int i = 0; i < 8; ++i) y[i] *= rn;
                }
                v4u o; o.x = pk2(y[0], y[1]); o.y = pk2(y[2], y[3]); o.z = pk2(y[4], y[5]); o.w = pk2(y[6], y[7]);
                *(v4u*)(qkvc + (size_t)(t0 + tb + u) * 4096 + ch) = o;
            }
        }
#pragma unroll
        for (int k = 0; k < 4; ++k) { const int item = tid + 512 * k, tok = t0 + (item >> 4), hv = item & 15;
            const float bb = __uint_as_float((unsigned)raw[(size_t)tok * RAWLD + 4096 + hv] << 16), aa = __uint_as_float((unsigned)raw[(size_t)tok * RAWLD + 4112 + hv] << 16);
            const float xx = aa + a.gdn_dt_bias[j * 16 + hv];
            const float sp = xx > 20.f ? xx : log1pf(__expf(xx));
            gb[(size_t)tok * 32 + hv] = -__expf(a.gdn_a_log[j * 16 + hv]) * sp;
            gb[(size_t)tok * 32 + 16 + hv] = sigmoid_f(bb); }
    }
}

DI void phase_gdn_naive(const Args& a, int j, LAS unsigned char* lds, int bid, int tid) {
    if (bid >= BATCH * HV) return;
    const int b = bid / HV, hv = bid % HV, hk = hv / 2, jc = tid & 127, r = tid >> 7;
    const bf16* zb = (const bf16*)(a.ws + WS_ZB); bf16* qkvc = (bf16*)(a.ws + WS_QKVC); const float* gb = (const float*)(a.ws + WS_GB);
    LAS float* qs = (LAS float*)lds; LAS float* ks = qs + 2048; LAS float* vs = ks + 2048; LAS float* gs = vs + 2048; LAS float* bs = gs + 16;
    LAS f32x2* red = (LAS f32x2*)(lds + 32768); LAS float* redkq = (LAS float*)(lds + 32768 + 8192); LAS float* ob = (LAS float*)(lds + 49152);
    float S[32];
#pragma unroll
    for (int i = 0; i < 32; ++i) S[i] = 0.f;
    const int lrow = tid >> 5, lcol = (tid & 31) * 4;
    for (int blk = 0; blk < SEQ / 16; ++blk) {
        const size_t t0 = (size_t)b * SEQ + blk * 16;
        __syncthreads();
        { const bf16* rowp = qkvc + (t0 + lrow) * 4096;
          const v2u qv = *(const v2u*)(rowp + hk * 128 + lcol), kv = *(const v2u*)(rowp + 1024 + hk * 128 + lcol), vv = *(const v2u*)(rowp + 2048 + hv * 128 + lcol);
          *(LAS f32x4*)(qs + lrow * 128 + lcol) = (f32x4){bf_lo(qv.x), bf_hi(qv.x), bf_lo(qv.y), bf_hi(qv.y)};
          *(LAS f32x4*)(ks + lrow * 128 + lcol) = (f32x4){bf_lo(kv.x), bf_hi(kv.x), bf_lo(kv.y), bf_hi(kv.y)};
          *(LAS f32x4*)(vs + lrow * 128 + lcol) = (f32x4){bf_lo(vv.x), bf_hi(vv.x), bf_lo(vv.y), bf_hi(vv.y)};
          if (tid < 16) { gs[tid] = __expf(gb[(t0 + tid) * 32 + hv]); bs[tid] = gb[(t0 + tid) * 32 + 16 + hv]; } }
        __syncthreads();
#pragma unroll 1
        for (int tt = 0; tt < 16; ++tt) {
            float pk = 0.f, pq = 0.f, pkq = 0.f;
#pragma unroll
            for (int i4 = 0; i4 < 8; ++i4) { const f32x4 k4 = *(const LAS f32x4*)(ks + tt * 128 + 32 * r + 4 * i4), q4 = *(const LAS f32x4*)(qs + tt * 128 + 32 * r + 4 * i4);
#pragma unroll
                for (int c = 0; c < 4; ++c) { pk += k4[c] * S[4 * i4 + c]; pq += q4[c] * S[4 * i4 + c]; pkq += k4[c] * q4[c]; } }
            const int buf = tt & 1;
            red[(buf * 4 + r) * 128 + jc] = (f32x2){pk, pq}; if (jc == 0) redkq[buf * 4 + r] = pkq;
            __syncthreads();
            float kS = 0.f, qS = 0.f, kq = 0.f;
#pragma unroll
            for (int rr = 0; rr < 4; ++rr) { const f32x2 p = red[(buf * 4 + rr) * 128 + jc]; kS += p.x; qS += p.y; kq += redkq[buf * 4 + rr]; }
            const float eg = gs[tt], vn = bs[tt] * (vs[tt * 128 + jc] - eg * kS);
#pragma unroll
            for (int i4 = 0; i4 < 8; ++i4) { const f32x4 k4 = *(const LAS f32x4*)(ks + tt * 128 + 32 * r + 4 * i4);
#pragma unroll
                for (int c = 0; c < 4; ++c) S[4 * i4 + c] = eg * S[4 * i4 + c] + k4[c] * vn; }
            if (r == 0) ob[tt * 128 + jc] = eg * qS + kq * vn;
        }
        __syncthreads();
        {
            const f32x4 o4 = *(const LAS f32x4*)(ob + lrow * 128 + lcol);
            float ss = o4[0] * o4[0] + o4[1] * o4[1] + o4[2] * o4[2] + o4[3] * o4[3];
            ss += __shfl_xor(ss, 1); ss += __shfl_xor(ss, 2); ss += __shfl_xor(ss, 4); ss += __shfl_xor(ss, 8); ss += __shfl_xor(ss, 16);
            const float rinv = 1.0f / sqrtf(ss * (1.0f / 128.0f) + RMS_EPS);
            const v2u zv = *(const v2u*)(zb + (t0 + lrow) * 2048 + hv * 128 + lcol);
            const f32x4 nw = *(const f32x4*)(a.gdn_norm_w + j * 128 + lcol);
            const float z0 = bf_lo(zv.x), z1 = bf_hi(zv.x), z2 = bf_lo(zv.y), z3 = bf_hi(zv.y);
            v2u o; o.x = pk2(o4[0] * rinv * nw[0] * z0 * sigmoid_f(z0), o4[1] * rinv * nw[1] * z1 * sigmoid_f(z1));
            o.y = pk2(o4[2] * rinv * nw[2] * z2 * sigmoid_f(z2), o4[3] * rinv * nw[3] * z3 * sigmoid_f(z3));
            *(v2u*)(qkvc + (t0 + lrow) * 4096 + 2048 + hv * 128 + lcol) = o;
        }
    }
}

template <bool ROUTER>
DI void phase_ln(const Args& a, int lnidx, int j, LAS unsigned char* lds, int bid, int G, int tid, int wave, int lane) {
    float* out = a.out; bf16* HB = (bf16*)(a.ws + WS_HB);
    const float* g = a.ln_g + (size_t)lnidx * D; const float* bta = a.ln_b + (size_t)lnidx * D;
    const int gw = bid * NWAVES + wave, NGW = G * NWAVES;
    LAS unsigned* lcnt = (LAS unsigned*)lds;
    if (ROUTER) { if (tid < 8) lcnt[tid] = 0u; __syncthreads(); }
    f32x4 gv[4], bv[4];
#pragma unroll
    for (int q = 0; q < 4; ++q) { gv[q] = *(const f32x4*)(g + 4 * (lane + 64 * q)); bv[q] = *(const f32x4*)(bta + 4 * (lane + 64 * q)); }
    for (int t = gw; t < TT; t += NGW) {
        f32x4* row = (f32x4*)(out + (size_t)t * D);
        f32x4 v[4]; float s = 0.f;
#pragma unroll
        for (int q = 0; q < 4; ++q) { v[q] = row[lane + 64 * q]; s += (v[q][0] + v[q][1]) + (v[q][2] + v[q][3]); }
        const float mean = wave_sum(s) * (1.0f / D); float s2 = 0.f;
#pragma unroll
        for (int q = 0; q < 4; ++q) { v[q] = v[q] - mean; s2 += (v[q][0] * v[q][0] + v[q][1] * v[q][1]) + (v[q][2] * v[q][2] + v[q][3] * v[q][3]); }
        const float rstd = 1.0f / sqrtf(wave_sum(s2) * (1.0f / D) + LN_EPS);
#pragma unroll
        for (int q = 0; q < 4; ++q) { v[q] = v[q] * rstd * gv[q] + bv[q]; row[lane + 64 * q] = v[q];
            v2u o; o.x = pk2(v[q][0], v[q][1]); o.y = pk2(v[q][2], v[q][3]); *(v2u*)(HB + (size_t)t * D + 4 * (lane + 64 * q)) = o; }
        if (ROUTER) {
            const float* R = a.moe_router + (size_t)j * D * NE;
            float lg[8];
#pragma unroll
            for (int e = 0; e < 8; ++e) lg[e] = 0.f;
#pragma unroll
            for (int q = 0; q < 4; ++q)
#pragma unroll
                for (int c = 0; c < 4; ++c) { const int k = 4 * (lane + 64 * q) + c; const f32x4 r0 = *(const f32x4*)(R + k * 8), r1 = *(const f32x4*)(R + k * 8 + 4); const float hv = v[q][c];
                    lg[0] += hv * r0[0]; lg[1] += hv * r0[1]; lg[2] += hv * r0[2]; lg[3] += hv * r0[3]; lg[4] += hv * r1[0]; lg[5] += hv * r1[1]; lg[6] += hv * r1[2]; lg[7] += hv * r1[3]; }
#pragma unroll
            for (int e = 0; e < 8; ++e) lg[e] = wave_sum(lg[e]);
            int i1 = 0; float v1 = lg[0];
#pragma unroll
            for (int e = 1; e < 8; ++e) if (lg[e] > v1) { v1 = lg[e]; i1 = e; }
            int i2 = -1; float v2 = -3.0e38f;
#pragma unroll
            for (int e = 0; e < 8; ++e) if (e != i1 && lg[e] > v2) { v2 = lg[e]; i2 = e; }
            if (lane == 0) {
                const float g1 = 1.0f / (1.0f + __expf(v2 - v1));
                ((unsigned*)(a.ws + WS_E12))[t] = (unsigned)i1 | ((unsigned)i2 << 8);
                ((f32x2*)(a.ws + WS_G12))[t] = (f32x2){g1, 1.0f - g1};
                __hip_atomic_fetch_add(lcnt + i1, 1u, __ATOMIC_RELAXED, __HIP_MEMORY_SCOPE_WORKGROUP); __hip_atomic_fetch_add(lcnt + i2, 1u, __ATOMIC_RELAXED, __HIP_MEMORY_SCOPE_WORKGROUP);
            }
        }
    }
    if (ROUTER) { __syncthreads(); if (tid < 8) { unsigned* cnt = (unsigned*)(a.ws + WS_CTL) + CW_CNT + 256 * j; __hip_atomic_fetch_add(cnt + tid, lcnt[tid], __ATOMIC_RELAXED, __HIP_MEMORY_SCOPE_AGENT); } }
}

DI void phase_sb_naive(const Args& a, LAS unsigned char* lds, int bid, int G, int tid) {
    const bf16* qkv = (const bf16*)(a.ws + WS_QKV); bf16* ao = (bf16*)(a.ws + WS_AO);
    LAS unsigned char* Ks = lds; LAS unsigned char* Vs = lds + 16384;
    const int qi = tid >> 2, r = tid & 3;
    for (int idx = bid; idx < 64 * 32; idx += G) {
        const int qb = 31 - idx / 64, bh = idx % 64, b = bh >> 3, h = bh & 7;
        const int t = qb * 128 + qi;
        const size_t rowq = (size_t)b * SEQ + t;
        float q[32], o[32];
        { const bf16* qp = qkv + rowq * 3072 + h * 128 + 32 * r;
#pragma unroll
          for (int c = 0; c < 4; ++c) { const v4u w = *(const v4u*)(qp + 8 * c);
              q[8 * c + 0] = bf_lo(w.x); q[8 * c + 1] = bf_hi(w.x); q[8 * c + 2] = bf_lo(w.y); q[8 * c + 3] = bf_hi(w.y);
              q[8 * c + 4] = bf_lo(w.z); q[8 * c + 5] = bf_hi(w.z); q[8 * c + 6] = bf_lo(w.w); q[8 * c + 7] = bf_hi(w.w); }
#pragma unroll
          for (int i = 0; i < 32; ++i) { q[i] *= 0.08838834764831845f; o[i] = 0.f; } }
        float P = 1.0f;
        for (int kt = 2 * qb + 1; kt >= 0; --kt) {
            __syncthreads();
#pragma unroll
            for (int i = 0; i < 2; ++i) { const int c = tid + 512 * i, row = c >> 4, part = c & 15;
                const bf16* src = qkv + ((size_t)b * SEQ + kt * 64 + row) * 3072 + h * 128 + part * 8;
                *(LAS v4u*)(Ks + c * 16) = *(const v4u*)(src + 1024); *(LAS v4u*)(Vs + c * 16) = *(const v4u*)(src + 2048); }
            __syncthreads();
#pragma unroll 1
            for (int s = 63; s >= 0; --s) {
                float z = 0.f;
#pragma unroll
                for (int c = 0; c < 4; ++c) { const v4u w = *(const LAS v4u*)(Ks + s * 256 + r * 64 + c * 16);
                    z += q[8 * c + 0] * bf_lo(w.x) + q[8 * c + 1] * bf_hi(w.x) + q[8 * c + 2] * bf_lo(w.y) + q[8 * c + 3] * bf_hi(w.y)
                       + q[8 * c + 4] * bf_lo(w.z) + q[8 * c + 5] * bf_hi(w.z) + q[8 * c + 6] * bf_lo(w.w) + q[8 * c + 7] * bf_hi(w.w); }
                z += __shfl_xor(z, 1); z += __shfl_xor(z, 2);
                const bool live = (kt * 64 + s) < t;
                const float e = __expf(fminf(z, 80.f)), rr = 1.0f / (1.0f + e);
                const float A = live ? e * rr * P : 0.f;
                P = live ? P * rr : P;
#pragma unroll
                for (int c = 0; c < 4; ++c) { const v4u w = *(const LAS v4u*)(Vs + s * 256 + r * 64 + c * 16);
                    o[8 * c + 0] += A * bf_lo(w.x); o[8 * c + 1] += A * bf_hi(w.x); o[8 * c + 2] += A * bf_lo(w.y); o[8 * c + 3] += A * bf_hi(w.y);
                    o[8 * c + 4] += A * bf_lo(w.z); o[8 * c + 5] += A * bf_hi(w.z); o[8 * c + 6] += A * bf_lo(w.w); o[8 * c + 7] += A * bf_hi(w.w); }
            }
        }
        { bf16* op = ao + rowq * 1024 + h * 128 + 32 * r;
#pragma unroll
          for (int c = 0; c < 4; ++c) { v4u w; w.x = pk2(o[8 * c + 0], o[8 * c + 1]); w.y = pk2(o[8 * c + 2], o[8 * c + 3]); w.z = pk2(o[8 * c + 4], o[8 * c + 5]); w.w = pk2(o[8 * c + 6], o[8 * c + 7]);
              *(v4u*)(op + 8 * c) = w; } }
    }
}


namespace sba {
using bf16x8 = __attribute__((ext_vector_type(8))) short;
using s16x4  = __attribute__((ext_vector_type(4))) short;
using f32x16 = __attribute__((ext_vector_type(16))) float;
constexpr int SHM_V = 16384, SHM_K = 16384, LDQ = 3072;
#define KSWZ(row, colB) ((row) * 256 + ((colB) ^ (((row) & 7) << 4)))
#define SBAR() __builtin_amdgcn_sched_barrier(0)
DI int crow(int r, int hi) { return (r & 3) + 8 * (r >> 2) + 4 * hi; }
DI int v_st(int k, int c) { const int kk = (k & ~0xC) | ((k & 4) << 1) | ((k & 8) >> 1); return ((kk >> 3) * 4 + (c >> 5)) * 512 + ((kk & 7) * 32 + (c & 31)) * 2; }
DI int v_rd_base(int lane) { return ((lane & 3) << 3) | (((lane >> 2) & 3) << 6) | (((lane >> 4) & 1) << 5) | (((lane >> 5) & 1) << 8); }
constexpr int v_rd_off(int d0, int ks, int half) { return d0 * 512 + ks * 4096 + half * 2048; }
template <int OFF> DI s16x4 tr_read(int vb) { s16x4 r; asm volatile("ds_read_b64_tr_b16 %0, %1 offset:%2" : "=&v"(r) : "v"(vb), "i"(OFF) : "memory"); return r; }
template <int D0> DI void pv_one(f32x16& od, int vb, bf16x8 pa0, bf16x8 pa1, bf16x8 pa2, bf16x8 pa3) {
  const s16x4 l0 = tr_read<v_rd_off(D0, 0, 0)>(vb), h0 = tr_read<v_rd_off(D0, 0, 1)>(vb), l1 = tr_read<v_rd_off(D0, 1, 0)>(vb), h1 = tr_read<v_rd_off(D0, 1, 1)>(vb);
  const s16x4 l2 = tr_read<v_rd_off(D0, 2, 0)>(vb), h2 = tr_read<v_rd_off(D0, 2, 1)>(vb), l3 = tr_read<v_rd_off(D0, 3, 0)>(vb), h3 = tr_read<v_rd_off(D0, 3, 1)>(vb);
  asm volatile("s_waitcnt lgkmcnt(0)" ::: "memory"); SBAR();
#define PK(L, H) (bf16x8){L[0], L[1], L[2], L[3], H[0], H[1], H[2], H[3]}
  od = __builtin_amdgcn_mfma_f32_32x32x16_bf16(pa0, PK(l0, h0), od, 0, 0, 0);
  od = __builtin_amdgcn_mfma_f32_32x32x16_bf16(pa1, PK(l1, h1), od, 0, 0, 0);
  od = __builtin_amdgcn_mfma_f32_32x32x16_bf16(pa2, PK(l2, h2), od, 0, 0, 0);
  od = __builtin_amdgcn_mfma_f32_32x32x16_bf16(pa3, PK(l3, h3), od, 0, 0, 0);
#undef PK
}
DI void qkt(f32x16& p0, f32x16& p1, const LAS unsigned char* Ks, const bf16x8 (&qr)[8], int r32, int hi) {
  p0 = f32x16{}; p1 = f32x16{};
#pragma unroll
  for (int d0 = 0; d0 < 8; ++d0) { const int cb = (d0 * 16 + hi * 8) * 2;
    const bf16x8 b0 = *(const LAS bf16x8*)(Ks + KSWZ(r32, cb));
    const bf16x8 b1 = *(const LAS bf16x8*)(Ks + KSWZ(32 + r32, cb));
    p0 = __builtin_amdgcn_mfma_f32_32x32x16_bf16(b0, qr[d0], p0, 0, 0, 0);
    p1 = __builtin_amdgcn_mfma_f32_32x32x16_bf16(b1, qr[d0], p1, 0, 0, 0); }
}
template <bool MASK> DI void sb_half(f32x16& p, float& Pc, int hi, int kbase, int trow) {
  constexpr float C = 0.08838834764831845f * 1.4426950408889634f;
  float rr[16];
#pragma unroll
  for (int r = 0; r < 16; ++r) {
    float z = p[r] * C;
    if (MASK) z = (kbase + crow(r, hi) < trow) ? z : -__builtin_inff();
    const float k = __builtin_amdgcn_rcpf(1.0f + __builtin_amdgcn_exp2f(z));
    rr[r] = k; p[r] = 1.0f - k;
  }
  float R0[4], R1[4];
#pragma unroll
  for (int g = 0; g < 4; ++g) {
    const float c2 = rr[4 * g + 3], c1 = c2 * rr[4 * g + 2], c0 = c1 * rr[4 * g + 1], R = c0 * rr[4 * g];
    rr[4 * g + 2] = c2; rr[4 * g + 1] = c1; rr[4 * g] = c0;
    const auto sw = __builtin_amdgcn_permlane32_swap(__float_as_uint(R), __float_as_uint(R), false, false);
    R0[g] = __uint_as_float(sw[0]); R1[g] = __uint_as_float(sw[1]);
  }
#pragma unroll
  for (int g = 3; g >= 0; --g) {
    const float Pin = hi ? Pc : Pc * R1[g];
    p[4 * g + 3] *= Pin; p[4 * g + 2] *= Pin * rr[4 * g + 2]; p[4 * g + 1] *= Pin * rr[4 * g + 1]; p[4 * g] *= Pin * rr[4 * g];
    Pc *= R0[g] * R1[g];
  }
}
DI unsigned cvtpk(float lo, float hi) { unsigned r; asm volatile("v_cvt_pk_bf16_f32 %0, %1, %2" : "=v"(r) : "v"(lo), "v"(hi)); return r; }
#define PK4(P, BASE, OUT) do { const unsigned a0 = cvtpk(P[BASE + 0], P[BASE + 1]), a1 = cvtpk(P[BASE + 2], P[BASE + 3]);   \
    const unsigned b0 = cvtpk(P[BASE + 4], P[BASE + 5]), b1 = cvtpk(P[BASE + 6], P[BASE + 7]);                              \
    const auto r0 = __builtin_amdgcn_permlane32_swap(a0, b0, false, false); const auto r1 = __builtin_amdgcn_permlane32_swap(a1, b1, false, false); \
    const v4u w = {r0[0], r1[0], r0[1], r1[1]}; OUT = __builtin_bit_cast(bf16x8, w); } while (0)

DI void unit(const bf16* qkv, bf16* ao, int b, int h, int qb, LAS unsigned char* lds, int tid) {
  const int wid = __builtin_amdgcn_readfirstlane(tid >> 6), lane = tid & 63, r32 = lane & 31, hi = lane >> 5;
  LAS unsigned char* V_lds = lds; LAS unsigned char* K_lds = lds + 2 * SHM_V;
  const size_t rowbase = (size_t)b * SEQ; const int q0 = qb * 256, t_lo = q0 + wid * 32, trow = t_lo + r32;
  bf16x8 qr[8];
  { const bf16* Qw = qkv + (rowbase + trow) * LDQ + h * 128 + hi * 8;
#pragma unroll
    for (int d0 = 0; d0 < 8; ++d0) qr[d0] = *(const bf16x8*)(Qw + d0 * 16); }
  const bf16* Kh = qkv + rowbase * LDQ + 1024 + h * 128; const bf16* Vh = Kh + 1024;
  const int sr = tid >> 4, sc = (tid & 15) * 8, vst0 = v_st(sr, sc), vst1 = v_st(32 + sr, sc);
  const int vb0 = (int)(unsigned)(size_t)V_lds + v_rd_base(lane);
  bf16x8 vs0, vs1, ks0, ks1;
#define SLOAD(k0) do { vs0 = *(const bf16x8*)(Vh + (size_t)((k0) + sr) * LDQ + sc); vs1 = *(const bf16x8*)(Vh + (size_t)((k0) + 32 + sr) * LDQ + sc); \
    ks0 = *(const bf16x8*)(Kh + (size_t)((k0) + sr) * LDQ + sc); ks1 = *(const bf16x8*)(Kh + (size_t)((k0) + 32 + sr) * LDQ + sc); } while (0)
#define SWRITE(bb) do { *(LAS bf16x8*)(V_lds + (bb) * SHM_V + vst0) = vs0; *(LAS bf16x8*)(V_lds + (bb) * SHM_V + vst1) = vs1; const int kc = sc * 2; \
    *(LAS bf16x8*)(K_lds + (bb) * SHM_K + KSWZ(sr, kc)) = ks0; *(LAS bf16x8*)(K_lds + (bb) * SHM_K + KSWZ(32 + sr, kc)) = ks1; } while (0)
  f32x16 o[4] = {}; float Pc = 1.0f;
  const int kt_max = qb * 4 + 3;
  SLOAD(kt_max * 64);
  for (int kt = kt_max; kt >= 0; --kt) {
    const int buf = kt & 1, k0 = kt * 64;
    asm volatile("s_waitcnt vmcnt(0)" ::: "memory");
    SWRITE(buf);
    if (kt > 0) SLOAD(k0 - 64);
    __syncthreads();
    if (k0 < t_lo + 31) {
      f32x16 p0, p1;
      qkt(p0, p1, K_lds + buf * SHM_K, qr, r32, hi);
      if (k0 + 63 >= t_lo) { sb_half<true>(p1, Pc, hi, k0 + 32, trow); sb_half<true>(p0, Pc, hi, k0, trow); }
      else { sb_half<false>(p1, Pc, hi, k0 + 32, trow); sb_half<false>(p0, Pc, hi, k0, trow); }
      bf16x8 pa0, pa1, pa2, pa3;
      PK4(p0, 0, pa0); PK4(p0, 8, pa1); PK4(p1, 0, pa2); PK4(p1, 8, pa3);
      const int vb = vb0 + buf * SHM_V;
      pv_one<0>(o[0], vb, pa0, pa1, pa2, pa3); pv_one<1>(o[1], vb, pa0, pa1, pa2, pa3); pv_one<2>(o[2], vb, pa0, pa1, pa2, pa3); pv_one<3>(o[3], vb, pa0, pa1, pa2, pa3);
    }
  }
  bf16* Ow = ao + (rowbase + t_lo) * 1024 + h * 128 + r32;
#pragma unroll
  for (int r = 0; r < 16; ++r) { const int orow = crow(r, hi);
#pragma unroll
    for (int d0 = 0; d0 < 4; ++d0) Ow[(size_t)orow * 1024 + d0 * 32] = (bf16)(cvtpk(o[d0][r], 0.f) & 0xffffu); }
#undef SLOAD
#undef SWRITE
}
#undef PK4
#undef KSWZ
#undef SBAR
}
DI void phase_sb_mfma(const Args& a, LAS unsigned char* lds, int bid, int G, int tid) {
    const bf16* qkv = (const bf16*)(a.ws + WS_QKV); bf16* ao = (bf16*)(a.ws + WS_AO);
    const int vcu = (G % 8 == 0) ? (bid % 8) * (G / 8) + bid / 8 : bid;
    for (int pi = vcu; pi < 512; pi += G) {
        const int bh = pi >> 3, p = pi & 7, b = bh >> 3, h = bh & 7;
        sba::unit(qkv, ao, b, h, 15 - p, lds, tid);
        sba::unit(qkv, ao, b, h, p, lds, tid);
    }
}


namespace gdn {
using bf16x8 = __attribute__((ext_vector_type(8))) short;
using s16x4  = __attribute__((ext_vector_type(4))) short;
using f32x16 = __attribute__((ext_vector_type(16))) float;
typedef float f2v __attribute__((ext_vector_type(2)));
typedef __bf16 b2v __attribute__((ext_vector_type(2)));
DI unsigned pk(float a, float b) { const f2v v = {a, b}; const b2v r = __builtin_convertvector(v, b2v); return __builtin_bit_cast(unsigned, r); }
DI int crow(int r, int hi) { return (r & 3) + 8 * (r >> 2) + 4 * hi; }
DI int pi_slot(int x) { return 8 * ((x >> 2) & 3) + 4 * ((x >> 4) & 1) + (x & 3); }
DI bf16x8 pack_step(const f32x16& x, int s) {
    v4u w; w.x = pk(x[8 * s + 0], x[8 * s + 1]); w.y = pk(x[8 * s + 2], x[8 * s + 3]); w.z = pk(x[8 * s + 4], x[8 * s + 5]); w.w = pk(x[8 * s + 6], x[8 * s + 7]);
    return __builtin_bit_cast(bf16x8, w);
}
DI f32x16 mm(const f32x16& P, const f32x16& Q, f32x16 acc) {
    acc = __builtin_amdgcn_mfma_f32_32x32x16_bf16(pack_step(P, 0), pack_step(Q, 0), acc, 0, 0, 0);
    acc = __builtin_amdgcn_mfma_f32_32x32x16_bf16(pack_step(P, 1), pack_step(Q, 1), acc, 0, 0, 0);
    return acc;
}
#define GPK4(P, BASE, OUT) do { const unsigned a0 = pk(P[BASE + 0], P[BASE + 1]), a1 = pk(P[BASE + 2], P[BASE + 3]);   \
    const unsigned b0 = pk(P[BASE + 4], P[BASE + 5]), b1 = pk(P[BASE + 6], P[BASE + 7]);                              \
    const auto r0 = __builtin_amdgcn_permlane32_swap(a0, b0, false, false); const auto r1 = __builtin_amdgcn_permlane32_swap(a1, b1, false, false); \
    const v4u w_ = {r0[0], r1[0], r0[1], r1[1]}; OUT = __builtin_bit_cast(bf16x8, w_); } while (0)

DI void local_unit(const Args& a, int unit, LAS unsigned char* img, LAS float* tab, int lane, bool dry) {
    const int r32 = lane & 31, hi = lane >> 5;
    const int chunk = unit & 63, bh = unit >> 6, hv = bh & 15, b = bh >> 4, hk = hv >> 1;
    const size_t t0 = (size_t)b * SEQ + chunk * 64;
    bf16* qkvc = (bf16*)(a.ws + WS_QKVC); const float* gb = (const float*)(a.ws + WS_GB);
    bf16* wmem = (bf16*)(a.ws + WS_WMEM) + (size_t)unit * 8192; bf16* imem = (bf16*)(a.ws + WS_IMEM) + (size_t)unit * 4096;
    bf16* ktmem = (bf16*)(a.ws + WS_KTMEM) + (size_t)((b * HK + hk) * 64 + chunk) * 8192; float* gtab = (float*)(a.ws + WS_GTAB) + (size_t)unit * 192;
    float gc = gb[(t0 + lane) * 32 + hv]; const float be = gb[(t0 + lane) * 32 + 16 + hv];
#pragma unroll
    for (int off = 1; off < 64; off <<= 1) { const float y = __shfl_up(gc, off); if (lane >= off) gc += y; }
    const float glast = __shfl(gc, 63);
    tab[lane] = gc; tab[64 + lane] = be; tab[128 + lane] = -be * __expf(gc);
    gtab[lane] = __expf(gc); gtab[64 + lane] = __expf(glast - gc); if (lane == 0) gtab[128] = __expf(glast);
    const bf16* kbase = qkvc + t0 * 4096 + 1024 + hk * 128; const bf16* qbase = qkvc + t0 * 4096 + hk * 128; bf16* vbase = qkvc + t0 * 4096 + 2048 + hv * 128;
    if ((hv & 1) == 0) {
        const int slot = 32 * (lane >> 5) + pi_slot(lane & 31);
#pragma unroll 4
        for (int c8 = 0; c8 < 16; ++c8) { const v4u kv = *(const v4u*)(kbase + (size_t)lane * 4096 + 8 * c8);
            bf16* dst = ktmem + (size_t)(8 * c8) * 64 + slot;
            dst[0 * 64] = (bf16)(kv.x & 0xffffu); dst[1 * 64] = (bf16)(kv.x >> 16); dst[2 * 64] = (bf16)(kv.y & 0xffffu); dst[3 * 64] = (bf16)(kv.y >> 16);
            dst[4 * 64] = (bf16)(kv.z & 0xffffu); dst[5 * 64] = (bf16)(kv.z >> 16); dst[6 * 64] = (bf16)(kv.w & 0xffffu); dst[7 * 64] = (bf16)(kv.w >> 16); }
    }
#define GSB() __builtin_amdgcn_sched_barrier(0)
    {
        f32x16 IT00 = {}, IT11 = {}, IT01 = {};
#pragma unroll
        for (int s = 0; s < 8; ++s) {
            const bf16x8 k0 = *(const bf16x8*)(kbase + (size_t)r32 * 4096 + 16 * s + 8 * hi), k1 = *(const bf16x8*)(kbase + (size_t)(32 + r32) * 4096 + 16 * s + 8 * hi);
            const bf16x8 q0 = *(const bf16x8*)(qbase + (size_t)r32 * 4096 + 16 * s + 8 * hi), q1 = *(const bf16x8*)(qbase + (size_t)(32 + r32) * 4096 + 16 * s + 8 * hi);
            IT00 = __builtin_amdgcn_mfma_f32_32x32x16_bf16(k0, q0, IT00, 0, 0, 0); IT11 = __builtin_amdgcn_mfma_f32_32x32x16_bf16(k1, q1, IT11, 0, 0, 0);
            IT01 = __builtin_amdgcn_mfma_f32_32x32x16_bf16(k0, q1, IT01, 0, 0, 0);
        }
#pragma unroll
        for (int I = 0; I < 2; ++I) { const int c = 32 * I + r32; const float gcc = tab[c];
#pragma unroll
            for (int J = 0; J < 2; ++J)
#pragma unroll
                for (int g = 0; g < 4; ++g) { float v[4];
#pragma unroll
                    for (int i = 0; i < 4; ++i) { const int r = 4 * g + i, cp = 32 * J + crow(r, hi);
                        const float raw = (I == 0) ? (J == 0 ? IT00[r] : 0.f) : (J == 0 ? IT01[r] : IT11[r]);
                        const float val = raw * __expf(-fabsf(gcc - tab[cp])); v[i] = (c >= cp) ? val : 0.f; }
                    v2u o; o.x = pk(v[0], v[1]); o.y = pk(v[2], v[3]);
                    *(v2u*)(imem + (size_t)c * 64 + 32 * J + 16 * (g & 1) + 8 * hi + 4 * (g >> 1)) = o; } }
    }
    GSB();
    f32x16 T1, T1T, T2T, T21T;
    {
        f32x16 KK = {};
#pragma unroll
        for (int s = 0; s < 8; ++s) { const bf16x8 k0 = *(const bf16x8*)(kbase + (size_t)r32 * 4096 + 16 * s + 8 * hi); KK = __builtin_amdgcn_mfma_f32_32x32x16_bf16(k0, k0, KK, 0, 0, 0); }
        f32x16 M, MT;
        { const float gb0 = tab[r32], bb0 = tab[64 + r32];
#pragma unroll
        for (int r = 0; r < 16; ++r) { const int a0 = crow(r, hi), b0 = r32; const float ke = -KK[r] * __expf(-fabsf(tab[a0] - gb0));
            const float nv = ke * tab[64 + a0], ntv = ke * bb0;
            const float n = (a0 > b0) ? nv : 0.f, nt = (b0 > a0) ? ntv : 0.f, id = (a0 == b0) ? 1.f : 0.f;
            M[r] = n; MT[r] = nt; T1[r] = id + n; T1T[r] = id + nt; } }
#pragma unroll
        for (int it = 0; it < 4; ++it) { const f32x16 z = {};
            const f32x16 Mn = mm(MT, M, z), MTn = mm(M, MT, z);
            const f32x16 Tn = mm(T1T, Mn, T1);
            T1T = mm(Mn, T1T, T1T);
            T1 = Tn; M = Mn; MT = MTn; }
    }
    GSB();
    {
        f32x16 KK = {};
#pragma unroll
        for (int s = 0; s < 8; ++s) { const bf16x8 k1 = *(const bf16x8*)(kbase + (size_t)(32 + r32) * 4096 + 16 * s + 8 * hi); KK = __builtin_amdgcn_mfma_f32_32x32x16_bf16(k1, k1, KK, 0, 0, 0); }
        f32x16 M, MT;
        { const float gb0 = tab[32 + r32], bb0 = tab[96 + r32];
#pragma unroll
        for (int r = 0; r < 16; ++r) { const int a0 = crow(r, hi), b0 = r32; const float ke = -KK[r] * __expf(-fabsf(tab[32 + a0] - gb0));
            const float nv = ke * tab[96 + a0], ntv = ke * bb0;
            const float n = (a0 > b0) ? nv : 0.f, nt = (b0 > a0) ? ntv : 0.f, id = (a0 == b0) ? 1.f : 0.f;
            M[r] = n; MT[r] = nt; T2T[r] = id + nt; } }
#pragma unroll
        for (int it = 0; it < 4; ++it) { const f32x16 z = {};
            const f32x16 Mn = mm(MT, M, z), MTn = mm(M, MT, z);
            T2T = mm(Mn, T2T, T2T);
            M = Mn; MT = MTn; }
    }
    GSB();
    {
        f32x16 L21 = {};
#pragma unroll
        for (int s = 0; s < 8; ++s) { const bf16x8 k0 = *(const bf16x8*)(kbase + (size_t)r32 * 4096 + 16 * s + 8 * hi), k1 = *(const bf16x8*)(kbase + (size_t)(32 + r32) * 4096 + 16 * s + 8 * hi);
            L21 = __builtin_amdgcn_mfma_f32_32x32x16_bf16(k1, k0, L21, 0, 0, 0); }
#pragma unroll
        for (int r = 0; r < 16; ++r) { const int a0 = crow(r, hi); L21[r] = L21[r] * tab[96 + a0] * __expf(tab[32 + a0] - tab[r32]); }
        const f32x16 z = {}; const f32x16 Y = mm(L21, T2T, z); T21T = mm(T1, Y, z);
#pragma unroll
        for (int r = 0; r < 16; ++r) T21T[r] = -T21T[r];
    }
    GSB();
    const int vb = (int)(unsigned)(size_t)img + sba::v_rd_base(lane);
    bf16* ubl = dry ? (bf16*)(a.ws + WS_END) + (size_t)(unit & 63) * 64 * 4096 : vbase;
#pragma unroll 1
    for (int mode = 0; mode < 2; ++mode) {
        const bf16* src = mode == 0 ? (const bf16*)vbase : kbase;
#pragma unroll 4
        for (int it = 0; it < 16; ++it) { const int row = (lane >> 4) + 4 * it, col = (lane & 15) * 8;
            *(LAS v4u*)(img + sba::v_st(row, col)) = *(const v4u*)(src + (size_t)row * 4096 + col); }
        LAS float* sc = tab + (mode == 0 ? 64 : 128);
#pragma unroll 1
        for (int I = 0; I < 2; ++I) {
            bf16x8 pa0, pa1, pa2, pa3;
            { f32x16 X;
#pragma unroll
              for (int r = 0; r < 16; ++r) X[r] = (I ? T21T[r] : T1T[r]) * sc[crow(r, hi)];
              GPK4(X, 0, pa0); GPK4(X, 8, pa1);
#pragma unroll
              for (int r = 0; r < 16; ++r) X[r] = I ? T2T[r] * sc[32 + crow(r, hi)] : 0.f;
              GPK4(X, 0, pa2); GPK4(X, 8, pa3); }
            const int ubase = ((((r32 >> 4) * 64 + hi * 16 + (r32 & 15)) * 16) + 8 * I);
            const int wbase = (32 * I + 4 * hi) * 128 + pi_slot(r32);
#define GDN_OUT(D0) do { f32x16 od = {}; sba::pv_one<D0>(od, vb, pa0, pa1, pa2, pa3); \
            if (mode == 0) { _Pragma("unroll") for (int g = 0; g < 4; ++g) { const int f = ubase + D0 * 2048 + (g & 1) * 512 + (g >> 1) * 4; \
                    v2u w; w.x = pk(od[4 * g + 0], od[4 * g + 1]); w.y = pk(od[4 * g + 2], od[4 * g + 3]); *(v2u*)(ubl + (unsigned)((f >> 7) * 4096 + (f & 127))) = w; } } \
            else { _Pragma("unroll") for (int r = 0; r < 16; ++r) wmem[(unsigned)(wbase + ((r & 3) + 8 * (r >> 2)) * 128 + 32 * D0)] = (bf16)(pk(od[r], 0.f) & 0xffffu); } \
            GSB(); } while (0)
            GDN_OUT(0); GDN_OUT(1); GDN_OUT(2); GDN_OUT(3);
#undef GDN_OUT
        }
    }
#undef GSB
}
#undef GPK4
}
DI void phase_gdn_local(const Args& a, LAS unsigned char* lds, int bid, int G, int wave, int lane, bool dry) {
    LAS unsigned char* img = lds + wave * 16384; LAS float* tab = (LAS float*)(lds + RING_BYTES + 4096 + wave * 1024);
    const int gw = bid * NWAVES + wave, NGW = G * NWAVES;
    for (int unit = gw; unit < BATCH * HV * 64; unit += NGW) gdn::local_unit(a, unit, img, tab, lane, dry);
}
namespace gdn {
constexpr int PW = 272, PI = 144;
constexpr int L_W = 0, L_Q = 64 * PW, L_I = 2 * 64 * PW, L_K = L_I + 64 * PI, L_G = L_K + 128 * PI, L_BUF = L_G + 768;
constexpr int L_PART = 2 * L_BUF;
static_assert(L_PART + 4096 <= RING_BYTES, "scan LDS map");
}
DI void phase_gdn_scan(const Args& a, int j, LAS unsigned char* lds, int bid, int tid, bool dry) {
    if (bid >= BATCH * HV) return;
    using gdn::bf16x8; using gdn::pk; using namespace gdn;
    typedef float f4v __attribute__((ext_vector_type(4)));
    const int wave = __builtin_amdgcn_readfirstlane(tid >> 6), lane = tid & 63, n = lane & 15, kq = lane >> 4;
    const int b = bid / HV, hv = bid % HV, hk = hv >> 1;
    bf16* qkvc = (bf16*)(a.ws + WS_QKVC); const bf16* zb = (const bf16*)(a.ws + WS_ZB);
    LAS float* part = (LAS float*)(lds + L_PART); LAS unsigned char* stg = lds + OGST_OFF;
    const int unit0 = (b * HV + hv) * 64, hku0 = (b * HK + hk) * 64; const size_t tb0 = (size_t)b * SEQ;
    if (wave >= 4) {
        const int st = tid - 256;
        v4u rw[4], rq[4], ri[2], rk[4], rz[4]; float rg = 0.f;
#define SV_LOAD(ch) do { const int u_ = unit0 + (ch); const size_t t_ = tb0 + (size_t)(ch) * 64; \
        const bf16* wm_ = (const bf16*)(a.ws + WS_WMEM) + (size_t)u_ * 8192; const bf16* im_ = (const bf16*)(a.ws + WS_IMEM) + (size_t)u_ * 4096; \
        const bf16* kt_ = (const bf16*)(a.ws + WS_KTMEM) + (size_t)(hku0 + (ch)) * 8192; const bf16* qb_ = qkvc + t_ * 4096 + hk * 128; const bf16* zr_ = zb + t_ * 2048 + hv * 128; \
        _Pragma("unroll") for (int k = 0; k < 4; ++k) { const int c = st + 256 * k; rw[k] = *(const v4u*)(wm_ + c * 8); rk[k] = *(const v4u*)(kt_ + c * 8); \
            rq[k] = *(const v4u*)(qb_ + (size_t)(c >> 4) * 4096 + (c & 15) * 8); rz[k] = *(const v4u*)(zr_ + (size_t)(c >> 4) * 2048 + (c & 15) * 8); } \
        _Pragma("unroll") for (int k = 0; k < 2; ++k) { const int c = st + 256 * k; ri[k] = *(const v4u*)(im_ + c * 8); } \
        if (st < 192) rg = ((const float*)(a.ws + WS_GTAB))[(size_t)u_ * 192 + st]; } while (0)
#define SV_WRITE(bf) do { LAS unsigned char* B_ = lds + (bf) * L_BUF; \
        _Pragma("unroll") for (int k = 0; k < 4; ++k) { const int c = st + 256 * k; *(LAS v4u*)(B_ + L_W + (c >> 4) * PW + (c & 15) * 16) = rw[k]; \
            *(LAS v4u*)(B_ + L_Q + (c >> 4) * PW + (c & 15) * 16) = rq[k]; *(LAS v4u*)(B_ + L_K + (c >> 3) * PI + (c & 7) * 16) = rk[k]; } \
        _Pragma("unroll") for (int k = 0; k < 2; ++k) { const int c = st + 256 * k; *(LAS v4u*)(B_ + L_I + (c >> 3) * PI + (c & 7) * 16) = ri[k]; } \
        if (st < 192) *(LAS float*)(B_ + L_G + st * 4) = rg; } while (0)
#define SV_ZWRITE() do { _Pragma("unroll") for (int k = 0; k < 4; ++k) { const int c = st + 256 * k; *(LAS v4u*)(stg + (c >> 4) * 256 + (c & 15) * 16) = rz[k]; } } while (0)
        SV_LOAD(0); SV_WRITE(0); SV_ZWRITE();
        __syncthreads();
#pragma unroll 1
        for (int chunk = 0; chunk < 64; ++chunk) {
            if (chunk + 1 < 64) { SV_LOAD(chunk + 1); SV_WRITE((chunk + 1) & 1); }
            __syncthreads();
            __syncthreads();
            { bf16* ob = dry ? (bf16*)(a.ws + WS_END) + (size_t)bid * 64 * 128 : qkvc + (tb0 + (size_t)chunk * 64) * 4096 + 2048 + hv * 128; const int opitch = dry ? 128 : 4096;
#pragma unroll
              for (int k = 0; k < 4; ++k) { const int c = st + 256 * k; *(v4u*)(ob + (size_t)(c >> 4) * opitch + (c & 15) * 8) = *(const LAS v4u*)(stg + (c >> 4) * 256 + (c & 15) * 16); } }
            if (chunk + 1 < 64) SV_ZWRITE();
        }
#undef SV_LOAD
#undef SV_WRITE
#undef SV_ZWRITE
        return;
    }
    float nw[2]; nw[0] = a.gdn_norm_w[j * 128 + 32 * wave + n]; nw[1] = a.gdn_norm_w[j * 128 + 32 * wave + 16 + n];
    f4v S[2][8];
#pragma unroll
    for (int g = 0; g < 2; ++g)
#pragma unroll
        for (int m = 0; m < 8; ++m) S[g][m] = (f4v){0.f, 0.f, 0.f, 0.f};
    v4u un[2][2];
#define CW_ULOAD(ch) do { const bf16* vb_ = qkvc + (tb0 + (size_t)(ch) * 64) * 4096 + 2048 + hv * 128; \
        _Pragma("unroll") for (int g = 0; g < 2; ++g) { const int f = ((2 * wave + g) * 64 + lane) * 16; un[g][0] = *(const v4u*)(vb_ + (size_t)(f >> 7) * 4096 + (f & 127)); un[g][1] = *(const v4u*)(vb_ + (size_t)(f >> 7) * 4096 + (f & 127) + 8); } } while (0)
    CW_ULOAD(0);
    __syncthreads();
#pragma unroll 1
    for (int chunk = 0; chunk < 64; ++chunk) {
        const LAS unsigned char* B = lds + (chunk & 1) * L_BUF; const LAS float* gt = (const LAS float*)(B + L_G);
        f4v av[2][4], ao[2][4];
#pragma unroll
        for (int g = 0; g < 2; ++g) { const v4u u0 = un[g][0], u1 = un[g][1];
            av[g][0] = (f4v){bf_lo(u0.x), bf_hi(u0.x), bf_lo(u0.y), bf_hi(u0.y)}; av[g][1] = (f4v){bf_lo(u0.z), bf_hi(u0.z), bf_lo(u0.w), bf_hi(u0.w)};
            av[g][2] = (f4v){bf_lo(u1.x), bf_hi(u1.x), bf_lo(u1.y), bf_hi(u1.y)}; av[g][3] = (f4v){bf_lo(u1.z), bf_hi(u1.z), bf_lo(u1.w), bf_hi(u1.w)}; }
        if (chunk + 1 < 64) CW_ULOAD(chunk + 1);
        bf16x8 Sb[2][4];
#pragma unroll
        for (int g = 0; g < 2; ++g)
#pragma unroll
            for (int p = 0; p < 4; ++p) { v4u w; w.x = pk(S[g][2 * p][0], S[g][2 * p][1]); w.y = pk(S[g][2 * p][2], S[g][2 * p][3]); w.z = pk(S[g][2 * p + 1][0], S[g][2 * p + 1][1]); w.w = pk(S[g][2 * p + 1][2], S[g][2 * p + 1][3]);
                Sb[g][p] = __builtin_bit_cast(bf16x8, w); }
#pragma unroll
        for (int mt = 0; mt < 4; ++mt) { ao[0][mt] = (f4v){0.f, 0.f, 0.f, 0.f}; ao[1][mt] = (f4v){0.f, 0.f, 0.f, 0.f};
#pragma unroll
            for (int p = 0; p < 4; ++p) {
                const bf16x8 aw = *(const LAS bf16x8*)(B + L_W + (16 * mt + n) * PW + 64 * p + 16 * kq);
                const v2u q0 = *(const LAS v2u*)(B + L_Q + (16 * mt + n) * PW + 64 * p + 8 * kq), q1 = *(const LAS v2u*)(B + L_Q + (16 * mt + n) * PW + 64 * p + 32 + 8 * kq);
                const v4u qq = {q0.x, q0.y, q1.x, q1.y}; const bf16x8 aq = __builtin_bit_cast(bf16x8, qq);
                av[0][mt] = __builtin_amdgcn_mfma_f32_16x16x32_bf16(aw, Sb[0][p], av[0][mt], 0, 0, 0); av[1][mt] = __builtin_amdgcn_mfma_f32_16x16x32_bf16(aw, Sb[1][p], av[1][mt], 0, 0, 0);
                ao[0][mt] = __builtin_amdgcn_mfma_f32_16x16x32_bf16(aq, Sb[0][p], ao[0][mt], 0, 0, 0); ao[1][mt] = __builtin_amdgcn_mfma_f32_16x16x32_bf16(aq, Sb[1][p], ao[1][mt], 0, 0, 0); } }
        bf16x8 vbf[2][2], vbd[2][2];
#pragma unroll
        for (int pp = 0; pp < 2; ++pp) {
            const f4v d0 = *(const LAS f4v*)(gt + 64 + 32 * pp + 4 * kq), d1 = *(const LAS f4v*)(gt + 64 + 32 * pp + 16 + 4 * kq);
#pragma unroll
            for (int g = 0; g < 2; ++g) { const f4v x0 = av[g][2 * pp], x1 = av[g][2 * pp + 1];
                v4u w; w.x = pk(x0[0], x0[1]); w.y = pk(x0[2], x0[3]); w.z = pk(x1[0], x1[1]); w.w = pk(x1[2], x1[3]); vbf[g][pp] = __builtin_bit_cast(bf16x8, w);
                v4u y; y.x = pk(x0[0] * d0[0], x0[1] * d0[1]); y.y = pk(x0[2] * d0[2], x0[3] * d0[3]); y.z = pk(x1[0] * d1[0], x1[1] * d1[1]); y.w = pk(x1[2] * d1[2], x1[3] * d1[3]); vbd[g][pp] = __builtin_bit_cast(bf16x8, y); }
        }
#pragma unroll
        for (int mt = 0; mt < 4; ++mt) { const f4v eg = *(const LAS f4v*)(gt + 16 * mt + 4 * kq); ao[0][mt] = ao[0][mt] * eg; ao[1][mt] = ao[1][mt] * eg;
#pragma unroll
            for (int pp = 0; pp < 2; ++pp) { const bf16x8 ai = *(const LAS bf16x8*)(B + L_I + (16 * mt + n) * PI + 64 * pp + 16 * kq);
                ao[0][mt] = __builtin_amdgcn_mfma_f32_16x16x32_bf16(ai, vbf[0][pp], ao[0][mt], 0, 0, 0); ao[1][mt] = __builtin_amdgcn_mfma_f32_16x16x32_bf16(ai, vbf[1][pp], ao[1][mt], 0, 0, 0); } }
        { const float egl = gt[128];
#pragma unroll
          for (int m8 = 0; m8 < 8; ++m8) { S[0][m8] = S[0][m8] * egl; S[1][m8] = S[1][m8] * egl;
#pragma unroll
              for (int pp = 0; pp < 2; ++pp) { const bf16x8 ak = *(const LAS bf16x8*)(B + L_K + (16 * m8 + n) * PI + 64 * pp + 16 * kq);
                  S[0][m8] = __builtin_amdgcn_mfma_f32_16x16x32_bf16(ak, vbd[0][pp], S[0][m8], 0, 0, 0); S[1][m8] = __builtin_amdgcn_mfma_f32_16x16x32_bf16(ak, vbd[1][pp], S[1][m8], 0, 0, 0); } } }
        LAS float* pb = part + (chunk & 1) * 512;
#pragma unroll
        for (int g = 0; g < 2; ++g)
#pragma unroll
            for (int mt = 0; mt < 4; ++mt)
#pragma unroll
                for (int i = 0; i < 4; ++i) { const float ss = dpp_sum16(ao[g][mt][i] * ao[g][mt][i]);
                    if (n == 0) pb[(16 * mt + 4 * kq + i) * 8 + 2 * wave + g] = ss; }
        __syncthreads();
#pragma unroll
        for (int mt = 0; mt < 4; ++mt)
#pragma unroll
            for (int i = 0; i < 4; ++i) { const int c = 16 * mt + 4 * kq + i;
                const f4v s0 = *(const LAS f4v*)(pb + c * 8), s1 = *(const LAS f4v*)(pb + c * 8 + 4);
                const float tot = (s0[0] + s0[1]) + (s0[2] + s0[3]) + (s1[0] + s1[1]) + (s1[2] + s1[3]);
                const float rinv = __builtin_amdgcn_rsqf(tot * (1.0f / 128.0f) + RMS_EPS);
#pragma unroll
                for (int g = 0; g < 2; ++g) { LAS bf16* zp = (LAS bf16*)(stg + c * 256 + (32 * wave + 16 * g + n) * 2);
                    const float z = __uint_as_float((unsigned)(*zp) << 16);
                    const float sg = z * __builtin_amdgcn_rcpf(1.0f + __builtin_amdgcn_exp2f(-1.4426950408889634f * z));
                    *zp = (bf16)(pk(ao[g][mt][i] * rinv * nw[g] * sg, 0.f) & 0xffffu); } }
        __syncthreads();
    }
#undef CW_ULOAD
}

DI void moe_offsets(const Args& a, int j, unsigned (&off)[9]) {
    unsigned* cnt = (unsigned*)(a.ws + WS_CTL) + CW_CNT + 256 * j; unsigned acc = 0u;
#pragma unroll
    for (int e = 0; e < 8; ++e) { off[e] = acc; const unsigned c = __hip_atomic_load(cnt + e, __ATOMIC_RELAXED, __HIP_MEMORY_SCOPE_AGENT); acc += (c + 255u) & ~255u; }
    off[8] = acc;
}
DI void phase_scatter(const Args& a, int j, LAS unsigned char* lds, int bid, int G, int tid, int wave, int lane) {
    LAS unsigned* lc = (LAS unsigned*)lds; LAS unsigned* lb = lc + 8; LAS unsigned* loff = lc + 16; LAS int* lpos = (LAS int*)(lc + 32);
    const unsigned* E12 = (const unsigned*)(a.ws + WS_E12); int* POS = (int*)(a.ws + WS_POS);
    const bf16* HB = (const bf16*)(a.ws + WS_HB); bf16* XS = (bf16*)(a.ws + WS_XS);
    unsigned* fill = (unsigned*)(a.ws + WS_CTL) + CW_CNT + 256 * j + 64;
    unsigned off[9]; moe_offsets(a, j, off);
    if (tid == 0) {
#pragma unroll
        for (int e = 0; e < 8; ++e) loff[e] = off[e]; }
    for (int ci = bid; ci < TT / 128; ci += G) {
        __syncthreads();
        if (tid < 8) lc[tid] = 0u;
        __syncthreads();
        unsigned e1 = 0, e2 = 0, r1 = 0, r2 = 0;
        if (tid < 128) { const unsigned w = E12[ci * 128 + tid]; e1 = w & 255u; e2 = (w >> 8) & 255u;
            r1 = __hip_atomic_fetch_add(lc + e1, 1u, __ATOMIC_RELAXED, __HIP_MEMORY_SCOPE_WORKGROUP); r2 = __hip_atomic_fetch_add(lc + e2, 1u, __ATOMIC_RELAXED, __HIP_MEMORY_SCOPE_WORKGROUP); }
        __syncthreads();
        if (tid < 8) lb[tid] = __hip_atomic_fetch_add(fill + tid, lc[tid], __ATOMIC_RELAXED, __HIP_MEMORY_SCOPE_AGENT);
        __syncthreads();
        if (tid < 128) { const int p1 = (int)(loff[e1] + lb[e1] + r1), p2 = (int)(loff[e2] + lb[e2] + r2);
            lpos[2 * tid] = p1; lpos[2 * tid + 1] = p2; POS[2 * (ci * 128 + tid)] = p1; POS[2 * (ci * 128 + tid) + 1] = p2; }
        __syncthreads();
        for (int tk = wave; tk < 128; tk += NWAVES) {
            const int p1 = lpos[2 * tk], p2 = lpos[2 * tk + 1];
            const v4u* src = (const v4u*)(HB + (size_t)(ci * 128 + tk) * D);
            const v4u x0 = src[lane], x1 = src[lane + 64];
            v4u* d1 = (v4u*)(XS + (size_t)p1 * D); v4u* d2 = (v4u*)(XS + (size_t)p2 * D);
            d1[lane] = x0; d1[lane + 64] = x1; d2[lane] = x0; d2[lane + 64] = x1;
        }
    }
}

DI void phase_combine_ln(const Args& a, int lnidx, int bid, int G, int wave, int lane) {
    float* out = a.out; bf16* HB = (bf16*)(a.ws + WS_HB); const bf16* YE = (const bf16*)(a.ws + WS_XS);
    const int* POS = (const int*)(a.ws + WS_POS); const f32x2* G12 = (const f32x2*)(a.ws + WS_G12);
    const float* g = a.ln_g + (size_t)lnidx * D; const float* bta = a.ln_b + (size_t)lnidx * D;
    const int gw = bid * NWAVES + wave, NGW = G * NWAVES;
    f32x4 gv[4], bv[4];
#pragma unroll
    for (int q = 0; q < 4; ++q) { gv[q] = *(const f32x4*)(g + 4 * (lane + 64 * q)); bv[q] = *(const f32x4*)(bta + 4 * (lane + 64 * q)); }
    for (int t = gw; t < TT; t += NGW) {
        f32x4* row = (f32x4*)(out + (size_t)t * D);
        const int p1 = POS[2 * t], p2 = POS[2 * t + 1]; const f32x2 gg = G12[t];
        const v2u* y1 = (const v2u*)(YE + (size_t)p1 * D); const v2u* y2 = (const v2u*)(YE + (size_t)p2 * D);
        f32x4 v[4]; float s = 0.f;
#pragma unroll
        for (int q = 0; q < 4; ++q) { const v2u a1 = y1[lane + 64 * q], a2 = y2[lane + 64 * q];
            const f32x4 e1 = (f32x4){bf_lo(a1.x), bf_hi(a1.x), bf_lo(a1.y), bf_hi(a1.y)}, e2 = (f32x4){bf_lo(a2.x), bf_hi(a2.x), bf_lo(a2.y), bf_hi(a2.y)};
            v[q] = row[lane + 64 * q] * ALPHA + e1 * gg.x + e2 * gg.y; s += (v[q][0] + v[q][1]) + (v[q][2] + v[q][3]); }
        const float mean = wave_sum(s) * (1.0f / D); float s2 = 0.f;
#pragma unroll
        for (int q = 0; q < 4; ++q) { v[q] = v[q] - mean; s2 += (v[q][0] * v[q][0] + v[q][1] * v[q][1]) + (v[q][2] * v[q][2] + v[q][3] * v[q][3]); }
        const float rstd = 1.0f / sqrtf(wave_sum(s2) * (1.0f / D) + LN_EPS);
#pragma unroll
        for (int q = 0; q < 4; ++q) { v[q] = v[q] * rstd * gv[q] + bv[q]; row[lane + 64 * q] = v[q];
            v2u o; o.x = pk2(v[q][0], v[q][1]); o.y = pk2(v[q][2], v[q][3]); *(v2u*)(HB + (size_t)t * D + 4 * (lane + 64 * q)) = o; }
    }
}

constexpr int ARGS_OFF = RING_BYTES + 1024;
DI unsigned long long lds_u64(LAS unsigned char* p) { const v2u w = *(const volatile LAS v2u*)p; return ((unsigned long long)(unsigned)__builtin_amdgcn_readfirstlane((int)w.y) << 32) | (unsigned)__builtin_amdgcn_readfirstlane((int)w.x); }
DI Args load_args(LAS unsigned char* lds) {
    Args a; LAS unsigned char* p = lds + ARGS_OFF;
    a.x = (const float*)(const GAS float*)lds_u64(p + 0); a.gdn_w_in = (const float*)(const GAS float*)lds_u64(p + 8); a.gdn_conv_w = (const float*)(const GAS float*)lds_u64(p + 16); a.gdn_a_log = (const float*)(const GAS float*)lds_u64(p + 24);
    a.gdn_dt_bias = (const float*)(const GAS float*)lds_u64(p + 32); a.gdn_norm_w = (const float*)(const GAS float*)lds_u64(p + 40); a.gdn_w_out = (const float*)(const GAS float*)lds_u64(p + 48); a.sb_w_in = (const float*)(const GAS float*)lds_u64(p + 56);
    a.sb_w_out = (const float*)(const GAS float*)lds_u64(p + 64); a.ffn_w_gate = (const float*)(const GAS float*)lds_u64(p + 72); a.ffn_w_up = (const float*)(const GAS float*)lds_u64(p + 80); a.ffn_w_down = (const float*)(const GAS float*)lds_u64(p + 88);
    a.moe_router = (const float*)(const GAS float*)lds_u64(p + 96); a.moe_w_gate = (const float*)(const GAS float*)lds_u64(p + 104); a.moe_w_up = (const float*)(const GAS float*)lds_u64(p + 112); a.moe_w_down = (const float*)(const GAS float*)lds_u64(p + 120);
    a.ln_g = (const float*)(const GAS float*)lds_u64(p + 128); a.ln_b = (const float*)(const GAS float*)lds_u64(p + 136); a.out = (float*)(GAS float*)lds_u64(p + 144); a.ws = (unsigned char*)(GAS unsigned char*)lds_u64(p + 152);
    const v2u w = *(const volatile LAS v2u*)(p + 160); a.ph_lo = __builtin_amdgcn_readfirstlane((int)w.x); a.ph_hi = __builtin_amdgcn_readfirstlane((int)w.y);
    return a;
}
#ifdef PH_ONLY
#define IN(k) (((k) % NPH) == PH_ONLY && lo <= (k) && (k) < hi)
#else
#define IN(k) (lo <= (k) && (k) < hi)
#endif
#define SEAM(k) do { if ((k) + 1 < hi) xcd_barrier(bar); } while (0)
DI int fresh_lane() { int l; asm volatile("v_mbcnt_lo_u32_b32 %0, -1, 0\n\tv_mbcnt_hi_u32_b32 %0, -1, %0" : "=v"(l)); return l; }
#define ARGS() const Args args = load_args(lds); const int lo = args.ph_lo, hi = args.ph_hi; const int lane = fresh_lane(), tid = wave * 64 + lane
#ifndef PROBE_REP_MASK
#define PROBE_REP_MASK 0
#endif
#ifndef PROBE_DELAY_MASK
#define PROBE_DELAY_MASK 0
#endif
#define PROBE_DELAY_MULT 4u
#define TICK_IN(k) do { if (((PROBE_DELAY_MASK) >> (k)) & 1) { if (bid == 0 && tid == 0) ((volatile LAS unsigned*)(lds + MISC_OFF))[20] -= (unsigned)__builtin_amdgcn_s_memrealtime(); } } while (0)
#define TICK_OUT(k) do { if (((PROBE_DELAY_MASK) >> (k)) & 1) { if (bid == 0 && tid == 0) ((volatile LAS unsigned*)(lds + MISC_OFF))[20] += (unsigned)__builtin_amdgcn_s_memrealtime(); } } while (0)
#define NREP(k) ((((PROBE_REP_MASK) >> (k)) & 1) ? 2 : 1)
template <int j>
DI void layer_pair(LAS unsigned char* lds, const XcdBarrier& bar, const int wave, const int G, const int bid) {
    constexpr int pb = j * NPH;
    { ARGS(); if (IN(pb + 0)) { TICK_IN(0); _Pragma("unroll 1") for (int rep_ = 0; rep_ < NREP(0); ++rep_) { phase_w_gdn(args, j, lds, bid, G, tid, wave, lane); } SEAM(pb + 0); TICK_OUT(0); } }
    { ARGS(); if (IN(pb + 1)) { TICK_IN(1); {
        pg8::Gemm g{(const bf16*)(args.ws + WS_HB), (const bf16*)(args.ws + W_IN), D, D}; pg8::StaticOrder S; S.init(TT, GINP, G, bid, NREP(1));
        pg8::EpiInProj E{(bf16*)(args.ws + WS_RAW), (bf16*)(args.ws + WS_ZB)};
        pg8::gemm_phase<pg8::EpiInProj, pg8::StaticOrder, true, true>(lds, g, S, E);
        } SEAM(pb + 1); TICK_OUT(1); } }
    { ARGS(); if (IN(pb + 2)) { TICK_IN(2); _Pragma("unroll 1") for (int rep_ = 0; rep_ < NREP(2); ++rep_) { phase_conv(args, j, bid, G, tid); } SEAM(pb + 2); TICK_OUT(2); } }
#if GDN_NAIVE
    { ARGS(); if (IN(pb + 4)) { TICK_IN(4); _Pragma("unroll 1") for (int rep_ = 0; rep_ < NREP(4); ++rep_) { phase_gdn_naive(args, j, lds, bid, tid); } SEAM(pb + 4); TICK_OUT(4); } }
#else
    { ARGS(); if (IN(pb + 3)) { TICK_IN(3); _Pragma("unroll 1") for (int rep_ = 0; rep_ < NREP(3); ++rep_) { phase_gdn_local(args, lds, bid, G, wave, lane, rep_ + 1 < NREP(3)); } SEAM(pb + 3); TICK_OUT(3); } }
    { ARGS(); if (IN(pb + 4)) { TICK_IN(4); _Pragma("unroll 1") for (int rep_ = 0; rep_ < NREP(4); ++rep_) { phase_gdn_scan(args, j, lds, bid, tid, rep_ + 1 < NREP(4)); } SEAM(pb + 4); TICK_OUT(4); } }
#endif
    { ARGS(); if (IN(pb + 5)) { TICK_IN(5); {
        pg8::Gemm g{(const bf16*)(args.ws + WS_QKVC) + 2048, (const bf16*)(args.ws + W_OUT), 4096, 2048}; pg8::StaticOrder S; S.init(TT, D, G, bid);
        pg8::EpiResid E{j == 0 ? args.x : args.out, args.out, D, ALPHA};
        pg8::gemm_phase<pg8::EpiResid, pg8::StaticOrder, true, true>(lds, g, S, E);
        } SEAM(pb + 5); TICK_OUT(5); } }
    { ARGS(); if (IN(pb + 6)) { TICK_IN(6); _Pragma("unroll 1") for (int rep_ = 0; rep_ < NREP(6); ++rep_) { phase_ln<false>(args, (2 * j) * 2 + 0, j, lds, bid, G, tid, wave, lane); } SEAM(pb + 6); TICK_OUT(6); } }
    { ARGS(); if (IN(pb + 7)) { TICK_IN(7); {
        pg8::Gemm g{(const bf16*)(args.ws + WS_HB), (const bf16*)(args.ws + W_GU), D, D}; pg8::StaticOrder S; S.init(TT, 2 * FF, G, bid, NREP(7));
        pg8::EpiSwiGLU E{(bf16*)(args.ws + WS_ACT), FF, 0};
        pg8::gemm_phase<pg8::EpiSwiGLU, pg8::StaticOrder, true, true>(lds, g, S, E);
        } SEAM(pb + 7); TICK_OUT(7); } }
    { ARGS(); if (IN(pb + 8)) { TICK_IN(8); {
        pg8::Gemm g{(const bf16*)(args.ws + WS_ACT), (const bf16*)(args.ws + W_D), FF, FF}; pg8::StaticOrder S; S.init(TT, D, G, bid);
        pg8::EpiResid E{args.out, args.out, D, ALPHA};
        pg8::gemm_phase<pg8::EpiResid, pg8::StaticOrder, true, true>(lds, g, S, E);
        } SEAM(pb + 8); TICK_OUT(8); } }
    { ARGS(); if (IN(pb + 9)) { TICK_IN(9); _Pragma("unroll 1") for (int rep_ = 0; rep_ < NREP(9); ++rep_) { phase_ln<false>(args, (2 * j) * 2 + 1, j, lds, bid, G, tid, wave, lane); _Pragma("unroll 1") for (int r2_ = 0; r2_ < NREP(18); ++r2_) phase_w_sb(args, j, lds, bid, G, wave, lane); } SEAM(pb + 9); TICK_OUT(9); } }
    { ARGS(); if (IN(pb + 10)) { TICK_IN(10); {
        pg8::Gemm g{(const bf16*)(args.ws + WS_HB), (const bf16*)(args.ws + W_QKV), D, D}; pg8::StaticOrder S; S.init(TT, 3072, G, bid, NREP(10));
        pg8::EpiBf16 E{(bf16*)(args.ws + WS_QKV), 3072, 0};
        pg8::gemm_phase<pg8::EpiBf16, pg8::StaticOrder, true, true>(lds, g, S, E);
        } SEAM(pb + 10); TICK_OUT(10); } }
    #if SB_NAIVE
    { ARGS(); if (IN(pb + 11)) { TICK_IN(11); _Pragma("unroll 1") for (int rep_ = 0; rep_ < NREP(11); ++rep_) { phase_sb_naive(args, lds, bid, G, tid); } SEAM(pb + 11); TICK_OUT(11); } }
#else
    { ARGS(); if (IN(pb + 11)) { TICK_IN(11); _Pragma("unroll 1") for (int rep_ = 0; rep_ < NREP(11); ++rep_) { phase_sb_mfma(args, lds, bid, G, tid); } SEAM(pb + 11); TICK_OUT(11); } }
#endif
    { ARGS(); if (IN(pb + 12)) { TICK_IN(12); {
        pg8::Gemm g{(const bf16*)(args.ws + WS_AO), (const bf16*)(args.ws + W_O), D, D}; pg8::StaticOrder S; S.init(TT, D, G, bid);
        pg8::EpiResid E{args.out, args.out, D, ALPHA};
        pg8::gemm_phase<pg8::EpiResid, pg8::StaticOrder, true, true>(lds, g, S, E);
        } SEAM(pb + 12); TICK_OUT(12); } }
    { ARGS(); if (IN(pb + 13)) { TICK_IN(13); _Pragma("unroll 1") for (int rep_ = 0; rep_ < NREP(13); ++rep_) { phase_ln<true>(args, (2 * j + 1) * 2 + 0, j, lds, bid, G, tid, wave, lane); } SEAM(pb + 13); TICK_OUT(13); } }
    { ARGS(); if (IN(pb + 14)) { TICK_IN(14); _Pragma("unroll 1") for (int rep_ = 0; rep_ < NREP(14); ++rep_) { phase_scatter(args, j, lds, bid, G, tid, wave, lane); } SEAM(pb + 14); TICK_OUT(14); } }
    { ARGS(); if (IN(pb + 15)) { TICK_IN(15); {
        unsigned off[9]; moe_offsets(args, j, off);
        pg8::MoeOrder S; S.nM = (int)(off[8] >> 8); S.G = G; S.c = bid; S.nN = 2 * FF / 256; S.nwg = S.nM * S.nN; S.rep = NREP(15);
        S.ps1 = (int)(off[1] >> 8); S.ps2 = (int)(off[2] >> 8); S.ps3 = (int)(off[3] >> 8); S.ps4 = (int)(off[4] >> 8); S.ps5 = (int)(off[5] >> 8); S.ps6 = (int)(off[6] >> 8); S.ps7 = (int)(off[7] >> 8);
        pg8::Gemm g{(const bf16*)(args.ws + WS_XS), (const bf16*)(args.ws + W_MGU), D, D};
        pg8::EpiSwiGLU E{(bf16*)(args.ws + WS_MACT), FF, 2 * FF / 256};
        pg8::gemm_phase<pg8::EpiSwiGLU, pg8::MoeOrder, true, true>(lds, g, S, E);
        } SEAM(pb + 15); TICK_OUT(15); } }
    { ARGS(); if (IN(pb + 16)) { TICK_IN(16); {
        unsigned off[9]; moe_offsets(args, j, off);
        pg8::MoeOrder S; S.nM = (int)(off[8] >> 8); S.G = G; S.c = bid; S.nN = D / 256; S.nwg = S.nM * S.nN; S.rep = NREP(16);
        S.ps1 = (int)(off[1] >> 8); S.ps2 = (int)(off[2] >> 8); S.ps3 = (int)(off[3] >> 8); S.ps4 = (int)(off[4] >> 8); S.ps5 = (int)(off[5] >> 8); S.ps6 = (int)(off[6] >> 8); S.ps7 = (int)(off[7] >> 8);
        pg8::Gemm g{(const bf16*)(args.ws + WS_MACT), (const bf16*)(args.ws + W_MD), FF, FF};
        pg8::EpiBf16 E{(bf16*)(args.ws + WS_XS), D, D / 256};
        pg8::gemm_phase<pg8::EpiBf16, pg8::MoeOrder, true, true>(lds, g, S, E);
        } SEAM(pb + 16); TICK_OUT(16); } }
    { ARGS(); if (IN(pb + 17)) { TICK_IN(17); _Pragma("unroll 1") for (int rep_ = 0; rep_ < NREP(17); ++rep_) { phase_combine_ln(args, (2 * j + 1) * 2 + 1, bid, G, wave, lane); } SEAM(pb + 17); TICK_OUT(17); } }
}
__global__ void __launch_bounds__(NWAVES * 64, 2) fwd(Args kargs) {
    extern __shared__ __attribute__((aligned(16))) unsigned char lds_raw[];
    LAS unsigned char* lds = (LAS unsigned char*)lds_raw;
    volatile LAS unsigned* MISC = (volatile LAS unsigned*)(lds + MISC_OFF);
    const int tid = threadIdx.x, lane = tid & 63, wave = __builtin_amdgcn_readfirstlane(tid >> 6), G = gridDim.x, bid = blockIdx.x;
    for (int u = tid; u < (LDS_BYTES - RING_BYTES) / 4; u += NWAVES * 64) ((LAS unsigned*)(lds + RING_BYTES))[u] = 0u;
    __syncthreads();
    if (tid == 0) { LAS unsigned long long* pa = (LAS unsigned long long*)(lds + ARGS_OFF);
        pa[0] = (unsigned long long)kargs.x; pa[1] = (unsigned long long)kargs.gdn_w_in; pa[2] = (unsigned long long)kargs.gdn_conv_w; pa[3] = (unsigned long long)kargs.gdn_a_log;
        pa[4] = (unsigned long long)kargs.gdn_dt_bias; pa[5] = (unsigned long long)kargs.gdn_norm_w; pa[6] = (unsigned long long)kargs.gdn_w_out; pa[7] = (unsigned long long)kargs.sb_w_in;
        pa[8] = (unsigned long long)kargs.sb_w_out; pa[9] = (unsigned long long)kargs.ffn_w_gate; pa[10] = (unsigned long long)kargs.ffn_w_up; pa[11] = (unsigned long long)kargs.ffn_w_down;
        pa[12] = (unsigned long long)kargs.moe_router; pa[13] = (unsigned long long)kargs.moe_w_gate; pa[14] = (unsigned long long)kargs.moe_w_up; pa[15] = (unsigned long long)kargs.moe_w_down;
        pa[16] = (unsigned long long)kargs.ln_g; pa[17] = (unsigned long long)kargs.ln_b; pa[18] = (unsigned long long)kargs.out; pa[19] = (unsigned long long)kargs.ws;
        pa[20] = (unsigned long long)(unsigned)kargs.ph_lo | ((unsigned long long)(unsigned)kargs.ph_hi << 32); }
    XcdBarrier bar = xcd_barrier_post((unsigned*)(kargs.ws + WS_CTL) + CW_BAR, MISC + 8);
    __syncthreads();
    layer_pair<0>(lds, bar, wave, G, bid);
    layer_pair<1>(lds, bar, wave, G, bid);
    if (PROBE_DELAY_MASK) { if (bid == 0 && threadIdx.x == 0) { const unsigned acc = ((volatile LAS unsigned*)(lds + MISC_OFF))[20] * PROBE_DELAY_MULT; const unsigned long long t0 = __builtin_amdgcn_s_memrealtime(); while ((unsigned)(__builtin_amdgcn_s_memrealtime() - t0) < acc) __builtin_amdgcn_s_sleep(8); } }
}
#undef IN
#undef SEAM
#undef ARGS

extern "C" void kernel_launch(void* const* d_in, const int* in_sizes, int n_in, void* d_out, int out_size, void* d_ws, size_t ws_size, hipStream_t stream) {
    static int grid = 0;
    if (grid == 0) {
        if (n_in != 18 || in_sizes[0] != TT * D || out_size != TT * D || ws_size < WS_END + 32 * MiB) { fprintf(stderr, "kernel_launch: unexpected shapes (n_in %d, in0 %d, out %d, ws %zu); nothing launched\n", n_in, n_in > 0 ? in_sizes[0] : -1, out_size, ws_size); grid = -1; return; }
        int dev = 0, cus = 0, per_cu = 0;
        if (hipGetDevice(&dev) != hipSuccess || hipDeviceGetAttribute(&cus, hipDeviceAttributeMultiprocessorCount, dev) != hipSuccess) { grid = -1; return; }
        if (hipFuncSetAttribute((const void*)fwd, hipFuncAttributeMaxDynamicSharedMemorySize, LDS_BYTES) != hipSuccess) { fprintf(stderr, "kernel_launch: hipFuncSetAttribute failed\n"); grid = -1; return; }
        if (hipOccupancyMaxActiveBlocksPerMultiprocessor(&per_cu, (const void*)fwd, NWAVES * 64, LDS_BYTES) != hipSuccess || per_cu < 1) { fprintf(stderr, "kernel_launch: occupancy query says %d blocks per CU\n", per_cu); (void)hipGetLastError(); grid = -1; return; }
        grid = cus;
    }
    if (grid < 0) return;
    if (hipMemsetAsync((char*)d_ws + WS_CTL, 0, CTL_ZERO_BYTES, stream) != hipSuccess) return;
    Args a{};
    a.x = (const float*)d_in[0]; a.gdn_w_in = (const float*)d_in[1]; a.gdn_conv_w = (const float*)d_in[2]; a.gdn_a_log = (const float*)d_in[3]; a.gdn_dt_bias = (const float*)d_in[4];
    a.gdn_norm_w = (const float*)d_in[5]; a.gdn_w_out = (const float*)d_in[6]; a.sb_w_in = (const float*)d_in[7]; a.sb_w_out = (const float*)d_in[8];
    a.ffn_w_gate = (const float*)d_in[9]; a.ffn_w_up = (const float*)d_in[10]; a.ffn_w_down = (const float*)d_in[11]; a.moe_router = (const float*)d_in[12];
    a.moe_w_gate = (const float*)d_in[13]; a.moe_w_up = (const float*)d_in[14]; a.moe_w_down = (const float*)d_in[15]; a.ln_g = (const float*)d_in[16]; a.ln_b = (const float*)d_in[17];
    a.out = (float*)d_out; a.ws = (unsigned char*)d_ws;
#if MK_ONE_LAUNCH
    a.ph_lo = 0; a.ph_hi = NPHASES;
    hipLaunchKernelGGL(fwd, dim3(grid), dim3(NWAVES * 64), LDS_BYTES, stream, a);
#else
    for (int p = 0; p < NPHASES; ++p) { a.ph_lo = p; a.ph_hi = p + 1; hipLaunchKernelGGL(fwd, dim3(grid), dim3(NWAVES * 64), LDS_BYTES, stream, a); }
#endif
}
```

```cpp
#include <hip/hip_runtime.h>
#include <cstdio>
#include <cstdint>
#ifndef GDN_NAIVE
#define GDN_NAIVE 0
#endif
#ifndef SB_NAIVE
#define SB_NAIVE 0
#endif
#ifndef MK_ONE_LAUNCH
#define MK_ONE_LAUNCH 1
#endif
namespace pg8 {
#define PG8_LAS __attribute__((address_space(3)))
typedef unsigned short bf16_t;
typedef short bf16x8 __attribute__((ext_vector_type(8)));
typedef float f32x4 __attribute__((ext_vector_type(4)));
typedef unsigned u32x4 __attribute__((ext_vector_type(4)));
constexpr int BM = 256, BK = 64, HALF = 128, HTB = HALF * BK * 2  , STAGE_BYTES = 8 * HTB, NXCD = 8, WGM = 8;

__host__ __device__ __forceinline__ int lds_byte(int r, int c) { const int st = (r >> 4) * 2 + (c >> 5), rr = r & 15, cc = c & 31, ob = rr * 64 + cc * 2; return st * 1024 + (ob ^ (((ob >> 9) & 1) << 5)); }
__host__ __device__ __forceinline__ void stage_rc(int b, int& R, int& C) { const int st = b / 1024, sb = b % 1024, swz = sb ^ (((sb >> 9) & 1) << 5); R = (st >> 1) * 16 + swz / 64; C = (st & 1) * 32 + (swz % 64) / 2; }
__host__ __device__ __forceinline__ int perm32(int rho) { const int n = rho >> 4, i = rho & 15; return 8 * (i >> 2) + 4 * n + (i & 3); }

struct Unit { int pm, pn; };
struct Gemm { const bf16_t* A; const bf16_t* Bt; int lda, K; };

struct StaticOrder {
    int nM, nN, nwg, G, c, rep;
    __host__ __device__ void init(int M, int N, int G_, int c_, int rep_ = 1) { nM = M / BM; nN = N / BM; nwg = nM * nN; G = G_; c = c_; rep = rep_; }
    __host__ __device__ bool next(int i, Unit& u) const {
        const long L = (long)i * G + c; if (L >= (long)rep * nwg) return false;
        int wgid = (int)(L % nwg); { const int q = nwg / NXCD, r = nwg % NXCD, xcd = wgid % NXCD, off = wgid / NXCD; wgid = (xcd < r ? xcd * (q + 1) : r * (q + 1) + (xcd - r) * q) + off; }
        const int nig = WGM * nN, gid = wgid / nig, fm = gid * WGM, gsz = (nM - fm) < WGM ? (nM - fm) : WGM;
        u.pm = fm + ((wgid % nig) % gsz); u.pn = (wgid % nig) / gsz; return true;
    }
    __device__ __forceinline__ void a_ready(const Unit&) const {}
    __device__ __forceinline__ void done(const Unit&) const {}
};

__device__ __forceinline__ unsigned cvt_pk_bf16(float lo, float hi) { unsigned r; asm volatile("v_cvt_pk_bf16_f32 %0, %1, %2" : "=v"(r) : "v"(lo), "v"(hi)); return r; }
struct EpiBf16 {
    static constexpr bool PERM = true, AFTER_DRAIN = false;
    bf16_t* O; int ldc; int nmod;
    __device__ __forceinline__ void operator()(const f32x4 (&acc)[2][2][4][2], const Unit& u, int wr, int wc, int fr, int fq) const {
        const int pnl = nmod ? (u.pn % nmod) : u.pn;
        const int row0 = u.pm * BM + wr * 64 + fr, col0 = pnl * BM + wc * 32 + 8 * fq;
#pragma unroll
        for (int ai = 0; ai < 2; ++ai)
#pragma unroll
            for (int m = 0; m < 4; ++m) { bf16_t* rowp = O + (size_t)(row0 + ai * HALF + m * 16) * ldc + col0;
#pragma unroll
                for (int bj = 0; bj < 2; ++bj) { const f32x4 v0 = acc[ai][bj][m][0], v1 = acc[ai][bj][m][1];
                    u32x4 w; w.x = cvt_pk_bf16(v0[0], v0[1]); w.y = cvt_pk_bf16(v0[2], v0[3]); w.z = cvt_pk_bf16(v1[0], v1[1]); w.w = cvt_pk_bf16(v1[2], v1[3]);
                    *(u32x4*)(rowp + bj * HALF) = w; } }
    }
};
struct EpiInProj {
    static constexpr bool PERM = true, AFTER_DRAIN = false;
    bf16_t* RAW; bf16_t* ZB;
    __device__ __forceinline__ void operator()(const f32x4 (&acc)[2][2][4][2], const Unit& u, int wr, int wc, int fr, int fq) const {
        const bool isz = (u.pn >= 16 && u.pn < 24);
        bf16_t* O = isz ? ZB : RAW; const int ldc = isz ? 2048 : 4352; const int ct = isz ? (u.pn - 16) : (u.pn < 16 ? u.pn : 16);
        const int row0 = u.pm * BM + wr * 64 + fr, col0 = ct * BM + wc * 32 + 8 * fq;
#pragma unroll
        for (int ai = 0; ai < 2; ++ai)
#pragma unroll
            for (int m = 0; m < 4; ++m) { bf16_t* rowp = O + (size_t)(row0 + ai * HALF + m * 16) * ldc + col0;
#pragma unroll
                for (int bj = 0; bj < 2; ++bj) { const f32x4 v0 = acc[ai][bj][m][0], v1 = acc[ai][bj][m][1];
                    u32x4 w; w.x = cvt_pk_bf16(v0[0], v0[1]); w.y = cvt_pk_bf16(v0[2], v0[3]); w.z = cvt_pk_bf16(v1[0], v1[1]); w.w = cvt_pk_bf16(v1[2], v1[3]);
                    *(u32x4*)(rowp + bj * HALF) = w; } }
    }
};
__device__ __forceinline__ float silu_f(float x) { return x * __builtin_amdgcn_rcpf(1.0f + __builtin_amdgcn_exp2f(-1.4426950408889634f * x)); }
struct EpiSwiGLU {
    static constexpr bool PERM = true, AFTER_DRAIN = false;
    bf16_t* O; int ldc; int nmod;
    __device__ __forceinline__ void operator()(const f32x4 (&acc)[2][2][4][2], const Unit& u, int wr, int wc, int fr, int fq) const {
        const int pnl = nmod ? (u.pn % nmod) : u.pn;
        const int row0 = u.pm * BM + wr * 64 + fr, col0 = pnl * HALF + wc * 32 + 8 * fq;
#pragma unroll
        for (int ai = 0; ai < 2; ++ai)
#pragma unroll
            for (int m = 0; m < 4; ++m) { bf16_t* rowp = O + (size_t)(row0 + ai * HALF + m * 16) * ldc + col0;
                const f32x4 g0 = acc[ai][0][m][0], g1 = acc[ai][0][m][1], u0 = acc[ai][1][m][0], u1 = acc[ai][1][m][1];
                u32x4 w;
                w.x = cvt_pk_bf16(silu_f(g0[0]) * u0[0], silu_f(g0[1]) * u0[1]); w.y = cvt_pk_bf16(silu_f(g0[2]) * u0[2], silu_f(g0[3]) * u0[3]);
                w.z = cvt_pk_bf16(silu_f(g1[0]) * u1[0], silu_f(g1[1]) * u1[1]); w.w = cvt_pk_bf16(silu_f(g1[2]) * u1[2], silu_f(g1[3]) * u1[3]);
                *(u32x4*)rowp = w; }
    }
};
template <bool LNR> struct EpiResid {
    static constexpr bool PERM = false, AFTER_DRAIN = false;
    const float* res; float* out; const float* stats; const float* g; const float* b;
    __device__ __forceinline__ void operator()(const f32x4 (&acc)[2][2][4][2], const Unit& u, int wr, int wc, int fr, int fq) const {
        constexpr int ldc = 1024; constexpr float alpha = 1.6817928305074290f;
        const int row0 = u.pm * BM + wr * 64 + fr, col0 = u.pn * BM + wc * 32 + 4 * fq;
        if constexpr (!LNR) {
#pragma unroll
            for (int ai = 0; ai < 2; ++ai)
#pragma unroll
                for (int m = 0; m < 4; ++m) { const size_t off = (size_t)(row0 + ai * HALF + m * 16) * ldc + col0;
#pragma unroll
                    for (int bj = 0; bj < 2; ++bj)
#pragma unroll
                        for (int n = 0; n < 2; ++n) { const f32x4 r = *(const f32x4*)(res + off + bj * HALF + n * 16);
                            *(f32x4*)(out + off + bj * HALF + n * 16) = r * alpha + acc[ai][bj][m][n]; } }
        } else {
#pragma unroll
            for (int bj = 0; bj < 2; ++bj)
#pragma unroll
                for (int n = 0; n < 2; ++n) {
                    const f32x4 gv = *(const f32x4*)(g + col0 + bj * HALF + n * 16) * alpha, bv = *(const f32x4*)(b + col0 + bj * HALF + n * 16) * alpha;
#pragma unroll
                    for (int ai = 0; ai < 2; ++ai)
#pragma unroll
                        for (int m = 0; m < 4; ++m) { const int row = row0 + ai * HALF + m * 16; const size_t off = (size_t)row * ldc + col0 + bj * HALF + n * 16;
                            const float mean = stats[2 * row], rstd = stats[2 * row + 1];
                            const f32x4 r = *(const f32x4*)(res + off);
                            *(f32x4*)(out + off) = (r - mean) * rstd * gv + bv + acc[ai][bj][m][n]; }
                    asm volatile("" ::: "memory");
                }
        }
    }
};
struct MoeOrder {
    int nM, nN, nwg, G, c, rep; int ps1, ps2, ps3, ps4, ps5, ps6, ps7;
    __device__ __forceinline__ bool next(int i, Unit& u) const {
        const long L = (long)i * G + c; if (nwg == 0 || L >= (long)rep * nwg) return false;
        int wgid = (int)(L % nwg); { const int q = nwg / NXCD, r = nwg % NXCD, xcd = wgid % NXCD, off = wgid / NXCD; wgid = (xcd < r ? xcd * (q + 1) : r * (q + 1) + (xcd - r) * q) + off; }
        const int nig = WGM * nN, gid = wgid / nig, fm = gid * WGM, gsz = (nM - fm) < WGM ? (nM - fm) : WGM;
        const int pm = fm + ((wgid % nig) % gsz), pnl = (wgid % nig) / gsz;
        const int e = (pm >= ps1) + (pm >= ps2) + (pm >= ps3) + (pm >= ps4) + (pm >= ps5) + (pm >= ps6) + (pm >= ps7);
        u.pm = pm; u.pn = e * nN + pnl; return true;
    }
    __device__ __forceinline__ void a_ready(const Unit&) const {}
    __device__ __forceinline__ void done(const Unit&) const {}
};
template <class Epi, class Sched, bool ALIGN_EPI = false, bool SP2 = false>
__device__ __forceinline__ void gemm_phase(PG8_LAS unsigned char* lds, const Gemm g, const Sched& S, const Epi& E) {
    const int tid = threadIdx.x, wid = __builtin_amdgcn_readfirstlane(tid >> 6), lane = tid & 63, wr = wid >> 2, wc = wid & 3, fr = lane & 15, fq = lane >> 4;
    const int K = g.K, nt = K / BK;
    unsigned voffA[2], voffB[2];
#pragma unroll
    for (int i = 0; i < 2; ++i) { int R, C; stage_rc(tid * 16 + i * 8192, R, C); const int Rb = Epi::PERM ? ((R & ~31) + perm32(R & 31)) : R;
        voffA[i] = (unsigned)(R * g.lda + C) * 2u; voffB[i] = (unsigned)(Rb * K + C) * 2u; }
    const size_t kstep = (size_t)(BK * 2);
    const size_t hstepA = (size_t)HALF * g.lda * 2, hstepB = (size_t)HALF * K * 2;
    const size_t tstepA = 2 * hstepA, tstepB = 2 * hstepB;
    const unsigned ldsw = (unsigned)wid * 1024u;
    const int aoff = lds_byte(wr * 64 + fr, fq * 8), boff = lds_byte(wc * 32 + fr, fq * 8);
#define PG8_SA(b, h) (((b) * 2 + (h)) * HTB)
#define PG8_SB(b, h) ((4 + (b) * 2 + (h)) * HTB)
#define PG8_STAGE(bufoff, gbase, voff) do { _Pragma("unroll") for (int _i = 0; _i < 2; ++_i) \
        __builtin_amdgcn_global_load_lds((const unsigned*)((const char*)(gbase) + (voff)[_i]), (PG8_LAS unsigned*)(lds + (bufoff) + ldsw + _i * 8192), 16, 0, 0); } while (0)
#define PG8_LDA(dst, b, h) do { _Pragma("unroll") for (int m = 0; m < 4; ++m) _Pragma("unroll") for (int k = 0; k < 2; ++k) dst[m][k] = *(const PG8_LAS bf16x8*)(lds + PG8_SA(b, h) + aoff + m * 2048 + k * 1024); } while (0)
#define PG8_LDB(dst, b, h) do { _Pragma("unroll") for (int n = 0; n < 2; ++n) _Pragma("unroll") for (int k = 0; k < 2; ++k) dst[n][k] = *(const PG8_LAS bf16x8*)(lds + PG8_SB(b, h) + boff + n * 2048 + k * 1024); } while (0)
#define PG8_MMA(ai, bj, At, Bt) do { __builtin_amdgcn_s_setprio(1); _Pragma("unroll") for (int m = 0; m < 4; ++m) _Pragma("unroll") for (int n = 0; n < 2; ++n) _Pragma("unroll") for (int k = 0; k < 2; ++k) \
        acc[ai][bj][m][n] = __builtin_amdgcn_mfma_f32_16x16x32_bf16(Bt[n][k], At[m][k], acc[ai][bj][m][n], 0, 0, 0); __builtin_amdgcn_s_setprio(0); } while (0)
#define PG8_WAIT_V(n) asm volatile("s_waitcnt vmcnt(" #n ")" ::: "memory")
#define PG8_WAIT_L(n) asm volatile("s_waitcnt lgkmcnt(" #n ")" ::: "memory")
#define PG8_BAR __builtin_amdgcn_s_barrier()
#define PG8_SCHED __builtin_amdgcn_sched_barrier(0)
    Unit cur, nxt; int ui = 0;
    if (!S.next(0, cur)) return;
    f32x4 acc[2][2][4][2];
#pragma unroll
    for (int a = 0; a < 2; ++a)
#pragma unroll
        for (int b = 0; b < 2; ++b)
#pragma unroll
            for (int m = 0; m < 4; ++m)
#pragma unroll
                for (int n = 0; n < 2; ++n) acc[a][b][m][n] = (f32x4){0.f, 0.f, 0.f, 0.f};
    bf16x8 At[4][2], B0[2][2], B1[2][2];
    const char* cA = (const char*)g.A + (size_t)cur.pm * tstepA; const char* cB = (const char*)g.Bt + (size_t)cur.pn * tstepB;
    S.a_ready(cur);
    if constexpr (SP2) {
        PG8_STAGE(PG8_SB(0, 0), cB, voffB); PG8_STAGE(PG8_SB(0, 1), cB + hstepB, voffB); PG8_STAGE(PG8_SA(0, 0), cA, voffA); PG8_STAGE(PG8_SA(0, 1), cA + hstepA, voffA);
        if (wr == 1) PG8_BAR;
        PG8_WAIT_V(2); PG8_BAR;
        PG8_STAGE(PG8_SB(1, 0), cB + kstep, voffB); PG8_STAGE(PG8_SA(1, 0), cA + kstep, voffA); PG8_STAGE(PG8_SB(1, 1), cB + hstepB + kstep, voffB);
        PG8_WAIT_V(6); PG8_BAR;
    } else {
        PG8_STAGE(PG8_SB(0, 0), cB, voffB); PG8_STAGE(PG8_SA(0, 0), cA, voffA); PG8_STAGE(PG8_SB(0, 1), cB + hstepB, voffB); PG8_STAGE(PG8_SA(0, 1), cA + hstepA, voffA);
        if (wr == 1) PG8_BAR;
        PG8_WAIT_V(4); PG8_BAR;
        PG8_STAGE(PG8_SB(1, 0), cB + kstep, voffB); PG8_STAGE(PG8_SA(1, 0), cA + kstep, voffA); PG8_STAGE(PG8_SB(1, 1), cB + hstepB + kstep, voffB);
        PG8_WAIT_V(6); PG8_BAR;
    }
    for (;;) {
        const bool has_next = S.next(ui + 1, nxt);
        const char* nA = has_next ? (const char*)g.A + (size_t)nxt.pm * tstepA : cA; const char* nB = has_next ? (const char*)g.Bt + (size_t)nxt.pn * tstepB : cB;
        for (int t = 0; t < nt; t += 2) {
            const bool last = (t == nt - 2);
            const char* a1 = cA + (size_t)(t + 1) * kstep;
            const char* a2 = last ? nA : cA + (size_t)(t + 2) * kstep; const char* b2 = last ? nB : cB + (size_t)(t + 2) * kstep;
            const char* a3 = a2 + kstep; const char* b3 = b2 + kstep;
            if (last && has_next) S.a_ready(nxt);
            if constexpr (SP2) {
            PG8_LDB(B0, 0, 0); PG8_LDB(B1, 0, 1); PG8_SCHED; PG8_LDA(At, 0, 0); PG8_STAGE(PG8_SA(1, 1), a1 + hstepA, voffA);
            PG8_WAIT_V(8); PG8_WAIT_L(0); PG8_BAR; PG8_MMA(0, 0, At, B0); PG8_MMA(0, 1, At, B1); PG8_BAR; PG8_SCHED;
            PG8_LDA(At, 0, 1); PG8_STAGE(PG8_SB(0, 0), b2, voffB); PG8_STAGE(PG8_SB(0, 1), b2 + hstepB, voffB); PG8_STAGE(PG8_SA(0, 0), a2, voffA);
            PG8_WAIT_V(8); PG8_WAIT_L(0); PG8_BAR; PG8_MMA(1, 0, At, B0); PG8_MMA(1, 1, At, B1); PG8_BAR; PG8_SCHED;
            PG8_LDB(B0, 1, 0); PG8_LDB(B1, 1, 1); PG8_SCHED; PG8_LDA(At, 1, 0); PG8_STAGE(PG8_SA(0, 1), a2 + hstepA, voffA);
            PG8_WAIT_V(8); PG8_WAIT_L(0); PG8_BAR; PG8_MMA(0, 0, At, B0); PG8_MMA(0, 1, At, B1); PG8_BAR; PG8_SCHED;
            PG8_LDA(At, 1, 1); PG8_STAGE(PG8_SB(1, 0), b3, voffB); PG8_STAGE(PG8_SB(1, 1), b3 + hstepB, voffB); PG8_STAGE(PG8_SA(1, 0), a3, voffA);
            PG8_WAIT_V(8); PG8_WAIT_L(0); PG8_BAR; PG8_MMA(1, 0, At, B0); PG8_MMA(1, 1, At, B1); PG8_BAR; PG8_SCHED;
            } else {
            PG8_LDB(B0, 0, 0); PG8_SCHED; PG8_LDA(At, 0, 0); PG8_STAGE(PG8_SA(1, 1), a1 + hstepA, voffA);
            PG8_WAIT_L(8); PG8_BAR; PG8_WAIT_L(0); PG8_MMA(0, 0, At, B0); PG8_BAR; PG8_SCHED;
            PG8_LDB(B1, 0, 1); PG8_STAGE(PG8_SB(0, 0), b2, voffB);
            PG8_BAR; PG8_WAIT_L(0); PG8_MMA(0, 1, At, B1); PG8_BAR;
            PG8_LDA(At, 0, 1); PG8_STAGE(PG8_SA(0, 0), a2, voffA);
            PG8_BAR; PG8_WAIT_L(0); PG8_MMA(1, 0, At, B0); PG8_BAR; PG8_SCHED;
            PG8_STAGE(PG8_SB(0, 1), b2 + hstepB, voffB);
            PG8_WAIT_V(6); PG8_BAR; PG8_MMA(1, 1, At, B1); PG8_BAR;
            PG8_LDB(B0, 1, 0); PG8_SCHED; PG8_LDA(At, 1, 0); PG8_STAGE(PG8_SA(0, 1), a2 + hstepA, voffA);
            PG8_WAIT_L(8); PG8_BAR; PG8_WAIT_L(0); PG8_MMA(0, 0, At, B0); PG8_BAR; PG8_SCHED;
            PG8_LDB(B1, 1, 1); PG8_STAGE(PG8_SB(1, 0), b3, voffB);
            PG8_BAR; PG8_WAIT_L(0); PG8_MMA(0, 1, At, B1); PG8_BAR;
            PG8_LDA(At, 1, 1); PG8_STAGE(PG8_SA(1, 0), a3, voffA);
            PG8_BAR; PG8_WAIT_L(0); PG8_MMA(1, 0, At, B0); PG8_BAR; PG8_SCHED;
            PG8_STAGE(PG8_SB(1, 1), b3 + hstepB, voffB);
            PG8_WAIT_V(6); PG8_BAR; PG8_MMA(1, 1, At, B1); PG8_BAR;
            }
        }
        if constexpr (ALIGN_EPI) { if (wr == 0) PG8_BAR; }
        if constexpr (!Epi::AFTER_DRAIN) { E(acc, cur, wr, wc, fr, fq); S.done(cur); }
        if (!has_next) break;
#pragma unroll
        for (int a = 0; a < 2; ++a)
#pragma unroll
            for (int b = 0; b < 2; ++b)
#pragma unroll
                for (int m = 0; m < 4; ++m)
#pragma unroll
                    for (int n = 0; n < 2; ++n) acc[a][b][m][n] = (f32x4){0.f, 0.f, 0.f, 0.f};
        cur = nxt; cA = nA; cB = nB; ++ui;
        if constexpr (ALIGN_EPI) { if (wr == 1) PG8_BAR; }
    }
    PG8_WAIT_V(0);
    if constexpr (!ALIGN_EPI) { if (wr == 0) PG8_BAR; }
    PG8_BAR;
    if constexpr (Epi::AFTER_DRAIN) { E.fused(acc, cur, wr, wc, fr, fq, lds, wid, lane); S.done(cur); }
#undef PG8_SA
#undef PG8_SB
#undef PG8_STAGE
#undef PG8_LDA
#undef PG8_LDB
#undef PG8_MMA
#undef PG8_WAIT_V
#undef PG8_WAIT_L
#undef PG8_BAR
#undef PG8_SCHED
}
}

constexpr int NWAVES = 8;
constexpr int BATCH = 8, SEQ = 4096, TT = BATCH * SEQ, D = 1024;
constexpr int HK = 8, HV = 16, HD = 128;
constexpr int GIN = 6176, GINP = 6400;
constexpr int FF = 3584, NE = 8, MOE_ROWS = 67584;
constexpr float ALPHA = 1.6817928305074290f;
constexpr float LN_EPS = 1e-5f, RMS_EPS = 1e-6f;
constexpr int NPH = 18, NPHASES = 2 * NPH;

constexpr size_t MiB = 1ull << 20;
constexpr size_t WS_CTL = 0, CTL_ZERO_BYTES = 1 * MiB;
constexpr size_t WS_E12 = 1 * MiB;
constexpr size_t WS_G12 = WS_E12 + 256 * 1024;
constexpr size_t WS_POS = WS_G12 + 256 * 1024;
constexpr size_t WS_GB = 2 * MiB;
constexpr size_t WS_W = 16 * MiB;
constexpr size_t WS_W2 = 912 * MiB;
constexpr size_t W_IN = WS_W2, W_OUT = WS_W2 + 13 * MiB, W_GU = WS_W2 + 17 * MiB, W_D = WS_W2 + 31 * MiB;
constexpr size_t W_QKV = WS_W, W_O = WS_W + 6 * MiB, W_MGU = WS_W + 8 * MiB, W_MD = WS_W + 120 * MiB;
constexpr size_t WS_HB = 192 * MiB;
constexpr size_t WS_BIG = 256 * MiB;
constexpr size_t WS_ZB = WS_BIG, WS_RAW = WS_BIG + 128 * MiB, WS_QKVC = WS_BIG + 400 * MiB;
constexpr int RAWLD = 4352;
constexpr size_t WS_WMEM = WS_RAW, WS_IMEM = WS_RAW + 128 * MiB, WS_KTMEM = WS_RAW + 192 * MiB;
constexpr size_t WS_STATS = 12 * MiB;
constexpr size_t WS_GTAB = 6 * MiB;
constexpr size_t WS_ACT = WS_BIG;
constexpr size_t WS_QKV = WS_BIG, WS_AO = WS_BIG + 192 * MiB;
constexpr size_t WS_XS = WS_BIG, WS_MACT = WS_BIG + 132 * MiB;
constexpr size_t WS_END = 950 * MiB;
static_assert(WS_QKVC + (size_t)TT * 4096 * 2 <= WS_W2 && WS_MACT + (size_t)MOE_ROWS * FF * 2 <= WS_END && WS_RAW + (size_t)TT * RAWLD * 2 <= WS_QKVC && WS_KTMEM + (size_t)4096 * 8192 * 2 <= WS_QKVC && WS_GTAB + (size_t)8192 * 192 * 4 <= WS_W, "d_ws map");
static_assert(W_MD + (size_t)NE * D * FF * 2 <= WS_HB && W_IN + (size_t)GINP * D * 2 <= W_OUT && W_D + (size_t)D * FF * 2 <= WS_END && WS_QKVC + (size_t)TT * 4096 * 2 <= WS_W2 && W_MGU + (size_t)NE * 2 * FF * D * 2 <= W_MD, "weight map");
constexpr int CW_BAR = 4096;
constexpr int CW_CNT = 16384;

constexpr int RING_BYTES = 131072;
constexpr int MISC_OFF = RING_BYTES + 320;
constexpr int OGST_OFF = 147456;
constexpr int LDS_BYTES = 163840;

#define GAS __attribute__((address_space(1)))
#define LAS __attribute__((address_space(3)))
#define DI __device__ __forceinline__
typedef unsigned short bf16;
typedef unsigned v4u __attribute__((ext_vector_type(4)));
typedef unsigned v2u __attribute__((ext_vector_type(2)));
typedef float f32x4 __attribute__((ext_vector_type(4)));
typedef float f32x2 __attribute__((ext_vector_type(2)));
typedef GAS unsigned gu32;
#define RLX_AGENT __ATOMIC_RELAXED, __HIP_MEMORY_SCOPE_AGENT
#define LDS_WAIT() asm volatile("s_waitcnt lgkmcnt(0)" ::: "memory")
#define VM_WAIT() asm volatile("s_waitcnt vmcnt(0)" ::: "memory")
__device__ __forceinline__ unsigned long long rt() { return __builtin_amdgcn_s_memrealtime(); }
__device__ __forceinline__ unsigned f2bf(float f) { unsigned u = __builtin_bit_cast(unsigned, f); return (u + 0x7fffu + ((u >> 16) & 1u)) >> 16; }
__device__ __forceinline__ unsigned pk2(float lo, float hi) { return f2bf(lo) | (f2bf(hi) << 16); }

#define XB_TMO      128
#define XB_XCNT(j)  (256  + 64 * (j))
#define XB_XSUB(j)  (1280 + 64 * (j))
#define XB_XGEN(j)  (2304 + 64 * (j))
#define XB_TOP      3328
#define XB_TOPGEN   3392
#define XCD_BAR_WORDS 3456
#define XB_SPIN_CAP (1u << 22)

__device__ __forceinline__ unsigned xb_ld(unsigned* p)              { return __hip_atomic_load(p, __ATOMIC_RELAXED, __HIP_MEMORY_SCOPE_AGENT); }
__device__ __forceinline__ unsigned xb_add(unsigned* p, unsigned v) { return __hip_atomic_fetch_add(p, v, __ATOMIC_RELAXED, __HIP_MEMORY_SCOPE_AGENT); }
__device__ __forceinline__ unsigned xb_xcc_id() { return (unsigned)__builtin_amdgcn_s_getreg((3 << 11) | 20) & 0xFu; }
#define XB_SPIN(cond, bar) do { unsigned _sp = 0; while (cond) { __builtin_amdgcn_s_sleep(1); \
    if ((++_sp & 255u) == 0u) { if (xb_ld(&(bar)[XB_TMO])) break; if (_sp > XB_SPIN_CAP) { atomicAdd(&(bar)[XB_TMO], 1u); break; } } } } while (0)

struct XcdBarrier {
    unsigned* bar; unsigned x;
    volatile LAS unsigned* st;
};

__device__ __forceinline__ XcdBarrier xcd_barrier_post(unsigned* bar, volatile LAS unsigned* st) {
    XcdBarrier b; b.bar = bar; b.x = xb_xcc_id(); b.st = st;
    if (threadIdx.x == 0) (void)xb_add(&bar[XB_XCNT(b.x)], 1u);
    return b;
}
__device__ __forceinline__ void xcd_barrier_complete(unsigned* bar, unsigned x, unsigned& nloc, unsigned& nx) {
    const unsigned G = gridDim.x * gridDim.y * gridDim.z;
    unsigned sum, cnt, mine, sp = 0u;
    for (;;) {
        sum = 0u; cnt = 0u; mine = 0u;
#pragma unroll
        for (unsigned j = 0; j < 16; ++j) { const unsigned c = xb_ld(&bar[XB_XCNT(j)]); sum += c; cnt += (c > 0u) ? 1u : 0u; mine = (j == x) ? c : mine; }
        if (sum == G) break;
        __builtin_amdgcn_s_sleep(1);
        if ((++sp & 255u) == 0u) { if (xb_ld(&bar[XB_TMO])) break; if (sp > XB_SPIN_CAP) { atomicAdd(&bar[XB_TMO], 1u); break; } }
    }
    nloc = mine > 0u ? mine : 1u; nx = cnt > 0u ? cnt : 1u;
}

__device__ __forceinline__ void xcd_barrier(const XcdBarrier& b) {
    asm volatile("s_waitcnt vmcnt(0)" ::: "memory");
    __syncthreads();
    if (threadIdx.x == 0) {
        unsigned* bar = b.bar;
        __builtin_amdgcn_s_waitcnt(0);
        unsigned nloc = b.st[0], nx = b.st[1];
        if (nloc == 0u) { xcd_barrier_complete(bar, b.x, nloc, nx); b.st[0] = nloc; b.st[1] = nx; }
        const unsigned old = xb_add(&bar[XB_XSUB(b.x)], 1u);
        const unsigned gen = old / nloc;
        if (old + 1u == (gen + 1u) * nloc) {
            __builtin_amdgcn_fence(__ATOMIC_RELEASE, "agent");
            asm volatile("s_waitcnt vmcnt(0)" ::: "memory");
            const unsigned og = xb_add(&bar[XB_TOP], 1u);
            const unsigned tg = og / nx;
            if (og + 1u == (tg + 1u) * nx) xb_add(&bar[XB_TOPGEN], 1u);
            else XB_SPIN(xb_ld(&bar[XB_TOPGEN]) == tg, bar);
            __builtin_amdgcn_fence(__ATOMIC_ACQUIRE, "agent");
            xb_add(&bar[XB_XGEN(b.x)], 1u);
            asm volatile("s_waitcnt vmcnt(0)" ::: "memory");
        } else {
            XB_SPIN(xb_ld(&bar[XB_XGEN(b.x)]) == gen, bar);
            __builtin_amdgcn_fence(__ATOMIC_ACQUIRE, "agent");
            asm volatile("s_waitcnt vmcnt(0)" ::: "memory");
        }
    }
    __syncthreads();
}

DI float bf_lo(unsigned w) { return __uint_as_float(w << 16); }
DI float bf_hi(unsigned w) { return __uint_as_float(w & 0xffff0000u); }
DI float wave_sum(float v) {
#pragma unroll
    for (int o = 1; o < 64; o <<= 1) v += __shfl_xor(v, o);
    return v;
}
DI float sigmoid_f(float x) { return 1.0f / (1.0f + __expf(-x)); }

struct Args {
    const float *x, *gdn_w_in, *gdn_conv_w, *gdn_a_log, *gdn_dt_bias, *gdn_norm_w, *gdn_w_out, *sb_w_in, *sb_w_out, *ffn_w_gate, *ffn_w_up, *ffn_w_down,
                *moe_router, *moe_w_gate, *moe_w_up, *moe_w_down, *ln_g, *ln_b;
    float* out; unsigned char* ws; int ph_lo, ph_hi;
};

DI void transpose_item(const float* W, int ldw, bf16* WT, int K, int drow0, int k0, int n0, LAS float* scr, int lane) {
#pragma unroll 8
    for (int i = 0; i < 32; ++i) { const int kk = 2 * i + (lane >> 5); scr[kk * 33 + (lane & 31)] = W[(size_t)(k0 + kk) * ldw + n0 + (lane & 31)]; }
    LDS_WAIT(); asm volatile("" ::: "memory");
    const int c = lane & 7;
#pragma unroll
    for (int jj = 0; jj < 4; ++jj) { const int n = (lane >> 3) + 8 * jj; const LAS float* s = scr + (8 * c) * 33 + n;
        v4u o; o.x = pk2(s[0 * 33], s[1 * 33]); o.y = pk2(s[2 * 33], s[3 * 33]); o.z = pk2(s[4 * 33], s[5 * 33]); o.w = pk2(s[6 * 33], s[7 * 33]);
        *(v4u*)(WT + (size_t)(drow0 + n) * K + k0 + 8 * c) = o; }
    LDS_WAIT(); asm volatile("" ::: "memory");
}

DI void phase_w_gdn(const Args& a, int j, LAS unsigned char* lds, int bid, int G, int tid, int wave, int lane) {
    LAS float* scr = (LAS float*)(lds + wave * 16384);
    const int gw = bid * NWAVES + wave, NGW = G * NWAVES;
    const float* Win = a.gdn_w_in + (size_t)j * D * GIN; const float* Wout = a.gdn_w_out + (size_t)j * 2048 * D;
    const float* Wg = a.ffn_w_gate + (size_t)j * D * FF; const float* Wu = a.ffn_w_up + (size_t)j * D * FF; const float* Wd = a.ffn_w_down + (size_t)j * FF * D;
    bf16* WIN_T = (bf16*)(a.ws + W_IN); bf16* WOUT_T = (bf16*)(a.ws + W_OUT); bf16* WGU_T = (bf16*)(a.ws + W_GU); bf16* WD_T = (bf16*)(a.ws + W_D);
    constexpr int NB_IN = GIN / 32, I_IN = 16 * NB_IN, I_OUT = 32 * 32, I_G = 16 * 112, I_D = 56 * 32, NIT = I_IN + I_OUT + 2 * I_G + I_D;
    for (int it = gw; it < NIT; it += NGW) {
        int r = it;
        if (r < I_IN) { const int kb = r / NB_IN, nb = r % NB_IN; transpose_item(Win, GIN, WIN_T, D, 32 * nb, 64 * kb, 32 * nb, scr, lane); continue; } r -= I_IN;
        if (r < I_OUT) { const int kb = r / 32, nb = r % 32; transpose_item(Wout, D, WOUT_T, 2048, 32 * nb, 64 * kb, 32 * nb, scr, lane); continue; } r -= I_OUT;
        if (r < I_G) { const int kb = r / 112, nb = r % 112, n0 = 32 * nb; transpose_item(Wg, FF, WGU_T, D, 256 * (n0 >> 7) + (n0 & 127), 64 * kb, n0, scr, lane); continue; } r -= I_G;
        if (r < I_G) { const int kb = r / 112, nb = r % 112, n0 = 32 * nb; transpose_item(Wu, FF, WGU_T, D, 256 * (n0 >> 7) + 128 + (n0 & 127), 64 * kb, n0, scr, lane); continue; } r -= I_G;
        { const int kb = r / 32, nb = r % 32; transpose_item(Wd, D, WD_T, FF, 32 * nb, 64 * kb, 32 * nb, scr, lane); }
    }
    if (j == 0) {
        bf16* HB = (bf16*)(a.ws + WS_HB); const f32x4* x4 = (const f32x4*)a.x;
        for (size_t i = (size_t)bid * 512 + tid; i < (size_t)TT * D / 8; i += (size_t)G * 512) { const f32x4 p = x4[2 * i], q = x4[2 * i + 1];
            v4u o; o.x = pk2(p[0], p[1]); o.y = pk2(p[2], p[3]); o.z = pk2(q[0], q[1]); o.w = pk2(q[2], q[3]); *(v4u*)(HB + 8 * i) = o; }
    }
}
DI void phase_w_sb(const Args& a, int j, LAS unsigned char* lds, int bid, int G, int wave, int lane) {
    LAS float* scr = (LAS float*)(lds + wave * 16384);
    const int gw = bid * NWAVES + wave, NGW = G * NWAVES;
    const float* Wqkv = a.sb_w_in + (size_t)j * D * 3072; const float* Wo = a.sb_w_out + (size_t)j * D * D;
    const float* Mg = a.moe_w_gate + (size_t)j * NE * D * FF; const float* Mu = a.moe_w_up + (size_t)j * NE * D * FF; const float* Md = a.moe_w_down + (size_t)j * NE * FF * D;
    bf16* WQKV_T = (bf16*)(a.ws + W_QKV); bf16* WO_T = (bf16*)(a.ws + W_O); bf16* MGU_T = (bf16*)(a.ws + W_MGU); bf16* MD_T = (bf16*)(a.ws + W_MD);
    constexpr int I_QKV = 16 * 96, I_O = 16 * 32, I_G = 16 * 112, I_D = 56 * 32, I_E = 2 * I_G + I_D, NIT = I_QKV + I_O + NE * I_E;
    for (int it = gw; it < NIT; it += NGW) {
        int r = it;
        if (r < I_QKV) { const int kb = r / 96, nb = r % 96; transpose_item(Wqkv, 3072, WQKV_T, D, 32 * nb, 64 * kb, 32 * nb, scr, lane); continue; } r -= I_QKV;
        if (r < I_O) { const int kb = r / 32, nb = r % 32; transpose_item(Wo, D, WO_T, D, 32 * nb, 64 * kb, 32 * nb, scr, lane); continue; } r -= I_O;
        const int e = r / I_E; r -= e * I_E;
        bf16* gu = MGU_T + (size_t)e * 2 * FF * D; bf16* dn = MD_T + (size_t)e * D * FF;
        if (r < I_G) { const int kb = r / 112, nb = r % 112, n0 = 32 * nb; transpose_item(Mg + (size_t)e * D * FF, FF, gu, D, 256 * (n0 >> 7) + (n0 & 127), 64 * kb, n0, scr, lane); continue; } r -= I_G;
        if (r < I_G) { const int kb = r / 112, nb = r % 112, n0 = 32 * nb; transpose_item(Mu + (size_t)e * D * FF, FF, gu, D, 256 * (n0 >> 7) + 128 + (n0 & 127), 64 * kb, n0, scr, lane); continue; } r -= I_G;
        { const int kb = r / 32, nb = r % 32; transpose_item(Md + (size_t)e * FF * D, D, dn, FF, 32 * nb, 64 * kb, 32 * nb, scr, lane); }
    }
}

DI float dpp_sum16(float v) {
    v += __builtin_bit_cast(float, __builtin_amdgcn_update_dpp(0, __builtin_bit_cast(int, v), 0xB1, 0xF, 0xF, false));
    v += __builtin_bit_cast(float, __builtin_amdgcn_update_dpp(0, __builtin_bit_cast(int, v), 0x4E, 0xF, 0xF, false));
    v += __builtin_bit_cast(float, __builtin_amdgcn_update_dpp(0, __builtin_bit_cast(int, v), 0x141, 0xF, 0xF, false));
    v += __builtin_bit_cast(float, __builtin_amdgcn_update_dpp(0, __builtin_bit_cast(int, v), 0x140, 0xF, 0xF, false));
    return v;
}
DI void phase_conv(const Args& a, int j, int bid, int G, int tid) {
    const bf16* raw = (const bf16*)(a.ws + WS_RAW); bf16* qkvc = (bf16*)(a.ws + WS_QKVC); float* gb = (float*)(a.ws + WS_GB);
    const float* cw = a.gdn_conv_w + (size_t)j * 4 * 4096;
    const int ch = 8 * tid;
    float w0[8], w1[8], w2[8], w3[8];
#pragma unroll
    for (int i = 0; i < 8; ++i) { w0[i] = cw[ch + i]; w1[i] = cw[4096 + ch + i]; w2[i] = cw[2 * 4096 + ch + i]; w3[i] = cw[3 * 4096 + ch + i]; }
    const float post = tid < 128 ? 0.08838834764831845f : 1.0f;
    for (int run = bid; run < TT / 128; run += G) {
        const int t0 = run * 128; const bool first = (t0 & (SEQ - 1)) == 0;
        float xa[8], xb[8], xc[8];
        { v4u h0 = {0u, 0u, 0u, 0u}, h1 = h0, h2 = h0;
          if (!first) { h0 = *(const v4u*)(raw + (size_t)(t0 - 3) * RAWLD + ch); h1 = *(const v4u*)(raw + (size_t)(t0 - 2) * RAWLD + ch); h2 = *(const v4u*)(raw + (size_t)(t0 - 1) * RAWLD + ch); }
          xa[0] = bf_lo(h0.x); xa[1] = bf_hi(h0.x); xa[2] = bf_lo(h0.y); xa[3] = bf_hi(h0.y); xa[4] = bf_lo(h0.z); xa[5] = bf_hi(h0.z); xa[6] = bf_lo(h0.w); xa[7] = bf_hi(h0.w);
          xb[0] = bf_lo(h1.x); xb[1] = bf_hi(h1.x); xb[2] = bf_lo(h1.y); xb[3] = bf_hi(h1.y); xb[4] = bf_lo(h1.z); xb[5] = bf_hi(h1.z); xb[6] = bf_lo(h1.w); xb[7] = bf_hi(h1.w);
          xc[0] = bf_lo(h2.x); xc[1] = bf_hi(h2.x); xc[2] = bf_lo(h2.y); xc[3] = bf_hi(h2.y); xc[4] = bf_lo(h2.z); xc[5] = bf_hi(h2.z); xc[6] = bf_lo(h2.w); xc[7] = bf_hi(h2.w); }
#pragma unroll 1
        for (int tb = 0; tb < 128; tb += 8) {
            v4u xr[8];
#pragma unroll
            for (int u = 0; u < 8; ++u) xr[u] = *(const v4u*)(raw + (size_t)(t0 + tb + u) * RAWLD + ch);
#pragma unroll
            for (int u = 0; u < 8; ++u) {
                float xd[8]; xd[0] = bf_lo(xr[u].x); xd[1] = bf_hi(xr[u].x); xd[2] = bf_lo(xr[u].y); xd[3] = bf_hi(xr[u].y); xd[4] = bf_lo(xr[u].z); xd[5] = bf_hi(xr[u].z); xd[6] = bf_lo(xr[u].w); xd[7] = bf_hi(xr[u].w);
                float y[8]; float ss = 0.f;
#pragma unroll
                for (int i = 0; i < 8; ++i) { const float c = w0[i] * xa[i] + w1[i] * xb[i] + w2[i] * xc[i] + w3[i] * xd[i];
                    y[i] = c * __builtin_amdgcn_rcpf(1.0f + __builtin_amdgcn_exp2f(-1.4426950408889634f * c)); ss += y[i] * y[i];
                    xa[i] = xb[i]; xb[i] = xc[i]; xc[i] = xd[i]; }
                if (tid < 256) {
                    const float rn = post / sqrtf(dpp_sum16(ss) + RMS_EPS);
#pragma unroll
                    for (int i = 0; i < 8; ++i) y[i] *= rn;
                }
                v4u o; o.x = pk2(y[0], y[1]); o.y = pk2(y[2], y[3]); o.z = pk2(y[4], y[5]); o.w = pk2(y[6], y[7]);
                *(v4u*)(qkvc + (size_t)(t0 + tb + u) * 4096 + ch) = o;
            }
        }
#pragma unroll
        for (int k = 0; k < 4; ++k) { const int item = tid + 512 * k, tok = t0 + (item >> 4), hv = item & 15;
            const float bb = __uint_as_float((unsigned)raw[(size_t)tok * RAWLD + 4096 + hv] << 16), aa = __uint_as_float((unsigned)raw[(size_t)tok * RAWLD + 4112 + hv] << 16);
            const float xx = aa + a.gdn_dt_bias[j * 16 + hv];
            const float sp = xx > 20.f ? xx : log1pf(__expf(xx));
            gb[(size_t)tok * 32 + hv] = -__expf(a.gdn_a_log[j * 16 + hv]) * sp;
            gb[(size_t)tok * 32 + 16 + hv] = sigmoid_f(bb); }
    }
}

DI void phase_gdn_naive(const Args& a, int j, LAS unsigned char* lds, int bid, int tid) {
    if (bid >= BATCH * HV) return;
    const int b = bid / HV, hv = bid % HV, hk = hv / 2, jc = tid & 127, r = tid >> 7;
    const bf16* zb = (const bf16*)(a.ws + WS_ZB); bf16* qkvc = (bf16*)(a.ws + WS_QKVC); const float* gb = (const float*)(a.ws + WS_GB);
    LAS float* qs = (LAS float*)lds; LAS float* ks = qs + 2048; LAS float* vs = ks + 2048; LAS float* gs = vs + 2048; LAS float* bs = gs + 16;
    LAS f32x2* red = (LAS f32x2*)(lds + 32768); LAS float* redkq = (LAS float*)(lds + 32768 + 8192); LAS float* ob = (LAS float*)(lds + 49152);
    float S[32];
#pragma unroll
    for (int i = 0; i < 32; ++i) S[i] = 0.f;
    const int lrow = tid >> 5, lcol = (tid & 31) * 4;
    for (int blk = 0; blk < SEQ / 16; ++blk) {
        const size_t t0 = (size_t)b * SEQ + blk * 16;
        __syncthreads();
        { const bf16* rowp = qkvc + (t0 + lrow) * 4096;
          const v2u qv = *(const v2u*)(rowp + hk * 128 + lcol), kv = *(const v2u*)(rowp + 1024 + hk * 128 + lcol), vv = *(const v2u*)(rowp + 2048 + hv * 128 + lcol);
          *(LAS f32x4*)(qs + lrow * 128 + lcol) = (f32x4){bf_lo(qv.x), bf_hi(qv.x), bf_lo(qv.y), bf_hi(qv.y)};
          *(LAS f32x4*)(ks + lrow * 128 + lcol) = (f32x4){bf_lo(kv.x), bf_hi(kv.x), bf_lo(kv.y), bf_hi(kv.y)};
          *(LAS f32x4*)(vs + lrow * 128 + lcol) = (f32x4){bf_lo(vv.x), bf_hi(vv.x), bf_lo(vv.y), bf_hi(vv.y)};
          if (tid < 16) { gs[tid] = __expf(gb[(t0 + tid) * 32 + hv]); bs[tid] = gb[(t0 + tid) * 32 + 16 + hv]; } }
        __syncthreads();
#pragma unroll 1
        for (int tt = 0; tt < 16; ++tt) {
            float pk = 0.f, pq = 0.f, pkq = 0.f;
#pragma unroll
            for (int i4 = 0; i4 < 8; ++i4) { const f32x4 k4 = *(const LAS f32x4*)(ks + tt * 128 + 32 * r + 4 * i4), q4 = *(const LAS f32x4*)(qs + tt * 128 + 32 * r + 4 * i4);
#pragma unroll
                for (int c = 0; c < 4; ++c) { pk += k4[c] * S[4 * i4 + c]; pq += q4[c] * S[4 * i4 + c]; pkq += k4[c] * q4[c]; } }
            const int buf = tt & 1;
            red[(buf * 4 + r) * 128 + jc] = (f32x2){pk, pq}; if (jc == 0) redkq[buf * 4 + r] = pkq;
            __syncthreads();
            float kS = 0.f, qS = 0.f, kq = 0.f;
#pragma unroll
            for (int rr = 0; rr < 4; ++rr) { const f32x2 p = red[(buf * 4 + rr) * 128 + jc]; kS += p.x; qS += p.y; kq += redkq[buf * 4 + rr]; }
            const float eg = gs[tt], vn = bs[tt] * (vs[tt * 128 + jc] - eg * kS);
#pragma unroll
            for (int i4 = 0; i4 < 8; ++i4) { const f32x4 k4 = *(const LAS f32x4*)(ks + tt * 128 + 32 * r + 4 * i4);
#pragma unroll
                for (int c = 0; c < 4; ++c) S[4 * i4 + c] = eg * S[4 * i4 + c] + k4[c] * vn; }
            if (r == 0) ob[tt * 128 + jc] = eg * qS + kq * vn;
        }
        __syncthreads();
        {
            const f32x4 o4 = *(const LAS f32x4*)(ob + lrow * 128 + lcol);
            float ss = o4[0] * o4[0] + o4[1] * o4[1] + o4[2] * o4[2] + o4[3] * o4[3];
            ss += __shfl_xor(ss, 1); ss += __shfl_xor(ss, 2); ss += __shfl_xor(ss, 4); ss += __shfl_xor(ss, 8); ss += __shfl_xor(ss, 16);
            const float rinv = 1.0f / sqrtf(ss * (1.0f / 128.0f) + RMS_EPS);
            const v2u zv = *(const v2u*)(zb + (t0 + lrow) * 2048 + hv * 128 + lcol);
            const f32x4 nw = *(const f32x4*)(a.gdn_norm_w + j * 128 + lcol);
            const float z0 = bf_lo(zv.x), z1 = bf_hi(zv.x), z2 = bf_lo(zv.y), z3 = bf_hi(zv.y);
            v2u o; o.x = pk2(o4[0] * rinv * nw[0] * z0 * sigmoid_f(z0), o4[1] * rinv * nw[1] * z1 * sigmoid_f(z1));
            o.y = pk2(o4[2] * rinv * nw[2] * z2 * sigmoid_f(z2), o4[3] * rinv * nw[3] * z3 * sigmoid_f(z3));
            *(v2u*)(qkvc + (t0 + lrow) * 4096 + 2048 + hv * 128 + lcol) = o;
        }
    }
}

template <bool ROUTER>
DI void phase_ln(const Args& a, int lnidx, int j, LAS unsigned char* lds, int bid, int G, int tid, int wave, int lane) {
    const float* out = a.out; bf16* HB = (bf16*)(a.ws + WS_HB); float* stats = (float*)(a.ws + WS_STATS);
    const float* g = a.ln_g + (size_t)lnidx * D; const float* bta = a.ln_b + (size_t)lnidx * D;
    const int gw = bid * NWAVES + wave, NGW = G * NWAVES;
    LAS unsigned* lcnt = (LAS unsigned*)lds;
    if (ROUTER) { if (tid < 8) lcnt[tid] = 0u; __syncthreads(); }
    f32x4 gv[4], bv[4];
#pragma unroll
    for (int q = 0; q < 4; ++q) { gv[q] = *(const f32x4*)(g + 4 * (lane + 64 * q)); bv[q] = *(const f32x4*)(bta + 4 * (lane + 64 * q)); }
    f32x4 nx[4];
    if (gw < TT) {
#pragma unroll
        for (int q = 0; q < 4; ++q) nx[q] = ((const f32x4*)(out + (size_t)gw * D))[lane + 64 * q]; }
    for (int t = gw; t < TT; t += NGW) {
        f32x4 v[4]; float s = 0.f;
#pragma unroll
        for (int q = 0; q < 4; ++q) { v[q] = nx[q]; s += (v[q][0] + v[q][1]) + (v[q][2] + v[q][3]); }
        if (t + NGW < TT) {
#pragma unroll
            for (int q = 0; q < 4; ++q) nx[q] = ((const f32x4*)(out + (size_t)(t + NGW) * D))[lane + 64 * q]; }
        const float mean = wave_sum(s) * (1.0f / D); float s2 = 0.f;
#pragma unroll
        for (int q = 0; q < 4; ++q) { v[q] = v[q] - mean; s2 += (v[q][0] * v[q][0] + v[q][1] * v[q][1]) + (v[q][2] * v[q][2] + v[q][3] * v[q][3]); }
        const float rstd = 1.0f / sqrtf(wave_sum(s2) * (1.0f / D) + LN_EPS);
        if (lane == 0) *(f32x2*)(stats + 2 * (size_t)t) = (f32x2){mean, rstd};
#pragma unroll
        for (int q = 0; q < 4; ++q) { v[q] = v[q] * rstd * gv[q] + bv[q];
            v2u o; o.x = pk2(v[q][0], v[q][1]); o.y = pk2(v[q][2], v[q][3]); *(v2u*)(HB + (size_t)t * D + 4 * (lane + 64 * q)) = o; }
        if (ROUTER) {
            const float* R = a.moe_router + (size_t)j * D * NE;
            float lg[8];
#pragma unroll
            for (int e = 0; e < 8; ++e) lg[e] = 0.f;
#pragma unroll
            for (int q = 0; q < 4; ++q)
#pragma unroll
                for (int c = 0; c < 4; ++c) { const int k = 4 * (lane + 64 * q) + c; const f32x4 r0 = *(const f32x4*)(R + k * 8), r1 = *(const f32x4*)(R + k * 8 + 4); const float hv = v[q][c];
                    lg[0] += hv * r0[0]; lg[1] += hv * r0[1]; lg[2] += hv * r0[2]; lg[3] += hv * r0[3]; lg[4] += hv * r1[0]; lg[5] += hv * r1[1]; lg[6] += hv * r1[2]; lg[7] += hv * r1[3]; }
#pragma unroll
            for (int e = 0; e < 8; ++e) lg[e] = wave_sum(lg[e]);
            int i1 = 0; float v1 = lg[0];
#pragma unroll
            for (int e = 1; e < 8; ++e) if (lg[e] > v1) { v1 = lg[e]; i1 = e; }
            int i2 = -1; float v2 = -3.0e38f;
#pragma unroll
            for (int e = 0; e < 8; ++e) if (e != i1 && lg[e] > v2) { v2 = lg[e]; i2 = e; }
            if (lane == 0) {
                const float g1 = 1.0f / (1.0f + __expf(v2 - v1));
                ((unsigned*)(a.ws + WS_E12))[t] = (unsigned)i1 | ((unsigned)i2 << 8);
                ((f32x2*)(a.ws + WS_G12))[t] = (f32x2){g1, 1.0f - g1};
                __hip_atomic_fetch_add(lcnt + i1, 1u, __ATOMIC_RELAXED, __HIP_MEMORY_SCOPE_WORKGROUP); __hip_atomic_fetch_add(lcnt + i2, 1u, __ATOMIC_RELAXED, __HIP_MEMORY_SCOPE_WORKGROUP);
            }
        }
    }
    if (ROUTER) { __syncthreads(); if (tid < 8) { unsigned* cnt = (unsigned*)(a.ws + WS_CTL) + CW_CNT + 256 * j; __hip_atomic_fetch_add(cnt + tid, lcnt[tid], __ATOMIC_RELAXED, __HIP_MEMORY_SCOPE_AGENT); } }
}

DI void phase_sb_naive(const Args& a, LAS unsigned char* lds, int bid, int G, int tid) {
    const bf16* qkv = (const bf16*)(a.ws + WS_QKV); bf16* ao = (bf16*)(a.ws + WS_AO);
    LAS unsigned char* Ks = lds; LAS unsigned char* Vs = lds + 16384;
    const int qi = tid >> 2, r = tid & 3;
    for (int idx = bid; idx < 64 * 32; idx += G) {
        const int qb = 31 - idx / 64, bh = idx % 64, b = bh >> 3, h = bh & 7;
        const int t = qb * 128 + qi;
        const size_t rowq = (size_t)b * SEQ + t;
        float q[32], o[32];
        { const bf16* qp = qkv + rowq * 3072 + h * 128 + 32 * r;
#pragma unroll
          for (int c = 0; c < 4; ++c) { const v4u w = *(const v4u*)(qp + 8 * c);
              q[8 * c + 0] = bf_lo(w.x); q[8 * c + 1] = bf_hi(w.x); q[8 * c + 2] = bf_lo(w.y); q[8 * c + 3] = bf_hi(w.y);
              q[8 * c + 4] = bf_lo(w.z); q[8 * c + 5] = bf_hi(w.z); q[8 * c + 6] = bf_lo(w.w); q[8 * c + 7] = bf_hi(w.w); }
#pragma unroll
          for (int i = 0; i < 32; ++i) { q[i] *= 0.08838834764831845f; o[i] = 0.f; } }
        float P = 1.0f;
        for (int kt = 2 * qb + 1; kt >= 0; --kt) {
            __syncthreads();
#pragma unroll
            for (int i = 0; i < 2; ++i) { const int c = tid + 512 * i, row = c >> 4, part = c & 15;
                const bf16* src = qkv + ((size_t)b * SEQ + kt * 64 + row) * 3072 + h * 128 + part * 8;
                *(LAS v4u*)(Ks + c * 16) = *(const v4u*)(src + 1024); *(LAS v4u*)(Vs + c * 16) = *(const v4u*)(src + 2048); }
            __syncthreads();
#pragma unroll 1
            for (int s = 63; s >= 0; --s) {
                float z = 0.f;
#pragma unroll
                for (int c = 0; c < 4; ++c) { const v4u w = *(const LAS v4u*)(Ks + s * 256 + r * 64 + c * 16);
                    z += q[8 * c + 0] * bf_lo(w.x) + q[8 * c + 1] * bf_hi(w.x) + q[8 * c + 2] * bf_lo(w.y) + q[8 * c + 3] * bf_hi(w.y)
                       + q[8 * c + 4] * bf_lo(w.z) + q[8 * c + 5] * bf_hi(w.z) + q[8 * c + 6] * bf_lo(w.w) + q[8 * c + 7] * bf_hi(w.w); }
                z += __shfl_xor(z, 1); z += __shfl_xor(z, 2);
                const bool live = (kt * 64 + s) < t;
                const float e = __expf(fminf(z, 80.f)), rr = 1.0f / (1.0f + e);
                const float A = live ? e * rr * P : 0.f;
                P = live ? P * rr : P;
#pragma unroll
                for (int c = 0; c < 4; ++c) { const v4u w = *(const LAS v4u*)(Vs + s * 256 + r * 64 + c * 16);
                    o[8 * c + 0] += A * bf_lo(w.x); o[8 * c + 1] += A * bf_hi(w.x); o[8 * c + 2] += A * bf_lo(w.y); o[8 * c + 3] += A * bf_hi(w.y);
                    o[8 * c + 4] += A * bf_lo(w.z); o[8 * c + 5] += A * bf_hi(w.z); o[8 * c + 6] += A * bf_lo(w.w); o[8 * c + 7] += A * bf_hi(w.w); }
            }
        }
        { bf16* op = ao + rowq * 1024 + h * 128 + 32 * r;
#pragma unroll
          for (int c = 0; c < 4; ++c) { v4u w; w.x = pk2(o[8 * c + 0], o[8 * c + 1]); w.y = pk2(o[8 * c + 2], o[8 * c + 3]); w.z = pk2(o[8 * c + 4], o[8 * c + 5]); w.w = pk2(o[8 * c + 6], o[8 * c + 7]);
              *(v4u*)(op + 8 * c) = w; } }
    }
}


namespace sba {
using bf16x8 = __attribute__((ext_vector_type(8))) short;
using s16x4  = __attribute__((ext_vector_type(4))) short;
using f32x16 = __attribute__((ext_vector_type(16))) float;
constexpr int SHM_V = 16384, SHM_K = 16384, LDQ = 3072;
#define KSWZ(row, colB) ((row) * 256 + ((colB) ^ (((row) & 7) << 4)))
#define SBAR() __builtin_amdgcn_sched_barrier(0)
DI int crow(int r, int hi) { return (r & 3) + 8 * (r >> 2) + 4 * hi; }
DI int v_st(int k, int c) { const int kk = (k & ~0xC) | ((k & 4) << 1) | ((k & 8) >> 1); return ((kk >> 3) * 4 + (c >> 5)) * 512 + ((kk & 7) * 32 + (c & 31)) * 2; }
DI int v_rd_base(int lane) { return ((lane & 3) << 3) | (((lane >> 2) & 3) << 6) | (((lane >> 4) & 1) << 5) | (((lane >> 5) & 1) << 8); }
constexpr int v_rd_off(int d0, int ks, int half) { return d0 * 512 + ks * 4096 + half * 2048; }
template <int OFF> DI s16x4 tr_read(int vb) { s16x4 r; asm volatile("ds_read_b64_tr_b16 %0, %1 offset:%2" : "=&v"(r) : "v"(vb), "i"(OFF) : "memory"); return r; }
template <int D0> DI void pv_one(f32x16& od, int vb, bf16x8 pa0, bf16x8 pa1, bf16x8 pa2, bf16x8 pa3) {
  const s16x4 l0 = tr_read<v_rd_off(D0, 0, 0)>(vb), h0 = tr_read<v_rd_off(D0, 0, 1)>(vb), l1 = tr_read<v_rd_off(D0, 1, 0)>(vb), h1 = tr_read<v_rd_off(D0, 1, 1)>(vb);
  const s16x4 l2 = tr_read<v_rd_off(D0, 2, 0)>(vb), h2 = tr_read<v_rd_off(D0, 2, 1)>(vb), l3 = tr_read<v_rd_off(D0, 3, 0)>(vb), h3 = tr_read<v_rd_off(D0, 3, 1)>(vb);
  asm volatile("s_waitcnt lgkmcnt(0)" ::: "memory"); SBAR();
#define PK(L, H) (bf16x8){L[0], L[1], L[2], L[3], H[0], H[1], H[2], H[3]}
  od = __builtin_amdgcn_mfma_f32_32x32x16_bf16(pa0, PK(l0, h0), od, 0, 0, 0);
  od = __builtin_amdgcn_mfma_f32_32x32x16_bf16(pa1, PK(l1, h1), od, 0, 0, 0);
  od = __builtin_amdgcn_mfma_f32_32x32x16_bf16(pa2, PK(l2, h2), od, 0, 0, 0);
  od = __builtin_amdgcn_mfma_f32_32x32x16_bf16(pa3, PK(l3, h3), od, 0, 0, 0);
#undef PK
}
DI void qkt(f32x16& p0, f32x16& p1, const LAS unsigned char* Ks, const bf16x8 (&qr)[8], int r32, int hi) {
  p0 = f32x16{}; p1 = f32x16{};
#pragma unroll
  for (int d0 = 0; d0 < 8; ++d0) { const int cb = (d0 * 16 + hi * 8) * 2;
    const bf16x8 b0 = *(const LAS bf16x8*)(Ks + KSWZ(r32, cb));
    const bf16x8 b1 = *(const LAS bf16x8*)(Ks + KSWZ(32 + r32, cb));
    p0 = __builtin_amdgcn_mfma_f32_32x32x16_bf16(b0, qr[d0], p0, 0, 0, 0);
    p1 = __builtin_amdgcn_mfma_f32_32x32x16_bf16(b1, qr[d0], p1, 0, 0, 0); }
}
template <bool MASK> DI void sb_half(f32x16& p, float& Pc, int hi, int kbase, int trow) {
  constexpr float C = 0.08838834764831845f * 1.4426950408889634f;
  float rr[16];
#pragma unroll
  for (int r = 0; r < 16; ++r) {
    float z = p[r] * C;
    if (MASK) z = (kbase + crow(r, hi) < trow) ? z : -__builtin_inff();
    const float k = __builtin_amdgcn_rcpf(1.0f + __builtin_amdgcn_exp2f(z));
    rr[r] = k; p[r] = 1.0f - k;
  }
  float R0[4], R1[4];
#pragma unroll
  for (int g = 0; g < 4; ++g) {
    const float c2 = rr[4 * g + 3], c1 = c2 * rr[4 * g + 2], c0 = c1 * rr[4 * g + 1], R = c0 * rr[4 * g];
    rr[4 * g + 2] = c2; rr[4 * g + 1] = c1; rr[4 * g] = c0;
    const auto sw = __builtin_amdgcn_permlane32_swap(__float_as_uint(R), __float_as_uint(R), false, false);
    R0[g] = __uint_as_float(sw[0]); R1[g] = __uint_as_float(sw[1]);
  }
#pragma unroll
  for (int g = 3; g >= 0; --g) {
    const float Pin = hi ? Pc : Pc * R1[g];
    p[4 * g + 3] *= Pin; p[4 * g + 2] *= Pin * rr[4 * g + 2]; p[4 * g + 1] *= Pin * rr[4 * g + 1]; p[4 * g] *= Pin * rr[4 * g];
    Pc *= R0[g] * R1[g];
  }
}
DI unsigned cvtpk(float lo, float hi) { unsigned r; asm volatile("v_cvt_pk_bf16_f32 %0, %1, %2" : "=v"(r) : "v"(lo), "v"(hi)); return r; }
#define PK4(P, BASE, OUT) do { const unsigned a0 = cvtpk(P[BASE + 0], P[BASE + 1]), a1 = cvtpk(P[BASE + 2], P[BASE + 3]);   \
    const unsigned b0 = cvtpk(P[BASE + 4], P[BASE + 5]), b1 = cvtpk(P[BASE + 6], P[BASE + 7]);                              \
    const auto r0 = __builtin_amdgcn_permlane32_swap(a0, b0, false, false); const auto r1 = __builtin_amdgcn_permlane32_swap(a1, b1, false, false); \
    const v4u w = {r0[0], r1[0], r0[1], r1[1]}; OUT = __builtin_bit_cast(bf16x8, w); } while (0)

DI void unit(const bf16* qkv, bf16* ao, int b, int h, int qb, LAS unsigned char* lds, int tid) {
  const int wid = __builtin_amdgcn_readfirstlane(tid >> 6), lane = tid & 63, r32 = lane & 31, hi = lane >> 5;
  LAS unsigned char* V_lds = lds; LAS unsigned char* K_lds = lds + 2 * SHM_V;
  const size_t rowbase = (size_t)b * SEQ; const int q0 = qb * 256, t_lo = q0 + wid * 32, trow = t_lo + r32;
  bf16x8 qr[8];
  { const bf16* Qw = qkv + (rowbase + trow) * LDQ + h * 128 + hi * 8;
#pragma unroll
    for (int d0 = 0; d0 < 8; ++d0) qr[d0] = *(const bf16x8*)(Qw + d0 * 16); }
  const bf16* Kh = qkv + rowbase * LDQ + 1024 + h * 128; const bf16* Vh = Kh + 1024;
  const int sr = tid >> 4, sc = (tid & 15) * 8, vst0 = v_st(sr, sc), vst1 = v_st(32 + sr, sc);
  const int vb0 = (int)(unsigned)(size_t)V_lds + v_rd_base(lane);
  bf16x8 vs0, vs1, ks0, ks1;
#define SLOAD(k0) do { vs0 = *(const bf16x8*)(Vh + (size_t)((k0) + sr) * LDQ + sc); vs1 = *(const bf16x8*)(Vh + (size_t)((k0) + 32 + sr) * LDQ + sc); \
    ks0 = *(const bf16x8*)(Kh + (size_t)((k0) + sr) * LDQ + sc); ks1 = *(const bf16x8*)(Kh + (size_t)((k0) + 32 + sr) * LDQ + sc); } while (0)
#define SWRITE(bb) do { *(LAS bf16x8*)(V_lds + (bb) * SHM_V + vst0) = vs0; *(LAS bf16x8*)(V_lds + (bb) * SHM_V + vst1) = vs1; const int kc = sc * 2; \
    *(LAS bf16x8*)(K_lds + (bb) * SHM_K + KSWZ(sr, kc)) = ks0; *(LAS bf16x8*)(K_lds + (bb) * SHM_K + KSWZ(32 + sr, kc)) = ks1; } while (0)
  f32x16 o[4] = {}; float Pc = 1.0f;
  const int kt_max = qb * 4 + 3;
  SLOAD(kt_max * 64);
  for (int kt = kt_max; kt >= 0; --kt) {
    const int buf = kt & 1, k0 = kt * 64;
    asm volatile("s_waitcnt vmcnt(0)" ::: "memory");
    SWRITE(buf);
    if (kt > 0) SLOAD(k0 - 64);
    __syncthreads();
    if (k0 < t_lo + 31) {
      f32x16 p0, p1;
      qkt(p0, p1, K_lds + buf * SHM_K, qr, r32, hi);
      if (k0 + 63 >= t_lo) { sb_half<true>(p1, Pc, hi, k0 + 32, trow); sb_half<true>(p0, Pc, hi, k0, trow); }
      else { sb_half<false>(p1, Pc, hi, k0 + 32, trow); sb_half<false>(p0, Pc, hi, k0, trow); }
      bf16x8 pa0, pa1, pa2, pa3;
      PK4(p0, 0, pa0); PK4(p0, 8, pa1); PK4(p1, 0, pa2); PK4(p1, 8, pa3);
      const int vb = vb0 + buf * SHM_V;
      pv_one<0>(o[0], vb, pa0, pa1, pa2, pa3); pv_one<1>(o[1], vb, pa0, pa1, pa2, pa3); pv_one<2>(o[2], vb, pa0, pa1, pa2, pa3); pv_one<3>(o[3], vb, pa0, pa1, pa2, pa3);
    }
  }
  bf16* Ow = ao + (rowbase + t_lo) * 1024 + h * 128 + r32;
#pragma unroll
  for (int r = 0; r < 16; ++r) { const int orow = crow(r, hi);
#pragma unroll
    for (int d0 = 0; d0 < 4; ++d0) Ow[(size_t)orow * 1024 + d0 * 32] = (bf16)(cvtpk(o[d0][r], 0.f) & 0xffffu); }
#undef SLOAD
#undef SWRITE
}
#undef PK4
#undef KSWZ
#undef SBAR
}
DI void phase_sb_mfma(const Args& a, LAS unsigned char* lds, int bid, int G, int tid) {
    const bf16* qkv = (const bf16*)(a.ws + WS_QKV); bf16* ao = (bf16*)(a.ws + WS_AO);
    const int vcu = (G % 8 == 0) ? (bid % 8) * (G / 8) + bid / 8 : bid;
    for (int pi = vcu; pi < 512; pi += G) {
        const int bh = pi >> 3, p = pi & 7, b = bh >> 3, h = bh & 7;
        sba::unit(qkv, ao, b, h, 15 - p, lds, tid);
        sba::unit(qkv, ao, b, h, p, lds, tid);
    }
}


namespace gdn {
using bf16x8 = __attribute__((ext_vector_type(8))) short;
using s16x4  = __attribute__((ext_vector_type(4))) short;
using f32x16 = __attribute__((ext_vector_type(16))) float;
typedef float f2v __attribute__((ext_vector_type(2)));
typedef __bf16 b2v __attribute__((ext_vector_type(2)));
DI unsigned pk(float a, float b) { const f2v v = {a, b}; const b2v r = __builtin_convertvector(v, b2v); return __builtin_bit_cast(unsigned, r); }
DI int crow(int r, int hi) { return (r & 3) + 8 * (r >> 2) + 4 * hi; }
DI int pi_slot(int x) { return 8 * ((x >> 2) & 3) + 4 * ((x >> 4) & 1) + (x & 3); }
DI bf16x8 pack_step(const f32x16& x, int s) {
    v4u w; w.x = pk(x[8 * s + 0], x[8 * s + 1]); w.y = pk(x[8 * s + 2], x[8 * s + 3]); w.z = pk(x[8 * s + 4], x[8 * s + 5]); w.w = pk(x[8 * s + 6], x[8 * s + 7]);
    return __builtin_bit_cast(bf16x8, w);
}
DI f32x16 mm(const f32x16& P, const f32x16& Q, f32x16 acc) {
    acc = __builtin_amdgcn_mfma_f32_32x32x16_bf16(pack_step(P, 0), pack_step(Q, 0), acc, 0, 0, 0);
    acc = __builtin_amdgcn_mfma_f32_32x32x16_bf16(pack_step(P, 1), pack_step(Q, 1), acc, 0, 0, 0);
    return acc;
}
#define GPK4(P, BASE, OUT) do { const unsigned a0 = pk(P[BASE + 0], P[BASE + 1]), a1 = pk(P[BASE + 2], P[BASE + 3]);   \
    const unsigned b0 = pk(P[BASE + 4], P[BASE + 5]), b1 = pk(P[BASE + 6], P[BASE + 7]);                              \
    const auto r0 = __builtin_amdgcn_permlane32_swap(a0, b0, false, false); const auto r1 = __builtin_amdgcn_permlane32_swap(a1, b1, false, false); \
    const v4u w_ = {r0[0], r1[0], r0[1], r1[1]}; OUT = __builtin_bit_cast(bf16x8, w_); } while (0)

DI void local_unit(const Args& a, int unit, LAS unsigned char* img, LAS float* tab, int lane, bool dry) {
    const int r32 = lane & 31, hi = lane >> 5;
    const int chunk = unit & 63, bh = unit >> 6, hv = bh & 15, b = bh >> 4, hk = hv >> 1;
    const size_t t0 = (size_t)b * SEQ + chunk * 64;
    bf16* qkvc = (bf16*)(a.ws + WS_QKVC); const float* gb = (const float*)(a.ws + WS_GB);
    bf16* wmem = (bf16*)(a.ws + WS_WMEM) + (size_t)unit * 8192; bf16* imem = (bf16*)(a.ws + WS_IMEM) + (size_t)unit * 4096;
    bf16* ktmem = (bf16*)(a.ws + WS_KTMEM) + (size_t)((b * HK + hk) * 64 + chunk) * 8192; float* gtab = (float*)(a.ws + WS_GTAB) + (size_t)unit * 192;
    float gc = gb[(t0 + lane) * 32 + hv]; const float be = gb[(t0 + lane) * 32 + 16 + hv];
#pragma unroll
    for (int off = 1; off < 64; off <<= 1) { const float y = __shfl_up(gc, off); if (lane >= off) gc += y; }
    const float glast = __shfl(gc, 63);
    tab[lane] = gc; tab[64 + lane] = be; tab[128 + lane] = -be * __expf(gc);
    gtab[lane] = __expf(gc); gtab[64 + lane] = __expf(glast - gc); if (lane == 0) gtab[128] = __expf(glast);
    const bf16* kbase = qkvc + t0 * 4096 + 1024 + hk * 128; const bf16* qbase = qkvc + t0 * 4096 + hk * 128; bf16* vbase = qkvc + t0 * 4096 + 2048 + hv * 128;
    if ((hv & 1) == 0) {
        const int slot = 32 * (lane >> 5) + pi_slot(lane & 31);
#pragma unroll 4
        for (int c8 = 0; c8 < 16; ++c8) { const v4u kv = *(const v4u*)(kbase + (size_t)lane * 4096 + 8 * c8);
            bf16* dst = ktmem + (size_t)(8 * c8) * 64 + slot;
            dst[0 * 64] = (bf16)(kv.x & 0xffffu); dst[1 * 64] = (bf16)(kv.x >> 16); dst[2 * 64] = (bf16)(kv.y & 0xffffu); dst[3 * 64] = (bf16)(kv.y >> 16);
            dst[4 * 64] = (bf16)(kv.z & 0xffffu); dst[5 * 64] = (bf16)(kv.z >> 16); dst[6 * 64] = (bf16)(kv.w & 0xffffu); dst[7 * 64] = (bf16)(kv.w >> 16); }
    }
#define GSB() __builtin_amdgcn_sched_barrier(0)
    {
        f32x16 IT00 = {}, IT11 = {}, IT01 = {};
#pragma unroll
        for (int s = 0; s < 8; ++s) {
            const bf16x8 k0 = *(const bf16x8*)(kbase + (size_t)r32 * 4096 + 16 * s + 8 * hi), k1 = *(const bf16x8*)(kbase + (size_t)(32 + r32) * 4096 + 16 * s + 8 * hi);
            const bf16x8 q0 = *(const bf16x8*)(qbase + (size_t)r32 * 4096 + 16 * s + 8 * hi), q1 = *(const bf16x8*)(qbase + (size_t)(32 + r32) * 4096 + 16 * s + 8 * hi);
            IT00 = __builtin_amdgcn_mfma_f32_32x32x16_bf16(k0, q0, IT00, 0, 0, 0); IT11 = __builtin_amdgcn_mfma_f32_32x32x16_bf16(k1, q1, IT11, 0, 0, 0);
            IT01 = __builtin_amdgcn_mfma_f32_32x32x16_bf16(k0, q1, IT01, 0, 0, 0);
        }
#pragma unroll
        for (int I = 0; I < 2; ++I) { const int c = 32 * I + r32; const float gcc = tab[c];
#pragma unroll
            for (int J = 0; J < 2; ++J)
#pragma unroll
                for (int g = 0; g < 4; ++g) { float v[4];
#pragma unroll
                    for (int i = 0; i < 4; ++i) { const int r = 4 * g + i, cp = 32 * J + crow(r, hi);
                        const float raw = (I == 0) ? (J == 0 ? IT00[r] : 0.f) : (J == 0 ? IT01[r] : IT11[r]);
                        const float val = raw * __expf(-fabsf(gcc - tab[cp])); v[i] = (c >= cp) ? val : 0.f; }
                    v2u o; o.x = pk(v[0], v[1]); o.y = pk(v[2], v[3]);
                    *(v2u*)(imem + (size_t)c * 64 + 32 * J + 16 * (g & 1) + 8 * hi + 4 * (g >> 1)) = o; } }
    }
    GSB();
    f32x16 T1, T1T, T2T, T21T;
    {
        f32x16 KK = {};
#pragma unroll
        for (int s = 0; s < 8; ++s) { const bf16x8 k0 = *(const bf16x8*)(kbase + (size_t)r32 * 4096 + 16 * s + 8 * hi); KK = __builtin_amdgcn_mfma_f32_32x32x16_bf16(k0, k0, KK, 0, 0, 0); }
        f32x16 M, MT;
        { const float gb0 = tab[r32], bb0 = tab[64 + r32];
#pragma unroll
        for (int r = 0; r < 16; ++r) { const int a0 = crow(r, hi), b0 = r32; const float ke = -KK[r] * __expf(-fabsf(tab[a0] - gb0));
            const float nv = ke * tab[64 + a0], ntv = ke * bb0;
            const float n = (a0 > b0) ? nv : 0.f, nt = (b0 > a0) ? ntv : 0.f, id = (a0 == b0) ? 1.f : 0.f;
            M[r] = n; MT[r] = nt; T1[r] = id + n; T1T[r] = id + nt; } }
#pragma unroll
        for (int it = 0; it < 4; ++it) { const f32x16 z = {};
            const f32x16 Mn = mm(MT, M, z), MTn = mm(M, MT, z);
            const f32x16 Tn = mm(T1T, Mn, T1);
            T1T = mm(Mn, T1T, T1T);
            T1 = Tn; M = Mn; MT = MTn; }
    }
    GSB();
    {
        f32x16 KK = {};
#pragma unroll
        for (int s = 0; s < 8; ++s) { const bf16x8 k1 = *(const bf16x8*)(kbase + (size_t)(32 + r32) * 4096 + 16 * s + 8 * hi); KK = __builtin_amdgcn_mfma_f32_32x32x16_bf16(k1, k1, KK, 0, 0, 0); }
        f32x16 M, MT;
        { const float gb0 = tab[32 + r32], bb0 = tab[96 + r32];
#pragma unroll
        for (int r = 0; r < 16; ++r) { const int a0 = crow(r, hi), b0 = r32; const float ke = -KK[r] * __expf(-fabsf(tab[32 + a0] - gb0));
            const float nv = ke * tab[96 + a0], ntv = ke * bb0;
            const float n = (a0 > b0) ? nv : 0.f, nt = (b0 > a0) ? ntv : 0.f, id = (a0 == b0) ? 1.f : 0.f;
            M[r] = n; MT[r] = nt; T2T[r] = id + nt; } }
#pragma unroll
        for (int it = 0; it < 4; ++it) { const f32x16 z = {};
            const f32x16 Mn = mm(MT, M, z), MTn = mm(M, MT, z);
            T2T = mm(Mn, T2T, T2T);
            M = Mn; MT = MTn; }
    }
    GSB();
    {
        f32x16 L21 = {};
#pragma unroll
        for (int s = 0; s < 8; ++s) { const bf16x8 k0 = *(const bf16x8*)(kbase + (size_t)r32 * 4096 + 16 * s + 8 * hi), k1 = *(const bf16x8*)(kbase + (size_t)(32 + r32) * 4096 + 16 * s + 8 * hi);
            L21 = __builtin_amdgcn_mfma_f32_32x32x16_bf16(k1, k0, L21, 0, 0, 0); }
#pragma unroll
        for (int r = 0; r < 16; ++r) { const int a0 = crow(r, hi); L21[r] = L21[r] * tab[96 + a0] * __expf(tab[32 + a0] - tab[r32]); }
        const f32x16 z = {}; const f32x16 Y = mm(L21, T2T, z); T21T = mm(T1, Y, z);
#pragma unroll
        for (int r = 0; r < 16; ++r) T21T[r] = -T21T[r];
    }
    GSB();
    const int vb = (int)(unsigned)(size_t)img + sba::v_rd_base(lane);
    bf16* ubl = dry ? (bf16*)(a.ws + WS_END) + (size_t)(unit & 63) * 64 * 4096 : vbase;
#pragma unroll 1
    for (int mode = 0; mode < 2; ++mode) {
        const bf16* src = mode == 0 ? (const bf16*)vbase : kbase;
#pragma unroll 4
        for (int it = 0; it < 16; ++it) { const int row = (lane >> 4) + 4 * it, col = (lane & 15) * 8;
            *(LAS v4u*)(img + sba::v_st(row, col)) = *(const v4u*)(src + (size_t)row * 4096 + col); }
        LAS float* sc = tab + (mode == 0 ? 64 : 128);
#pragma unroll 1
        for (int I = 0; I < 2; ++I) {
            bf16x8 pa0, pa1, pa2, pa3;
            { f32x16 X;
#pragma unroll
              for (int r = 0; r < 16; ++r) X[r] = (I ? T21T[r] : T1T[r]) * sc[crow(r, hi)];
              GPK4(X, 0, pa0); GPK4(X, 8, pa1);
#pragma unroll
              for (int r = 0; r < 16; ++r) X[r] = I ? T2T[r] * sc[32 + crow(r, hi)] : 0.f;
              GPK4(X, 0, pa2); GPK4(X, 8, pa3); }
            const int ubase = ((((r32 >> 4) * 64 + hi * 16 + (r32 & 15)) * 16) + 8 * I);
            const int wbase = (32 * I + 4 * hi) * 128 + pi_slot(r32);
#define GDN_OUT(D0) do { f32x16 od = {}; sba::pv_one<D0>(od, vb, pa0, pa1, pa2, pa3); \
            if (mode == 0) { _Pragma("unroll") for (int g = 0; g < 4; ++g) { const int f = ubase + D0 * 2048 + (g & 1) * 512 + (g >> 1) * 4; \
                    v2u w; w.x = pk(od[4 * g + 0], od[4 * g + 1]); w.y = pk(od[4 * g + 2], od[4 * g + 3]); *(v2u*)(ubl + (unsigned)((f >> 7) * 4096 + (f & 127))) = w; } } \
            else { _Pragma("unroll") for (int r = 0; r < 16; ++r) wmem[(unsigned)(wbase + ((r & 3) + 8 * (r >> 2)) * 128 + 32 * D0)] = (bf16)(pk(od[r], 0.f) & 0xffffu); } \
            GSB(); } while (0)
            GDN_OUT(0); GDN_OUT(1); GDN_OUT(2); GDN_OUT(3);
#undef GDN_OUT
        }
    }
#undef GSB
}
#undef GPK4
}
DI void phase_gdn_local(const Args& a, LAS unsigned char* lds, int bid, int G, int wave, int lane, bool dry) {
    LAS unsigned char* img = lds + wave * 16384; LAS float* tab = (LAS float*)(lds + RING_BYTES + 4096 + wave * 1024);
    const int gw = bid * NWAVES + wave, NGW = G * NWAVES;
    for (int unit = gw; unit < BATCH * HV * 64; unit += NGW) gdn::local_unit(a, unit, img, tab, lane, dry);
}
namespace gdn {
constexpr int PW = 272, PI = 144;
constexpr int L_W = 0, L_Q = 64 * PW, L_I = 2 * 64 * PW, L_K = L_I + 64 * PI, L_G = L_K + 128 * PI, L_BUF = L_G + 768;
constexpr int L_PART = 2 * L_BUF;
static_assert(L_PART + 4096 <= RING_BYTES, "scan LDS map");
}
DI void phase_gdn_scan(const Args& a, int j, LAS unsigned char* lds, int bid, int tid, bool dry) {
    if (bid >= BATCH * HV) return;
    using gdn::bf16x8; using gdn::pk; using namespace gdn;
    typedef float f4v __attribute__((ext_vector_type(4)));
    const int wave = __builtin_amdgcn_readfirstlane(tid >> 6), lane = tid & 63, n = lane & 15, kq = lane >> 4;
    const int b = bid / HV, hv = bid % HV, hk = hv >> 1;
    bf16* qkvc = (bf16*)(a.ws + WS_QKVC); const bf16* zb = (const bf16*)(a.ws + WS_ZB);
    LAS float* part = (LAS float*)(lds + L_PART); LAS unsigned char* stg = lds + OGST_OFF;
    const int unit0 = (b * HV + hv) * 64, hku0 = (b * HK + hk) * 64; const size_t tb0 = (size_t)b * SEQ;
    if (wave >= 4) {
        const int st = tid - 256;
        v4u rw[4], rq[4], ri[2], rk[4], rz[4]; float rg = 0.f;
#define SV_LOAD(ch) do { const int u_ = unit0 + (ch); const size_t t_ = tb0 + (size_t)(ch) * 64; \
        const bf16* wm_ = (const bf16*)(a.ws + WS_WMEM) + (size_t)u_ * 8192; const bf16* im_ = (const bf16*)(a.ws + WS_IMEM) + (size_t)u_ * 4096; \
        const bf16* kt_ = (const bf16*)(a.ws + WS_KTMEM) + (size_t)(hku0 + (ch)) * 8192; const bf16* qb_ = qkvc + t_ * 4096 + hk * 128; const bf16* zr_ = zb + t_ * 2048 + hv * 128; \
        _Pragma("unroll") for (int k = 0; k < 4; ++k) { const int c = st + 256 * k; rw[k] = *(const v4u*)(wm_ + c * 8); rk[k] = *(const v4u*)(kt_ + c * 8); \
            rq[k] = *(const v4u*)(qb_ + (size_t)(c >> 4) * 4096 + (c & 15) * 8); rz[k] = *(const v4u*)(zr_ + (size_t)(c >> 4) * 2048 + (c & 15) * 8); } \
        _Pragma("unroll") for (int k = 0; k < 2; ++k) { const int c = st + 256 * k; ri[k] = *(const v4u*)(im_ + c * 8); } \
        if (st < 192) rg = ((const float*)(a.ws + WS_GTAB))[(size_t)u_ * 192 + st]; } while (0)
#define SV_WRITE(bf) do { LAS unsigned char* B_ = lds + (bf) * L_BUF; \
        _Pragma("unroll") for (int k = 0; k < 4; ++k) { const int c = st + 256 * k; *(LAS v4u*)(B_ + L_W + (c >> 4) * PW + (c & 15) * 16) = rw[k]; \
            *(LAS v4u*)(B_ + L_Q + (c >> 4) * PW + (c & 15) * 16) = rq[k]; *(LAS v4u*)(B_ + L_K + (c >> 3) * PI + (c & 7) * 16) = rk[k]; } \
        _Pragma("unroll") for (int k = 0; k < 2; ++k) { const int c = st + 256 * k; *(LAS v4u*)(B_ + L_I + (c >> 3) * PI + (c & 7) * 16) = ri[k]; } \
        if (st < 192) *(LAS float*)(B_ + L_G + st * 4) = rg; } while (0)
#define SV_ZWRITE() do { _Pragma("unroll") for (int k = 0; k < 4; ++k) { const int c = st + 256 * k; *(LAS v4u*)(stg + (c >> 4) * 256 + (c & 15) * 16) = rz[k]; } } while (0)
        SV_LOAD(0); SV_WRITE(0); SV_ZWRITE();
        __syncthreads();
#pragma unroll 1
        for (int chunk = 0; chunk < 64; ++chunk) {
            if (chunk + 1 < 64) { SV_LOAD(chunk + 1); SV_WRITE((chunk + 1) & 1); }
            __syncthreads();
            __syncthreads();
            { bf16* ob = dry ? (bf16*)(a.ws + WS_END) + (size_t)bid * 64 * 128 : qkvc + (tb0 + (size_t)chunk * 64) * 4096 + 2048 + hv * 128; const int opitch = dry ? 128 : 4096;
#pragma unroll
              for (int k = 0; k < 4; ++k) { const int c = st + 256 * k; *(v4u*)(ob + (size_t)(c >> 4) * opitch + (c & 15) * 8) = *(const LAS v4u*)(stg + (c >> 4) * 256 + (c & 15) * 16); } }
            if (chunk + 1 < 64) SV_ZWRITE();
        }
#undef SV_LOAD
#undef SV_WRITE
#undef SV_ZWRITE
        return;
    }
    float nw[2]; nw[0] = a.gdn_norm_w[j * 128 + 32 * wave + n]; nw[1] = a.gdn_norm_w[j * 128 + 32 * wave + 16 + n];
    f4v S[2][8];
#pragma unroll
    for (int g = 0; g < 2; ++g)
#pragma unroll
        for (int m = 0; m < 8; ++m) S[g][m] = (f4v){0.f, 0.f, 0.f, 0.f};
    v4u un[2][2];
#define CW_ULOAD(ch) do { const bf16* vb_ = qkvc + (tb0 + (size_t)(ch) * 64) * 4096 + 2048 + hv * 128; \
        _Pragma("unroll") for (int g = 0; g < 2; ++g) { const int f = ((2 * wave + g) * 64 + lane) * 16; un[g][0] = *(const v4u*)(vb_ + (size_t)(f >> 7) * 4096 + (f & 127)); un[g][1] = *(const v4u*)(vb_ + (size_t)(f >> 7) * 4096 + (f & 127) + 8); } } while (0)
    CW_ULOAD(0);
    __syncthreads();
#pragma unroll 1
    for (int chunk = 0; chunk < 64; ++chunk) {
        const LAS unsigned char* B = lds + (chunk & 1) * L_BUF; const LAS float* gt = (const LAS float*)(B + L_G);
        f4v av[2][4], ao[2][4];
#pragma unroll
        for (int g = 0; g < 2; ++g) { const v4u u0 = un[g][0], u1 = un[g][1];
            av[g][0] = (f4v){bf_lo(u0.x), bf_hi(u0.x), bf_lo(u0.y), bf_hi(u0.y)}; av[g][1] = (f4v){bf_lo(u0.z), bf_hi(u0.z), bf_lo(u0.w), bf_hi(u0.w)};
            av[g][2] = (f4v){bf_lo(u1.x), bf_hi(u1.x), bf_lo(u1.y), bf_hi(u1.y)}; av[g][3] = (f4v){bf_lo(u1.z), bf_hi(u1.z), bf_lo(u1.w), bf_hi(u1.w)}; }
        if (chunk + 1 < 64) CW_ULOAD(chunk + 1);
        bf16x8 Sb[2][4];
#pragma unroll
        for (int g = 0; g < 2; ++g)
#pragma unroll
            for (int p = 0; p < 4; ++p) { v4u w; w.x = pk(S[g][2 * p][0], S[g][2 * p][1]); w.y = pk(S[g][2 * p][2], S[g][2 * p][3]); w.z = pk(S[g][2 * p + 1][0], S[g][2 * p + 1][1]); w.w = pk(S[g][2 * p + 1][2], S[g][2 * p + 1][3]);
                Sb[g][p] = __builtin_bit_cast(bf16x8, w); }
#pragma unroll
        for (int mt = 0; mt < 4; ++mt) { ao[0][mt] = (f4v){0.f, 0.f, 0.f, 0.f}; ao[1][mt] = (f4v){0.f, 0.f, 0.f, 0.f};
#pragma unroll
            for (int p = 0; p < 4; ++p) {
                const bf16x8 aw = *(const LAS bf16x8*)(B + L_W + (16 * mt + n) * PW + 64 * p + 16 * kq);
                const v2u q0 = *(const LAS v2u*)(B + L_Q + (16 * mt + n) * PW + 64 * p + 8 * kq), q1 = *(const LAS v2u*)(B + L_Q + (16 * mt + n) * PW + 64 * p + 32 + 8 * kq);
                const v4u qq = {q0.x, q0.y, q1.x, q1.y}; const bf16x8 aq = __builtin_bit_cast(bf16x8, qq);
                av[0][mt] = __builtin_amdgcn_mfma_f32_16x16x32_bf16(aw, Sb[0][p], av[0][mt], 0, 0, 0); av[1][mt] = __builtin_amdgcn_mfma_f32_16x16x32_bf16(aw, Sb[1][p], av[1][mt], 0, 0, 0);
                ao[0][mt] = __builtin_amdgcn_mfma_f32_16x16x32_bf16(aq, Sb[0][p], ao[0][mt], 0, 0, 0); ao[1][mt] = __builtin_amdgcn_mfma_f32_16x16x32_bf16(aq, Sb[1][p], ao[1][mt], 0, 0, 0); } }
        bf16x8 vbf[2][2], vbd[2][2];
#pragma unroll
        for (int pp = 0; pp < 2; ++pp) {
            const f4v d0 = *(const LAS f4v*)(gt + 64 + 32 * pp + 4 * kq), d1 = *(const LAS f4v*)(gt + 64 + 32 * pp + 16 + 4 * kq);
#pragma unroll
            for (int g = 0; g < 2; ++g) { const f4v x0 = av[g][2 * pp], x1 = av[g][2 * pp + 1];
                v4u w; w.x = pk(x0[0], x0[1]); w.y = pk(x0[2], x0[3]); w.z = pk(x1[0], x1[1]); w.w = pk(x1[2], x1[3]); vbf[g][pp] = __builtin_bit_cast(bf16x8, w);
                v4u y; y.x = pk(x0[0] * d0[0], x0[1] * d0[1]); y.y = pk(x0[2] * d0[2], x0[3] * d0[3]); y.z = pk(x1[0] * d1[0], x1[1] * d1[1]); y.w = pk(x1[2] * d1[2], x1[3] * d1[3]); vbd[g][pp] = __builtin_bit_cast(bf16x8, y); }
        }
#pragma unroll
        for (int mt = 0; mt < 4; ++mt) { const f4v eg = *(const LAS f4v*)(gt + 16 * mt + 4 * kq); ao[0][mt] = ao[0][mt] * eg; ao[1][mt] = ao[1][mt] * eg;
#pragma unroll
            for (int pp = 0; pp < 2; ++pp) { const bf16x8 ai = *(const LAS bf16x8*)(B + L_I + (16 * mt + n) * PI + 64 * pp + 16 * kq);
                ao[0][mt] = __builtin_amdgcn_mfma_f32_16x16x32_bf16(ai, vbf[0][pp], ao[0][mt], 0, 0, 0); ao[1][mt] = __builtin_amdgcn_mfma_f32_16x16x32_bf16(ai, vbf[1][pp], ao[1][mt], 0, 0, 0); } }
        { const float egl = gt[128];
#pragma unroll
          for (int m8 = 0; m8 < 8; ++m8) { S[0][m8] = S[0][m8] * egl; S[1][m8] = S[1][m8] * egl;
#pragma unroll
              for (int pp = 0; pp < 2; ++pp) { const bf16x8 ak = *(const LAS bf16x8*)(B + L_K + (16 * m8 + n) * PI + 64 * pp + 16 * kq);
                  S[0][m8] = __builtin_amdgcn_mfma_f32_16x16x32_bf16(ak, vbd[0][pp], S[0][m8], 0, 0, 0); S[1][m8] = __builtin_amdgcn_mfma_f32_16x16x32_bf16(ak, vbd[1][pp], S[1][m8], 0, 0, 0); } } }
        LAS float* pb = part + (chunk & 1) * 512;
#pragma unroll
        for (int g = 0; g < 2; ++g)
#pragma unroll
            for (int mt = 0; mt < 4; ++mt)
#pragma unroll
                for (int i = 0; i < 4; ++i) { const float ss = dpp_sum16(ao[g][mt][i] * ao[g][mt][i]);
                    if (n == 0) pb[(16 * mt + 4 * kq + i) * 8 + 2 * wave + g] = ss; }
        __syncthreads();
#pragma unroll
        for (int mt = 0; mt < 4; ++mt)
#pragma unroll
            for (int i = 0; i < 4; ++i) { const int c = 16 * mt + 4 * kq + i;
                const f4v s0 = *(const LAS f4v*)(pb + c * 8), s1 = *(const LAS f4v*)(pb + c * 8 + 4);
                const float tot = (s0[0] + s0[1]) + (s0[2] + s0[3]) + (s1[0] + s1[1]) + (s1[2] + s1[3]);
                const float rinv = __builtin_amdgcn_rsqf(tot * (1.0f / 128.0f) + RMS_EPS);
#pragma unroll
                for (int g = 0; g < 2; ++g) { LAS bf16* zp = (LAS bf16*)(stg + c * 256 + (32 * wave + 16 * g + n) * 2);
                    const float z = __uint_as_float((unsigned)(*zp) << 16);
                    const float sg = z * __builtin_amdgcn_rcpf(1.0f + __builtin_amdgcn_exp2f(-1.4426950408889634f * z));
                    *zp = (bf16)(pk(ao[g][mt][i] * rinv * nw[g] * sg, 0.f) & 0xffffu); } }
        __syncthreads();
    }
#undef CW_ULOAD
}

DI void moe_offsets(const Args& a, int j, unsigned (&off)[9]) {
    unsigned* cnt = (unsigned*)(a.ws + WS_CTL) + CW_CNT + 256 * j; unsigned acc = 0u;
#pragma unroll
    for (int e = 0; e < 8; ++e) { off[e] = acc; const unsigned c = __hip_atomic_load(cnt + e, __ATOMIC_RELAXED, __HIP_MEMORY_SCOPE_AGENT); acc += (c + 255u) & ~255u; }
    off[8] = acc;
}
DI void phase_scatter(const Args& a, int j, LAS unsigned char* lds, int bid, int G, int tid, int wave, int lane) {
    LAS unsigned* lc = (LAS unsigned*)lds; LAS unsigned* lb = lc + 8; LAS unsigned* loff = lc + 16; LAS int* lpos = (LAS int*)(lc + 32);
    const unsigned* E12 = (const unsigned*)(a.ws + WS_E12); int* POS = (int*)(a.ws + WS_POS);
    const bf16* HB = (const bf16*)(a.ws + WS_HB); bf16* XS = (bf16*)(a.ws + WS_XS);
    unsigned* fill = (unsigned*)(a.ws + WS_CTL) + CW_CNT + 256 * j + 64;
    unsigned off[9]; moe_offsets(a, j, off);
    if (tid == 0) {
#pragma unroll
        for (int e = 0; e < 8; ++e) loff[e] = off[e]; }
    for (int ci = bid; ci < TT / 128; ci += G) {
        __syncthreads();
        if (tid < 8) lc[tid] = 0u;
        __syncthreads();
        unsigned e1 = 0, e2 = 0, r1 = 0, r2 = 0;
        if (tid < 128) { const unsigned w = E12[ci * 128 + tid]; e1 = w & 255u; e2 = (w >> 8) & 255u;
            r1 = __hip_atomic_fetch_add(lc + e1, 1u, __ATOMIC_RELAXED, __HIP_MEMORY_SCOPE_WORKGROUP); r2 = __hip_atomic_fetch_add(lc + e2, 1u, __ATOMIC_RELAXED, __HIP_MEMORY_SCOPE_WORKGROUP); }
        __syncthreads();
        if (tid < 8) lb[tid] = __hip_atomic_fetch_add(fill + tid, lc[tid], __ATOMIC_RELAXED, __HIP_MEMORY_SCOPE_AGENT);
        __syncthreads();
        if (tid < 128) { const int p1 = (int)(loff[e1] + lb[e1] + r1), p2 = (int)(loff[e2] + lb[e2] + r2);
            lpos[2 * tid] = p1; lpos[2 * tid + 1] = p2; POS[2 * (ci * 128 + tid)] = p1; POS[2 * (ci * 128 + tid) + 1] = p2; }
        __syncthreads();
        for (int tk = wave; tk < 128; tk += NWAVES) {
            const int p1 = lpos[2 * tk], p2 = lpos[2 * tk + 1];
            const v4u* src = (const v4u*)(HB + (size_t)(ci * 128 + tk) * D);
            const v4u x0 = src[lane], x1 = src[lane + 64];
            v4u* d1 = (v4u*)(XS + (size_t)p1 * D); v4u* d2 = (v4u*)(XS + (size_t)p2 * D);
            d1[lane] = x0; d1[lane + 64] = x1; d2[lane] = x0; d2[lane + 64] = x1;
        }
    }
}

template <bool FINAL>
DI void phase_combine_ln(const Args& a, int lnprev, int lnidx, int bid, int G, int wave, int lane) {
    float* out = a.out; bf16* HB = (bf16*)(a.ws + WS_HB); const bf16* YE = (const bf16*)(a.ws + WS_XS); float* stats = (float*)(a.ws + WS_STATS);
    const int* POS = (const int*)(a.ws + WS_POS); const f32x2* G12 = (const f32x2*)(a.ws + WS_G12);
    const float* g = a.ln_g + (size_t)lnidx * D; const float* bta = a.ln_b + (size_t)lnidx * D;
    const float* gp = a.ln_g + (size_t)lnprev * D; const float* bp = a.ln_b + (size_t)lnprev * D;
    const int gw = bid * NWAVES + wave, NGW = G * NWAVES;
    f32x4 gv[4], bv[4], gq[4], bq[4];
#pragma unroll
    for (int q = 0; q < 4; ++q) { gv[q] = *(const f32x4*)(g + 4 * (lane + 64 * q)); bv[q] = *(const f32x4*)(bta + 4 * (lane + 64 * q));
        gq[q] = *(const f32x4*)(gp + 4 * (lane + 64 * q)) * ALPHA; bq[q] = *(const f32x4*)(bp + 4 * (lane + 64 * q)) * ALPHA; }
    for (int t = gw; t < TT; t += NGW) {
        f32x4* row = (f32x4*)(out + (size_t)t * D);
        const int p1 = POS[2 * t], p2 = POS[2 * t + 1]; const f32x2 gg = G12[t]; const f32x2 st = *(const f32x2*)(stats + 2 * (size_t)t);
        const v2u* y1 = (const v2u*)(YE + (size_t)p1 * D); const v2u* y2 = (const v2u*)(YE + (size_t)p2 * D);
        f32x4 v[4]; float s = 0.f;
#pragma unroll
        for (int q = 0; q < 4; ++q) { const v2u a1 = y1[lane + 64 * q], a2 = y2[lane + 64 * q];
            const f32x4 e1 = (f32x4){bf_lo(a1.x), bf_hi(a1.x), bf_lo(a1.y), bf_hi(a1.y)}, e2 = (f32x4){bf_lo(a2.x), bf_hi(a2.x), bf_lo(a2.y), bf_hi(a2.y)};
            v[q] = (row[lane + 64 * q] - st.x) * st.y * gq[q] + bq[q] + e1 * gg.x + e2 * gg.y; s += (v[q][0] + v[q][1]) + (v[q][2] + v[q][3]); }
        const float mean = wave_sum(s) * (1.0f / D); float s2 = 0.f;
#pragma unroll
        for (int q = 0; q < 4; ++q) { const f32x4 d = v[q] - mean; s2 += (d[0] * d[0] + d[1] * d[1]) + (d[2] * d[2] + d[3] * d[3]); }
        const float rstd = 1.0f / sqrtf(wave_sum(s2) * (1.0f / D) + LN_EPS);
        if (lane == 0) *(f32x2*)(stats + 2 * (size_t)t) = (f32x2){mean, rstd};
#pragma unroll
        for (int q = 0; q < 4; ++q) { const f32x4 hn = (v[q] - mean) * rstd * gv[q] + bv[q]; row[lane + 64 * q] = FINAL ? hn : v[q];
            v2u o; o.x = pk2(hn[0], hn[1]); o.y = pk2(hn[2], hn[3]); *(v2u*)(HB + (size_t)t * D + 4 * (lane + 64 * q)) = o; }
    }
}

constexpr int ARGS_OFF = RING_BYTES + 1024;
DI unsigned long long lds_u64(LAS unsigned char* p) { const v2u w = *(const volatile LAS v2u*)p; return ((unsigned long long)(unsigned)__builtin_amdgcn_readfirstlane((int)w.y) << 32) | (unsigned)__builtin_amdgcn_readfirstlane((int)w.x); }
DI Args load_args(LAS unsigned char* lds) {
    Args a; LAS unsigned char* p = lds + ARGS_OFF;
    a.x = (const float*)(const GAS float*)lds_u64(p + 0); a.gdn_w_in = (const float*)(const GAS float*)lds_u64(p + 8); a.gdn_conv_w = (const float*)(const GAS float*)lds_u64(p + 16); a.gdn_a_log = (const float*)(const GAS float*)lds_u64(p + 24);
    a.gdn_dt_bias = (const float*)(const GAS float*)lds_u64(p + 32); a.gdn_norm_w = (const float*)(const GAS float*)lds_u64(p + 40); a.gdn_w_out = (const float*)(const GAS float*)lds_u64(p + 48); a.sb_w_in = (const float*)(const GAS float*)lds_u64(p + 56);
    a.sb_w_out = (const float*)(const GAS float*)lds_u64(p + 64); a.ffn_w_gate = (const float*)(const GAS float*)lds_u64(p + 72); a.ffn_w_up = (const float*)(const GAS float*)lds_u64(p + 80); a.ffn_w_down = (const float*)(const GAS float*)lds_u64(p + 88);
    a.moe_router = (const float*)(const GAS float*)lds_u64(p + 96); a.moe_w_gate = (const float*)(const GAS float*)lds_u64(p + 104); a.moe_w_up = (const float*)(const GAS float*)lds_u64(p + 112); a.moe_w_down = (const float*)(const GAS float*)lds_u64(p + 120);
    a.ln_g = (const float*)(const GAS float*)lds_u64(p + 128); a.ln_b = (const float*)(const GAS float*)lds_u64(p + 136); a.out = (float*)(GAS float*)lds_u64(p + 144); a.ws = (unsigned char*)(GAS unsigned char*)lds_u64(p + 152);
    const v2u w = *(const volatile LAS v2u*)(p + 160); a.ph_lo = __builtin_amdgcn_readfirstlane((int)w.x); a.ph_hi = __builtin_amdgcn_readfirstlane((int)w.y);
    return a;
}
#ifdef PH_ONLY
#define IN(k) (((k) % NPH) == PH_ONLY && lo <= (k) && (k) < hi)
#else
#define IN(k) (lo <= (k) && (k) < hi)
#endif
#define SEAM(k) do { if ((k) + 1 < hi) xcd_barrier(bar); } while (0)
DI int fresh_lane() { int l; asm volatile("v_mbcnt_lo_u32_b32 %0, -1, 0\n\tv_mbcnt_hi_u32_b32 %0, -1, %0" : "=v"(l)); return l; }
#define ARGS() const Args args = load_args(lds); const int lo = args.ph_lo, hi = args.ph_hi; const int lane = fresh_lane(), tid = wave * 64 + lane
#ifndef PROBE_REP_MASK
#define PROBE_REP_MASK 0
#endif
#ifndef PROBE_DELAY_MASK
#define PROBE_DELAY_MASK 0
#endif
#define PROBE_DELAY_MULT 4u
#define TICK_IN(k) do { if (((PROBE_DELAY_MASK) >> (k)) & 1) { if (bid == 0 && tid == 0) ((volatile LAS unsigned*)(lds + MISC_OFF))[20] -= (unsigned)__builtin_amdgcn_s_memrealtime(); } } while (0)
#define TICK_OUT(k) do { if (((PROBE_DELAY_MASK) >> (k)) & 1) { if (bid == 0 && tid == 0) ((volatile LAS unsigned*)(lds + MISC_OFF))[20] += (unsigned)__builtin_amdgcn_s_memrealtime(); } } while (0)
#define NREP(k) ((((PROBE_REP_MASK) >> (k)) & 1) ? 2 : 1)
template <int j>
DI void layer_pair(LAS unsigned char* lds, const XcdBarrier& bar, const int wave, const int G, const int bid) {
    constexpr int pb = j * NPH;
    { ARGS(); if (IN(pb + 0)) { TICK_IN(0); _Pragma("unroll 1") for (int rep_ = 0; rep_ < NREP(0); ++rep_) { phase_w_gdn(args, j, lds, bid, G, tid, wave, lane); } SEAM(pb + 0); TICK_OUT(0); } }
    { ARGS(); if (IN(pb + 1)) { TICK_IN(1); {
        pg8::Gemm g{(const bf16*)(args.ws + WS_HB), (const bf16*)(args.ws + W_IN), D, D}; pg8::StaticOrder S; S.init(TT, GINP, G, bid, NREP(1));
        pg8::EpiInProj E{(bf16*)(args.ws + WS_RAW), (bf16*)(args.ws + WS_ZB)};
        pg8::gemm_phase<pg8::EpiInProj, pg8::StaticOrder, true, true>(lds, g, S, E);
        } SEAM(pb + 1); TICK_OUT(1); } }
    { ARGS(); if (IN(pb + 2)) { TICK_IN(2); _Pragma("unroll 1") for (int rep_ = 0; rep_ < NREP(2); ++rep_) { phase_conv(args, j, bid, G, tid); } SEAM(pb + 2); TICK_OUT(2); } }
#if GDN_NAIVE
    { ARGS(); if (IN(pb + 4)) { TICK_IN(4); _Pragma("unroll 1") for (int rep_ = 0; rep_ < NREP(4); ++rep_) { phase_gdn_naive(args, j, lds, bid, tid); } SEAM(pb + 4); TICK_OUT(4); } }
#else
    { ARGS(); if (IN(pb + 3)) { TICK_IN(3); _Pragma("unroll 1") for (int rep_ = 0; rep_ < NREP(3); ++rep_) { phase_gdn_local(args, lds, bid, G, wave, lane, rep_ + 1 < NREP(3)); } SEAM(pb + 3); TICK_OUT(3); } }
    { ARGS(); if (IN(pb + 4)) { TICK_IN(4); _Pragma("unroll 1") for (int rep_ = 0; rep_ < NREP(4); ++rep_) { if (bid >= BATCH * HV && G > BATCH * HV) phase_w_sb(args, j, lds, bid - BATCH * HV, G - BATCH * HV, wave, lane); else if (G <= BATCH * HV && rep_ == 0) phase_w_sb(args, j, lds, bid, G, wave, lane);
        phase_gdn_scan(args, j, lds, bid, tid, rep_ + 1 < NREP(4)); } SEAM(pb + 4); TICK_OUT(4); } }
#endif
    { ARGS(); if (IN(pb + 5)) { TICK_IN(5); {
        pg8::Gemm g{(const bf16*)(args.ws + WS_QKVC) + 2048, (const bf16*)(args.ws + W_OUT), 4096, 2048}; pg8::StaticOrder S; S.init(TT, D, G, bid);
        pg8::EpiResid<(j > 0)> E{j == 0 ? args.x : args.out, args.out, (const float*)(args.ws + WS_STATS), args.ln_g + (size_t)(4 * (j > 0 ? j - 1 : 0) + 3) * D, args.ln_b + (size_t)(4 * (j > 0 ? j - 1 : 0) + 3) * D};
        pg8::gemm_phase<pg8::EpiResid<(j > 0)>, pg8::StaticOrder, true, true>(lds, g, S, E);
        } SEAM(pb + 5); TICK_OUT(5); } }
    { ARGS(); if (IN(pb + 6)) { TICK_IN(6); _Pragma("unroll 1") for (int rep_ = 0; rep_ < NREP(6); ++rep_) { phase_ln<false>(args, (2 * j) * 2 + 0, j, lds, bid, G, tid, wave, lane); } SEAM(pb + 6); TICK_OUT(6); } }
    { ARGS(); if (IN(pb + 7)) { TICK_IN(7); {
        pg8::Gemm g{(const bf16*)(args.ws + WS_HB), (const bf16*)(args.ws + W_GU), D, D}; pg8::StaticOrder S; S.init(TT, 2 * FF, G, bid, NREP(7));
        pg8::EpiSwiGLU E{(bf16*)(args.ws + WS_ACT), FF, 0};
        pg8::gemm_phase<pg8::EpiSwiGLU, pg8::StaticOrder, true, true>(lds, g, S, E);
        } SEAM(pb + 7); TICK_OUT(7); } }
    { ARGS(); if (IN(pb + 8)) { TICK_IN(8); {
        pg8::Gemm g{(const bf16*)(args.ws + WS_ACT), (const bf16*)(args.ws + W_D), FF, FF}; pg8::StaticOrder S; S.init(TT, D, G, bid);
        pg8::EpiResid<true> E{args.out, args.out, (const float*)(args.ws + WS_STATS), args.ln_g + (size_t)(4 * j + 0) * D, args.ln_b + (size_t)(4 * j + 0) * D};
        pg8::gemm_phase<pg8::EpiResid<true>, pg8::StaticOrder, true, true>(lds, g, S, E);
        } SEAM(pb + 8); TICK_OUT(8); } }
    { ARGS(); if (IN(pb + 9)) { TICK_IN(9); _Pragma("unroll 1") for (int rep_ = 0; rep_ < NREP(9); ++rep_) { phase_ln<false>(args, (2 * j) * 2 + 1, j, lds, bid, G, tid, wave, lane); } SEAM(pb + 9); TICK_OUT(9); } }
    { ARGS(); if (IN(pb + 10)) { TICK_IN(10); {
        pg8::Gemm g{(const bf16*)(args.ws + WS_HB), (const bf16*)(args.ws + W_QKV), D, D}; pg8::StaticOrder S; S.init(TT, 3072, G, bid, NREP(10));
        pg8::EpiBf16 E{(bf16*)(args.ws + WS_QKV), 3072, 0};
        pg8::gemm_phase<pg8::EpiBf16, pg8::StaticOrder, true, true>(lds, g, S, E);
        } SEAM(pb + 10); TICK_OUT(10); } }
    #if SB_NAIVE
    { ARGS(); if (IN(pb + 11)) { TICK_IN(11); _Pragma("unroll 1") for (int rep_ = 0; rep_ < NREP(11); ++rep_) { phase_sb_naive(args, lds, bid, G, tid); } SEAM(pb + 11); TICK_OUT(11); } }
#else
    { ARGS(); if (IN(pb + 11)) { TICK_IN(11); _Pragma("unroll 1") for (int rep_ = 0; rep_ < NREP(11); ++rep_) { phase_sb_mfma(args, lds, bid, G, tid); } SEAM(pb + 11); TICK_OUT(11); } }
#endif
    { ARGS(); if (IN(pb + 12)) { TICK_IN(12); {
        pg8::Gemm g{(const bf16*)(args.ws + WS_AO), (const bf16*)(args.ws + W_O), D, D}; pg8::StaticOrder S; S.init(TT, D, G, bid);
        pg8::EpiResid<true> E{args.out, args.out, (const float*)(args.ws + WS_STATS), args.ln_g + (size_t)(4 * j + 1) * D, args.ln_b + (size_t)(4 * j + 1) * D};
        pg8::gemm_phase<pg8::EpiResid<true>, pg8::StaticOrder, true, true>(lds, g, S, E);
        } SEAM(pb + 12); TICK_OUT(12); } }
    { ARGS(); if (IN(pb + 13)) { TICK_IN(13); _Pragma("unroll 1") for (int rep_ = 0; rep_ < NREP(13); ++rep_) { phase_ln<true>(args, (2 * j + 1) * 2 + 0, j, lds, bid, G, tid, wave, lane); } SEAM(pb + 13); TICK_OUT(13); } }
    { ARGS(); if (IN(pb + 14)) { TICK_IN(14); _Pragma("unroll 1") for (int rep_ = 0; rep_ < NREP(14); ++rep_) { phase_scatter(args, j, lds, bid, G, tid, wave, lane); } SEAM(pb + 14); TICK_OUT(14); } }
    { ARGS(); if (IN(pb + 15)) { TICK_IN(15); {
        unsigned off[9]; moe_offsets(args, j, off);
        pg8::MoeOrder S; S.nM = (int)(off[8] >> 8); S.G = G; S.c = bid; S.nN = 2 * FF / 256; S.nwg = S.nM * S.nN; S.rep = NREP(15);
        S.ps1 = (int)(off[1] >> 8); S.ps2 = (int)(off[2] >> 8); S.ps3 = (int)(off[3] >> 8); S.ps4 = (int)(off[4] >> 8); S.ps5 = (int)(off[5] >> 8); S.ps6 = (int)(off[6] >> 8); S.ps7 = (int)(off[7] >> 8);
        pg8::Gemm g{(const bf16*)(args.ws + WS_XS), (const bf16*)(args.ws + W_MGU), D, D};
        pg8::EpiSwiGLU E{(bf16*)(args.ws + WS_MACT), FF, 2 * FF / 256};
        pg8::gemm_phase<pg8::EpiSwiGLU, pg8::MoeOrder, true, true>(lds, g, S, E);
        } SEAM(pb + 15); TICK_OUT(15); } }
    { ARGS(); if (IN(pb + 16)) { TICK_IN(16); {
        unsigned off[9]; moe_offsets(args, j, off);
        pg8::MoeOrder S; S.nM = (int)(off[8] >> 8); S.G = G; S.c = bid; S.nN = D / 256; S.nwg = S.nM * S.nN; S.rep = NREP(16);
        S.ps1 = (int)(off[1] >> 8); S.ps2 = (int)(off[2] >> 8); S.ps3 = (int)(off[3] >> 8); S.ps4 = (int)(off[4] >> 8); S.ps5 = (int)(off[5] >> 8); S.ps6 = (int)(off[6] >> 8); S.ps7 = (int)(off[7] >> 8);
        pg8::Gemm g{(const bf16*)(args.ws + WS_MACT), (const bf16*)(args.ws + W_MD), FF, FF};
        pg8::EpiBf16 E{(bf16*)(args.ws + WS_XS), D, D / 256};
        pg8::gemm_phase<pg8::EpiBf16, pg8::MoeOrder, true, true>(lds, g, S, E);
        } SEAM(pb + 16); TICK_OUT(16); } }
    { ARGS(); if (IN(pb + 17)) { TICK_IN(17); _Pragma("unroll 1") for (int rep_ = 0; rep_ < NREP(17); ++rep_) { phase_combine_ln<(j == 1)>(args, 4 * j + 2, 4 * j + 3, bid, G, wave, lane); } SEAM(pb + 17); TICK_OUT(17); } }
}
__global__ void __launch_bounds__(NWAVES * 64, 2) fwd(Args kargs) {
    extern __shared__ __attribute__((aligned(16))) unsigned char lds_raw[];
    LAS unsigned char* lds = (LAS unsigned char*)lds_raw;
    volatile LAS unsigned* MISC = (volatile LAS unsigned*)(lds + MISC_OFF);
    const int tid = threadIdx.x, lane = tid & 63, wave = __builtin_amdgcn_readfirstlane(tid >> 6), G = gridDim.x, bid = blockIdx.x;
    for (int u = tid; u < (LDS_BYTES - RING_BYTES) / 4; u += NWAVES * 64) ((LAS unsigned*)(lds + RING_BYTES))[u] = 0u;
    __syncthreads();
    if (tid == 0) { LAS unsigned long long* pa = (LAS unsigned long long*)(lds + ARGS_OFF);
        pa[0] = (unsigned long long)kargs.x; pa[1] = (unsigned long long)kargs.gdn_w_in; pa[2] = (unsigned long long)kargs.gdn_conv_w; pa[3] = (unsigned long long)kargs.gdn_a_log;
        pa[4] = (unsigned long long)kargs.gdn_dt_bias; pa[5] = (unsigned long long)kargs.gdn_norm_w; pa[6] = (unsigned long long)kargs.gdn_w_out; pa[7] = (unsigned long long)kargs.sb_w_in;
        pa[8] = (unsigned long long)kargs.sb_w_out; pa[9] = (unsigned long long)kargs.ffn_w_gate; pa[10] = (unsigned long long)kargs.ffn_w_up; pa[11] = (unsigned long long)kargs.ffn_w_down;
        pa[12] = (unsigned long long)kargs.moe_router; pa[13] = (unsigned long long)kargs.moe_w_gate; pa[14] = (unsigned long long)kargs.moe_w_up; pa[15] = (unsigned long long)kargs.moe_w_down;
        pa[16] = (unsigned long long)kargs.ln_g; pa[17] = (unsigned long long)kargs.ln_b; pa[18] = (unsigned long long)kargs.out; pa[19] = (unsigned long long)kargs.ws;
        pa[20] = (unsigned long long)(unsigned)kargs.ph_lo | ((unsigned long long)(unsigned)kargs.ph_hi << 32); }
    XcdBarrier bar = xcd_barrier_post((unsigned*)(kargs.ws + WS_CTL) + CW_BAR, MISC + 8);
    __syncthreads();
    layer_pair<0>(lds, bar, wave, G, bid);
    layer_pair<1>(lds, bar, wave, G, bid);
    if (PROBE_DELAY_MASK) { if (bid == 0 && threadIdx.x == 0) { const unsigned acc = ((volatile LAS unsigned*)(lds + MISC_OFF))[20] * PROBE_DELAY_MULT; const unsigned long long t0 = __builtin_amdgcn_s_memrealtime(); while ((unsigned)(__builtin_amdgcn_s_memrealtime() - t0) < acc) __builtin_amdgcn_s_sleep(8); } }
}
#undef IN
#undef SEAM
#undef ARGS

extern "C" void kernel_launch(void* const* d_in, const int* in_sizes, int n_in, void* d_out, int out_size, void* d_ws, size_t ws_size, hipStream_t stream) {
    static int grid = 0;
    if (grid == 0) {
        if (n_in != 18 || in_sizes[0] != TT * D || out_size != TT * D || ws_size < WS_END) { fprintf(stderr, "kernel_launch: unexpected shapes (n_in %d, in0 %d, out %d, ws %zu); nothing launched\n", n_in, n_in > 0 ? in_sizes[0] : -1, out_size, ws_size); grid = -1; return; }
        int dev = 0, cus = 0, per_cu = 0;
        if (hipGetDevice(&dev) != hipSuccess || hipDeviceGetAttribute(&cus, hipDeviceAttributeMultiprocessorCount, dev) != hipSuccess) { grid = -1; return; }
        if (hipFuncSetAttribute((const void*)fwd, hipFuncAttributeMaxDynamicSharedMemorySize, LDS_BYTES) != hipSuccess) { fprintf(stderr, "kernel_launch: hipFuncSetAttribute failed\n"); grid = -1; return; }
        if (hipOccupancyMaxActiveBlocksPerMultiprocessor(&per_cu, (const void*)fwd, NWAVES * 64, LDS_BYTES) != hipSuccess || per_cu < 1) { fprintf(stderr, "kernel_launch: occupancy query says %d blocks per CU\n", per_cu); (void)hipGetLastError(); grid = -1; return; }
        grid = cus;
    }
    if (grid < 0) return;
    if (hipMemsetAsync((char*)d_ws + WS_CTL, 0, CTL_ZERO_BYTES, stream) != hipSuccess) return;
    Args a{};
    a.x = (const float*)d_in[0]; a.gdn_w_in = (const float*)d_in[1]; a.gdn_conv_w = (const float*)d_in[2]; a.gdn_a_log = (const float*)d_in[3]; a.gdn_dt_bias = (const float*)d_in[4];
    a.gdn_norm_w = (const float*)d_in[5]; a.gdn_w_out = (const float*)d_in[6]; a.sb_w_in = (const float*)d_in[7]; a.sb_w_out = (const float*)d_in[8];
    a.ffn_w_gate = (const float*)d_in[9]; a.ffn_w_up = (const float*)d_in[10]; a.ffn_w_down = (const float*)d_in[11]; a.moe_router = (const float*)d_in[12];
    a.moe_w_gate = (const float*)d_in[13]; a.moe_w_up = (const float*)d_in[14]; a.moe_w_down = (const float*)d_in[15]; a.ln_g = (const float*)d_in[16]; a.ln_b = (const float*)d_in[17];
    a.out = (float*)d_out; a.ws = (unsigned char*)d_ws;
#if MK_ONE_LAUNCH
    a.ph_lo = 0; a.ph_hi = NPHASES;
    hipLaunchKernelGGL(fwd, dim3(grid), dim3(NWAVES * 64), LDS_BYTES, stream, a);
#else
    for (int p = 0; p < NPHASES; ++p) { a.ph_lo = p; a.ph_hi = p + 1; hipLaunchKernelGGL(fwd, dim3(grid), dim3(NWAVES * 64), LDS_BYTES, stream, a); }
#endif
}
```

```cpp
#include <hip/hip_runtime.h>
#include <cstdio>
#include <cstdint>
#ifndef GDN_NAIVE
#define GDN_NAIVE 0
#endif
#ifndef SB_NAIVE
#define SB_NAIVE 0
#endif
#ifndef MK_ONE_LAUNCH
#define MK_ONE_LAUNCH 1
#endif
namespace pg8 {
#define PG8_LAS __attribute__((address_space(3)))
typedef unsigned short bf16_t;
typedef short bf16x8 __attribute__((ext_vector_type(8)));
typedef float f32x4 __attribute__((ext_vector_type(4)));
typedef unsigned u32x4 __attribute__((ext_vector_type(4)));
constexpr int BM = 256, BK = 64, HALF = 128, HTB = HALF * BK * 2  , STAGE_BYTES = 8 * HTB, NXCD = 8, WGM = 8;

__host__ __device__ __forceinline__ int lds_byte(int r, int c) { const int st = (r >> 4) * 2 + (c >> 5), rr = r & 15, cc = c & 31, ob = rr * 64 + cc * 2; return st * 1024 + (ob ^ (((ob >> 9) & 1) << 5)); }
__host__ __device__ __forceinline__ void stage_rc(int b, int& R, int& C) { const int st = b / 1024, sb = b % 1024, swz = sb ^ (((sb >> 9) & 1) << 5); R = (st >> 1) * 16 + swz / 64; C = (st & 1) * 32 + (swz % 64) / 2; }
__host__ __device__ __forceinline__ int perm32(int rho) { const int n = rho >> 4, i = rho & 15; return 8 * (i >> 2) + 4 * n + (i & 3); }

struct Unit { int pm, pn; };
struct Gemm { const bf16_t* A; const bf16_t* Bt; int lda, K; };

struct StaticOrder {
    int nM, nN, nwg, G, c, rep;
    __host__ __device__ void init(int M, int N, int G_, int c_, int rep_ = 1) { nM = M / BM; nN = N / BM; nwg = nM * nN; G = G_; c = c_; rep = rep_; }
    __host__ __device__ bool next(int i, Unit& u) const {
        const long L = (long)i * G + c; if (L >= (long)rep * nwg) return false;
        int wgid = (int)(L % nwg); { const int q = nwg / NXCD, r = nwg % NXCD, xcd = wgid % NXCD, off = wgid / NXCD; wgid = (xcd < r ? xcd * (q + 1) : r * (q + 1) + (xcd - r) * q) + off; }
        const int nig = WGM * nN, gid = wgid / nig, fm = gid * WGM, gsz = (nM - fm) < WGM ? (nM - fm) : WGM;
        u.pm = fm + ((wgid % nig) % gsz); u.pn = (wgid % nig) / gsz; return true;
    }
    __device__ __forceinline__ void a_ready(const Unit&) const {}
    __device__ __forceinline__ void done(const Unit&) const {}
};

__device__ __forceinline__ unsigned cvt_pk_bf16(float lo, float hi) { unsigned r; asm volatile("v_cvt_pk_bf16_f32 %0, %1, %2" : "=v"(r) : "v"(lo), "v"(hi)); return r; }
struct EpiBf16 {
    static constexpr bool PERM = true, AFTER_DRAIN = false;
    bf16_t* O; int ldc; int nmod;
    __device__ __forceinline__ void operator()(const f32x4 (&acc)[2][2][4][2], const Unit& u, int wr, int wc, int fr, int fq) const {
        const int pnl = nmod ? (u.pn % nmod) : u.pn;
        const int row0 = u.pm * BM + wr * 64 + fr, col0 = pnl * BM + wc * 32 + 8 * fq;
#pragma unroll
        for (int ai = 0; ai < 2; ++ai)
#pragma unroll
            for (int m = 0; m < 4; ++m) { bf16_t* rowp = O + (size_t)(row0 + ai * HALF + m * 16) * ldc + col0;
#pragma unroll
                for (int bj = 0; bj < 2; ++bj) { const f32x4 v0 = acc[ai][bj][m][0], v1 = acc[ai][bj][m][1];
                    u32x4 w; w.x = cvt_pk_bf16(v0[0], v0[1]); w.y = cvt_pk_bf16(v0[2], v0[3]); w.z = cvt_pk_bf16(v1[0], v1[1]); w.w = cvt_pk_bf16(v1[2], v1[3]);
                    *(u32x4*)(rowp + bj * HALF) = w; } }
    }
};
struct EpiInProj {
    static constexpr bool PERM = true, AFTER_DRAIN = false;
    bf16_t* RAW; bf16_t* ZB;
    __device__ __forceinline__ void operator()(const f32x4 (&acc)[2][2][4][2], const Unit& u, int wr, int wc, int fr, int fq) const {
        const bool isz = (u.pn >= 16 && u.pn < 24);
        bf16_t* O = isz ? ZB : RAW; const int ldc = isz ? 2048 : 4352; const int ct = isz ? (u.pn - 16) : (u.pn < 16 ? u.pn : 16);
        const int row0 = u.pm * BM + wr * 64 + fr, col0 = ct * BM + wc * 32 + 8 * fq;
#pragma unroll
        for (int ai = 0; ai < 2; ++ai)
#pragma unroll
            for (int m = 0; m < 4; ++m) { bf16_t* rowp = O + (size_t)(row0 + ai * HALF + m * 16) * ldc + col0;
#pragma unroll
                for (int bj = 0; bj < 2; ++bj) { const f32x4 v0 = acc[ai][bj][m][0], v1 = acc[ai][bj][m][1];
                    u32x4 w; w.x = cvt_pk_bf16(v0[0], v0[1]); w.y = cvt_pk_bf16(v0[2], v0[3]); w.z = cvt_pk_bf16(v1[0], v1[1]); w.w = cvt_pk_bf16(v1[2], v1[3]);
                    *(u32x4*)(rowp + bj * HALF) = w; } }
    }
};
__device__ __forceinline__ float silu_f(float x) { return x * __builtin_amdgcn_rcpf(1.0f + __builtin_amdgcn_exp2f(-1.4426950408889634f * x)); }
struct EpiSwiGLU {
    static constexpr bool PERM = true, AFTER_DRAIN = false;
    bf16_t* O; int ldc; int nmod;
    __device__ __forceinline__ void operator()(const f32x4 (&acc)[2][2][4][2], const Unit& u, int wr, int wc, int fr, int fq) const {
        const int pnl = nmod ? (u.pn % nmod) : u.pn;
        const int row0 = u.pm * BM + wr * 64 + fr, col0 = pnl * HALF + wc * 32 + 8 * fq;
#pragma unroll
        for (int ai = 0; ai < 2; ++ai)
#pragma unroll
            for (int m = 0; m < 4; ++m) { bf16_t* rowp = O + (size_t)(row0 + ai * HALF + m * 16) * ldc + col0;
                const f32x4 g0 = acc[ai][0][m][0], g1 = acc[ai][0][m][1], u0 = acc[ai][1][m][0], u1 = acc[ai][1][m][1];
                u32x4 w;
                w.x = cvt_pk_bf16(silu_f(g0[0]) * u0[0], silu_f(g0[1]) * u0[1]); w.y = cvt_pk_bf16(silu_f(g0[2]) * u0[2], silu_f(g0[3]) * u0[3]);
                w.z = cvt_pk_bf16(silu_f(g1[0]) * u1[0], silu_f(g1[1]) * u1[1]); w.w = cvt_pk_bf16(silu_f(g1[2]) * u1[2], silu_f(g1[3]) * u1[3]);
                *(u32x4*)rowp = w; }
    }
};
template <bool LNR> struct EpiResid {
    static constexpr bool PERM = false, AFTER_DRAIN = false;
    const float* res; float* out; const float* stats; const float* g; const float* b;
    __device__ __forceinline__ void operator()(const f32x4 (&acc)[2][2][4][2], const Unit& u, int wr, int wc, int fr, int fq) const {
        constexpr int ldc = 1024; constexpr float alpha = 1.6817928305074290f;
        const int row0 = u.pm * BM + wr * 64 + fr, col0 = u.pn * BM + wc * 32 + 4 * fq;
        if constexpr (!LNR) {
#pragma unroll
            for (int ai = 0; ai < 2; ++ai)
#pragma unroll
                for (int m = 0; m < 4; ++m) { const size_t off = (size_t)(row0 + ai * HALF + m * 16) * ldc + col0;
#pragma unroll
                    for (int bj = 0; bj < 2; ++bj)
#pragma unroll
                        for (int n = 0; n < 2; ++n) { const f32x4 r = *(const f32x4*)(res + off + bj * HALF + n * 16);
                            *(f32x4*)(out + off + bj * HALF + n * 16) = r * alpha + acc[ai][bj][m][n]; } }
        } else {
#pragma unroll
            for (int bj = 0; bj < 2; ++bj)
#pragma unroll
                for (int n = 0; n < 2; ++n) {
                    const f32x4 gv = *(const f32x4*)(g + col0 + bj * HALF + n * 16) * alpha, bv = *(const f32x4*)(b + col0 + bj * HALF + n * 16) * alpha;
#pragma unroll
                    for (int ai = 0; ai < 2; ++ai)
#pragma unroll
                        for (int m = 0; m < 4; ++m) { const int row = row0 + ai * HALF + m * 16; const size_t off = (size_t)row * ldc + col0 + bj * HALF + n * 16;
                            const float mean = stats[2 * row], rstd = stats[2 * row + 1];
                            const f32x4 r = *(const f32x4*)(res + off);
                            *(f32x4*)(out + off) = (r - mean) * rstd * gv + bv + acc[ai][bj][m][n]; }
                    asm volatile("" ::: "memory");
                }
        }
    }
};
struct MoeOrder {
    int nM, nN, nwg, G, c, rep; int ps1, ps2, ps3, ps4, ps5, ps6, ps7;
    __device__ __forceinline__ bool next(int i, Unit& u) const {
        const long L = (long)i * G + c; if (nwg == 0 || L >= (long)rep * nwg) return false;
        int wgid = (int)(L % nwg); { const int q = nwg / NXCD, r = nwg % NXCD, xcd = wgid % NXCD, off = wgid / NXCD; wgid = (xcd < r ? xcd * (q + 1) : r * (q + 1) + (xcd - r) * q) + off; }
        const int nig = WGM * nN, gid = wgid / nig, fm = gid * WGM, gsz = (nM - fm) < WGM ? (nM - fm) : WGM;
        const int pm = fm + ((wgid % nig) % gsz), pnl = (wgid % nig) / gsz;
        const int e = (pm >= ps1) + (pm >= ps2) + (pm >= ps3) + (pm >= ps4) + (pm >= ps5) + (pm >= ps6) + (pm >= ps7);
        u.pm = pm; u.pn = e * nN + pnl; return true;
    }
    __device__ __forceinline__ void a_ready(const Unit&) const {}
    __device__ __forceinline__ void done(const Unit&) const {}
};
template <class Epi, class Sched, bool ALIGN_EPI = false, bool SP2 = false>
__device__ __forceinline__ void gemm_phase(PG8_LAS unsigned char* lds, const Gemm g, const Sched& S, const Epi& E) {
    const int tid = threadIdx.x, wid = __builtin_amdgcn_readfirstlane(tid >> 6), lane = tid & 63, wr = wid >> 2, wc = wid & 3, fr = lane & 15, fq = lane >> 4;
    const int K = g.K, nt = K / BK;
    unsigned voffA[2], voffB[2];
#pragma unroll
    for (int i = 0; i < 2; ++i) { int R, C; stage_rc(tid * 16 + i * 8192, R, C); const int Rb = Epi::PERM ? ((R & ~31) + perm32(R & 31)) : R;
        voffA[i] = (unsigned)(R * g.lda + C) * 2u; voffB[i] = (unsigned)(Rb * K + C) * 2u; }
    const size_t kstep = (size_t)(BK * 2);
    const size_t hstepA = (size_t)HALF * g.lda * 2, hstepB = (size_t)HALF * K * 2;
    const size_t tstepA = 2 * hstepA, tstepB = 2 * hstepB;
    const unsigned ldsw = (unsigned)wid * 1024u;
    const int aoff = lds_byte(wr * 64 + fr, fq * 8), boff = lds_byte(wc * 32 + fr, fq * 8);
#define PG8_SA(b, h) (((b) * 2 + (h)) * HTB)
#define PG8_SB(b, h) ((4 + (b) * 2 + (h)) * HTB)
#define PG8_STAGE(bufoff, gbase, voff) do { _Pragma("unroll") for (int _i = 0; _i < 2; ++_i) \
        __builtin_amdgcn_global_load_lds((const unsigned*)((const char*)(gbase) + (voff)[_i]), (PG8_LAS unsigned*)(lds + (bufoff) + ldsw + _i * 8192), 16, 0, 0); } while (0)
#define PG8_LDA(dst, b, h) do { _Pragma("unroll") for (int m = 0; m < 4; ++m) _Pragma("unroll") for (int k = 0; k < 2; ++k) dst[m][k] = *(const PG8_LAS bf16x8*)(lds + PG8_SA(b, h) + aoff + m * 2048 + k * 1024); } while (0)
#define PG8_LDB(dst, b, h) do { _Pragma("unroll") for (int n = 0; n < 2; ++n) _Pragma("unroll") for (int k = 0; k < 2; ++k) dst[n][k] = *(const PG8_LAS bf16x8*)(lds + PG8_SB(b, h) + boff + n * 2048 + k * 1024); } while (0)
#define PG8_MMA(ai, bj, At, Bt) do { __builtin_amdgcn_s_setprio(1); _Pragma("unroll") for (int m = 0; m < 4; ++m) _Pragma("unroll") for (int n = 0; n < 2; ++n) _Pragma("unroll") for (int k = 0; k < 2; ++k) \
        acc[ai][bj][m][n] = __builtin_amdgcn_mfma_f32_16x16x32_bf16(Bt[n][k], At[m][k], acc[ai][bj][m][n], 0, 0, 0); __builtin_amdgcn_s_setprio(0); } while (0)
#define PG8_WAIT_V(n) asm volatile("s_waitcnt vmcnt(" #n ")" ::: "memory")
#define PG8_WAIT_L(n) asm volatile("s_waitcnt lgkmcnt(" #n ")" ::: "memory")
#define PG8_BAR __builtin_amdgcn_s_barrier()
#define PG8_SCHED __builtin_amdgcn_sched_barrier(0)
    Unit cur, nxt; int ui = 0;
    if (!S.next(0, cur)) return;
    f32x4 acc[2][2][4][2];
#pragma unroll
    for (int a = 0; a < 2; ++a)
#pragma unroll
        for (int b = 0; b < 2; ++b)
#pragma unroll
            for (int m = 0; m < 4; ++m)
#pragma unroll
                for (int n = 0; n < 2; ++n) acc[a][b][m][n] = (f32x4){0.f, 0.f, 0.f, 0.f};
    bf16x8 At[4][2], B0[2][2], B1[2][2];
    const char* cA = (const char*)g.A + (size_t)cur.pm * tstepA; const char* cB = (const char*)g.Bt + (size_t)cur.pn * tstepB;
    S.a_ready(cur);
    if constexpr (SP2) {
        PG8_STAGE(PG8_SB(0, 0), cB, voffB); PG8_STAGE(PG8_SB(0, 1), cB + hstepB, voffB); PG8_STAGE(PG8_SA(0, 0), cA, voffA); PG8_STAGE(PG8_SA(0, 1), cA + hstepA, voffA);
        if (wr == 1) PG8_BAR;
        PG8_WAIT_V(2); PG8_BAR;
        PG8_STAGE(PG8_SB(1, 0), cB + kstep, voffB); PG8_STAGE(PG8_SA(1, 0), cA + kstep, voffA); PG8_STAGE(PG8_SB(1, 1), cB + hstepB + kstep, voffB);
        PG8_WAIT_V(6); PG8_BAR;
    } else {
        PG8_STAGE(PG8_SB(0, 0), cB, voffB); PG8_STAGE(PG8_SA(0, 0), cA, voffA); PG8_STAGE(PG8_SB(0, 1), cB + hstepB, voffB); PG8_STAGE(PG8_SA(0, 1), cA + hstepA, voffA);
        if (wr == 1) PG8_BAR;
        PG8_WAIT_V(4); PG8_BAR;
        PG8_STAGE(PG8_SB(1, 0), cB + kstep, voffB); PG8_STAGE(PG8_SA(1, 0), cA + kstep, voffA); PG8_STAGE(PG8_SB(1, 1), cB + hstepB + kstep, voffB);
        PG8_WAIT_V(6); PG8_BAR;
    }
    for (;;) {
        const bool has_next = S.next(ui + 1, nxt);
        const char* nA = has_next ? (const char*)g.A + (size_t)nxt.pm * tstepA : cA; const char* nB = has_next ? (const char*)g.Bt + (size_t)nxt.pn * tstepB : cB;
        for (int t = 0; t < nt; t += 2) {
            const bool last = (t == nt - 2);
            const char* a1 = cA + (size_t)(t + 1) * kstep;
            const char* a2 = last ? nA : cA + (size_t)(t + 2) * kstep; const char* b2 = last ? nB : cB + (size_t)(t + 2) * kstep;
            const char* a3 = a2 + kstep; const char* b3 = b2 + kstep;
            if (last && has_next) S.a_ready(nxt);
            if constexpr (SP2) {
            PG8_LDB(B0, 0, 0); PG8_LDB(B1, 0, 1); PG8_SCHED; PG8_LDA(At, 0, 0); PG8_STAGE(PG8_SA(1, 1), a1 + hstepA, voffA);
            PG8_WAIT_V(8); PG8_WAIT_L(0); PG8_BAR; PG8_MMA(0, 0, At, B0); PG8_MMA(0, 1, At, B1); PG8_BAR; PG8_SCHED;
            PG8_LDA(At, 0, 1); PG8_STAGE(PG8_SB(0, 0), b2, voffB); PG8_STAGE(PG8_SB(0, 1), b2 + hstepB, voffB); PG8_STAGE(PG8_SA(0, 0), a2, voffA);
            PG8_WAIT_V(8); PG8_WAIT_L(0); PG8_BAR; PG8_MMA(1, 0, At, B0); PG8_MMA(1, 1, At, B1); PG8_BAR; PG8_SCHED;
            PG8_LDB(B0, 1, 0); PG8_LDB(B1, 1, 1); PG8_SCHED; PG8_LDA(At, 1, 0); PG8_STAGE(PG8_SA(0, 1), a2 + hstepA, voffA);
            PG8_WAIT_V(8); PG8_WAIT_L(0); PG8_BAR; PG8_MMA(0, 0, At, B0); PG8_MMA(0, 1, At, B1); PG8_BAR; PG8_SCHED;
            PG8_LDA(At, 1, 1); PG8_STAGE(PG8_SB(1, 0), b3, voffB); PG8_STAGE(PG8_SB(1, 1), b3 + hstepB, voffB); PG8_STAGE(PG8_SA(1, 0), a3, voffA);
            PG8_WAIT_V(8); PG8_WAIT_L(0); PG8_BAR; PG8_MMA(1, 0, At, B0); PG8_MMA(1, 1, At, B1); PG8_BAR; PG8_SCHED;
            } else {
            PG8_LDB(B0, 0, 0); PG8_SCHED; PG8_LDA(At, 0, 0); PG8_STAGE(PG8_SA(1, 1), a1 + hstepA, voffA);
            PG8_WAIT_L(8); PG8_BAR; PG8_WAIT_L(0); PG8_MMA(0, 0, At, B0); PG8_BAR; PG8_SCHED;
            PG8_LDB(B1, 0, 1); PG8_STAGE(PG8_SB(0, 0), b2, voffB);
            PG8_BAR; PG8_WAIT_L(0); PG8_MMA(0, 1, At, B1); PG8_BAR;
            PG8_LDA(At, 0, 1); PG8_STAGE(PG8_SA(0, 0), a2, voffA);
            PG8_BAR; PG8_WAIT_L(0); PG8_MMA(1, 0, At, B0); PG8_BAR; PG8_SCHED;
            PG8_STAGE(PG8_SB(0, 1), b2 + hstepB, voffB);
            PG8_WAIT_V(6); PG8_BAR; PG8_MMA(1, 1, At, B1); PG8_BAR;
            PG8_LDB(B0, 1, 0); PG8_SCHED; PG8_LDA(At, 1, 0); PG8_STAGE(PG8_SA(0, 1), a2 + hstepA, voffA);
            PG8_WAIT_L(8); PG8_BAR; PG8_WAIT_L(0); PG8_MMA(0, 0, At, B0); PG8_BAR; PG8_SCHED;
            PG8_LDB(B1, 1, 1); PG8_STAGE(PG8_SB(1, 0), b3, voffB);
            PG8_BAR; PG8_WAIT_L(0); PG8_MMA(0, 1, At, B1); PG8_BAR;
            PG8_LDA(At, 1, 1); PG8_STAGE(PG8_SA(1, 0), a3, voffA);
            PG8_BAR; PG8_WAIT_L(0); PG8_MMA(1, 0, At, B0); PG8_BAR; PG8_SCHED;
            PG8_STAGE(PG8_SB(1, 1), b3 + hstepB, voffB);
            PG8_WAIT_V(6); PG8_BAR; PG8_MMA(1, 1, At, B1); PG8_BAR;
            }
        }
        if constexpr (ALIGN_EPI) { if (wr == 0) PG8_BAR; }
        if constexpr (!Epi::AFTER_DRAIN) { E(acc, cur, wr, wc, fr, fq); S.done(cur); }
        if (!has_next) break;
#pragma unroll
        for (int a = 0; a < 2; ++a)
#pragma unroll
            for (int b = 0; b < 2; ++b)
#pragma unroll
                for (int m = 0; m < 4; ++m)
#pragma unroll
                    for (int n = 0; n < 2; ++n) acc[a][b][m][n] = (f32x4){0.f, 0.f, 0.f, 0.f};
        cur = nxt; cA = nA; cB = nB; ++ui;
        if constexpr (ALIGN_EPI) { if (wr == 1) PG8_BAR; }
    }
    PG8_WAIT_V(0);
    if constexpr (!ALIGN_EPI) { if (wr == 0) PG8_BAR; }
    PG8_BAR;
    if constexpr (Epi::AFTER_DRAIN) { E.fused(acc, cur, wr, wc, fr, fq, lds, wid, lane); S.done(cur); }
#undef PG8_SA
#undef PG8_SB
#undef PG8_STAGE
#undef PG8_LDA
#undef PG8_LDB
#undef PG8_MMA
#undef PG8_WAIT_V
#undef PG8_WAIT_L
#undef PG8_BAR
#undef PG8_SCHED
}
}

constexpr int NWAVES = 8;
constexpr int BATCH = 8, SEQ = 4096, TT = BATCH * SEQ, D = 1024;
constexpr int HK = 8, HV = 16, HD = 128;
constexpr int GIN = 6176, GINP = 6400;
constexpr int FF = 3584, NE = 8, MOE_ROWS = 67584;
constexpr float ALPHA = 1.6817928305074290f;
constexpr float LN_EPS = 1e-5f, RMS_EPS = 1e-6f;
constexpr int NPH = 18, NPHASES = 2 * NPH;

constexpr size_t MiB = 1ull << 20;
constexpr size_t WS_CTL = 0, CTL_ZERO_BYTES = 1 * MiB;
constexpr size_t WS_E12 = 1 * MiB;
constexpr size_t WS_G12 = WS_E12 + 256 * 1024;
constexpr size_t WS_POS = WS_G12 + 256 * 1024;
constexpr size_t WS_GB = 2 * MiB;
constexpr size_t WS_W = 16 * MiB;
constexpr size_t WS_W2 = 912 * MiB;
constexpr size_t W_IN = WS_W2, W_OUT = WS_W2 + 13 * MiB, W_GU = WS_W2 + 17 * MiB, W_D = WS_W2 + 31 * MiB;
constexpr size_t W_QKV = WS_W, W_O = WS_W + 6 * MiB, W_MGU = WS_W + 8 * MiB, W_MD = WS_W + 120 * MiB;
constexpr size_t WS_HB = 192 * MiB;
constexpr size_t WS_BIG = 256 * MiB;
constexpr size_t WS_ZB = WS_BIG, WS_RAW = WS_BIG + 128 * MiB, WS_QKVC = WS_BIG + 400 * MiB;
constexpr int RAWLD = 4352;
constexpr size_t WS_WMEM = WS_RAW, WS_IMEM = WS_RAW + 128 * MiB, WS_KTMEM = WS_RAW + 192 * MiB;
constexpr size_t WS_STATS = 12 * MiB;
constexpr size_t WS_GTAB = 6 * MiB;
constexpr size_t WS_ACT = WS_BIG;
constexpr size_t WS_QKV = WS_BIG, WS_AO = WS_BIG + 192 * MiB;
constexpr size_t WS_XS = WS_BIG, WS_MACT = WS_BIG + 132 * MiB;
constexpr size_t WS_END = 950 * MiB;
static_assert(WS_QKVC + (size_t)TT * 4096 * 2 <= WS_W2 && WS_MACT + (size_t)MOE_ROWS * FF * 2 <= WS_END && WS_RAW + (size_t)TT * RAWLD * 2 <= WS_QKVC && WS_KTMEM + (size_t)4096 * 8192 * 2 <= WS_QKVC && WS_GTAB + (size_t)8192 * 192 * 4 <= WS_W, "d_ws map");
static_assert(W_MD + (size_t)NE * D * FF * 2 <= WS_HB && W_IN + (size_t)GINP * D * 2 <= W_OUT && W_D + (size_t)D * FF * 2 <= WS_END && WS_QKVC + (size_t)TT * 4096 * 2 <= WS_W2 && W_MGU + (size_t)NE * 2 * FF * D * 2 <= W_MD, "weight map");
constexpr int CW_BAR = 4096;
constexpr int CW_CNT = 16384;

constexpr int RING_BYTES = 131072;
constexpr int MISC_OFF = RING_BYTES + 320;
constexpr int OGST_OFF = 147456;
constexpr int LDS_BYTES = 163840;

#define GAS __attribute__((address_space(1)))
#define LAS __attribute__((address_space(3)))
#define DI __device__ __forceinline__
typedef unsigned short bf16;
typedef unsigned v4u __attribute__((ext_vector_type(4)));
typedef unsigned v2u __attribute__((ext_vector_type(2)));
typedef float f32x4 __attribute__((ext_vector_type(4)));
typedef float f32x2 __attribute__((ext_vector_type(2)));
typedef GAS unsigned gu32;
#define RLX_AGENT __ATOMIC_RELAXED, __HIP_MEMORY_SCOPE_AGENT
#define LDS_WAIT() asm volatile("s_waitcnt lgkmcnt(0)" ::: "memory")
#define VM_WAIT() asm volatile("s_waitcnt vmcnt(0)" ::: "memory")
__device__ __forceinline__ unsigned long long rt() { return __builtin_amdgcn_s_memrealtime(); }
__device__ __forceinline__ unsigned f2bf(float f) { unsigned u = __builtin_bit_cast(unsigned, f); return (u + 0x7fffu + ((u >> 16) & 1u)) >> 16; }
__device__ __forceinline__ unsigned pk2(float lo, float hi) { return f2bf(lo) | (f2bf(hi) << 16); }

#define XB_TMO      128
#define XB_XCNT(j)  (256  + 64 * (j))
#define XB_XSUB(j)  (1280 + 64 * (j))
#define XB_XGEN(j)  (2304 + 64 * (j))
#define XB_TOP      3328
#define XB_TOPGEN   3392
#define XCD_BAR_WORDS 3456
#define XB_SPIN_CAP (1u << 22)

__device__ __forceinline__ unsigned xb_ld(unsigned* p)              { return __hip_atomic_load(p, __ATOMIC_RELAXED, __HIP_MEMORY_SCOPE_AGENT); }
__device__ __forceinline__ unsigned xb_add(unsigned* p, unsigned v) { return __hip_atomic_fetch_add(p, v, __ATOMIC_RELAXED, __HIP_MEMORY_SCOPE_AGENT); }
__device__ __forceinline__ unsigned xb_xcc_id() { return (unsigned)__builtin_amdgcn_s_getreg((3 << 11) | 20) & 0xFu; }
#define XB_SPIN(cond, bar) do { unsigned _sp = 0; while (cond) { __builtin_amdgcn_s_sleep(1); \
    if ((++_sp & 255u) == 0u) { if (xb_ld(&(bar)[XB_TMO])) break; if (_sp > XB_SPIN_CAP) { atomicAdd(&(bar)[XB_TMO], 1u); break; } } } } while (0)

struct XcdBarrier {
    unsigned* bar; unsigned x;
    volatile LAS unsigned* st;
};

__device__ __forceinline__ XcdBarrier xcd_barrier_post(unsigned* bar, volatile LAS unsigned* st) {
    XcdBarrier b; b.bar = bar; b.x = xb_xcc_id(); b.st = st;
    if (threadIdx.x == 0) (void)xb_add(&bar[XB_XCNT(b.x)], 1u);
    return b;
}
__device__ __forceinline__ void xcd_barrier_complete(unsigned* bar, unsigned x, unsigned& nloc, unsigned& nx) {
    const unsigned G = gridDim.x * gridDim.y * gridDim.z;
    unsigned sum, cnt, mine, sp = 0u;
    for (;;) {
        sum = 0u; cnt = 0u; mine = 0u;
#pragma unroll
        for (unsigned j = 0; j < 16; ++j) { const unsigned c = xb_ld(&bar[XB_XCNT(j)]); sum += c; cnt += (c > 0u) ? 1u : 0u; mine = (j == x) ? c : mine; }
        if (sum == G) break;
        __builtin_amdgcn_s_sleep(1);
        if ((++sp & 255u) == 0u) { if (xb_ld(&bar[XB_TMO])) break; if (sp > XB_SPIN_CAP) { atomicAdd(&bar[XB_TMO], 1u); break; } }
    }
    nloc = mine > 0u ? mine : 1u; nx = cnt > 0u ? cnt : 1u;
}

__device__ __forceinline__ void xcd_barrier(const XcdBarrier& b) {
    asm volatile("s_waitcnt vmcnt(0)" ::: "memory");
    __syncthreads();
    if (threadIdx.x == 0) {
        unsigned* bar = b.bar;
        __builtin_amdgcn_s_waitcnt(0);
        unsigned nloc = b.st[0], nx = b.st[1];
        if (nloc == 0u) { xcd_barrier_complete(bar, b.x, nloc, nx); b.st[0] = nloc; b.st[1] = nx; }
        const unsigned old = xb_add(&bar[XB_XSUB(b.x)], 1u);
        const unsigned gen = old / nloc;
        if (old + 1u == (gen + 1u) * nloc) {
            __builtin_amdgcn_fence(__ATOMIC_RELEASE, "agent");
            asm volatile("s_waitcnt vmcnt(0)" ::: "memory");
            const unsigned og = xb_add(&bar[XB_TOP], 1u);
            const unsigned tg = og / nx;
            if (og + 1u == (tg + 1u) * nx) xb_add(&bar[XB_TOPGEN], 1u);
            else XB_SPIN(xb_ld(&bar[XB_TOPGEN]) == tg, bar);
            __builtin_amdgcn_fence(__ATOMIC_ACQUIRE, "agent");
            xb_add(&bar[XB_XGEN(b.x)], 1u);
            asm volatile("s_waitcnt vmcnt(0)" ::: "memory");
        } else {
            XB_SPIN(xb_ld(&bar[XB_XGEN(b.x)]) == gen, bar);
            __builtin_amdgcn_fence(__ATOMIC_ACQUIRE, "agent");
            asm volatile("s_waitcnt vmcnt(0)" ::: "memory");
        }
    }
    __syncthreads();
}

DI float bf_lo(unsigned w) { return __uint_as_float(w << 16); }
DI float bf_hi(unsigned w) { return __uint_as_float(w & 0xffff0000u); }
DI float wave_sum(float v) {
#pragma unroll
    for (int o = 1; o < 64; o <<= 1) v += __shfl_xor(v, o);
    return v;
}
DI float sigmoid_f(float x) { return 1.0f / (1.0f + __expf(-x)); }

struct Args {
    const float *x, *gdn_w_in, *gdn_conv_w, *gdn_a_log, *gdn_dt_bias, *gdn_norm_w, *gdn_w_out, *sb_w_in, *sb_w_out, *ffn_w_gate, *ffn_w_up, *ffn_w_down,
                *moe_router, *moe_w_gate, *moe_w_up, *moe_w_down, *ln_g, *ln_b;
    float* out; unsigned char* ws; int ph_lo, ph_hi;
};

DI void transpose_item(const float* W, int ldw, bf16* WT, int K, int drow0, int k0, int n0, LAS float* scr, int lane) {
#pragma unroll 8
    for (int i = 0; i < 32; ++i) { const int kk = 2 * i + (lane >> 5); scr[kk * 33 + (lane & 31)] = W[(size_t)(k0 + kk) * ldw + n0 + (lane & 31)]; }
    LDS_WAIT(); asm volatile("" ::: "memory");
    const int c = lane & 7;
#pragma unroll
    for (int jj = 0; jj < 4; ++jj) { const int n = (lane >> 3) + 8 * jj; const LAS float* s = scr + (8 * c) * 33 + n;
        v4u o; o.x = pk2(s[0 * 33], s[1 * 33]); o.y = pk2(s[2 * 33], s[3 * 33]); o.z = pk2(s[4 * 33], s[5 * 33]); o.w = pk2(s[6 * 33], s[7 * 33]);
        *(v4u*)(WT + (size_t)(drow0 + n) * K + k0 + 8 * c) = o; }
    LDS_WAIT(); asm volatile("" ::: "memory");
}

DI void phase_w_gdn(const Args& a, int j, LAS unsigned char* lds, int bid, int G, int tid, int wave, int lane) {
    LAS float* scr = (LAS float*)(lds + wave * 16384);
    const int gw = bid * NWAVES + wave, NGW = G * NWAVES;
    const float* Win = a.gdn_w_in + (size_t)j * D * GIN; const float* Wout = a.gdn_w_out + (size_t)j * 2048 * D;
    const float* Wg = a.ffn_w_gate + (size_t)j * D * FF; const float* Wu = a.ffn_w_up + (size_t)j * D * FF; const float* Wd = a.ffn_w_down + (size_t)j * FF * D;
    bf16* WIN_T = (bf16*)(a.ws + W_IN); bf16* WOUT_T = (bf16*)(a.ws + W_OUT); bf16* WGU_T = (bf16*)(a.ws + W_GU); bf16* WD_T = (bf16*)(a.ws + W_D);
    constexpr int NB_IN = GIN / 32, I_IN = 16 * NB_IN, I_OUT = 32 * 32, I_G = 16 * 112, I_D = 56 * 32, NIT = I_IN + I_OUT + 2 * I_G + I_D;
    for (int it = gw; it < NIT; it += NGW) {
        int r = it;
        if (r < I_IN) { const int kb = r / NB_IN, nb = r % NB_IN; transpose_item(Win, GIN, WIN_T, D, 32 * nb, 64 * kb, 32 * nb, scr, lane); continue; } r -= I_IN;
        if (r < I_OUT) { const int kb = r / 32, nb = r % 32; transpose_item(Wout, D, WOUT_T, 2048, 32 * nb, 64 * kb, 32 * nb, scr, lane); continue; } r -= I_OUT;
        if (r < I_G) { const int kb = r / 112, nb = r % 112, n0 = 32 * nb; transpose_item(Wg, FF, WGU_T, D, 256 * (n0 >> 7) + (n0 & 127), 64 * kb, n0, scr, lane); continue; } r -= I_G;
        if (r < I_G) { const int kb = r / 112, nb = r % 112, n0 = 32 * nb; transpose_item(Wu, FF, WGU_T, D, 256 * (n0 >> 7) + 128 + (n0 & 127), 64 * kb, n0, scr, lane); continue; } r -= I_G;
        { const int kb = r / 32, nb = r % 32; transpose_item(Wd, D, WD_T, FF, 32 * nb, 64 * kb, 32 * nb, scr, lane); }
    }
    if (j == 0) {
        bf16* HB = (bf16*)(a.ws + WS_HB); const f32x4* x4 = (const f32x4*)a.x;
        for (size_t i = (size_t)bid * 512 + tid; i < (size_t)TT * D / 8; i += (size_t)G * 512) { const f32x4 p = x4[2 * i], q = x4[2 * i + 1];
            v4u o; o.x = pk2(p[0], p[1]); o.y = pk2(p[2], p[3]); o.z = pk2(q[0], q[1]); o.w = pk2(q[2], q[3]); *(v4u*)(HB + 8 * i) = o; }
    }
}
DI void phase_w_sb(const Args& a, int j, LAS unsigned char* lds, int bid, int G, int wave, int lane) {
    LAS float* scr = (LAS float*)(lds + wave * 16384);
    const int gw = bid * NWAVES + wave, NGW = G * NWAVES;
    const float* Wqkv = a.sb_w_in + (size_t)j * D * 3072; const float* Wo = a.sb_w_out + (size_t)j * D * D;
    const float* Mg = a.moe_w_gate + (size_t)j * NE * D * FF; const float* Mu = a.moe_w_up + (size_t)j * NE * D * FF; const float* Md = a.moe_w_down + (size_t)j * NE * FF * D;
    bf16* WQKV_T = (bf16*)(a.ws + W_QKV); bf16* WO_T = (bf16*)(a.ws + W_O); bf16* MGU_T = (bf16*)(a.ws + W_MGU); bf16* MD_T = (bf16*)(a.ws + W_MD);
    constexpr int I_QKV = 16 * 96, I_O = 16 * 32, I_G = 16 * 112, I_D = 56 * 32, I_E = 2 * I_G + I_D, NIT = I_QKV + I_O + NE * I_E;
    for (int it = gw; it < NIT; it += NGW) {
        int r = it;
        if (r < I_QKV) { const int kb = r / 96, nb = r % 96; transpose_item(Wqkv, 3072, WQKV_T, D, 32 * nb, 64 * kb, 32 * nb, scr, lane); continue; } r -= I_QKV;
        if (r < I_O) { const int kb = r / 32, nb = r % 32; transpose_item(Wo, D, WO_T, D, 32 * nb, 64 * kb, 32 * nb, scr, lane); continue; } r -= I_O;
        const int e = r / I_E; r -= e * I_E;
        bf16* gu = MGU_T + (size_t)e * 2 * FF * D; bf16* dn = MD_T + (size_t)e * D * FF;
        if (r < I_G) { const int kb = r / 112, nb = r % 112, n0 = 32 * nb; transpose_item(Mg + (size_t)e * D * FF, FF, gu, D, 256 * (n0 >> 7) + (n0 & 127), 64 * kb, n0, scr, lane); continue; } r -= I_G;
        if (r < I_G) { const int kb = r / 112, nb = r % 112, n0 = 32 * nb; transpose_item(Mu + (size_t)e * D * FF, FF, gu, D, 256 * (n0 >> 7) + 128 + (n0 & 127), 64 * kb, n0, scr, lane); continue; } r -= I_G;
        { const int kb = r / 32, nb = r % 32; transpose_item(Md + (size_t)e * FF * D, D, dn, FF, 32 * nb, 64 * kb, 32 * nb, scr, lane); }
    }
}

DI float dpp_sum16(float v) {
    v += __builtin_bit_cast(float, __builtin_amdgcn_update_dpp(0, __builtin_bit_cast(int, v), 0xB1, 0xF, 0xF, false));
    v += __builtin_bit_cast(float, __builtin_amdgcn_update_dpp(0, __builtin_bit_cast(int, v), 0x4E, 0xF, 0xF, false));
    v += __builtin_bit_cast(float, __builtin_amdgcn_update_dpp(0, __builtin_bit_cast(int, v), 0x141, 0xF, 0xF, false));
    v += __builtin_bit_cast(float, __builtin_amdgcn_update_dpp(0, __builtin_bit_cast(int, v), 0x140, 0xF, 0xF, false));
    return v;
}
DI void phase_conv(const Args& a, int j, int bid, int G, int tid) {
    const bf16* raw = (const bf16*)(a.ws + WS_RAW); bf16* qkvc = (bf16*)(a.ws + WS_QKVC); float* gb = (float*)(a.ws + WS_GB);
    const float* cw = a.gdn_conv_w + (size_t)j * 4 * 4096;
    const int ch = 8 * tid;
    float w0[8], w1[8], w2[8], w3[8];
#pragma unroll
    for (int i = 0; i < 8; ++i) { w0[i] = cw[ch + i]; w1[i] = cw[4096 + ch + i]; w2[i] = cw[2 * 4096 + ch + i]; w3[i] = cw[3 * 4096 + ch + i]; }
    const float post = tid < 128 ? 0.08838834764831845f : 1.0f;
    for (int run = bid; run < TT / 128; run += G) {
        const int t0 = run * 128; const bool first = (t0 & (SEQ - 1)) == 0;
        float xa[8], xb[8], xc[8];
        { v4u h0 = {0u, 0u, 0u, 0u}, h1 = h0, h2 = h0;
          if (!first) { h0 = *(const v4u*)(raw + (size_t)(t0 - 3) * RAWLD + ch); h1 = *(const v4u*)(raw + (size_t)(t0 - 2) * RAWLD + ch); h2 = *(const v4u*)(raw + (size_t)(t0 - 1) * RAWLD + ch); }
          xa[0] = bf_lo(h0.x); xa[1] = bf_hi(h0.x); xa[2] = bf_lo(h0.y); xa[3] = bf_hi(h0.y); xa[4] = bf_lo(h0.z); xa[5] = bf_hi(h0.z); xa[6] = bf_lo(h0.w); xa[7] = bf_hi(h0.w);
          xb[0] = bf_lo(h1.x); xb[1] = bf_hi(h1.x); xb[2] = bf_lo(h1.y); xb[3] = bf_hi(h1.y); xb[4] = bf_lo(h1.z); xb[5] = bf_hi(h1.z); xb[6] = bf_lo(h1.w); xb[7] = bf_hi(h1.w);
          xc[0] = bf_lo(h2.x); xc[1] = bf_hi(h2.x); xc[2] = bf_lo(h2.y); xc[3] = bf_hi(h2.y); xc[4] = bf_lo(h2.z); xc[5] = bf_hi(h2.z); xc[6] = bf_lo(h2.w); xc[7] = bf_hi(h2.w); }
#pragma unroll 1
        for (int tb = 0; tb < 128; tb += 8) {
            v4u xr[8];
#pragma unroll
            for (int u = 0; u < 8; ++u) xr[u] = *(const v4u*)(raw + (size_t)(t0 + tb + u) * RAWLD + ch);
#pragma unroll
            for (int u = 0; u < 8; ++u) {
                float xd[8]; xd[0] = bf_lo(xr[u].x); xd[1] = bf_hi(xr[u].x); xd[2] = bf_lo(xr[u].y); xd[3] = bf_hi(xr[u].y); xd[4] = bf_lo(xr[u].z); xd[5] = bf_hi(xr[u].z); xd[6] = bf_lo(xr[u].w); xd[7] = bf_hi(xr[u].w);
                float y[8]; float ss = 0.f;
#pragma unroll
                for (int i = 0; i < 8; ++i) { const float c = w0[i] * xa[i] + w1[i] * xb[i] + w2[i] * xc[i] + w3[i] * xd[i];
                    y[i] = c * __builtin_amdgcn_rcpf(1.0f + __builtin_amdgcn_exp2f(-1.4426950408889634f * c)); ss += y[i] * y[i];
                    xa[i] = xb[i]; xb[i] = xc[i]; xc[i] = xd[i]; }
                if (tid < 256) {
                    const float rn = post / sqrtf(dpp_sum16(ss) + RMS_EPS);
#pragma unroll
                    for (int i = 0; i < 8; ++i) y[i] *= rn;
                }
                v4u o; o.x = pk2(y[0], y[1]); o.y = pk2(y[2], y[3]); o.z = pk2(y[4], y[5]); o.w = pk2(y[6], y[7]);
                *(v4u*)(qkvc + (size_t)(t0 + tb + u) * 4096 + ch) = o;
            }
        }
#pragma unroll
        for (int k = 0; k < 4; ++k) { const int item = tid + 512 * k, tok = t0 + (item >> 4), hv = item & 15;
            const float bb = __uint_as_float((unsigned)raw[(size_t)tok * RAWLD + 4096 + hv] << 16), aa = __uint_as_float((unsigned)raw[(size_t)tok * RAWLD + 4112 + hv] << 16);
            const float xx = aa + a.gdn_dt_bias[j * 16 + hv];
            const float sp = xx > 20.f ? xx : log1pf(__expf(xx));
            gb[(size_t)tok * 32 + hv] = -__expf(a.gdn_a_log[j * 16 + hv]) * sp;
            gb[(size_t)tok * 32 + 16 + hv] = sigmoid_f(bb); }
    }
}

DI void phase_gdn_naive(const Args& a, int j, LAS unsigned char* lds, int bid, int tid) {
    if (bid >= BATCH * HV) return;
    const int b = bid / HV, hv = bid % HV, hk = hv / 2, jc = tid & 127, r = tid >> 7;
    const bf16* zb = (const bf16*)(a.ws + WS_ZB); bf16* qkvc = (bf16*)(a.ws + WS_QKVC); const float* gb = (const float*)(a.ws + WS_GB);
    LAS float* qs = (LAS float*)lds; LAS float* ks = qs + 2048; LAS float* vs = ks + 2048; LAS float* gs = vs + 2048; LAS float* bs = gs + 16;
    LAS f32x2* red = (LAS f32x2*)(lds + 32768); LAS float* redkq = (LAS float*)(lds + 32768 + 8192); LAS float* ob = (LAS float*)(lds + 49152);
    float S[32];
#pragma unroll
    for (int i = 0; i < 32; ++i) S[i] = 0.f;
    const int lrow = tid >> 5, lcol = (tid & 31) * 4;
    for (int blk = 0; blk < SEQ / 16; ++blk) {
        const size_t t0 = (size_t)b * SEQ + blk * 16;
        __syncthreads();
        { const bf16* rowp = qkvc + (t0 + lrow) * 4096;
          const v2u qv = *(const v2u*)(rowp + hk * 128 + lcol), kv = *(const v2u*)(rowp + 1024 + hk * 128 + lcol), vv = *(const v2u*)(rowp + 2048 + hv * 128 + lcol);
          *(LAS f32x4*)(qs + lrow * 128 + lcol) = (f32x4){bf_lo(qv.x), bf_hi(qv.x), bf_lo(qv.y), bf_hi(qv.y)};
          *(LAS f32x4*)(ks + lrow * 128 + lcol) = (f32x4){bf_lo(kv.x), bf_hi(kv.x), bf_lo(kv.y), bf_hi(kv.y)};
          *(LAS f32x4*)(vs + lrow * 128 + lcol) = (f32x4){bf_lo(vv.x), bf_hi(vv.x), bf_lo(vv.y), bf_hi(vv.y)};
          if (tid < 16) { gs[tid] = __expf(gb[(t0 + tid) * 32 + hv]); bs[tid] = gb[(t0 + tid) * 32 + 16 + hv]; } }
        __syncthreads();
#pragma unroll 1
        for (int tt = 0; tt < 16; ++tt) {
            float pk = 0.f, pq = 0.f, pkq = 0.f;
#pragma unroll
            for (int i4 = 0; i4 < 8; ++i4) { const f32x4 k4 = *(const LAS f32x4*)(ks + tt * 128 + 32 * r + 4 * i4), q4 = *(const LAS f32x4*)(qs + tt * 128 + 32 * r + 4 * i4);
#pragma unroll
                for (int c = 0; c < 4; ++c) { pk += k4[c] * S[4 * i4 + c]; pq += q4[c] * S[4 * i4 + c]; pkq += k4[c] * q4[c]; } }
            const int buf = tt & 1;
            red[(buf * 4 + r) * 128 + jc] = (f32x2){pk, pq}; if (jc == 0) redkq[buf * 4 + r] = pkq;
            __syncthreads();
            float kS = 0.f, qS = 0.f, kq = 0.f;
#pragma unroll
            for (int rr = 0; rr < 4; ++rr) { const f32x2 p = red[(buf * 4 + rr) * 128 + jc]; kS += p.x; qS += p.y; kq += redkq[buf * 4 + rr]; }
            const float eg = gs[tt], vn = bs[tt] * (vs[tt * 128 + jc] - eg * kS);
#pragma unroll
            for (int i4 = 0; i4 < 8; ++i4) { const f32x4 k4 = *(const LAS f32x4*)(ks + tt * 128 + 32 * r + 4 * i4);
#pragma unroll
                for (int c = 0; c < 4; ++c) S[4 * i4 + c] = eg * S[4 * i4 + c] + k4[c] * vn; }
            if (r == 0) ob[tt * 128 + jc] = eg * qS + kq * vn;
        }
        __syncthreads();
        {
            const f32x4 o4 = *(const LAS f32x4*)(ob + lrow * 128 + lcol);
            float ss = o4[0] * o4[0] + o4[1] * o4[1] + o4[2] * o4[2] + o4[3] * o4[3];
            ss += __shfl_xor(ss, 1); ss += __shfl_xor(ss, 2); ss += __shfl_xor(ss, 4); ss += __shfl_xor(ss, 8); ss += __shfl_xor(ss, 16);
            const float rinv = 1.0f / sqrtf(ss * (1.0f / 128.0f) + RMS_EPS);
            const v2u zv = *(const v2u*)(zb + (t0 + lrow) * 2048 + hv * 128 + lcol);
            const f32x4 nw = *(const f32x4*)(a.gdn_norm_w + j * 128 + lcol);
            const float z0 = bf_lo(zv.x), z1 = bf_hi(zv.x), z2 = bf_lo(zv.y), z3 = bf_hi(zv.y);
            v2u o; o.x = pk2(o4[0] * rinv * nw[0] * z0 * sigmoid_f(z0), o4[1] * rinv * nw[1] * z1 * sigmoid_f(z1));
            o.y = pk2(o4[2] * rinv * nw[2] * z2 * sigmoid_f(z2), o4[3] * rinv * nw[3] * z3 * sigmoid_f(z3));
            *(v2u*)(qkvc + (t0 + lrow) * 4096 + 2048 + hv * 128 + lcol) = o;
        }
    }
}

template <bool ROUTER>
DI void phase_ln(const Args& a, int lnidx, int j, LAS unsigned char* lds, int bid, int G, int tid, int wave, int lane) {
    const float* out = a.out; bf16* HB = (bf16*)(a.ws + WS_HB); float* stats = (float*)(a.ws + WS_STATS);
    const float* g = a.ln_g + (size_t)lnidx * D; const float* bta = a.ln_b + (size_t)lnidx * D;
    const int gw = bid * NWAVES + wave, NGW = G * NWAVES;
    LAS unsigned* lcnt = (LAS unsigned*)lds;
    if (ROUTER) { if (tid < 8) lcnt[tid] = 0u; __syncthreads(); }
    f32x4 gv[4], bv[4];
#pragma unroll
    for (int q = 0; q < 4; ++q) { gv[q] = *(const f32x4*)(g + 4 * (lane + 64 * q)); bv[q] = *(const f32x4*)(bta + 4 * (lane + 64 * q)); }
    f32x4 nx[4];
    if (gw < TT) {
#pragma unroll
        for (int q = 0; q < 4; ++q) nx[q] = ((const f32x4*)(out + (size_t)gw * D))[lane + 64 * q]; }
    for (int t = gw; t < TT; t += NGW) {
        f32x4 v[4]; float s = 0.f;
#pragma unroll
        for (int q = 0; q < 4; ++q) { v[q] = nx[q]; s += (v[q][0] + v[q][1]) + (v[q][2] + v[q][3]); }
        if (t + NGW < TT) {
#pragma unroll
            for (int q = 0; q < 4; ++q) nx[q] = ((const f32x4*)(out + (size_t)(t + NGW) * D))[lane + 64 * q]; }
        const float mean = wave_sum(s) * (1.0f / D); float s2 = 0.f;
#pragma unroll
        for (int q = 0; q < 4; ++q) { v[q] = v[q] - mean; s2 += (v[q][0] * v[q][0] + v[q][1] * v[q][1]) + (v[q][2] * v[q][2] + v[q][3] * v[q][3]); }
        const float rstd = 1.0f / sqrtf(wave_sum(s2) * (1.0f / D) + LN_EPS);
        if (lane == 0) *(f32x2*)(stats + 2 * (size_t)t) = (f32x2){mean, rstd};
#pragma unroll
        for (int q = 0; q < 4; ++q) { v[q] = v[q] * rstd * gv[q] + bv[q];
            v2u o; o.x = pk2(v[q][0], v[q][1]); o.y = pk2(v[q][2], v[q][3]); *(v2u*)(HB + (size_t)t * D + 4 * (lane + 64 * q)) = o; }
        if (ROUTER) {
            const float* R = a.moe_router + (size_t)j * D * NE;
            float lg[8];
#pragma unroll
            for (int e = 0; e < 8; ++e) lg[e] = 0.f;
#pragma unroll
            for (int q = 0; q < 4; ++q)
#pragma unroll
                for (int c = 0; c < 4; ++c) { const int k = 4 * (lane + 64 * q) + c; const f32x4 r0 = *(const f32x4*)(R + k * 8), r1 = *(const f32x4*)(R + k * 8 + 4); const float hv = v[q][c];
                    lg[0] += hv * r0[0]; lg[1] += hv * r0[1]; lg[2] += hv * r0[2]; lg[3] += hv * r0[3]; lg[4] += hv * r1[0]; lg[5] += hv * r1[1]; lg[6] += hv * r1[2]; lg[7] += hv * r1[3]; }
#pragma unroll
            for (int e = 0; e < 8; ++e) lg[e] = wave_sum(lg[e]);
            int i1 = 0; float v1 = lg[0];
#pragma unroll
            for (int e = 1; e < 8; ++e) if (lg[e] > v1) { v1 = lg[e]; i1 = e; }
            int i2 = -1; float v2 = -3.0e38f;
#pragma unroll
            for (int e = 0; e < 8; ++e) if (e != i1 && lg[e] > v2) { v2 = lg[e]; i2 = e; }
            if (lane == 0) {
                const float g1 = 1.0f / (1.0f + __expf(v2 - v1));
                ((unsigned*)(a.ws + WS_E12))[t] = (unsigned)i1 | ((unsigned)i2 << 8);
                ((f32x2*)(a.ws + WS_G12))[t] = (f32x2){g1, 1.0f - g1};
                __hip_atomic_fetch_add(lcnt + i1, 1u, __ATOMIC_RELAXED, __HIP_MEMORY_SCOPE_WORKGROUP); __hip_atomic_fetch_add(lcnt + i2, 1u, __ATOMIC_RELAXED, __HIP_MEMORY_SCOPE_WORKGROUP);
            }
        }
    }
    if (ROUTER) { __syncthreads(); if (tid < 8) { unsigned* cnt = (unsigned*)(a.ws + WS_CTL) + CW_CNT + 256 * j; __hip_atomic_fetch_add(cnt + tid, lcnt[tid], __ATOMIC_RELAXED, __HIP_MEMORY_SCOPE_AGENT); } }
}

DI void phase_sb_naive(const Args& a, LAS unsigned char* lds, int bid, int G, int tid) {
    const bf16* qkv = (const bf16*)(a.ws + WS_QKV); bf16* ao = (bf16*)(a.ws + WS_AO);
    LAS unsigned char* Ks = lds; LAS unsigned char* Vs = lds + 16384;
    const int qi = tid >> 2, r = tid & 3;
    for (int idx = bid; idx < 64 * 32; idx += G) {
        const int qb = 31 - idx / 64, bh = idx % 64, b = bh >> 3, h = bh & 7;
        const int t = qb * 128 + qi;
        const size_t rowq = (size_t)b * SEQ + t;
        float q[32], o[32];
        { const bf16* qp = qkv + rowq * 3072 + h * 128 + 32 * r;
#pragma unroll
          for (int c = 0; c < 4; ++c) { const v4u w = *(const v4u*)(qp + 8 * c);
              q[8 * c + 0] = bf_lo(w.x); q[8 * c + 1] = bf_hi(w.x); q[8 * c + 2] = bf_lo(w.y); q[8 * c + 3] = bf_hi(w.y);
              q[8 * c + 4] = bf_lo(w.z); q[8 * c + 5] = bf_hi(w.z); q[8 * c + 6] = bf_lo(w.w); q[8 * c + 7] = bf_hi(w.w); }
#pragma unroll
          for (int i = 0; i < 32; ++i) { q[i] *= 0.08838834764831845f; o[i] = 0.f; } }
        float P = 1.0f;
        for (int kt = 2 * qb + 1; kt >= 0; --kt) {
            __syncthreads();
#pragma unroll
            for (int i = 0; i < 2; ++i) { const int c = tid + 512 * i, row = c >> 4, part = c & 15;
                const bf16* src = qkv + ((size_t)b * SEQ + kt * 64 + row) * 3072 + h * 128 + part * 8;
                *(LAS v4u*)(Ks + c * 16) = *(const v4u*)(src + 1024); *(LAS v4u*)(Vs + c * 16) = *(const v4u*)(src + 2048); }
            __syncthreads();
#pragma unroll 1
            for (int s = 63; s >= 0; --s) {
                float z = 0.f;
#pragma unroll
                for (int c = 0; c < 4; ++c) { const v4u w = *(const LAS v4u*)(Ks + s * 256 + r * 64 + c * 16);
                    z += q[8 * c + 0] * bf_lo(w.x) + q[8 * c + 1] * bf_hi(w.x) + q[8 * c + 2] * bf_lo(w.y) + q[8 * c + 3] * bf_hi(w.y)
                       + q[8 * c + 4] * bf_lo(w.z) + q[8 * c + 5] * bf_hi(w.z) + q[8 * c + 6] * bf_lo(w.w) + q[8 * c + 7] * bf_hi(w.w); }
                z += __shfl_xor(z, 1); z += __shfl_xor(z, 2);
                const bool live = (kt * 64 + s) < t;
                const float e = __expf(fminf(z, 80.f)), rr = 1.0f / (1.0f + e);
                const float A = live ? e * rr * P : 0.f;
                P = live ? P * rr : P;
#pragma unroll
                for (int c = 0; c < 4; ++c) { const v4u w = *(const LAS v4u*)(Vs + s * 256 + r * 64 + c * 16);
                    o[8 * c + 0] += A * bf_lo(w.x); o[8 * c + 1] += A * bf_hi(w.x); o[8 * c + 2] += A * bf_lo(w.y); o[8 * c + 3] += A * bf_hi(w.y);
                    o[8 * c + 4] += A * bf_lo(w.z); o[8 * c + 5] += A * bf_hi(w.z); o[8 * c + 6] += A * bf_lo(w.w); o[8 * c + 7] += A * bf_hi(w.w); }
            }
        }
        { bf16* op = ao + rowq * 1024 + h * 128 + 32 * r;
#pragma unroll
          for (int c = 0; c < 4; ++c) { v4u w; w.x = pk2(o[8 * c + 0], o[8 * c + 1]); w.y = pk2(o[8 * c + 2], o[8 * c + 3]); w.z = pk2(o[8 * c + 4], o[8 * c + 5]); w.w = pk2(o[8 * c + 6], o[8 * c + 7]);
              *(v4u*)(op + 8 * c) = w; } }
    }
}


namespace sba {
using bf16x8 = __attribute__((ext_vector_type(8))) short;
using s16x4  = __attribute__((ext_vector_type(4))) short;
using f32x16 = __attribute__((ext_vector_type(16))) float;
constexpr int SHM_V = 16384, SHM_K = 16384, LDQ = 3072;
#define KSWZ(row, colB) ((row) * 256 + ((colB) ^ (((row) & 7) << 4)))
#define SBAR() __builtin_amdgcn_sched_barrier(0)
DI int crow(int r, int hi) { return (r & 3) + 8 * (r >> 2) + 4 * hi; }
DI int v_st(int k, int c) { const int kk = (k & ~0xC) | ((k & 4) << 1) | ((k & 8) >> 1); return ((kk >> 3) * 4 + (c >> 5)) * 512 + ((kk & 7) * 32 + (c & 31)) * 2; }
DI int v_rd_base(int lane) { return ((lane & 3) << 3) | (((lane >> 2) & 3) << 6) | (((lane >> 4) & 1) << 5) | (((lane >> 5) & 1) << 8); }
constexpr int v_rd_off(int d0, int ks, int half) { return d0 * 512 + ks * 4096 + half * 2048; }
template <int OFF> DI s16x4 tr_read(int vb) { s16x4 r; asm volatile("ds_read_b64_tr_b16 %0, %1 offset:%2" : "=&v"(r) : "v"(vb), "i"(OFF) : "memory"); return r; }
template <int D0> DI void pv_one(f32x16& od, int vb, bf16x8 pa0, bf16x8 pa1, bf16x8 pa2, bf16x8 pa3) {
  const s16x4 l0 = tr_read<v_rd_off(D0, 0, 0)>(vb), h0 = tr_read<v_rd_off(D0, 0, 1)>(vb), l1 = tr_read<v_rd_off(D0, 1, 0)>(vb), h1 = tr_read<v_rd_off(D0, 1, 1)>(vb);
  const s16x4 l2 = tr_read<v_rd_off(D0, 2, 0)>(vb), h2 = tr_read<v_rd_off(D0, 2, 1)>(vb), l3 = tr_read<v_rd_off(D0, 3, 0)>(vb), h3 = tr_read<v_rd_off(D0, 3, 1)>(vb);
  asm volatile("s_waitcnt lgkmcnt(0)" ::: "memory"); SBAR();
#define PK(L, H) (bf16x8){L[0], L[1], L[2], L[3], H[0], H[1], H[2], H[3]}
  od = __builtin_amdgcn_mfma_f32_32x32x16_bf16(pa0, PK(l0, h0), od, 0, 0, 0);
  od = __builtin_amdgcn_mfma_f32_32x32x16_bf16(pa1, PK(l1, h1), od, 0, 0, 0);
  od = __builtin_amdgcn_mfma_f32_32x32x16_bf16(pa2, PK(l2, h2), od, 0, 0, 0);
  od = __builtin_amdgcn_mfma_f32_32x32x16_bf16(pa3, PK(l3, h3), od, 0, 0, 0);
#undef PK
}
template <int D0> DI void pv_one_T(f32x16& od, int vb, bf16x8 pa0, bf16x8 pa1, bf16x8 pa2, bf16x8 pa3) {
  const s16x4 l0 = tr_read<v_rd_off(D0, 0, 0)>(vb), h0 = tr_read<v_rd_off(D0, 0, 1)>(vb), l1 = tr_read<v_rd_off(D0, 1, 0)>(vb), h1 = tr_read<v_rd_off(D0, 1, 1)>(vb);
  const s16x4 l2 = tr_read<v_rd_off(D0, 2, 0)>(vb), h2 = tr_read<v_rd_off(D0, 2, 1)>(vb), l3 = tr_read<v_rd_off(D0, 3, 0)>(vb), h3 = tr_read<v_rd_off(D0, 3, 1)>(vb);
  asm volatile("s_waitcnt lgkmcnt(0)" ::: "memory"); SBAR();
#define PK(L, H) (bf16x8){L[0], L[1], L[2], L[3], H[0], H[1], H[2], H[3]}
  od = __builtin_amdgcn_mfma_f32_32x32x16_bf16(PK(l0, h0), pa0, od, 0, 0, 0);
  od = __builtin_amdgcn_mfma_f32_32x32x16_bf16(PK(l1, h1), pa1, od, 0, 0, 0);
  od = __builtin_amdgcn_mfma_f32_32x32x16_bf16(PK(l2, h2), pa2, od, 0, 0, 0);
  od = __builtin_amdgcn_mfma_f32_32x32x16_bf16(PK(l3, h3), pa3, od, 0, 0, 0);
#undef PK
}
DI void qkt(f32x16& p0, f32x16& p1, const LAS unsigned char* Ks, const bf16x8 (&qr)[8], int r32, int hi) {
  p0 = f32x16{}; p1 = f32x16{};
#pragma unroll
  for (int d0 = 0; d0 < 8; ++d0) { const int cb = (d0 * 16 + hi * 8) * 2;
    const bf16x8 b0 = *(const LAS bf16x8*)(Ks + KSWZ(r32, cb));
    const bf16x8 b1 = *(const LAS bf16x8*)(Ks + KSWZ(32 + r32, cb));
    p0 = __builtin_amdgcn_mfma_f32_32x32x16_bf16(b0, qr[d0], p0, 0, 0, 0);
    p1 = __builtin_amdgcn_mfma_f32_32x32x16_bf16(b1, qr[d0], p1, 0, 0, 0); }
}
template <bool MASK> DI void sb_half(f32x16& p, float& Pc, int hi, int kbase, int trow) {
  constexpr float C = 0.08838834764831845f * 1.4426950408889634f;
  float rr[16];
#pragma unroll
  for (int r = 0; r < 16; ++r) {
    float z = p[r] * C;
    if (MASK) z = (kbase + crow(r, hi) < trow) ? z : -__builtin_inff();
    const float k = __builtin_amdgcn_rcpf(1.0f + __builtin_amdgcn_exp2f(z));
    rr[r] = k; p[r] = 1.0f - k;
  }
  float R0[4], R1[4];
#pragma unroll
  for (int g = 0; g < 4; ++g) {
    const float c2 = rr[4 * g + 3], c1 = c2 * rr[4 * g + 2], c0 = c1 * rr[4 * g + 1], R = c0 * rr[4 * g];
    rr[4 * g + 2] = c2; rr[4 * g + 1] = c1; rr[4 * g] = c0;
    const auto sw = __builtin_amdgcn_permlane32_swap(__float_as_uint(R), __float_as_uint(R), false, false);
    R0[g] = __uint_as_float(sw[0]); R1[g] = __uint_as_float(sw[1]);
  }
#pragma unroll
  for (int g = 3; g >= 0; --g) {
    const float Pin = hi ? Pc : Pc * R1[g];
    p[4 * g + 3] *= Pin; p[4 * g + 2] *= Pin * rr[4 * g + 2]; p[4 * g + 1] *= Pin * rr[4 * g + 1]; p[4 * g] *= Pin * rr[4 * g];
    Pc *= R0[g] * R1[g];
  }
}
DI unsigned cvtpk(float lo, float hi) { unsigned r; asm volatile("v_cvt_pk_bf16_f32 %0, %1, %2" : "=v"(r) : "v"(lo), "v"(hi)); return r; }
#define PK4(P, BASE, OUT) do { const unsigned a0 = cvtpk(P[BASE + 0], P[BASE + 1]), a1 = cvtpk(P[BASE + 2], P[BASE + 3]);   \
    const unsigned b0 = cvtpk(P[BASE + 4], P[BASE + 5]), b1 = cvtpk(P[BASE + 6], P[BASE + 7]);                              \
    const auto r0 = __builtin_amdgcn_permlane32_swap(a0, b0, false, false); const auto r1 = __builtin_amdgcn_permlane32_swap(a1, b1, false, false); \
    const v4u w = {r0[0], r1[0], r0[1], r1[1]}; OUT = __builtin_bit_cast(bf16x8, w); } while (0)

DI void unit(const bf16* qkv, bf16* ao, int b, int h, int qb, LAS unsigned char* lds, int tid) {
  const int wid = __builtin_amdgcn_readfirstlane(tid >> 6), lane = tid & 63, r32 = lane & 31, hi = lane >> 5;
  LAS unsigned char* V_lds = lds; LAS unsigned char* K_lds = lds + 2 * SHM_V;
  const size_t rowbase = (size_t)b * SEQ; const int q0 = qb * 256, t_lo = q0 + wid * 32, trow = t_lo + r32;
  bf16x8 qr[8];
  { const bf16* Qw = qkv + (rowbase + trow) * LDQ + h * 128 + hi * 8;
#pragma unroll
    for (int d0 = 0; d0 < 8; ++d0) qr[d0] = *(const bf16x8*)(Qw + d0 * 16); }
  const bf16* Kh = qkv + rowbase * LDQ + 1024 + h * 128; const bf16* Vh = Kh + 1024;
  const int sr = tid >> 4, sc = (tid & 15) * 8, vst0 = v_st(sr, sc), vst1 = v_st(32 + sr, sc);
  const int vb0 = (int)(unsigned)(size_t)V_lds + v_rd_base(lane);
  bf16x8 vs0, vs1, ks0, ks1;
#define SLOAD(k0) do { vs0 = *(const bf16x8*)(Vh + (size_t)((k0) + sr) * LDQ + sc); vs1 = *(const bf16x8*)(Vh + (size_t)((k0) + 32 + sr) * LDQ + sc); \
    ks0 = *(const bf16x8*)(Kh + (size_t)((k0) + sr) * LDQ + sc); ks1 = *(const bf16x8*)(Kh + (size_t)((k0) + 32 + sr) * LDQ + sc); } while (0)
#define SWRITE(bb) do { *(LAS bf16x8*)(V_lds + (bb) * SHM_V + vst0) = vs0; *(LAS bf16x8*)(V_lds + (bb) * SHM_V + vst1) = vs1; const int kc = sc * 2; \
    *(LAS bf16x8*)(K_lds + (bb) * SHM_K + KSWZ(sr, kc)) = ks0; *(LAS bf16x8*)(K_lds + (bb) * SHM_K + KSWZ(32 + sr, kc)) = ks1; } while (0)
  f32x16 o[4] = {}; float Pc = 1.0f;
  const int kt_max = qb * 4 + 3;
  SLOAD(kt_max * 64);
  for (int kt = kt_max; kt >= 0; --kt) {
    const int buf = kt & 1, k0 = kt * 64;
    asm volatile("s_waitcnt vmcnt(0)" ::: "memory");
    SWRITE(buf);
    if (kt > 0) SLOAD(k0 - 64);
    __syncthreads();
    if (k0 < t_lo + 31) {
      f32x16 p0, p1;
      qkt(p0, p1, K_lds + buf * SHM_K, qr, r32, hi);
      if (k0 + 63 >= t_lo) { sb_half<true>(p1, Pc, hi, k0 + 32, trow); sb_half<true>(p0, Pc, hi, k0, trow); }
      else { sb_half<false>(p1, Pc, hi, k0 + 32, trow); sb_half<false>(p0, Pc, hi, k0, trow); }
      bf16x8 pa0, pa1, pa2, pa3;
      PK4(p0, 0, pa0); PK4(p0, 8, pa1); PK4(p1, 0, pa2); PK4(p1, 8, pa3);
      const int vb = vb0 + buf * SHM_V;
      pv_one<0>(o[0], vb, pa0, pa1, pa2, pa3); pv_one<1>(o[1], vb, pa0, pa1, pa2, pa3); pv_one<2>(o[2], vb, pa0, pa1, pa2, pa3); pv_one<3>(o[3], vb, pa0, pa1, pa2, pa3);
    }
  }
  bf16* Ow = ao + (rowbase + t_lo) * 1024 + h * 128 + r32;
#pragma unroll
  for (int r = 0; r < 16; ++r) { const int orow = crow(r, hi);
#pragma unroll
    for (int d0 = 0; d0 < 4; ++d0) Ow[(size_t)orow * 1024 + d0 * 32] = (bf16)(cvtpk(o[d0][r], 0.f) & 0xffffu); }
#undef SLOAD
#undef SWRITE
}
#undef PK4
#undef KSWZ
#undef SBAR
}
DI void phase_sb_mfma(const Args& a, LAS unsigned char* lds, int bid, int G, int tid) {
    const bf16* qkv = (const bf16*)(a.ws + WS_QKV); bf16* ao = (bf16*)(a.ws + WS_AO);
    const int vcu = (G % 8 == 0) ? (bid % 8) * (G / 8) + bid / 8 : bid;
    for (int pi = vcu; pi < 512; pi += G) {
        const int bh = pi >> 3, p = pi & 7, b = bh >> 3, h = bh & 7;
        sba::unit(qkv, ao, b, h, 15 - p, lds, tid);
        sba::unit(qkv, ao, b, h, p, lds, tid);
    }
}


namespace gdn {
using bf16x8 = __attribute__((ext_vector_type(8))) short;
using s16x4  = __attribute__((ext_vector_type(4))) short;
using f32x16 = __attribute__((ext_vector_type(16))) float;
typedef float f2v __attribute__((ext_vector_type(2)));
typedef __bf16 b2v __attribute__((ext_vector_type(2)));
DI unsigned pk(float a, float b) { const f2v v = {a, b}; const b2v r = __builtin_convertvector(v, b2v); return __builtin_bit_cast(unsigned, r); }
DI int crow(int r, int hi) { return (r & 3) + 8 * (r >> 2) + 4 * hi; }
DI int pi_slot(int x) { return 8 * ((x >> 2) & 3) + 4 * ((x >> 4) & 1) + (x & 3); }
DI bf16x8 pack_step(const f32x16& x, int s) {
    v4u w; w.x = pk(x[8 * s + 0], x[8 * s + 1]); w.y = pk(x[8 * s + 2], x[8 * s + 3]); w.z = pk(x[8 * s + 4], x[8 * s + 5]); w.w = pk(x[8 * s + 6], x[8 * s + 7]);
    return __builtin_bit_cast(bf16x8, w);
}
DI f32x16 mm(const f32x16& P, const f32x16& Q, f32x16 acc) {
    acc = __builtin_amdgcn_mfma_f32_32x32x16_bf16(pack_step(P, 0), pack_step(Q, 0), acc, 0, 0, 0);
    acc = __builtin_amdgcn_mfma_f32_32x32x16_bf16(pack_step(P, 1), pack_step(Q, 1), acc, 0, 0, 0);
    return acc;
}
#define GPK4(P, BASE, OUT) do { const unsigned a0 = pk(P[BASE + 0], P[BASE + 1]), a1 = pk(P[BASE + 2], P[BASE + 3]);   \
    const unsigned b0 = pk(P[BASE + 4], P[BASE + 5]), b1 = pk(P[BASE + 6], P[BASE + 7]);                              \
    const auto r0 = __builtin_amdgcn_permlane32_swap(a0, b0, false, false); const auto r1 = __builtin_amdgcn_permlane32_swap(a1, b1, false, false); \
    const v4u w_ = {r0[0], r1[0], r0[1], r1[1]}; OUT = __builtin_bit_cast(bf16x8, w_); } while (0)

DI void local_unit(const Args& a, int unit, LAS unsigned char* img, LAS float* tab, int lane, bool dry) {
    const int r32 = lane & 31, hi = lane >> 5;
    const int chunk = unit & 63, bh = unit >> 6, hv = bh & 15, b = bh >> 4, hk = hv >> 1;
    const size_t t0 = (size_t)b * SEQ + chunk * 64;
    bf16* qkvc = (bf16*)(a.ws + WS_QKVC); const float* gb = (const float*)(a.ws + WS_GB);
    bf16* wmem = (bf16*)(a.ws + WS_WMEM) + (size_t)unit * 8192; bf16* imem = (bf16*)(a.ws + WS_IMEM) + (size_t)unit * 4096;
    bf16* ktmem = (bf16*)(a.ws + WS_KTMEM) + (size_t)((b * HK + hk) * 64 + chunk) * 8192; float* gtab = (float*)(a.ws + WS_GTAB) + (size_t)unit * 192;
    float gc = gb[(t0 + lane) * 32 + hv]; const float be = gb[(t0 + lane) * 32 + 16 + hv];
#pragma unroll
    for (int off = 1; off < 64; off <<= 1) { const float y = __shfl_up(gc, off); if (lane >= off) gc += y; }
    const float glast = __shfl(gc, 63);
    tab[lane] = gc; tab[64 + lane] = be; tab[128 + lane] = -be * __expf(gc);
    gtab[lane] = __expf(gc); gtab[64 + lane] = __expf(glast - gc); if (lane == 0) gtab[128] = __expf(glast);
    const bf16* kbase = qkvc + t0 * 4096 + 1024 + hk * 128; const bf16* qbase = qkvc + t0 * 4096 + hk * 128; bf16* vbase = qkvc + t0 * 4096 + 2048 + hv * 128;
#define GSB() __builtin_amdgcn_sched_barrier(0)
    {
        f32x16 IT00 = {}, IT11 = {}, IT01 = {};
#pragma unroll
        for (int s = 0; s < 8; ++s) {
            const bf16x8 k0 = *(const bf16x8*)(kbase + (size_t)r32 * 4096 + 16 * s + 8 * hi), k1 = *(const bf16x8*)(kbase + (size_t)(32 + r32) * 4096 + 16 * s + 8 * hi);
            const bf16x8 q0 = *(const bf16x8*)(qbase + (size_t)r32 * 4096 + 16 * s + 8 * hi), q1 = *(const bf16x8*)(qbase + (size_t)(32 + r32) * 4096 + 16 * s + 8 * hi);
            IT00 = __builtin_amdgcn_mfma_f32_32x32x16_bf16(k0, q0, IT00, 0, 0, 0); IT11 = __builtin_amdgcn_mfma_f32_32x32x16_bf16(k1, q1, IT11, 0, 0, 0);
            IT01 = __builtin_amdgcn_mfma_f32_32x32x16_bf16(k0, q1, IT01, 0, 0, 0);
        }
#pragma unroll
        for (int I = 0; I < 2; ++I) { const int c = 32 * I + r32; const float gcc = tab[c];
#pragma unroll
            for (int J = 0; J < 2; ++J)
#pragma unroll
                for (int g = 0; g < 4; ++g) { float v[4];
#pragma unroll
                    for (int i = 0; i < 4; ++i) { const int r = 4 * g + i, cp = 32 * J + crow(r, hi);
                        const float raw = (I == 0) ? (J == 0 ? IT00[r] : 0.f) : (J == 0 ? IT01[r] : IT11[r]);
                        const float val = raw * __expf(-fabsf(gcc - tab[cp])); v[i] = (c >= cp) ? val : 0.f; }
                    v2u o; o.x = pk(v[0], v[1]); o.y = pk(v[2], v[3]);
                    *(v2u*)(imem + (unsigned)((((I * 2 + J) * 4 + g) * 64 + lane) * 4)) = o; } }
    }
    GSB();
    f32x16 T1, T1T, T2T, T21T;
    {
        f32x16 KK = {};
#pragma unroll
        for (int s = 0; s < 8; ++s) { const bf16x8 k0 = *(const bf16x8*)(kbase + (size_t)r32 * 4096 + 16 * s + 8 * hi); KK = __builtin_amdgcn_mfma_f32_32x32x16_bf16(k0, k0, KK, 0, 0, 0); }
        f32x16 M, MT;
        { const float gb0 = tab[r32], bb0 = tab[64 + r32];
#pragma unroll
        for (int r = 0; r < 16; ++r) { const int a0 = crow(r, hi), b0 = r32; const float ke = -KK[r] * __expf(-fabsf(tab[a0] - gb0));
            const float nv = ke * tab[64 + a0], ntv = ke * bb0;
            const float n = (a0 > b0) ? nv : 0.f, nt = (b0 > a0) ? ntv : 0.f, id = (a0 == b0) ? 1.f : 0.f;
            M[r] = n; MT[r] = nt; T1[r] = id + n; T1T[r] = id + nt; } }
#pragma unroll
        for (int it = 0; it < 4; ++it) { const f32x16 z = {};
            const f32x16 Mn = mm(MT, M, z), MTn = mm(M, MT, z);
            const f32x16 Tn = mm(T1T, Mn, T1);
            T1T = mm(Mn, T1T, T1T);
            T1 = Tn; M = Mn; MT = MTn; }
    }
    GSB();
    {
        f32x16 KK = {};
#pragma unroll
        for (int s = 0; s < 8; ++s) { const bf16x8 k1 = *(const bf16x8*)(kbase + (size_t)(32 + r32) * 4096 + 16 * s + 8 * hi); KK = __builtin_amdgcn_mfma_f32_32x32x16_bf16(k1, k1, KK, 0, 0, 0); }
        f32x16 M, MT;
        { const float gb0 = tab[32 + r32], bb0 = tab[96 + r32];
#pragma unroll
        for (int r = 0; r < 16; ++r) { const int a0 = crow(r, hi), b0 = r32; const float ke = -KK[r] * __expf(-fabsf(tab[32 + a0] - gb0));
            const float nv = ke * tab[96 + a0], ntv = ke * bb0;
            const float n = (a0 > b0) ? nv : 0.f, nt = (b0 > a0) ? ntv : 0.f, id = (a0 == b0) ? 1.f : 0.f;
            M[r] = n; MT[r] = nt; T2T[r] = id + nt; } }
#pragma unroll
        for (int it = 0; it < 4; ++it) { const f32x16 z = {};
            const f32x16 Mn = mm(MT, M, z), MTn = mm(M, MT, z);
            T2T = mm(Mn, T2T, T2T);
            M = Mn; MT = MTn; }
    }
    GSB();
    {
        f32x16 L21 = {};
#pragma unroll
        for (int s = 0; s < 8; ++s) { const bf16x8 k0 = *(const bf16x8*)(kbase + (size_t)r32 * 4096 + 16 * s + 8 * hi), k1 = *(const bf16x8*)(kbase + (size_t)(32 + r32) * 4096 + 16 * s + 8 * hi);
            L21 = __builtin_amdgcn_mfma_f32_32x32x16_bf16(k1, k0, L21, 0, 0, 0); }
#pragma unroll
        for (int r = 0; r < 16; ++r) { const int a0 = crow(r, hi); L21[r] = L21[r] * tab[96 + a0] * __expf(tab[32 + a0] - tab[r32]); }
        const f32x16 z = {}; const f32x16 Y = mm(L21, T2T, z); T21T = mm(T1, Y, z);
#pragma unroll
        for (int r = 0; r < 16; ++r) T21T[r] = -T21T[r];
    }
    GSB();
    const int vb = (int)(unsigned)(size_t)img + sba::v_rd_base(lane);
    bf16* ubl = dry ? (bf16*)(a.ws + WS_END) + (size_t)(unit & 63) * 64 * 4096 : vbase;
#pragma unroll 1
    for (int mode = 0; mode < 2; ++mode) {
        const bf16* src = mode == 0 ? (const bf16*)vbase : kbase;
#pragma unroll 4
        for (int it = 0; it < 16; ++it) { const int row = (lane >> 4) + 4 * it, col = (lane & 15) * 8;
            *(LAS v4u*)(img + sba::v_st(row, col)) = *(const v4u*)(src + (size_t)row * 4096 + col); }
        LAS float* sc = tab + (mode == 0 ? 64 : 128);
#pragma unroll 1
        for (int I = 0; I < 2; ++I) {
            bf16x8 pa0, pa1, pa2, pa3;
            { f32x16 X;
#pragma unroll
              for (int r = 0; r < 16; ++r) X[r] = (I ? T21T[r] : T1T[r]) * sc[crow(r, hi)];
              GPK4(X, 0, pa0); GPK4(X, 8, pa1);
#pragma unroll
              for (int r = 0; r < 16; ++r) X[r] = I ? T2T[r] * sc[32 + crow(r, hi)] : 0.f;
              GPK4(X, 0, pa2); GPK4(X, 8, pa3); }
#pragma unroll 1
            for (int d0 = 0; d0 < 4; ++d0) {
                f32x16 od = {};
                if (mode == 0) { sba::pv_one<0>(od, vb + d0 * 512, pa0, pa1, pa2, pa3);
                    const unsigned e0 = (unsigned)(((I * 32 + 8 * d0 + (lane >> 5)) * 4096) + (lane & 31) * 4);
#pragma unroll
                    for (int g = 0; g < 4; ++g) { v2u w; w.x = pk(od[4 * g + 0], od[4 * g + 1]); w.y = pk(od[4 * g + 2], od[4 * g + 3]); *(v2u*)(ubl + e0 + (unsigned)(g * 8192)) = w; }
                } else { sba::pv_one_T<0>(od, vb + d0 * 512, pa0, pa1, pa2, pa3);
                    bf16* wp = wmem + (unsigned)((((I * 4 + d0) * 4) * 64 + lane) * 4);
#pragma unroll
                    for (int g = 0; g < 4; ++g) { v2u w; w.x = pk(od[4 * g + 0], od[4 * g + 1]); w.y = pk(od[4 * g + 2], od[4 * g + 3]); *(v2u*)(wp + g * 256) = w; }
                }
                GSB();
            }
        }
        if (mode == 1) {
            const int Ik = hv & 1;
            v4u idw0, idw1;
            { const int d0_ = r32 - 8 * hi, d1_ = r32 - 16 - 8 * hi;
              idw0.x = (d0_ == 0 ? 0x3f80u : 0u) | (d0_ == 1 ? 0x3f800000u : 0u); idw0.y = (d0_ == 2 ? 0x3f80u : 0u) | (d0_ == 3 ? 0x3f800000u : 0u);
              idw0.z = (d0_ == 4 ? 0x3f80u : 0u) | (d0_ == 5 ? 0x3f800000u : 0u); idw0.w = (d0_ == 6 ? 0x3f80u : 0u) | (d0_ == 7 ? 0x3f800000u : 0u);
              idw1.x = (d1_ == 0 ? 0x3f80u : 0u) | (d1_ == 1 ? 0x3f800000u : 0u); idw1.y = (d1_ == 2 ? 0x3f80u : 0u) | (d1_ == 3 ? 0x3f800000u : 0u);
              idw1.z = (d1_ == 4 ? 0x3f80u : 0u) | (d1_ == 5 ? 0x3f800000u : 0u); idw1.w = (d1_ == 6 ? 0x3f80u : 0u) | (d1_ == 7 ? 0x3f800000u : 0u); }
            const bf16x8 id0 = __builtin_bit_cast(bf16x8, idw0), id1 = __builtin_bit_cast(bf16x8, idw1), zf = (bf16x8){};
            const bf16x8 pa0 = Ik ? zf : id0, pa1 = Ik ? zf : id1, pa2 = Ik ? id0 : zf, pa3 = Ik ? id1 : zf;
#pragma unroll 1
            for (int d0 = 0; d0 < 4; ++d0) {
                f32x16 od = {}; sba::pv_one<0>(od, vb + d0 * 512, pa0, pa1, pa2, pa3);
                bf16* kp = ktmem + (unsigned)((((Ik * 4 + d0) * 4) * 64 + lane) * 4);
#pragma unroll
                for (int g = 0; g < 4; ++g) { v2u w; w.x = pk(od[4 * g + 0], od[4 * g + 1]); w.y = pk(od[4 * g + 2], od[4 * g + 3]); *(v2u*)(kp + g * 256) = w; }
                GSB();
            }
        }
    }
#undef GSB
}
#undef GPK4
}
DI void phase_gdn_local(const Args& a, LAS unsigned char* lds, int bid, int G, int wave, int lane, bool dry) {
    LAS unsigned char* img = lds + wave * 16384; LAS float* tab = (LAS float*)(lds + RING_BYTES + 4096 + wave * 1024);
    const int gw = bid * NWAVES + wave, NGW = G * NWAVES;
    for (int unit = gw; unit < BATCH * HV * 64; unit += NGW) gdn::local_unit(a, unit, img, tab, lane, dry);
}
namespace gdn {
constexpr int PW = 272, PI = 144;
constexpr int L_W = 0, L_Q = 64 * PW, L_I = 2 * 64 * PW, L_K = L_I + 64 * PI, L_G = L_K + 128 * PI, L_BUF = L_G + 768;
constexpr int L_PART = 2 * L_BUF;
static_assert(L_PART + 4096 <= RING_BYTES, "scan LDS map");
}
DI void phase_gdn_scan(const Args& a, int j, LAS unsigned char* lds, int bid, int tid, bool dry) {
    if (bid >= BATCH * HV) return;
    using gdn::bf16x8; using gdn::pk; using namespace gdn;
    typedef float f4v __attribute__((ext_vector_type(4)));
    const int wave = __builtin_amdgcn_readfirstlane(tid >> 6), lane = tid & 63, n = lane & 15, kq = lane >> 4;
    const int b = bid / HV, hv = bid % HV, hk = hv >> 1;
    bf16* qkvc = (bf16*)(a.ws + WS_QKVC); const bf16* zb = (const bf16*)(a.ws + WS_ZB);
    LAS float* part = (LAS float*)(lds + L_PART); LAS unsigned char* stg = lds + OGST_OFF;
    const int unit0 = (b * HV + hv) * 64, hku0 = (b * HK + hk) * 64; const size_t tb0 = (size_t)b * SEQ;
    if (wave >= 4) {
        const int st = tid - 256;
        v4u rw[4], rq[4], ri[2], rk[4], rz[4]; float rg = 0.f;
#define SV_RUN2(dst, base, o0) do { const v2u a_ = *(const v2u*)((base) + (o0)), b_ = *(const v2u*)((base) + (o0) + 2 * 64 * 4); dst = (v4u){a_.x, a_.y, b_.x, b_.y}; } while (0)
#define SV_LOAD(ch) do { const int u_ = unit0 + (ch); const size_t t_ = tb0 + (size_t)(ch) * 64; \
        const bf16* wm_ = (const bf16*)(a.ws + WS_WMEM) + (size_t)u_ * 8192; const bf16* im_ = (const bf16*)(a.ws + WS_IMEM) + (size_t)u_ * 4096; \
        const bf16* kt_ = (const bf16*)(a.ws + WS_KTMEM) + (size_t)(hku0 + (ch)) * 8192; const bf16* qb_ = qkvc + t_ * 4096 + hk * 128; const bf16* zr_ = zb + t_ * 2048 + hv * 128; \
        _Pragma("unroll") for (int k = 0; k < 4; ++k) { const int c = st + 256 * k; \
            { const int row = c & 63, p = c >> 6, pp = p & 3; SV_RUN2(rw[k], wm_, (((((row >> 5) * 4 + (p >> 2)) * 4 + (pp >> 1)) * 64 + (pp & 1) * 32 + (row & 31)) * 4)); }     \
            { const int dk = c & 127, p = c >> 7, pp = p & 3; SV_RUN2(rk[k], kt_, (((((p >> 2) * 4 + (dk >> 5)) * 4 + (pp >> 1)) * 64 + (pp & 1) * 32 + (dk & 31)) * 4)); }         \
            rq[k] = *(const v4u*)(qb_ + (size_t)(c >> 4) * 4096 + (c & 15) * 8); rz[k] = *(const v4u*)(zr_ + (size_t)(c >> 4) * 2048 + (c & 15) * 8); } \
        _Pragma("unroll") for (int k = 0; k < 2; ++k) { const int c = st + 256 * k; const int row = c & 63, p = c >> 6, pp = p & 3; \
            SV_RUN2(ri[k], im_, (((((row >> 5) * 2 + (p >> 2)) * 4 + (pp >> 1)) * 64 + (pp & 1) * 32 + (row & 31)) * 4)); } \
        if (st < 192) rg = ((const float*)(a.ws + WS_GTAB))[(size_t)u_ * 192 + st]; } while (0)
#define SV_WRITE(bf) do { LAS unsigned char* B_ = lds + (bf) * L_BUF; \
        _Pragma("unroll") for (int k = 0; k < 4; ++k) { const int c = st + 256 * k; *(LAS v4u*)(B_ + L_W + (c & 63) * PW + (c >> 6) * 16) = rw[k]; \
            *(LAS v4u*)(B_ + L_Q + (c >> 4) * PW + (c & 15) * 16) = rq[k]; *(LAS v4u*)(B_ + L_K + (c & 127) * PI + (c >> 7) * 16) = rk[k]; } \
        _Pragma("unroll") for (int k = 0; k < 2; ++k) { const int c = st + 256 * k; *(LAS v4u*)(B_ + L_I + (c & 63) * PI + (c >> 6) * 16) = ri[k]; } \
        if (st < 192) *(LAS float*)(B_ + L_G + st * 4) = rg; } while (0)
#define SV_ZWRITE() do { _Pragma("unroll") for (int k = 0; k < 4; ++k) { const int c = st + 256 * k; *(LAS v4u*)(stg + (c >> 4) * 256 + (c & 15) * 16) = rz[k]; } } while (0)
        SV_LOAD(0); SV_WRITE(0); SV_ZWRITE();
        __syncthreads();
#pragma unroll 1
        for (int chunk = 0; chunk < 64; ++chunk) {
            if (chunk + 1 < 64) { SV_LOAD(chunk + 1); SV_WRITE((chunk + 1) & 1); }
            __syncthreads();
            __syncthreads();
            { bf16* ob = dry ? (bf16*)(a.ws + WS_END) + (size_t)bid * 64 * 128 : qkvc + (tb0 + (size_t)chunk * 64) * 4096 + 2048 + hv * 128; const int opitch = dry ? 128 : 4096;
#pragma unroll
              for (int k = 0; k < 4; ++k) { const int c = st + 256 * k; *(v4u*)(ob + (size_t)(c >> 4) * opitch + (c & 15) * 8) = *(const LAS v4u*)(stg + (c >> 4) * 256 + (c & 15) * 16); } }
            if (chunk + 1 < 64) SV_ZWRITE();
        }
#undef SV_RUN2
#undef SV_LOAD
#undef SV_WRITE
#undef SV_ZWRITE
        return;
    }
    float nw[2]; nw[0] = a.gdn_norm_w[j * 128 + 32 * wave + n]; nw[1] = a.gdn_norm_w[j * 128 + 32 * wave + 16 + n];
    f4v S[2][8];
#pragma unroll
    for (int g = 0; g < 2; ++g)
#pragma unroll
        for (int m = 0; m < 8; ++m) S[g][m] = (f4v){0.f, 0.f, 0.f, 0.f};
    v2u un[2][4];
#define CW_ULOAD(ch) do { const bf16* vb_ = qkvc + (tb0 + (size_t)(ch) * 64) * 4096 + 2048 + hv * 128; \
        _Pragma("unroll") for (int g = 0; g < 2; ++g) _Pragma("unroll") for (int mt = 0; mt < 4; ++mt) { \
            const int f = (((((mt >> 1) * 4 + wave) * 4 + 2 * (mt & 1) + (kq >> 1)) * 64) + (kq & 1) * 32 + 16 * g + n) * 4;     \
            un[g][mt] = *(const v2u*)(vb_ + (size_t)(f >> 7) * 4096 + (f & 127)); } } while (0)
    CW_ULOAD(0);
    __syncthreads();
#pragma unroll 1
    for (int chunk = 0; chunk < 64; ++chunk) {
        const LAS unsigned char* B = lds + (chunk & 1) * L_BUF; const LAS float* gt = (const LAS float*)(B + L_G);
        f4v av[2][4], ao[2][4];
#pragma unroll
        for (int g = 0; g < 2; ++g)
#pragma unroll
            for (int mt = 0; mt < 4; ++mt) { const v2u u0 = un[g][mt]; av[g][mt] = (f4v){bf_lo(u0.x), bf_hi(u0.x), bf_lo(u0.y), bf_hi(u0.y)}; }
        if (chunk + 1 < 64) CW_ULOAD(chunk + 1);
        bf16x8 Sb[2][4];
#pragma unroll
        for (int g = 0; g < 2; ++g)
#pragma unroll
            for (int p = 0; p < 4; ++p) { v4u w; w.x = pk(S[g][2 * p][0], S[g][2 * p][1]); w.y = pk(S[g][2 * p][2], S[g][2 * p][3]); w.z = pk(S[g][2 * p + 1][0], S[g][2 * p + 1][1]); w.w = pk(S[g][2 * p + 1][2], S[g][2 * p + 1][3]);
                Sb[g][p] = __builtin_bit_cast(bf16x8, w); }
#pragma unroll
        for (int mt = 0; mt < 4; ++mt) { ao[0][mt] = (f4v){0.f, 0.f, 0.f, 0.f}; ao[1][mt] = (f4v){0.f, 0.f, 0.f, 0.f};
#pragma unroll
            for (int p = 0; p < 4; ++p) {
                const bf16x8 aw = *(const LAS bf16x8*)(B + L_W + (16 * mt + n) * PW + 64 * p + 16 * kq);
                const v2u q0 = *(const LAS v2u*)(B + L_Q + (16 * mt + n) * PW + 64 * p + 8 * kq), q1 = *(const LAS v2u*)(B + L_Q + (16 * mt + n) * PW + 64 * p + 32 + 8 * kq);
                const v4u qq = {q0.x, q0.y, q1.x, q1.y}; const bf16x8 aq = __builtin_bit_cast(bf16x8, qq);
                av[0][mt] = __builtin_amdgcn_mfma_f32_16x16x32_bf16(aw, Sb[0][p], av[0][mt], 0, 0, 0); av[1][mt] = __builtin_amdgcn_mfma_f32_16x16x32_bf16(aw, Sb[1][p], av[1][mt], 0, 0, 0);
                ao[0][mt] = __builtin_amdgcn_mfma_f32_16x16x32_bf16(aq, Sb[0][p], ao[0][mt], 0, 0, 0); ao[1][mt] = __builtin_amdgcn_mfma_f32_16x16x32_bf16(aq, Sb[1][p], ao[1][mt], 0, 0, 0); } }
        bf16x8 vbf[2][2], vbd[2][2];
#pragma unroll
        for (int pp = 0; pp < 2; ++pp) {
            const f4v d0 = *(const LAS f4v*)(gt + 64 + 32 * pp + 4 * kq), d1 = *(const LAS f4v*)(gt + 64 + 32 * pp + 16 + 4 * kq);
#pragma unroll
            for (int g = 0; g < 2; ++g) { const f4v x0 = av[g][2 * pp], x1 = av[g][2 * pp + 1];
                v4u w; w.x = pk(x0[0], x0[1]); w.y = pk(x0[2], x0[3]); w.z = pk(x1[0], x1[1]); w.w = pk(x1[2], x1[3]); vbf[g][pp] = __builtin_bit_cast(bf16x8, w);
                v4u y; y.x = pk(x0[0] * d0[0], x0[1] * d0[1]); y.y = pk(x0[2] * d0[2], x0[3] * d0[3]); y.z = pk(x1[0] * d1[0], x1[1] * d1[1]); y.w = pk(x1[2] * d1[2], x1[3] * d1[3]); vbd[g][pp] = __builtin_bit_cast(bf16x8, y); }
        }
#pragma unroll
        for (int mt = 0; mt < 4; ++mt) { const f4v eg = *(const LAS f4v*)(gt + 16 * mt + 4 * kq); ao[0][mt] = ao[0][mt] * eg; ao[1][mt] = ao[1][mt] * eg;
#pragma unroll
            for (int pp = 0; pp < 2; ++pp) { const bf16x8 ai = *(const LAS bf16x8*)(B + L_I + (16 * mt + n) * PI + 64 * pp + 16 * kq);
                ao[0][mt] = __builtin_amdgcn_mfma_f32_16x16x32_bf16(ai, vbf[0][pp], ao[0][mt], 0, 0, 0); ao[1][mt] = __builtin_amdgcn_mfma_f32_16x16x32_bf16(ai, vbf[1][pp], ao[1][mt], 0, 0, 0); } }
        { const float egl = gt[128];
#pragma unroll
          for (int m8 = 0; m8 < 8; ++m8) { S[0][m8] = S[0][m8] * egl; S[1][m8] = S[1][m8] * egl;
#pragma unroll
              for (int pp = 0; pp < 2; ++pp) { const bf16x8 ak = *(const LAS bf16x8*)(B + L_K + (16 * m8 + n) * PI + 64 * pp + 16 * kq);
                  S[0][m8] = __builtin_amdgcn_mfma_f32_16x16x32_bf16(ak, vbd[0][pp], S[0][m8], 0, 0, 0); S[1][m8] = __builtin_amdgcn_mfma_f32_16x16x32_bf16(ak, vbd[1][pp], S[1][m8], 0, 0, 0); } } }
        LAS float* pb = part + (chunk & 1) * 512;
#pragma unroll
        for (int g = 0; g < 2; ++g)
#pragma unroll
            for (int mt = 0; mt < 4; ++mt)
#pragma unroll
                for (int i = 0; i < 4; ++i) { const float ss = dpp_sum16(ao[g][mt][i] * ao[g][mt][i]);
                    if (n == 0) pb[(16 * mt + 4 * kq + i) * 8 + 2 * wave + g] = ss; }
        __syncthreads();
#pragma unroll
        for (int mt = 0; mt < 4; ++mt)
#pragma unroll
            for (int i = 0; i < 4; ++i) { const int c = 16 * mt + 4 * kq + i;
                const f4v s0 = *(const LAS f4v*)(pb + c * 8), s1 = *(const LAS f4v*)(pb + c * 8 + 4);
                const float tot = (s0[0] + s0[1]) + (s0[2] + s0[3]) + (s1[0] + s1[1]) + (s1[2] + s1[3]);
                const float rinv = __builtin_amdgcn_rsqf(tot * (1.0f / 128.0f) + RMS_EPS);
#pragma unroll
                for (int g = 0; g < 2; ++g) { LAS bf16* zp = (LAS bf16*)(stg + c * 256 + (32 * wave + 16 * g + n) * 2);
                    const float z = __uint_as_float((unsigned)(*zp) << 16);
                    const float sg = z * __builtin_amdgcn_rcpf(1.0f + __builtin_amdgcn_exp2f(-1.4426950408889634f * z));
                    *zp = (bf16)(pk(ao[g][mt][i] * rinv * nw[g] * sg, 0.f) & 0xffffu); } }
        __syncthreads();
    }
#undef CW_ULOAD
}

DI void moe_offsets(const Args& a, int j, unsigned (&off)[9]) {
    unsigned* cnt = (unsigned*)(a.ws + WS_CTL) + CW_CNT + 256 * j; unsigned acc = 0u;
#pragma unroll
    for (int e = 0; e < 8; ++e) { off[e] = acc; const unsigned c = __hip_atomic_load(cnt + e, __ATOMIC_RELAXED, __HIP_MEMORY_SCOPE_AGENT); acc += (c + 255u) & ~255u; }
    off[8] = acc;
}
DI void phase_scatter(const Args& a, int j, LAS unsigned char* lds, int bid, int G, int tid, int wave, int lane) {
    LAS unsigned* lc = (LAS unsigned*)lds; LAS unsigned* lb = lc + 8; LAS unsigned* loff = lc + 16; LAS int* lpos = (LAS int*)(lc + 32);
    const unsigned* E12 = (const unsigned*)(a.ws + WS_E12); int* POS = (int*)(a.ws + WS_POS);
    const bf16* HB = (const bf16*)(a.ws + WS_HB); bf16* XS = (bf16*)(a.ws + WS_XS);
    unsigned* fill = (unsigned*)(a.ws + WS_CTL) + CW_CNT + 256 * j + 64;
    unsigned off[9]; moe_offsets(a, j, off);
    if (tid == 0) {
#pragma unroll
        for (int e = 0; e < 8; ++e) loff[e] = off[e]; }
    for (int ci = bid; ci < TT / 128; ci += G) {
        __syncthreads();
        if (tid < 8) lc[tid] = 0u;
        __syncthreads();
        unsigned e1 = 0, e2 = 0, r1 = 0, r2 = 0;
        if (tid < 128) { const unsigned w = E12[ci * 128 + tid]; e1 = w & 255u; e2 = (w >> 8) & 255u;
            r1 = __hip_atomic_fetch_add(lc + e1, 1u, __ATOMIC_RELAXED, __HIP_MEMORY_SCOPE_WORKGROUP); r2 = __hip_atomic_fetch_add(lc + e2, 1u, __ATOMIC_RELAXED, __HIP_MEMORY_SCOPE_WORKGROUP); }
        __syncthreads();
        if (tid < 8) lb[tid] = __hip_atomic_fetch_add(fill + tid, lc[tid], __ATOMIC_RELAXED, __HIP_MEMORY_SCOPE_AGENT);
        __syncthreads();
        if (tid < 128) { const int p1 = (int)(loff[e1] + lb[e1] + r1), p2 = (int)(loff[e2] + lb[e2] + r2);
            lpos[2 * tid] = p1; lpos[2 * tid + 1] = p2; POS[2 * (ci * 128 + tid)] = p1; POS[2 * (ci * 128 + tid) + 1] = p2; }
        __syncthreads();
        for (int tk = wave; tk < 128; tk += NWAVES) {
            const int p1 = lpos[2 * tk], p2 = lpos[2 * tk + 1];
            const v4u* src = (const v4u*)(HB + (size_t)(ci * 128 + tk) * D);
            const v4u x0 = src[lane], x1 = src[lane + 64];
            v4u* d1 = (v4u*)(XS + (size_t)p1 * D); v4u* d2 = (v4u*)(XS + (size_t)p2 * D);
            d1[lane] = x0; d1[lane + 64] = x1; d2[lane] = x0; d2[lane + 64] = x1;
        }
    }
}

template <bool FINAL>
DI void phase_combine_ln(const Args& a, int lnprev, int lnidx, int bid, int G, int wave, int lane) {
    float* out = a.out; bf16* HB = (bf16*)(a.ws + WS_HB); const bf16* YE = (const bf16*)(a.ws + WS_XS); float* stats = (float*)(a.ws + WS_STATS);
    const int* POS = (const int*)(a.ws + WS_POS); const f32x2* G12 = (const f32x2*)(a.ws + WS_G12);
    const float* g = a.ln_g + (size_t)lnidx * D; const float* bta = a.ln_b + (size_t)lnidx * D;
    const float* gp = a.ln_g + (size_t)lnprev * D; const float* bp = a.ln_b + (size_t)lnprev * D;
    const int gw = bid * NWAVES + wave, NGW = G * NWAVES;
    f32x4 gv[4], bv[4], gq[4], bq[4];
#pragma unroll
    for (int q = 0; q < 4; ++q) { gv[q] = *(const f32x4*)(g + 4 * (lane + 64 * q)); bv[q] = *(const f32x4*)(bta + 4 * (lane + 64 * q));
        gq[q] = *(const f32x4*)(gp + 4 * (lane + 64 * q)) * ALPHA; bq[q] = *(const f32x4*)(bp + 4 * (lane + 64 * q)) * ALPHA; }
    for (int t = gw; t < TT; t += NGW) {
        f32x4* row = (f32x4*)(out + (size_t)t * D);
        const int p1 = POS[2 * t], p2 = POS[2 * t + 1]; const f32x2 gg = G12[t]; const f32x2 st = *(const f32x2*)(stats + 2 * (size_t)t);
        const v2u* y1 = (const v2u*)(YE + (size_t)p1 * D); const v2u* y2 = (const v2u*)(YE + (size_t)p2 * D);
        f32x4 v[4]; float s = 0.f;
#pragma unroll
        for (int q = 0; q < 4; ++q) { const v2u a1 = y1[lane + 64 * q], a2 = y2[lane + 64 * q];
            const f32x4 e1 = (f32x4){bf_lo(a1.x), bf_hi(a1.x), bf_lo(a1.y), bf_hi(a1.y)}, e2 = (f32x4){bf_lo(a2.x), bf_hi(a2.x), bf_lo(a2.y), bf_hi(a2.y)};
            v[q] = (row[lane + 64 * q] - st.x) * st.y * gq[q] + bq[q] + e1 * gg.x + e2 * gg.y; s += (v[q][0] + v[q][1]) + (v[q][2] + v[q][3]); }
        const float mean = wave_sum(s) * (1.0f / D); float s2 = 0.f;
#pragma unroll
        for (int q = 0; q < 4; ++q) { const f32x4 d = v[q] - mean; s2 += (d[0] * d[0] + d[1] * d[1]) + (d[2] * d[2] + d[3] * d[3]); }
        const float rstd = 1.0f / sqrtf(wave_sum(s2) * (1.0f / D) + LN_EPS);
        if (lane == 0) *(f32x2*)(stats + 2 * (size_t)t) = (f32x2){mean, rstd};
#pragma unroll
        for (int q = 0; q < 4; ++q) { const f32x4 hn = (v[q] - mean) * rstd * gv[q] + bv[q]; row[lane + 64 * q] = FINAL ? hn : v[q];
            v2u o; o.x = pk2(hn[0], hn[1]); o.y = pk2(hn[2], hn[3]); *(v2u*)(HB + (size_t)t * D + 4 * (lane + 64 * q)) = o; }
    }
}

constexpr int ARGS_OFF = RING_BYTES + 1024;
DI unsigned long long lds_u64(LAS unsigned char* p) { const v2u w = *(const volatile LAS v2u*)p; return ((unsigned long long)(unsigned)__builtin_amdgcn_readfirstlane((int)w.y) << 32) | (unsigned)__builtin_amdgcn_readfirstlane((int)w.x); }
DI Args load_args(LAS unsigned char* lds) {
    Args a; LAS unsigned char* p = lds + ARGS_OFF;
    a.x = (const float*)(const GAS float*)lds_u64(p + 0); a.gdn_w_in = (const float*)(const GAS float*)lds_u64(p + 8); a.gdn_conv_w = (const float*)(const GAS float*)lds_u64(p + 16); a.gdn_a_log = (const float*)(const GAS float*)lds_u64(p + 24);
    a.gdn_dt_bias = (const float*)(const GAS float*)lds_u64(p + 32); a.gdn_norm_w = (const float*)(const GAS float*)lds_u64(p + 40); a.gdn_w_out = (const float*)(const GAS float*)lds_u64(p + 48); a.sb_w_in = (const float*)(const GAS float*)lds_u64(p + 56);
    a.sb_w_out = (const float*)(const GAS float*)lds_u64(p + 64); a.ffn_w_gate = (const float*)(const GAS float*)lds_u64(p + 72); a.ffn_w_up = (const float*)(const GAS float*)lds_u64(p + 80); a.ffn_w_down = (const float*)(const GAS float*)lds_u64(p + 88);
    a.moe_router = (const float*)(const GAS float*)lds_u64(p + 96); a.moe_w_gate = (const float*)(const GAS float*)lds_u64(p + 104); a.moe_w_up = (const float*)(const GAS float*)lds_u64(p + 112); a.moe_w_down = (const float*)(const GAS float*)lds_u64(p + 120);
    a.ln_g = (const float*)(const GAS float*)lds_u64(p + 128); a.ln_b = (const float*)(const GAS float*)lds_u64(p + 136); a.out = (float*)(GAS float*)lds_u64(p + 144); a.ws = (unsigned char*)(GAS unsigned char*)lds_u64(p + 152);
    const v2u w = *(const volatile LAS v2u*)(p + 160); a.ph_lo = __builtin_amdgcn_readfirstlane((int)w.x); a.ph_hi = __builtin_amdgcn_readfirstlane((int)w.y);
    return a;
}
#ifdef PH_ONLY
#define IN(k) (((k) % NPH) == PH_ONLY && lo <= (k) && (k) < hi)
#else
#define IN(k) (lo <= (k) && (k) < hi)
#endif
#define SEAM(k) do { if ((k) + 1 < hi) xcd_barrier(bar); } while (0)
DI int fresh_lane() { int l; asm volatile("v_mbcnt_lo_u32_b32 %0, -1, 0\n\tv_mbcnt_hi_u32_b32 %0, -1, %0" : "=v"(l)); return l; }
#define ARGS() const Args args = load_args(lds); const int lo = args.ph_lo, hi = args.ph_hi; const int lane = fresh_lane(), tid = wave * 64 + lane
#ifndef PROBE_REP_MASK
#define PROBE_REP_MASK 0
#endif
#ifndef PROBE_DELAY_MASK
#define PROBE_DELAY_MASK 0
#endif
#define PROBE_DELAY_MULT 4u
#define TICK_IN(k) do { if (((PROBE_DELAY_MASK) >> (k)) & 1) { if (bid == 0 && tid == 0) ((volatile LAS unsigned*)(lds + MISC_OFF))[20] -= (unsigned)__builtin_amdgcn_s_memrealtime(); } } while (0)
#define TICK_OUT(k) do { if (((PROBE_DELAY_MASK) >> (k)) & 1) { if (bid == 0 && tid == 0) ((volatile LAS unsigned*)(lds + MISC_OFF))[20] += (unsigned)__builtin_amdgcn_s_memrealtime(); } } while (0)
#define NREP(k) ((((PROBE_REP_MASK) >> (k)) & 1) ? 2 : 1)
template <int j>
DI void layer_pair(LAS unsigned char* lds, const XcdBarrier& bar, const int wave, const int G, const int bid) {
    constexpr int pb = j * NPH;
    { ARGS(); if (IN(pb + 0)) { TICK_IN(0); _Pragma("unroll 1") for (int rep_ = 0; rep_ < NREP(0); ++rep_) { phase_w_gdn(args, j, lds, bid, G, tid, wave, lane); } SEAM(pb + 0); TICK_OUT(0); } }
    { ARGS(); if (IN(pb + 1)) { TICK_IN(1); {
        pg8::Gemm g{(const bf16*)(args.ws + WS_HB), (const bf16*)(args.ws + W_IN), D, D}; pg8::StaticOrder S; S.init(TT, GINP, G, bid, NREP(1));
        pg8::EpiInProj E{(bf16*)(args.ws + WS_RAW), (bf16*)(args.ws + WS_ZB)};
        pg8::gemm_phase<pg8::EpiInProj, pg8::StaticOrder, true, true>(lds, g, S, E);
        } SEAM(pb + 1); TICK_OUT(1); } }
    { ARGS(); if (IN(pb + 2)) { TICK_IN(2); _Pragma("unroll 1") for (int rep_ = 0; rep_ < NREP(2); ++rep_) { phase_conv(args, j, bid, G, tid); } SEAM(pb + 2); TICK_OUT(2); } }
#if GDN_NAIVE
    { ARGS(); if (IN(pb + 4)) { TICK_IN(4); _Pragma("unroll 1") for (int rep_ = 0; rep_ < NREP(4); ++rep_) { phase_gdn_naive(args, j, lds, bid, tid); } SEAM(pb + 4); TICK_OUT(4); } }
#else
    { ARGS(); if (IN(pb + 3)) { TICK_IN(3); _Pragma("unroll 1") for (int rep_ = 0; rep_ < NREP(3); ++rep_) { phase_gdn_local(args, lds, bid, G, wave, lane, rep_ + 1 < NREP(3)); } SEAM(pb + 3); TICK_OUT(3); } }
    { ARGS(); if (IN(pb + 4)) { TICK_IN(4); _Pragma("unroll 1") for (int rep_ = 0; rep_ < NREP(4); ++rep_) { if (bid >= BATCH * HV && G > BATCH * HV) phase_w_sb(args, j, lds, bid - BATCH * HV, G - BATCH * HV, wave, lane); else if (G <= BATCH * HV && rep_ == 0) phase_w_sb(args, j, lds, bid, G, wave, lane);
        phase_gdn_scan(args, j, lds, bid, tid, rep_ + 1 < NREP(4)); } SEAM(pb + 4); TICK_OUT(4); } }
#endif
    { ARGS(); if (IN(pb + 5)) { TICK_IN(5); {
        pg8::Gemm g{(const bf16*)(args.ws + WS_QKVC) + 2048, (const bf16*)(args.ws + W_OUT), 4096, 2048}; pg8::StaticOrder S; S.init(TT, D, G, bid);
        pg8::EpiResid<(j > 0)> E{j == 0 ? args.x : args.out, args.out, (const float*)(args.ws + WS_STATS), args.ln_g + (size_t)(4 * (j > 0 ? j - 1 : 0) + 3) * D, args.ln_b + (size_t)(4 * (j > 0 ? j - 1 : 0) + 3) * D};
        pg8::gemm_phase<pg8::EpiResid<(j > 0)>, pg8::StaticOrder, true, true>(lds, g, S, E);
        } SEAM(pb + 5); TICK_OUT(5); } }
    { ARGS(); if (IN(pb + 6)) { TICK_IN(6); _Pragma("unroll 1") for (int rep_ = 0; rep_ < NREP(6); ++rep_) { phase_ln<false>(args, (2 * j) * 2 + 0, j, lds, bid, G, tid, wave, lane); } SEAM(pb + 6); TICK_OUT(6); } }
    { ARGS(); if (IN(pb + 7)) { TICK_IN(7); {
        pg8::Gemm g{(const bf16*)(args.ws + WS_HB), (const bf16*)(args.ws + W_GU), D, D}; pg8::StaticOrder S; S.init(TT, 2 * FF, G, bid, NREP(7));
        pg8::EpiSwiGLU E{(bf16*)(args.ws + WS_ACT), FF, 0};
        pg8::gemm_phase<pg8::EpiSwiGLU, pg8::StaticOrder, true, true>(lds, g, S, E);
        } SEAM(pb + 7); TICK_OUT(7); } }
    { ARGS(); if (IN(pb + 8)) { TICK_IN(8); {
        pg8::Gemm g{(const bf16*)(args.ws + WS_ACT), (const bf16*)(args.ws + W_D), FF, FF}; pg8::StaticOrder S; S.init(TT, D, G, bid);
        pg8::EpiResid<true> E{args.out, args.out, (const float*)(args.ws + WS_STATS), args.ln_g + (size_t)(4 * j + 0) * D, args.ln_b + (size_t)(4 * j + 0) * D};
        pg8::gemm_phase<pg8::EpiResid<true>, pg8::StaticOrder, true, true>(lds, g, S, E);
        } SEAM(pb + 8); TICK_OUT(8); } }
    { ARGS(); if (IN(pb + 9)) { TICK_IN(9); _Pragma("unroll 1") for (int rep_ = 0; rep_ < NREP(9); ++rep_) { phase_ln<false>(args, (2 * j) * 2 + 1, j, lds, bid, G, tid, wave, lane); } SEAM(pb + 9); TICK_OUT(9); } }
    { ARGS(); if (IN(pb + 10)) { TICK_IN(10); {
        pg8::Gemm g{(const bf16*)(args.ws + WS_HB), (const bf16*)(args.ws + W_QKV), D, D}; pg8::StaticOrder S; S.init(TT, 3072, G, bid, NREP(10));
        pg8::EpiBf16 E{(bf16*)(args.ws + WS_QKV), 3072, 0};
        pg8::gemm_phase<pg8::EpiBf16, pg8::StaticOrder, true, true>(lds, g, S, E);
        } SEAM(pb + 10); TICK_OUT(10); } }
    #if SB_NAIVE
    { ARGS(); if (IN(pb + 11)) { TICK_IN(11); _Pragma("unroll 1") for (int rep_ = 0; rep_ < NREP(11); ++rep_) { phase_sb_naive(args, lds, bid, G, tid); } SEAM(pb + 11); TICK_OUT(11); } }
#else
    { ARGS(); if (IN(pb + 11)) { TICK_IN(11); _Pragma("unroll 1") for (int rep_ = 0; rep_ < NREP(11); ++rep_) { phase_sb_mfma(args, lds, bid, G, tid); } SEAM(pb + 11); TICK_OUT(11); } }
#endif
    { ARGS(); if (IN(pb + 12)) { TICK_IN(12); {
        pg8::Gemm g{(const bf16*)(args.ws + WS_AO), (const bf16*)(args.ws + W_O), D, D}; pg8::StaticOrder S; S.init(TT, D, G, bid);
        pg8::EpiResid<true> E{args.out, args.out, (const float*)(args.ws + WS_STATS), args.ln_g + (size_t)(4 * j + 1) * D, args.ln_b + (size_t)(4 * j + 1) * D};
        pg8::gemm_phase<pg8::EpiResid<true>, pg8::StaticOrder, true, true>(lds, g, S, E);
        } SEAM(pb + 12); TICK_OUT(12); } }
    { ARGS(); if (IN(pb + 13)) { TICK_IN(13); _Pragma("unroll 1") for (int rep_ = 0; rep_ < NREP(13); ++rep_) { phase_ln<true>(args, (2 * j + 1) * 2 + 0, j, lds, bid, G, tid, wave, lane); } SEAM(pb + 13); TICK_OUT(13); } }
    { ARGS(); if (IN(pb + 14)) { TICK_IN(14); _Pragma("unroll 1") for (int rep_ = 0; rep_ < NREP(14); ++rep_) { phase_scatter(args, j, lds, bid, G, tid, wave, lane); } SEAM(pb + 14); TICK_OUT(14); } }
    { ARGS(); if (IN(pb + 15)) { TICK_IN(15); {
        unsigned off[9]; moe_offsets(args, j, off);
        pg8::MoeOrder S; S.nM = (int)(off[8] >> 8); S.G = G; S.c = bid; S.nN = 2 * FF / 256; S.nwg = S.nM * S.nN; S.rep = NREP(15);
        S.ps1 = (int)(off[1] >> 8); S.ps2 = (int)(off[2] >> 8); S.ps3 = (int)(off[3] >> 8); S.ps4 = (int)(off[4] >> 8); S.ps5 = (int)(off[5] >> 8); S.ps6 = (int)(off[6] >> 8); S.ps7 = (int)(off[7] >> 8);
        pg8::Gemm g{(const bf16*)(args.ws + WS_XS), (const bf16*)(args.ws + W_MGU), D, D};
        pg8::EpiSwiGLU E{(bf16*)(args.ws + WS_MACT), FF, 2 * FF / 256};
        pg8::gemm_phase<pg8::EpiSwiGLU, pg8::MoeOrder, true, true>(lds, g, S, E);
        } SEAM(pb + 15); TICK_OUT(15); } }
    { ARGS(); if (IN(pb + 16)) { TICK_IN(16); {
        unsigned off[9]; moe_offsets(args, j, off);
        pg8::MoeOrder S; S.nM = (int)(off[8] >> 8); S.G = G; S.c = bid; S.nN = D / 256; S.nwg = S.nM * S.nN; S.rep = NREP(16);
        S.ps1 = (int)(off[1] >> 8); S.ps2 = (int)(off[2] >> 8); S.ps3 = (int)(off[3] >> 8); S.ps4 = (int)(off[4] >> 8); S.ps5 = (int)(off[5] >> 8); S.ps6 = (int)(off[6] >> 8); S.ps7 = (int)(off[7] >> 8);
        pg8::Gemm g{(const bf16*)(args.ws + WS_MACT), (const bf16*)(args.ws + W_MD), FF, FF};
        pg8::EpiBf16 E{(bf16*)(args.ws + WS_XS), D, D / 256};
        pg8::gemm_phase<pg8::EpiBf16, pg8::MoeOrder, true, true>(lds, g, S, E);
        } SEAM(pb + 16); TICK_OUT(16); } }
    { ARGS(); if (IN(pb + 17)) { TICK_IN(17); _Pragma("unroll 1") for (int rep_ = 0; rep_ < NREP(17); ++rep_) { phase_combine_ln<(j == 1)>(args, 4 * j + 2, 4 * j + 3, bid, G, wave, lane); } SEAM(pb + 17); TICK_OUT(17); } }
}
__global__ void __launch_bounds__(NWAVES * 64, 2) fwd(Args kargs) {
    extern __shared__ __attribute__((aligned(16))) unsigned char lds_raw[];
    LAS unsigned char* lds = (LAS unsigned char*)lds_raw;
    volatile LAS unsigned* MISC = (volatile LAS unsigned*)(lds + MISC_OFF);
    const int tid = threadIdx.x, lane = tid & 63, wave = __builtin_amdgcn_readfirstlane(tid >> 6), G = gridDim.x, bid = blockIdx.x;
    for (int u = tid; u < (LDS_BYTES - RING_BYTES) / 4; u += NWAVES * 64) ((LAS unsigned*)(lds + RING_BYTES))[u] = 0u;
    __syncthreads();
    if (tid == 0) { LAS unsigned long long* pa = (LAS unsigned long long*)(lds + ARGS_OFF);
        pa[0] = (unsigned long long)kargs.x; pa[1] = (unsigned long long)kargs.gdn_w_in; pa[2] = (unsigned long long)kargs.gdn_conv_w; pa[3] = (unsigned long long)kargs.gdn_a_log;
        pa[4] = (unsigned long long)kargs.gdn_dt_bias; pa[5] = (unsigned long long)kargs.gdn_norm_w; pa[6] = (unsigned long long)kargs.gdn_w_out; pa[7] = (unsigned long long)kargs.sb_w_in;
        pa[8] = (unsigned long long)kargs.sb_w_out; pa[9] = (unsigned long long)kargs.ffn_w_gate; pa[10] = (unsigned long long)kargs.ffn_w_up; pa[11] = (unsigned long long)kargs.ffn_w_down;
        pa[12] = (unsigned long long)kargs.moe_router; pa[13] = (unsigned long long)kargs.moe_w_gate; pa[14] = (unsigned long long)kargs.moe_w_up; pa[15] = (unsigned long long)kargs.moe_w_down;
        pa[16] = (unsigned long long)kargs.ln_g; pa[17] = (unsigned long long)kargs.ln_b; pa[18] = (unsigned long long)kargs.out; pa[19] = (unsigned long long)kargs.ws;
        pa[20] = (unsigned long long)(unsigned)kargs.ph_lo | ((unsigned long long)(unsigned)kargs.ph_hi << 32); }
    XcdBarrier bar = xcd_barrier_post((unsigned*)(kargs.ws + WS_CTL) + CW_BAR, MISC + 8);
    __syncthreads();
    layer_pair<0>(lds, bar, wave, G, bid);
    layer_pair<1>(lds, bar, wave, G, bid);
    if (PROBE_DELAY_MASK) { if (bid == 0 && threadIdx.x == 0) { const unsigned acc = ((volatile LAS unsigned*)(lds + MISC_OFF))[20] * PROBE_DELAY_MULT; const unsigned long long t0 = __builtin_amdgcn_s_memrealtime(); while ((unsigned)(__builtin_amdgcn_s_memrealtime() - t0) < acc) __builtin_amdgcn_s_sleep(8); } }
}
#undef IN
#undef SEAM
#undef ARGS

extern "C" void kernel_launch(void* const* d_in, const int* in_sizes, int n_in, void* d_out, int out_size, void* d_ws, size_t ws_size, hipStream_t stream) {
    static int grid = 0;
    if (grid == 0) {
        if (n_in != 18 || in_sizes[0] != TT * D || out_size != TT * D || ws_size < WS_END) { fprintf(stderr, "kernel_launch: unexpected shapes (n_in %d, in0 %d, out %d, ws %zu); nothing launched\n", n_in, n_in > 0 ? in_sizes[0] : -1, out_size, ws_size); grid = -1; return; }
        int dev = 0, cus = 0, per_cu = 0;
        if (hipGetDevice(&dev) != hipSuccess || hipDeviceGetAttribute(&cus, hipDeviceAttributeMultiprocessorCount, dev) != hipSuccess) { grid = -1; return; }
        if (hipFuncSetAttribute((const void*)fwd, hipFuncAttributeMaxDynamicSharedMemorySize, LDS_BYTES) != hipSuccess) { fprintf(stderr, "kernel_launch: hipFuncSetAttribute failed\n"); grid = -1; return; }
        if (hipOccupancyMaxActiveBlocksPerMultiprocessor(&per_cu, (const void*)fwd, NWAVES * 64, LDS_BYTES) != hipSuccess || per_cu < 1) { fprintf(stderr, "kernel_launch: occupancy query says %d blocks per CU\n", per_cu); (void)hipGetLastError(); grid = -1; return; }
        grid = cus;
    }
    if (grid < 0) return;
    if (hipMemsetAsync((char*)d_ws + WS_CTL, 0, CTL_ZERO_BYTES, stream) != hipSuccess) return;
    Args a{};
    a.x = (const float*)d_in[0]; a.gdn_w_in = (const float*)d_in[1]; a.gdn_conv_w = (const float*)d_in[2]; a.gdn_a_log = (const float*)d_in[3]; a.gdn_dt_bias = (const float*)d_in[4];
    a.gdn_norm_w = (const float*)d_in[5]; a.gdn_w_out = (const float*)d_in[6]; a.sb_w_in = (const float*)d_in[7]; a.sb_w_out = (const float*)d_in[8];
    a.ffn_w_gate = (const float*)d_in[9]; a.ffn_w_up = (const float*)d_in[10]; a.ffn_w_down = (const float*)d_in[11]; a.moe_router = (const float*)d_in[12];
    a.moe_w_gate = (const float*)d_in[13]; a.moe_w_up = (const float*)d_in[14]; a.moe_w_down = (const float*)d_in[15]; a.ln_g = (const float*)d_in[16]; a.ln_b = (const float*)d_in[17];
    a.out = (float*)d_out; a.ws = (unsigned char*)d_ws;
#if MK_ONE_LAUNCH
    a.ph_lo = 0; a.ph_hi = NPHASES;
    hipLaunchKernelGGL(fwd, dim3(grid), dim3(NWAVES * 64), LDS_BYTES, stream, a);
#else
    for (int p = 0; p < NPHASES; ++p) { a.ph_lo = p; a.ph_hi = p + 1; hipLaunchKernelGGL(fwd, dim3(grid), dim3(NWAVES * 64), LDS_BYTES, stream, a); }
#endif
}
```

```cpp
#include <hip/hip_runtime.h>
#include <cstdio>
#include <cstdint>
#ifndef GDN_NAIVE
#define GDN_NAIVE 0
#endif
#ifndef SB_NAIVE
#define SB_NAIVE 0
#endif
#ifndef MK_ONE_LAUNCH
#define MK_ONE_LAUNCH 1
#endif
namespace pg8 {
#define PG8_LAS __attribute__((address_space(3)))
typedef unsigned short bf16_t;
typedef short bf16x8 __attribute__((ext_vector_type(8)));
typedef float f32x4 __attribute__((ext_vector_type(4)));
typedef unsigned u32x4 __attribute__((ext_vector_type(4)));
constexpr int BM = 256, BK = 64, HALF = 128, HTB = HALF * BK * 2  , STAGE_BYTES = 8 * HTB, NXCD = 8, WGM = 8;

__host__ __device__ __forceinline__ int lds_byte(int r, int c) { const int st = (r >> 4) * 2 + (c >> 5), rr = r & 15, cc = c & 31, ob = rr * 64 + cc * 2; return st * 1024 + (ob ^ (((ob >> 9) & 1) << 5)); }
__host__ __device__ __forceinline__ void stage_rc(int b, int& R, int& C) { const int st = b / 1024, sb = b % 1024, swz = sb ^ (((sb >> 9) & 1) << 5); R = (st >> 1) * 16 + swz / 64; C = (st & 1) * 32 + (swz % 64) / 2; }
__host__ __device__ __forceinline__ int perm32(int rho) { const int n = rho >> 4, i = rho & 15; return 8 * (i >> 2) + 4 * n + (i & 3); }

struct Unit { int pm, pn; };
struct Gemm { const bf16_t* A; const bf16_t* Bt; int lda, K; };

struct StaticOrder {
    int nM, nN, nwg, G, c, rep;
    __host__ __device__ void init(int M, int N, int G_, int c_, int rep_ = 1) { nM = M / BM; nN = N / BM; nwg = nM * nN; G = G_; c = c_; rep = rep_; }
    __host__ __device__ bool next(int i, Unit& u) const {
        const long L = (long)i * G + c; if (L >= (long)rep * nwg) return false;
        int wgid = (int)(L % nwg); { const int q = nwg / NXCD, r = nwg % NXCD, xcd = wgid % NXCD, off = wgid / NXCD; wgid = (xcd < r ? xcd * (q + 1) : r * (q + 1) + (xcd - r) * q) + off; }
        const int nig = WGM * nN, gid = wgid / nig, fm = gid * WGM, gsz = (nM - fm) < WGM ? (nM - fm) : WGM;
        u.pm = fm + ((wgid % nig) % gsz); u.pn = (wgid % nig) / gsz; return true;
    }
    __device__ __forceinline__ void a_ready(const Unit&) const {}
    __device__ __forceinline__ void done(const Unit&) const {}
};

__device__ __forceinline__ unsigned cvt_pk_bf16(float lo, float hi) { unsigned r; asm volatile("v_cvt_pk_bf16_f32 %0, %1, %2" : "=v"(r) : "v"(lo), "v"(hi)); return r; }
struct EpiBf16 {
    static constexpr bool PERM = true, AFTER_DRAIN = false;
    bf16_t* O; int ldc; int nmod;
    __device__ __forceinline__ void operator()(const f32x4 (&acc)[2][2][4][2], const Unit& u, int wr, int wc, int fr, int fq) const {
        const int pnl = nmod ? (u.pn % nmod) : u.pn;
        const int row0 = u.pm * BM + wr * 64 + fr, col0 = pnl * BM + wc * 32 + 8 * fq;
#pragma unroll
        for (int ai = 0; ai < 2; ++ai)
#pragma unroll
            for (int m = 0; m < 4; ++m) { bf16_t* rowp = O + (size_t)(row0 + ai * HALF + m * 16) * ldc + col0;
#pragma unroll
                for (int bj = 0; bj < 2; ++bj) { const f32x4 v0 = acc[ai][bj][m][0], v1 = acc[ai][bj][m][1];
                    u32x4 w; w.x = cvt_pk_bf16(v0[0], v0[1]); w.y = cvt_pk_bf16(v0[2], v0[3]); w.z = cvt_pk_bf16(v1[0], v1[1]); w.w = cvt_pk_bf16(v1[2], v1[3]);
                    *(u32x4*)(rowp + bj * HALF) = w; } }
    }
};
struct EpiInProj {
    static constexpr bool PERM = true, AFTER_DRAIN = false;
    bf16_t* RAW; bf16_t* ZB;
    __device__ __forceinline__ void operator()(const f32x4 (&acc)[2][2][4][2], const Unit& u, int wr, int wc, int fr, int fq) const {
        const bool isz = (u.pn >= 16 && u.pn < 24);
        bf16_t* O = isz ? ZB : RAW; const int ldc = isz ? 2048 : 4352; const int ct = isz ? (u.pn - 16) : (u.pn < 16 ? u.pn : 16);
        const int row0 = u.pm * BM + wr * 64 + fr, col0 = ct * BM + wc * 32 + 8 * fq;
#pragma unroll
        for (int ai = 0; ai < 2; ++ai)
#pragma unroll
            for (int m = 0; m < 4; ++m) { bf16_t* rowp = O + (size_t)(row0 + ai * HALF + m * 16) * ldc + col0;
#pragma unroll
                for (int bj = 0; bj < 2; ++bj) { const f32x4 v0 = acc[ai][bj][m][0], v1 = acc[ai][bj][m][1];
                    u32x4 w; w.x = cvt_pk_bf16(v0[0], v0[1]); w.y = cvt_pk_bf16(v0[2], v0[3]); w.z = cvt_pk_bf16(v1[0], v1[1]); w.w = cvt_pk_bf16(v1[2], v1[3]);
                    *(u32x4*)(rowp + bj * HALF) = w; } }
    }
};
__device__ __forceinline__ float silu_f(float x) { return x * __builtin_amdgcn_rcpf(1.0f + __builtin_amdgcn_exp2f(-1.4426950408889634f * x)); }
struct EpiSwiGLU {
    static constexpr bool PERM = true, AFTER_DRAIN = false;
    bf16_t* O; int ldc; int nmod;
    __device__ __forceinline__ void operator()(const f32x4 (&acc)[2][2][4][2], const Unit& u, int wr, int wc, int fr, int fq) const {
        const int pnl = nmod ? (u.pn % nmod) : u.pn;
        const int row0 = u.pm * BM + wr * 64 + fr, col0 = pnl * HALF + wc * 32 + 8 * fq;
#pragma unroll
        for (int ai = 0; ai < 2; ++ai)
#pragma unroll
            for (int m = 0; m < 4; ++m) { bf16_t* rowp = O + (size_t)(row0 + ai * HALF + m * 16) * ldc + col0;
                const f32x4 g0 = acc[ai][0][m][0], g1 = acc[ai][0][m][1], u0 = acc[ai][1][m][0], u1 = acc[ai][1][m][1];
                u32x4 w;
                w.x = cvt_pk_bf16(silu_f(g0[0]) * u0[0], silu_f(g0[1]) * u0[1]); w.y = cvt_pk_bf16(silu_f(g0[2]) * u0[2], silu_f(g0[3]) * u0[3]);
                w.z = cvt_pk_bf16(silu_f(g1[0]) * u1[0], silu_f(g1[1]) * u1[1]); w.w = cvt_pk_bf16(silu_f(g1[2]) * u1[2], silu_f(g1[3]) * u1[3]);
                *(u32x4*)rowp = w; }
    }
};
template <bool LNR> struct EpiResid {
    static constexpr bool PERM = false, AFTER_DRAIN = false;
    const float* res; float* out; const float* stats; const float* g; const float* b;
    __device__ __forceinline__ void operator()(const f32x4 (&acc)[2][2][4][2], const Unit& u, int wr, int wc, int fr, int fq) const {
        constexpr int ldc = 1024; constexpr float alpha = 1.6817928305074290f;
        const int row0 = u.pm * BM + wr * 64 + fr, col0 = u.pn * BM + wc * 32 + 4 * fq;
        if constexpr (!LNR) {
#pragma unroll
            for (int ai = 0; ai < 2; ++ai)
#pragma unroll
                for (int m = 0; m < 4; ++m) { const size_t off = (size_t)(row0 + ai * HALF + m * 16) * ldc + col0;
#pragma unroll
                    for (int bj = 0; bj < 2; ++bj)
#pragma unroll
                        for (int n = 0; n < 2; ++n) { const f32x4 r = *(const f32x4*)(res + off + bj * HALF + n * 16);
                            *(f32x4*)(out + off + bj * HALF + n * 16) = r * alpha + acc[ai][bj][m][n]; } }
        } else {
#pragma unroll
            for (int bj = 0; bj < 2; ++bj)
#pragma unroll
                for (int n = 0; n < 2; ++n) {
                    const f32x4 gv = *(const f32x4*)(g + col0 + bj * HALF + n * 16) * alpha, bv = *(const f32x4*)(b + col0 + bj * HALF + n * 16) * alpha;
#pragma unroll
                    for (int ai = 0; ai < 2; ++ai)
#pragma unroll
                        for (int m = 0; m < 4; ++m) { const int row = row0 + ai * HALF + m * 16; const size_t off = (size_t)row * ldc + col0 + bj * HALF + n * 16;
                            const float mean = stats[2 * row], rstd = stats[2 * row + 1];
                            const f32x4 r = *(const f32x4*)(res + off);
                            *(f32x4*)(out + off) = (r - mean) * rstd * gv + bv + acc[ai][bj][m][n]; }
                    asm volatile("" ::: "memory");
                }
        }
    }
};
struct MoeOrder {
    int nM, nN, nwg, G, c, rep; int ps1, ps2, ps3, ps4, ps5, ps6, ps7;
    __device__ __forceinline__ bool next(int i, Unit& u) const {
        const long L = (long)i * G + c; if (nwg == 0 || L >= (long)rep * nwg) return false;
        int wgid = (int)(L % nwg); { const int q = nwg / NXCD, r = nwg % NXCD, xcd = wgid % NXCD, off = wgid / NXCD; wgid = (xcd < r ? xcd * (q + 1) : r * (q + 1) + (xcd - r) * q) + off; }
        const int nig = WGM * nN, gid = wgid / nig, fm = gid * WGM, gsz = (nM - fm) < WGM ? (nM - fm) : WGM;
        const int pm = fm + ((wgid % nig) % gsz), pnl = (wgid % nig) / gsz;
        const int e = (pm >= ps1) + (pm >= ps2) + (pm >= ps3) + (pm >= ps4) + (pm >= ps5) + (pm >= ps6) + (pm >= ps7);
        u.pm = pm; u.pn = e * nN + pnl; return true;
    }
    __device__ __forceinline__ void a_ready(const Unit&) const {}
    __device__ __forceinline__ void done(const Unit&) const {}
};
template <class Epi, class Sched, bool ALIGN_EPI = false, bool SP2 = false>
__device__ __forceinline__ void gemm_phase(PG8_LAS unsigned char* lds, const Gemm g, const Sched& S, const Epi& E) {
    const int tid = threadIdx.x, wid = __builtin_amdgcn_readfirstlane(tid >> 6), lane = tid & 63, wr = wid >> 2, wc = wid & 3, fr = lane & 15, fq = lane >> 4;
    const int K = g.K, nt = K / BK;
    unsigned voffA[2], voffB[2];
#pragma unroll
    for (int i = 0; i < 2; ++i) { int R, C; stage_rc(tid * 16 + i * 8192, R, C); const int Rb = Epi::PERM ? ((R & ~31) + perm32(R & 31)) : R;
        voffA[i] = (unsigned)(R * g.lda + C) * 2u; voffB[i] = (unsigned)(Rb * K + C) * 2u; }
    const size_t kstep = (size_t)(BK * 2);
    const size_t hstepA = (size_t)HALF * g.lda * 2, hstepB = (size_t)HALF * K * 2;
    const size_t tstepA = 2 * hstepA, tstepB = 2 * hstepB;
    const unsigned ldsw = (unsigned)wid * 1024u;
    const int aoff = lds_byte(wr * 64 + fr, fq * 8), boff = lds_byte(wc * 32 + fr, fq * 8);
#define PG8_SA(b, h) (((b) * 2 + (h)) * HTB)
#define PG8_SB(b, h) ((4 + (b) * 2 + (h)) * HTB)
#define PG8_STAGE(bufoff, gbase, voff) do { _Pragma("unroll") for (int _i = 0; _i < 2; ++_i) \
        __builtin_amdgcn_global_load_lds((const unsigned*)((const char*)(gbase) + (voff)[_i]), (PG8_LAS unsigned*)(lds + (bufoff) + ldsw + _i * 8192), 16, 0, 0); } while (0)
#define PG8_LDA(dst, b, h) do { _Pragma("unroll") for (int m = 0; m < 4; ++m) _Pragma("unroll") for (int k = 0; k < 2; ++k) dst[m][k] = *(const PG8_LAS bf16x8*)(lds + PG8_SA(b, h) + aoff + m * 2048 + k * 1024); } while (0)
#define PG8_LDB(dst, b, h) do { _Pragma("unroll") for (int n = 0; n < 2; ++n) _Pragma("unroll") for (int k = 0; k < 2; ++k) dst[n][k] = *(const PG8_LAS bf16x8*)(lds + PG8_SB(b, h) + boff + n * 2048 + k * 1024); } while (0)
#define PG8_MMA(ai, bj, At, Bt) do { __builtin_amdgcn_s_setprio(1); _Pragma("unroll") for (int m = 0; m < 4; ++m) _Pragma("unroll") for (int n = 0; n < 2; ++n) _Pragma("unroll") for (int k = 0; k < 2; ++k) \
        acc[ai][bj][m][n] = __builtin_amdgcn_mfma_f32_16x16x32_bf16(Bt[n][k], At[m][k], acc[ai][bj][m][n], 0, 0, 0); __builtin_amdgcn_s_setprio(0); } while (0)
#define PG8_WAIT_V(n) asm volatile("s_waitcnt vmcnt(" #n ")" ::: "memory")
#define PG8_WAIT_L(n) asm volatile("s_waitcnt lgkmcnt(" #n ")" ::: "memory")
#define PG8_BAR __builtin_amdgcn_s_barrier()
#define PG8_SCHED __builtin_amdgcn_sched_barrier(0)
    Unit cur, nxt; int ui = 0;
    if (!S.next(0, cur)) return;
    f32x4 acc[2][2][4][2];
#pragma unroll
    for (int a = 0; a < 2; ++a)
#pragma unroll
        for (int b = 0; b < 2; ++b)
#pragma unroll
            for (int m = 0; m < 4; ++m)
#pragma unroll
                for (int n = 0; n < 2; ++n) acc[a][b][m][n] = (f32x4){0.f, 0.f, 0.f, 0.f};
    bf16x8 At[4][2], B0[2][2], B1[2][2];
    const char* cA = (const char*)g.A + (size_t)cur.pm * tstepA; const char* cB = (const char*)g.Bt + (size_t)cur.pn * tstepB;
    S.a_ready(cur);
    if constexpr (SP2) {
        PG8_STAGE(PG8_SB(0, 0), cB, voffB); PG8_STAGE(PG8_SB(0, 1), cB + hstepB, voffB); PG8_STAGE(PG8_SA(0, 0), cA, voffA); PG8_STAGE(PG8_SA(0, 1), cA + hstepA, voffA);
        if (wr == 1) PG8_BAR;
        PG8_WAIT_V(2); PG8_BAR;
        PG8_STAGE(PG8_SB(1, 0), cB + kstep, voffB); PG8_STAGE(PG8_SA(1, 0), cA + kstep, voffA); PG8_STAGE(PG8_SB(1, 1), cB + hstepB + kstep, voffB);
        PG8_WAIT_V(6); PG8_BAR;
    } else {
        PG8_STAGE(PG8_SB(0, 0), cB, voffB); PG8_STAGE(PG8_SA(0, 0), cA, voffA); PG8_STAGE(PG8_SB(0, 1), cB + hstepB, voffB); PG8_STAGE(PG8_SA(0, 1), cA + hstepA, voffA);
        if (wr == 1) PG8_BAR;
        PG8_WAIT_V(4); PG8_BAR;
        PG8_STAGE(PG8_SB(1, 0), cB + kstep, voffB); PG8_STAGE(PG8_SA(1, 0), cA + kstep, voffA); PG8_STAGE(PG8_SB(1, 1), cB + hstepB + kstep, voffB);
        PG8_WAIT_V(6); PG8_BAR;
    }
    for (;;) {
        const bool has_next = S.next(ui + 1, nxt);
        const char* nA = has_next ? (const char*)g.A + (size_t)nxt.pm * tstepA : cA; const char* nB = has_next ? (const char*)g.Bt + (size_t)nxt.pn * tstepB : cB;
        for (int t = 0; t < nt; t += 2) {
            const bool last = (t == nt - 2);
            const char* a1 = cA + (size_t)(t + 1) * kstep;
            const char* a2 = last ? nA : cA + (size_t)(t + 2) * kstep; const char* b2 = last ? nB : cB + (size_t)(t + 2) * kstep;
            const char* a3 = a2 + kstep; const char* b3 = b2 + kstep;
            if (last && has_next) S.a_ready(nxt);
            if constexpr (SP2) {
            PG8_LDB(B0, 0, 0); PG8_LDB(B1, 0, 1); PG8_SCHED; PG8_LDA(At, 0, 0); PG8_STAGE(PG8_SA(1, 1), a1 + hstepA, voffA);
            PG8_WAIT_V(8); PG8_WAIT_L(0); PG8_BAR; PG8_MMA(0, 0, At, B0); PG8_MMA(0, 1, At, B1); PG8_BAR; PG8_SCHED;
            PG8_LDA(At, 0, 1); PG8_STAGE(PG8_SB(0, 0), b2, voffB); PG8_STAGE(PG8_SB(0, 1), b2 + hstepB, voffB); PG8_STAGE(PG8_SA(0, 0), a2, voffA);
            PG8_WAIT_V(8); PG8_WAIT_L(0); PG8_BAR; PG8_MMA(1, 0, At, B0); PG8_MMA(1, 1, At, B1); PG8_BAR; PG8_SCHED;
            PG8_LDB(B0, 1, 0); PG8_LDB(B1, 1, 1); PG8_SCHED; PG8_LDA(At, 1, 0); PG8_STAGE(PG8_SA(0, 1), a2 + hstepA, voffA);
            PG8_WAIT_V(8); PG8_WAIT_L(0); PG8_BAR; PG8_MMA(0, 0, At, B0); PG8_MMA(0, 1, At, B1); PG8_BAR; PG8_SCHED;
            PG8_LDA(At, 1, 1); PG8_STAGE(PG8_SB(1, 0), b3, voffB); PG8_STAGE(PG8_SB(1, 1), b3 + hstepB, voffB); PG8_STAGE(PG8_SA(1, 0), a3, voffA);
            PG8_WAIT_V(8); PG8_WAIT_L(0); PG8_BAR; PG8_MMA(1, 0, At, B0); PG8_MMA(1, 1, At, B1); PG8_BAR; PG8_SCHED;
            } else {
            PG8_LDB(B0, 0, 0); PG8_SCHED; PG8_LDA(At, 0, 0); PG8_STAGE(PG8_SA(1, 1), a1 + hstepA, voffA);
            PG8_WAIT_L(8); PG8_BAR; PG8_WAIT_L(0); PG8_MMA(0, 0, At, B0); PG8_BAR; PG8_SCHED;
            PG8_LDB(B1, 0, 1); PG8_STAGE(PG8_SB(0, 0), b2, voffB);
            PG8_BAR; PG8_WAIT_L(0); PG8_MMA(0, 1, At, B1); PG8_BAR;
            PG8_LDA(At, 0, 1); PG8_STAGE(PG8_SA(0, 0), a2, voffA);
            PG8_BAR; PG8_WAIT_L(0); PG8_MMA(1, 0, At, B0); PG8_BAR; PG8_SCHED;
            PG8_STAGE(PG8_SB(0, 1), b2 + hstepB, voffB);
            PG8_WAIT_V(6); PG8_BAR; PG8_MMA(1, 1, At, B1); PG8_BAR;
            PG8_LDB(B0, 1, 0); PG8_SCHED; PG8_LDA(At, 1, 0); PG8_STAGE(PG8_SA(0, 1), a2 + hstepA, voffA);
            PG8_WAIT_L(8); PG8_BAR; PG8_WAIT_L(0); PG8_MMA(0, 0, At, B0); PG8_BAR; PG8_SCHED;
            PG8_LDB(B1, 1, 1); PG8_STAGE(PG8_SB(1, 0), b3, voffB);
            PG8_BAR; PG8_WAIT_L(0); PG8_MMA(0, 1, At, B1); PG8_BAR;
            PG8_LDA(At, 1, 1); PG8_STAGE(PG8_SA(1, 0), a3, voffA);
            PG8_BAR; PG8_WAIT_L(0); PG8_MMA(1, 0, At, B0); PG8_BAR; PG8_SCHED;
            PG8_STAGE(PG8_SB(1, 1), b3 + hstepB, voffB);
            PG8_WAIT_V(6); PG8_BAR; PG8_MMA(1, 1, At, B1); PG8_BAR;
            }
        }
        if constexpr (ALIGN_EPI) { if (wr == 0) PG8_BAR; }
        if constexpr (!Epi::AFTER_DRAIN) { E(acc, cur, wr, wc, fr, fq); S.done(cur); }
        if (!has_next) break;
#pragma unroll
        for (int a = 0; a < 2; ++a)
#pragma unroll
            for (int b = 0; b < 2; ++b)
#pragma unroll
                for (int m = 0; m < 4; ++m)
#pragma unroll
                    for (int n = 0; n < 2; ++n) acc[a][b][m][n] = (f32x4){0.f, 0.f, 0.f, 0.f};
        cur = nxt; cA = nA; cB = nB; ++ui;
        if constexpr (ALIGN_EPI) { if (wr == 1) PG8_BAR; }
    }
    PG8_WAIT_V(0);
    if constexpr (!ALIGN_EPI) { if (wr == 0) PG8_BAR; }
    PG8_BAR;
    if constexpr (Epi::AFTER_DRAIN) { E.fused(acc, cur, wr, wc, fr, fq, lds, wid, lane); S.done(cur); }
#undef PG8_SA
#undef PG8_SB
#undef PG8_STAGE
#undef PG8_LDA
#undef PG8_LDB
#undef PG8_MMA
#undef PG8_WAIT_V
#undef PG8_WAIT_L
#undef PG8_BAR
#undef PG8_SCHED
}
}

constexpr int NWAVES = 8;
constexpr int BATCH = 8, SEQ = 4096, TT = BATCH * SEQ, D = 1024;
constexpr int HK = 8, HV = 16, HD = 128;
constexpr int GIN = 6176, GINP = 6400;
constexpr int FF = 3584, NE = 8, MOE_ROWS = 67584;
constexpr float ALPHA = 1.6817928305074290f;
constexpr float LN_EPS = 1e-5f, RMS_EPS = 1e-6f;
constexpr int NPH = 18, NPHASES = 2 * NPH;

constexpr size_t MiB = 1ull << 20;
constexpr size_t WS_CTL = 0, CTL_ZERO_BYTES = 1 * MiB;
constexpr size_t WS_E12 = 1 * MiB;
constexpr size_t WS_G12 = WS_E12 + 256 * 1024;
constexpr size_t WS_POS = WS_G12 + 256 * 1024;
constexpr size_t WS_GB = 2 * MiB;
constexpr size_t WS_W = 16 * MiB;
constexpr size_t WS_W2 = 912 * MiB;
constexpr size_t W_IN = WS_W2, W_OUT = WS_W2 + 13 * MiB, W_GU = WS_W2 + 17 * MiB, W_D = WS_W2 + 31 * MiB;
constexpr size_t W_QKV = WS_W, W_O = WS_W + 6 * MiB, W_MGU = WS_W + 8 * MiB, W_MD = WS_W + 120 * MiB;
constexpr size_t WS_HB = 192 * MiB;
constexpr size_t WS_BIG = 256 * MiB;
constexpr size_t WS_ZB = WS_BIG, WS_RAW = WS_BIG + 128 * MiB, WS_QKVC = WS_BIG + 400 * MiB;
constexpr int RAWLD = 4352;
constexpr size_t WS_WMEM = WS_RAW, WS_IMEM = WS_RAW + 128 * MiB, WS_KTMEM = WS_RAW + 192 * MiB;
constexpr size_t WS_STATS = 12 * MiB;
constexpr size_t WS_GTAB = 6 * MiB;
constexpr size_t WS_ACT = WS_BIG;
constexpr size_t WS_QKV = WS_BIG, WS_AO = WS_BIG + 192 * MiB;
constexpr size_t WS_XS = WS_BIG, WS_MACT = WS_BIG + 132 * MiB;
constexpr size_t WS_END = 950 * MiB;
static_assert(WS_QKVC + (size_t)TT * 4096 * 2 <= WS_W2 && WS_MACT + (size_t)MOE_ROWS * FF * 2 <= WS_END && WS_RAW + (size_t)TT * RAWLD * 2 <= WS_QKVC && WS_KTMEM + (size_t)4096 * 8192 * 2 <= WS_QKVC && WS_GTAB + (size_t)8192 * 192 * 4 <= WS_W, "d_ws map");
static_assert(W_MD + (size_t)NE * D * FF * 2 <= WS_HB && W_IN + (size_t)GINP * D * 2 <= W_OUT && W_D + (size_t)D * FF * 2 <= WS_END && WS_QKVC + (size_t)TT * 4096 * 2 <= WS_W2 && W_MGU + (size_t)NE * 2 * FF * D * 2 <= W_MD, "weight map");
constexpr int CW_BAR = 4096;
constexpr int CW_CNT = 16384;

constexpr int RING_BYTES = 131072;
constexpr int MISC_OFF = RING_BYTES + 320;
constexpr int OGST_OFF = 147456;
constexpr int LDS_BYTES = 163840;

#define GAS __attribute__((address_space(1)))
#define LAS __attribute__((address_space(3)))
#define DI __device__ __forceinline__
typedef unsigned short bf16;
typedef unsigned v4u __attribute__((ext_vector_type(4)));
typedef unsigned v2u __attribute__((ext_vector_type(2)));
typedef float f32x4 __attribute__((ext_vector_type(4)));
typedef float f32x2 __attribute__((ext_vector_type(2)));
typedef GAS unsigned gu32;
#define RLX_AGENT __ATOMIC_RELAXED, __HIP_MEMORY_SCOPE_AGENT
#define LDS_WAIT() asm volatile("s_waitcnt lgkmcnt(0)" ::: "memory")
#define VM_WAIT() asm volatile("s_waitcnt vmcnt(0)" ::: "memory")
__device__ __forceinline__ unsigned long long rt() { return __builtin_amdgcn_s_memrealtime(); }
__device__ __forceinline__ unsigned f2bf(float f) { unsigned u = __builtin_bit_cast(unsigned, f); return (u + 0x7fffu + ((u >> 16) & 1u)) >> 16; }
__device__ __forceinline__ unsigned pk2(float lo, float hi) { return f2bf(lo) | (f2bf(hi) << 16); }

#define XB_TMO      128
#define XB_XCNT(j)  (256  + 64 * (j))
#define XB_XSUB(j)  (1280 + 64 * (j))
#define XB_XGEN(j)  (2304 + 64 * (j))
#define XB_TOP      3328
#define XB_TOPGEN   3392
#define XCD_BAR_WORDS 3456
#define XB_SPIN_CAP (1u << 22)

__device__ __forceinline__ unsigned xb_ld(unsigned* p)              { return __hip_atomic_load(p, __ATOMIC_RELAXED, __HIP_MEMORY_SCOPE_AGENT); }
__device__ __forceinline__ unsigned xb_add(unsigned* p, unsigned v) { return __hip_atomic_fetch_add(p, v, __ATOMIC_RELAXED, __HIP_MEMORY_SCOPE_AGENT); }
__device__ __forceinline__ unsigned xb_xcc_id() { return (unsigned)__builtin_amdgcn_s_getreg((3 << 11) | 20) & 0xFu; }
#define XB_SPIN(cond, bar) do { unsigned _sp = 0; while (cond) { __builtin_amdgcn_s_sleep(1); \
    if ((++_sp & 255u) == 0u) { if (xb_ld(&(bar)[XB_TMO])) break; if (_sp > XB_SPIN_CAP) { atomicAdd(&(bar)[XB_TMO], 1u); break; } } } } while (0)

struct XcdBarrier {
    unsigned* bar; unsigned x;
    volatile LAS unsigned* st;
};

__device__ __forceinline__ XcdBarrier xcd_barrier_post(unsigned* bar, volatile LAS unsigned* st) {
    XcdBarrier b; b.bar = bar; b.x = xb_xcc_id(); b.st = st;
    if (threadIdx.x == 0) (void)xb_add(&bar[XB_XCNT(b.x)], 1u);
    return b;
}
__device__ __forceinline__ void xcd_barrier_complete(unsigned* bar, unsigned x, unsigned& nloc, unsigned& nx) {
    const unsigned G = gridDim.x * gridDim.y * gridDim.z;
    unsigned sum, cnt, mine, sp = 0u;
    for (;;) {
        sum = 0u; cnt = 0u; mine = 0u;
#pragma unroll
        for (unsigned j = 0; j < 16; ++j) { const unsigned c = xb_ld(&bar[XB_XCNT(j)]); sum += c; cnt += (c > 0u) ? 1u : 0u; mine = (j == x) ? c : mine; }
        if (sum == G) break;
        __builtin_amdgcn_s_sleep(1);
        if ((++sp & 255u) == 0u) { if (xb_ld(&bar[XB_TMO])) break; if (sp > XB_SPIN_CAP) { atomicAdd(&bar[XB_TMO], 1u); break; } }
    }
    nloc = mine > 0u ? mine : 1u; nx = cnt > 0u ? cnt : 1u;
}

__device__ __forceinline__ void xcd_barrier(const XcdBarrier& b) {
    asm volatile("s_waitcnt vmcnt(0)" ::: "memory");
    __syncthreads();
    if (threadIdx.x == 0) {
        unsigned* bar = b.bar;
        __builtin_amdgcn_s_waitcnt(0);
        unsigned nloc = b.st[0], nx = b.st[1];
        if (nloc == 0u) { xcd_barrier_complete(bar, b.x, nloc, nx); b.st[0] = nloc; b.st[1] = nx; }
        const unsigned old = xb_add(&bar[XB_XSUB(b.x)], 1u);
        const unsigned gen = old / nloc;
        if (old + 1u == (gen + 1u) * nloc) {
            __builtin_amdgcn_fence(__ATOMIC_RELEASE, "agent");
            asm volatile("s_waitcnt vmcnt(0)" ::: "memory");
            const unsigned og = xb_add(&bar[XB_TOP], 1u);
            const unsigned tg = og / nx;
            if (og + 1u == (tg + 1u) * nx) xb_add(&bar[XB_TOPGEN], 1u);
            else XB_SPIN(xb_ld(&bar[XB_TOPGEN]) == tg, bar);
            __builtin_amdgcn_fence(__ATOMIC_ACQUIRE, "agent");
            xb_add(&bar[XB_XGEN(b.x)], 1u);
            asm volatile("s_waitcnt vmcnt(0)" ::: "memory");
        } else {
            XB_SPIN(xb_ld(&bar[XB_XGEN(b.x)]) == gen, bar);
            __builtin_amdgcn_fence(__ATOMIC_ACQUIRE, "agent");
            asm volatile("s_waitcnt vmcnt(0)" ::: "memory");
        }
    }
    __syncthreads();
}

DI float bf_lo(unsigned w) { return __uint_as_float(w << 16); }
DI float bf_hi(unsigned w) { return __uint_as_float(w & 0xffff0000u); }
DI float wave_sum(float v) {
#pragma unroll
    for (int o = 1; o < 64; o <<= 1) v += __shfl_xor(v, o);
    return v;
}
DI float sigmoid_f(float x) { return 1.0f / (1.0f + __expf(-x)); }

struct Args {
    const float *x, *gdn_w_in, *gdn_conv_w, *gdn_a_log, *gdn_dt_bias, *gdn_norm_w, *gdn_w_out, *sb_w_in, *sb_w_out, *ffn_w_gate, *ffn_w_up, *ffn_w_down,
                *moe_router, *moe_w_gate, *moe_w_up, *moe_w_down, *ln_g, *ln_b;
    float* out; unsigned char* ws; int ph_lo, ph_hi;
};

DI void transpose_item(const float* W, int ldw, bf16* WT, int K, int drow0, int k0, int n0, LAS float* scr, int lane) {
#pragma unroll 8
    for (int i = 0; i < 32; ++i) { const int kk = 2 * i + (lane >> 5); scr[kk * 33 + (lane & 31)] = W[(size_t)(k0 + kk) * ldw + n0 + (lane & 31)]; }
    LDS_WAIT(); asm volatile("" ::: "memory");
    const int c = lane & 7;
#pragma unroll
    for (int jj = 0; jj < 4; ++jj) { const int n = (lane >> 3) + 8 * jj; const LAS float* s = scr + (8 * c) * 33 + n;
        v4u o; o.x = pk2(s[0 * 33], s[1 * 33]); o.y = pk2(s[2 * 33], s[3 * 33]); o.z = pk2(s[4 * 33], s[5 * 33]); o.w = pk2(s[6 * 33], s[7 * 33]);
        *(v4u*)(WT + (size_t)(drow0 + n) * K + k0 + 8 * c) = o; }
    LDS_WAIT(); asm volatile("" ::: "memory");
}

DI void transpose_item64(const float* W, int ldw, bf16* WT, int K, int drow0, int k0, int n0, LAS unsigned char* scr, int lane) {
    const int q = lane >> 4, cx = lane & 15;
    f32x4 r[16];
#pragma unroll
    for (int i = 0; i < 16; ++i) r[i] = *(const f32x4*)(W + (size_t)(k0 + 16 * q + i) * ldw + n0 + 4 * cx);
#pragma unroll
    for (int e = 0; e < 4; ++e) {
        v4u w0, w1;
        w0.x = pk2(r[0][e], r[1][e]); w0.y = pk2(r[2][e], r[3][e]); w0.z = pk2(r[4][e], r[5][e]); w0.w = pk2(r[6][e], r[7][e]);
        w1.x = pk2(r[8][e], r[9][e]); w1.y = pk2(r[10][e], r[11][e]); w1.z = pk2(r[12][e], r[13][e]); w1.w = pk2(r[14][e], r[15][e]);
        *(LAS v4u*)(scr + (4 * cx + e) * 144 + q * 32) = w0; *(LAS v4u*)(scr + (4 * cx + e) * 144 + q * 32 + 16) = w1;
    }
    LDS_WAIT(); asm volatile("" ::: "memory");
#pragma unroll
    for (int j = 0; j < 8; ++j) { const int id = lane + 64 * j, n = id >> 3, kp = id & 7;
        *(v4u*)(WT + (size_t)(drow0 + n) * K + k0 + 8 * kp) = *(const LAS v4u*)(scr + n * 144 + kp * 16); }
    LDS_WAIT(); asm volatile("" ::: "memory");
}

DI void phase_w_gdn(const Args& a, int j, LAS unsigned char* lds, int bid, int G, int tid, int wave, int lane) {
    LAS float* scr = (LAS float*)(lds + wave * 16384);
    const int gw = bid * NWAVES + wave, NGW = G * NWAVES;
    const float* Win = a.gdn_w_in + (size_t)j * D * GIN; const float* Wout = a.gdn_w_out + (size_t)j * 2048 * D;
    const float* Wg = a.ffn_w_gate + (size_t)j * D * FF; const float* Wu = a.ffn_w_up + (size_t)j * D * FF; const float* Wd = a.ffn_w_down + (size_t)j * FF * D;
    bf16* WIN_T = (bf16*)(a.ws + W_IN); bf16* WOUT_T = (bf16*)(a.ws + W_OUT); bf16* WGU_T = (bf16*)(a.ws + W_GU); bf16* WD_T = (bf16*)(a.ws + W_D);
    LAS unsigned char* scb = (LAS unsigned char*)scr;
    constexpr int I_IN = 16 * 96, I_INT = 16, I_OUT = 32 * 16, I_G = 16 * 56, I_D = 56 * 16, NIT = I_IN + I_INT + I_OUT + 2 * I_G + I_D;
    for (int it = gw; it < NIT; it += NGW) {
        int r = it;
        if (r < I_IN) { const int kb = r / 96, nb = r % 96; transpose_item64(Win, GIN, WIN_T, D, 64 * nb, 64 * kb, 64 * nb, scb, lane); continue; } r -= I_IN;
        if (r < I_INT) { transpose_item(Win, GIN, WIN_T, D, 6144, 64 * r, 6144, scr, lane); continue; } r -= I_INT;
        if (r < I_OUT) { const int kb = r / 16, nb = r % 16; transpose_item64(Wout, D, WOUT_T, 2048, 64 * nb, 64 * kb, 64 * nb, scb, lane); continue; } r -= I_OUT;
        if (r < I_G) { const int kb = r / 56, nb = r % 56, n0 = 64 * nb; transpose_item64(Wg, FF, WGU_T, D, 256 * (n0 >> 7) + (n0 & 127), 64 * kb, n0, scb, lane); continue; } r -= I_G;
        if (r < I_G) { const int kb = r / 56, nb = r % 56, n0 = 64 * nb; transpose_item64(Wu, FF, WGU_T, D, 256 * (n0 >> 7) + 128 + (n0 & 127), 64 * kb, n0, scb, lane); continue; } r -= I_G;
        { const int kb = r / 16, nb = r % 16; transpose_item64(Wd, D, WD_T, FF, 64 * nb, 64 * kb, 64 * nb, scb, lane); }
    }
    if (j == 0) {
        bf16* HB = (bf16*)(a.ws + WS_HB); const f32x4* x4 = (const f32x4*)a.x;
        for (size_t i = (size_t)bid * 512 + tid; i < (size_t)TT * D / 8; i += (size_t)G * 512) { const f32x4 p = x4[2 * i], q = x4[2 * i + 1];
            v4u o; o.x = pk2(p[0], p[1]); o.y = pk2(p[2], p[3]); o.z = pk2(q[0], q[1]); o.w = pk2(q[2], q[3]); *(v4u*)(HB + 8 * i) = o; }
    }
}
DI void phase_w_sb(const Args& a, int j, LAS unsigned char* lds, int bid, int G, int wave, int lane) {
    LAS float* scr = (LAS float*)(lds + wave * 16384);
    const int gw = bid * NWAVES + wave, NGW = G * NWAVES;
    const float* Wqkv = a.sb_w_in + (size_t)j * D * 3072; const float* Wo = a.sb_w_out + (size_t)j * D * D;
    const float* Mg = a.moe_w_gate + (size_t)j * NE * D * FF; const float* Mu = a.moe_w_up + (size_t)j * NE * D * FF; const float* Md = a.moe_w_down + (size_t)j * NE * FF * D;
    bf16* WQKV_T = (bf16*)(a.ws + W_QKV); bf16* WO_T = (bf16*)(a.ws + W_O); bf16* MGU_T = (bf16*)(a.ws + W_MGU); bf16* MD_T = (bf16*)(a.ws + W_MD);
    LAS unsigned char* scb = (LAS unsigned char*)scr;
    constexpr int I_QKV = 16 * 48, I_O = 16 * 16, I_G = 16 * 56, I_D = 56 * 16, I_E = 2 * I_G + I_D, NIT = I_QKV + I_O + NE * I_E;
    for (int it = gw; it < NIT; it += NGW) {
        int r = it;
        if (r < I_QKV) { const int kb = r / 48, nb = r % 48; transpose_item64(Wqkv, 3072, WQKV_T, D, 64 * nb, 64 * kb, 64 * nb, scb, lane); continue; } r -= I_QKV;
        if (r < I_O) { const int kb = r / 16, nb = r % 16; transpose_item64(Wo, D, WO_T, D, 64 * nb, 64 * kb, 64 * nb, scb, lane); continue; } r -= I_O;
        const int e = r / I_E; r -= e * I_E;
        bf16* gu = MGU_T + (size_t)e * 2 * FF * D; bf16* dn = MD_T + (size_t)e * D * FF;
        if (r < I_G) { const int kb = r / 56, nb = r % 56, n0 = 64 * nb; transpose_item64(Mg + (size_t)e * D * FF, FF, gu, D, 256 * (n0 >> 7) + (n0 & 127), 64 * kb, n0, scb, lane); continue; } r -= I_G;
        if (r < I_G) { const int kb = r / 56, nb = r % 56, n0 = 64 * nb; transpose_item64(Mu + (size_t)e * D * FF, FF, gu, D, 256 * (n0 >> 7) + 128 + (n0 & 127), 64 * kb, n0, scb, lane); continue; } r -= I_G;
        { const int kb = r / 16, nb = r % 16; transpose_item64(Md + (size_t)e * FF * D, D, dn, FF, 64 * nb, 64 * kb, 64 * nb, scb, lane); }
    }
}

DI float dpp_sum16(float v) {
    v += __builtin_bit_cast(float, __builtin_amdgcn_update_dpp(0, __builtin_bit_cast(int, v), 0xB1, 0xF, 0xF, false));
    v += __builtin_bit_cast(float, __builtin_amdgcn_update_dpp(0, __builtin_bit_cast(int, v), 0x4E, 0xF, 0xF, false));
    v += __builtin_bit_cast(float, __builtin_amdgcn_update_dpp(0, __builtin_bit_cast(int, v), 0x141, 0xF, 0xF, false));
    v += __builtin_bit_cast(float, __builtin_amdgcn_update_dpp(0, __builtin_bit_cast(int, v), 0x140, 0xF, 0xF, false));
    return v;
}
DI void phase_conv(const Args& a, int j, int bid, int G, int tid) {
    const bf16* raw = (const bf16*)(a.ws + WS_RAW); bf16* qkvc = (bf16*)(a.ws + WS_QKVC); float* gb = (float*)(a.ws + WS_GB);
    const float* cw = a.gdn_conv_w + (size_t)j * 4 * 4096;
    const int ch = 8 * tid;
    float w0[8], w1[8], w2[8], w3[8];
#pragma unroll
    for (int i = 0; i < 8; ++i) { w0[i] = cw[ch + i]; w1[i] = cw[4096 + ch + i]; w2[i] = cw[2 * 4096 + ch + i]; w3[i] = cw[3 * 4096 + ch + i]; }
    const float post = tid < 128 ? 0.08838834764831845f : 1.0f;
    for (int run = bid; run < TT / 128; run += G) {
        const int t0 = run * 128; const bool first = (t0 & (SEQ - 1)) == 0;
        float xa[8], xb[8], xc[8];
        { v4u h0 = {0u, 0u, 0u, 0u}, h1 = h0, h2 = h0;
          if (!first) { h0 = *(const v4u*)(raw + (size_t)(t0 - 3) * RAWLD + ch); h1 = *(const v4u*)(raw + (size_t)(t0 - 2) * RAWLD + ch); h2 = *(const v4u*)(raw + (size_t)(t0 - 1) * RAWLD + ch); }
          xa[0] = bf_lo(h0.x); xa[1] = bf_hi(h0.x); xa[2] = bf_lo(h0.y); xa[3] = bf_hi(h0.y); xa[4] = bf_lo(h0.z); xa[5] = bf_hi(h0.z); xa[6] = bf_lo(h0.w); xa[7] = bf_hi(h0.w);
          xb[0] = bf_lo(h1.x); xb[1] = bf_hi(h1.x); xb[2] = bf_lo(h1.y); xb[3] = bf_hi(h1.y); xb[4] = bf_lo(h1.z); xb[5] = bf_hi(h1.z); xb[6] = bf_lo(h1.w); xb[7] = bf_hi(h1.w);
          xc[0] = bf_lo(h2.x); xc[1] = bf_hi(h2.x); xc[2] = bf_lo(h2.y); xc[3] = bf_hi(h2.y); xc[4] = bf_lo(h2.z); xc[5] = bf_hi(h2.z); xc[6] = bf_lo(h2.w); xc[7] = bf_hi(h2.w); }
#pragma unroll 1
        for (int tb = 0; tb < 128; tb += 8) {
            v4u xr[8];
#pragma unroll
            for (int u = 0; u < 8; ++u) xr[u] = *(const v4u*)(raw + (size_t)(t0 + tb + u) * RAWLD + ch);
#pragma unroll
            for (int u = 0; u < 8; ++u) {
                float xd[8]; xd[0] = bf_lo(xr[u].x); xd[1] = bf_hi(xr[u].x); xd[2] = bf_lo(xr[u].y); xd[3] = bf_hi(xr[u].y); xd[4] = bf_lo(xr[u].z); xd[5] = bf_hi(xr[u].z); xd[6] = bf_lo(xr[u].w); xd[7] = bf_hi(xr[u].w);
                float y[8]; float ss = 0.f;
#pragma unroll
                for (int i = 0; i < 8; ++i) { const float c = w0[i] * xa[i] + w1[i] * xb[i] + w2[i] * xc[i] + w3[i] * xd[i];
                    y[i] = c * __builtin_amdgcn_rcpf(1.0f + __builtin_amdgcn_exp2f(-1.4426950408889634f * c)); ss += y[i] * y[i];
                    xa[i] = xb[i]; xb[i] = xc[i]; xc[i] = xd[i]; }
                if (tid < 256) {
                    const float rn = post / sqrtf(dpp_sum16(ss) + RMS_EPS);
#pragma unroll
                    for (int i = 0; i < 8; ++i) y[i] *= rn;
                }
                v4u o; o.x = pk2(y[0], y[1]); o.y = pk2(y[2], y[3]); o.z = pk2(y[4], y[5]); o.w = pk2(y[6], y[7]);
                *(v4u*)(qkvc + (size_t)(t0 + tb + u) * 4096 + ch) = o;
            }
        }
#pragma unroll
        for (int k = 0; k < 4; ++k) { const int item = tid + 512 * k, tok = t0 + (item >> 4), hv = item & 15;
            const float bb = __uint_as_float((unsigned)raw[(size_t)tok * RAWLD + 4096 + hv] << 16), aa = __uint_as_float((unsigned)raw[(size_t)tok * RAWLD + 4112 + hv] << 16);
            const float xx = aa + a.gdn_dt_bias[j * 16 + hv];
            const float sp = xx > 20.f ? xx : log1pf(__expf(xx));
            gb[(size_t)tok * 32 + hv] = -__expf(a.gdn_a_log[j * 16 + hv]) * sp;
            gb[(size_t)tok * 32 + 16 + hv] = sigmoid_f(bb); }
    }
}

DI void phase_gdn_naive(const Args& a, int j, LAS unsigned char* lds, int bid, int tid) {
    if (bid >= BATCH * HV) return;
    const int b = bid / HV, hv = bid % HV, hk = hv / 2, jc = tid & 127, r = tid >> 7;
    const bf16* zb = (const bf16*)(a.ws + WS_ZB); bf16* qkvc = (bf16*)(a.ws + WS_QKVC); const float* gb = (const float*)(a.ws + WS_GB);
    LAS float* qs = (LAS float*)lds; LAS float* ks = qs + 2048; LAS float* vs = ks + 2048; LAS float* gs = vs + 2048; LAS float* bs = gs + 16;
    LAS f32x2* red = (LAS f32x2*)(lds + 32768); LAS float* redkq = (LAS float*)(lds + 32768 + 8192); LAS float* ob = (LAS float*)(lds + 49152);
    float S[32];
#pragma unroll
    for (int i = 0; i < 32; ++i) S[i] = 0.f;
    const int lrow = tid >> 5, lcol = (tid & 31) * 4;
    for (int blk = 0; blk < SEQ / 16; ++blk) {
        const size_t t0 = (size_t)b * SEQ + blk * 16;
        __syncthreads();
        { const bf16* rowp = qkvc + (t0 + lrow) * 4096;
          const v2u qv = *(const v2u*)(rowp + hk * 128 + lcol), kv = *(const v2u*)(rowp + 1024 + hk * 128 + lcol), vv = *(const v2u*)(rowp + 2048 + hv * 128 + lcol);
          *(LAS f32x4*)(qs + lrow * 128 + lcol) = (f32x4){bf_lo(qv.x), bf_hi(qv.x), bf_lo(qv.y), bf_hi(qv.y)};
          *(LAS f32x4*)(ks + lrow * 128 + lcol) = (f32x4){bf_lo(kv.x), bf_hi(kv.x), bf_lo(kv.y), bf_hi(kv.y)};
          *(LAS f32x4*)(vs + lrow * 128 + lcol) = (f32x4){bf_lo(vv.x), bf_hi(vv.x), bf_lo(vv.y), bf_hi(vv.y)};
          if (tid < 16) { gs[tid] = __expf(gb[(t0 + tid) * 32 + hv]); bs[tid] = gb[(t0 + tid) * 32 + 16 + hv]; } }
        __syncthreads();
#pragma unroll 1
        for (int tt = 0; tt < 16; ++tt) {
            float pk = 0.f, pq = 0.f, pkq = 0.f;
#pragma unroll
            for (int i4 = 0; i4 < 8; ++i4) { const f32x4 k4 = *(const LAS f32x4*)(ks + tt * 128 + 32 * r + 4 * i4), q4 = *(const LAS f32x4*)(qs + tt * 128 + 32 * r + 4 * i4);
#pragma unroll
                for (int c = 0; c < 4; ++c) { pk += k4[c] * S[4 * i4 + c]; pq += q4[c] * S[4 * i4 + c]; pkq += k4[c] * q4[c]; } }
            const int buf = tt & 1;
            red[(buf * 4 + r) * 128 + jc] = (f32x2){pk, pq}; if (jc == 0) redkq[buf * 4 + r] = pkq;
            __syncthreads();
            float kS = 0.f, qS = 0.f, kq = 0.f;
#pragma unroll
            for (int rr = 0; rr < 4; ++rr) { const f32x2 p = red[(buf * 4 + rr) * 128 + jc]; kS += p.x; qS += p.y; kq += redkq[buf * 4 + rr]; }
            const float eg = gs[tt], vn = bs[tt] * (vs[tt * 128 + jc] - eg * kS);
#pragma unroll
            for (int i4 = 0; i4 < 8; ++i4) { const f32x4 k4 = *(const LAS f32x4*)(ks + tt * 128 + 32 * r + 4 * i4);
#pragma unroll
                for (int c = 0; c < 4; ++c) S[4 * i4 + c] = eg * S[4 * i4 + c] + k4[c] * vn; }
            if (r == 0) ob[tt * 128 + jc] = eg * qS + kq * vn;
        }
        __syncthreads();
        {
            const f32x4 o4 = *(const LAS f32x4*)(ob + lrow * 128 + lcol);
            float ss = o4[0] * o4[0] + o4[1] * o4[1] + o4[2] * o4[2] + o4[3] * o4[3];
            ss += __shfl_xor(ss, 1); ss += __shfl_xor(ss, 2); ss += __shfl_xor(ss, 4); ss += __shfl_xor(ss, 8); ss += __shfl_xor(ss, 16);
            const float rinv = 1.0f / sqrtf(ss * (1.0f / 128.0f) + RMS_EPS);
            const v2u zv = *(const v2u*)(zb + (t0 + lrow) * 2048 + hv * 128 + lcol);
            const f32x4 nw = *(const f32x4*)(a.gdn_norm_w + j * 128 + lcol);
            const float z0 = bf_lo(zv.x), z1 = bf_hi(zv.x), z2 = bf_lo(zv.y), z3 = bf_hi(zv.y);
            v2u o; o.x = pk2(o4[0] * rinv * nw[0] * z0 * sigmoid_f(z0), o4[1] * rinv * nw[1] * z1 * sigmoid_f(z1));
            o.y = pk2(o4[2] * rinv * nw[2] * z2 * sigmoid_f(z2), o4[3] * rinv * nw[3] * z3 * sigmoid_f(z3));
            *(v2u*)(qkvc + (t0 + lrow) * 4096 + 2048 + hv * 128 + lcol) = o;
        }
    }
}

template <bool ROUTER>
DI void phase_ln(const Args& a, int lnidx, int j, LAS unsigned char* lds, int bid, int G, int tid, int wave, int lane) {
    const float* out = a.out; bf16* HB = (bf16*)(a.ws + WS_HB); float* stats = (float*)(a.ws + WS_STATS);
    const float* g = a.ln_g + (size_t)lnidx * D; const float* bta = a.ln_b + (size_t)lnidx * D;
    const int gw = bid * NWAVES + wave, NGW = G * NWAVES;
    LAS unsigned* lcnt = (LAS unsigned*)lds;
    if (ROUTER) { if (tid < 8) lcnt[tid] = 0u; __syncthreads(); }
    f32x4 gv[4], bv[4];
#pragma unroll
    for (int q = 0; q < 4; ++q) { gv[q] = *(const f32x4*)(g + 4 * (lane + 64 * q)); bv[q] = *(const f32x4*)(bta + 4 * (lane + 64 * q)); }
    f32x4 nx[4];
    if (gw < TT) {
#pragma unroll
        for (int q = 0; q < 4; ++q) nx[q] = ((const f32x4*)(out + (size_t)gw * D))[lane + 64 * q]; }
    for (int t = gw; t < TT; t += NGW) {
        f32x4 v[4]; float s = 0.f;
#pragma unroll
        for (int q = 0; q < 4; ++q) { v[q] = nx[q]; s += (v[q][0] + v[q][1]) + (v[q][2] + v[q][3]); }
        if (t + NGW < TT) {
#pragma unroll
            for (int q = 0; q < 4; ++q) nx[q] = ((const f32x4*)(out + (size_t)(t + NGW) * D))[lane + 64 * q]; }
        const float mean = wave_sum(s) * (1.0f / D); float s2 = 0.f;
#pragma unroll
        for (int q = 0; q < 4; ++q) { v[q] = v[q] - mean; s2 += (v[q][0] * v[q][0] + v[q][1] * v[q][1]) + (v[q][2] * v[q][2] + v[q][3] * v[q][3]); }
        const float rstd = 1.0f / sqrtf(wave_sum(s2) * (1.0f / D) + LN_EPS);
        if (lane == 0) *(f32x2*)(stats + 2 * (size_t)t) = (f32x2){mean, rstd};
#pragma unroll
        for (int q = 0; q < 4; ++q) { v[q] = v[q] * rstd * gv[q] + bv[q];
            v2u o; o.x = pk2(v[q][0], v[q][1]); o.y = pk2(v[q][2], v[q][3]); *(v2u*)(HB + (size_t)t * D + 4 * (lane + 64 * q)) = o; }
        if (ROUTER) {
            const float* R = a.moe_router + (size_t)j * D * NE;
            float lg[8];
#pragma unroll
            for (int e = 0; e < 8; ++e) lg[e] = 0.f;
#pragma unroll
            for (int q = 0; q < 4; ++q)
#pragma unroll
                for (int c = 0; c < 4; ++c) { const int k = 4 * (lane + 64 * q) + c; const f32x4 r0 = *(const f32x4*)(R + k * 8), r1 = *(const f32x4*)(R + k * 8 + 4); const float hv = v[q][c];
                    lg[0] += hv * r0[0]; lg[1] += hv * r0[1]; lg[2] += hv * r0[2]; lg[3] += hv * r0[3]; lg[4] += hv * r1[0]; lg[5] += hv * r1[1]; lg[6] += hv * r1[2]; lg[7] += hv * r1[3]; }
#pragma unroll
            for (int e = 0; e < 8; ++e) lg[e] = wave_sum(lg[e]);
            int i1 = 0; float v1 = lg[0];
#pragma unroll
            for (int e = 1; e < 8; ++e) if (lg[e] > v1) { v1 = lg[e]; i1 = e; }
            int i2 = -1; float v2 = -3.0e38f;
#pragma unroll
            for (int e = 0; e < 8; ++e) if (e != i1 && lg[e] > v2) { v2 = lg[e]; i2 = e; }
            if (lane == 0) {
                const float g1 = 1.0f / (1.0f + __expf(v2 - v1));
                ((unsigned*)(a.ws + WS_E12))[t] = (unsigned)i1 | ((unsigned)i2 << 8);
                ((f32x2*)(a.ws + WS_G12))[t] = (f32x2){g1, 1.0f - g1};
                __hip_atomic_fetch_add(lcnt + i1, 1u, __ATOMIC_RELAXED, __HIP_MEMORY_SCOPE_WORKGROUP); __hip_atomic_fetch_add(lcnt + i2, 1u, __ATOMIC_RELAXED, __HIP_MEMORY_SCOPE_WORKGROUP);
            }
        }
    }
    if (ROUTER) { __syncthreads(); if (tid < 8) { unsigned* cnt = (unsigned*)(a.ws + WS_CTL) + CW_CNT + 256 * j; __hip_atomic_fetch_add(cnt + tid, lcnt[tid], __ATOMIC_RELAXED, __HIP_MEMORY_SCOPE_AGENT); } }
}

DI void phase_sb_naive(const Args& a, LAS unsigned char* lds, int bid, int G, int tid) {
    const bf16* qkv = (const bf16*)(a.ws + WS_QKV); bf16* ao = (bf16*)(a.ws + WS_AO);
    LAS unsigned char* Ks = lds; LAS unsigned char* Vs = lds + 16384;
    const int qi = tid >> 2, r = tid & 3;
    for (int idx = bid; idx < 64 * 32; idx += G) {
        const int qb = 31 - idx / 64, bh = idx % 64, b = bh >> 3, h = bh & 7;
        const int t = qb * 128 + qi;
        const size_t rowq = (size_t)b * SEQ + t;
        float q[32], o[32];
        { const bf16* qp = qkv + rowq * 3072 + h * 128 + 32 * r;
#pragma unroll
          for (int c = 0; c < 4; ++c) { const v4u w = *(const v4u*)(qp + 8 * c);
              q[8 * c + 0] = bf_lo(w.x); q[8 * c + 1] = bf_hi(w.x); q[8 * c + 2] = bf_lo(w.y); q[8 * c + 3] = bf_hi(w.y);
              q[8 * c + 4] = bf_lo(w.z); q[8 * c + 5] = bf_hi(w.z); q[8 * c + 6] = bf_lo(w.w); q[8 * c + 7] = bf_hi(w.w); }
#pragma unroll
          for (int i = 0; i < 32; ++i) { q[i] *= 0.08838834764831845f; o[i] = 0.f; } }
        float P = 1.0f;
        for (int kt = 2 * qb + 1; kt >= 0; --kt) {
            __syncthreads();
#pragma unroll
            for (int i = 0; i < 2; ++i) { const int c = tid + 512 * i, row = c >> 4, part = c & 15;
                const bf16* src = qkv + ((size_t)b * SEQ + kt * 64 + row) * 3072 + h * 128 + part * 8;
                *(LAS v4u*)(Ks + c * 16) = *(const v4u*)(src + 1024); *(LAS v4u*)(Vs + c * 16) = *(const v4u*)(src + 2048); }
            __syncthreads();
#pragma unroll 1
            for (int s = 63; s >= 0; --s) {
                float z = 0.f;
#pragma unroll
                for (int c = 0; c < 4; ++c) { const v4u w = *(const LAS v4u*)(Ks + s * 256 + r * 64 + c * 16);
                    z += q[8 * c + 0] * bf_lo(w.x) + q[8 * c + 1] * bf_hi(w.x) + q[8 * c + 2] * bf_lo(w.y) + q[8 * c + 3] * bf_hi(w.y)
                       + q[8 * c + 4] * bf_lo(w.z) + q[8 * c + 5] * bf_hi(w.z) + q[8 * c + 6] * bf_lo(w.w) + q[8 * c + 7] * bf_hi(w.w); }
                z += __shfl_xor(z, 1); z += __shfl_xor(z, 2);
                const bool live = (kt * 64 + s) < t;
                const float e = __expf(fminf(z, 80.f)), rr = 1.0f / (1.0f + e);
                const float A = live ? e * rr * P : 0.f;
                P = live ? P * rr : P;
#pragma unroll
                for (int c = 0; c < 4; ++c) { const v4u w = *(const LAS v4u*)(Vs + s * 256 + r * 64 + c * 16);
                    o[8 * c + 0] += A * bf_lo(w.x); o[8 * c + 1] += A * bf_hi(w.x); o[8 * c + 2] += A * bf_lo(w.y); o[8 * c + 3] += A * bf_hi(w.y);
                    o[8 * c + 4] += A * bf_lo(w.z); o[8 * c + 5] += A * bf_hi(w.z); o[8 * c + 6] += A * bf_lo(w.w); o[8 * c + 7] += A * bf_hi(w.w); }
            }
        }
        { bf16* op = ao + rowq * 1024 + h * 128 + 32 * r;
#pragma unroll
          for (int c = 0; c < 4; ++c) { v4u w; w.x = pk2(o[8 * c + 0], o[8 * c + 1]); w.y = pk2(o[8 * c + 2], o[8 * c + 3]); w.z = pk2(o[8 * c + 4], o[8 * c + 5]); w.w = pk2(o[8 * c + 6], o[8 * c + 7]);
              *(v4u*)(op + 8 * c) = w; } }
    }
}


namespace sba {
using bf16x8 = __attribute__((ext_vector_type(8))) short;
using s16x4  = __attribute__((ext_vector_type(4))) short;
using f32x16 = __attribute__((ext_vector_type(16))) float;
constexpr int SHM_V = 16384, SHM_K = 16384, LDQ = 3072;
#define KSWZ(row, colB) ((row) * 256 + ((colB) ^ (((row) & 7) << 4)))
#define SBAR() __builtin_amdgcn_sched_barrier(0)
DI int crow(int r, int hi) { return (r & 3) + 8 * (r >> 2) + 4 * hi; }
DI int v_st(int k, int c) { const int kk = (k & ~0xC) | ((k & 4) << 1) | ((k & 8) >> 1); return ((kk >> 3) * 4 + (c >> 5)) * 512 + ((kk & 7) * 32 + (c & 31)) * 2; }
DI int v_rd_base(int lane) { return ((lane & 3) << 3) | (((lane >> 2) & 3) << 6) | (((lane >> 4) & 1) << 5) | (((lane >> 5) & 1) << 8); }
constexpr int v_rd_off(int d0, int ks, int half) { return d0 * 512 + ks * 4096 + half * 2048; }
template <int OFF> DI s16x4 tr_read(int vb) { s16x4 r; asm volatile("ds_read_b64_tr_b16 %0, %1 offset:%2" : "=&v"(r) : "v"(vb), "i"(OFF) : "memory"); return r; }
template <int D0> DI void pv_one(f32x16& od, int vb, bf16x8 pa0, bf16x8 pa1, bf16x8 pa2, bf16x8 pa3) {
  const s16x4 l0 = tr_read<v_rd_off(D0, 0, 0)>(vb), h0 = tr_read<v_rd_off(D0, 0, 1)>(vb), l1 = tr_read<v_rd_off(D0, 1, 0)>(vb), h1 = tr_read<v_rd_off(D0, 1, 1)>(vb);
  const s16x4 l2 = tr_read<v_rd_off(D0, 2, 0)>(vb), h2 = tr_read<v_rd_off(D0, 2, 1)>(vb), l3 = tr_read<v_rd_off(D0, 3, 0)>(vb), h3 = tr_read<v_rd_off(D0, 3, 1)>(vb);
  asm volatile("s_waitcnt lgkmcnt(0)" ::: "memory"); SBAR();
#define PK(L, H) (bf16x8){L[0], L[1], L[2], L[3], H[0], H[1], H[2], H[3]}
  od = __builtin_amdgcn_mfma_f32_32x32x16_bf16(pa0, PK(l0, h0), od, 0, 0, 0);
  od = __builtin_amdgcn_mfma_f32_32x32x16_bf16(pa1, PK(l1, h1), od, 0, 0, 0);
  od = __builtin_amdgcn_mfma_f32_32x32x16_bf16(pa2, PK(l2, h2), od, 0, 0, 0);
  od = __builtin_amdgcn_mfma_f32_32x32x16_bf16(pa3, PK(l3, h3), od, 0, 0, 0);
#undef PK
}
template <int D0> DI void pv_one_T(f32x16& od, int vb, bf16x8 pa0, bf16x8 pa1, bf16x8 pa2, bf16x8 pa3) {
  const s16x4 l0 = tr_read<v_rd_off(D0, 0, 0)>(vb), h0 = tr_read<v_rd_off(D0, 0, 1)>(vb), l1 = tr_read<v_rd_off(D0, 1, 0)>(vb), h1 = tr_read<v_rd_off(D0, 1, 1)>(vb);
  const s16x4 l2 = tr_read<v_rd_off(D0, 2, 0)>(vb), h2 = tr_read<v_rd_off(D0, 2, 1)>(vb), l3 = tr_read<v_rd_off(D0, 3, 0)>(vb), h3 = tr_read<v_rd_off(D0, 3, 1)>(vb);
  asm volatile("s_waitcnt lgkmcnt(0)" ::: "memory"); SBAR();
#define PK(L, H) (bf16x8){L[0], L[1], L[2], L[3], H[0], H[1], H[2], H[3]}
  od = __builtin_amdgcn_mfma_f32_32x32x16_bf16(PK(l0, h0), pa0, od, 0, 0, 0);
  od = __builtin_amdgcn_mfma_f32_32x32x16_bf16(PK(l1, h1), pa1, od, 0, 0, 0);
  od = __builtin_amdgcn_mfma_f32_32x32x16_bf16(PK(l2, h2), pa2, od, 0, 0, 0);
  od = __builtin_amdgcn_mfma_f32_32x32x16_bf16(PK(l3, h3), pa3, od, 0, 0, 0);
#undef PK
}
DI void qkt(f32x16& p0, f32x16& p1, const LAS unsigned char* Ks, const bf16x8 (&qr)[8], int r32, int hi) {
  p0 = f32x16{}; p1 = f32x16{};
#pragma unroll
  for (int d0 = 0; d0 < 8; ++d0) { const int cb = (d0 * 16 + hi * 8) * 2;
    const bf16x8 b0 = *(const LAS bf16x8*)(Ks + KSWZ(r32, cb));
    const bf16x8 b1 = *(const LAS bf16x8*)(Ks + KSWZ(32 + r32, cb));
    p0 = __builtin_amdgcn_mfma_f32_32x32x16_bf16(b0, qr[d0], p0, 0, 0, 0);
    p1 = __builtin_amdgcn_mfma_f32_32x32x16_bf16(b1, qr[d0], p1, 0, 0, 0); }
}
template <bool MASK> DI void sb_half(f32x16& p, float& Pc, int hi, int kbase, int trow) {
  constexpr float C = 0.08838834764831845f * 1.4426950408889634f;
  float rr[16];
#pragma unroll
  for (int r = 0; r < 16; ++r) {
    float z = p[r] * C;
    if (MASK) z = (kbase + crow(r, hi) < trow) ? z : -__builtin_inff();
    const float k = __builtin_amdgcn_rcpf(1.0f + __builtin_amdgcn_exp2f(z));
    rr[r] = k; p[r] = 1.0f - k;
  }
  float R0[4], R1[4];
#pragma unroll
  for (int g = 0; g < 4; ++g) {
    const float c2 = rr[4 * g + 3], c1 = c2 * rr[4 * g + 2], c0 = c1 * rr[4 * g + 1], R = c0 * rr[4 * g];
    rr[4 * g + 2] = c2; rr[4 * g + 1] = c1; rr[4 * g] = c0;
    const auto sw = __builtin_amdgcn_permlane32_swap(__float_as_uint(R), __float_as_uint(R), false, false);
    R0[g] = __uint_as_float(sw[0]); R1[g] = __uint_as_float(sw[1]);
  }
#pragma unroll
  for (int g = 3; g >= 0; --g) {
    const float Pin = hi ? Pc : Pc * R1[g];
    p[4 * g + 3] *= Pin; p[4 * g + 2] *= Pin * rr[4 * g + 2]; p[4 * g + 1] *= Pin * rr[4 * g + 1]; p[4 * g] *= Pin * rr[4 * g];
    Pc *= R0[g] * R1[g];
  }
}
DI unsigned cvtpk(float lo, float hi) { unsigned r; asm volatile("v_cvt_pk_bf16_f32 %0, %1, %2" : "=v"(r) : "v"(lo), "v"(hi)); return r; }
#define PK4(P, BASE, OUT) do { const unsigned a0 = cvtpk(P[BASE + 0], P[BASE + 1]), a1 = cvtpk(P[BASE + 2], P[BASE + 3]);   \
    const unsigned b0 = cvtpk(P[BASE + 4], P[BASE + 5]), b1 = cvtpk(P[BASE + 6], P[BASE + 7]);                              \
    const auto r0 = __builtin_amdgcn_permlane32_swap(a0, b0, false, false); const auto r1 = __builtin_amdgcn_permlane32_swap(a1, b1, false, false); \
    const v4u w = {r0[0], r1[0], r0[1], r1[1]}; OUT = __builtin_bit_cast(bf16x8, w); } while (0)

DI void unit(const bf16* qkv, bf16* ao, int b, int h, int qb, LAS unsigned char* lds, int tid) {
  const int wid = __builtin_amdgcn_readfirstlane(tid >> 6), lane = tid & 63, r32 = lane & 31, hi = lane >> 5;
  LAS unsigned char* V_lds = lds; LAS unsigned char* K_lds = lds + 2 * SHM_V;
  const size_t rowbase = (size_t)b * SEQ; const int q0 = qb * 256, t_lo = q0 + wid * 32, trow = t_lo + r32;
  bf16x8 qr[8];
  { const bf16* Qw = qkv + (rowbase + trow) * LDQ + h * 128 + hi * 8;
#pragma unroll
    for (int d0 = 0; d0 < 8; ++d0) qr[d0] = *(const bf16x8*)(Qw + d0 * 16); }
  const bf16* Kh = qkv + rowbase * LDQ + 1024 + h * 128; const bf16* Vh = Kh + 1024;
  const int sr = tid >> 4, sc = (tid & 15) * 8, vst0 = v_st(sr, sc), vst1 = v_st(32 + sr, sc);
  const int vb0 = (int)(unsigned)(size_t)V_lds + v_rd_base(lane);
  bf16x8 vs0, vs1, ks0, ks1;
#define SLOAD(k0) do { vs0 = *(const bf16x8*)(Vh + (size_t)((k0) + sr) * LDQ + sc); vs1 = *(const bf16x8*)(Vh + (size_t)((k0) + 32 + sr) * LDQ + sc); \
    ks0 = *(const bf16x8*)(Kh + (size_t)((k0) + sr) * LDQ + sc); ks1 = *(const bf16x8*)(Kh + (size_t)((k0) + 32 + sr) * LDQ + sc); } while (0)
#define SWRITE(bb) do { *(LAS bf16x8*)(V_lds + (bb) * SHM_V + vst0) = vs0; *(LAS bf16x8*)(V_lds + (bb) * SHM_V + vst1) = vs1; const int kc = sc * 2; \
    *(LAS bf16x8*)(K_lds + (bb) * SHM_K + KSWZ(sr, kc)) = ks0; *(LAS bf16x8*)(K_lds + (bb) * SHM_K + KSWZ(32 + sr, kc)) = ks1; } while (0)
  f32x16 o[4] = {}; float Pc = 1.0f;
  const int kt_max = qb * 4 + 3;
  SLOAD(kt_max * 64);
  for (int kt = kt_max; kt >= 0; --kt) {
    const int buf = kt & 1, k0 = kt * 64;
    asm volatile("s_waitcnt vmcnt(0)" ::: "memory");
    SWRITE(buf);
    if (kt > 0) SLOAD(k0 - 64);
    __syncthreads();
    if (k0 < t_lo + 31) {
      f32x16 p0, p1;
      qkt(p0, p1, K_lds + buf * SHM_K, qr, r32, hi);
      if (k0 + 63 >= t_lo) { sb_half<true>(p1, Pc, hi, k0 + 32, trow); sb_half<true>(p0, Pc, hi, k0, trow); }
      else { sb_half<false>(p1, Pc, hi, k0 + 32, trow); sb_half<false>(p0, Pc, hi, k0, trow); }
      bf16x8 pa0, pa1, pa2, pa3;
      PK4(p0, 0, pa0); PK4(p0, 8, pa1); PK4(p1, 0, pa2); PK4(p1, 8, pa3);
      const int vb = vb0 + buf * SHM_V;
      pv_one<0>(o[0], vb, pa0, pa1, pa2, pa3); pv_one<1>(o[1], vb, pa0, pa1, pa2, pa3); pv_one<2>(o[2], vb, pa0, pa1, pa2, pa3); pv_one<3>(o[3], vb, pa0, pa1, pa2, pa3);
    }
  }
  bf16* Ow = ao + (rowbase + t_lo) * 1024 + h * 128 + r32;
#pragma unroll
  for (int r = 0; r < 16; ++r) { const int orow = crow(r, hi);
#pragma unroll
    for (int d0 = 0; d0 < 4; ++d0) Ow[(size_t)orow * 1024 + d0 * 32] = (bf16)(cvtpk(o[d0][r], 0.f) & 0xffffu); }
#undef SLOAD
#undef SWRITE
}
#undef PK4
#undef KSWZ
#undef SBAR
}
DI void phase_sb_mfma(const Args& a, LAS unsigned char* lds, int bid, int G, int tid) {
    const bf16* qkv = (const bf16*)(a.ws + WS_QKV); bf16* ao = (bf16*)(a.ws + WS_AO);
    const int vcu = (G % 8 == 0) ? (bid % 8) * (G / 8) + bid / 8 : bid;
    for (int pi = vcu; pi < 512; pi += G) {
        const int bh = pi >> 3, p = pi & 7, b = bh >> 3, h = bh & 7;
        sba::unit(qkv, ao, b, h, 15 - p, lds, tid);
        sba::unit(qkv, ao, b, h, p, lds, tid);
    }
}


namespace gdn {
using bf16x8 = __attribute__((ext_vector_type(8))) short;
using s16x4  = __attribute__((ext_vector_type(4))) short;
using f32x16 = __attribute__((ext_vector_type(16))) float;
typedef float f2v __attribute__((ext_vector_type(2)));
typedef __bf16 b2v __attribute__((ext_vector_type(2)));
DI unsigned pk(float a, float b) { const f2v v = {a, b}; const b2v r = __builtin_convertvector(v, b2v); return __builtin_bit_cast(unsigned, r); }
DI int crow(int r, int hi) { return (r & 3) + 8 * (r >> 2) + 4 * hi; }
DI int pi_slot(int x) { return 8 * ((x >> 2) & 3) + 4 * ((x >> 4) & 1) + (x & 3); }
DI bf16x8 pack_step(const f32x16& x, int s) {
    v4u w; w.x = pk(x[8 * s + 0], x[8 * s + 1]); w.y = pk(x[8 * s + 2], x[8 * s + 3]); w.z = pk(x[8 * s + 4], x[8 * s + 5]); w.w = pk(x[8 * s + 6], x[8 * s + 7]);
    return __builtin_bit_cast(bf16x8, w);
}
DI f32x16 mm(const f32x16& P, const f32x16& Q, f32x16 acc) {
    acc = __builtin_amdgcn_mfma_f32_32x32x16_bf16(pack_step(P, 0), pack_step(Q, 0), acc, 0, 0, 0);
    acc = __builtin_amdgcn_mfma_f32_32x32x16_bf16(pack_step(P, 1), pack_step(Q, 1), acc, 0, 0, 0);
    return acc;
}
#define GPK4(P, BASE, OUT) do { const unsigned a0 = pk(P[BASE + 0], P[BASE + 1]), a1 = pk(P[BASE + 2], P[BASE + 3]);   \
    const unsigned b0 = pk(P[BASE + 4], P[BASE + 5]), b1 = pk(P[BASE + 6], P[BASE + 7]);                              \
    const auto r0 = __builtin_amdgcn_permlane32_swap(a0, b0, false, false); const auto r1 = __builtin_amdgcn_permlane32_swap(a1, b1, false, false); \
    const v4u w_ = {r0[0], r1[0], r0[1], r1[1]}; OUT = __builtin_bit_cast(bf16x8, w_); } while (0)

DI void local_unit(const Args& a, int unit, LAS unsigned char* img, LAS float* tab, int lane, bool dry) {
    const int r32 = lane & 31, hi = lane >> 5;
    const int chunk = unit & 63, bh = unit >> 6, hv = bh & 15, b = bh >> 4, hk = hv >> 1;
    const size_t t0 = (size_t)b * SEQ + chunk * 64;
    bf16* qkvc = (bf16*)(a.ws + WS_QKVC); const float* gb = (const float*)(a.ws + WS_GB);
    bf16* wmem = (bf16*)(a.ws + WS_WMEM) + (size_t)unit * 8192; bf16* imem = (bf16*)(a.ws + WS_IMEM) + (size_t)unit * 4096;
    bf16* ktmem = (bf16*)(a.ws + WS_KTMEM) + (size_t)((b * HK + hk) * 64 + chunk) * 8192; float* gtab = (float*)(a.ws + WS_GTAB) + (size_t)unit * 192;
    float gc = gb[(t0 + lane) * 32 + hv]; const float be = gb[(t0 + lane) * 32 + 16 + hv];
#pragma unroll
    for (int off = 1; off < 64; off <<= 1) { const float y = __shfl_up(gc, off); if (lane >= off) gc += y; }
    const float glast = __shfl(gc, 63);
    tab[lane] = gc; tab[64 + lane] = be; tab[128 + lane] = -be * __expf(gc);
    gtab[lane] = __expf(gc); gtab[64 + lane] = __expf(glast - gc); if (lane == 0) gtab[128] = __expf(glast);
    const bf16* kbase = qkvc + t0 * 4096 + 1024 + hk * 128; const bf16* qbase = qkvc + t0 * 4096 + hk * 128; bf16* vbase = qkvc + t0 * 4096 + 2048 + hv * 128;
#define GSB() __builtin_amdgcn_sched_barrier(0)
    {
        f32x16 IT00 = {}, IT11 = {}, IT01 = {};
#pragma unroll
        for (int s = 0; s < 8; ++s) {
            const bf16x8 k0 = *(const bf16x8*)(kbase + (size_t)r32 * 4096 + 16 * s + 8 * hi), k1 = *(const bf16x8*)(kbase + (size_t)(32 + r32) * 4096 + 16 * s + 8 * hi);
            const bf16x8 q0 = *(const bf16x8*)(qbase + (size_t)r32 * 4096 + 16 * s + 8 * hi), q1 = *(const bf16x8*)(qbase + (size_t)(32 + r32) * 4096 + 16 * s + 8 * hi);
            IT00 = __builtin_amdgcn_mfma_f32_32x32x16_bf16(k0, q0, IT00, 0, 0, 0); IT11 = __builtin_amdgcn_mfma_f32_32x32x16_bf16(k1, q1, IT11, 0, 0, 0);
            IT01 = __builtin_amdgcn_mfma_f32_32x32x16_bf16(k0, q1, IT01, 0, 0, 0);
        }
#pragma unroll
        for (int I = 0; I < 2; ++I) { const int c = 32 * I + r32; const float gcc = tab[c];
#pragma unroll
            for (int J = 0; J < 2; ++J)
#pragma unroll
                for (int g = 0; g < 4; ++g) { float v[4];
#pragma unroll
                    for (int i = 0; i < 4; ++i) { const int r = 4 * g + i, cp = 32 * J + crow(r, hi);
                        const float raw = (I == 0) ? (J == 0 ? IT00[r] : 0.f) : (J == 0 ? IT01[r] : IT11[r]);
                        const float val = raw * __expf(-fabsf(gcc - tab[cp])); v[i] = (c >= cp) ? val : 0.f; }
                    v2u o; o.x = pk(v[0], v[1]); o.y = pk(v[2], v[3]);
                    *(v2u*)(imem + (unsigned)((((I * 2 + J) * 4 + g) * 64 + lane) * 4)) = o; } }
    }
    GSB();
    f32x16 T1, T1T, T2T, T21T;
    {
        f32x16 KK = {};
#pragma unroll
        for (int s = 0; s < 8; ++s) { const bf16x8 k0 = *(const bf16x8*)(kbase + (size_t)r32 * 4096 + 16 * s + 8 * hi); KK = __builtin_amdgcn_mfma_f32_32x32x16_bf16(k0, k0, KK, 0, 0, 0); }
        f32x16 M, MT;
        { const float gb0 = tab[r32], bb0 = tab[64 + r32];
#pragma unroll
        for (int r = 0; r < 16; ++r) { const int a0 = crow(r, hi), b0 = r32; const float ke = -KK[r] * __expf(-fabsf(tab[a0] - gb0));
            const float nv = ke * tab[64 + a0], ntv = ke * bb0;
            const float n = (a0 > b0) ? nv : 0.f, nt = (b0 > a0) ? ntv : 0.f, id = (a0 == b0) ? 1.f : 0.f;
            M[r] = n; MT[r] = nt; T1[r] = id + n; T1T[r] = id + nt; } }
#pragma unroll
        for (int it = 0; it < 4; ++it) { const f32x16 z = {};
            const f32x16 Mn = mm(MT, M, z), MTn = mm(M, MT, z);
            const f32x16 Tn = mm(T1T, Mn, T1);
            T1T = mm(Mn, T1T, T1T);
            T1 = Tn; M = Mn; MT = MTn; }
    }
    GSB();
    {
        f32x16 KK = {};
#pragma unroll
        for (int s = 0; s < 8; ++s) { const bf16x8 k1 = *(const bf16x8*)(kbase + (size_t)(32 + r32) * 4096 + 16 * s + 8 * hi); KK = __builtin_amdgcn_mfma_f32_32x32x16_bf16(k1, k1, KK, 0, 0, 0); }
        f32x16 M, MT;
        { const float gb0 = tab[32 + r32], bb0 = tab[96 + r32];
#pragma unroll
        for (int r = 0; r < 16; ++r) { const int a0 = crow(r, hi), b0 = r32; const float ke = -KK[r] * __expf(-fabsf(tab[32 + a0] - gb0));
            const float nv = ke * tab[96 + a0], ntv = ke * bb0;
            const float n = (a0 > b0) ? nv : 0.f, nt = (b0 > a0) ? ntv : 0.f, id = (a0 == b0) ? 1.f : 0.f;
            M[r] = n; MT[r] = nt; T2T[r] = id + nt; } }
#pragma unroll
        for (int it = 0; it < 4; ++it) { const f32x16 z = {};
            const f32x16 Mn = mm(MT, M, z), MTn = mm(M, MT, z);
            T2T = mm(Mn, T2T, T2T);
            M = Mn; MT = MTn; }
    }
    GSB();
    {
        f32x16 L21 = {};
#pragma unroll
        for (int s = 0; s < 8; ++s) { const bf16x8 k0 = *(const bf16x8*)(kbase + (size_t)r32 * 4096 + 16 * s + 8 * hi), k1 = *(const bf16x8*)(kbase + (size_t)(32 + r32) * 4096 + 16 * s + 8 * hi);
            L21 = __builtin_amdgcn_mfma_f32_32x32x16_bf16(k1, k0, L21, 0, 0, 0); }
#pragma unroll
        for (int r = 0; r < 16; ++r) { const int a0 = crow(r, hi); L21[r] = L21[r] * tab[96 + a0] * __expf(tab[32 + a0] - tab[r32]); }
        const f32x16 z = {}; const f32x16 Y = mm(L21, T2T, z); T21T = mm(T1, Y, z);
#pragma unroll
        for (int r = 0; r < 16; ++r) T21T[r] = -T21T[r];
    }
    GSB();
    const int vb = (int)(unsigned)(size_t)img + sba::v_rd_base(lane);
    bf16* ubl = dry ? (bf16*)(a.ws + WS_END) + (size_t)(unit & 63) * 64 * 4096 : vbase;
#pragma unroll 1
    for (int mode = 0; mode < 2; ++mode) {
        const bf16* src = mode == 0 ? (const bf16*)vbase : kbase;
#pragma unroll 4
        for (int it = 0; it < 16; ++it) { const int row = (lane >> 4) + 4 * it, col = (lane & 15) * 8;
            *(LAS v4u*)(img + sba::v_st(row, col)) = *(const v4u*)(src + (size_t)row * 4096 + col); }
        LAS float* sc = tab + (mode == 0 ? 64 : 128);
#pragma unroll 1
        for (int I = 0; I < 2; ++I) {
            bf16x8 pa0, pa1, pa2, pa3;
            { f32x16 X;
#pragma unroll
              for (int r = 0; r < 16; ++r) X[r] = (I ? T21T[r] : T1T[r]) * sc[crow(r, hi)];
              GPK4(X, 0, pa0); GPK4(X, 8, pa1);
#pragma unroll
              for (int r = 0; r < 16; ++r) X[r] = I ? T2T[r] * sc[32 + crow(r, hi)] : 0.f;
              GPK4(X, 0, pa2); GPK4(X, 8, pa3); }
#pragma unroll 1
            for (int d0 = 0; d0 < 4; ++d0) {
                f32x16 od = {};
                if (mode == 0) { sba::pv_one<0>(od, vb + d0 * 512, pa0, pa1, pa2, pa3);
                    const unsigned e0 = (unsigned)(((I * 32 + 8 * d0 + (lane >> 5)) * 4096) + (lane & 31) * 4);
#pragma unroll
                    for (int g = 0; g < 4; ++g) { v2u w; w.x = pk(od[4 * g + 0], od[4 * g + 1]); w.y = pk(od[4 * g + 2], od[4 * g + 3]); *(v2u*)(ubl + e0 + (unsigned)(g * 8192)) = w; }
                } else { sba::pv_one_T<0>(od, vb + d0 * 512, pa0, pa1, pa2, pa3);
                    bf16* wp = wmem + (unsigned)((((I * 4 + d0) * 4) * 64 + lane) * 4);
#pragma unroll
                    for (int g = 0; g < 4; ++g) { v2u w; w.x = pk(od[4 * g + 0], od[4 * g + 1]); w.y = pk(od[4 * g + 2], od[4 * g + 3]); *(v2u*)(wp + g * 256) = w; }
                }
                GSB();
            }
        }
        if (mode == 1) {
            const int Ik = hv & 1;
            v4u idw0, idw1;
            { const int d0_ = r32 - 8 * hi, d1_ = r32 - 16 - 8 * hi;
              idw0.x = (d0_ == 0 ? 0x3f80u : 0u) | (d0_ == 1 ? 0x3f800000u : 0u); idw0.y = (d0_ == 2 ? 0x3f80u : 0u) | (d0_ == 3 ? 0x3f800000u : 0u);
              idw0.z = (d0_ == 4 ? 0x3f80u : 0u) | (d0_ == 5 ? 0x3f800000u : 0u); idw0.w = (d0_ == 6 ? 0x3f80u : 0u) | (d0_ == 7 ? 0x3f800000u : 0u);
              idw1.x = (d1_ == 0 ? 0x3f80u : 0u) | (d1_ == 1 ? 0x3f800000u : 0u); idw1.y = (d1_ == 2 ? 0x3f80u : 0u) | (d1_ == 3 ? 0x3f800000u : 0u);
              idw1.z = (d1_ == 4 ? 0x3f80u : 0u) | (d1_ == 5 ? 0x3f800000u : 0u); idw1.w = (d1_ == 6 ? 0x3f80u : 0u) | (d1_ == 7 ? 0x3f800000u : 0u); }
            const bf16x8 id0 = __builtin_bit_cast(bf16x8, idw0), id1 = __builtin_bit_cast(bf16x8, idw1), zf = (bf16x8){};
            const bf16x8 pa0 = Ik ? zf : id0, pa1 = Ik ? zf : id1, pa2 = Ik ? id0 : zf, pa3 = Ik ? id1 : zf;
#pragma unroll 1
            for (int d0 = 0; d0 < 4; ++d0) {
                f32x16 od = {}; sba::pv_one<0>(od, vb + d0 * 512, pa0, pa1, pa2, pa3);
                bf16* kp = ktmem + (unsigned)((((Ik * 4 + d0) * 4) * 64 + lane) * 4);
#pragma unroll
                for (int g = 0; g < 4; ++g) { v2u w; w.x = pk(od[4 * g + 0], od[4 * g + 1]); w.y = pk(od[4 * g + 2], od[4 * g + 3]); *(v2u*)(kp + g * 256) = w; }
                GSB();
            }
        }
    }
#undef GSB
}
#undef GPK4
}
DI void phase_gdn_local(const Args& a, LAS unsigned char* lds, int bid, int G, int wave, int lane, bool dry) {
    LAS unsigned char* img = lds + wave * 16384; LAS float* tab = (LAS float*)(lds + RING_BYTES + 4096 + wave * 1024);
    const int gw = bid * NWAVES + wave, NGW = G * NWAVES;
    for (int unit = gw; unit < BATCH * HV * 64; unit += NGW) gdn::local_unit(a, unit, img, tab, lane, dry);
}
namespace gdn {
constexpr int PW = 272, PI = 144;
constexpr int L_W = 0, L_Q = 64 * PW, L_I = 2 * 64 * PW, L_K = L_I + 64 * PI, L_G = L_K + 128 * PI, L_BUF = L_G + 768;
constexpr int L_PART = 2 * L_BUF;
static_assert(L_PART + 4096 <= RING_BYTES, "scan LDS map");
}
DI void phase_gdn_scan(const Args& a, int j, LAS unsigned char* lds, int bid, int tid, bool dry) {
    if (bid >= BATCH * HV) return;
    using gdn::bf16x8; using gdn::pk; using namespace gdn;
    typedef float f4v __attribute__((ext_vector_type(4)));
    const int wave = __builtin_amdgcn_readfirstlane(tid >> 6), lane = tid & 63, n = lane & 15, kq = lane >> 4;
    const int b = bid / HV, hv = bid % HV, hk = hv >> 1;
    bf16* qkvc = (bf16*)(a.ws + WS_QKVC); const bf16* zb = (const bf16*)(a.ws + WS_ZB);
    LAS float* part = (LAS float*)(lds + L_PART); LAS unsigned char* stg = lds + OGST_OFF;
    const int unit0 = (b * HV + hv) * 64, hku0 = (b * HK + hk) * 64; const size_t tb0 = (size_t)b * SEQ;
    if (wave >= 4) {
        const int st = tid - 256;
        v4u rw[4], rq[4], ri[2], rk[4], rz[4]; float rg = 0.f;
#define SV_RUN2(dst, base, o0) do { const v2u a_ = *(const v2u*)((base) + (o0)), b_ = *(const v2u*)((base) + (o0) + 2 * 64 * 4); dst = (v4u){a_.x, a_.y, b_.x, b_.y}; } while (0)
#define SV_LOAD(ch) do { const int u_ = unit0 + (ch); const size_t t_ = tb0 + (size_t)(ch) * 64; \
        const bf16* wm_ = (const bf16*)(a.ws + WS_WMEM) + (size_t)u_ * 8192; const bf16* im_ = (const bf16*)(a.ws + WS_IMEM) + (size_t)u_ * 4096; \
        const bf16* kt_ = (const bf16*)(a.ws + WS_KTMEM) + (size_t)(hku0 + (ch)) * 8192; const bf16* qb_ = qkvc + t_ * 4096 + hk * 128; const bf16* zr_ = zb + t_ * 2048 + hv * 128; \
        _Pragma("unroll") for (int k = 0; k < 4; ++k) { const int c = st + 256 * k; \
            { const int row = c & 63, p = c >> 6, pp = p & 3; SV_RUN2(rw[k], wm_, (((((row >> 5) * 4 + (p >> 2)) * 4 + (pp >> 1)) * 64 + (pp & 1) * 32 + (row & 31)) * 4)); }     \
            { const int dk = c & 127, p = c >> 7, pp = p & 3; SV_RUN2(rk[k], kt_, (((((p >> 2) * 4 + (dk >> 5)) * 4 + (pp >> 1)) * 64 + (pp & 1) * 32 + (dk & 31)) * 4)); }         \
            rq[k] = *(const v4u*)(qb_ + (size_t)(c >> 4) * 4096 + (c & 15) * 8); rz[k] = *(const v4u*)(zr_ + (size_t)(c >> 4) * 2048 + (c & 15) * 8); } \
        _Pragma("unroll") for (int k = 0; k < 2; ++k) { const int c = st + 256 * k; const int row = c & 63, p = c >> 6, pp = p & 3; \
            SV_RUN2(ri[k], im_, (((((row >> 5) * 2 + (p >> 2)) * 4 + (pp >> 1)) * 64 + (pp & 1) * 32 + (row & 31)) * 4)); } \
        if (st < 192) rg = ((const float*)(a.ws + WS_GTAB))[(size_t)u_ * 192 + st]; } while (0)
#define SV_WRITE(bf) do { LAS unsigned char* B_ = lds + (bf) * L_BUF; \
        _Pragma("unroll") for (int k = 0; k < 4; ++k) { const int c = st + 256 * k; *(LAS v4u*)(B_ + L_W + (c & 63) * PW + (c >> 6) * 16) = rw[k]; \
            *(LAS v4u*)(B_ + L_Q + (c >> 4) * PW + (c & 15) * 16) = rq[k]; *(LAS v4u*)(B_ + L_K + (c & 127) * PI + (c >> 7) * 16) = rk[k]; } \
        _Pragma("unroll") for (int k = 0; k < 2; ++k) { const int c = st + 256 * k; *(LAS v4u*)(B_ + L_I + (c & 63) * PI + (c >> 6) * 16) = ri[k]; } \
        if (st < 192) *(LAS float*)(B_ + L_G + st * 4) = rg; } while (0)
        f32x4 nwa, nwb;
        { const float* nwp = a.gdn_norm_w + j * 128 + (st & 15) * 8; nwa = *(const f32x4*)nwp; nwb = *(const f32x4*)(nwp + 4); }
        volatile LAS unsigned* flag = (volatile LAS unsigned*)(lds + L_PART);
        SV_LOAD(0); SV_WRITE(0);
        v4u zc[4], zn[4];
#pragma unroll
        for (int k = 0; k < 4; ++k) zc[k] = rz[k];
        __syncthreads();
        SV_LOAD(1);
#pragma unroll 1
        for (int chunk = 0; chunk < 64; ++chunk) {
            if (chunk + 1 < 64) { SV_WRITE((chunk + 1) & 1);
#pragma unroll
                for (int k = 0; k < 4; ++k) zn[k] = rz[k]; }
            __syncthreads();
            v4u ov[4];
#pragma unroll
            for (int k = 0; k < 4; ++k) { const int c = st + 256 * k; ov[k] = *(const LAS v4u*)(stg + (c >> 4) * 256 + (c & 15) * 16); }
            asm volatile("s_waitcnt lgkmcnt(0)" ::: "memory");
            if (lane == 0) __hip_atomic_fetch_add((LAS unsigned*)(lds + L_PART), 1u, __ATOMIC_RELAXED, __HIP_MEMORY_SCOPE_WORKGROUP);
            if (chunk + 2 < 64) SV_LOAD(chunk + 2);
            __builtin_amdgcn_sched_barrier(0);
            bf16* ob = dry ? (bf16*)(a.ws + WS_END) + (size_t)bid * 64 * 128 : qkvc + (tb0 + (size_t)chunk * 64) * 4096 + 2048 + hv * 128; const int opitch = dry ? 128 : 4096;
#pragma unroll
            for (int k = 0; k < 4; ++k) { const int c = st + 256 * k;
                float o8[8]; o8[0] = bf_lo(ov[k].x); o8[1] = bf_hi(ov[k].x); o8[2] = bf_lo(ov[k].y); o8[3] = bf_hi(ov[k].y); o8[4] = bf_lo(ov[k].z); o8[5] = bf_hi(ov[k].z); o8[6] = bf_lo(ov[k].w); o8[7] = bf_hi(ov[k].w);
                float ss = 0.f;
#pragma unroll
                for (int e = 0; e < 8; ++e) ss += o8[e] * o8[e];
                const float rinv = __builtin_amdgcn_rsqf(dpp_sum16(ss) * (1.0f / 128.0f) + RMS_EPS);
                float z8[8]; z8[0] = bf_lo(zc[k].x); z8[1] = bf_hi(zc[k].x); z8[2] = bf_lo(zc[k].y); z8[3] = bf_hi(zc[k].y); z8[4] = bf_lo(zc[k].z); z8[5] = bf_hi(zc[k].z); z8[6] = bf_lo(zc[k].w); z8[7] = bf_hi(zc[k].w);
                float r8[8];
#pragma unroll
                for (int e = 0; e < 8; ++e) { const float sg = z8[e] * __builtin_amdgcn_rcpf(1.0f + __builtin_amdgcn_exp2f(-1.4426950408889634f * z8[e])); r8[e] = o8[e] * rinv * (e < 4 ? nwa[e] : nwb[e - 4]) * sg; }
                v4u w; w.x = pk(r8[0], r8[1]); w.y = pk(r8[2], r8[3]); w.z = pk(r8[4], r8[5]); w.w = pk(r8[6], r8[7]);
                *(v4u*)(ob + (size_t)(c >> 4) * opitch + (c & 15) * 8) = w; }
#pragma unroll
            for (int k = 0; k < 4; ++k) zc[k] = zn[k];
        }
#undef SV_RUN2
#undef SV_LOAD
#undef SV_WRITE
        return;
    }
    f4v S[2][8];
#pragma unroll
    for (int g = 0; g < 2; ++g)
#pragma unroll
        for (int m = 0; m < 8; ++m) S[g][m] = (f4v){0.f, 0.f, 0.f, 0.f};
    v2u un[2][4];
#define CW_ULOAD(ch) do { const bf16* vb_ = qkvc + (tb0 + (size_t)(ch) * 64) * 4096 + 2048 + hv * 128; \
        _Pragma("unroll") for (int g = 0; g < 2; ++g) _Pragma("unroll") for (int mt = 0; mt < 4; ++mt) { \
            const int f = (((((mt >> 1) * 4 + wave) * 4 + 2 * (mt & 1) + (kq >> 1)) * 64) + (kq & 1) * 32 + 16 * g + n) * 4;     \
            un[g][mt] = *(const v2u*)(vb_ + (size_t)(f >> 7) * 4096 + (f & 127)); } } while (0)
    CW_ULOAD(0);
    if (tid == 0) *(volatile LAS unsigned*)(lds + L_PART) = 0u;
    __syncthreads();
#pragma unroll 1
    for (int chunk = 0; chunk < 64; ++chunk) {
        const LAS unsigned char* B = lds + (chunk & 1) * L_BUF; const LAS float* gt = (const LAS float*)(B + L_G);
        f4v av[2][4], ao[2][4];
#pragma unroll
        for (int g = 0; g < 2; ++g)
#pragma unroll
            for (int mt = 0; mt < 4; ++mt) { const v2u u0 = un[g][mt]; av[g][mt] = (f4v){bf_lo(u0.x), bf_hi(u0.x), bf_lo(u0.y), bf_hi(u0.y)}; }
        if (chunk + 1 < 64) CW_ULOAD(chunk + 1);
        bf16x8 Sb[2][4];
#pragma unroll
        for (int g = 0; g < 2; ++g)
#pragma unroll
            for (int p = 0; p < 4; ++p) { v4u w; w.x = pk(S[g][2 * p][0], S[g][2 * p][1]); w.y = pk(S[g][2 * p][2], S[g][2 * p][3]); w.z = pk(S[g][2 * p + 1][0], S[g][2 * p + 1][1]); w.w = pk(S[g][2 * p + 1][2], S[g][2 * p + 1][3]);
                Sb[g][p] = __builtin_bit_cast(bf16x8, w); }
#pragma unroll
        for (int mt = 0; mt < 4; ++mt) { ao[0][mt] = (f4v){0.f, 0.f, 0.f, 0.f}; ao[1][mt] = (f4v){0.f, 0.f, 0.f, 0.f};
#pragma unroll
            for (int p = 0; p < 4; ++p) {
                const bf16x8 aw = *(const LAS bf16x8*)(B + L_W + (16 * mt + n) * PW + 64 * p + 16 * kq);
                const v2u q0 = *(const LAS v2u*)(B + L_Q + (16 * mt + n) * PW + 64 * p + 8 * kq), q1 = *(const LAS v2u*)(B + L_Q + (16 * mt + n) * PW + 64 * p + 32 + 8 * kq);
                const v4u qq = {q0.x, q0.y, q1.x, q1.y}; const bf16x8 aq = __builtin_bit_cast(bf16x8, qq);
                av[0][mt] = __builtin_amdgcn_mfma_f32_16x16x32_bf16(aw, Sb[0][p], av[0][mt], 0, 0, 0); av[1][mt] = __builtin_amdgcn_mfma_f32_16x16x32_bf16(aw, Sb[1][p], av[1][mt], 0, 0, 0);
                ao[0][mt] = __builtin_amdgcn_mfma_f32_16x16x32_bf16(aq, Sb[0][p], ao[0][mt], 0, 0, 0); ao[1][mt] = __builtin_amdgcn_mfma_f32_16x16x32_bf16(aq, Sb[1][p], ao[1][mt], 0, 0, 0); } }
        bf16x8 vbf[2][2], vbd[2][2];
#pragma unroll
        for (int pp = 0; pp < 2; ++pp) {
            const f4v d0 = *(const LAS f4v*)(gt + 64 + 32 * pp + 4 * kq), d1 = *(const LAS f4v*)(gt + 64 + 32 * pp + 16 + 4 * kq);
#pragma unroll
            for (int g = 0; g < 2; ++g) { const f4v x0 = av[g][2 * pp], x1 = av[g][2 * pp + 1];
                v4u w; w.x = pk(x0[0], x0[1]); w.y = pk(x0[2], x0[3]); w.z = pk(x1[0], x1[1]); w.w = pk(x1[2], x1[3]); vbf[g][pp] = __builtin_bit_cast(bf16x8, w);
                v4u y; y.x = pk(x0[0] * d0[0], x0[1] * d0[1]); y.y = pk(x0[2] * d0[2], x0[3] * d0[3]); y.z = pk(x1[0] * d1[0], x1[1] * d1[1]); y.w = pk(x1[2] * d1[2], x1[3] * d1[3]); vbd[g][pp] = __builtin_bit_cast(bf16x8, y); }
        }
#pragma unroll
        for (int mt = 0; mt < 4; ++mt) { const f4v eg = *(const LAS f4v*)(gt + 16 * mt + 4 * kq); ao[0][mt] = ao[0][mt] * eg; ao[1][mt] = ao[1][mt] * eg;
#pragma unroll
            for (int pp = 0; pp < 2; ++pp) { const bf16x8 ai = *(const LAS bf16x8*)(B + L_I + (16 * mt + n) * PI + 64 * pp + 16 * kq);
                ao[0][mt] = __builtin_amdgcn_mfma_f32_16x16x32_bf16(ai, vbf[0][pp], ao[0][mt], 0, 0, 0); ao[1][mt] = __builtin_amdgcn_mfma_f32_16x16x32_bf16(ai, vbf[1][pp], ao[1][mt], 0, 0, 0); } }
        { const float egl = gt[128];
#pragma unroll
          for (int m8 = 0; m8 < 8; ++m8) { S[0][m8] = S[0][m8] * egl; S[1][m8] = S[1][m8] * egl;
#pragma unroll
              for (int pp = 0; pp < 2; ++pp) { const bf16x8 ak = *(const LAS bf16x8*)(B + L_K + (16 * m8 + n) * PI + 64 * pp + 16 * kq);
                  S[0][m8] = __builtin_amdgcn_mfma_f32_16x16x32_bf16(ak, vbd[0][pp], S[0][m8], 0, 0, 0); S[1][m8] = __builtin_amdgcn_mfma_f32_16x16x32_bf16(ak, vbd[1][pp], S[1][m8], 0, 0, 0); } } }
        { unsigned spins = 0; while (*(volatile LAS unsigned*)(lds + L_PART) < 4u * (unsigned)chunk) { __builtin_amdgcn_s_sleep(1); if (++spins > (1u << 22)) break; } }
#pragma unroll
        for (int g = 0; g < 2; ++g)
#pragma unroll
            for (int mt = 0; mt < 4; ++mt)
#pragma unroll
                for (int i = 0; i < 4; ++i) *(LAS bf16*)(stg + (16 * mt + 4 * kq + i) * 256 + (32 * wave + 16 * g + n) * 2) = (bf16)(pk(ao[g][mt][i], 0.f) & 0xffffu);
        __syncthreads();
    }
#undef CW_ULOAD
}

DI void moe_offsets(const Args& a, int j, unsigned (&off)[9]) {
    unsigned* cnt = (unsigned*)(a.ws + WS_CTL) + CW_CNT + 256 * j; unsigned acc = 0u;
#pragma unroll
    for (int e = 0; e < 8; ++e) { off[e] = acc; const unsigned c = __hip_atomic_load(cnt + e, __ATOMIC_RELAXED, __HIP_MEMORY_SCOPE_AGENT); acc += (c + 255u) & ~255u; }
    off[8] = acc;
}
DI void phase_scatter(const Args& a, int j, LAS unsigned char* lds, int bid, int G, int tid, int wave, int lane) {
    LAS unsigned* lc = (LAS unsigned*)lds; LAS unsigned* lb = lc + 8; LAS unsigned* loff = lc + 16; LAS int* lpos = (LAS int*)(lc + 32);
    const unsigned* E12 = (const unsigned*)(a.ws + WS_E12); int* POS = (int*)(a.ws + WS_POS);
    const bf16* HB = (const bf16*)(a.ws + WS_HB); bf16* XS = (bf16*)(a.ws + WS_XS);
    unsigned* fill = (unsigned*)(a.ws + WS_CTL) + CW_CNT + 256 * j + 64;
    unsigned off[9]; moe_offsets(a, j, off);
    if (tid == 0) {
#pragma unroll
        for (int e = 0; e < 8; ++e) loff[e] = off[e]; }
    for (int ci = bid; ci < TT / 128; ci += G) {
        __syncthreads();
        if (tid < 8) lc[tid] = 0u;
        __syncthreads();
        unsigned e1 = 0, e2 = 0, r1 = 0, r2 = 0;
        if (tid < 128) { const unsigned w = E12[ci * 128 + tid]; e1 = w & 255u; e2 = (w >> 8) & 255u;
            r1 = __hip_atomic_fetch_add(lc + e1, 1u, __ATOMIC_RELAXED, __HIP_MEMORY_SCOPE_WORKGROUP); r2 = __hip_atomic_fetch_add(lc + e2, 1u, __ATOMIC_RELAXED, __HIP_MEMORY_SCOPE_WORKGROUP); }
        __syncthreads();
        if (tid < 8) lb[tid] = __hip_atomic_fetch_add(fill + tid, lc[tid], __ATOMIC_RELAXED, __HIP_MEMORY_SCOPE_AGENT);
        __syncthreads();
        if (tid < 128) { const int p1 = (int)(loff[e1] + lb[e1] + r1), p2 = (int)(loff[e2] + lb[e2] + r2);
            lpos[2 * tid] = p1; lpos[2 * tid + 1] = p2; POS[2 * (ci * 128 + tid)] = p1; POS[2 * (ci * 128 + tid) + 1] = p2; }
        __syncthreads();
        for (int tk = wave; tk < 128; tk += NWAVES) {
            const int p1 = lpos[2 * tk], p2 = lpos[2 * tk + 1];
            const v4u* src = (const v4u*)(HB + (size_t)(ci * 128 + tk) * D);
            const v4u x0 = src[lane], x1 = src[lane + 64];
            v4u* d1 = (v4u*)(XS + (size_t)p1 * D); v4u* d2 = (v4u*)(XS + (size_t)p2 * D);
            d1[lane] = x0; d1[lane + 64] = x1; d2[lane] = x0; d2[lane + 64] = x1;
        }
    }
}

template <bool FINAL>
DI void phase_combine_ln(const Args& a, int lnprev, int lnidx, int bid, int G, int wave, int lane) {
    float* out = a.out; bf16* HB = (bf16*)(a.ws + WS_HB); const bf16* YE = (const bf16*)(a.ws + WS_XS); float* stats = (float*)(a.ws + WS_STATS);
    const int* POS = (const int*)(a.ws + WS_POS); const f32x2* G12 = (const f32x2*)(a.ws + WS_G12);
    const float* g = a.ln_g + (size_t)lnidx * D; const float* bta = a.ln_b + (size_t)lnidx * D;
    const float* gp = a.ln_g + (size_t)lnprev * D; const float* bp = a.ln_b + (size_t)lnprev * D;
    const int gw = bid * NWAVES + wave, NGW = G * NWAVES;
    f32x4 gv[4], bv[4], gq[4], bq[4];
#pragma unroll
    for (int q = 0; q < 4; ++q) { gv[q] = *(const f32x4*)(g + 4 * (lane + 64 * q)); bv[q] = *(const f32x4*)(bta + 4 * (lane + 64 * q));
        gq[q] = *(const f32x4*)(gp + 4 * (lane + 64 * q)) * ALPHA; bq[q] = *(const f32x4*)(bp + 4 * (lane + 64 * q)) * ALPHA; }
    for (int t = gw; t < TT; t += NGW) {
        f32x4* row = (f32x4*)(out + (size_t)t * D);
        const int p1 = POS[2 * t], p2 = POS[2 * t + 1]; const f32x2 gg = G12[t]; const f32x2 st = *(const f32x2*)(stats + 2 * (size_t)t);
        const v2u* y1 = (const v2u*)(YE + (size_t)p1 * D); const v2u* y2 = (const v2u*)(YE + (size_t)p2 * D);
        f32x4 v[4]; float s = 0.f;
#pragma unroll
        for (int q = 0; q < 4; ++q) { const v2u a1 = y1[lane + 64 * q], a2 = y2[lane + 64 * q];
            const f32x4 e1 = (f32x4){bf_lo(a1.x), bf_hi(a1.x), bf_lo(a1.y), bf_hi(a1.y)}, e2 = (f32x4){bf_lo(a2.x), bf_hi(a2.x), bf_lo(a2.y), bf_hi(a2.y)};
            v[q] = (row[lane + 64 * q] - st.x) * st.y * gq[q] + bq[q] + e1 * gg.x + e2 * gg.y; s += (v[q][0] + v[q][1]) + (v[q][2] + v[q][3]); }
        const float mean = wave_sum(s) * (1.0f / D); float s2 = 0.f;
#pragma unroll
        for (int q = 0; q < 4; ++q) { const f32x4 d = v[q] - mean; s2 += (d[0] * d[0] + d[1] * d[1]) + (d[2] * d[2] + d[3] * d[3]); }
        const float rstd = 1.0f / sqrtf(wave_sum(s2) * (1.0f / D) + LN_EPS);
        if (lane == 0) *(f32x2*)(stats + 2 * (size_t)t) = (f32x2){mean, rstd};
#pragma unroll
        for (int q = 0; q < 4; ++q) { const f32x4 hn = (v[q] - mean) * rstd * gv[q] + bv[q]; row[lane + 64 * q] = FINAL ? hn : v[q];
            v2u o; o.x = pk2(hn[0], hn[1]); o.y = pk2(hn[2], hn[3]); *(v2u*)(HB + (size_t)t * D + 4 * (lane + 64 * q)) = o; }
    }
}

constexpr int ARGS_OFF = RING_BYTES + 1024;
DI unsigned long long lds_u64(LAS unsigned char* p) { const v2u w = *(const volatile LAS v2u*)p; return ((unsigned long long)(unsigned)__builtin_amdgcn_readfirstlane((int)w.y) << 32) | (unsigned)__builtin_amdgcn_readfirstlane((int)w.x); }
DI Args load_args(LAS unsigned char* lds) {
    Args a; LAS unsigned char* p = lds + ARGS_OFF;
    a.x = (const float*)(const GAS float*)lds_u64(p + 0); a.gdn_w_in = (const float*)(const GAS float*)lds_u64(p + 8); a.gdn_conv_w = (const float*)(const GAS float*)lds_u64(p + 16); a.gdn_a_log = (const float*)(const GAS float*)lds_u64(p + 24);
    a.gdn_dt_bias = (const float*)(const GAS float*)lds_u64(p + 32); a.gdn_norm_w = (const float*)(const GAS float*)lds_u64(p + 40); a.gdn_w_out = (const float*)(const GAS float*)lds_u64(p + 48); a.sb_w_in = (const float*)(const GAS float*)lds_u64(p + 56);
    a.sb_w_out = (const float*)(const GAS float*)lds_u64(p + 64); a.ffn_w_gate = (const float*)(const GAS float*)lds_u64(p + 72); a.ffn_w_up = (const float*)(const GAS float*)lds_u64(p + 80); a.ffn_w_down = (const float*)(const GAS float*)lds_u64(p + 88);
    a.moe_router = (const float*)(const GAS float*)lds_u64(p + 96); a.moe_w_gate = (const float*)(const GAS float*)lds_u64(p + 104); a.moe_w_up = (const float*)(const GAS float*)lds_u64(p + 112); a.moe_w_down = (const float*)(const GAS float*)lds_u64(p + 120);
    a.ln_g = (const float*)(const GAS float*)lds_u64(p + 128); a.ln_b = (const float*)(const GAS float*)lds_u64(p + 136); a.out = (float*)(GAS float*)lds_u64(p + 144); a.ws = (unsigned char*)(GAS unsigned char*)lds_u64(p + 152);
    const v2u w = *(const volatile LAS v2u*)(p + 160); a.ph_lo = __builtin_amdgcn_readfirstlane((int)w.x); a.ph_hi = __builtin_amdgcn_readfirstlane((int)w.y);
    return a;
}
#ifdef PH_ONLY
#define IN(k) (((k) % NPH) == PH_ONLY && lo <= (k) && (k) < hi)
#else
#define IN(k) (lo <= (k) && (k) < hi)
#endif
#define SEAM(k) do { if ((k) + 1 < hi) xcd_barrier(bar); } while (0)
DI int fresh_lane() { int l; asm volatile("v_mbcnt_lo_u32_b32 %0, -1, 0\n\tv_mbcnt_hi_u32_b32 %0, -1, %0" : "=v"(l)); return l; }
#define ARGS() const Args args = load_args(lds); const int lo = args.ph_lo, hi = args.ph_hi; const int lane = fresh_lane(), tid = wave * 64 + lane
#ifndef PROBE_REP_MASK
#define PROBE_REP_MASK 0
#endif
#ifndef PROBE_DELAY_MASK
#define PROBE_DELAY_MASK 0
#endif
#define PROBE_DELAY_MULT 4u
#define TICK_IN(k) do { if (((PROBE_DELAY_MASK) >> (k)) & 1) { if (bid == 0 && tid == 0) ((volatile LAS unsigned*)(lds + MISC_OFF))[20] -= (unsigned)__builtin_amdgcn_s_memrealtime(); } } while (0)
#define TICK_OUT(k) do { if (((PROBE_DELAY_MASK) >> (k)) & 1) { if (bid == 0 && tid == 0) ((volatile LAS unsigned*)(lds + MISC_OFF))[20] += (unsigned)__builtin_amdgcn_s_memrealtime(); } } while (0)
#define NREP(k) ((((PROBE_REP_MASK) >> (k)) & 1) ? 2 : 1)
template <int j>
DI void layer_pair(LAS unsigned char* lds, const XcdBarrier& bar, const int wave, const int G, const int bid) {
    constexpr int pb = j * NPH;
    { ARGS(); if (IN(pb + 0)) { TICK_IN(0); _Pragma("unroll 1") for (int rep_ = 0; rep_ < NREP(0); ++rep_) { phase_w_gdn(args, j, lds, bid, G, tid, wave, lane); } SEAM(pb + 0); TICK_OUT(0); } }
    { ARGS(); if (IN(pb + 1)) { TICK_IN(1); {
        pg8::Gemm g{(const bf16*)(args.ws + WS_HB), (const bf16*)(args.ws + W_IN), D, D}; pg8::StaticOrder S; S.init(TT, GINP, G, bid, NREP(1));
        pg8::EpiInProj E{(bf16*)(args.ws + WS_RAW), (bf16*)(args.ws + WS_ZB)};
        pg8::gemm_phase<pg8::EpiInProj, pg8::StaticOrder, true, true>(lds, g, S, E);
        } SEAM(pb + 1); TICK_OUT(1); } }
    { ARGS(); if (IN(pb + 2)) { TICK_IN(2); _Pragma("unroll 1") for (int rep_ = 0; rep_ < NREP(2); ++rep_) { phase_conv(args, j, bid, G, tid); } SEAM(pb + 2); TICK_OUT(2); } }
#if GDN_NAIVE
    { ARGS(); if (IN(pb + 4)) { TICK_IN(4); _Pragma("unroll 1") for (int rep_ = 0; rep_ < NREP(4); ++rep_) { phase_gdn_naive(args, j, lds, bid, tid); } SEAM(pb + 4); TICK_OUT(4); } }
#else
    { ARGS(); if (IN(pb + 3)) { TICK_IN(3); _Pragma("unroll 1") for (int rep_ = 0; rep_ < NREP(3); ++rep_) { phase_gdn_local(args, lds, bid, G, wave, lane, rep_ + 1 < NREP(3)); } SEAM(pb + 3); TICK_OUT(3); } }
    { ARGS(); if (IN(pb + 4)) { TICK_IN(4); _Pragma("unroll 1") for (int rep_ = 0; rep_ < NREP(4); ++rep_) { if (bid >= BATCH * HV && G > BATCH * HV) phase_w_sb(args, j, lds, bid - BATCH * HV, G - BATCH * HV, wave, lane); else if (G <= BATCH * HV && rep_ == 0) phase_w_sb(args, j, lds, bid, G, wave, lane);
        phase_gdn_scan(args, j, lds, bid, tid, rep_ + 1 < NREP(4)); } SEAM(pb + 4); TICK_OUT(4); } }
#endif
    { ARGS(); if (IN(pb + 5)) { TICK_IN(5); {
        pg8::Gemm g{(const bf16*)(args.ws + WS_QKVC) + 2048, (const bf16*)(args.ws + W_OUT), 4096, 2048}; pg8::StaticOrder S; S.init(TT, D, G, bid);
        pg8::EpiResid<(j > 0)> E{j == 0 ? args.x : args.out, args.out, (const float*)(args.ws + WS_STATS), args.ln_g + (size_t)(4 * (j > 0 ? j - 1 : 0) + 3) * D, args.ln_b + (size_t)(4 * (j > 0 ? j - 1 : 0) + 3) * D};
        pg8::gemm_phase<pg8::EpiResid<(j > 0)>, pg8::StaticOrder, true, true>(lds, g, S, E);
        } SEAM(pb + 5); TICK_OUT(5); } }
    { ARGS(); if (IN(pb + 6)) { TICK_IN(6); _Pragma("unroll 1") for (int rep_ = 0; rep_ < NREP(6); ++rep_) { phase_ln<false>(args, (2 * j) * 2 + 0, j, lds, bid, G, tid, wave, lane); } SEAM(pb + 6); TICK_OUT(6); } }
    { ARGS(); if (IN(pb + 7)) { TICK_IN(7); {
        pg8::Gemm g{(const bf16*)(args.ws + WS_HB), (const bf16*)(args.ws + W_GU), D, D}; pg8::StaticOrder S; S.init(TT, 2 * FF, G, bid, NREP(7));
        pg8::EpiSwiGLU E{(bf16*)(args.ws + WS_ACT), FF, 0};
        pg8::gemm_phase<pg8::EpiSwiGLU, pg8::StaticOrder, true, true>(lds, g, S, E);
        } SEAM(pb + 7); TICK_OUT(7); } }
    { ARGS(); if (IN(pb + 8)) { TICK_IN(8); {
        pg8::Gemm g{(const bf16*)(args.ws + WS_ACT), (const bf16*)(args.ws + W_D), FF, FF}; pg8::StaticOrder S; S.init(TT, D, G, bid);
        pg8::EpiResid<true> E{args.out, args.out, (const float*)(args.ws + WS_STATS), args.ln_g + (size_t)(4 * j + 0) * D, args.ln_b + (size_t)(4 * j + 0) * D};
        pg8::gemm_phase<pg8::EpiResid<true>, pg8::StaticOrder, true, true>(lds, g, S, E);
        } SEAM(pb + 8); TICK_OUT(8); } }
    { ARGS(); if (IN(pb + 9)) { TICK_IN(9); _Pragma("unroll 1") for (int rep_ = 0; rep_ < NREP(9); ++rep_) { phase_ln<false>(args, (2 * j) * 2 + 1, j, lds, bid, G, tid, wave, lane); } SEAM(pb + 9); TICK_OUT(9); } }
    { ARGS(); if (IN(pb + 10)) { TICK_IN(10); {
        pg8::Gemm g{(const bf16*)(args.ws + WS_HB), (const bf16*)(args.ws + W_QKV), D, D}; pg8::StaticOrder S; S.init(TT, 3072, G, bid, NREP(10));
        pg8::EpiBf16 E{(bf16*)(args.ws + WS_QKV), 3072, 0};
        pg8::gemm_phase<pg8::EpiBf16, pg8::StaticOrder, true, true>(lds, g, S, E);
        } SEAM(pb + 10); TICK_OUT(10); } }
    #if SB_NAIVE
    { ARGS(); if (IN(pb + 11)) { TICK_IN(11); _Pragma("unroll 1") for (int rep_ = 0; rep_ < NREP(11); ++rep_) { phase_sb_naive(args, lds, bid, G, tid); } SEAM(pb + 11); TICK_OUT(11); } }
#else
    { ARGS(); if (IN(pb + 11)) { TICK_IN(11); _Pragma("unroll 1") for (int rep_ = 0; rep_ < NREP(11); ++rep_) { phase_sb_mfma(args, lds, bid, G, tid); } SEAM(pb + 11); TICK_OUT(11); } }
#endif
    { ARGS(); if (IN(pb + 12)) { TICK_IN(12); {
        pg8::Gemm g{(const bf16*)(args.ws + WS_AO), (const bf16*)(args.ws + W_O), D, D}; pg8::StaticOrder S; S.init(TT, D, G, bid);
        pg8::EpiResid<true> E{args.out, args.out, (const float*)(args.ws + WS_STATS), args.ln_g + (size_t)(4 * j + 1) * D, args.ln_b + (size_t)(4 * j + 1) * D};
        pg8::gemm_phase<pg8::EpiResid<true>, pg8::StaticOrder, true, true>(lds, g, S, E);
        } SEAM(pb + 12); TICK_OUT(12); } }
    { ARGS(); if (IN(pb + 13)) { TICK_IN(13); _Pragma("unroll 1") for (int rep_ = 0; rep_ < NREP(13); ++rep_) { phase_ln<true>(args, (2 * j + 1) * 2 + 0, j, lds, bid, G, tid, wave, lane); } SEAM(pb + 13); TICK_OUT(13); } }
    { ARGS(); if (IN(pb + 14)) { TICK_IN(14); _Pragma("unroll 1") for (int rep_ = 0; rep_ < NREP(14); ++rep_) { phase_scatter(args, j, lds, bid, G, tid, wave, lane); } SEAM(pb + 14); TICK_OUT(14); } }
    { ARGS(); if (IN(pb + 15)) { TICK_IN(15); {
        unsigned off[9]; moe_offsets(args, j, off);
        pg8::MoeOrder S; S.nM = (int)(off[8] >> 8); S.G = G; S.c = bid; S.nN = 2 * FF / 256; S.nwg = S.nM * S.nN; S.rep = NREP(15);
        S.ps1 = (int)(off[1] >> 8); S.ps2 = (int)(off[2] >> 8); S.ps3 = (int)(off[3] >> 8); S.ps4 = (int)(off[4] >> 8); S.ps5 = (int)(off[5] >> 8); S.ps6 = (int)(off[6] >> 8); S.ps7 = (int)(off[7] >> 8);
        pg8::Gemm g{(const bf16*)(args.ws + WS_XS), (const bf16*)(args.ws + W_MGU), D, D};
        pg8::EpiSwiGLU E{(bf16*)(args.ws + WS_MACT), FF, 2 * FF / 256};
        pg8::gemm_phase<pg8::EpiSwiGLU, pg8::MoeOrder, true, true>(lds, g, S, E);
        } SEAM(pb + 15); TICK_OUT(15); } }
    { ARGS(); if (IN(pb + 16)) { TICK_IN(16); {
        unsigned off[9]; moe_offsets(args, j, off);
        pg8::MoeOrder S; S.nM = (int)(off[8] >> 8); S.G = G; S.c = bid; S.nN = D / 256; S.nwg = S.nM * S.nN; S.rep = NREP(16);
        S.ps1 = (int)(off[1] >> 8); S.ps2 = (int)(off[2] >> 8); S.ps3 = (int)(off[3] >> 8); S.ps4 = (int)(off[4] >> 8); S.ps5 = (int)(off[5] >> 8); S.ps6 = (int)(off[6] >> 8); S.ps7 = (int)(off[7] >> 8);
        pg8::Gemm g{(const bf16*)(args.ws + WS_MACT), (const bf16*)(args.ws + W_MD), FF, FF};
        pg8::EpiBf16 E{(bf16*)(args.ws + WS_XS), D, D / 256};
        pg8::gemm_phase<pg8::EpiBf16, pg8::MoeOrder, true, true>(lds, g, S, E);
        } SEAM(pb + 16); TICK_OUT(16); } }
    { ARGS(); if (IN(pb + 17)) { TICK_IN(17); _Pragma("unroll 1") for (int rep_ = 0; rep_ < NREP(17); ++rep_) { phase_combine_ln<(j == 1)>(args, 4 * j + 2, 4 * j + 3, bid, G, wave, lane); } SEAM(pb + 17); TICK_OUT(17); } }
}
__global__ void __launch_bounds__(NWAVES * 64, 2) fwd(Args kargs) {
    extern __shared__ __attribute__((aligned(16))) unsigned char lds_raw[];
    LAS unsigned char* lds = (LAS unsigned char*)lds_raw;
    volatile LAS unsigned* MISC = (volatile LAS unsigned*)(lds + MISC_OFF);
    const int tid = threadIdx.x, lane = tid & 63, wave = __builtin_amdgcn_readfirstlane(tid >> 6), G = gridDim.x, bid = blockIdx.x;
    for (int u = tid; u < (LDS_BYTES - RING_BYTES) / 4; u += NWAVES * 64) ((LAS unsigned*)(lds + RING_BYTES))[u] = 0u;
    __syncthreads();
    if (tid == 0) { LAS unsigned long long* pa = (LAS unsigned long long*)(lds + ARGS_OFF);
        pa[0] = (unsigned long long)kargs.x; pa[1] = (unsigned long long)kargs.gdn_w_in; pa[2] = (unsigned long long)kargs.gdn_conv_w; pa[3] = (unsigned long long)kargs.gdn_a_log;
        pa[4] = (unsigned long long)kargs.gdn_dt_bias; pa[5] = (unsigned long long)kargs.gdn_norm_w; pa[6] = (unsigned long long)kargs.gdn_w_out; pa[7] = (unsigned long long)kargs.sb_w_in;
        pa[8] = (unsigned long long)kargs.sb_w_out; pa[9] = (unsigned long long)kargs.ffn_w_gate; pa[10] = (unsigned long long)kargs.ffn_w_up; pa[11] = (unsigned long long)kargs.ffn_w_down;
        pa[12] = (unsigned long long)kargs.moe_router; pa[13] = (unsigned long long)kargs.moe_w_gate; pa[14] = (unsigned long long)kargs.moe_w_up; pa[15] = (unsigned long long)kargs.moe_w_down;
        pa[16] = (unsigned long long)kargs.ln_g; pa[17] = (unsigned long long)kargs.ln_b; pa[18] = (unsigned long long)kargs.out; pa[19] = (unsigned long long)kargs.ws;
        pa[20] = (unsigned long long)(unsigned)kargs.ph_lo | ((unsigned long long)(unsigned)kargs.ph_hi << 32); }
    XcdBarrier bar = xcd_barrier_post((unsigned*)(kargs.ws + WS_CTL) + CW_BAR, MISC + 8);
    __syncthreads();
    layer_pair<0>(lds, bar, wave, G, bid);
    layer_pair<1>(lds, bar, wave, G, bid);
    if (PROBE_DELAY_MASK) { if (bid == 0 && threadIdx.x == 0) { const unsigned acc = ((volatile LAS unsigned*)(lds + MISC_OFF))[20] * PROBE_DELAY_MULT; const unsigned long long t0 = __builtin_amdgcn_s_memrealtime(); while ((unsigned)(__builtin_amdgcn_s_memrealtime() - t0) < acc) __builtin_amdgcn_s_sleep(8); } }
}
#undef IN
#undef SEAM
#undef ARGS

extern "C" void kernel_launch(void* const* d_in, const int* in_sizes, int n_in, void* d_out, int out_size, void* d_ws, size_t ws_size, hipStream_t stream) {
    static int grid = 0;
    if (grid == 0) {
        if (n_in != 18 || in_sizes[0] != TT * D || out_size != TT * D || ws_size < WS_END) { fprintf(stderr, "kernel_launch: unexpected shapes (n_in %d, in0 %d, out %d, ws %zu); nothing launched\n", n_in, n_in > 0 ? in_sizes[0] : -1, out_size, ws_size); grid = -1; return; }
        int dev = 0, cus = 0, per_cu = 0;
        if (hipGetDevice(&dev) != hipSuccess || hipDeviceGetAttribute(&cus, hipDeviceAttributeMultiprocessorCount, dev) != hipSuccess) { grid = -1; return; }
        if (hipFuncSetAttribute((const void*)fwd, hipFuncAttributeMaxDynamicSharedMemorySize, LDS_BYTES) != hipSuccess) { fprintf(stderr, "kernel_launch: hipFuncSetAttribute failed\n"); grid = -1; return; }
        if (hipOccupancyMaxActiveBlocksPerMultiprocessor(&per_cu, (const void*)fwd, NWAVES * 64, LDS_BYTES) != hipSuccess || per_cu < 1) { fprintf(stderr, "kernel_launch: occupancy query says %d blocks per CU\n", per_cu); (void)hipGetLastError(); grid = -1; return; }
        grid = cus;
    }
    if (grid < 0) return;
    if (hipMemsetAsync((char*)d_ws + WS_CTL, 0, CTL_ZERO_BYTES, stream) != hipSuccess) return;
    Args a{};
    a.x = (const float*)d_in[0]; a.gdn_w_in = (const float*)d_in[1]; a.gdn_conv_w = (const float*)d_in[2]; a.gdn_a_log = (const float*)d_in[3]; a.gdn_dt_bias = (const float*)d_in[4];
    a.gdn_norm_w = (const float*)d_in[5]; a.gdn_w_out = (const float*)d_in[6]; a.sb_w_in = (const float*)d_in[7]; a.sb_w_out = (const float*)d_in[8];
    a.ffn_w_gate = (const float*)d_in[9]; a.ffn_w_up = (const float*)d_in[10]; a.ffn_w_down = (const float*)d_in[11]; a.moe_router = (const float*)d_in[12];
    a.moe_w_gate = (const float*)d_in[13]; a.moe_w_up = (const float*)d_in[14]; a.moe_w_down = (const float*)d_in[15]; a.ln_g = (const float*)d_in[16]; a.ln_b = (const float*)d_in[17];
    a.out = (float*)d_out; a.ws = (unsigned char*)d_ws;
#if MK_ONE_LAUNCH
    a.ph_lo = 0; a.ph_hi = NPHASES;
    hipLaunchKernelGGL(fwd, dim3(grid), dim3(NWAVES * 64), LDS_BYTES, stream, a);
#else
    for (int p = 0; p < NPHASES; ++p) { a.ph_lo = p; a.ph_hi = p + 1; hipLaunchKernelGGL(fwd, dim3(grid), dim3(NWAVES * 64), LDS_BYTES, stream, a); }
#endif
}
```

```cpp
#include <hip/hip_runtime.h>
#include <cstdio>
#include <cstdint>
#ifndef GDN_NAIVE
#define GDN_NAIVE 0
#endif
#ifndef SB_NAIVE
#define SB_NAIVE 0
#endif
#ifndef MK_ONE_LAUNCH
#define MK_ONE_LAUNCH 1
#endif
namespace pg8 {
#define PG8_LAS __attribute__((address_space(3)))
typedef unsigned short bf16_t;
typedef short bf16x8 __attribute__((ext_vector_type(8)));
typedef float f32x4 __attribute__((ext_vector_type(4)));
typedef unsigned u32x4 __attribute__((ext_vector_type(4)));
constexpr int BM = 256, BK = 64, HALF = 128, HTB = HALF * BK * 2  , STAGE_BYTES = 8 * HTB, NXCD = 8, WGM = 8;

__host__ __device__ __forceinline__ int lds_byte(int r, int c) { const int st = (r >> 4) * 2 + (c >> 5), rr = r & 15, cc = c & 31, ob = rr * 64 + cc * 2; return st * 1024 + (ob ^ (((ob >> 9) & 1) << 5)); }
__host__ __device__ __forceinline__ void stage_rc(int b, int& R, int& C) { const int st = b / 1024, sb = b % 1024, swz = sb ^ (((sb >> 9) & 1) << 5); R = (st >> 1) * 16 + swz / 64; C = (st & 1) * 32 + (swz % 64) / 2; }
__host__ __device__ __forceinline__ int perm32(int rho) { const int n = rho >> 4, i = rho & 15; return 8 * (i >> 2) + 4 * n + (i & 3); }

struct Unit { int pm, pn; };
struct Gemm { const bf16_t* A; const bf16_t* Bt; int lda, K; };

struct StaticOrder {
    int nM, nN, nwg, G, c, rep;
    __host__ __device__ void init(int M, int N, int G_, int c_, int rep_ = 1) { nM = M / BM; nN = N / BM; nwg = nM * nN; G = G_; c = c_; rep = rep_; }
    __host__ __device__ bool next(int i, Unit& u) const {
        const long L = (long)i * G + c; if (L >= (long)rep * nwg) return false;
        int wgid = (int)(L % nwg); { const int q = nwg / NXCD, r = nwg % NXCD, xcd = wgid % NXCD, off = wgid / NXCD; wgid = (xcd < r ? xcd * (q + 1) : r * (q + 1) + (xcd - r) * q) + off; }
        const int nig = WGM * nN, gid = wgid / nig, fm = gid * WGM, gsz = (nM - fm) < WGM ? (nM - fm) : WGM;
        u.pm = fm + ((wgid % nig) % gsz); u.pn = (wgid % nig) / gsz; return true;
    }
    __device__ __forceinline__ void a_ready(const Unit&) const {}
    __device__ __forceinline__ void done(const Unit&) const {}
};

__device__ __forceinline__ unsigned cvt_pk_bf16(float lo, float hi) { unsigned r; asm volatile("v_cvt_pk_bf16_f32 %0, %1, %2" : "=v"(r) : "v"(lo), "v"(hi)); return r; }
struct EpiBf16 {
    static constexpr bool PERM = true, AFTER_DRAIN = false;
    bf16_t* O; int ldc; int nmod;
    __device__ __forceinline__ void operator()(const f32x4 (&acc)[2][2][4][2], const Unit& u, int wr, int wc, int fr, int fq) const {
        const int pnl = nmod ? (u.pn % nmod) : u.pn;
        const int row0 = u.pm * BM + wr * 64 + fr, col0 = pnl * BM + wc * 32 + 8 * fq;
#pragma unroll
        for (int ai = 0; ai < 2; ++ai)
#pragma unroll
            for (int m = 0; m < 4; ++m) { bf16_t* rowp = O + (size_t)(row0 + ai * HALF + m * 16) * ldc + col0;
#pragma unroll
                for (int bj = 0; bj < 2; ++bj) { const f32x4 v0 = acc[ai][bj][m][0], v1 = acc[ai][bj][m][1];
                    u32x4 w; w.x = cvt_pk_bf16(v0[0], v0[1]); w.y = cvt_pk_bf16(v0[2], v0[3]); w.z = cvt_pk_bf16(v1[0], v1[1]); w.w = cvt_pk_bf16(v1[2], v1[3]);
                    *(u32x4*)(rowp + bj * HALF) = w; } }
    }
};
struct EpiInProj {
    static constexpr bool PERM = true, AFTER_DRAIN = false;
    bf16_t* RAW; bf16_t* ZB;
    __device__ __forceinline__ void operator()(const f32x4 (&acc)[2][2][4][2], const Unit& u, int wr, int wc, int fr, int fq) const {
        const bool isz = (u.pn >= 16 && u.pn < 24);
        bf16_t* O = isz ? ZB : RAW; const int ldc = isz ? 2048 : 4352; const int ct = isz ? (u.pn - 16) : (u.pn < 16 ? u.pn : 16);
        const int row0 = u.pm * BM + wr * 64 + fr, col0 = ct * BM + wc * 32 + 8 * fq;
#pragma unroll
        for (int ai = 0; ai < 2; ++ai)
#pragma unroll
            for (int m = 0; m < 4; ++m) { bf16_t* rowp = O + (size_t)(row0 + ai * HALF + m * 16) * ldc + col0;
#pragma unroll
                for (int bj = 0; bj < 2; ++bj) { const f32x4 v0 = acc[ai][bj][m][0], v1 = acc[ai][bj][m][1];
                    u32x4 w; w.x = cvt_pk_bf16(v0[0], v0[1]); w.y = cvt_pk_bf16(v0[2], v0[3]); w.z = cvt_pk_bf16(v1[0], v1[1]); w.w = cvt_pk_bf16(v1[2], v1[3]);
                    *(u32x4*)(rowp + bj * HALF) = w; } }
    }
};
__device__ __forceinline__ float silu_f(float x) { return x * __builtin_amdgcn_rcpf(1.0f + __builtin_amdgcn_exp2f(-1.4426950408889634f * x)); }
struct EpiSwiGLU {
    static constexpr bool PERM = true, AFTER_DRAIN = false;
    bf16_t* O; int ldc; int nmod;
    __device__ __forceinline__ void operator()(const f32x4 (&acc)[2][2][4][2], const Unit& u, int wr, int wc, int fr, int fq) const {
        const int pnl = nmod ? (u.pn % nmod) : u.pn;
        const int row0 = u.pm * BM + wr * 64 + fr, col0 = pnl * HALF + wc * 32 + 8 * fq;
#pragma unroll
        for (int ai = 0; ai < 2; ++ai)
#pragma unroll
            for (int m = 0; m < 4; ++m) { bf16_t* rowp = O + (size_t)(row0 + ai * HALF + m * 16) * ldc + col0;
                const f32x4 g0 = acc[ai][0][m][0], g1 = acc[ai][0][m][1], u0 = acc[ai][1][m][0], u1 = acc[ai][1][m][1];
                u32x4 w;
                w.x = cvt_pk_bf16(silu_f(g0[0]) * u0[0], silu_f(g0[1]) * u0[1]); w.y = cvt_pk_bf16(silu_f(g0[2]) * u0[2], silu_f(g0[3]) * u0[3]);
                w.z = cvt_pk_bf16(silu_f(g1[0]) * u1[0], silu_f(g1[1]) * u1[1]); w.w = cvt_pk_bf16(silu_f(g1[2]) * u1[2], silu_f(g1[3]) * u1[3]);
                *(u32x4*)rowp = w; }
    }
};
template <bool LNR> struct EpiResid {
    static constexpr bool PERM = false, AFTER_DRAIN = false;
    const float* res; float* out; const float* stats; const float* g; const float* b;
    __device__ __forceinline__ void operator()(const f32x4 (&acc)[2][2][4][2], const Unit& u, int wr, int wc, int fr, int fq) const {
        constexpr int ldc = 1024; constexpr float alpha = 1.6817928305074290f;
        const int row0 = u.pm * BM + wr * 64 + fr, col0 = u.pn * BM + wc * 32 + 4 * fq;
        if constexpr (!LNR) {
#pragma unroll
            for (int ai = 0; ai < 2; ++ai)
#pragma unroll
                for (int m = 0; m < 4; ++m) { const size_t off = (size_t)(row0 + ai * HALF + m * 16) * ldc + col0;
#pragma unroll
                    for (int bj = 0; bj < 2; ++bj)
#pragma unroll
                        for (int n = 0; n < 2; ++n) { const f32x4 r = *(const f32x4*)(res + off + bj * HALF + n * 16);
                            *(f32x4*)(out + off + bj * HALF + n * 16) = r * alpha + acc[ai][bj][m][n]; } }
        } else {
#pragma unroll
            for (int bj = 0; bj < 2; ++bj)
#pragma unroll
                for (int n = 0; n < 2; ++n) {
                    const f32x4 gv = *(const f32x4*)(g + col0 + bj * HALF + n * 16) * alpha, bv = *(const f32x4*)(b + col0 + bj * HALF + n * 16) * alpha;
#pragma unroll
                    for (int ai = 0; ai < 2; ++ai)
#pragma unroll
                        for (int m = 0; m < 4; ++m) { const int row = row0 + ai * HALF + m * 16; const size_t off = (size_t)row * ldc + col0 + bj * HALF + n * 16;
                            const float mean = stats[2 * row], rstd = stats[2 * row + 1];
                            const f32x4 r = *(const f32x4*)(res + off);
                            *(f32x4*)(out + off) = (r - mean) * rstd * gv + bv + acc[ai][bj][m][n]; }
                    asm volatile("" ::: "memory");
                }
        }
    }
};
struct MoeOrder {
    int nM, nN, nwg, G, c, rep; int ps1, ps2, ps3, ps4, ps5, ps6, ps7;
    __device__ __forceinline__ bool next(int i, Unit& u) const {
        const long L = (long)i * G + c; if (nwg == 0 || L >= (long)rep * nwg) return false;
        int wgid = (int)(L % nwg); { const int q = nwg / NXCD, r = nwg % NXCD, xcd = wgid % NXCD, off = wgid / NXCD; wgid = (xcd < r ? xcd * (q + 1) : r * (q + 1) + (xcd - r) * q) + off; }
        const int nig = WGM * nN, gid = wgid / nig, fm = gid * WGM, gsz = (nM - fm) < WGM ? (nM - fm) : WGM;
        const int pm = fm + ((wgid % nig) % gsz), pnl = (wgid % nig) / gsz;
        const int e = (pm >= ps1) + (pm >= ps2) + (pm >= ps3) + (pm >= ps4) + (pm >= ps5) + (pm >= ps6) + (pm >= ps7);
        u.pm = pm; u.pn = e * nN + pnl; return true;
    }
    __device__ __forceinline__ void a_ready(const Unit&) const {}
    __device__ __forceinline__ void done(const Unit&) const {}
};
template <class Epi, class Sched, bool ALIGN_EPI = false, bool SP2 = false>
__device__ __forceinline__ void gemm_phase(PG8_LAS unsigned char* lds, const Gemm g, const Sched& S, const Epi& E) {
    const int tid = threadIdx.x, wid = __builtin_amdgcn_readfirstlane(tid >> 6), lane = tid & 63, wr = wid >> 2, wc = wid & 3, fr = lane & 15, fq = lane >> 4;
    const int K = g.K, nt = K / BK;
    unsigned voffA[2], voffB[2];
#pragma unroll
    for (int i = 0; i < 2; ++i) { int R, C; stage_rc(tid * 16 + i * 8192, R, C); const int Rb = Epi::PERM ? ((R & ~31) + perm32(R & 31)) : R;
        voffA[i] = (unsigned)(R * g.lda + C) * 2u; voffB[i] = (unsigned)(Rb * K + C) * 2u; }
    const size_t kstep = (size_t)(BK * 2);
    const size_t hstepA = (size_t)HALF * g.lda * 2, hstepB = (size_t)HALF * K * 2;
    const size_t tstepA = 2 * hstepA, tstepB = 2 * hstepB;
    const unsigned ldsw = (unsigned)wid * 1024u;
    const int aoff = lds_byte(wr * 64 + fr, fq * 8), boff = lds_byte(wc * 32 + fr, fq * 8);
#define PG8_SA(b, h) (((b) * 2 + (h)) * HTB)
#define PG8_SB(b, h) ((4 + (b) * 2 + (h)) * HTB)
#define PG8_STAGE(bufoff, gbase, voff) do { _Pragma("unroll") for (int _i = 0; _i < 2; ++_i) \
        __builtin_amdgcn_global_load_lds((const unsigned*)((const char*)(gbase) + (voff)[_i]), (PG8_LAS unsigned*)(lds + (bufoff) + ldsw + _i * 8192), 16, 0, 0); } while (0)
#define PG8_LDA(dst, b, h) do { _Pragma("unroll") for (int m = 0; m < 4; ++m) _Pragma("unroll") for (int k = 0; k < 2; ++k) dst[m][k] = *(const PG8_LAS bf16x8*)(lds + PG8_SA(b, h) + aoff + m * 2048 + k * 1024); } while (0)
#define PG8_LDB(dst, b, h) do { _Pragma("unroll") for (int n = 0; n < 2; ++n) _Pragma("unroll") for (int k = 0; k < 2; ++k) dst[n][k] = *(const PG8_LAS bf16x8*)(lds + PG8_SB(b, h) + boff + n * 2048 + k * 1024); } while (0)
#define PG8_MMA(ai, bj, At, Bt) do { __builtin_amdgcn_s_setprio(1); _Pragma("unroll") for (int m = 0; m < 4; ++m) _Pragma("unroll") for (int n = 0; n < 2; ++n) _Pragma("unroll") for (int k = 0; k < 2; ++k) \
        acc[ai][bj][m][n] = __builtin_amdgcn_mfma_f32_16x16x32_bf16(Bt[n][k], At[m][k], acc[ai][bj][m][n], 0, 0, 0); __builtin_amdgcn_s_setprio(0); } while (0)
#define PG8_WAIT_V(n) asm volatile("s_waitcnt vmcnt(" #n ")" ::: "memory")
#define PG8_WAIT_L(n) asm volatile("s_waitcnt lgkmcnt(" #n ")" ::: "memory")
#define PG8_BAR __builtin_amdgcn_s_barrier()
#define PG8_SCHED __builtin_amdgcn_sched_barrier(0)
    Unit cur, nxt; int ui = 0;
    if (!S.next(0, cur)) return;
    f32x4 acc[2][2][4][2];
#pragma unroll
    for (int a = 0; a < 2; ++a)
#pragma unroll
        for (int b = 0; b < 2; ++b)
#pragma unroll
            for (int m = 0; m < 4; ++m)
#pragma unroll
                for (int n = 0; n < 2; ++n) acc[a][b][m][n] = (f32x4){0.f, 0.f, 0.f, 0.f};
    bf16x8 At[4][2], B0[2][2], B1[2][2];
    const char* cA = (const char*)g.A + (size_t)cur.pm * tstepA; const char* cB = (const char*)g.Bt + (size_t)cur.pn * tstepB;
    S.a_ready(cur);
    if constexpr (SP2) {
        PG8_STAGE(PG8_SB(0, 0), cB, voffB); PG8_STAGE(PG8_SB(0, 1), cB + hstepB, voffB); PG8_STAGE(PG8_SA(0, 0), cA, voffA); PG8_STAGE(PG8_SA(0, 1), cA + hstepA, voffA);
        if (wr == 1) PG8_BAR;
        PG8_WAIT_V(2); PG8_BAR;
        PG8_STAGE(PG8_SB(1, 0), cB + kstep, voffB); PG8_STAGE(PG8_SA(1, 0), cA + kstep, voffA); PG8_STAGE(PG8_SB(1, 1), cB + hstepB + kstep, voffB);
        PG8_WAIT_V(6); PG8_BAR;
    } else {
        PG8_STAGE(PG8_SB(0, 0), cB, voffB); PG8_STAGE(PG8_SA(0, 0), cA, voffA); PG8_STAGE(PG8_SB(0, 1), cB + hstepB, voffB); PG8_STAGE(PG8_SA(0, 1), cA + hstepA, voffA);
        if (wr == 1) PG8_BAR;
        PG8_WAIT_V(4); PG8_BAR;
        PG8_STAGE(PG8_SB(1, 0), cB + kstep, voffB); PG8_STAGE(PG8_SA(1, 0), cA + kstep, voffA); PG8_STAGE(PG8_SB(1, 1), cB + hstepB + kstep, voffB);
        PG8_WAIT_V(6); PG8_BAR;
    }
    for (;;) {
        const bool has_next = S.next(ui + 1, nxt);
        const char* nA = has_next ? (const char*)g.A + (size_t)nxt.pm * tstepA : cA; const char* nB = has_next ? (const char*)g.Bt + (size_t)nxt.pn * tstepB : cB;
        for (int t = 0; t < nt; t += 2) {
            const bool last = (t == nt - 2);
            const char* a1 = cA + (size_t)(t + 1) * kstep;
            const char* a2 = last ? nA : cA + (size_t)(t + 2) * kstep; const char* b2 = last ? nB : cB + (size_t)(t + 2) * kstep;
            const char* a3 = a2 + kstep; const char* b3 = b2 + kstep;
            if (last && has_next) S.a_ready(nxt);
            if constexpr (SP2) {
            PG8_LDB(B0, 0, 0); PG8_LDB(B1, 0, 1); PG8_SCHED; PG8_LDA(At, 0, 0); PG8_STAGE(PG8_SA(1, 1), a1 + hstepA, voffA);
            PG8_WAIT_V(8); PG8_WAIT_L(0); PG8_BAR; PG8_MMA(0, 0, At, B0); PG8_MMA(0, 1, At, B1); PG8_BAR; PG8_SCHED;
            PG8_LDA(At, 0, 1); PG8_STAGE(PG8_SB(0, 0), b2, voffB); PG8_STAGE(PG8_SB(0, 1), b2 + hstepB, voffB); PG8_STAGE(PG8_SA(0, 0), a2, voffA);
            PG8_WAIT_V(8); PG8_WAIT_L(0); PG8_BAR; PG8_MMA(1, 0, At, B0); PG8_MMA(1, 1, At, B1); PG8_BAR; PG8_SCHED;
            PG8_LDB(B0, 1, 0); PG8_LDB(B1, 1, 1); PG8_SCHED; PG8_LDA(At, 1, 0); PG8_STAGE(PG8_SA(0, 1), a2 + hstepA, voffA);
            PG8_WAIT_V(8); PG8_WAIT_L(0); PG8_BAR; PG8_MMA(0, 0, At, B0); PG8_MMA(0, 1, At, B1); PG8_BAR; PG8_SCHED;
            PG8_LDA(At, 1, 1); PG8_STAGE(PG8_SB(1, 0), b3, voffB); PG8_STAGE(PG8_SB(1, 1), b3 + hstepB, voffB); PG8_STAGE(PG8_SA(1, 0), a3, voffA);
            PG8_WAIT_V(8); PG8_WAIT_L(0); PG8_BAR; PG8_MMA(1, 0, At, B0); PG8_MMA(1, 1, At, B1); PG8_BAR; PG8_SCHED;
            } else {
            PG8_LDB(B0, 0, 0); PG8_SCHED; PG8_LDA(At, 0, 0); PG8_STAGE(PG8_SA(1, 1), a1 + hstepA, voffA);
            PG8_WAIT_L(8); PG8_BAR; PG8_WAIT_L(0); PG8_MMA(0, 0, At, B0); PG8_BAR; PG8_SCHED;
            PG8_LDB(B1, 0, 1); PG8_STAGE(PG8_SB(0, 0), b2, voffB);
            PG8_BAR; PG8_WAIT_L(0); PG8_MMA(0, 1, At, B1); PG8_BAR;
            PG8_LDA(At, 0, 1); PG8_STAGE(PG8_SA(0, 0), a2, voffA);
            PG8_BAR; PG8_WAIT_L(0); PG8_MMA(1, 0, At, B0); PG8_BAR; PG8_SCHED;
            PG8_STAGE(PG8_SB(0, 1), b2 + hstepB, voffB);
            PG8_WAIT_V(6); PG8_BAR; PG8_MMA(1, 1, At, B1); PG8_BAR;
            PG8_LDB(B0, 1, 0); PG8_SCHED; PG8_LDA(At, 1, 0); PG8_STAGE(PG8_SA(0, 1), a2 + hstepA, voffA);
            PG8_WAIT_L(8); PG8_BAR; PG8_WAIT_L(0); PG8_MMA(0, 0, At, B0); PG8_BAR; PG8_SCHED;
            PG8_LDB(B1, 1, 1); PG8_STAGE(PG8_SB(1, 0), b3, voffB);
            PG8_BAR; PG8_WAIT_L(0); PG8_MMA(0, 1, At, B1); PG8_BAR;
            PG8_LDA(At, 1, 1); PG8_STAGE(PG8_SA(1, 0), a3, voffA);
            PG8_BAR; PG8_WAIT_L(0); PG8_MMA(1, 0, At, B0); PG8_BAR; PG8_SCHED;
            PG8_STAGE(PG8_SB(1, 1), b3 + hstepB, voffB);
            PG8_WAIT_V(6); PG8_BAR; PG8_MMA(1, 1, At, B1); PG8_BAR;
            }
        }
        if constexpr (ALIGN_EPI) { if (wr == 0) PG8_BAR; }
        if constexpr (!Epi::AFTER_DRAIN) { E(acc, cur, wr, wc, fr, fq); S.done(cur); }
        if (!has_next) break;
#pragma unroll
        for (int a = 0; a < 2; ++a)
#pragma unroll
            for (int b = 0; b < 2; ++b)
#pragma unroll
                for (int m = 0; m < 4; ++m)
#pragma unroll
                    for (int n = 0; n < 2; ++n) acc[a][b][m][n] = (f32x4){0.f, 0.f, 0.f, 0.f};
        cur = nxt; cA = nA; cB = nB; ++ui;
        if constexpr (ALIGN_EPI) { if (wr == 1) PG8_BAR; }
    }
    PG8_WAIT_V(0);
    if constexpr (!ALIGN_EPI) { if (wr == 0) PG8_BAR; }
    PG8_BAR;
    if constexpr (Epi::AFTER_DRAIN) { E.fused(acc, cur, wr, wc, fr, fq, lds, wid, lane); S.done(cur); }
#undef PG8_SA
#undef PG8_SB
#undef PG8_STAGE
#undef PG8_LDA
#undef PG8_LDB
#undef PG8_MMA
#undef PG8_WAIT_V
#undef PG8_WAIT_L
#undef PG8_BAR
#undef PG8_SCHED
}
}

constexpr int NWAVES = 8;
constexpr int BATCH = 8, SEQ = 4096, TT = BATCH * SEQ, D = 1024;
constexpr int HK = 8, HV = 16, HD = 128;
constexpr int GIN = 6176, GINP = 6400;
constexpr int FF = 3584, NE = 8, MOE_ROWS = 67584;
constexpr float ALPHA = 1.6817928305074290f;
constexpr float LN_EPS = 1e-5f, RMS_EPS = 1e-6f;
constexpr int NPH = 18, NPHASES = 2 * NPH;

constexpr size_t MiB = 1ull << 20;
constexpr size_t WS_CTL = 0, CTL_ZERO_BYTES = 1 * MiB;
constexpr size_t WS_E12 = 1 * MiB;
constexpr size_t WS_G12 = WS_E12 + 256 * 1024;
constexpr size_t WS_POS = WS_G12 + 256 * 1024;
constexpr size_t WS_GB = 2 * MiB;
constexpr size_t WS_W = 16 * MiB;
constexpr size_t WS_W2 = 912 * MiB;
constexpr size_t W_IN = WS_W2, W_OUT = WS_W2 + 13 * MiB, W_GU = WS_W2 + 17 * MiB, W_D = WS_W2 + 31 * MiB;
constexpr size_t W_QKV = WS_W, W_O = WS_W + 6 * MiB, W_MGU = WS_W + 8 * MiB, W_MD = WS_W + 120 * MiB;
constexpr size_t WS_HB = 192 * MiB;
constexpr size_t WS_BIG = 256 * MiB;
constexpr size_t WS_ZB = WS_BIG, WS_RAW = WS_BIG + 128 * MiB, WS_QKVC = WS_BIG + 400 * MiB;
constexpr int RAWLD = 4352;
constexpr size_t WS_WMEM = WS_RAW, WS_IMEM = WS_RAW + 128 * MiB, WS_KTMEM = WS_RAW + 192 * MiB;
constexpr size_t WS_STATS = 12 * MiB;
constexpr size_t WS_GTAB = 6 * MiB;
constexpr size_t WS_ACT = WS_BIG;
constexpr size_t WS_QKV = WS_BIG, WS_AO = WS_BIG + 192 * MiB;
constexpr size_t WS_XS = WS_BIG, WS_MACT = WS_BIG + 132 * MiB;
constexpr size_t WS_END = 950 * MiB;
static_assert(WS_QKVC + (size_t)TT * 4096 * 2 <= WS_W2 && WS_MACT + (size_t)MOE_ROWS * FF * 2 <= WS_END && WS_RAW + (size_t)TT * RAWLD * 2 <= WS_QKVC && WS_KTMEM + (size_t)4096 * 8192 * 2 <= WS_QKVC && WS_GTAB + (size_t)8192 * 192 * 4 <= WS_W, "d_ws map");
static_assert(W_MD + (size_t)NE * D * FF * 2 <= WS_HB && W_IN + (size_t)GINP * D * 2 <= W_OUT && W_D + (size_t)D * FF * 2 <= WS_END && WS_QKVC + (size_t)TT * 4096 * 2 <= WS_W2 && W_MGU + (size_t)NE * 2 * FF * D * 2 <= W_MD, "weight map");
constexpr int CW_BAR = 4096;
constexpr int CW_CNT = 16384;

constexpr int RING_BYTES = 131072;
constexpr int MISC_OFF = RING_BYTES + 320;
constexpr int OGST_OFF = 147456;
#ifndef PROBE_SEC
#define PROBE_SEC 0
#endif
#define SEC_IN(k) do { if (PROBE_SEC == (k)) { if (blockIdx.x == 0 && (threadIdx.x == 0)) ((volatile LAS unsigned*)((LAS unsigned char*)0 + MISC_OFF))[20] -= (unsigned)__builtin_amdgcn_s_memrealtime(); } } while (0)
#define SEC_OUT(k) do { if (PROBE_SEC == (k)) { if (blockIdx.x == 0 && (threadIdx.x == 0)) ((volatile LAS unsigned*)((LAS unsigned char*)0 + MISC_OFF))[20] += (unsigned)__builtin_amdgcn_s_memrealtime(); } } while (0)
constexpr int LDS_BYTES = 163840;

#define GAS __attribute__((address_space(1)))
#define LAS __attribute__((address_space(3)))
#define DI __device__ __forceinline__
typedef unsigned short bf16;
typedef unsigned v4u __attribute__((ext_vector_type(4)));
typedef unsigned v2u __attribute__((ext_vector_type(2)));
typedef float f32x4 __attribute__((ext_vector_type(4)));
typedef float f32x2 __attribute__((ext_vector_type(2)));
typedef GAS unsigned gu32;
#define RLX_AGENT __ATOMIC_RELAXED, __HIP_MEMORY_SCOPE_AGENT
#define LDS_WAIT() asm volatile("s_waitcnt lgkmcnt(0)" ::: "memory")
#define VM_WAIT() asm volatile("s_waitcnt vmcnt(0)" ::: "memory")
__device__ __forceinline__ unsigned long long rt() { return __builtin_amdgcn_s_memrealtime(); }
__device__ __forceinline__ unsigned f2bf(float f) { unsigned u = __builtin_bit_cast(unsigned, f); return (u + 0x7fffu + ((u >> 16) & 1u)) >> 16; }
__device__ __forceinline__ unsigned pk2(float lo, float hi) { return f2bf(lo) | (f2bf(hi) << 16); }

#define XB_TMO      128
#define XB_XCNT(j)  (256  + 64 * (j))
#define XB_XSUB(j)  (1280 + 64 * (j))
#define XB_XGEN(j)  (2304 + 64 * (j))
#define XB_TOP      3328
#define XB_TOPGEN   3392
#define XCD_BAR_WORDS 3456
#define XB_SPIN_CAP (1u << 22)

__device__ __forceinline__ unsigned xb_ld(unsigned* p)              { return __hip_atomic_load(p, __ATOMIC_RELAXED, __HIP_MEMORY_SCOPE_AGENT); }
__device__ __forceinline__ unsigned xb_add(unsigned* p, unsigned v) { return __hip_atomic_fetch_add(p, v, __ATOMIC_RELAXED, __HIP_MEMORY_SCOPE_AGENT); }
__device__ __forceinline__ unsigned xb_xcc_id() { return (unsigned)__builtin_amdgcn_s_getreg((3 << 11) | 20) & 0xFu; }
#define XB_SPIN(cond, bar) do { unsigned _sp = 0; while (cond) { __builtin_amdgcn_s_sleep(1); \
    if ((++_sp & 255u) == 0u) { if (xb_ld(&(bar)[XB_TMO])) break; if (_sp > XB_SPIN_CAP) { atomicAdd(&(bar)[XB_TMO], 1u); break; } } } } while (0)

struct XcdBarrier {
    unsigned* bar; unsigned x;
    volatile LAS unsigned* st;
};

__device__ __forceinline__ XcdBarrier xcd_barrier_post(unsigned* bar, volatile LAS unsigned* st) {
    XcdBarrier b; b.bar = bar; b.x = xb_xcc_id(); b.st = st;
    if (threadIdx.x == 0) (void)xb_add(&bar[XB_XCNT(b.x)], 1u);
    return b;
}
__device__ __forceinline__ void xcd_barrier_complete(unsigned* bar, unsigned x, unsigned& nloc, unsigned& nx) {
    const unsigned G = gridDim.x * gridDim.y * gridDim.z;
    unsigned sum, cnt, mine, sp = 0u;
    for (;;) {
        sum = 0u; cnt = 0u; mine = 0u;
#pragma unroll
        for (unsigned j = 0; j < 16; ++j) { const unsigned c = xb_ld(&bar[XB_XCNT(j)]); sum += c; cnt += (c > 0u) ? 1u : 0u; mine = (j == x) ? c : mine; }
        if (sum == G) break;
        __builtin_amdgcn_s_sleep(1);
        if ((++sp & 255u) == 0u) { if (xb_ld(&bar[XB_TMO])) break; if (sp > XB_SPIN_CAP) { atomicAdd(&bar[XB_TMO], 1u); break; } }
    }
    nloc = mine > 0u ? mine : 1u; nx = cnt > 0u ? cnt : 1u;
}

__device__ __forceinline__ void xcd_barrier(const XcdBarrier& b) {
    asm volatile("s_waitcnt vmcnt(0)" ::: "memory");
    __syncthreads();
    if (threadIdx.x == 0) {
        unsigned* bar = b.bar;
        __builtin_amdgcn_s_waitcnt(0);
        unsigned nloc = b.st[0], nx = b.st[1];
        if (nloc == 0u) { xcd_barrier_complete(bar, b.x, nloc, nx); b.st[0] = nloc; b.st[1] = nx; }
        const unsigned old = xb_add(&bar[XB_XSUB(b.x)], 1u);
        const unsigned gen = old / nloc;
        if (old + 1u == (gen + 1u) * nloc) {
            __builtin_amdgcn_fence(__ATOMIC_RELEASE, "agent");
            asm volatile("s_waitcnt vmcnt(0)" ::: "memory");
            const unsigned og = xb_add(&bar[XB_TOP], 1u);
            const unsigned tg = og / nx;
            if (og + 1u == (tg + 1u) * nx) xb_add(&bar[XB_TOPGEN], 1u);
            else XB_SPIN(xb_ld(&bar[XB_TOPGEN]) == tg, bar);
            __builtin_amdgcn_fence(__ATOMIC_ACQUIRE, "agent");
            xb_add(&bar[XB_XGEN(b.x)], 1u);
            asm volatile("s_waitcnt vmcnt(0)" ::: "memory");
        } else {
            XB_SPIN(xb_ld(&bar[XB_XGEN(b.x)]) == gen, bar);
            __builtin_amdgcn_fence(__ATOMIC_ACQUIRE, "agent");
            asm volatile("s_waitcnt vmcnt(0)" ::: "memory");
        }
    }
    __syncthreads();
}

DI float bf_lo(unsigned w) { return __uint_as_float(w << 16); }
DI float bf_hi(unsigned w) { return __uint_as_float(w & 0xffff0000u); }
DI float wave_sum(float v) {
#pragma unroll
    for (int o = 1; o < 64; o <<= 1) v += __shfl_xor(v, o);
    return v;
}
DI float sigmoid_f(float x) { return 1.0f / (1.0f + __expf(-x)); }

struct Args {
    const float *x, *gdn_w_in, *gdn_conv_w, *gdn_a_log, *gdn_dt_bias, *gdn_norm_w, *gdn_w_out, *sb_w_in, *sb_w_out, *ffn_w_gate, *ffn_w_up, *ffn_w_down,
                *moe_router, *moe_w_gate, *moe_w_up, *moe_w_down, *ln_g, *ln_b;
    float* out; unsigned char* ws; int ph_lo, ph_hi;
};

DI void transpose_item(const float* W, int ldw, bf16* WT, int K, int drow0, int k0, int n0, LAS float* scr, int lane) {
#pragma unroll 8
    for (int i = 0; i < 32; ++i) { const int kk = 2 * i + (lane >> 5); scr[kk * 33 + (lane & 31)] = W[(size_t)(k0 + kk) * ldw + n0 + (lane & 31)]; }
    LDS_WAIT(); asm volatile("" ::: "memory");
    const int c = lane & 7;
#pragma unroll
    for (int jj = 0; jj < 4; ++jj) { const int n = (lane >> 3) + 8 * jj; const LAS float* s = scr + (8 * c) * 33 + n;
        v4u o; o.x = pk2(s[0 * 33], s[1 * 33]); o.y = pk2(s[2 * 33], s[3 * 33]); o.z = pk2(s[4 * 33], s[5 * 33]); o.w = pk2(s[6 * 33], s[7 * 33]);
        *(v4u*)(WT + (size_t)(drow0 + n) * K + k0 + 8 * c) = o; }
    LDS_WAIT(); asm volatile("" ::: "memory");
}

DI void transpose_item64(const float* W, int ldw, bf16* WT, int K, int drow0, int k0, int n0, LAS unsigned char* scr, int lane) {
    const int q = lane >> 4, cx = lane & 15;
    f32x4 r[16];
#pragma unroll
    for (int i = 0; i < 16; ++i) r[i] = *(const f32x4*)(W + (size_t)(k0 + 16 * q + i) * ldw + n0 + 4 * cx);
#pragma unroll
    for (int e = 0; e < 4; ++e) {
        v4u w0, w1;
        w0.x = pk2(r[0][e], r[1][e]); w0.y = pk2(r[2][e], r[3][e]); w0.z = pk2(r[4][e], r[5][e]); w0.w = pk2(r[6][e], r[7][e]);
        w1.x = pk2(r[8][e], r[9][e]); w1.y = pk2(r[10][e], r[11][e]); w1.z = pk2(r[12][e], r[13][e]); w1.w = pk2(r[14][e], r[15][e]);
        *(LAS v4u*)(scr + (4 * cx + e) * 144 + q * 32) = w0; *(LAS v4u*)(scr + (4 * cx + e) * 144 + q * 32 + 16) = w1;
    }
    LDS_WAIT(); asm volatile("" ::: "memory");
#pragma unroll
    for (int j = 0; j < 8; ++j) { const int id = lane + 64 * j, n = id >> 3, kp = id & 7;
        *(v4u*)(WT + (size_t)(drow0 + n) * K + k0 + 8 * kp) = *(const LAS v4u*)(scr + n * 144 + kp * 16); }
    LDS_WAIT(); asm volatile("" ::: "memory");
}

DI void phase_w_gdn(const Args& a, int j, LAS unsigned char* lds, int bid, int G, int tid, int wave, int lane) {
    LAS float* scr = (LAS float*)(lds + wave * 16384);
    const int gw = bid * NWAVES + wave, NGW = G * NWAVES;
    const float* Win = a.gdn_w_in + (size_t)j * D * GIN; const float* Wout = a.gdn_w_out + (size_t)j * 2048 * D;
    const float* Wg = a.ffn_w_gate + (size_t)j * D * FF; const float* Wu = a.ffn_w_up + (size_t)j * D * FF; const float* Wd = a.ffn_w_down + (size_t)j * FF * D;
    bf16* WIN_T = (bf16*)(a.ws + W_IN); bf16* WOUT_T = (bf16*)(a.ws + W_OUT); bf16* WGU_T = (bf16*)(a.ws + W_GU); bf16* WD_T = (bf16*)(a.ws + W_D);
    LAS unsigned char* scb = (LAS unsigned char*)scr;
    constexpr int I_IN = 16 * 96, I_INT = 16, I_OUT = 32 * 16, I_G = 16 * 56, I_D = 56 * 16, NIT = I_IN + I_INT + I_OUT + 2 * I_G + I_D;
    for (int it = gw; it < NIT; it += NGW) {
        int r = it;
        if (r < I_IN) { const int kb = r / 96, nb = r % 96; transpose_item64(Win, GIN, WIN_T, D, 64 * nb, 64 * kb, 64 * nb, scb, lane); continue; } r -= I_IN;
        if (r < I_INT) { transpose_item(Win, GIN, WIN_T, D, 6144, 64 * r, 6144, scr, lane); continue; } r -= I_INT;
        if (r < I_OUT) { const int kb = r / 16, nb = r % 16; transpose_item64(Wout, D, WOUT_T, 2048, 64 * nb, 64 * kb, 64 * nb, scb, lane); continue; } r -= I_OUT;
        if (r < I_G) { const int kb = r / 56, nb = r % 56, n0 = 64 * nb; transpose_item64(Wg, FF, WGU_T, D, 256 * (n0 >> 7) + (n0 & 127), 64 * kb, n0, scb, lane); continue; } r -= I_G;
        if (r < I_G) { const int kb = r / 56, nb = r % 56, n0 = 64 * nb; transpose_item64(Wu, FF, WGU_T, D, 256 * (n0 >> 7) + 128 + (n0 & 127), 64 * kb, n0, scb, lane); continue; } r -= I_G;
        { const int kb = r / 16, nb = r % 16; transpose_item64(Wd, D, WD_T, FF, 64 * nb, 64 * kb, 64 * nb, scb, lane); }
    }
    if (j == 0) {
        bf16* HB = (bf16*)(a.ws + WS_HB); const f32x4* x4 = (const f32x4*)a.x;
        for (size_t i = (size_t)bid * 512 + tid; i < (size_t)TT * D / 8; i += (size_t)G * 512) { const f32x4 p = x4[2 * i], q = x4[2 * i + 1];
            v4u o; o.x = pk2(p[0], p[1]); o.y = pk2(p[2], p[3]); o.z = pk2(q[0], q[1]); o.w = pk2(q[2], q[3]); *(v4u*)(HB + 8 * i) = o; }
    }
}
DI void phase_w_sb(const Args& a, int j, LAS unsigned char* lds, int bid, int G, int wave, int lane) {
    LAS float* scr = (LAS float*)(lds + wave * 16384);
    const int gw = bid * NWAVES + wave, NGW = G * NWAVES;
    const float* Wqkv = a.sb_w_in + (size_t)j * D * 3072; const float* Wo = a.sb_w_out + (size_t)j * D * D;
    const float* Mg = a.moe_w_gate + (size_t)j * NE * D * FF; const float* Mu = a.moe_w_up + (size_t)j * NE * D * FF; const float* Md = a.moe_w_down + (size_t)j * NE * FF * D;
    bf16* WQKV_T = (bf16*)(a.ws + W_QKV); bf16* WO_T = (bf16*)(a.ws + W_O); bf16* MGU_T = (bf16*)(a.ws + W_MGU); bf16* MD_T = (bf16*)(a.ws + W_MD);
    LAS unsigned char* scb = (LAS unsigned char*)scr;
    constexpr int I_QKV = 16 * 48, I_O = 16 * 16, I_G = 16 * 56, I_D = 56 * 16, I_E = 2 * I_G + I_D, NIT = I_QKV + I_O + NE * I_E;
    for (int it = gw; it < NIT; it += NGW) {
        int r = it;
        if (r < I_QKV) { const int kb = r / 48, nb = r % 48; transpose_item64(Wqkv, 3072, WQKV_T, D, 64 * nb, 64 * kb, 64 * nb, scb, lane); continue; } r -= I_QKV;
        if (r < I_O) { const int kb = r / 16, nb = r % 16; transpose_item64(Wo, D, WO_T, D, 64 * nb, 64 * kb, 64 * nb, scb, lane); continue; } r -= I_O;
        const int e = r / I_E; r -= e * I_E;
        bf16* gu = MGU_T + (size_t)e * 2 * FF * D; bf16* dn = MD_T + (size_t)e * D * FF;
        if (r < I_G) { const int kb = r / 56, nb = r % 56, n0 = 64 * nb; transpose_item64(Mg + (size_t)e * D * FF, FF, gu, D, 256 * (n0 >> 7) + (n0 & 127), 64 * kb, n0, scb, lane); continue; } r -= I_G;
        if (r < I_G) { const int kb = r / 56, nb = r % 56, n0 = 64 * nb; transpose_item64(Mu + (size_t)e * D * FF, FF, gu, D, 256 * (n0 >> 7) + 128 + (n0 & 127), 64 * kb, n0, scb, lane); continue; } r -= I_G;
        { const int kb = r / 16, nb = r % 16; transpose_item64(Md + (size_t)e * FF * D, D, dn, FF, 64 * nb, 64 * kb, 64 * nb, scb, lane); }
    }
}

DI float dpp_sum16(float v) {
    v += __builtin_bit_cast(float, __builtin_amdgcn_update_dpp(0, __builtin_bit_cast(int, v), 0xB1, 0xF, 0xF, false));
    v += __builtin_bit_cast(float, __builtin_amdgcn_update_dpp(0, __builtin_bit_cast(int, v), 0x4E, 0xF, 0xF, false));
    v += __builtin_bit_cast(float, __builtin_amdgcn_update_dpp(0, __builtin_bit_cast(int, v), 0x141, 0xF, 0xF, false));
    v += __builtin_bit_cast(float, __builtin_amdgcn_update_dpp(0, __builtin_bit_cast(int, v), 0x140, 0xF, 0xF, false));
    return v;
}
DI void phase_conv(const Args& a, int j, int bid, int G, int tid) {
    const bf16* raw = (const bf16*)(a.ws + WS_RAW); bf16* qkvc = (bf16*)(a.ws + WS_QKVC); float* gb = (float*)(a.ws + WS_GB);
    const float* cw = a.gdn_conv_w + (size_t)j * 4 * 4096;
    const int ch = 8 * tid;
    float w0[8], w1[8], w2[8], w3[8];
#pragma unroll
    for (int i = 0; i < 8; ++i) { w0[i] = cw[ch + i]; w1[i] = cw[4096 + ch + i]; w2[i] = cw[2 * 4096 + ch + i]; w3[i] = cw[3 * 4096 + ch + i]; }
    const float post = tid < 128 ? 0.08838834764831845f : 1.0f;
    for (int run = bid; run < TT / 128; run += G) {
        const int t0 = run * 128; const bool first = (t0 & (SEQ - 1)) == 0;
        float xa[8], xb[8], xc[8];
        { v4u h0 = {0u, 0u, 0u, 0u}, h1 = h0, h2 = h0;
          if (!first) { h0 = *(const v4u*)(raw + (size_t)(t0 - 3) * RAWLD + ch); h1 = *(const v4u*)(raw + (size_t)(t0 - 2) * RAWLD + ch); h2 = *(const v4u*)(raw + (size_t)(t0 - 1) * RAWLD + ch); }
          xa[0] = bf_lo(h0.x); xa[1] = bf_hi(h0.x); xa[2] = bf_lo(h0.y); xa[3] = bf_hi(h0.y); xa[4] = bf_lo(h0.z); xa[5] = bf_hi(h0.z); xa[6] = bf_lo(h0.w); xa[7] = bf_hi(h0.w);
          xb[0] = bf_lo(h1.x); xb[1] = bf_hi(h1.x); xb[2] = bf_lo(h1.y); xb[3] = bf_hi(h1.y); xb[4] = bf_lo(h1.z); xb[5] = bf_hi(h1.z); xb[6] = bf_lo(h1.w); xb[7] = bf_hi(h1.w);
          xc[0] = bf_lo(h2.x); xc[1] = bf_hi(h2.x); xc[2] = bf_lo(h2.y); xc[3] = bf_hi(h2.y); xc[4] = bf_lo(h2.z); xc[5] = bf_hi(h2.z); xc[6] = bf_lo(h2.w); xc[7] = bf_hi(h2.w); }
#pragma unroll 1
        for (int tb = 0; tb < 128; tb += 8) {
            v4u xr[8];
#pragma unroll
            for (int u = 0; u < 8; ++u) xr[u] = *(const v4u*)(raw + (size_t)(t0 + tb + u) * RAWLD + ch);
#pragma unroll
            for (int u = 0; u < 8; ++u) {
                float xd[8]; xd[0] = bf_lo(xr[u].x); xd[1] = bf_hi(xr[u].x); xd[2] = bf_lo(xr[u].y); xd[3] = bf_hi(xr[u].y); xd[4] = bf_lo(xr[u].z); xd[5] = bf_hi(xr[u].z); xd[6] = bf_lo(xr[u].w); xd[7] = bf_hi(xr[u].w);
                float y[8]; float ss = 0.f;
#pragma unroll
                for (int i = 0; i < 8; ++i) { const float c = w0[i] * xa[i] + w1[i] * xb[i] + w2[i] * xc[i] + w3[i] * xd[i];
                    y[i] = c * __builtin_amdgcn_rcpf(1.0f + __builtin_amdgcn_exp2f(-1.4426950408889634f * c)); ss += y[i] * y[i];
                    xa[i] = xb[i]; xb[i] = xc[i]; xc[i] = xd[i]; }
                if (tid < 256) {
                    const float rn = post / sqrtf(dpp_sum16(ss) + RMS_EPS);
#pragma unroll
                    for (int i = 0; i < 8; ++i) y[i] *= rn;
                }
                v4u o; o.x = pk2(y[0], y[1]); o.y = pk2(y[2], y[3]); o.z = pk2(y[4], y[5]); o.w = pk2(y[6], y[7]);
                *(v4u*)(qkvc + (size_t)(t0 + tb + u) * 4096 + ch) = o;
            }
        }
#pragma unroll
        for (int k = 0; k < 4; ++k) { const int item = tid + 512 * k, tok = t0 + (item >> 4), hv = item & 15;
            const float bb = __uint_as_float((unsigned)raw[(size_t)tok * RAWLD + 4096 + hv] << 16), aa = __uint_as_float((unsigned)raw[(size_t)tok * RAWLD + 4112 + hv] << 16);
            const float xx = aa + a.gdn_dt_bias[j * 16 + hv];
            const float sp = xx > 20.f ? xx : log1pf(__expf(xx));
            gb[(size_t)tok * 32 + hv] = -__expf(a.gdn_a_log[j * 16 + hv]) * sp;
            gb[(size_t)tok * 32 + 16 + hv] = sigmoid_f(bb); }
    }
}

DI void phase_gdn_naive(const Args& a, int j, LAS unsigned char* lds, int bid, int tid) {
    if (bid >= BATCH * HV) return;
    const int b = bid / HV, hv = bid % HV, hk = hv / 2, jc = tid & 127, r = tid >> 7;
    const bf16* zb = (const bf16*)(a.ws + WS_ZB); bf16* qkvc = (bf16*)(a.ws + WS_QKVC); const float* gb = (const float*)(a.ws + WS_GB);
    LAS float* qs = (LAS float*)lds; LAS float* ks = qs + 2048; LAS float* vs = ks + 2048; LAS float* gs = vs + 2048; LAS float* bs = gs + 16;
    LAS f32x2* red = (LAS f32x2*)(lds + 32768); LAS float* redkq = (LAS float*)(lds + 32768 + 8192); LAS float* ob = (LAS float*)(lds + 49152);
    float S[32];
#pragma unroll
    for (int i = 0; i < 32; ++i) S[i] = 0.f;
    const int lrow = tid >> 5, lcol = (tid & 31) * 4;
    for (int blk = 0; blk < SEQ / 16; ++blk) {
        const size_t t0 = (size_t)b * SEQ + blk * 16;
        __syncthreads();
        { const bf16* rowp = qkvc + (t0 + lrow) * 4096;
          const v2u qv = *(const v2u*)(rowp + hk * 128 + lcol), kv = *(const v2u*)(rowp + 1024 + hk * 128 + lcol), vv = *(const v2u*)(rowp + 2048 + hv * 128 + lcol);
          *(LAS f32x4*)(qs + lrow * 128 + lcol) = (f32x4){bf_lo(qv.x), bf_hi(qv.x), bf_lo(qv.y), bf_hi(qv.y)};
          *(LAS f32x4*)(ks + lrow * 128 + lcol) = (f32x4){bf_lo(kv.x), bf_hi(kv.x), bf_lo(kv.y), bf_hi(kv.y)};
          *(LAS f32x4*)(vs + lrow * 128 + lcol) = (f32x4){bf_lo(vv.x), bf_hi(vv.x), bf_lo(vv.y), bf_hi(vv.y)};
          if (tid < 16) { gs[tid] = __expf(gb[(t0 + tid) * 32 + hv]); bs[tid] = gb[(t0 + tid) * 32 + 16 + hv]; } }
        __syncthreads();
#pragma unroll 1
        for (int tt = 0; tt < 16; ++tt) {
            float pk = 0.f, pq = 0.f, pkq = 0.f;
#pragma unroll
            for (int i4 = 0; i4 < 8; ++i4) { const f32x4 k4 = *(const LAS f32x4*)(ks + tt * 128 + 32 * r + 4 * i4), q4 = *(const LAS f32x4*)(qs + tt * 128 + 32 * r + 4 * i4);
#pragma unroll
                for (int c = 0; c < 4; ++c) { pk += k4[c] * S[4 * i4 + c]; pq += q4[c] * S[4 * i4 + c]; pkq += k4[c] * q4[c]; } }
            const int buf = tt & 1;
            red[(buf * 4 + r) * 128 + jc] = (f32x2){pk, pq}; if (jc == 0) redkq[buf * 4 + r] = pkq;
            __syncthreads();
            float kS = 0.f, qS = 0.f, kq = 0.f;
#pragma unroll
            for (int rr = 0; rr < 4; ++rr) { const f32x2 p = red[(buf * 4 + rr) * 128 + jc]; kS += p.x; qS += p.y; kq += redkq[buf * 4 + rr]; }
            const float eg = gs[tt], vn = bs[tt] * (vs[tt * 128 + jc] - eg * kS);
#pragma unroll
            for (int i4 = 0; i4 < 8; ++i4) { const f32x4 k4 = *(const LAS f32x4*)(ks + tt * 128 + 32 * r + 4 * i4);
#pragma unroll
                for (int c = 0; c < 4; ++c) S[4 * i4 + c] = eg * S[4 * i4 + c] + k4[c] * vn; }
            if (r == 0) ob[tt * 128 + jc] = eg * qS + kq * vn;
        }
        __syncthreads();
        {
            const f32x4 o4 = *(const LAS f32x4*)(ob + lrow * 128 + lcol);
            float ss = o4[0] * o4[0] + o4[1] * o4[1] + o4[2] * o4[2] + o4[3] * o4[3];
            ss += __shfl_xor(ss, 1); ss += __shfl_xor(ss, 2); ss += __shfl_xor(ss, 4); ss += __shfl_xor(ss, 8); ss += __shfl_xor(ss, 16);
            const float rinv = 1.0f / sqrtf(ss * (1.0f / 128.0f) + RMS_EPS);
            const v2u zv = *(const v2u*)(zb + (t0 + lrow) * 2048 + hv * 128 + lcol);
            const f32x4 nw = *(const f32x4*)(a.gdn_norm_w + j * 128 + lcol);
            const float z0 = bf_lo(zv.x), z1 = bf_hi(zv.x), z2 = bf_lo(zv.y), z3 = bf_hi(zv.y);
            v2u o; o.x = pk2(o4[0] * rinv * nw[0] * z0 * sigmoid_f(z0), o4[1] * rinv * nw[1] * z1 * sigmoid_f(z1));
            o.y = pk2(o4[2] * rinv * nw[2] * z2 * sigmoid_f(z2), o4[3] * rinv * nw[3] * z3 * sigmoid_f(z3));
            *(v2u*)(qkvc + (t0 + lrow) * 4096 + 2048 + hv * 128 + lcol) = o;
        }
    }
}

template <bool ROUTER>
DI void phase_ln(const Args& a, int lnidx, int j, LAS unsigned char* lds, int bid, int G, int tid, int wave, int lane) {
    const float* out = a.out; bf16* HB = (bf16*)(a.ws + WS_HB); float* stats = (float*)(a.ws + WS_STATS);
    const float* g = a.ln_g + (size_t)lnidx * D; const float* bta = a.ln_b + (size_t)lnidx * D;
    const int gw = bid * NWAVES + wave, NGW = G * NWAVES;
    LAS unsigned* lcnt = (LAS unsigned*)lds;
    if (ROUTER) { if (tid < 8) lcnt[tid] = 0u; __syncthreads(); }
    f32x4 gv[4], bv[4];
#pragma unroll
    for (int q = 0; q < 4; ++q) { gv[q] = *(const f32x4*)(g + 4 * (lane + 64 * q)); bv[q] = *(const f32x4*)(bta + 4 * (lane + 64 * q)); }
    f32x4 nx[4];
    if (gw < TT) {
#pragma unroll
        for (int q = 0; q < 4; ++q) nx[q] = ((const f32x4*)(out + (size_t)gw * D))[lane + 64 * q]; }
    for (int t = gw; t < TT; t += NGW) {
        f32x4 v[4]; float s = 0.f;
#pragma unroll
        for (int q = 0; q < 4; ++q) { v[q] = nx[q]; s += (v[q][0] + v[q][1]) + (v[q][2] + v[q][3]); }
        if (t + NGW < TT) {
#pragma unroll
            for (int q = 0; q < 4; ++q) nx[q] = ((const f32x4*)(out + (size_t)(t + NGW) * D))[lane + 64 * q]; }
        const float mean = wave_sum(s) * (1.0f / D); float s2 = 0.f;
#pragma unroll
        for (int q = 0; q < 4; ++q) { v[q] = v[q] - mean; s2 += (v[q][0] * v[q][0] + v[q][1] * v[q][1]) + (v[q][2] * v[q][2] + v[q][3] * v[q][3]); }
        const float rstd = 1.0f / sqrtf(wave_sum(s2) * (1.0f / D) + LN_EPS);
        if (lane == 0) *(f32x2*)(stats + 2 * (size_t)t) = (f32x2){mean, rstd};
#pragma unroll
        for (int q = 0; q < 4; ++q) { v[q] = v[q] * rstd * gv[q] + bv[q];
            v2u o; o.x = pk2(v[q][0], v[q][1]); o.y = pk2(v[q][2], v[q][3]); *(v2u*)(HB + (size_t)t * D + 4 * (lane + 64 * q)) = o; }
        if (ROUTER) {
            const float* R = a.moe_router + (size_t)j * D * NE;
            float lg[8];
#pragma unroll
            for (int e = 0; e < 8; ++e) lg[e] = 0.f;
#pragma unroll
            for (int q = 0; q < 4; ++q)
#pragma unroll
                for (int c = 0; c < 4; ++c) { const int k = 4 * (lane + 64 * q) + c; const f32x4 r0 = *(const f32x4*)(R + k * 8), r1 = *(const f32x4*)(R + k * 8 + 4); const float hv = v[q][c];
                    lg[0] += hv * r0[0]; lg[1] += hv * r0[1]; lg[2] += hv * r0[2]; lg[3] += hv * r0[3]; lg[4] += hv * r1[0]; lg[5] += hv * r1[1]; lg[6] += hv * r1[2]; lg[7] += hv * r1[3]; }
#pragma unroll
            for (int e = 0; e < 8; ++e) lg[e] = wave_sum(lg[e]);
            int i1 = 0; float v1 = lg[0];
#pragma unroll
            for (int e = 1; e < 8; ++e) if (lg[e] > v1) { v1 = lg[e]; i1 = e; }
            int i2 = -1; float v2 = -3.0e38f;
#pragma unroll
            for (int e = 0; e < 8; ++e) if (e != i1 && lg[e] > v2) { v2 = lg[e]; i2 = e; }
            if (lane == 0) {
                const float g1 = 1.0f / (1.0f + __expf(v2 - v1));
                ((unsigned*)(a.ws + WS_E12))[t] = (unsigned)i1 | ((unsigned)i2 << 8);
                ((f32x2*)(a.ws + WS_G12))[t] = (f32x2){g1, 1.0f - g1};
                __hip_atomic_fetch_add(lcnt + i1, 1u, __ATOMIC_RELAXED, __HIP_MEMORY_SCOPE_WORKGROUP); __hip_atomic_fetch_add(lcnt + i2, 1u, __ATOMIC_RELAXED, __HIP_MEMORY_SCOPE_WORKGROUP);
            }
        }
    }
    if (ROUTER) { __syncthreads(); if (tid < 8) { unsigned* cnt = (unsigned*)(a.ws + WS_CTL) + CW_CNT + 256 * j; __hip_atomic_fetch_add(cnt + tid, lcnt[tid], __ATOMIC_RELAXED, __HIP_MEMORY_SCOPE_AGENT); } }
}

DI void phase_sb_naive(const Args& a, LAS unsigned char* lds, int bid, int G, int tid) {
    const bf16* qkv = (const bf16*)(a.ws + WS_QKV); bf16* ao = (bf16*)(a.ws + WS_AO);
    LAS unsigned char* Ks = lds; LAS unsigned char* Vs = lds + 16384;
    const int qi = tid >> 2, r = tid & 3;
    for (int idx = bid; idx < 64 * 32; idx += G) {
        const int qb = 31 - idx / 64, bh = idx % 64, b = bh >> 3, h = bh & 7;
        const int t = qb * 128 + qi;
        const size_t rowq = (size_t)b * SEQ + t;
        float q[32], o[32];
        { const bf16* qp = qkv + rowq * 3072 + h * 128 + 32 * r;
#pragma unroll
          for (int c = 0; c < 4; ++c) { const v4u w = *(const v4u*)(qp + 8 * c);
              q[8 * c + 0] = bf_lo(w.x); q[8 * c + 1] = bf_hi(w.x); q[8 * c + 2] = bf_lo(w.y); q[8 * c + 3] = bf_hi(w.y);
              q[8 * c + 4] = bf_lo(w.z); q[8 * c + 5] = bf_hi(w.z); q[8 * c + 6] = bf_lo(w.w); q[8 * c + 7] = bf_hi(w.w); }
#pragma unroll
          for (int i = 0; i < 32; ++i) { q[i] *= 0.08838834764831845f; o[i] = 0.f; } }
        float P = 1.0f;
        for (int kt = 2 * qb + 1; kt >= 0; --kt) {
            __syncthreads();
#pragma unroll
            for (int i = 0; i < 2; ++i) { const int c = tid + 512 * i, row = c >> 4, part = c & 15;
                const bf16* src = qkv + ((size_t)b * SEQ + kt * 64 + row) * 3072 + h * 128 + part * 8;
                *(LAS v4u*)(Ks + c * 16) = *(const v4u*)(src + 1024); *(LAS v4u*)(Vs + c * 16) = *(const v4u*)(src + 2048); }
            __syncthreads();
#pragma unroll 1
            for (int s = 63; s >= 0; --s) {
                float z = 0.f;
#pragma unroll
                for (int c = 0; c < 4; ++c) { const v4u w = *(const LAS v4u*)(Ks + s * 256 + r * 64 + c * 16);
                    z += q[8 * c + 0] * bf_lo(w.x) + q[8 * c + 1] * bf_hi(w.x) + q[8 * c + 2] * bf_lo(w.y) + q[8 * c + 3] * bf_hi(w.y)
                       + q[8 * c + 4] * bf_lo(w.z) + q[8 * c + 5] * bf_hi(w.z) + q[8 * c + 6] * bf_lo(w.w) + q[8 * c + 7] * bf_hi(w.w); }
                z += __shfl_xor(z, 1); z += __shfl_xor(z, 2);
                const bool live = (kt * 64 + s) < t;
                const float e = __expf(fminf(z, 80.f)), rr = 1.0f / (1.0f + e);
                const float A = live ? e * rr * P : 0.f;
                P = live ? P * rr : P;
#pragma unroll
                for (int c = 0; c < 4; ++c) { const v4u w = *(const LAS v4u*)(Vs + s * 256 + r * 64 + c * 16);
                    o[8 * c + 0] += A * bf_lo(w.x); o[8 * c + 1] += A * bf_hi(w.x); o[8 * c + 2] += A * bf_lo(w.y); o[8 * c + 3] += A * bf_hi(w.y);
                    o[8 * c + 4] += A * bf_lo(w.z); o[8 * c + 5] += A * bf_hi(w.z); o[8 * c + 6] += A * bf_lo(w.w); o[8 * c + 7] += A * bf_hi(w.w); }
            }
        }
        { bf16* op = ao + rowq * 1024 + h * 128 + 32 * r;
#pragma unroll
          for (int c = 0; c < 4; ++c) { v4u w; w.x = pk2(o[8 * c + 0], o[8 * c + 1]); w.y = pk2(o[8 * c + 2], o[8 * c + 3]); w.z = pk2(o[8 * c + 4], o[8 * c + 5]); w.w = pk2(o[8 * c + 6], o[8 * c + 7]);
              *(v4u*)(op + 8 * c) = w; } }
    }
}


namespace sba {
using bf16x8 = __attribute__((ext_vector_type(8))) short;
using s16x4  = __attribute__((ext_vector_type(4))) short;
using f32x16 = __attribute__((ext_vector_type(16))) float;
constexpr int SHM_V = 16384, SHM_K = 16384, LDQ = 3072;
#define KSWZ(row, colB) ((row) * 256 + ((colB) ^ (((row) & 7) << 4)))
#define SBAR() __builtin_amdgcn_sched_barrier(0)
DI int crow(int r, int hi) { return (r & 3) + 8 * (r >> 2) + 4 * hi; }
DI int v_st(int k, int c) { const int kk = (k & ~0xC) | ((k & 4) << 1) | ((k & 8) >> 1); return ((kk >> 3) * 4 + (c >> 5)) * 512 + ((kk & 7) * 32 + (c & 31)) * 2; }
DI int v_rd_base(int lane) { return ((lane & 3) << 3) | (((lane >> 2) & 3) << 6) | (((lane >> 4) & 1) << 5) | (((lane >> 5) & 1) << 8); }
constexpr int v_rd_off(int d0, int ks, int half) { return d0 * 512 + ks * 4096 + half * 2048; }
template <int OFF> DI s16x4 tr_read(int vb) { s16x4 r; asm volatile("ds_read_b64_tr_b16 %0, %1 offset:%2" : "=&v"(r) : "v"(vb), "i"(OFF) : "memory"); return r; }
template <int D0> DI void pv_one(f32x16& od, int vb, bf16x8 pa0, bf16x8 pa1, bf16x8 pa2, bf16x8 pa3) {
  const s16x4 l0 = tr_read<v_rd_off(D0, 0, 0)>(vb), h0 = tr_read<v_rd_off(D0, 0, 1)>(vb), l1 = tr_read<v_rd_off(D0, 1, 0)>(vb), h1 = tr_read<v_rd_off(D0, 1, 1)>(vb);
  const s16x4 l2 = tr_read<v_rd_off(D0, 2, 0)>(vb), h2 = tr_read<v_rd_off(D0, 2, 1)>(vb), l3 = tr_read<v_rd_off(D0, 3, 0)>(vb), h3 = tr_read<v_rd_off(D0, 3, 1)>(vb);
  asm volatile("s_waitcnt lgkmcnt(0)" ::: "memory"); SBAR();
#define PK(L, H) (bf16x8){L[0], L[1], L[2], L[3], H[0], H[1], H[2], H[3]}
  od = __builtin_amdgcn_mfma_f32_32x32x16_bf16(pa0, PK(l0, h0), od, 0, 0, 0);
  od = __builtin_amdgcn_mfma_f32_32x32x16_bf16(pa1, PK(l1, h1), od, 0, 0, 0);
  od = __builtin_amdgcn_mfma_f32_32x32x16_bf16(pa2, PK(l2, h2), od, 0, 0, 0);
  od = __builtin_amdgcn_mfma_f32_32x32x16_bf16(pa3, PK(l3, h3), od, 0, 0, 0);
#undef PK
}
template <int D0> DI void pv_one_T(f32x16& od, int vb, bf16x8 pa0, bf16x8 pa1, bf16x8 pa2, bf16x8 pa3) {
  const s16x4 l0 = tr_read<v_rd_off(D0, 0, 0)>(vb), h0 = tr_read<v_rd_off(D0, 0, 1)>(vb), l1 = tr_read<v_rd_off(D0, 1, 0)>(vb), h1 = tr_read<v_rd_off(D0, 1, 1)>(vb);
  const s16x4 l2 = tr_read<v_rd_off(D0, 2, 0)>(vb), h2 = tr_read<v_rd_off(D0, 2, 1)>(vb), l3 = tr_read<v_rd_off(D0, 3, 0)>(vb), h3 = tr_read<v_rd_off(D0, 3, 1)>(vb);
  asm volatile("s_waitcnt lgkmcnt(0)" ::: "memory"); SBAR();
#define PK(L, H) (bf16x8){L[0], L[1], L[2], L[3], H[0], H[1], H[2], H[3]}
  od = __builtin_amdgcn_mfma_f32_32x32x16_bf16(PK(l0, h0), pa0, od, 0, 0, 0);
  od = __builtin_amdgcn_mfma_f32_32x32x16_bf16(PK(l1, h1), pa1, od, 0, 0, 0);
  od = __builtin_amdgcn_mfma_f32_32x32x16_bf16(PK(l2, h2), pa2, od, 0, 0, 0);
  od = __builtin_amdgcn_mfma_f32_32x32x16_bf16(PK(l3, h3), pa3, od, 0, 0, 0);
#undef PK
}
DI void pv_split(f32x16& od, int vb, bf16x8 pa0, bf16x8 pa1, bf16x8 pa2, bf16x8 pa3) {
  const s16x4 l0 = tr_read<v_rd_off(0, 0, 0)>(vb), h0 = tr_read<v_rd_off(0, 0, 1)>(vb), l1 = tr_read<v_rd_off(0, 1, 0)>(vb), h1 = tr_read<v_rd_off(0, 1, 1)>(vb);
  const s16x4 l2 = tr_read<v_rd_off(0, 2, 0)>(vb), h2 = tr_read<v_rd_off(0, 2, 1)>(vb), l3 = tr_read<v_rd_off(0, 3, 0)>(vb), h3 = tr_read<v_rd_off(0, 3, 1)>(vb);
  asm volatile("s_waitcnt lgkmcnt(0)" ::: "memory"); SBAR();
#define PK(L, H) (bf16x8){L[0], L[1], L[2], L[3], H[0], H[1], H[2], H[3]}
  f32x16 ob = {};
  od = __builtin_amdgcn_mfma_f32_32x32x16_bf16(pa0, PK(l0, h0), od, 0, 0, 0); ob = __builtin_amdgcn_mfma_f32_32x32x16_bf16(pa2, PK(l2, h2), ob, 0, 0, 0);
  od = __builtin_amdgcn_mfma_f32_32x32x16_bf16(pa1, PK(l1, h1), od, 0, 0, 0); ob = __builtin_amdgcn_mfma_f32_32x32x16_bf16(pa3, PK(l3, h3), ob, 0, 0, 0);
  od = od + ob;
#undef PK
}
DI void pv_split_T(f32x16& od, int vb, bf16x8 pa0, bf16x8 pa1, bf16x8 pa2, bf16x8 pa3) {
  const s16x4 l0 = tr_read<v_rd_off(0, 0, 0)>(vb), h0 = tr_read<v_rd_off(0, 0, 1)>(vb), l1 = tr_read<v_rd_off(0, 1, 0)>(vb), h1 = tr_read<v_rd_off(0, 1, 1)>(vb);
  const s16x4 l2 = tr_read<v_rd_off(0, 2, 0)>(vb), h2 = tr_read<v_rd_off(0, 2, 1)>(vb), l3 = tr_read<v_rd_off(0, 3, 0)>(vb), h3 = tr_read<v_rd_off(0, 3, 1)>(vb);
  asm volatile("s_waitcnt lgkmcnt(0)" ::: "memory"); SBAR();
#define PK(L, H) (bf16x8){L[0], L[1], L[2], L[3], H[0], H[1], H[2], H[3]}
  f32x16 ob = {};
  od = __builtin_amdgcn_mfma_f32_32x32x16_bf16(PK(l0, h0), pa0, od, 0, 0, 0); ob = __builtin_amdgcn_mfma_f32_32x32x16_bf16(PK(l2, h2), pa2, ob, 0, 0, 0);
  od = __builtin_amdgcn_mfma_f32_32x32x16_bf16(PK(l1, h1), pa1, od, 0, 0, 0); ob = __builtin_amdgcn_mfma_f32_32x32x16_bf16(PK(l3, h3), pa3, ob, 0, 0, 0);
  od = od + ob;
#undef PK
}
DI void qkt(f32x16& p0, f32x16& p1, const LAS unsigned char* Ks, const bf16x8 (&qr)[8], int r32, int hi) {
  p0 = f32x16{}; p1 = f32x16{};
#pragma unroll
  for (int d0 = 0; d0 < 8; ++d0) { const int cb = (d0 * 16 + hi * 8) * 2;
    const bf16x8 b0 = *(const LAS bf16x8*)(Ks + KSWZ(r32, cb));
    const bf16x8 b1 = *(const LAS bf16x8*)(Ks + KSWZ(32 + r32, cb));
    p0 = __builtin_amdgcn_mfma_f32_32x32x16_bf16(b0, qr[d0], p0, 0, 0, 0);
    p1 = __builtin_amdgcn_mfma_f32_32x32x16_bf16(b1, qr[d0], p1, 0, 0, 0); }
}
template <bool MASK> DI void sb_half(f32x16& p, float& Pc, int hi, int kbase, int trow) {
  constexpr float C = 0.08838834764831845f * 1.4426950408889634f;
  float rr[16];
#pragma unroll
  for (int r = 0; r < 16; ++r) {
    float z = p[r] * C;
    if (MASK) z = (kbase + crow(r, hi) < trow) ? z : -__builtin_inff();
    const float k = __builtin_amdgcn_rcpf(1.0f + __builtin_amdgcn_exp2f(z));
    rr[r] = k; p[r] = 1.0f - k;
  }
  float R0[4], R1[4];
#pragma unroll
  for (int g = 0; g < 4; ++g) {
    const float c2 = rr[4 * g + 3], c1 = c2 * rr[4 * g + 2], c0 = c1 * rr[4 * g + 1], R = c0 * rr[4 * g];
    rr[4 * g + 2] = c2; rr[4 * g + 1] = c1; rr[4 * g] = c0;
    const auto sw = __builtin_amdgcn_permlane32_swap(__float_as_uint(R), __float_as_uint(R), false, false);
    R0[g] = __uint_as_float(sw[0]); R1[g] = __uint_as_float(sw[1]);
  }
#pragma unroll
  for (int g = 3; g >= 0; --g) {
    const float Pin = hi ? Pc : Pc * R1[g];
    p[4 * g + 3] *= Pin; p[4 * g + 2] *= Pin * rr[4 * g + 2]; p[4 * g + 1] *= Pin * rr[4 * g + 1]; p[4 * g] *= Pin * rr[4 * g];
    Pc *= R0[g] * R1[g];
  }
}
DI unsigned cvtpk(float lo, float hi) { unsigned r; asm volatile("v_cvt_pk_bf16_f32 %0, %1, %2" : "=v"(r) : "v"(lo), "v"(hi)); return r; }
#define PK4(P, BASE, OUT) do { const unsigned a0 = cvtpk(P[BASE + 0], P[BASE + 1]), a1 = cvtpk(P[BASE + 2], P[BASE + 3]);   \
    const unsigned b0 = cvtpk(P[BASE + 4], P[BASE + 5]), b1 = cvtpk(P[BASE + 6], P[BASE + 7]);                              \
    const auto r0 = __builtin_amdgcn_permlane32_swap(a0, b0, false, false); const auto r1 = __builtin_amdgcn_permlane32_swap(a1, b1, false, false); \
    const v4u w = {r0[0], r1[0], r0[1], r1[1]}; OUT = __builtin_bit_cast(bf16x8, w); } while (0)

DI void unit(const bf16* qkv, bf16* ao, int b, int h, int qb, LAS unsigned char* lds, int tid) {
  const int wid = __builtin_amdgcn_readfirstlane(tid >> 6), lane = tid & 63, r32 = lane & 31, hi = lane >> 5;
  LAS unsigned char* V_lds = lds; LAS unsigned char* K_lds = lds + 2 * SHM_V;
  const size_t rowbase = (size_t)b * SEQ; const int q0 = qb * 256, t_lo = q0 + wid * 32, trow = t_lo + r32;
  bf16x8 qr[8];
  { const bf16* Qw = qkv + (rowbase + trow) * LDQ + h * 128 + hi * 8;
#pragma unroll
    for (int d0 = 0; d0 < 8; ++d0) qr[d0] = *(const bf16x8*)(Qw + d0 * 16); }
  const bf16* Kh = qkv + rowbase * LDQ + 1024 + h * 128; const bf16* Vh = Kh + 1024;
  const int sr = tid >> 4, sc = (tid & 15) * 8, vst0 = v_st(sr, sc), vst1 = v_st(32 + sr, sc);
  const int vb0 = (int)(unsigned)(size_t)V_lds + v_rd_base(lane);
  bf16x8 vs0, vs1, ks0, ks1;
#define SLOAD(k0) do { vs0 = *(const bf16x8*)(Vh + (size_t)((k0) + sr) * LDQ + sc); vs1 = *(const bf16x8*)(Vh + (size_t)((k0) + 32 + sr) * LDQ + sc); \
    ks0 = *(const bf16x8*)(Kh + (size_t)((k0) + sr) * LDQ + sc); ks1 = *(const bf16x8*)(Kh + (size_t)((k0) + 32 + sr) * LDQ + sc); } while (0)
#define SWRITE(bb) do { *(LAS bf16x8*)(V_lds + (bb) * SHM_V + vst0) = vs0; *(LAS bf16x8*)(V_lds + (bb) * SHM_V + vst1) = vs1; const int kc = sc * 2; \
    *(LAS bf16x8*)(K_lds + (bb) * SHM_K + KSWZ(sr, kc)) = ks0; *(LAS bf16x8*)(K_lds + (bb) * SHM_K + KSWZ(32 + sr, kc)) = ks1; } while (0)
  f32x16 o[4] = {}; float Pc = 1.0f;
  const int kt_max = qb * 4 + 3;
  SLOAD(kt_max * 64);
  for (int kt = kt_max; kt >= 0; --kt) {
    const int buf = kt & 1, k0 = kt * 64;
    asm volatile("s_waitcnt vmcnt(0)" ::: "memory");
    SWRITE(buf);
    if (kt > 0) SLOAD(k0 - 64);
    __syncthreads();
    if (k0 < t_lo + 31) {
      f32x16 p0, p1;
      qkt(p0, p1, K_lds + buf * SHM_K, qr, r32, hi);
      if (k0 + 63 >= t_lo) { sb_half<true>(p1, Pc, hi, k0 + 32, trow); sb_half<true>(p0, Pc, hi, k0, trow); }
      else { sb_half<false>(p1, Pc, hi, k0 + 32, trow); sb_half<false>(p0, Pc, hi, k0, trow); }
      bf16x8 pa0, pa1, pa2, pa3;
      PK4(p0, 0, pa0); PK4(p0, 8, pa1); PK4(p1, 0, pa2); PK4(p1, 8, pa3);
      const int vb = vb0 + buf * SHM_V;
      pv_one<0>(o[0], vb, pa0, pa1, pa2, pa3); pv_one<1>(o[1], vb, pa0, pa1, pa2, pa3); pv_one<2>(o[2], vb, pa0, pa1, pa2, pa3); pv_one<3>(o[3], vb, pa0, pa1, pa2, pa3);
    }
  }
  bf16* Ow = ao + (rowbase + t_lo) * 1024 + h * 128 + r32;
#pragma unroll
  for (int r = 0; r < 16; ++r) { const int orow = crow(r, hi);
#pragma unroll
    for (int d0 = 0; d0 < 4; ++d0) Ow[(size_t)orow * 1024 + d0 * 32] = (bf16)(cvtpk(o[d0][r], 0.f) & 0xffffu); }
#undef SLOAD
#undef SWRITE
}
#undef PK4
#undef KSWZ
#undef SBAR
}
DI void phase_sb_mfma(const Args& a, LAS unsigned char* lds, int bid, int G, int tid) {
    const bf16* qkv = (const bf16*)(a.ws + WS_QKV); bf16* ao = (bf16*)(a.ws + WS_AO);
    const int vcu = (G % 8 == 0) ? (bid % 8) * (G / 8) + bid / 8 : bid;
    for (int pi = vcu; pi < 512; pi += G) {
        const int bh = pi >> 3, p = pi & 7, b = bh >> 3, h = bh & 7;
        sba::unit(qkv, ao, b, h, 15 - p, lds, tid);
        sba::unit(qkv, ao, b, h, p, lds, tid);
    }
}


namespace gdn {
using bf16x8 = __attribute__((ext_vector_type(8))) short;
using s16x4  = __attribute__((ext_vector_type(4))) short;
using f32x16 = __attribute__((ext_vector_type(16))) float;
typedef float f2v __attribute__((ext_vector_type(2)));
typedef __bf16 b2v __attribute__((ext_vector_type(2)));
DI unsigned pk(float a, float b) { const f2v v = {a, b}; const b2v r = __builtin_convertvector(v, b2v); return __builtin_bit_cast(unsigned, r); }
DI int crow(int r, int hi) { return (r & 3) + 8 * (r >> 2) + 4 * hi; }
DI int pi_slot(int x) { return 8 * ((x >> 2) & 3) + 4 * ((x >> 4) & 1) + (x & 3); }
DI bf16x8 pack_step(const f32x16& x, int s) {
    v4u w; w.x = pk(x[8 * s + 0], x[8 * s + 1]); w.y = pk(x[8 * s + 2], x[8 * s + 3]); w.z = pk(x[8 * s + 4], x[8 * s + 5]); w.w = pk(x[8 * s + 6], x[8 * s + 7]);
    return __builtin_bit_cast(bf16x8, w);
}
DI f32x16 mm(const f32x16& P, const f32x16& Q, f32x16 acc) {
    acc = __builtin_amdgcn_mfma_f32_32x32x16_bf16(pack_step(P, 0), pack_step(Q, 0), acc, 0, 0, 0);
    acc = __builtin_amdgcn_mfma_f32_32x32x16_bf16(pack_step(P, 1), pack_step(Q, 1), acc, 0, 0, 0);
    return acc;
}
#define GPK4(P, BASE, OUT) do { const unsigned a0 = pk(P[BASE + 0], P[BASE + 1]), a1 = pk(P[BASE + 2], P[BASE + 3]);   \
    const unsigned b0 = pk(P[BASE + 4], P[BASE + 5]), b1 = pk(P[BASE + 6], P[BASE + 7]);                              \
    const auto r0 = __builtin_amdgcn_permlane32_swap(a0, b0, false, false); const auto r1 = __builtin_amdgcn_permlane32_swap(a1, b1, false, false); \
    const v4u w_ = {r0[0], r1[0], r0[1], r1[1]}; OUT = __builtin_bit_cast(bf16x8, w_); } while (0)

DI void local_unit(const Args& a, int unit, LAS unsigned char* img, LAS float* tab, int lane, bool dry) {
    const int r32 = lane & 31, hi = lane >> 5;
    const int chunk = unit & 63, bh = unit >> 6, hv = bh & 15, b = bh >> 4, hk = hv >> 1;
    const size_t t0 = (size_t)b * SEQ + chunk * 64;
    bf16* qkvc = (bf16*)(a.ws + WS_QKVC); const float* gb = (const float*)(a.ws + WS_GB);
    bf16* wmem = (bf16*)(a.ws + WS_WMEM) + (size_t)unit * 8192; bf16* imem = (bf16*)(a.ws + WS_IMEM) + (size_t)unit * 4096;
    bf16* ktmem = (bf16*)(a.ws + WS_KTMEM) + (size_t)((b * HK + hk) * 64 + chunk) * 8192; float* gtab = (float*)(a.ws + WS_GTAB) + (size_t)unit * 192;
    SEC_IN(1);
    float gc = gb[(t0 + lane) * 32 + hv]; const float be = gb[(t0 + lane) * 32 + 16 + hv];
#pragma unroll
    for (int off = 1; off < 64; off <<= 1) { const float y = __shfl_up(gc, off); if (lane >= off) gc += y; }
    const float glast = __shfl(gc, 63);
    tab[lane] = gc; tab[64 + lane] = be; tab[128 + lane] = -be * __expf(gc);
    gtab[lane] = __expf(gc); gtab[64 + lane] = __expf(glast - gc); if (lane == 0) gtab[128] = __expf(glast);
    const bf16* kbase = qkvc + t0 * 4096 + 1024 + hk * 128; const bf16* qbase = qkvc + t0 * 4096 + hk * 128; bf16* vbase = qkvc + t0 * 4096 + 2048 + hv * 128;
#define GSB() __builtin_amdgcn_sched_barrier(0)
    {
        f32x16 IT00 = {}, IT11 = {}, IT01 = {};
#pragma unroll
        for (int s = 0; s < 8; ++s) {
            const bf16x8 k0 = *(const bf16x8*)(kbase + (size_t)r32 * 4096 + 16 * s + 8 * hi), k1 = *(const bf16x8*)(kbase + (size_t)(32 + r32) * 4096 + 16 * s + 8 * hi);
            const bf16x8 q0 = *(const bf16x8*)(qbase + (size_t)r32 * 4096 + 16 * s + 8 * hi), q1 = *(const bf16x8*)(qbase + (size_t)(32 + r32) * 4096 + 16 * s + 8 * hi);
            IT00 = __builtin_amdgcn_mfma_f32_32x32x16_bf16(k0, q0, IT00, 0, 0, 0); IT11 = __builtin_amdgcn_mfma_f32_32x32x16_bf16(k1, q1, IT11, 0, 0, 0);
            IT01 = __builtin_amdgcn_mfma_f32_32x32x16_bf16(k0, q1, IT01, 0, 0, 0);
        }
#pragma unroll
        for (int I = 0; I < 2; ++I) { const int c = 32 * I + r32; const float gcc = tab[c];
#pragma unroll
            for (int J = 0; J < 2; ++J)
#pragma unroll
                for (int g = 0; g < 4; ++g) { float v[4];
#pragma unroll
                    for (int i = 0; i < 4; ++i) { const int r = 4 * g + i, cp = 32 * J + crow(r, hi);
                        const float raw = (I == 0) ? (J == 0 ? IT00[r] : 0.f) : (J == 0 ? IT01[r] : IT11[r]);
                        const float val = raw * __expf(-fabsf(gcc - tab[cp])); v[i] = (c >= cp) ? val : 0.f; }
                    v2u o; o.x = pk(v[0], v[1]); o.y = pk(v[2], v[3]);
                    *(v2u*)(imem + (unsigned)((((I * 2 + J) * 4 + g) * 64 + lane) * 4)) = o; } }
    }
    GSB();
    SEC_OUT(1); SEC_IN(2);
    f32x16 T1, T1T, T2T, T21T;
    {
        f32x16 KK = {};
#pragma unroll
        for (int s = 0; s < 8; ++s) { const bf16x8 k0 = *(const bf16x8*)(kbase + (size_t)r32 * 4096 + 16 * s + 8 * hi); KK = __builtin_amdgcn_mfma_f32_32x32x16_bf16(k0, k0, KK, 0, 0, 0); }
        f32x16 M, MT;
        { const float gb0 = tab[r32], bb0 = tab[64 + r32];
#pragma unroll
        for (int r = 0; r < 16; ++r) { const int a0 = crow(r, hi), b0 = r32; const float ke = -KK[r] * __expf(-fabsf(tab[a0] - gb0));
            const float nv = ke * tab[64 + a0], ntv = ke * bb0;
            const float n = (a0 > b0) ? nv : 0.f, nt = (b0 > a0) ? ntv : 0.f, id = (a0 == b0) ? 1.f : 0.f;
            M[r] = n; MT[r] = nt; T1[r] = id + n; T1T[r] = id + nt; } }
#pragma unroll
        for (int it = 0; it < 4; ++it) { const f32x16 z = {};
            const f32x16 Mn = mm(MT, M, z), MTn = mm(M, MT, z);
            const f32x16 Tn = mm(T1T, Mn, T1);
            T1T = mm(Mn, T1T, T1T);
            T1 = Tn; M = Mn; MT = MTn; }
    }
    GSB();
    {
        f32x16 KK = {};
#pragma unroll
        for (int s = 0; s < 8; ++s) { const bf16x8 k1 = *(const bf16x8*)(kbase + (size_t)(32 + r32) * 4096 + 16 * s + 8 * hi); KK = __builtin_amdgcn_mfma_f32_32x32x16_bf16(k1, k1, KK, 0, 0, 0); }
        f32x16 M, MT;
        { const float gb0 = tab[32 + r32], bb0 = tab[96 + r32];
#pragma unroll
        for (int r = 0; r < 16; ++r) { const int a0 = crow(r, hi), b0 = r32; const float ke = -KK[r] * __expf(-fabsf(tab[32 + a0] - gb0));
            const float nv = ke * tab[96 + a0], ntv = ke * bb0;
            const float n = (a0 > b0) ? nv : 0.f, nt = (b0 > a0) ? ntv : 0.f, id = (a0 == b0) ? 1.f : 0.f;
            M[r] = n; MT[r] = nt; T2T[r] = id + nt; } }
#pragma unroll
        for (int it = 0; it < 4; ++it) { const f32x16 z = {};
            const f32x16 Mn = mm(MT, M, z), MTn = mm(M, MT, z);
            T2T = mm(Mn, T2T, T2T);
            M = Mn; MT = MTn; }
    }
    GSB();
    {
        f32x16 L21 = {};
#pragma unroll
        for (int s = 0; s < 8; ++s) { const bf16x8 k0 = *(const bf16x8*)(kbase + (size_t)r32 * 4096 + 16 * s + 8 * hi), k1 = *(const bf16x8*)(kbase + (size_t)(32 + r32) * 4096 + 16 * s + 8 * hi);
            L21 = __builtin_amdgcn_mfma_f32_32x32x16_bf16(k1, k0, L21, 0, 0, 0); }
#pragma unroll
        for (int r = 0; r < 16; ++r) { const int a0 = crow(r, hi); L21[r] = L21[r] * tab[96 + a0] * __expf(tab[32 + a0] - tab[r32]); }
        const f32x16 z = {}; const f32x16 Y = mm(L21, T2T, z); T21T = mm(T1, Y, z);
#pragma unroll
        for (int r = 0; r < 16; ++r) T21T[r] = -T21T[r];
    }
    GSB();
    SEC_OUT(2); SEC_IN(3);
    const int vb = (int)(unsigned)(size_t)img + sba::v_rd_base(lane);
    bf16* ubl = dry ? (bf16*)(a.ws + WS_END) + (size_t)(unit & 63) * 64 * 4096 : vbase;
#pragma unroll 1
    for (int mode = 0; mode < 2; ++mode) {
        const bf16* src = mode == 0 ? (const bf16*)vbase : kbase;
#pragma unroll 4
        for (int it = 0; it < 16; ++it) { const int row = (lane >> 4) + 4 * it, col = (lane & 15) * 8;
            *(LAS v4u*)(img + sba::v_st(row, col)) = *(const v4u*)(src + (size_t)row * 4096 + col); }
        LAS float* sc = tab + (mode == 0 ? 64 : 128);
#pragma unroll 1
        for (int I = 0; I < 2; ++I) {
            bf16x8 pa0, pa1, pa2, pa3;
            { f32x16 X;
#pragma unroll
              for (int r = 0; r < 16; ++r) X[r] = (I ? T21T[r] : T1T[r]) * sc[crow(r, hi)];
              GPK4(X, 0, pa0); GPK4(X, 8, pa1);
              { const float on = I ? 1.0f : 0.0f;
#pragma unroll
              for (int r = 0; r < 16; ++r) X[r] = T2T[r] * (sc[32 + crow(r, hi)] * on); }
              GPK4(X, 0, pa2); GPK4(X, 8, pa3); }
#pragma unroll 1
            for (int d0 = 0; d0 < 4; ++d0) {
                f32x16 od = {};
                if (mode == 0) { sba::pv_split(od, vb + d0 * 512, pa0, pa1, pa2, pa3);
                    const unsigned e0 = (unsigned)(((I * 32 + 8 * d0 + (lane >> 5)) * 4096) + (lane & 31) * 4);
#pragma unroll
                    for (int g = 0; g < 4; ++g) { v2u w; w.x = pk(od[4 * g + 0], od[4 * g + 1]); w.y = pk(od[4 * g + 2], od[4 * g + 3]); *(v2u*)(ubl + e0 + (unsigned)(g * 8192)) = w; }
                } else { sba::pv_split_T(od, vb + d0 * 512, pa0, pa1, pa2, pa3);
                    bf16* wp = wmem + (unsigned)((((I * 4 + d0) * 4) * 64 + lane) * 4);
#pragma unroll
                    for (int g = 0; g < 4; ++g) { v2u w; w.x = pk(od[4 * g + 0], od[4 * g + 1]); w.y = pk(od[4 * g + 2], od[4 * g + 3]); *(v2u*)(wp + g * 256) = w; }
                }
                GSB();
            }
        }
        if (mode == 1) {
            const int Ik = hv & 1;
            v4u idw0, idw1;
            { const int d0_ = r32 - 8 * hi, d1_ = r32 - 16 - 8 * hi;
              idw0.x = (d0_ == 0 ? 0x3f80u : 0u) | (d0_ == 1 ? 0x3f800000u : 0u); idw0.y = (d0_ == 2 ? 0x3f80u : 0u) | (d0_ == 3 ? 0x3f800000u : 0u);
              idw0.z = (d0_ == 4 ? 0x3f80u : 0u) | (d0_ == 5 ? 0x3f800000u : 0u); idw0.w = (d0_ == 6 ? 0x3f80u : 0u) | (d0_ == 7 ? 0x3f800000u : 0u);
              idw1.x = (d1_ == 0 ? 0x3f80u : 0u) | (d1_ == 1 ? 0x3f800000u : 0u); idw1.y = (d1_ == 2 ? 0x3f80u : 0u) | (d1_ == 3 ? 0x3f800000u : 0u);
              idw1.z = (d1_ == 4 ? 0x3f80u : 0u) | (d1_ == 5 ? 0x3f800000u : 0u); idw1.w = (d1_ == 6 ? 0x3f80u : 0u) | (d1_ == 7 ? 0x3f800000u : 0u); }
            const bf16x8 id0 = __builtin_bit_cast(bf16x8, idw0), id1 = __builtin_bit_cast(bf16x8, idw1), zf = (bf16x8){};
            const bf16x8 pa0 = Ik ? zf : id0, pa1 = Ik ? zf : id1, pa2 = Ik ? id0 : zf, pa3 = Ik ? id1 : zf;
#pragma unroll 1
            for (int d0 = 0; d0 < 4; ++d0) {
                f32x16 od = {}; sba::pv_split(od, vb + d0 * 512, pa0, pa1, pa2, pa3);
                bf16* kp = ktmem + (unsigned)((((Ik * 4 + d0) * 4) * 64 + lane) * 4);
#pragma unroll
                for (int g = 0; g < 4; ++g) { v2u w; w.x = pk(od[4 * g + 0], od[4 * g + 1]); w.y = pk(od[4 * g + 2], od[4 * g + 3]); *(v2u*)(kp + g * 256) = w; }
                GSB();
            }
        }
    }
    SEC_OUT(3);
#undef GSB
}
#undef GPK4
}
DI void phase_gdn_local(const Args& a, LAS unsigned char* lds, int bid, int G, int wave, int lane, bool dry) {
    LAS unsigned char* img = lds + wave * 16384; LAS float* tab = (LAS float*)(lds + RING_BYTES + 4096 + wave * 1024);
    const int gw = bid * NWAVES + wave, NGW = G * NWAVES;
    for (int unit = gw; unit < BATCH * HV * 64; unit += NGW) gdn::local_unit(a, unit, img, tab, lane, dry);
}
namespace gdn {
constexpr int PW = 272, PI = 144;
constexpr int L_W = 0, L_Q = 64 * PW, L_I = 2 * 64 * PW, L_K = L_I + 64 * PI, L_G = L_K + 128 * PI, L_BUF = L_G + 768;
constexpr int L_PART = 2 * L_BUF;
static_assert(L_PART + 4096 <= RING_BYTES, "scan LDS map");
}
DI void phase_gdn_scan(const Args& a, int j, LAS unsigned char* lds, int bid, int tid, bool dry) {
    if (bid >= BATCH * HV) return;
    using gdn::bf16x8; using gdn::pk; using namespace gdn;
    typedef float f4v __attribute__((ext_vector_type(4)));
    const int wave = __builtin_amdgcn_readfirstlane(tid >> 6), lane = tid & 63, n = lane & 15, kq = lane >> 4;
    const int b = bid / HV, hv = bid % HV, hk = hv >> 1;
    bf16* qkvc = (bf16*)(a.ws + WS_QKVC); const bf16* zb = (const bf16*)(a.ws + WS_ZB);
    LAS float* part = (LAS float*)(lds + L_PART); LAS unsigned char* stg = lds + OGST_OFF;
    const int unit0 = (b * HV + hv) * 64, hku0 = (b * HK + hk) * 64; const size_t tb0 = (size_t)b * SEQ;
    if (wave >= 4) {
        const int st = tid - 256;
        v4u rw[4], rq[4], ri[2], rk[4], rz[4]; float rg = 0.f;
#define SV_RUN2(dst, base, o0) do { const v2u a_ = *(const v2u*)((base) + (o0)), b_ = *(const v2u*)((base) + (o0) + 2 * 64 * 4); dst = (v4u){a_.x, a_.y, b_.x, b_.y}; } while (0)
#define SV_LOAD(ch) do { const int u_ = unit0 + (ch); const size_t t_ = tb0 + (size_t)(ch) * 64; \
        const bf16* wm_ = (const bf16*)(a.ws + WS_WMEM) + (size_t)u_ * 8192; const bf16* im_ = (const bf16*)(a.ws + WS_IMEM) + (size_t)u_ * 4096; \
        const bf16* kt_ = (const bf16*)(a.ws + WS_KTMEM) + (size_t)(hku0 + (ch)) * 8192; const bf16* qb_ = qkvc + t_ * 4096 + hk * 128; const bf16* zr_ = zb + t_ * 2048 + hv * 128; \
        _Pragma("unroll") for (int k = 0; k < 4; ++k) { const int c = st + 256 * k; \
            { const int row = c & 63, p = c >> 6, pp = p & 3; SV_RUN2(rw[k], wm_, (((((row >> 5) * 4 + (p >> 2)) * 4 + (pp >> 1)) * 64 + (pp & 1) * 32 + (row & 31)) * 4)); }     \
            { const int dk = c & 127, p = c >> 7, pp = p & 3; SV_RUN2(rk[k], kt_, (((((p >> 2) * 4 + (dk >> 5)) * 4 + (pp >> 1)) * 64 + (pp & 1) * 32 + (dk & 31)) * 4)); }         \
            rq[k] = *(const v4u*)(qb_ + (size_t)(c >> 4) * 4096 + (c & 15) * 8); rz[k] = *(const v4u*)(zr_ + (size_t)(c >> 4) * 2048 + (c & 15) * 8); } \
        _Pragma("unroll") for (int k = 0; k < 2; ++k) { const int c = st + 256 * k; const int row = c & 63, p = c >> 6, pp = p & 3; \
            SV_RUN2(ri[k], im_, (((((row >> 5) * 2 + (p >> 2)) * 4 + (pp >> 1)) * 64 + (pp & 1) * 32 + (row & 31)) * 4)); } \
        if (st < 192) rg = ((const float*)(a.ws + WS_GTAB))[(size_t)u_ * 192 + st]; } while (0)
#define SV_WRITE(bf) do { LAS unsigned char* B_ = lds + (bf) * L_BUF; \
        _Pragma("unroll") for (int k = 0; k < 4; ++k) { const int c = st + 256 * k; *(LAS v4u*)(B_ + L_W + (c & 63) * PW + (c >> 6) * 16) = rw[k]; \
            *(LAS v4u*)(B_ + L_Q + (c >> 4) * PW + (c & 15) * 16) = rq[k]; *(LAS v4u*)(B_ + L_K + (c & 127) * PI + (c >> 7) * 16) = rk[k]; } \
        _Pragma("unroll") for (int k = 0; k < 2; ++k) { const int c = st + 256 * k; *(LAS v4u*)(B_ + L_I + (c & 63) * PI + (c >> 6) * 16) = ri[k]; } \
        if (st < 192) *(LAS float*)(B_ + L_G + st * 4) = rg; } while (0)
        f32x4 nwa, nwb;
        { const float* nwp = a.gdn_norm_w + j * 128 + (st & 15) * 8; nwa = *(const f32x4*)nwp; nwb = *(const f32x4*)(nwp + 4); }
        volatile LAS unsigned* flag = (volatile LAS unsigned*)(lds + L_PART);
        SV_LOAD(0); SV_WRITE(0);
        v4u zc[4], zn[4];
#pragma unroll
        for (int k = 0; k < 4; ++k) zc[k] = rz[k];
        __syncthreads();
        SV_LOAD(1);
#pragma unroll 1
        for (int chunk = 0; chunk < 64; ++chunk) {
            if (chunk + 1 < 64) { SV_WRITE((chunk + 1) & 1);
#pragma unroll
                for (int k = 0; k < 4; ++k) zn[k] = rz[k]; }
            __syncthreads();
            v4u ov[4];
#pragma unroll
            for (int k = 0; k < 4; ++k) { const int c = st + 256 * k; ov[k] = *(const LAS v4u*)(stg + (c >> 4) * 256 + (c & 15) * 16); }
            asm volatile("s_waitcnt lgkmcnt(0)" ::: "memory");
            if (lane == 0) __hip_atomic_fetch_add((LAS unsigned*)(lds + L_PART), 1u, __ATOMIC_RELAXED, __HIP_MEMORY_SCOPE_WORKGROUP);
            if (chunk + 2 < 64) SV_LOAD(chunk + 2);
            __builtin_amdgcn_sched_barrier(0);
            bf16* ob = dry ? (bf16*)(a.ws + WS_END) + (size_t)bid * 64 * 128 : qkvc + (tb0 + (size_t)chunk * 64) * 4096 + 2048 + hv * 128; const int opitch = dry ? 128 : 4096;
#pragma unroll
            for (int k = 0; k < 4; ++k) { const int c = st + 256 * k;
                float o8[8]; o8[0] = bf_lo(ov[k].x); o8[1] = bf_hi(ov[k].x); o8[2] = bf_lo(ov[k].y); o8[3] = bf_hi(ov[k].y); o8[4] = bf_lo(ov[k].z); o8[5] = bf_hi(ov[k].z); o8[6] = bf_lo(ov[k].w); o8[7] = bf_hi(ov[k].w);
                float ss = 0.f;
#pragma unroll
                for (int e = 0; e < 8; ++e) ss += o8[e] * o8[e];
                const float rinv = __builtin_amdgcn_rsqf(dpp_sum16(ss) * (1.0f / 128.0f) + RMS_EPS);
                float z8[8]; z8[0] = bf_lo(zc[k].x); z8[1] = bf_hi(zc[k].x); z8[2] = bf_lo(zc[k].y); z8[3] = bf_hi(zc[k].y); z8[4] = bf_lo(zc[k].z); z8[5] = bf_hi(zc[k].z); z8[6] = bf_lo(zc[k].w); z8[7] = bf_hi(zc[k].w);
                float r8[8];
#pragma unroll
                for (int e = 0; e < 8; ++e) { const float sg = z8[e] * __builtin_amdgcn_rcpf(1.0f + __builtin_amdgcn_exp2f(-1.4426950408889634f * z8[e])); r8[e] = o8[e] * rinv * (e < 4 ? nwa[e] : nwb[e - 4]) * sg; }
                v4u w; w.x = pk(r8[0], r8[1]); w.y = pk(r8[2], r8[3]); w.z = pk(r8[4], r8[5]); w.w = pk(r8[6], r8[7]);
                *(v4u*)(ob + (size_t)(c >> 4) * opitch + (c & 15) * 8) = w; }
#pragma unroll
            for (int k = 0; k < 4; ++k) zc[k] = zn[k];
        }
#undef SV_RUN2
#undef SV_LOAD
#undef SV_WRITE
        return;
    }
    f4v S[2][8];
#pragma unroll
    for (int g = 0; g < 2; ++g)
#pragma unroll
        for (int m = 0; m < 8; ++m) S[g][m] = (f4v){0.f, 0.f, 0.f, 0.f};
    v2u un[2][4];
#define CW_ULOAD(ch) do { const bf16* vb_ = qkvc + (tb0 + (size_t)(ch) * 64) * 4096 + 2048 + hv * 128; \
        _Pragma("unroll") for (int g = 0; g < 2; ++g) _Pragma("unroll") for (int mt = 0; mt < 4; ++mt) { \
            const int f = (((((mt >> 1) * 4 + wave) * 4 + 2 * (mt & 1) + (kq >> 1)) * 64) + (kq & 1) * 32 + 16 * g + n) * 4;     \
            un[g][mt] = *(const v2u*)(vb_ + (size_t)(f >> 7) * 4096 + (f & 127)); } } while (0)
    CW_ULOAD(0);
    if (tid == 0) *(volatile LAS unsigned*)(lds + L_PART) = 0u;
    __syncthreads();
#pragma unroll 1
    for (int chunk = 0; chunk < 64; ++chunk) {
        const LAS unsigned char* B = lds + (chunk & 1) * L_BUF; const LAS float* gt = (const LAS float*)(B + L_G);
        f4v av[2][4], ao[2][4];
#pragma unroll
        for (int g = 0; g < 2; ++g)
#pragma unroll
            for (int mt = 0; mt < 4; ++mt) { const v2u u0 = un[g][mt]; av[g][mt] = (f4v){bf_lo(u0.x), bf_hi(u0.x), bf_lo(u0.y), bf_hi(u0.y)}; }
        if (chunk + 1 < 64) CW_ULOAD(chunk + 1);
        bf16x8 Sb[2][4];
#pragma unroll
        for (int g = 0; g < 2; ++g)
#pragma unroll
            for (int p = 0; p < 4; ++p) { v4u w; w.x = pk(S[g][2 * p][0], S[g][2 * p][1]); w.y = pk(S[g][2 * p][2], S[g][2 * p][3]); w.z = pk(S[g][2 * p + 1][0], S[g][2 * p + 1][1]); w.w = pk(S[g][2 * p + 1][2], S[g][2 * p + 1][3]);
                Sb[g][p] = __builtin_bit_cast(bf16x8, w); }
#pragma unroll
        for (int mt = 0; mt < 4; ++mt) { ao[0][mt] = (f4v){0.f, 0.f, 0.f, 0.f}; ao[1][mt] = (f4v){0.f, 0.f, 0.f, 0.f};
#pragma unroll
            for (int p = 0; p < 4; ++p) {
                const bf16x8 aw = *(const LAS bf16x8*)(B + L_W + (16 * mt + n) * PW + 64 * p + 16 * kq);
                const v2u q0 = *(const LAS v2u*)(B + L_Q + (16 * mt + n) * PW + 64 * p + 8 * kq), q1 = *(const LAS v2u*)(B + L_Q + (16 * mt + n) * PW + 64 * p + 32 + 8 * kq);
                const v4u qq = {q0.x, q0.y, q1.x, q1.y}; const bf16x8 aq = __builtin_bit_cast(bf16x8, qq);
                av[0][mt] = __builtin_amdgcn_mfma_f32_16x16x32_bf16(aw, Sb[0][p], av[0][mt], 0, 0, 0); av[1][mt] = __builtin_amdgcn_mfma_f32_16x16x32_bf16(aw, Sb[1][p], av[1][mt], 0, 0, 0);
                ao[0][mt] = __builtin_amdgcn_mfma_f32_16x16x32_bf16(aq, Sb[0][p], ao[0][mt], 0, 0, 0); ao[1][mt] = __builtin_amdgcn_mfma_f32_16x16x32_bf16(aq, Sb[1][p], ao[1][mt], 0, 0, 0); } }
        bf16x8 vbf[2][2], vbd[2][2];
#pragma unroll
        for (int pp = 0; pp < 2; ++pp) {
            const f4v d0 = *(const LAS f4v*)(gt + 64 + 32 * pp + 4 * kq), d1 = *(const LAS f4v*)(gt + 64 + 32 * pp + 16 + 4 * kq);
#pragma unroll
            for (int g = 0; g < 2; ++g) { const f4v x0 = av[g][2 * pp], x1 = av[g][2 * pp + 1];
                v4u w; w.x = pk(x0[0], x0[1]); w.y = pk(x0[2], x0[3]); w.z = pk(x1[0], x1[1]); w.w = pk(x1[2], x1[3]); vbf[g][pp] = __builtin_bit_cast(bf16x8, w);
                v4u y; y.x = pk(x0[0] * d0[0], x0[1] * d0[1]); y.y = pk(x0[2] * d0[2], x0[3] * d0[3]); y.z = pk(x1[0] * d1[0], x1[1] * d1[1]); y.w = pk(x1[2] * d1[2], x1[3] * d1[3]); vbd[g][pp] = __builtin_bit_cast(bf16x8, y); }
        }
#pragma unroll
        for (int mt = 0; mt < 4; ++mt) { const f4v eg = *(const LAS f4v*)(gt + 16 * mt + 4 * kq); ao[0][mt] = ao[0][mt] * eg; ao[1][mt] = ao[1][mt] * eg;
#pragma unroll
            for (int pp = 0; pp < 2; ++pp) { const bf16x8 ai = *(const LAS bf16x8*)(B + L_I + (16 * mt + n) * PI + 64 * pp + 16 * kq);
                ao[0][mt] = __builtin_amdgcn_mfma_f32_16x16x32_bf16(ai, vbf[0][pp], ao[0][mt], 0, 0, 0); ao[1][mt] = __builtin_amdgcn_mfma_f32_16x16x32_bf16(ai, vbf[1][pp], ao[1][mt], 0, 0, 0); } }
        { const float egl = gt[128];
#pragma unroll
          for (int m8 = 0; m8 < 8; ++m8) { S[0][m8] = S[0][m8] * egl; S[1][m8] = S[1][m8] * egl;
#pragma unroll
              for (int pp = 0; pp < 2; ++pp) { const bf16x8 ak = *(const LAS bf16x8*)(B + L_K + (16 * m8 + n) * PI + 64 * pp + 16 * kq);
                  S[0][m8] = __builtin_amdgcn_mfma_f32_16x16x32_bf16(ak, vbd[0][pp], S[0][m8], 0, 0, 0); S[1][m8] = __builtin_amdgcn_mfma_f32_16x16x32_bf16(ak, vbd[1][pp], S[1][m8], 0, 0, 0); } } }
        { unsigned spins = 0; while (*(volatile LAS unsigned*)(lds + L_PART) < 4u * (unsigned)chunk) { __builtin_amdgcn_s_sleep(1); if (++spins > (1u << 22)) break; } }
#pragma unroll
        for (int g = 0; g < 2; ++g)
#pragma unroll
            for (int mt = 0; mt < 4; ++mt)
#pragma unroll
                for (int i = 0; i < 4; ++i) *(LAS bf16*)(stg + (16 * mt + 4 * kq + i) * 256 + (32 * wave + 16 * g + n) * 2) = (bf16)(pk(ao[g][mt][i], 0.f) & 0xffffu);
        __syncthreads();
    }
#undef CW_ULOAD
}

DI void moe_offsets(const Args& a, int j, unsigned (&off)[9]) {
    unsigned* cnt = (unsigned*)(a.ws + WS_CTL) + CW_CNT + 256 * j; unsigned acc = 0u;
#pragma unroll
    for (int e = 0; e < 8; ++e) { off[e] = acc; const unsigned c = __hip_atomic_load(cnt + e, __ATOMIC_RELAXED, __HIP_MEMORY_SCOPE_AGENT); acc += (c + 255u) & ~255u; }
    off[8] = acc;
}
DI void phase_scatter(const Args& a, int j, LAS unsigned char* lds, int bid, int G, int tid, int wave, int lane) {
    LAS unsigned* lc = (LAS unsigned*)lds; LAS unsigned* lb = lc + 8; LAS unsigned* loff = lc + 16; LAS int* lpos = (LAS int*)(lc + 32);
    const unsigned* E12 = (const unsigned*)(a.ws + WS_E12); int* POS = (int*)(a.ws + WS_POS);
    const bf16* HB = (const bf16*)(a.ws + WS_HB); bf16* XS = (bf16*)(a.ws + WS_XS);
    unsigned* fill = (unsigned*)(a.ws + WS_CTL) + CW_CNT + 256 * j + 64;
    unsigned off[9]; moe_offsets(a, j, off);
    if (tid == 0) {
#pragma unroll
        for (int e = 0; e < 8; ++e) loff[e] = off[e]; }
    for (int ci = bid; ci < TT / 128; ci += G) {
        __syncthreads();
        if (tid < 8) lc[tid] = 0u;
        __syncthreads();
        unsigned e1 = 0, e2 = 0, r1 = 0, r2 = 0;
        if (tid < 128) { const unsigned w = E12[ci * 128 + tid]; e1 = w & 255u; e2 = (w >> 8) & 255u;
            r1 = __hip_atomic_fetch_add(lc + e1, 1u, __ATOMIC_RELAXED, __HIP_MEMORY_SCOPE_WORKGROUP); r2 = __hip_atomic_fetch_add(lc + e2, 1u, __ATOMIC_RELAXED, __HIP_MEMORY_SCOPE_WORKGROUP); }
        __syncthreads();
        if (tid < 8) lb[tid] = __hip_atomic_fetch_add(fill + tid, lc[tid], __ATOMIC_RELAXED, __HIP_MEMORY_SCOPE_AGENT);
        __syncthreads();
        if (tid < 128) { const int p1 = (int)(loff[e1] + lb[e1] + r1), p2 = (int)(loff[e2] + lb[e2] + r2);
            lpos[2 * tid] = p1; lpos[2 * tid + 1] = p2; POS[2 * (ci * 128 + tid)] = p1; POS[2 * (ci * 128 + tid) + 1] = p2; }
        __syncthreads();
        for (int tk = wave; tk < 128; tk += NWAVES) {
            const int p1 = lpos[2 * tk], p2 = lpos[2 * tk + 1];
            const v4u* src = (const v4u*)(HB + (size_t)(ci * 128 + tk) * D);
            const v4u x0 = src[lane], x1 = src[lane + 64];
            v4u* d1 = (v4u*)(XS + (size_t)p1 * D); v4u* d2 = (v4u*)(XS + (size_t)p2 * D);
            d1[lane] = x0; d1[lane + 64] = x1; d2[lane] = x0; d2[lane + 64] = x1;
        }
    }
}

template <bool FINAL>
DI void phase_combine_ln(const Args& a, int lnprev, int lnidx, int bid, int G, int wave, int lane) {
    float* out = a.out; bf16* HB = (bf16*)(a.ws + WS_HB); const bf16* YE = (const bf16*)(a.ws + WS_XS); float* stats = (float*)(a.ws + WS_STATS);
    const int* POS = (const int*)(a.ws + WS_POS); const f32x2* G12 = (const f32x2*)(a.ws + WS_G12);
    const float* g = a.ln_g + (size_t)lnidx * D; const float* bta = a.ln_b + (size_t)lnidx * D;
    const float* gp = a.ln_g + (size_t)lnprev * D; const float* bp = a.ln_b + (size_t)lnprev * D;
    const int gw = bid * NWAVES + wave, NGW = G * NWAVES;
    f32x4 gv[4], bv[4], gq[4], bq[4];
#pragma unroll
    for (int q = 0; q < 4; ++q) { gv[q] = *(const f32x4*)(g + 4 * (lane + 64 * q)); bv[q] = *(const f32x4*)(bta + 4 * (lane + 64 * q));
        gq[q] = *(const f32x4*)(gp + 4 * (lane + 64 * q)) * ALPHA; bq[q] = *(const f32x4*)(bp + 4 * (lane + 64 * q)) * ALPHA; }
    for (int t = gw; t < TT; t += NGW) {
        f32x4* row = (f32x4*)(out + (size_t)t * D);
        const int p1 = POS[2 * t], p2 = POS[2 * t + 1]; const f32x2 gg = G12[t]; const f32x2 st = *(const f32x2*)(stats + 2 * (size_t)t);
        const v2u* y1 = (const v2u*)(YE + (size_t)p1 * D); const v2u* y2 = (const v2u*)(YE + (size_t)p2 * D);
        f32x4 v[4]; float s = 0.f;
#pragma unroll
        for (int q = 0; q < 4; ++q) { const v2u a1 = y1[lane + 64 * q], a2 = y2[lane + 64 * q];
            const f32x4 e1 = (f32x4){bf_lo(a1.x), bf_hi(a1.x), bf_lo(a1.y), bf_hi(a1.y)}, e2 = (f32x4){bf_lo(a2.x), bf_hi(a2.x), bf_lo(a2.y), bf_hi(a2.y)};
            v[q] = (row[lane + 64 * q] - st.x) * st.y * gq[q] + bq[q] + e1 * gg.x + e2 * gg.y; s += (v[q][0] + v[q][1]) + (v[q][2] + v[q][3]); }
        const float mean = wave_sum(s) * (1.0f / D); float s2 = 0.f;
#pragma unroll
        for (int q = 0; q < 4; ++q) { const f32x4 d = v[q] - mean; s2 += (d[0] * d[0] + d[1] * d[1]) + (d[2] * d[2] + d[3] * d[3]); }
        const float rstd = 1.0f / sqrtf(wave_sum(s2) * (1.0f / D) + LN_EPS);
        if (lane == 0) *(f32x2*)(stats + 2 * (size_t)t) = (f32x2){mean, rstd};
#pragma unroll
        for (int q = 0; q < 4; ++q) { const f32x4 hn = (v[q] - mean) * rstd * gv[q] + bv[q]; row[lane + 64 * q] = FINAL ? hn : v[q];
            v2u o; o.x = pk2(hn[0], hn[1]); o.y = pk2(hn[2], hn[3]); *(v2u*)(HB + (size_t)t * D + 4 * (lane + 64 * q)) = o; }
    }
}

constexpr int ARGS_OFF = RING_BYTES + 1024;
DI unsigned long long lds_u64(LAS unsigned char* p) { const v2u w = *(const volatile LAS v2u*)p; return ((unsigned long long)(unsigned)__builtin_amdgcn_readfirstlane((int)w.y) << 32) | (unsigned)__builtin_amdgcn_readfirstlane((int)w.x); }
DI Args load_args(LAS unsigned char* lds) {
    Args a; LAS unsigned char* p = lds + ARGS_OFF;
    a.x = (const float*)(const GAS float*)lds_u64(p + 0); a.gdn_w_in = (const float*)(const GAS float*)lds_u64(p + 8); a.gdn_conv_w = (const float*)(const GAS float*)lds_u64(p + 16); a.gdn_a_log = (const float*)(const GAS float*)lds_u64(p + 24);
    a.gdn_dt_bias = (const float*)(const GAS float*)lds_u64(p + 32); a.gdn_norm_w = (const float*)(const GAS float*)lds_u64(p + 40); a.gdn_w_out = (const float*)(const GAS float*)lds_u64(p + 48); a.sb_w_in = (const float*)(const GAS float*)lds_u64(p + 56);
    a.sb_w_out = (const float*)(const GAS float*)lds_u64(p + 64); a.ffn_w_gate = (const float*)(const GAS float*)lds_u64(p + 72); a.ffn_w_up = (const float*)(const GAS float*)lds_u64(p + 80); a.ffn_w_down = (const float*)(const GAS float*)lds_u64(p + 88);
    a.moe_router = (const float*)(const GAS float*)lds_u64(p + 96); a.moe_w_gate = (const float*)(const GAS float*)lds_u64(p + 104); a.moe_w_up = (const float*)(const GAS float*)lds_u64(p + 112); a.moe_w_down = (const float*)(const GAS float*)lds_u64(p + 120);
    a.ln_g = (const float*)(const GAS float*)lds_u64(p + 128); a.ln_b = (const float*)(const GAS float*)lds_u64(p + 136); a.out = (float*)(GAS float*)lds_u64(p + 144); a.ws = (unsigned char*)(GAS unsigned char*)lds_u64(p + 152);
    const v2u w = *(const volatile LAS v2u*)(p + 160); a.ph_lo = __builtin_amdgcn_readfirstlane((int)w.x); a.ph_hi = __builtin_amdgcn_readfirstlane((int)w.y);
    return a;
}
#ifdef PH_ONLY
#define IN(k) (((k) % NPH) == PH_ONLY && lo <= (k) && (k) < hi)
#else
#define IN(k) (lo <= (k) && (k) < hi)
#endif
#define SEAM(k) do { if ((k) + 1 < hi) xcd_barrier(bar); } while (0)
DI int fresh_lane() { int l; asm volatile("v_mbcnt_lo_u32_b32 %0, -1, 0\n\tv_mbcnt_hi_u32_b32 %0, -1, %0" : "=v"(l)); return l; }
#define ARGS() const Args args = load_args(lds); const int lo = args.ph_lo, hi = args.ph_hi; const int lane = fresh_lane(), tid = wave * 64 + lane
#ifndef PROBE_REP_MASK
#define PROBE_REP_MASK 0
#endif
#ifndef PROBE_DELAY_MASK
#define PROBE_DELAY_MASK 0
#endif
#define PROBE_DELAY_MULT 4u
#define TICK_IN(k) do { if (((PROBE_DELAY_MASK) >> (k)) & 1) { if (bid == 0 && tid == 0) ((volatile LAS unsigned*)(lds + MISC_OFF))[20] -= (unsigned)__builtin_amdgcn_s_memrealtime(); } } while (0)
#define TICK_OUT(k) do { if (((PROBE_DELAY_MASK) >> (k)) & 1) { if (bid == 0 && tid == 0) ((volatile LAS unsigned*)(lds + MISC_OFF))[20] += (unsigned)__builtin_amdgcn_s_memrealtime(); } } while (0)
#define NREP(k) ((((PROBE_REP_MASK) >> (k)) & 1) ? 2 : 1)
template <int j>
DI void layer_pair(LAS unsigned char* lds, const XcdBarrier& bar, const int wave, const int G, const int bid) {
    constexpr int pb = j * NPH;
    { ARGS(); if (IN(pb + 0)) { TICK_IN(0); _Pragma("unroll 1") for (int rep_ = 0; rep_ < NREP(0); ++rep_) { phase_w_gdn(args, j, lds, bid, G, tid, wave, lane); } SEAM(pb + 0); TICK_OUT(0); } }
    { ARGS(); if (IN(pb + 1)) { TICK_IN(1); {
        pg8::Gemm g{(const bf16*)(args.ws + WS_HB), (const bf16*)(args.ws + W_IN), D, D}; pg8::StaticOrder S; S.init(TT, GINP, G, bid, NREP(1));
        pg8::EpiInProj E{(bf16*)(args.ws + WS_RAW), (bf16*)(args.ws + WS_ZB)};
        pg8::gemm_phase<pg8::EpiInProj, pg8::StaticOrder, true, true>(lds, g, S, E);
        } SEAM(pb + 1); TICK_OUT(1); } }
    { ARGS(); if (IN(pb + 2)) { TICK_IN(2); _Pragma("unroll 1") for (int rep_ = 0; rep_ < NREP(2); ++rep_) { phase_conv(args, j, bid, G, tid); } SEAM(pb + 2); TICK_OUT(2); } }
#if GDN_NAIVE
    { ARGS(); if (IN(pb + 4)) { TICK_IN(4); _Pragma("unroll 1") for (int rep_ = 0; rep_ < NREP(4); ++rep_) { phase_gdn_naive(args, j, lds, bid, tid); } SEAM(pb + 4); TICK_OUT(4); } }
#else
    { ARGS(); if (IN(pb + 3)) { TICK_IN(3); _Pragma("unroll 1") for (int rep_ = 0; rep_ < NREP(3); ++rep_) { phase_gdn_local(args, lds, bid, G, wave, lane, rep_ + 1 < NREP(3)); } SEAM(pb + 3); TICK_OUT(3); } }
    { ARGS(); if (IN(pb + 4)) { TICK_IN(4); _Pragma("unroll 1") for (int rep_ = 0; rep_ < NREP(4); ++rep_) { if (bid >= BATCH * HV && G > BATCH * HV) phase_w_sb(args, j, lds, bid - BATCH * HV, G - BATCH * HV, wave, lane); else if (G <= BATCH * HV && rep_ == 0) phase_w_sb(args, j, lds, bid, G, wave, lane);
        phase_gdn_scan(args, j, lds, bid, tid, rep_ + 1 < NREP(4)); } SEAM(pb + 4); TICK_OUT(4); } }
#endif
    { ARGS(); if (IN(pb + 5)) { TICK_IN(5); {
        pg8::Gemm g{(const bf16*)(args.ws + WS_QKVC) + 2048, (const bf16*)(args.ws + W_OUT), 4096, 2048}; pg8::StaticOrder S; S.init(TT, D, G, bid);
        pg8::EpiResid<(j > 0)> E{j == 0 ? args.x : args.out, args.out, (const float*)(args.ws + WS_STATS), args.ln_g + (size_t)(4 * (j > 0 ? j - 1 : 0) + 3) * D, args.ln_b + (size_t)(4 * (j > 0 ? j - 1 : 0) + 3) * D};
        pg8::gemm_phase<pg8::EpiResid<(j > 0)>, pg8::StaticOrder, true, true>(lds, g, S, E);
        } SEAM(pb + 5); TICK_OUT(5); } }
    { ARGS(); if (IN(pb + 6)) { TICK_IN(6); _Pragma("unroll 1") for (int rep_ = 0; rep_ < NREP(6); ++rep_) { phase_ln<false>(args, (2 * j) * 2 + 0, j, lds, bid, G, tid, wave, lane); } SEAM(pb + 6); TICK_OUT(6); } }
    { ARGS(); if (IN(pb + 7)) { TICK_IN(7); {
        pg8::Gemm g{(const bf16*)(args.ws + WS_HB), (const bf16*)(args.ws + W_GU), D, D}; pg8::StaticOrder S; S.init(TT, 2 * FF, G, bid, NREP(7));
        pg8::EpiSwiGLU E{(bf16*)(args.ws + WS_ACT), FF, 0};
        pg8::gemm_phase<pg8::EpiSwiGLU, pg8::StaticOrder, true, true>(lds, g, S, E);
        } SEAM(pb + 7); TICK_OUT(7); } }
    { ARGS(); if (IN(pb + 8)) { TICK_IN(8); {
        pg8::Gemm g{(const bf16*)(args.ws + WS_ACT), (const bf16*)(args.ws + W_D), FF, FF}; pg8::StaticOrder S; S.init(TT, D, G, bid);
        pg8::EpiResid<true> E{args.out, args.out, (const float*)(args.ws + WS_STATS), args.ln_g + (size_t)(4 * j + 0) * D, args.ln_b + (size_t)(4 * j + 0) * D};
        pg8::gemm_phase<pg8::EpiResid<true>, pg8::StaticOrder, true, true>(lds, g, S, E);
        } SEAM(pb + 8); TICK_OUT(8); } }
    { ARGS(); if (IN(pb + 9)) { TICK_IN(9); _Pragma("unroll 1") for (int rep_ = 0; rep_ < NREP(9); ++rep_) { phase_ln<false>(args, (2 * j) * 2 + 1, j, lds, bid, G, tid, wave, lane); } SEAM(pb + 9); TICK_OUT(9); } }
    { ARGS(); if (IN(pb + 10)) { TICK_IN(10); {
        pg8::Gemm g{(const bf16*)(args.ws + WS_HB), (const bf16*)(args.ws + W_QKV), D, D}; pg8::StaticOrder S; S.init(TT, 3072, G, bid, NREP(10));
        pg8::EpiBf16 E{(bf16*)(args.ws + WS_QKV), 3072, 0};
        pg8::gemm_phase<pg8::EpiBf16, pg8::StaticOrder, true, true>(lds, g, S, E);
        } SEAM(pb + 10); TICK_OUT(10); } }
    #if SB_NAIVE
    { ARGS(); if (IN(pb + 11)) { TICK_IN(11); _Pragma("unroll 1") for (int rep_ = 0; rep_ < NREP(11); ++rep_) { phase_sb_naive(args, lds, bid, G, tid); } SEAM(pb + 11); TICK_OUT(11); } }
#else
    { ARGS(); if (IN(pb + 11)) { TICK_IN(11); _Pragma("unroll 1") for (int rep_ = 0; rep_ < NREP(11); ++rep_) { phase_sb_mfma(args, lds, bid, G, tid); } SEAM(pb + 11); TICK_OUT(11); } }
#endif
    { ARGS(); if (IN(pb + 12)) { TICK_IN(12); {
        pg8::Gemm g{(const bf16*)(args.ws + WS_AO), (const bf16*)(args.ws + W_O), D, D}; pg8::StaticOrder S; S.init(TT, D, G, bid);
        pg8::EpiResid<true> E{args.out, args.out, (const float*)(args.ws + WS_STATS), args.ln_g + (size_t)(4 * j + 1) * D, args.ln_b + (size_t)(4 * j + 1) * D};
        pg8::gemm_phase<pg8::EpiResid<true>, pg8::StaticOrder, true, true>(lds, g, S, E);
        } SEAM(pb + 12); TICK_OUT(12); } }
    { ARGS(); if (IN(pb + 13)) { TICK_IN(13); _Pragma("unroll 1") for (int rep_ = 0; rep_ < NREP(13); ++rep_) { phase_ln<true>(args, (2 * j + 1) * 2 + 0, j, lds, bid, G, tid, wave, lane); } SEAM(pb + 13); TICK_OUT(13); } }
    { ARGS(); if (IN(pb + 14)) { TICK_IN(14); _Pragma("unroll 1") for (int rep_ = 0; rep_ < NREP(14); ++rep_) { phase_scatter(args, j, lds, bid, G, tid, wave, lane); } SEAM(pb + 14); TICK_OUT(14); } }
    { ARGS(); if (IN(pb + 15)) { TICK_IN(15); {
        unsigned off[9]; moe_offsets(args, j, off);
        pg8::MoeOrder S; S.nM = (int)(off[8] >> 8); S.G = G; S.c = bid; S.nN = 2 * FF / 256; S.nwg = S.nM * S.nN; S.rep = NREP(15);
        S.ps1 = (int)(off[1] >> 8); S.ps2 = (int)(off[2] >> 8); S.ps3 = (int)(off[3] >> 8); S.ps4 = (int)(off[4] >> 8); S.ps5 = (int)(off[5] >> 8); S.ps6 = (int)(off[6] >> 8); S.ps7 = (int)(off[7] >> 8);
        pg8::Gemm g{(const bf16*)(args.ws + WS_XS), (const bf16*)(args.ws + W_MGU), D, D};
        pg8::EpiSwiGLU E{(bf16*)(args.ws + WS_MACT), FF, 2 * FF / 256};
        pg8::gemm_phase<pg8::EpiSwiGLU, pg8::MoeOrder, true, true>(lds, g, S, E);
        } SEAM(pb + 15); TICK_OUT(15); } }
    { ARGS(); if (IN(pb + 16)) { TICK_IN(16); {
        unsigned off[9]; moe_offsets(args, j, off);
        pg8::MoeOrder S; S.nM = (int)(off[8] >> 8); S.G = G; S.c = bid; S.nN = D / 256; S.nwg = S.nM * S.nN; S.rep = NREP(16);
        S.ps1 = (int)(off[1] >> 8); S.ps2 = (int)(off[2] >> 8); S.ps3 = (int)(off[3] >> 8); S.ps4 = (int)(off[4] >> 8); S.ps5 = (int)(off[5] >> 8); S.ps6 = (int)(off[6] >> 8); S.ps7 = (int)(off[7] >> 8);
        pg8::Gemm g{(const bf16*)(args.ws + WS_MACT), (const bf16*)(args.ws + W_MD), FF, FF};
        pg8::EpiBf16 E{(bf16*)(args.ws + WS_XS), D, D / 256};
        pg8::gemm_phase<pg8::EpiBf16, pg8::MoeOrder, true, true>(lds, g, S, E);
        } SEAM(pb + 16); TICK_OUT(16); } }
    { ARGS(); if (IN(pb + 17)) { TICK_IN(17); _Pragma("unroll 1") for (int rep_ = 0; rep_ < NREP(17); ++rep_) { phase_combine_ln<(j == 1)>(args, 4 * j + 2, 4 * j + 3, bid, G, wave, lane); } SEAM(pb + 17); TICK_OUT(17); } }
}
__global__ void __launch_bounds__(NWAVES * 64, 2) fwd(Args kargs) {
    extern __shared__ __attribute__((aligned(16))) unsigned char lds_raw[];
    LAS unsigned char* lds = (LAS unsigned char*)lds_raw;
    volatile LAS unsigned* MISC = (volatile LAS unsigned*)(lds + MISC_OFF);
    const int tid = threadIdx.x, lane = tid & 63, wave = __builtin_amdgcn_readfirstlane(tid >> 6), G = gridDim.x, bid = blockIdx.x;
    for (int u = tid; u < (LDS_BYTES - RING_BYTES) / 4; u += NWAVES * 64) ((LAS unsigned*)(lds + RING_BYTES))[u] = 0u;
    __syncthreads();
    if (tid == 0) { LAS unsigned long long* pa = (LAS unsigned long long*)(lds + ARGS_OFF);
        pa[0] = (unsigned long long)kargs.x; pa[1] = (unsigned long long)kargs.gdn_w_in; pa[2] = (unsigned long long)kargs.gdn_conv_w; pa[3] = (unsigned long long)kargs.gdn_a_log;
        pa[4] = (unsigned long long)kargs.gdn_dt_bias; pa[5] = (unsigned long long)kargs.gdn_norm_w; pa[6] = (unsigned long long)kargs.gdn_w_out; pa[7] = (unsigned long long)kargs.sb_w_in;
        pa[8] = (unsigned long long)kargs.sb_w_out; pa[9] = (unsigned long long)kargs.ffn_w_gate; pa[10] = (unsigned long long)kargs.ffn_w_up; pa[11] = (unsigned long long)kargs.ffn_w_down;
        pa[12] = (unsigned long long)kargs.moe_router; pa[13] = (unsigned long long)kargs.moe_w_gate; pa[14] = (unsigned long long)kargs.moe_w_up; pa[15] = (unsigned long long)kargs.moe_w_down;
        pa[16] = (unsigned long long)kargs.ln_g; pa[17] = (unsigned long long)kargs.ln_b; pa[18] = (unsigned long long)kargs.out; pa[19] = (unsigned long long)kargs.ws;
        pa[20] = (unsigned long long)(unsigned)kargs.ph_lo | ((unsigned long long)(unsigned)kargs.ph_hi << 32); }
    XcdBarrier bar = xcd_barrier_post((unsigned*)(kargs.ws + WS_CTL) + CW_BAR, MISC + 8);
    __syncthreads();
    layer_pair<0>(lds, bar, wave, G, bid);
    layer_pair<1>(lds, bar, wave, G, bid);
    if (PROBE_DELAY_MASK || PROBE_SEC) { if (bid == 0 && threadIdx.x == 0) { const unsigned acc = ((volatile LAS unsigned*)(lds + MISC_OFF))[20] * PROBE_DELAY_MULT; const unsigned long long t0 = __builtin_amdgcn_s_memrealtime(); while ((unsigned)(__builtin_amdgcn_s_memrealtime() - t0) < acc) __builtin_amdgcn_s_sleep(8); } }
}
#undef IN
#undef SEAM
#undef ARGS

extern "C" void kernel_launch(void* const* d_in, const int* in_sizes, int n_in, void* d_out, int out_size, void* d_ws, size_t ws_size, hipStream_t stream) {
    static int grid = 0;
    if (grid == 0) {
        if (n_in != 18 || in_sizes[0] != TT * D || out_size != TT * D || ws_size < WS_END) { fprintf(stderr, "kernel_launch: unexpected shapes (n_in %d, in0 %d, out %d, ws %zu); nothing launched\n", n_in, n_in > 0 ? in_sizes[0] : -1, out_size, ws_size); grid = -1; return; }
        int dev = 0, cus = 0, per_cu = 0;
        if (hipGetDevice(&dev) != hipSuccess || hipDeviceGetAttribute(&cus, hipDeviceAttributeMultiprocessorCount, dev) != hipSuccess) { grid = -1; return; }
        if (hipFuncSetAttribute((const void*)fwd, hipFuncAttributeMaxDynamicSharedMemorySize, LDS_BYTES) != hipSuccess) { fprintf(stderr, "kernel_launch: hipFuncSetAttribute failed\n"); grid = -1; return; }
        if (hipOccupancyMaxActiveBlocksPerMultiprocessor(&per_cu, (const void*)fwd, NWAVES * 64, LDS_BYTES) != hipSuccess || per_cu < 1) { fprintf(stderr, "kernel_launch: occupancy query says %d blocks per CU\n", per_cu); (void)hipGetLastError(); grid = -1; return; }
        grid = cus;
    }
    if (grid < 0) return;
    if (hipMemsetAsync((char*)d_ws + WS_CTL, 0, CTL_ZERO_BYTES, stream) != hipSuccess) return;
    Args a{};
    a.x = (const float*)d_in[0]; a.gdn_w_in = (const float*)d_in[1]; a.gdn_conv_w = (const float*)d_in[2]; a.gdn_a_log = (const float*)d_in[3]; a.gdn_dt_bias = (const float*)d_in[4];
    a.gdn_norm_w = (const float*)d_in[5]; a.gdn_w_out = (const float*)d_in[6]; a.sb_w_in = (const float*)d_in[7]; a.sb_w_out = (const float*)d_in[8];
    a.ffn_w_gate = (const float*)d_in[9]; a.ffn_w_up = (const float*)d_in[10]; a.ffn_w_down = (const float*)d_in[11]; a.moe_router = (const float*)d_in[12];
    a.moe_w_gate = (const float*)d_in[13]; a.moe_w_up = (const float*)d_in[14]; a.moe_w_down = (const float*)d_in[15]; a.ln_g = (const float*)d_in[16]; a.ln_b = (const float*)d_in[17];
    a.out = (float*)d_out; a.ws = (unsigned char*)d_ws;
#if MK_ONE_LAUNCH
    a.ph_lo = 0; a.ph_hi = NPHASES;
    hipLaunchKernelGGL(fwd, dim3(grid), dim3(NWAVES * 64), LDS_BYTES, stream, a);
#else
    for (int p = 0; p < NPHASES; ++p) { a.ph_lo = p; a.ph_hi = p + 1; hipLaunchKernelGGL(fwd, dim3(grid), dim3(NWAVES * 64), LDS_BYTES, stream, a); }
#endif
}
```

```cpp
#include <hip/hip_runtime.h>
#include <cstdio>
#include <cstdint>
#ifndef GDN_NAIVE
#define GDN_NAIVE 0
#endif
#ifndef SB_NAIVE
#define SB_NAIVE 0
#endif
#ifndef MK_ONE_LAUNCH
#define MK_ONE_LAUNCH 1
#endif
namespace pg8 {
#define PG8_LAS __attribute__((address_space(3)))
typedef unsigned short bf16_t;
typedef short bf16x8 __attribute__((ext_vector_type(8)));
typedef float f32x4 __attribute__((ext_vector_type(4)));
typedef unsigned u32x4 __attribute__((ext_vector_type(4)));
constexpr int BM = 256, BK = 64, HALF = 128, HTB = HALF * BK * 2  , STAGE_BYTES = 8 * HTB, NXCD = 8, WGM = 8;

__host__ __device__ __forceinline__ int lds_byte(int r, int c) { const int st = (r >> 4) * 2 + (c >> 5), rr = r & 15, cc = c & 31, ob = rr * 64 + cc * 2; return st * 1024 + (ob ^ (((ob >> 9) & 1) << 5)); }
__host__ __device__ __forceinline__ void stage_rc(int b, int& R, int& C) { const int st = b / 1024, sb = b % 1024, swz = sb ^ (((sb >> 9) & 1) << 5); R = (st >> 1) * 16 + swz / 64; C = (st & 1) * 32 + (swz % 64) / 2; }
__host__ __device__ __forceinline__ int perm32(int rho) { const int n = rho >> 4, i = rho & 15; return 8 * (i >> 2) + 4 * n + (i & 3); }

struct Unit { int pm, pn; };
struct Gemm { const bf16_t* A; const bf16_t* Bt; int lda, K; };

struct StaticOrder {
    int nM, nN, nwg, G, c, rep;
    __host__ __device__ void init(int M, int N, int G_, int c_, int rep_ = 1) { nM = M / BM; nN = N / BM; nwg = nM * nN; G = G_; c = c_; rep = rep_; }
    __host__ __device__ bool next(int i, Unit& u) const {
        const long L = (long)i * G + c; if (L >= (long)rep * nwg) return false;
        int wgid = (int)(L % nwg); { const int q = nwg / NXCD, r = nwg % NXCD, xcd = wgid % NXCD, off = wgid / NXCD; wgid = (xcd < r ? xcd * (q + 1) : r * (q + 1) + (xcd - r) * q) + off; }
        const int nig = WGM * nN, gid = wgid / nig, fm = gid * WGM, gsz = (nM - fm) < WGM ? (nM - fm) : WGM;
        u.pm = fm + ((wgid % nig) % gsz); u.pn = (wgid % nig) / gsz; return true;
    }
    __device__ __forceinline__ void a_ready(const Unit&) const {}
    __device__ __forceinline__ void done(const Unit&) const {}
};

__device__ __forceinline__ unsigned cvt_pk_bf16(float lo, float hi) { unsigned r; asm volatile("v_cvt_pk_bf16_f32 %0, %1, %2" : "=v"(r) : "v"(lo), "v"(hi)); return r; }
struct EpiBf16 {
    static constexpr bool PERM = true, AFTER_DRAIN = false;
    bf16_t* O; int ldc; int nmod;
    __device__ __forceinline__ void operator()(const f32x4 (&acc)[2][2][4][2], const Unit& u, int wr, int wc, int fr, int fq) const {
        const int pnl = nmod ? (u.pn % nmod) : u.pn;
        const int row0 = u.pm * BM + wr * 64 + fr, col0 = pnl * BM + wc * 32 + 8 * fq;
#pragma unroll
        for (int ai = 0; ai < 2; ++ai)
#pragma unroll
            for (int m = 0; m < 4; ++m) { bf16_t* rowp = O + (size_t)(row0 + ai * HALF + m * 16) * ldc + col0;
#pragma unroll
                for (int bj = 0; bj < 2; ++bj) { const f32x4 v0 = acc[ai][bj][m][0], v1 = acc[ai][bj][m][1];
                    u32x4 w; w.x = cvt_pk_bf16(v0[0], v0[1]); w.y = cvt_pk_bf16(v0[2], v0[3]); w.z = cvt_pk_bf16(v1[0], v1[1]); w.w = cvt_pk_bf16(v1[2], v1[3]);
                    *(u32x4*)(rowp + bj * HALF) = w; } }
    }
};
struct EpiInProj {
    static constexpr bool PERM = true, AFTER_DRAIN = false;
    bf16_t* RAW; bf16_t* ZB;
    __device__ __forceinline__ void operator()(const f32x4 (&acc)[2][2][4][2], const Unit& u, int wr, int wc, int fr, int fq) const {
        const bool isz = (u.pn >= 16 && u.pn < 24);
        bf16_t* O = isz ? ZB : RAW; const int ldc = isz ? 2048 : 4352; const int ct = isz ? (u.pn - 16) : (u.pn < 16 ? u.pn : 16);
        const int row0 = u.pm * BM + wr * 64 + fr, col0 = ct * BM + wc * 32 + 8 * fq;
#pragma unroll
        for (int ai = 0; ai < 2; ++ai)
#pragma unroll
            for (int m = 0; m < 4; ++m) { bf16_t* rowp = O + (size_t)(row0 + ai * HALF + m * 16) * ldc + col0;
#pragma unroll
                for (int bj = 0; bj < 2; ++bj) { const f32x4 v0 = acc[ai][bj][m][0], v1 = acc[ai][bj][m][1];
                    u32x4 w; w.x = cvt_pk_bf16(v0[0], v0[1]); w.y = cvt_pk_bf16(v0[2], v0[3]); w.z = cvt_pk_bf16(v1[0], v1[1]); w.w = cvt_pk_bf16(v1[2], v1[3]);
                    *(u32x4*)(rowp + bj * HALF) = w; } }
    }
};
__device__ __forceinline__ float silu_f(float x) { return x * __builtin_amdgcn_rcpf(1.0f + __builtin_amdgcn_exp2f(-1.4426950408889634f * x)); }
struct EpiSwiGLU {
    static constexpr bool PERM = true, AFTER_DRAIN = false;
    bf16_t* O; int ldc; int nmod;
    __device__ __forceinline__ void operator()(const f32x4 (&acc)[2][2][4][2], const Unit& u, int wr, int wc, int fr, int fq) const {
        const int pnl = nmod ? (u.pn % nmod) : u.pn;
        const int row0 = u.pm * BM + wr * 64 + fr, col0 = pnl * HALF + wc * 32 + 8 * fq;
#pragma unroll
        for (int ai = 0; ai < 2; ++ai)
#pragma unroll
            for (int m = 0; m < 4; ++m) { bf16_t* rowp = O + (size_t)(row0 + ai * HALF + m * 16) * ldc + col0;
                const f32x4 g0 = acc[ai][0][m][0], g1 = acc[ai][0][m][1], u0 = acc[ai][1][m][0], u1 = acc[ai][1][m][1];
                u32x4 w;
                w.x = cvt_pk_bf16(silu_f(g0[0]) * u0[0], silu_f(g0[1]) * u0[1]); w.y = cvt_pk_bf16(silu_f(g0[2]) * u0[2], silu_f(g0[3]) * u0[3]);
                w.z = cvt_pk_bf16(silu_f(g1[0]) * u1[0], silu_f(g1[1]) * u1[1]); w.w = cvt_pk_bf16(silu_f(g1[2]) * u1[2], silu_f(g1[3]) * u1[3]);
                *(u32x4*)rowp = w; }
    }
};
template <bool LNR> struct EpiResid {
    static constexpr bool PERM = false, AFTER_DRAIN = false;
    const float* res; float* out; const float* stats; const float* g; const float* b;
    __device__ __forceinline__ void operator()(const f32x4 (&acc)[2][2][4][2], const Unit& u, int wr, int wc, int fr, int fq) const {
        constexpr int ldc = 1024; constexpr float alpha = 1.6817928305074290f;
        const int row0 = u.pm * BM + wr * 64 + fr, col0 = u.pn * BM + wc * 32 + 4 * fq;
        if constexpr (!LNR) {
#pragma unroll
            for (int ai = 0; ai < 2; ++ai)
#pragma unroll
                for (int m = 0; m < 4; ++m) { const size_t off = (size_t)(row0 + ai * HALF + m * 16) * ldc + col0;
#pragma unroll
                    for (int bj = 0; bj < 2; ++bj)
#pragma unroll
                        for (int n = 0; n < 2; ++n) { const f32x4 r = *(const f32x4*)(res + off + bj * HALF + n * 16);
                            *(f32x4*)(out + off + bj * HALF + n * 16) = r * alpha + acc[ai][bj][m][n]; } }
        } else {
#pragma unroll
            for (int bj = 0; bj < 2; ++bj)
#pragma unroll
                for (int n = 0; n < 2; ++n) {
                    const f32x4 gv = *(const f32x4*)(g + col0 + bj * HALF + n * 16) * alpha, bv = *(const f32x4*)(b + col0 + bj * HALF + n * 16) * alpha;
#pragma unroll
                    for (int ai = 0; ai < 2; ++ai)
#pragma unroll
                        for (int m = 0; m < 4; ++m) { const int row = row0 + ai * HALF + m * 16; const size_t off = (size_t)row * ldc + col0 + bj * HALF + n * 16;
                            const float mean = stats[2 * row], rstd = stats[2 * row + 1];
                            const f32x4 r = *(const f32x4*)(res + off);
                            *(f32x4*)(out + off) = (r - mean) * rstd * gv + bv + acc[ai][bj][m][n]; }
                    asm volatile("" ::: "memory");
                }
        }
    }
};
struct MoeOrder {
    int nM, nN, nwg, G, c, rep; int ps1, ps2, ps3, ps4, ps5, ps6, ps7;
    __device__ __forceinline__ bool next(int i, Unit& u) const {
        const long L = (long)i * G + c; if (nwg == 0 || L >= (long)rep * nwg) return false;
        int wgid = (int)(L % nwg); { const int q = nwg / NXCD, r = nwg % NXCD, xcd = wgid % NXCD, off = wgid / NXCD; wgid = (xcd < r ? xcd * (q + 1) : r * (q + 1) + (xcd - r) * q) + off; }
        const int nig = WGM * nN, gid = wgid / nig, fm = gid * WGM, gsz = (nM - fm) < WGM ? (nM - fm) : WGM;
        const int pm = fm + ((wgid % nig) % gsz), pnl = (wgid % nig) / gsz;
        const int e = (pm >= ps1) + (pm >= ps2) + (pm >= ps3) + (pm >= ps4) + (pm >= ps5) + (pm >= ps6) + (pm >= ps7);
        u.pm = pm; u.pn = e * nN + pnl; return true;
    }
    __device__ __forceinline__ void a_ready(const Unit&) const {}
    __device__ __forceinline__ void done(const Unit&) const {}
};
template <class Epi, class Sched, bool ALIGN_EPI = false, bool SP2 = false>
__device__ __forceinline__ void gemm_phase(PG8_LAS unsigned char* lds, const Gemm g, const Sched& S, const Epi& E) {
    const int tid = threadIdx.x, wid = __builtin_amdgcn_readfirstlane(tid >> 6), lane = tid & 63, wr = wid >> 2, wc = wid & 3, fr = lane & 15, fq = lane >> 4;
    const int K = g.K, nt = K / BK;
    unsigned voffA[2], voffB[2];
#pragma unroll
    for (int i = 0; i < 2; ++i) { int R, C; stage_rc(tid * 16 + i * 8192, R, C); const int Rb = Epi::PERM ? ((R & ~31) + perm32(R & 31)) : R;
        voffA[i] = (unsigned)(R * g.lda + C) * 2u; voffB[i] = (unsigned)(Rb * K + C) * 2u; }
    const size_t kstep = (size_t)(BK * 2);
    const size_t hstepA = (size_t)HALF * g.lda * 2, hstepB = (size_t)HALF * K * 2;
    const size_t tstepA = 2 * hstepA, tstepB = 2 * hstepB;
    const unsigned ldsw = (unsigned)wid * 1024u;
    const int aoff = lds_byte(wr * 64 + fr, fq * 8), boff = lds_byte(wc * 32 + fr, fq * 8);
#define PG8_SA(b, h) (((b) * 2 + (h)) * HTB)
#define PG8_SB(b, h) ((4 + (b) * 2 + (h)) * HTB)
#define PG8_STAGE(bufoff, gbase, voff) do { _Pragma("unroll") for (int _i = 0; _i < 2; ++_i) \
        __builtin_amdgcn_global_load_lds((const unsigned*)((const char*)(gbase) + (voff)[_i]), (PG8_LAS unsigned*)(lds + (bufoff) + ldsw + _i * 8192), 16, 0, 0); } while (0)
#define PG8_LDA(dst, b, h) do { _Pragma("unroll") for (int m = 0; m < 4; ++m) _Pragma("unroll") for (int k = 0; k < 2; ++k) dst[m][k] = *(const PG8_LAS bf16x8*)(lds + PG8_SA(b, h) + aoff + m * 2048 + k * 1024); } while (0)
#define PG8_LDB(dst, b, h) do { _Pragma("unroll") for (int n = 0; n < 2; ++n) _Pragma("unroll") for (int k = 0; k < 2; ++k) dst[n][k] = *(const PG8_LAS bf16x8*)(lds + PG8_SB(b, h) + boff + n * 2048 + k * 1024); } while (0)
#define PG8_MMA(ai, bj, At, Bt) do { __builtin_amdgcn_s_setprio(1); _Pragma("unroll") for (int m = 0; m < 4; ++m) _Pragma("unroll") for (int n = 0; n < 2; ++n) _Pragma("unroll") for (int k = 0; k < 2; ++k) \
        acc[ai][bj][m][n] = __builtin_amdgcn_mfma_f32_16x16x32_bf16(Bt[n][k], At[m][k], acc[ai][bj][m][n], 0, 0, 0); __builtin_amdgcn_s_setprio(0); } while (0)
#define PG8_WAIT_V(n) asm volatile("s_waitcnt vmcnt(" #n ")" ::: "memory")
#define PG8_WAIT_L(n) asm volatile("s_waitcnt lgkmcnt(" #n ")" ::: "memory")
#define PG8_BAR __builtin_amdgcn_s_barrier()
#define PG8_SCHED __builtin_amdgcn_sched_barrier(0)
    Unit cur, nxt; int ui = 0;
    if (!S.next(0, cur)) return;
    f32x4 acc[2][2][4][2];
#pragma unroll
    for (int a = 0; a < 2; ++a)
#pragma unroll
        for (int b = 0; b < 2; ++b)
#pragma unroll
            for (int m = 0; m < 4; ++m)
#pragma unroll
                for (int n = 0; n < 2; ++n) acc[a][b][m][n] = (f32x4){0.f, 0.f, 0.f, 0.f};
    bf16x8 At[4][2], B0[2][2], B1[2][2];
    const char* cA = (const char*)g.A + (size_t)cur.pm * tstepA; const char* cB = (const char*)g.Bt + (size_t)cur.pn * tstepB;
    S.a_ready(cur);
    if constexpr (SP2) {
        PG8_STAGE(PG8_SB(0, 0), cB, voffB); PG8_STAGE(PG8_SB(0, 1), cB + hstepB, voffB); PG8_STAGE(PG8_SA(0, 0), cA, voffA); PG8_STAGE(PG8_SA(0, 1), cA + hstepA, voffA);
        if (wr == 1) PG8_BAR;
        PG8_WAIT_V(2); PG8_BAR;
        PG8_STAGE(PG8_SB(1, 0), cB + kstep, voffB); PG8_STAGE(PG8_SA(1, 0), cA + kstep, voffA); PG8_STAGE(PG8_SB(1, 1), cB + hstepB + kstep, voffB);
        PG8_WAIT_V(6); PG8_BAR;
    } else {
        PG8_STAGE(PG8_SB(0, 0), cB, voffB); PG8_STAGE(PG8_SA(0, 0), cA, voffA); PG8_STAGE(PG8_SB(0, 1), cB + hstepB, voffB); PG8_STAGE(PG8_SA(0, 1), cA + hstepA, voffA);
        if (wr == 1) PG8_BAR;
        PG8_WAIT_V(4); PG8_BAR;
        PG8_STAGE(PG8_SB(1, 0), cB + kstep, voffB); PG8_STAGE(PG8_SA(1, 0), cA + kstep, voffA); PG8_STAGE(PG8_SB(1, 1), cB + hstepB + kstep, voffB);
        PG8_WAIT_V(6); PG8_BAR;
    }
    for (;;) {
        const bool has_next = S.next(ui + 1, nxt);
        const char* nA = has_next ? (const char*)g.A + (size_t)nxt.pm * tstepA : cA; const char* nB = has_next ? (const char*)g.Bt + (size_t)nxt.pn * tstepB : cB;
        for (int t = 0; t < nt; t += 2) {
            const bool last = (t == nt - 2);
            const char* a1 = cA + (size_t)(t + 1) * kstep;
            const char* a2 = last ? nA : cA + (size_t)(t + 2) * kstep; const char* b2 = last ? nB : cB + (size_t)(t + 2) * kstep;
            const char* a3 = a2 + kstep; const char* b3 = b2 + kstep;
            if (last && has_next) S.a_ready(nxt);
            if constexpr (SP2) {
            PG8_LDB(B0, 0, 0); PG8_LDB(B1, 0, 1); PG8_SCHED; PG8_LDA(At, 0, 0); PG8_STAGE(PG8_SA(1, 1), a1 + hstepA, voffA);
            PG8_WAIT_V(8); PG8_WAIT_L(0); PG8_BAR; PG8_MMA(0, 0, At, B0); PG8_MMA(0, 1, At, B1); PG8_BAR; PG8_SCHED;
            PG8_LDA(At, 0, 1); PG8_STAGE(PG8_SB(0, 0), b2, voffB); PG8_STAGE(PG8_SB(0, 1), b2 + hstepB, voffB); PG8_STAGE(PG8_SA(0, 0), a2, voffA);
            PG8_WAIT_V(8); PG8_WAIT_L(0); PG8_BAR; PG8_MMA(1, 0, At, B0); PG8_MMA(1, 1, At, B1); PG8_BAR; PG8_SCHED;
            PG8_LDB(B0, 1, 0); PG8_LDB(B1, 1, 1); PG8_SCHED; PG8_LDA(At, 1, 0); PG8_STAGE(PG8_SA(0, 1), a2 + hstepA, voffA);
            PG8_WAIT_V(8); PG8_WAIT_L(0); PG8_BAR; PG8_MMA(0, 0, At, B0); PG8_MMA(0, 1, At, B1); PG8_BAR; PG8_SCHED;
            PG8_LDA(At, 1, 1); PG8_STAGE(PG8_SB(1, 0), b3, voffB); PG8_STAGE(PG8_SB(1, 1), b3 + hstepB, voffB); PG8_STAGE(PG8_SA(1, 0), a3, voffA);
            PG8_WAIT_V(8); PG8_WAIT_L(0); PG8_BAR; PG8_MMA(1, 0, At, B0); PG8_MMA(1, 1, At, B1); PG8_BAR; PG8_SCHED;
            } else {
            PG8_LDB(B0, 0, 0); PG8_SCHED; PG8_LDA(At, 0, 0); PG8_STAGE(PG8_SA(1, 1), a1 + hstepA, voffA);
            PG8_WAIT_L(8); PG8_BAR; PG8_WAIT_L(0); PG8_MMA(0, 0, At, B0); PG8_BAR; PG8_SCHED;
            PG8_LDB(B1, 0, 1); PG8_STAGE(PG8_SB(0, 0), b2, voffB);
            PG8_BAR; PG8_WAIT_L(0); PG8_MMA(0, 1, At, B1); PG8_BAR;
            PG8_LDA(At, 0, 1); PG8_STAGE(PG8_SA(0, 0), a2, voffA);
            PG8_BAR; PG8_WAIT_L(0); PG8_MMA(1, 0, At, B0); PG8_BAR; PG8_SCHED;
            PG8_STAGE(PG8_SB(0, 1), b2 + hstepB, voffB);
            PG8_WAIT_V(6); PG8_BAR; PG8_MMA(1, 1, At, B1); PG8_BAR;
            PG8_LDB(B0, 1, 0); PG8_SCHED; PG8_LDA(At, 1, 0); PG8_STAGE(PG8_SA(0, 1), a2 + hstepA, voffA);
            PG8_WAIT_L(8); PG8_BAR; PG8_WAIT_L(0); PG8_MMA(0, 0, At, B0); PG8_BAR; PG8_SCHED;
            PG8_LDB(B1, 1, 1); PG8_STAGE(PG8_SB(1, 0), b3, voffB);
            PG8_BAR; PG8_WAIT_L(0); PG8_MMA(0, 1, At, B1); PG8_BAR;
            PG8_LDA(At, 1, 1); PG8_STAGE(PG8_SA(1, 0), a3, voffA);
            PG8_BAR; PG8_WAIT_L(0); PG8_MMA(1, 0, At, B0); PG8_BAR; PG8_SCHED;
            PG8_STAGE(PG8_SB(1, 1), b3 + hstepB, voffB);
            PG8_WAIT_V(6); PG8_BAR; PG8_MMA(1, 1, At, B1); PG8_BAR;
            }
        }
        if constexpr (ALIGN_EPI) { if (wr == 0) PG8_BAR; }
        if constexpr (!Epi::AFTER_DRAIN) { E(acc, cur, wr, wc, fr, fq); S.done(cur); }
        if (!has_next) break;
#pragma unroll
        for (int a = 0; a < 2; ++a)
#pragma unroll
            for (int b = 0; b < 2; ++b)
#pragma unroll
                for (int m = 0; m < 4; ++m)
#pragma unroll
                    for (int n = 0; n < 2; ++n) acc[a][b][m][n] = (f32x4){0.f, 0.f, 0.f, 0.f};
        cur = nxt; cA = nA; cB = nB; ++ui;
        if constexpr (ALIGN_EPI) { if (wr == 1) PG8_BAR; }
    }
    PG8_WAIT_V(0);
    if constexpr (!ALIGN_EPI) { if (wr == 0) PG8_BAR; }
    PG8_BAR;
    if constexpr (Epi::AFTER_DRAIN) { E.fused(acc, cur, wr, wc, fr, fq, lds, wid, lane); S.done(cur); }
#undef PG8_SA
#undef PG8_SB
#undef PG8_STAGE
#undef PG8_LDA
#undef PG8_LDB
#undef PG8_MMA
#undef PG8_WAIT_V
#undef PG8_WAIT_L
#undef PG8_BAR
#undef PG8_SCHED
}
}

constexpr int NWAVES = 8;
constexpr int BATCH = 8, SEQ = 4096, TT = BATCH * SEQ, D = 1024;
constexpr int HK = 8, HV = 16, HD = 128;
constexpr int GIN = 6176, GINP = 6400;
constexpr int FF = 3584, NE = 8, MOE_ROWS = 67584;
constexpr float ALPHA = 1.6817928305074290f;
constexpr float LN_EPS = 1e-5f, RMS_EPS = 1e-6f;
constexpr int NPH = 18, NPHASES = 2 * NPH;

constexpr size_t MiB = 1ull << 20;
constexpr size_t WS_CTL = 0, CTL_ZERO_BYTES = 1 * MiB;
constexpr size_t WS_E12 = 1 * MiB;
constexpr size_t WS_G12 = WS_E12 + 256 * 1024;
constexpr size_t WS_POS = WS_G12 + 256 * 1024;
constexpr size_t WS_GB = 2 * MiB;
constexpr size_t WS_W = 16 * MiB;
constexpr size_t WS_W2 = 912 * MiB;
constexpr size_t W_IN = WS_W2, W_OUT = WS_W2 + 13 * MiB, W_GU = WS_W2 + 17 * MiB, W_D = WS_W2 + 31 * MiB;
constexpr size_t W_QKV = WS_W, W_O = WS_W + 6 * MiB, W_MGU = WS_W + 8 * MiB, W_MD = WS_W + 120 * MiB;
constexpr size_t WS_HB = 192 * MiB;
constexpr size_t WS_BIG = 256 * MiB;
constexpr size_t WS_ZB = WS_BIG, WS_RAW = WS_BIG + 128 * MiB, WS_QKVC = WS_BIG + 400 * MiB;
constexpr int RAWLD = 4352;
constexpr size_t WS_WMEM = WS_RAW, WS_IMEM = WS_RAW + 128 * MiB, WS_KTMEM = WS_RAW + 192 * MiB;
constexpr size_t WS_STATS = 12 * MiB;
constexpr size_t WS_GTAB = 6 * MiB;
constexpr size_t WS_ACT = WS_BIG;
constexpr size_t WS_QKV = WS_BIG, WS_AO = WS_BIG + 192 * MiB;
constexpr size_t WS_XS = WS_BIG, WS_MACT = WS_BIG + 132 * MiB;
constexpr size_t WS_END = 950 * MiB;
static_assert(WS_QKVC + (size_t)TT * 4096 * 2 <= WS_W2 && WS_MACT + (size_t)MOE_ROWS * FF * 2 <= WS_END && WS_RAW + (size_t)TT * RAWLD * 2 <= WS_QKVC && WS_KTMEM + (size_t)4096 * 8192 * 2 <= WS_QKVC && WS_GTAB + (size_t)8192 * 192 * 4 <= WS_W, "d_ws map");
static_assert(W_MD + (size_t)NE * D * FF * 2 <= WS_HB && W_IN + (size_t)GINP * D * 2 <= W_OUT && W_D + (size_t)D * FF * 2 <= WS_END && WS_QKVC + (size_t)TT * 4096 * 2 <= WS_W2 && W_MGU + (size_t)NE * 2 * FF * D * 2 <= W_MD, "weight map");
constexpr int CW_BAR = 4096;
constexpr int CW_CNT = 16384;

constexpr int RING_BYTES = 131072;
constexpr int MISC_OFF = RING_BYTES + 320;
constexpr int OGST_OFF = 147456;
#ifndef PROBE_SEC
#define PROBE_SEC 0
#endif
#define SEC_IN(k) do { if (PROBE_SEC == (k)) { if (blockIdx.x == 0 && (threadIdx.x == 0)) ((volatile LAS unsigned*)((LAS unsigned char*)0 + MISC_OFF))[20] -= (unsigned)__builtin_amdgcn_s_memrealtime(); } } while (0)
#define SEC_OUT(k) do { if (PROBE_SEC == (k)) { if (blockIdx.x == 0 && (threadIdx.x == 0)) ((volatile LAS unsigned*)((LAS unsigned char*)0 + MISC_OFF))[20] += (unsigned)__builtin_amdgcn_s_memrealtime(); } } while (0)
constexpr int LDS_BYTES = 163840;

#define GAS __attribute__((address_space(1)))
#define LAS __attribute__((address_space(3)))
#define DI __device__ __forceinline__
typedef unsigned short bf16;
typedef unsigned v4u __attribute__((ext_vector_type(4)));
typedef unsigned v2u __attribute__((ext_vector_type(2)));
typedef float f32x4 __attribute__((ext_vector_type(4)));
typedef float f32x2 __attribute__((ext_vector_type(2)));
typedef GAS unsigned gu32;
#define RLX_AGENT __ATOMIC_RELAXED, __HIP_MEMORY_SCOPE_AGENT
#define LDS_WAIT() asm volatile("s_waitcnt lgkmcnt(0)" ::: "memory")
#define VM_WAIT() asm volatile("s_waitcnt vmcnt(0)" ::: "memory")
__device__ __forceinline__ unsigned long long rt() { return __builtin_amdgcn_s_memrealtime(); }
__device__ __forceinline__ unsigned f2bf(float f) { unsigned u = __builtin_bit_cast(unsigned, f); return (u + 0x7fffu + ((u >> 16) & 1u)) >> 16; }
__device__ __forceinline__ unsigned pk2(float lo, float hi) { return f2bf(lo) | (f2bf(hi) << 16); }

#define XB_TMO      128
#define XB_XCNT(j)  (256  + 64 * (j))
#define XB_XSUB(j)  (1280 + 64 * (j))
#define XB_XGEN(j)  (2304 + 64 * (j))
#define XB_TOP      3328
#define XB_TOPGEN   3392
#define XCD_BAR_WORDS 3456
#define XB_SPIN_CAP (1u << 22)

__device__ __forceinline__ unsigned xb_ld(unsigned* p)              { return __hip_atomic_load(p, __ATOMIC_RELAXED, __HIP_MEMORY_SCOPE_AGENT); }
__device__ __forceinline__ unsigned xb_add(unsigned* p, unsigned v) { return __hip_atomic_fetch_add(p, v, __ATOMIC_RELAXED, __HIP_MEMORY_SCOPE_AGENT); }
__device__ __forceinline__ unsigned xb_xcc_id() { return (unsigned)__builtin_amdgcn_s_getreg((3 << 11) | 20) & 0xFu; }
#define XB_SPIN(cond, bar) do { unsigned _sp = 0; while (cond) { __builtin_amdgcn_s_sleep(1); \
    if ((++_sp & 255u) == 0u) { if (xb_ld(&(bar)[XB_TMO])) break; if (_sp > XB_SPIN_CAP) { atomicAdd(&(bar)[XB_TMO], 1u); break; } } } } while (0)

struct XcdBarrier {
    unsigned* bar; unsigned x;
    volatile LAS unsigned* st;
};

__device__ __forceinline__ XcdBarrier xcd_barrier_post(unsigned* bar, volatile LAS unsigned* st) {
    XcdBarrier b; b.bar = bar; b.x = xb_xcc_id(); b.st = st;
    if (threadIdx.x == 0) (void)xb_add(&bar[XB_XCNT(b.x)], 1u);
    return b;
}
__device__ __forceinline__ void xcd_barrier_complete(unsigned* bar, unsigned x, unsigned& nloc, unsigned& nx) {
    const unsigned G = gridDim.x * gridDim.y * gridDim.z;
    unsigned sum, cnt, mine, sp = 0u;
    for (;;) {
        sum = 0u; cnt = 0u; mine = 0u;
#pragma unroll
        for (unsigned j = 0; j < 16; ++j) { const unsigned c = xb_ld(&bar[XB_XCNT(j)]); sum += c; cnt += (c > 0u) ? 1u : 0u; mine = (j == x) ? c : mine; }
        if (sum == G) break;
        __builtin_amdgcn_s_sleep(1);
        if ((++sp & 255u) == 0u) { if (xb_ld(&bar[XB_TMO])) break; if (sp > XB_SPIN_CAP) { atomicAdd(&bar[XB_TMO], 1u); break; } }
    }
    nloc = mine > 0u ? mine : 1u; nx = cnt > 0u ? cnt : 1u;
}

__device__ __forceinline__ void xcd_barrier(const XcdBarrier& b) {
    asm volatile("s_waitcnt vmcnt(0)" ::: "memory");
    __syncthreads();
    if (threadIdx.x == 0) {
        unsigned* bar = b.bar;
        __builtin_amdgcn_s_waitcnt(0);
        unsigned nloc = b.st[0], nx = b.st[1];
        if (nloc == 0u) { xcd_barrier_complete(bar, b.x, nloc, nx); b.st[0] = nloc; b.st[1] = nx; }
        const unsigned old = xb_add(&bar[XB_XSUB(b.x)], 1u);
        const unsigned gen = old / nloc;
        if (old + 1u == (gen + 1u) * nloc) {
            __builtin_amdgcn_fence(__ATOMIC_RELEASE, "agent");
            asm volatile("s_waitcnt vmcnt(0)" ::: "memory");
            const unsigned og = xb_add(&bar[XB_TOP], 1u);
            const unsigned tg = og / nx;
            if (og + 1u == (tg + 1u) * nx) xb_add(&bar[XB_TOPGEN], 1u);
            else XB_SPIN(xb_ld(&bar[XB_TOPGEN]) == tg, bar);
            __builtin_amdgcn_fence(__ATOMIC_ACQUIRE, "agent");
            xb_add(&bar[XB_XGEN(b.x)], 1u);
            asm volatile("s_waitcnt vmcnt(0)" ::: "memory");
        } else {
            XB_SPIN(xb_ld(&bar[XB_XGEN(b.x)]) == gen, bar);
            __builtin_amdgcn_fence(__ATOMIC_ACQUIRE, "agent");
            asm volatile("s_waitcnt vmcnt(0)" ::: "memory");
        }
    }
    __syncthreads();
}

DI float bf_lo(unsigned w) { return __uint_as_float(w << 16); }
DI float bf_hi(unsigned w) { return __uint_as_float(w & 0xffff0000u); }
DI float wave_sum(float v) {
    v += __builtin_bit_cast(float, __builtin_amdgcn_update_dpp(0, __builtin_bit_cast(int, v), 0xB1, 0xF, 0xF, false));
    v += __builtin_bit_cast(float, __builtin_amdgcn_update_dpp(0, __builtin_bit_cast(int, v), 0x4E, 0xF, 0xF, false));
    v += __builtin_bit_cast(float, __builtin_amdgcn_update_dpp(0, __builtin_bit_cast(int, v), 0x141, 0xF, 0xF, false));
    v += __builtin_bit_cast(float, __builtin_amdgcn_update_dpp(0, __builtin_bit_cast(int, v), 0x140, 0xF, 0xF, false));
    v += __builtin_bit_cast(float, __builtin_amdgcn_update_dpp(0, __builtin_bit_cast(int, v), 0x142, 0xA, 0xF, false));
    v += __builtin_bit_cast(float, __builtin_amdgcn_update_dpp(0, __builtin_bit_cast(int, v), 0x143, 0xC, 0xF, false));
    return __builtin_bit_cast(float, __builtin_amdgcn_readlane(__builtin_bit_cast(int, v), 63));
}
DI float sigmoid_f(float x) { return 1.0f / (1.0f + __expf(-x)); }

struct Args {
    const float *x, *gdn_w_in, *gdn_conv_w, *gdn_a_log, *gdn_dt_bias, *gdn_norm_w, *gdn_w_out, *sb_w_in, *sb_w_out, *ffn_w_gate, *ffn_w_up, *ffn_w_down,
                *moe_router, *moe_w_gate, *moe_w_up, *moe_w_down, *ln_g, *ln_b;
    float* out; unsigned char* ws; int ph_lo, ph_hi;
};

DI void transpose_item(const float* W, int ldw, bf16* WT, int K, int drow0, int k0, int n0, LAS float* scr, int lane) {
#pragma unroll 8
    for (int i = 0; i < 32; ++i) { const int kk = 2 * i + (lane >> 5); scr[kk * 33 + (lane & 31)] = W[(size_t)(k0 + kk) * ldw + n0 + (lane & 31)]; }
    LDS_WAIT(); asm volatile("" ::: "memory");
    const int c = lane & 7;
#pragma unroll
    for (int jj = 0; jj < 4; ++jj) { const int n = (lane >> 3) + 8 * jj; const LAS float* s = scr + (8 * c) * 33 + n;
        v4u o; o.x = pk2(s[0 * 33], s[1 * 33]); o.y = pk2(s[2 * 33], s[3 * 33]); o.z = pk2(s[4 * 33], s[5 * 33]); o.w = pk2(s[6 * 33], s[7 * 33]);
        *(v4u*)(WT + (size_t)(drow0 + n) * K + k0 + 8 * c) = o; }
    LDS_WAIT(); asm volatile("" ::: "memory");
}

DI void transpose_item64(const float* W, int ldw, bf16* WT, int K, int drow0, int k0, int n0, LAS unsigned char* scr, int lane) {
    const int q = lane >> 4, cx = lane & 15;
    f32x4 r[16];
#pragma unroll
    for (int i = 0; i < 16; ++i) r[i] = *(const f32x4*)(W + (size_t)(k0 + 16 * q + i) * ldw + n0 + 4 * cx);
#pragma unroll
    for (int e = 0; e < 4; ++e) {
        v4u w0, w1;
        w0.x = pk2(r[0][e], r[1][e]); w0.y = pk2(r[2][e], r[3][e]); w0.z = pk2(r[4][e], r[5][e]); w0.w = pk2(r[6][e], r[7][e]);
        w1.x = pk2(r[8][e], r[9][e]); w1.y = pk2(r[10][e], r[11][e]); w1.z = pk2(r[12][e], r[13][e]); w1.w = pk2(r[14][e], r[15][e]);
        *(LAS v4u*)(scr + (4 * cx + e) * 144 + q * 32) = w0; *(LAS v4u*)(scr + (4 * cx + e) * 144 + q * 32 + 16) = w1;
    }
    LDS_WAIT(); asm volatile("" ::: "memory");
#pragma unroll
    for (int j = 0; j < 8; ++j) { const int id = lane + 64 * j, n = id >> 3, kp = id & 7;
        *(v4u*)(WT + (size_t)(drow0 + n) * K + k0 + 8 * kp) = *(const LAS v4u*)(scr + n * 144 + kp * 16); }
    LDS_WAIT(); asm volatile("" ::: "memory");
}

DI void phase_w_gdn(const Args& a, int j, LAS unsigned char* lds, int bid, int G, int tid, int wave, int lane) {
    LAS float* scr = (LAS float*)(lds + wave * 16384);
    const int gw = bid * NWAVES + wave, NGW = G * NWAVES;
    const float* Win = a.gdn_w_in + (size_t)j * D * GIN; const float* Wout = a.gdn_w_out + (size_t)j * 2048 * D;
    const float* Wg = a.ffn_w_gate + (size_t)j * D * FF; const float* Wu = a.ffn_w_up + (size_t)j * D * FF; const float* Wd = a.ffn_w_down + (size_t)j * FF * D;
    bf16* WIN_T = (bf16*)(a.ws + W_IN); bf16* WOUT_T = (bf16*)(a.ws + W_OUT); bf16* WGU_T = (bf16*)(a.ws + W_GU); bf16* WD_T = (bf16*)(a.ws + W_D);
    LAS unsigned char* scb = (LAS unsigned char*)scr;
    constexpr int I_IN = 16 * 96, I_INT = 16, I_OUT = 32 * 16, I_G = 16 * 56, I_D = 56 * 16, NIT = I_IN + I_INT + I_OUT + 2 * I_G + I_D;
    for (int it = gw; it < NIT; it += NGW) {
        int r = it;
        if (r < I_IN) { const int kb = r / 96, nb = r % 96; transpose_item64(Win, GIN, WIN_T, D, 64 * nb, 64 * kb, 64 * nb, scb, lane); continue; } r -= I_IN;
        if (r < I_INT) { transpose_item(Win, GIN, WIN_T, D, 6144, 64 * r, 6144, scr, lane); continue; } r -= I_INT;
        if (r < I_OUT) { const int kb = r / 16, nb = r % 16; transpose_item64(Wout, D, WOUT_T, 2048, 64 * nb, 64 * kb, 64 * nb, scb, lane); continue; } r -= I_OUT;
        if (r < I_G) { const int kb = r / 56, nb = r % 56, n0 = 64 * nb; transpose_item64(Wg, FF, WGU_T, D, 256 * (n0 >> 7) + (n0 & 127), 64 * kb, n0, scb, lane); continue; } r -= I_G;
        if (r < I_G) { const int kb = r / 56, nb = r % 56, n0 = 64 * nb; transpose_item64(Wu, FF, WGU_T, D, 256 * (n0 >> 7) + 128 + (n0 & 127), 64 * kb, n0, scb, lane); continue; } r -= I_G;
        { const int kb = r / 16, nb = r % 16; transpose_item64(Wd, D, WD_T, FF, 64 * nb, 64 * kb, 64 * nb, scb, lane); }
    }
    if (j == 0) {
        bf16* HB = (bf16*)(a.ws + WS_HB); const f32x4* x4 = (const f32x4*)a.x;
        for (size_t i = (size_t)bid * 512 + tid; i < (size_t)TT * D / 8; i += (size_t)G * 512) { const f32x4 p = x4[2 * i], q = x4[2 * i + 1];
            v4u o; o.x = pk2(p[0], p[1]); o.y = pk2(p[2], p[3]); o.z = pk2(q[0], q[1]); o.w = pk2(q[2], q[3]); *(v4u*)(HB + 8 * i) = o; }
    }
}
DI void phase_w_sb(const Args& a, int j, LAS unsigned char* lds, int bid, int G, int wave, int lane) {
    LAS float* scr = (LAS float*)(lds + wave * 16384);
    const int gw = bid * NWAVES + wave, NGW = G * NWAVES;
    const float* Wqkv = a.sb_w_in + (size_t)j * D * 3072; const float* Wo = a.sb_w_out + (size_t)j * D * D;
    const float* Mg = a.moe_w_gate + (size_t)j * NE * D * FF; const float* Mu = a.moe_w_up + (size_t)j * NE * D * FF; const float* Md = a.moe_w_down + (size_t)j * NE * FF * D;
    bf16* WQKV_T = (bf16*)(a.ws + W_QKV); bf16* WO_T = (bf16*)(a.ws + W_O); bf16* MGU_T = (bf16*)(a.ws + W_MGU); bf16* MD_T = (bf16*)(a.ws + W_MD);
    LAS unsigned char* scb = (LAS unsigned char*)scr;
    constexpr int I_QKV = 16 * 48, I_O = 16 * 16, I_G = 16 * 56, I_D = 56 * 16, I_E = 2 * I_G + I_D, NIT = I_QKV + I_O + NE * I_E;
    for (int it = gw; it < NIT; it += NGW) {
        int r = it;
        if (r < I_QKV) { const int kb = r / 48, nb = r % 48; transpose_item64(Wqkv, 3072, WQKV_T, D, 64 * nb, 64 * kb, 64 * nb, scb, lane); continue; } r -= I_QKV;
        if (r < I_O) { const int kb = r / 16, nb = r % 16; transpose_item64(Wo, D, WO_T, D, 64 * nb, 64 * kb, 64 * nb, scb, lane); continue; } r -= I_O;
        const int e = r / I_E; r -= e * I_E;
        bf16* gu = MGU_T + (size_t)e * 2 * FF * D; bf16* dn = MD_T + (size_t)e * D * FF;
        if (r < I_G) { const int kb = r / 56, nb = r % 56, n0 = 64 * nb; transpose_item64(Mg + (size_t)e * D * FF, FF, gu, D, 256 * (n0 >> 7) + (n0 & 127), 64 * kb, n0, scb, lane); continue; } r -= I_G;
        if (r < I_G) { const int kb = r / 56, nb = r % 56, n0 = 64 * nb; transpose_item64(Mu + (size_t)e * D * FF, FF, gu, D, 256 * (n0 >> 7) + 128 + (n0 & 127), 64 * kb, n0, scb, lane); continue; } r -= I_G;
        { const int kb = r / 16, nb = r % 16; transpose_item64(Md + (size_t)e * FF * D, D, dn, FF, 64 * nb, 64 * kb, 64 * nb, scb, lane); }
    }
}

DI float dpp_sum16(float v) {
    v += __builtin_bit_cast(float, __builtin_amdgcn_update_dpp(0, __builtin_bit_cast(int, v), 0xB1, 0xF, 0xF, false));
    v += __builtin_bit_cast(float, __builtin_amdgcn_update_dpp(0, __builtin_bit_cast(int, v), 0x4E, 0xF, 0xF, false));
    v += __builtin_bit_cast(float, __builtin_amdgcn_update_dpp(0, __builtin_bit_cast(int, v), 0x141, 0xF, 0xF, false));
    v += __builtin_bit_cast(float, __builtin_amdgcn_update_dpp(0, __builtin_bit_cast(int, v), 0x140, 0xF, 0xF, false));
    return v;
}
DI void phase_conv(const Args& a, int j, int bid, int G, int tid) {
    const bf16* raw = (const bf16*)(a.ws + WS_RAW); bf16* qkvc = (bf16*)(a.ws + WS_QKVC); float* gb = (float*)(a.ws + WS_GB);
    const float* cw = a.gdn_conv_w + (size_t)j * 4 * 4096;
    const int ch = 8 * tid;
    float w0[8], w1[8], w2[8], w3[8];
#pragma unroll
    for (int i = 0; i < 8; ++i) { w0[i] = cw[ch + i]; w1[i] = cw[4096 + ch + i]; w2[i] = cw[2 * 4096 + ch + i]; w3[i] = cw[3 * 4096 + ch + i]; }
    const float post = tid < 128 ? 0.08838834764831845f : 1.0f;
    for (int run = bid; run < TT / 128; run += G) {
        const int t0 = run * 128; const bool first = (t0 & (SEQ - 1)) == 0;
        float xa[8], xb[8], xc[8];
        { v4u h0 = {0u, 0u, 0u, 0u}, h1 = h0, h2 = h0;
          if (!first) { h0 = *(const v4u*)(raw + (size_t)(t0 - 3) * RAWLD + ch); h1 = *(const v4u*)(raw + (size_t)(t0 - 2) * RAWLD + ch); h2 = *(const v4u*)(raw + (size_t)(t0 - 1) * RAWLD + ch); }
          xa[0] = bf_lo(h0.x); xa[1] = bf_hi(h0.x); xa[2] = bf_lo(h0.y); xa[3] = bf_hi(h0.y); xa[4] = bf_lo(h0.z); xa[5] = bf_hi(h0.z); xa[6] = bf_lo(h0.w); xa[7] = bf_hi(h0.w);
          xb[0] = bf_lo(h1.x); xb[1] = bf_hi(h1.x); xb[2] = bf_lo(h1.y); xb[3] = bf_hi(h1.y); xb[4] = bf_lo(h1.z); xb[5] = bf_hi(h1.z); xb[6] = bf_lo(h1.w); xb[7] = bf_hi(h1.w);
          xc[0] = bf_lo(h2.x); xc[1] = bf_hi(h2.x); xc[2] = bf_lo(h2.y); xc[3] = bf_hi(h2.y); xc[4] = bf_lo(h2.z); xc[5] = bf_hi(h2.z); xc[6] = bf_lo(h2.w); xc[7] = bf_hi(h2.w); }
#pragma unroll 1
        for (int tb = 0; tb < 128; tb += 8) {
            v4u xr[8];
#pragma unroll
            for (int u = 0; u < 8; ++u) xr[u] = *(const v4u*)(raw + (size_t)(t0 + tb + u) * RAWLD + ch);
#pragma unroll
            for (int u = 0; u < 8; ++u) {
                float xd[8]; xd[0] = bf_lo(xr[u].x); xd[1] = bf_hi(xr[u].x); xd[2] = bf_lo(xr[u].y); xd[3] = bf_hi(xr[u].y); xd[4] = bf_lo(xr[u].z); xd[5] = bf_hi(xr[u].z); xd[6] = bf_lo(xr[u].w); xd[7] = bf_hi(xr[u].w);
                float y[8]; float ss = 0.f;
#pragma unroll
                for (int i = 0; i < 8; ++i) { const float c = w0[i] * xa[i] + w1[i] * xb[i] + w2[i] * xc[i] + w3[i] * xd[i];
                    y[i] = c * __builtin_amdgcn_rcpf(1.0f + __builtin_amdgcn_exp2f(-1.4426950408889634f * c)); ss += y[i] * y[i];
                    xa[i] = xb[i]; xb[i] = xc[i]; xc[i] = xd[i]; }
                if (tid < 256) {
                    const float rn = post / sqrtf(dpp_sum16(ss) + RMS_EPS);
#pragma unroll
                    for (int i = 0; i < 8; ++i) y[i] *= rn;
                }
                v4u o; o.x = pk2(y[0], y[1]); o.y = pk2(y[2], y[3]); o.z = pk2(y[4], y[5]); o.w = pk2(y[6], y[7]);
                *(v4u*)(qkvc + (size_t)(t0 + tb + u) * 4096 + ch) = o;
            }
        }
#pragma unroll
        for (int k = 0; k < 4; ++k) { const int item = tid + 512 * k, tok = t0 + (item >> 4), hv = item & 15;
            const float bb = __uint_as_float((unsigned)raw[(size_t)tok * RAWLD + 4096 + hv] << 16), aa = __uint_as_float((unsigned)raw[(size_t)tok * RAWLD + 4112 + hv] << 16);
            const float xx = aa + a.gdn_dt_bias[j * 16 + hv];
            const float sp = xx > 20.f ? xx : log1pf(__expf(xx));
            gb[(size_t)tok * 32 + hv] = -__expf(a.gdn_a_log[j * 16 + hv]) * sp;
            gb[(size_t)tok * 32 + 16 + hv] = sigmoid_f(bb); }
    }
}

DI void phase_gdn_naive(const Args& a, int j, LAS unsigned char* lds, int bid, int tid) {
    if (bid >= BATCH * HV) return;
    const int b = bid / HV, hv = bid % HV, hk = hv / 2, jc = tid & 127, r = tid >> 7;
    const bf16* zb = (const bf16*)(a.ws + WS_ZB); bf16* qkvc = (bf16*)(a.ws + WS_QKVC); const float* gb = (const float*)(a.ws + WS_GB);
    LAS float* qs = (LAS float*)lds; LAS float* ks = qs + 2048; LAS float* vs = ks + 2048; LAS float* gs = vs + 2048; LAS float* bs = gs + 16;
    LAS f32x2* red = (LAS f32x2*)(lds + 32768); LAS float* redkq = (LAS float*)(lds + 32768 + 8192); LAS float* ob = (LAS float*)(lds + 49152);
    float S[32];
#pragma unroll
    for (int i = 0; i < 32; ++i) S[i] = 0.f;
    const int lrow = tid >> 5, lcol = (tid & 31) * 4;
    for (int blk = 0; blk < SEQ / 16; ++blk) {
        const size_t t0 = (size_t)b * SEQ + blk * 16;
        __syncthreads();
        { const bf16* rowp = qkvc + (t0 + lrow) * 4096;
          const v2u qv = *(const v2u*)(rowp + hk * 128 + lcol), kv = *(const v2u*)(rowp + 1024 + hk * 128 + lcol), vv = *(const v2u*)(rowp + 2048 + hv * 128 + lcol);
          *(LAS f32x4*)(qs + lrow * 128 + lcol) = (f32x4){bf_lo(qv.x), bf_hi(qv.x), bf_lo(qv.y), bf_hi(qv.y)};
          *(LAS f32x4*)(ks + lrow * 128 + lcol) = (f32x4){bf_lo(kv.x), bf_hi(kv.x), bf_lo(kv.y), bf_hi(kv.y)};
          *(LAS f32x4*)(vs + lrow * 128 + lcol) = (f32x4){bf_lo(vv.x), bf_hi(vv.x), bf_lo(vv.y), bf_hi(vv.y)};
          if (tid < 16) { gs[tid] = __expf(gb[(t0 + tid) * 32 + hv]); bs[tid] = gb[(t0 + tid) * 32 + 16 + hv]; } }
        __syncthreads();
#pragma unroll 1
        for (int tt = 0; tt < 16; ++tt) {
            float pk = 0.f, pq = 0.f, pkq = 0.f;
#pragma unroll
            for (int i4 = 0; i4 < 8; ++i4) { const f32x4 k4 = *(const LAS f32x4*)(ks + tt * 128 + 32 * r + 4 * i4), q4 = *(const LAS f32x4*)(qs + tt * 128 + 32 * r + 4 * i4);
#pragma unroll
                for (int c = 0; c < 4; ++c) { pk += k4[c] * S[4 * i4 + c]; pq += q4[c] * S[4 * i4 + c]; pkq += k4[c] * q4[c]; } }
            const int buf = tt & 1;
            red[(buf * 4 + r) * 128 + jc] = (f32x2){pk, pq}; if (jc == 0) redkq[buf * 4 + r] = pkq;
            __syncthreads();
            float kS = 0.f, qS = 0.f, kq = 0.f;
#pragma unroll
            for (int rr = 0; rr < 4; ++rr) { const f32x2 p = red[(buf * 4 + rr) * 128 + jc]; kS += p.x; qS += p.y; kq += redkq[buf * 4 + rr]; }
            const float eg = gs[tt], vn = bs[tt] * (vs[tt * 128 + jc] - eg * kS);
#pragma unroll
            for (int i4 = 0; i4 < 8; ++i4) { const f32x4 k4 = *(const LAS f32x4*)(ks + tt * 128 + 32 * r + 4 * i4);
#pragma unroll
                for (int c = 0; c < 4; ++c) S[4 * i4 + c] = eg * S[4 * i4 + c] + k4[c] * vn; }
            if (r == 0) ob[tt * 128 + jc] = eg * qS + kq * vn;
        }
        __syncthreads();
        {
            const f32x4 o4 = *(const LAS f32x4*)(ob + lrow * 128 + lcol);
            float ss = o4[0] * o4[0] + o4[1] * o4[1] + o4[2] * o4[2] + o4[3] * o4[3];
            ss += __shfl_xor(ss, 1); ss += __shfl_xor(ss, 2); ss += __shfl_xor(ss, 4); ss += __shfl_xor(ss, 8); ss += __shfl_xor(ss, 16);
            const float rinv = 1.0f / sqrtf(ss * (1.0f / 128.0f) + RMS_EPS);
            const v2u zv = *(const v2u*)(zb + (t0 + lrow) * 2048 + hv * 128 + lcol);
            const f32x4 nw = *(const f32x4*)(a.gdn_norm_w + j * 128 + lcol);
            const float z0 = bf_lo(zv.x), z1 = bf_hi(zv.x), z2 = bf_lo(zv.y), z3 = bf_hi(zv.y);
            v2u o; o.x = pk2(o4[0] * rinv * nw[0] * z0 * sigmoid_f(z0), o4[1] * rinv * nw[1] * z1 * sigmoid_f(z1));
            o.y = pk2(o4[2] * rinv * nw[2] * z2 * sigmoid_f(z2), o4[3] * rinv * nw[3] * z3 * sigmoid_f(z3));
            *(v2u*)(qkvc + (t0 + lrow) * 4096 + 2048 + hv * 128 + lcol) = o;
        }
    }
}

template <bool ROUTER>
DI void phase_ln(const Args& a, int lnidx, int j, LAS unsigned char* lds, int bid, int G, int tid, int wave, int lane) {
    const float* out = a.out; bf16* HB = (bf16*)(a.ws + WS_HB); float* stats = (float*)(a.ws + WS_STATS);
    const float* g = a.ln_g + (size_t)lnidx * D; const float* bta = a.ln_b + (size_t)lnidx * D;
    const int gw = bid * NWAVES + wave, NGW = G * NWAVES;
    LAS unsigned* lcnt = (LAS unsigned*)lds;
    LAS float* RT = (LAS float*)(lds + 1024);
    if (ROUTER) { if (tid < 8) lcnt[tid] = 0u;
        const float* R = a.moe_router + (size_t)j * D * NE;
#pragma unroll
        for (int i = 0; i < 2; ++i) { const int k = tid + 512 * i; const f32x4 r0 = *(const f32x4*)(R + k * 8), r1 = *(const f32x4*)(R + k * 8 + 4);
            RT[0 * 1024 + k] = r0[0]; RT[1 * 1024 + k] = r0[1]; RT[2 * 1024 + k] = r0[2]; RT[3 * 1024 + k] = r0[3]; RT[4 * 1024 + k] = r1[0]; RT[5 * 1024 + k] = r1[1]; RT[6 * 1024 + k] = r1[2]; RT[7 * 1024 + k] = r1[3]; }
        __syncthreads(); }
    f32x4 gv[4], bv[4];
#pragma unroll
    for (int q = 0; q < 4; ++q) { gv[q] = *(const f32x4*)(g + 4 * (lane + 64 * q)); bv[q] = *(const f32x4*)(bta + 4 * (lane + 64 * q)); }
    f32x4 nx[4];
    if (gw < TT) {
#pragma unroll
        for (int q = 0; q < 4; ++q) nx[q] = ((const f32x4*)(out + (size_t)gw * D))[lane + 64 * q]; }
    for (int t = gw; t < TT; t += NGW) {
        f32x4 v[4]; float s = 0.f;
#pragma unroll
        for (int q = 0; q < 4; ++q) { v[q] = nx[q]; s += (v[q][0] + v[q][1]) + (v[q][2] + v[q][3]); }
        if (t + NGW < TT) {
#pragma unroll
            for (int q = 0; q < 4; ++q) nx[q] = ((const f32x4*)(out + (size_t)(t + NGW) * D))[lane + 64 * q]; }
        const float mean = wave_sum(s) * (1.0f / D); float s2 = 0.f;
#pragma unroll
        for (int q = 0; q < 4; ++q) { v[q] = v[q] - mean; s2 += (v[q][0] * v[q][0] + v[q][1] * v[q][1]) + (v[q][2] * v[q][2] + v[q][3] * v[q][3]); }
        const float rstd = 1.0f / sqrtf(wave_sum(s2) * (1.0f / D) + LN_EPS);
        if (lane == 0) *(f32x2*)(stats + 2 * (size_t)t) = (f32x2){mean, rstd};
#pragma unroll
        for (int q = 0; q < 4; ++q) { v[q] = v[q] * rstd * gv[q] + bv[q];
            v2u o; o.x = pk2(v[q][0], v[q][1]); o.y = pk2(v[q][2], v[q][3]); *(v2u*)(HB + (size_t)t * D + 4 * (lane + 64 * q)) = o; }
        if (ROUTER) {
            float lg[8];
#pragma unroll
            for (int e = 0; e < 8; ++e) { lg[e] = 0.f;
#pragma unroll
                for (int q = 0; q < 4; ++q) { const f32x4 r = *(const LAS f32x4*)(RT + e * 1024 + 4 * (lane + 64 * q));
                    lg[e] += (v[q][0] * r[0] + v[q][1] * r[1]) + (v[q][2] * r[2] + v[q][3] * r[3]); } }
#pragma unroll
            for (int e = 0; e < 8; ++e) lg[e] = wave_sum(lg[e]);
            int i1 = 0; float v1 = lg[0];
#pragma unroll
            for (int e = 1; e < 8; ++e) if (lg[e] > v1) { v1 = lg[e]; i1 = e; }
            int i2 = -1; float v2 = -3.0e38f;
#pragma unroll
            for (int e = 0; e < 8; ++e) if (e != i1 && lg[e] > v2) { v2 = lg[e]; i2 = e; }
            if (lane == 0) {
                const float g1 = 1.0f / (1.0f + __expf(v2 - v1));
                ((unsigned*)(a.ws + WS_E12))[t] = (unsigned)i1 | ((unsigned)i2 << 8);
                ((f32x2*)(a.ws + WS_G12))[t] = (f32x2){g1, 1.0f - g1};
                __hip_atomic_fetch_add(lcnt + i1, 1u, __ATOMIC_RELAXED, __HIP_MEMORY_SCOPE_WORKGROUP); __hip_atomic_fetch_add(lcnt + i2, 1u, __ATOMIC_RELAXED, __HIP_MEMORY_SCOPE_WORKGROUP);
            }
        }
    }
    if (ROUTER) { __syncthreads(); if (tid < 8) { unsigned* cnt = (unsigned*)(a.ws + WS_CTL) + CW_CNT + 256 * j; __hip_atomic_fetch_add(cnt + tid, lcnt[tid], __ATOMIC_RELAXED, __HIP_MEMORY_SCOPE_AGENT); } }
}

DI void phase_sb_naive(const Args& a, LAS unsigned char* lds, int bid, int G, int tid) {
    const bf16* qkv = (const bf16*)(a.ws + WS_QKV); bf16* ao = (bf16*)(a.ws + WS_AO);
    LAS unsigned char* Ks = lds; LAS unsigned char* Vs = lds + 16384;
    const int qi = tid >> 2, r = tid & 3;
    for (int idx = bid; idx < 64 * 32; idx += G) {
        const int qb = 31 - idx / 64, bh = idx % 64, b = bh >> 3, h = bh & 7;
        const int t = qb * 128 + qi;
        const size_t rowq = (size_t)b * SEQ + t;
        float q[32], o[32];
        { const bf16* qp = qkv + rowq * 3072 + h * 128 + 32 * r;
#pragma unroll
          for (int c = 0; c < 4; ++c) { const v4u w = *(const v4u*)(qp + 8 * c);
              q[8 * c + 0] = bf_lo(w.x); q[8 * c + 1] = bf_hi(w.x); q[8 * c + 2] = bf_lo(w.y); q[8 * c + 3] = bf_hi(w.y);
              q[8 * c + 4] = bf_lo(w.z); q[8 * c + 5] = bf_hi(w.z); q[8 * c + 6] = bf_lo(w.w); q[8 * c + 7] = bf_hi(w.w); }
#pragma unroll
          for (int i = 0; i < 32; ++i) { q[i] *= 0.08838834764831845f; o[i] = 0.f; } }
        float P = 1.0f;
        for (int kt = 2 * qb + 1; kt >= 0; --kt) {
            __syncthreads();
#pragma unroll
            for (int i = 0; i < 2; ++i) { const int c = tid + 512 * i, row = c >> 4, part = c & 15;
                const bf16* src = qkv + ((size_t)b * SEQ + kt * 64 + row) * 3072 + h * 128 + part * 8;
                *(LAS v4u*)(Ks + c * 16) = *(const v4u*)(src + 1024); *(LAS v4u*)(Vs + c * 16) = *(const v4u*)(src + 2048); }
            __syncthreads();
#pragma unroll 1
            for (int s = 63; s >= 0; --s) {
                float z = 0.f;
#pragma unroll
                for (int c = 0; c < 4; ++c) { const v4u w = *(const LAS v4u*)(Ks + s * 256 + r * 64 + c * 16);
                    z += q[8 * c + 0] * bf_lo(w.x) + q[8 * c + 1] * bf_hi(w.x) + q[8 * c + 2] * bf_lo(w.y) + q[8 * c + 3] * bf_hi(w.y)
                       + q[8 * c + 4] * bf_lo(w.z) + q[8 * c + 5] * bf_hi(w.z) + q[8 * c + 6] * bf_lo(w.w) + q[8 * c + 7] * bf_hi(w.w); }
                z += __shfl_xor(z, 1); z += __shfl_xor(z, 2);
                const bool live = (kt * 64 + s) < t;
                const float e = __expf(fminf(z, 80.f)), rr = 1.0f / (1.0f + e);
                const float A = live ? e * rr * P : 0.f;
                P = live ? P * rr : P;
#pragma unroll
                for (int c = 0; c < 4; ++c) { const v4u w = *(const LAS v4u*)(Vs + s * 256 + r * 64 + c * 16);
                    o[8 * c + 0] += A * bf_lo(w.x); o[8 * c + 1] += A * bf_hi(w.x); o[8 * c + 2] += A * bf_lo(w.y); o[8 * c + 3] += A * bf_hi(w.y);
                    o[8 * c + 4] += A * bf_lo(w.z); o[8 * c + 5] += A * bf_hi(w.z); o[8 * c + 6] += A * bf_lo(w.w); o[8 * c + 7] += A * bf_hi(w.w); }
            }
        }
        { bf16* op = ao + rowq * 1024 + h * 128 + 32 * r;
#pragma unroll
          for (int c = 0; c < 4; ++c) { v4u w; w.x = pk2(o[8 * c + 0], o[8 * c + 1]); w.y = pk2(o[8 * c + 2], o[8 * c + 3]); w.z = pk2(o[8 * c + 4], o[8 * c + 5]); w.w = pk2(o[8 * c + 6], o[8 * c + 7]);
              *(v4u*)(op + 8 * c) = w; } }
    }
}


namespace sba {
using bf16x8 = __attribute__((ext_vector_type(8))) short;
using s16x4  = __attribute__((ext_vector_type(4))) short;
using f32x16 = __attribute__((ext_vector_type(16))) float;
constexpr int SHM_V = 16384, SHM_K = 16384, LDQ = 3072;
#define KSWZ(row, colB) ((row) * 256 + ((colB) ^ (((row) & 7) << 4)))
#define SBAR() __builtin_amdgcn_sched_barrier(0)
DI int crow(int r, int hi) { return (r & 3) + 8 * (r >> 2) + 4 * hi; }
DI int v_st(int k, int c) { const int kk = (k & ~0xC) | ((k & 4) << 1) | ((k & 8) >> 1); return ((kk >> 3) * 4 + (c >> 5)) * 512 + ((kk & 7) * 32 + (c & 31)) * 2; }
DI int v_rd_base(int lane) { return ((lane & 3) << 3) | (((lane >> 2) & 3) << 6) | (((lane >> 4) & 1) << 5) | (((lane >> 5) & 1) << 8); }
constexpr int v_rd_off(int d0, int ks, int half) { return d0 * 512 + ks * 4096 + half * 2048; }
template <int OFF> DI s16x4 tr_read(int vb) { s16x4 r; asm volatile("ds_read_b64_tr_b16 %0, %1 offset:%2" : "=&v"(r) : "v"(vb), "i"(OFF) : "memory"); return r; }
template <int D0> DI void pv_one(f32x16& od, int vb, bf16x8 pa0, bf16x8 pa1, bf16x8 pa2, bf16x8 pa3) {
  const s16x4 l0 = tr_read<v_rd_off(D0, 0, 0)>(vb), h0 = tr_read<v_rd_off(D0, 0, 1)>(vb), l1 = tr_read<v_rd_off(D0, 1, 0)>(vb), h1 = tr_read<v_rd_off(D0, 1, 1)>(vb);
  const s16x4 l2 = tr_read<v_rd_off(D0, 2, 0)>(vb), h2 = tr_read<v_rd_off(D0, 2, 1)>(vb), l3 = tr_read<v_rd_off(D0, 3, 0)>(vb), h3 = tr_read<v_rd_off(D0, 3, 1)>(vb);
  asm volatile("s_waitcnt lgkmcnt(0)" ::: "memory"); SBAR();
#define PK(L, H) (bf16x8){L[0], L[1], L[2], L[3], H[0], H[1], H[2], H[3]}
  od = __builtin_amdgcn_mfma_f32_32x32x16_bf16(pa0, PK(l0, h0), od, 0, 0, 0);
  od = __builtin_amdgcn_mfma_f32_32x32x16_bf16(pa1, PK(l1, h1), od, 0, 0, 0);
  od = __builtin_amdgcn_mfma_f32_32x32x16_bf16(pa2, PK(l2, h2), od, 0, 0, 0);
  od = __builtin_amdgcn_mfma_f32_32x32x16_bf16(pa3, PK(l3, h3), od, 0, 0, 0);
#undef PK
}
template <int D0> DI void pv_one_T(f32x16& od, int vb, bf16x8 pa0, bf16x8 pa1, bf16x8 pa2, bf16x8 pa3) {
  const s16x4 l0 = tr_read<v_rd_off(D0, 0, 0)>(vb), h0 = tr_read<v_rd_off(D0, 0, 1)>(vb), l1 = tr_read<v_rd_off(D0, 1, 0)>(vb), h1 = tr_read<v_rd_off(D0, 1, 1)>(vb);
  const s16x4 l2 = tr_read<v_rd_off(D0, 2, 0)>(vb), h2 = tr_read<v_rd_off(D0, 2, 1)>(vb), l3 = tr_read<v_rd_off(D0, 3, 0)>(vb), h3 = tr_read<v_rd_off(D0, 3, 1)>(vb);
  asm volatile("s_waitcnt lgkmcnt(0)" ::: "memory"); SBAR();
#define PK(L, H) (bf16x8){L[0], L[1], L[2], L[3], H[0], H[1], H[2], H[3]}
  od = __builtin_amdgcn_mfma_f32_32x32x16_bf16(PK(l0, h0), pa0, od, 0, 0, 0);
  od = __builtin_amdgcn_mfma_f32_32x32x16_bf16(PK(l1, h1), pa1, od, 0, 0, 0);
  od = __builtin_amdgcn_mfma_f32_32x32x16_bf16(PK(l2, h2), pa2, od, 0, 0, 0);
  od = __builtin_amdgcn_mfma_f32_32x32x16_bf16(PK(l3, h3), pa3, od, 0, 0, 0);
#undef PK
}
DI void pv_split(f32x16& od, int vb, bf16x8 pa0, bf16x8 pa1, bf16x8 pa2, bf16x8 pa3) {
  const s16x4 l0 = tr_read<v_rd_off(0, 0, 0)>(vb), h0 = tr_read<v_rd_off(0, 0, 1)>(vb), l1 = tr_read<v_rd_off(0, 1, 0)>(vb), h1 = tr_read<v_rd_off(0, 1, 1)>(vb);
  const s16x4 l2 = tr_read<v_rd_off(0, 2, 0)>(vb), h2 = tr_read<v_rd_off(0, 2, 1)>(vb), l3 = tr_read<v_rd_off(0, 3, 0)>(vb), h3 = tr_read<v_rd_off(0, 3, 1)>(vb);
  asm volatile("s_waitcnt lgkmcnt(0)" ::: "memory"); SBAR();
#define PK(L, H) (bf16x8){L[0], L[1], L[2], L[3], H[0], H[1], H[2], H[3]}
  f32x16 ob = {};
  od = __builtin_amdgcn_mfma_f32_32x32x16_bf16(pa0, PK(l0, h0), od, 0, 0, 0); ob = __builtin_amdgcn_mfma_f32_32x32x16_bf16(pa2, PK(l2, h2), ob, 0, 0, 0);
  od = __builtin_amdgcn_mfma_f32_32x32x16_bf16(pa1, PK(l1, h1), od, 0, 0, 0); ob = __builtin_amdgcn_mfma_f32_32x32x16_bf16(pa3, PK(l3, h3), ob, 0, 0, 0);
  od = od + ob;
#undef PK
}
DI void pv_split_T(f32x16& od, int vb, bf16x8 pa0, bf16x8 pa1, bf16x8 pa2, bf16x8 pa3) {
  const s16x4 l0 = tr_read<v_rd_off(0, 0, 0)>(vb), h0 = tr_read<v_rd_off(0, 0, 1)>(vb), l1 = tr_read<v_rd_off(0, 1, 0)>(vb), h1 = tr_read<v_rd_off(0, 1, 1)>(vb);
  const s16x4 l2 = tr_read<v_rd_off(0, 2, 0)>(vb), h2 = tr_read<v_rd_off(0, 2, 1)>(vb), l3 = tr_read<v_rd_off(0, 3, 0)>(vb), h3 = tr_read<v_rd_off(0, 3, 1)>(vb);
  asm volatile("s_waitcnt lgkmcnt(0)" ::: "memory"); SBAR();
#define PK(L, H) (bf16x8){L[0], L[1], L[2], L[3], H[0], H[1], H[2], H[3]}
  f32x16 ob = {};
  od = __builtin_amdgcn_mfma_f32_32x32x16_bf16(PK(l0, h0), pa0, od, 0, 0, 0); ob = __builtin_amdgcn_mfma_f32_32x32x16_bf16(PK(l2, h2), pa2, ob, 0, 0, 0);
  od = __builtin_amdgcn_mfma_f32_32x32x16_bf16(PK(l1, h1), pa1, od, 0, 0, 0); ob = __builtin_amdgcn_mfma_f32_32x32x16_bf16(PK(l3, h3), pa3, ob, 0, 0, 0);
  od = od + ob;
#undef PK
}
DI void qkt(f32x16& p0, f32x16& p1, const LAS unsigned char* Ks, const bf16x8 (&qr)[8], int r32, int hi) {
  p0 = f32x16{}; p1 = f32x16{};
#pragma unroll
  for (int d0 = 0; d0 < 8; ++d0) { const int cb = (d0 * 16 + hi * 8) * 2;
    const bf16x8 b0 = *(const LAS bf16x8*)(Ks + KSWZ(r32, cb));
    const bf16x8 b1 = *(const LAS bf16x8*)(Ks + KSWZ(32 + r32, cb));
    p0 = __builtin_amdgcn_mfma_f32_32x32x16_bf16(b0, qr[d0], p0, 0, 0, 0);
    p1 = __builtin_amdgcn_mfma_f32_32x32x16_bf16(b1, qr[d0], p1, 0, 0, 0); }
}
template <bool MASK> DI void sb_half(f32x16& p, float& Pc, int hi, int kbase, int trow) {
  constexpr float C = 0.08838834764831845f * 1.4426950408889634f;
  float rr[16];
#pragma unroll
  for (int r = 0; r < 16; ++r) {
    float z = p[r] * C;
    if (MASK) z = (kbase + crow(r, hi) < trow) ? z : -__builtin_inff();
    const float k = __builtin_amdgcn_rcpf(1.0f + __builtin_amdgcn_exp2f(z));
    rr[r] = k; p[r] = 1.0f - k;
  }
  float R0[4], R1[4];
#pragma unroll
  for (int g = 0; g < 4; ++g) {
    const float c2 = rr[4 * g + 3], c1 = c2 * rr[4 * g + 2], c0 = c1 * rr[4 * g + 1], R = c0 * rr[4 * g];
    rr[4 * g + 2] = c2; rr[4 * g + 1] = c1; rr[4 * g] = c0;
    const auto sw = __builtin_amdgcn_permlane32_swap(__float_as_uint(R), __float_as_uint(R), false, false);
    R0[g] = __uint_as_float(sw[0]); R1[g] = __uint_as_float(sw[1]);
  }
#pragma unroll
  for (int g = 3; g >= 0; --g) {
    const float Pin = hi ? Pc : Pc * R1[g];
    p[4 * g + 3] *= Pin; p[4 * g + 2] *= Pin * rr[4 * g + 2]; p[4 * g + 1] *= Pin * rr[4 * g + 1]; p[4 * g] *= Pin * rr[4 * g];
    Pc *= R0[g] * R1[g];
  }
}
DI unsigned cvtpk(float lo, float hi) { unsigned r; asm volatile("v_cvt_pk_bf16_f32 %0, %1, %2" : "=v"(r) : "v"(lo), "v"(hi)); return r; }
#define PK4(P, BASE, OUT) do { const unsigned a0 = cvtpk(P[BASE + 0], P[BASE + 1]), a1 = cvtpk(P[BASE + 2], P[BASE + 3]);   \
    const unsigned b0 = cvtpk(P[BASE + 4], P[BASE + 5]), b1 = cvtpk(P[BASE + 6], P[BASE + 7]);                              \
    const auto r0 = __builtin_amdgcn_permlane32_swap(a0, b0, false, false); const auto r1 = __builtin_amdgcn_permlane32_swap(a1, b1, false, false); \
    const v4u w = {r0[0], r1[0], r0[1], r1[1]}; OUT = __builtin_bit_cast(bf16x8, w); } while (0)

DI void unit(const bf16* qkv, bf16* ao, int b, int h, int qb, LAS unsigned char* lds, int tid) {
  const int wid = __builtin_amdgcn_readfirstlane(tid >> 6), lane = tid & 63, r32 = lane & 31, hi = lane >> 5;
  LAS unsigned char* V_lds = lds; LAS unsigned char* K_lds = lds + 2 * SHM_V;
  const size_t rowbase = (size_t)b * SEQ; const int q0 = qb * 256, t_lo = q0 + wid * 32, trow = t_lo + r32;
  bf16x8 qr[8];
  { const bf16* Qw = qkv + (rowbase + trow) * LDQ + h * 128 + hi * 8;
#pragma unroll
    for (int d0 = 0; d0 < 8; ++d0) qr[d0] = *(const bf16x8*)(Qw + d0 * 16); }
  const bf16* Kh = qkv + rowbase * LDQ + 1024 + h * 128; const bf16* Vh = Kh + 1024;
  const int sr = tid >> 4, sc = (tid & 15) * 8, vst0 = v_st(sr, sc), vst1 = v_st(32 + sr, sc);
  const int vb0 = (int)(unsigned)(size_t)V_lds + v_rd_base(lane);
  bf16x8 vs0, vs1, ks0, ks1;
#define SLOAD(k0) do { vs0 = *(const bf16x8*)(Vh + (size_t)((k0) + sr) * LDQ + sc); vs1 = *(const bf16x8*)(Vh + (size_t)((k0) + 32 + sr) * LDQ + sc); \
    ks0 = *(const bf16x8*)(Kh + (size_t)((k0) + sr) * LDQ + sc); ks1 = *(const bf16x8*)(Kh + (size_t)((k0) + 32 + sr) * LDQ + sc); } while (0)
#define SWRITE(bb) do { *(LAS bf16x8*)(V_lds + (bb) * SHM_V + vst0) = vs0; *(LAS bf16x8*)(V_lds + (bb) * SHM_V + vst1) = vs1; const int kc = sc * 2; \
    *(LAS bf16x8*)(K_lds + (bb) * SHM_K + KSWZ(sr, kc)) = ks0; *(LAS bf16x8*)(K_lds + (bb) * SHM_K + KSWZ(32 + sr, kc)) = ks1; } while (0)
  f32x16 o[4] = {}; float Pc = 1.0f;
  const int kt_max = qb * 4 + 3;
  SLOAD(kt_max * 64);
  for (int kt = kt_max; kt >= 0; --kt) {
    const int buf = kt & 1, k0 = kt * 64;
    asm volatile("s_waitcnt vmcnt(0)" ::: "memory");
    SWRITE(buf);
    if (kt > 0) SLOAD(k0 - 64);
    __syncthreads();
    if (k0 < t_lo + 31) {
      f32x16 p0, p1;
      qkt(p0, p1, K_lds + buf * SHM_K, qr, r32, hi);
      if (k0 + 63 >= t_lo) { sb_half<true>(p1, Pc, hi, k0 + 32, trow); sb_half<true>(p0, Pc, hi, k0, trow); }
      else { sb_half<false>(p1, Pc, hi, k0 + 32, trow); sb_half<false>(p0, Pc, hi, k0, trow); }
      bf16x8 pa0, pa1, pa2, pa3;
      PK4(p0, 0, pa0); PK4(p0, 8, pa1); PK4(p1, 0, pa2); PK4(p1, 8, pa3);
      const int vb = vb0 + buf * SHM_V;
      pv_one<0>(o[0], vb, pa0, pa1, pa2, pa3); pv_one<1>(o[1], vb, pa0, pa1, pa2, pa3); pv_one<2>(o[2], vb, pa0, pa1, pa2, pa3); pv_one<3>(o[3], vb, pa0, pa1, pa2, pa3);
    }
  }
  bf16* Ow = ao + (rowbase + t_lo) * 1024 + h * 128 + r32;
#pragma unroll
  for (int r = 0; r < 16; ++r) { const int orow = crow(r, hi);
#pragma unroll
    for (int d0 = 0; d0 < 4; ++d0) Ow[(size_t)orow * 1024 + d0 * 32] = (bf16)(cvtpk(o[d0][r], 0.f) & 0xffffu); }
#undef SLOAD
#undef SWRITE
}
#undef PK4
#undef KSWZ
#undef SBAR
}
DI void phase_sb_mfma(const Args& a, LAS unsigned char* lds, int bid, int G, int tid) {
    const bf16* qkv = (const bf16*)(a.ws + WS_QKV); bf16* ao = (bf16*)(a.ws + WS_AO);
    const int vcu = (G % 8 == 0) ? (bid % 8) * (G / 8) + bid / 8 : bid;
    for (int pi = vcu; pi < 512; pi += G) {
        const int bh = pi >> 3, p = pi & 7, b = bh >> 3, h = bh & 7;
        sba::unit(qkv, ao, b, h, 15 - p, lds, tid);
        sba::unit(qkv, ao, b, h, p, lds, tid);
    }
}


namespace gdn {
using bf16x8 = __attribute__((ext_vector_type(8))) short;
using s16x4  = __attribute__((ext_vector_type(4))) short;
using f32x16 = __attribute__((ext_vector_type(16))) float;
typedef float f2v __attribute__((ext_vector_type(2)));
typedef __bf16 b2v __attribute__((ext_vector_type(2)));
DI unsigned pk(float a, float b) { const f2v v = {a, b}; const b2v r = __builtin_convertvector(v, b2v); return __builtin_bit_cast(unsigned, r); }
DI int crow(int r, int hi) { return (r & 3) + 8 * (r >> 2) + 4 * hi; }
DI int pi_slot(int x) { return 8 * ((x >> 2) & 3) + 4 * ((x >> 4) & 1) + (x & 3); }
DI bf16x8 pack_step(const f32x16& x, int s) {
    v4u w; w.x = pk(x[8 * s + 0], x[8 * s + 1]); w.y = pk(x[8 * s + 2], x[8 * s + 3]); w.z = pk(x[8 * s + 4], x[8 * s + 5]); w.w = pk(x[8 * s + 6], x[8 * s + 7]);
    return __builtin_bit_cast(bf16x8, w);
}
DI f32x16 mm(const f32x16& P, const f32x16& Q, f32x16 acc) {
    acc = __builtin_amdgcn_mfma_f32_32x32x16_bf16(pack_step(P, 0), pack_step(Q, 0), acc, 0, 0, 0);
    acc = __builtin_amdgcn_mfma_f32_32x32x16_bf16(pack_step(P, 1), pack_step(Q, 1), acc, 0, 0, 0);
    return acc;
}
#define GPK4(P, BASE, OUT) do { const unsigned a0 = pk(P[BASE + 0], P[BASE + 1]), a1 = pk(P[BASE + 2], P[BASE + 3]);   \
    const unsigned b0 = pk(P[BASE + 4], P[BASE + 5]), b1 = pk(P[BASE + 6], P[BASE + 7]);                              \
    const auto r0 = __builtin_amdgcn_permlane32_swap(a0, b0, false, false); const auto r1 = __builtin_amdgcn_permlane32_swap(a1, b1, false, false); \
    const v4u w_ = {r0[0], r1[0], r0[1], r1[1]}; OUT = __builtin_bit_cast(bf16x8, w_); } while (0)

DI void local_unit(const Args& a, int unit, LAS unsigned char* img, LAS float* tab, int lane, bool dry) {
    const int r32 = lane & 31, hi = lane >> 5;
    const int chunk = unit & 63, bh = unit >> 6, hv = bh & 15, b = bh >> 4, hk = hv >> 1;
    const size_t t0 = (size_t)b * SEQ + chunk * 64;
    bf16* qkvc = (bf16*)(a.ws + WS_QKVC); const float* gb = (const float*)(a.ws + WS_GB);
    bf16* wmem = (bf16*)(a.ws + WS_WMEM) + (size_t)unit * 8192; bf16* imem = (bf16*)(a.ws + WS_IMEM) + (size_t)unit * 4096;
    bf16* ktmem = (bf16*)(a.ws + WS_KTMEM) + (size_t)((b * HK + hk) * 64 + chunk) * 8192; float* gtab = (float*)(a.ws + WS_GTAB) + (size_t)unit * 192;
    SEC_IN(1);
    float gc = gb[(t0 + lane) * 32 + hv]; const float be = gb[(t0 + lane) * 32 + 16 + hv];
#pragma unroll
    for (int off = 1; off < 64; off <<= 1) { const float y = __shfl_up(gc, off); if (lane >= off) gc += y; }
    const float glast = __shfl(gc, 63);
    tab[lane] = gc; tab[64 + lane] = be; tab[128 + lane] = -be * __expf(gc);
    gtab[lane] = __expf(gc); gtab[64 + lane] = __expf(glast - gc); if (lane == 0) gtab[128] = __expf(glast);
    const bf16* kbase = qkvc + t0 * 4096 + 1024 + hk * 128; const bf16* qbase = qkvc + t0 * 4096 + hk * 128; bf16* vbase = qkvc + t0 * 4096 + 2048 + hv * 128;
#define GSB() __builtin_amdgcn_sched_barrier(0)
    {
        f32x16 IT00 = {}, IT11 = {}, IT01 = {};
#pragma unroll
        for (int s = 0; s < 8; ++s) {
            const bf16x8 k0 = *(const bf16x8*)(kbase + (size_t)r32 * 4096 + 16 * s + 8 * hi), k1 = *(const bf16x8*)(kbase + (size_t)(32 + r32) * 4096 + 16 * s + 8 * hi);
            const bf16x8 q0 = *(const bf16x8*)(qbase + (size_t)r32 * 4096 + 16 * s + 8 * hi), q1 = *(const bf16x8*)(qbase + (size_t)(32 + r32) * 4096 + 16 * s + 8 * hi);
            IT00 = __builtin_amdgcn_mfma_f32_32x32x16_bf16(k0, q0, IT00, 0, 0, 0); IT11 = __builtin_amdgcn_mfma_f32_32x32x16_bf16(k1, q1, IT11, 0, 0, 0);
            IT01 = __builtin_amdgcn_mfma_f32_32x32x16_bf16(k0, q1, IT01, 0, 0, 0);
        }
#pragma unroll
        for (int I = 0; I < 2; ++I) { const int c = 32 * I + r32; const float gcc = tab[c];
#pragma unroll
            for (int J = 0; J < 2; ++J)
#pragma unroll
                for (int g = 0; g < 4; ++g) { float v[4];
#pragma unroll
                    for (int i = 0; i < 4; ++i) { const int r = 4 * g + i, cp = 32 * J + crow(r, hi);
                        const float raw = (I == 0) ? (J == 0 ? IT00[r] : 0.f) : (J == 0 ? IT01[r] : IT11[r]);
                        const float val = raw * __expf(-fabsf(gcc - tab[cp])); v[i] = (c >= cp) ? val : 0.f; }
                    v2u o; o.x = pk(v[0], v[1]); o.y = pk(v[2], v[3]);
                    *(v2u*)(imem + (unsigned)((((I * 2 + J) * 4 + g) * 64 + lane) * 4)) = o; } }
    }
    GSB();
    SEC_OUT(1); SEC_IN(2);
    f32x16 T1, T1T, T2T, T21T;
    {
        f32x16 KK = {};
#pragma unroll
        for (int s = 0; s < 8; ++s) { const bf16x8 k0 = *(const bf16x8*)(kbase + (size_t)r32 * 4096 + 16 * s + 8 * hi); KK = __builtin_amdgcn_mfma_f32_32x32x16_bf16(k0, k0, KK, 0, 0, 0); }
        f32x16 M, MT;
        { const float gb0 = tab[r32], bb0 = tab[64 + r32];
#pragma unroll
        for (int r = 0; r < 16; ++r) { const int a0 = crow(r, hi), b0 = r32; const float ke = -KK[r] * __expf(-fabsf(tab[a0] - gb0));
            const float nv = ke * tab[64 + a0], ntv = ke * bb0;
            const float n = (a0 > b0) ? nv : 0.f, nt = (b0 > a0) ? ntv : 0.f, id = (a0 == b0) ? 1.f : 0.f;
            M[r] = n; MT[r] = nt; T1[r] = id + n; T1T[r] = id + nt; } }
#pragma unroll
        for (int it = 0; it < 4; ++it) { const f32x16 z = {};
            const f32x16 Mn = mm(MT, M, z), MTn = mm(M, MT, z);
            const f32x16 Tn = mm(T1T, Mn, T1);
            T1T = mm(Mn, T1T, T1T);
            T1 = Tn; M = Mn; MT = MTn; }
    }
    GSB();
    {
        f32x16 KK = {};
#pragma unroll
        for (int s = 0; s < 8; ++s) { const bf16x8 k1 = *(const bf16x8*)(kbase + (size_t)(32 + r32) * 4096 + 16 * s + 8 * hi); KK = __builtin_amdgcn_mfma_f32_32x32x16_bf16(k1, k1, KK, 0, 0, 0); }
        f32x16 M, MT;
        { const float gb0 = tab[32 + r32], bb0 = tab[96 + r32];
#pragma unroll
        for (int r = 0; r < 16; ++r) { const int a0 = crow(r, hi), b0 = r32; const float ke = -KK[r] * __expf(-fabsf(tab[32 + a0] - gb0));
            const float nv = ke * tab[96 + a0], ntv = ke * bb0;
            const float n = (a0 > b0) ? nv : 0.f, nt = (b0 > a0) ? ntv : 0.f, id = (a0 == b0) ? 1.f : 0.f;
            M[r] = n; MT[r] = nt; T2T[r] = id + nt; } }
#pragma unroll
        for (int it = 0; it < 4; ++it) { const f32x16 z = {};
            const f32x16 Mn = mm(MT, M, z), MTn = mm(M, MT, z);
            T2T = mm(Mn, T2T, T2T);
            M = Mn; MT = MTn; }
    }
    GSB();
    {
        f32x16 L21 = {};
#pragma unroll
        for (int s = 0; s < 8; ++s) { const bf16x8 k0 = *(const bf16x8*)(kbase + (size_t)r32 * 4096 + 16 * s + 8 * hi), k1 = *(const bf16x8*)(kbase + (size_t)(32 + r32) * 4096 + 16 * s + 8 * hi);
            L21 = __builtin_amdgcn_mfma_f32_32x32x16_bf16(k1, k0, L21, 0, 0, 0); }
#pragma unroll
        for (int r = 0; r < 16; ++r) { const int a0 = crow(r, hi); L21[r] = L21[r] * tab[96 + a0] * __expf(tab[32 + a0] - tab[r32]); }
        const f32x16 z = {}; const f32x16 Y = mm(L21, T2T, z); T21T = mm(T1, Y, z);
#pragma unroll
        for (int r = 0; r < 16; ++r) T21T[r] = -T21T[r];
    }
    GSB();
    SEC_OUT(2); SEC_IN(3);
    const int vb = (int)(unsigned)(size_t)img + sba::v_rd_base(lane);
    bf16* ubl = dry ? (bf16*)(a.ws + WS_END) + (size_t)(unit & 63) * 64 * 4096 : vbase;
#pragma unroll 1
    for (int mode = 0; mode < 2; ++mode) {
        const bf16* src = mode == 0 ? (const bf16*)vbase : kbase;
#pragma unroll 4
        for (int it = 0; it < 16; ++it) { const int row = (lane >> 4) + 4 * it, col = (lane & 15) * 8;
            *(LAS v4u*)(img + sba::v_st(row, col)) = *(const v4u*)(src + (size_t)row * 4096 + col); }
        LAS float* sc = tab + (mode == 0 ? 64 : 128);
#pragma unroll 1
        for (int I = 0; I < 2; ++I) {
            bf16x8 pa0, pa1, pa2, pa3;
            { f32x16 X;
#pragma unroll
              for (int r = 0; r < 16; ++r) X[r] = (I ? T21T[r] : T1T[r]) * sc[crow(r, hi)];
              GPK4(X, 0, pa0); GPK4(X, 8, pa1);
              { const float on = I ? 1.0f : 0.0f;
#pragma unroll
              for (int r = 0; r < 16; ++r) X[r] = T2T[r] * (sc[32 + crow(r, hi)] * on); }
              GPK4(X, 0, pa2); GPK4(X, 8, pa3); }
#pragma unroll 1
            for (int d0 = 0; d0 < 4; ++d0) {
                f32x16 od = {};
                if (mode == 0) { sba::pv_split(od, vb + d0 * 512, pa0, pa1, pa2, pa3);
                    const unsigned e0 = (unsigned)(((I * 32 + 8 * d0 + (lane >> 5)) * 4096) + (lane & 31) * 4);
#pragma unroll
                    for (int g = 0; g < 4; ++g) { v2u w; w.x = pk(od[4 * g + 0], od[4 * g + 1]); w.y = pk(od[4 * g + 2], od[4 * g + 3]); *(v2u*)(ubl + e0 + (unsigned)(g * 8192)) = w; }
                } else { sba::pv_split_T(od, vb + d0 * 512, pa0, pa1, pa2, pa3);
                    bf16* wp = wmem + (unsigned)((((I * 4 + d0) * 4) * 64 + lane) * 4);
#pragma unroll
                    for (int g = 0; g < 4; ++g) { v2u w; w.x = pk(od[4 * g + 0], od[4 * g + 1]); w.y = pk(od[4 * g + 2], od[4 * g + 3]); *(v2u*)(wp + g * 256) = w; }
                }
                GSB();
            }
        }
        if (mode == 1) {
            const int Ik = hv & 1;
            v4u idw0, idw1;
            { const int d0_ = r32 - 8 * hi, d1_ = r32 - 16 - 8 * hi;
              idw0.x = (d0_ == 0 ? 0x3f80u : 0u) | (d0_ == 1 ? 0x3f800000u : 0u); idw0.y = (d0_ == 2 ? 0x3f80u : 0u) | (d0_ == 3 ? 0x3f800000u : 0u);
              idw0.z = (d0_ == 4 ? 0x3f80u : 0u) | (d0_ == 5 ? 0x3f800000u : 0u); idw0.w = (d0_ == 6 ? 0x3f80u : 0u) | (d0_ == 7 ? 0x3f800000u : 0u);
              idw1.x = (d1_ == 0 ? 0x3f80u : 0u) | (d1_ == 1 ? 0x3f800000u : 0u); idw1.y = (d1_ == 2 ? 0x3f80u : 0u) | (d1_ == 3 ? 0x3f800000u : 0u);
              idw1.z = (d1_ == 4 ? 0x3f80u : 0u) | (d1_ == 5 ? 0x3f800000u : 0u); idw1.w = (d1_ == 6 ? 0x3f80u : 0u) | (d1_ == 7 ? 0x3f800000u : 0u); }
            const bf16x8 id0 = __builtin_bit_cast(bf16x8, idw0), id1 = __builtin_bit_cast(bf16x8, idw1), zf = (bf16x8){};
            const bf16x8 pa0 = Ik ? zf : id0, pa1 = Ik ? zf : id1, pa2 = Ik ? id0 : zf, pa3 = Ik ? id1 : zf;
#pragma unroll 1
            for (int d0 = 0; d0 < 4; ++d0) {
                f32x16 od = {}; sba::pv_split(od, vb + d0 * 512, pa0, pa1, pa2, pa3);
                bf16* kp = ktmem + (unsigned)((((Ik * 4 + d0) * 4) * 64 + lane) * 4);
#pragma unroll
                for (int g = 0; g < 4; ++g) { v2u w; w.x = pk(od[4 * g + 0], od[4 * g + 1]); w.y = pk(od[4 * g + 2], od[4 * g + 3]); *(v2u*)(kp + g * 256) = w; }
                GSB();
            }
        }
    }
    SEC_OUT(3);
#undef GSB
}
#undef GPK4
}
DI void phase_gdn_local(const Args& a, LAS unsigned char* lds, int bid, int G, int wave, int lane, bool dry) {
    LAS unsigned char* img = lds + wave * 16384; LAS float* tab = (LAS float*)(lds + RING_BYTES + 4096 + wave * 1024);
    const int gw = bid * NWAVES + wave, NGW = G * NWAVES;
    for (int unit = gw; unit < BATCH * HV * 64; unit += NGW) gdn::local_unit(a, unit, img, tab, lane, dry);
}
namespace gdn {
constexpr int PW = 272, PI = 144;
constexpr int L_W = 0, L_Q = 64 * PW, L_I = 2 * 64 * PW, L_K = L_I + 64 * PI, L_G = L_K + 128 * PI, L_BUF = L_G + 768;
constexpr int L_PART = 2 * L_BUF;
static_assert(L_PART + 4096 <= RING_BYTES, "scan LDS map");
}
DI void phase_gdn_scan(const Args& a, int j, LAS unsigned char* lds, int bid, int tid, bool dry) {
    if (bid >= BATCH * HV) return;
    using gdn::bf16x8; using gdn::pk; using namespace gdn;
    typedef float f4v __attribute__((ext_vector_type(4)));
    const int wave = __builtin_amdgcn_readfirstlane(tid >> 6), lane = tid & 63, n = lane & 15, kq = lane >> 4;
    const int b = bid / HV, hv = bid % HV, hk = hv >> 1;
    bf16* qkvc = (bf16*)(a.ws + WS_QKVC); const bf16* zb = (const bf16*)(a.ws + WS_ZB);
    LAS float* part = (LAS float*)(lds + L_PART); LAS unsigned char* stg = lds + OGST_OFF;
    const int unit0 = (b * HV + hv) * 64, hku0 = (b * HK + hk) * 64; const size_t tb0 = (size_t)b * SEQ;
    if (wave >= 4) {
        const int st = tid - 256;
        v4u rw[4], rq[4], ri[2], rk[4], rz[4]; float rg = 0.f;
#define SV_RUN2(dst, base, o0) do { const v2u a_ = *(const v2u*)((base) + (o0)), b_ = *(const v2u*)((base) + (o0) + 2 * 64 * 4); dst = (v4u){a_.x, a_.y, b_.x, b_.y}; } while (0)
#define SV_LOAD(ch) do { const int u_ = unit0 + (ch); const size_t t_ = tb0 + (size_t)(ch) * 64; \
        const bf16* wm_ = (const bf16*)(a.ws + WS_WMEM) + (size_t)u_ * 8192; const bf16* im_ = (const bf16*)(a.ws + WS_IMEM) + (size_t)u_ * 4096; \
        const bf16* kt_ = (const bf16*)(a.ws + WS_KTMEM) + (size_t)(hku0 + (ch)) * 8192; const bf16* qb_ = qkvc + t_ * 4096 + hk * 128; const bf16* zr_ = zb + t_ * 2048 + hv * 128; \
        _Pragma("unroll") for (int k = 0; k < 4; ++k) { const int c = st + 256 * k; \
            { const int row = c & 63, p = c >> 6, pp = p & 3; SV_RUN2(rw[k], wm_, (((((row >> 5) * 4 + (p >> 2)) * 4 + (pp >> 1)) * 64 + (pp & 1) * 32 + (row & 31)) * 4)); }     \
            { const int dk = c & 127, p = c >> 7, pp = p & 3; SV_RUN2(rk[k], kt_, (((((p >> 2) * 4 + (dk >> 5)) * 4 + (pp >> 1)) * 64 + (pp & 1) * 32 + (dk & 31)) * 4)); }         \
            rq[k] = *(const v4u*)(qb_ + (size_t)(c >> 4) * 4096 + (c & 15) * 8); rz[k] = *(const v4u*)(zr_ + (size_t)(c >> 4) * 2048 + (c & 15) * 8); } \
        _Pragma("unroll") for (int k = 0; k < 2; ++k) { const int c = st + 256 * k; const int row = c & 63, p = c >> 6, pp = p & 3; \
            SV_RUN2(ri[k], im_, (((((row >> 5) * 2 + (p >> 2)) * 4 + (pp >> 1)) * 64 + (pp & 1) * 32 + (row & 31)) * 4)); } \
        if (st < 192) rg = ((const float*)(a.ws + WS_GTAB))[(size_t)u_ * 192 + st]; } while (0)
#define SV_WRITE(bf) do { LAS unsigned char* B_ = lds + (bf) * L_BUF; \
        _Pragma("unroll") for (int k = 0; k < 4; ++k) { const int c = st + 256 * k; *(LAS v4u*)(B_ + L_W + (c & 63) * PW + (c >> 6) * 16) = rw[k]; \
            *(LAS v4u*)(B_ + L_Q + (c >> 4) * PW + (c & 15) * 16) = rq[k]; *(LAS v4u*)(B_ + L_K + (c & 127) * PI + (c >> 7) * 16) = rk[k]; } \
        _Pragma("unroll") for (int k = 0; k < 2; ++k) { const int c = st + 256 * k; *(LAS v4u*)(B_ + L_I + (c & 63) * PI + (c >> 6) * 16) = ri[k]; } \
        if (st < 192) *(LAS float*)(B_ + L_G + st * 4) = rg; } while (0)
        f32x4 nwa, nwb;
        { const float* nwp = a.gdn_norm_w + j * 128 + (st & 15) * 8; nwa = *(const f32x4*)nwp; nwb = *(const f32x4*)(nwp + 4); }
        volatile LAS unsigned* flag = (volatile LAS unsigned*)(lds + L_PART);
        SV_LOAD(0); SV_WRITE(0);
        v4u zc[4], zn[4];
#pragma unroll
        for (int k = 0; k < 4; ++k) zc[k] = rz[k];
        __syncthreads();
        SV_LOAD(1);
#pragma unroll 1
        for (int chunk = 0; chunk < 64; ++chunk) {
            if (chunk + 1 < 64) { SV_WRITE((chunk + 1) & 1);
#pragma unroll
                for (int k = 0; k < 4; ++k) zn[k] = rz[k]; }
            __syncthreads();
            v4u ov[4];
#pragma unroll
            for (int k = 0; k < 4; ++k) { const int c = st + 256 * k; ov[k] = *(const LAS v4u*)(stg + (c >> 4) * 256 + (c & 15) * 16); }
            asm volatile("s_waitcnt lgkmcnt(0)" ::: "memory");
            if (lane == 0) __hip_atomic_fetch_add((LAS unsigned*)(lds + L_PART), 1u, __ATOMIC_RELAXED, __HIP_MEMORY_SCOPE_WORKGROUP);
            if (chunk + 2 < 64) SV_LOAD(chunk + 2);
            __builtin_amdgcn_sched_barrier(0);
            bf16* ob = dry ? (bf16*)(a.ws + WS_END) + (size_t)bid * 64 * 128 : qkvc + (tb0 + (size_t)chunk * 64) * 4096 + 2048 + hv * 128; const int opitch = dry ? 128 : 4096;
#pragma unroll
            for (int k = 0; k < 4; ++k) { const int c = st + 256 * k;
                float o8[8]; o8[0] = bf_lo(ov[k].x); o8[1] = bf_hi(ov[k].x); o8[2] = bf_lo(ov[k].y); o8[3] = bf_hi(ov[k].y); o8[4] = bf_lo(ov[k].z); o8[5] = bf_hi(ov[k].z); o8[6] = bf_lo(ov[k].w); o8[7] = bf_hi(ov[k].w);
                float ss = 0.f;
#pragma unroll
                for (int e = 0; e < 8; ++e) ss += o8[e] * o8[e];
                const float rinv = __builtin_amdgcn_rsqf(dpp_sum16(ss) * (1.0f / 128.0f) + RMS_EPS);
                float z8[8]; z8[0] = bf_lo(zc[k].x); z8[1] = bf_hi(zc[k].x); z8[2] = bf_lo(zc[k].y); z8[3] = bf_hi(zc[k].y); z8[4] = bf_lo(zc[k].z); z8[5] = bf_hi(zc[k].z); z8[6] = bf_lo(zc[k].w); z8[7] = bf_hi(zc[k].w);
                float r8[8];
#pragma unroll
                for (int e = 0; e < 8; ++e) { const float sg = z8[e] * __builtin_amdgcn_rcpf(1.0f + __builtin_amdgcn_exp2f(-1.4426950408889634f * z8[e])); r8[e] = o8[e] * rinv * (e < 4 ? nwa[e] : nwb[e - 4]) * sg; }
                v4u w; w.x = pk(r8[0], r8[1]); w.y = pk(r8[2], r8[3]); w.z = pk(r8[4], r8[5]); w.w = pk(r8[6], r8[7]);
                *(v4u*)(ob + (size_t)(c >> 4) * opitch + (c & 15) * 8) = w; }
#pragma unroll
            for (int k = 0; k < 4; ++k) zc[k] = zn[k];
        }
#undef SV_RUN2
#undef SV_LOAD
#undef SV_WRITE
        return;
    }
    f4v S[2][8];
#pragma unroll
    for (int g = 0; g < 2; ++g)
#pragma unroll
        for (int m = 0; m < 8; ++m) S[g][m] = (f4v){0.f, 0.f, 0.f, 0.f};
    v2u un[2][4];
#define CW_ULOAD(ch) do { const bf16* vb_ = qkvc + (tb0 + (size_t)(ch) * 64) * 4096 + 2048 + hv * 128; \
        _Pragma("unroll") for (int g = 0; g < 2; ++g) _Pragma("unroll") for (int mt = 0; mt < 4; ++mt) { \
            const int f = (((((mt >> 1) * 4 + wave) * 4 + 2 * (mt & 1) + (kq >> 1)) * 64) + (kq & 1) * 32 + 16 * g + n) * 4;     \
            un[g][mt] = *(const v2u*)(vb_ + (size_t)(f >> 7) * 4096 + (f & 127)); } } while (0)
    CW_ULOAD(0);
    if (tid == 0) *(volatile LAS unsigned*)(lds + L_PART) = 0u;
    __syncthreads();
#pragma unroll 1
    for (int chunk = 0; chunk < 64; ++chunk) {
        const LAS unsigned char* B = lds + (chunk & 1) * L_BUF; const LAS float* gt = (const LAS float*)(B + L_G);
        f4v av[2][4], ao[2][4];
#pragma unroll
        for (int g = 0; g < 2; ++g)
#pragma unroll
            for (int mt = 0; mt < 4; ++mt) { const v2u u0 = un[g][mt]; av[g][mt] = (f4v){bf_lo(u0.x), bf_hi(u0.x), bf_lo(u0.y), bf_hi(u0.y)}; }
        if (chunk + 1 < 64) CW_ULOAD(chunk + 1);
        bf16x8 Sb[2][4];
#pragma unroll
        for (int g = 0; g < 2; ++g)
#pragma unroll
            for (int p = 0; p < 4; ++p) { v4u w; w.x = pk(S[g][2 * p][0], S[g][2 * p][1]); w.y = pk(S[g][2 * p][2], S[g][2 * p][3]); w.z = pk(S[g][2 * p + 1][0], S[g][2 * p + 1][1]); w.w = pk(S[g][2 * p + 1][2], S[g][2 * p + 1][3]);
                Sb[g][p] = __builtin_bit_cast(bf16x8, w); }
#pragma unroll
        for (int mt = 0; mt < 4; ++mt) { ao[0][mt] = (f4v){0.f, 0.f, 0.f, 0.f}; ao[1][mt] = (f4v){0.f, 0.f, 0.f, 0.f};
#pragma unroll
            for (int p = 0; p < 4; ++p) {
                const bf16x8 aw = *(const LAS bf16x8*)(B + L_W + (16 * mt + n) * PW + 64 * p + 16 * kq);
                const v2u q0 = *(const LAS v2u*)(B + L_Q + (16 * mt + n) * PW + 64 * p + 8 * kq), q1 = *(const LAS v2u*)(B + L_Q + (16 * mt + n) * PW + 64 * p + 32 + 8 * kq);
                const v4u qq = {q0.x, q0.y, q1.x, q1.y}; const bf16x8 aq = __builtin_bit_cast(bf16x8, qq);
                av[0][mt] = __builtin_amdgcn_mfma_f32_16x16x32_bf16(aw, Sb[0][p], av[0][mt], 0, 0, 0); av[1][mt] = __builtin_amdgcn_mfma_f32_16x16x32_bf16(aw, Sb[1][p], av[1][mt], 0, 0, 0);
                ao[0][mt] = __builtin_amdgcn_mfma_f32_16x16x32_bf16(aq, Sb[0][p], ao[0][mt], 0, 0, 0); ao[1][mt] = __builtin_amdgcn_mfma_f32_16x16x32_bf16(aq, Sb[1][p], ao[1][mt], 0, 0, 0); } }
        bf16x8 vbf[2][2], vbd[2][2];
#pragma unroll
        for (int pp = 0; pp < 2; ++pp) {
            const f4v d0 = *(const LAS f4v*)(gt + 64 + 32 * pp + 4 * kq), d1 = *(const LAS f4v*)(gt + 64 + 32 * pp + 16 + 4 * kq);
#pragma unroll
            for (int g = 0; g < 2; ++g) { const f4v x0 = av[g][2 * pp], x1 = av[g][2 * pp + 1];
                v4u w; w.x = pk(x0[0], x0[1]); w.y = pk(x0[2], x0[3]); w.z = pk(x1[0], x1[1]); w.w = pk(x1[2], x1[3]); vbf[g][pp] = __builtin_bit_cast(bf16x8, w);
                v4u y; y.x = pk(x0[0] * d0[0], x0[1] * d0[1]); y.y = pk(x0[2] * d0[2], x0[3] * d0[3]); y.z = pk(x1[0] * d1[0], x1[1] * d1[1]); y.w = pk(x1[2] * d1[2], x1[3] * d1[3]); vbd[g][pp] = __builtin_bit_cast(bf16x8, y); }
        }
#pragma unroll
        for (int mt = 0; mt < 4; ++mt) { const f4v eg = *(const LAS f4v*)(gt + 16 * mt + 4 * kq); ao[0][mt] = ao[0][mt] * eg; ao[1][mt] = ao[1][mt] * eg;
#pragma unroll
            for (int pp = 0; pp < 2; ++pp) { const bf16x8 ai = *(const LAS bf16x8*)(B + L_I + (16 * mt + n) * PI + 64 * pp + 16 * kq);
                ao[0][mt] = __builtin_amdgcn_mfma_f32_16x16x32_bf16(ai, vbf[0][pp], ao[0][mt], 0, 0, 0); ao[1][mt] = __builtin_amdgcn_mfma_f32_16x16x32_bf16(ai, vbf[1][pp], ao[1][mt], 0, 0, 0); } }
        { const float egl = gt[128];
#pragma unroll
          for (int m8 = 0; m8 < 8; ++m8) { S[0][m8] = S[0][m8] * egl; S[1][m8] = S[1][m8] * egl;
#pragma unroll
              for (int pp = 0; pp < 2; ++pp) { const bf16x8 ak = *(const LAS bf16x8*)(B + L_K + (16 * m8 + n) * PI + 64 * pp + 16 * kq);
                  S[0][m8] = __builtin_amdgcn_mfma_f32_16x16x32_bf16(ak, vbd[0][pp], S[0][m8], 0, 0, 0); S[1][m8] = __builtin_amdgcn_mfma_f32_16x16x32_bf16(ak, vbd[1][pp], S[1][m8], 0, 0, 0); } } }
        { unsigned spins = 0; while (*(volatile LAS unsigned*)(lds + L_PART) < 4u * (unsigned)chunk) { __builtin_amdgcn_s_sleep(1); if (++spins > (1u << 22)) break; } }
#pragma unroll
        for (int g = 0; g < 2; ++g)
#pragma unroll
            for (int mt = 0; mt < 4; ++mt)
#pragma unroll
                for (int i = 0; i < 4; ++i) *(LAS bf16*)(stg + (16 * mt + 4 * kq + i) * 256 + (32 * wave + 16 * g + n) * 2) = (bf16)(pk(ao[g][mt][i], 0.f) & 0xffffu);
        __syncthreads();
    }
#undef CW_ULOAD
}

DI void moe_offsets(const Args& a, int j, unsigned (&off)[9]) {
    unsigned* cnt = (unsigned*)(a.ws + WS_CTL) + CW_CNT + 256 * j; unsigned acc = 0u;
#pragma unroll
    for (int e = 0; e < 8; ++e) { off[e] = acc; const unsigned c = __hip_atomic_load(cnt + e, __ATOMIC_RELAXED, __HIP_MEMORY_SCOPE_AGENT); acc += (c + 255u) & ~255u; }
    off[8] = acc;
}
DI void phase_scatter(const Args& a, int j, LAS unsigned char* lds, int bid, int G, int tid, int wave, int lane) {
    LAS unsigned* lc = (LAS unsigned*)lds; LAS unsigned* lb = lc + 8; LAS unsigned* loff = lc + 16; LAS int* lpos = (LAS int*)(lc + 32);
    const unsigned* E12 = (const unsigned*)(a.ws + WS_E12); int* POS = (int*)(a.ws + WS_POS);
    const bf16* HB = (const bf16*)(a.ws + WS_HB); bf16* XS = (bf16*)(a.ws + WS_XS);
    unsigned* fill = (unsigned*)(a.ws + WS_CTL) + CW_CNT + 256 * j + 64;
    unsigned off[9]; moe_offsets(a, j, off);
    if (tid == 0) {
#pragma unroll
        for (int e = 0; e < 8; ++e) loff[e] = off[e]; }
    for (int ci = bid; ci < TT / 128; ci += G) {
        __syncthreads();
        if (tid < 8) lc[tid] = 0u;
        __syncthreads();
        unsigned e1 = 0, e2 = 0, r1 = 0, r2 = 0;
        if (tid < 128) { const unsigned w = E12[ci * 128 + tid]; e1 = w & 255u; e2 = (w >> 8) & 255u;
            r1 = __hip_atomic_fetch_add(lc + e1, 1u, __ATOMIC_RELAXED, __HIP_MEMORY_SCOPE_WORKGROUP); r2 = __hip_atomic_fetch_add(lc + e2, 1u, __ATOMIC_RELAXED, __HIP_MEMORY_SCOPE_WORKGROUP); }
        __syncthreads();
        if (tid < 8) lb[tid] = __hip_atomic_fetch_add(fill + tid, lc[tid], __ATOMIC_RELAXED, __HIP_MEMORY_SCOPE_AGENT);
        __syncthreads();
        if (tid < 128) { const int p1 = (int)(loff[e1] + lb[e1] + r1), p2 = (int)(loff[e2] + lb[e2] + r2);
            lpos[2 * tid] = p1; lpos[2 * tid + 1] = p2; POS[2 * (ci * 128 + tid)] = p1; POS[2 * (ci * 128 + tid) + 1] = p2; }
        __syncthreads();
        for (int tk = wave; tk < 128; tk += NWAVES) {
            const int p1 = lpos[2 * tk], p2 = lpos[2 * tk + 1];
            const v4u* src = (const v4u*)(HB + (size_t)(ci * 128 + tk) * D);
            const v4u x0 = src[lane], x1 = src[lane + 64];
            v4u* d1 = (v4u*)(XS + (size_t)p1 * D); v4u* d2 = (v4u*)(XS + (size_t)p2 * D);
            d1[lane] = x0; d1[lane + 64] = x1; d2[lane] = x0; d2[lane + 64] = x1;
        }
    }
}

template <bool FINAL>
DI void phase_combine_ln(const Args& a, int lnprev, int lnidx, int bid, int G, int wave, int lane) {
    float* out = a.out; bf16* HB = (bf16*)(a.ws + WS_HB); const bf16* YE = (const bf16*)(a.ws + WS_XS); float* stats = (float*)(a.ws + WS_STATS);
    const int* POS = (const int*)(a.ws + WS_POS); const f32x2* G12 = (const f32x2*)(a.ws + WS_G12);
    const float* g = a.ln_g + (size_t)lnidx * D; const float* bta = a.ln_b + (size_t)lnidx * D;
    const float* gp = a.ln_g + (size_t)lnprev * D; const float* bp = a.ln_b + (size_t)lnprev * D;
    const int gw = bid * NWAVES + wave, NGW = G * NWAVES;
    f32x4 gv[4], bv[4], gq[4], bq[4];
#pragma unroll
    for (int q = 0; q < 4; ++q) { gv[q] = *(const f32x4*)(g + 4 * (lane + 64 * q)); bv[q] = *(const f32x4*)(bta + 4 * (lane + 64 * q));
        gq[q] = *(const f32x4*)(gp + 4 * (lane + 64 * q)) * ALPHA; bq[q] = *(const f32x4*)(bp + 4 * (lane + 64 * q)) * ALPHA; }
    for (int t = gw; t < TT; t += NGW) {
        f32x4* row = (f32x4*)(out + (size_t)t * D);
        const int p1 = POS[2 * t], p2 = POS[2 * t + 1]; const f32x2 gg = G12[t]; const f32x2 st = *(const f32x2*)(stats + 2 * (size_t)t);
        const v2u* y1 = (const v2u*)(YE + (size_t)p1 * D); const v2u* y2 = (const v2u*)(YE + (size_t)p2 * D);
        f32x4 v[4]; float s = 0.f;
#pragma unroll
        for (int q = 0; q < 4; ++q) { const v2u a1 = y1[lane + 64 * q], a2 = y2[lane + 64 * q];
            const f32x4 e1 = (f32x4){bf_lo(a1.x), bf_hi(a1.x), bf_lo(a1.y), bf_hi(a1.y)}, e2 = (f32x4){bf_lo(a2.x), bf_hi(a2.x), bf_lo(a2.y), bf_hi(a2.y)};
            v[q] = (row[lane + 64 * q] - st.x) * st.y * gq[q] + bq[q] + e1 * gg.x + e2 * gg.y; s += (v[q][0] + v[q][1]) + (v[q][2] + v[q][3]); }
        const float mean = wave_sum(s) * (1.0f / D); float s2 = 0.f;
#pragma unroll
        for (int q = 0; q < 4; ++q) { const f32x4 d = v[q] - mean; s2 += (d[0] * d[0] + d[1] * d[1]) + (d[2] * d[2] + d[3] * d[3]); }
        const float rstd = 1.0f / sqrtf(wave_sum(s2) * (1.0f / D) + LN_EPS);
        if (lane == 0) *(f32x2*)(stats + 2 * (size_t)t) = (f32x2){mean, rstd};
#pragma unroll
        for (int q = 0; q < 4; ++q) { const f32x4 hn = (v[q] - mean) * rstd * gv[q] + bv[q]; row[lane + 64 * q] = FINAL ? hn : v[q];
            v2u o; o.x = pk2(hn[0], hn[1]); o.y = pk2(hn[2], hn[3]); *(v2u*)(HB + (size_t)t * D + 4 * (lane + 64 * q)) = o; }
    }
}

constexpr int ARGS_OFF = RING_BYTES + 1024;
DI unsigned long long lds_u64(LAS unsigned char* p) { const v2u w = *(const volatile LAS v2u*)p; return ((unsigned long long)(unsigned)__builtin_amdgcn_readfirstlane((int)w.y) << 32) | (unsigned)__builtin_amdgcn_readfirstlane((int)w.x); }
DI Args load_args(LAS unsigned char* lds) {
    Args a; LAS unsigned char* p = lds + ARGS_OFF;
    a.x = (const float*)(const GAS float*)lds_u64(p + 0); a.gdn_w_in = (const float*)(const GAS float*)lds_u64(p + 8); a.gdn_conv_w = (const float*)(const GAS float*)lds_u64(p + 16); a.gdn_a_log = (const float*)(const GAS float*)lds_u64(p + 24);
    a.gdn_dt_bias = (const float*)(const GAS float*)lds_u64(p + 32); a.gdn_norm_w = (const float*)(const GAS float*)lds_u64(p + 40); a.gdn_w_out = (const float*)(const GAS float*)lds_u64(p + 48); a.sb_w_in = (const float*)(const GAS float*)lds_u64(p + 56);
    a.sb_w_out = (const float*)(const GAS float*)lds_u64(p + 64); a.ffn_w_gate = (const float*)(const GAS float*)lds_u64(p + 72); a.ffn_w_up = (const float*)(const GAS float*)lds_u64(p + 80); a.ffn_w_down = (const float*)(const GAS float*)lds_u64(p + 88);
    a.moe_router = (const float*)(const GAS float*)lds_u64(p + 96); a.moe_w_gate = (const float*)(const GAS float*)lds_u64(p + 104); a.moe_w_up = (const float*)(const GAS float*)lds_u64(p + 112); a.moe_w_down = (const float*)(const GAS float*)lds_u64(p + 120);
    a.ln_g = (const float*)(const GAS float*)lds_u64(p + 128); a.ln_b = (const float*)(const GAS float*)lds_u64(p + 136); a.out = (float*)(GAS float*)lds_u64(p + 144); a.ws = (unsigned char*)(GAS unsigned char*)lds_u64(p + 152);
    const v2u w = *(const volatile LAS v2u*)(p + 160); a.ph_lo = __builtin_amdgcn_readfirstlane((int)w.x); a.ph_hi = __builtin_amdgcn_readfirstlane((int)w.y);
    return a;
}
#ifdef PH_ONLY
#define IN(k) (((k) % NPH) == PH_ONLY && lo <= (k) && (k) < hi)
#else
#define IN(k) (lo <= (k) && (k) < hi)
#endif
#define SEAM(k) do { if ((k) + 1 < hi) xcd_barrier(bar); } while (0)
DI int fresh_lane() { int l; asm volatile("v_mbcnt_lo_u32_b32 %0, -1, 0\n\tv_mbcnt_hi_u32_b32 %0, -1, %0" : "=v"(l)); return l; }
#define ARGS() const Args args = load_args(lds); const int lo = args.ph_lo, hi = args.ph_hi; const int lane = fresh_lane(), tid = wave * 64 + lane
#ifndef PROBE_REP_MASK
#define PROBE_REP_MASK 0
#endif
#ifndef PROBE_DELAY_MASK
#define PROBE_DELAY_MASK 0
#endif
#define PROBE_DELAY_MULT 4u
#define TICK_IN(k) do { if (((PROBE_DELAY_MASK) >> (k)) & 1) { if (bid == 0 && tid == 0) ((volatile LAS unsigned*)(lds + MISC_OFF))[20] -= (unsigned)__builtin_amdgcn_s_memrealtime(); } } while (0)
#define TICK_OUT(k) do { if (((PROBE_DELAY_MASK) >> (k)) & 1) { if (bid == 0 && tid == 0) ((volatile LAS unsigned*)(lds + MISC_OFF))[20] += (unsigned)__builtin_amdgcn_s_memrealtime(); } } while (0)
#define NREP(k) ((((PROBE_REP_MASK) >> (k)) & 1) ? 2 : 1)
template <int j>
DI void layer_pair(LAS unsigned char* lds, const XcdBarrier& bar, const int wave, const int G, const int bid) {
    constexpr int pb = j * NPH;
    { ARGS(); if (IN(pb + 0)) { TICK_IN(0); _Pragma("unroll 1") for (int rep_ = 0; rep_ < NREP(0); ++rep_) { phase_w_gdn(args, j, lds, bid, G, tid, wave, lane); } SEAM(pb + 0); TICK_OUT(0); } }
    { ARGS(); if (IN(pb + 1)) { TICK_IN(1); {
        pg8::Gemm g{(const bf16*)(args.ws + WS_HB), (const bf16*)(args.ws + W_IN), D, D}; pg8::StaticOrder S; S.init(TT, GINP, G, bid, NREP(1));
        pg8::EpiInProj E{(bf16*)(args.ws + WS_RAW), (bf16*)(args.ws + WS_ZB)};
        pg8::gemm_phase<pg8::EpiInProj, pg8::StaticOrder, true, true>(lds, g, S, E);
        } SEAM(pb + 1); TICK_OUT(1); } }
    { ARGS(); if (IN(pb + 2)) { TICK_IN(2); _Pragma("unroll 1") for (int rep_ = 0; rep_ < NREP(2); ++rep_) { phase_conv(args, j, bid, G, tid); } SEAM(pb + 2); TICK_OUT(2); } }
#if GDN_NAIVE
    { ARGS(); if (IN(pb + 4)) { TICK_IN(4); _Pragma("unroll 1") for (int rep_ = 0; rep_ < NREP(4); ++rep_) { phase_gdn_naive(args, j, lds, bid, tid); } SEAM(pb + 4); TICK_OUT(4); } }
#else
    { ARGS(); if (IN(pb + 3)) { TICK_IN(3); _Pragma("unroll 1") for (int rep_ = 0; rep_ < NREP(3); ++rep_) { phase_gdn_local(args, lds, bid, G, wave, lane, rep_ + 1 < NREP(3)); } SEAM(pb + 3); TICK_OUT(3); } }
    { ARGS(); if (IN(pb + 4)) { TICK_IN(4); _Pragma("unroll 1") for (int rep_ = 0; rep_ < NREP(4); ++rep_) { if (bid >= BATCH * HV && G > BATCH * HV) phase_w_sb(args, j, lds, bid - BATCH * HV, G - BATCH * HV, wave, lane); else if (G <= BATCH * HV && rep_ == 0) phase_w_sb(args, j, lds, bid, G, wave, lane);
        phase_gdn_scan(args, j, lds, bid, tid, rep_ + 1 < NREP(4)); } SEAM(pb + 4); TICK_OUT(4); } }
#endif
    { ARGS(); if (IN(pb + 5)) { TICK_IN(5); {
        pg8::Gemm g{(const bf16*)(args.ws + WS_QKVC) + 2048, (const bf16*)(args.ws + W_OUT), 4096, 2048}; pg8::StaticOrder S; S.init(TT, D, G, bid);
        pg8::EpiResid<(j > 0)> E{j == 0 ? args.x : args.out, args.out, (const float*)(args.ws + WS_STATS), args.ln_g + (size_t)(4 * (j > 0 ? j - 1 : 0) + 3) * D, args.ln_b + (size_t)(4 * (j > 0 ? j - 1 : 0) + 3) * D};
        pg8::gemm_phase<pg8::EpiResid<(j > 0)>, pg8::StaticOrder, true, true>(lds, g, S, E);
        } SEAM(pb + 5); TICK_OUT(5); } }
    { ARGS(); if (IN(pb + 6)) { TICK_IN(6); _Pragma("unroll 1") for (int rep_ = 0; rep_ < NREP(6); ++rep_) { phase_ln<false>(args, (2 * j) * 2 + 0, j, lds, bid, G, tid, wave, lane); } SEAM(pb + 6); TICK_OUT(6); } }
    { ARGS(); if (IN(pb + 7)) { TICK_IN(7); {
        pg8::Gemm g{(const bf16*)(args.ws + WS_HB), (const bf16*)(args.ws + W_GU), D, D}; pg8::StaticOrder S; S.init(TT, 2 * FF, G, bid, NREP(7));
        pg8::EpiSwiGLU E{(bf16*)(args.ws + WS_ACT), FF, 0};
        pg8::gemm_phase<pg8::EpiSwiGLU, pg8::StaticOrder, true, true>(lds, g, S, E);
        } SEAM(pb + 7); TICK_OUT(7); } }
    { ARGS(); if (IN(pb + 8)) { TICK_IN(8); {
        pg8::Gemm g{(const bf16*)(args.ws + WS_ACT), (const bf16*)(args.ws + W_D), FF, FF}; pg8::StaticOrder S; S.init(TT, D, G, bid);
        pg8::EpiResid<true> E{args.out, args.out, (const float*)(args.ws + WS_STATS), args.ln_g + (size_t)(4 * j + 0) * D, args.ln_b + (size_t)(4 * j + 0) * D};
        pg8::gemm_phase<pg8::EpiResid<true>, pg8::StaticOrder, true, true>(lds, g, S, E);
        } SEAM(pb + 8); TICK_OUT(8); } }
    { ARGS(); if (IN(pb + 9)) { TICK_IN(9); _Pragma("unroll 1") for (int rep_ = 0; rep_ < NREP(9); ++rep_) { phase_ln<false>(args, (2 * j) * 2 + 1, j, lds, bid, G, tid, wave, lane); } SEAM(pb + 9); TICK_OUT(9); } }
    { ARGS(); if (IN(pb + 10)) { TICK_IN(10); {
        pg8::Gemm g{(const bf16*)(args.ws + WS_HB), (const bf16*)(args.ws + W_QKV), D, D}; pg8::StaticOrder S; S.init(TT, 3072, G, bid, NREP(10));
        pg8::EpiBf16 E{(bf16*)(args.ws + WS_QKV), 3072, 0};
        pg8::gemm_phase<pg8::EpiBf16, pg8::StaticOrder, true, true>(lds, g, S, E);
        } SEAM(pb + 10); TICK_OUT(10); } }
    #if SB_NAIVE
    { ARGS(); if (IN(pb + 11)) { TICK_IN(11); _Pragma("unroll 1") for (int rep_ = 0; rep_ < NREP(11); ++rep_) { phase_sb_naive(args, lds, bid, G, tid); } SEAM(pb + 11); TICK_OUT(11); } }
#else
    { ARGS(); if (IN(pb + 11)) { TICK_IN(11); _Pragma("unroll 1") for (int rep_ = 0; rep_ < NREP(11); ++rep_) { phase_sb_mfma(args, lds, bid, G, tid); } SEAM(pb + 11); TICK_OUT(11); } }
#endif
    { ARGS(); if (IN(pb + 12)) { TICK_IN(12); {
        pg8::Gemm g{(const bf16*)(args.ws + WS_AO), (const bf16*)(args.ws + W_O), D, D}; pg8::StaticOrder S; S.init(TT, D, G, bid);
        pg8::EpiResid<true> E{args.out, args.out, (const float*)(args.ws + WS_STATS), args.ln_g + (size_t)(4 * j + 1) * D, args.ln_b + (size_t)(4 * j + 1) * D};
        pg8::gemm_phase<pg8::EpiResid<true>, pg8::StaticOrder, true, true>(lds, g, S, E);
        } SEAM(pb + 12); TICK_OUT(12); } }
    { ARGS(); if (IN(pb + 13)) { TICK_IN(13); _Pragma("unroll 1") for (int rep_ = 0; rep_ < NREP(13); ++rep_) { phase_ln<true>(args, (2 * j + 1) * 2 + 0, j, lds, bid, G, tid, wave, lane); } SEAM(pb + 13); TICK_OUT(13); } }
    { ARGS(); if (IN(pb + 14)) { TICK_IN(14); _Pragma("unroll 1") for (int rep_ = 0; rep_ < NREP(14); ++rep_) { phase_scatter(args, j, lds, bid, G, tid, wave, lane); } SEAM(pb + 14); TICK_OUT(14); } }
    { ARGS(); if (IN(pb + 15)) { TICK_IN(15); {
        unsigned off[9]; moe_offsets(args, j, off);
        pg8::MoeOrder S; S.nM = (int)(off[8] >> 8); S.G = G; S.c = bid; S.nN = 2 * FF / 256; S.nwg = S.nM * S.nN; S.rep = NREP(15);
        S.ps1 = (int)(off[1] >> 8); S.ps2 = (int)(off[2] >> 8); S.ps3 = (int)(off[3] >> 8); S.ps4 = (int)(off[4] >> 8); S.ps5 = (int)(off[5] >> 8); S.ps6 = (int)(off[6] >> 8); S.ps7 = (int)(off[7] >> 8);
        pg8::Gemm g{(const bf16*)(args.ws + WS_XS), (const bf16*)(args.ws + W_MGU), D, D};
        pg8::EpiSwiGLU E{(bf16*)(args.ws + WS_MACT), FF, 2 * FF / 256};
        pg8::gemm_phase<pg8::EpiSwiGLU, pg8::MoeOrder, true, true>(lds, g, S, E);
        } SEAM(pb + 15); TICK_OUT(15); } }
    { ARGS(); if (IN(pb + 16)) { TICK_IN(16); {
        unsigned off[9]; moe_offsets(args, j, off);
        pg8::MoeOrder S; S.nM = (int)(off[8] >> 8); S.G = G; S.c = bid; S.nN = D / 256; S.nwg = S.nM * S.nN; S.rep = NREP(16);
        S.ps1 = (int)(off[1] >> 8); S.ps2 = (int)(off[2] >> 8); S.ps3 = (int)(off[3] >> 8); S.ps4 = (int)(off[4] >> 8); S.ps5 = (int)(off[5] >> 8); S.ps6 = (int)(off[6] >> 8); S.ps7 = (int)(off[7] >> 8);
        pg8::Gemm g{(const bf16*)(args.ws + WS_MACT), (const bf16*)(args.ws + W_MD), FF, FF};
        pg8::EpiBf16 E{(bf16*)(args.ws + WS_XS), D, D / 256};
        pg8::gemm_phase<pg8::EpiBf16, pg8::MoeOrder, true, true>(lds, g, S, E);
        } SEAM(pb + 16); TICK_OUT(16); } }
    { ARGS(); if (IN(pb + 17)) { TICK_IN(17); _Pragma("unroll 1") for (int rep_ = 0; rep_ < NREP(17); ++rep_) { phase_combine_ln<(j == 1)>(args, 4 * j + 2, 4 * j + 3, bid, G, wave, lane); } SEAM(pb + 17); TICK_OUT(17); } }
}
__global__ void __launch_bounds__(NWAVES * 64, 2) fwd(Args kargs) {
    extern __shared__ __attribute__((aligned(16))) unsigned char lds_raw[];
    LAS unsigned char* lds = (LAS unsigned char*)lds_raw;
    volatile LAS unsigned* MISC = (volatile LAS unsigned*)(lds + MISC_OFF);
    const int tid = threadIdx.x, lane = tid & 63, wave = __builtin_amdgcn_readfirstlane(tid >> 6), G = gridDim.x, bid = blockIdx.x;
    for (int u = tid; u < (LDS_BYTES - RING_BYTES) / 4; u += NWAVES * 64) ((LAS unsigned*)(lds + RING_BYTES))[u] = 0u;
    __syncthreads();
    if (tid == 0) { LAS unsigned long long* pa = (LAS unsigned long long*)(lds + ARGS_OFF);
        pa[0] = (unsigned long long)kargs.x; pa[1] = (unsigned long long)kargs.gdn_w_in; pa[2] = (unsigned long long)kargs.gdn_conv_w; pa[3] = (unsigned long long)kargs.gdn_a_log;
        pa[4] = (unsigned long long)kargs.gdn_dt_bias; pa[5] = (unsigned long long)kargs.gdn_norm_w; pa[6] = (unsigned long long)kargs.gdn_w_out; pa[7] = (unsigned long long)kargs.sb_w_in;
        pa[8] = (unsigned long long)kargs.sb_w_out; pa[9] = (unsigned long long)kargs.ffn_w_gate; pa[10] = (unsigned long long)kargs.ffn_w_up; pa[11] = (unsigned long long)kargs.ffn_w_down;
        pa[12] = (unsigned long long)kargs.moe_router; pa[13] = (unsigned long long)kargs.moe_w_gate; pa[14] = (unsigned long long)kargs.moe_w_up; pa[15] = (unsigned long long)kargs.moe_w_down;
        pa[16] = (unsigned long long)kargs.ln_g; pa[17] = (unsigned long long)kargs.ln_b; pa[18] = (unsigned long long)kargs.out; pa[19] = (unsigned long long)kargs.ws;
        pa[20] = (unsigned long long)(unsigned)kargs.ph_lo | ((unsigned long long)(unsigned)kargs.ph_hi << 32); }
    XcdBarrier bar = xcd_barrier_post((unsigned*)(kargs.ws + WS_CTL) + CW_BAR, MISC + 8);
    __syncthreads();
    layer_pair<0>(lds, bar, wave, G, bid);
    layer_pair<1>(lds, bar, wave, G, bid);
    if (PROBE_DELAY_MASK || PROBE_SEC) { if (bid == 0 && threadIdx.x == 0) { const unsigned acc = ((volatile LAS unsigned*)(lds + MISC_OFF))[20] * PROBE_DELAY_MULT; const unsigned long long t0 = __builtin_amdgcn_s_memrealtime(); while ((unsigned)(__builtin_amdgcn_s_memrealtime() - t0) < acc) __builtin_amdgcn_s_sleep(8); } }
}
#undef IN
#undef SEAM
#undef ARGS

extern "C" void kernel_launch(void* const* d_in, const int* in_sizes, int n_in, void* d_out, int out_size, void* d_ws, size_t ws_size, hipStream_t stream) {
    static int grid = 0;
    if (grid == 0) {
        if (n_in != 18 || in_sizes[0] != TT * D || out_size != TT * D || ws_size < WS_END) { fprintf(stderr, "kernel_launch: unexpected shapes (n_in %d, in0 %d, out %d, ws %zu); nothing launched\n", n_in, n_in > 0 ? in_sizes[0] : -1, out_size, ws_size); grid = -1; return; }
        int dev = 0, cus = 0, per_cu = 0;
        if (hipGetDevice(&dev) != hipSuccess || hipDeviceGetAttribute(&cus, hipDeviceAttributeMultiprocessorCount, dev) != hipSuccess) { grid = -1; return; }
        if (hipFuncSetAttribute((const void*)fwd, hipFuncAttributeMaxDynamicSharedMemorySize, LDS_BYTES) != hipSuccess) { fprintf(stderr, "kernel_launch: hipFuncSetAttribute failed\n"); grid = -1; return; }
        if (hipOccupancyMaxActiveBlocksPerMultiprocessor(&per_cu, (const void*)fwd, NWAVES * 64, LDS_BYTES) != hipSuccess || per_cu < 1) { fprintf(stderr, "kernel_launch: occupancy query says %d blocks per CU\n", per_cu); (void)hipGetLastError(); grid = -1; return; }
        grid = cus;
    }
    if (grid < 0) return;
    if (hipMemsetAsync((char*)d_ws + WS_CTL, 0, CTL_ZERO_BYTES, stream) != hipSuccess) return;
    Args a{};
    a.x = (const float*)d_in[0]; a.gdn_w_in = (const float*)d_in[1]; a.gdn_conv_w = (const float*)d_in[2]; a.gdn_a_log = (const float*)d_in[3]; a.gdn_dt_bias = (const float*)d_in[4];
    a.gdn_norm_w = (const float*)d_in[5]; a.gdn_w_out = (const float*)d_in[6]; a.sb_w_in = (const float*)d_in[7]; a.sb_w_out = (const float*)d_in[8];
    a.ffn_w_gate = (const float*)d_in[9]; a.ffn_w_up = (const float*)d_in[10]; a.ffn_w_down = (const float*)d_in[11]; a.moe_router = (const float*)d_in[12];
    a.moe_w_gate = (const float*)d_in[13]; a.moe_w_up = (const float*)d_in[14]; a.moe_w_down = (const float*)d_in[15]; a.ln_g = (const float*)d_in[16]; a.ln_b = (const float*)d_in[17];
    a.out = (float*)d_out; a.ws = (unsigned char*)d_ws;
#if MK_ONE_LAUNCH
    a.ph_lo = 0; a.ph_hi = NPHASES;
    hipLaunchKernelGGL(fwd, dim3(grid), dim3(NWAVES * 64), LDS_BYTES, stream, a);
#else
    for (int p = 0; p < NPHASES; ++p) { a.ph_lo = p; a.ph_hi = p + 1; hipLaunchKernelGGL(fwd, dim3(grid), dim3(NWAVES * 64), LDS_BYTES, stream, a); }
#endif
}
```

```cpp
#include <hip/hip_runtime.h>
#include <cstdio>
#include <cstdint>
#ifndef GDN_NAIVE
#define GDN_NAIVE 0
#endif
#ifndef SB_NAIVE
#define SB_NAIVE 0
#endif
#ifndef MK_ONE_LAUNCH
#define MK_ONE_LAUNCH 1
#endif
namespace pg8 {
#define PG8_LAS __attribute__((address_space(3)))
typedef unsigned short bf16_t;
typedef short bf16x8 __attribute__((ext_vector_type(8)));
typedef float f32x4 __attribute__((ext_vector_type(4)));
typedef unsigned u32x4 __attribute__((ext_vector_type(4)));
constexpr int BM = 256, BK = 64, HALF = 128, HTB = HALF * BK * 2  , STAGE_BYTES = 8 * HTB, NXCD = 8, WGM = 8;

__host__ __device__ __forceinline__ int lds_byte(int r, int c) { const int st = (r >> 4) * 2 + (c >> 5), rr = r & 15, cc = c & 31, ob = rr * 64 + cc * 2; return st * 1024 + (ob ^ (((ob >> 9) & 1) << 5)); }
__host__ __device__ __forceinline__ void stage_rc(int b, int& R, int& C) { const int st = b / 1024, sb = b % 1024, swz = sb ^ (((sb >> 9) & 1) << 5); R = (st >> 1) * 16 + swz / 64; C = (st & 1) * 32 + (swz % 64) / 2; }
__host__ __device__ __forceinline__ int perm32(int rho) { const int n = rho >> 4, i = rho & 15; return 8 * (i >> 2) + 4 * n + (i & 3); }

struct Unit { int pm, pn; };
struct Gemm { const bf16_t* A; const bf16_t* Bt; int lda, K; };

struct StaticOrder {
    int nM, nN, nwg, G, c, rep;
    __host__ __device__ void init(int M, int N, int G_, int c_, int rep_ = 1) { nM = M / BM; nN = N / BM; nwg = nM * nN; G = G_; c = c_; rep = rep_; }
    __host__ __device__ bool next(int i, Unit& u) const {
        const long L = (long)i * G + c; if (L >= (long)rep * nwg) return false;
        int wgid = (int)(L % nwg); { const int q = nwg / NXCD, r = nwg % NXCD, xcd = wgid % NXCD, off = wgid / NXCD; wgid = (xcd < r ? xcd * (q + 1) : r * (q + 1) + (xcd - r) * q) + off; }
        const int nig = WGM * nN, gid = wgid / nig, fm = gid * WGM, gsz = (nM - fm) < WGM ? (nM - fm) : WGM;
        u.pm = fm + ((wgid % nig) % gsz); u.pn = (wgid % nig) / gsz; return true;
    }
    __device__ __forceinline__ void a_ready(const Unit&) const {}
    __device__ __forceinline__ void done(const Unit&) const {}
};

__device__ __forceinline__ unsigned cvt_pk_bf16(float lo, float hi) { unsigned r; asm volatile("v_cvt_pk_bf16_f32 %0, %1, %2" : "=v"(r) : "v"(lo), "v"(hi)); return r; }
struct EpiBf16 {
    static constexpr bool PERM = true, AFTER_DRAIN = false;
    bf16_t* O; int ldc; int nmod;
    __device__ __forceinline__ void operator()(const f32x4 (&acc)[2][2][4][2], const Unit& u, int wr, int wc, int fr, int fq) const {
        const int pnl = nmod ? (u.pn % nmod) : u.pn;
        const int row0 = u.pm * BM + wr * 64 + fr, col0 = pnl * BM + wc * 32 + 8 * fq;
#pragma unroll
        for (int ai = 0; ai < 2; ++ai)
#pragma unroll
            for (int m = 0; m < 4; ++m) { bf16_t* rowp = O + (size_t)(row0 + ai * HALF + m * 16) * ldc + col0;
#pragma unroll
                for (int bj = 0; bj < 2; ++bj) { const f32x4 v0 = acc[ai][bj][m][0], v1 = acc[ai][bj][m][1];
                    u32x4 w; w.x = cvt_pk_bf16(v0[0], v0[1]); w.y = cvt_pk_bf16(v0[2], v0[3]); w.z = cvt_pk_bf16(v1[0], v1[1]); w.w = cvt_pk_bf16(v1[2], v1[3]);
                    *(u32x4*)(rowp + bj * HALF) = w; } }
    }
};
struct EpiInProj {
    static constexpr bool PERM = true, AFTER_DRAIN = false;
    bf16_t* RAW; bf16_t* ZB;
    __device__ __forceinline__ void operator()(const f32x4 (&acc)[2][2][4][2], const Unit& u, int wr, int wc, int fr, int fq) const {
        const bool isz = (u.pn >= 16 && u.pn < 24);
        bf16_t* O = isz ? ZB : RAW; const int ldc = isz ? 2048 : 4352; const int ct = isz ? (u.pn - 16) : (u.pn < 16 ? u.pn : 16);
        const int row0 = u.pm * BM + wr * 64 + fr, col0 = ct * BM + wc * 32 + 8 * fq;
#pragma unroll
        for (int ai = 0; ai < 2; ++ai)
#pragma unroll
            for (int m = 0; m < 4; ++m) { bf16_t* rowp = O + (size_t)(row0 + ai * HALF + m * 16) * ldc + col0;
#pragma unroll
                for (int bj = 0; bj < 2; ++bj) { const f32x4 v0 = acc[ai][bj][m][0], v1 = acc[ai][bj][m][1];
                    u32x4 w; w.x = cvt_pk_bf16(v0[0], v0[1]); w.y = cvt_pk_bf16(v0[2], v0[3]); w.z = cvt_pk_bf16(v1[0], v1[1]); w.w = cvt_pk_bf16(v1[2], v1[3]);
                    *(u32x4*)(rowp + bj * HALF) = w; } }
    }
};
__device__ __forceinline__ float silu_f(float x) { return x * __builtin_amdgcn_rcpf(1.0f + __builtin_amdgcn_exp2f(-1.4426950408889634f * x)); }
struct EpiSwiGLU {
    static constexpr bool PERM = true, AFTER_DRAIN = false;
    bf16_t* O; int ldc; int nmod;
    __device__ __forceinline__ void operator()(const f32x4 (&acc)[2][2][4][2], const Unit& u, int wr, int wc, int fr, int fq) const {
        const int pnl = nmod ? (u.pn % nmod) : u.pn;
        const int row0 = u.pm * BM + wr * 64 + fr, col0 = pnl * HALF + wc * 32 + 8 * fq;
#pragma unroll
        for (int ai = 0; ai < 2; ++ai)
#pragma unroll
            for (int m = 0; m < 4; ++m) { bf16_t* rowp = O + (size_t)(row0 + ai * HALF + m * 16) * ldc + col0;
                const f32x4 g0 = acc[ai][0][m][0], g1 = acc[ai][0][m][1], u0 = acc[ai][1][m][0], u1 = acc[ai][1][m][1];
                u32x4 w;
                w.x = cvt_pk_bf16(silu_f(g0[0]) * u0[0], silu_f(g0[1]) * u0[1]); w.y = cvt_pk_bf16(silu_f(g0[2]) * u0[2], silu_f(g0[3]) * u0[3]);
                w.z = cvt_pk_bf16(silu_f(g1[0]) * u1[0], silu_f(g1[1]) * u1[1]); w.w = cvt_pk_bf16(silu_f(g1[2]) * u1[2], silu_f(g1[3]) * u1[3]);
                *(u32x4*)rowp = w; }
    }
};
template <bool LNR> struct EpiResid {
    static constexpr bool PERM = true, AFTER_DRAIN = false;
    const void* res; bf16_t* out; const float* stats; const float* g; const float* b;
    __device__ __forceinline__ void operator()(const f32x4 (&acc)[2][2][4][2], const Unit& u, int wr, int wc, int fr, int fq) const {
        constexpr int ldc = 1024; constexpr float alpha = 1.6817928305074290f;
        const int row0 = u.pm * BM + wr * 64 + fr, col0 = u.pn * BM + wc * 32 + 8 * fq;
#pragma unroll
        for (int bj = 0; bj < 2; ++bj) {
            f32x4 g0, g1, b0, b1;
            if constexpr (LNR) { g0 = *(const f32x4*)(g + col0 + bj * HALF) * alpha; g1 = *(const f32x4*)(g + col0 + bj * HALF + 4) * alpha;
                                 b0 = *(const f32x4*)(b + col0 + bj * HALF) * alpha; b1 = *(const f32x4*)(b + col0 + bj * HALF + 4) * alpha; }
#pragma unroll
            for (int ai = 0; ai < 2; ++ai)
#pragma unroll
                for (int m = 0; m < 4; ++m) { const int row = row0 + ai * HALF + m * 16; const size_t off = (size_t)row * ldc + col0 + bj * HALF;
                    f32x4 v0, v1;
                    if constexpr (LNR) { const u32x4 w = *(const u32x4*)((const bf16_t*)res + off); const float mean = stats[2 * row], rstd = stats[2 * row + 1];
                        const f32x4 r0 = {__uint_as_float(w.x << 16), __uint_as_float(w.x & 0xffff0000u), __uint_as_float(w.y << 16), __uint_as_float(w.y & 0xffff0000u)};
                        const f32x4 r1 = {__uint_as_float(w.z << 16), __uint_as_float(w.z & 0xffff0000u), __uint_as_float(w.w << 16), __uint_as_float(w.w & 0xffff0000u)};
                        v0 = (r0 - mean) * rstd * g0 + b0 + acc[ai][bj][m][0]; v1 = (r1 - mean) * rstd * g1 + b1 + acc[ai][bj][m][1]; }
                    else { const f32x4 r0 = *(const f32x4*)((const float*)res + off), r1 = *(const f32x4*)((const float*)res + off + 4);
                        v0 = r0 * alpha + acc[ai][bj][m][0]; v1 = r1 * alpha + acc[ai][bj][m][1]; }
                    u32x4 o; o.x = cvt_pk_bf16(v0[0], v0[1]); o.y = cvt_pk_bf16(v0[2], v0[3]); o.z = cvt_pk_bf16(v1[0], v1[1]); o.w = cvt_pk_bf16(v1[2], v1[3]);
                    *(u32x4*)(out + off) = o; }
            asm volatile("" ::: "memory");
        }
    }
};
struct MoeOrder {
    int nM, nN, nwg, G, c, rep; int ps1, ps2, ps3, ps4, ps5, ps6, ps7;
    __device__ __forceinline__ bool next(int i, Unit& u) const {
        const long L = (long)i * G + c; if (nwg == 0 || L >= (long)rep * nwg) return false;
        int wgid = (int)(L % nwg); { const int q = nwg / NXCD, r = nwg % NXCD, xcd = wgid % NXCD, off = wgid / NXCD; wgid = (xcd < r ? xcd * (q + 1) : r * (q + 1) + (xcd - r) * q) + off; }
        const int nig = WGM * nN, gid = wgid / nig, fm = gid * WGM, gsz = (nM - fm) < WGM ? (nM - fm) : WGM;
        const int pm = fm + ((wgid % nig) % gsz), pnl = (wgid % nig) / gsz;
        const int e = (pm >= ps1) + (pm >= ps2) + (pm >= ps3) + (pm >= ps4) + (pm >= ps5) + (pm >= ps6) + (pm >= ps7);
        u.pm = pm; u.pn = e * nN + pnl; return true;
    }
    __device__ __forceinline__ void a_ready(const Unit&) const {}
    __device__ __forceinline__ void done(const Unit&) const {}
};
template <class Epi, class Sched, bool ALIGN_EPI = false, bool SP2 = false>
__device__ __forceinline__ void gemm_phase(PG8_LAS unsigned char* lds, const Gemm g, const Sched& S, const Epi& E) {
    const int tid = threadIdx.x, wid = __builtin_amdgcn_readfirstlane(tid >> 6), lane = tid & 63, wr = wid >> 2, wc = wid & 3, fr = lane & 15, fq = lane >> 4;
    const int K = g.K, nt = K / BK;
    unsigned voffA[2], voffB[2];
#pragma unroll
    for (int i = 0; i < 2; ++i) { int R, C; stage_rc(tid * 16 + i * 8192, R, C); const int Rb = Epi::PERM ? ((R & ~31) + perm32(R & 31)) : R;
        voffA[i] = (unsigned)(R * g.lda + C) * 2u; voffB[i] = (unsigned)(Rb * K + C) * 2u; }
    const size_t kstep = (size_t)(BK * 2);
    const size_t hstepA = (size_t)HALF * g.lda * 2, hstepB = (size_t)HALF * K * 2;
    const size_t tstepA = 2 * hstepA, tstepB = 2 * hstepB;
    const unsigned ldsw = (unsigned)wid * 1024u;
    const int aoff = lds_byte(wr * 64 + fr, fq * 8), boff = lds_byte(wc * 32 + fr, fq * 8);
#define PG8_SA(b, h) (((b) * 2 + (h)) * HTB)
#define PG8_SB(b, h) ((4 + (b) * 2 + (h)) * HTB)
#define PG8_STAGE(bufoff, gbase, voff) do { _Pragma("unroll") for (int _i = 0; _i < 2; ++_i) \
        __builtin_amdgcn_global_load_lds((const unsigned*)((const char*)(gbase) + (voff)[_i]), (PG8_LAS unsigned*)(lds + (bufoff) + ldsw + _i * 8192), 16, 0, 0); } while (0)
#define PG8_LDA(dst, b, h) do { _Pragma("unroll") for (int m = 0; m < 4; ++m) _Pragma("unroll") for (int k = 0; k < 2; ++k) dst[m][k] = *(const PG8_LAS bf16x8*)(lds + PG8_SA(b, h) + aoff + m * 2048 + k * 1024); } while (0)
#define PG8_LDB(dst, b, h) do { _Pragma("unroll") for (int n = 0; n < 2; ++n) _Pragma("unroll") for (int k = 0; k < 2; ++k) dst[n][k] = *(const PG8_LAS bf16x8*)(lds + PG8_SB(b, h) + boff + n * 2048 + k * 1024); } while (0)
#define PG8_MMA(ai, bj, At, Bt) do { __builtin_amdgcn_s_setprio(1); _Pragma("unroll") for (int m = 0; m < 4; ++m) _Pragma("unroll") for (int n = 0; n < 2; ++n) _Pragma("unroll") for (int k = 0; k < 2; ++k) \
        acc[ai][bj][m][n] = __builtin_amdgcn_mfma_f32_16x16x32_bf16(Bt[n][k], At[m][k], acc[ai][bj][m][n], 0, 0, 0); __builtin_amdgcn_s_setprio(0); } while (0)
#define PG8_WAIT_V(n) asm volatile("s_waitcnt vmcnt(" #n ")" ::: "memory")
#define PG8_WAIT_L(n) asm volatile("s_waitcnt lgkmcnt(" #n ")" ::: "memory")
#define PG8_BAR __builtin_amdgcn_s_barrier()
#define PG8_SCHED __builtin_amdgcn_sched_barrier(0)
    Unit cur, nxt; int ui = 0;
    if (!S.next(0, cur)) return;
    f32x4 acc[2][2][4][2];
#pragma unroll
    for (int a = 0; a < 2; ++a)
#pragma unroll
        for (int b = 0; b < 2; ++b)
#pragma unroll
            for (int m = 0; m < 4; ++m)
#pragma unroll
                for (int n = 0; n < 2; ++n) acc[a][b][m][n] = (f32x4){0.f, 0.f, 0.f, 0.f};
    bf16x8 At[4][2], B0[2][2], B1[2][2];
    const char* cA = (const char*)g.A + (size_t)cur.pm * tstepA; const char* cB = (const char*)g.Bt + (size_t)cur.pn * tstepB;
    S.a_ready(cur);
    if constexpr (SP2) {
        PG8_STAGE(PG8_SB(0, 0), cB, voffB); PG8_STAGE(PG8_SB(0, 1), cB + hstepB, voffB); PG8_STAGE(PG8_SA(0, 0), cA, voffA); PG8_STAGE(PG8_SA(0, 1), cA + hstepA, voffA);
        if (wr == 1) PG8_BAR;
        PG8_WAIT_V(2); PG8_BAR;
        PG8_STAGE(PG8_SB(1, 0), cB + kstep, voffB); PG8_STAGE(PG8_SA(1, 0), cA + kstep, voffA); PG8_STAGE(PG8_SB(1, 1), cB + hstepB + kstep, voffB);
        PG8_WAIT_V(6); PG8_BAR;
    } else {
        PG8_STAGE(PG8_SB(0, 0), cB, voffB); PG8_STAGE(PG8_SA(0, 0), cA, voffA); PG8_STAGE(PG8_SB(0, 1), cB + hstepB, voffB); PG8_STAGE(PG8_SA(0, 1), cA + hstepA, voffA);
        if (wr == 1) PG8_BAR;
        PG8_WAIT_V(4); PG8_BAR;
        PG8_STAGE(PG8_SB(1, 0), cB + kstep, voffB); PG8_STAGE(PG8_SA(1, 0), cA + kstep, voffA); PG8_STAGE(PG8_SB(1, 1), cB + hstepB + kstep, voffB);
        PG8_WAIT_V(6); PG8_BAR;
    }
    for (;;) {
        const bool has_next = S.next(ui + 1, nxt);
        const char* nA = has_next ? (const char*)g.A + (size_t)nxt.pm * tstepA : cA; const char* nB = has_next ? (const char*)g.Bt + (size_t)nxt.pn * tstepB : cB;
        for (int t = 0; t < nt; t += 2) {
            const bool last = (t == nt - 2);
            const char* a1 = cA + (size_t)(t + 1) * kstep;
            const char* a2 = last ? nA : cA + (size_t)(t + 2) * kstep; const char* b2 = last ? nB : cB + (size_t)(t + 2) * kstep;
            const char* a3 = a2 + kstep; const char* b3 = b2 + kstep;
            if (last && has_next) S.a_ready(nxt);
            if constexpr (SP2) {
            PG8_LDB(B0, 0, 0); PG8_LDB(B1, 0, 1); PG8_SCHED; PG8_LDA(At, 0, 0); PG8_STAGE(PG8_SA(1, 1), a1 + hstepA, voffA);
            PG8_WAIT_V(8); PG8_WAIT_L(0); PG8_BAR; PG8_MMA(0, 0, At, B0); PG8_MMA(0, 1, At, B1); PG8_BAR; PG8_SCHED;
            PG8_LDA(At, 0, 1); PG8_STAGE(PG8_SB(0, 0), b2, voffB); PG8_STAGE(PG8_SB(0, 1), b2 + hstepB, voffB); PG8_STAGE(PG8_SA(0, 0), a2, voffA);
            PG8_WAIT_V(8); PG8_WAIT_L(0); PG8_BAR; PG8_MMA(1, 0, At, B0); PG8_MMA(1, 1, At, B1); PG8_BAR; PG8_SCHED;
            PG8_LDB(B0, 1, 0); PG8_LDB(B1, 1, 1); PG8_SCHED; PG8_LDA(At, 1, 0); PG8_STAGE(PG8_SA(0, 1), a2 + hstepA, voffA);
            PG8_WAIT_V(8); PG8_WAIT_L(0); PG8_BAR; PG8_MMA(0, 0, At, B0); PG8_MMA(0, 1, At, B1); PG8_BAR; PG8_SCHED;
            PG8_LDA(At, 1, 1); PG8_STAGE(PG8_SB(1, 0), b3, voffB); PG8_STAGE(PG8_SB(1, 1), b3 + hstepB, voffB); PG8_STAGE(PG8_SA(1, 0), a3, voffA);
            PG8_WAIT_V(8); PG8_WAIT_L(0); PG8_BAR; PG8_MMA(1, 0, At, B0); PG8_MMA(1, 1, At, B1); PG8_BAR; PG8_SCHED;
            } else {
            PG8_LDB(B0, 0, 0); PG8_SCHED; PG8_LDA(At, 0, 0); PG8_STAGE(PG8_SA(1, 1), a1 + hstepA, voffA);
            PG8_WAIT_L(8); PG8_BAR; PG8_WAIT_L(0); PG8_MMA(0, 0, At, B0); PG8_BAR; PG8_SCHED;
            PG8_LDB(B1, 0, 1); PG8_STAGE(PG8_SB(0, 0), b2, voffB);
            PG8_BAR; PG8_WAIT_L(0); PG8_MMA(0, 1, At, B1); PG8_BAR;
            PG8_LDA(At, 0, 1); PG8_STAGE(PG8_SA(0, 0), a2, voffA);
            PG8_BAR; PG8_WAIT_L(0); PG8_MMA(1, 0, At, B0); PG8_BAR; PG8_SCHED;
            PG8_STAGE(PG8_SB(0, 1), b2 + hstepB, voffB);
            PG8_WAIT_V(6); PG8_BAR; PG8_MMA(1, 1, At, B1); PG8_BAR;
            PG8_LDB(B0, 1, 0); PG8_SCHED; PG8_LDA(At, 1, 0); PG8_STAGE(PG8_SA(0, 1), a2 + hstepA, voffA);
            PG8_WAIT_L(8); PG8_BAR; PG8_WAIT_L(0); PG8_MMA(0, 0, At, B0); PG8_BAR; PG8_SCHED;
            PG8_LDB(B1, 1, 1); PG8_STAGE(PG8_SB(1, 0), b3, voffB);
            PG8_BAR; PG8_WAIT_L(0); PG8_MMA(0, 1, At, B1); PG8_BAR;
            PG8_LDA(At, 1, 1); PG8_STAGE(PG8_SA(1, 0), a3, voffA);
            PG8_BAR; PG8_WAIT_L(0); PG8_MMA(1, 0, At, B0); PG8_BAR; PG8_SCHED;
            PG8_STAGE(PG8_SB(1, 1), b3 + hstepB, voffB);
            PG8_WAIT_V(6); PG8_BAR; PG8_MMA(1, 1, At, B1); PG8_BAR;
            }
        }
        if constexpr (ALIGN_EPI) { if (wr == 0) PG8_BAR; }
        if constexpr (!Epi::AFTER_DRAIN) { E(acc, cur, wr, wc, fr, fq); S.done(cur); }
        if (!has_next) break;
#pragma unroll
        for (int a = 0; a < 2; ++a)
#pragma unroll
            for (int b = 0; b < 2; ++b)
#pragma unroll
                for (int m = 0; m < 4; ++m)
#pragma unroll
                    for (int n = 0; n < 2; ++n) acc[a][b][m][n] = (f32x4){0.f, 0.f, 0.f, 0.f};
        cur = nxt; cA = nA; cB = nB; ++ui;
        if constexpr (ALIGN_EPI) { if (wr == 1) PG8_BAR; }
    }
    PG8_WAIT_V(0);
    if constexpr (!ALIGN_EPI) { if (wr == 0) PG8_BAR; }
    PG8_BAR;
    if constexpr (Epi::AFTER_DRAIN) { E.fused(acc, cur, wr, wc, fr, fq, lds, wid, lane); S.done(cur); }
#undef PG8_SA
#undef PG8_SB
#undef PG8_STAGE
#undef PG8_LDA
#undef PG8_LDB
#undef PG8_MMA
#undef PG8_WAIT_V
#undef PG8_WAIT_L
#undef PG8_BAR
#undef PG8_SCHED
}
}

constexpr int NWAVES = 8;
constexpr int BATCH = 8, SEQ = 4096, TT = BATCH * SEQ, D = 1024;
constexpr int HK = 8, HV = 16, HD = 128;
constexpr int GIN = 6176, GINP = 6400;
constexpr int FF = 3584, NE = 8, MOE_ROWS = 67584;
constexpr float ALPHA = 1.6817928305074290f;
constexpr float LN_EPS = 1e-5f, RMS_EPS = 1e-6f;
constexpr int NPH = 18, NPHASES = 2 * NPH;

constexpr size_t MiB = 1ull << 20;
constexpr size_t WS_CTL = 0, CTL_ZERO_BYTES = 1 * MiB;
constexpr size_t WS_E12 = 1 * MiB;
constexpr size_t WS_G12 = WS_E12 + 256 * 1024;
constexpr size_t WS_POS = WS_G12 + 256 * 1024;
constexpr size_t WS_GB = 2 * MiB;
constexpr size_t WS_W = 16 * MiB;
constexpr size_t WS_W2 = 912 * MiB;
constexpr size_t W_IN = WS_W2, W_OUT = WS_W2 + 13 * MiB, W_GU = WS_W2 + 17 * MiB, W_D = WS_W2 + 31 * MiB;
constexpr size_t W_QKV = WS_W, W_O = WS_W + 6 * MiB, W_MGU = WS_W + 8 * MiB, W_MD = WS_W + 120 * MiB;
constexpr size_t WS_HB = 192 * MiB;
constexpr size_t WS_BIG = 256 * MiB;
constexpr size_t WS_ZB = WS_BIG, WS_RAW = WS_BIG + 128 * MiB, WS_QKVC = WS_BIG + 400 * MiB;
constexpr int RAWLD = 4352;
constexpr size_t WS_WMEM = WS_RAW, WS_IMEM = WS_RAW + 128 * MiB, WS_KTMEM = WS_RAW + 192 * MiB;
constexpr size_t WS_STATS = 12 * MiB;
constexpr size_t WS_GTAB = 6 * MiB;
constexpr size_t WS_ACT = WS_BIG;
constexpr size_t WS_QKV = WS_BIG, WS_AO = WS_BIG + 192 * MiB;
constexpr size_t WS_XS = WS_BIG, WS_MACT = WS_BIG + 132 * MiB;
constexpr size_t WS_YT = 850 * MiB;
constexpr size_t WS_END = 950 * MiB;
static_assert(WS_QKVC + (size_t)TT * 4096 * 2 <= WS_W2 && WS_MACT + (size_t)MOE_ROWS * FF * 2 <= WS_END && WS_RAW + (size_t)TT * RAWLD * 2 <= WS_QKVC && WS_KTMEM + (size_t)4096 * 8192 * 2 <= WS_QKVC && WS_GTAB + (size_t)8192 * 192 * 4 <= WS_W, "d_ws map");
static_assert(W_MD + (size_t)NE * D * FF * 2 <= WS_HB && W_IN + (size_t)GINP * D * 2 <= W_OUT && W_D + (size_t)D * FF * 2 <= WS_END && WS_QKVC + (size_t)TT * 4096 * 2 <= WS_W2 && W_MGU + (size_t)NE * 2 * FF * D * 2 <= W_MD, "weight map");
constexpr int CW_BAR = 4096;
constexpr int CW_CNT = 16384;

constexpr int RING_BYTES = 131072;
constexpr int MISC_OFF = RING_BYTES + 320;
constexpr int OGST_OFF = 147456;
#ifndef PROBE_SEC
#define PROBE_SEC 0
#endif
#define SEC_IN(k) do { if (PROBE_SEC == (k)) { if (blockIdx.x == 0 && (threadIdx.x == 0)) ((volatile LAS unsigned*)((LAS unsigned char*)0 + MISC_OFF))[20] -= (unsigned)__builtin_amdgcn_s_memrealtime(); } } while (0)
#define SEC_OUT(k) do { if (PROBE_SEC == (k)) { if (blockIdx.x == 0 && (threadIdx.x == 0)) ((volatile LAS unsigned*)((LAS unsigned char*)0 + MISC_OFF))[20] += (unsigned)__builtin_amdgcn_s_memrealtime(); } } while (0)
constexpr int LDS_BYTES = 163840;

#define GAS __attribute__((address_space(1)))
#define LAS __attribute__((address_space(3)))
#define DI __device__ __forceinline__
typedef unsigned short bf16;
typedef unsigned v4u __attribute__((ext_vector_type(4)));
typedef unsigned v2u __attribute__((ext_vector_type(2)));
typedef float f32x4 __attribute__((ext_vector_type(4)));
typedef float f32x2 __attribute__((ext_vector_type(2)));
typedef GAS unsigned gu32;
#define RLX_AGENT __ATOMIC_RELAXED, __HIP_MEMORY_SCOPE_AGENT
#define LDS_WAIT() asm volatile("s_waitcnt lgkmcnt(0)" ::: "memory")
#define VM_WAIT() asm volatile("s_waitcnt vmcnt(0)" ::: "memory")
__device__ __forceinline__ unsigned long long rt() { return __builtin_amdgcn_s_memrealtime(); }
__device__ __forceinline__ unsigned f2bf(float f) { unsigned u = __builtin_bit_cast(unsigned, f); return (u + 0x7fffu + ((u >> 16) & 1u)) >> 16; }
__device__ __forceinline__ unsigned pk2(float lo, float hi) { return f2bf(lo) | (f2bf(hi) << 16); }

#define XB_TMO      128
#define XB_XCNT(j)  (256  + 64 * (j))
#define XB_XSUB(j)  (1280 + 64 * (j))
#define XB_XGEN(j)  (2304 + 64 * (j))
#define XB_TOP      3328
#define XB_TOPGEN   3392
#define XCD_BAR_WORDS 3456
#define XB_SPIN_CAP (1u << 22)

__device__ __forceinline__ unsigned xb_ld(unsigned* p)              { return __hip_atomic_load(p, __ATOMIC_RELAXED, __HIP_MEMORY_SCOPE_AGENT); }
__device__ __forceinline__ unsigned xb_add(unsigned* p, unsigned v) { return __hip_atomic_fetch_add(p, v, __ATOMIC_RELAXED, __HIP_MEMORY_SCOPE_AGENT); }
__device__ __forceinline__ unsigned xb_xcc_id() { return (unsigned)__builtin_amdgcn_s_getreg((3 << 11) | 20) & 0xFu; }
#define XB_SPIN(cond, bar) do { unsigned _sp = 0; while (cond) { __builtin_amdgcn_s_sleep(1); \
    if ((++_sp & 255u) == 0u) { if (xb_ld(&(bar)[XB_TMO])) break; if (_sp > XB_SPIN_CAP) { atomicAdd(&(bar)[XB_TMO], 1u); break; } } } } while (0)

struct XcdBarrier {
    unsigned* bar; unsigned x;
    volatile LAS unsigned* st;
};

__device__ __forceinline__ XcdBarrier xcd_barrier_post(unsigned* bar, volatile LAS unsigned* st) {
    XcdBarrier b; b.bar = bar; b.x = xb_xcc_id(); b.st = st;
    if (threadIdx.x == 0) (void)xb_add(&bar[XB_XCNT(b.x)], 1u);
    return b;
}
__device__ __forceinline__ void xcd_barrier_complete(unsigned* bar, unsigned x, unsigned& nloc, unsigned& nx) {
    const unsigned G = gridDim.x * gridDim.y * gridDim.z;
    unsigned sum, cnt, mine, sp = 0u;
    for (;;) {
        sum = 0u; cnt = 0u; mine = 0u;
#pragma unroll
        for (unsigned j = 0; j < 16; ++j) { const unsigned c = xb_ld(&bar[XB_XCNT(j)]); sum += c; cnt += (c > 0u) ? 1u : 0u; mine = (j == x) ? c : mine; }
        if (sum == G) break;
        __builtin_amdgcn_s_sleep(1);
        if ((++sp & 255u) == 0u) { if (xb_ld(&bar[XB_TMO])) break; if (sp > XB_SPIN_CAP) { atomicAdd(&bar[XB_TMO], 1u); break; } }
    }
    nloc = mine > 0u ? mine : 1u; nx = cnt > 0u ? cnt : 1u;
}

__device__ __forceinline__ void xcd_barrier(const XcdBarrier& b) {
    asm volatile("s_waitcnt vmcnt(0)" ::: "memory");
    __syncthreads();
    if (threadIdx.x == 0) {
        unsigned* bar = b.bar;
        __builtin_amdgcn_s_waitcnt(0);
        unsigned nloc = b.st[0], nx = b.st[1];
        if (nloc == 0u) { xcd_barrier_complete(bar, b.x, nloc, nx); b.st[0] = nloc; b.st[1] = nx; }
        const unsigned old = xb_add(&bar[XB_XSUB(b.x)], 1u);
        const unsigned gen = old / nloc;
        if (old + 1u == (gen + 1u) * nloc) {
            __builtin_amdgcn_fence(__ATOMIC_RELEASE, "agent");
            asm volatile("s_waitcnt vmcnt(0)" ::: "memory");
            const unsigned og = xb_add(&bar[XB_TOP], 1u);
            const unsigned tg = og / nx;
            if (og + 1u == (tg + 1u) * nx) xb_add(&bar[XB_TOPGEN], 1u);
            else XB_SPIN(xb_ld(&bar[XB_TOPGEN]) == tg, bar);
            __builtin_amdgcn_fence(__ATOMIC_ACQUIRE, "agent");
            xb_add(&bar[XB_XGEN(b.x)], 1u);
            asm volatile("s_waitcnt vmcnt(0)" ::: "memory");
        } else {
            XB_SPIN(xb_ld(&bar[XB_XGEN(b.x)]) == gen, bar);
            __builtin_amdgcn_fence(__ATOMIC_ACQUIRE, "agent");
            asm volatile("s_waitcnt vmcnt(0)" ::: "memory");
        }
    }
    __syncthreads();
}

DI float bf_lo(unsigned w) { return __uint_as_float(w << 16); }
DI float bf_hi(unsigned w) { return __uint_as_float(w & 0xffff0000u); }
DI float wave_sum(float v) {
    v += __builtin_bit_cast(float, __builtin_amdgcn_update_dpp(0, __builtin_bit_cast(int, v), 0xB1, 0xF, 0xF, false));
    v += __builtin_bit_cast(float, __builtin_amdgcn_update_dpp(0, __builtin_bit_cast(int, v), 0x4E, 0xF, 0xF, false));
    v += __builtin_bit_cast(float, __builtin_amdgcn_update_dpp(0, __builtin_bit_cast(int, v), 0x141, 0xF, 0xF, false));
    v += __builtin_bit_cast(float, __builtin_amdgcn_update_dpp(0, __builtin_bit_cast(int, v), 0x140, 0xF, 0xF, false));
    v += __builtin_bit_cast(float, __builtin_amdgcn_update_dpp(0, __builtin_bit_cast(int, v), 0x142, 0xA, 0xF, false));
    v += __builtin_bit_cast(float, __builtin_amdgcn_update_dpp(0, __builtin_bit_cast(int, v), 0x143, 0xC, 0xF, false));
    return __builtin_bit_cast(float, __builtin_amdgcn_readlane(__builtin_bit_cast(int, v), 63));
}
DI float sigmoid_f(float x) { return 1.0f / (1.0f + __expf(-x)); }

struct Args {
    const float *x, *gdn_w_in, *gdn_conv_w, *gdn_a_log, *gdn_dt_bias, *gdn_norm_w, *gdn_w_out, *sb_w_in, *sb_w_out, *ffn_w_gate, *ffn_w_up, *ffn_w_down,
                *moe_router, *moe_w_gate, *moe_w_up, *moe_w_down, *ln_g, *ln_b;
    float* out; unsigned char* ws; int ph_lo, ph_hi;
};

DI void transpose_item(const float* W, int ldw, bf16* WT, int K, int drow0, int k0, int n0, LAS float* scr, int lane) {
#pragma unroll 8
    for (int i = 0; i < 32; ++i) { const int kk = 2 * i + (lane >> 5); scr[kk * 33 + (lane & 31)] = W[(size_t)(k0 + kk) * ldw + n0 + (lane & 31)]; }
    LDS_WAIT(); asm volatile("" ::: "memory");
    const int c = lane & 7;
#pragma unroll
    for (int jj = 0; jj < 4; ++jj) { const int n = (lane >> 3) + 8 * jj; const LAS float* s = scr + (8 * c) * 33 + n;
        v4u o; o.x = pk2(s[0 * 33], s[1 * 33]); o.y = pk2(s[2 * 33], s[3 * 33]); o.z = pk2(s[4 * 33], s[5 * 33]); o.w = pk2(s[6 * 33], s[7 * 33]);
        *(v4u*)(WT + (size_t)(drow0 + n) * K + k0 + 8 * c) = o; }
    LDS_WAIT(); asm volatile("" ::: "memory");
}

DI void transpose_item64(const float* W, int ldw, bf16* WT, int K, int drow0, int k0, int n0, LAS unsigned char* scr, int lane) {
    const int q = lane >> 4, cx = lane & 15;
    f32x4 r[16];
#pragma unroll
    for (int i = 0; i < 16; ++i) r[i] = *(const f32x4*)(W + (size_t)(k0 + 16 * q + i) * ldw + n0 + 4 * cx);
#pragma unroll
    for (int e = 0; e < 4; ++e) {
        v4u w0, w1;
        w0.x = pk2(r[0][e], r[1][e]); w0.y = pk2(r[2][e], r[3][e]); w0.z = pk2(r[4][e], r[5][e]); w0.w = pk2(r[6][e], r[7][e]);
        w1.x = pk2(r[8][e], r[9][e]); w1.y = pk2(r[10][e], r[11][e]); w1.z = pk2(r[12][e], r[13][e]); w1.w = pk2(r[14][e], r[15][e]);
        *(LAS v4u*)(scr + (4 * cx + e) * 144 + q * 32) = w0; *(LAS v4u*)(scr + (4 * cx + e) * 144 + q * 32 + 16) = w1;
    }
    LDS_WAIT(); asm volatile("" ::: "memory");
#pragma unroll
    for (int j = 0; j < 8; ++j) { const int id = lane + 64 * j, n = id >> 3, kp = id & 7;
        *(v4u*)(WT + (size_t)(drow0 + n) * K + k0 + 8 * kp) = *(const LAS v4u*)(scr + n * 144 + kp * 16); }
    LDS_WAIT(); asm volatile("" ::: "memory");
}

DI void phase_w_gdn(const Args& a, int j, LAS unsigned char* lds, int bid, int G, int tid, int wave, int lane) {
    LAS float* scr = (LAS float*)(lds + wave * 16384);
    const int gw = bid * NWAVES + wave, NGW = G * NWAVES;
    const float* Win = a.gdn_w_in + (size_t)j * D * GIN; const float* Wout = a.gdn_w_out + (size_t)j * 2048 * D;
    const float* Wg = a.ffn_w_gate + (size_t)j * D * FF; const float* Wu = a.ffn_w_up + (size_t)j * D * FF; const float* Wd = a.ffn_w_down + (size_t)j * FF * D;
    bf16* WIN_T = (bf16*)(a.ws + W_IN); bf16* WOUT_T = (bf16*)(a.ws + W_OUT); bf16* WGU_T = (bf16*)(a.ws + W_GU); bf16* WD_T = (bf16*)(a.ws + W_D);
    LAS unsigned char* scb = (LAS unsigned char*)scr;
    constexpr int I_IN = 16 * 96, I_INT = 16, I_OUT = 32 * 16, I_G = 16 * 56, I_D = 56 * 16, NIT = I_IN + I_INT + I_OUT + 2 * I_G + I_D;
    for (int it = gw; it < NIT; it += NGW) {
        int r = it;
        if (r < I_IN) { const int kb = r / 96, nb = r % 96; transpose_item64(Win, GIN, WIN_T, D, 64 * nb, 64 * kb, 64 * nb, scb, lane); continue; } r -= I_IN;
        if (r < I_INT) { transpose_item(Win, GIN, WIN_T, D, 6144, 64 * r, 6144, scr, lane); continue; } r -= I_INT;
        if (r < I_OUT) { const int kb = r / 16, nb = r % 16; transpose_item64(Wout, D, WOUT_T, 2048, 64 * nb, 64 * kb, 64 * nb, scb, lane); continue; } r -= I_OUT;
        if (r < I_G) { const int kb = r / 56, nb = r % 56, n0 = 64 * nb; transpose_item64(Wg, FF, WGU_T, D, 256 * (n0 >> 7) + (n0 & 127), 64 * kb, n0, scb, lane); continue; } r -= I_G;
        if (r < I_G) { const int kb = r / 56, nb = r % 56, n0 = 64 * nb; transpose_item64(Wu, FF, WGU_T, D, 256 * (n0 >> 7) + 128 + (n0 & 127), 64 * kb, n0, scb, lane); continue; } r -= I_G;
        { const int kb = r / 16, nb = r % 16; transpose_item64(Wd, D, WD_T, FF, 64 * nb, 64 * kb, 64 * nb, scb, lane); }
    }
    if (j == 0) {
        bf16* HB = (bf16*)(a.ws + WS_HB); const f32x4* x4 = (const f32x4*)a.x;
        for (size_t i = (size_t)bid * 512 + tid; i < (size_t)TT * D / 8; i += (size_t)G * 512) { const f32x4 p = x4[2 * i], q = x4[2 * i + 1];
            v4u o; o.x = pk2(p[0], p[1]); o.y = pk2(p[2], p[3]); o.z = pk2(q[0], q[1]); o.w = pk2(q[2], q[3]); *(v4u*)(HB + 8 * i) = o; }
    }
}
DI void phase_w_sb(const Args& a, int j, LAS unsigned char* lds, int bid, int G, int wave, int lane) {
    LAS float* scr = (LAS float*)(lds + wave * 16384);
    const int gw = bid * NWAVES + wave, NGW = G * NWAVES;
    const float* Wqkv = a.sb_w_in + (size_t)j * D * 3072; const float* Wo = a.sb_w_out + (size_t)j * D * D;
    const float* Mg = a.moe_w_gate + (size_t)j * NE * D * FF; const float* Mu = a.moe_w_up + (size_t)j * NE * D * FF; const float* Md = a.moe_w_down + (size_t)j * NE * FF * D;
    bf16* WQKV_T = (bf16*)(a.ws + W_QKV); bf16* WO_T = (bf16*)(a.ws + W_O); bf16* MGU_T = (bf16*)(a.ws + W_MGU); bf16* MD_T = (bf16*)(a.ws + W_MD);
    LAS unsigned char* scb = (LAS unsigned char*)scr;
    constexpr int I_QKV = 16 * 48, I_O = 16 * 16, I_G = 16 * 56, I_D = 56 * 16, I_E = 2 * I_G + I_D, NIT = I_QKV + I_O + NE * I_E;
    for (int it = gw; it < NIT; it += NGW) {
        int r = it;
        if (r < I_QKV) { const int kb = r / 48, nb = r % 48; transpose_item64(Wqkv, 3072, WQKV_T, D, 64 * nb, 64 * kb, 64 * nb, scb, lane); continue; } r -= I_QKV;
        if (r < I_O) { const int kb = r / 16, nb = r % 16; transpose_item64(Wo, D, WO_T, D, 64 * nb, 64 * kb, 64 * nb, scb, lane); continue; } r -= I_O;
        const int e = r / I_E; r -= e * I_E;
        bf16* gu = MGU_T + (size_t)e * 2 * FF * D; bf16* dn = MD_T + (size_t)e * D * FF;
        if (r < I_G) { const int kb = r / 56, nb = r % 56, n0 = 64 * nb; transpose_item64(Mg + (size_t)e * D * FF, FF, gu, D, 256 * (n0 >> 7) + (n0 & 127), 64 * kb, n0, scb, lane); continue; } r -= I_G;
        if (r < I_G) { const int kb = r / 56, nb = r % 56, n0 = 64 * nb; transpose_item64(Mu + (size_t)e * D * FF, FF, gu, D, 256 * (n0 >> 7) + 128 + (n0 & 127), 64 * kb, n0, scb, lane); continue; } r -= I_G;
        { const int kb = r / 16, nb = r % 16; transpose_item64(Md + (size_t)e * FF * D, D, dn, FF, 64 * nb, 64 * kb, 64 * nb, scb, lane); }
    }
}

DI float dpp_sum16(float v) {
    v += __builtin_bit_cast(float, __builtin_amdgcn_update_dpp(0, __builtin_bit_cast(int, v), 0xB1, 0xF, 0xF, false));
    v += __builtin_bit_cast(float, __builtin_amdgcn_update_dpp(0, __builtin_bit_cast(int, v), 0x4E, 0xF, 0xF, false));
    v += __builtin_bit_cast(float, __builtin_amdgcn_update_dpp(0, __builtin_bit_cast(int, v), 0x141, 0xF, 0xF, false));
    v += __builtin_bit_cast(float, __builtin_amdgcn_update_dpp(0, __builtin_bit_cast(int, v), 0x140, 0xF, 0xF, false));
    return v;
}
DI void phase_conv(const Args& a, int j, int bid, int G, int tid) {
    const bf16* raw = (const bf16*)(a.ws + WS_RAW); bf16* qkvc = (bf16*)(a.ws + WS_QKVC); float* gb = (float*)(a.ws + WS_GB);
    const float* cw = a.gdn_conv_w + (size_t)j * 4 * 4096;
    const int ch = 8 * tid;
    float w0[8], w1[8], w2[8], w3[8];
#pragma unroll
    for (int i = 0; i < 8; ++i) { w0[i] = cw[ch + i]; w1[i] = cw[4096 + ch + i]; w2[i] = cw[2 * 4096 + ch + i]; w3[i] = cw[3 * 4096 + ch + i]; }
    const float post = tid < 128 ? 0.08838834764831845f : 1.0f;
    for (int run = bid; run < TT / 128; run += G) {
        const int t0 = run * 128; const bool first = (t0 & (SEQ - 1)) == 0;
        float xa[8], xb[8], xc[8];
        { v4u h0 = {0u, 0u, 0u, 0u}, h1 = h0, h2 = h0;
          if (!first) { h0 = *(const v4u*)(raw + (size_t)(t0 - 3) * RAWLD + ch); h1 = *(const v4u*)(raw + (size_t)(t0 - 2) * RAWLD + ch); h2 = *(const v4u*)(raw + (size_t)(t0 - 1) * RAWLD + ch); }
          xa[0] = bf_lo(h0.x); xa[1] = bf_hi(h0.x); xa[2] = bf_lo(h0.y); xa[3] = bf_hi(h0.y); xa[4] = bf_lo(h0.z); xa[5] = bf_hi(h0.z); xa[6] = bf_lo(h0.w); xa[7] = bf_hi(h0.w);
          xb[0] = bf_lo(h1.x); xb[1] = bf_hi(h1.x); xb[2] = bf_lo(h1.y); xb[3] = bf_hi(h1.y); xb[4] = bf_lo(h1.z); xb[5] = bf_hi(h1.z); xb[6] = bf_lo(h1.w); xb[7] = bf_hi(h1.w);
          xc[0] = bf_lo(h2.x); xc[1] = bf_hi(h2.x); xc[2] = bf_lo(h2.y); xc[3] = bf_hi(h2.y); xc[4] = bf_lo(h2.z); xc[5] = bf_hi(h2.z); xc[6] = bf_lo(h2.w); xc[7] = bf_hi(h2.w); }
#pragma unroll 1
        for (int tb = 0; tb < 128; tb += 8) {
            v4u xr[8];
#pragma unroll
            for (int u = 0; u < 8; ++u) xr[u] = *(const v4u*)(raw + (size_t)(t0 + tb + u) * RAWLD + ch);
#pragma unroll
            for (int u = 0; u < 8; ++u) {
                float xd[8]; xd[0] = bf_lo(xr[u].x); xd[1] = bf_hi(xr[u].x); xd[2] = bf_lo(xr[u].y); xd[3] = bf_hi(xr[u].y); xd[4] = bf_lo(xr[u].z); xd[5] = bf_hi(xr[u].z); xd[6] = bf_lo(xr[u].w); xd[7] = bf_hi(xr[u].w);
                float y[8]; float ss = 0.f;
#pragma unroll
                for (int i = 0; i < 8; ++i) { const float c = w0[i] * xa[i] + w1[i] * xb[i] + w2[i] * xc[i] + w3[i] * xd[i];
                    y[i] = c * __builtin_amdgcn_rcpf(1.0f + __builtin_amdgcn_exp2f(-1.4426950408889634f * c)); ss += y[i] * y[i];
                    xa[i] = xb[i]; xb[i] = xc[i]; xc[i] = xd[i]; }
                if (tid < 256) {
                    const float rn = post / sqrtf(dpp_sum16(ss) + RMS_EPS);
#pragma unroll
                    for (int i = 0; i < 8; ++i) y[i] *= rn;
                }
                v4u o; o.x = pk2(y[0], y[1]); o.y = pk2(y[2], y[3]); o.z = pk2(y[4], y[5]); o.w = pk2(y[6], y[7]);
                *(v4u*)(qkvc + (size_t)(t0 + tb + u) * 4096 + ch) = o;
            }
        }
#pragma unroll
        for (int k = 0; k < 4; ++k) { const int item = tid + 512 * k, tok = t0 + (item >> 4), hv = item & 15;
            const float bb = __uint_as_float((unsigned)raw[(size_t)tok * RAWLD + 4096 + hv] << 16), aa = __uint_as_float((unsigned)raw[(size_t)tok * RAWLD + 4112 + hv] << 16);
            const float xx = aa + a.gdn_dt_bias[j * 16 + hv];
            const float sp = xx > 20.f ? xx : log1pf(__expf(xx));
            gb[(size_t)tok * 32 + hv] = -__expf(a.gdn_a_log[j * 16 + hv]) * sp;
            gb[(size_t)tok * 32 + 16 + hv] = sigmoid_f(bb); }
    }
}

DI void phase_gdn_naive(const Args& a, int j, LAS unsigned char* lds, int bid, int tid) {
    if (bid >= BATCH * HV) return;
    const int b = bid / HV, hv = bid % HV, hk = hv / 2, jc = tid & 127, r = tid >> 7;
    const bf16* zb = (const bf16*)(a.ws + WS_ZB); bf16* qkvc = (bf16*)(a.ws + WS_QKVC); const float* gb = (const float*)(a.ws + WS_GB);
    LAS float* qs = (LAS float*)lds; LAS float* ks = qs + 2048; LAS float* vs = ks + 2048; LAS float* gs = vs + 2048; LAS float* bs = gs + 16;
    LAS f32x2* red = (LAS f32x2*)(lds + 32768); LAS float* redkq = (LAS float*)(lds + 32768 + 8192); LAS float* ob = (LAS float*)(lds + 49152);
    float S[32];
#pragma unroll
    for (int i = 0; i < 32; ++i) S[i] = 0.f;
    const int lrow = tid >> 5, lcol = (tid & 31) * 4;
    for (int blk = 0; blk < SEQ / 16; ++blk) {
        const size_t t0 = (size_t)b * SEQ + blk * 16;
        __syncthreads();
        { const bf16* rowp = qkvc + (t0 + lrow) * 4096;
          const v2u qv = *(const v2u*)(rowp + hk * 128 + lcol), kv = *(const v2u*)(rowp + 1024 + hk * 128 + lcol), vv = *(const v2u*)(rowp + 2048 + hv * 128 + lcol);
          *(LAS f32x4*)(qs + lrow * 128 + lcol) = (f32x4){bf_lo(qv.x), bf_hi(qv.x), bf_lo(qv.y), bf_hi(qv.y)};
          *(LAS f32x4*)(ks + lrow * 128 + lcol) = (f32x4){bf_lo(kv.x), bf_hi(kv.x), bf_lo(kv.y), bf_hi(kv.y)};
          *(LAS f32x4*)(vs + lrow * 128 + lcol) = (f32x4){bf_lo(vv.x), bf_hi(vv.x), bf_lo(vv.y), bf_hi(vv.y)};
          if (tid < 16) { gs[tid] = __expf(gb[(t0 + tid) * 32 + hv]); bs[tid] = gb[(t0 + tid) * 32 + 16 + hv]; } }
        __syncthreads();
#pragma unroll 1
        for (int tt = 0; tt < 16; ++tt) {
            float pk = 0.f, pq = 0.f, pkq = 0.f;
#pragma unroll
            for (int i4 = 0; i4 < 8; ++i4) { const f32x4 k4 = *(const LAS f32x4*)(ks + tt * 128 + 32 * r + 4 * i4), q4 = *(const LAS f32x4*)(qs + tt * 128 + 32 * r + 4 * i4);
#pragma unroll
                for (int c = 0; c < 4; ++c) { pk += k4[c] * S[4 * i4 + c]; pq += q4[c] * S[4 * i4 + c]; pkq += k4[c] * q4[c]; } }
            const int buf = tt & 1;
            red[(buf * 4 + r) * 128 + jc] = (f32x2){pk, pq}; if (jc == 0) redkq[buf * 4 + r] = pkq;
            __syncthreads();
            float kS = 0.f, qS = 0.f, kq = 0.f;
#pragma unroll
            for (int rr = 0; rr < 4; ++rr) { const f32x2 p = red[(buf * 4 + rr) * 128 + jc]; kS += p.x; qS += p.y; kq += redkq[buf * 4 + rr]; }
            const float eg = gs[tt], vn = bs[tt] * (vs[tt * 128 + jc] - eg * kS);
#pragma unroll
            for (int i4 = 0; i4 < 8; ++i4) { const f32x4 k4 = *(const LAS f32x4*)(ks + tt * 128 + 32 * r + 4 * i4);
#pragma unroll
                for (int c = 0; c < 4; ++c) S[4 * i4 + c] = eg * S[4 * i4 + c] + k4[c] * vn; }
            if (r == 0) ob[tt * 128 + jc] = eg * qS + kq * vn;
        }
        __syncthreads();
        {
            const f32x4 o4 = *(const LAS f32x4*)(ob + lrow * 128 + lcol);
            float ss = o4[0] * o4[0] + o4[1] * o4[1] + o4[2] * o4[2] + o4[3] * o4[3];
            ss += __shfl_xor(ss, 1); ss += __shfl_xor(ss, 2); ss += __shfl_xor(ss, 4); ss += __shfl_xor(ss, 8); ss += __shfl_xor(ss, 16);
            const float rinv = 1.0f / sqrtf(ss * (1.0f / 128.0f) + RMS_EPS);
            const v2u zv = *(const v2u*)(zb + (t0 + lrow) * 2048 + hv * 128 + lcol);
            const f32x4 nw = *(const f32x4*)(a.gdn_norm_w + j * 128 + lcol);
            const float z0 = bf_lo(zv.x), z1 = bf_hi(zv.x), z2 = bf_lo(zv.y), z3 = bf_hi(zv.y);
            v2u o; o.x = pk2(o4[0] * rinv * nw[0] * z0 * sigmoid_f(z0), o4[1] * rinv * nw[1] * z1 * sigmoid_f(z1));
            o.y = pk2(o4[2] * rinv * nw[2] * z2 * sigmoid_f(z2), o4[3] * rinv * nw[3] * z3 * sigmoid_f(z3));
            *(v2u*)(qkvc + (t0 + lrow) * 4096 + 2048 + hv * 128 + lcol) = o;
        }
    }
}

DI void unpack8(const v4u w, float (&x)[8]) { x[0] = bf_lo(w.x); x[1] = bf_hi(w.x); x[2] = bf_lo(w.y); x[3] = bf_hi(w.y); x[4] = bf_lo(w.z); x[5] = bf_hi(w.z); x[6] = bf_lo(w.w); x[7] = bf_hi(w.w); }
template <bool ROUTER>
DI void phase_ln(const Args& a, const bf16* Y, int lnidx, int j, LAS unsigned char* lds, int bid, int G, int tid, int wave, int lane) {
    bf16* HB = (bf16*)(a.ws + WS_HB); float* stats = (float*)(a.ws + WS_STATS);
    const float* g = a.ln_g + (size_t)lnidx * D; const float* bta = a.ln_b + (size_t)lnidx * D;
    const int gw = bid * NWAVES + wave, NGW = G * NWAVES;
    LAS unsigned* lcnt = (LAS unsigned*)lds;
    LAS float* RT = (LAS float*)(lds + 1024);
    if (ROUTER) { if (tid < 8) lcnt[tid] = 0u;
        const float* R = a.moe_router + (size_t)j * D * NE;
#pragma unroll
        for (int i = 0; i < 2; ++i) { const int k = tid + 512 * i; const f32x4 r0 = *(const f32x4*)(R + k * 8), r1 = *(const f32x4*)(R + k * 8 + 4);
            RT[0 * 1024 + k] = r0[0]; RT[1 * 1024 + k] = r0[1]; RT[2 * 1024 + k] = r0[2]; RT[3 * 1024 + k] = r0[3]; RT[4 * 1024 + k] = r1[0]; RT[5 * 1024 + k] = r1[1]; RT[6 * 1024 + k] = r1[2]; RT[7 * 1024 + k] = r1[3]; }
        __syncthreads(); }
    float gv[2][8], bv[2][8];
#pragma unroll
    for (int q = 0; q < 2; ++q)
#pragma unroll
        for (int c = 0; c < 8; ++c) { gv[q][c] = g[8 * (lane + 64 * q) + c]; bv[q][c] = bta[8 * (lane + 64 * q) + c]; }
    v4u nx[2];
    if (gw < TT) { nx[0] = ((const v4u*)(Y + (size_t)gw * D))[lane]; nx[1] = ((const v4u*)(Y + (size_t)gw * D))[lane + 64]; }
    for (int t = gw; t < TT; t += NGW) {
        float v[2][8]; float s = 0.f;
        unpack8(nx[0], v[0]); unpack8(nx[1], v[1]);
        if (t + NGW < TT) { nx[0] = ((const v4u*)(Y + (size_t)(t + NGW) * D))[lane]; nx[1] = ((const v4u*)(Y + (size_t)(t + NGW) * D))[lane + 64]; }
#pragma unroll
        for (int q = 0; q < 2; ++q)
#pragma unroll
            for (int c = 0; c < 8; ++c) s += v[q][c];
        const float mean = wave_sum(s) * (1.0f / D); float s2 = 0.f;
#pragma unroll
        for (int q = 0; q < 2; ++q)
#pragma unroll
            for (int c = 0; c < 8; ++c) { v[q][c] -= mean; s2 += v[q][c] * v[q][c]; }
        const float rstd = 1.0f / sqrtf(wave_sum(s2) * (1.0f / D) + LN_EPS);
        if (lane == 0) *(f32x2*)(stats + 2 * (size_t)t) = (f32x2){mean, rstd};
#pragma unroll
        for (int q = 0; q < 2; ++q) {
#pragma unroll
            for (int c = 0; c < 8; ++c) v[q][c] = v[q][c] * rstd * gv[q][c] + bv[q][c];
            v4u o; o.x = pk2(v[q][0], v[q][1]); o.y = pk2(v[q][2], v[q][3]); o.z = pk2(v[q][4], v[q][5]); o.w = pk2(v[q][6], v[q][7]);
            ((v4u*)(HB + (size_t)t * D))[lane + 64 * q] = o; }
        if (ROUTER) {
            float lg[8];
#pragma unroll
            for (int e = 0; e < 8; ++e) { lg[e] = 0.f;
#pragma unroll
                for (int q = 0; q < 2; ++q) { const f32x4 r0 = *(const LAS f32x4*)(RT + e * 1024 + 8 * (lane + 64 * q)), r1 = *(const LAS f32x4*)(RT + e * 1024 + 8 * (lane + 64 * q) + 4);
                    lg[e] += (v[q][0] * r0[0] + v[q][1] * r0[1]) + (v[q][2] * r0[2] + v[q][3] * r0[3]) + (v[q][4] * r1[0] + v[q][5] * r1[1]) + (v[q][6] * r1[2] + v[q][7] * r1[3]); } }
#pragma unroll
            for (int e = 0; e < 8; ++e) lg[e] = wave_sum(lg[e]);
            int i1 = 0; float v1 = lg[0];
#pragma unroll
            for (int e = 1; e < 8; ++e) if (lg[e] > v1) { v1 = lg[e]; i1 = e; }
            int i2 = -1; float v2 = -3.0e38f;
#pragma unroll
            for (int e = 0; e < 8; ++e) if (e != i1 && lg[e] > v2) { v2 = lg[e]; i2 = e; }
            if (lane == 0) {
                const float g1 = 1.0f / (1.0f + __expf(v2 - v1));
                ((unsigned*)(a.ws + WS_E12))[t] = (unsigned)i1 | ((unsigned)i2 << 8);
                ((f32x2*)(a.ws + WS_G12))[t] = (f32x2){g1, 1.0f - g1};
                __hip_atomic_fetch_add(lcnt + i1, 1u, __ATOMIC_RELAXED, __HIP_MEMORY_SCOPE_WORKGROUP); __hip_atomic_fetch_add(lcnt + i2, 1u, __ATOMIC_RELAXED, __HIP_MEMORY_SCOPE_WORKGROUP);
            }
        }
    }
    if (ROUTER) { __syncthreads(); if (tid < 8) { unsigned* cnt = (unsigned*)(a.ws + WS_CTL) + CW_CNT + 256 * j; __hip_atomic_fetch_add(cnt + tid, lcnt[tid], __ATOMIC_RELAXED, __HIP_MEMORY_SCOPE_AGENT); } }
}

DI void phase_sb_naive(const Args& a, LAS unsigned char* lds, int bid, int G, int tid) {
    const bf16* qkv = (const bf16*)(a.ws + WS_QKV); bf16* ao = (bf16*)(a.ws + WS_AO);
    LAS unsigned char* Ks = lds; LAS unsigned char* Vs = lds + 16384;
    const int qi = tid >> 2, r = tid & 3;
    for (int idx = bid; idx < 64 * 32; idx += G) {
        const int qb = 31 - idx / 64, bh = idx % 64, b = bh >> 3, h = bh & 7;
        const int t = qb * 128 + qi;
        const size_t rowq = (size_t)b * SEQ + t;
        float q[32], o[32];
        { const bf16* qp = qkv + rowq * 3072 + h * 128 + 32 * r;
#pragma unroll
          for (int c = 0; c < 4; ++c) { const v4u w = *(const v4u*)(qp + 8 * c);
              q[8 * c + 0] = bf_lo(w.x); q[8 * c + 1] = bf_hi(w.x); q[8 * c + 2] = bf_lo(w.y); q[8 * c + 3] = bf_hi(w.y);
              q[8 * c + 4] = bf_lo(w.z); q[8 * c + 5] = bf_hi(w.z); q[8 * c + 6] = bf_lo(w.w); q[8 * c + 7] = bf_hi(w.w); }
#pragma unroll
          for (int i = 0; i < 32; ++i) { q[i] *= 0.08838834764831845f; o[i] = 0.f; } }
        float P = 1.0f;
        for (int kt = 2 * qb + 1; kt >= 0; --kt) {
            __syncthreads();
#pragma unroll
            for (int i = 0; i < 2; ++i) { const int c = tid + 512 * i, row = c >> 4, part = c & 15;
                const bf16* src = qkv + ((size_t)b * SEQ + kt * 64 + row) * 3072 + h * 128 + part * 8;
                *(LAS v4u*)(Ks + c * 16) = *(const v4u*)(src + 1024); *(LAS v4u*)(Vs + c * 16) = *(const v4u*)(src + 2048); }
            __syncthreads();
#pragma unroll 1
            for (int s = 63; s >= 0; --s) {
                float z = 0.f;
#pragma unroll
                for (int c = 0; c < 4; ++c) { const v4u w = *(const LAS v4u*)(Ks + s * 256 + r * 64 + c * 16);
                    z += q[8 * c + 0] * bf_lo(w.x) + q[8 * c + 1] * bf_hi(w.x) + q[8 * c + 2] * bf_lo(w.y) + q[8 * c + 3] * bf_hi(w.y)
                       + q[8 * c + 4] * bf_lo(w.z) + q[8 * c + 5] * bf_hi(w.z) + q[8 * c + 6] * bf_lo(w.w) + q[8 * c + 7] * bf_hi(w.w); }
                z += __shfl_xor(z, 1); z += __shfl_xor(z, 2);
                const bool live = (kt * 64 + s) < t;
                const float e = __expf(fminf(z, 80.f)), rr = 1.0f / (1.0f + e);
                const float A = live ? e * rr * P : 0.f;
                P = live ? P * rr : P;
#pragma unroll
                for (int c = 0; c < 4; ++c) { const v4u w = *(const LAS v4u*)(Vs + s * 256 + r * 64 + c * 16);
                    o[8 * c + 0] += A * bf_lo(w.x); o[8 * c + 1] += A * bf_hi(w.x); o[8 * c + 2] += A * bf_lo(w.y); o[8 * c + 3] += A * bf_hi(w.y);
                    o[8 * c + 4] += A * bf_lo(w.z); o[8 * c + 5] += A * bf_hi(w.z); o[8 * c + 6] += A * bf_lo(w.w); o[8 * c + 7] += A * bf_hi(w.w); }
            }
        }
        { bf16* op = ao + rowq * 1024 + h * 128 + 32 * r;
#pragma unroll
          for (int c = 0; c < 4; ++c) { v4u w; w.x = pk2(o[8 * c + 0], o[8 * c + 1]); w.y = pk2(o[8 * c + 2], o[8 * c + 3]); w.z = pk2(o[8 * c + 4], o[8 * c + 5]); w.w = pk2(o[8 * c + 6], o[8 * c + 7]);
              *(v4u*)(op + 8 * c) = w; } }
    }
}


typedef float f2v_ __attribute__((ext_vector_type(2)));
typedef __bf16 b2v_ __attribute__((ext_vector_type(2)));
DI unsigned gdnpk(float a, float b) { const f2v_ v = {a, b}; const b2v_ r = __builtin_convertvector(v, b2v_); return __builtin_bit_cast(unsigned, r); }
namespace sba {
using bf16x8 = __attribute__((ext_vector_type(8))) short;
using s16x4  = __attribute__((ext_vector_type(4))) short;
using f32x16 = __attribute__((ext_vector_type(16))) float;
constexpr int SHM_V = 16384, KPITCH = 272, SHM_K = 64 * KPITCH, LDQ = 3072;
#define KSWZ(row, colB) ((row) * KPITCH + (colB))
#define SBAR() __builtin_amdgcn_sched_barrier(0)
DI int crow(int r, int hi) { return (r & 3) + 8 * (r >> 2) + 4 * hi; }
DI int v_st(int k, int c) { const int kk = (k & ~0xC) | ((k & 4) << 1) | ((k & 8) >> 1); return ((kk >> 3) * 4 + (c >> 5)) * 512 + ((kk & 7) * 32 + (c & 31)) * 2; }
DI int v_rd_base(int lane) { return ((lane & 3) << 3) | (((lane >> 2) & 3) << 6) | (((lane >> 4) & 1) << 5) | (((lane >> 5) & 1) << 8); }
constexpr int v_rd_off(int d0, int ks, int half) { return d0 * 512 + ks * 4096 + half * 2048; }
template <int OFF> DI s16x4 tr_read(int vb) { s16x4 r; asm volatile("ds_read_b64_tr_b16 %0, %1 offset:%2" : "=&v"(r) : "v"(vb), "i"(OFF) : "memory"); return r; }
template <int D0> DI void pv_one(f32x16& od, int vb, bf16x8 pa0, bf16x8 pa1, bf16x8 pa2, bf16x8 pa3) {
  const s16x4 l0 = tr_read<v_rd_off(D0, 0, 0)>(vb), h0 = tr_read<v_rd_off(D0, 0, 1)>(vb), l1 = tr_read<v_rd_off(D0, 1, 0)>(vb), h1 = tr_read<v_rd_off(D0, 1, 1)>(vb);
  const s16x4 l2 = tr_read<v_rd_off(D0, 2, 0)>(vb), h2 = tr_read<v_rd_off(D0, 2, 1)>(vb), l3 = tr_read<v_rd_off(D0, 3, 0)>(vb), h3 = tr_read<v_rd_off(D0, 3, 1)>(vb);
  asm volatile("s_waitcnt lgkmcnt(0)" ::: "memory"); SBAR();
#define PK(L, H) (bf16x8){L[0], L[1], L[2], L[3], H[0], H[1], H[2], H[3]}
  od = __builtin_amdgcn_mfma_f32_32x32x16_bf16(pa0, PK(l0, h0), od, 0, 0, 0);
  od = __builtin_amdgcn_mfma_f32_32x32x16_bf16(pa1, PK(l1, h1), od, 0, 0, 0);
  od = __builtin_amdgcn_mfma_f32_32x32x16_bf16(pa2, PK(l2, h2), od, 0, 0, 0);
  od = __builtin_amdgcn_mfma_f32_32x32x16_bf16(pa3, PK(l3, h3), od, 0, 0, 0);
#undef PK
}
template <int D0> DI void pv_one_T(f32x16& od, int vb, bf16x8 pa0, bf16x8 pa1, bf16x8 pa2, bf16x8 pa3) {
  const s16x4 l0 = tr_read<v_rd_off(D0, 0, 0)>(vb), h0 = tr_read<v_rd_off(D0, 0, 1)>(vb), l1 = tr_read<v_rd_off(D0, 1, 0)>(vb), h1 = tr_read<v_rd_off(D0, 1, 1)>(vb);
  const s16x4 l2 = tr_read<v_rd_off(D0, 2, 0)>(vb), h2 = tr_read<v_rd_off(D0, 2, 1)>(vb), l3 = tr_read<v_rd_off(D0, 3, 0)>(vb), h3 = tr_read<v_rd_off(D0, 3, 1)>(vb);
  asm volatile("s_waitcnt lgkmcnt(0)" ::: "memory"); SBAR();
#define PK(L, H) (bf16x8){L[0], L[1], L[2], L[3], H[0], H[1], H[2], H[3]}
  od = __builtin_amdgcn_mfma_f32_32x32x16_bf16(PK(l0, h0), pa0, od, 0, 0, 0);
  od = __builtin_amdgcn_mfma_f32_32x32x16_bf16(PK(l1, h1), pa1, od, 0, 0, 0);
  od = __builtin_amdgcn_mfma_f32_32x32x16_bf16(PK(l2, h2), pa2, od, 0, 0, 0);
  od = __builtin_amdgcn_mfma_f32_32x32x16_bf16(PK(l3, h3), pa3, od, 0, 0, 0);
#undef PK
}
DI void pv_split(f32x16& od, int vb, bf16x8 pa0, bf16x8 pa1, bf16x8 pa2, bf16x8 pa3) {
  const s16x4 l0 = tr_read<v_rd_off(0, 0, 0)>(vb), h0 = tr_read<v_rd_off(0, 0, 1)>(vb), l1 = tr_read<v_rd_off(0, 1, 0)>(vb), h1 = tr_read<v_rd_off(0, 1, 1)>(vb);
  const s16x4 l2 = tr_read<v_rd_off(0, 2, 0)>(vb), h2 = tr_read<v_rd_off(0, 2, 1)>(vb), l3 = tr_read<v_rd_off(0, 3, 0)>(vb), h3 = tr_read<v_rd_off(0, 3, 1)>(vb);
  asm volatile("s_waitcnt lgkmcnt(0)" ::: "memory"); SBAR();
#define PK(L, H) (bf16x8){L[0], L[1], L[2], L[3], H[0], H[1], H[2], H[3]}
  f32x16 ob = {};
  od = __builtin_amdgcn_mfma_f32_32x32x16_bf16(pa0, PK(l0, h0), od, 0, 0, 0); ob = __builtin_amdgcn_mfma_f32_32x32x16_bf16(pa2, PK(l2, h2), ob, 0, 0, 0);
  od = __builtin_amdgcn_mfma_f32_32x32x16_bf16(pa1, PK(l1, h1), od, 0, 0, 0); ob = __builtin_amdgcn_mfma_f32_32x32x16_bf16(pa3, PK(l3, h3), ob, 0, 0, 0);
  od = od + ob;
#undef PK
}
DI void pv_split_T(f32x16& od, int vb, bf16x8 pa0, bf16x8 pa1, bf16x8 pa2, bf16x8 pa3) {
  const s16x4 l0 = tr_read<v_rd_off(0, 0, 0)>(vb), h0 = tr_read<v_rd_off(0, 0, 1)>(vb), l1 = tr_read<v_rd_off(0, 1, 0)>(vb), h1 = tr_read<v_rd_off(0, 1, 1)>(vb);
  const s16x4 l2 = tr_read<v_rd_off(0, 2, 0)>(vb), h2 = tr_read<v_rd_off(0, 2, 1)>(vb), l3 = tr_read<v_rd_off(0, 3, 0)>(vb), h3 = tr_read<v_rd_off(0, 3, 1)>(vb);
  asm volatile("s_waitcnt lgkmcnt(0)" ::: "memory"); SBAR();
#define PK(L, H) (bf16x8){L[0], L[1], L[2], L[3], H[0], H[1], H[2], H[3]}
  f32x16 ob = {};
  od = __builtin_amdgcn_mfma_f32_32x32x16_bf16(PK(l0, h0), pa0, od, 0, 0, 0); ob = __builtin_amdgcn_mfma_f32_32x32x16_bf16(PK(l2, h2), pa2, ob, 0, 0, 0);
  od = __builtin_amdgcn_mfma_f32_32x32x16_bf16(PK(l1, h1), pa1, od, 0, 0, 0); ob = __builtin_amdgcn_mfma_f32_32x32x16_bf16(PK(l3, h3), pa3, ob, 0, 0, 0);
  od = od + ob;
#undef PK
}
DI void qkt(f32x16& p0, f32x16& p1, const LAS unsigned char* Ks, const bf16x8 (&qr)[8], int r32, int hi) {
  p0 = f32x16{}; p1 = f32x16{};
#pragma unroll
  for (int d0 = 0; d0 < 8; ++d0) { const int cb = (d0 * 16 + hi * 8) * 2;
    const bf16x8 b0 = *(const LAS bf16x8*)(Ks + KSWZ(r32, cb));
    const bf16x8 b1 = *(const LAS bf16x8*)(Ks + KSWZ(32 + r32, cb));
    p0 = __builtin_amdgcn_mfma_f32_32x32x16_bf16(b0, qr[d0], p0, 0, 0, 0);
    p1 = __builtin_amdgcn_mfma_f32_32x32x16_bf16(b1, qr[d0], p1, 0, 0, 0); }
}
template <bool MASK> DI void sb_half(f32x16& p, float& Pc, int hi, int kbase, int trow) {
  float kk[16];
#pragma unroll
  for (int r = 0; r < 16; ++r) {
    float z = p[r];
    if (MASK) z = (kbase + crow(r, hi) < trow) ? z : -__builtin_inff();
    kk[r] = __builtin_amdgcn_rcpf(1.0f + __builtin_amdgcn_exp2f(z));
  }
  float R0[4], R1[4];
#pragma unroll
  for (int g = 0; g < 4; ++g) {
    const float c2 = kk[4 * g + 3], c1 = c2 * kk[4 * g + 2], c0 = c1 * kk[4 * g + 1], R = c0 * kk[4 * g];
    p[4 * g + 3] = 1.0f - c2; p[4 * g + 2] = c2 - c1; p[4 * g + 1] = c1 - c0; p[4 * g] = c0 - R;
    const auto sw = __builtin_amdgcn_permlane32_swap(__float_as_uint(R), __float_as_uint(R), false, false);
    R0[g] = __uint_as_float(sw[0]); R1[g] = __uint_as_float(sw[1]);
  }
#pragma unroll
  for (int g = 3; g >= 0; --g) {
    const float Pin = hi ? Pc : Pc * R1[g];
    p[4 * g + 3] *= Pin; p[4 * g + 2] *= Pin; p[4 * g + 1] *= Pin; p[4 * g] *= Pin;
    Pc *= R0[g] * R1[g];
  }
}
DI unsigned cvtpk(float lo, float hi) { unsigned r; asm volatile("v_cvt_pk_bf16_f32 %0, %1, %2" : "=v"(r) : "v"(lo), "v"(hi)); return r; }
#define PK4(P, BASE, OUT) do { const unsigned a0 = cvtpk(P[BASE + 0], P[BASE + 1]), a1 = cvtpk(P[BASE + 2], P[BASE + 3]);   \
    const unsigned b0 = cvtpk(P[BASE + 4], P[BASE + 5]), b1 = cvtpk(P[BASE + 6], P[BASE + 7]);                              \
    const auto r0 = __builtin_amdgcn_permlane32_swap(a0, b0, false, false); const auto r1 = __builtin_amdgcn_permlane32_swap(a1, b1, false, false); \
    const v4u w = {r0[0], r1[0], r0[1], r1[1]}; OUT = __builtin_bit_cast(bf16x8, w); } while (0)

DI void unit(const bf16* qkv, bf16* ao, int b, int h, int qb, LAS unsigned char* lds, int tid) {
  const int wid = __builtin_amdgcn_readfirstlane(tid >> 6), lane = tid & 63, r32 = lane & 31, hi = lane >> 5;
  const bool late = wid >= 4;
  LAS unsigned char* V_lds = lds; LAS unsigned char* K_lds = lds + 3 * SHM_V;
  const size_t rowbase = (size_t)b * SEQ; const int q0 = qb * 256, t_lo = q0 + wid * 32, trow = t_lo + r32;
  bf16x8 qr[8];
  { const bf16* Qw = qkv + (rowbase + trow) * LDQ + h * 128 + hi * 8; constexpr float C = 0.08838834764831845f * 1.4426950408889634f;
#pragma unroll
    for (int d0 = 0; d0 < 8; ++d0) { const v4u w = *(const v4u*)(Qw + d0 * 16); v4u o;
      o.x = gdnpk(bf_lo(w.x) * C, bf_hi(w.x) * C); o.y = gdnpk(bf_lo(w.y) * C, bf_hi(w.y) * C); o.z = gdnpk(bf_lo(w.z) * C, bf_hi(w.z) * C); o.w = gdnpk(bf_lo(w.w) * C, bf_hi(w.w) * C);
      qr[d0] = __builtin_bit_cast(bf16x8, o); } }
  const bf16* Kh = qkv + rowbase * LDQ + 1024 + h * 128; const bf16* Vh = Kh + 1024;
  const int sr = tid >> 4, sc = (tid & 15) * 8, vst0 = v_st(sr, sc), vst1 = v_st(32 + sr, sc);
  const int vb0 = (int)(unsigned)(size_t)V_lds + v_rd_base(lane);
  bf16x8 vs0, vs1, ks0, ks1;
  const unsigned soff = (unsigned)(sr * LDQ + sc) * 2u;
#define SLOAD(k0) do { const char* kb_ = (const char*)(Kh + (size_t)(k0) * LDQ); const char* vb_ = (const char*)(Vh + (size_t)(k0) * LDQ); \
    vs0 = *(const bf16x8*)(vb_ + soff); vs1 = *(const bf16x8*)(vb_ + (size_t)32 * LDQ * 2 + soff); ks0 = *(const bf16x8*)(kb_ + soff); ks1 = *(const bf16x8*)(kb_ + (size_t)32 * LDQ * 2 + soff); } while (0)
#define SWRITE(bb) do { *(LAS bf16x8*)(V_lds + (bb) * SHM_V + vst0) = vs0; *(LAS bf16x8*)(V_lds + (bb) * SHM_V + vst1) = vs1; const int kc = sc * 2; \
    *(LAS bf16x8*)(K_lds + (bb) * SHM_K + KSWZ(sr, kc)) = ks0; *(LAS bf16x8*)(K_lds + (bb) * SHM_K + KSWZ(32 + sr, kc)) = ks1; } while (0)
  f32x16 o[4] = {}; float Pc = 1.0f;
  f32x16 p0 = {}, p1 = {};
  const int NT = qb * 4 + 4;
  SLOAD((NT - 1) * 64);
  int bufc = 0, bufp = 0;
  for (int wi = 0; wi <= NT; ++wi) {
    const int kt = NT - 1 - wi, k0 = kt * 64;
    SEC_IN(4);
    if (wi < NT) { asm volatile("s_waitcnt vmcnt(0)" ::: "memory"); SWRITE(bufc); if (kt > 0) SLOAD(k0 - 64); }
    __syncthreads();
    SEC_OUT(4); SEC_IN(5);
    if (!late && wi < NT && k0 < t_lo + 31) qkt(p0, p1, K_lds + bufc * SHM_K, qr, r32, hi);
    { const int ka = late ? k0 + 64 : k0;
      const bool doit = late ? (wi > 0 && ka < t_lo + 31) : (wi < NT && k0 < t_lo + 31);
      if (doit) {
        bf16x8 pa0, pa1, pa2, pa3;
        if (ka + 63 >= t_lo) { sb_half<true>(p1, Pc, hi, ka + 32, trow); PK4(p1, 0, pa2); PK4(p1, 8, pa3); SBAR(); sb_half<true>(p0, Pc, hi, ka, trow); }
        else { sb_half<false>(p1, Pc, hi, ka + 32, trow); PK4(p1, 0, pa2); PK4(p1, 8, pa3); SBAR(); sb_half<false>(p0, Pc, hi, ka, trow); }
        PK4(p0, 0, pa0); PK4(p0, 8, pa1);
        const int vb = vb0 + (late ? bufp : bufc) * SHM_V;
        pv_one<0>(o[0], vb, pa0, pa1, pa2, pa3); pv_one<1>(o[1], vb, pa0, pa1, pa2, pa3); pv_one<2>(o[2], vb, pa0, pa1, pa2, pa3); pv_one<3>(o[3], vb, pa0, pa1, pa2, pa3);
      } }
    if (late && wi < NT && k0 < t_lo + 31) qkt(p0, p1, K_lds + bufc * SHM_K, qr, r32, hi);
    SEC_OUT(5);
    bufp = bufc; bufc = (bufc == 2) ? 0 : bufc + 1;
  }
  { bf16* Ob = ao + ((size_t)b * SEQ + qb * 256 + wid * 32) * 1024 + h * 128; const unsigned ooff = (unsigned)(4 * hi * 1024 + r32);
#pragma unroll
    for (int r = 0; r < 16; ++r)
#pragma unroll
      for (int d0 = 0; d0 < 4; ++d0) Ob[ooff + (unsigned)(((r & 3) + 8 * (r >> 2)) * 1024 + d0 * 32)] = (bf16)(cvtpk(o[d0][r], 0.f) & 0xffffu); }
#undef SLOAD
#undef SWRITE
}
#undef PK4
#undef KSWZ
#undef SBAR
}
DI void phase_sb_mfma(const Args& a, LAS unsigned char* lds, int bid, int G, int tid) {
    const bf16* qkv = (const bf16*)(a.ws + WS_QKV); bf16* ao = (bf16*)(a.ws + WS_AO);
    const int vcu = (G % 8 == 0) ? (bid % 8) * (G / 8) + bid / 8 : bid;
    for (int pi = vcu; pi < 512; pi += G) {
        const int bh = pi >> 3, p = pi & 7, b = bh >> 3, h = bh & 7;
        sba::unit(qkv, ao, b, h, 15 - p, lds, tid);
        sba::unit(qkv, ao, b, h, p, lds, tid);
    }
}


namespace gdn {
using bf16x8 = __attribute__((ext_vector_type(8))) short;
using s16x4  = __attribute__((ext_vector_type(4))) short;
using f32x16 = __attribute__((ext_vector_type(16))) float;
typedef float f2v __attribute__((ext_vector_type(2)));
typedef __bf16 b2v __attribute__((ext_vector_type(2)));
DI unsigned pk(float a, float b) { const f2v v = {a, b}; const b2v r = __builtin_convertvector(v, b2v); return __builtin_bit_cast(unsigned, r); }
DI int crow(int r, int hi) { return (r & 3) + 8 * (r >> 2) + 4 * hi; }
DI int pi_slot(int x) { return 8 * ((x >> 2) & 3) + 4 * ((x >> 4) & 1) + (x & 3); }
DI bf16x8 pack_step(const f32x16& x, int s) {
    v4u w; w.x = pk(x[8 * s + 0], x[8 * s + 1]); w.y = pk(x[8 * s + 2], x[8 * s + 3]); w.z = pk(x[8 * s + 4], x[8 * s + 5]); w.w = pk(x[8 * s + 6], x[8 * s + 7]);
    return __builtin_bit_cast(bf16x8, w);
}
DI f32x16 mm(const f32x16& P, const f32x16& Q, f32x16 acc) {
    acc = __builtin_amdgcn_mfma_f32_32x32x16_bf16(pack_step(P, 0), pack_step(Q, 0), acc, 0, 0, 0);
    acc = __builtin_amdgcn_mfma_f32_32x32x16_bf16(pack_step(P, 1), pack_step(Q, 1), acc, 0, 0, 0);
    return acc;
}
#define GPK4(P, BASE, OUT) do { const unsigned a0 = pk(P[BASE + 0], P[BASE + 1]), a1 = pk(P[BASE + 2], P[BASE + 3]);   \
    const unsigned b0 = pk(P[BASE + 4], P[BASE + 5]), b1 = pk(P[BASE + 6], P[BASE + 7]);                              \
    const auto r0 = __builtin_amdgcn_permlane32_swap(a0, b0, false, false); const auto r1 = __builtin_amdgcn_permlane32_swap(a1, b1, false, false); \
    const v4u w_ = {r0[0], r1[0], r0[1], r1[1]}; OUT = __builtin_bit_cast(bf16x8, w_); } while (0)

DI void local_unit(const Args& a, int unit, LAS unsigned char* img, LAS float* tab, int lane, bool dry) {
    const int r32 = lane & 31, hi = lane >> 5;
    const int chunk = unit & 63, bh = unit >> 6, hv = bh & 15, b = bh >> 4, hk = hv >> 1;
    const size_t t0 = (size_t)b * SEQ + chunk * 64;
    bf16* qkvc = (bf16*)(a.ws + WS_QKVC); const float* gb = (const float*)(a.ws + WS_GB);
    bf16* wmem = (bf16*)(a.ws + WS_WMEM) + (size_t)unit * 8192; bf16* imem = (bf16*)(a.ws + WS_IMEM) + (size_t)unit * 4096;
    bf16* ktmem = (bf16*)(a.ws + WS_KTMEM) + (size_t)((b * HK + hk) * 64 + chunk) * 8192; float* gtab = (float*)(a.ws + WS_GTAB) + (size_t)unit * 192;
    SEC_IN(1);
    float gc = gb[(t0 + lane) * 32 + hv]; const float be = gb[(t0 + lane) * 32 + 16 + hv];
#pragma unroll
    for (int off = 1; off < 64; off <<= 1) { const float y = __shfl_up(gc, off); if (lane >= off) gc += y; }
    const float glast = __shfl(gc, 63);
    tab[lane] = gc; tab[64 + lane] = be; tab[128 + lane] = -be * __expf(gc);
    gtab[lane] = __expf(gc); gtab[64 + lane] = __expf(glast - gc); if (lane == 0) gtab[128] = __expf(glast);
    const bf16* kbase = qkvc + t0 * 4096 + 1024 + hk * 128; const bf16* qbase = qkvc + t0 * 4096 + hk * 128; bf16* vbase = qkvc + t0 * 4096 + 2048 + hv * 128;
#define GSB() __builtin_amdgcn_sched_barrier(0)
    {
        f32x16 IT00 = {}, IT11 = {}, IT01 = {};
#pragma unroll
        for (int s = 0; s < 8; ++s) {
            const bf16x8 k0 = *(const bf16x8*)(kbase + (size_t)r32 * 4096 + 16 * s + 8 * hi), k1 = *(const bf16x8*)(kbase + (size_t)(32 + r32) * 4096 + 16 * s + 8 * hi);
            const bf16x8 q0 = *(const bf16x8*)(qbase + (size_t)r32 * 4096 + 16 * s + 8 * hi), q1 = *(const bf16x8*)(qbase + (size_t)(32 + r32) * 4096 + 16 * s + 8 * hi);
            IT00 = __builtin_amdgcn_mfma_f32_32x32x16_bf16(k0, q0, IT00, 0, 0, 0); IT11 = __builtin_amdgcn_mfma_f32_32x32x16_bf16(k1, q1, IT11, 0, 0, 0);
            IT01 = __builtin_amdgcn_mfma_f32_32x32x16_bf16(k0, q1, IT01, 0, 0, 0);
        }
#pragma unroll
        for (int I = 0; I < 2; ++I) { const int c = 32 * I + r32; const float gcc = tab[c];
#pragma unroll
            for (int J = 0; J < 2; ++J)
#pragma unroll
                for (int g = 0; g < 4; ++g) { float v[4];
#pragma unroll
                    for (int i = 0; i < 4; ++i) { const int r = 4 * g + i, cp = 32 * J + crow(r, hi);
                        const float raw = (I == 0) ? (J == 0 ? IT00[r] : 0.f) : (J == 0 ? IT01[r] : IT11[r]);
                        const float val = raw * __expf(-fabsf(gcc - tab[cp])); v[i] = (c >= cp) ? val : 0.f; }
                    v2u o; o.x = pk(v[0], v[1]); o.y = pk(v[2], v[3]);
                    *(v2u*)(imem + (unsigned)((((I * 2 + J) * 4 + g) * 64 + lane) * 4)) = o; } }
    }
    GSB();
    SEC_OUT(1); SEC_IN(2);
    f32x16 T1, T1T, T2T, T21T;
    {
        f32x16 KK = {};
#pragma unroll
        for (int s = 0; s < 8; ++s) { const bf16x8 k0 = *(const bf16x8*)(kbase + (size_t)r32 * 4096 + 16 * s + 8 * hi); KK = __builtin_amdgcn_mfma_f32_32x32x16_bf16(k0, k0, KK, 0, 0, 0); }
        f32x16 M, MT;
        { const float gb0 = tab[r32], bb0 = tab[64 + r32];
#pragma unroll
        for (int r = 0; r < 16; ++r) { const int a0 = crow(r, hi), b0 = r32; const float ke = -KK[r] * __expf(-fabsf(tab[a0] - gb0));
            const float nv = ke * tab[64 + a0], ntv = ke * bb0;
            const float n = (a0 > b0) ? nv : 0.f, nt = (b0 > a0) ? ntv : 0.f, id = (a0 == b0) ? 1.f : 0.f;
            M[r] = n; MT[r] = nt; T1[r] = id + n; T1T[r] = id + nt; } }
#pragma unroll
        for (int it = 0; it < 4; ++it) { const f32x16 z = {};
            const f32x16 Mn = mm(MT, M, z), MTn = mm(M, MT, z);
            const f32x16 Tn = mm(T1T, Mn, T1);
            T1T = mm(Mn, T1T, T1T);
            T1 = Tn; M = Mn; MT = MTn; }
    }
    GSB();
    {
        f32x16 KK = {};
#pragma unroll
        for (int s = 0; s < 8; ++s) { const bf16x8 k1 = *(const bf16x8*)(kbase + (size_t)(32 + r32) * 4096 + 16 * s + 8 * hi); KK = __builtin_amdgcn_mfma_f32_32x32x16_bf16(k1, k1, KK, 0, 0, 0); }
        f32x16 M, MT;
        { const float gb0 = tab[32 + r32], bb0 = tab[96 + r32];
#pragma unroll
        for (int r = 0; r < 16; ++r) { const int a0 = crow(r, hi), b0 = r32; const float ke = -KK[r] * __expf(-fabsf(tab[32 + a0] - gb0));
            const float nv = ke * tab[96 + a0], ntv = ke * bb0;
            const float n = (a0 > b0) ? nv : 0.f, nt = (b0 > a0) ? ntv : 0.f, id = (a0 == b0) ? 1.f : 0.f;
            M[r] = n; MT[r] = nt; T2T[r] = id + nt; } }
#pragma unroll
        for (int it = 0; it < 4; ++it) { const f32x16 z = {};
            const f32x16 Mn = mm(MT, M, z), MTn = mm(M, MT, z);
            T2T = mm(Mn, T2T, T2T);
            M = Mn; MT = MTn; }
    }
    GSB();
    {
        f32x16 L21 = {};
#pragma unroll
        for (int s = 0; s < 8; ++s) { const bf16x8 k0 = *(const bf16x8*)(kbase + (size_t)r32 * 4096 + 16 * s + 8 * hi), k1 = *(const bf16x8*)(kbase + (size_t)(32 + r32) * 4096 + 16 * s + 8 * hi);
            L21 = __builtin_amdgcn_mfma_f32_32x32x16_bf16(k1, k0, L21, 0, 0, 0); }
#pragma unroll
        for (int r = 0; r < 16; ++r) { const int a0 = crow(r, hi); L21[r] = L21[r] * tab[96 + a0] * __expf(tab[32 + a0] - tab[r32]); }
        const f32x16 z = {}; const f32x16 Y = mm(L21, T2T, z); T21T = mm(T1, Y, z);
#pragma unroll
        for (int r = 0; r < 16; ++r) T21T[r] = -T21T[r];
    }
    GSB();
    SEC_OUT(2); SEC_IN(3);
    const int vb = (int)(unsigned)(size_t)img + sba::v_rd_base(lane);
    bf16* ubl = dry ? (bf16*)(a.ws + WS_END) + (size_t)(unit & 63) * 64 * 4096 : vbase;
#pragma unroll 1
    for (int mode = 0; mode < 2; ++mode) {
        const bf16* src = mode == 0 ? (const bf16*)vbase : kbase;
#pragma unroll 4
        for (int it = 0; it < 16; ++it) { const int row = (lane >> 4) + 4 * it, col = (lane & 15) * 8;
            *(LAS v4u*)(img + sba::v_st(row, col)) = *(const v4u*)(src + (size_t)row * 4096 + col); }
        LAS float* sc = tab + (mode == 0 ? 64 : 128);
#pragma unroll 1
        for (int I = 0; I < 2; ++I) {
            bf16x8 pa0, pa1, pa2, pa3;
            { f32x16 X;
#pragma unroll
              for (int r = 0; r < 16; ++r) X[r] = (I ? T21T[r] : T1T[r]) * sc[crow(r, hi)];
              GPK4(X, 0, pa0); GPK4(X, 8, pa1);
              { const float on = I ? 1.0f : 0.0f;
#pragma unroll
              for (int r = 0; r < 16; ++r) X[r] = T2T[r] * (sc[32 + crow(r, hi)] * on); }
              GPK4(X, 0, pa2); GPK4(X, 8, pa3); }
#pragma unroll 1
            for (int d0 = 0; d0 < 4; ++d0) {
                f32x16 od = {};
                if (mode == 0) { sba::pv_split(od, vb + d0 * 512, pa0, pa1, pa2, pa3);
                    const unsigned e0 = (unsigned)(((I * 32 + 8 * d0 + (lane >> 5)) * 4096) + (lane & 31) * 4);
#pragma unroll
                    for (int g = 0; g < 4; ++g) { v2u w; w.x = pk(od[4 * g + 0], od[4 * g + 1]); w.y = pk(od[4 * g + 2], od[4 * g + 3]); *(v2u*)(ubl + e0 + (unsigned)(g * 8192)) = w; }
                } else { sba::pv_split_T(od, vb + d0 * 512, pa0, pa1, pa2, pa3);
                    bf16* wp = wmem + (unsigned)((((I * 4 + d0) * 4) * 64 + lane) * 4);
#pragma unroll
                    for (int g = 0; g < 4; ++g) { v2u w; w.x = pk(od[4 * g + 0], od[4 * g + 1]); w.y = pk(od[4 * g + 2], od[4 * g + 3]); *(v2u*)(wp + g * 256) = w; }
                }
                GSB();
            }
        }
        if (mode == 1) {
            const int Ik = hv & 1;
            v4u idw0, idw1;
            { const int d0_ = r32 - 8 * hi, d1_ = r32 - 16 - 8 * hi;
              idw0.x = (d0_ == 0 ? 0x3f80u : 0u) | (d0_ == 1 ? 0x3f800000u : 0u); idw0.y = (d0_ == 2 ? 0x3f80u : 0u) | (d0_ == 3 ? 0x3f800000u : 0u);
              idw0.z = (d0_ == 4 ? 0x3f80u : 0u) | (d0_ == 5 ? 0x3f800000u : 0u); idw0.w = (d0_ == 6 ? 0x3f80u : 0u) | (d0_ == 7 ? 0x3f800000u : 0u);
              idw1.x = (d1_ == 0 ? 0x3f80u : 0u) | (d1_ == 1 ? 0x3f800000u : 0u); idw1.y = (d1_ == 2 ? 0x3f80u : 0u) | (d1_ == 3 ? 0x3f800000u : 0u);
              idw1.z = (d1_ == 4 ? 0x3f80u : 0u) | (d1_ == 5 ? 0x3f800000u : 0u); idw1.w = (d1_ == 6 ? 0x3f80u : 0u) | (d1_ == 7 ? 0x3f800000u : 0u); }
            const bf16x8 id0 = __builtin_bit_cast(bf16x8, idw0), id1 = __builtin_bit_cast(bf16x8, idw1), zf = (bf16x8){};
            const bf16x8 pa0 = Ik ? zf : id0, pa1 = Ik ? zf : id1, pa2 = Ik ? id0 : zf, pa3 = Ik ? id1 : zf;
#pragma unroll 1
            for (int d0 = 0; d0 < 4; ++d0) {
                f32x16 od = {}; sba::pv_split(od, vb + d0 * 512, pa0, pa1, pa2, pa3);
                bf16* kp = ktmem + (unsigned)((((Ik * 4 + d0) * 4) * 64 + lane) * 4);
#pragma unroll
                for (int g = 0; g < 4; ++g) { v2u w; w.x = pk(od[4 * g + 0], od[4 * g + 1]); w.y = pk(od[4 * g + 2], od[4 * g + 3]); *(v2u*)(kp + g * 256) = w; }
                GSB();
            }
        }
    }
    SEC_OUT(3);
#undef GSB
}
#undef GPK4
}
DI void phase_gdn_local(const Args& a, LAS unsigned char* lds, int bid, int G, int wave, int lane, bool dry) {
    LAS unsigned char* img = lds + wave * 16384; LAS float* tab = (LAS float*)(lds + RING_BYTES + 4096 + wave * 1024);
    const int gw = bid * NWAVES + wave, NGW = G * NWAVES;
    for (int unit = gw; unit < BATCH * HV * 64; unit += NGW) gdn::local_unit(a, unit, img, tab, lane, dry);
}
namespace gdn {
constexpr int PW = 272, PI = 144;
constexpr int L_W = 0, L_Q = 64 * PW, L_I = 2 * 64 * PW, L_K = L_I + 64 * PI, L_G = L_K + 128 * PI, L_BUF = L_G + 768;
constexpr int L_PART = 2 * L_BUF;
static_assert(L_PART + 4096 <= RING_BYTES, "scan LDS map");
}
DI void phase_gdn_scan(const Args& a, int j, LAS unsigned char* lds, int bid, int tid, bool dry) {
    if (bid >= BATCH * HV) return;
    using gdn::bf16x8; using gdn::pk; using namespace gdn;
    typedef float f4v __attribute__((ext_vector_type(4)));
    const int wave = __builtin_amdgcn_readfirstlane(tid >> 6), lane = tid & 63, n = lane & 15, kq = lane >> 4;
    const int b = bid / HV, hv = bid % HV, hk = hv >> 1;
    bf16* qkvc = (bf16*)(a.ws + WS_QKVC); const bf16* zb = (const bf16*)(a.ws + WS_ZB);
    LAS float* part = (LAS float*)(lds + L_PART); LAS unsigned char* stg = lds + OGST_OFF;
    const int unit0 = (b * HV + hv) * 64, hku0 = (b * HK + hk) * 64; const size_t tb0 = (size_t)b * SEQ;
    if (wave >= 4) {
        const int st = tid - 256;
        v4u rw[4], rq[4], ri[2], rk[4], rz[4]; float rg = 0.f;
#define SV_RUN2(dst, base, o0) do { const v2u a_ = *(const v2u*)((base) + (o0)), b_ = *(const v2u*)((base) + (o0) + 2 * 64 * 4); dst = (v4u){a_.x, a_.y, b_.x, b_.y}; } while (0)
#define SV_LOAD(ch) do { const int u_ = unit0 + (ch); const size_t t_ = tb0 + (size_t)(ch) * 64; \
        const bf16* wm_ = (const bf16*)(a.ws + WS_WMEM) + (size_t)u_ * 8192; const bf16* im_ = (const bf16*)(a.ws + WS_IMEM) + (size_t)u_ * 4096; \
        const bf16* kt_ = (const bf16*)(a.ws + WS_KTMEM) + (size_t)(hku0 + (ch)) * 8192; const bf16* qb_ = qkvc + t_ * 4096 + hk * 128; const bf16* zr_ = zb + t_ * 2048 + hv * 128; \
        _Pragma("unroll") for (int k = 0; k < 4; ++k) { const int c = st + 256 * k; \
            { const int row = c & 63, p = c >> 6, pp = p & 3; SV_RUN2(rw[k], wm_, (((((row >> 5) * 4 + (p >> 2)) * 4 + (pp >> 1)) * 64 + (pp & 1) * 32 + (row & 31)) * 4)); }     \
            { const int dk = c & 127, p = c >> 7, pp = p & 3; SV_RUN2(rk[k], kt_, (((((p >> 2) * 4 + (dk >> 5)) * 4 + (pp >> 1)) * 64 + (pp & 1) * 32 + (dk & 31)) * 4)); }         \
            rq[k] = *(const v4u*)(qb_ + (size_t)(c >> 4) * 4096 + (c & 15) * 8); rz[k] = *(const v4u*)(zr_ + (size_t)(c >> 4) * 2048 + (c & 15) * 8); } \
        _Pragma("unroll") for (int k = 0; k < 2; ++k) { const int c = st + 256 * k; const int row = c & 63, p = c >> 6, pp = p & 3; \
            SV_RUN2(ri[k], im_, (((((row >> 5) * 2 + (p >> 2)) * 4 + (pp >> 1)) * 64 + (pp & 1) * 32 + (row & 31)) * 4)); } \
        if (st < 192) rg = ((const float*)(a.ws + WS_GTAB))[(size_t)u_ * 192 + st]; } while (0)
#define SV_WRITE(bf) do { LAS unsigned char* B_ = lds + (bf) * L_BUF; \
        _Pragma("unroll") for (int k = 0; k < 4; ++k) { const int c = st + 256 * k; *(LAS v4u*)(B_ + L_W + (c & 63) * PW + (c >> 6) * 16) = rw[k]; \
            *(LAS v4u*)(B_ + L_Q + (c >> 4) * PW + (c & 15) * 16) = rq[k]; *(LAS v4u*)(B_ + L_K + (c & 127) * PI + (c >> 7) * 16) = rk[k]; } \
        _Pragma("unroll") for (int k = 0; k < 2; ++k) { const int c = st + 256 * k; *(LAS v4u*)(B_ + L_I + (c & 63) * PI + (c >> 6) * 16) = ri[k]; } \
        if (st < 192) *(LAS float*)(B_ + L_G + st * 4) = rg; } while (0)
        f32x4 nwa, nwb;
        { const float* nwp = a.gdn_norm_w + j * 128 + (st & 15) * 8; nwa = *(const f32x4*)nwp; nwb = *(const f32x4*)(nwp + 4); }
        volatile LAS unsigned* flag = (volatile LAS unsigned*)(lds + L_PART);
        SV_LOAD(0); SV_WRITE(0);
        v4u zc[4], zn[4];
#pragma unroll
        for (int k = 0; k < 4; ++k) zc[k] = rz[k];
        __syncthreads();
        SV_LOAD(1);
#pragma unroll 1
        for (int chunk = 0; chunk < 64; ++chunk) {
            if (chunk + 1 < 64) { SV_WRITE((chunk + 1) & 1);
#pragma unroll
                for (int k = 0; k < 4; ++k) zn[k] = rz[k]; }
            __syncthreads();
            v4u ov[4];
#pragma unroll
            for (int k = 0; k < 4; ++k) { const int c = st + 256 * k; ov[k] = *(const LAS v4u*)(stg + (c >> 4) * 256 + (c & 15) * 16); }
            asm volatile("s_waitcnt lgkmcnt(0)" ::: "memory");
            if (lane == 0) __hip_atomic_fetch_add((LAS unsigned*)(lds + L_PART), 1u, __ATOMIC_RELAXED, __HIP_MEMORY_SCOPE_WORKGROUP);
            if (chunk + 2 < 64) SV_LOAD(chunk + 2);
            __builtin_amdgcn_sched_barrier(0);
            bf16* ob = dry ? (bf16*)(a.ws + WS_END) + (size_t)bid * 64 * 128 : qkvc + (tb0 + (size_t)chunk * 64) * 4096 + 2048 + hv * 128; const int opitch = dry ? 128 : 4096;
#pragma unroll
            for (int k = 0; k < 4; ++k) { const int c = st + 256 * k;
                float o8[8]; o8[0] = bf_lo(ov[k].x); o8[1] = bf_hi(ov[k].x); o8[2] = bf_lo(ov[k].y); o8[3] = bf_hi(ov[k].y); o8[4] = bf_lo(ov[k].z); o8[5] = bf_hi(ov[k].z); o8[6] = bf_lo(ov[k].w); o8[7] = bf_hi(ov[k].w);
                float ss = 0.f;
#pragma unroll
                for (int e = 0; e < 8; ++e) ss += o8[e] * o8[e];
                const float rinv = __builtin_amdgcn_rsqf(dpp_sum16(ss) * (1.0f / 128.0f) + RMS_EPS);
                float z8[8]; z8[0] = bf_lo(zc[k].x); z8[1] = bf_hi(zc[k].x); z8[2] = bf_lo(zc[k].y); z8[3] = bf_hi(zc[k].y); z8[4] = bf_lo(zc[k].z); z8[5] = bf_hi(zc[k].z); z8[6] = bf_lo(zc[k].w); z8[7] = bf_hi(zc[k].w);
                float r8[8];
#pragma unroll
                for (int e = 0; e < 8; ++e) { const float sg = z8[e] * __builtin_amdgcn_rcpf(1.0f + __builtin_amdgcn_exp2f(-1.4426950408889634f * z8[e])); r8[e] = o8[e] * rinv * (e < 4 ? nwa[e] : nwb[e - 4]) * sg; }
                v4u w; w.x = pk(r8[0], r8[1]); w.y = pk(r8[2], r8[3]); w.z = pk(r8[4], r8[5]); w.w = pk(r8[6], r8[7]);
                *(v4u*)(ob + (size_t)(c >> 4) * opitch + (c & 15) * 8) = w; }
#pragma unroll
            for (int k = 0; k < 4; ++k) zc[k] = zn[k];
        }
#undef SV_RUN2
#undef SV_LOAD
#undef SV_WRITE
        return;
    }
    f4v S[2][8];
#pragma unroll
    for (int g = 0; g < 2; ++g)
#pragma unroll
        for (int m = 0; m < 8; ++m) S[g][m] = (f4v){0.f, 0.f, 0.f, 0.f};
    v2u un[2][4];
#define CW_ULOAD(ch) do { const bf16* vb_ = qkvc + (tb0 + (size_t)(ch) * 64) * 4096 + 2048 + hv * 128; \
        _Pragma("unroll") for (int g = 0; g < 2; ++g) _Pragma("unroll") for (int mt = 0; mt < 4; ++mt) { \
            const int f = (((((mt >> 1) * 4 + wave) * 4 + 2 * (mt & 1) + (kq >> 1)) * 64) + (kq & 1) * 32 + 16 * g + n) * 4;     \
            un[g][mt] = *(const v2u*)(vb_ + (size_t)(f >> 7) * 4096 + (f & 127)); } } while (0)
    CW_ULOAD(0);
    if (tid == 0) *(volatile LAS unsigned*)(lds + L_PART) = 0u;
    __syncthreads();
#pragma unroll 1
    for (int chunk = 0; chunk < 64; ++chunk) {
        const LAS unsigned char* B = lds + (chunk & 1) * L_BUF; const LAS float* gt = (const LAS float*)(B + L_G);
        f4v av[2][4], ao[2][4];
#pragma unroll
        for (int g = 0; g < 2; ++g)
#pragma unroll
            for (int mt = 0; mt < 4; ++mt) { const v2u u0 = un[g][mt]; av[g][mt] = (f4v){bf_lo(u0.x), bf_hi(u0.x), bf_lo(u0.y), bf_hi(u0.y)}; }
        if (chunk + 1 < 64) CW_ULOAD(chunk + 1);
        bf16x8 Sb[2][4];
#pragma unroll
        for (int g = 0; g < 2; ++g)
#pragma unroll
            for (int p = 0; p < 4; ++p) { v4u w; w.x = pk(S[g][2 * p][0], S[g][2 * p][1]); w.y = pk(S[g][2 * p][2], S[g][2 * p][3]); w.z = pk(S[g][2 * p + 1][0], S[g][2 * p + 1][1]); w.w = pk(S[g][2 * p + 1][2], S[g][2 * p + 1][3]);
                Sb[g][p] = __builtin_bit_cast(bf16x8, w); }
#pragma unroll
        for (int mt = 0; mt < 4; ++mt) { ao[0][mt] = (f4v){0.f, 0.f, 0.f, 0.f}; ao[1][mt] = (f4v){0.f, 0.f, 0.f, 0.f};
#pragma unroll
            for (int p = 0; p < 4; ++p) {
                const bf16x8 aw = *(const LAS bf16x8*)(B + L_W + (16 * mt + n) * PW + 64 * p + 16 * kq);
                const v2u q0 = *(const LAS v2u*)(B + L_Q + (16 * mt + n) * PW + 64 * p + 8 * kq), q1 = *(const LAS v2u*)(B + L_Q + (16 * mt + n) * PW + 64 * p + 32 + 8 * kq);
                const v4u qq = {q0.x, q0.y, q1.x, q1.y}; const bf16x8 aq = __builtin_bit_cast(bf16x8, qq);
                av[0][mt] = __builtin_amdgcn_mfma_f32_16x16x32_bf16(aw, Sb[0][p], av[0][mt], 0, 0, 0); av[1][mt] = __builtin_amdgcn_mfma_f32_16x16x32_bf16(aw, Sb[1][p], av[1][mt], 0, 0, 0);
                ao[0][mt] = __builtin_amdgcn_mfma_f32_16x16x32_bf16(aq, Sb[0][p], ao[0][mt], 0, 0, 0); ao[1][mt] = __builtin_amdgcn_mfma_f32_16x16x32_bf16(aq, Sb[1][p], ao[1][mt], 0, 0, 0); } }
        bf16x8 vbf[2][2], vbd[2][2];
#pragma unroll
        for (int pp = 0; pp < 2; ++pp) {
            const f4v d0 = *(const LAS f4v*)(gt + 64 + 32 * pp + 4 * kq), d1 = *(const LAS f4v*)(gt + 64 + 32 * pp + 16 + 4 * kq);
#pragma unroll
            for (int g = 0; g < 2; ++g) { const f4v x0 = av[g][2 * pp], x1 = av[g][2 * pp + 1];
                v4u w; w.x = pk(x0[0], x0[1]); w.y = pk(x0[2], x0[3]); w.z = pk(x1[0], x1[1]); w.w = pk(x1[2], x1[3]); vbf[g][pp] = __builtin_bit_cast(bf16x8, w);
                v4u y; y.x = pk(x0[0] * d0[0], x0[1] * d0[1]); y.y = pk(x0[2] * d0[2], x0[3] * d0[3]); y.z = pk(x1[0] * d1[0], x1[1] * d1[1]); y.w = pk(x1[2] * d1[2], x1[3] * d1[3]); vbd[g][pp] = __builtin_bit_cast(bf16x8, y); }
        }
#pragma unroll
        for (int mt = 0; mt < 4; ++mt) { const f4v eg = *(const LAS f4v*)(gt + 16 * mt + 4 * kq); ao[0][mt] = ao[0][mt] * eg; ao[1][mt] = ao[1][mt] * eg;
#pragma unroll
            for (int pp = 0; pp < 2; ++pp) { const bf16x8 ai = *(const LAS bf16x8*)(B + L_I + (16 * mt + n) * PI + 64 * pp + 16 * kq);
                ao[0][mt] = __builtin_amdgcn_mfma_f32_16x16x32_bf16(ai, vbf[0][pp], ao[0][mt], 0, 0, 0); ao[1][mt] = __builtin_amdgcn_mfma_f32_16x16x32_bf16(ai, vbf[1][pp], ao[1][mt], 0, 0, 0); } }
        { const float egl = gt[128];
#pragma unroll
          for (int m8 = 0; m8 < 8; ++m8) { S[0][m8] = S[0][m8] * egl; S[1][m8] = S[1][m8] * egl;
#pragma unroll
              for (int pp = 0; pp < 2; ++pp) { const bf16x8 ak = *(const LAS bf16x8*)(B + L_K + (16 * m8 + n) * PI + 64 * pp + 16 * kq);
                  S[0][m8] = __builtin_amdgcn_mfma_f32_16x16x32_bf16(ak, vbd[0][pp], S[0][m8], 0, 0, 0); S[1][m8] = __builtin_amdgcn_mfma_f32_16x16x32_bf16(ak, vbd[1][pp], S[1][m8], 0, 0, 0); } } }
        { unsigned spins = 0; while (*(volatile LAS unsigned*)(lds + L_PART) < 4u * (unsigned)chunk) { __builtin_amdgcn_s_sleep(1); if (++spins > (1u << 22)) break; } }
#pragma unroll
        for (int g = 0; g < 2; ++g)
#pragma unroll
            for (int mt = 0; mt < 4; ++mt)
#pragma unroll
                for (int i = 0; i < 4; ++i) *(LAS bf16*)(stg + (16 * mt + 4 * kq + i) * 256 + (32 * wave + 16 * g + n) * 2) = (bf16)(pk(ao[g][mt][i], 0.f) & 0xffffu);
        __syncthreads();
    }
#undef CW_ULOAD
}

DI void moe_offsets(const Args& a, int j, unsigned (&off)[9]) {
    unsigned* cnt = (unsigned*)(a.ws + WS_CTL) + CW_CNT + 256 * j; unsigned acc = 0u;
#pragma unroll
    for (int e = 0; e < 8; ++e) { off[e] = acc; const unsigned c = __hip_atomic_load(cnt + e, __ATOMIC_RELAXED, __HIP_MEMORY_SCOPE_AGENT); acc += (c + 255u) & ~255u; }
    off[8] = acc;
}
DI void phase_scatter(const Args& a, int j, LAS unsigned char* lds, int bid, int G, int tid, int wave, int lane) {
    LAS unsigned* lc = (LAS unsigned*)lds; LAS unsigned* lb = lc + 8; LAS unsigned* loff = lc + 16; LAS int* lpos = (LAS int*)(lc + 32);
    const unsigned* E12 = (const unsigned*)(a.ws + WS_E12); int* POS = (int*)(a.ws + WS_POS);
    const bf16* HB = (const bf16*)(a.ws + WS_HB); bf16* XS = (bf16*)(a.ws + WS_XS);
    unsigned* fill = (unsigned*)(a.ws + WS_CTL) + CW_CNT + 256 * j + 64;
    unsigned off[9]; moe_offsets(a, j, off);
    if (tid == 0) {
#pragma unroll
        for (int e = 0; e < 8; ++e) loff[e] = off[e]; }
    for (int ci = bid; ci < TT / 128; ci += G) {
        __syncthreads();
        if (tid < 8) lc[tid] = 0u;
        __syncthreads();
        unsigned e1 = 0, e2 = 0, r1 = 0, r2 = 0;
        if (tid < 128) { const unsigned w = E12[ci * 128 + tid]; e1 = w & 255u; e2 = (w >> 8) & 255u;
            r1 = __hip_atomic_fetch_add(lc + e1, 1u, __ATOMIC_RELAXED, __HIP_MEMORY_SCOPE_WORKGROUP); r2 = __hip_atomic_fetch_add(lc + e2, 1u, __ATOMIC_RELAXED, __HIP_MEMORY_SCOPE_WORKGROUP); }
        __syncthreads();
        if (tid < 8) lb[tid] = __hip_atomic_fetch_add(fill + tid, lc[tid], __ATOMIC_RELAXED, __HIP_MEMORY_SCOPE_AGENT);
        __syncthreads();
        if (tid < 128) { const int p1 = (int)(loff[e1] + lb[e1] + r1), p2 = (int)(loff[e2] + lb[e2] + r2);
            lpos[2 * tid] = p1; lpos[2 * tid + 1] = p2; POS[2 * (ci * 128 + tid)] = p1; POS[2 * (ci * 128 + tid) + 1] = p2; }
        __syncthreads();
        for (int tk = wave; tk < 128; tk += NWAVES) {
            const int p1 = lpos[2 * tk], p2 = lpos[2 * tk + 1];
            const v4u* src = (const v4u*)(HB + (size_t)(ci * 128 + tk) * D);
            const v4u x0 = src[lane], x1 = src[lane + 64];
            v4u* d1 = (v4u*)(XS + (size_t)p1 * D); v4u* d2 = (v4u*)(XS + (size_t)p2 * D);
            d1[lane] = x0; d1[lane + 64] = x1; d2[lane] = x0; d2[lane + 64] = x1;
        }
    }
}

template <bool FINAL>
DI void phase_combine_ln(const Args& a, const bf16* Yin, bf16* Yout, int lnprev, int lnidx, int bid, int G, int wave, int lane) {
    bf16* HB = (bf16*)(a.ws + WS_HB); const bf16* YE = (const bf16*)(a.ws + WS_XS); float* stats = (float*)(a.ws + WS_STATS);
    const int* POS = (const int*)(a.ws + WS_POS); const f32x2* G12 = (const f32x2*)(a.ws + WS_G12);
    const float* g = a.ln_g + (size_t)lnidx * D; const float* bta = a.ln_b + (size_t)lnidx * D;
    const float* gp = a.ln_g + (size_t)lnprev * D; const float* bp = a.ln_b + (size_t)lnprev * D;
    const int gw = bid * NWAVES + wave, NGW = G * NWAVES;
    float gv[2][8], bv[2][8], gq[2][8], bq[2][8];
#pragma unroll
    for (int q = 0; q < 2; ++q)
#pragma unroll
        for (int c = 0; c < 8; ++c) { const int col = 8 * (lane + 64 * q) + c; gv[q][c] = g[col]; bv[q][c] = bta[col]; gq[q][c] = gp[col] * ALPHA; bq[q][c] = bp[col] * ALPHA; }
    for (int t = gw; t < TT; t += NGW) {
        const int p1 = POS[2 * t], p2 = POS[2 * t + 1]; const f32x2 gg = G12[t]; const f32x2 st = *(const f32x2*)(stats + 2 * (size_t)t);
        float v[2][8]; float s = 0.f;
#pragma unroll
        for (int q = 0; q < 2; ++q) { float y[8], e1[8], e2[8];
            unpack8(((const v4u*)(Yin + (size_t)t * D))[lane + 64 * q], y); unpack8(((const v4u*)(YE + (size_t)p1 * D))[lane + 64 * q], e1); unpack8(((const v4u*)(YE + (size_t)p2 * D))[lane + 64 * q], e2);
#pragma unroll
            for (int c = 0; c < 8; ++c) { v[q][c] = (y[c] - st.x) * st.y * gq[q][c] + bq[q][c] + e1[c] * gg.x + e2[c] * gg.y; s += v[q][c]; } }
        const float mean = wave_sum(s) * (1.0f / D); float s2 = 0.f;
#pragma unroll
        for (int q = 0; q < 2; ++q)
#pragma unroll
            for (int c = 0; c < 8; ++c) { const float d = v[q][c] - mean; s2 += d * d; }
        const float rstd = 1.0f / sqrtf(wave_sum(s2) * (1.0f / D) + LN_EPS);
        if (!FINAL && lane == 0) *(f32x2*)(stats + 2 * (size_t)t) = (f32x2){mean, rstd};
#pragma unroll
        for (int q = 0; q < 2; ++q) { float hn[8];
#pragma unroll
            for (int c = 0; c < 8; ++c) hn[c] = (v[q][c] - mean) * rstd * gv[q][c] + bv[q][c];
            if (FINAL) { f32x4* orow = (f32x4*)(a.out + (size_t)t * D + 8 * (lane + 64 * q)); orow[0] = (f32x4){hn[0], hn[1], hn[2], hn[3]}; orow[1] = (f32x4){hn[4], hn[5], hn[6], hn[7]}; }
            else { v4u yo; yo.x = pk2(v[q][0], v[q][1]); yo.y = pk2(v[q][2], v[q][3]); yo.z = pk2(v[q][4], v[q][5]); yo.w = pk2(v[q][6], v[q][7]); ((v4u*)(Yout + (size_t)t * D))[lane + 64 * q] = yo;
                v4u o; o.x = pk2(hn[0], hn[1]); o.y = pk2(hn[2], hn[3]); o.z = pk2(hn[4], hn[5]); o.w = pk2(hn[6], hn[7]); ((v4u*)(HB + (size_t)t * D))[lane + 64 * q] = o; } }
    }
}

constexpr int ARGS_OFF = RING_BYTES + 1024;
DI unsigned long long lds_u64(LAS unsigned char* p) { const v2u w = *(const volatile LAS v2u*)p; return ((unsigned long long)(unsigned)__builtin_amdgcn_readfirstlane((int)w.y) << 32) | (unsigned)__builtin_amdgcn_readfirstlane((int)w.x); }
DI Args load_args(LAS unsigned char* lds) {
    Args a; LAS unsigned char* p = lds + ARGS_OFF;
    a.x = (const float*)(const GAS float*)lds_u64(p + 0); a.gdn_w_in = (const float*)(const GAS float*)lds_u64(p + 8); a.gdn_conv_w = (const float*)(const GAS float*)lds_u64(p + 16); a.gdn_a_log = (const float*)(const GAS float*)lds_u64(p + 24);
    a.gdn_dt_bias = (const float*)(const GAS float*)lds_u64(p + 32); a.gdn_norm_w = (const float*)(const GAS float*)lds_u64(p + 40); a.gdn_w_out = (const float*)(const GAS float*)lds_u64(p + 48); a.sb_w_in = (const float*)(const GAS float*)lds_u64(p + 56);
    a.sb_w_out = (const float*)(const GAS float*)lds_u64(p + 64); a.ffn_w_gate = (const float*)(const GAS float*)lds_u64(p + 72); a.ffn_w_up = (const float*)(const GAS float*)lds_u64(p + 80); a.ffn_w_down = (const float*)(const GAS float*)lds_u64(p + 88);
    a.moe_router = (const float*)(const GAS float*)lds_u64(p + 96); a.moe_w_gate = (const float*)(const GAS float*)lds_u64(p + 104); a.moe_w_up = (const float*)(const GAS float*)lds_u64(p + 112); a.moe_w_down = (const float*)(const GAS float*)lds_u64(p + 120);
    a.ln_g = (const float*)(const GAS float*)lds_u64(p + 128); a.ln_b = (const float*)(const GAS float*)lds_u64(p + 136); a.out = (float*)(GAS float*)lds_u64(p + 144); a.ws = (unsigned char*)(GAS unsigned char*)lds_u64(p + 152);
    const v2u w = *(const volatile LAS v2u*)(p + 160); a.ph_lo = __builtin_amdgcn_readfirstlane((int)w.x); a.ph_hi = __builtin_amdgcn_readfirstlane((int)w.y);
    return a;
}
#ifdef PH_ONLY
#define IN(k) (((k) % NPH) == PH_ONLY && lo <= (k) && (k) < hi)
#else
#define IN(k) (lo <= (k) && (k) < hi)
#endif
#define SEAM(k) do { if ((k) + 1 < hi) xcd_barrier(bar); } while (0)
DI int fresh_lane() { int l; asm volatile("v_mbcnt_lo_u32_b32 %0, -1, 0\n\tv_mbcnt_hi_u32_b32 %0, -1, %0" : "=v"(l)); return l; }
#define YMOE ((bf16*)(j == 1 ? (void*)(args.ws + WS_YT) : (void*)args.out))
#define ARGS() const Args args = load_args(lds); const int lo = args.ph_lo, hi = args.ph_hi; const int lane = fresh_lane(), tid = wave * 64 + lane
#ifndef PROBE_REP_MASK
#define PROBE_REP_MASK 0
#endif
#ifndef PROBE_DELAY_MASK
#define PROBE_DELAY_MASK 0
#endif
#define PROBE_DELAY_MULT 4u
#define TICK_IN(k) do { if (((PROBE_DELAY_MASK) >> (k)) & 1) { if (bid == 0 && tid == 0) ((volatile LAS unsigned*)(lds + MISC_OFF))[20] -= (unsigned)__builtin_amdgcn_s_memrealtime(); } } while (0)
#define TICK_OUT(k) do { if (((PROBE_DELAY_MASK) >> (k)) & 1) { if (bid == 0 && tid == 0) ((volatile LAS unsigned*)(lds + MISC_OFF))[20] += (unsigned)__builtin_amdgcn_s_memrealtime(); } } while (0)
#define NREP(k) ((((PROBE_REP_MASK) >> (k)) & 1) ? 2 : 1)
template <int j>
DI void layer_pair(LAS unsigned char* lds, const XcdBarrier& bar, const int wave, const int G, const int bid) {
    constexpr int pb = j * NPH;
    { ARGS(); if (IN(pb + 0)) { TICK_IN(0); _Pragma("unroll 1") for (int rep_ = 0; rep_ < NREP(0); ++rep_) { phase_w_gdn(args, j, lds, bid, G, tid, wave, lane); } SEAM(pb + 0); TICK_OUT(0); } }
    { ARGS(); if (IN(pb + 1)) { TICK_IN(1); {
        pg8::Gemm g{(const bf16*)(args.ws + WS_HB), (const bf16*)(args.ws + W_IN), D, D}; pg8::StaticOrder S; S.init(TT, GINP, G, bid, NREP(1));
        pg8::EpiInProj E{(bf16*)(args.ws + WS_RAW), (bf16*)(args.ws + WS_ZB)};
        pg8::gemm_phase<pg8::EpiInProj, pg8::StaticOrder, true, true>(lds, g, S, E);
        } SEAM(pb + 1); TICK_OUT(1); } }
    { ARGS(); if (IN(pb + 2)) { TICK_IN(2); _Pragma("unroll 1") for (int rep_ = 0; rep_ < NREP(2); ++rep_) { phase_conv(args, j, bid, G, tid); } SEAM(pb + 2); TICK_OUT(2); } }
#if GDN_NAIVE
    { ARGS(); if (IN(pb + 4)) { TICK_IN(4); _Pragma("unroll 1") for (int rep_ = 0; rep_ < NREP(4); ++rep_) { phase_gdn_naive(args, j, lds, bid, tid); } SEAM(pb + 4); TICK_OUT(4); } }
#else
    { ARGS(); if (IN(pb + 3)) { TICK_IN(3); _Pragma("unroll 1") for (int rep_ = 0; rep_ < NREP(3); ++rep_) { phase_gdn_local(args, lds, bid, G, wave, lane, rep_ + 1 < NREP(3)); } SEAM(pb + 3); TICK_OUT(3); } }
    { ARGS(); if (IN(pb + 4)) { TICK_IN(4); _Pragma("unroll 1") for (int rep_ = 0; rep_ < NREP(4); ++rep_) { if (bid >= BATCH * HV && G > BATCH * HV) phase_w_sb(args, j, lds, bid - BATCH * HV, G - BATCH * HV, wave, lane); else if (G <= BATCH * HV && rep_ == 0) phase_w_sb(args, j, lds, bid, G, wave, lane);
        phase_gdn_scan(args, j, lds, bid, tid, rep_ + 1 < NREP(4)); } SEAM(pb + 4); TICK_OUT(4); } }
#endif
    { ARGS(); if (IN(pb + 5)) { TICK_IN(5); {
        pg8::Gemm g{(const bf16*)(args.ws + WS_QKVC) + 2048, (const bf16*)(args.ws + W_OUT), 4096, 2048}; pg8::StaticOrder S; S.init(TT, D, G, bid);
        pg8::EpiResid<(j > 0)> E{j == 0 ? (const void*)args.x : (const void*)args.out, (bf16*)args.out, (const float*)(args.ws + WS_STATS), args.ln_g + (size_t)(4 * (j > 0 ? j - 1 : 0) + 3) * D, args.ln_b + (size_t)(4 * (j > 0 ? j - 1 : 0) + 3) * D};
        pg8::gemm_phase<pg8::EpiResid<(j > 0)>, pg8::StaticOrder, true, true>(lds, g, S, E);
        } SEAM(pb + 5); TICK_OUT(5); } }
    { ARGS(); if (IN(pb + 6)) { TICK_IN(6); _Pragma("unroll 1") for (int rep_ = 0; rep_ < NREP(6); ++rep_) { phase_ln<false>(args, (const bf16*)args.out, (2 * j) * 2 + 0, j, lds, bid, G, tid, wave, lane); } SEAM(pb + 6); TICK_OUT(6); } }
    { ARGS(); if (IN(pb + 7)) { TICK_IN(7); {
        pg8::Gemm g{(const bf16*)(args.ws + WS_HB), (const bf16*)(args.ws + W_GU), D, D}; pg8::StaticOrder S; S.init(TT, 2 * FF, G, bid, NREP(7));
        pg8::EpiSwiGLU E{(bf16*)(args.ws + WS_ACT), FF, 0};
        pg8::gemm_phase<pg8::EpiSwiGLU, pg8::StaticOrder, true, true>(lds, g, S, E);
        } SEAM(pb + 7); TICK_OUT(7); } }
    { ARGS(); if (IN(pb + 8)) { TICK_IN(8); {
        pg8::Gemm g{(const bf16*)(args.ws + WS_ACT), (const bf16*)(args.ws + W_D), FF, FF}; pg8::StaticOrder S; S.init(TT, D, G, bid);
        pg8::EpiResid<true> E{(const void*)args.out, (bf16*)args.out, (const float*)(args.ws + WS_STATS), args.ln_g + (size_t)(4 * j + 0) * D, args.ln_b + (size_t)(4 * j + 0) * D};
        pg8::gemm_phase<pg8::EpiResid<true>, pg8::StaticOrder, true, true>(lds, g, S, E);
        } SEAM(pb + 8); TICK_OUT(8); } }
    { ARGS(); if (IN(pb + 9)) { TICK_IN(9); _Pragma("unroll 1") for (int rep_ = 0; rep_ < NREP(9); ++rep_) { phase_ln<false>(args, (const bf16*)args.out, (2 * j) * 2 + 1, j, lds, bid, G, tid, wave, lane); } SEAM(pb + 9); TICK_OUT(9); } }
    { ARGS(); if (IN(pb + 10)) { TICK_IN(10); {
        pg8::Gemm g{(const bf16*)(args.ws + WS_HB), (const bf16*)(args.ws + W_QKV), D, D}; pg8::StaticOrder S; S.init(TT, 3072, G, bid, NREP(10));
        pg8::EpiBf16 E{(bf16*)(args.ws + WS_QKV), 3072, 0};
        pg8::gemm_phase<pg8::EpiBf16, pg8::StaticOrder, true, true>(lds, g, S, E);
        } SEAM(pb + 10); TICK_OUT(10); } }
    #if SB_NAIVE
    { ARGS(); if (IN(pb + 11)) { TICK_IN(11); _Pragma("unroll 1") for (int rep_ = 0; rep_ < NREP(11); ++rep_) { phase_sb_naive(args, lds, bid, G, tid); } SEAM(pb + 11); TICK_OUT(11); } }
#else
    { ARGS(); if (IN(pb + 11)) { TICK_IN(11); _Pragma("unroll 1") for (int rep_ = 0; rep_ < NREP(11); ++rep_) { phase_sb_mfma(args, lds, bid, G, tid); } SEAM(pb + 11); TICK_OUT(11); } }
#endif
    { ARGS(); if (IN(pb + 12)) { TICK_IN(12); {
        pg8::Gemm g{(const bf16*)(args.ws + WS_AO), (const bf16*)(args.ws + W_O), D, D}; pg8::StaticOrder S; S.init(TT, D, G, bid);
        pg8::EpiResid<true> E{(const void*)args.out, YMOE, (const float*)(args.ws + WS_STATS), args.ln_g + (size_t)(4 * j + 1) * D, args.ln_b + (size_t)(4 * j + 1) * D};
        pg8::gemm_phase<pg8::EpiResid<true>, pg8::StaticOrder, true, true>(lds, g, S, E);
        } SEAM(pb + 12); TICK_OUT(12); } }
    { ARGS(); if (IN(pb + 13)) { TICK_IN(13); _Pragma("unroll 1") for (int rep_ = 0; rep_ < NREP(13); ++rep_) { phase_ln<true>(args, YMOE, (2 * j + 1) * 2 + 0, j, lds, bid, G, tid, wave, lane); } SEAM(pb + 13); TICK_OUT(13); } }
    { ARGS(); if (IN(pb + 14)) { TICK_IN(14); _Pragma("unroll 1") for (int rep_ = 0; rep_ < NREP(14); ++rep_) { phase_scatter(args, j, lds, bid, G, tid, wave, lane); } SEAM(pb + 14); TICK_OUT(14); } }
    { ARGS(); if (IN(pb + 15)) { TICK_IN(15); {
        unsigned off[9]; moe_offsets(args, j, off);
        pg8::MoeOrder S; S.nM = (int)(off[8] >> 8); S.G = G; S.c = bid; S.nN = 2 * FF / 256; S.nwg = S.nM * S.nN; S.rep = NREP(15);
        S.ps1 = (int)(off[1] >> 8); S.ps2 = (int)(off[2] >> 8); S.ps3 = (int)(off[3] >> 8); S.ps4 = (int)(off[4] >> 8); S.ps5 = (int)(off[5] >> 8); S.ps6 = (int)(off[6] >> 8); S.ps7 = (int)(off[7] >> 8);
        pg8::Gemm g{(const bf16*)(args.ws + WS_XS), (const bf16*)(args.ws + W_MGU), D, D};
        pg8::EpiSwiGLU E{(bf16*)(args.ws + WS_MACT), FF, 2 * FF / 256};
        pg8::gemm_phase<pg8::EpiSwiGLU, pg8::MoeOrder, true, true>(lds, g, S, E);
        } SEAM(pb + 15); TICK_OUT(15); } }
    { ARGS(); if (IN(pb + 16)) { TICK_IN(16); {
        unsigned off[9]; moe_offsets(args, j, off);
        pg8::MoeOrder S; S.nM = (int)(off[8] >> 8); S.G = G; S.c = bid; S.nN = D / 256; S.nwg = S.nM * S.nN; S.rep = NREP(16);
        S.ps1 = (int)(off[1] >> 8); S.ps2 = (int)(off[2] >> 8); S.ps3 = (int)(off[3] >> 8); S.ps4 = (int)(off[4] >> 8); S.ps5 = (int)(off[5] >> 8); S.ps6 = (int)(off[6] >> 8); S.ps7 = (int)(off[7] >> 8);
        pg8::Gemm g{(const bf16*)(args.ws + WS_MACT), (const bf16*)(args.ws + W_MD), FF, FF};
        pg8::EpiBf16 E{(bf16*)(args.ws + WS_XS), D, D / 256};
        pg8::gemm_phase<pg8::EpiBf16, pg8::MoeOrder, true, true>(lds, g, S, E);
        } SEAM(pb + 16); TICK_OUT(16); } }
    { ARGS(); if (IN(pb + 17)) { TICK_IN(17); _Pragma("unroll 1") for (int rep_ = 0; rep_ < NREP(17); ++rep_) { phase_combine_ln<(j == 1)>(args, YMOE, (bf16*)args.out, 4 * j + 2, 4 * j + 3, bid, G, wave, lane); } SEAM(pb + 17); TICK_OUT(17); } }
}
__global__ void __launch_bounds__(NWAVES * 64, 2) fwd(Args kargs) {
    extern __shared__ __attribute__((aligned(16))) unsigned char lds_raw[];
    LAS unsigned char* lds = (LAS unsigned char*)lds_raw;
    volatile LAS unsigned* MISC = (volatile LAS unsigned*)(lds + MISC_OFF);
    const int tid = threadIdx.x, lane = tid & 63, wave = __builtin_amdgcn_readfirstlane(tid >> 6), G = gridDim.x, bid = blockIdx.x;
    for (int u = tid; u < (LDS_BYTES - RING_BYTES) / 4; u += NWAVES * 64) ((LAS unsigned*)(lds + RING_BYTES))[u] = 0u;
    __syncthreads();
    if (tid == 0) { LAS unsigned long long* pa = (LAS unsigned long long*)(lds + ARGS_OFF);
        pa[0] = (unsigned long long)kargs.x; pa[1] = (unsigned long long)kargs.gdn_w_in; pa[2] = (unsigned long long)kargs.gdn_conv_w; pa[3] = (unsigned long long)kargs.gdn_a_log;
        pa[4] = (unsigned long long)kargs.gdn_dt_bias; pa[5] = (unsigned long long)kargs.gdn_norm_w; pa[6] = (unsigned long long)kargs.gdn_w_out; pa[7] = (unsigned long long)kargs.sb_w_in;
        pa[8] = (unsigned long long)kargs.sb_w_out; pa[9] = (unsigned long long)kargs.ffn_w_gate; pa[10] = (unsigned long long)kargs.ffn_w_up; pa[11] = (unsigned long long)kargs.ffn_w_down;
        pa[12] = (unsigned long long)kargs.moe_router; pa[13] = (unsigned long long)kargs.moe_w_gate; pa[14] = (unsigned long long)kargs.moe_w_up; pa[15] = (unsigned long long)kargs.moe_w_down;
        pa[16] = (unsigned long long)kargs.ln_g; pa[17] = (unsigned long long)kargs.ln_b; pa[18] = (unsigned long long)kargs.out; pa[19] = (unsigned long long)kargs.ws;
        pa[20] = (unsigned long long)(unsigned)kargs.ph_lo | ((unsigned long long)(unsigned)kargs.ph_hi << 32); }
    XcdBarrier bar = xcd_barrier_post((unsigned*)(kargs.ws + WS_CTL) + CW_BAR, MISC + 8);
    __syncthreads();
    layer_pair<0>(lds, bar, wave, G, bid);
    layer_pair<1>(lds, bar, wave, G, bid);
    if (PROBE_DELAY_MASK || PROBE_SEC) { if (bid == 0 && threadIdx.x == 0) { const unsigned acc = ((volatile LAS unsigned*)(lds + MISC_OFF))[20] * PROBE_DELAY_MULT; const unsigned long long t0 = __builtin_amdgcn_s_memrealtime(); while ((unsigned)(__builtin_amdgcn_s_memrealtime() - t0) < acc) __builtin_amdgcn_s_sleep(8); } }
}
#undef IN
#undef SEAM
#undef ARGS

extern "C" void kernel_launch(void* const* d_in, const int* in_sizes, int n_in, void* d_out, int out_size, void* d_ws, size_t ws_size, hipStream_t stream) {
    static int grid = 0;
    if (grid == 0) {
        if (n_in != 18 || in_sizes[0] != TT * D || out_size != TT * D || ws_size < WS_END) { fprintf(stderr, "kernel_launch: unexpected shapes (n_in %d, in0 %d, out %d, ws %zu); nothing launched\n", n_in, n_in > 0 ? in_sizes[0] : -1, out_size, ws_size); grid = -1; return; }
        int dev = 0, cus = 0, per_cu = 0;
        if (hipGetDevice(&dev) != hipSuccess || hipDeviceGetAttribute(&cus, hipDeviceAttributeMultiprocessorCount, dev) != hipSuccess) { grid = -1; return; }
        if (hipFuncSetAttribute((const void*)fwd, hipFuncAttributeMaxDynamicSharedMemorySize, LDS_BYTES) != hipSuccess) { fprintf(stderr, "kernel_launch: hipFuncSetAttribute failed\n"); grid = -1; return; }
        if (hipOccupancyMaxActiveBlocksPerMultiprocessor(&per_cu, (const void*)fwd, NWAVES * 64, LDS_BYTES) != hipSuccess || per_cu < 1) { fprintf(stderr, "kernel_launch: occupancy query says %d blocks per CU\n", per_cu); (void)hipGetLastError(); grid = -1; return; }
        grid = cus;
    }
    if (grid < 0) return;
    if (hipMemsetAsync((char*)d_ws + WS_CTL, 0, CTL_ZERO_BYTES, stream) != hipSuccess) return;
    Args a{};
    a.x = (const float*)d_in[0]; a.gdn_w_in = (const float*)d_in[1]; a.gdn_conv_w = (const float*)d_in[2]; a.gdn_a_log = (const float*)d_in[3]; a.gdn_dt_bias = (const float*)d_in[4];
    a.gdn_norm_w = (const float*)d_in[5]; a.gdn_w_out = (const float*)d_in[6]; a.sb_w_in = (const float*)d_in[7]; a.sb_w_out = (const float*)d_in[8];
    a.ffn_w_gate = (const float*)d_in[9]; a.ffn_w_up = (const float*)d_in[10]; a.ffn_w_down = (const float*)d_in[11]; a.moe_router = (const float*)d_in[12];
    a.moe_w_gate = (const float*)d_in[13]; a.moe_w_up = (const float*)d_in[14]; a.moe_w_down = (const float*)d_in[15]; a.ln_g = (const float*)d_in[16]; a.ln_b = (const float*)d_in[17];
    a.out = (float*)d_out; a.ws = (unsigned char*)d_ws;
#if MK_ONE_LAUNCH
    a.ph_lo = 0; a.ph_hi = NPHASES;
    hipLaunchKernelGGL(fwd, dim3(grid), dim3(NWAVES * 64), LDS_BYTES, stream, a);
#else
    for (int p = 0; p < NPHASES; ++p) { a.ph_lo = p; a.ph_hi = p + 1; hipLaunchKernelGGL(fwd, dim3(grid), dim3(NWAVES * 64), LDS_BYTES, stream, a); }
#endif
}
```

```cpp
#include <hip/hip_runtime.h>
#include <cstdio>
#include <cstdint>
#ifndef GDN_NAIVE
#define GDN_NAIVE 0
#endif
#ifndef SB_NAIVE
#define SB_NAIVE 0
#endif
#ifndef MK_ONE_LAUNCH
#define MK_ONE_LAUNCH 1
#endif
#ifndef PROBE_SEC
#define PROBE_SEC 0
#endif
#define GSEC_ACC(k, sign) do { if (PROBE_SEC == (k)) { if (blockIdx.x == 0 && threadIdx.x == 0) { volatile __attribute__((address_space(3))) unsigned* p_ = (volatile __attribute__((address_space(3))) unsigned*)(131072 + 320 + 80); *p_ = *p_ sign (unsigned)__builtin_amdgcn_s_memrealtime(); } } } while (0)
namespace pg8 {
#define PG8_LAS __attribute__((address_space(3)))
typedef unsigned short bf16_t;
typedef short bf16x8 __attribute__((ext_vector_type(8)));
typedef float f32x4 __attribute__((ext_vector_type(4)));
typedef unsigned u32x4 __attribute__((ext_vector_type(4)));
constexpr int BM = 256, BK = 64, HALF = 128, HTB = HALF * BK * 2  , STAGE_BYTES = 8 * HTB, NXCD = 8, WGM = 8;

__host__ __device__ __forceinline__ int lds_byte(int r, int c) { const int st = (r >> 4) * 2 + (c >> 5), rr = r & 15, cc = c & 31, ob = rr * 64 + cc * 2; return st * 1024 + (ob ^ (((ob >> 9) & 1) << 5)); }
__host__ __device__ __forceinline__ void stage_rc(int b, int& R, int& C) { const int st = b / 1024, sb = b % 1024, swz = sb ^ (((sb >> 9) & 1) << 5); R = (st >> 1) * 16 + swz / 64; C = (st & 1) * 32 + (swz % 64) / 2; }
__host__ __device__ __forceinline__ int perm32(int rho) { const int n = rho >> 4, i = rho & 15; return 8 * (i >> 2) + 4 * n + (i & 3); }

struct Unit { int pm, pn; };
struct Gemm { const bf16_t* A; const bf16_t* Bt; int lda, K; };

struct StaticOrder {
    int nM, nN, nwg, G, c, rep;
    __host__ __device__ void init(int M, int N, int G_, int c_, int rep_ = 1) { nM = M / BM; nN = N / BM; nwg = nM * nN; G = G_; c = c_; rep = rep_; }
    __host__ __device__ bool next(int i, Unit& u) const {
        const long L = (long)i * G + c; if (L >= (long)rep * nwg) return false;
        int wgid = (int)(L % nwg); { const int q = nwg / NXCD, r = nwg % NXCD, xcd = wgid % NXCD, off = wgid / NXCD; wgid = (xcd < r ? xcd * (q + 1) : r * (q + 1) + (xcd - r) * q) + off; }
        const int nig = WGM * nN, gid = wgid / nig, fm = gid * WGM, gsz = (nM - fm) < WGM ? (nM - fm) : WGM;
        u.pm = fm + ((wgid % nig) % gsz); u.pn = (wgid % nig) / gsz; return true;
    }
    __device__ __forceinline__ void a_ready(const Unit&) const {}
    __device__ __forceinline__ void done(const Unit&) const {}
};

__device__ __forceinline__ unsigned cvt_pk_bf16(float lo, float hi) { unsigned r; asm volatile("v_cvt_pk_bf16_f32 %0, %1, %2" : "=v"(r) : "v"(lo), "v"(hi)); return r; }
struct EpiBf16 {
    static constexpr bool PERM = true, AFTER_DRAIN = false;
    bf16_t* O; int ldc; int nmod;
    __device__ __forceinline__ void operator()(const f32x4 (&acc)[2][2][4][2], const Unit& u, int wr, int wc, int fr, int fq) const {
        const int pnl = nmod ? (u.pn % nmod) : u.pn;
        const int row0 = u.pm * BM + wr * 64 + fr, col0 = pnl * BM + wc * 32 + 8 * fq;
#pragma unroll
        for (int ai = 0; ai < 2; ++ai)
#pragma unroll
            for (int m = 0; m < 4; ++m) { bf16_t* rowp = O + (size_t)(row0 + ai * HALF + m * 16) * ldc + col0;
#pragma unroll
                for (int bj = 0; bj < 2; ++bj) { const f32x4 v0 = acc[ai][bj][m][0], v1 = acc[ai][bj][m][1];
                    u32x4 w; w.x = cvt_pk_bf16(v0[0], v0[1]); w.y = cvt_pk_bf16(v0[2], v0[3]); w.z = cvt_pk_bf16(v1[0], v1[1]); w.w = cvt_pk_bf16(v1[2], v1[3]);
                    *(u32x4*)(rowp + bj * HALF) = w; } }
    }
};
struct EpiInProj {
    static constexpr bool PERM = true, AFTER_DRAIN = false;
    bf16_t* RAW; bf16_t* ZB;
    __device__ __forceinline__ void operator()(const f32x4 (&acc)[2][2][4][2], const Unit& u, int wr, int wc, int fr, int fq) const {
        const bool isz = (u.pn >= 16 && u.pn < 24);
        bf16_t* O = isz ? ZB : RAW; const int ldc = isz ? 2048 : 4352; const int ct = isz ? (u.pn - 16) : (u.pn < 16 ? u.pn : 16);
        const int row0 = u.pm * BM + wr * 64 + fr, col0 = ct * BM + wc * 32 + 8 * fq;
#pragma unroll
        for (int ai = 0; ai < 2; ++ai)
#pragma unroll
            for (int m = 0; m < 4; ++m) { bf16_t* rowp = O + (size_t)(row0 + ai * HALF + m * 16) * ldc + col0;
#pragma unroll
                for (int bj = 0; bj < 2; ++bj) { f32x4 v0 = acc[ai][bj][m][0], v1 = acc[ai][bj][m][1];
                    if (isz) {
#pragma unroll
                        for (int e = 0; e < 4; ++e) { v0[e] = v0[e] * __builtin_amdgcn_rcpf(1.0f + __builtin_amdgcn_exp2f(-1.4426950408889634f * v0[e])); v1[e] = v1[e] * __builtin_amdgcn_rcpf(1.0f + __builtin_amdgcn_exp2f(-1.4426950408889634f * v1[e])); } }
                    u32x4 w; w.x = cvt_pk_bf16(v0[0], v0[1]); w.y = cvt_pk_bf16(v0[2], v0[3]); w.z = cvt_pk_bf16(v1[0], v1[1]); w.w = cvt_pk_bf16(v1[2], v1[3]);
                    *(u32x4*)(rowp + bj * HALF) = w; } }
    }
};
__device__ __forceinline__ float silu_f(float x) { return x * __builtin_amdgcn_rcpf(1.0f + __builtin_amdgcn_exp2f(-1.4426950408889634f * x)); }
struct EpiSwiGLU {
    static constexpr bool PERM = true, AFTER_DRAIN = false;
    bf16_t* O; int ldc; int nmod;
    __device__ __forceinline__ void operator()(const f32x4 (&acc)[2][2][4][2], const Unit& u, int wr, int wc, int fr, int fq) const {
        const int pnl = nmod ? (u.pn % nmod) : u.pn;
        const int row0 = u.pm * BM + wr * 64 + fr, col0 = pnl * HALF + wc * 32 + 8 * fq;
#pragma unroll
        for (int ai = 0; ai < 2; ++ai)
#pragma unroll
            for (int m = 0; m < 4; ++m) { bf16_t* rowp = O + (size_t)(row0 + ai * HALF + m * 16) * ldc + col0;
                const f32x4 g0 = acc[ai][0][m][0], g1 = acc[ai][0][m][1], u0 = acc[ai][1][m][0], u1 = acc[ai][1][m][1];
                u32x4 w;
                w.x = cvt_pk_bf16(silu_f(g0[0]) * u0[0], silu_f(g0[1]) * u0[1]); w.y = cvt_pk_bf16(silu_f(g0[2]) * u0[2], silu_f(g0[3]) * u0[3]);
                w.z = cvt_pk_bf16(silu_f(g1[0]) * u1[0], silu_f(g1[1]) * u1[1]); w.w = cvt_pk_bf16(silu_f(g1[2]) * u1[2], silu_f(g1[3]) * u1[3]);
                *(u32x4*)rowp = w; }
    }
};
typedef float f32x2e __attribute__((ext_vector_type(2)));
template <bool LNR> struct EpiResid {
    static constexpr bool PERM = true, AFTER_DRAIN = false;
    const void* res; bf16_t* out; const float* stats; const float* g; const float* b;
    __device__ __forceinline__ void operator()(const f32x4 (&acc)[2][2][4][2], const Unit& u, int wr, int wc, int fr, int fq) const {
        constexpr int ldc = 1024; constexpr float alpha = 1.6817928305074290f;
        const int row0 = u.pm * BM + wr * 64 + fr, col0 = u.pn * BM + wc * 32 + 8 * fq;
#pragma unroll
        for (int bj = 0; bj < 2; ++bj) {
            f32x4 g0, g1, b0, b1;
            if constexpr (LNR) { g0 = *(const f32x4*)(g + col0 + bj * HALF) * alpha; g1 = *(const f32x4*)(g + col0 + bj * HALF + 4) * alpha;
                                 b0 = *(const f32x4*)(b + col0 + bj * HALF) * alpha; b1 = *(const f32x4*)(b + col0 + bj * HALF + 4) * alpha; }
#pragma unroll
            for (int ai = 0; ai < 2; ++ai) {
                if constexpr (LNR) {
                    u32x4 w[4]; f32x2e st[4];
#pragma unroll
                    for (int m = 0; m < 4; ++m) { const int row = row0 + ai * HALF + m * 16; w[m] = *(const u32x4*)((const bf16_t*)res + (size_t)row * ldc + col0 + bj * HALF); st[m] = *(const f32x2e*)(stats + 2 * row); }
                    asm volatile("" ::: "memory");
#pragma unroll
                    for (int m = 0; m < 4; ++m) { const int row = row0 + ai * HALF + m * 16; const float mean = st[m].x, rstd = st[m].y;
                        const f32x4 r0 = {__uint_as_float(w[m].x << 16), __uint_as_float(w[m].x & 0xffff0000u), __uint_as_float(w[m].y << 16), __uint_as_float(w[m].y & 0xffff0000u)};
                        const f32x4 r1 = {__uint_as_float(w[m].z << 16), __uint_as_float(w[m].z & 0xffff0000u), __uint_as_float(w[m].w << 16), __uint_as_float(w[m].w & 0xffff0000u)};
                        const f32x4 v0 = (r0 - mean) * rstd * g0 + b0 + acc[ai][bj][m][0], v1 = (r1 - mean) * rstd * g1 + b1 + acc[ai][bj][m][1];
                        u32x4 o; o.x = cvt_pk_bf16(v0[0], v0[1]); o.y = cvt_pk_bf16(v0[2], v0[3]); o.z = cvt_pk_bf16(v1[0], v1[1]); o.w = cvt_pk_bf16(v1[2], v1[3]);
                        *(u32x4*)(out + (size_t)row * ldc + col0 + bj * HALF) = o; }
                } else {
                    f32x4 x0[4], x1[4];
#pragma unroll
                    for (int m = 0; m < 4; ++m) { const size_t off = (size_t)(row0 + ai * HALF + m * 16) * ldc + col0 + bj * HALF; x0[m] = *(const f32x4*)((const float*)res + off); x1[m] = *(const f32x4*)((const float*)res + off + 4); }
                    asm volatile("" ::: "memory");
#pragma unroll
                    for (int m = 0; m < 4; ++m) { const size_t off = (size_t)(row0 + ai * HALF + m * 16) * ldc + col0 + bj * HALF;
                        const f32x4 v0 = x0[m] * alpha + acc[ai][bj][m][0], v1 = x1[m] * alpha + acc[ai][bj][m][1];
                        u32x4 o; o.x = cvt_pk_bf16(v0[0], v0[1]); o.y = cvt_pk_bf16(v0[2], v0[3]); o.z = cvt_pk_bf16(v1[0], v1[1]); o.w = cvt_pk_bf16(v1[2], v1[3]);
                        *(u32x4*)(out + off) = o; }
                }
                asm volatile("" ::: "memory");
            }
        }
    }
};
struct MoeOrder {
    int nM, nN, nwg, G, c, rep; int ps1, ps2, ps3, ps4, ps5, ps6, ps7;
    __device__ __forceinline__ bool next(int i, Unit& u) const {
        const long L = (long)i * G + c; if (nwg == 0 || L >= (long)rep * nwg) return false;
        int wgid = (int)(L % nwg); { const int q = nwg / NXCD, r = nwg % NXCD, xcd = wgid % NXCD, off = wgid / NXCD; wgid = (xcd < r ? xcd * (q + 1) : r * (q + 1) + (xcd - r) * q) + off; }
        const int nig = WGM * nN, gid = wgid / nig, fm = gid * WGM, gsz = (nM - fm) < WGM ? (nM - fm) : WGM;
        const int pm = fm + ((wgid % nig) % gsz), pnl = (wgid % nig) / gsz;
        const int e = (pm >= ps1) + (pm >= ps2) + (pm >= ps3) + (pm >= ps4) + (pm >= ps5) + (pm >= ps6) + (pm >= ps7);
        u.pm = pm; u.pn = e * nN + pnl; return true;
    }
    __device__ __forceinline__ void a_ready(const Unit&) const {}
    __device__ __forceinline__ void done(const Unit&) const {}
};
template <class Epi, class Sched, bool ALIGN_EPI = false, bool SP2 = false>
__device__ __forceinline__ void gemm_phase(PG8_LAS unsigned char* lds, const Gemm g, const Sched& S, const Epi& E) {
    const int tid = threadIdx.x, wid = __builtin_amdgcn_readfirstlane(tid >> 6), lane = tid & 63, wr = wid >> 2, wc = wid & 3, fr = lane & 15, fq = lane >> 4;
    const int K = g.K, nt = K / BK;
    unsigned voffA[2], voffB[2];
#pragma unroll
    for (int i = 0; i < 2; ++i) { int R, C; stage_rc(tid * 16 + i * 8192, R, C); const int Rb = Epi::PERM ? ((R & ~31) + perm32(R & 31)) : R;
        voffA[i] = (unsigned)(R * g.lda + C) * 2u; voffB[i] = (unsigned)(Rb * K + C) * 2u; }
    const size_t kstep = (size_t)(BK * 2);
    const size_t hstepA = (size_t)HALF * g.lda * 2, hstepB = (size_t)HALF * K * 2;
    const size_t tstepA = 2 * hstepA, tstepB = 2 * hstepB;
    const unsigned ldsw = (unsigned)wid * 1024u;
    const int aoff = lds_byte(wr * 64 + fr, fq * 8), boff = lds_byte(wc * 32 + fr, fq * 8);
#define PG8_SA(b, h) (((b) * 2 + (h)) * HTB)
#define PG8_SB(b, h) ((4 + (b) * 2 + (h)) * HTB)
#define PG8_STAGE(bufoff, gbase, voff) do { _Pragma("unroll") for (int _i = 0; _i < 2; ++_i) \
        __builtin_amdgcn_global_load_lds((const unsigned*)((const char*)(gbase) + (voff)[_i]), (PG8_LAS unsigned*)(lds + (bufoff) + ldsw + _i * 8192), 16, 0, 0); } while (0)
#define PG8_LDA(dst, b, h) do { _Pragma("unroll") for (int m = 0; m < 4; ++m) _Pragma("unroll") for (int k = 0; k < 2; ++k) dst[m][k] = *(const PG8_LAS bf16x8*)(lds + PG8_SA(b, h) + aoff + m * 2048 + k * 1024); } while (0)
#define PG8_LDB(dst, b, h) do { _Pragma("unroll") for (int n = 0; n < 2; ++n) _Pragma("unroll") for (int k = 0; k < 2; ++k) dst[n][k] = *(const PG8_LAS bf16x8*)(lds + PG8_SB(b, h) + boff + n * 2048 + k * 1024); } while (0)
#define PG8_MMA(ai, bj, At, Bt) do { __builtin_amdgcn_s_setprio(1); _Pragma("unroll") for (int m = 0; m < 4; ++m) _Pragma("unroll") for (int n = 0; n < 2; ++n) _Pragma("unroll") for (int k = 0; k < 2; ++k) \
        acc[ai][bj][m][n] = __builtin_amdgcn_mfma_f32_16x16x32_bf16(Bt[n][k], At[m][k], acc[ai][bj][m][n], 0, 0, 0); __builtin_amdgcn_s_setprio(0); } while (0)
#define PG8_WAIT_V(n) asm volatile("s_waitcnt vmcnt(" #n ")" ::: "memory")
#define PG8_WAIT_L(n) asm volatile("s_waitcnt lgkmcnt(" #n ")" ::: "memory")
#define PG8_BAR __builtin_amdgcn_s_barrier()
#define PG8_SCHED __builtin_amdgcn_sched_barrier(0)
    Unit cur, nxt; int ui = 0;
    if (!S.next(0, cur)) return;
    f32x4 acc[2][2][4][2];
#pragma unroll
    for (int a = 0; a < 2; ++a)
#pragma unroll
        for (int b = 0; b < 2; ++b)
#pragma unroll
            for (int m = 0; m < 4; ++m)
#pragma unroll
                for (int n = 0; n < 2; ++n) acc[a][b][m][n] = (f32x4){0.f, 0.f, 0.f, 0.f};
    bf16x8 At[4][2], B0[2][2], B1[2][2];
    const char* cA = (const char*)g.A + (size_t)cur.pm * tstepA; const char* cB = (const char*)g.Bt + (size_t)cur.pn * tstepB;
    S.a_ready(cur);
    if constexpr (SP2) {
        PG8_STAGE(PG8_SB(0, 0), cB, voffB); PG8_STAGE(PG8_SB(0, 1), cB + hstepB, voffB); PG8_STAGE(PG8_SA(0, 0), cA, voffA); PG8_STAGE(PG8_SA(0, 1), cA + hstepA, voffA);
        if (wr == 1) PG8_BAR;
        PG8_WAIT_V(2); PG8_BAR;
        PG8_STAGE(PG8_SB(1, 0), cB + kstep, voffB); PG8_STAGE(PG8_SA(1, 0), cA + kstep, voffA); PG8_STAGE(PG8_SB(1, 1), cB + hstepB + kstep, voffB);
        PG8_WAIT_V(6); PG8_BAR;
    } else {
        PG8_STAGE(PG8_SB(0, 0), cB, voffB); PG8_STAGE(PG8_SA(0, 0), cA, voffA); PG8_STAGE(PG8_SB(0, 1), cB + hstepB, voffB); PG8_STAGE(PG8_SA(0, 1), cA + hstepA, voffA);
        if (wr == 1) PG8_BAR;
        PG8_WAIT_V(4); PG8_BAR;
        PG8_STAGE(PG8_SB(1, 0), cB + kstep, voffB); PG8_STAGE(PG8_SA(1, 0), cA + kstep, voffA); PG8_STAGE(PG8_SB(1, 1), cB + hstepB + kstep, voffB);
        PG8_WAIT_V(6); PG8_BAR;
    }
    for (;;) {
        const bool has_next = S.next(ui + 1, nxt);
        const char* nA = has_next ? (const char*)g.A + (size_t)nxt.pm * tstepA : cA; const char* nB = has_next ? (const char*)g.Bt + (size_t)nxt.pn * tstepB : cB;
        GSEC_ACC(6, -);
        for (int t = 0; t < nt; t += 2) {
            const bool last = (t == nt - 2);
            const char* a1 = cA + (size_t)(t + 1) * kstep;
            const char* a2 = last ? nA : cA + (size_t)(t + 2) * kstep; const char* b2 = last ? nB : cB + (size_t)(t + 2) * kstep;
            const char* a3 = a2 + kstep; const char* b3 = b2 + kstep;
            if (last && has_next) S.a_ready(nxt);
            if constexpr (SP2) {
            PG8_LDB(B0, 0, 0); PG8_LDB(B1, 0, 1); PG8_SCHED; PG8_LDA(At, 0, 0); PG8_STAGE(PG8_SA(1, 1), a1 + hstepA, voffA);
            PG8_WAIT_V(8); PG8_WAIT_L(0); PG8_BAR; PG8_MMA(0, 0, At, B0); PG8_MMA(0, 1, At, B1); PG8_BAR; PG8_SCHED;
            PG8_LDA(At, 0, 1); PG8_STAGE(PG8_SB(0, 0), b2, voffB); PG8_STAGE(PG8_SB(0, 1), b2 + hstepB, voffB); PG8_STAGE(PG8_SA(0, 0), a2, voffA);
            PG8_WAIT_V(8); PG8_WAIT_L(0); PG8_BAR; PG8_MMA(1, 0, At, B0); PG8_MMA(1, 1, At, B1); PG8_BAR; PG8_SCHED;
            PG8_LDB(B0, 1, 0); PG8_LDB(B1, 1, 1); PG8_SCHED; PG8_LDA(At, 1, 0); PG8_STAGE(PG8_SA(0, 1), a2 + hstepA, voffA);
            PG8_WAIT_V(8); PG8_WAIT_L(0); PG8_BAR; PG8_MMA(0, 0, At, B0); PG8_MMA(0, 1, At, B1); PG8_BAR; PG8_SCHED;
            PG8_LDA(At, 1, 1); PG8_STAGE(PG8_SB(1, 0), b3, voffB); PG8_STAGE(PG8_SB(1, 1), b3 + hstepB, voffB); PG8_STAGE(PG8_SA(1, 0), a3, voffA);
            PG8_WAIT_V(8); PG8_WAIT_L(0); PG8_BAR; PG8_MMA(1, 0, At, B0); PG8_MMA(1, 1, At, B1); PG8_BAR; PG8_SCHED;
            } else {
            PG8_LDB(B0, 0, 0); PG8_SCHED; PG8_LDA(At, 0, 0); PG8_STAGE(PG8_SA(1, 1), a1 + hstepA, voffA);
            PG8_WAIT_L(8); PG8_BAR; PG8_WAIT_L(0); PG8_MMA(0, 0, At, B0); PG8_BAR; PG8_SCHED;
            PG8_LDB(B1, 0, 1); PG8_STAGE(PG8_SB(0, 0), b2, voffB);
            PG8_BAR; PG8_WAIT_L(0); PG8_MMA(0, 1, At, B1); PG8_BAR;
            PG8_LDA(At, 0, 1); PG8_STAGE(PG8_SA(0, 0), a2, voffA);
            PG8_BAR; PG8_WAIT_L(0); PG8_MMA(1, 0, At, B0); PG8_BAR; PG8_SCHED;
            PG8_STAGE(PG8_SB(0, 1), b2 + hstepB, voffB);
            PG8_WAIT_V(6); PG8_BAR; PG8_MMA(1, 1, At, B1); PG8_BAR;
            PG8_LDB(B0, 1, 0); PG8_SCHED; PG8_LDA(At, 1, 0); PG8_STAGE(PG8_SA(0, 1), a2 + hstepA, voffA);
            PG8_WAIT_L(8); PG8_BAR; PG8_WAIT_L(0); PG8_MMA(0, 0, At, B0); PG8_BAR; PG8_SCHED;
            PG8_LDB(B1, 1, 1); PG8_STAGE(PG8_SB(1, 0), b3, voffB);
            PG8_BAR; PG8_WAIT_L(0); PG8_MMA(0, 1, At, B1); PG8_BAR;
            PG8_LDA(At, 1, 1); PG8_STAGE(PG8_SA(1, 0), a3, voffA);
            PG8_BAR; PG8_WAIT_L(0); PG8_MMA(1, 0, At, B0); PG8_BAR; PG8_SCHED;
            PG8_STAGE(PG8_SB(1, 1), b3 + hstepB, voffB);
            PG8_WAIT_V(6); PG8_BAR; PG8_MMA(1, 1, At, B1); PG8_BAR;
            }
        }
        GSEC_ACC(6, +); GSEC_ACC(7, -);
        if constexpr (ALIGN_EPI) { if (wr == 0) PG8_BAR; }
        if constexpr (!Epi::AFTER_DRAIN) { E(acc, cur, wr, wc, fr, fq); S.done(cur); }
        GSEC_ACC(7, +);
        if (!has_next) break;
#pragma unroll
        for (int a = 0; a < 2; ++a)
#pragma unroll
            for (int b = 0; b < 2; ++b)
#pragma unroll
                for (int m = 0; m < 4; ++m)
#pragma unroll
                    for (int n = 0; n < 2; ++n) acc[a][b][m][n] = (f32x4){0.f, 0.f, 0.f, 0.f};
        cur = nxt; cA = nA; cB = nB; ++ui;
        if constexpr (ALIGN_EPI) { if (wr == 1) PG8_BAR; }
    }
    PG8_WAIT_V(0);
    if constexpr (!ALIGN_EPI) { if (wr == 0) PG8_BAR; }
    PG8_BAR;
    if constexpr (Epi::AFTER_DRAIN) { E.fused(acc, cur, wr, wc, fr, fq, lds, wid, lane); S.done(cur); }
#undef PG8_SA
#undef PG8_SB
#undef PG8_STAGE
#undef PG8_LDA
#undef PG8_LDB
#undef PG8_MMA
#undef PG8_WAIT_V
#undef PG8_WAIT_L
#undef PG8_BAR
#undef PG8_SCHED
}
}

constexpr int NWAVES = 8;
constexpr int BATCH = 8, SEQ = 4096, TT = BATCH * SEQ, D = 1024;
constexpr int HK = 8, HV = 16, HD = 128;
constexpr int GIN = 6176, GINP = 6400;
constexpr int FF = 3584, NE = 8, MOE_ROWS = 67584;
constexpr float ALPHA = 1.6817928305074290f;
constexpr float LN_EPS = 1e-5f, RMS_EPS = 1e-6f;
constexpr int NPH = 18, NPHASES = 2 * NPH;

constexpr size_t MiB = 1ull << 20;
constexpr size_t WS_CTL = 0, CTL_ZERO_BYTES = 1 * MiB;
constexpr size_t WS_E12 = 1 * MiB;
constexpr size_t WS_G12 = WS_E12 + 256 * 1024;
constexpr size_t WS_POS = WS_G12 + 256 * 1024;
constexpr size_t WS_GB = 2 * MiB;
constexpr size_t WS_W = 16 * MiB;
constexpr size_t WS_W2 = 912 * MiB;
constexpr size_t W_IN = WS_W2, W_OUT = WS_W2 + 13 * MiB, W_GU = WS_W2 + 17 * MiB, W_D = WS_W2 + 31 * MiB;
constexpr size_t W_QKV = WS_W, W_O = WS_W + 6 * MiB, W_MGU = WS_W + 8 * MiB, W_MD = WS_W + 120 * MiB;
constexpr size_t WS_HB = 192 * MiB;
constexpr size_t WS_BIG = 256 * MiB;
constexpr size_t WS_ZB = WS_BIG, WS_RAW = WS_BIG + 128 * MiB, WS_QKVC = WS_BIG + 400 * MiB;
constexpr int RAWLD = 4352;
constexpr size_t WS_WMEM = WS_RAW, WS_IMEM = WS_RAW + 128 * MiB, WS_KTMEM = WS_RAW + 192 * MiB;
constexpr size_t WS_STATS = 12 * MiB;
constexpr size_t WS_GTAB = 6 * MiB;
constexpr size_t WS_ACT = WS_BIG;
constexpr size_t WS_QKV = WS_BIG, WS_AO = WS_BIG + 192 * MiB;
constexpr size_t WS_XS = WS_BIG, WS_MACT = WS_BIG + 132 * MiB;
constexpr size_t WS_YT = 850 * MiB;
constexpr size_t WS_END = 950 * MiB;
static_assert(WS_QKVC + (size_t)TT * 4096 * 2 <= WS_W2 && WS_MACT + (size_t)MOE_ROWS * FF * 2 <= WS_END && WS_RAW + (size_t)TT * RAWLD * 2 <= WS_QKVC && WS_KTMEM + (size_t)4096 * 8192 * 2 <= WS_QKVC && WS_GTAB + (size_t)8192 * 192 * 4 <= WS_W, "d_ws map");
static_assert(W_MD + (size_t)NE * D * FF * 2 <= WS_HB && W_IN + (size_t)GINP * D * 2 <= W_OUT && W_D + (size_t)D * FF * 2 <= WS_END && WS_QKVC + (size_t)TT * 4096 * 2 <= WS_W2 && W_MGU + (size_t)NE * 2 * FF * D * 2 <= W_MD, "weight map");
constexpr int CW_BAR = 4096;
constexpr int CW_CNT = 16384;

constexpr int RING_BYTES = 131072;
constexpr int MISC_OFF = RING_BYTES + 320;
constexpr int OGST_OFF = 147456;
#define SEC_IN(k) do { if (PROBE_SEC == (k)) { if (blockIdx.x == 0 && (threadIdx.x == 0)) ((volatile LAS unsigned*)((LAS unsigned char*)0 + MISC_OFF))[20] -= (unsigned)__builtin_amdgcn_s_memrealtime(); } } while (0)
#define SEC_OUT(k) do { if (PROBE_SEC == (k)) { if (blockIdx.x == 0 && (threadIdx.x == 0)) ((volatile LAS unsigned*)((LAS unsigned char*)0 + MISC_OFF))[20] += (unsigned)__builtin_amdgcn_s_memrealtime(); } } while (0)
constexpr int LDS_BYTES = 163840;

#define GAS __attribute__((address_space(1)))
#define LAS __attribute__((address_space(3)))
#define DI __device__ __forceinline__
typedef unsigned short bf16;
typedef unsigned v4u __attribute__((ext_vector_type(4)));
typedef unsigned v2u __attribute__((ext_vector_type(2)));
typedef float f32x4 __attribute__((ext_vector_type(4)));
typedef float f32x2 __attribute__((ext_vector_type(2)));
typedef GAS unsigned gu32;
#define RLX_AGENT __ATOMIC_RELAXED, __HIP_MEMORY_SCOPE_AGENT
#define LDS_WAIT() asm volatile("s_waitcnt lgkmcnt(0)" ::: "memory")
#define VM_WAIT() asm volatile("s_waitcnt vmcnt(0)" ::: "memory")
__device__ __forceinline__ unsigned long long rt() { return __builtin_amdgcn_s_memrealtime(); }
__device__ __forceinline__ unsigned f2bf(float f) { unsigned u = __builtin_bit_cast(unsigned, f); return (u + 0x7fffu + ((u >> 16) & 1u)) >> 16; }
__device__ __forceinline__ unsigned pk2(float lo, float hi) { return f2bf(lo) | (f2bf(hi) << 16); }

#define XB_TMO      128
#define XB_XCNT(j)  (256  + 64 * (j))
#define XB_XSUB(j)  (1280 + 64 * (j))
#define XB_XGEN(j)  (2304 + 64 * (j))
#define XB_TOP      3328
#define XB_TOPGEN   3392
#define XCD_BAR_WORDS 3456
#define XB_SPIN_CAP (1u << 22)

__device__ __forceinline__ unsigned xb_ld(unsigned* p)              { return __hip_atomic_load(p, __ATOMIC_RELAXED, __HIP_MEMORY_SCOPE_AGENT); }
__device__ __forceinline__ unsigned xb_add(unsigned* p, unsigned v) { return __hip_atomic_fetch_add(p, v, __ATOMIC_RELAXED, __HIP_MEMORY_SCOPE_AGENT); }
__device__ __forceinline__ unsigned xb_xcc_id() { return (unsigned)__builtin_amdgcn_s_getreg((3 << 11) | 20) & 0xFu; }
#define XB_SPIN(cond, bar) do { unsigned _sp = 0; while (cond) { __builtin_amdgcn_s_sleep(1); \
    if ((++_sp & 255u) == 0u) { if (xb_ld(&(bar)[XB_TMO])) break; if (_sp > XB_SPIN_CAP) { atomicAdd(&(bar)[XB_TMO], 1u); break; } } } } while (0)

struct XcdBarrier {
    unsigned* bar; unsigned x;
    volatile LAS unsigned* st;
};

__device__ __forceinline__ XcdBarrier xcd_barrier_post(unsigned* bar, volatile LAS unsigned* st) {
    XcdBarrier b; b.bar = bar; b.x = xb_xcc_id(); b.st = st;
    if (threadIdx.x == 0) (void)xb_add(&bar[XB_XCNT(b.x)], 1u);
    return b;
}
__device__ __forceinline__ void xcd_barrier_complete(unsigned* bar, unsigned x, unsigned& nloc, unsigned& nx) {
    const unsigned G = gridDim.x * gridDim.y * gridDim.z;
    unsigned sum, cnt, mine, sp = 0u;
    for (;;) {
        sum = 0u; cnt = 0u; mine = 0u;
#pragma unroll
        for (unsigned j = 0; j < 16; ++j) { const unsigned c = xb_ld(&bar[XB_XCNT(j)]); sum += c; cnt += (c > 0u) ? 1u : 0u; mine = (j == x) ? c : mine; }
        if (sum == G) break;
        __builtin_amdgcn_s_sleep(1);
        if ((++sp & 255u) == 0u) { if (xb_ld(&bar[XB_TMO])) break; if (sp > XB_SPIN_CAP) { atomicAdd(&bar[XB_TMO], 1u); break; } }
    }
    nloc = mine > 0u ? mine : 1u; nx = cnt > 0u ? cnt : 1u;
}

__device__ __forceinline__ void xcd_barrier(const XcdBarrier& b) {
    asm volatile("s_waitcnt vmcnt(0)" ::: "memory");
    __syncthreads();
    if (threadIdx.x == 0) {
        unsigned* bar = b.bar;
        __builtin_amdgcn_s_waitcnt(0);
        unsigned nloc = b.st[0], nx = b.st[1];
        if (nloc == 0u) { xcd_barrier_complete(bar, b.x, nloc, nx); b.st[0] = nloc; b.st[1] = nx; }
        const unsigned old = xb_add(&bar[XB_XSUB(b.x)], 1u);
        const unsigned gen = old / nloc;
        if (old + 1u == (gen + 1u) * nloc) {
            __builtin_amdgcn_fence(__ATOMIC_RELEASE, "agent");
            asm volatile("s_waitcnt vmcnt(0)" ::: "memory");
            const unsigned og = xb_add(&bar[XB_TOP], 1u);
            const unsigned tg = og / nx;
            if (og + 1u == (tg + 1u) * nx) xb_add(&bar[XB_TOPGEN], 1u);
            else XB_SPIN(xb_ld(&bar[XB_TOPGEN]) == tg, bar);
            __builtin_amdgcn_fence(__ATOMIC_ACQUIRE, "agent");
            xb_add(&bar[XB_XGEN(b.x)], 1u);
            asm volatile("s_waitcnt vmcnt(0)" ::: "memory");
        } else {
            XB_SPIN(xb_ld(&bar[XB_XGEN(b.x)]) == gen, bar);
            __builtin_amdgcn_fence(__ATOMIC_ACQUIRE, "agent");
            asm volatile("s_waitcnt vmcnt(0)" ::: "memory");
        }
    }
    __syncthreads();
}

DI float bf_lo(unsigned w) { return __uint_as_float(w << 16); }
DI float bf_hi(unsigned w) { return __uint_as_float(w & 0xffff0000u); }
DI float wave_sum(float v) {
    v += __builtin_bit_cast(float, __builtin_amdgcn_update_dpp(0, __builtin_bit_cast(int, v), 0xB1, 0xF, 0xF, false));
    v += __builtin_bit_cast(float, __builtin_amdgcn_update_dpp(0, __builtin_bit_cast(int, v), 0x4E, 0xF, 0xF, false));
    v += __builtin_bit_cast(float, __builtin_amdgcn_update_dpp(0, __builtin_bit_cast(int, v), 0x141, 0xF, 0xF, false));
    v += __builtin_bit_cast(float, __builtin_amdgcn_update_dpp(0, __builtin_bit_cast(int, v), 0x140, 0xF, 0xF, false));
    v += __builtin_bit_cast(float, __builtin_amdgcn_update_dpp(0, __builtin_bit_cast(int, v), 0x142, 0xA, 0xF, false));
    v += __builtin_bit_cast(float, __builtin_amdgcn_update_dpp(0, __builtin_bit_cast(int, v), 0x143, 0xC, 0xF, false));
    return __builtin_bit_cast(float, __builtin_amdgcn_readlane(__builtin_bit_cast(int, v), 63));
}
DI float sigmoid_f(float x) { return 1.0f / (1.0f + __expf(-x)); }

struct Args {
    const float *x, *gdn_w_in, *gdn_conv_w, *gdn_a_log, *gdn_dt_bias, *gdn_norm_w, *gdn_w_out, *sb_w_in, *sb_w_out, *ffn_w_gate, *ffn_w_up, *ffn_w_down,
                *moe_router, *moe_w_gate, *moe_w_up, *moe_w_down, *ln_g, *ln_b;
    float* out; unsigned char* ws; int ph_lo, ph_hi;
};

DI void transpose_item(const float* W, int ldw, bf16* WT, int K, int drow0, int k0, int n0, LAS float* scr, int lane) {
#pragma unroll 8
    for (int i = 0; i < 32; ++i) { const int kk = 2 * i + (lane >> 5); scr[kk * 33 + (lane & 31)] = W[(size_t)(k0 + kk) * ldw + n0 + (lane & 31)]; }
    LDS_WAIT(); asm volatile("" ::: "memory");
    const int c = lane & 7;
#pragma unroll
    for (int jj = 0; jj < 4; ++jj) { const int n = (lane >> 3) + 8 * jj; const LAS float* s = scr + (8 * c) * 33 + n;
        v4u o; o.x = pk2(s[0 * 33], s[1 * 33]); o.y = pk2(s[2 * 33], s[3 * 33]); o.z = pk2(s[4 * 33], s[5 * 33]); o.w = pk2(s[6 * 33], s[7 * 33]);
        *(v4u*)(WT + (size_t)(drow0 + n) * K + k0 + 8 * c) = o; }
    LDS_WAIT(); asm volatile("" ::: "memory");
}

DI void transpose_item64(const float* W, int ldw, bf16* WT, int K, int drow0, int k0, int n0, LAS unsigned char* scr, int lane) {
    const int q = lane >> 4, cx = lane & 15;
    f32x4 r[16];
#pragma unroll
    for (int i = 0; i < 16; ++i) r[i] = *(const f32x4*)(W + (size_t)(k0 + 16 * q + i) * ldw + n0 + 4 * cx);
#pragma unroll
    for (int e = 0; e < 4; ++e) {
        v4u w0, w1;
        w0.x = pk2(r[0][e], r[1][e]); w0.y = pk2(r[2][e], r[3][e]); w0.z = pk2(r[4][e], r[5][e]); w0.w = pk2(r[6][e], r[7][e]);
        w1.x = pk2(r[8][e], r[9][e]); w1.y = pk2(r[10][e], r[11][e]); w1.z = pk2(r[12][e], r[13][e]); w1.w = pk2(r[14][e], r[15][e]);
        *(LAS v4u*)(scr + (4 * cx + e) * 144 + q * 32) = w0; *(LAS v4u*)(scr + (4 * cx + e) * 144 + q * 32 + 16) = w1;
    }
    LDS_WAIT(); asm volatile("" ::: "memory");
#pragma unroll
    for (int j = 0; j < 8; ++j) { const int id = lane + 64 * j, n = id >> 3, kp = id & 7;
        *(v4u*)(WT + (size_t)(drow0 + n) * K + k0 + 8 * kp) = *(const LAS v4u*)(scr + n * 144 + kp * 16); }
    LDS_WAIT(); asm volatile("" ::: "memory");
}

DI void phase_w_gdn(const Args& a, int j, LAS unsigned char* lds, int bid, int G, int tid, int wave, int lane) {
    LAS float* scr = (LAS float*)(lds + wave * 16384);
    const int gw = bid * NWAVES + wave, NGW = G * NWAVES;
    const float* Win = a.gdn_w_in + (size_t)j * D * GIN; const float* Wout = a.gdn_w_out + (size_t)j * 2048 * D;
    const float* Wg = a.ffn_w_gate + (size_t)j * D * FF; const float* Wu = a.ffn_w_up + (size_t)j * D * FF; const float* Wd = a.ffn_w_down + (size_t)j * FF * D;
    bf16* WIN_T = (bf16*)(a.ws + W_IN); bf16* WOUT_T = (bf16*)(a.ws + W_OUT); bf16* WGU_T = (bf16*)(a.ws + W_GU); bf16* WD_T = (bf16*)(a.ws + W_D);
    LAS unsigned char* scb = (LAS unsigned char*)scr;
    constexpr int I_IN = 16 * 96, I_INT = 16, I_OUT = 32 * 16, I_G = 16 * 56, I_D = 56 * 16, NIT = I_IN + I_INT + I_OUT + 2 * I_G + I_D;
    for (int it = gw; it < NIT; it += NGW) {
        int r = it;
        if (r < I_IN) { const int kb = r / 96, nb = r % 96; transpose_item64(Win, GIN, WIN_T, D, 64 * nb, 64 * kb, 64 * nb, scb, lane); continue; } r -= I_IN;
        if (r < I_INT) { transpose_item(Win, GIN, WIN_T, D, 6144, 64 * r, 6144, scr, lane); continue; } r -= I_INT;
        if (r < I_OUT) { const int kb = r / 16, nb = r % 16; transpose_item64(Wout, D, WOUT_T, 2048, 64 * nb, 64 * kb, 64 * nb, scb, lane); continue; } r -= I_OUT;
        if (r < I_G) { const int kb = r / 56, nb = r % 56, n0 = 64 * nb; transpose_item64(Wg, FF, WGU_T, D, 256 * (n0 >> 7) + (n0 & 127), 64 * kb, n0, scb, lane); continue; } r -= I_G;
        if (r < I_G) { const int kb = r / 56, nb = r % 56, n0 = 64 * nb; transpose_item64(Wu, FF, WGU_T, D, 256 * (n0 >> 7) + 128 + (n0 & 127), 64 * kb, n0, scb, lane); continue; } r -= I_G;
        { const int kb = r / 16, nb = r % 16; transpose_item64(Wd, D, WD_T, FF, 64 * nb, 64 * kb, 64 * nb, scb, lane); }
    }
    if (j == 0) {
        bf16* HB = (bf16*)(a.ws + WS_HB); const f32x4* x4 = (const f32x4*)a.x;
        for (size_t i = (size_t)bid * 512 + tid; i < (size_t)TT * D / 8; i += (size_t)G * 512) { const f32x4 p = x4[2 * i], q = x4[2 * i + 1];
            v4u o; o.x = pk2(p[0], p[1]); o.y = pk2(p[2], p[3]); o.z = pk2(q[0], q[1]); o.w = pk2(q[2], q[3]); *(v4u*)(HB + 8 * i) = o; }
    }
}
DI void phase_w_sb(const Args& a, int j, LAS unsigned char* lds, int bid, int G, int wave, int lane) {
    LAS float* scr = (LAS float*)(lds + wave * 16384);
    const int gw = bid * NWAVES + wave, NGW = G * NWAVES;
    const float* Wqkv = a.sb_w_in + (size_t)j * D * 3072; const float* Wo = a.sb_w_out + (size_t)j * D * D;
    const float* Mg = a.moe_w_gate + (size_t)j * NE * D * FF; const float* Mu = a.moe_w_up + (size_t)j * NE * D * FF; const float* Md = a.moe_w_down + (size_t)j * NE * FF * D;
    bf16* WQKV_T = (bf16*)(a.ws + W_QKV); bf16* WO_T = (bf16*)(a.ws + W_O); bf16* MGU_T = (bf16*)(a.ws + W_MGU); bf16* MD_T = (bf16*)(a.ws + W_MD);
    LAS unsigned char* scb = (LAS unsigned char*)scr;
    constexpr int I_QKV = 16 * 48, I_O = 16 * 16, I_G = 16 * 56, I_D = 56 * 16, I_E = 2 * I_G + I_D, NIT = I_QKV + I_O + NE * I_E;
    for (int it = gw; it < NIT; it += NGW) {
        int r = it;
        if (r < I_QKV) { const int kb = r / 48, nb = r % 48; transpose_item64(Wqkv, 3072, WQKV_T, D, 64 * nb, 64 * kb, 64 * nb, scb, lane); continue; } r -= I_QKV;
        if (r < I_O) { const int kb = r / 16, nb = r % 16; transpose_item64(Wo, D, WO_T, D, 64 * nb, 64 * kb, 64 * nb, scb, lane); continue; } r -= I_O;
        const int e = r / I_E; r -= e * I_E;
        bf16* gu = MGU_T + (size_t)e * 2 * FF * D; bf16* dn = MD_T + (size_t)e * D * FF;
        if (r < I_G) { const int kb = r / 56, nb = r % 56, n0 = 64 * nb; transpose_item64(Mg + (size_t)e * D * FF, FF, gu, D, 256 * (n0 >> 7) + (n0 & 127), 64 * kb, n0, scb, lane); continue; } r -= I_G;
        if (r < I_G) { const int kb = r / 56, nb = r % 56, n0 = 64 * nb; transpose_item64(Mu + (size_t)e * D * FF, FF, gu, D, 256 * (n0 >> 7) + 128 + (n0 & 127), 64 * kb, n0, scb, lane); continue; } r -= I_G;
        { const int kb = r / 16, nb = r % 16; transpose_item64(Md + (size_t)e * FF * D, D, dn, FF, 64 * nb, 64 * kb, 64 * nb, scb, lane); }
    }
}

DI float dpp_sum16(float v) {
    v += __builtin_bit_cast(float, __builtin_amdgcn_update_dpp(0, __builtin_bit_cast(int, v), 0xB1, 0xF, 0xF, false));
    v += __builtin_bit_cast(float, __builtin_amdgcn_update_dpp(0, __builtin_bit_cast(int, v), 0x4E, 0xF, 0xF, false));
    v += __builtin_bit_cast(float, __builtin_amdgcn_update_dpp(0, __builtin_bit_cast(int, v), 0x141, 0xF, 0xF, false));
    v += __builtin_bit_cast(float, __builtin_amdgcn_update_dpp(0, __builtin_bit_cast(int, v), 0x140, 0xF, 0xF, false));
    return v;
}
DI void phase_conv(const Args& a, int j, int bid, int G, int tid) {
    const bf16* raw = (const bf16*)(a.ws + WS_RAW); bf16* qkvc = (bf16*)(a.ws + WS_QKVC); float* gb = (float*)(a.ws + WS_GB);
    const float* cw = a.gdn_conv_w + (size_t)j * 4 * 4096;
    const int ch = 8 * tid;
    float w0[8], w1[8], w2[8], w3[8];
#pragma unroll
    for (int i = 0; i < 8; ++i) { w0[i] = cw[ch + i]; w1[i] = cw[4096 + ch + i]; w2[i] = cw[2 * 4096 + ch + i]; w3[i] = cw[3 * 4096 + ch + i]; }
    const float post = tid < 128 ? 0.08838834764831845f : 1.0f;
    for (int run = bid; run < TT / 128; run += G) {
        const int t0 = run * 128; const bool first = (t0 & (SEQ - 1)) == 0;
        float xa[8], xb[8], xc[8];
        { v4u h0 = {0u, 0u, 0u, 0u}, h1 = h0, h2 = h0;
          if (!first) { h0 = *(const v4u*)(raw + (size_t)(t0 - 3) * RAWLD + ch); h1 = *(const v4u*)(raw + (size_t)(t0 - 2) * RAWLD + ch); h2 = *(const v4u*)(raw + (size_t)(t0 - 1) * RAWLD + ch); }
          xa[0] = bf_lo(h0.x); xa[1] = bf_hi(h0.x); xa[2] = bf_lo(h0.y); xa[3] = bf_hi(h0.y); xa[4] = bf_lo(h0.z); xa[5] = bf_hi(h0.z); xa[6] = bf_lo(h0.w); xa[7] = bf_hi(h0.w);
          xb[0] = bf_lo(h1.x); xb[1] = bf_hi(h1.x); xb[2] = bf_lo(h1.y); xb[3] = bf_hi(h1.y); xb[4] = bf_lo(h1.z); xb[5] = bf_hi(h1.z); xb[6] = bf_lo(h1.w); xb[7] = bf_hi(h1.w);
          xc[0] = bf_lo(h2.x); xc[1] = bf_hi(h2.x); xc[2] = bf_lo(h2.y); xc[3] = bf_hi(h2.y); xc[4] = bf_lo(h2.z); xc[5] = bf_hi(h2.z); xc[6] = bf_lo(h2.w); xc[7] = bf_hi(h2.w); }
#pragma unroll 1
        for (int tb = 0; tb < 128; tb += 8) {
            v4u xr[8];
#pragma unroll
            for (int u = 0; u < 8; ++u) xr[u] = *(const v4u*)(raw + (size_t)(t0 + tb + u) * RAWLD + ch);
#pragma unroll
            for (int u = 0; u < 8; ++u) {
                float xd[8]; xd[0] = bf_lo(xr[u].x); xd[1] = bf_hi(xr[u].x); xd[2] = bf_lo(xr[u].y); xd[3] = bf_hi(xr[u].y); xd[4] = bf_lo(xr[u].z); xd[5] = bf_hi(xr[u].z); xd[6] = bf_lo(xr[u].w); xd[7] = bf_hi(xr[u].w);
                float y[8]; float ss = 0.f;
#pragma unroll
                for (int i = 0; i < 8; ++i) { const float c = w0[i] * xa[i] + w1[i] * xb[i] + w2[i] * xc[i] + w3[i] * xd[i];
                    y[i] = c * __builtin_amdgcn_rcpf(1.0f + __builtin_amdgcn_exp2f(-1.4426950408889634f * c)); ss += y[i] * y[i];
                    xa[i] = xb[i]; xb[i] = xc[i]; xc[i] = xd[i]; }
                if (tid < 256) {
                    const float rn = post / sqrtf(dpp_sum16(ss) + RMS_EPS);
#pragma unroll
                    for (int i = 0; i < 8; ++i) y[i] *= rn;
                }
                v4u o; o.x = pk2(y[0], y[1]); o.y = pk2(y[2], y[3]); o.z = pk2(y[4], y[5]); o.w = pk2(y[6], y[7]);
                *(v4u*)(qkvc + (size_t)(t0 + tb + u) * 4096 + ch) = o;
            }
        }
#pragma unroll
        for (int k = 0; k < 4; ++k) { const int item = tid + 512 * k, tok = t0 + (item >> 4), hv = item & 15;
            const float bb = __uint_as_float((unsigned)raw[(size_t)tok * RAWLD + 4096 + hv] << 16), aa = __uint_as_float((unsigned)raw[(size_t)tok * RAWLD + 4112 + hv] << 16);
            const float xx = aa + a.gdn_dt_bias[j * 16 + hv];
            const float sp = xx > 20.f ? xx : log1pf(__expf(xx));
            gb[(size_t)tok * 32 + hv] = -__expf(a.gdn_a_log[j * 16 + hv]) * sp;
            gb[(size_t)tok * 32 + 16 + hv] = sigmoid_f(bb); }
    }
}

DI void phase_gdn_naive(const Args& a, int j, LAS unsigned char* lds, int bid, int tid) {
    if (bid >= BATCH * HV) return;
    const int b = bid / HV, hv = bid % HV, hk = hv / 2, jc = tid & 127, r = tid >> 7;
    const bf16* zb = (const bf16*)(a.ws + WS_ZB); bf16* qkvc = (bf16*)(a.ws + WS_QKVC); const float* gb = (const float*)(a.ws + WS_GB);
    LAS float* qs = (LAS float*)lds; LAS float* ks = qs + 2048; LAS float* vs = ks + 2048; LAS float* gs = vs + 2048; LAS float* bs = gs + 16;
    LAS f32x2* red = (LAS f32x2*)(lds + 32768); LAS float* redkq = (LAS float*)(lds + 32768 + 8192); LAS float* ob = (LAS float*)(lds + 49152);
    float S[32];
#pragma unroll
    for (int i = 0; i < 32; ++i) S[i] = 0.f;
    const int lrow = tid >> 5, lcol = (tid & 31) * 4;
    for (int blk = 0; blk < SEQ / 16; ++blk) {
        const size_t t0 = (size_t)b * SEQ + blk * 16;
        __syncthreads();
        { const bf16* rowp = qkvc + (t0 + lrow) * 4096;
          const v2u qv = *(const v2u*)(rowp + hk * 128 + lcol), kv = *(const v2u*)(rowp + 1024 + hk * 128 + lcol), vv = *(const v2u*)(rowp + 2048 + hv * 128 + lcol);
          *(LAS f32x4*)(qs + lrow * 128 + lcol) = (f32x4){bf_lo(qv.x), bf_hi(qv.x), bf_lo(qv.y), bf_hi(qv.y)};
          *(LAS f32x4*)(ks + lrow * 128 + lcol) = (f32x4){bf_lo(kv.x), bf_hi(kv.x), bf_lo(kv.y), bf_hi(kv.y)};
          *(LAS f32x4*)(vs + lrow * 128 + lcol) = (f32x4){bf_lo(vv.x), bf_hi(vv.x), bf_lo(vv.y), bf_hi(vv.y)};
          if (tid < 16) { gs[tid] = __expf(gb[(t0 + tid) * 32 + hv]); bs[tid] = gb[(t0 + tid) * 32 + 16 + hv]; } }
        __syncthreads();
#pragma unroll 1
        for (int tt = 0; tt < 16; ++tt) {
            float pk = 0.f, pq = 0.f, pkq = 0.f;
#pragma unroll
            for (int i4 = 0; i4 < 8; ++i4) { const f32x4 k4 = *(const LAS f32x4*)(ks + tt * 128 + 32 * r + 4 * i4), q4 = *(const LAS f32x4*)(qs + tt * 128 + 32 * r + 4 * i4);
#pragma unroll
                for (int c = 0; c < 4; ++c) { pk += k4[c] * S[4 * i4 + c]; pq += q4[c] * S[4 * i4 + c]; pkq += k4[c] * q4[c]; } }
            const int buf = tt & 1;
            red[(buf * 4 + r) * 128 + jc] = (f32x2){pk, pq}; if (jc == 0) redkq[buf * 4 + r] = pkq;
            __syncthreads();
            float kS = 0.f, qS = 0.f, kq = 0.f;
#pragma unroll
            for (int rr = 0; rr < 4; ++rr) { const f32x2 p = red[(buf * 4 + rr) * 128 + jc]; kS += p.x; qS += p.y; kq += redkq[buf * 4 + rr]; }
            const float eg = gs[tt], vn = bs[tt] * (vs[tt * 128 + jc] - eg * kS);
#pragma unroll
            for (int i4 = 0; i4 < 8; ++i4) { const f32x4 k4 = *(const LAS f32x4*)(ks + tt * 128 + 32 * r + 4 * i4);
#pragma unroll
                for (int c = 0; c < 4; ++c) S[4 * i4 + c] = eg * S[4 * i4 + c] + k4[c] * vn; }
            if (r == 0) ob[tt * 128 + jc] = eg * qS + kq * vn;
        }
        __syncthreads();
        {
            const f32x4 o4 = *(const LAS f32x4*)(ob + lrow * 128 + lcol);
            float ss = o4[0] * o4[0] + o4[1] * o4[1] + o4[2] * o4[2] + o4[3] * o4[3];
            ss += __shfl_xor(ss, 1); ss += __shfl_xor(ss, 2); ss += __shfl_xor(ss, 4); ss += __shfl_xor(ss, 8); ss += __shfl_xor(ss, 16);
            const float rinv = 1.0f / sqrtf(ss * (1.0f / 128.0f) + RMS_EPS);
            const v2u zv = *(const v2u*)(zb + (t0 + lrow) * 2048 + hv * 128 + lcol);
            const f32x4 nw = *(const f32x4*)(a.gdn_norm_w + j * 128 + lcol);
            const float z0 = bf_lo(zv.x), z1 = bf_hi(zv.x), z2 = bf_lo(zv.y), z3 = bf_hi(zv.y);
            v2u o; o.x = pk2(o4[0] * rinv * nw[0] * z0 * sigmoid_f(z0), o4[1] * rinv * nw[1] * z1 * sigmoid_f(z1));
            o.y = pk2(o4[2] * rinv * nw[2] * z2 * sigmoid_f(z2), o4[3] * rinv * nw[3] * z3 * sigmoid_f(z3));
            *(v2u*)(qkvc + (t0 + lrow) * 4096 + 2048 + hv * 128 + lcol) = o;
        }
    }
}

DI void unpack8(const v4u w, float (&x)[8]) { x[0] = bf_lo(w.x); x[1] = bf_hi(w.x); x[2] = bf_lo(w.y); x[3] = bf_hi(w.y); x[4] = bf_lo(w.z); x[5] = bf_hi(w.z); x[6] = bf_lo(w.w); x[7] = bf_hi(w.w); }
template <bool ROUTER>
DI void phase_ln(const Args& a, const bf16* Y, int lnidx, int j, LAS unsigned char* lds, int bid, int G, int tid, int wave, int lane) {
    bf16* HB = (bf16*)(a.ws + WS_HB); float* stats = (float*)(a.ws + WS_STATS);
    const float* g = a.ln_g + (size_t)lnidx * D; const float* bta = a.ln_b + (size_t)lnidx * D;
    const int gw = bid * NWAVES + wave, NGW = G * NWAVES;
    LAS unsigned* lcnt = (LAS unsigned*)lds;
    LAS float* RT = (LAS float*)(lds + 1024);
    if (ROUTER) { if (tid < 8) lcnt[tid] = 0u;
        const float* R = a.moe_router + (size_t)j * D * NE;
#pragma unroll
        for (int i = 0; i < 2; ++i) { const int k = tid + 512 * i; const f32x4 r0 = *(const f32x4*)(R + k * 8), r1 = *(const f32x4*)(R + k * 8 + 4);
            RT[0 * 1024 + k] = r0[0]; RT[1 * 1024 + k] = r0[1]; RT[2 * 1024 + k] = r0[2]; RT[3 * 1024 + k] = r0[3]; RT[4 * 1024 + k] = r1[0]; RT[5 * 1024 + k] = r1[1]; RT[6 * 1024 + k] = r1[2]; RT[7 * 1024 + k] = r1[3]; }
        __syncthreads(); }
    float gv[2][8], bv[2][8];
#pragma unroll
    for (int q = 0; q < 2; ++q)
#pragma unroll
        for (int c = 0; c < 8; ++c) { gv[q][c] = g[8 * (lane + 64 * q) + c]; bv[q][c] = bta[8 * (lane + 64 * q) + c]; }
    v4u nx[2];
    if (gw < TT) { nx[0] = ((const v4u*)(Y + (size_t)gw * D))[lane]; nx[1] = ((const v4u*)(Y + (size_t)gw * D))[lane + 64]; }
    for (int t = gw; t < TT; t += NGW) {
        float v[2][8]; float s = 0.f;
        unpack8(nx[0], v[0]); unpack8(nx[1], v[1]);
        if (t + NGW < TT) { nx[0] = ((const v4u*)(Y + (size_t)(t + NGW) * D))[lane]; nx[1] = ((const v4u*)(Y + (size_t)(t + NGW) * D))[lane + 64]; }
#pragma unroll
        for (int q = 0; q < 2; ++q)
#pragma unroll
            for (int c = 0; c < 8; ++c) s += v[q][c];
        const float mean = wave_sum(s) * (1.0f / D); float s2 = 0.f;
#pragma unroll
        for (int q = 0; q < 2; ++q)
#pragma unroll
            for (int c = 0; c < 8; ++c) { v[q][c] -= mean; s2 += v[q][c] * v[q][c]; }
        const float rstd = 1.0f / sqrtf(wave_sum(s2) * (1.0f / D) + LN_EPS);
        if (lane == 0) *(f32x2*)(stats + 2 * (size_t)t) = (f32x2){mean, rstd};
#pragma unroll
        for (int q = 0; q < 2; ++q) {
#pragma unroll
            for (int c = 0; c < 8; ++c) v[q][c] = v[q][c] * rstd * gv[q][c] + bv[q][c];
            v4u o; o.x = pk2(v[q][0], v[q][1]); o.y = pk2(v[q][2], v[q][3]); o.z = pk2(v[q][4], v[q][5]); o.w = pk2(v[q][6], v[q][7]);
            ((v4u*)(HB + (size_t)t * D))[lane + 64 * q] = o; }
        if (ROUTER) {
            float lg[8];
#pragma unroll
            for (int e = 0; e < 8; ++e) { lg[e] = 0.f;
#pragma unroll
                for (int q = 0; q < 2; ++q) { const f32x4 r0 = *(const LAS f32x4*)(RT + e * 1024 + 8 * (lane + 64 * q)), r1 = *(const LAS f32x4*)(RT + e * 1024 + 8 * (lane + 64 * q) + 4);
                    lg[e] += (v[q][0] * r0[0] + v[q][1] * r0[1]) + (v[q][2] * r0[2] + v[q][3] * r0[3]) + (v[q][4] * r1[0] + v[q][5] * r1[1]) + (v[q][6] * r1[2] + v[q][7] * r1[3]); } }
#pragma unroll
            for (int e = 0; e < 8; ++e) lg[e] = wave_sum(lg[e]);
            int i1 = 0; float v1 = lg[0];
#pragma unroll
            for (int e = 1; e < 8; ++e) if (lg[e] > v1) { v1 = lg[e]; i1 = e; }
            int i2 = -1; float v2 = -3.0e38f;
#pragma unroll
            for (int e = 0; e < 8; ++e) if (e != i1 && lg[e] > v2) { v2 = lg[e]; i2 = e; }
            if (lane == 0) {
                const float g1 = 1.0f / (1.0f + __expf(v2 - v1));
                ((unsigned*)(a.ws + WS_E12))[t] = (unsigned)i1 | ((unsigned)i2 << 8);
                ((f32x2*)(a.ws + WS_G12))[t] = (f32x2){g1, 1.0f - g1};
                __hip_atomic_fetch_add(lcnt + i1, 1u, __ATOMIC_RELAXED, __HIP_MEMORY_SCOPE_WORKGROUP); __hip_atomic_fetch_add(lcnt + i2, 1u, __ATOMIC_RELAXED, __HIP_MEMORY_SCOPE_WORKGROUP);
            }
        }
    }
    if (ROUTER) { __syncthreads(); if (tid < 8) { unsigned* cnt = (unsigned*)(a.ws + WS_CTL) + CW_CNT + 256 * j; __hip_atomic_fetch_add(cnt + tid, lcnt[tid], __ATOMIC_RELAXED, __HIP_MEMORY_SCOPE_AGENT); } }
}

DI void phase_sb_naive(const Args& a, LAS unsigned char* lds, int bid, int G, int tid) {
    const bf16* qkv = (const bf16*)(a.ws + WS_QKV); bf16* ao = (bf16*)(a.ws + WS_AO);
    LAS unsigned char* Ks = lds; LAS unsigned char* Vs = lds + 16384;
    const int qi = tid >> 2, r = tid & 3;
    for (int idx = bid; idx < 64 * 32; idx += G) {
        const int qb = 31 - idx / 64, bh = idx % 64, b = bh >> 3, h = bh & 7;
        const int t = qb * 128 + qi;
        const size_t rowq = (size_t)b * SEQ + t;
        float q[32], o[32];
        { const bf16* qp = qkv + rowq * 3072 + h * 128 + 32 * r;
#pragma unroll
          for (int c = 0; c < 4; ++c) { const v4u w = *(const v4u*)(qp + 8 * c);
              q[8 * c + 0] = bf_lo(w.x); q[8 * c + 1] = bf_hi(w.x); q[8 * c + 2] = bf_lo(w.y); q[8 * c + 3] = bf_hi(w.y);
              q[8 * c + 4] = bf_lo(w.z); q[8 * c + 5] = bf_hi(w.z); q[8 * c + 6] = bf_lo(w.w); q[8 * c + 7] = bf_hi(w.w); }
#pragma unroll
          for (int i = 0; i < 32; ++i) { q[i] *= 0.08838834764831845f; o[i] = 0.f; } }
        float P = 1.0f;
        for (int kt = 2 * qb + 1; kt >= 0; --kt) {
            __syncthreads();
#pragma unroll
            for (int i = 0; i < 2; ++i) { const int c = tid + 512 * i, row = c >> 4, part = c & 15;
                const bf16* src = qkv + ((size_t)b * SEQ + kt * 64 + row) * 3072 + h * 128 + part * 8;
                *(LAS v4u*)(Ks + c * 16) = *(const v4u*)(src + 1024); *(LAS v4u*)(Vs + c * 16) = *(const v4u*)(src + 2048); }
            __syncthreads();
#pragma unroll 1
            for (int s = 63; s >= 0; --s) {
                float z = 0.f;
#pragma unroll
                for (int c = 0; c < 4; ++c) { const v4u w = *(const LAS v4u*)(Ks + s * 256 + r * 64 + c * 16);
                    z += q[8 * c + 0] * bf_lo(w.x) + q[8 * c + 1] * bf_hi(w.x) + q[8 * c + 2] * bf_lo(w.y) + q[8 * c + 3] * bf_hi(w.y)
                       + q[8 * c + 4] * bf_lo(w.z) + q[8 * c + 5] * bf_hi(w.z) + q[8 * c + 6] * bf_lo(w.w) + q[8 * c + 7] * bf_hi(w.w); }
                z += __shfl_xor(z, 1); z += __shfl_xor(z, 2);
                const bool live = (kt * 64 + s) < t;
                const float e = __expf(fminf(z, 80.f)), rr = 1.0f / (1.0f + e);
                const float A = live ? e * rr * P : 0.f;
                P = live ? P * rr : P;
#pragma unroll
                for (int c = 0; c < 4; ++c) { const v4u w = *(const LAS v4u*)(Vs + s * 256 + r * 64 + c * 16);
                    o[8 * c + 0] += A * bf_lo(w.x); o[8 * c + 1] += A * bf_hi(w.x); o[8 * c + 2] += A * bf_lo(w.y); o[8 * c + 3] += A * bf_hi(w.y);
                    o[8 * c + 4] += A * bf_lo(w.z); o[8 * c + 5] += A * bf_hi(w.z); o[8 * c + 6] += A * bf_lo(w.w); o[8 * c + 7] += A * bf_hi(w.w); }
            }
        }
        { bf16* op = ao + rowq * 1024 + h * 128 + 32 * r;
#pragma unroll
          for (int c = 0; c < 4; ++c) { v4u w; w.x = pk2(o[8 * c + 0], o[8 * c + 1]); w.y = pk2(o[8 * c + 2], o[8 * c + 3]); w.z = pk2(o[8 * c + 4], o[8 * c + 5]); w.w = pk2(o[8 * c + 6], o[8 * c + 7]);
              *(v4u*)(op + 8 * c) = w; } }
    }
}


typedef float f2v_ __attribute__((ext_vector_type(2)));
typedef __bf16 b2v_ __attribute__((ext_vector_type(2)));
DI unsigned gdnpk(float a, float b) { const f2v_ v = {a, b}; const b2v_ r = __builtin_convertvector(v, b2v_); return __builtin_bit_cast(unsigned, r); }
namespace sba {
using bf16x8 = __attribute__((ext_vector_type(8))) short;
using s16x4  = __attribute__((ext_vector_type(4))) short;
using f32x16 = __attribute__((ext_vector_type(16))) float;
constexpr int SHM_V = 16384, KPITCH = 272, SHM_K = 64 * KPITCH, LDQ = 3072;
#define KSWZ(row, colB) ((row) * KPITCH + (colB))
#define SBAR() __builtin_amdgcn_sched_barrier(0)
DI int crow(int r, int hi) { return (r & 3) + 8 * (r >> 2) + 4 * hi; }
DI int v_st(int k, int c) { const int kk = (k & ~0xC) | ((k & 4) << 1) | ((k & 8) >> 1); return ((kk >> 3) * 4 + (c >> 5)) * 512 + ((kk & 7) * 32 + (c & 31)) * 2; }
DI int v_rd_base(int lane) { return ((lane & 3) << 3) | (((lane >> 2) & 3) << 6) | (((lane >> 4) & 1) << 5) | (((lane >> 5) & 1) << 8); }
constexpr int v_rd_off(int d0, int ks, int half) { return d0 * 512 + ks * 4096 + half * 2048; }
template <int OFF> DI s16x4 tr_read(int vb) { s16x4 r; asm volatile("ds_read_b64_tr_b16 %0, %1 offset:%2" : "=&v"(r) : "v"(vb), "i"(OFF) : "memory"); return r; }
template <int D0> DI void pv_one(f32x16& od, int vb, bf16x8 pa0, bf16x8 pa1, bf16x8 pa2, bf16x8 pa3) {
  const s16x4 l0 = tr_read<v_rd_off(D0, 0, 0)>(vb), h0 = tr_read<v_rd_off(D0, 0, 1)>(vb), l1 = tr_read<v_rd_off(D0, 1, 0)>(vb), h1 = tr_read<v_rd_off(D0, 1, 1)>(vb);
  const s16x4 l2 = tr_read<v_rd_off(D0, 2, 0)>(vb), h2 = tr_read<v_rd_off(D0, 2, 1)>(vb), l3 = tr_read<v_rd_off(D0, 3, 0)>(vb), h3 = tr_read<v_rd_off(D0, 3, 1)>(vb);
  asm volatile("s_waitcnt lgkmcnt(0)" ::: "memory"); SBAR();
#define PK(L, H) (bf16x8){L[0], L[1], L[2], L[3], H[0], H[1], H[2], H[3]}
  od = __builtin_amdgcn_mfma_f32_32x32x16_bf16(pa0, PK(l0, h0), od, 0, 0, 0);
  od = __builtin_amdgcn_mfma_f32_32x32x16_bf16(pa1, PK(l1, h1), od, 0, 0, 0);
  od = __builtin_amdgcn_mfma_f32_32x32x16_bf16(pa2, PK(l2, h2), od, 0, 0, 0);
  od = __builtin_amdgcn_mfma_f32_32x32x16_bf16(pa3, PK(l3, h3), od, 0, 0, 0);
#undef PK
}
template <int D0> DI void pv_one_T(f32x16& od, int vb, bf16x8 pa0, bf16x8 pa1, bf16x8 pa2, bf16x8 pa3) {
  const s16x4 l0 = tr_read<v_rd_off(D0, 0, 0)>(vb), h0 = tr_read<v_rd_off(D0, 0, 1)>(vb), l1 = tr_read<v_rd_off(D0, 1, 0)>(vb), h1 = tr_read<v_rd_off(D0, 1, 1)>(vb);
  const s16x4 l2 = tr_read<v_rd_off(D0, 2, 0)>(vb), h2 = tr_read<v_rd_off(D0, 2, 1)>(vb), l3 = tr_read<v_rd_off(D0, 3, 0)>(vb), h3 = tr_read<v_rd_off(D0, 3, 1)>(vb);
  asm volatile("s_waitcnt lgkmcnt(0)" ::: "memory"); SBAR();
#define PK(L, H) (bf16x8){L[0], L[1], L[2], L[3], H[0], H[1], H[2], H[3]}
  od = __builtin_amdgcn_mfma_f32_32x32x16_bf16(PK(l0, h0), pa0, od, 0, 0, 0);
  od = __builtin_amdgcn_mfma_f32_32x32x16_bf16(PK(l1, h1), pa1, od, 0, 0, 0);
  od = __builtin_amdgcn_mfma_f32_32x32x16_bf16(PK(l2, h2), pa2, od, 0, 0, 0);
  od = __builtin_amdgcn_mfma_f32_32x32x16_bf16(PK(l3, h3), pa3, od, 0, 0, 0);
#undef PK
}
DI void pv_split(f32x16& od, int vb, bf16x8 pa0, bf16x8 pa1, bf16x8 pa2, bf16x8 pa3) {
  const s16x4 l0 = tr_read<v_rd_off(0, 0, 0)>(vb), h0 = tr_read<v_rd_off(0, 0, 1)>(vb), l1 = tr_read<v_rd_off(0, 1, 0)>(vb), h1 = tr_read<v_rd_off(0, 1, 1)>(vb);
  const s16x4 l2 = tr_read<v_rd_off(0, 2, 0)>(vb), h2 = tr_read<v_rd_off(0, 2, 1)>(vb), l3 = tr_read<v_rd_off(0, 3, 0)>(vb), h3 = tr_read<v_rd_off(0, 3, 1)>(vb);
  asm volatile("s_waitcnt lgkmcnt(0)" ::: "memory"); SBAR();
#define PK(L, H) (bf16x8){L[0], L[1], L[2], L[3], H[0], H[1], H[2], H[3]}
  f32x16 ob = {};
  od = __builtin_amdgcn_mfma_f32_32x32x16_bf16(pa0, PK(l0, h0), od, 0, 0, 0); ob = __builtin_amdgcn_mfma_f32_32x32x16_bf16(pa2, PK(l2, h2), ob, 0, 0, 0);
  od = __builtin_amdgcn_mfma_f32_32x32x16_bf16(pa1, PK(l1, h1), od, 0, 0, 0); ob = __builtin_amdgcn_mfma_f32_32x32x16_bf16(pa3, PK(l3, h3), ob, 0, 0, 0);
  od = od + ob;
#undef PK
}
DI void pv_split_T(f32x16& od, int vb, bf16x8 pa0, bf16x8 pa1, bf16x8 pa2, bf16x8 pa3) {
  const s16x4 l0 = tr_read<v_rd_off(0, 0, 0)>(vb), h0 = tr_read<v_rd_off(0, 0, 1)>(vb), l1 = tr_read<v_rd_off(0, 1, 0)>(vb), h1 = tr_read<v_rd_off(0, 1, 1)>(vb);
  const s16x4 l2 = tr_read<v_rd_off(0, 2, 0)>(vb), h2 = tr_read<v_rd_off(0, 2, 1)>(vb), l3 = tr_read<v_rd_off(0, 3, 0)>(vb), h3 = tr_read<v_rd_off(0, 3, 1)>(vb);
  asm volatile("s_waitcnt lgkmcnt(0)" ::: "memory"); SBAR();
#define PK(L, H) (bf16x8){L[0], L[1], L[2], L[3], H[0], H[1], H[2], H[3]}
  f32x16 ob = {};
  od = __builtin_amdgcn_mfma_f32_32x32x16_bf16(PK(l0, h0), pa0, od, 0, 0, 0); ob = __builtin_amdgcn_mfma_f32_32x32x16_bf16(PK(l2, h2), pa2, ob, 0, 0, 0);
  od = __builtin_amdgcn_mfma_f32_32x32x16_bf16(PK(l1, h1), pa1, od, 0, 0, 0); ob = __builtin_amdgcn_mfma_f32_32x32x16_bf16(PK(l3, h3), pa3, ob, 0, 0, 0);
  od = od + ob;
#undef PK
}
DI void qkt(f32x16& p0, f32x16& p1, const LAS unsigned char* Ks, const bf16x8 (&qr)[8], int r32, int hi) {
  p0 = f32x16{}; p1 = f32x16{};
#pragma unroll
  for (int d0 = 0; d0 < 8; ++d0) { const int cb = (d0 * 16 + hi * 8) * 2;
    const bf16x8 b0 = *(const LAS bf16x8*)(Ks + KSWZ(r32, cb));
    const bf16x8 b1 = *(const LAS bf16x8*)(Ks + KSWZ(32 + r32, cb));
    p0 = __builtin_amdgcn_mfma_f32_32x32x16_bf16(b0, qr[d0], p0, 0, 0, 0);
    p1 = __builtin_amdgcn_mfma_f32_32x32x16_bf16(b1, qr[d0], p1, 0, 0, 0); }
}
template <bool MASK> DI void sb_half(f32x16& p, float& Pc, int hi, int kbase, int trow) {
  float kk[16];
#pragma unroll
  for (int r = 0; r < 16; ++r) {
    float z = p[r];
    if (MASK) z = (kbase + crow(r, hi) < trow) ? z : -__builtin_inff();
    kk[r] = __builtin_amdgcn_rcpf(1.0f + __builtin_amdgcn_exp2f(z));
  }
  float R0[4], R1[4];
#pragma unroll
  for (int g = 0; g < 4; ++g) {
    const float c2 = kk[4 * g + 3], c1 = c2 * kk[4 * g + 2], c0 = c1 * kk[4 * g + 1], R = c0 * kk[4 * g];
    p[4 * g + 3] = 1.0f - c2; p[4 * g + 2] = c2 - c1; p[4 * g + 1] = c1 - c0; p[4 * g] = c0 - R;
    const auto sw = __builtin_amdgcn_permlane32_swap(__float_as_uint(R), __float_as_uint(R), false, false);
    R0[g] = __uint_as_float(sw[0]); R1[g] = __uint_as_float(sw[1]);
  }
#pragma unroll
  for (int g = 3; g >= 0; --g) {
    const float Pin = hi ? Pc : Pc * R1[g];
    p[4 * g + 3] *= Pin; p[4 * g + 2] *= Pin; p[4 * g + 1] *= Pin; p[4 * g] *= Pin;
    Pc *= R0[g] * R1[g];
  }
}
DI unsigned cvtpk(float lo, float hi) { unsigned r; asm volatile("v_cvt_pk_bf16_f32 %0, %1, %2" : "=v"(r) : "v"(lo), "v"(hi)); return r; }
#define PK4(P, BASE, OUT) do { const unsigned a0 = cvtpk(P[BASE + 0], P[BASE + 1]), a1 = cvtpk(P[BASE + 2], P[BASE + 3]);   \
    const unsigned b0 = cvtpk(P[BASE + 4], P[BASE + 5]), b1 = cvtpk(P[BASE + 6], P[BASE + 7]);                              \
    const auto r0 = __builtin_amdgcn_permlane32_swap(a0, b0, false, false); const auto r1 = __builtin_amdgcn_permlane32_swap(a1, b1, false, false); \
    const v4u w = {r0[0], r1[0], r0[1], r1[1]}; OUT = __builtin_bit_cast(bf16x8, w); } while (0)

DI void unit(const bf16* qkv, bf16* ao, int b, int h, int qb, LAS unsigned char* lds, int tid) {
  const int wid = __builtin_amdgcn_readfirstlane(tid >> 6), lane = tid & 63, r32 = lane & 31, hi = lane >> 5;
  const bool late = wid >= 4;
  LAS unsigned char* V_lds = lds; LAS unsigned char* K_lds = lds + 3 * SHM_V;
  const size_t rowbase = (size_t)b * SEQ; const int q0 = qb * 256, t_lo = q0 + wid * 32, trow = t_lo + r32;
  bf16x8 qr[8];
  { const bf16* Qw = qkv + (rowbase + trow) * LDQ + h * 128 + hi * 8; constexpr float C = 0.08838834764831845f * 1.4426950408889634f;
#pragma unroll
    for (int d0 = 0; d0 < 8; ++d0) { const v4u w = *(const v4u*)(Qw + d0 * 16); v4u o;
      o.x = gdnpk(bf_lo(w.x) * C, bf_hi(w.x) * C); o.y = gdnpk(bf_lo(w.y) * C, bf_hi(w.y) * C); o.z = gdnpk(bf_lo(w.z) * C, bf_hi(w.z) * C); o.w = gdnpk(bf_lo(w.w) * C, bf_hi(w.w) * C);
      qr[d0] = __builtin_bit_cast(bf16x8, o); } }
  const bf16* Kh = qkv + rowbase * LDQ + 1024 + h * 128; const bf16* Vh = Kh + 1024;
  const int sr = tid >> 4, sc = (tid & 15) * 8, vst0 = v_st(sr, sc), vst1 = v_st(32 + sr, sc);
  const int vb0 = (int)(unsigned)(size_t)V_lds + v_rd_base(lane);
  bf16x8 vs0, vs1, ks0, ks1;
  const unsigned soff = (unsigned)(sr * LDQ + sc) * 2u;
#define SLOAD(k0) do { const char* kb_ = (const char*)(Kh + (size_t)(k0) * LDQ); const char* vb_ = (const char*)(Vh + (size_t)(k0) * LDQ); \
    vs0 = *(const bf16x8*)(vb_ + soff); vs1 = *(const bf16x8*)(vb_ + (size_t)32 * LDQ * 2 + soff); ks0 = *(const bf16x8*)(kb_ + soff); ks1 = *(const bf16x8*)(kb_ + (size_t)32 * LDQ * 2 + soff); } while (0)
#define SWRITE(bb) do { *(LAS bf16x8*)(V_lds + (bb) * SHM_V + vst0) = vs0; *(LAS bf16x8*)(V_lds + (bb) * SHM_V + vst1) = vs1; const int kc = sc * 2; \
    *(LAS bf16x8*)(K_lds + (bb) * SHM_K + KSWZ(sr, kc)) = ks0; *(LAS bf16x8*)(K_lds + (bb) * SHM_K + KSWZ(32 + sr, kc)) = ks1; } while (0)
  f32x16 o[4] = {}; float Pc = 1.0f;
  f32x16 p0 = {}, p1 = {};
  const int NT = qb * 4 + 4;
  SLOAD((NT - 1) * 64);
  int bufc = 0, bufp = 0;
  for (int wi = 0; wi <= NT; ++wi) {
    const int kt = NT - 1 - wi, k0 = kt * 64;
    SEC_IN(4);
    if (wi < NT) { asm volatile("s_waitcnt vmcnt(0)" ::: "memory"); SWRITE(bufc); if (kt > 0) SLOAD(k0 - 64); }
    __syncthreads();
    SEC_OUT(4); SEC_IN(5);
    if (!late && wi < NT && k0 < t_lo + 31) { __builtin_amdgcn_s_setprio(1); qkt(p0, p1, K_lds + bufc * SHM_K, qr, r32, hi); __builtin_amdgcn_s_setprio(0); }
    { const int ka = late ? k0 + 64 : k0;
      const bool doit = late ? (wi > 0 && ka < t_lo + 31) : (wi < NT && k0 < t_lo + 31);
      if (doit) {
        bf16x8 pa0, pa1, pa2, pa3;
        if (ka + 63 >= t_lo) { sb_half<true>(p1, Pc, hi, ka + 32, trow); PK4(p1, 0, pa2); PK4(p1, 8, pa3); SBAR(); sb_half<true>(p0, Pc, hi, ka, trow); }
        else { sb_half<false>(p1, Pc, hi, ka + 32, trow); PK4(p1, 0, pa2); PK4(p1, 8, pa3); SBAR(); sb_half<false>(p0, Pc, hi, ka, trow); }
        PK4(p0, 0, pa0); PK4(p0, 8, pa1);
        const int vb = vb0 + (late ? bufp : bufc) * SHM_V;
        __builtin_amdgcn_s_setprio(1);
        pv_one<0>(o[0], vb, pa0, pa1, pa2, pa3); pv_one<1>(o[1], vb, pa0, pa1, pa2, pa3); pv_one<2>(o[2], vb, pa0, pa1, pa2, pa3); pv_one<3>(o[3], vb, pa0, pa1, pa2, pa3);
        __builtin_amdgcn_s_setprio(0);
      } }
    if (late && wi < NT && k0 < t_lo + 31) { __builtin_amdgcn_s_setprio(1); qkt(p0, p1, K_lds + bufc * SHM_K, qr, r32, hi); __builtin_amdgcn_s_setprio(0); }
    SEC_OUT(5);
    bufp = bufc; bufc = (bufc == 2) ? 0 : bufc + 1;
  }
  { bf16* Ob = ao + ((size_t)b * SEQ + qb * 256 + wid * 32) * 1024 + h * 128; const unsigned ooff = (unsigned)(4 * hi * 1024 + r32);
#pragma unroll
    for (int r = 0; r < 16; ++r)
#pragma unroll
      for (int d0 = 0; d0 < 4; ++d0) Ob[ooff + (unsigned)(((r & 3) + 8 * (r >> 2)) * 1024 + d0 * 32)] = (bf16)(cvtpk(o[d0][r], 0.f) & 0xffffu); }
#undef SLOAD
#undef SWRITE
}
#undef PK4
#undef KSWZ
#undef SBAR
}
DI void phase_sb_mfma(const Args& a, LAS unsigned char* lds, int bid, int G, int tid) {
    const bf16* qkv = (const bf16*)(a.ws + WS_QKV); bf16* ao = (bf16*)(a.ws + WS_AO);
    const int vcu = (G % 8 == 0) ? (bid % 8) * (G / 8) + bid / 8 : bid;
    for (int pi = vcu; pi < 512; pi += G) {
        const int bh = pi >> 3, p = pi & 7, b = bh >> 3, h = bh & 7;
        sba::unit(qkv, ao, b, h, 15 - p, lds, tid);
        sba::unit(qkv, ao, b, h, p, lds, tid);
    }
}


namespace gdn {
using bf16x8 = __attribute__((ext_vector_type(8))) short;
using s16x4  = __attribute__((ext_vector_type(4))) short;
using f32x16 = __attribute__((ext_vector_type(16))) float;
typedef float f2v __attribute__((ext_vector_type(2)));
typedef __bf16 b2v __attribute__((ext_vector_type(2)));
DI unsigned pk(float a, float b) { const f2v v = {a, b}; const b2v r = __builtin_convertvector(v, b2v); return __builtin_bit_cast(unsigned, r); }
DI int crow(int r, int hi) { return (r & 3) + 8 * (r >> 2) + 4 * hi; }
DI int pi_slot(int x) { return 8 * ((x >> 2) & 3) + 4 * ((x >> 4) & 1) + (x & 3); }
DI bf16x8 pack_step(const f32x16& x, int s) {
    v4u w; w.x = pk(x[8 * s + 0], x[8 * s + 1]); w.y = pk(x[8 * s + 2], x[8 * s + 3]); w.z = pk(x[8 * s + 4], x[8 * s + 5]); w.w = pk(x[8 * s + 6], x[8 * s + 7]);
    return __builtin_bit_cast(bf16x8, w);
}
DI f32x16 mm(const f32x16& P, const f32x16& Q, f32x16 acc) {
    acc = __builtin_amdgcn_mfma_f32_32x32x16_bf16(pack_step(P, 0), pack_step(Q, 0), acc, 0, 0, 0);
    acc = __builtin_amdgcn_mfma_f32_32x32x16_bf16(pack_step(P, 1), pack_step(Q, 1), acc, 0, 0, 0);
    return acc;
}
#define GPK4(P, BASE, OUT) do { const unsigned a0 = pk(P[BASE + 0], P[BASE + 1]), a1 = pk(P[BASE + 2], P[BASE + 3]);   \
    const unsigned b0 = pk(P[BASE + 4], P[BASE + 5]), b1 = pk(P[BASE + 6], P[BASE + 7]);                              \
    const auto r0 = __builtin_amdgcn_permlane32_swap(a0, b0, false, false); const auto r1 = __builtin_amdgcn_permlane32_swap(a1, b1, false, false); \
    const v4u w_ = {r0[0], r1[0], r0[1], r1[1]}; OUT = __builtin_bit_cast(bf16x8, w_); } while (0)

DI void local_unit(const Args& a, int unit, LAS unsigned char* img, LAS float* tab, int lane, bool dry) {
    const int r32 = lane & 31, hi = lane >> 5;
    const int chunk = unit & 63, bh = unit >> 6, hv = bh & 15, b = bh >> 4, hk = hv >> 1;
    const size_t t0 = (size_t)b * SEQ + chunk * 64;
    bf16* qkvc = (bf16*)(a.ws + WS_QKVC); const float* gb = (const float*)(a.ws + WS_GB);
    bf16* wmem = (bf16*)(a.ws + WS_WMEM) + (size_t)unit * 8192; bf16* imem = (bf16*)(a.ws + WS_IMEM) + (size_t)unit * 4096;
    bf16* ktmem = (bf16*)(a.ws + WS_KTMEM) + (size_t)((b * HK + hk) * 64 + chunk) * 8192; float* gtab = (float*)(a.ws + WS_GTAB) + (size_t)unit * 192;
    SEC_IN(1);
    float gc = gb[(t0 + lane) * 32 + hv]; const float be = gb[(t0 + lane) * 32 + 16 + hv];
#pragma unroll
    for (int off = 1; off < 64; off <<= 1) { const float y = __shfl_up(gc, off); if (lane >= off) gc += y; }
    const float glast = __shfl(gc, 63);
    tab[lane] = gc; tab[64 + lane] = be; tab[128 + lane] = -be * __expf(gc);
    gtab[lane] = __expf(gc); gtab[64 + lane] = __expf(glast - gc); if (lane == 0) gtab[128] = __expf(glast);
    const bf16* kbase = qkvc + t0 * 4096 + 1024 + hk * 128; const bf16* qbase = qkvc + t0 * 4096 + hk * 128; bf16* vbase = qkvc + t0 * 4096 + 2048 + hv * 128;
#define GSB() __builtin_amdgcn_sched_barrier(0)
    {
        f32x16 IT00 = {}, IT11 = {}, IT01 = {};
#pragma unroll
        for (int s = 0; s < 8; ++s) {
            const bf16x8 k0 = *(const bf16x8*)(kbase + (size_t)r32 * 4096 + 16 * s + 8 * hi), k1 = *(const bf16x8*)(kbase + (size_t)(32 + r32) * 4096 + 16 * s + 8 * hi);
            const bf16x8 q0 = *(const bf16x8*)(qbase + (size_t)r32 * 4096 + 16 * s + 8 * hi), q1 = *(const bf16x8*)(qbase + (size_t)(32 + r32) * 4096 + 16 * s + 8 * hi);
            IT00 = __builtin_amdgcn_mfma_f32_32x32x16_bf16(k0, q0, IT00, 0, 0, 0); IT11 = __builtin_amdgcn_mfma_f32_32x32x16_bf16(k1, q1, IT11, 0, 0, 0);
            IT01 = __builtin_amdgcn_mfma_f32_32x32x16_bf16(k0, q1, IT01, 0, 0, 0);
        }
#pragma unroll
        for (int I = 0; I < 2; ++I) { const int c = 32 * I + r32; const float gcc = tab[c];
#pragma unroll
            for (int J = 0; J < 2; ++J)
#pragma unroll
                for (int g = 0; g < 4; ++g) { float v[4];
#pragma unroll
                    for (int i = 0; i < 4; ++i) { const int r = 4 * g + i, cp = 32 * J + crow(r, hi);
                        const float raw = (I == 0) ? (J == 0 ? IT00[r] : 0.f) : (J == 0 ? IT01[r] : IT11[r]);
                        const float val = raw * __expf(-fabsf(gcc - tab[cp])); v[i] = (c >= cp) ? val : 0.f; }
                    v2u o; o.x = pk(v[0], v[1]); o.y = pk(v[2], v[3]);
                    *(v2u*)(imem + (unsigned)((((I * 2 + J) * 4 + g) * 64 + lane) * 4)) = o; } }
    }
    GSB();
    SEC_OUT(1); SEC_IN(2);
    f32x16 T1, T1T, T2T, T21T;
    {
        f32x16 KK = {};
#pragma unroll
        for (int s = 0; s < 8; ++s) { const bf16x8 k0 = *(const bf16x8*)(kbase + (size_t)r32 * 4096 + 16 * s + 8 * hi); KK = __builtin_amdgcn_mfma_f32_32x32x16_bf16(k0, k0, KK, 0, 0, 0); }
        f32x16 M, MT;
        { const float gb0 = tab[r32], bb0 = tab[64 + r32];
#pragma unroll
        for (int r = 0; r < 16; ++r) { const int a0 = crow(r, hi), b0 = r32; const float ke = -KK[r] * __expf(-fabsf(tab[a0] - gb0));
            const float nv = ke * tab[64 + a0], ntv = ke * bb0;
            const float n = (a0 > b0) ? nv : 0.f, nt = (b0 > a0) ? ntv : 0.f, id = (a0 == b0) ? 1.f : 0.f;
            M[r] = n; MT[r] = nt; T1[r] = id + n; T1T[r] = id + nt; } }
#pragma unroll
        for (int it = 0; it < 4; ++it) { const f32x16 z = {};
            const f32x16 Mn = mm(MT, M, z), MTn = mm(M, MT, z);
            const f32x16 Tn = mm(T1T, Mn, T1);
            T1T = mm(Mn, T1T, T1T);
            T1 = Tn; M = Mn; MT = MTn; }
    }
    GSB();
    {
        f32x16 KK = {};
#pragma unroll
        for (int s = 0; s < 8; ++s) { const bf16x8 k1 = *(const bf16x8*)(kbase + (size_t)(32 + r32) * 4096 + 16 * s + 8 * hi); KK = __builtin_amdgcn_mfma_f32_32x32x16_bf16(k1, k1, KK, 0, 0, 0); }
        f32x16 M, MT;
        { const float gb0 = tab[32 + r32], bb0 = tab[96 + r32];
#pragma unroll
        for (int r = 0; r < 16; ++r) { const int a0 = crow(r, hi), b0 = r32; const float ke = -KK[r] * __expf(-fabsf(tab[32 + a0] - gb0));
            const float nv = ke * tab[96 + a0], ntv = ke * bb0;
            const float n = (a0 > b0) ? nv : 0.f, nt = (b0 > a0) ? ntv : 0.f, id = (a0 == b0) ? 1.f : 0.f;
            M[r] = n; MT[r] = nt; T2T[r] = id + nt; } }
#pragma unroll
        for (int it = 0; it < 4; ++it) { const f32x16 z = {};
            const f32x16 Mn = mm(MT, M, z), MTn = mm(M, MT, z);
            T2T = mm(Mn, T2T, T2T);
            M = Mn; MT = MTn; }
    }
    GSB();
    {
        f32x16 L21 = {};
#pragma unroll
        for (int s = 0; s < 8; ++s) { const bf16x8 k0 = *(const bf16x8*)(kbase + (size_t)r32 * 4096 + 16 * s + 8 * hi), k1 = *(const bf16x8*)(kbase + (size_t)(32 + r32) * 4096 + 16 * s + 8 * hi);
            L21 = __builtin_amdgcn_mfma_f32_32x32x16_bf16(k1, k0, L21, 0, 0, 0); }
#pragma unroll
        for (int r = 0; r < 16; ++r) { const int a0 = crow(r, hi); L21[r] = L21[r] * tab[96 + a0] * __expf(tab[32 + a0] - tab[r32]); }
        const f32x16 z = {}; const f32x16 Y = mm(L21, T2T, z); T21T = mm(T1, Y, z);
#pragma unroll
        for (int r = 0; r < 16; ++r) T21T[r] = -T21T[r];
    }
    GSB();
    SEC_OUT(2); SEC_IN(3);
    const int vb = (int)(unsigned)(size_t)img + sba::v_rd_base(lane);
    bf16* ubl = dry ? (bf16*)(a.ws + WS_END) + (size_t)(unit & 63) * 64 * 4096 : vbase;
#pragma unroll 1
    for (int mode = 0; mode < 2; ++mode) {
        const bf16* src = mode == 0 ? (const bf16*)vbase : kbase;
#pragma unroll 4
        for (int it = 0; it < 16; ++it) { const int row = (lane >> 4) + 4 * it, col = (lane & 15) * 8;
            *(LAS v4u*)(img + sba::v_st(row, col)) = *(const v4u*)(src + (size_t)row * 4096 + col); }
        LAS float* sc = tab + (mode == 0 ? 64 : 128);
#pragma unroll 1
        for (int I = 0; I < 2; ++I) {
            bf16x8 pa0, pa1, pa2, pa3;
            { f32x16 X;
#pragma unroll
              for (int r = 0; r < 16; ++r) X[r] = (I ? T21T[r] : T1T[r]) * sc[crow(r, hi)];
              GPK4(X, 0, pa0); GPK4(X, 8, pa1);
              { const float on = I ? 1.0f : 0.0f;
#pragma unroll
              for (int r = 0; r < 16; ++r) X[r] = T2T[r] * (sc[32 + crow(r, hi)] * on); }
              GPK4(X, 0, pa2); GPK4(X, 8, pa3); }
#pragma unroll 1
            for (int d0 = 0; d0 < 4; ++d0) {
                f32x16 od = {};
                if (mode == 0) { sba::pv_split(od, vb + d0 * 512, pa0, pa1, pa2, pa3);
                    const unsigned e0 = (unsigned)(((I * 32 + 8 * d0 + (lane >> 5)) * 4096) + (lane & 31) * 4);
#pragma unroll
                    for (int g = 0; g < 4; ++g) { v2u w; w.x = pk(od[4 * g + 0], od[4 * g + 1]); w.y = pk(od[4 * g + 2], od[4 * g + 3]); *(v2u*)(ubl + e0 + (unsigned)(g * 8192)) = w; }
                } else { sba::pv_split_T(od, vb + d0 * 512, pa0, pa1, pa2, pa3);
                    bf16* wp = wmem + (unsigned)((((I * 4 + d0) * 4) * 64 + lane) * 4);
#pragma unroll
                    for (int g = 0; g < 4; ++g) { v2u w; w.x = pk(od[4 * g + 0], od[4 * g + 1]); w.y = pk(od[4 * g + 2], od[4 * g + 3]); *(v2u*)(wp + g * 256) = w; }
                }
                GSB();
            }
        }
        if (mode == 1) {
            const int Ik = hv & 1;
            v4u idw0, idw1;
            { const int d0_ = r32 - 8 * hi, d1_ = r32 - 16 - 8 * hi;
              idw0.x = (d0_ == 0 ? 0x3f80u : 0u) | (d0_ == 1 ? 0x3f800000u : 0u); idw0.y = (d0_ == 2 ? 0x3f80u : 0u) | (d0_ == 3 ? 0x3f800000u : 0u);
              idw0.z = (d0_ == 4 ? 0x3f80u : 0u) | (d0_ == 5 ? 0x3f800000u : 0u); idw0.w = (d0_ == 6 ? 0x3f80u : 0u) | (d0_ == 7 ? 0x3f800000u : 0u);
              idw1.x = (d1_ == 0 ? 0x3f80u : 0u) | (d1_ == 1 ? 0x3f800000u : 0u); idw1.y = (d1_ == 2 ? 0x3f80u : 0u) | (d1_ == 3 ? 0x3f800000u : 0u);
              idw1.z = (d1_ == 4 ? 0x3f80u : 0u) | (d1_ == 5 ? 0x3f800000u : 0u); idw1.w = (d1_ == 6 ? 0x3f80u : 0u) | (d1_ == 7 ? 0x3f800000u : 0u); }
            const bf16x8 id0 = __builtin_bit_cast(bf16x8, idw0), id1 = __builtin_bit_cast(bf16x8, idw1), zf = (bf16x8){};
            const bf16x8 pa0 = Ik ? zf : id0, pa1 = Ik ? zf : id1, pa2 = Ik ? id0 : zf, pa3 = Ik ? id1 : zf;
#pragma unroll 1
            for (int d0 = 0; d0 < 4; ++d0) {
                f32x16 od = {}; sba::pv_split(od, vb + d0 * 512, pa0, pa1, pa2, pa3);
                bf16* kp = ktmem + (unsigned)((((Ik * 4 + d0) * 4) * 64 + lane) * 4);
#pragma unroll
                for (int g = 0; g < 4; ++g) { v2u w; w.x = pk(od[4 * g + 0], od[4 * g + 1]); w.y = pk(od[4 * g + 2], od[4 * g + 3]); *(v2u*)(kp + g * 256) = w; }
                GSB();
            }
        }
    }
    SEC_OUT(3);
#undef GSB
}
#undef GPK4
}
DI void phase_gdn_local(const Args& a, LAS unsigned char* lds, int bid, int G, int wave, int lane, bool dry) {
    LAS unsigned char* img = lds + wave * 16384; LAS float* tab = (LAS float*)(lds + RING_BYTES + 4096 + wave * 1024);
    const int gw = bid * NWAVES + wave, NGW = G * NWAVES;
    for (int unit = gw; unit < BATCH * HV * 64; unit += NGW) gdn::local_unit(a, unit, img, tab, lane, dry);
}
namespace gdn {
constexpr int PW = 272, PI = 144;
constexpr int L_W = 0, L_Q = 64 * PW, L_I = 2 * 64 * PW, L_K = L_I + 64 * PI, L_G = L_K + 128 * PI, L_BUF = L_G + 768;
constexpr int L_PART = 2 * L_BUF;
static_assert(L_PART + 4096 <= RING_BYTES, "scan LDS map");
}
DI void phase_gdn_scan(const Args& a, int j, LAS unsigned char* lds, int bid, int tid, bool dry) {
    if (bid >= BATCH * HV) return;
    using gdn::bf16x8; using gdn::pk; using namespace gdn;
    typedef float f4v __attribute__((ext_vector_type(4)));
    const int wave = __builtin_amdgcn_readfirstlane(tid >> 6), lane = tid & 63, n = lane & 15, kq = lane >> 4;
    const int b = bid / HV, hv = bid % HV, hk = hv >> 1;
    bf16* qkvc = (bf16*)(a.ws + WS_QKVC); const bf16* zb = (const bf16*)(a.ws + WS_ZB);
    LAS float* part = (LAS float*)(lds + L_PART); LAS unsigned char* stg = lds + OGST_OFF;
    const int unit0 = (b * HV + hv) * 64, hku0 = (b * HK + hk) * 64; const size_t tb0 = (size_t)b * SEQ;
    if (wave >= 4) {
        const int st = tid - 256;
        v4u rw[4], rq[4], ri[2], rk[4], rz[4]; float rg = 0.f;
        unsigned ow[4], ok_[4], oi[2], oq[4], oz[4];
#pragma unroll
        for (int k = 0; k < 4; ++k) { const int c = st + 256 * k;
            { const int row = c & 63, p = c >> 6, pp = p & 3; ow[k] = (unsigned)((((((row >> 5) * 4 + (p >> 2)) * 4 + (pp >> 1)) * 64 + (pp & 1) * 32 + (row & 31)) * 4) * 2); }
            { const int dk = c & 127, p = c >> 7, pp = p & 3; ok_[k] = (unsigned)((((((p >> 2) * 4 + (dk >> 5)) * 4 + (pp >> 1)) * 64 + (pp & 1) * 32 + (dk & 31)) * 4) * 2); }
            oq[k] = (unsigned)(((c >> 4) * 4096 + (c & 15) * 8) * 2); oz[k] = (unsigned)(((c >> 4) * 2048 + (c & 15) * 8) * 2); }
#pragma unroll
        for (int k = 0; k < 2; ++k) { const int c = st + 256 * k; const int row = c & 63, p = c >> 6, pp = p & 3; oi[k] = (unsigned)((((((row >> 5) * 2 + (p >> 2)) * 4 + (pp >> 1)) * 64 + (pp & 1) * 32 + (row & 31)) * 4) * 2); }
#define SV_RUN2(dst, base, ob_) do { const v2u a_ = *(const v2u*)((const char*)(base) + (ob_)), b_ = *(const v2u*)((const char*)(base) + (ob_) + 1024); dst = (v4u){a_.x, a_.y, b_.x, b_.y}; } while (0)
#define SV_LOAD(ch) do { const int u_ = unit0 + (ch); const size_t t_ = tb0 + (size_t)(ch) * 64; \
        const bf16* wm_ = (const bf16*)(a.ws + WS_WMEM) + (size_t)u_ * 8192; const bf16* im_ = (const bf16*)(a.ws + WS_IMEM) + (size_t)u_ * 4096; \
        const bf16* kt_ = (const bf16*)(a.ws + WS_KTMEM) + (size_t)(hku0 + (ch)) * 8192; const bf16* qb_ = qkvc + t_ * 4096 + hk * 128; const bf16* zr_ = zb + t_ * 2048 + hv * 128; \
        _Pragma("unroll") for (int k = 0; k < 4; ++k) { SV_RUN2(rw[k], wm_, ow[k]); SV_RUN2(rk[k], kt_, ok_[k]); rq[k] = *(const v4u*)((const char*)qb_ + oq[k]); rz[k] = *(const v4u*)((const char*)zr_ + oz[k]); } \
        _Pragma("unroll") for (int k = 0; k < 2; ++k) { SV_RUN2(ri[k], im_, oi[k]); } \
        if (st < 192) rg = ((const float*)(a.ws + WS_GTAB))[(size_t)u_ * 192 + st]; } while (0)
#define SV_WRITE(bf) do { LAS unsigned char* B_ = lds + (bf) * L_BUF; \
        _Pragma("unroll") for (int k = 0; k < 4; ++k) { const int c = st + 256 * k; *(LAS v4u*)(B_ + L_W + (c & 63) * PW + (c >> 6) * 16) = rw[k]; \
            *(LAS v4u*)(B_ + L_Q + (c >> 4) * PW + (c & 15) * 16) = rq[k]; *(LAS v4u*)(B_ + L_K + (c & 127) * PI + (c >> 7) * 16) = rk[k]; } \
        _Pragma("unroll") for (int k = 0; k < 2; ++k) { const int c = st + 256 * k; *(LAS v4u*)(B_ + L_I + (c & 63) * PI + (c >> 6) * 16) = ri[k]; } \
        if (st < 192) *(LAS float*)(B_ + L_G + st * 4) = rg; } while (0)
        f32x4 nwa, nwb;
        { const float* nwp = a.gdn_norm_w + j * 128 + (st & 15) * 8; nwa = *(const f32x4*)nwp; nwb = *(const f32x4*)(nwp + 4); }
        volatile LAS unsigned* flag = (volatile LAS unsigned*)(lds + L_PART);
        SV_LOAD(0); SV_WRITE(0);
        v4u zc[4], zn[4];
#pragma unroll
        for (int k = 0; k < 4; ++k) zc[k] = rz[k];
        __syncthreads();
        SV_LOAD(1);
#pragma unroll 1
        for (int chunk = 0; chunk < 64; ++chunk) {
            if (chunk + 1 < 64) { SV_WRITE((chunk + 1) & 1);
#pragma unroll
                for (int k = 0; k < 4; ++k) zn[k] = rz[k]; }
            __syncthreads();
            v4u ov[4];
#pragma unroll
            for (int k = 0; k < 4; ++k) { const int c = st + 256 * k; ov[k] = *(const LAS v4u*)(stg + (c >> 4) * 256 + (c & 15) * 16); }
            asm volatile("s_waitcnt lgkmcnt(0)" ::: "memory");
            if (lane == 0) __hip_atomic_fetch_add((LAS unsigned*)(lds + L_PART), 1u, __ATOMIC_RELAXED, __HIP_MEMORY_SCOPE_WORKGROUP);
            if (chunk + 2 < 64) SV_LOAD(chunk + 2);
            __builtin_amdgcn_sched_barrier(0);
            bf16* ob = dry ? (bf16*)(a.ws + WS_END) + (size_t)bid * 64 * 128 : qkvc + (tb0 + (size_t)chunk * 64) * 4096 + 2048 + hv * 128; const int opitch = dry ? 128 : 4096;
#pragma unroll
            for (int k = 0; k < 4; ++k) {
                float o8[8]; o8[0] = bf_lo(ov[k].x); o8[1] = bf_hi(ov[k].x); o8[2] = bf_lo(ov[k].y); o8[3] = bf_hi(ov[k].y); o8[4] = bf_lo(ov[k].z); o8[5] = bf_hi(ov[k].z); o8[6] = bf_lo(ov[k].w); o8[7] = bf_hi(ov[k].w);
                float ss = 0.f;
#pragma unroll
                for (int e = 0; e < 8; ++e) ss += o8[e] * o8[e];
                const float rinv = __builtin_amdgcn_rsqf(dpp_sum16(ss) * (1.0f / 128.0f) + RMS_EPS);
                float z8[8]; z8[0] = bf_lo(zc[k].x); z8[1] = bf_hi(zc[k].x); z8[2] = bf_lo(zc[k].y); z8[3] = bf_hi(zc[k].y); z8[4] = bf_lo(zc[k].z); z8[5] = bf_hi(zc[k].z); z8[6] = bf_lo(zc[k].w); z8[7] = bf_hi(zc[k].w);
                float r8[8];
#pragma unroll
                for (int e = 0; e < 8; ++e) r8[e] = o8[e] * rinv * (e < 4 ? nwa[e] : nwb[e - 4]) * z8[e];
                v4u w; w.x = pk(r8[0], r8[1]); w.y = pk(r8[2], r8[3]); w.z = pk(r8[4], r8[5]); w.w = pk(r8[6], r8[7]);
                *(v4u*)((char*)ob + (dry ? (unsigned)((((st + 256 * k) >> 4) * 128 + ((st + 256 * k) & 15) * 8) * 2) : oq[k])) = w; }
#pragma unroll
            for (int k = 0; k < 4; ++k) zc[k] = zn[k];
        }
#undef SV_RUN2
#undef SV_LOAD
#undef SV_WRITE
        return;
    }
    f4v S[2][8];
#pragma unroll
    for (int g = 0; g < 2; ++g)
#pragma unroll
        for (int m = 0; m < 8; ++m) S[g][m] = (f4v){0.f, 0.f, 0.f, 0.f};
    v2u un[2][4];
#define CW_ULOAD(ch) do { const bf16* vb_ = qkvc + (tb0 + (size_t)(ch) * 64) * 4096 + 2048 + hv * 128; \
        _Pragma("unroll") for (int g = 0; g < 2; ++g) _Pragma("unroll") for (int mt = 0; mt < 4; ++mt) { \
            const int f = (((((mt >> 1) * 4 + wave) * 4 + 2 * (mt & 1) + (kq >> 1)) * 64) + (kq & 1) * 32 + 16 * g + n) * 4;     \
            un[g][mt] = *(const v2u*)(vb_ + (size_t)(f >> 7) * 4096 + (f & 127)); } } while (0)
    CW_ULOAD(0);
    if (tid == 0) *(volatile LAS unsigned*)(lds + L_PART) = 0u;
    __syncthreads();
#pragma unroll 1
    for (int chunk = 0; chunk < 64; ++chunk) {
        GSEC_ACC(8, -);
        const LAS unsigned char* B = lds + (chunk & 1) * L_BUF; const LAS float* gt = (const LAS float*)(B + L_G);
        f4v av[2][4], ao[2][4];
#pragma unroll
        for (int g = 0; g < 2; ++g)
#pragma unroll
            for (int mt = 0; mt < 4; ++mt) { const v2u u0 = un[g][mt]; av[g][mt] = (f4v){bf_lo(u0.x), bf_hi(u0.x), bf_lo(u0.y), bf_hi(u0.y)}; }
        if (chunk + 1 < 64) CW_ULOAD(chunk + 1);
        bf16x8 Sb[2][4];
#pragma unroll
        for (int g = 0; g < 2; ++g)
#pragma unroll
            for (int p = 0; p < 4; ++p) { v4u w; w.x = pk(S[g][2 * p][0], S[g][2 * p][1]); w.y = pk(S[g][2 * p][2], S[g][2 * p][3]); w.z = pk(S[g][2 * p + 1][0], S[g][2 * p + 1][1]); w.w = pk(S[g][2 * p + 1][2], S[g][2 * p + 1][3]);
                Sb[g][p] = __builtin_bit_cast(bf16x8, w); }
#pragma unroll
        for (int mt = 0; mt < 4; ++mt) { ao[0][mt] = (f4v){0.f, 0.f, 0.f, 0.f}; ao[1][mt] = (f4v){0.f, 0.f, 0.f, 0.f};
#pragma unroll
            for (int p = 0; p < 4; ++p) {
                const bf16x8 aw = *(const LAS bf16x8*)(B + L_W + (16 * mt + n) * PW + 64 * p + 16 * kq);
                const v2u q0 = *(const LAS v2u*)(B + L_Q + (16 * mt + n) * PW + 64 * p + 8 * kq), q1 = *(const LAS v2u*)(B + L_Q + (16 * mt + n) * PW + 64 * p + 32 + 8 * kq);
                const v4u qq = {q0.x, q0.y, q1.x, q1.y}; const bf16x8 aq = __builtin_bit_cast(bf16x8, qq);
                av[0][mt] = __builtin_amdgcn_mfma_f32_16x16x32_bf16(aw, Sb[0][p], av[0][mt], 0, 0, 0); av[1][mt] = __builtin_amdgcn_mfma_f32_16x16x32_bf16(aw, Sb[1][p], av[1][mt], 0, 0, 0);
                ao[0][mt] = __builtin_amdgcn_mfma_f32_16x16x32_bf16(aq, Sb[0][p], ao[0][mt], 0, 0, 0); ao[1][mt] = __builtin_amdgcn_mfma_f32_16x16x32_bf16(aq, Sb[1][p], ao[1][mt], 0, 0, 0); } }
        bf16x8 vbf[2][2], vbd[2][2];
#pragma unroll
        for (int pp = 0; pp < 2; ++pp) {
            const f4v d0 = *(const LAS f4v*)(gt + 64 + 32 * pp + 4 * kq), d1 = *(const LAS f4v*)(gt + 64 + 32 * pp + 16 + 4 * kq);
#pragma unroll
            for (int g = 0; g < 2; ++g) { const f4v x0 = av[g][2 * pp], x1 = av[g][2 * pp + 1];
                v4u w; w.x = pk(x0[0], x0[1]); w.y = pk(x0[2], x0[3]); w.z = pk(x1[0], x1[1]); w.w = pk(x1[2], x1[3]); vbf[g][pp] = __builtin_bit_cast(bf16x8, w);
                v4u y; y.x = pk(x0[0] * d0[0], x0[1] * d0[1]); y.y = pk(x0[2] * d0[2], x0[3] * d0[3]); y.z = pk(x1[0] * d1[0], x1[1] * d1[1]); y.w = pk(x1[2] * d1[2], x1[3] * d1[3]); vbd[g][pp] = __builtin_bit_cast(bf16x8, y); }
        }
#pragma unroll
        for (int mt = 0; mt < 4; ++mt) { const f4v eg = *(const LAS f4v*)(gt + 16 * mt + 4 * kq); ao[0][mt] = ao[0][mt] * eg; ao[1][mt] = ao[1][mt] * eg;
#pragma unroll
            for (int pp = 0; pp < 2; ++pp) { const bf16x8 ai = *(const LAS bf16x8*)(B + L_I + (16 * mt + n) * PI + 64 * pp + 16 * kq);
                ao[0][mt] = __builtin_amdgcn_mfma_f32_16x16x32_bf16(ai, vbf[0][pp], ao[0][mt], 0, 0, 0); ao[1][mt] = __builtin_amdgcn_mfma_f32_16x16x32_bf16(ai, vbf[1][pp], ao[1][mt], 0, 0, 0); } }
        { const float egl = gt[128];
#pragma unroll
          for (int m8 = 0; m8 < 8; ++m8) { S[0][m8] = S[0][m8] * egl; S[1][m8] = S[1][m8] * egl;
#pragma unroll
              for (int pp = 0; pp < 2; ++pp) { const bf16x8 ak = *(const LAS bf16x8*)(B + L_K + (16 * m8 + n) * PI + 64 * pp + 16 * kq);
                  S[0][m8] = __builtin_amdgcn_mfma_f32_16x16x32_bf16(ak, vbd[0][pp], S[0][m8], 0, 0, 0); S[1][m8] = __builtin_amdgcn_mfma_f32_16x16x32_bf16(ak, vbd[1][pp], S[1][m8], 0, 0, 0); } } }
        GSEC_ACC(8, +); GSEC_ACC(9, -);
        { unsigned spins = 0; while (*(volatile LAS unsigned*)(lds + L_PART) < 4u * (unsigned)chunk) { __builtin_amdgcn_s_sleep(1); if (++spins > (1u << 22)) break; } }
#pragma unroll
        for (int g = 0; g < 2; ++g)
#pragma unroll
            for (int mt = 0; mt < 4; ++mt)
#pragma unroll
                for (int i = 0; i < 4; ++i) *(LAS bf16*)(stg + (16 * mt + 4 * kq + i) * 256 + (32 * wave + 16 * g + n) * 2) = (bf16)(pk(ao[g][mt][i], 0.f) & 0xffffu);
        __syncthreads();
        GSEC_ACC(9, +);
    }
#undef CW_ULOAD
}

DI void moe_offsets(const Args& a, int j, unsigned (&off)[9]) {
    unsigned* cnt = (unsigned*)(a.ws + WS_CTL) + CW_CNT + 256 * j; unsigned acc = 0u;
#pragma unroll
    for (int e = 0; e < 8; ++e) { off[e] = acc; const unsigned c = __hip_atomic_load(cnt + e, __ATOMIC_RELAXED, __HIP_MEMORY_SCOPE_AGENT); acc += (c + 255u) & ~255u; }
    off[8] = acc;
}
DI void phase_scatter(const Args& a, int j, LAS unsigned char* lds, int bid, int G, int tid, int wave, int lane) {
    LAS unsigned* lc = (LAS unsigned*)lds; LAS unsigned* lb = lc + 8; LAS unsigned* loff = lc + 16; LAS int* lpos = (LAS int*)(lc + 32);
    const unsigned* E12 = (const unsigned*)(a.ws + WS_E12); int* POS = (int*)(a.ws + WS_POS);
    const bf16* HB = (const bf16*)(a.ws + WS_HB); bf16* XS = (bf16*)(a.ws + WS_XS);
    unsigned* fill = (unsigned*)(a.ws + WS_CTL) + CW_CNT + 256 * j + 64;
    unsigned off[9]; moe_offsets(a, j, off);
    if (tid == 0) {
#pragma unroll
        for (int e = 0; e < 8; ++e) loff[e] = off[e]; }
    for (int ci = bid; ci < TT / 128; ci += G) {
        __syncthreads();
        if (tid < 8) lc[tid] = 0u;
        __syncthreads();
        unsigned e1 = 0, e2 = 0, r1 = 0, r2 = 0;
        if (tid < 128) { const unsigned w = E12[ci * 128 + tid]; e1 = w & 255u; e2 = (w >> 8) & 255u;
            r1 = __hip_atomic_fetch_add(lc + e1, 1u, __ATOMIC_RELAXED, __HIP_MEMORY_SCOPE_WORKGROUP); r2 = __hip_atomic_fetch_add(lc + e2, 1u, __ATOMIC_RELAXED, __HIP_MEMORY_SCOPE_WORKGROUP); }
        __syncthreads();
        if (tid < 8) lb[tid] = __hip_atomic_fetch_add(fill + tid, lc[tid], __ATOMIC_RELAXED, __HIP_MEMORY_SCOPE_AGENT);
        __syncthreads();
        if (tid < 128) { const int p1 = (int)(loff[e1] + lb[e1] + r1), p2 = (int)(loff[e2] + lb[e2] + r2);
            lpos[2 * tid] = p1; lpos[2 * tid + 1] = p2; POS[2 * (ci * 128 + tid)] = p1; POS[2 * (ci * 128 + tid) + 1] = p2; }
        __syncthreads();
        for (int tk = wave; tk < 128; tk += NWAVES) {
            const int p1 = lpos[2 * tk], p2 = lpos[2 * tk + 1];
            const v4u* src = (const v4u*)(HB + (size_t)(ci * 128 + tk) * D);
            const v4u x0 = src[lane], x1 = src[lane + 64];
            v4u* d1 = (v4u*)(XS + (size_t)p1 * D); v4u* d2 = (v4u*)(XS + (size_t)p2 * D);
            d1[lane] = x0; d1[lane + 64] = x1; d2[lane] = x0; d2[lane + 64] = x1;
        }
    }
}

template <bool FINAL>
DI void phase_combine_ln(const Args& a, const bf16* Yin, bf16* Yout, int lnprev, int lnidx, int bid, int G, int wave, int lane) {
    bf16* HB = (bf16*)(a.ws + WS_HB); const bf16* YE = (const bf16*)(a.ws + WS_XS); float* stats = (float*)(a.ws + WS_STATS);
    const int* POS = (const int*)(a.ws + WS_POS); const f32x2* G12 = (const f32x2*)(a.ws + WS_G12);
    const float* g = a.ln_g + (size_t)lnidx * D; const float* bta = a.ln_b + (size_t)lnidx * D;
    const float* gp = a.ln_g + (size_t)lnprev * D; const float* bp = a.ln_b + (size_t)lnprev * D;
    const int gw = bid * NWAVES + wave, NGW = G * NWAVES;
    float gv[2][8], bv[2][8], gq[2][8], bq[2][8];
#pragma unroll
    for (int q = 0; q < 2; ++q)
#pragma unroll
        for (int c = 0; c < 8; ++c) { const int col = 8 * (lane + 64 * q) + c; gv[q][c] = g[col]; bv[q][c] = bta[col]; gq[q][c] = gp[col] * ALPHA; bq[q][c] = bp[col] * ALPHA; }
    for (int t = gw; t < TT; t += NGW) {
        const int p1 = POS[2 * t], p2 = POS[2 * t + 1]; const f32x2 gg = G12[t]; const f32x2 st = *(const f32x2*)(stats + 2 * (size_t)t);
        float v[2][8]; float s = 0.f;
#pragma unroll
        for (int q = 0; q < 2; ++q) { float y[8], e1[8], e2[8];
            unpack8(((const v4u*)(Yin + (size_t)t * D))[lane + 64 * q], y); unpack8(((const v4u*)(YE + (size_t)p1 * D))[lane + 64 * q], e1); unpack8(((const v4u*)(YE + (size_t)p2 * D))[lane + 64 * q], e2);
#pragma unroll
            for (int c = 0; c < 8; ++c) { v[q][c] = (y[c] - st.x) * st.y * gq[q][c] + bq[q][c] + e1[c] * gg.x + e2[c] * gg.y; s += v[q][c]; } }
        const float mean = wave_sum(s) * (1.0f / D); float s2 = 0.f;
#pragma unroll
        for (int q = 0; q < 2; ++q)
#pragma unroll
            for (int c = 0; c < 8; ++c) { const float d = v[q][c] - mean; s2 += d * d; }
        const float rstd = 1.0f / sqrtf(wave_sum(s2) * (1.0f / D) + LN_EPS);
        if (!FINAL && lane == 0) *(f32x2*)(stats + 2 * (size_t)t) = (f32x2){mean, rstd};
#pragma unroll
        for (int q = 0; q < 2; ++q) { float hn[8];
#pragma unroll
            for (int c = 0; c < 8; ++c) hn[c] = (v[q][c] - mean) * rstd * gv[q][c] + bv[q][c];
            if (FINAL) { f32x4* orow = (f32x4*)(a.out + (size_t)t * D + 8 * (lane + 64 * q)); orow[0] = (f32x4){hn[0], hn[1], hn[2], hn[3]}; orow[1] = (f32x4){hn[4], hn[5], hn[6], hn[7]}; }
            else { v4u yo; yo.x = pk2(v[q][0], v[q][1]); yo.y = pk2(v[q][2], v[q][3]); yo.z = pk2(v[q][4], v[q][5]); yo.w = pk2(v[q][6], v[q][7]); ((v4u*)(Yout + (size_t)t * D))[lane + 64 * q] = yo;
                v4u o; o.x = pk2(hn[0], hn[1]); o.y = pk2(hn[2], hn[3]); o.z = pk2(hn[4], hn[5]); o.w = pk2(hn[6], hn[7]); ((v4u*)(HB + (size_t)t * D))[lane + 64 * q] = o; } }
    }
}

constexpr int ARGS_OFF = RING_BYTES + 1024;
DI unsigned long long lds_u64(LAS unsigned char* p) { const v2u w = *(const volatile LAS v2u*)p; return ((unsigned long long)(unsigned)__builtin_amdgcn_readfirstlane((int)w.y) << 32) | (unsigned)__builtin_amdgcn_readfirstlane((int)w.x); }
DI Args load_args(LAS unsigned char* lds) {
    Args a; LAS unsigned char* p = lds + ARGS_OFF;
    a.x = (const float*)(const GAS float*)lds_u64(p + 0); a.gdn_w_in = (const float*)(const GAS float*)lds_u64(p + 8); a.gdn_conv_w = (const float*)(const GAS float*)lds_u64(p + 16); a.gdn_a_log = (const float*)(const GAS float*)lds_u64(p + 24);
    a.gdn_dt_bias = (const float*)(const GAS float*)lds_u64(p + 32); a.gdn_norm_w = (const float*)(const GAS float*)lds_u64(p + 40); a.gdn_w_out = (const float*)(const GAS float*)lds_u64(p + 48); a.sb_w_in = (const float*)(const GAS float*)lds_u64(p + 56);
    a.sb_w_out = (const float*)(const GAS float*)lds_u64(p + 64); a.ffn_w_gate = (const float*)(const GAS float*)lds_u64(p + 72); a.ffn_w_up = (const float*)(const GAS float*)lds_u64(p + 80); a.ffn_w_down = (const float*)(const GAS float*)lds_u64(p + 88);
    a.moe_router = (const float*)(const GAS float*)lds_u64(p + 96); a.moe_w_gate = (const float*)(const GAS float*)lds_u64(p + 104); a.moe_w_up = (const float*)(const GAS float*)lds_u64(p + 112); a.moe_w_down = (const float*)(const GAS float*)lds_u64(p + 120);
    a.ln_g = (const float*)(const GAS float*)lds_u64(p + 128); a.ln_b = (const float*)(const GAS float*)lds_u64(p + 136); a.out = (float*)(GAS float*)lds_u64(p + 144); a.ws = (unsigned char*)(GAS unsigned char*)lds_u64(p + 152);
    const v2u w = *(const volatile LAS v2u*)(p + 160); a.ph_lo = __builtin_amdgcn_readfirstlane((int)w.x); a.ph_hi = __builtin_amdgcn_readfirstlane((int)w.y);
    return a;
}
#ifdef PH_ONLY
#define IN(k) (((k) % NPH) == PH_ONLY && lo <= (k) && (k) < hi)
#else
#define IN(k) (lo <= (k) && (k) < hi)
#endif
#define SEAM(k) do { if ((k) + 1 < hi) xcd_barrier(bar); } while (0)
DI int fresh_lane() { int l; asm volatile("v_mbcnt_lo_u32_b32 %0, -1, 0\n\tv_mbcnt_hi_u32_b32 %0, -1, %0" : "=v"(l)); return l; }
#define YMOE ((bf16*)(j == 1 ? (void*)(args.ws + WS_YT) : (void*)args.out))
#define ARGS() const Args args = load_args(lds); const int lo = args.ph_lo, hi = args.ph_hi; const int lane = fresh_lane(), tid = wave * 64 + lane
#ifndef PROBE_REP_MASK
#define PROBE_REP_MASK 0
#endif
#ifndef PROBE_DELAY_MASK
#define PROBE_DELAY_MASK 0
#endif
#define PROBE_DELAY_MULT 4u
#define TICK_IN(k) do { if (((PROBE_DELAY_MASK) >> (k)) & 1) { if (bid == 0 && tid == 0) ((volatile LAS unsigned*)(lds + MISC_OFF))[20] -= (unsigned)__builtin_amdgcn_s_memrealtime(); } } while (0)
#define TICK_OUT(k) do { if (((PROBE_DELAY_MASK) >> (k)) & 1) { if (bid == 0 && tid == 0) ((volatile LAS unsigned*)(lds + MISC_OFF))[20] += (unsigned)__builtin_amdgcn_s_memrealtime(); } } while (0)
#define NREP(k) ((((PROBE_REP_MASK) >> (k)) & 1) ? 2 : 1)
template <int j>
DI void layer_pair(LAS unsigned char* lds, const XcdBarrier& bar, const int wave, const int G, const int bid) {
    constexpr int pb = j * NPH;
    { ARGS(); if (IN(pb + 0)) { TICK_IN(0); _Pragma("unroll 1") for (int rep_ = 0; rep_ < NREP(0); ++rep_) { phase_w_gdn(args, j, lds, bid, G, tid, wave, lane); } SEAM(pb + 0); TICK_OUT(0); } }
    { ARGS(); if (IN(pb + 1)) { TICK_IN(1); {
        pg8::Gemm g{(const bf16*)(args.ws + WS_HB), (const bf16*)(args.ws + W_IN), D, D}; pg8::StaticOrder S; S.init(TT, GINP, G, bid, NREP(1));
        pg8::EpiInProj E{(bf16*)(args.ws + WS_RAW), (bf16*)(args.ws + WS_ZB)};
        pg8::gemm_phase<pg8::EpiInProj, pg8::StaticOrder, true, true>(lds, g, S, E);
        } SEAM(pb + 1); TICK_OUT(1); } }
    { ARGS(); if (IN(pb + 2)) { TICK_IN(2); _Pragma("unroll 1") for (int rep_ = 0; rep_ < NREP(2); ++rep_) { phase_conv(args, j, bid, G, tid); } SEAM(pb + 2); TICK_OUT(2); } }
#if GDN_NAIVE
    { ARGS(); if (IN(pb + 4)) { TICK_IN(4); _Pragma("unroll 1") for (int rep_ = 0; rep_ < NREP(4); ++rep_) { phase_gdn_naive(args, j, lds, bid, tid); } SEAM(pb + 4); TICK_OUT(4); } }
#else
    { ARGS(); if (IN(pb + 3)) { TICK_IN(3); _Pragma("unroll 1") for (int rep_ = 0; rep_ < NREP(3); ++rep_) { phase_gdn_local(args, lds, bid, G, wave, lane, rep_ + 1 < NREP(3)); } SEAM(pb + 3); TICK_OUT(3); } }
    { ARGS(); if (IN(pb + 4)) { TICK_IN(4); _Pragma("unroll 1") for (int rep_ = 0; rep_ < NREP(4); ++rep_) { if (bid >= BATCH * HV && G > BATCH * HV) phase_w_sb(args, j, lds, bid - BATCH * HV, G - BATCH * HV, wave, lane); else if (G <= BATCH * HV && rep_ == 0) phase_w_sb(args, j, lds, bid, G, wave, lane);
        phase_gdn_scan(args, j, lds, bid, tid, rep_ + 1 < NREP(4)); } SEAM(pb + 4); TICK_OUT(4); } }
#endif
    { ARGS(); if (IN(pb + 5)) { TICK_IN(5); {
        pg8::Gemm g{(const bf16*)(args.ws + WS_QKVC) + 2048, (const bf16*)(args.ws + W_OUT), 4096, 2048}; pg8::StaticOrder S; S.init(TT, D, G, bid);
        pg8::EpiResid<(j > 0)> E{j == 0 ? (const void*)args.x : (const void*)args.out, (bf16*)args.out, (const float*)(args.ws + WS_STATS), args.ln_g + (size_t)(4 * (j > 0 ? j - 1 : 0) + 3) * D, args.ln_b + (size_t)(4 * (j > 0 ? j - 1 : 0) + 3) * D};
        pg8::gemm_phase<pg8::EpiResid<(j > 0)>, pg8::StaticOrder, true, true>(lds, g, S, E);
        } SEAM(pb + 5); TICK_OUT(5); } }
    { ARGS(); if (IN(pb + 6)) { TICK_IN(6); _Pragma("unroll 1") for (int rep_ = 0; rep_ < NREP(6); ++rep_) { phase_ln<false>(args, (const bf16*)args.out, (2 * j) * 2 + 0, j, lds, bid, G, tid, wave, lane); } SEAM(pb + 6); TICK_OUT(6); } }
    { ARGS(); if (IN(pb + 7)) { TICK_IN(7); {
        pg8::Gemm g{(const bf16*)(args.ws + WS_HB), (const bf16*)(args.ws + W_GU), D, D}; pg8::StaticOrder S; S.init(TT, 2 * FF, G, bid, NREP(7));
        pg8::EpiSwiGLU E{(bf16*)(args.ws + WS_ACT), FF, 0};
        pg8::gemm_phase<pg8::EpiSwiGLU, pg8::StaticOrder, true, true>(lds, g, S, E);
        } SEAM(pb + 7); TICK_OUT(7); } }
    { ARGS(); if (IN(pb + 8)) { TICK_IN(8); {
        pg8::Gemm g{(const bf16*)(args.ws + WS_ACT), (const bf16*)(args.ws + W_D), FF, FF}; pg8::StaticOrder S; S.init(TT, D, G, bid);
        pg8::EpiResid<true> E{(const void*)args.out, (bf16*)args.out, (const float*)(args.ws + WS_STATS), args.ln_g + (size_t)(4 * j + 0) * D, args.ln_b + (size_t)(4 * j + 0) * D};
        pg8::gemm_phase<pg8::EpiResid<true>, pg8::StaticOrder, true, true>(lds, g, S, E);
        } SEAM(pb + 8); TICK_OUT(8); } }
    { ARGS(); if (IN(pb + 9)) { TICK_IN(9); _Pragma("unroll 1") for (int rep_ = 0; rep_ < NREP(9); ++rep_) { phase_ln<false>(args, (const bf16*)args.out, (2 * j) * 2 + 1, j, lds, bid, G, tid, wave, lane); } SEAM(pb + 9); TICK_OUT(9); } }
    { ARGS(); if (IN(pb + 10)) { TICK_IN(10); {
        pg8::Gemm g{(const bf16*)(args.ws + WS_HB), (const bf16*)(args.ws + W_QKV), D, D}; pg8::StaticOrder S; S.init(TT, 3072, G, bid, NREP(10));
        pg8::EpiBf16 E{(bf16*)(args.ws + WS_QKV), 3072, 0};
        pg8::gemm_phase<pg8::EpiBf16, pg8::StaticOrder, true, true>(lds, g, S, E);
        } SEAM(pb + 10); TICK_OUT(10); } }
    #if SB_NAIVE
    { ARGS(); if (IN(pb + 11)) { TICK_IN(11); _Pragma("unroll 1") for (int rep_ = 0; rep_ < NREP(11); ++rep_) { phase_sb_naive(args, lds, bid, G, tid); } SEAM(pb + 11); TICK_OUT(11); } }
#else
    { ARGS(); if (IN(pb + 11)) { TICK_IN(11); _Pragma("unroll 1") for (int rep_ = 0; rep_ < NREP(11); ++rep_) { phase_sb_mfma(args, lds, bid, G, tid); } SEAM(pb + 11); TICK_OUT(11); } }
#endif
    { ARGS(); if (IN(pb + 12)) { TICK_IN(12); {
        pg8::Gemm g{(const bf16*)(args.ws + WS_AO), (const bf16*)(args.ws + W_O), D, D}; pg8::StaticOrder S; S.init(TT, D, G, bid);
        pg8::EpiResid<true> E{(const void*)args.out, YMOE, (const float*)(args.ws + WS_STATS), args.ln_g + (size_t)(4 * j + 1) * D, args.ln_b + (size_t)(4 * j + 1) * D};
        pg8::gemm_phase<pg8::EpiResid<true>, pg8::StaticOrder, true, true>(lds, g, S, E);
        } SEAM(pb + 12); TICK_OUT(12); } }
    { ARGS(); if (IN(pb + 13)) { TICK_IN(13); _Pragma("unroll 1") for (int rep_ = 0; rep_ < NREP(13); ++rep_) { phase_ln<true>(args, YMOE, (2 * j + 1) * 2 + 0, j, lds, bid, G, tid, wave, lane); } SEAM(pb + 13); TICK_OUT(13); } }
    { ARGS(); if (IN(pb + 14)) { TICK_IN(14); _Pragma("unroll 1") for (int rep_ = 0; rep_ < NREP(14); ++rep_) { phase_scatter(args, j, lds, bid, G, tid, wave, lane); } SEAM(pb + 14); TICK_OUT(14); } }
    { ARGS(); if (IN(pb + 15)) { TICK_IN(15); {
        unsigned off[9]; moe_offsets(args, j, off);
        pg8::MoeOrder S; S.nM = (int)(off[8] >> 8); S.G = G; S.c = bid; S.nN = 2 * FF / 256; S.nwg = S.nM * S.nN; S.rep = NREP(15);
        S.ps1 = (int)(off[1] >> 8); S.ps2 = (int)(off[2] >> 8); S.ps3 = (int)(off[3] >> 8); S.ps4 = (int)(off[4] >> 8); S.ps5 = (int)(off[5] >> 8); S.ps6 = (int)(off[6] >> 8); S.ps7 = (int)(off[7] >> 8);
        pg8::Gemm g{(const bf16*)(args.ws + WS_XS), (const bf16*)(args.ws + W_MGU), D, D};
        pg8::EpiSwiGLU E{(bf16*)(args.ws + WS_MACT), FF, 2 * FF / 256};
        pg8::gemm_phase<pg8::EpiSwiGLU, pg8::MoeOrder, true, true>(lds, g, S, E);
        } SEAM(pb + 15); TICK_OUT(15); } }
    { ARGS(); if (IN(pb + 16)) { TICK_IN(16); {
        unsigned off[9]; moe_offsets(args, j, off);
        pg8::MoeOrder S; S.nM = (int)(off[8] >> 8); S.G = G; S.c = bid; S.nN = D / 256; S.nwg = S.nM * S.nN; S.rep = NREP(16);
        S.ps1 = (int)(off[1] >> 8); S.ps2 = (int)(off[2] >> 8); S.ps3 = (int)(off[3] >> 8); S.ps4 = (int)(off[4] >> 8); S.ps5 = (int)(off[5] >> 8); S.ps6 = (int)(off[6] >> 8); S.ps7 = (int)(off[7] >> 8);
        pg8::Gemm g{(const bf16*)(args.ws + WS_MACT), (const bf16*)(args.ws + W_MD), FF, FF};
        pg8::EpiBf16 E{(bf16*)(args.ws + WS_XS), D, D / 256};
        pg8::gemm_phase<pg8::EpiBf16, pg8::MoeOrder, true, true>(lds, g, S, E);
        } SEAM(pb + 16); TICK_OUT(16); } }
    { ARGS(); if (IN(pb + 17)) { TICK_IN(17); _Pragma("unroll 1") for (int rep_ = 0; rep_ < NREP(17); ++rep_) { phase_combine_ln<(j == 1)>(args, YMOE, (bf16*)args.out, 4 * j + 2, 4 * j + 3, bid, G, wave, lane); } SEAM(pb + 17); TICK_OUT(17); } }
}
__global__ void __launch_bounds__(NWAVES * 64, 2) fwd(Args kargs) {
    extern __shared__ __attribute__((aligned(16))) unsigned char lds_raw[];
    LAS unsigned char* lds = (LAS unsigned char*)lds_raw;
    volatile LAS unsigned* MISC = (volatile LAS unsigned*)(lds + MISC_OFF);
    const int tid = threadIdx.x, lane = tid & 63, wave = __builtin_amdgcn_readfirstlane(tid >> 6), G = gridDim.x, bid = blockIdx.x;
    for (int u = tid; u < (LDS_BYTES - RING_BYTES) / 4; u += NWAVES * 64) ((LAS unsigned*)(lds + RING_BYTES))[u] = 0u;
    __syncthreads();
    if (tid == 0) { LAS unsigned long long* pa = (LAS unsigned long long*)(lds + ARGS_OFF);
        pa[0] = (unsigned long long)kargs.x; pa[1] = (unsigned long long)kargs.gdn_w_in; pa[2] = (unsigned long long)kargs.gdn_conv_w; pa[3] = (unsigned long long)kargs.gdn_a_log;
        pa[4] = (unsigned long long)kargs.gdn_dt_bias; pa[5] = (unsigned long long)kargs.gdn_norm_w; pa[6] = (unsigned long long)kargs.gdn_w_out; pa[7] = (unsigned long long)kargs.sb_w_in;
        pa[8] = (unsigned long long)kargs.sb_w_out; pa[9] = (unsigned long long)kargs.ffn_w_gate; pa[10] = (unsigned long long)kargs.ffn_w_up; pa[11] = (unsigned long long)kargs.ffn_w_down;
        pa[12] = (unsigned long long)kargs.moe_router; pa[13] = (unsigned long long)kargs.moe_w_gate; pa[14] = (unsigned long long)kargs.moe_w_up; pa[15] = (unsigned long long)kargs.moe_w_down;
        pa[16] = (unsigned long long)kargs.ln_g; pa[17] = (unsigned long long)kargs.ln_b; pa[18] = (unsigned long long)kargs.out; pa[19] = (unsigned long long)kargs.ws;
        pa[20] = (unsigned long long)(unsigned)kargs.ph_lo | ((unsigned long long)(unsigned)kargs.ph_hi << 32); }
    XcdBarrier bar = xcd_barrier_post((unsigned*)(kargs.ws + WS_CTL) + CW_BAR, MISC + 8);
    __syncthreads();
    layer_pair<0>(lds, bar, wave, G, bid);
    layer_pair<1>(lds, bar, wave, G, bid);
    if (PROBE_DELAY_MASK || PROBE_SEC) { if (bid == 0 && threadIdx.x == 0) { const unsigned acc = ((volatile LAS unsigned*)(lds + MISC_OFF))[20] * PROBE_DELAY_MULT; const unsigned long long t0 = __builtin_amdgcn_s_memrealtime(); while ((unsigned)(__builtin_amdgcn_s_memrealtime() - t0) < acc) __builtin_amdgcn_s_sleep(8); } }
}
#undef IN
#undef SEAM
#undef ARGS

extern "C" void kernel_launch(void* const* d_in, const int* in_sizes, int n_in, void* d_out, int out_size, void* d_ws, size_t ws_size, hipStream_t stream) {
    static int grid = 0;
    if (grid == 0) {
        if (n_in != 18 || in_sizes[0] != TT * D || out_size != TT * D || ws_size < WS_END) { fprintf(stderr, "kernel_launch: unexpected shapes (n_in %d, in0 %d, out %d, ws %zu); nothing launched\n", n_in, n_in > 0 ? in_sizes[0] : -1, out_size, ws_size); grid = -1; return; }
        int dev = 0, cus = 0, per_cu = 0;
        if (hipGetDevice(&dev) != hipSuccess || hipDeviceGetAttribute(&cus, hipDeviceAttributeMultiprocessorCount, dev) != hipSuccess) { grid = -1; return; }
        if (hipFuncSetAttribute((const void*)fwd, hipFuncAttributeMaxDynamicSharedMemorySize, LDS_BYTES) != hipSuccess) { fprintf(stderr, "kernel_launch: hipFuncSetAttribute failed\n"); grid = -1; return; }
        if (hipOccupancyMaxActiveBlocksPerMultiprocessor(&per_cu, (const void*)fwd, NWAVES * 64, LDS_BYTES) != hipSuccess || per_cu < 1) { fprintf(stderr, "kernel_launch: occupancy query says %d blocks per CU\n", per_cu); (void)hipGetLastError(); grid = -1; return; }
        grid = cus;
    }
    if (grid < 0) return;
    if (hipMemsetAsync((char*)d_ws + WS_CTL, 0, CTL_ZERO_BYTES, stream) != hipSuccess) return;
    Args a{};
    a.x = (const float*)d_in[0]; a.gdn_w_in = (const float*)d_in[1]; a.gdn_conv_w = (const float*)d_in[2]; a.gdn_a_log = (const float*)d_in[3]; a.gdn_dt_bias = (const float*)d_in[4];
    a.gdn_norm_w = (const float*)d_in[5]; a.gdn_w_out = (const float*)d_in[6]; a.sb_w_in = (const float*)d_in[7]; a.sb_w_out = (const float*)d_in[8];
    a.ffn_w_gate = (const float*)d_in[9]; a.ffn_w_up = (const float*)d_in[10]; a.ffn_w_down = (const float*)d_in[11]; a.moe_router = (const float*)d_in[12];
    a.moe_w_gate = (const float*)d_in[13]; a.moe_w_up = (const float*)d_in[14]; a.moe_w_down = (const float*)d_in[15]; a.ln_g = (const float*)d_in[16]; a.ln_b = (const float*)d_in[17];
    a.out = (float*)d_out; a.ws = (unsigned char*)d_ws;
#if MK_ONE_LAUNCH
    a.ph_lo = 0; a.ph_hi = NPHASES;
    hipLaunchKernelGGL(fwd, dim3(grid), dim3(NWAVES * 64), LDS_BYTES, stream, a);
#else
    for (int p = 0; p < NPHASES; ++p) { a.ph_lo = p; a.ph_hi = p + 1; hipLaunchKernelGGL(fwd, dim3(grid), dim3(NWAVES * 64), LDS_BYTES, stream, a); }
#endif
}
```

```cpp
#include <hip/hip_runtime.h>
#include <cstdio>
#include <cstdint>
#ifndef GDN_NAIVE
#define GDN_NAIVE 0
#endif
#ifndef SB_NAIVE
#define SB_NAIVE 0
#endif
#ifndef MK_ONE_LAUNCH
#define MK_ONE_LAUNCH 1
#endif
#ifndef PROBE_SEC
#define PROBE_SEC 0
#endif
#define GSEC_ACC(k, sign) do { if (PROBE_SEC == (k)) { if (blockIdx.x == 0 && threadIdx.x == 0) { volatile __attribute__((address_space(3))) unsigned* p_ = (volatile __attribute__((address_space(3))) unsigned*)(131072 + 320 + 80); *p_ = *p_ sign (unsigned)__builtin_amdgcn_s_memrealtime(); } } } while (0)
namespace pg8 {
#define PG8_LAS __attribute__((address_space(3)))
typedef unsigned short bf16_t;
typedef short bf16x8 __attribute__((ext_vector_type(8)));
typedef float f32x4 __attribute__((ext_vector_type(4)));
typedef unsigned u32x4 __attribute__((ext_vector_type(4)));
constexpr int BM = 256, BK = 64, HALF = 128, HTB = HALF * BK * 2  , STAGE_BYTES = 8 * HTB, NXCD = 8, WGM = 8;

__host__ __device__ __forceinline__ int lds_byte(int r, int c) { const int st = (r >> 4) * 2 + (c >> 5), rr = r & 15, cc = c & 31, ob = rr * 64 + cc * 2; return st * 1024 + (ob ^ (((ob >> 9) & 1) << 5)); }
__host__ __device__ __forceinline__ void stage_rc(int b, int& R, int& C) { const int st = b / 1024, sb = b % 1024, swz = sb ^ (((sb >> 9) & 1) << 5); R = (st >> 1) * 16 + swz / 64; C = (st & 1) * 32 + (swz % 64) / 2; }
__host__ __device__ __forceinline__ int perm32(int rho) { const int n = rho >> 4, i = rho & 15; return 8 * (i >> 2) + 4 * n + (i & 3); }

struct Unit { int pm, pn; };
struct Gemm { const bf16_t* A; const bf16_t* Bt; int lda, K; };

struct StaticOrder {
    int nM, nN, nwg, G, c, rep;
    __host__ __device__ void init(int M, int N, int G_, int c_, int rep_ = 1) { nM = M / BM; nN = N / BM; nwg = nM * nN; G = G_; c = c_; rep = rep_; }
    __host__ __device__ bool next(int i, Unit& u) const {
        const long L = (long)i * G + c; if (L >= (long)rep * nwg) return false;
        int wgid = (int)(L % nwg); { const int q = nwg / NXCD, r = nwg % NXCD, xcd = wgid % NXCD, off = wgid / NXCD; wgid = (xcd < r ? xcd * (q + 1) : r * (q + 1) + (xcd - r) * q) + off; }
        const int nig = WGM * nN, gid = wgid / nig, fm = gid * WGM, gsz = (nM - fm) < WGM ? (nM - fm) : WGM;
        u.pm = fm + ((wgid % nig) % gsz); u.pn = (wgid % nig) / gsz; return true;
    }
    __device__ __forceinline__ void a_ready(const Unit&) const {}
    __device__ __forceinline__ void done(const Unit&) const {}
};

__device__ __forceinline__ unsigned cvt_pk_bf16(float lo, float hi) { unsigned r; asm volatile("v_cvt_pk_bf16_f32 %0, %1, %2" : "=v"(r) : "v"(lo), "v"(hi)); return r; }
struct EpiBf16 {
    static constexpr bool PERM = true, AFTER_DRAIN = false;
    bf16_t* O; int ldc; int nmod;
    __device__ __forceinline__ void operator()(const f32x4 (&acc)[2][2][4][2], const Unit& u, int wr, int wc, int fr, int fq) const {
        const int pnl = nmod ? (u.pn % nmod) : u.pn;
        const int row0 = u.pm * BM + wr * 64 + fr, col0 = pnl * BM + wc * 32 + 8 * fq;
#pragma unroll
        for (int ai = 0; ai < 2; ++ai)
#pragma unroll
            for (int m = 0; m < 4; ++m) { bf16_t* rowp = O + (size_t)(row0 + ai * HALF + m * 16) * ldc + col0;
#pragma unroll
                for (int bj = 0; bj < 2; ++bj) { const f32x4 v0 = acc[ai][bj][m][0], v1 = acc[ai][bj][m][1];
                    u32x4 w; w.x = cvt_pk_bf16(v0[0], v0[1]); w.y = cvt_pk_bf16(v0[2], v0[3]); w.z = cvt_pk_bf16(v1[0], v1[1]); w.w = cvt_pk_bf16(v1[2], v1[3]);
                    *(u32x4*)(rowp + bj * HALF) = w; } }
    }
};
struct EpiInProj {
    static constexpr bool PERM = true, AFTER_DRAIN = false;
    bf16_t* RAW; bf16_t* ZB;
    __device__ __forceinline__ void operator()(const f32x4 (&acc)[2][2][4][2], const Unit& u, int wr, int wc, int fr, int fq) const {
        const bool isz = (u.pn >= 16 && u.pn < 24);
        bf16_t* O = isz ? ZB : RAW; const int ldc = isz ? 2048 : 4352; const int ct = isz ? (u.pn - 16) : (u.pn < 16 ? u.pn : 16);
        const int row0 = u.pm * BM + wr * 64 + fr, col0 = ct * BM + wc * 32 + 8 * fq;
#pragma unroll
        for (int ai = 0; ai < 2; ++ai)
#pragma unroll
            for (int m = 0; m < 4; ++m) { bf16_t* rowp = O + (size_t)(row0 + ai * HALF + m * 16) * ldc + col0;
#pragma unroll
                for (int bj = 0; bj < 2; ++bj) { f32x4 v0 = acc[ai][bj][m][0], v1 = acc[ai][bj][m][1];
                    if (isz) {
#pragma unroll
                        for (int e = 0; e < 4; ++e) { v0[e] = v0[e] * __builtin_amdgcn_rcpf(1.0f + __builtin_amdgcn_exp2f(-1.4426950408889634f * v0[e])); v1[e] = v1[e] * __builtin_amdgcn_rcpf(1.0f + __builtin_amdgcn_exp2f(-1.4426950408889634f * v1[e])); } }
                    u32x4 w; w.x = cvt_pk_bf16(v0[0], v0[1]); w.y = cvt_pk_bf16(v0[2], v0[3]); w.z = cvt_pk_bf16(v1[0], v1[1]); w.w = cvt_pk_bf16(v1[2], v1[3]);
                    *(u32x4*)(rowp + bj * HALF) = w; } }
    }
};
__device__ __forceinline__ float silu_f(float x) { return x * __builtin_amdgcn_rcpf(1.0f + __builtin_amdgcn_exp2f(-1.4426950408889634f * x)); }
struct EpiSwiGLU {
    static constexpr bool PERM = true, AFTER_DRAIN = false;
    bf16_t* O; int ldc; int nmod;
    __device__ __forceinline__ void operator()(const f32x4 (&acc)[2][2][4][2], const Unit& u, int wr, int wc, int fr, int fq) const {
        const int pnl = nmod ? (u.pn % nmod) : u.pn;
        const int row0 = u.pm * BM + wr * 64 + fr, col0 = pnl * HALF + wc * 32 + 8 * fq;
#pragma unroll
        for (int ai = 0; ai < 2; ++ai)
#pragma unroll
            for (int m = 0; m < 4; ++m) { bf16_t* rowp = O + (size_t)(row0 + ai * HALF + m * 16) * ldc + col0;
                const f32x4 g0 = acc[ai][0][m][0], g1 = acc[ai][0][m][1], u0 = acc[ai][1][m][0], u1 = acc[ai][1][m][1];
                u32x4 w;
                w.x = cvt_pk_bf16(silu_f(g0[0]) * u0[0], silu_f(g0[1]) * u0[1]); w.y = cvt_pk_bf16(silu_f(g0[2]) * u0[2], silu_f(g0[3]) * u0[3]);
                w.z = cvt_pk_bf16(silu_f(g1[0]) * u1[0], silu_f(g1[1]) * u1[1]); w.w = cvt_pk_bf16(silu_f(g1[2]) * u1[2], silu_f(g1[3]) * u1[3]);
                *(u32x4*)rowp = w; }
    }
};
typedef float f32x2e __attribute__((ext_vector_type(2)));
template <bool LNR> struct EpiResid {
    static constexpr bool PERM = true, AFTER_DRAIN = false;
    const void* res; bf16_t* out; const float* stats; const float* g; const float* b;
    __device__ __forceinline__ void operator()(const f32x4 (&acc)[2][2][4][2], const Unit& u, int wr, int wc, int fr, int fq) const {
        constexpr int ldc = 1024; constexpr float alpha = 1.6817928305074290f;
        const int row0 = u.pm * BM + wr * 64 + fr, col0 = u.pn * BM + wc * 32 + 8 * fq;
#pragma unroll
        for (int bj = 0; bj < 2; ++bj) {
            f32x4 g0, g1, b0, b1;
            if constexpr (LNR) { g0 = *(const f32x4*)(g + col0 + bj * HALF) * alpha; g1 = *(const f32x4*)(g + col0 + bj * HALF + 4) * alpha;
                                 b0 = *(const f32x4*)(b + col0 + bj * HALF) * alpha; b1 = *(const f32x4*)(b + col0 + bj * HALF + 4) * alpha; }
#pragma unroll
            for (int ai = 0; ai < 2; ++ai) {
                if constexpr (LNR) {
                    u32x4 w[4]; f32x2e st[4];
#pragma unroll
                    for (int m = 0; m < 4; ++m) { const int row = row0 + ai * HALF + m * 16; w[m] = *(const u32x4*)((const bf16_t*)res + (size_t)row * ldc + col0 + bj * HALF); st[m] = *(const f32x2e*)(stats + 2 * row); }
                    asm volatile("" ::: "memory");
#pragma unroll
                    for (int m = 0; m < 4; ++m) { const int row = row0 + ai * HALF + m * 16; const float mean = st[m].x, rstd = st[m].y;
                        const f32x4 r0 = {__uint_as_float(w[m].x << 16), __uint_as_float(w[m].x & 0xffff0000u), __uint_as_float(w[m].y << 16), __uint_as_float(w[m].y & 0xffff0000u)};
                        const f32x4 r1 = {__uint_as_float(w[m].z << 16), __uint_as_float(w[m].z & 0xffff0000u), __uint_as_float(w[m].w << 16), __uint_as_float(w[m].w & 0xffff0000u)};
                        const f32x4 v0 = (r0 - mean) * rstd * g0 + b0 + acc[ai][bj][m][0], v1 = (r1 - mean) * rstd * g1 + b1 + acc[ai][bj][m][1];
                        u32x4 o; o.x = cvt_pk_bf16(v0[0], v0[1]); o.y = cvt_pk_bf16(v0[2], v0[3]); o.z = cvt_pk_bf16(v1[0], v1[1]); o.w = cvt_pk_bf16(v1[2], v1[3]);
                        *(u32x4*)(out + (size_t)row * ldc + col0 + bj * HALF) = o; }
                } else {
                    f32x4 x0[4], x1[4];
#pragma unroll
                    for (int m = 0; m < 4; ++m) { const size_t off = (size_t)(row0 + ai * HALF + m * 16) * ldc + col0 + bj * HALF; x0[m] = *(const f32x4*)((const float*)res + off); x1[m] = *(const f32x4*)((const float*)res + off + 4); }
                    asm volatile("" ::: "memory");
#pragma unroll
                    for (int m = 0; m < 4; ++m) { const size_t off = (size_t)(row0 + ai * HALF + m * 16) * ldc + col0 + bj * HALF;
                        const f32x4 v0 = x0[m] * alpha + acc[ai][bj][m][0], v1 = x1[m] * alpha + acc[ai][bj][m][1];
                        u32x4 o; o.x = cvt_pk_bf16(v0[0], v0[1]); o.y = cvt_pk_bf16(v0[2], v0[3]); o.z = cvt_pk_bf16(v1[0], v1[1]); o.w = cvt_pk_bf16(v1[2], v1[3]);
                        *(u32x4*)(out + off) = o; }
                }
                asm volatile("" ::: "memory");
            }
        }
    }
};
struct MoeOrder {
    int nM, nN, nwg, G, c, rep; int ps1, ps2, ps3, ps4, ps5, ps6, ps7;
    __device__ __forceinline__ bool next(int i, Unit& u) const {
        const long L = (long)i * G + c; if (nwg == 0 || L >= (long)rep * nwg) return false;
        int wgid = (int)(L % nwg); { const int q = nwg / NXCD, r = nwg % NXCD, xcd = wgid % NXCD, off = wgid / NXCD; wgid = (xcd < r ? xcd * (q + 1) : r * (q + 1) + (xcd - r) * q) + off; }
        const int nig = WGM * nN, gid = wgid / nig, fm = gid * WGM, gsz = (nM - fm) < WGM ? (nM - fm) : WGM;
        const int pm = fm + ((wgid % nig) % gsz), pnl = (wgid % nig) / gsz;
        const int e = (pm >= ps1) + (pm >= ps2) + (pm >= ps3) + (pm >= ps4) + (pm >= ps5) + (pm >= ps6) + (pm >= ps7);
        u.pm = pm; u.pn = e * nN + pnl; return true;
    }
    __device__ __forceinline__ void a_ready(const Unit&) const {}
    __device__ __forceinline__ void done(const Unit&) const {}
};
template <class Epi, class Sched, bool ALIGN_EPI = false, bool SP2 = false>
__device__ __forceinline__ void gemm_phase(PG8_LAS unsigned char* lds, const Gemm g, const Sched& S, const Epi& E) {
    const int tid = threadIdx.x, wid = __builtin_amdgcn_readfirstlane(tid >> 6), lane = tid & 63, wr = wid >> 2, wc = wid & 3, fr = lane & 15, fq = lane >> 4;
    const int K = g.K, nt = K / BK;
    unsigned voffA[2], voffB[2];
#pragma unroll
    for (int i = 0; i < 2; ++i) { int R, C; stage_rc(tid * 16 + i * 8192, R, C); const int Rb = Epi::PERM ? ((R & ~31) + perm32(R & 31)) : R;
        voffA[i] = (unsigned)(R * g.lda + C) * 2u; voffB[i] = (unsigned)(Rb * K + C) * 2u; }
    const size_t kstep = (size_t)(BK * 2);
    const size_t hstepA = (size_t)HALF * g.lda * 2, hstepB = (size_t)HALF * K * 2;
    const size_t tstepA = 2 * hstepA, tstepB = 2 * hstepB;
    const unsigned ldsw = (unsigned)wid * 1024u;
    const int aoff = lds_byte(wr * 64 + fr, fq * 8), boff = lds_byte(wc * 32 + fr, fq * 8);
#define PG8_SA(b, h) (((b) * 2 + (h)) * HTB)
#define PG8_SB(b, h) ((4 + (b) * 2 + (h)) * HTB)
#define PG8_STAGE(bufoff, gbase, voff) do { _Pragma("unroll") for (int _i = 0; _i < 2; ++_i) \
        __builtin_amdgcn_global_load_lds((const unsigned*)((const char*)(gbase) + (voff)[_i]), (PG8_LAS unsigned*)(lds + (bufoff) + ldsw + _i * 8192), 16, 0, 0); } while (0)
#define PG8_LDA(dst, b, h) do { _Pragma("unroll") for (int m = 0; m < 4; ++m) _Pragma("unroll") for (int k = 0; k < 2; ++k) dst[m][k] = *(const PG8_LAS bf16x8*)(lds + PG8_SA(b, h) + aoff + m * 2048 + k * 1024); } while (0)
#define PG8_LDB(dst, b, h) do { _Pragma("unroll") for (int n = 0; n < 2; ++n) _Pragma("unroll") for (int k = 0; k < 2; ++k) dst[n][k] = *(const PG8_LAS bf16x8*)(lds + PG8_SB(b, h) + boff + n * 2048 + k * 1024); } while (0)
#define PG8_MMA(ai, bj, At, Bt) do { __builtin_amdgcn_s_setprio(1); _Pragma("unroll") for (int m = 0; m < 4; ++m) _Pragma("unroll") for (int n = 0; n < 2; ++n) _Pragma("unroll") for (int k = 0; k < 2; ++k) \
        acc[ai][bj][m][n] = __builtin_amdgcn_mfma_f32_16x16x32_bf16(Bt[n][k], At[m][k], acc[ai][bj][m][n], 0, 0, 0); __builtin_amdgcn_s_setprio(0); } while (0)
#define PG8_WAIT_V(n) asm volatile("s_waitcnt vmcnt(" #n ")" ::: "memory")
#define PG8_WAIT_L(n) asm volatile("s_waitcnt lgkmcnt(" #n ")" ::: "memory")
#define PG8_BAR __builtin_amdgcn_s_barrier()
#define PG8_SCHED __builtin_amdgcn_sched_barrier(0)
    Unit cur, nxt; int ui = 0;
    if (!S.next(0, cur)) return;
    f32x4 acc[2][2][4][2];
#pragma unroll
    for (int a = 0; a < 2; ++a)
#pragma unroll
        for (int b = 0; b < 2; ++b)
#pragma unroll
            for (int m = 0; m < 4; ++m)
#pragma unroll
                for (int n = 0; n < 2; ++n) acc[a][b][m][n] = (f32x4){0.f, 0.f, 0.f, 0.f};
    bf16x8 At[4][2], B0[2][2], B1[2][2];
    const char* cA = (const char*)g.A + (size_t)cur.pm * tstepA; const char* cB = (const char*)g.Bt + (size_t)cur.pn * tstepB;
    S.a_ready(cur);
    if constexpr (SP2) {
        PG8_STAGE(PG8_SB(0, 0), cB, voffB); PG8_STAGE(PG8_SB(0, 1), cB + hstepB, voffB); PG8_STAGE(PG8_SA(0, 0), cA, voffA); PG8_STAGE(PG8_SA(0, 1), cA + hstepA, voffA);
        if (wr == 1) PG8_BAR;
        PG8_WAIT_V(2); PG8_BAR;
        PG8_STAGE(PG8_SB(1, 0), cB + kstep, voffB); PG8_STAGE(PG8_SA(1, 0), cA + kstep, voffA); PG8_STAGE(PG8_SB(1, 1), cB + hstepB + kstep, voffB);
        PG8_WAIT_V(6); PG8_BAR;
    } else {
        PG8_STAGE(PG8_SB(0, 0), cB, voffB); PG8_STAGE(PG8_SA(0, 0), cA, voffA); PG8_STAGE(PG8_SB(0, 1), cB + hstepB, voffB); PG8_STAGE(PG8_SA(0, 1), cA + hstepA, voffA);
        if (wr == 1) PG8_BAR;
        PG8_WAIT_V(4); PG8_BAR;
        PG8_STAGE(PG8_SB(1, 0), cB + kstep, voffB); PG8_STAGE(PG8_SA(1, 0), cA + kstep, voffA); PG8_STAGE(PG8_SB(1, 1), cB + hstepB + kstep, voffB);
        PG8_WAIT_V(6); PG8_BAR;
    }
    for (;;) {
        const bool has_next = S.next(ui + 1, nxt);
        const char* nA = has_next ? (const char*)g.A + (size_t)nxt.pm * tstepA : cA; const char* nB = has_next ? (const char*)g.Bt + (size_t)nxt.pn * tstepB : cB;
        GSEC_ACC(6, -);
        for (int t = 0; t < nt; t += 2) {
            const bool last = (t == nt - 2);
            const char* a1 = cA + (size_t)(t + 1) * kstep;
            const char* a2 = last ? nA : cA + (size_t)(t + 2) * kstep; const char* b2 = last ? nB : cB + (size_t)(t + 2) * kstep;
            const char* a3 = a2 + kstep; const char* b3 = b2 + kstep;
            if (last && has_next) S.a_ready(nxt);
            if constexpr (SP2) {
            PG8_LDB(B0, 0, 0); PG8_LDB(B1, 0, 1); PG8_SCHED; PG8_LDA(At, 0, 0); PG8_STAGE(PG8_SA(1, 1), a1 + hstepA, voffA);
            PG8_WAIT_V(8); PG8_WAIT_L(0); PG8_BAR; PG8_MMA(0, 0, At, B0); PG8_MMA(0, 1, At, B1); PG8_BAR; PG8_SCHED;
            PG8_LDA(At, 0, 1); PG8_STAGE(PG8_SB(0, 0), b2, voffB); PG8_STAGE(PG8_SB(0, 1), b2 + hstepB, voffB); PG8_STAGE(PG8_SA(0, 0), a2, voffA);
            PG8_WAIT_V(8); PG8_WAIT_L(0); PG8_BAR; PG8_MMA(1, 0, At, B0); PG8_MMA(1, 1, At, B1); PG8_BAR; PG8_SCHED;
            PG8_LDB(B0, 1, 0); PG8_LDB(B1, 1, 1); PG8_SCHED; PG8_LDA(At, 1, 0); PG8_STAGE(PG8_SA(0, 1), a2 + hstepA, voffA);
            PG8_WAIT_V(8); PG8_WAIT_L(0); PG8_BAR; PG8_MMA(0, 0, At, B0); PG8_MMA(0, 1, At, B1); PG8_BAR; PG8_SCHED;
            PG8_LDA(At, 1, 1); PG8_STAGE(PG8_SB(1, 0), b3, voffB); PG8_STAGE(PG8_SB(1, 1), b3 + hstepB, voffB); PG8_STAGE(PG8_SA(1, 0), a3, voffA);
            PG8_WAIT_V(8); PG8_WAIT_L(0); PG8_BAR; PG8_MMA(1, 0, At, B0); PG8_MMA(1, 1, At, B1); PG8_BAR; PG8_SCHED;
            } else {
            PG8_LDB(B0, 0, 0); PG8_SCHED; PG8_LDA(At, 0, 0); PG8_STAGE(PG8_SA(1, 1), a1 + hstepA, voffA);
            PG8_WAIT_L(8); PG8_BAR; PG8_WAIT_L(0); PG8_MMA(0, 0, At, B0); PG8_BAR; PG8_SCHED;
            PG8_LDB(B1, 0, 1); PG8_STAGE(PG8_SB(0, 0), b2, voffB);
            PG8_BAR; PG8_WAIT_L(0); PG8_MMA(0, 1, At, B1); PG8_BAR;
            PG8_LDA(At, 0, 1); PG8_STAGE(PG8_SA(0, 0), a2, voffA);
            PG8_BAR; PG8_WAIT_L(0); PG8_MMA(1, 0, At, B0); PG8_BAR; PG8_SCHED;
            PG8_STAGE(PG8_SB(0, 1), b2 + hstepB, voffB);
            PG8_WAIT_V(6); PG8_BAR; PG8_MMA(1, 1, At, B1); PG8_BAR;
            PG8_LDB(B0, 1, 0); PG8_SCHED; PG8_LDA(At, 1, 0); PG8_STAGE(PG8_SA(0, 1), a2 + hstepA, voffA);
            PG8_WAIT_L(8); PG8_BAR; PG8_WAIT_L(0); PG8_MMA(0, 0, At, B0); PG8_BAR; PG8_SCHED;
            PG8_LDB(B1, 1, 1); PG8_STAGE(PG8_SB(1, 0), b3, voffB);
            PG8_BAR; PG8_WAIT_L(0); PG8_MMA(0, 1, At, B1); PG8_BAR;
            PG8_LDA(At, 1, 1); PG8_STAGE(PG8_SA(1, 0), a3, voffA);
            PG8_BAR; PG8_WAIT_L(0); PG8_MMA(1, 0, At, B0); PG8_BAR; PG8_SCHED;
            PG8_STAGE(PG8_SB(1, 1), b3 + hstepB, voffB);
            PG8_WAIT_V(6); PG8_BAR; PG8_MMA(1, 1, At, B1); PG8_BAR;
            }
        }
        GSEC_ACC(6, +); GSEC_ACC(7, -);
        if constexpr (ALIGN_EPI) { if (wr == 0) PG8_BAR; }
        if constexpr (!Epi::AFTER_DRAIN) { E(acc, cur, wr, wc, fr, fq); S.done(cur); }
        GSEC_ACC(7, +);
        if (!has_next) break;
#pragma unroll
        for (int a = 0; a < 2; ++a)
#pragma unroll
            for (int b = 0; b < 2; ++b)
#pragma unroll
                for (int m = 0; m < 4; ++m)
#pragma unroll
                    for (int n = 0; n < 2; ++n) acc[a][b][m][n] = (f32x4){0.f, 0.f, 0.f, 0.f};
        cur = nxt; cA = nA; cB = nB; ++ui;
        if constexpr (ALIGN_EPI) { if (wr == 1) PG8_BAR; }
    }
    PG8_WAIT_V(0);
    if constexpr (!ALIGN_EPI) { if (wr == 0) PG8_BAR; }
    PG8_BAR;
    if constexpr (Epi::AFTER_DRAIN) { E.fused(acc, cur, wr, wc, fr, fq, lds, wid, lane); S.done(cur); }
#undef PG8_SA
#undef PG8_SB
#undef PG8_STAGE
#undef PG8_LDA
#undef PG8_LDB
#undef PG8_MMA
#undef PG8_WAIT_V
#undef PG8_WAIT_L
#undef PG8_BAR
#undef PG8_SCHED
}
}

constexpr int NWAVES = 8;
constexpr int BATCH = 8, SEQ = 4096, TT = BATCH * SEQ, D = 1024;
constexpr int HK = 8, HV = 16, HD = 128;
constexpr int GIN = 6176, GINP = 6400;
constexpr int FF = 3584, NE = 8, MOE_ROWS = 67584;
constexpr float ALPHA = 1.6817928305074290f;
constexpr float LN_EPS = 1e-5f, RMS_EPS = 1e-6f;
constexpr int NPH = 18, NPHASES = 2 * NPH;

constexpr size_t MiB = 1ull << 20;
constexpr size_t WS_CTL = 0, CTL_ZERO_BYTES = 1 * MiB;
constexpr size_t WS_E12 = 1 * MiB;
constexpr size_t WS_G12 = WS_E12 + 256 * 1024;
constexpr size_t WS_POS = WS_G12 + 256 * 1024;
constexpr size_t WS_GB = 2 * MiB;
constexpr size_t WS_W = 16 * MiB;
constexpr size_t WS_W2 = 912 * MiB;
constexpr size_t W_IN = WS_W2, W_OUT = WS_W2 + 13 * MiB, W_GU = WS_W2 + 17 * MiB, W_D = WS_W2 + 31 * MiB;
constexpr size_t W_QKV = WS_W, W_O = WS_W + 6 * MiB, W_MGU = WS_W + 8 * MiB, W_MD = WS_W + 120 * MiB;
constexpr size_t WS_HB = 192 * MiB;
constexpr size_t WS_BIG = 256 * MiB;
constexpr size_t WS_ZB = WS_BIG, WS_RAW = WS_BIG + 128 * MiB, WS_QKVC = WS_BIG + 400 * MiB;
constexpr int RAWLD = 4352;
constexpr size_t WS_WMEM = WS_RAW, WS_IMEM = WS_RAW + 128 * MiB, WS_KTMEM = WS_RAW + 192 * MiB;
constexpr size_t WS_STATS = 12 * MiB;
constexpr size_t WS_GTAB = 6 * MiB;
constexpr size_t WS_ACT = WS_BIG;
constexpr size_t WS_QKV = WS_BIG, WS_AO = WS_BIG + 192 * MiB;
constexpr size_t WS_XS = WS_BIG, WS_MACT = WS_BIG + 132 * MiB;
constexpr size_t WS_YT = 850 * MiB;
constexpr size_t WS_END = 950 * MiB;
static_assert(WS_QKVC + (size_t)TT * 4096 * 2 <= WS_W2 && WS_MACT + (size_t)MOE_ROWS * FF * 2 <= WS_END && WS_RAW + (size_t)TT * RAWLD * 2 <= WS_QKVC && WS_KTMEM + (size_t)4096 * 8192 * 2 <= WS_QKVC && WS_GTAB + (size_t)8192 * 192 * 4 <= WS_W, "d_ws map");
static_assert(W_MD + (size_t)NE * D * FF * 2 <= WS_HB && W_IN + (size_t)GINP * D * 2 <= W_OUT && W_D + (size_t)D * FF * 2 <= WS_END && WS_QKVC + (size_t)TT * 4096 * 2 <= WS_W2 && W_MGU + (size_t)NE * 2 * FF * D * 2 <= W_MD, "weight map");
constexpr int CW_BAR = 4096;
constexpr int CW_CNT = 16384;

constexpr int RING_BYTES = 131072;
constexpr int MISC_OFF = RING_BYTES + 320;
constexpr int OGST_OFF = 147456;
#define SEC_IN(k) do { if (PROBE_SEC == (k)) { if (blockIdx.x == 0 && (threadIdx.x == 0)) ((volatile LAS unsigned*)((LAS unsigned char*)0 + MISC_OFF))[20] -= (unsigned)__builtin_amdgcn_s_memrealtime(); } } while (0)
#define SEC_OUT(k) do { if (PROBE_SEC == (k)) { if (blockIdx.x == 0 && (threadIdx.x == 0)) ((volatile LAS unsigned*)((LAS unsigned char*)0 + MISC_OFF))[20] += (unsigned)__builtin_amdgcn_s_memrealtime(); } } while (0)
constexpr int LDS_BYTES = 163840;

#define GAS __attribute__((address_space(1)))
#define LAS __attribute__((address_space(3)))
#define DI __device__ __forceinline__
typedef unsigned short bf16;
typedef unsigned v4u __attribute__((ext_vector_type(4)));
typedef unsigned v2u __attribute__((ext_vector_type(2)));
typedef float f32x4 __attribute__((ext_vector_type(4)));
typedef float f32x2 __attribute__((ext_vector_type(2)));
typedef GAS unsigned gu32;
#define RLX_AGENT __ATOMIC_RELAXED, __HIP_MEMORY_SCOPE_AGENT
#define LDS_WAIT() asm volatile("s_waitcnt lgkmcnt(0)" ::: "memory")
#define VM_WAIT() asm volatile("s_waitcnt vmcnt(0)" ::: "memory")
__device__ __forceinline__ unsigned long long rt() { return __builtin_amdgcn_s_memrealtime(); }
__device__ __forceinline__ unsigned f2bf(float f) { unsigned u = __builtin_bit_cast(unsigned, f); return (u + 0x7fffu + ((u >> 16) & 1u)) >> 16; }
__device__ __forceinline__ unsigned pk2(float lo, float hi) { return f2bf(lo) | (f2bf(hi) << 16); }

#define XB_TMO      128
#define XB_XCNT(j)  (256  + 64 * (j))
#define XB_XSUB(j)  (1280 + 64 * (j))
#define XB_XGEN(j)  (2304 + 64 * (j))
#define XB_TOP      3328
#define XB_TOPGEN   3392
#define XCD_BAR_WORDS 3456
#define XB_SPIN_CAP (1u << 22)

__device__ __forceinline__ unsigned xb_ld(unsigned* p)              { return __hip_atomic_load(p, __ATOMIC_RELAXED, __HIP_MEMORY_SCOPE_AGENT); }
__device__ __forceinline__ unsigned xb_add(unsigned* p, unsigned v) { return __hip_atomic_fetch_add(p, v, __ATOMIC_RELAXED, __HIP_MEMORY_SCOPE_AGENT); }
__device__ __forceinline__ unsigned xb_xcc_id() { return (unsigned)__builtin_amdgcn_s_getreg((3 << 11) | 20) & 0xFu; }
#define XB_SPIN(cond, bar) do { unsigned _sp = 0; while (cond) { __builtin_amdgcn_s_sleep(1); \
    if ((++_sp & 255u) == 0u) { if (xb_ld(&(bar)[XB_TMO])) break; if (_sp > XB_SPIN_CAP) { atomicAdd(&(bar)[XB_TMO], 1u); break; } } } } while (0)

struct XcdBarrier {
    unsigned* bar; unsigned x;
    volatile LAS unsigned* st;
};

__device__ __forceinline__ XcdBarrier xcd_barrier_post(unsigned* bar, volatile LAS unsigned* st) {
    XcdBarrier b; b.bar = bar; b.x = xb_xcc_id(); b.st = st;
    if (threadIdx.x == 0) (void)xb_add(&bar[XB_XCNT(b.x)], 1u);
    return b;
}
__device__ __forceinline__ void xcd_barrier_complete(unsigned* bar, unsigned x, unsigned& nloc, unsigned& nx) {
    const unsigned G = gridDim.x * gridDim.y * gridDim.z;
    unsigned sum, cnt, mine, sp = 0u;
    for (;;) {
        sum = 0u; cnt = 0u; mine = 0u;
#pragma unroll
        for (unsigned j = 0; j < 16; ++j) { const unsigned c = xb_ld(&bar[XB_XCNT(j)]); sum += c; cnt += (c > 0u) ? 1u : 0u; mine = (j == x) ? c : mine; }
        if (sum == G) break;
        __builtin_amdgcn_s_sleep(1);
        if ((++sp & 255u) == 0u) { if (xb_ld(&bar[XB_TMO])) break; if (sp > XB_SPIN_CAP) { atomicAdd(&bar[XB_TMO], 1u); break; } }
    }
    nloc = mine > 0u ? mine : 1u; nx = cnt > 0u ? cnt : 1u;
}

__device__ __forceinline__ void xcd_barrier(const XcdBarrier& b) {
    asm volatile("s_waitcnt vmcnt(0)" ::: "memory");
    __syncthreads();
    if (threadIdx.x == 0) {
        unsigned* bar = b.bar;
        __builtin_amdgcn_s_waitcnt(0);
        unsigned nloc = b.st[0], nx = b.st[1];
        if (nloc == 0u) { xcd_barrier_complete(bar, b.x, nloc, nx); b.st[0] = nloc; b.st[1] = nx; }
        const unsigned old = xb_add(&bar[XB_XSUB(b.x)], 1u);
        const unsigned gen = old / nloc;
        if (old + 1u == (gen + 1u) * nloc) {
            __builtin_amdgcn_fence(__ATOMIC_RELEASE, "agent");
            asm volatile("s_waitcnt vmcnt(0)" ::: "memory");
            const unsigned og = xb_add(&bar[XB_TOP], 1u);
            const unsigned tg = og / nx;
            if (og + 1u == (tg + 1u) * nx) xb_add(&bar[XB_TOPGEN], 1u);
            else XB_SPIN(xb_ld(&bar[XB_TOPGEN]) == tg, bar);
            __builtin_amdgcn_fence(__ATOMIC_ACQUIRE, "agent");
            xb_add(&bar[XB_XGEN(b.x)], 1u);
            asm volatile("s_waitcnt vmcnt(0)" ::: "memory");
        } else {
            XB_SPIN(xb_ld(&bar[XB_XGEN(b.x)]) == gen, bar);
            __builtin_amdgcn_fence(__ATOMIC_ACQUIRE, "agent");
            asm volatile("s_waitcnt vmcnt(0)" ::: "memory");
        }
    }
    __syncthreads();
}

DI float bf_lo(unsigned w) { return __uint_as_float(w << 16); }
DI float bf_hi(unsigned w) { return __uint_as_float(w & 0xffff0000u); }
DI float wave_sum(float v) {
    v += __builtin_bit_cast(float, __builtin_amdgcn_update_dpp(0, __builtin_bit_cast(int, v), 0xB1, 0xF, 0xF, false));
    v += __builtin_bit_cast(float, __builtin_amdgcn_update_dpp(0, __builtin_bit_cast(int, v), 0x4E, 0xF, 0xF, false));
    v += __builtin_bit_cast(float, __builtin_amdgcn_update_dpp(0, __builtin_bit_cast(int, v), 0x141, 0xF, 0xF, false));
    v += __builtin_bit_cast(float, __builtin_amdgcn_update_dpp(0, __builtin_bit_cast(int, v), 0x140, 0xF, 0xF, false));
    v += __builtin_bit_cast(float, __builtin_amdgcn_update_dpp(0, __builtin_bit_cast(int, v), 0x142, 0xA, 0xF, false));
    v += __builtin_bit_cast(float, __builtin_amdgcn_update_dpp(0, __builtin_bit_cast(int, v), 0x143, 0xC, 0xF, false));
    return __builtin_bit_cast(float, __builtin_amdgcn_readlane(__builtin_bit_cast(int, v), 63));
}
DI float sigmoid_f(float x) { return 1.0f / (1.0f + __expf(-x)); }

struct Args {
    const float *x, *gdn_w_in, *gdn_conv_w, *gdn_a_log, *gdn_dt_bias, *gdn_norm_w, *gdn_w_out, *sb_w_in, *sb_w_out, *ffn_w_gate, *ffn_w_up, *ffn_w_down,
                *moe_router, *moe_w_gate, *moe_w_up, *moe_w_down, *ln_g, *ln_b;
    float* out; unsigned char* ws; int ph_lo, ph_hi;
};

DI void transpose_item(const float* W, int ldw, bf16* WT, int K, int drow0, int k0, int n0, LAS float* scr, int lane) {
#pragma unroll 8
    for (int i = 0; i < 32; ++i) { const int kk = 2 * i + (lane >> 5); scr[kk * 33 + (lane & 31)] = W[(size_t)(k0 + kk) * ldw + n0 + (lane & 31)]; }
    LDS_WAIT(); asm volatile("" ::: "memory");
    const int c = lane & 7;
#pragma unroll
    for (int jj = 0; jj < 4; ++jj) { const int n = (lane >> 3) + 8 * jj; const LAS float* s = scr + (8 * c) * 33 + n;
        v4u o; o.x = pk2(s[0 * 33], s[1 * 33]); o.y = pk2(s[2 * 33], s[3 * 33]); o.z = pk2(s[4 * 33], s[5 * 33]); o.w = pk2(s[6 * 33], s[7 * 33]);
        *(v4u*)(WT + (size_t)(drow0 + n) * K + k0 + 8 * c) = o; }
    LDS_WAIT(); asm volatile("" ::: "memory");
}

DI void transpose_item64(const float* W, int ldw, bf16* WT, int K, int drow0, int k0, int n0, LAS unsigned char* scr, int lane) {
    const int q = lane >> 4, cx = lane & 15;
    f32x4 r[16];
#pragma unroll
    for (int i = 0; i < 16; ++i) r[i] = *(const f32x4*)(W + (size_t)(k0 + 16 * q + i) * ldw + n0 + 4 * cx);
#pragma unroll
    for (int e = 0; e < 4; ++e) {
        v4u w0, w1;
        w0.x = pk2(r[0][e], r[1][e]); w0.y = pk2(r[2][e], r[3][e]); w0.z = pk2(r[4][e], r[5][e]); w0.w = pk2(r[6][e], r[7][e]);
        w1.x = pk2(r[8][e], r[9][e]); w1.y = pk2(r[10][e], r[11][e]); w1.z = pk2(r[12][e], r[13][e]); w1.w = pk2(r[14][e], r[15][e]);
        *(LAS v4u*)(scr + (4 * cx + e) * 144 + q * 32) = w0; *(LAS v4u*)(scr + (4 * cx + e) * 144 + q * 32 + 16) = w1;
    }
    LDS_WAIT(); asm volatile("" ::: "memory");
#pragma unroll
    for (int j = 0; j < 8; ++j) { const int id = lane + 64 * j, n = id >> 3, kp = id & 7;
        *(v4u*)(WT + (size_t)(drow0 + n) * K + k0 + 8 * kp) = *(const LAS v4u*)(scr + n * 144 + kp * 16); }
    LDS_WAIT(); asm volatile("" ::: "memory");
}

DI void phase_w_gdn(const Args& a, int j, LAS unsigned char* lds, int bid, int G, int tid, int wave, int lane) {
    LAS float* scr = (LAS float*)(lds + wave * 16384);
    const int gw = bid * NWAVES + wave, NGW = G * NWAVES;
    const float* Win = a.gdn_w_in + (size_t)j * D * GIN; const float* Wout = a.gdn_w_out + (size_t)j * 2048 * D;
    const float* Wg = a.ffn_w_gate + (size_t)j * D * FF; const float* Wu = a.ffn_w_up + (size_t)j * D * FF; const float* Wd = a.ffn_w_down + (size_t)j * FF * D;
    bf16* WIN_T = (bf16*)(a.ws + W_IN); bf16* WOUT_T = (bf16*)(a.ws + W_OUT); bf16* WGU_T = (bf16*)(a.ws + W_GU); bf16* WD_T = (bf16*)(a.ws + W_D);
    LAS unsigned char* scb = (LAS unsigned char*)scr;
    constexpr int I_IN = 16 * 96, I_INT = 16, I_OUT = 32 * 16, I_G = 16 * 56, I_D = 56 * 16, NIT = I_IN + I_INT + I_OUT + 2 * I_G + I_D;
    for (int it = gw; it < NIT; it += NGW) {
        int r = it;
        if (r < I_IN) { const int kb = r / 96, nb = r % 96; transpose_item64(Win, GIN, WIN_T, D, 64 * nb, 64 * kb, 64 * nb, scb, lane); continue; } r -= I_IN;
        if (r < I_INT) { transpose_item(Win, GIN, WIN_T, D, 6144, 64 * r, 6144, scr, lane); continue; } r -= I_INT;
        if (r < I_OUT) { const int kb = r / 16, nb = r % 16; transpose_item64(Wout, D, WOUT_T, 2048, 64 * nb, 64 * kb, 64 * nb, scb, lane); continue; } r -= I_OUT;
        if (r < I_G) { const int kb = r / 56, nb = r % 56, n0 = 64 * nb; transpose_item64(Wg, FF, WGU_T, D, 256 * (n0 >> 7) + (n0 & 127), 64 * kb, n0, scb, lane); continue; } r -= I_G;
        if (r < I_G) { const int kb = r / 56, nb = r % 56, n0 = 64 * nb; transpose_item64(Wu, FF, WGU_T, D, 256 * (n0 >> 7) + 128 + (n0 & 127), 64 * kb, n0, scb, lane); continue; } r -= I_G;
        { const int kb = r / 16, nb = r % 16; transpose_item64(Wd, D, WD_T, FF, 64 * nb, 64 * kb, 64 * nb, scb, lane); }
    }
    if (j == 0) {
        bf16* HB = (bf16*)(a.ws + WS_HB); const f32x4* x4 = (const f32x4*)a.x;
        for (size_t i = (size_t)bid * 512 + tid; i < (size_t)TT * D / 8; i += (size_t)G * 512) { const f32x4 p = x4[2 * i], q = x4[2 * i + 1];
            v4u o; o.x = pk2(p[0], p[1]); o.y = pk2(p[2], p[3]); o.z = pk2(q[0], q[1]); o.w = pk2(q[2], q[3]); *(v4u*)(HB + 8 * i) = o; }
    }
}
DI void phase_w_sb(const Args& a, int j, LAS unsigned char* lds, int bid, int G, int wave, int lane) {
    LAS float* scr = (LAS float*)(lds + wave * 16384);
    const int gw = bid * NWAVES + wave, NGW = G * NWAVES;
    const float* Wqkv = a.sb_w_in + (size_t)j * D * 3072; const float* Wo = a.sb_w_out + (size_t)j * D * D;
    const float* Mg = a.moe_w_gate + (size_t)j * NE * D * FF; const float* Mu = a.moe_w_up + (size_t)j * NE * D * FF; const float* Md = a.moe_w_down + (size_t)j * NE * FF * D;
    bf16* WQKV_T = (bf16*)(a.ws + W_QKV); bf16* WO_T = (bf16*)(a.ws + W_O); bf16* MGU_T = (bf16*)(a.ws + W_MGU); bf16* MD_T = (bf16*)(a.ws + W_MD);
    LAS unsigned char* scb = (LAS unsigned char*)scr;
    constexpr int I_QKV = 16 * 48, I_O = 16 * 16, I_G = 16 * 56, I_D = 56 * 16, I_E = 2 * I_G + I_D, NIT = I_QKV + I_O + NE * I_E;
    for (int it = gw; it < NIT; it += NGW) {
        int r = it;
        if (r < I_QKV) { const int kb = r / 48, nb = r % 48; transpose_item64(Wqkv, 3072, WQKV_T, D, 64 * nb, 64 * kb, 64 * nb, scb, lane); continue; } r -= I_QKV;
        if (r < I_O) { const int kb = r / 16, nb = r % 16; transpose_item64(Wo, D, WO_T, D, 64 * nb, 64 * kb, 64 * nb, scb, lane); continue; } r -= I_O;
        const int e = r / I_E; r -= e * I_E;
        bf16* gu = MGU_T + (size_t)e * 2 * FF * D; bf16* dn = MD_T + (size_t)e * D * FF;
        if (r < I_G) { const int kb = r / 56, nb = r % 56, n0 = 64 * nb; transpose_item64(Mg + (size_t)e * D * FF, FF, gu, D, 256 * (n0 >> 7) + (n0 & 127), 64 * kb, n0, scb, lane); continue; } r -= I_G;
        if (r < I_G) { const int kb = r / 56, nb = r % 56, n0 = 64 * nb; transpose_item64(Mu + (size_t)e * D * FF, FF, gu, D, 256 * (n0 >> 7) + 128 + (n0 & 127), 64 * kb, n0, scb, lane); continue; } r -= I_G;
        { const int kb = r / 16, nb = r % 16; transpose_item64(Md + (size_t)e * FF * D, D, dn, FF, 64 * nb, 64 * kb, 64 * nb, scb, lane); }
    }
}

DI float dpp_sum16(float v) {
    v += __builtin_bit_cast(float, __builtin_amdgcn_update_dpp(0, __builtin_bit_cast(int, v), 0xB1, 0xF, 0xF, false));
    v += __builtin_bit_cast(float, __builtin_amdgcn_update_dpp(0, __builtin_bit_cast(int, v), 0x4E, 0xF, 0xF, false));
    v += __builtin_bit_cast(float, __builtin_amdgcn_update_dpp(0, __builtin_bit_cast(int, v), 0x141, 0xF, 0xF, false));
    v += __builtin_bit_cast(float, __builtin_amdgcn_update_dpp(0, __builtin_bit_cast(int, v), 0x140, 0xF, 0xF, false));
    return v;
}
DI void phase_conv(const Args& a, int j, int bid, int G, int tid) {
    const bf16* raw = (const bf16*)(a.ws + WS_RAW); bf16* qkvc = (bf16*)(a.ws + WS_QKVC); float* gb = (float*)(a.ws + WS_GB);
    const float* cw = a.gdn_conv_w + (size_t)j * 4 * 4096;
    const int ch = 8 * tid;
    float w0[8], w1[8], w2[8], w3[8];
#pragma unroll
    for (int i = 0; i < 8; ++i) { w0[i] = cw[ch + i]; w1[i] = cw[4096 + ch + i]; w2[i] = cw[2 * 4096 + ch + i]; w3[i] = cw[3 * 4096 + ch + i]; }
    const float post = tid < 128 ? 0.08838834764831845f : 1.0f;
    for (int run = bid; run < TT / 128; run += G) {
        const int t0 = run * 128; const bool first = (t0 & (SEQ - 1)) == 0;
        float xa[8], xb[8], xc[8];
        { v4u h0 = {0u, 0u, 0u, 0u}, h1 = h0, h2 = h0;
          if (!first) { h0 = *(const v4u*)(raw + (size_t)(t0 - 3) * RAWLD + ch); h1 = *(const v4u*)(raw + (size_t)(t0 - 2) * RAWLD + ch); h2 = *(const v4u*)(raw + (size_t)(t0 - 1) * RAWLD + ch); }
          xa[0] = bf_lo(h0.x); xa[1] = bf_hi(h0.x); xa[2] = bf_lo(h0.y); xa[3] = bf_hi(h0.y); xa[4] = bf_lo(h0.z); xa[5] = bf_hi(h0.z); xa[6] = bf_lo(h0.w); xa[7] = bf_hi(h0.w);
          xb[0] = bf_lo(h1.x); xb[1] = bf_hi(h1.x); xb[2] = bf_lo(h1.y); xb[3] = bf_hi(h1.y); xb[4] = bf_lo(h1.z); xb[5] = bf_hi(h1.z); xb[6] = bf_lo(h1.w); xb[7] = bf_hi(h1.w);
          xc[0] = bf_lo(h2.x); xc[1] = bf_hi(h2.x); xc[2] = bf_lo(h2.y); xc[3] = bf_hi(h2.y); xc[4] = bf_lo(h2.z); xc[5] = bf_hi(h2.z); xc[6] = bf_lo(h2.w); xc[7] = bf_hi(h2.w); }
#pragma unroll 1
        for (int tb = 0; tb < 128; tb += 8) {
            v4u xr[8];
#pragma unroll
            for (int u = 0; u < 8; ++u) xr[u] = *(const v4u*)(raw + (size_t)(t0 + tb + u) * RAWLD + ch);
#pragma unroll
            for (int u = 0; u < 8; ++u) {
                float xd[8]; xd[0] = bf_lo(xr[u].x); xd[1] = bf_hi(xr[u].x); xd[2] = bf_lo(xr[u].y); xd[3] = bf_hi(xr[u].y); xd[4] = bf_lo(xr[u].z); xd[5] = bf_hi(xr[u].z); xd[6] = bf_lo(xr[u].w); xd[7] = bf_hi(xr[u].w);
                float y[8]; float ss = 0.f;
#pragma unroll
                for (int i = 0; i < 8; ++i) { const float c = w0[i] * xa[i] + w1[i] * xb[i] + w2[i] * xc[i] + w3[i] * xd[i];
                    y[i] = c * __builtin_amdgcn_rcpf(1.0f + __builtin_amdgcn_exp2f(-1.4426950408889634f * c)); ss += y[i] * y[i];
                    xa[i] = xb[i]; xb[i] = xc[i]; xc[i] = xd[i]; }
                if (tid < 256) {
                    const float rn = post / sqrtf(dpp_sum16(ss) + RMS_EPS);
#pragma unroll
                    for (int i = 0; i < 8; ++i) y[i] *= rn;
                }
                v4u o; o.x = pk2(y[0], y[1]); o.y = pk2(y[2], y[3]); o.z = pk2(y[4], y[5]); o.w = pk2(y[6], y[7]);
                *(v4u*)(qkvc + (size_t)(t0 + tb + u) * 4096 + ch) = o;
            }
        }
#pragma unroll
        for (int k = 0; k < 4; ++k) { const int item = tid + 512 * k, tok = t0 + (item >> 4), hv = item & 15;
            const float bb = __uint_as_float((unsigned)raw[(size_t)tok * RAWLD + 4096 + hv] << 16), aa = __uint_as_float((unsigned)raw[(size_t)tok * RAWLD + 4112 + hv] << 16);
            const float xx = aa + a.gdn_dt_bias[j * 16 + hv];
            const float sp = xx > 20.f ? xx : log1pf(__expf(xx));
            gb[(size_t)tok * 32 + hv] = -__expf(a.gdn_a_log[j * 16 + hv]) * sp;
            gb[(size_t)tok * 32 + 16 + hv] = sigmoid_f(bb); }
    }
}

DI void phase_gdn_naive(const Args& a, int j, LAS unsigned char* lds, int bid, int tid) {
    if (bid >= BATCH * HV) return;
    const int b = bid / HV, hv = bid % HV, hk = hv / 2, jc = tid & 127, r = tid >> 7;
    const bf16* zb = (const bf16*)(a.ws + WS_ZB); bf16* qkvc = (bf16*)(a.ws + WS_QKVC); const float* gb = (const float*)(a.ws + WS_GB);
    LAS float* qs = (LAS float*)lds; LAS float* ks = qs + 2048; LAS float* vs = ks + 2048; LAS float* gs = vs + 2048; LAS float* bs = gs + 16;
    LAS f32x2* red = (LAS f32x2*)(lds + 32768); LAS float* redkq = (LAS float*)(lds + 32768 + 8192); LAS float* ob = (LAS float*)(lds + 49152);
    float S[32];
#pragma unroll
    for (int i = 0; i < 32; ++i) S[i] = 0.f;
    const int lrow = tid >> 5, lcol = (tid & 31) * 4;
    for (int blk = 0; blk < SEQ / 16; ++blk) {
        const size_t t0 = (size_t)b * SEQ + blk * 16;
        __syncthreads();
        { const bf16* rowp = qkvc + (t0 + lrow) * 4096;
          const v2u qv = *(const v2u*)(rowp + hk * 128 + lcol), kv = *(const v2u*)(rowp + 1024 + hk * 128 + lcol), vv = *(const v2u*)(rowp + 2048 + hv * 128 + lcol);
          *(LAS f32x4*)(qs + lrow * 128 + lcol) = (f32x4){bf_lo(qv.x), bf_hi(qv.x), bf_lo(qv.y), bf_hi(qv.y)};
          *(LAS f32x4*)(ks + lrow * 128 + lcol) = (f32x4){bf_lo(kv.x), bf_hi(kv.x), bf_lo(kv.y), bf_hi(kv.y)};
          *(LAS f32x4*)(vs + lrow * 128 + lcol) = (f32x4){bf_lo(vv.x), bf_hi(vv.x), bf_lo(vv.y), bf_hi(vv.y)};
          if (tid < 16) { gs[tid] = __expf(gb[(t0 + tid) * 32 + hv]); bs[tid] = gb[(t0 + tid) * 32 + 16 + hv]; } }
        __syncthreads();
#pragma unroll 1
        for (int tt = 0; tt < 16; ++tt) {
            float pk = 0.f, pq = 0.f, pkq = 0.f;
#pragma unroll
            for (int i4 = 0; i4 < 8; ++i4) { const f32x4 k4 = *(const LAS f32x4*)(ks + tt * 128 + 32 * r + 4 * i4), q4 = *(const LAS f32x4*)(qs + tt * 128 + 32 * r + 4 * i4);
#pragma unroll
                for (int c = 0; c < 4; ++c) { pk += k4[c] * S[4 * i4 + c]; pq += q4[c] * S[4 * i4 + c]; pkq += k4[c] * q4[c]; } }
            const int buf = tt & 1;
            red[(buf * 4 + r) * 128 + jc] = (f32x2){pk, pq}; if (jc == 0) redkq[buf * 4 + r] = pkq;
            __syncthreads();
            float kS = 0.f, qS = 0.f, kq = 0.f;
#pragma unroll
            for (int rr = 0; rr < 4; ++rr) { const f32x2 p = red[(buf * 4 + rr) * 128 + jc]; kS += p.x; qS += p.y; kq += redkq[buf * 4 + rr]; }
            const float eg = gs[tt], vn = bs[tt] * (vs[tt * 128 + jc] - eg * kS);
#pragma unroll
            for (int i4 = 0; i4 < 8; ++i4) { const f32x4 k4 = *(const LAS f32x4*)(ks + tt * 128 + 32 * r + 4 * i4);
#pragma unroll
                for (int c = 0; c < 4; ++c) S[4 * i4 + c] = eg * S[4 * i4 + c] + k4[c] * vn; }
            if (r == 0) ob[tt * 128 + jc] = eg * qS + kq * vn;
        }
        __syncthreads();
        {
            const f32x4 o4 = *(const LAS f32x4*)(ob + lrow * 128 + lcol);
            float ss = o4[0] * o4[0] + o4[1] * o4[1] + o4[2] * o4[2] + o4[3] * o4[3];
            ss += __shfl_xor(ss, 1); ss += __shfl_xor(ss, 2); ss += __shfl_xor(ss, 4); ss += __shfl_xor(ss, 8); ss += __shfl_xor(ss, 16);
            const float rinv = 1.0f / sqrtf(ss * (1.0f / 128.0f) + RMS_EPS);
            const v2u zv = *(const v2u*)(zb + (t0 + lrow) * 2048 + hv * 128 + lcol);
            const f32x4 nw = *(const f32x4*)(a.gdn_norm_w + j * 128 + lcol);
            const float z0 = bf_lo(zv.x), z1 = bf_hi(zv.x), z2 = bf_lo(zv.y), z3 = bf_hi(zv.y);
            v2u o; o.x = pk2(o4[0] * rinv * nw[0] * z0 * sigmoid_f(z0), o4[1] * rinv * nw[1] * z1 * sigmoid_f(z1));
            o.y = pk2(o4[2] * rinv * nw[2] * z2 * sigmoid_f(z2), o4[3] * rinv * nw[3] * z3 * sigmoid_f(z3));
            *(v2u*)(qkvc + (t0 + lrow) * 4096 + 2048 + hv * 128 + lcol) = o;
        }
    }
}

DI void unpack8(const v4u w, float (&x)[8]) { x[0] = bf_lo(w.x); x[1] = bf_hi(w.x); x[2] = bf_lo(w.y); x[3] = bf_hi(w.y); x[4] = bf_lo(w.z); x[5] = bf_hi(w.z); x[6] = bf_lo(w.w); x[7] = bf_hi(w.w); }
template <bool ROUTER>
DI void phase_ln(const Args& a, const bf16* Y, int lnidx, int j, LAS unsigned char* lds, int bid, int G, int tid, int wave, int lane) {
    bf16* HB = (bf16*)(a.ws + WS_HB); float* stats = (float*)(a.ws + WS_STATS);
    const float* g = a.ln_g + (size_t)lnidx * D; const float* bta = a.ln_b + (size_t)lnidx * D;
    const int gw = bid * NWAVES + wave, NGW = G * NWAVES;
    LAS unsigned* lcnt = (LAS unsigned*)lds;
    LAS float* RT = (LAS float*)(lds + 1024);
    if (ROUTER) { if (tid < 8) lcnt[tid] = 0u;
        const float* R = a.moe_router + (size_t)j * D * NE;
#pragma unroll
        for (int i = 0; i < 2; ++i) { const int k = tid + 512 * i; const f32x4 r0 = *(const f32x4*)(R + k * 8), r1 = *(const f32x4*)(R + k * 8 + 4);
            RT[0 * 1024 + k] = r0[0]; RT[1 * 1024 + k] = r0[1]; RT[2 * 1024 + k] = r0[2]; RT[3 * 1024 + k] = r0[3]; RT[4 * 1024 + k] = r1[0]; RT[5 * 1024 + k] = r1[1]; RT[6 * 1024 + k] = r1[2]; RT[7 * 1024 + k] = r1[3]; }
        __syncthreads(); }
    float gv[2][8], bv[2][8];
#pragma unroll
    for (int q = 0; q < 2; ++q)
#pragma unroll
        for (int c = 0; c < 8; ++c) { gv[q][c] = g[8 * (lane + 64 * q) + c]; bv[q][c] = bta[8 * (lane + 64 * q) + c]; }
    v4u nx[2];
    if (gw < TT) { nx[0] = ((const v4u*)(Y + (size_t)gw * D))[lane]; nx[1] = ((const v4u*)(Y + (size_t)gw * D))[lane + 64]; }
    for (int t = gw; t < TT; t += NGW) {
        float v[2][8]; float s = 0.f;
        unpack8(nx[0], v[0]); unpack8(nx[1], v[1]);
        if (t + NGW < TT) { nx[0] = ((const v4u*)(Y + (size_t)(t + NGW) * D))[lane]; nx[1] = ((const v4u*)(Y + (size_t)(t + NGW) * D))[lane + 64]; }
#pragma unroll
        for (int q = 0; q < 2; ++q)
#pragma unroll
            for (int c = 0; c < 8; ++c) s += v[q][c];
        const float mean = wave_sum(s) * (1.0f / D); float s2 = 0.f;
#pragma unroll
        for (int q = 0; q < 2; ++q)
#pragma unroll
            for (int c = 0; c < 8; ++c) { v[q][c] -= mean; s2 += v[q][c] * v[q][c]; }
        const float rstd = 1.0f / sqrtf(wave_sum(s2) * (1.0f / D) + LN_EPS);
        if (lane == 0) *(f32x2*)(stats + 2 * (size_t)t) = (f32x2){mean, rstd};
#pragma unroll
        for (int q = 0; q < 2; ++q) {
#pragma unroll
            for (int c = 0; c < 8; ++c) v[q][c] = v[q][c] * rstd * gv[q][c] + bv[q][c];
            v4u o; o.x = pk2(v[q][0], v[q][1]); o.y = pk2(v[q][2], v[q][3]); o.z = pk2(v[q][4], v[q][5]); o.w = pk2(v[q][6], v[q][7]);
            ((v4u*)(HB + (size_t)t * D))[lane + 64 * q] = o; }
        if (ROUTER) {
            float lg[8];
#pragma unroll
            for (int e = 0; e < 8; ++e) { lg[e] = 0.f;
#pragma unroll
                for (int q = 0; q < 2; ++q) { const f32x4 r0 = *(const LAS f32x4*)(RT + e * 1024 + 8 * (lane + 64 * q)), r1 = *(const LAS f32x4*)(RT + e * 1024 + 8 * (lane + 64 * q) + 4);
                    lg[e] += (v[q][0] * r0[0] + v[q][1] * r0[1]) + (v[q][2] * r0[2] + v[q][3] * r0[3]) + (v[q][4] * r1[0] + v[q][5] * r1[1]) + (v[q][6] * r1[2] + v[q][7] * r1[3]); } }
#pragma unroll
            for (int e = 0; e < 8; ++e) lg[e] = wave_sum(lg[e]);
            int i1 = 0; float v1 = lg[0];
#pragma unroll
            for (int e = 1; e < 8; ++e) if (lg[e] > v1) { v1 = lg[e]; i1 = e; }
            int i2 = -1; float v2 = -3.0e38f;
#pragma unroll
            for (int e = 0; e < 8; ++e) if (e != i1 && lg[e] > v2) { v2 = lg[e]; i2 = e; }
            if (lane == 0) {
                const float g1 = 1.0f / (1.0f + __expf(v2 - v1));
                ((unsigned*)(a.ws + WS_E12))[t] = (unsigned)i1 | ((unsigned)i2 << 8);
                ((f32x2*)(a.ws + WS_G12))[t] = (f32x2){g1, 1.0f - g1};
                __hip_atomic_fetch_add(lcnt + i1, 1u, __ATOMIC_RELAXED, __HIP_MEMORY_SCOPE_WORKGROUP); __hip_atomic_fetch_add(lcnt + i2, 1u, __ATOMIC_RELAXED, __HIP_MEMORY_SCOPE_WORKGROUP);
            }
        }
    }
    if (ROUTER) { __syncthreads(); if (tid < 8) { unsigned* cnt = (unsigned*)(a.ws + WS_CTL) + CW_CNT + 256 * j; __hip_atomic_fetch_add(cnt + tid, lcnt[tid], __ATOMIC_RELAXED, __HIP_MEMORY_SCOPE_AGENT); } }
}

DI void phase_sb_naive(const Args& a, LAS unsigned char* lds, int bid, int G, int tid) {
    const bf16* qkv = (const bf16*)(a.ws + WS_QKV); bf16* ao = (bf16*)(a.ws + WS_AO);
    LAS unsigned char* Ks = lds; LAS unsigned char* Vs = lds + 16384;
    const int qi = tid >> 2, r = tid & 3;
    for (int idx = bid; idx < 64 * 32; idx += G) {
        const int qb = 31 - idx / 64, bh = idx % 64, b = bh >> 3, h = bh & 7;
        const int t = qb * 128 + qi;
        const size_t rowq = (size_t)b * SEQ + t;
        float q[32], o[32];
        { const bf16* qp = qkv + rowq * 3072 + h * 128 + 32 * r;
#pragma unroll
          for (int c = 0; c < 4; ++c) { const v4u w = *(const v4u*)(qp + 8 * c);
              q[8 * c + 0] = bf_lo(w.x); q[8 * c + 1] = bf_hi(w.x); q[8 * c + 2] = bf_lo(w.y); q[8 * c + 3] = bf_hi(w.y);
              q[8 * c + 4] = bf_lo(w.z); q[8 * c + 5] = bf_hi(w.z); q[8 * c + 6] = bf_lo(w.w); q[8 * c + 7] = bf_hi(w.w); }
#pragma unroll
          for (int i = 0; i < 32; ++i) { q[i] *= 0.08838834764831845f; o[i] = 0.f; } }
        float P = 1.0f;
        for (int kt = 2 * qb + 1; kt >= 0; --kt) {
            __syncthreads();
#pragma unroll
            for (int i = 0; i < 2; ++i) { const int c = tid + 512 * i, row = c >> 4, part = c & 15;
                const bf16* src = qkv + ((size_t)b * SEQ + kt * 64 + row) * 3072 + h * 128 + part * 8;
                *(LAS v4u*)(Ks + c * 16) = *(const v4u*)(src + 1024); *(LAS v4u*)(Vs + c * 16) = *(const v4u*)(src + 2048); }
            __syncthreads();
#pragma unroll 1
            for (int s = 63; s >= 0; --s) {
                float z = 0.f;
#pragma unroll
                for (int c = 0; c < 4; ++c) { const v4u w = *(const LAS v4u*)(Ks + s * 256 + r * 64 + c * 16);
                    z += q[8 * c + 0] * bf_lo(w.x) + q[8 * c + 1] * bf_hi(w.x) + q[8 * c + 2] * bf_lo(w.y) + q[8 * c + 3] * bf_hi(w.y)
                       + q[8 * c + 4] * bf_lo(w.z) + q[8 * c + 5] * bf_hi(w.z) + q[8 * c + 6] * bf_lo(w.w) + q[8 * c + 7] * bf_hi(w.w); }
                z += __shfl_xor(z, 1); z += __shfl_xor(z, 2);
                const bool live = (kt * 64 + s) < t;
                const float e = __expf(fminf(z, 80.f)), rr = 1.0f / (1.0f + e);
                const float A = live ? e * rr * P : 0.f;
                P = live ? P * rr : P;
#pragma unroll
                for (int c = 0; c < 4; ++c) { const v4u w = *(const LAS v4u*)(Vs + s * 256 + r * 64 + c * 16);
                    o[8 * c + 0] += A * bf_lo(w.x); o[8 * c + 1] += A * bf_hi(w.x); o[8 * c + 2] += A * bf_lo(w.y); o[8 * c + 3] += A * bf_hi(w.y);
                    o[8 * c + 4] += A * bf_lo(w.z); o[8 * c + 5] += A * bf_hi(w.z); o[8 * c + 6] += A * bf_lo(w.w); o[8 * c + 7] += A * bf_hi(w.w); }
            }
        }
        { bf16* op = ao + rowq * 1024 + h * 128 + 32 * r;
#pragma unroll
          for (int c = 0; c < 4; ++c) { v4u w; w.x = pk2(o[8 * c + 0], o[8 * c + 1]); w.y = pk2(o[8 * c + 2], o[8 * c + 3]); w.z = pk2(o[8 * c + 4], o[8 * c + 5]); w.w = pk2(o[8 * c + 6], o[8 * c + 7]);
              *(v4u*)(op + 8 * c) = w; } }
    }
}


typedef float f2v_ __attribute__((ext_vector_type(2)));
typedef __bf16 b2v_ __attribute__((ext_vector_type(2)));
DI unsigned gdnpk(float a, float b) { const f2v_ v = {a, b}; const b2v_ r = __builtin_convertvector(v, b2v_); return __builtin_bit_cast(unsigned, r); }
namespace sba {
using bf16x8 = __attribute__((ext_vector_type(8))) short;
using s16x4  = __attribute__((ext_vector_type(4))) short;
using f32x16 = __attribute__((ext_vector_type(16))) float;
constexpr int SHM_V = 16384, KPITCH = 272, SHM_K = 64 * KPITCH, LDQ = 3072;
#define KSWZ(row, colB) ((row) * KPITCH + (colB))
#define SBAR() __builtin_amdgcn_sched_barrier(0)
DI int crow(int r, int hi) { return (r & 3) + 8 * (r >> 2) + 4 * hi; }
DI int v_st(int k, int c) { const int kk = (k & ~0xC) | ((k & 4) << 1) | ((k & 8) >> 1); return ((kk >> 3) * 4 + (c >> 5)) * 512 + ((kk & 7) * 32 + (c & 31)) * 2; }
DI int v_rd_base(int lane) { return ((lane & 3) << 3) | (((lane >> 2) & 3) << 6) | (((lane >> 4) & 1) << 5) | (((lane >> 5) & 1) << 8); }
constexpr int v_rd_off(int d0, int ks, int half) { return d0 * 512 + ks * 4096 + half * 2048; }
template <int OFF> DI s16x4 tr_read(int vb) { s16x4 r; asm volatile("ds_read_b64_tr_b16 %0, %1 offset:%2" : "=&v"(r) : "v"(vb), "i"(OFF) : "memory"); return r; }
template <int D0> DI void pv_one(f32x16& od, int vb, bf16x8 pa0, bf16x8 pa1, bf16x8 pa2, bf16x8 pa3) {
  const s16x4 l0 = tr_read<v_rd_off(D0, 0, 0)>(vb), h0 = tr_read<v_rd_off(D0, 0, 1)>(vb), l1 = tr_read<v_rd_off(D0, 1, 0)>(vb), h1 = tr_read<v_rd_off(D0, 1, 1)>(vb);
  const s16x4 l2 = tr_read<v_rd_off(D0, 2, 0)>(vb), h2 = tr_read<v_rd_off(D0, 2, 1)>(vb), l3 = tr_read<v_rd_off(D0, 3, 0)>(vb), h3 = tr_read<v_rd_off(D0, 3, 1)>(vb);
  asm volatile("s_waitcnt lgkmcnt(0)" ::: "memory"); SBAR();
#define PK(L, H) (bf16x8){L[0], L[1], L[2], L[3], H[0], H[1], H[2], H[3]}
  od = __builtin_amdgcn_mfma_f32_32x32x16_bf16(pa0, PK(l0, h0), od, 0, 0, 0);
  od = __builtin_amdgcn_mfma_f32_32x32x16_bf16(pa1, PK(l1, h1), od, 0, 0, 0);
  od = __builtin_amdgcn_mfma_f32_32x32x16_bf16(pa2, PK(l2, h2), od, 0, 0, 0);
  od = __builtin_amdgcn_mfma_f32_32x32x16_bf16(pa3, PK(l3, h3), od, 0, 0, 0);
#undef PK
}
template <int D0> DI void pv_one_T(f32x16& od, int vb, bf16x8 pa0, bf16x8 pa1, bf16x8 pa2, bf16x8 pa3) {
  const s16x4 l0 = tr_read<v_rd_off(D0, 0, 0)>(vb), h0 = tr_read<v_rd_off(D0, 0, 1)>(vb), l1 = tr_read<v_rd_off(D0, 1, 0)>(vb), h1 = tr_read<v_rd_off(D0, 1, 1)>(vb);
  const s16x4 l2 = tr_read<v_rd_off(D0, 2, 0)>(vb), h2 = tr_read<v_rd_off(D0, 2, 1)>(vb), l3 = tr_read<v_rd_off(D0, 3, 0)>(vb), h3 = tr_read<v_rd_off(D0, 3, 1)>(vb);
  asm volatile("s_waitcnt lgkmcnt(0)" ::: "memory"); SBAR();
#define PK(L, H) (bf16x8){L[0], L[1], L[2], L[3], H[0], H[1], H[2], H[3]}
  od = __builtin_amdgcn_mfma_f32_32x32x16_bf16(PK(l0, h0), pa0, od, 0, 0, 0);
  od = __builtin_amdgcn_mfma_f32_32x32x16_bf16(PK(l1, h1), pa1, od, 0, 0, 0);
  od = __builtin_amdgcn_mfma_f32_32x32x16_bf16(PK(l2, h2), pa2, od, 0, 0, 0);
  od = __builtin_amdgcn_mfma_f32_32x32x16_bf16(PK(l3, h3), pa3, od, 0, 0, 0);
#undef PK
}
DI void pv_split(f32x16& od, int vb, bf16x8 pa0, bf16x8 pa1, bf16x8 pa2, bf16x8 pa3) {
  const s16x4 l0 = tr_read<v_rd_off(0, 0, 0)>(vb), h0 = tr_read<v_rd_off(0, 0, 1)>(vb), l1 = tr_read<v_rd_off(0, 1, 0)>(vb), h1 = tr_read<v_rd_off(0, 1, 1)>(vb);
  const s16x4 l2 = tr_read<v_rd_off(0, 2, 0)>(vb), h2 = tr_read<v_rd_off(0, 2, 1)>(vb), l3 = tr_read<v_rd_off(0, 3, 0)>(vb), h3 = tr_read<v_rd_off(0, 3, 1)>(vb);
  asm volatile("s_waitcnt lgkmcnt(0)" ::: "memory"); SBAR();
#define PK(L, H) (bf16x8){L[0], L[1], L[2], L[3], H[0], H[1], H[2], H[3]}
  f32x16 ob = {};
  od = __builtin_amdgcn_mfma_f32_32x32x16_bf16(pa0, PK(l0, h0), od, 0, 0, 0); ob = __builtin_amdgcn_mfma_f32_32x32x16_bf16(pa2, PK(l2, h2), ob, 0, 0, 0);
  od = __builtin_amdgcn_mfma_f32_32x32x16_bf16(pa1, PK(l1, h1), od, 0, 0, 0); ob = __builtin_amdgcn_mfma_f32_32x32x16_bf16(pa3, PK(l3, h3), ob, 0, 0, 0);
  od = od + ob;
#undef PK
}
DI void pv_split_T(f32x16& od, int vb, bf16x8 pa0, bf16x8 pa1, bf16x8 pa2, bf16x8 pa3) {
  const s16x4 l0 = tr_read<v_rd_off(0, 0, 0)>(vb), h0 = tr_read<v_rd_off(0, 0, 1)>(vb), l1 = tr_read<v_rd_off(0, 1, 0)>(vb), h1 = tr_read<v_rd_off(0, 1, 1)>(vb);
  const s16x4 l2 = tr_read<v_rd_off(0, 2, 0)>(vb), h2 = tr_read<v_rd_off(0, 2, 1)>(vb), l3 = tr_read<v_rd_off(0, 3, 0)>(vb), h3 = tr_read<v_rd_off(0, 3, 1)>(vb);
  asm volatile("s_waitcnt lgkmcnt(0)" ::: "memory"); SBAR();
#define PK(L, H) (bf16x8){L[0], L[1], L[2], L[3], H[0], H[1], H[2], H[3]}
  f32x16 ob = {};
  od = __builtin_amdgcn_mfma_f32_32x32x16_bf16(PK(l0, h0), pa0, od, 0, 0, 0); ob = __builtin_amdgcn_mfma_f32_32x32x16_bf16(PK(l2, h2), pa2, ob, 0, 0, 0);
  od = __builtin_amdgcn_mfma_f32_32x32x16_bf16(PK(l1, h1), pa1, od, 0, 0, 0); ob = __builtin_amdgcn_mfma_f32_32x32x16_bf16(PK(l3, h3), pa3, ob, 0, 0, 0);
  od = od + ob;
#undef PK
}
DI void qkt(f32x16& p0, f32x16& p1, const LAS unsigned char* Ks, const bf16x8 (&qr)[8], int r32, int hi) {
  p0 = f32x16{}; p1 = f32x16{};
#pragma unroll
  for (int d0 = 0; d0 < 8; ++d0) { const int cb = (d0 * 16 + hi * 8) * 2;
    const bf16x8 b0 = *(const LAS bf16x8*)(Ks + KSWZ(r32, cb));
    const bf16x8 b1 = *(const LAS bf16x8*)(Ks + KSWZ(32 + r32, cb));
    p0 = __builtin_amdgcn_mfma_f32_32x32x16_bf16(b0, qr[d0], p0, 0, 0, 0);
    p1 = __builtin_amdgcn_mfma_f32_32x32x16_bf16(b1, qr[d0], p1, 0, 0, 0); }
}
template <bool MASK> DI void sb_half(f32x16& p, float& Pc, int hi, int kbase, int trow) {
  float kk[16];
#pragma unroll
  for (int r = 0; r < 16; ++r) {
    float z = p[r];
    if (MASK) z = (kbase + crow(r, hi) < trow) ? z : -__builtin_inff();
    kk[r] = __builtin_amdgcn_rcpf(1.0f + __builtin_amdgcn_exp2f(z));
  }
  float R0[4], R1[4];
#pragma unroll
  for (int g = 0; g < 4; ++g) {
    const float c2 = kk[4 * g + 3], c1 = c2 * kk[4 * g + 2], c0 = c1 * kk[4 * g + 1], R = c0 * kk[4 * g];
    p[4 * g + 3] = 1.0f - c2; p[4 * g + 2] = c2 - c1; p[4 * g + 1] = c1 - c0; p[4 * g] = c0 - R;
    const auto sw = __builtin_amdgcn_permlane32_swap(__float_as_uint(R), __float_as_uint(R), false, false);
    R0[g] = __uint_as_float(sw[0]); R1[g] = __uint_as_float(sw[1]);
  }
#pragma unroll
  for (int g = 3; g >= 0; --g) {
    const float Pin = hi ? Pc : Pc * R1[g];
    p[4 * g + 3] *= Pin; p[4 * g + 2] *= Pin; p[4 * g + 1] *= Pin; p[4 * g] *= Pin;
    Pc *= R0[g] * R1[g];
  }
}
DI unsigned cvtpk(float lo, float hi) { unsigned r; asm volatile("v_cvt_pk_bf16_f32 %0, %1, %2" : "=v"(r) : "v"(lo), "v"(hi)); return r; }
#define PK4(P, BASE, OUT) do { const unsigned a0 = cvtpk(P[BASE + 0], P[BASE + 1]), a1 = cvtpk(P[BASE + 2], P[BASE + 3]);   \
    const unsigned b0 = cvtpk(P[BASE + 4], P[BASE + 5]), b1 = cvtpk(P[BASE + 6], P[BASE + 7]);                              \
    const auto r0 = __builtin_amdgcn_permlane32_swap(a0, b0, false, false); const auto r1 = __builtin_amdgcn_permlane32_swap(a1, b1, false, false); \
    const v4u w = {r0[0], r1[0], r0[1], r1[1]}; OUT = __builtin_bit_cast(bf16x8, w); } while (0)

DI void unit(const bf16* qkv, bf16* ao, int b, int h, int qb, LAS unsigned char* lds, int tid) {
  const int wid = __builtin_amdgcn_readfirstlane(tid >> 6), lane = tid & 63, r32 = lane & 31, hi = lane >> 5;
  const bool late = wid >= 4;
  LAS unsigned char* V_lds = lds; LAS unsigned char* K_lds = lds + 3 * SHM_V;
  const size_t rowbase = (size_t)b * SEQ; const int q0 = qb * 256, t_lo = q0 + wid * 32, trow = t_lo + r32;
  bf16x8 qr[8];
  { const bf16* Qw = qkv + (rowbase + trow) * LDQ + h * 128 + hi * 8; constexpr float C = 0.08838834764831845f * 1.4426950408889634f;
#pragma unroll
    for (int d0 = 0; d0 < 8; ++d0) { const v4u w = *(const v4u*)(Qw + d0 * 16); v4u o;
      o.x = gdnpk(bf_lo(w.x) * C, bf_hi(w.x) * C); o.y = gdnpk(bf_lo(w.y) * C, bf_hi(w.y) * C); o.z = gdnpk(bf_lo(w.z) * C, bf_hi(w.z) * C); o.w = gdnpk(bf_lo(w.w) * C, bf_hi(w.w) * C);
      qr[d0] = __builtin_bit_cast(bf16x8, o); } }
  const bf16* Kh = qkv + rowbase * LDQ + 1024 + h * 128; const bf16* Vh = Kh + 1024;
  const int sr = tid >> 4, sc = (tid & 15) * 8, vst0 = v_st(sr, sc), vst1 = v_st(32 + sr, sc);
  const int vb0 = (int)(unsigned)(size_t)V_lds + v_rd_base(lane);
  bf16x8 vs0, vs1, ks0, ks1;
  const unsigned soff = (unsigned)(sr * LDQ + sc) * 2u;
#define SLOAD(k0) do { const char* kb_ = (const char*)(Kh + (size_t)(k0) * LDQ); const char* vb_ = (const char*)(Vh + (size_t)(k0) * LDQ); \
    vs0 = *(const bf16x8*)(vb_ + soff); vs1 = *(const bf16x8*)(vb_ + (size_t)32 * LDQ * 2 + soff); ks0 = *(const bf16x8*)(kb_ + soff); ks1 = *(const bf16x8*)(kb_ + (size_t)32 * LDQ * 2 + soff); } while (0)
#define SWRITE(bb) do { *(LAS bf16x8*)(V_lds + (bb) * SHM_V + vst0) = vs0; *(LAS bf16x8*)(V_lds + (bb) * SHM_V + vst1) = vs1; const int kc = sc * 2; \
    *(LAS bf16x8*)(K_lds + (bb) * SHM_K + KSWZ(sr, kc)) = ks0; *(LAS bf16x8*)(K_lds + (bb) * SHM_K + KSWZ(32 + sr, kc)) = ks1; } while (0)
  f32x16 o[4] = {}; float Pc = 1.0f;
  f32x16 p0 = {}, p1 = {};
  const int NT = qb * 4 + 4;
  SLOAD((NT - 1) * 64);
  int bufc = 0, bufp = 0;
  for (int wi = 0; wi <= NT; ++wi) {
    const int kt = NT - 1 - wi, k0 = kt * 64;
    SEC_IN(4);
    if (wi < NT) { asm volatile("s_waitcnt vmcnt(0)" ::: "memory"); SWRITE(bufc); if (kt > 0) SLOAD(k0 - 64); }
    __syncthreads();
    SEC_OUT(4); SEC_IN(5);
    if (!late && wi < NT && k0 < t_lo + 31) { __builtin_amdgcn_s_setprio(1); qkt(p0, p1, K_lds + bufc * SHM_K, qr, r32, hi); __builtin_amdgcn_s_setprio(0); }
    { const int ka = late ? k0 + 64 : k0;
      const bool doit = late ? (wi > 0 && ka < t_lo + 31) : (wi < NT && k0 < t_lo + 31);
      if (doit) {
        bf16x8 pa0, pa1, pa2, pa3;
        if (ka + 63 >= t_lo) { sb_half<true>(p1, Pc, hi, ka + 32, trow); PK4(p1, 0, pa2); PK4(p1, 8, pa3); SBAR(); sb_half<true>(p0, Pc, hi, ka, trow); }
        else { sb_half<false>(p1, Pc, hi, ka + 32, trow); PK4(p1, 0, pa2); PK4(p1, 8, pa3); SBAR(); sb_half<false>(p0, Pc, hi, ka, trow); }
        PK4(p0, 0, pa0); PK4(p0, 8, pa1);
        const int vb = vb0 + (late ? bufp : bufc) * SHM_V;
        __builtin_amdgcn_s_setprio(1);
        pv_one<0>(o[0], vb, pa0, pa1, pa2, pa3); pv_one<1>(o[1], vb, pa0, pa1, pa2, pa3); pv_one<2>(o[2], vb, pa0, pa1, pa2, pa3); pv_one<3>(o[3], vb, pa0, pa1, pa2, pa3);
        __builtin_amdgcn_s_setprio(0);
      } }
    if (late && wi < NT && k0 < t_lo + 31) { __builtin_amdgcn_s_setprio(1); qkt(p0, p1, K_lds + bufc * SHM_K, qr, r32, hi); __builtin_amdgcn_s_setprio(0); }
    SEC_OUT(5);
    bufp = bufc; bufc = (bufc == 2) ? 0 : bufc + 1;
  }
  { bf16* Ob = ao + ((size_t)b * SEQ + qb * 256 + wid * 32) * 1024 + h * 128; const unsigned ooff = (unsigned)(4 * hi * 1024 + r32);
#pragma unroll
    for (int r = 0; r < 16; ++r)
#pragma unroll
      for (int d0 = 0; d0 < 4; ++d0) Ob[ooff + (unsigned)(((r & 3) + 8 * (r >> 2)) * 1024 + d0 * 32)] = (bf16)(cvtpk(o[d0][r], 0.f) & 0xffffu); }
#undef SLOAD
#undef SWRITE
}
#undef PK4
#undef KSWZ
#undef SBAR
}
DI void phase_sb_mfma(const Args& a, LAS unsigned char* lds, int bid, int G, int tid) {
    const bf16* qkv = (const bf16*)(a.ws + WS_QKV); bf16* ao = (bf16*)(a.ws + WS_AO);
    const int vcu = (G % 8 == 0) ? (bid % 8) * (G / 8) + bid / 8 : bid;
    for (int pi = vcu; pi < 512; pi += G) {
        const int bh = pi >> 3, p = pi & 7, b = bh >> 3, h = bh & 7;
        sba::unit(qkv, ao, b, h, 15 - p, lds, tid);
        sba::unit(qkv, ao, b, h, p, lds, tid);
    }
}


namespace gdn {
using bf16x8 = __attribute__((ext_vector_type(8))) short;
using s16x4  = __attribute__((ext_vector_type(4))) short;
using f32x16 = __attribute__((ext_vector_type(16))) float;
typedef float f2v __attribute__((ext_vector_type(2)));
typedef __bf16 b2v __attribute__((ext_vector_type(2)));
DI unsigned pk(float a, float b) { const f2v v = {a, b}; const b2v r = __builtin_convertvector(v, b2v); return __builtin_bit_cast(unsigned, r); }
DI int crow(int r, int hi) { return (r & 3) + 8 * (r >> 2) + 4 * hi; }
DI int pi_slot(int x) { return 8 * ((x >> 2) & 3) + 4 * ((x >> 4) & 1) + (x & 3); }
DI bf16x8 pack_step(const f32x16& x, int s) {
    v4u w; w.x = pk(x[8 * s + 0], x[8 * s + 1]); w.y = pk(x[8 * s + 2], x[8 * s + 3]); w.z = pk(x[8 * s + 4], x[8 * s + 5]); w.w = pk(x[8 * s + 6], x[8 * s + 7]);
    return __builtin_bit_cast(bf16x8, w);
}
DI f32x16 mm(const f32x16& P, const f32x16& Q, f32x16 acc) {
    acc = __builtin_amdgcn_mfma_f32_32x32x16_bf16(pack_step(P, 0), pack_step(Q, 0), acc, 0, 0, 0);
    acc = __builtin_amdgcn_mfma_f32_32x32x16_bf16(pack_step(P, 1), pack_step(Q, 1), acc, 0, 0, 0);
    return acc;
}
#define GPK4(P, BASE, OUT) do { const unsigned a0 = pk(P[BASE + 0], P[BASE + 1]), a1 = pk(P[BASE + 2], P[BASE + 3]);   \
    const unsigned b0 = pk(P[BASE + 4], P[BASE + 5]), b1 = pk(P[BASE + 6], P[BASE + 7]);                              \
    const auto r0 = __builtin_amdgcn_permlane32_swap(a0, b0, false, false); const auto r1 = __builtin_amdgcn_permlane32_swap(a1, b1, false, false); \
    const v4u w_ = {r0[0], r1[0], r0[1], r1[1]}; OUT = __builtin_bit_cast(bf16x8, w_); } while (0)

DI void local_unit(const Args& a, int unit, LAS unsigned char* img, LAS float* tab, int lane, bool dry) {
    const int r32 = lane & 31, hi = lane >> 5;
    const int chunk = unit & 63, bh = unit >> 6, hv = bh & 15, b = bh >> 4, hk = hv >> 1;
    const size_t t0 = (size_t)b * SEQ + chunk * 64;
    bf16* qkvc = (bf16*)(a.ws + WS_QKVC); const float* gb = (const float*)(a.ws + WS_GB);
    bf16* wmem = (bf16*)(a.ws + WS_WMEM) + (size_t)unit * 8192; bf16* imem = (bf16*)(a.ws + WS_IMEM) + (size_t)unit * 4096;
    bf16* ktmem = (bf16*)(a.ws + WS_KTMEM) + (size_t)((b * HK + hk) * 64 + chunk) * 8192; float* gtab = (float*)(a.ws + WS_GTAB) + (size_t)unit * 192;
    SEC_IN(1);
    float gc = gb[(t0 + lane) * 32 + hv]; const float be = gb[(t0 + lane) * 32 + 16 + hv];
#pragma unroll
    for (int off = 1; off < 64; off <<= 1) { const float y = __shfl_up(gc, off); if (lane >= off) gc += y; }
    const float glast = __shfl(gc, 63);
    tab[lane] = gc; tab[64 + lane] = be; tab[128 + lane] = -be * __expf(gc);
    gtab[lane] = __expf(gc); gtab[64 + lane] = __expf(glast - gc); if (lane == 0) gtab[128] = __expf(glast);
    const bf16* kbase = qkvc + t0 * 4096 + 1024 + hk * 128; const bf16* qbase = qkvc + t0 * 4096 + hk * 128; bf16* vbase = qkvc + t0 * 4096 + 2048 + hv * 128;
#define GSB() __builtin_amdgcn_sched_barrier(0)
    {
        f32x16 IT00 = {}, IT11 = {}, IT01 = {};
#pragma unroll
        for (int s = 0; s < 8; ++s) {
            const bf16x8 k0 = *(const bf16x8*)(kbase + (size_t)r32 * 4096 + 16 * s + 8 * hi), k1 = *(const bf16x8*)(kbase + (size_t)(32 + r32) * 4096 + 16 * s + 8 * hi);
            const bf16x8 q0 = *(const bf16x8*)(qbase + (size_t)r32 * 4096 + 16 * s + 8 * hi), q1 = *(const bf16x8*)(qbase + (size_t)(32 + r32) * 4096 + 16 * s + 8 * hi);
            IT00 = __builtin_amdgcn_mfma_f32_32x32x16_bf16(k0, q0, IT00, 0, 0, 0); IT11 = __builtin_amdgcn_mfma_f32_32x32x16_bf16(k1, q1, IT11, 0, 0, 0);
            IT01 = __builtin_amdgcn_mfma_f32_32x32x16_bf16(k0, q1, IT01, 0, 0, 0);
        }
#pragma unroll
        for (int I = 0; I < 2; ++I) { const int c = 32 * I + r32; const float gcc = tab[c];
#pragma unroll
            for (int J = 0; J < 2; ++J)
#pragma unroll
                for (int g = 0; g < 4; ++g) { float v[4];
#pragma unroll
                    for (int i = 0; i < 4; ++i) { const int r = 4 * g + i, cp = 32 * J + crow(r, hi);
                        const float raw = (I == 0) ? (J == 0 ? IT00[r] : 0.f) : (J == 0 ? IT01[r] : IT11[r]);
                        const float val = raw * __expf(-fabsf(gcc - tab[cp])); v[i] = (c >= cp) ? val : 0.f; }
                    v2u o; o.x = pk(v[0], v[1]); o.y = pk(v[2], v[3]);
                    *(v2u*)(imem + (unsigned)((((I * 2 + J) * 4 + g) * 64 + lane) * 4)) = o; } }
    }
    GSB();
    SEC_OUT(1); SEC_IN(2);
    f32x16 T1, T1T, T2T, T21T;
    {
        f32x16 KK = {};
#pragma unroll
        for (int s = 0; s < 8; ++s) { const bf16x8 k0 = *(const bf16x8*)(kbase + (size_t)r32 * 4096 + 16 * s + 8 * hi); KK = __builtin_amdgcn_mfma_f32_32x32x16_bf16(k0, k0, KK, 0, 0, 0); }
        f32x16 M, MT;
        { const float gb0 = tab[r32], bb0 = tab[64 + r32];
#pragma unroll
        for (int r = 0; r < 16; ++r) { const int a0 = crow(r, hi), b0 = r32; const float ke = -KK[r] * __expf(-fabsf(tab[a0] - gb0));
            const float nv = ke * tab[64 + a0], ntv = ke * bb0;
            const float n = (a0 > b0) ? nv : 0.f, nt = (b0 > a0) ? ntv : 0.f, id = (a0 == b0) ? 1.f : 0.f;
            M[r] = n; MT[r] = nt; T1[r] = id + n; T1T[r] = id + nt; } }
#pragma unroll
        for (int it = 0; it < 4; ++it) { const f32x16 z = {};
            const f32x16 Mn = mm(MT, M, z), MTn = mm(M, MT, z);
            const f32x16 Tn = mm(T1T, Mn, T1);
            T1T = mm(Mn, T1T, T1T);
            T1 = Tn; M = Mn; MT = MTn; }
    }
    GSB();
    {
        f32x16 KK = {};
#pragma unroll
        for (int s = 0; s < 8; ++s) { const bf16x8 k1 = *(const bf16x8*)(kbase + (size_t)(32 + r32) * 4096 + 16 * s + 8 * hi); KK = __builtin_amdgcn_mfma_f32_32x32x16_bf16(k1, k1, KK, 0, 0, 0); }
        f32x16 M, MT;
        { const float gb0 = tab[32 + r32], bb0 = tab[96 + r32];
#pragma unroll
        for (int r = 0; r < 16; ++r) { const int a0 = crow(r, hi), b0 = r32; const float ke = -KK[r] * __expf(-fabsf(tab[32 + a0] - gb0));
            const float nv = ke * tab[96 + a0], ntv = ke * bb0;
            const float n = (a0 > b0) ? nv : 0.f, nt = (b0 > a0) ? ntv : 0.f, id = (a0 == b0) ? 1.f : 0.f;
            M[r] = n; MT[r] = nt; T2T[r] = id + nt; } }
#pragma unroll
        for (int it = 0; it < 4; ++it) { const f32x16 z = {};
            const f32x16 Mn = mm(MT, M, z), MTn = mm(M, MT, z);
            T2T = mm(Mn, T2T, T2T);
            M = Mn; MT = MTn; }
    }
    GSB();
    {
        f32x16 L21 = {};
#pragma unroll
        for (int s = 0; s < 8; ++s) { const bf16x8 k0 = *(const bf16x8*)(kbase + (size_t)r32 * 4096 + 16 * s + 8 * hi), k1 = *(const bf16x8*)(kbase + (size_t)(32 + r32) * 4096 + 16 * s + 8 * hi);
            L21 = __builtin_amdgcn_mfma_f32_32x32x16_bf16(k1, k0, L21, 0, 0, 0); }
#pragma unroll
        for (int r = 0; r < 16; ++r) { const int a0 = crow(r, hi); L21[r] = L21[r] * tab[96 + a0] * __expf(tab[32 + a0] - tab[r32]); }
        const f32x16 z = {}; const f32x16 Y = mm(L21, T2T, z); T21T = mm(T1, Y, z);
#pragma unroll
        for (int r = 0; r < 16; ++r) T21T[r] = -T21T[r];
    }
    GSB();
    SEC_OUT(2); SEC_IN(3);
    const int vb = (int)(unsigned)(size_t)img + sba::v_rd_base(lane);
    bf16* ubl = dry ? (bf16*)(a.ws + WS_END) + (size_t)(unit & 63) * 64 * 4096 : vbase;
#pragma unroll 1
    for (int mode = 0; mode < 2; ++mode) {
        const bf16* src = mode == 0 ? (const bf16*)vbase : kbase;
#pragma unroll 1
        for (int hb_ = 0; hb_ < 2; ++hb_) { v4u tl[8];
#pragma unroll
          for (int it = 0; it < 8; ++it) { const int row = (lane >> 4) + 4 * (it + 8 * hb_), col = (lane & 15) * 8; tl[it] = *(const v4u*)(src + (size_t)row * 4096 + col); }
#pragma unroll
          for (int it = 0; it < 8; ++it) { const int row = (lane >> 4) + 4 * (it + 8 * hb_), col = (lane & 15) * 8; *(LAS v4u*)(img + sba::v_st(row, col)) = tl[it]; } }
        LAS float* sc = tab + (mode == 0 ? 64 : 128);
#pragma unroll 1
        for (int I = 0; I < 2; ++I) {
            bf16x8 pa0, pa1, pa2, pa3;
            { f32x16 X;
#pragma unroll
              for (int r = 0; r < 16; ++r) X[r] = (I ? T21T[r] : T1T[r]) * sc[crow(r, hi)];
              GPK4(X, 0, pa0); GPK4(X, 8, pa1);
              { const float on = I ? 1.0f : 0.0f;
#pragma unroll
              for (int r = 0; r < 16; ++r) X[r] = T2T[r] * (sc[32 + crow(r, hi)] * on); }
              GPK4(X, 0, pa2); GPK4(X, 8, pa3); }
#pragma unroll 1
            for (int d0 = 0; d0 < 4; ++d0) {
                f32x16 od = {};
                if (mode == 0) { sba::pv_split(od, vb + d0 * 512, pa0, pa1, pa2, pa3);
                    const unsigned e0 = (unsigned)(((I * 32 + 8 * d0 + (lane >> 5)) * 4096) + (lane & 31) * 4);
#pragma unroll
                    for (int g = 0; g < 4; ++g) { v2u w; w.x = pk(od[4 * g + 0], od[4 * g + 1]); w.y = pk(od[4 * g + 2], od[4 * g + 3]); *(v2u*)(ubl + e0 + (unsigned)(g * 8192)) = w; }
                } else { sba::pv_split_T(od, vb + d0 * 512, pa0, pa1, pa2, pa3);
                    bf16* wp = wmem + (unsigned)((((I * 4 + d0) * 4) * 64 + lane) * 4);
#pragma unroll
                    for (int g = 0; g < 4; ++g) { v2u w; w.x = pk(od[4 * g + 0], od[4 * g + 1]); w.y = pk(od[4 * g + 2], od[4 * g + 3]); *(v2u*)(wp + g * 256) = w; }
                }
                GSB();
            }
        }
        if (mode == 1) {
            const int Ik = hv & 1;
            v4u idw0, idw1;
            { const int d0_ = r32 - 8 * hi, d1_ = r32 - 16 - 8 * hi;
              idw0.x = (d0_ == 0 ? 0x3f80u : 0u) | (d0_ == 1 ? 0x3f800000u : 0u); idw0.y = (d0_ == 2 ? 0x3f80u : 0u) | (d0_ == 3 ? 0x3f800000u : 0u);
              idw0.z = (d0_ == 4 ? 0x3f80u : 0u) | (d0_ == 5 ? 0x3f800000u : 0u); idw0.w = (d0_ == 6 ? 0x3f80u : 0u) | (d0_ == 7 ? 0x3f800000u : 0u);
              idw1.x = (d1_ == 0 ? 0x3f80u : 0u) | (d1_ == 1 ? 0x3f800000u : 0u); idw1.y = (d1_ == 2 ? 0x3f80u : 0u) | (d1_ == 3 ? 0x3f800000u : 0u);
              idw1.z = (d1_ == 4 ? 0x3f80u : 0u) | (d1_ == 5 ? 0x3f800000u : 0u); idw1.w = (d1_ == 6 ? 0x3f80u : 0u) | (d1_ == 7 ? 0x3f800000u : 0u); }
            const bf16x8 id0 = __builtin_bit_cast(bf16x8, idw0), id1 = __builtin_bit_cast(bf16x8, idw1), zf = (bf16x8){};
            const bf16x8 pa0 = Ik ? zf : id0, pa1 = Ik ? zf : id1, pa2 = Ik ? id0 : zf, pa3 = Ik ? id1 : zf;
#pragma unroll 1
            for (int d0 = 0; d0 < 4; ++d0) {
                f32x16 od = {}; sba::pv_split(od, vb + d0 * 512, pa0, pa1, pa2, pa3);
                bf16* kp = ktmem + (unsigned)((((Ik * 4 + d0) * 4) * 64 + lane) * 4);
#pragma unroll
                for (int g = 0; g < 4; ++g) { v2u w; w.x = pk(od[4 * g + 0], od[4 * g + 1]); w.y = pk(od[4 * g + 2], od[4 * g + 3]); *(v2u*)(kp + g * 256) = w; }
                GSB();
            }
        }
    }
    SEC_OUT(3);
#undef GSB
}
#undef GPK4
}
DI void phase_gdn_local(const Args& a, LAS unsigned char* lds, int bid, int G, int wave, int lane, bool dry) {
    LAS unsigned char* img = lds + wave * 16384; LAS float* tab = (LAS float*)(lds + RING_BYTES + 4096 + wave * 1024);
    const int gw = bid * NWAVES + wave, NGW = G * NWAVES;
    for (int unit = gw; unit < BATCH * HV * 64; unit += NGW) gdn::local_unit(a, unit, img, tab, lane, dry);
}
namespace gdn {
constexpr int PW = 272, PI = 144;
constexpr int L_W = 0, L_Q = 64 * PW, L_I = 2 * 64 * PW, L_K = L_I + 64 * PI, L_G = L_K + 128 * PI, L_BUF = L_G + 768;
constexpr int L_PART = 2 * L_BUF;
static_assert(L_PART + 4096 <= RING_BYTES, "scan LDS map");
}
DI void phase_gdn_scan(const Args& a, int j, LAS unsigned char* lds, int bid, int tid, bool dry) {
    if (bid >= BATCH * HV) return;
    using gdn::bf16x8; using gdn::pk; using namespace gdn;
    typedef float f4v __attribute__((ext_vector_type(4)));
    const int wave = __builtin_amdgcn_readfirstlane(tid >> 6), lane = tid & 63, n = lane & 15, kq = lane >> 4;
    const int b = bid / HV, hv = bid % HV, hk = hv >> 1;
    bf16* qkvc = (bf16*)(a.ws + WS_QKVC); const bf16* zb = (const bf16*)(a.ws + WS_ZB);
    LAS float* part = (LAS float*)(lds + L_PART); LAS unsigned char* stg = lds + OGST_OFF;
    const int unit0 = (b * HV + hv) * 64, hku0 = (b * HK + hk) * 64; const size_t tb0 = (size_t)b * SEQ;
    if (wave >= 4) {
        const int st = tid - 256;
        v4u rw[4], rq[4], ri[2], rk[4], rz[4]; float rg = 0.f;
        unsigned ow[4], ok_[4], oi[2], oq[4], oz[4];
#pragma unroll
        for (int k = 0; k < 4; ++k) { const int c = st + 256 * k;
            { const int row = c & 63, p = c >> 6, pp = p & 3; ow[k] = (unsigned)((((((row >> 5) * 4 + (p >> 2)) * 4 + (pp >> 1)) * 64 + (pp & 1) * 32 + (row & 31)) * 4) * 2); }
            { const int dk = c & 127, p = c >> 7, pp = p & 3; ok_[k] = (unsigned)((((((p >> 2) * 4 + (dk >> 5)) * 4 + (pp >> 1)) * 64 + (pp & 1) * 32 + (dk & 31)) * 4) * 2); }
            oq[k] = (unsigned)(((c >> 4) * 4096 + (c & 15) * 8) * 2); oz[k] = (unsigned)(((c >> 4) * 2048 + (c & 15) * 8) * 2); }
#pragma unroll
        for (int k = 0; k < 2; ++k) { const int c = st + 256 * k; const int row = c & 63, p = c >> 6, pp = p & 3; oi[k] = (unsigned)((((((row >> 5) * 2 + (p >> 2)) * 4 + (pp >> 1)) * 64 + (pp & 1) * 32 + (row & 31)) * 4) * 2); }
#define SV_RUN2(dst, base, ob_) do { const v2u a_ = *(const v2u*)((const char*)(base) + (ob_)), b_ = *(const v2u*)((const char*)(base) + (ob_) + 1024); dst = (v4u){a_.x, a_.y, b_.x, b_.y}; } while (0)
#define SV_LOAD(ch) do { const int u_ = unit0 + (ch); const size_t t_ = tb0 + (size_t)(ch) * 64; \
        const bf16* wm_ = (const bf16*)(a.ws + WS_WMEM) + (size_t)u_ * 8192; const bf16* im_ = (const bf16*)(a.ws + WS_IMEM) + (size_t)u_ * 4096; \
        const bf16* kt_ = (const bf16*)(a.ws + WS_KTMEM) + (size_t)(hku0 + (ch)) * 8192; const bf16* qb_ = qkvc + t_ * 4096 + hk * 128; const bf16* zr_ = zb + t_ * 2048 + hv * 128; \
        _Pragma("unroll") for (int k = 0; k < 4; ++k) { SV_RUN2(rw[k], wm_, ow[k]); SV_RUN2(rk[k], kt_, ok_[k]); rq[k] = *(const v4u*)((const char*)qb_ + oq[k]); rz[k] = *(const v4u*)((const char*)zr_ + oz[k]); } \
        _Pragma("unroll") for (int k = 0; k < 2; ++k) { SV_RUN2(ri[k], im_, oi[k]); } \
        if (st < 192) rg = ((const float*)(a.ws + WS_GTAB))[(size_t)u_ * 192 + st]; } while (0)
#define SV_WRITE(bf) do { LAS unsigned char* B_ = lds + (bf) * L_BUF; \
        _Pragma("unroll") for (int k = 0; k < 4; ++k) { const int c = st + 256 * k; *(LAS v4u*)(B_ + L_W + (c & 63) * PW + (c >> 6) * 16) = rw[k]; \
            *(LAS v4u*)(B_ + L_Q + (c >> 4) * PW + (c & 15) * 16) = rq[k]; *(LAS v4u*)(B_ + L_K + (c & 127) * PI + (c >> 7) * 16) = rk[k]; } \
        _Pragma("unroll") for (int k = 0; k < 2; ++k) { const int c = st + 256 * k; *(LAS v4u*)(B_ + L_I + (c & 63) * PI + (c >> 6) * 16) = ri[k]; } \
        if (st < 192) *(LAS float*)(B_ + L_G + st * 4) = rg; } while (0)
        f32x4 nwa, nwb;
        { const float* nwp = a.gdn_norm_w + j * 128 + (st & 15) * 8; nwa = *(const f32x4*)nwp; nwb = *(const f32x4*)(nwp + 4); }
        volatile LAS unsigned* flag = (volatile LAS unsigned*)(lds + L_PART);
        SV_LOAD(0); SV_WRITE(0);
        v4u zc[4], zn[4];
#pragma unroll
        for (int k = 0; k < 4; ++k) zc[k] = rz[k];
        __syncthreads();
        SV_LOAD(1);
#pragma unroll 1
        for (int chunk = 0; chunk < 64; ++chunk) {
            if (chunk + 1 < 64) { SV_WRITE((chunk + 1) & 1);
#pragma unroll
                for (int k = 0; k < 4; ++k) zn[k] = rz[k]; }
            __syncthreads();
            v4u ov[4];
#pragma unroll
            for (int k = 0; k < 4; ++k) { const int c = st + 256 * k; ov[k] = *(const LAS v4u*)(stg + (c >> 4) * 256 + (c & 15) * 16); }
            asm volatile("s_waitcnt lgkmcnt(0)" ::: "memory");
            if (lane == 0) __hip_atomic_fetch_add((LAS unsigned*)(lds + L_PART), 1u, __ATOMIC_RELAXED, __HIP_MEMORY_SCOPE_WORKGROUP);
            if (chunk + 2 < 64) SV_LOAD(chunk + 2);
            __builtin_amdgcn_sched_barrier(0);
            bf16* ob = dry ? (bf16*)(a.ws + WS_END) + (size_t)bid * 64 * 128 : qkvc + (tb0 + (size_t)chunk * 64) * 4096 + 2048 + hv * 128; const int opitch = dry ? 128 : 4096;
#pragma unroll
            for (int k = 0; k < 4; ++k) {
                float o8[8]; o8[0] = bf_lo(ov[k].x); o8[1] = bf_hi(ov[k].x); o8[2] = bf_lo(ov[k].y); o8[3] = bf_hi(ov[k].y); o8[4] = bf_lo(ov[k].z); o8[5] = bf_hi(ov[k].z); o8[6] = bf_lo(ov[k].w); o8[7] = bf_hi(ov[k].w);
                float ss = 0.f;
#pragma unroll
                for (int e = 0; e < 8; ++e) ss += o8[e] * o8[e];
                const float rinv = __builtin_amdgcn_rsqf(dpp_sum16(ss) * (1.0f / 128.0f) + RMS_EPS);
                float z8[8]; z8[0] = bf_lo(zc[k].x); z8[1] = bf_hi(zc[k].x); z8[2] = bf_lo(zc[k].y); z8[3] = bf_hi(zc[k].y); z8[4] = bf_lo(zc[k].z); z8[5] = bf_hi(zc[k].z); z8[6] = bf_lo(zc[k].w); z8[7] = bf_hi(zc[k].w);
                float r8[8];
#pragma unroll
                for (int e = 0; e < 8; ++e) r8[e] = o8[e] * rinv * (e < 4 ? nwa[e] : nwb[e - 4]) * z8[e];
                v4u w; w.x = pk(r8[0], r8[1]); w.y = pk(r8[2], r8[3]); w.z = pk(r8[4], r8[5]); w.w = pk(r8[6], r8[7]);
                *(v4u*)((char*)ob + (dry ? (unsigned)((((st + 256 * k) >> 4) * 128 + ((st + 256 * k) & 15) * 8) * 2) : oq[k])) = w; }
#pragma unroll
            for (int k = 0; k < 4; ++k) zc[k] = zn[k];
        }
#undef SV_RUN2
#undef SV_LOAD
#undef SV_WRITE
        return;
    }
    f4v S[2][8];
#pragma unroll
    for (int g = 0; g < 2; ++g)
#pragma unroll
        for (int m = 0; m < 8; ++m) S[g][m] = (f4v){0.f, 0.f, 0.f, 0.f};
    v2u un[2][4];
#define CW_ULOAD(ch) do { const bf16* vb_ = qkvc + (tb0 + (size_t)(ch) * 64) * 4096 + 2048 + hv * 128; \
        _Pragma("unroll") for (int g = 0; g < 2; ++g) _Pragma("unroll") for (int mt = 0; mt < 4; ++mt) { \
            const int f = (((((mt >> 1) * 4 + wave) * 4 + 2 * (mt & 1) + (kq >> 1)) * 64) + (kq & 1) * 32 + 16 * g + n) * 4;     \
            un[g][mt] = *(const v2u*)(vb_ + (size_t)(f >> 7) * 4096 + (f & 127)); } } while (0)
    CW_ULOAD(0);
    if (tid == 0) *(volatile LAS unsigned*)(lds + L_PART) = 0u;
    __syncthreads();
#pragma unroll 1
    for (int chunk = 0; chunk < 64; ++chunk) {
        GSEC_ACC(8, -);
        const LAS unsigned char* B = lds + (chunk & 1) * L_BUF; const LAS float* gt = (const LAS float*)(B + L_G);
        f4v av[2][4], ao[2][4];
#pragma unroll
        for (int g = 0; g < 2; ++g)
#pragma unroll
            for (int mt = 0; mt < 4; ++mt) { const v2u u0 = un[g][mt]; av[g][mt] = (f4v){bf_lo(u0.x), bf_hi(u0.x), bf_lo(u0.y), bf_hi(u0.y)}; }
        if (chunk + 1 < 64) CW_ULOAD(chunk + 1);
        bf16x8 Sb[2][4];
#pragma unroll
        for (int g = 0; g < 2; ++g)
#pragma unroll
            for (int p = 0; p < 4; ++p) { v4u w; w.x = pk(S[g][2 * p][0], S[g][2 * p][1]); w.y = pk(S[g][2 * p][2], S[g][2 * p][3]); w.z = pk(S[g][2 * p + 1][0], S[g][2 * p + 1][1]); w.w = pk(S[g][2 * p + 1][2], S[g][2 * p + 1][3]);
                Sb[g][p] = __builtin_bit_cast(bf16x8, w); }
#pragma unroll
        for (int mt = 0; mt < 4; ++mt) { ao[0][mt] = (f4v){0.f, 0.f, 0.f, 0.f}; ao[1][mt] = (f4v){0.f, 0.f, 0.f, 0.f};
#pragma unroll
            for (int p = 0; p < 4; ++p) {
                const bf16x8 aw = *(const LAS bf16x8*)(B + L_W + (16 * mt + n) * PW + 64 * p + 16 * kq);
                const v2u q0 = *(const LAS v2u*)(B + L_Q + (16 * mt + n) * PW + 64 * p + 8 * kq), q1 = *(const LAS v2u*)(B + L_Q + (16 * mt + n) * PW + 64 * p + 32 + 8 * kq);
                const v4u qq = {q0.x, q0.y, q1.x, q1.y}; const bf16x8 aq = __builtin_bit_cast(bf16x8, qq);
                av[0][mt] = __builtin_amdgcn_mfma_f32_16x16x32_bf16(aw, Sb[0][p], av[0][mt], 0, 0, 0); av[1][mt] = __builtin_amdgcn_mfma_f32_16x16x32_bf16(aw, Sb[1][p], av[1][mt], 0, 0, 0);
                ao[0][mt] = __builtin_amdgcn_mfma_f32_16x16x32_bf16(aq, Sb[0][p], ao[0][mt], 0, 0, 0); ao[1][mt] = __builtin_amdgcn_mfma_f32_16x16x32_bf16(aq, Sb[1][p], ao[1][mt], 0, 0, 0); } }
        bf16x8 vbf[2][2], vbd[2][2];
#pragma unroll
        for (int pp = 0; pp < 2; ++pp) {
            const f4v d0 = *(const LAS f4v*)(gt + 64 + 32 * pp + 4 * kq), d1 = *(const LAS f4v*)(gt + 64 + 32 * pp + 16 + 4 * kq);
#pragma unroll
            for (int g = 0; g < 2; ++g) { const f4v x0 = av[g][2 * pp], x1 = av[g][2 * pp + 1];
                v4u w; w.x = pk(x0[0], x0[1]); w.y = pk(x0[2], x0[3]); w.z = pk(x1[0], x1[1]); w.w = pk(x1[2], x1[3]); vbf[g][pp] = __builtin_bit_cast(bf16x8, w);
                v4u y; y.x = pk(x0[0] * d0[0], x0[1] * d0[1]); y.y = pk(x0[2] * d0[2], x0[3] * d0[3]); y.z = pk(x1[0] * d1[0], x1[1] * d1[1]); y.w = pk(x1[2] * d1[2], x1[3] * d1[3]); vbd[g][pp] = __builtin_bit_cast(bf16x8, y); }
        }
#pragma unroll
        for (int mt = 0; mt < 4; ++mt) { const f4v eg = *(const LAS f4v*)(gt + 16 * mt + 4 * kq); ao[0][mt] = ao[0][mt] * eg; ao[1][mt] = ao[1][mt] * eg;
#pragma unroll
            for (int pp = 0; pp < 2; ++pp) { const bf16x8 ai = *(const LAS bf16x8*)(B + L_I + (16 * mt + n) * PI + 64 * pp + 16 * kq);
                ao[0][mt] = __builtin_amdgcn_mfma_f32_16x16x32_bf16(ai, vbf[0][pp], ao[0][mt], 0, 0, 0); ao[1][mt] = __builtin_amdgcn_mfma_f32_16x16x32_bf16(ai, vbf[1][pp], ao[1][mt], 0, 0, 0); } }
        { const float egl = gt[128];
#pragma unroll
          for (int m8 = 0; m8 < 8; ++m8) { S[0][m8] = S[0][m8] * egl; S[1][m8] = S[1][m8] * egl;
#pragma unroll
              for (int pp = 0; pp < 2; ++pp) { const bf16x8 ak = *(const LAS bf16x8*)(B + L_K + (16 * m8 + n) * PI + 64 * pp + 16 * kq);
                  S[0][m8] = __builtin_amdgcn_mfma_f32_16x16x32_bf16(ak, vbd[0][pp], S[0][m8], 0, 0, 0); S[1][m8] = __builtin_amdgcn_mfma_f32_16x16x32_bf16(ak, vbd[1][pp], S[1][m8], 0, 0, 0); } } }
        GSEC_ACC(8, +); GSEC_ACC(9, -);
        { unsigned spins = 0; while (*(volatile LAS unsigned*)(lds + L_PART) < 4u * (unsigned)chunk) { __builtin_amdgcn_s_sleep(1); if (++spins > (1u << 22)) break; } }
#pragma unroll
        for (int g = 0; g < 2; ++g)
#pragma unroll
            for (int mt = 0; mt < 4; ++mt)
#pragma unroll
                for (int i = 0; i < 4; ++i) *(LAS bf16*)(stg + (16 * mt + 4 * kq + i) * 256 + (32 * wave + 16 * g + n) * 2) = (bf16)(pk(ao[g][mt][i], 0.f) & 0xffffu);
        __syncthreads();
        GSEC_ACC(9, +);
    }
#undef CW_ULOAD
}

DI void moe_offsets(const Args& a, int j, unsigned (&off)[9]) {
    unsigned* cnt = (unsigned*)(a.ws + WS_CTL) + CW_CNT + 256 * j; unsigned acc = 0u;
#pragma unroll
    for (int e = 0; e < 8; ++e) { off[e] = acc; const unsigned c = __hip_atomic_load(cnt + e, __ATOMIC_RELAXED, __HIP_MEMORY_SCOPE_AGENT); acc += (c + 255u) & ~255u; }
    off[8] = acc;
}
DI void phase_scatter(const Args& a, int j, LAS unsigned char* lds, int bid, int G, int tid, int wave, int lane) {
    LAS unsigned* lc = (LAS unsigned*)lds; LAS unsigned* lb = lc + 8; LAS unsigned* loff = lc + 16; LAS int* lpos = (LAS int*)(lc + 32);
    const unsigned* E12 = (const unsigned*)(a.ws + WS_E12); int* POS = (int*)(a.ws + WS_POS);
    const bf16* HB = (const bf16*)(a.ws + WS_HB); bf16* XS = (bf16*)(a.ws + WS_XS);
    unsigned* fill = (unsigned*)(a.ws + WS_CTL) + CW_CNT + 256 * j + 64;
    unsigned off[9]; moe_offsets(a, j, off);
    if (tid == 0) {
#pragma unroll
        for (int e = 0; e < 8; ++e) loff[e] = off[e]; }
    for (int ci = bid; ci < TT / 128; ci += G) {
        __syncthreads();
        if (tid < 8) lc[tid] = 0u;
        __syncthreads();
        unsigned e1 = 0, e2 = 0, r1 = 0, r2 = 0;
        if (tid < 128) { const unsigned w = E12[ci * 128 + tid]; e1 = w & 255u; e2 = (w >> 8) & 255u;
            r1 = __hip_atomic_fetch_add(lc + e1, 1u, __ATOMIC_RELAXED, __HIP_MEMORY_SCOPE_WORKGROUP); r2 = __hip_atomic_fetch_add(lc + e2, 1u, __ATOMIC_RELAXED, __HIP_MEMORY_SCOPE_WORKGROUP); }
        __syncthreads();
        if (tid < 8) lb[tid] = __hip_atomic_fetch_add(fill + tid, lc[tid], __ATOMIC_RELAXED, __HIP_MEMORY_SCOPE_AGENT);
        __syncthreads();
        if (tid < 128) { const int p1 = (int)(loff[e1] + lb[e1] + r1), p2 = (int)(loff[e2] + lb[e2] + r2);
            lpos[2 * tid] = p1; lpos[2 * tid + 1] = p2; POS[2 * (ci * 128 + tid)] = p1; POS[2 * (ci * 128 + tid) + 1] = p2; }
        __syncthreads();
        for (int tk = wave; tk < 128; tk += NWAVES) {
            const int p1 = lpos[2 * tk], p2 = lpos[2 * tk + 1];
            const v4u* src = (const v4u*)(HB + (size_t)(ci * 128 + tk) * D);
            const v4u x0 = src[lane], x1 = src[lane + 64];
            v4u* d1 = (v4u*)(XS + (size_t)p1 * D); v4u* d2 = (v4u*)(XS + (size_t)p2 * D);
            d1[lane] = x0; d1[lane + 64] = x1; d2[lane] = x0; d2[lane + 64] = x1;
        }
    }
}

template <bool FINAL>
DI void phase_combine_ln(const Args& a, const bf16* Yin, bf16* Yout, int lnprev, int lnidx, int bid, int G, int wave, int lane) {
    bf16* HB = (bf16*)(a.ws + WS_HB); const bf16* YE = (const bf16*)(a.ws + WS_XS); float* stats = (float*)(a.ws + WS_STATS);
    const int* POS = (const int*)(a.ws + WS_POS); const f32x2* G12 = (const f32x2*)(a.ws + WS_G12);
    const float* g = a.ln_g + (size_t)lnidx * D; const float* bta = a.ln_b + (size_t)lnidx * D;
    const float* gp = a.ln_g + (size_t)lnprev * D; const float* bp = a.ln_b + (size_t)lnprev * D;
    const int gw = bid * NWAVES + wave, NGW = G * NWAVES;
    float gv[2][8], bv[2][8], gq[2][8], bq[2][8];
#pragma unroll
    for (int q = 0; q < 2; ++q)
#pragma unroll
        for (int c = 0; c < 8; ++c) { const int col = 8 * (lane + 64 * q) + c; gv[q][c] = g[col]; bv[q][c] = bta[col]; gq[q][c] = gp[col] * ALPHA; bq[q][c] = bp[col] * ALPHA; }
    for (int t = gw; t < TT; t += NGW) {
        const int p1 = POS[2 * t], p2 = POS[2 * t + 1]; const f32x2 gg = G12[t]; const f32x2 st = *(const f32x2*)(stats + 2 * (size_t)t);
        float v[2][8]; float s = 0.f;
#pragma unroll
        for (int q = 0; q < 2; ++q) { float y[8], e1[8], e2[8];
            unpack8(((const v4u*)(Yin + (size_t)t * D))[lane + 64 * q], y); unpack8(((const v4u*)(YE + (size_t)p1 * D))[lane + 64 * q], e1); unpack8(((const v4u*)(YE + (size_t)p2 * D))[lane + 64 * q], e2);
#pragma unroll
            for (int c = 0; c < 8; ++c) { v[q][c] = (y[c] - st.x) * st.y * gq[q][c] + bq[q][c] + e1[c] * gg.x + e2[c] * gg.y; s += v[q][c]; } }
        const float mean = wave_sum(s) * (1.0f / D); float s2 = 0.f;
#pragma unroll
        for (int q = 0; q < 2; ++q)
#pragma unroll
            for (int c = 0; c < 8; ++c) { const float d = v[q][c] - mean; s2 += d * d; }
        const float rstd = 1.0f / sqrtf(wave_sum(s2) * (1.0f / D) + LN_EPS);
        if (!FINAL && lane == 0) *(f32x2*)(stats + 2 * (size_t)t) = (f32x2){mean, rstd};
#pragma unroll
        for (int q = 0; q < 2; ++q) { float hn[8];
#pragma unroll
            for (int c = 0; c < 8; ++c) hn[c] = (v[q][c] - mean) * rstd * gv[q][c] + bv[q][c];
            if (FINAL) { f32x4* orow = (f32x4*)(a.out + (size_t)t * D + 8 * (lane + 64 * q)); orow[0] = (f32x4){hn[0], hn[1], hn[2], hn[3]}; orow[1] = (f32x4){hn[4], hn[5], hn[6], hn[7]}; }
            else { v4u yo; yo.x = pk2(v[q][0], v[q][1]); yo.y = pk2(v[q][2], v[q][3]); yo.z = pk2(v[q][4], v[q][5]); yo.w = pk2(v[q][6], v[q][7]); ((v4u*)(Yout + (size_t)t * D))[lane + 64 * q] = yo;
                v4u o; o.x = pk2(hn[0], hn[1]); o.y = pk2(hn[2], hn[3]); o.z = pk2(hn[4], hn[5]); o.w = pk2(hn[6], hn[7]); ((v4u*)(HB + (size_t)t * D))[lane + 64 * q] = o; } }
    }
}

constexpr int ARGS_OFF = RING_BYTES + 1024;
DI unsigned long long lds_u64(LAS unsigned char* p) { const v2u w = *(const volatile LAS v2u*)p; return ((unsigned long long)(unsigned)__builtin_amdgcn_readfirstlane((int)w.y) << 32) | (unsigned)__builtin_amdgcn_readfirstlane((int)w.x); }
DI Args load_args(LAS unsigned char* lds) {
    Args a; LAS unsigned char* p = lds + ARGS_OFF;
    a.x = (const float*)(const GAS float*)lds_u64(p + 0); a.gdn_w_in = (const float*)(const GAS float*)lds_u64(p + 8); a.gdn_conv_w = (const float*)(const GAS float*)lds_u64(p + 16); a.gdn_a_log = (const float*)(const GAS float*)lds_u64(p + 24);
    a.gdn_dt_bias = (const float*)(const GAS float*)lds_u64(p + 32); a.gdn_norm_w = (const float*)(const GAS float*)lds_u64(p + 40); a.gdn_w_out = (const float*)(const GAS float*)lds_u64(p + 48); a.sb_w_in = (const float*)(const GAS float*)lds_u64(p + 56);
    a.sb_w_out = (const float*)(const GAS float*)lds_u64(p + 64); a.ffn_w_gate = (const float*)(const GAS float*)lds_u64(p + 72); a.ffn_w_up = (const float*)(const GAS float*)lds_u64(p + 80); a.ffn_w_down = (const float*)(const GAS float*)lds_u64(p + 88);
    a.moe_router = (const float*)(const GAS float*)lds_u64(p + 96); a.moe_w_gate = (const float*)(const GAS float*)lds_u64(p + 104); a.moe_w_up = (const float*)(const GAS float*)lds_u64(p + 112); a.moe_w_down = (const float*)(const GAS float*)lds_u64(p + 120);
    a.ln_g = (const float*)(const GAS float*)lds_u64(p + 128); a.ln_b = (const float*)(const GAS float*)lds_u64(p + 136); a.out = (float*)(GAS float*)lds_u64(p + 144); a.ws = (unsigned char*)(GAS unsigned char*)lds_u64(p + 152);
    const v2u w = *(const volatile LAS v2u*)(p + 160); a.ph_lo = __builtin_amdgcn_readfirstlane((int)w.x); a.ph_hi = __builtin_amdgcn_readfirstlane((int)w.y);
    return a;
}
#ifdef PH_ONLY
#define IN(k) (((k) % NPH) == PH_ONLY && lo <= (k) && (k) < hi)
#else
#define IN(k) (lo <= (k) && (k) < hi)
#endif
#define SEAM(k) do { if ((k) + 1 < hi) xcd_barrier(bar); } while (0)
DI int fresh_lane() { int l; asm volatile("v_mbcnt_lo_u32_b32 %0, -1, 0\n\tv_mbcnt_hi_u32_b32 %0, -1, %0" : "=v"(l)); return l; }
#define YMOE ((bf16*)(j == 1 ? (void*)(args.ws + WS_YT) : (void*)args.out))
#define ARGS() const Args args = load_args(lds); const int lo = args.ph_lo, hi = args.ph_hi; const int lane = fresh_lane(), tid = wave * 64 + lane
#ifndef PROBE_REP_MASK
#define PROBE_REP_MASK 0
#endif
#ifndef PROBE_DELAY_MASK
#define PROBE_DELAY_MASK 0
#endif
#define PROBE_DELAY_MULT 4u
#define TICK_IN(k) do { if (((PROBE_DELAY_MASK) >> (k)) & 1) { if (bid == 0 && tid == 0) ((volatile LAS unsigned*)(lds + MISC_OFF))[20] -= (unsigned)__builtin_amdgcn_s_memrealtime(); } } while (0)
#define TICK_OUT(k) do { if (((PROBE_DELAY_MASK) >> (k)) & 1) { if (bid == 0 && tid == 0) ((volatile LAS unsigned*)(lds + MISC_OFF))[20] += (unsigned)__builtin_amdgcn_s_memrealtime(); } } while (0)
#define NREP(k) ((((PROBE_REP_MASK) >> (k)) & 1) ? 2 : 1)
template <int j>
DI void layer_pair(LAS unsigned char* lds, const XcdBarrier& bar, const int wave, const int G, const int bid) {
    constexpr int pb = j * NPH;
    { ARGS(); if (IN(pb + 0)) { TICK_IN(0); _Pragma("unroll 1") for (int rep_ = 0; rep_ < NREP(0); ++rep_) { phase_w_gdn(args, j, lds, bid, G, tid, wave, lane); } SEAM(pb + 0); TICK_OUT(0); } }
    { ARGS(); if (IN(pb + 1)) { TICK_IN(1); {
        pg8::Gemm g{(const bf16*)(args.ws + WS_HB), (const bf16*)(args.ws + W_IN), D, D}; pg8::StaticOrder S; S.init(TT, GINP, G, bid, NREP(1));
        pg8::EpiInProj E{(bf16*)(args.ws + WS_RAW), (bf16*)(args.ws + WS_ZB)};
        pg8::gemm_phase<pg8::EpiInProj, pg8::StaticOrder, true, true>(lds, g, S, E);
        } SEAM(pb + 1); TICK_OUT(1); } }
    { ARGS(); if (IN(pb + 2)) { TICK_IN(2); _Pragma("unroll 1") for (int rep_ = 0; rep_ < NREP(2); ++rep_) { phase_conv(args, j, bid, G, tid); } SEAM(pb + 2); TICK_OUT(2); } }
#if GDN_NAIVE
    { ARGS(); if (IN(pb + 4)) { TICK_IN(4); _Pragma("unroll 1") for (int rep_ = 0; rep_ < NREP(4); ++rep_) { phase_gdn_naive(args, j, lds, bid, tid); } SEAM(pb + 4); TICK_OUT(4); } }
#else
    { ARGS(); if (IN(pb + 3)) { TICK_IN(3); _Pragma("unroll 1") for (int rep_ = 0; rep_ < NREP(3); ++rep_) { phase_gdn_local(args, lds, bid, G, wave, lane, rep_ + 1 < NREP(3)); } SEAM(pb + 3); TICK_OUT(3); } }
    { ARGS(); if (IN(pb + 4)) { TICK_IN(4); _Pragma("unroll 1") for (int rep_ = 0; rep_ < NREP(4); ++rep_) { if (bid >= BATCH * HV && G > BATCH * HV) phase_w_sb(args, j, lds, bid - BATCH * HV, G - BATCH * HV, wave, lane); else if (G <= BATCH * HV && rep_ == 0) phase_w_sb(args, j, lds, bid, G, wave, lane);
        phase_gdn_scan(args, j, lds, bid, tid, rep_ + 1 < NREP(4)); } SEAM(pb + 4); TICK_OUT(4); } }
#endif
    { ARGS(); if (IN(pb + 5)) { TICK_IN(5); {
        pg8::Gemm g{(const bf16*)(args.ws + WS_QKVC) + 2048, (const bf16*)(args.ws + W_OUT), 4096, 2048}; pg8::StaticOrder S; S.init(TT, D, G, bid);
        pg8::EpiResid<(j > 0)> E{j == 0 ? (const void*)args.x : (const void*)args.out, (bf16*)args.out, (const float*)(args.ws + WS_STATS), args.ln_g + (size_t)(4 * (j > 0 ? j - 1 : 0) + 3) * D, args.ln_b + (size_t)(4 * (j > 0 ? j - 1 : 0) + 3) * D};
        pg8::gemm_phase<pg8::EpiResid<(j > 0)>, pg8::StaticOrder, true, true>(lds, g, S, E);
        } SEAM(pb + 5); TICK_OUT(5); } }
    { ARGS(); if (IN(pb + 6)) { TICK_IN(6); _Pragma("unroll 1") for (int rep_ = 0; rep_ < NREP(6); ++rep_) { phase_ln<false>(args, (const bf16*)args.out, (2 * j) * 2 + 0, j, lds, bid, G, tid, wave, lane); } SEAM(pb + 6); TICK_OUT(6); } }
    { ARGS(); if (IN(pb + 7)) { TICK_IN(7); {
        pg8::Gemm g{(const bf16*)(args.ws + WS_HB), (const bf16*)(args.ws + W_GU), D, D}; pg8::StaticOrder S; S.init(TT, 2 * FF, G, bid, NREP(7));
        pg8::EpiSwiGLU E{(bf16*)(args.ws + WS_ACT), FF, 0};
        pg8::gemm_phase<pg8::EpiSwiGLU, pg8::StaticOrder, true, true>(lds, g, S, E);
        } SEAM(pb + 7); TICK_OUT(7); } }
    { ARGS(); if (IN(pb + 8)) { TICK_IN(8); {
        pg8::Gemm g{(const bf16*)(args.ws + WS_ACT), (const bf16*)(args.ws + W_D), FF, FF}; pg8::StaticOrder S; S.init(TT, D, G, bid);
        pg8::EpiResid<true> E{(const void*)args.out, (bf16*)args.out, (const float*)(args.ws + WS_STATS), args.ln_g + (size_t)(4 * j + 0) * D, args.ln_b + (size_t)(4 * j + 0) * D};
        pg8::gemm_phase<pg8::EpiResid<true>, pg8::StaticOrder, true, true>(lds, g, S, E);
        } SEAM(pb + 8); TICK_OUT(8); } }
    { ARGS(); if (IN(pb + 9)) { TICK_IN(9); _Pragma("unroll 1") for (int rep_ = 0; rep_ < NREP(9); ++rep_) { phase_ln<false>(args, (const bf16*)args.out, (2 * j) * 2 + 1, j, lds, bid, G, tid, wave, lane); } SEAM(pb + 9); TICK_OUT(9); } }
    { ARGS(); if (IN(pb + 10)) { TICK_IN(10); {
        pg8::Gemm g{(const bf16*)(args.ws + WS_HB), (const bf16*)(args.ws + W_QKV), D, D}; pg8::StaticOrder S; S.init(TT, 3072, G, bid, NREP(10));
        pg8::EpiBf16 E{(bf16*)(args.ws + WS_QKV), 3072, 0};
        pg8::gemm_phase<pg8::EpiBf16, pg8::StaticOrder, true, true>(lds, g, S, E);
        } SEAM(pb + 10); TICK_OUT(10); } }
    #if SB_NAIVE
    { ARGS(); if (IN(pb + 11)) { TICK_IN(11); _Pragma("unroll 1") for (int rep_ = 0; rep_ < NREP(11); ++rep_) { phase_sb_naive(args, lds, bid, G, tid); } SEAM(pb + 11); TICK_OUT(11); } }
#else
    { ARGS(); if (IN(pb + 11)) { TICK_IN(11); _Pragma("unroll 1") for (int rep_ = 0; rep_ < NREP(11); ++rep_) { phase_sb_mfma(args, lds, bid, G, tid); } SEAM(pb + 11); TICK_OUT(11); } }
#endif
    { ARGS(); if (IN(pb + 12)) { TICK_IN(12); {
        pg8::Gemm g{(const bf16*)(args.ws + WS_AO), (const bf16*)(args.ws + W_O), D, D}; pg8::StaticOrder S; S.init(TT, D, G, bid);
        pg8::EpiResid<true> E{(const void*)args.out, YMOE, (const float*)(args.ws + WS_STATS), args.ln_g + (size_t)(4 * j + 1) * D, args.ln_b + (size_t)(4 * j + 1) * D};
        pg8::gemm_phase<pg8::EpiResid<true>, pg8::StaticOrder, true, true>(lds, g, S, E);
        } SEAM(pb + 12); TICK_OUT(12); } }
    { ARGS(); if (IN(pb + 13)) { TICK_IN(13); _Pragma("unroll 1") for (int rep_ = 0; rep_ < NREP(13); ++rep_) { phase_ln<true>(args, YMOE, (2 * j + 1) * 2 + 0, j, lds, bid, G, tid, wave, lane); } SEAM(pb + 13); TICK_OUT(13); } }
    { ARGS(); if (IN(pb + 14)) { TICK_IN(14); _Pragma("unroll 1") for (int rep_ = 0; rep_ < NREP(14); ++rep_) { phase_scatter(args, j, lds, bid, G, tid, wave, lane); } SEAM(pb + 14); TICK_OUT(14); } }
    { ARGS(); if (IN(pb + 15)) { TICK_IN(15); {
        unsigned off[9]; moe_offsets(args, j, off);
        pg8::MoeOrder S; S.nM = (int)(off[8] >> 8); S.G = G; S.c = bid; S.nN = 2 * FF / 256; S.nwg = S.nM * S.nN; S.rep = NREP(15);
        S.ps1 = (int)(off[1] >> 8); S.ps2 = (int)(off[2] >> 8); S.ps3 = (int)(off[3] >> 8); S.ps4 = (int)(off[4] >> 8); S.ps5 = (int)(off[5] >> 8); S.ps6 = (int)(off[6] >> 8); S.ps7 = (int)(off[7] >> 8);
        pg8::Gemm g{(const bf16*)(args.ws + WS_XS), (const bf16*)(args.ws + W_MGU), D, D};
        pg8::EpiSwiGLU E{(bf16*)(args.ws + WS_MACT), FF, 2 * FF / 256};
        pg8::gemm_phase<pg8::EpiSwiGLU, pg8::MoeOrder, true, true>(lds, g, S, E);
        } SEAM(pb + 15); TICK_OUT(15); } }
    { ARGS(); if (IN(pb + 16)) { TICK_IN(16); {
        unsigned off[9]; moe_offsets(args, j, off);
        pg8::MoeOrder S; S.nM = (int)(off[8] >> 8); S.G = G; S.c = bid; S.nN = D / 256; S.nwg = S.nM * S.nN; S.rep = NREP(16);
        S.ps1 = (int)(off[1] >> 8); S.ps2 = (int)(off[2] >> 8); S.ps3 = (int)(off[3] >> 8); S.ps4 = (int)(off[4] >> 8); S.ps5 = (int)(off[5] >> 8); S.ps6 = (int)(off[6] >> 8); S.ps7 = (int)(off[7] >> 8);
        pg8::Gemm g{(const bf16*)(args.ws + WS_MACT), (const bf16*)(args.ws + W_MD), FF, FF};
        pg8::EpiBf16 E{(bf16*)(args.ws + WS_XS), D, D / 256};
        pg8::gemm_phase<pg8::EpiBf16, pg8::MoeOrder, true, true>(lds, g, S, E);
        } SEAM(pb + 16); TICK_OUT(16); } }
    { ARGS(); if (IN(pb + 17)) { TICK_IN(17); _Pragma("unroll 1") for (int rep_ = 0; rep_ < NREP(17); ++rep_) { phase_combine_ln<(j == 1)>(args, YMOE, (bf16*)args.out, 4 * j + 2, 4 * j + 3, bid, G, wave, lane); } SEAM(pb + 17); TICK_OUT(17); } }
}
__global__ void __launch_bounds__(NWAVES * 64, 2) fwd(Args kargs) {
    extern __shared__ __attribute__((aligned(16))) unsigned char lds_raw[];
    LAS unsigned char* lds = (LAS unsigned char*)lds_raw;
    volatile LAS unsigned* MISC = (volatile LAS unsigned*)(lds + MISC_OFF);
    const int tid = threadIdx.x, lane = tid & 63, wave = __builtin_amdgcn_readfirstlane(tid >> 6), G = gridDim.x, bid = blockIdx.x;
    for (int u = tid; u < (LDS_BYTES - RING_BYTES) / 4; u += NWAVES * 64) ((LAS unsigned*)(lds + RING_BYTES))[u] = 0u;
    __syncthreads();
    if (tid == 0) { LAS unsigned long long* pa = (LAS unsigned long long*)(lds + ARGS_OFF);
        pa[0] = (unsigned long long)kargs.x; pa[1] = (unsigned long long)kargs.gdn_w_in; pa[2] = (unsigned long long)kargs.gdn_conv_w; pa[3] = (unsigned long long)kargs.gdn_a_log;
        pa[4] = (unsigned long long)kargs.gdn_dt_bias; pa[5] = (unsigned long long)kargs.gdn_norm_w; pa[6] = (unsigned long long)kargs.gdn_w_out; pa[7] = (unsigned long long)kargs.sb_w_in;
        pa[8] = (unsigned long long)kargs.sb_w_out; pa[9] = (unsigned long long)kargs.ffn_w_gate; pa[10] = (unsigned long long)kargs.ffn_w_up; pa[11] = (unsigned long long)kargs.ffn_w_down;
        pa[12] = (unsigned long long)kargs.moe_router; pa[13] = (unsigned long long)kargs.moe_w_gate; pa[14] = (unsigned long long)kargs.moe_w_up; pa[15] = (unsigned long long)kargs.moe_w_down;
        pa[16] = (unsigned long long)kargs.ln_g; pa[17] = (unsigned long long)kargs.ln_b; pa[18] = (unsigned long long)kargs.out; pa[19] = (unsigned long long)kargs.ws;
        pa[20] = (unsigned long long)(unsigned)kargs.ph_lo | ((unsigned long long)(unsigned)kargs.ph_hi << 32); }
    XcdBarrier bar = xcd_barrier_post((unsigned*)(kargs.ws + WS_CTL) + CW_BAR, MISC + 8);
    __syncthreads();
    layer_pair<0>(lds, bar, wave, G, bid);
    layer_pair<1>(lds, bar, wave, G, bid);
    if (PROBE_DELAY_MASK || PROBE_SEC) { if (bid == 0 && threadIdx.x == 0) { const unsigned acc = ((volatile LAS unsigned*)(lds + MISC_OFF))[20] * PROBE_DELAY_MULT; const unsigned long long t0 = __builtin_amdgcn_s_memrealtime(); while ((unsigned)(__builtin_amdgcn_s_memrealtime() - t0) < acc) __builtin_amdgcn_s_sleep(8); } }
}
#undef IN
#undef SEAM
#undef ARGS

extern "C" void kernel_launch(void* const* d_in, const int* in_sizes, int n_in, void* d_out, int out_size, void* d_ws, size_t ws_size, hipStream_t stream) {
    static int grid = 0;
    if (grid == 0) {
        if (n_in != 18 || in_sizes[0] != TT * D || out_size != TT * D || ws_size < WS_END) { fprintf(stderr, "kernel_launch: unexpected shapes (n_in %d, in0 %d, out %d, ws %zu); nothing launched\n", n_in, n_in > 0 ? in_sizes[0] : -1, out_size, ws_size); grid = -1; return; }
        int dev = 0, cus = 0, per_cu = 0;
        if (hipGetDevice(&dev) != hipSuccess || hipDeviceGetAttribute(&cus, hipDeviceAttributeMultiprocessorCount, dev) != hipSuccess) { grid = -1; return; }
        if (hipFuncSetAttribute((const void*)fwd, hipFuncAttributeMaxDynamicSharedMemorySize, LDS_BYTES) != hipSuccess) { fprintf(stderr, "kernel_launch: hipFuncSetAttribute failed\n"); grid = -1; return; }
        if (hipOccupancyMaxActiveBlocksPerMultiprocessor(&per_cu, (const void*)fwd, NWAVES * 64, LDS_BYTES) != hipSuccess || per_cu < 1) { fprintf(stderr, "kernel_launch: occupancy query says %d blocks per CU\n", per_cu); (void)hipGetLastError(); grid = -1; return; }
        grid = cus;
    }
    if (grid < 0) return;
    if (hipMemsetAsync((char*)d_ws + WS_CTL, 0, CTL_ZERO_BYTES, stream) != hipSuccess) return;
    Args a{};
    a.x = (const float*)d_in[0]; a.gdn_w_in = (const float*)d_in[1]; a.gdn_conv_w = (const float*)d_in[2]; a.gdn_a_log = (const float*)d_in[3]; a.gdn_dt_bias = (const float*)d_in[4];
    a.gdn_norm_w = (const float*)d_in[5]; a.gdn_w_out = (const float*)d_in[6]; a.sb_w_in = (const float*)d_in[7]; a.sb_w_out = (const float*)d_in[8];
    a.ffn_w_gate = (const float*)d_in[9]; a.ffn_w_up = (const float*)d_in[10]; a.ffn_w_down = (const float*)d_in[11]; a.moe_router = (const float*)d_in[12];
    a.moe_w_gate = (const float*)d_in[13]; a.moe_w_up = (const float*)d_in[14]; a.moe_w_down = (const float*)d_in[15]; a.ln_g = (const float*)d_in[16]; a.ln_b = (const float*)d_in[17];
    a.out = (float*)d_out; a.ws = (unsigned char*)d_ws;
#if MK_ONE_LAUNCH
    a.ph_lo = 0; a.ph_hi = NPHASES;
    hipLaunchKernelGGL(fwd, dim3(grid), dim3(NWAVES * 64), LDS_BYTES, stream, a);
#else
    for (int p = 0; p < NPHASES; ++p) { a.ph_lo = p; a.ph_hi = p + 1; hipLaunchKernelGGL(fwd, dim3(grid), dim3(NWAVES * 64), LDS_BYTES, stream, a); }
#endif
}
```

```cpp
#include <hip/hip_runtime.h>
#include <cstdio>
#include <cstdint>
#ifndef GDN_NAIVE
#define GDN_NAIVE 0
#endif
#ifndef SB_NAIVE
#define SB_NAIVE 0
#endif
#ifndef MK_ONE_LAUNCH
#define MK_ONE_LAUNCH 1
#endif
#ifndef PROBE_SEC
#define PROBE_SEC 0
#endif
#define GSEC_ACC(k, sign) do { if (PROBE_SEC == (k)) { if (blockIdx.x == 0 && threadIdx.x == 0) { volatile __attribute__((address_space(3))) unsigned* p_ = (volatile __attribute__((address_space(3))) unsigned*)(131072 + 320 + 80); *p_ = *p_ sign (unsigned)__builtin_amdgcn_s_memrealtime(); } } } while (0)
namespace pg8 {
#define PG8_LAS __attribute__((address_space(3)))
typedef unsigned short bf16_t;
typedef short bf16x8 __attribute__((ext_vector_type(8)));
typedef float f32x4 __attribute__((ext_vector_type(4)));
typedef unsigned u32x4 __attribute__((ext_vector_type(4)));
constexpr int BM = 256, BK = 64, HALF = 128, HTB = HALF * BK * 2  , STAGE_BYTES = 8 * HTB, NXCD = 8, WGM = 8;

__host__ __device__ __forceinline__ int lds_byte(int r, int c) { const int st = (r >> 4) * 2 + (c >> 5), rr = r & 15, cc = c & 31, ob = rr * 64 + cc * 2; return st * 1024 + (ob ^ (((ob >> 9) & 1) << 5)); }
__host__ __device__ __forceinline__ void stage_rc(int b, int& R, int& C) { const int st = b / 1024, sb = b % 1024, swz = sb ^ (((sb >> 9) & 1) << 5); R = (st >> 1) * 16 + swz / 64; C = (st & 1) * 32 + (swz % 64) / 2; }
__host__ __device__ __forceinline__ int perm32(int rho) { const int n = rho >> 4, i = rho & 15; return 8 * (i >> 2) + 4 * n + (i & 3); }

struct Unit { int pm, pn; };
struct Gemm { const bf16_t* A; const bf16_t* Bt; int lda, K; };

struct StaticOrder {
    int nM, nN, nwg, G, c, rep;
    __host__ __device__ void init(int M, int N, int G_, int c_, int rep_ = 1) { nM = M / BM; nN = N / BM; nwg = nM * nN; G = G_; c = c_; rep = rep_; }
    __host__ __device__ bool next(int i, Unit& u) const {
        const long L = (long)i * G + c; if (L >= (long)rep * nwg) return false;
        int wgid = (int)(L % nwg); { const int q = nwg / NXCD, r = nwg % NXCD, xcd = wgid % NXCD, off = wgid / NXCD; wgid = (xcd < r ? xcd * (q + 1) : r * (q + 1) + (xcd - r) * q) + off; }
        const int nig = WGM * nN, gid = wgid / nig, fm = gid * WGM, gsz = (nM - fm) < WGM ? (nM - fm) : WGM;
        u.pm = fm + ((wgid % nig) % gsz); u.pn = (wgid % nig) / gsz; return true;
    }
    __device__ __forceinline__ void a_ready(const Unit&) const {}
    __device__ __forceinline__ void done(const Unit&) const {}
};

__device__ __forceinline__ unsigned cvt_pk_bf16(float lo, float hi) { unsigned r; asm volatile("v_cvt_pk_bf16_f32 %0, %1, %2" : "=v"(r) : "v"(lo), "v"(hi)); return r; }
struct EpiBf16 {
    static constexpr bool PERM = true, AFTER_DRAIN = false;
    bf16_t* O; int ldc; int nmod;
    __device__ __forceinline__ void operator()(const f32x4 (&acc)[2][2][4][2], const Unit& u, int wr, int wc, int fr, int fq) const {
        const int pnl = nmod ? (u.pn % nmod) : u.pn;
        const int row0 = u.pm * BM + wr * 64 + fr, col0 = pnl * BM + wc * 32 + 8 * fq;
#pragma unroll
        for (int ai = 0; ai < 2; ++ai)
#pragma unroll
            for (int m = 0; m < 4; ++m) { bf16_t* rowp = O + (size_t)(row0 + ai * HALF + m * 16) * ldc + col0;
#pragma unroll
                for (int bj = 0; bj < 2; ++bj) { const f32x4 v0 = acc[ai][bj][m][0], v1 = acc[ai][bj][m][1];
                    u32x4 w; w.x = cvt_pk_bf16(v0[0], v0[1]); w.y = cvt_pk_bf16(v0[2], v0[3]); w.z = cvt_pk_bf16(v1[0], v1[1]); w.w = cvt_pk_bf16(v1[2], v1[3]);
                    *(u32x4*)(rowp + bj * HALF) = w; } }
    }
};
struct EpiInProj {
    static constexpr bool PERM = true, AFTER_DRAIN = false;
    bf16_t* RAW; bf16_t* ZB;
    __device__ __forceinline__ void operator()(const f32x4 (&acc)[2][2][4][2], const Unit& u, int wr, int wc, int fr, int fq) const {
        const bool isz = (u.pn >= 16 && u.pn < 24);
        bf16_t* O = isz ? ZB : RAW; const int ldc = isz ? 2048 : 4352; const int ct = isz ? (u.pn - 16) : (u.pn < 16 ? u.pn : 16);
        const int row0 = u.pm * BM + wr * 64 + fr, col0 = ct * BM + wc * 32 + 8 * fq;
#pragma unroll
        for (int ai = 0; ai < 2; ++ai)
#pragma unroll
            for (int m = 0; m < 4; ++m) { bf16_t* rowp = O + (size_t)(row0 + ai * HALF + m * 16) * ldc + col0;
#pragma unroll
                for (int bj = 0; bj < 2; ++bj) { f32x4 v0 = acc[ai][bj][m][0], v1 = acc[ai][bj][m][1];
                    if (isz) {
#pragma unroll
                        for (int e = 0; e < 4; ++e) { v0[e] = v0[e] * __builtin_amdgcn_rcpf(1.0f + __builtin_amdgcn_exp2f(-1.4426950408889634f * v0[e])); v1[e] = v1[e] * __builtin_amdgcn_rcpf(1.0f + __builtin_amdgcn_exp2f(-1.4426950408889634f * v1[e])); } }
                    u32x4 w; w.x = cvt_pk_bf16(v0[0], v0[1]); w.y = cvt_pk_bf16(v0[2], v0[3]); w.z = cvt_pk_bf16(v1[0], v1[1]); w.w = cvt_pk_bf16(v1[2], v1[3]);
                    *(u32x4*)(rowp + bj * HALF) = w; } }
    }
};
__device__ __forceinline__ float silu_f(float x) { return x * __builtin_amdgcn_rcpf(1.0f + __builtin_amdgcn_exp2f(-1.4426950408889634f * x)); }
struct EpiSwiGLU {
    static constexpr bool PERM = true, AFTER_DRAIN = false;
    bf16_t* O; int ldc; int nmod;
    __device__ __forceinline__ void operator()(const f32x4 (&acc)[2][2][4][2], const Unit& u, int wr, int wc, int fr, int fq) const {
        const int pnl = nmod ? (u.pn % nmod) : u.pn;
        const int row0 = u.pm * BM + wr * 64 + fr, col0 = pnl * HALF + wc * 32 + 8 * fq;
#pragma unroll
        for (int ai = 0; ai < 2; ++ai)
#pragma unroll
            for (int m = 0; m < 4; ++m) { bf16_t* rowp = O + (size_t)(row0 + ai * HALF + m * 16) * ldc + col0;
                const f32x4 g0 = acc[ai][0][m][0], g1 = acc[ai][0][m][1], u0 = acc[ai][1][m][0], u1 = acc[ai][1][m][1];
                u32x4 w;
                w.x = cvt_pk_bf16(silu_f(g0[0]) * u0[0], silu_f(g0[1]) * u0[1]); w.y = cvt_pk_bf16(silu_f(g0[2]) * u0[2], silu_f(g0[3]) * u0[3]);
                w.z = cvt_pk_bf16(silu_f(g1[0]) * u1[0], silu_f(g1[1]) * u1[1]); w.w = cvt_pk_bf16(silu_f(g1[2]) * u1[2], silu_f(g1[3]) * u1[3]);
                *(u32x4*)rowp = w; }
    }
};
typedef float f32x2e __attribute__((ext_vector_type(2)));
template <bool LNR> struct EpiResid {
    static constexpr bool PERM = true, AFTER_DRAIN = false;
    const void* res; bf16_t* out; const float* stats; const float* g; const float* b;
    __device__ __forceinline__ void operator()(const f32x4 (&acc)[2][2][4][2], const Unit& u, int wr, int wc, int fr, int fq) const {
        constexpr int ldc = 1024; constexpr float alpha = 1.6817928305074290f;
        const int row0 = u.pm * BM + wr * 64 + fr, col0 = u.pn * BM + wc * 32 + 8 * fq;
#pragma unroll
        for (int bj = 0; bj < 2; ++bj) {
            f32x4 g0, g1, b0, b1;
            if constexpr (LNR) { g0 = *(const f32x4*)(g + col0 + bj * HALF) * alpha; g1 = *(const f32x4*)(g + col0 + bj * HALF + 4) * alpha;
                                 b0 = *(const f32x4*)(b + col0 + bj * HALF) * alpha; b1 = *(const f32x4*)(b + col0 + bj * HALF + 4) * alpha; }
#pragma unroll
            for (int ai = 0; ai < 2; ++ai) {
                if constexpr (LNR) {
                    u32x4 w[4]; f32x2e st[4];
#pragma unroll
                    for (int m = 0; m < 4; ++m) { const int row = row0 + ai * HALF + m * 16; w[m] = *(const u32x4*)((const bf16_t*)res + (size_t)row * ldc + col0 + bj * HALF); st[m] = *(const f32x2e*)(stats + 2 * row); }
                    asm volatile("" ::: "memory");
#pragma unroll
                    for (int m = 0; m < 4; ++m) { const int row = row0 + ai * HALF + m * 16; const float mean = st[m].x, rstd = st[m].y;
                        const f32x4 r0 = {__uint_as_float(w[m].x << 16), __uint_as_float(w[m].x & 0xffff0000u), __uint_as_float(w[m].y << 16), __uint_as_float(w[m].y & 0xffff0000u)};
                        const f32x4 r1 = {__uint_as_float(w[m].z << 16), __uint_as_float(w[m].z & 0xffff0000u), __uint_as_float(w[m].w << 16), __uint_as_float(w[m].w & 0xffff0000u)};
                        const f32x4 v0 = (r0 - mean) * rstd * g0 + b0 + acc[ai][bj][m][0], v1 = (r1 - mean) * rstd * g1 + b1 + acc[ai][bj][m][1];
                        u32x4 o; o.x = cvt_pk_bf16(v0[0], v0[1]); o.y = cvt_pk_bf16(v0[2], v0[3]); o.z = cvt_pk_bf16(v1[0], v1[1]); o.w = cvt_pk_bf16(v1[2], v1[3]);
                        *(u32x4*)(out + (size_t)row * ldc + col0 + bj * HALF) = o; }
                } else {
                    f32x4 x0[4], x1[4];
#pragma unroll
                    for (int m = 0; m < 4; ++m) { const size_t off = (size_t)(row0 + ai * HALF + m * 16) * ldc + col0 + bj * HALF; x0[m] = *(const f32x4*)((const float*)res + off); x1[m] = *(const f32x4*)((const float*)res + off + 4); }
                    asm volatile("" ::: "memory");
#pragma unroll
                    for (int m = 0; m < 4; ++m) { const size_t off = (size_t)(row0 + ai * HALF + m * 16) * ldc + col0 + bj * HALF;
                        const f32x4 v0 = x0[m] * alpha + acc[ai][bj][m][0], v1 = x1[m] * alpha + acc[ai][bj][m][1];
                        u32x4 o; o.x = cvt_pk_bf16(v0[0], v0[1]); o.y = cvt_pk_bf16(v0[2], v0[3]); o.z = cvt_pk_bf16(v1[0], v1[1]); o.w = cvt_pk_bf16(v1[2], v1[3]);
                        *(u32x4*)(out + off) = o; }
                }
                asm volatile("" ::: "memory");
            }
        }
    }
};
struct MoeOrder {
    int nM, nN, nwg, G, c, rep; int ps1, ps2, ps3, ps4, ps5, ps6, ps7;
    __device__ __forceinline__ bool next(int i, Unit& u) const {
        const long L = (long)i * G + c; if (nwg == 0 || L >= (long)rep * nwg) return false;
        int wgid = (int)(L % nwg); { const int q = nwg / NXCD, r = nwg % NXCD, xcd = wgid % NXCD, off = wgid / NXCD; wgid = (xcd < r ? xcd * (q + 1) : r * (q + 1) + (xcd - r) * q) + off; }
        const int nig = WGM * nN, gid = wgid / nig, fm = gid * WGM, gsz = (nM - fm) < WGM ? (nM - fm) : WGM;
        const int pm = fm + ((wgid % nig) % gsz), pnl = (wgid % nig) / gsz;
        const int e = (pm >= ps1) + (pm >= ps2) + (pm >= ps3) + (pm >= ps4) + (pm >= ps5) + (pm >= ps6) + (pm >= ps7);
        u.pm = pm; u.pn = e * nN + pnl; return true;
    }
    __device__ __forceinline__ void a_ready(const Unit&) const {}
    __device__ __forceinline__ void done(const Unit&) const {}
};
template <class Epi, class Sched, bool ALIGN_EPI = false, bool SP2 = false>
__device__ __forceinline__ void gemm_phase(PG8_LAS unsigned char* lds, const Gemm g, const Sched& S, const Epi& E) {
    const int tid = threadIdx.x, wid = __builtin_amdgcn_readfirstlane(tid >> 6), lane = tid & 63, wr = wid >> 2, wc = wid & 3, fr = lane & 15, fq = lane >> 4;
    const int K = g.K, nt = K / BK;
    unsigned voffA[2], voffB[2];
#pragma unroll
    for (int i = 0; i < 2; ++i) { int R, C; stage_rc(tid * 16 + i * 8192, R, C); const int Rb = Epi::PERM ? ((R & ~31) + perm32(R & 31)) : R;
        voffA[i] = (unsigned)(R * g.lda + C) * 2u; voffB[i] = (unsigned)(Rb * K + C) * 2u; }
    const size_t kstep = (size_t)(BK * 2);
    const size_t hstepA = (size_t)HALF * g.lda * 2, hstepB = (size_t)HALF * K * 2;
    const size_t tstepA = 2 * hstepA, tstepB = 2 * hstepB;
    const unsigned ldsw = (unsigned)wid * 1024u;
    const int aoff = lds_byte(wr * 64 + fr, fq * 8), boff = lds_byte(wc * 32 + fr, fq * 8);
#define PG8_SA(b, h) (((b) * 2 + (h)) * HTB)
#define PG8_SB(b, h) ((4 + (b) * 2 + (h)) * HTB)
#define PG8_STAGE(bufoff, gbase, voff) do { _Pragma("unroll") for (int _i = 0; _i < 2; ++_i) \
        __builtin_amdgcn_global_load_lds((const unsigned*)((const char*)(gbase) + (voff)[_i]), (PG8_LAS unsigned*)(lds + (bufoff) + ldsw + _i * 8192), 16, 0, 0); } while (0)
#define PG8_LDA(dst, b, h) do { _Pragma("unroll") for (int m = 0; m < 4; ++m) _Pragma("unroll") for (int k = 0; k < 2; ++k) dst[m][k] = *(const PG8_LAS bf16x8*)(lds + PG8_SA(b, h) + aoff + m * 2048 + k * 1024); } while (0)
#define PG8_LDB(dst, b, h) do { _Pragma("unroll") for (int n = 0; n < 2; ++n) _Pragma("unroll") for (int k = 0; k < 2; ++k) dst[n][k] = *(const PG8_LAS bf16x8*)(lds + PG8_SB(b, h) + boff + n * 2048 + k * 1024); } while (0)
#define PG8_MMA(ai, bj, At, Bt) do { __builtin_amdgcn_s_setprio(1); _Pragma("unroll") for (int m = 0; m < 4; ++m) _Pragma("unroll") for (int n = 0; n < 2; ++n) _Pragma("unroll") for (int k = 0; k < 2; ++k) \
        acc[ai][bj][m][n] = __builtin_amdgcn_mfma_f32_16x16x32_bf16(Bt[n][k], At[m][k], acc[ai][bj][m][n], 0, 0, 0); __builtin_amdgcn_s_setprio(0); } while (0)
#define PG8_WAIT_V(n) asm volatile("s_waitcnt vmcnt(" #n ")" ::: "memory")
#define PG8_WAIT_L(n) asm volatile("s_waitcnt lgkmcnt(" #n ")" ::: "memory")
#define PG8_BAR __builtin_amdgcn_s_barrier()
#define PG8_SCHED __builtin_amdgcn_sched_barrier(0)
    Unit cur, nxt; int ui = 0;
    if (!S.next(0, cur)) return;
    f32x4 acc[2][2][4][2];
#pragma unroll
    for (int a = 0; a < 2; ++a)
#pragma unroll
        for (int b = 0; b < 2; ++b)
#pragma unroll
            for (int m = 0; m < 4; ++m)
#pragma unroll
                for (int n = 0; n < 2; ++n) acc[a][b][m][n] = (f32x4){0.f, 0.f, 0.f, 0.f};
    bf16x8 At[4][2], B0[2][2], B1[2][2];
    const char* cA = (const char*)g.A + (size_t)cur.pm * tstepA; const char* cB = (const char*)g.Bt + (size_t)cur.pn * tstepB;
    S.a_ready(cur);
    if constexpr (SP2) {
        PG8_STAGE(PG8_SB(0, 0), cB, voffB); PG8_STAGE(PG8_SB(0, 1), cB + hstepB, voffB); PG8_STAGE(PG8_SA(0, 0), cA, voffA); PG8_STAGE(PG8_SA(0, 1), cA + hstepA, voffA);
        if (wr == 1) PG8_BAR;
        PG8_WAIT_V(2); PG8_BAR;
        PG8_STAGE(PG8_SB(1, 0), cB + kstep, voffB); PG8_STAGE(PG8_SA(1, 0), cA + kstep, voffA); PG8_STAGE(PG8_SB(1, 1), cB + hstepB + kstep, voffB);
        PG8_WAIT_V(6); PG8_BAR;
    } else {
        PG8_STAGE(PG8_SB(0, 0), cB, voffB); PG8_STAGE(PG8_SA(0, 0), cA, voffA); PG8_STAGE(PG8_SB(0, 1), cB + hstepB, voffB); PG8_STAGE(PG8_SA(0, 1), cA + hstepA, voffA);
        if (wr == 1) PG8_BAR;
        PG8_WAIT_V(4); PG8_BAR;
        PG8_STAGE(PG8_SB(1, 0), cB + kstep, voffB); PG8_STAGE(PG8_SA(1, 0), cA + kstep, voffA); PG8_STAGE(PG8_SB(1, 1), cB + hstepB + kstep, voffB);
        PG8_WAIT_V(6); PG8_BAR;
    }
    for (;;) {
        const bool has_next = S.next(ui + 1, nxt);
        const char* nA = has_next ? (const char*)g.A + (size_t)nxt.pm * tstepA : cA; const char* nB = has_next ? (const char*)g.Bt + (size_t)nxt.pn * tstepB : cB;
        GSEC_ACC(6, -);
        for (int t = 0; t < nt; t += 2) {
            const bool last = (t == nt - 2);
            const char* a1 = cA + (size_t)(t + 1) * kstep;
            const char* a2 = last ? nA : cA + (size_t)(t + 2) * kstep; const char* b2 = last ? nB : cB + (size_t)(t + 2) * kstep;
            const char* a3 = a2 + kstep; const char* b3 = b2 + kstep;
            if (last && has_next) S.a_ready(nxt);
            if constexpr (SP2) {
            PG8_LDB(B0, 0, 0); PG8_LDB(B1, 0, 1); PG8_SCHED; PG8_LDA(At, 0, 0); PG8_STAGE(PG8_SA(1, 1), a1 + hstepA, voffA);
            PG8_WAIT_V(8); PG8_WAIT_L(0); PG8_BAR; PG8_MMA(0, 0, At, B0); PG8_MMA(0, 1, At, B1); PG8_BAR; PG8_SCHED;
            PG8_LDA(At, 0, 1); PG8_STAGE(PG8_SB(0, 0), b2, voffB); PG8_STAGE(PG8_SB(0, 1), b2 + hstepB, voffB); PG8_STAGE(PG8_SA(0, 0), a2, voffA);
            PG8_WAIT_V(8); PG8_WAIT_L(0); PG8_BAR; PG8_MMA(1, 0, At, B0); PG8_MMA(1, 1, At, B1); PG8_BAR; PG8_SCHED;
            PG8_LDB(B0, 1, 0); PG8_LDB(B1, 1, 1); PG8_SCHED; PG8_LDA(At, 1, 0); PG8_STAGE(PG8_SA(0, 1), a2 + hstepA, voffA);
            PG8_WAIT_V(8); PG8_WAIT_L(0); PG8_BAR; PG8_MMA(0, 0, At, B0); PG8_MMA(0, 1, At, B1); PG8_BAR; PG8_SCHED;
            PG8_LDA(At, 1, 1); PG8_STAGE(PG8_SB(1, 0), b3, voffB); PG8_STAGE(PG8_SB(1, 1), b3 + hstepB, voffB); PG8_STAGE(PG8_SA(1, 0), a3, voffA);
            PG8_WAIT_V(8); PG8_WAIT_L(0); PG8_BAR; PG8_MMA(1, 0, At, B0); PG8_MMA(1, 1, At, B1); PG8_BAR; PG8_SCHED;
            } else {
            PG8_LDB(B0, 0, 0); PG8_SCHED; PG8_LDA(At, 0, 0); PG8_STAGE(PG8_SA(1, 1), a1 + hstepA, voffA);
            PG8_WAIT_L(8); PG8_BAR; PG8_WAIT_L(0); PG8_MMA(0, 0, At, B0); PG8_BAR; PG8_SCHED;
            PG8_LDB(B1, 0, 1); PG8_STAGE(PG8_SB(0, 0), b2, voffB);
            PG8_BAR; PG8_WAIT_L(0); PG8_MMA(0, 1, At, B1); PG8_BAR;
            PG8_LDA(At, 0, 1); PG8_STAGE(PG8_SA(0, 0), a2, voffA);
            PG8_BAR; PG8_WAIT_L(0); PG8_MMA(1, 0, At, B0); PG8_BAR; PG8_SCHED;
            PG8_STAGE(PG8_SB(0, 1), b2 + hstepB, voffB);
            PG8_WAIT_V(6); PG8_BAR; PG8_MMA(1, 1, At, B1); PG8_BAR;
            PG8_LDB(B0, 1, 0); PG8_SCHED; PG8_LDA(At, 1, 0); PG8_STAGE(PG8_SA(0, 1), a2 + hstepA, voffA);
            PG8_WAIT_L(8); PG8_BAR; PG8_WAIT_L(0); PG8_MMA(0, 0, At, B0); PG8_BAR; PG8_SCHED;
            PG8_LDB(B1, 1, 1); PG8_STAGE(PG8_SB(1, 0), b3, voffB);
            PG8_BAR; PG8_WAIT_L(0); PG8_MMA(0, 1, At, B1); PG8_BAR;
            PG8_LDA(At, 1, 1); PG8_STAGE(PG8_SA(1, 0), a3, voffA);
            PG8_BAR; PG8_WAIT_L(0); PG8_MMA(1, 0, At, B0); PG8_BAR; PG8_SCHED;
            PG8_STAGE(PG8_SB(1, 1), b3 + hstepB, voffB);
            PG8_WAIT_V(6); PG8_BAR; PG8_MMA(1, 1, At, B1); PG8_BAR;
            }
        }
        GSEC_ACC(6, +); GSEC_ACC(7, -);
        if constexpr (ALIGN_EPI) { if (wr == 0) PG8_BAR; }
        if constexpr (!Epi::AFTER_DRAIN) { E(acc, cur, wr, wc, fr, fq); S.done(cur); }
        GSEC_ACC(7, +);
        if (!has_next) break;
#pragma unroll
        for (int a = 0; a < 2; ++a)
#pragma unroll
            for (int b = 0; b < 2; ++b)
#pragma unroll
                for (int m = 0; m < 4; ++m)
#pragma unroll
                    for (int n = 0; n < 2; ++n) acc[a][b][m][n] = (f32x4){0.f, 0.f, 0.f, 0.f};
        cur = nxt; cA = nA; cB = nB; ++ui;
        if constexpr (ALIGN_EPI) { if (wr == 1) PG8_BAR; }
    }
    PG8_WAIT_V(0);
    if constexpr (!ALIGN_EPI) { if (wr == 0) PG8_BAR; }
    PG8_BAR;
    if constexpr (Epi::AFTER_DRAIN) { E.fused(acc, cur, wr, wc, fr, fq, lds, wid, lane); S.done(cur); }
#undef PG8_SA
#undef PG8_SB
#undef PG8_STAGE
#undef PG8_LDA
#undef PG8_LDB
#undef PG8_MMA
#undef PG8_WAIT_V
#undef PG8_WAIT_L
#undef PG8_BAR
#undef PG8_SCHED
}
}

constexpr int NWAVES = 8;
constexpr int BATCH = 8, SEQ = 4096, TT = BATCH * SEQ, D = 1024;
constexpr int HK = 8, HV = 16, HD = 128;
constexpr int GIN = 6176, GINP = 6400;
constexpr int FF = 3584, NE = 8, MOE_ROWS = 67584;
constexpr float ALPHA = 1.6817928305074290f;
constexpr float LN_EPS = 1e-5f, RMS_EPS = 1e-6f;
constexpr int NPH = 18, NPHASES = 2 * NPH;

constexpr size_t MiB = 1ull << 20;
constexpr size_t WS_CTL = 0, CTL_ZERO_BYTES = 1 * MiB;
constexpr size_t WS_E12 = 1 * MiB;
constexpr size_t WS_G12 = WS_E12 + 256 * 1024;
constexpr size_t WS_POS = WS_G12 + 256 * 1024;
constexpr size_t WS_GB = 2 * MiB;
constexpr size_t WS_W = 16 * MiB;
constexpr size_t WS_W2 = 912 * MiB;
constexpr size_t W_IN = WS_W2, W_OUT = WS_W2 + 13 * MiB, W_GU = WS_W2 + 17 * MiB, W_D = WS_W2 + 31 * MiB;
constexpr size_t W_QKV = WS_W, W_O = WS_W + 6 * MiB, W_MGU = WS_W + 8 * MiB, W_MD = WS_W + 120 * MiB;
constexpr size_t WS_HB = 192 * MiB;
constexpr size_t WS_BIG = 256 * MiB;
constexpr size_t WS_ZB = WS_BIG, WS_RAW = WS_BIG + 128 * MiB, WS_QKVC = WS_BIG + 400 * MiB;
constexpr int RAWLD = 4352;
constexpr size_t WS_WMEM = WS_RAW, WS_IMEM = WS_RAW + 128 * MiB, WS_KTMEM = WS_RAW + 192 * MiB;
constexpr size_t WS_STATS = 12 * MiB;
constexpr size_t WS_GTAB = 6 * MiB;
constexpr size_t WS_ACT = WS_BIG;
constexpr size_t WS_QKV = WS_BIG, WS_AO = WS_BIG + 192 * MiB;
constexpr size_t WS_XS = WS_BIG, WS_MACT = WS_BIG + 132 * MiB;
constexpr size_t WS_YT = 850 * MiB;
constexpr size_t WS_END = 950 * MiB;
static_assert(WS_QKVC + (size_t)TT * 4096 * 2 <= WS_W2 && WS_MACT + (size_t)MOE_ROWS * FF * 2 <= WS_END && WS_RAW + (size_t)TT * RAWLD * 2 <= WS_QKVC && WS_KTMEM + (size_t)4096 * 8192 * 2 <= WS_QKVC && WS_GTAB + (size_t)8192 * 192 * 4 <= WS_W, "d_ws map");
static_assert(W_MD + (size_t)NE * D * FF * 2 <= WS_HB && W_IN + (size_t)GINP * D * 2 <= W_OUT && W_D + (size_t)D * FF * 2 <= WS_END && WS_QKVC + (size_t)TT * 4096 * 2 <= WS_W2 && W_MGU + (size_t)NE * 2 * FF * D * 2 <= W_MD, "weight map");
constexpr int CW_BAR = 4096;
constexpr int CW_CNT = 16384;

constexpr int RING_BYTES = 131072;
constexpr int MISC_OFF = RING_BYTES + 320;
constexpr int OGST_OFF = 147456;
#define SEC_IN(k) do { if (PROBE_SEC == (k)) { if (blockIdx.x == 0 && (threadIdx.x == 0)) ((volatile LAS unsigned*)((LAS unsigned char*)0 + MISC_OFF))[20] -= (unsigned)__builtin_amdgcn_s_memrealtime(); } } while (0)
#define SEC_OUT(k) do { if (PROBE_SEC == (k)) { if (blockIdx.x == 0 && (threadIdx.x == 0)) ((volatile LAS unsigned*)((LAS unsigned char*)0 + MISC_OFF))[20] += (unsigned)__builtin_amdgcn_s_memrealtime(); } } while (0)
constexpr int LDS_BYTES = 163840;

#define GAS __attribute__((address_space(1)))
#define LAS __attribute__((address_space(3)))
#define DI __device__ __forceinline__
typedef unsigned short bf16;
typedef unsigned v4u __attribute__((ext_vector_type(4)));
typedef unsigned v2u __attribute__((ext_vector_type(2)));
typedef float f32x4 __attribute__((ext_vector_type(4)));
typedef float f32x2 __attribute__((ext_vector_type(2)));
typedef GAS unsigned gu32;
#define RLX_AGENT __ATOMIC_RELAXED, __HIP_MEMORY_SCOPE_AGENT
#define LDS_WAIT() asm volatile("s_waitcnt lgkmcnt(0)" ::: "memory")
#define VM_WAIT() asm volatile("s_waitcnt vmcnt(0)" ::: "memory")
__device__ __forceinline__ unsigned long long rt() { return __builtin_amdgcn_s_memrealtime(); }
__device__ __forceinline__ unsigned f2bf(float f) { unsigned u = __builtin_bit_cast(unsigned, f); return (u + 0x7fffu + ((u >> 16) & 1u)) >> 16; }
__device__ __forceinline__ unsigned pk2(float lo, float hi) { return f2bf(lo) | (f2bf(hi) << 16); }

#define XB_TMO      128
#define XB_XCNT(j)  (256  + 64 * (j))
#define XB_XSUB(j)  (1280 + 64 * (j))
#define XB_XGEN(j)  (2304 + 64 * (j))
#define XB_TOP      3328
#define XB_TOPGEN   3392
#define XCD_BAR_WORDS 3456
#define XB_SPIN_CAP (1u << 22)

__device__ __forceinline__ unsigned xb_ld(unsigned* p)              { return __hip_atomic_load(p, __ATOMIC_RELAXED, __HIP_MEMORY_SCOPE_AGENT); }
__device__ __forceinline__ unsigned xb_add(unsigned* p, unsigned v) { return __hip_atomic_fetch_add(p, v, __ATOMIC_RELAXED, __HIP_MEMORY_SCOPE_AGENT); }
__device__ __forceinline__ unsigned xb_xcc_id() { return (unsigned)__builtin_amdgcn_s_getreg((3 << 11) | 20) & 0xFu; }
#define XB_SPIN(cond, bar) do { unsigned _sp = 0; while (cond) { __builtin_amdgcn_s_sleep(1); \
    if ((++_sp & 255u) == 0u) { if (xb_ld(&(bar)[XB_TMO])) break; if (_sp > XB_SPIN_CAP) { atomicAdd(&(bar)[XB_TMO], 1u); break; } } } } while (0)

struct XcdBarrier {
    unsigned* bar; unsigned x;
    volatile LAS unsigned* st;
};

__device__ __forceinline__ XcdBarrier xcd_barrier_post(unsigned* bar, volatile LAS unsigned* st) {
    XcdBarrier b; b.bar = bar; b.x = xb_xcc_id(); b.st = st;
    if (threadIdx.x == 0) (void)xb_add(&bar[XB_XCNT(b.x)], 1u);
    return b;
}
__device__ __forceinline__ void xcd_barrier_complete(unsigned* bar, unsigned x, unsigned& nloc, unsigned& nx) {
    const unsigned G = gridDim.x * gridDim.y * gridDim.z;
    unsigned sum, cnt, mine, sp = 0u;
    for (;;) {
        sum = 0u; cnt = 0u; mine = 0u;
#pragma unroll
        for (unsigned j = 0; j < 16; ++j) { const unsigned c = xb_ld(&bar[XB_XCNT(j)]); sum += c; cnt += (c > 0u) ? 1u : 0u; mine = (j == x) ? c : mine; }
        if (sum == G) break;
        __builtin_amdgcn_s_sleep(1);
        if ((++sp & 255u) == 0u) { if (xb_ld(&bar[XB_TMO])) break; if (sp > XB_SPIN_CAP) { atomicAdd(&bar[XB_TMO], 1u); break; } }
    }
    nloc = mine > 0u ? mine : 1u; nx = cnt > 0u ? cnt : 1u;
}

__device__ __forceinline__ void xcd_barrier(const XcdBarrier& b) {
    asm volatile("s_waitcnt vmcnt(0)" ::: "memory");
    __syncthreads();
    if (threadIdx.x == 0) {
        unsigned* bar = b.bar;
        __builtin_amdgcn_s_waitcnt(0);
        unsigned nloc = b.st[0], nx = b.st[1];
        if (nloc == 0u) { xcd_barrier_complete(bar, b.x, nloc, nx); b.st[0] = nloc; b.st[1] = nx; }
        const unsigned old = xb_add(&bar[XB_XSUB(b.x)], 1u);
        const unsigned gen = old / nloc;
        if (old + 1u == (gen + 1u) * nloc) {
            __builtin_amdgcn_fence(__ATOMIC_RELEASE, "agent");
            asm volatile("s_waitcnt vmcnt(0)" ::: "memory");
            const unsigned og = xb_add(&bar[XB_TOP], 1u);
            const unsigned tg = og / nx;
            if (og + 1u == (tg + 1u) * nx) xb_add(&bar[XB_TOPGEN], 1u);
            else XB_SPIN(xb_ld(&bar[XB_TOPGEN]) == tg, bar);
            __builtin_amdgcn_fence(__ATOMIC_ACQUIRE, "agent");
            xb_add(&bar[XB_XGEN(b.x)], 1u);
            asm volatile("s_waitcnt vmcnt(0)" ::: "memory");
        } else {
            XB_SPIN(xb_ld(&bar[XB_XGEN(b.x)]) == gen, bar);
            __builtin_amdgcn_fence(__ATOMIC_ACQUIRE, "agent");
            asm volatile("s_waitcnt vmcnt(0)" ::: "memory");
        }
    }
    __syncthreads();
}

DI float bf_lo(unsigned w) { return __uint_as_float(w << 16); }
DI float bf_hi(unsigned w) { return __uint_as_float(w & 0xffff0000u); }
DI float wave_sum(float v) {
    v += __builtin_bit_cast(float, __builtin_amdgcn_update_dpp(0, __builtin_bit_cast(int, v), 0xB1, 0xF, 0xF, false));
    v += __builtin_bit_cast(float, __builtin_amdgcn_update_dpp(0, __builtin_bit_cast(int, v), 0x4E, 0xF, 0xF, false));
    v += __builtin_bit_cast(float, __builtin_amdgcn_update_dpp(0, __builtin_bit_cast(int, v), 0x141, 0xF, 0xF, false));
    v += __builtin_bit_cast(float, __builtin_amdgcn_update_dpp(0, __builtin_bit_cast(int, v), 0x140, 0xF, 0xF, false));
    v += __builtin_bit_cast(float, __builtin_amdgcn_update_dpp(0, __builtin_bit_cast(int, v), 0x142, 0xA, 0xF, false));
    v += __builtin_bit_cast(float, __builtin_amdgcn_update_dpp(0, __builtin_bit_cast(int, v), 0x143, 0xC, 0xF, false));
    return __builtin_bit_cast(float, __builtin_amdgcn_readlane(__builtin_bit_cast(int, v), 63));
}
DI float sigmoid_f(float x) { return 1.0f / (1.0f + __expf(-x)); }

struct Args {
    const float *x, *gdn_w_in, *gdn_conv_w, *gdn_a_log, *gdn_dt_bias, *gdn_norm_w, *gdn_w_out, *sb_w_in, *sb_w_out, *ffn_w_gate, *ffn_w_up, *ffn_w_down,
                *moe_router, *moe_w_gate, *moe_w_up, *moe_w_down, *ln_g, *ln_b;
    float* out; unsigned char* ws; int ph_lo, ph_hi;
};

DI void transpose_item(const float* W, int ldw, bf16* WT, int K, int drow0, int k0, int n0, LAS float* scr, int lane) {
#pragma unroll 8
    for (int i = 0; i < 32; ++i) { const int kk = 2 * i + (lane >> 5); scr[kk * 33 + (lane & 31)] = W[(size_t)(k0 + kk) * ldw + n0 + (lane & 31)]; }
    LDS_WAIT(); asm volatile("" ::: "memory");
    const int c = lane & 7;
#pragma unroll
    for (int jj = 0; jj < 4; ++jj) { const int n = (lane >> 3) + 8 * jj; const LAS float* s = scr + (8 * c) * 33 + n;
        v4u o; o.x = pk2(s[0 * 33], s[1 * 33]); o.y = pk2(s[2 * 33], s[3 * 33]); o.z = pk2(s[4 * 33], s[5 * 33]); o.w = pk2(s[6 * 33], s[7 * 33]);
        *(v4u*)(WT + (size_t)(drow0 + n) * K + k0 + 8 * c) = o; }
    LDS_WAIT(); asm volatile("" ::: "memory");
}

DI void transpose_item64(const float* W, int ldw, bf16* WT, int K, int drow0, int k0, int n0, LAS unsigned char* scr, int lane) {
    const int q = lane >> 4, cx = lane & 15;
    f32x4 r[16];
#pragma unroll
    for (int i = 0; i < 16; ++i) r[i] = *(const f32x4*)(W + (size_t)(k0 + 16 * q + i) * ldw + n0 + 4 * cx);
#pragma unroll
    for (int e = 0; e < 4; ++e) {
        v4u w0, w1;
        w0.x = pk2(r[0][e], r[1][e]); w0.y = pk2(r[2][e], r[3][e]); w0.z = pk2(r[4][e], r[5][e]); w0.w = pk2(r[6][e], r[7][e]);
        w1.x = pk2(r[8][e], r[9][e]); w1.y = pk2(r[10][e], r[11][e]); w1.z = pk2(r[12][e], r[13][e]); w1.w = pk2(r[14][e], r[15][e]);
        *(LAS v4u*)(scr + (4 * cx + e) * 144 + q * 32) = w0; *(LAS v4u*)(scr + (4 * cx + e) * 144 + q * 32 + 16) = w1;
    }
    LDS_WAIT(); asm volatile("" ::: "memory");
#pragma unroll
    for (int j = 0; j < 8; ++j) { const int id = lane + 64 * j, n = id >> 3, kp = id & 7;
        *(v4u*)(WT + (size_t)(drow0 + n) * K + k0 + 8 * kp) = *(const LAS v4u*)(scr + n * 144 + kp * 16); }
    LDS_WAIT(); asm volatile("" ::: "memory");
}

DI void phase_w_gdn(const Args& a, int j, LAS unsigned char* lds, int bid, int G, int tid, int wave, int lane) {
    LAS float* scr = (LAS float*)(lds + wave * 16384);
    const int gw = bid * NWAVES + wave, NGW = G * NWAVES;
    const float* Win = a.gdn_w_in + (size_t)j * D * GIN; const float* Wout = a.gdn_w_out + (size_t)j * 2048 * D;
    const float* Wg = a.ffn_w_gate + (size_t)j * D * FF; const float* Wu = a.ffn_w_up + (size_t)j * D * FF; const float* Wd = a.ffn_w_down + (size_t)j * FF * D;
    bf16* WIN_T = (bf16*)(a.ws + W_IN); bf16* WOUT_T = (bf16*)(a.ws + W_OUT); bf16* WGU_T = (bf16*)(a.ws + W_GU); bf16* WD_T = (bf16*)(a.ws + W_D);
    LAS unsigned char* scb = (LAS unsigned char*)scr;
    constexpr int I_IN = 16 * 96, I_INT = 16, I_OUT = 32 * 16, I_G = 16 * 56, I_D = 56 * 16, NIT = I_IN + I_INT + I_OUT + 2 * I_G + I_D;
    for (int it = gw; it < NIT; it += NGW) {
        int r = it;
        if (r < I_IN) { const int kb = r / 96, nb = r % 96; transpose_item64(Win, GIN, WIN_T, D, 64 * nb, 64 * kb, 64 * nb, scb, lane); continue; } r -= I_IN;
        if (r < I_INT) { transpose_item(Win, GIN, WIN_T, D, 6144, 64 * r, 6144, scr, lane); continue; } r -= I_INT;
        if (r < I_OUT) { const int kb = r / 16, nb = r % 16; transpose_item64(Wout, D, WOUT_T, 2048, 64 * nb, 64 * kb, 64 * nb, scb, lane); continue; } r -= I_OUT;
        if (r < I_G) { const int kb = r / 56, nb = r % 56, n0 = 64 * nb; transpose_item64(Wg, FF, WGU_T, D, 256 * (n0 >> 7) + (n0 & 127), 64 * kb, n0, scb, lane); continue; } r -= I_G;
        if (r < I_G) { const int kb = r / 56, nb = r % 56, n0 = 64 * nb; transpose_item64(Wu, FF, WGU_T, D, 256 * (n0 >> 7) + 128 + (n0 & 127), 64 * kb, n0, scb, lane); continue; } r -= I_G;
        { const int kb = r / 16, nb = r % 16; transpose_item64(Wd, D, WD_T, FF, 64 * nb, 64 * kb, 64 * nb, scb, lane); }
    }
    if (j == 0) {
        bf16* HB = (bf16*)(a.ws + WS_HB); const f32x4* x4 = (const f32x4*)a.x;
        for (size_t i = (size_t)bid * 512 + tid; i < (size_t)TT * D / 8; i += (size_t)G * 512) { const f32x4 p = x4[2 * i], q = x4[2 * i + 1];
            v4u o; o.x = pk2(p[0], p[1]); o.y = pk2(p[2], p[3]); o.z = pk2(q[0], q[1]); o.w = pk2(q[2], q[3]); *(v4u*)(HB + 8 * i) = o; }
    }
}
DI void phase_w_sb(const Args& a, int j, LAS unsigned char* lds, int bid, int G, int wave, int lane) {
    LAS float* scr = (LAS float*)(lds + wave * 16384);
    const int gw = bid * NWAVES + wave, NGW = G * NWAVES;
    const float* Wqkv = a.sb_w_in + (size_t)j * D * 3072; const float* Wo = a.sb_w_out + (size_t)j * D * D;
    const float* Mg = a.moe_w_gate + (size_t)j * NE * D * FF; const float* Mu = a.moe_w_up + (size_t)j * NE * D * FF; const float* Md = a.moe_w_down + (size_t)j * NE * FF * D;
    bf16* WQKV_T = (bf16*)(a.ws + W_QKV); bf16* WO_T = (bf16*)(a.ws + W_O); bf16* MGU_T = (bf16*)(a.ws + W_MGU); bf16* MD_T = (bf16*)(a.ws + W_MD);
    LAS unsigned char* scb = (LAS unsigned char*)scr;
    constexpr int I_QKV = 16 * 48, I_O = 16 * 16, I_G = 16 * 56, I_D = 56 * 16, I_E = 2 * I_G + I_D, NIT = I_QKV + I_O + NE * I_E;
    for (int it = gw; it < NIT; it += NGW) {
        int r = it;
        if (r < I_QKV) { const int kb = r / 48, nb = r % 48; transpose_item64(Wqkv, 3072, WQKV_T, D, 64 * nb, 64 * kb, 64 * nb, scb, lane); continue; } r -= I_QKV;
        if (r < I_O) { const int kb = r / 16, nb = r % 16; transpose_item64(Wo, D, WO_T, D, 64 * nb, 64 * kb, 64 * nb, scb, lane); continue; } r -= I_O;
        const int e = r / I_E; r -= e * I_E;
        bf16* gu = MGU_T + (size_t)e * 2 * FF * D; bf16* dn = MD_T + (size_t)e * D * FF;
        if (r < I_G) { const int kb = r / 56, nb = r % 56, n0 = 64 * nb; transpose_item64(Mg + (size_t)e * D * FF, FF, gu, D, 256 * (n0 >> 7) + (n0 & 127), 64 * kb, n0, scb, lane); continue; } r -= I_G;
        if (r < I_G) { const int kb = r / 56, nb = r % 56, n0 = 64 * nb; transpose_item64(Mu + (size_t)e * D * FF, FF, gu, D, 256 * (n0 >> 7) + 128 + (n0 & 127), 64 * kb, n0, scb, lane); continue; } r -= I_G;
        { const int kb = r / 16, nb = r % 16; transpose_item64(Md + (size_t)e * FF * D, D, dn, FF, 64 * nb, 64 * kb, 64 * nb, scb, lane); }
    }
}

DI float dpp_sum16(float v) {
    v += __builtin_bit_cast(float, __builtin_amdgcn_update_dpp(0, __builtin_bit_cast(int, v), 0xB1, 0xF, 0xF, false));
    v += __builtin_bit_cast(float, __builtin_amdgcn_update_dpp(0, __builtin_bit_cast(int, v), 0x4E, 0xF, 0xF, false));
    v += __builtin_bit_cast(float, __builtin_amdgcn_update_dpp(0, __builtin_bit_cast(int, v), 0x141, 0xF, 0xF, false));
    v += __builtin_bit_cast(float, __builtin_amdgcn_update_dpp(0, __builtin_bit_cast(int, v), 0x140, 0xF, 0xF, false));
    return v;
}
DI void phase_conv(const Args& a, int j, int bid, int G, int tid) {
    const bf16* raw = (const bf16*)(a.ws + WS_RAW); bf16* qkvc = (bf16*)(a.ws + WS_QKVC); float* gb = (float*)(a.ws + WS_GB);
    const float* cw = a.gdn_conv_w + (size_t)j * 4 * 4096;
    const int ch = 8 * tid;
    float w0[8], w1[8], w2[8], w3[8];
#pragma unroll
    for (int i = 0; i < 8; ++i) { w0[i] = cw[ch + i]; w1[i] = cw[4096 + ch + i]; w2[i] = cw[2 * 4096 + ch + i]; w3[i] = cw[3 * 4096 + ch + i]; }
    const float post = tid < 128 ? 0.08838834764831845f : 1.0f;
    for (int run = bid; run < TT / 128; run += G) {
        const int t0 = run * 128; const bool first = (t0 & (SEQ - 1)) == 0;
        float xa[8], xb[8], xc[8];
        { v4u h0 = {0u, 0u, 0u, 0u}, h1 = h0, h2 = h0;
          if (!first) { h0 = *(const v4u*)(raw + (size_t)(t0 - 3) * RAWLD + ch); h1 = *(const v4u*)(raw + (size_t)(t0 - 2) * RAWLD + ch); h2 = *(const v4u*)(raw + (size_t)(t0 - 1) * RAWLD + ch); }
          xa[0] = bf_lo(h0.x); xa[1] = bf_hi(h0.x); xa[2] = bf_lo(h0.y); xa[3] = bf_hi(h0.y); xa[4] = bf_lo(h0.z); xa[5] = bf_hi(h0.z); xa[6] = bf_lo(h0.w); xa[7] = bf_hi(h0.w);
          xb[0] = bf_lo(h1.x); xb[1] = bf_hi(h1.x); xb[2] = bf_lo(h1.y); xb[3] = bf_hi(h1.y); xb[4] = bf_lo(h1.z); xb[5] = bf_hi(h1.z); xb[6] = bf_lo(h1.w); xb[7] = bf_hi(h1.w);
          xc[0] = bf_lo(h2.x); xc[1] = bf_hi(h2.x); xc[2] = bf_lo(h2.y); xc[3] = bf_hi(h2.y); xc[4] = bf_lo(h2.z); xc[5] = bf_hi(h2.z); xc[6] = bf_lo(h2.w); xc[7] = bf_hi(h2.w); }
#pragma unroll 1
        for (int tb = 0; tb < 128; tb += 8) {
            v4u xr[8];
#pragma unroll
            for (int u = 0; u < 8; ++u) xr[u] = *(const v4u*)(raw + (size_t)(t0 + tb + u) * RAWLD + ch);
#pragma unroll
            for (int u = 0; u < 8; ++u) {
                float xd[8]; xd[0] = bf_lo(xr[u].x); xd[1] = bf_hi(xr[u].x); xd[2] = bf_lo(xr[u].y); xd[3] = bf_hi(xr[u].y); xd[4] = bf_lo(xr[u].z); xd[5] = bf_hi(xr[u].z); xd[6] = bf_lo(xr[u].w); xd[7] = bf_hi(xr[u].w);
                float y[8]; float ss = 0.f;
#pragma unroll
                for (int i = 0; i < 8; ++i) { const float c = w0[i] * xa[i] + w1[i] * xb[i] + w2[i] * xc[i] + w3[i] * xd[i];
                    y[i] = c * __builtin_amdgcn_rcpf(1.0f + __builtin_amdgcn_exp2f(-1.4426950408889634f * c)); ss += y[i] * y[i];
                    xa[i] = xb[i]; xb[i] = xc[i]; xc[i] = xd[i]; }
                if (tid < 256) {
                    const float rn = post / sqrtf(dpp_sum16(ss) + RMS_EPS);
#pragma unroll
                    for (int i = 0; i < 8; ++i) y[i] *= rn;
                }
                v4u o; o.x = pk2(y[0], y[1]); o.y = pk2(y[2], y[3]); o.z = pk2(y[4], y[5]); o.w = pk2(y[6], y[7]);
                *(v4u*)(qkvc + (size_t)(t0 + tb + u) * 4096 + ch) = o;
            }
        }
#pragma unroll
        for (int k = 0; k < 4; ++k) { const int item = tid + 512 * k, tok = t0 + (item >> 4), hv = item & 15;
            const float bb = __uint_as_float((unsigned)raw[(size_t)tok * RAWLD + 4096 + hv] << 16), aa = __uint_as_float((unsigned)raw[(size_t)tok * RAWLD + 4112 + hv] << 16);
            const float xx = aa + a.gdn_dt_bias[j * 16 + hv];
            const float sp = xx > 20.f ? xx : log1pf(__expf(xx));
            gb[(size_t)tok * 32 + hv] = -__expf(a.gdn_a_log[j * 16 + hv]) * sp;
            gb[(size_t)tok * 32 + 16 + hv] = sigmoid_f(bb); }
    }
}

DI void phase_gdn_naive(const Args& a, int j, LAS unsigned char* lds, int bid, int tid) {
    if (bid >= BATCH * HV) return;
    const int b = bid / HV, hv = bid % HV, hk = hv / 2, jc = tid & 127, r = tid >> 7;
    const bf16* zb = (const bf16*)(a.ws + WS_ZB); bf16* qkvc = (bf16*)(a.ws + WS_QKVC); const float* gb = (const float*)(a.ws + WS_GB);
    LAS float* qs = (LAS float*)lds; LAS float* ks = qs + 2048; LAS float* vs = ks + 2048; LAS float* gs = vs + 2048; LAS float* bs = gs + 16;
    LAS f32x2* red = (LAS f32x2*)(lds + 32768); LAS float* redkq = (LAS float*)(lds + 32768 + 8192); LAS float* ob = (LAS float*)(lds + 49152);
    float S[32];
#pragma unroll
    for (int i = 0; i < 32; ++i) S[i] = 0.f;
    const int lrow = tid >> 5, lcol = (tid & 31) * 4;
    for (int blk = 0; blk < SEQ / 16; ++blk) {
        const size_t t0 = (size_t)b * SEQ + blk * 16;
        __syncthreads();
        { const bf16* rowp = qkvc + (t0 + lrow) * 4096;
          const v2u qv = *(const v2u*)(rowp + hk * 128 + lcol), kv = *(const v2u*)(rowp + 1024 + hk * 128 + lcol), vv = *(const v2u*)(rowp + 2048 + hv * 128 + lcol);
          *(LAS f32x4*)(qs + lrow * 128 + lcol) = (f32x4){bf_lo(qv.x), bf_hi(qv.x), bf_lo(qv.y), bf_hi(qv.y)};
          *(LAS f32x4*)(ks + lrow * 128 + lcol) = (f32x4){bf_lo(kv.x), bf_hi(kv.x), bf_lo(kv.y), bf_hi(kv.y)};
          *(LAS f32x4*)(vs + lrow * 128 + lcol) = (f32x4){bf_lo(vv.x), bf_hi(vv.x), bf_lo(vv.y), bf_hi(vv.y)};
          if (tid < 16) { gs[tid] = __expf(gb[(t0 + tid) * 32 + hv]); bs[tid] = gb[(t0 + tid) * 32 + 16 + hv]; } }
        __syncthreads();
#pragma unroll 1
        for (int tt = 0; tt < 16; ++tt) {
            float pk = 0.f, pq = 0.f, pkq = 0.f;
#pragma unroll
            for (int i4 = 0; i4 < 8; ++i4) { const f32x4 k4 = *(const LAS f32x4*)(ks + tt * 128 + 32 * r + 4 * i4), q4 = *(const LAS f32x4*)(qs + tt * 128 + 32 * r + 4 * i4);
#pragma unroll
                for (int c = 0; c < 4; ++c) { pk += k4[c] * S[4 * i4 + c]; pq += q4[c] * S[4 * i4 + c]; pkq += k4[c] * q4[c]; } }
            const int buf = tt & 1;
            red[(buf * 4 + r) * 128 + jc] = (f32x2){pk, pq}; if (jc == 0) redkq[buf * 4 + r] = pkq;
            __syncthreads();
            float kS = 0.f, qS = 0.f, kq = 0.f;
#pragma unroll
            for (int rr = 0; rr < 4; ++rr) { const f32x2 p = red[(buf * 4 + rr) * 128 + jc]; kS += p.x; qS += p.y; kq += redkq[buf * 4 + rr]; }
            const float eg = gs[tt], vn = bs[tt] * (vs[tt * 128 + jc] - eg * kS);
#pragma unroll
            for (int i4 = 0; i4 < 8; ++i4) { const f32x4 k4 = *(const LAS f32x4*)(ks + tt * 128 + 32 * r + 4 * i4);
#pragma unroll
                for (int c = 0; c < 4; ++c) S[4 * i4 + c] = eg * S[4 * i4 + c] + k4[c] * vn; }
            if (r == 0) ob[tt * 128 + jc] = eg * qS + kq * vn;
        }
        __syncthreads();
        {
            const f32x4 o4 = *(const LAS f32x4*)(ob + lrow * 128 + lcol);
            float ss = o4[0] * o4[0] + o4[1] * o4[1] + o4[2] * o4[2] + o4[3] * o4[3];
            ss += __shfl_xor(ss, 1); ss += __shfl_xor(ss, 2); ss += __shfl_xor(ss, 4); ss += __shfl_xor(ss, 8); ss += __shfl_xor(ss, 16);
            const float rinv = 1.0f / sqrtf(ss * (1.0f / 128.0f) + RMS_EPS);
            const v2u zv = *(const v2u*)(zb + (t0 + lrow) * 2048 + hv * 128 + lcol);
            const f32x4 nw = *(const f32x4*)(a.gdn_norm_w + j * 128 + lcol);
            const float z0 = bf_lo(zv.x), z1 = bf_hi(zv.x), z2 = bf_lo(zv.y), z3 = bf_hi(zv.y);
            v2u o; o.x = pk2(o4[0] * rinv * nw[0] * z0 * sigmoid_f(z0), o4[1] * rinv * nw[1] * z1 * sigmoid_f(z1));
            o.y = pk2(o4[2] * rinv * nw[2] * z2 * sigmoid_f(z2), o4[3] * rinv * nw[3] * z3 * sigmoid_f(z3));
            *(v2u*)(qkvc + (t0 + lrow) * 4096 + 2048 + hv * 128 + lcol) = o;
        }
    }
}

DI void unpack8(const v4u w, float (&x)[8]) { x[0] = bf_lo(w.x); x[1] = bf_hi(w.x); x[2] = bf_lo(w.y); x[3] = bf_hi(w.y); x[4] = bf_lo(w.z); x[5] = bf_hi(w.z); x[6] = bf_lo(w.w); x[7] = bf_hi(w.w); }
template <bool ROUTER>
DI void phase_ln(const Args& a, const bf16* Y, int lnidx, int j, LAS unsigned char* lds, int bid, int G, int tid, int wave, int lane) {
    bf16* HB = (bf16*)(a.ws + WS_HB); float* stats = (float*)(a.ws + WS_STATS);
    const float* g = a.ln_g + (size_t)lnidx * D; const float* bta = a.ln_b + (size_t)lnidx * D;
    const int gw = bid * NWAVES + wave, NGW = G * NWAVES;
    LAS unsigned* lcnt = (LAS unsigned*)lds;
    LAS float* RT = (LAS float*)(lds + 1024);
    if (ROUTER) { if (tid < 8) lcnt[tid] = 0u;
        const float* R = a.moe_router + (size_t)j * D * NE;
#pragma unroll
        for (int i = 0; i < 2; ++i) { const int k = tid + 512 * i; const f32x4 r0 = *(const f32x4*)(R + k * 8), r1 = *(const f32x4*)(R + k * 8 + 4);
            RT[0 * 1024 + k] = r0[0]; RT[1 * 1024 + k] = r0[1]; RT[2 * 1024 + k] = r0[2]; RT[3 * 1024 + k] = r0[3]; RT[4 * 1024 + k] = r1[0]; RT[5 * 1024 + k] = r1[1]; RT[6 * 1024 + k] = r1[2]; RT[7 * 1024 + k] = r1[3]; }
        __syncthreads(); }
    float gv[2][8], bv[2][8];
#pragma unroll
    for (int q = 0; q < 2; ++q)
#pragma unroll
        for (int c = 0; c < 8; ++c) { gv[q][c] = g[8 * (lane + 64 * q) + c]; bv[q][c] = bta[8 * (lane + 64 * q) + c]; }
    v4u nx[2];
    if (gw < TT) { nx[0] = ((const v4u*)(Y + (size_t)gw * D))[lane]; nx[1] = ((const v4u*)(Y + (size_t)gw * D))[lane + 64]; }
    for (int t = gw; t < TT; t += NGW) {
        float v[2][8]; float s = 0.f;
        unpack8(nx[0], v[0]); unpack8(nx[1], v[1]);
        if (t + NGW < TT) { nx[0] = ((const v4u*)(Y + (size_t)(t + NGW) * D))[lane]; nx[1] = ((const v4u*)(Y + (size_t)(t + NGW) * D))[lane + 64]; }
#pragma unroll
        for (int q = 0; q < 2; ++q)
#pragma unroll
            for (int c = 0; c < 8; ++c) s += v[q][c];
        const float mean = wave_sum(s) * (1.0f / D); float s2 = 0.f;
#pragma unroll
        for (int q = 0; q < 2; ++q)
#pragma unroll
            for (int c = 0; c < 8; ++c) { v[q][c] -= mean; s2 += v[q][c] * v[q][c]; }
        const float rstd = 1.0f / sqrtf(wave_sum(s2) * (1.0f / D) + LN_EPS);
        if (lane == 0) *(f32x2*)(stats + 2 * (size_t)t) = (f32x2){mean, rstd};
#pragma unroll
        for (int q = 0; q < 2; ++q) {
#pragma unroll
            for (int c = 0; c < 8; ++c) v[q][c] = v[q][c] * rstd * gv[q][c] + bv[q][c];
            v4u o; o.x = pk2(v[q][0], v[q][1]); o.y = pk2(v[q][2], v[q][3]); o.z = pk2(v[q][4], v[q][5]); o.w = pk2(v[q][6], v[q][7]);
            ((v4u*)(HB + (size_t)t * D))[lane + 64 * q] = o; }
        if (ROUTER) {
            float lg[8];
#pragma unroll
            for (int e = 0; e < 8; ++e) { lg[e] = 0.f;
#pragma unroll
                for (int q = 0; q < 2; ++q) { const f32x4 r0 = *(const LAS f32x4*)(RT + e * 1024 + 8 * (lane + 64 * q)), r1 = *(const LAS f32x4*)(RT + e * 1024 + 8 * (lane + 64 * q) + 4);
                    lg[e] += (v[q][0] * r0[0] + v[q][1] * r0[1]) + (v[q][2] * r0[2] + v[q][3] * r0[3]) + (v[q][4] * r1[0] + v[q][5] * r1[1]) + (v[q][6] * r1[2] + v[q][7] * r1[3]); } }
#pragma unroll
            for (int e = 0; e < 8; ++e) lg[e] = wave_sum(lg[e]);
            int i1 = 0; float v1 = lg[0];
#pragma unroll
            for (int e = 1; e < 8; ++e) if (lg[e] > v1) { v1 = lg[e]; i1 = e; }
            int i2 = -1; float v2 = -3.0e38f;
#pragma unroll
            for (int e = 0; e < 8; ++e) if (e != i1 && lg[e] > v2) { v2 = lg[e]; i2 = e; }
            if (lane == 0) {
                const float g1 = 1.0f / (1.0f + __expf(v2 - v1));
                ((unsigned*)(a.ws + WS_E12))[t] = (unsigned)i1 | ((unsigned)i2 << 8);
                ((f32x2*)(a.ws + WS_G12))[t] = (f32x2){g1, 1.0f - g1};
                __hip_atomic_fetch_add(lcnt + i1, 1u, __ATOMIC_RELAXED, __HIP_MEMORY_SCOPE_WORKGROUP); __hip_atomic_fetch_add(lcnt + i2, 1u, __ATOMIC_RELAXED, __HIP_MEMORY_SCOPE_WORKGROUP);
            }
        }
    }
    if (ROUTER) { __syncthreads(); if (tid < 8) { unsigned* cnt = (unsigned*)(a.ws + WS_CTL) + CW_CNT + 256 * j; __hip_atomic_fetch_add(cnt + tid, lcnt[tid], __ATOMIC_RELAXED, __HIP_MEMORY_SCOPE_AGENT); } }
}

DI void phase_sb_naive(const Args& a, LAS unsigned char* lds, int bid, int G, int tid) {
    const bf16* qkv = (const bf16*)(a.ws + WS_QKV); bf16* ao = (bf16*)(a.ws + WS_AO);
    LAS unsigned char* Ks = lds; LAS unsigned char* Vs = lds + 16384;
    const int qi = tid >> 2, r = tid & 3;
    for (int idx = bid; idx < 64 * 32; idx += G) {
        const int qb = 31 - idx / 64, bh = idx % 64, b = bh >> 3, h = bh & 7;
        const int t = qb * 128 + qi;
        const size_t rowq = (size_t)b * SEQ + t;
        float q[32], o[32];
        { const bf16* qp = qkv + rowq * 3072 + h * 128 + 32 * r;
#pragma unroll
          for (int c = 0; c < 4; ++c) { const v4u w = *(const v4u*)(qp + 8 * c);
              q[8 * c + 0] = bf_lo(w.x); q[8 * c + 1] = bf_hi(w.x); q[8 * c + 2] = bf_lo(w.y); q[8 * c + 3] = bf_hi(w.y);
              q[8 * c + 4] = bf_lo(w.z); q[8 * c + 5] = bf_hi(w.z); q[8 * c + 6] = bf_lo(w.w); q[8 * c + 7] = bf_hi(w.w); }
#pragma unroll
          for (int i = 0; i < 32; ++i) { q[i] *= 0.08838834764831845f; o[i] = 0.f; } }
        float P = 1.0f;
        for (int kt = 2 * qb + 1; kt >= 0; --kt) {
            __syncthreads();
#pragma unroll
            for (int i = 0; i < 2; ++i) { const int c = tid + 512 * i, row = c >> 4, part = c & 15;
                const bf16* src = qkv + ((size_t)b * SEQ + kt * 64 + row) * 3072 + h * 128 + part * 8;
                *(LAS v4u*)(Ks + c * 16) = *(const v4u*)(src + 1024); *(LAS v4u*)(Vs + c * 16) = *(const v4u*)(src + 2048); }
            __syncthreads();
#pragma unroll 1
            for (int s = 63; s >= 0; --s) {
                float z = 0.f;
#pragma unroll
                for (int c = 0; c < 4; ++c) { const v4u w = *(const LAS v4u*)(Ks + s * 256 + r * 64 + c * 16);
                    z += q[8 * c + 0] * bf_lo(w.x) + q[8 * c + 1] * bf_hi(w.x) + q[8 * c + 2] * bf_lo(w.y) + q[8 * c + 3] * bf_hi(w.y)
                       + q[8 * c + 4] * bf_lo(w.z) + q[8 * c + 5] * bf_hi(w.z) + q[8 * c + 6] * bf_lo(w.w) + q[8 * c + 7] * bf_hi(w.w); }
                z += __shfl_xor(z, 1); z += __shfl_xor(z, 2);
                const bool live = (kt * 64 + s) < t;
                const float e = __expf(fminf(z, 80.f)), rr = 1.0f / (1.0f + e);
                const float A = live ? e * rr * P : 0.f;
                P = live ? P * rr : P;
#pragma unroll
                for (int c = 0; c < 4; ++c) { const v4u w = *(const LAS v4u*)(Vs + s * 256 + r * 64 + c * 16);
                    o[8 * c + 0] += A * bf_lo(w.x); o[8 * c + 1] += A * bf_hi(w.x); o[8 * c + 2] += A * bf_lo(w.y); o[8 * c + 3] += A * bf_hi(w.y);
                    o[8 * c + 4] += A * bf_lo(w.z); o[8 * c + 5] += A * bf_hi(w.z); o[8 * c + 6] += A * bf_lo(w.w); o[8 * c + 7] += A * bf_hi(w.w); }
            }
        }
        { bf16* op = ao + rowq * 1024 + h * 128 + 32 * r;
#pragma unroll
          for (int c = 0; c < 4; ++c) { v4u w; w.x = pk2(o[8 * c + 0], o[8 * c + 1]); w.y = pk2(o[8 * c + 2], o[8 * c + 3]); w.z = pk2(o[8 * c + 4], o[8 * c + 5]); w.w = pk2(o[8 * c + 6], o[8 * c + 7]);
              *(v4u*)(op + 8 * c) = w; } }
    }
}


typedef float f2v_ __attribute__((ext_vector_type(2)));
typedef __bf16 b2v_ __attribute__((ext_vector_type(2)));
DI unsigned gdnpk(float a, float b) { const f2v_ v = {a, b}; const b2v_ r = __builtin_convertvector(v, b2v_); return __builtin_bit_cast(unsigned, r); }
namespace sba {
using bf16x8 = __attribute__((ext_vector_type(8))) short;
using s16x4  = __attribute__((ext_vector_type(4))) short;
using f32x16 = __attribute__((ext_vector_type(16))) float;
constexpr int SHM_V = 16384, KPITCH = 272, SHM_K = 64 * KPITCH, LDQ = 3072;
#define KSWZ(row, colB) ((row) * KPITCH + (colB))
#define SBAR() __builtin_amdgcn_sched_barrier(0)
DI int crow(int r, int hi) { return (r & 3) + 8 * (r >> 2) + 4 * hi; }
DI int v_st(int k, int c) { const int kk = (k & ~0xC) | ((k & 4) << 1) | ((k & 8) >> 1); return ((kk >> 3) * 4 + (c >> 5)) * 512 + ((kk & 7) * 32 + (c & 31)) * 2; }
DI int v_rd_base(int lane) { return ((lane & 3) << 3) | (((lane >> 2) & 3) << 6) | (((lane >> 4) & 1) << 5) | (((lane >> 5) & 1) << 8); }
constexpr int v_rd_off(int d0, int ks, int half) { return d0 * 512 + ks * 4096 + half * 2048; }
template <int OFF> DI s16x4 tr_read(int vb) { s16x4 r; asm volatile("ds_read_b64_tr_b16 %0, %1 offset:%2" : "=&v"(r) : "v"(vb), "i"(OFF) : "memory"); return r; }
template <int D0> DI void pv_one(f32x16& od, int vb, bf16x8 pa0, bf16x8 pa1, bf16x8 pa2, bf16x8 pa3) {
  const s16x4 l0 = tr_read<v_rd_off(D0, 0, 0)>(vb), h0 = tr_read<v_rd_off(D0, 0, 1)>(vb), l1 = tr_read<v_rd_off(D0, 1, 0)>(vb), h1 = tr_read<v_rd_off(D0, 1, 1)>(vb);
  const s16x4 l2 = tr_read<v_rd_off(D0, 2, 0)>(vb), h2 = tr_read<v_rd_off(D0, 2, 1)>(vb), l3 = tr_read<v_rd_off(D0, 3, 0)>(vb), h3 = tr_read<v_rd_off(D0, 3, 1)>(vb);
  asm volatile("s_waitcnt lgkmcnt(0)" ::: "memory"); SBAR();
#define PK(L, H) (bf16x8){L[0], L[1], L[2], L[3], H[0], H[1], H[2], H[3]}
  od = __builtin_amdgcn_mfma_f32_32x32x16_bf16(pa0, PK(l0, h0), od, 0, 0, 0);
  od = __builtin_amdgcn_mfma_f32_32x32x16_bf16(pa1, PK(l1, h1), od, 0, 0, 0);
  od = __builtin_amdgcn_mfma_f32_32x32x16_bf16(pa2, PK(l2, h2), od, 0, 0, 0);
  od = __builtin_amdgcn_mfma_f32_32x32x16_bf16(pa3, PK(l3, h3), od, 0, 0, 0);
#undef PK
}
template <int D0> DI void pv_one_T(f32x16& od, int vb, bf16x8 pa0, bf16x8 pa1, bf16x8 pa2, bf16x8 pa3) {
  const s16x4 l0 = tr_read<v_rd_off(D0, 0, 0)>(vb), h0 = tr_read<v_rd_off(D0, 0, 1)>(vb), l1 = tr_read<v_rd_off(D0, 1, 0)>(vb), h1 = tr_read<v_rd_off(D0, 1, 1)>(vb);
  const s16x4 l2 = tr_read<v_rd_off(D0, 2, 0)>(vb), h2 = tr_read<v_rd_off(D0, 2, 1)>(vb), l3 = tr_read<v_rd_off(D0, 3, 0)>(vb), h3 = tr_read<v_rd_off(D0, 3, 1)>(vb);
  asm volatile("s_waitcnt lgkmcnt(0)" ::: "memory"); SBAR();
#define PK(L, H) (bf16x8){L[0], L[1], L[2], L[3], H[0], H[1], H[2], H[3]}
  od = __builtin_amdgcn_mfma_f32_32x32x16_bf16(PK(l0, h0), pa0, od, 0, 0, 0);
  od = __builtin_amdgcn_mfma_f32_32x32x16_bf16(PK(l1, h1), pa1, od, 0, 0, 0);
  od = __builtin_amdgcn_mfma_f32_32x32x16_bf16(PK(l2, h2), pa2, od, 0, 0, 0);
  od = __builtin_amdgcn_mfma_f32_32x32x16_bf16(PK(l3, h3), pa3, od, 0, 0, 0);
#undef PK
}
DI void pv_split(f32x16& od, int vb, bf16x8 pa0, bf16x8 pa1, bf16x8 pa2, bf16x8 pa3) {
  const s16x4 l0 = tr_read<v_rd_off(0, 0, 0)>(vb), h0 = tr_read<v_rd_off(0, 0, 1)>(vb), l1 = tr_read<v_rd_off(0, 1, 0)>(vb), h1 = tr_read<v_rd_off(0, 1, 1)>(vb);
  const s16x4 l2 = tr_read<v_rd_off(0, 2, 0)>(vb), h2 = tr_read<v_rd_off(0, 2, 1)>(vb), l3 = tr_read<v_rd_off(0, 3, 0)>(vb), h3 = tr_read<v_rd_off(0, 3, 1)>(vb);
  asm volatile("s_waitcnt lgkmcnt(0)" ::: "memory"); SBAR();
#define PK(L, H) (bf16x8){L[0], L[1], L[2], L[3], H[0], H[1], H[2], H[3]}
  f32x16 ob = {};
  od = __builtin_amdgcn_mfma_f32_32x32x16_bf16(pa0, PK(l0, h0), od, 0, 0, 0); ob = __builtin_amdgcn_mfma_f32_32x32x16_bf16(pa2, PK(l2, h2), ob, 0, 0, 0);
  od = __builtin_amdgcn_mfma_f32_32x32x16_bf16(pa1, PK(l1, h1), od, 0, 0, 0); ob = __builtin_amdgcn_mfma_f32_32x32x16_bf16(pa3, PK(l3, h3), ob, 0, 0, 0);
  od = od + ob;
#undef PK
}
DI void pv_split_T(f32x16& od, int vb, bf16x8 pa0, bf16x8 pa1, bf16x8 pa2, bf16x8 pa3) {
  const s16x4 l0 = tr_read<v_rd_off(0, 0, 0)>(vb), h0 = tr_read<v_rd_off(0, 0, 1)>(vb), l1 = tr_read<v_rd_off(0, 1, 0)>(vb), h1 = tr_read<v_rd_off(0, 1, 1)>(vb);
  const s16x4 l2 = tr_read<v_rd_off(0, 2, 0)>(vb), h2 = tr_read<v_rd_off(0, 2, 1)>(vb), l3 = tr_read<v_rd_off(0, 3, 0)>(vb), h3 = tr_read<v_rd_off(0, 3, 1)>(vb);
  asm volatile("s_waitcnt lgkmcnt(0)" ::: "memory"); SBAR();
#define PK(L, H) (bf16x8){L[0], L[1], L[2], L[3], H[0], H[1], H[2], H[3]}
  f32x16 ob = {};
  od = __builtin_amdgcn_mfma_f32_32x32x16_bf16(PK(l0, h0), pa0, od, 0, 0, 0); ob = __builtin_amdgcn_mfma_f32_32x32x16_bf16(PK(l2, h2), pa2, ob, 0, 0, 0);
  od = __builtin_amdgcn_mfma_f32_32x32x16_bf16(PK(l1, h1), pa1, od, 0, 0, 0); ob = __builtin_amdgcn_mfma_f32_32x32x16_bf16(PK(l3, h3), pa3, ob, 0, 0, 0);
  od = od + ob;
#undef PK
}
DI void qkt(f32x16& p0, f32x16& p1, const LAS unsigned char* Ks, const bf16x8 (&qr)[8], int r32, int hi) {
  p0 = f32x16{}; p1 = f32x16{};
#pragma unroll
  for (int d0 = 0; d0 < 8; ++d0) { const int cb = (d0 * 16 + hi * 8) * 2;
    const bf16x8 b0 = *(const LAS bf16x8*)(Ks + KSWZ(r32, cb));
    const bf16x8 b1 = *(const LAS bf16x8*)(Ks + KSWZ(32 + r32, cb));
    p0 = __builtin_amdgcn_mfma_f32_32x32x16_bf16(b0, qr[d0], p0, 0, 0, 0);
    p1 = __builtin_amdgcn_mfma_f32_32x32x16_bf16(b1, qr[d0], p1, 0, 0, 0); }
}
template <bool MASK> DI void sb_half(f32x16& p, float& Pc, int hi, int kbase, int trow) {
  float kk[16];
#pragma unroll
  for (int r = 0; r < 16; ++r) {
    float z = p[r];
    if (MASK) z = (kbase + crow(r, hi) < trow) ? z : -__builtin_inff();
    kk[r] = __builtin_amdgcn_rcpf(1.0f + __builtin_amdgcn_exp2f(z));
  }
  float R0[4], R1[4];
#pragma unroll
  for (int g = 0; g < 4; ++g) {
    const float c2 = kk[4 * g + 3], c1 = c2 * kk[4 * g + 2], c0 = c1 * kk[4 * g + 1], R = c0 * kk[4 * g];
    p[4 * g + 3] = 1.0f - c2; p[4 * g + 2] = c2 - c1; p[4 * g + 1] = c1 - c0; p[4 * g] = c0 - R;
    const auto sw = __builtin_amdgcn_permlane32_swap(__float_as_uint(R), __float_as_uint(R), false, false);
    R0[g] = __uint_as_float(sw[0]); R1[g] = __uint_as_float(sw[1]);
  }
#pragma unroll
  for (int g = 3; g >= 0; --g) {
    const float Pin = hi ? Pc : Pc * R1[g];
    p[4 * g + 3] *= Pin; p[4 * g + 2] *= Pin; p[4 * g + 1] *= Pin; p[4 * g] *= Pin;
    Pc *= R0[g] * R1[g];
  }
}
DI unsigned cvtpk(float lo, float hi) { unsigned r; asm volatile("v_cvt_pk_bf16_f32 %0, %1, %2" : "=v"(r) : "v"(lo), "v"(hi)); return r; }
#define PK4(P, BASE, OUT) do { const unsigned a0 = cvtpk(P[BASE + 0], P[BASE + 1]), a1 = cvtpk(P[BASE + 2], P[BASE + 3]);   \
    const unsigned b0 = cvtpk(P[BASE + 4], P[BASE + 5]), b1 = cvtpk(P[BASE + 6], P[BASE + 7]);                              \
    const auto r0 = __builtin_amdgcn_permlane32_swap(a0, b0, false, false); const auto r1 = __builtin_amdgcn_permlane32_swap(a1, b1, false, false); \
    const v4u w = {r0[0], r1[0], r0[1], r1[1]}; OUT = __builtin_bit_cast(bf16x8, w); } while (0)

DI void unit(const bf16* qkv, bf16* ao, int b, int h, int qb, LAS unsigned char* lds, int tid) {
  const int wid = __builtin_amdgcn_readfirstlane(tid >> 6), lane = tid & 63, r32 = lane & 31, hi = lane >> 5;
  const bool late = wid >= 4;
  LAS unsigned char* V_lds = lds; LAS unsigned char* K_lds = lds + 3 * SHM_V;
  const size_t rowbase = (size_t)b * SEQ; const int q0 = qb * 256, t_lo = q0 + wid * 32, trow = t_lo + r32;
  bf16x8 qr[8];
  { const bf16* Qw = qkv + (rowbase + trow) * LDQ + h * 128 + hi * 8; constexpr float C = 0.08838834764831845f * 1.4426950408889634f;
#pragma unroll
    for (int d0 = 0; d0 < 8; ++d0) { const v4u w = *(const v4u*)(Qw + d0 * 16); v4u o;
      o.x = gdnpk(bf_lo(w.x) * C, bf_hi(w.x) * C); o.y = gdnpk(bf_lo(w.y) * C, bf_hi(w.y) * C); o.z = gdnpk(bf_lo(w.z) * C, bf_hi(w.z) * C); o.w = gdnpk(bf_lo(w.w) * C, bf_hi(w.w) * C);
      qr[d0] = __builtin_bit_cast(bf16x8, o); } }
  const bf16* Kh = qkv + rowbase * LDQ + 1024 + h * 128; const bf16* Vh = Kh + 1024;
  const int sr = tid >> 4, sc = (tid & 15) * 8, vst0 = v_st(sr, sc), vst1 = v_st(32 + sr, sc);
  const int vb0 = (int)(unsigned)(size_t)V_lds + v_rd_base(lane);
  bf16x8 vs0, vs1, ks0, ks1;
  const unsigned soff = (unsigned)(sr * LDQ + sc) * 2u;
#define SLOAD(k0) do { const char* kb_ = (const char*)(Kh + (size_t)(k0) * LDQ); const char* vb_ = (const char*)(Vh + (size_t)(k0) * LDQ); \
    vs0 = *(const bf16x8*)(vb_ + soff); vs1 = *(const bf16x8*)(vb_ + (size_t)32 * LDQ * 2 + soff); ks0 = *(const bf16x8*)(kb_ + soff); ks1 = *(const bf16x8*)(kb_ + (size_t)32 * LDQ * 2 + soff); } while (0)
#define SWRITE(bb) do { *(LAS bf16x8*)(V_lds + (bb) * SHM_V + vst0) = vs0; *(LAS bf16x8*)(V_lds + (bb) * SHM_V + vst1) = vs1; const int kc = sc * 2; \
    *(LAS bf16x8*)(K_lds + (bb) * SHM_K + KSWZ(sr, kc)) = ks0; *(LAS bf16x8*)(K_lds + (bb) * SHM_K + KSWZ(32 + sr, kc)) = ks1; } while (0)
  f32x16 o[4] = {}; float Pc = 1.0f;
  f32x16 p0 = {}, p1 = {};
  const int NT = qb * 4 + 4;
  SLOAD((NT - 1) * 64);
  int bufc = 0, bufp = 0;
  for (int wi = 0; wi <= NT; ++wi) {
    const int kt = NT - 1 - wi, k0 = kt * 64;
    SEC_IN(4);
    if (wi < NT) { asm volatile("s_waitcnt vmcnt(0)" ::: "memory"); SWRITE(bufc); if (kt > 0) SLOAD(k0 - 64); }
    __syncthreads();
    SEC_OUT(4); SEC_IN(5);
    if (!late && wi < NT && k0 < t_lo + 31) { __builtin_amdgcn_s_setprio(1); qkt(p0, p1, K_lds + bufc * SHM_K, qr, r32, hi); __builtin_amdgcn_s_setprio(0); }
    { const int ka = late ? k0 + 64 : k0;
      const bool doit = late ? (wi > 0 && ka < t_lo + 31) : (wi < NT && k0 < t_lo + 31);
      if (doit) {
        bf16x8 pa0, pa1, pa2, pa3;
        if (ka + 63 >= t_lo) { sb_half<true>(p1, Pc, hi, ka + 32, trow); PK4(p1, 0, pa2); PK4(p1, 8, pa3); SBAR(); sb_half<true>(p0, Pc, hi, ka, trow); }
        else { sb_half<false>(p1, Pc, hi, ka + 32, trow); PK4(p1, 0, pa2); PK4(p1, 8, pa3); SBAR(); sb_half<false>(p0, Pc, hi, ka, trow); }
        PK4(p0, 0, pa0); PK4(p0, 8, pa1);
        const int vb = vb0 + (late ? bufp : bufc) * SHM_V;
        __builtin_amdgcn_s_setprio(1);
        pv_one<0>(o[0], vb, pa0, pa1, pa2, pa3); pv_one<1>(o[1], vb, pa0, pa1, pa2, pa3); pv_one<2>(o[2], vb, pa0, pa1, pa2, pa3); pv_one<3>(o[3], vb, pa0, pa1, pa2, pa3);
        __builtin_amdgcn_s_setprio(0);
      } }
    if (late && wi < NT && k0 < t_lo + 31) { __builtin_amdgcn_s_setprio(1); qkt(p0, p1, K_lds + bufc * SHM_K, qr, r32, hi); __builtin_amdgcn_s_setprio(0); }
    SEC_OUT(5);
    bufp = bufc; bufc = (bufc == 2) ? 0 : bufc + 1;
  }
  { bf16* Ob = ao + ((size_t)b * SEQ + qb * 256 + wid * 32) * 1024 + h * 128; const unsigned ooff = (unsigned)(4 * hi * 1024 + r32);
#pragma unroll
    for (int r = 0; r < 16; ++r)
#pragma unroll
      for (int d0 = 0; d0 < 4; ++d0) Ob[ooff + (unsigned)(((r & 3) + 8 * (r >> 2)) * 1024 + d0 * 32)] = (bf16)(cvtpk(o[d0][r], 0.f) & 0xffffu); }
#undef SLOAD
#undef SWRITE
}
#undef PK4
#undef KSWZ
#undef SBAR
}
DI void phase_sb_mfma(const Args& a, LAS unsigned char* lds, int bid, int G, int tid) {
    const bf16* qkv = (const bf16*)(a.ws + WS_QKV); bf16* ao = (bf16*)(a.ws + WS_AO);
    const int vcu = (G % 8 == 0) ? (bid % 8) * (G / 8) + bid / 8 : bid;
    for (int pi = vcu; pi < 512; pi += G) {
        const int bh = pi >> 3, p = pi & 7, b = bh >> 3, h = bh & 7;
        sba::unit(qkv, ao, b, h, 15 - p, lds, tid);
        sba::unit(qkv, ao, b, h, p, lds, tid);
    }
}


namespace gdn {
using bf16x8 = __attribute__((ext_vector_type(8))) short;
using s16x4  = __attribute__((ext_vector_type(4))) short;
using f32x16 = __attribute__((ext_vector_type(16))) float;
typedef float f2v __attribute__((ext_vector_type(2)));
typedef __bf16 b2v __attribute__((ext_vector_type(2)));
DI unsigned pk(float a, float b) { const f2v v = {a, b}; const b2v r = __builtin_convertvector(v, b2v); return __builtin_bit_cast(unsigned, r); }
DI int crow(int r, int hi) { return (r & 3) + 8 * (r >> 2) + 4 * hi; }
DI int pi_slot(int x) { return 8 * ((x >> 2) & 3) + 4 * ((x >> 4) & 1) + (x & 3); }
DI bf16x8 pack_step(const f32x16& x, int s) {
    v4u w; w.x = pk(x[8 * s + 0], x[8 * s + 1]); w.y = pk(x[8 * s + 2], x[8 * s + 3]); w.z = pk(x[8 * s + 4], x[8 * s + 5]); w.w = pk(x[8 * s + 6], x[8 * s + 7]);
    return __builtin_bit_cast(bf16x8, w);
}
DI f32x16 mm(const f32x16& P, const f32x16& Q, f32x16 acc) {
    acc = __builtin_amdgcn_mfma_f32_32x32x16_bf16(pack_step(P, 0), pack_step(Q, 0), acc, 0, 0, 0);
    acc = __builtin_amdgcn_mfma_f32_32x32x16_bf16(pack_step(P, 1), pack_step(Q, 1), acc, 0, 0, 0);
    return acc;
}
#define GPK4(P, BASE, OUT) do { const unsigned a0 = pk(P[BASE + 0], P[BASE + 1]), a1 = pk(P[BASE + 2], P[BASE + 3]);   \
    const unsigned b0 = pk(P[BASE + 4], P[BASE + 5]), b1 = pk(P[BASE + 6], P[BASE + 7]);                              \
    const auto r0 = __builtin_amdgcn_permlane32_swap(a0, b0, false, false); const auto r1 = __builtin_amdgcn_permlane32_swap(a1, b1, false, false); \
    const v4u w_ = {r0[0], r1[0], r0[1], r1[1]}; OUT = __builtin_bit_cast(bf16x8, w_); } while (0)

DI void local_unit(const Args& a, int unit, LAS unsigned char* img, LAS float* tab, int lane, bool dry) {
    const int r32 = lane & 31, hi = lane >> 5;
    const int chunk = unit & 63, bh = unit >> 6, hv = bh & 15, b = bh >> 4, hk = hv >> 1;
    const size_t t0 = (size_t)b * SEQ + chunk * 64;
    bf16* qkvc = (bf16*)(a.ws + WS_QKVC); const float* gb = (const float*)(a.ws + WS_GB);
    bf16* wmem = (bf16*)(a.ws + WS_WMEM) + (size_t)unit * 8192; bf16* imem = (bf16*)(a.ws + WS_IMEM) + (size_t)unit * 4096;
    bf16* ktmem = (bf16*)(a.ws + WS_KTMEM) + (size_t)((b * HK + hk) * 64 + chunk) * 8192; float* gtab = (float*)(a.ws + WS_GTAB) + (size_t)unit * 192;
    SEC_IN(1);
    float gc = gb[(t0 + lane) * 32 + hv]; const float be = gb[(t0 + lane) * 32 + 16 + hv];
#pragma unroll
    for (int off = 1; off < 64; off <<= 1) { const float y = __shfl_up(gc, off); if (lane >= off) gc += y; }
    const float glast = __shfl(gc, 63);
    tab[lane] = gc; tab[64 + lane] = be; tab[128 + lane] = -be * __expf(gc);
    gtab[lane] = __expf(gc); gtab[64 + lane] = __expf(glast - gc); if (lane == 0) gtab[128] = __expf(glast);
    const bf16* kbase = qkvc + t0 * 4096 + 1024 + hk * 128; const bf16* qbase = qkvc + t0 * 4096 + hk * 128; bf16* vbase = qkvc + t0 * 4096 + 2048 + hv * 128;
#define GSB() __builtin_amdgcn_sched_barrier(0)
    {
        f32x16 IT00 = {}, IT11 = {}, IT01 = {};
#pragma unroll
        for (int s = 0; s < 8; ++s) {
            const bf16x8 k0 = *(const bf16x8*)(kbase + (size_t)r32 * 4096 + 16 * s + 8 * hi), k1 = *(const bf16x8*)(kbase + (size_t)(32 + r32) * 4096 + 16 * s + 8 * hi);
            const bf16x8 q0 = *(const bf16x8*)(qbase + (size_t)r32 * 4096 + 16 * s + 8 * hi), q1 = *(const bf16x8*)(qbase + (size_t)(32 + r32) * 4096 + 16 * s + 8 * hi);
            IT00 = __builtin_amdgcn_mfma_f32_32x32x16_bf16(k0, q0, IT00, 0, 0, 0); IT11 = __builtin_amdgcn_mfma_f32_32x32x16_bf16(k1, q1, IT11, 0, 0, 0);
            IT01 = __builtin_amdgcn_mfma_f32_32x32x16_bf16(k0, q1, IT01, 0, 0, 0);
        }
#pragma unroll
        for (int I = 0; I < 2; ++I) { const int c = 32 * I + r32; const float gcc = tab[c];
#pragma unroll
            for (int J = 0; J < 2; ++J)
#pragma unroll
                for (int g = 0; g < 4; ++g) { float v[4];
#pragma unroll
                    for (int i = 0; i < 4; ++i) { const int r = 4 * g + i, cp = 32 * J + crow(r, hi);
                        const float raw = (I == 0) ? (J == 0 ? IT00[r] : 0.f) : (J == 0 ? IT01[r] : IT11[r]);
                        const float val = raw * __expf(-fabsf(gcc - tab[cp])); v[i] = (c >= cp) ? val : 0.f; }
                    v2u o; o.x = pk(v[0], v[1]); o.y = pk(v[2], v[3]);
                    *(v2u*)(imem + (unsigned)((((I * 2 + J) * 4 + g) * 64 + lane) * 4)) = o; } }
    }
    GSB();
    SEC_OUT(1); SEC_IN(2);
    f32x16 T1, T1T, T2T, T21T;
    {
        f32x16 KK = {};
#pragma unroll
        for (int s = 0; s < 8; ++s) { const bf16x8 k0 = *(const bf16x8*)(kbase + (size_t)r32 * 4096 + 16 * s + 8 * hi); KK = __builtin_amdgcn_mfma_f32_32x32x16_bf16(k0, k0, KK, 0, 0, 0); }
        f32x16 M, MT;
        { const float gb0 = tab[r32], bb0 = tab[64 + r32];
#pragma unroll
        for (int r = 0; r < 16; ++r) { const int a0 = crow(r, hi), b0 = r32; const float ke = -KK[r] * __expf(-fabsf(tab[a0] - gb0));
            const float nv = ke * tab[64 + a0], ntv = ke * bb0;
            const float n = (a0 > b0) ? nv : 0.f, nt = (b0 > a0) ? ntv : 0.f, id = (a0 == b0) ? 1.f : 0.f;
            M[r] = n; MT[r] = nt; T1[r] = id + n; T1T[r] = id + nt; } }
#pragma unroll
        for (int it = 0; it < 4; ++it) { const f32x16 z = {};
            const f32x16 Mn = mm(MT, M, z), MTn = mm(M, MT, z);
            const f32x16 Tn = mm(T1T, Mn, T1);
            T1T = mm(Mn, T1T, T1T);
            T1 = Tn; M = Mn; MT = MTn; }
    }
    GSB();
    {
        f32x16 KK = {};
#pragma unroll
        for (int s = 0; s < 8; ++s) { const bf16x8 k1 = *(const bf16x8*)(kbase + (size_t)(32 + r32) * 4096 + 16 * s + 8 * hi); KK = __builtin_amdgcn_mfma_f32_32x32x16_bf16(k1, k1, KK, 0, 0, 0); }
        f32x16 M, MT;
        { const float gb0 = tab[32 + r32], bb0 = tab[96 + r32];
#pragma unroll
        for (int r = 0; r < 16; ++r) { const int a0 = crow(r, hi), b0 = r32; const float ke = -KK[r] * __expf(-fabsf(tab[32 + a0] - gb0));
            const float nv = ke * tab[96 + a0], ntv = ke * bb0;
            const float n = (a0 > b0) ? nv : 0.f, nt = (b0 > a0) ? ntv : 0.f, id = (a0 == b0) ? 1.f : 0.f;
            M[r] = n; MT[r] = nt; T2T[r] = id + nt; } }
#pragma unroll
        for (int it = 0; it < 4; ++it) { const f32x16 z = {};
            const f32x16 Mn = mm(MT, M, z), MTn = mm(M, MT, z);
            T2T = mm(Mn, T2T, T2T);
            M = Mn; MT = MTn; }
    }
    GSB();
    {
        f32x16 L21 = {};
#pragma unroll
        for (int s = 0; s < 8; ++s) { const bf16x8 k0 = *(const bf16x8*)(kbase + (size_t)r32 * 4096 + 16 * s + 8 * hi), k1 = *(const bf16x8*)(kbase + (size_t)(32 + r32) * 4096 + 16 * s + 8 * hi);
            L21 = __builtin_amdgcn_mfma_f32_32x32x16_bf16(k1, k0, L21, 0, 0, 0); }
#pragma unroll
        for (int r = 0; r < 16; ++r) { const int a0 = crow(r, hi); L21[r] = L21[r] * tab[96 + a0] * __expf(tab[32 + a0] - tab[r32]); }
        const f32x16 z = {}; const f32x16 Y = mm(L21, T2T, z); T21T = mm(T1, Y, z);
#pragma unroll
        for (int r = 0; r < 16; ++r) T21T[r] = -T21T[r];
    }
    GSB();
    SEC_OUT(2); SEC_IN(3);
    const int vb = (int)(unsigned)(size_t)img + sba::v_rd_base(lane);
    bf16* ubl = dry ? (bf16*)(a.ws + WS_END) + (size_t)(unit & 63) * 64 * 4096 : vbase;
#pragma unroll 1
    for (int mode = 0; mode < 2; ++mode) {
        const bf16* src = mode == 0 ? (const bf16*)vbase : kbase;
#pragma unroll 1
        for (int hb_ = 0; hb_ < 2; ++hb_) { v4u tl[8];
#pragma unroll
          for (int it = 0; it < 8; ++it) { const int row = (lane >> 4) + 4 * (it + 8 * hb_), col = (lane & 15) * 8; tl[it] = *(const v4u*)(src + (size_t)row * 4096 + col); }
#pragma unroll
          for (int it = 0; it < 8; ++it) { const int row = (lane >> 4) + 4 * (it + 8 * hb_), col = (lane & 15) * 8; *(LAS v4u*)(img + sba::v_st(row, col)) = tl[it]; } }
        LAS float* sc = tab + (mode == 0 ? 64 : 128);
#pragma unroll 1
        for (int I = 0; I < 2; ++I) {
            bf16x8 pa0, pa1, pa2, pa3;
            { f32x16 X;
#pragma unroll
              for (int r = 0; r < 16; ++r) X[r] = (I ? T21T[r] : T1T[r]) * sc[crow(r, hi)];
              GPK4(X, 0, pa0); GPK4(X, 8, pa1);
              { const float on = I ? 1.0f : 0.0f;
#pragma unroll
              for (int r = 0; r < 16; ++r) X[r] = T2T[r] * (sc[32 + crow(r, hi)] * on); }
              GPK4(X, 0, pa2); GPK4(X, 8, pa3); }
#pragma unroll 1
            for (int d0 = 0; d0 < 4; ++d0) {
                f32x16 od = {};
                if (mode == 0) { sba::pv_split(od, vb + d0 * 512, pa0, pa1, pa2, pa3);
                    const unsigned e0 = (unsigned)(((I * 32 + 8 * d0 + (lane >> 5)) * 4096) + (lane & 31) * 4);
#pragma unroll
                    for (int g = 0; g < 4; ++g) { v2u w; w.x = pk(od[4 * g + 0], od[4 * g + 1]); w.y = pk(od[4 * g + 2], od[4 * g + 3]); *(v2u*)(ubl + e0 + (unsigned)(g * 8192)) = w; }
                } else { sba::pv_split_T(od, vb + d0 * 512, pa0, pa1, pa2, pa3);
                    bf16* wp = wmem + (unsigned)((((I * 4 + d0) * 4) * 64 + lane) * 4);
#pragma unroll
                    for (int g = 0; g < 4; ++g) { v2u w; w.x = pk(od[4 * g + 0], od[4 * g + 1]); w.y = pk(od[4 * g + 2], od[4 * g + 3]); *(v2u*)(wp + g * 256) = w; }
                }
                GSB();
            }
        }
        if (mode == 1) {
            const int Ik = hv & 1;
            v4u idw0, idw1;
            { const int d0_ = r32 - 8 * hi, d1_ = r32 - 16 - 8 * hi;
              idw0.x = (d0_ == 0 ? 0x3f80u : 0u) | (d0_ == 1 ? 0x3f800000u : 0u); idw0.y = (d0_ == 2 ? 0x3f80u : 0u) | (d0_ == 3 ? 0x3f800000u : 0u);
              idw0.z = (d0_ == 4 ? 0x3f80u : 0u) | (d0_ == 5 ? 0x3f800000u : 0u); idw0.w = (d0_ == 6 ? 0x3f80u : 0u) | (d0_ == 7 ? 0x3f800000u : 0u);
              idw1.x = (d1_ == 0 ? 0x3f80u : 0u) | (d1_ == 1 ? 0x3f800000u : 0u); idw1.y = (d1_ == 2 ? 0x3f80u : 0u) | (d1_ == 3 ? 0x3f800000u : 0u);
              idw1.z = (d1_ == 4 ? 0x3f80u : 0u) | (d1_ == 5 ? 0x3f800000u : 0u); idw1.w = (d1_ == 6 ? 0x3f80u : 0u) | (d1_ == 7 ? 0x3f800000u : 0u); }
            const bf16x8 id0 = __builtin_bit_cast(bf16x8, idw0), id1 = __builtin_bit_cast(bf16x8, idw1), zf = (bf16x8){};
            const bf16x8 pa0 = Ik ? zf : id0, pa1 = Ik ? zf : id1, pa2 = Ik ? id0 : zf, pa3 = Ik ? id1 : zf;
#pragma unroll 1
            for (int d0 = 0; d0 < 4; ++d0) {
                f32x16 od = {}; sba::pv_split(od, vb + d0 * 512, pa0, pa1, pa2, pa3);
                bf16* kp = ktmem + (unsigned)((((Ik * 4 + d0) * 4) * 64 + lane) * 4);
#pragma unroll
                for (int g = 0; g < 4; ++g) { v2u w; w.x = pk(od[4 * g + 0], od[4 * g + 1]); w.y = pk(od[4 * g + 2], od[4 * g + 3]); *(v2u*)(kp + g * 256) = w; }
                GSB();
            }
        }
    }
    SEC_OUT(3);
#undef GSB
}
#undef GPK4
}
DI void phase_gdn_local(const Args& a, LAS unsigned char* lds, int bid, int G, int wave, int lane, bool dry) {
    LAS unsigned char* img = lds + wave * 16384; LAS float* tab = (LAS float*)(lds + RING_BYTES + 4096 + wave * 1024);
    const int gw = bid * NWAVES + wave, NGW = G * NWAVES;
    for (int unit = gw; unit < BATCH * HV * 64; unit += NGW) gdn::local_unit(a, unit, img, tab, lane, dry);
}
namespace gdn {
constexpr int PW = 272, PI = 144;
constexpr int L_W = 0, L_Q = 64 * PW, L_I = 2 * 64 * PW, L_K = L_I + 64 * PI, L_G = L_K + 128 * PI, L_BUF = L_G + 768;
constexpr int L_PART = 2 * L_BUF;
static_assert(L_PART + 4096 <= RING_BYTES, "scan LDS map");
}
DI void phase_gdn_scan(const Args& a, int j, LAS unsigned char* lds, int bid, int tid, bool dry) {
    if (bid >= BATCH * HV) return;
    using gdn::bf16x8; using gdn::pk; using namespace gdn;
    typedef float f4v __attribute__((ext_vector_type(4)));
    const int wave = __builtin_amdgcn_readfirstlane(tid >> 6), lane = tid & 63, n = lane & 15, kq = lane >> 4;
    const int b = bid / HV, hv = bid % HV, hk = hv >> 1;
    bf16* qkvc = (bf16*)(a.ws + WS_QKVC); const bf16* zb = (const bf16*)(a.ws + WS_ZB);
    LAS float* part = (LAS float*)(lds + L_PART); LAS unsigned char* stg = lds + OGST_OFF;
    const int unit0 = (b * HV + hv) * 64, hku0 = (b * HK + hk) * 64; const size_t tb0 = (size_t)b * SEQ;
    if (wave >= 4) {
        const int st = tid - 256;
        v4u rw[4], rq[4], ri[2], rk[4], rz[4]; float rg = 0.f;
        unsigned ow[4], ok_[4], oi[2], oq[4], oz[4];
#pragma unroll
        for (int k = 0; k < 4; ++k) { const int c = st + 256 * k;
            { const int row = c & 63, p = c >> 6, pp = p & 3; ow[k] = (unsigned)((((((row >> 5) * 4 + (p >> 2)) * 4 + (pp >> 1)) * 64 + (pp & 1) * 32 + (row & 31)) * 4) * 2); }
            { const int dk = c & 127, p = c >> 7, pp = p & 3; ok_[k] = (unsigned)((((((p >> 2) * 4 + (dk >> 5)) * 4 + (pp >> 1)) * 64 + (pp & 1) * 32 + (dk & 31)) * 4) * 2); }
            oq[k] = (unsigned)(((c >> 4) * 4096 + (c & 15) * 8) * 2); oz[k] = (unsigned)(((c >> 4) * 2048 + (c & 15) * 8) * 2); }
#pragma unroll
        for (int k = 0; k < 2; ++k) { const int c = st + 256 * k; const int row = c & 63, p = c >> 6, pp = p & 3; oi[k] = (unsigned)((((((row >> 5) * 2 + (p >> 2)) * 4 + (pp >> 1)) * 64 + (pp & 1) * 32 + (row & 31)) * 4) * 2); }
#define SV_RUN2(dst, base, ob_) do { const v2u a_ = *(const v2u*)((const char*)(base) + (ob_)), b_ = *(const v2u*)((const char*)(base) + (ob_) + 1024); dst = (v4u){a_.x, a_.y, b_.x, b_.y}; } while (0)
#define SV_LOAD(ch) do { const int u_ = unit0 + (ch); const size_t t_ = tb0 + (size_t)(ch) * 64; \
        const bf16* wm_ = (const bf16*)(a.ws + WS_WMEM) + (size_t)u_ * 8192; const bf16* im_ = (const bf16*)(a.ws + WS_IMEM) + (size_t)u_ * 4096; \
        const bf16* kt_ = (const bf16*)(a.ws + WS_KTMEM) + (size_t)(hku0 + (ch)) * 8192; const bf16* qb_ = qkvc + t_ * 4096 + hk * 128; const bf16* zr_ = zb + t_ * 2048 + hv * 128; \
        _Pragma("unroll") for (int k = 0; k < 4; ++k) { SV_RUN2(rw[k], wm_, ow[k]); SV_RUN2(rk[k], kt_, ok_[k]); rq[k] = *(const v4u*)((const char*)qb_ + oq[k]); if (k < 2) rz[k] = *(const v4u*)((const char*)zr_ + oz[k]); } \
        _Pragma("unroll") for (int k = 0; k < 2; ++k) { SV_RUN2(ri[k], im_, oi[k]); } \
        if (st < 192) rg = ((const float*)(a.ws + WS_GTAB))[(size_t)u_ * 192 + st]; } while (0)
#define SV_WRITE(bf) do { LAS unsigned char* B_ = lds + (bf) * L_BUF; \
        _Pragma("unroll") for (int k = 0; k < 4; ++k) { const int c = st + 256 * k; *(LAS v4u*)(B_ + L_W + (c & 63) * PW + (c >> 6) * 16) = rw[k]; \
            *(LAS v4u*)(B_ + L_Q + (c >> 4) * PW + (c & 15) * 16) = rq[k]; *(LAS v4u*)(B_ + L_K + (c & 127) * PI + (c >> 7) * 16) = rk[k]; } \
        _Pragma("unroll") for (int k = 0; k < 2; ++k) { const int c = st + 256 * k; *(LAS v4u*)(B_ + L_I + (c & 63) * PI + (c >> 6) * 16) = ri[k]; } \
        if (st < 192) *(LAS float*)(B_ + L_G + st * 4) = rg; } while (0)
        f32x4 nwa, nwb;
        { const float* nwp = a.gdn_norm_w + j * 128 + (st & 15) * 8; nwa = *(const f32x4*)nwp; nwb = *(const f32x4*)(nwp + 4); }
        volatile LAS unsigned* flag = (volatile LAS unsigned*)(lds + L_PART);
        SV_LOAD(0); SV_WRITE(0);
        v4u zc[2], zn[2];
#pragma unroll
        for (int k = 0; k < 2; ++k) zc[k] = rz[k];
        __syncthreads();
        SV_LOAD(1);
#pragma unroll 1
        for (int chunk = 0; chunk < 64; ++chunk) {
            if (chunk + 1 < 64) { SV_WRITE((chunk + 1) & 1);
#pragma unroll
                for (int k = 0; k < 2; ++k) zn[k] = rz[k]; }
            __syncthreads();
            v4u ov[2];
#pragma unroll
            for (int k = 0; k < 2; ++k) { const int c = st + 256 * k; ov[k] = *(const LAS v4u*)(stg + (c >> 4) * 256 + (c & 15) * 16); }
            asm volatile("s_waitcnt lgkmcnt(0)" ::: "memory");
            if (lane == 0) __hip_atomic_fetch_add((LAS unsigned*)(lds + L_PART), 1u, __ATOMIC_RELAXED, __HIP_MEMORY_SCOPE_WORKGROUP);
            if (chunk + 2 < 64) SV_LOAD(chunk + 2);
            __builtin_amdgcn_sched_barrier(0);
            bf16* ob = dry ? (bf16*)(a.ws + WS_END) + (size_t)bid * 64 * 128 : qkvc + (tb0 + (size_t)chunk * 64) * 4096 + 2048 + hv * 128; const int opitch = dry ? 128 : 4096;
#pragma unroll
            for (int k = 0; k < 2; ++k) {
                float o8[8]; o8[0] = bf_lo(ov[k].x); o8[1] = bf_hi(ov[k].x); o8[2] = bf_lo(ov[k].y); o8[3] = bf_hi(ov[k].y); o8[4] = bf_lo(ov[k].z); o8[5] = bf_hi(ov[k].z); o8[6] = bf_lo(ov[k].w); o8[7] = bf_hi(ov[k].w);
                float ss = 0.f;
#pragma unroll
                for (int e = 0; e < 8; ++e) ss += o8[e] * o8[e];
                const float rinv = __builtin_amdgcn_rsqf(dpp_sum16(ss) * (1.0f / 128.0f) + RMS_EPS);
                float z8[8]; z8[0] = bf_lo(zc[k].x); z8[1] = bf_hi(zc[k].x); z8[2] = bf_lo(zc[k].y); z8[3] = bf_hi(zc[k].y); z8[4] = bf_lo(zc[k].z); z8[5] = bf_hi(zc[k].z); z8[6] = bf_lo(zc[k].w); z8[7] = bf_hi(zc[k].w);
                float r8[8];
#pragma unroll
                for (int e = 0; e < 8; ++e) r8[e] = o8[e] * rinv * (e < 4 ? nwa[e] : nwb[e - 4]) * z8[e];
                v4u w; w.x = pk(r8[0], r8[1]); w.y = pk(r8[2], r8[3]); w.z = pk(r8[4], r8[5]); w.w = pk(r8[6], r8[7]);
                *(v4u*)((char*)ob + (dry ? (unsigned)((((st + 256 * k) >> 4) * 128 + ((st + 256 * k) & 15) * 8) * 2) : oq[k])) = w; }
#pragma unroll
            for (int k = 0; k < 2; ++k) zc[k] = zn[k];
        }
#undef SV_RUN2
#undef SV_LOAD
#undef SV_WRITE
        return;
    }
    f4v S[2][8];
#pragma unroll
    for (int g = 0; g < 2; ++g)
#pragma unroll
        for (int m = 0; m < 8; ++m) S[g][m] = (f4v){0.f, 0.f, 0.f, 0.f};
    v2u un[2][4];
#define CW_ULOAD(ch) do { const bf16* vb_ = qkvc + (tb0 + (size_t)(ch) * 64) * 4096 + 2048 + hv * 128; \
        _Pragma("unroll") for (int g = 0; g < 2; ++g) _Pragma("unroll") for (int mt = 0; mt < 4; ++mt) { \
            const int f = (((((mt >> 1) * 4 + wave) * 4 + 2 * (mt & 1) + (kq >> 1)) * 64) + (kq & 1) * 32 + 16 * g + n) * 4;     \
            un[g][mt] = *(const v2u*)(vb_ + (size_t)(f >> 7) * 4096 + (f & 127)); } } while (0)
    CW_ULOAD(0);
    if (tid == 0) *(volatile LAS unsigned*)(lds + L_PART) = 0u;
    __syncthreads();
#pragma unroll 1
    for (int chunk = 0; chunk < 64; ++chunk) {
        GSEC_ACC(8, -);
        const LAS unsigned char* B = lds + (chunk & 1) * L_BUF; const LAS float* gt = (const LAS float*)(B + L_G);
        f4v av[2][4], ao[2][4];
#pragma unroll
        for (int g = 0; g < 2; ++g)
#pragma unroll
            for (int mt = 0; mt < 4; ++mt) { const v2u u0 = un[g][mt]; av[g][mt] = (f4v){bf_lo(u0.x), bf_hi(u0.x), bf_lo(u0.y), bf_hi(u0.y)}; }
        v4u zq[2];
#pragma unroll
        for (int k = 0; k < 2; ++k) { const int c = tid + 512 + 256 * k; zq[k] = *(const v4u*)(zb + (tb0 + (size_t)chunk * 64 + (c >> 4)) * 2048 + hv * 128 + (c & 15) * 8); }
        if (chunk + 1 < 64) CW_ULOAD(chunk + 1);
        bf16x8 Sb[2][4];
#pragma unroll
        for (int g = 0; g < 2; ++g)
#pragma unroll
            for (int p = 0; p < 4; ++p) { v4u w; w.x = pk(S[g][2 * p][0], S[g][2 * p][1]); w.y = pk(S[g][2 * p][2], S[g][2 * p][3]); w.z = pk(S[g][2 * p + 1][0], S[g][2 * p + 1][1]); w.w = pk(S[g][2 * p + 1][2], S[g][2 * p + 1][3]);
                Sb[g][p] = __builtin_bit_cast(bf16x8, w); }
#pragma unroll
        for (int mt = 0; mt < 4; ++mt) { ao[0][mt] = (f4v){0.f, 0.f, 0.f, 0.f}; ao[1][mt] = (f4v){0.f, 0.f, 0.f, 0.f};
#pragma unroll
            for (int p = 0; p < 4; ++p) {
                const bf16x8 aw = *(const LAS bf16x8*)(B + L_W + (16 * mt + n) * PW + 64 * p + 16 * kq);
                const v2u q0 = *(const LAS v2u*)(B + L_Q + (16 * mt + n) * PW + 64 * p + 8 * kq), q1 = *(const LAS v2u*)(B + L_Q + (16 * mt + n) * PW + 64 * p + 32 + 8 * kq);
                const v4u qq = {q0.x, q0.y, q1.x, q1.y}; const bf16x8 aq = __builtin_bit_cast(bf16x8, qq);
                av[0][mt] = __builtin_amdgcn_mfma_f32_16x16x32_bf16(aw, Sb[0][p], av[0][mt], 0, 0, 0); av[1][mt] = __builtin_amdgcn_mfma_f32_16x16x32_bf16(aw, Sb[1][p], av[1][mt], 0, 0, 0);
                ao[0][mt] = __builtin_amdgcn_mfma_f32_16x16x32_bf16(aq, Sb[0][p], ao[0][mt], 0, 0, 0); ao[1][mt] = __builtin_amdgcn_mfma_f32_16x16x32_bf16(aq, Sb[1][p], ao[1][mt], 0, 0, 0); } }
        bf16x8 vbf[2][2], vbd[2][2];
#pragma unroll
        for (int pp = 0; pp < 2; ++pp) {
            const f4v d0 = *(const LAS f4v*)(gt + 64 + 32 * pp + 4 * kq), d1 = *(const LAS f4v*)(gt + 64 + 32 * pp + 16 + 4 * kq);
#pragma unroll
            for (int g = 0; g < 2; ++g) { const f4v x0 = av[g][2 * pp], x1 = av[g][2 * pp + 1];
                v4u w; w.x = pk(x0[0], x0[1]); w.y = pk(x0[2], x0[3]); w.z = pk(x1[0], x1[1]); w.w = pk(x1[2], x1[3]); vbf[g][pp] = __builtin_bit_cast(bf16x8, w);
                v4u y; y.x = pk(x0[0] * d0[0], x0[1] * d0[1]); y.y = pk(x0[2] * d0[2], x0[3] * d0[3]); y.z = pk(x1[0] * d1[0], x1[1] * d1[1]); y.w = pk(x1[2] * d1[2], x1[3] * d1[3]); vbd[g][pp] = __builtin_bit_cast(bf16x8, y); }
        }
#pragma unroll
        for (int mt = 0; mt < 4; ++mt) { const f4v eg = *(const LAS f4v*)(gt + 16 * mt + 4 * kq); ao[0][mt] = ao[0][mt] * eg; ao[1][mt] = ao[1][mt] * eg;
#pragma unroll
            for (int pp = 0; pp < 2; ++pp) { const bf16x8 ai = *(const LAS bf16x8*)(B + L_I + (16 * mt + n) * PI + 64 * pp + 16 * kq);
                ao[0][mt] = __builtin_amdgcn_mfma_f32_16x16x32_bf16(ai, vbf[0][pp], ao[0][mt], 0, 0, 0); ao[1][mt] = __builtin_amdgcn_mfma_f32_16x16x32_bf16(ai, vbf[1][pp], ao[1][mt], 0, 0, 0); } }
        { const float egl = gt[128];
#pragma unroll
          for (int m8 = 0; m8 < 8; ++m8) { S[0][m8] = S[0][m8] * egl; S[1][m8] = S[1][m8] * egl;
#pragma unroll
              for (int pp = 0; pp < 2; ++pp) { const bf16x8 ak = *(const LAS bf16x8*)(B + L_K + (16 * m8 + n) * PI + 64 * pp + 16 * kq);
                  S[0][m8] = __builtin_amdgcn_mfma_f32_16x16x32_bf16(ak, vbd[0][pp], S[0][m8], 0, 0, 0); S[1][m8] = __builtin_amdgcn_mfma_f32_16x16x32_bf16(ak, vbd[1][pp], S[1][m8], 0, 0, 0); } } }
        GSEC_ACC(8, +); GSEC_ACC(9, -);
        { unsigned spins = 0; while (*(volatile LAS unsigned*)(lds + L_PART) < 8u * (unsigned)chunk) { __builtin_amdgcn_s_sleep(1); if (++spins > (1u << 22)) break; } }
#pragma unroll
        for (int g = 0; g < 2; ++g)
#pragma unroll
            for (int mt = 0; mt < 4; ++mt)
#pragma unroll
                for (int i = 0; i < 4; ++i) *(LAS bf16*)(stg + (16 * mt + 4 * kq + i) * 256 + (32 * wave + 16 * g + n) * 2) = (bf16)(pk(ao[g][mt][i], 0.f) & 0xffffu);
        __syncthreads();
        GSEC_ACC(9, +);
        {
            v4u ov[2];
#pragma unroll
            for (int k = 0; k < 2; ++k) { const int c = tid + 512 + 256 * k; ov[k] = *(const LAS v4u*)(stg + (c >> 4) * 256 + (c & 15) * 16); }
            asm volatile("s_waitcnt lgkmcnt(0)" ::: "memory");
            if (lane == 0) __hip_atomic_fetch_add((LAS unsigned*)(lds + L_PART), 1u, __ATOMIC_RELAXED, __HIP_MEMORY_SCOPE_WORKGROUP);
            const f32x4 nwa = *(const f32x4*)(a.gdn_norm_w + j * 128 + (tid & 15) * 8), nwb = *(const f32x4*)(a.gdn_norm_w + j * 128 + (tid & 15) * 8 + 4);
            bf16* ob = qkvc + (tb0 + (size_t)chunk * 64) * 4096 + 2048 + hv * 128;
#pragma unroll
            for (int k = 0; k < 2; ++k) { const int c = tid + 512 + 256 * k;
                float o8[8]; unpack8(ov[k], o8); float ss = 0.f;
#pragma unroll
                for (int e = 0; e < 8; ++e) ss += o8[e] * o8[e];
                const float rinv = __builtin_amdgcn_rsqf(dpp_sum16(ss) * (1.0f / 128.0f) + RMS_EPS);
                float z8[8]; unpack8(zq[k], z8); float r8[8];
#pragma unroll
                for (int e = 0; e < 8; ++e) r8[e] = o8[e] * rinv * (e < 4 ? nwa[e] : nwb[e - 4]) * z8[e];
                v4u w; w.x = pk(r8[0], r8[1]); w.y = pk(r8[2], r8[3]); w.z = pk(r8[4], r8[5]); w.w = pk(r8[6], r8[7]);
                *(v4u*)(ob + (size_t)(c >> 4) * 4096 + (c & 15) * 8) = w; }
        }
    }
#undef CW_ULOAD
}

DI void moe_offsets(const Args& a, int j, unsigned (&off)[9]) {
    unsigned* cnt = (unsigned*)(a.ws + WS_CTL) + CW_CNT + 256 * j; unsigned acc = 0u;
#pragma unroll
    for (int e = 0; e < 8; ++e) { off[e] = acc; const unsigned c = __hip_atomic_load(cnt + e, __ATOMIC_RELAXED, __HIP_MEMORY_SCOPE_AGENT); acc += (c + 255u) & ~255u; }
    off[8] = acc;
}
DI void phase_scatter(const Args& a, int j, LAS unsigned char* lds, int bid, int G, int tid, int wave, int lane) {
    LAS unsigned* lc = (LAS unsigned*)lds; LAS unsigned* lb = lc + 8; LAS unsigned* loff = lc + 16; LAS int* lpos = (LAS int*)(lc + 32);
    const unsigned* E12 = (const unsigned*)(a.ws + WS_E12); int* POS = (int*)(a.ws + WS_POS);
    const bf16* HB = (const bf16*)(a.ws + WS_HB); bf16* XS = (bf16*)(a.ws + WS_XS);
    unsigned* fill = (unsigned*)(a.ws + WS_CTL) + CW_CNT + 256 * j + 64;
    unsigned off[9]; moe_offsets(a, j, off);
    if (tid == 0) {
#pragma unroll
        for (int e = 0; e < 8; ++e) loff[e] = off[e]; }
    for (int ci = bid; ci < TT / 128; ci += G) {
        __syncthreads();
        if (tid < 8) lc[tid] = 0u;
        __syncthreads();
        unsigned e1 = 0, e2 = 0, r1 = 0, r2 = 0;
        if (tid < 128) { const unsigned w = E12[ci * 128 + tid]; e1 = w & 255u; e2 = (w >> 8) & 255u;
            r1 = __hip_atomic_fetch_add(lc + e1, 1u, __ATOMIC_RELAXED, __HIP_MEMORY_SCOPE_WORKGROUP); r2 = __hip_atomic_fetch_add(lc + e2, 1u, __ATOMIC_RELAXED, __HIP_MEMORY_SCOPE_WORKGROUP); }
        __syncthreads();
        if (tid < 8) lb[tid] = __hip_atomic_fetch_add(fill + tid, lc[tid], __ATOMIC_RELAXED, __HIP_MEMORY_SCOPE_AGENT);
        __syncthreads();
        if (tid < 128) { const int p1 = (int)(loff[e1] + lb[e1] + r1), p2 = (int)(loff[e2] + lb[e2] + r2);
            lpos[2 * tid] = p1; lpos[2 * tid + 1] = p2; POS[2 * (ci * 128 + tid)] = p1; POS[2 * (ci * 128 + tid) + 1] = p2; }
        __syncthreads();
        for (int tk = wave; tk < 128; tk += NWAVES) {
            const int p1 = lpos[2 * tk], p2 = lpos[2 * tk + 1];
            const v4u* src = (const v4u*)(HB + (size_t)(ci * 128 + tk) * D);
            const v4u x0 = src[lane], x1 = src[lane + 64];
            v4u* d1 = (v4u*)(XS + (size_t)p1 * D); v4u* d2 = (v4u*)(XS + (size_t)p2 * D);
            d1[lane] = x0; d1[lane + 64] = x1; d2[lane] = x0; d2[lane + 64] = x1;
        }
    }
}

template <bool FINAL>
DI void phase_combine_ln(const Args& a, const bf16* Yin, bf16* Yout, int lnprev, int lnidx, int bid, int G, int wave, int lane) {
    bf16* HB = (bf16*)(a.ws + WS_HB); const bf16* YE = (const bf16*)(a.ws + WS_XS); float* stats = (float*)(a.ws + WS_STATS);
    const int* POS = (const int*)(a.ws + WS_POS); const f32x2* G12 = (const f32x2*)(a.ws + WS_G12);
    const float* g = a.ln_g + (size_t)lnidx * D; const float* bta = a.ln_b + (size_t)lnidx * D;
    const float* gp = a.ln_g + (size_t)lnprev * D; const float* bp = a.ln_b + (size_t)lnprev * D;
    const int gw = bid * NWAVES + wave, NGW = G * NWAVES;
    float gv[2][8], bv[2][8], gq[2][8], bq[2][8];
#pragma unroll
    for (int q = 0; q < 2; ++q)
#pragma unroll
        for (int c = 0; c < 8; ++c) { const int col = 8 * (lane + 64 * q) + c; gv[q][c] = g[col]; bv[q][c] = bta[col]; gq[q][c] = gp[col] * ALPHA; bq[q][c] = bp[col] * ALPHA; }
    for (int t = gw; t < TT; t += NGW) {
        const int p1 = POS[2 * t], p2 = POS[2 * t + 1]; const f32x2 gg = G12[t]; const f32x2 st = *(const f32x2*)(stats + 2 * (size_t)t);
        float v[2][8]; float s = 0.f;
#pragma unroll
        for (int q = 0; q < 2; ++q) { float y[8], e1[8], e2[8];
            unpack8(((const v4u*)(Yin + (size_t)t * D))[lane + 64 * q], y); unpack8(((const v4u*)(YE + (size_t)p1 * D))[lane + 64 * q], e1); unpack8(((const v4u*)(YE + (size_t)p2 * D))[lane + 64 * q], e2);
#pragma unroll
            for (int c = 0; c < 8; ++c) { v[q][c] = (y[c] - st.x) * st.y * gq[q][c] + bq[q][c] + e1[c] * gg.x + e2[c] * gg.y; s += v[q][c]; } }
        const float mean = wave_sum(s) * (1.0f / D); float s2 = 0.f;
#pragma unroll
        for (int q = 0; q < 2; ++q)
#pragma unroll
            for (int c = 0; c < 8; ++c) { const float d = v[q][c] - mean; s2 += d * d; }
        const float rstd = 1.0f / sqrtf(wave_sum(s2) * (1.0f / D) + LN_EPS);
        if (!FINAL && lane == 0) *(f32x2*)(stats + 2 * (size_t)t) = (f32x2){mean, rstd};
#pragma unroll
        for (int q = 0; q < 2; ++q) { float hn[8];
#pragma unroll
            for (int c = 0; c < 8; ++c) hn[c] = (v[q][c] - mean) * rstd * gv[q][c] + bv[q][c];
            if (FINAL) { f32x4* orow = (f32x4*)(a.out + (size_t)t * D + 8 * (lane + 64 * q)); orow[0] = (f32x4){hn[0], hn[1], hn[2], hn[3]}; orow[1] = (f32x4){hn[4], hn[5], hn[6], hn[7]}; }
            else { v4u yo; yo.x = pk2(v[q][0], v[q][1]); yo.y = pk2(v[q][2], v[q][3]); yo.z = pk2(v[q][4], v[q][5]); yo.w = pk2(v[q][6], v[q][7]); ((v4u*)(Yout + (size_t)t * D))[lane + 64 * q] = yo;
                v4u o; o.x = pk2(hn[0], hn[1]); o.y = pk2(hn[2], hn[3]); o.z = pk2(hn[4], hn[5]); o.w = pk2(hn[6], hn[7]); ((v4u*)(HB + (size_t)t * D))[lane + 64 * q] = o; } }
    }
}

constexpr int ARGS_OFF = RING_BYTES + 1024;
DI unsigned long long lds_u64(LAS unsigned char* p) { const v2u w = *(const volatile LAS v2u*)p; return ((unsigned long long)(unsigned)__builtin_amdgcn_readfirstlane((int)w.y) << 32) | (unsigned)__builtin_amdgcn_readfirstlane((int)w.x); }
DI Args load_args(LAS unsigned char* lds) {
    Args a; LAS unsigned char* p = lds + ARGS_OFF;
    a.x = (const float*)(const GAS float*)lds_u64(p + 0); a.gdn_w_in = (const float*)(const GAS float*)lds_u64(p + 8); a.gdn_conv_w = (const float*)(const GAS float*)lds_u64(p + 16); a.gdn_a_log = (const float*)(const GAS float*)lds_u64(p + 24);
    a.gdn_dt_bias = (const float*)(const GAS float*)lds_u64(p + 32); a.gdn_norm_w = (const float*)(const GAS float*)lds_u64(p + 40); a.gdn_w_out = (const float*)(const GAS float*)lds_u64(p + 48); a.sb_w_in = (const float*)(const GAS float*)lds_u64(p + 56);
    a.sb_w_out = (const float*)(const GAS float*)lds_u64(p + 64); a.ffn_w_gate = (const float*)(const GAS float*)lds_u64(p + 72); a.ffn_w_up = (const float*)(const GAS float*)lds_u64(p + 80); a.ffn_w_down = (const float*)(const GAS float*)lds_u64(p + 88);
    a.moe_router = (const float*)(const GAS float*)lds_u64(p + 96); a.moe_w_gate = (const float*)(const GAS float*)lds_u64(p + 104); a.moe_w_up = (const float*)(const GAS float*)lds_u64(p + 112); a.moe_w_down = (const float*)(const GAS float*)lds_u64(p + 120);
    a.ln_g = (const float*)(const GAS float*)lds_u64(p + 128); a.ln_b = (const float*)(const GAS float*)lds_u64(p + 136); a.out = (float*)(GAS float*)lds_u64(p + 144); a.ws = (unsigned char*)(GAS unsigned char*)lds_u64(p + 152);
    const v2u w = *(const volatile LAS v2u*)(p + 160); a.ph_lo = __builtin_amdgcn_readfirstlane((int)w.x); a.ph_hi = __builtin_amdgcn_readfirstlane((int)w.y);
    return a;
}
#ifdef PH_ONLY
#define IN(k) (((k) % NPH) == PH_ONLY && lo <= (k) && (k) < hi)
#else
#define IN(k) (lo <= (k) && (k) < hi)
#endif
#define SEAM(k) do { if ((k) + 1 < hi) xcd_barrier(bar); } while (0)
DI int fresh_lane() { int l; asm volatile("v_mbcnt_lo_u32_b32 %0, -1, 0\n\tv_mbcnt_hi_u32_b32 %0, -1, %0" : "=v"(l)); return l; }
#define YMOE ((bf16*)(j == 1 ? (void*)(args.ws + WS_YT) : (void*)args.out))
#define ARGS() const Args args = load_args(lds); const int lo = args.ph_lo, hi = args.ph_hi; const int lane = fresh_lane(), tid = wave * 64 + lane
#ifndef PROBE_REP_MASK
#define PROBE_REP_MASK 0
#endif
#ifndef PROBE_DELAY_MASK
#define PROBE_DELAY_MASK 0
#endif
#define PROBE_DELAY_MULT 4u
#define TICK_IN(k) do { if (((PROBE_DELAY_MASK) >> (k)) & 1) { if (bid == 0 && tid == 0) ((volatile LAS unsigned*)(lds + MISC_OFF))[20] -= (unsigned)__builtin_amdgcn_s_memrealtime(); } } while (0)
#define TICK_OUT(k) do { if (((PROBE_DELAY_MASK) >> (k)) & 1) { if (bid == 0 && tid == 0) ((volatile LAS unsigned*)(lds + MISC_OFF))[20] += (unsigned)__builtin_amdgcn_s_memrealtime(); } } while (0)
#define NREP(k) ((((PROBE_REP_MASK) >> (k)) & 1) ? 2 : 1)
template <int j>
DI void layer_pair(LAS unsigned char* lds, const XcdBarrier& bar, const int wave, const int G, const int bid) {
    constexpr int pb = j * NPH;
    { ARGS(); if (IN(pb + 0)) { TICK_IN(0); _Pragma("unroll 1") for (int rep_ = 0; rep_ < NREP(0); ++rep_) { phase_w_gdn(args, j, lds, bid, G, tid, wave, lane); } SEAM(pb + 0); TICK_OUT(0); } }
    { ARGS(); if (IN(pb + 1)) { TICK_IN(1); {
        pg8::Gemm g{(const bf16*)(args.ws + WS_HB), (const bf16*)(args.ws + W_IN), D, D}; pg8::StaticOrder S; S.init(TT, GINP, G, bid, NREP(1));
        pg8::EpiInProj E{(bf16*)(args.ws + WS_RAW), (bf16*)(args.ws + WS_ZB)};
        pg8::gemm_phase<pg8::EpiInProj, pg8::StaticOrder, true, true>(lds, g, S, E);
        } SEAM(pb + 1); TICK_OUT(1); } }
    { ARGS(); if (IN(pb + 2)) { TICK_IN(2); _Pragma("unroll 1") for (int rep_ = 0; rep_ < NREP(2); ++rep_) { phase_conv(args, j, bid, G, tid); } SEAM(pb + 2); TICK_OUT(2); } }
#if GDN_NAIVE
    { ARGS(); if (IN(pb + 4)) { TICK_IN(4); _Pragma("unroll 1") for (int rep_ = 0; rep_ < NREP(4); ++rep_) { phase_gdn_naive(args, j, lds, bid, tid); } SEAM(pb + 4); TICK_OUT(4); } }
#else
    { ARGS(); if (IN(pb + 3)) { TICK_IN(3); _Pragma("unroll 1") for (int rep_ = 0; rep_ < NREP(3); ++rep_) { phase_gdn_local(args, lds, bid, G, wave, lane, rep_ + 1 < NREP(3)); } SEAM(pb + 3); TICK_OUT(3); } }
    { ARGS(); if (IN(pb + 4)) { TICK_IN(4); _Pragma("unroll 1") for (int rep_ = 0; rep_ < NREP(4); ++rep_) { if (bid >= BATCH * HV && G > BATCH * HV) phase_w_sb(args, j, lds, bid - BATCH * HV, G - BATCH * HV, wave, lane); else if (G <= BATCH * HV && rep_ == 0) phase_w_sb(args, j, lds, bid, G, wave, lane);
        phase_gdn_scan(args, j, lds, bid, tid, rep_ + 1 < NREP(4)); } SEAM(pb + 4); TICK_OUT(4); } }
#endif
    { ARGS(); if (IN(pb + 5)) { TICK_IN(5); {
        pg8::Gemm g{(const bf16*)(args.ws + WS_QKVC) + 2048, (const bf16*)(args.ws + W_OUT), 4096, 2048}; pg8::StaticOrder S; S.init(TT, D, G, bid);
        pg8::EpiResid<(j > 0)> E{j == 0 ? (const void*)args.x : (const void*)args.out, (bf16*)args.out, (const float*)(args.ws + WS_STATS), args.ln_g + (size_t)(4 * (j > 0 ? j - 1 : 0) + 3) * D, args.ln_b + (size_t)(4 * (j > 0 ? j - 1 : 0) + 3) * D};
        pg8::gemm_phase<pg8::EpiResid<(j > 0)>, pg8::StaticOrder, true, true>(lds, g, S, E);
        } SEAM(pb + 5); TICK_OUT(5); } }
    { ARGS(); if (IN(pb + 6)) { TICK_IN(6); _Pragma("unroll 1") for (int rep_ = 0; rep_ < NREP(6); ++rep_) { phase_ln<false>(args, (const bf16*)args.out, (2 * j) * 2 + 0, j, lds, bid, G, tid, wave, lane); } SEAM(pb + 6); TICK_OUT(6); } }
    { ARGS(); if (IN(pb + 7)) { TICK_IN(7); {
        pg8::Gemm g{(const bf16*)(args.ws + WS_HB), (const bf16*)(args.ws + W_GU), D, D}; pg8::StaticOrder S; S.init(TT, 2 * FF, G, bid, NREP(7));
        pg8::EpiSwiGLU E{(bf16*)(args.ws + WS_ACT), FF, 0};
        pg8::gemm_phase<pg8::EpiSwiGLU, pg8::StaticOrder, true, true>(lds, g, S, E);
        } SEAM(pb + 7); TICK_OUT(7); } }
    { ARGS(); if (IN(pb + 8)) { TICK_IN(8); {
        pg8::Gemm g{(const bf16*)(args.ws + WS_ACT), (const bf16*)(args.ws + W_D), FF, FF}; pg8::StaticOrder S; S.init(TT, D, G, bid);
        pg8::EpiResid<true> E{(const void*)args.out, (bf16*)args.out, (const float*)(args.ws + WS_STATS), args.ln_g + (size_t)(4 * j + 0) * D, args.ln_b + (size_t)(4 * j + 0) * D};
        pg8::gemm_phase<pg8::EpiResid<true>, pg8::StaticOrder, true, true>(lds, g, S, E);
        } SEAM(pb + 8); TICK_OUT(8); } }
    { ARGS(); if (IN(pb + 9)) { TICK_IN(9); _Pragma("unroll 1") for (int rep_ = 0; rep_ < NREP(9); ++rep_) { phase_ln<false>(args, (const bf16*)args.out, (2 * j) * 2 + 1, j, lds, bid, G, tid, wave, lane); } SEAM(pb + 9); TICK_OUT(9); } }
    { ARGS(); if (IN(pb + 10)) { TICK_IN(10); {
        pg8::Gemm g{(const bf16*)(args.ws + WS_HB), (const bf16*)(args.ws + W_QKV), D, D}; pg8::StaticOrder S; S.init(TT, 3072, G, bid, NREP(10));
        pg8::EpiBf16 E{(bf16*)(args.ws + WS_QKV), 3072, 0};
        pg8::gemm_phase<pg8::EpiBf16, pg8::StaticOrder, true, true>(lds, g, S, E);
        } SEAM(pb + 10); TICK_OUT(10); } }
    #if SB_NAIVE
    { ARGS(); if (IN(pb + 11)) { TICK_IN(11); _Pragma("unroll 1") for (int rep_ = 0; rep_ < NREP(11); ++rep_) { phase_sb_naive(args, lds, bid, G, tid); } SEAM(pb + 11); TICK_OUT(11); } }
#else
    { ARGS(); if (IN(pb + 11)) { TICK_IN(11); _Pragma("unroll 1") for (int rep_ = 0; rep_ < NREP(11); ++rep_) { phase_sb_mfma(args, lds, bid, G, tid); } SEAM(pb + 11); TICK_OUT(11); } }
#endif
    { ARGS(); if (IN(pb + 12)) { TICK_IN(12); {
        pg8::Gemm g{(const bf16*)(args.ws + WS_AO), (const bf16*)(args.ws + W_O), D, D}; pg8::StaticOrder S; S.init(TT, D, G, bid);
        pg8::EpiResid<true> E{(const void*)args.out, YMOE, (const float*)(args.ws + WS_STATS), args.ln_g + (size_t)(4 * j + 1) * D, args.ln_b + (size_t)(4 * j + 1) * D};
        pg8::gemm_phase<pg8::EpiResid<true>, pg8::StaticOrder, true, true>(lds, g, S, E);
        } SEAM(pb + 12); TICK_OUT(12); } }
    { ARGS(); if (IN(pb + 13)) { TICK_IN(13); _Pragma("unroll 1") for (int rep_ = 0; rep_ < NREP(13); ++rep_) { phase_ln<true>(args, YMOE, (2 * j + 1) * 2 + 0, j, lds, bid, G, tid, wave, lane); } SEAM(pb + 13); TICK_OUT(13); } }
    { ARGS(); if (IN(pb + 14)) { TICK_IN(14); _Pragma("unroll 1") for (int rep_ = 0; rep_ < NREP(14); ++rep_) { phase_scatter(args, j, lds, bid, G, tid, wave, lane); } SEAM(pb + 14); TICK_OUT(14); } }
    { ARGS(); if (IN(pb + 15)) { TICK_IN(15); {
        unsigned off[9]; moe_offsets(args, j, off);
        pg8::MoeOrder S; S.nM = (int)(off[8] >> 8); S.G = G; S.c = bid; S.nN = 2 * FF / 256; S.nwg = S.nM * S.nN; S.rep = NREP(15);
        S.ps1 = (int)(off[1] >> 8); S.ps2 = (int)(off[2] >> 8); S.ps3 = (int)(off[3] >> 8); S.ps4 = (int)(off[4] >> 8); S.ps5 = (int)(off[5] >> 8); S.ps6 = (int)(off[6] >> 8); S.ps7 = (int)(off[7] >> 8);
        pg8::Gemm g{(const bf16*)(args.ws + WS_XS), (const bf16*)(args.ws + W_MGU), D, D};
        pg8::EpiSwiGLU E{(bf16*)(args.ws + WS_MACT), FF, 2 * FF / 256};
        pg8::gemm_phase<pg8::EpiSwiGLU, pg8::MoeOrder, true, true>(lds, g, S, E);
        } SEAM(pb + 15); TICK_OUT(15); } }
    { ARGS(); if (IN(pb + 16)) { TICK_IN(16); {
        unsigned off[9]; moe_offsets(args, j, off);
        pg8::MoeOrder S; S.nM = (int)(off[8] >> 8); S.G = G; S.c = bid; S.nN = D / 256; S.nwg = S.nM * S.nN; S.rep = NREP(16);
        S.ps1 = (int)(off[1] >> 8); S.ps2 = (int)(off[2] >> 8); S.ps3 = (int)(off[3] >> 8); S.ps4 = (int)(off[4] >> 8); S.ps5 = (int)(off[5] >> 8); S.ps6 = (int)(off[6] >> 8); S.ps7 = (int)(off[7] >> 8);
        pg8::Gemm g{(const bf16*)(args.ws + WS_MACT), (const bf16*)(args.ws + W_MD), FF, FF};
        pg8::EpiBf16 E{(bf16*)(args.ws + WS_XS), D, D / 256};
        pg8::gemm_phase<pg8::EpiBf16, pg8::MoeOrder, true, true>(lds, g, S, E);
        } SEAM(pb + 16); TICK_OUT(16); } }
    { ARGS(); if (IN(pb + 17)) { TICK_IN(17); _Pragma("unroll 1") for (int rep_ = 0; rep_ < NREP(17); ++rep_) { phase_combine_ln<(j == 1)>(args, YMOE, (bf16*)args.out, 4 * j + 2, 4 * j + 3, bid, G, wave, lane); } SEAM(pb + 17); TICK_OUT(17); } }
}
__global__ void __launch_bounds__(NWAVES * 64, 2) fwd(Args kargs) {
    extern __shared__ __attribute__((aligned(16))) unsigned char lds_raw[];
    LAS unsigned char* lds = (LAS unsigned char*)lds_raw;
    volatile LAS unsigned* MISC = (volatile LAS unsigned*)(lds + MISC_OFF);
    const int tid = threadIdx.x, lane = tid & 63, wave = __builtin_amdgcn_readfirstlane(tid >> 6), G = gridDim.x, bid = blockIdx.x;
    for (int u = tid; u < (LDS_BYTES - RING_BYTES) / 4; u += NWAVES * 64) ((LAS unsigned*)(lds + RING_BYTES))[u] = 0u;
    __syncthreads();
    if (tid == 0) { LAS unsigned long long* pa = (LAS unsigned long long*)(lds + ARGS_OFF);
        pa[0] = (unsigned long long)kargs.x; pa[1] = (unsigned long long)kargs.gdn_w_in; pa[2] = (unsigned long long)kargs.gdn_conv_w; pa[3] = (unsigned long long)kargs.gdn_a_log;
        pa[4] = (unsigned long long)kargs.gdn_dt_bias; pa[5] = (unsigned long long)kargs.gdn_norm_w; pa[6] = (unsigned long long)kargs.gdn_w_out; pa[7] = (unsigned long long)kargs.sb_w_in;
        pa[8] = (unsigned long long)kargs.sb_w_out; pa[9] = (unsigned long long)kargs.ffn_w_gate; pa[10] = (unsigned long long)kargs.ffn_w_up; pa[11] = (unsigned long long)kargs.ffn_w_down;
        pa[12] = (unsigned long long)kargs.moe_router; pa[13] = (unsigned long long)kargs.moe_w_gate; pa[14] = (unsigned long long)kargs.moe_w_up; pa[15] = (unsigned long long)kargs.moe_w_down;
        pa[16] = (unsigned long long)kargs.ln_g; pa[17] = (unsigned long long)kargs.ln_b; pa[18] = (unsigned long long)kargs.out; pa[19] = (unsigned long long)kargs.ws;
        pa[20] = (unsigned long long)(unsigned)kargs.ph_lo | ((unsigned long long)(unsigned)kargs.ph_hi << 32); }
    XcdBarrier bar = xcd_barrier_post((unsigned*)(kargs.ws + WS_CTL) + CW_BAR, MISC + 8);
    __syncthreads();
    layer_pair<0>(lds, bar, wave, G, bid);
    layer_pair<1>(lds, bar, wave, G, bid);
    if (PROBE_DELAY_MASK || PROBE_SEC) { if (bid == 0 && threadIdx.x == 0) { const unsigned acc = ((volatile LAS unsigned*)(lds + MISC_OFF))[20] * PROBE_DELAY_MULT; const unsigned long long t0 = __builtin_amdgcn_s_memrealtime(); while ((unsigned)(__builtin_amdgcn_s_memrealtime() - t0) < acc) __builtin_amdgcn_s_sleep(8); } }
}
#undef IN
#undef SEAM
#undef ARGS

extern "C" void kernel_launch(void* const* d_in, const int* in_sizes, int n_in, void* d_out, int out_size, void* d_ws, size_t ws_size, hipStream_t stream) {
    static int grid = 0;
    if (grid == 0) {
        if (n_in != 18 || in_sizes[0] != TT * D || out_size != TT * D || ws_size < WS_END) { fprintf(stderr, "kernel_launch: unexpected shapes (n_in %d, in0 %d, out %d, ws %zu); nothing launched\n", n_in, n_in > 0 ? in_sizes[0] : -1, out_size, ws_size); grid = -1; return; }
        int dev = 0, cus = 0, per_cu = 0;
        if (hipGetDevice(&dev) != hipSuccess || hipDeviceGetAttribute(&cus, hipDeviceAttributeMultiprocessorCount, dev) != hipSuccess) { grid = -1; return; }
        if (hipFuncSetAttribute((const void*)fwd, hipFuncAttributeMaxDynamicSharedMemorySize, LDS_BYTES) != hipSuccess) { fprintf(stderr, "kernel_launch: hipFuncSetAttribute failed\n"); grid = -1; return; }
        if (hipOccupancyMaxActiveBlocksPerMultiprocessor(&per_cu, (const void*)fwd, NWAVES * 64, LDS_BYTES) != hipSuccess || per_cu < 1) { fprintf(stderr, "kernel_launch: occupancy query says %d blocks per CU\n", per_cu); (void)hipGetLastError(); grid = -1; return; }
        grid = cus;
    }
    if (grid < 0) return;
    if (hipMemsetAsync((char*)d_ws + WS_CTL, 0, CTL_ZERO_BYTES, stream) != hipSuccess) return;
    Args a{};
    a.x = (const float*)d_in[0]; a.gdn_w_in = (const float*)d_in[1]; a.gdn_conv_w = (const float*)d_in[2]; a.gdn_a_log = (const float*)d_in[3]; a.gdn_dt_bias = (const float*)d_in[4];
    a.gdn_norm_w = (const float*)d_in[5]; a.gdn_w_out = (const float*)d_in[6]; a.sb_w_in = (const float*)d_in[7]; a.sb_w_out = (const float*)d_in[8];
    a.ffn_w_gate = (const float*)d_in[9]; a.ffn_w_up = (const float*)d_in[10]; a.ffn_w_down = (const float*)d_in[11]; a.moe_router = (const float*)d_in[12];
    a.moe_w_gate = (const float*)d_in[13]; a.moe_w_up = (const float*)d_in[14]; a.moe_w_down = (const float*)d_in[15]; a.ln_g = (const float*)d_in[16]; a.ln_b = (const float*)d_in[17];
    a.out = (float*)d_out; a.ws = (unsigned char*)d_ws;
#if MK_ONE_LAUNCH
    a.ph_lo = 0; a.ph_hi = NPHASES;
    hipLaunchKernelGGL(fwd, dim3(grid), dim3(NWAVES * 64), LDS_BYTES, stream, a);
#else
    for (int p = 0; p < NPHASES; ++p) { a.ph_lo = p; a.ph_hi = p + 1; hipLaunchKernelGGL(fwd, dim3(grid), dim3(NWAVES * 64), LDS_BYTES, stream, a); }
#endif
}
```

```cpp
#include <hip/hip_runtime.h>
#include <cstdio>
#include <cstdint>
#ifndef GDN_NAIVE
#define GDN_NAIVE 0
#endif
#ifndef SB_NAIVE
#define SB_NAIVE 0
#endif
#ifndef MK_ONE_LAUNCH
#define MK_ONE_LAUNCH 1
#endif
#ifndef PROBE_SEC
#define PROBE_SEC 0
#endif
#define GSEC_ACC(k, sign) do { if (PROBE_SEC == (k)) { if (blockIdx.x == 0 && threadIdx.x == 0) { volatile __attribute__((address_space(3))) unsigned* p_ = (volatile __attribute__((address_space(3))) unsigned*)(131072 + 320 + 80); *p_ = *p_ sign (unsigned)__builtin_amdgcn_s_memrealtime(); } } } while (0)
namespace pg8 {
#define PG8_LAS __attribute__((address_space(3)))
typedef unsigned short bf16_t;
typedef short bf16x8 __attribute__((ext_vector_type(8)));
typedef float f32x4 __attribute__((ext_vector_type(4)));
typedef unsigned u32x4 __attribute__((ext_vector_type(4)));
constexpr int BM = 256, BK = 64, HALF = 128, HTB = HALF * BK * 2  , STAGE_BYTES = 8 * HTB, NXCD = 8, WGM = 8;

__host__ __device__ __forceinline__ int lds_byte(int r, int c) { const int st = (r >> 4) * 2 + (c >> 5), rr = r & 15, cc = c & 31, ob = rr * 64 + cc * 2; return st * 1024 + (ob ^ (((ob >> 9) & 1) << 5)); }
__host__ __device__ __forceinline__ void stage_rc(int b, int& R, int& C) { const int st = b / 1024, sb = b % 1024, swz = sb ^ (((sb >> 9) & 1) << 5); R = (st >> 1) * 16 + swz / 64; C = (st & 1) * 32 + (swz % 64) / 2; }
__host__ __device__ __forceinline__ int perm32(int rho) { const int n = rho >> 4, i = rho & 15; return 8 * (i >> 2) + 4 * n + (i & 3); }

struct Unit { int pm, pn; };
struct Gemm { const bf16_t* A; const bf16_t* Bt; int lda, K; };

struct StaticOrder {
    int nM, nN, nwg, G, c, rep;
    __host__ __device__ void init(int M, int N, int G_, int c_, int rep_ = 1) { nM = M / BM; nN = N / BM; nwg = nM * nN; G = G_; c = c_; rep = rep_; }
    __host__ __device__ bool next(int i, Unit& u) const {
        const int L = i * G + c; if (L >= rep * nwg) return false;
        int wgid = rep == 1 ? L : L % nwg; { const int q = nwg / NXCD, r = nwg % NXCD, xcd = wgid % NXCD, off = wgid / NXCD; wgid = (xcd < r ? xcd * (q + 1) : r * (q + 1) + (xcd - r) * q) + off; }
        const int nig = WGM * nN, gid = wgid / nig, fm = gid * WGM, gsz = (nM - fm) < WGM ? (nM - fm) : WGM;
        u.pm = fm + ((wgid % nig) % gsz); u.pn = (wgid % nig) / gsz; return true;
    }
    __device__ __forceinline__ void a_ready(const Unit&) const {}
    __device__ __forceinline__ void done(const Unit&) const {}
};

__device__ __forceinline__ unsigned cvt_pk_bf16(float lo, float hi) { unsigned r; asm volatile("v_cvt_pk_bf16_f32 %0, %1, %2" : "=v"(r) : "v"(lo), "v"(hi)); return r; }
template <int SCL2 = 0> struct EpiBf16T {
    static constexpr bool PERM = true, AFTER_DRAIN = false;
    bf16_t* O; int ldc; int nmod;
    __device__ __forceinline__ void operator()(const f32x4 (&acc)[2][2][4][2], const Unit& u, int wr, int wc, int fr, int fq) const {
        const int pnl = nmod ? (u.pn % nmod) : u.pn;
        const int row0 = u.pm * BM + wr * 64 + fr, col0 = pnl * BM + wc * 32 + 8 * fq;
#pragma unroll
        for (int ai = 0; ai < 2; ++ai)
#pragma unroll
            for (int m = 0; m < 4; ++m) { bf16_t* rowp = O + (size_t)(row0 + ai * HALF + m * 16) * ldc + col0;
#pragma unroll
                for (int bj = 0; bj < 2; ++bj) { constexpr float sc = 1.0f / (float)(1 << SCL2); const f32x4 v0 = acc[ai][bj][m][0] * sc, v1 = acc[ai][bj][m][1] * sc;
                    u32x4 w; w.x = cvt_pk_bf16(v0[0], v0[1]); w.y = cvt_pk_bf16(v0[2], v0[3]); w.z = cvt_pk_bf16(v1[0], v1[1]); w.w = cvt_pk_bf16(v1[2], v1[3]);
                    *(u32x4*)(rowp + bj * HALF) = w; } }
    }
};
typedef EpiBf16T<0> EpiBf16;
struct EpiInProj {
    static constexpr bool PERM = true, AFTER_DRAIN = false;
    bf16_t* RAW; bf16_t* ZB;
    __device__ __forceinline__ void operator()(const f32x4 (&acc)[2][2][4][2], const Unit& u, int wr, int wc, int fr, int fq) const {
        const bool isz = (u.pn >= 16 && u.pn < 24);
        bf16_t* O = isz ? ZB : RAW; const int ldc = isz ? 2048 : 4352; const int ct = isz ? (u.pn - 16) : (u.pn < 16 ? u.pn : 16);
        const int row0 = u.pm * BM + wr * 64 + fr, col0 = ct * BM + wc * 32 + 8 * fq;
#pragma unroll
        for (int ai = 0; ai < 2; ++ai)
#pragma unroll
            for (int m = 0; m < 4; ++m) { bf16_t* rowp = O + (size_t)(row0 + ai * HALF + m * 16) * ldc + col0;
#pragma unroll
                for (int bj = 0; bj < 2; ++bj) { f32x4 v0 = acc[ai][bj][m][0], v1 = acc[ai][bj][m][1];
                    if (isz) {
#pragma unroll
                        for (int e = 0; e < 4; ++e) { v0[e] = v0[e] * __builtin_amdgcn_rcpf(1.0f + __builtin_amdgcn_exp2f(-1.4426950408889634f * v0[e])); v1[e] = v1[e] * __builtin_amdgcn_rcpf(1.0f + __builtin_amdgcn_exp2f(-1.4426950408889634f * v1[e])); } }
                    u32x4 w; w.x = cvt_pk_bf16(v0[0], v0[1]); w.y = cvt_pk_bf16(v0[2], v0[3]); w.z = cvt_pk_bf16(v1[0], v1[1]); w.w = cvt_pk_bf16(v1[2], v1[3]);
                    *(u32x4*)(rowp + bj * HALF) = w; } }
    }
};
__device__ __forceinline__ float silu_f(float x) { return x * __builtin_amdgcn_rcpf(1.0f + __builtin_amdgcn_exp2f(-1.4426950408889634f * x)); }
struct EpiSwiGLU {
    static constexpr bool PERM = true, AFTER_DRAIN = false;
    bf16_t* O; int ldc; int nmod;
    __device__ __forceinline__ void operator()(const f32x4 (&acc)[2][2][4][2], const Unit& u, int wr, int wc, int fr, int fq) const {
        const int pnl = nmod ? (u.pn % nmod) : u.pn;
        const int row0 = u.pm * BM + wr * 64 + fr, col0 = pnl * HALF + wc * 32 + 8 * fq;
#pragma unroll
        for (int ai = 0; ai < 2; ++ai)
#pragma unroll
            for (int m = 0; m < 4; ++m) { bf16_t* rowp = O + (size_t)(row0 + ai * HALF + m * 16) * ldc + col0;
                const f32x4 g0 = acc[ai][0][m][0], g1 = acc[ai][0][m][1], u0 = acc[ai][1][m][0], u1 = acc[ai][1][m][1];
                u32x4 w;
                w.x = cvt_pk_bf16(silu_f(g0[0]) * u0[0], silu_f(g0[1]) * u0[1]); w.y = cvt_pk_bf16(silu_f(g0[2]) * u0[2], silu_f(g0[3]) * u0[3]);
                w.z = cvt_pk_bf16(silu_f(g1[0]) * u1[0], silu_f(g1[1]) * u1[1]); w.w = cvt_pk_bf16(silu_f(g1[2]) * u1[2], silu_f(g1[3]) * u1[3]);
                *(u32x4*)rowp = w; }
    }
};
__device__ __forceinline__ float clamp_f8(float x) { return __builtin_fminf(__builtin_fmaxf(x, -448.0f), 448.0f); }
__device__ __forceinline__ unsigned pk4_f8(float a, float b, float c, float d) { int w = 0; w = __builtin_amdgcn_cvt_pk_fp8_f32(clamp_f8(a), clamp_f8(b), w, false); w = __builtin_amdgcn_cvt_pk_fp8_f32(clamp_f8(c), clamp_f8(d), w, true); return (unsigned)w; }
typedef unsigned u32x2 __attribute__((ext_vector_type(2)));
template <int SCL2, int OSC2> struct EpiSwiGLU8 {
    static constexpr bool PERM = true, AFTER_DRAIN = false;
    unsigned char* O; int ldc; int nmod;
    __device__ __forceinline__ void operator()(const f32x4 (&acc)[2][2][4][2], const Unit& u, int wr, int wc, int fr, int fq) const {
        constexpr float cg = 1.0f / (float)(1 << SCL2), cu = cg * (float)(1 << OSC2);
        const int pnl = nmod ? (u.pn % nmod) : u.pn;
        const int row0 = u.pm * BM + wr * 64 + fr, col0 = pnl * HALF + wc * 32 + 8 * fq;
#pragma unroll
        for (int ai = 0; ai < 2; ++ai)
#pragma unroll
            for (int m = 0; m < 4; ++m) { unsigned char* rowp = O + (size_t)(row0 + ai * HALF + m * 16) * ldc + col0;
                const f32x4 g0 = acc[ai][0][m][0] * cg, g1 = acc[ai][0][m][1] * cg, u0 = acc[ai][1][m][0] * cu, u1 = acc[ai][1][m][1] * cu;
                u32x2 w;
                w.x = pk4_f8(silu_f(g0[0]) * u0[0], silu_f(g0[1]) * u0[1], silu_f(g0[2]) * u0[2], silu_f(g0[3]) * u0[3]);
                w.y = pk4_f8(silu_f(g1[0]) * u1[0], silu_f(g1[1]) * u1[1], silu_f(g1[2]) * u1[2], silu_f(g1[3]) * u1[3]);
                *(u32x2*)rowp = w; }
    }
};
template <int SCL2, int OSC2> struct EpiF8T {
    static constexpr bool PERM = true, AFTER_DRAIN = false;
    unsigned char* O; int ldc; int nmod;
    __device__ __forceinline__ void operator()(const f32x4 (&acc)[2][2][4][2], const Unit& u, int wr, int wc, int fr, int fq) const {
        constexpr float sc = OSC2 >= SCL2 ? (float)(1 << (OSC2 >= SCL2 ? OSC2 - SCL2 : 0)) : 1.0f / (float)(1 << (SCL2 > OSC2 ? SCL2 - OSC2 : 0));
        const int pnl = nmod ? (u.pn % nmod) : u.pn;
        const int row0 = u.pm * BM + wr * 64 + fr, col0 = pnl * BM + wc * 32 + 8 * fq;
#pragma unroll
        for (int ai = 0; ai < 2; ++ai)
#pragma unroll
            for (int m = 0; m < 4; ++m) { unsigned char* rowp = O + (size_t)(row0 + ai * HALF + m * 16) * ldc + col0;
#pragma unroll
                for (int bj = 0; bj < 2; ++bj) { const f32x4 v0 = acc[ai][bj][m][0] * sc, v1 = acc[ai][bj][m][1] * sc;
                    u32x2 w; w.x = pk4_f8(v0[0], v0[1], v0[2], v0[3]); w.y = pk4_f8(v1[0], v1[1], v1[2], v1[3]);
                    *(u32x2*)(rowp + bj * HALF) = w; } }
    }
};
__device__ __forceinline__ f32x4 cvt_i4(const f32x4 a) { typedef int i32x4e __attribute__((ext_vector_type(4))); return __builtin_convertvector(__builtin_bit_cast(i32x4e, a), f32x4); }
template <int OSC2> struct EpiSwiGLUI8 {
    static constexpr bool PERM = true, AFTER_DRAIN = false;
    unsigned char* O; int ldc; int nmod; const float* sa; const float* sw;
    __device__ __forceinline__ void operator()(const f32x4 (&acc)[2][2][4][2], const Unit& u, int wr, int wc, int fr, int fq) const {
        constexpr float os = (float)(1 << OSC2);
        const int pnl = nmod ? (u.pn % nmod) : u.pn;
        const int row0 = u.pm * BM + wr * 64 + fr, col0 = pnl * HALF + wc * 32 + 8 * fq;
        const float* swp = sw + (size_t)u.pn * BM + wc * 32 + 8 * fq;
        const f32x4 sg0 = *(const f32x4*)swp, sg1 = *(const f32x4*)(swp + 4), su0 = *(const f32x4*)(swp + HALF) * os, su1 = *(const f32x4*)(swp + HALF + 4) * os;
#pragma unroll
        for (int ai = 0; ai < 2; ++ai) {
            float sr[4];
#pragma unroll
            for (int m = 0; m < 4; ++m) sr[m] = sa[row0 + ai * HALF + m * 16];
#pragma unroll
            for (int m = 0; m < 4; ++m) { unsigned char* rowp = O + (size_t)(row0 + ai * HALF + m * 16) * ldc + col0;
                const f32x4 g0 = cvt_i4(acc[ai][0][m][0]) * (sg0 * sr[m]), g1 = cvt_i4(acc[ai][0][m][1]) * (sg1 * sr[m]), u0 = cvt_i4(acc[ai][1][m][0]) * (su0 * sr[m]), u1 = cvt_i4(acc[ai][1][m][1]) * (su1 * sr[m]);
                u32x2 w;
                w.x = pk4_f8(silu_f(g0[0]) * u0[0], silu_f(g0[1]) * u0[1], silu_f(g0[2]) * u0[2], silu_f(g0[3]) * u0[3]);
                w.y = pk4_f8(silu_f(g1[0]) * u1[0], silu_f(g1[1]) * u1[1], silu_f(g1[2]) * u1[2], silu_f(g1[3]) * u1[3]);
                *(u32x2*)rowp = w; }
        }
    }
};
typedef float f32x2e __attribute__((ext_vector_type(2)));
template <bool LNR, int SCL2 = 0> struct EpiResid {
    static constexpr bool PERM = true, AFTER_DRAIN = false;
    const void* res; bf16_t* out; const float* stats; const float* g; const float* b;
    __device__ __forceinline__ void operator()(const f32x4 (&acc)[2][2][4][2], const Unit& u, int wr, int wc, int fr, int fq) const {
        constexpr int ldc = 1024; constexpr float alpha = 1.6817928305074290f, sc = 1.0f / (float)(1 << SCL2);
        const int row0 = u.pm * BM + wr * 64 + fr, col0 = u.pn * BM + wc * 32 + 8 * fq;
#pragma unroll
        for (int bj = 0; bj < 2; ++bj) {
            f32x4 g0, g1, b0, b1;
            if constexpr (LNR) { g0 = *(const f32x4*)(g + col0 + bj * HALF) * alpha; g1 = *(const f32x4*)(g + col0 + bj * HALF + 4) * alpha;
                                 b0 = *(const f32x4*)(b + col0 + bj * HALF) * alpha; b1 = *(const f32x4*)(b + col0 + bj * HALF + 4) * alpha; }
#pragma unroll
            for (int ai = 0; ai < 2; ++ai) {
                if constexpr (LNR) {
                    u32x4 w[4]; f32x2e st[4];
#pragma unroll
                    for (int m = 0; m < 4; ++m) { const int row = row0 + ai * HALF + m * 16; w[m] = *(const u32x4*)((const bf16_t*)res + (size_t)row * ldc + col0 + bj * HALF); st[m] = *(const f32x2e*)(stats + 2 * row); }
                    asm volatile("" ::: "memory");
#pragma unroll
                    for (int m = 0; m < 4; ++m) { const int row = row0 + ai * HALF + m * 16; const float mean = st[m].x, rstd = st[m].y;
                        const f32x4 r0 = {__uint_as_float(w[m].x << 16), __uint_as_float(w[m].x & 0xffff0000u), __uint_as_float(w[m].y << 16), __uint_as_float(w[m].y & 0xffff0000u)};
                        const f32x4 r1 = {__uint_as_float(w[m].z << 16), __uint_as_float(w[m].z & 0xffff0000u), __uint_as_float(w[m].w << 16), __uint_as_float(w[m].w & 0xffff0000u)};
                        const f32x4 v0 = (r0 - mean) * rstd * g0 + b0 + acc[ai][bj][m][0] * sc, v1 = (r1 - mean) * rstd * g1 + b1 + acc[ai][bj][m][1] * sc;
                        u32x4 o; o.x = cvt_pk_bf16(v0[0], v0[1]); o.y = cvt_pk_bf16(v0[2], v0[3]); o.z = cvt_pk_bf16(v1[0], v1[1]); o.w = cvt_pk_bf16(v1[2], v1[3]);
                        *(u32x4*)(out + (size_t)row * ldc + col0 + bj * HALF) = o; }
                } else {
                    f32x4 x0[4], x1[4];
#pragma unroll
                    for (int m = 0; m < 4; ++m) { const size_t off = (size_t)(row0 + ai * HALF + m * 16) * ldc + col0 + bj * HALF; x0[m] = *(const f32x4*)((const float*)res + off); x1[m] = *(const f32x4*)((const float*)res + off + 4); }
                    asm volatile("" ::: "memory");
#pragma unroll
                    for (int m = 0; m < 4; ++m) { const size_t off = (size_t)(row0 + ai * HALF + m * 16) * ldc + col0 + bj * HALF;
                        const f32x4 v0 = x0[m] * alpha + acc[ai][bj][m][0] * sc, v1 = x1[m] * alpha + acc[ai][bj][m][1] * sc;
                        u32x4 o; o.x = cvt_pk_bf16(v0[0], v0[1]); o.y = cvt_pk_bf16(v0[2], v0[3]); o.z = cvt_pk_bf16(v1[0], v1[1]); o.w = cvt_pk_bf16(v1[2], v1[3]);
                        *(u32x4*)(out + off) = o; }
                }
                asm volatile("" ::: "memory");
            }
        }
    }
};
struct MoeOrder {
    int nM, nN, nwg, G, c, rep; int ps1, ps2, ps3, ps4, ps5, ps6, ps7;
    __device__ __forceinline__ bool next(int i, Unit& u) const {
        const int L = i * G + c; if (nwg == 0 || L >= rep * nwg) return false;
        int wgid = rep == 1 ? L : L % nwg; { const int q = nwg / NXCD, r = nwg % NXCD, xcd = wgid % NXCD, off = wgid / NXCD; wgid = (xcd < r ? xcd * (q + 1) : r * (q + 1) + (xcd - r) * q) + off; }
        const int nig = WGM * nN, gid = wgid / nig, fm = gid * WGM, gsz = (nM - fm) < WGM ? (nM - fm) : WGM;
        const int pm = fm + ((wgid % nig) % gsz), pnl = (wgid % nig) / gsz;
        const int e = (pm >= ps1) + (pm >= ps2) + (pm >= ps3) + (pm >= ps4) + (pm >= ps5) + (pm >= ps6) + (pm >= ps7);
        u.pm = pm; u.pn = e * nN + pnl; return true;
    }
    __device__ __forceinline__ void a_ready(const Unit&) const {}
    __device__ __forceinline__ void done(const Unit&) const {}
};
template <class Inner> struct EpiI8 : Inner {
    static constexpr bool SCALE_PREP = true;
    const float* sa; const float* sw;
    __device__ __forceinline__ void prep(f32x4 (&acc)[2][2][4][2], const Unit& u, int wr, int wc, int fr, int fq) const {
        const float* swp = sw + (size_t)u.pn * BM + wc * 32 + 8 * fq; const float* sap = sa + u.pm * BM + wr * 64 + fr;
        f32x4 s4[2][2];
#pragma unroll
        for (int bj = 0; bj < 2; ++bj) { s4[bj][0] = *(const f32x4*)(swp + bj * HALF); s4[bj][1] = *(const f32x4*)(swp + bj * HALF + 4); }
#pragma unroll
        for (int ai = 0; ai < 2; ++ai) { float sr[4];
#pragma unroll
            for (int m = 0; m < 4; ++m) sr[m] = sap[ai * HALF + m * 16];
#pragma unroll
            for (int m = 0; m < 4; ++m)
#pragma unroll
                for (int bj = 0; bj < 2; ++bj)
#pragma unroll
                    for (int n = 0; n < 2; ++n) acc[ai][bj][m][n] = cvt_i4(acc[ai][bj][m][n]) * (s4[bj][n] * sr[m]); }
    }
};
template <class T, class = void> struct has_prep { static constexpr bool value = false; };
template <class T> struct has_prep<T, decltype((void)T::SCALE_PREP)> { static constexpr bool value = true; };
typedef int i32x8 __attribute__((ext_vector_type(8)));
typedef int i32x4q __attribute__((ext_vector_type(4)));
__device__ __forceinline__ i32x8 cat8(bf16x8 lo, bf16x8 hi) { const i32x4q a = __builtin_bit_cast(i32x4q, lo), b = __builtin_bit_cast(i32x4q, hi); return __builtin_shufflevector(a, b, 0, 1, 2, 3, 4, 5, 6, 7); }
template <class Epi, class Sched, bool ALIGN_EPI = false, bool SP2 = false, int QM = 0>
__device__ __forceinline__ void gemm_phase(PG8_LAS unsigned char* lds, const Gemm g, const Sched& S, const Epi& E, const int wid) {
    int lane; asm volatile("v_mbcnt_lo_u32_b32 %0, -1, 0\n\tv_mbcnt_hi_u32_b32 %0, -1, %0" : "=v"(lane));
    const int tid = wid * 64 + lane, wr = wid >> 2, wc = wid & 3, fr = lane & 15, fq = lane >> 4;
    const int K = g.K, nt = K / BK;
    unsigned voffA[2], voffB[2];
#pragma unroll
    for (int i = 0; i < 2; ++i) { int R, C; stage_rc(tid * 16 + i * 8192, R, C); const int Rb = Epi::PERM ? ((R & ~31) + perm32(R & 31)) : R;
        voffA[i] = (unsigned)(R * g.lda + C) * 2u; voffB[i] = (unsigned)(Rb * K + C) * 2u; }
    const size_t kstep = (size_t)(BK * 2);
    const size_t hstepA = (size_t)HALF * g.lda * 2, hstepB = (size_t)HALF * K * 2;
    const size_t tstepA = 2 * hstepA, tstepB = 2 * hstepB;
    const unsigned ldsw = (unsigned)wid * 1024u;
    const int aoff = lds_byte(wr * 64 + fr, fq * 8), boff = lds_byte(wc * 32 + fr, fq * 8);
#define PG8_SA(b, h) (((b) * 2 + (h)) * HTB)
#define PG8_SB(b, h) ((4 + (b) * 2 + (h)) * HTB)
#define PG8_STAGE(bufoff, gbase, voff) do { _Pragma("unroll") for (int _i = 0; _i < 2; ++_i) { unsigned vo_ = (voff)[_i]; asm volatile("" : "+v"(vo_));     \
        __builtin_amdgcn_global_load_lds((const unsigned*)((const char*)(gbase) + vo_), (PG8_LAS unsigned*)(lds + (bufoff) + ldsw + _i * 8192), 16, 0, 0); } } while (0)
#define PG8_LDA(dst, b, h) do { _Pragma("unroll") for (int m = 0; m < 4; ++m) _Pragma("unroll") for (int k = 0; k < 2; ++k) dst[m][k] = *(const PG8_LAS bf16x8*)(lds + PG8_SA(b, h) + aoff + m * 2048 + k * 1024); } while (0)
#define PG8_LDB(dst, b, h) do { _Pragma("unroll") for (int n = 0; n < 2; ++n) _Pragma("unroll") for (int k = 0; k < 2; ++k) dst[n][k] = *(const PG8_LAS bf16x8*)(lds + PG8_SB(b, h) + boff + n * 2048 + k * 1024); } while (0)
#define PG8_MMA(ai, bj, At, Bt) do { __builtin_amdgcn_s_setprio(1); _Pragma("unroll") for (int m = 0; m < 4; ++m) _Pragma("unroll") for (int n = 0; n < 2; ++n) { \
        if constexpr (QM == 1) acc[ai][bj][m][n] = __builtin_amdgcn_mfma_scale_f32_16x16x128_f8f6f4(cat8(Bt[n][0], Bt[n][1]), cat8(At[m][0], At[m][1]), acc[ai][bj][m][n], 0, 0, 0, 0, 0, 0); \
        else if constexpr (QM == 2) { _Pragma("unroll") for (int k = 0; k < 2; ++k) acc[ai][bj][m][n] = __builtin_bit_cast(f32x4, __builtin_amdgcn_mfma_i32_16x16x64_i8(__builtin_bit_cast(i32x4q, Bt[n][k]), __builtin_bit_cast(i32x4q, At[m][k]), __builtin_bit_cast(i32x4q, acc[ai][bj][m][n]), 0, 0, 0)); } \
        else { _Pragma("unroll") for (int k = 0; k < 2; ++k) acc[ai][bj][m][n] = __builtin_amdgcn_mfma_f32_16x16x32_bf16(Bt[n][k], At[m][k], acc[ai][bj][m][n], 0, 0, 0); } } __builtin_amdgcn_s_setprio(0); } while (0)
#define PG8_WAIT_V(n) asm volatile("s_waitcnt vmcnt(" #n ")" ::: "memory")
#define PG8_WAIT_L(n) asm volatile("s_waitcnt lgkmcnt(" #n ")" ::: "memory")
#define PG8_BAR __builtin_amdgcn_s_barrier()
#define PG8_SCHED __builtin_amdgcn_sched_barrier(0)
    Unit cur, nxt; int ui = 0;
    if (!S.next(0, cur)) return;
    f32x4 acc[2][2][4][2];
#pragma unroll
    for (int a = 0; a < 2; ++a)
#pragma unroll
        for (int b = 0; b < 2; ++b)
#pragma unroll
            for (int m = 0; m < 4; ++m)
#pragma unroll
                for (int n = 0; n < 2; ++n) acc[a][b][m][n] = (f32x4){0.f, 0.f, 0.f, 0.f};
    bf16x8 At[4][2], B0[2][2], B1[2][2];
    const char* cA = (const char*)g.A + (size_t)cur.pm * tstepA; const char* cB = (const char*)g.Bt + (size_t)cur.pn * tstepB;
    S.a_ready(cur);
    if constexpr (SP2) {
        PG8_STAGE(PG8_SB(0, 0), cB, voffB); PG8_STAGE(PG8_SB(0, 1), cB + hstepB, voffB); PG8_STAGE(PG8_SA(0, 0), cA, voffA); PG8_STAGE(PG8_SA(0, 1), cA + hstepA, voffA);
        if (wr == 1) PG8_BAR;
        PG8_WAIT_V(2); PG8_BAR;
        PG8_STAGE(PG8_SB(1, 0), cB + kstep, voffB); PG8_STAGE(PG8_SA(1, 0), cA + kstep, voffA); PG8_STAGE(PG8_SB(1, 1), cB + hstepB + kstep, voffB);
        PG8_WAIT_V(6); PG8_BAR;
    } else {
        PG8_STAGE(PG8_SB(0, 0), cB, voffB); PG8_STAGE(PG8_SA(0, 0), cA, voffA); PG8_STAGE(PG8_SB(0, 1), cB + hstepB, voffB); PG8_STAGE(PG8_SA(0, 1), cA + hstepA, voffA);
        if (wr == 1) PG8_BAR;
        PG8_WAIT_V(4); PG8_BAR;
        PG8_STAGE(PG8_SB(1, 0), cB + kstep, voffB); PG8_STAGE(PG8_SA(1, 0), cA + kstep, voffA); PG8_STAGE(PG8_SB(1, 1), cB + hstepB + kstep, voffB);
        PG8_WAIT_V(6); PG8_BAR;
    }
    for (;;) {
        const bool has_next = S.next(ui + 1, nxt);
        const char* nA = has_next ? (const char*)g.A + (size_t)nxt.pm * tstepA : cA; const char* nB = has_next ? (const char*)g.Bt + (size_t)nxt.pn * tstepB : cB;
        GSEC_ACC(6, -);
        for (int t = 0; t < nt; t += 2) {
            const bool last = (t == nt - 2);
            const char* a1 = cA + (size_t)(t + 1) * kstep;
            const char* a2 = last ? nA : cA + (size_t)(t + 2) * kstep; const char* b2 = last ? nB : cB + (size_t)(t + 2) * kstep;
            const char* a3 = a2 + kstep; const char* b3 = b2 + kstep;
            if (last && has_next) S.a_ready(nxt);
            if constexpr (SP2) {
            PG8_LDB(B0, 0, 0); PG8_LDB(B1, 0, 1); PG8_SCHED; PG8_LDA(At, 0, 0); PG8_STAGE(PG8_SA(1, 1), a1 + hstepA, voffA);
            PG8_WAIT_V(8); PG8_WAIT_L(0); PG8_BAR; PG8_MMA(0, 0, At, B0); PG8_MMA(0, 1, At, B1); PG8_BAR; PG8_SCHED;
            PG8_LDA(At, 0, 1); PG8_STAGE(PG8_SB(0, 0), b2, voffB); PG8_STAGE(PG8_SB(0, 1), b2 + hstepB, voffB); PG8_STAGE(PG8_SA(0, 0), a2, voffA);
            PG8_WAIT_V(8); PG8_WAIT_L(0); PG8_BAR; PG8_MMA(1, 0, At, B0); PG8_MMA(1, 1, At, B1); PG8_BAR; PG8_SCHED;
            PG8_LDB(B0, 1, 0); PG8_LDB(B1, 1, 1); PG8_SCHED; PG8_LDA(At, 1, 0); PG8_STAGE(PG8_SA(0, 1), a2 + hstepA, voffA);
            PG8_WAIT_V(8); PG8_WAIT_L(0); PG8_BAR; PG8_MMA(0, 0, At, B0); PG8_MMA(0, 1, At, B1); PG8_BAR; PG8_SCHED;
            PG8_LDA(At, 1, 1); PG8_STAGE(PG8_SB(1, 0), b3, voffB); PG8_STAGE(PG8_SB(1, 1), b3 + hstepB, voffB); PG8_STAGE(PG8_SA(1, 0), a3, voffA);
            PG8_WAIT_V(8); PG8_WAIT_L(0); PG8_BAR; PG8_MMA(1, 0, At, B0); PG8_MMA(1, 1, At, B1); PG8_BAR; PG8_SCHED;
            } else {
            PG8_LDB(B0, 0, 0); PG8_SCHED; PG8_LDA(At, 0, 0); PG8_STAGE(PG8_SA(1, 1), a1 + hstepA, voffA);
            PG8_WAIT_L(8); PG8_BAR; PG8_WAIT_L(0); PG8_MMA(0, 0, At, B0); PG8_BAR; PG8_SCHED;
            PG8_LDB(B1, 0, 1); PG8_STAGE(PG8_SB(0, 0), b2, voffB);
            PG8_BAR; PG8_WAIT_L(0); PG8_MMA(0, 1, At, B1); PG8_BAR;
            PG8_LDA(At, 0, 1); PG8_STAGE(PG8_SA(0, 0), a2, voffA);
            PG8_BAR; PG8_WAIT_L(0); PG8_MMA(1, 0, At, B0); PG8_BAR; PG8_SCHED;
            PG8_STAGE(PG8_SB(0, 1), b2 + hstepB, voffB);
            PG8_WAIT_V(6); PG8_BAR; PG8_MMA(1, 1, At, B1); PG8_BAR;
            PG8_LDB(B0, 1, 0); PG8_SCHED; PG8_LDA(At, 1, 0); PG8_STAGE(PG8_SA(0, 1), a2 + hstepA, voffA);
            PG8_WAIT_L(8); PG8_BAR; PG8_WAIT_L(0); PG8_MMA(0, 0, At, B0); PG8_BAR; PG8_SCHED;
            PG8_LDB(B1, 1, 1); PG8_STAGE(PG8_SB(1, 0), b3, voffB);
            PG8_BAR; PG8_WAIT_L(0); PG8_MMA(0, 1, At, B1); PG8_BAR;
            PG8_LDA(At, 1, 1); PG8_STAGE(PG8_SA(1, 0), a3, voffA);
            PG8_BAR; PG8_WAIT_L(0); PG8_MMA(1, 0, At, B0); PG8_BAR; PG8_SCHED;
            PG8_STAGE(PG8_SB(1, 1), b3 + hstepB, voffB);
            PG8_WAIT_V(6); PG8_BAR; PG8_MMA(1, 1, At, B1); PG8_BAR;
            }
        }
        GSEC_ACC(6, +); GSEC_ACC(7, -);
        if constexpr (ALIGN_EPI) { if (wr == 0) PG8_BAR; }
        if constexpr (!Epi::AFTER_DRAIN) { int l2_; asm volatile("v_mbcnt_lo_u32_b32 %0, -1, 0\n\tv_mbcnt_hi_u32_b32 %0, -1, %0" : "=v"(l2_));
            if constexpr (has_prep<Epi>::value) E.prep(acc, cur, wr, wc, l2_ & 15, l2_ >> 4);
            E(acc, cur, wr, wc, l2_ & 15, l2_ >> 4); S.done(cur); }
        GSEC_ACC(7, +);
        if (!has_next) break;
#pragma unroll
        for (int a = 0; a < 2; ++a)
#pragma unroll
            for (int b = 0; b < 2; ++b)
#pragma unroll
                for (int m = 0; m < 4; ++m)
#pragma unroll
                    for (int n = 0; n < 2; ++n) acc[a][b][m][n] = (f32x4){0.f, 0.f, 0.f, 0.f};
        cur = nxt; cA = nA; cB = nB; ++ui;
        if constexpr (ALIGN_EPI) { if (wr == 1) PG8_BAR; }
    }
    PG8_WAIT_V(0);
    if constexpr (!ALIGN_EPI) { if (wr == 0) PG8_BAR; }
    PG8_BAR;
    if constexpr (Epi::AFTER_DRAIN) { E.fused(acc, cur, wr, wc, fr, fq, lds, wid, lane); S.done(cur); }
#undef PG8_SA
#undef PG8_SB
#undef PG8_STAGE
#undef PG8_LDA
#undef PG8_LDB
#undef PG8_MMA
#undef PG8_WAIT_V
#undef PG8_WAIT_L
#undef PG8_BAR
#undef PG8_SCHED
}
}

constexpr int NWAVES = 8;
constexpr int BATCH = 8, SEQ = 4096, TT = BATCH * SEQ, D = 1024;
constexpr int HK = 8, HV = 16, HD = 128;
constexpr int GIN = 6176, GINP = 6400;
constexpr int FF = 3584, NE = 8, MOE_ROWS = 67584;
constexpr float ALPHA = 1.6817928305074290f;
constexpr float LN_EPS = 1e-5f, RMS_EPS = 1e-6f;
constexpr int NPH = 18, NPHASES = 2 * NPH;
constexpr int F8_YE = 6;
constexpr int F8_GO = 4, F8_WO = 11, F8_AO = 5, F8_WSO = 10;
constexpr int F8_H = 4, F8_WGU = 9, F8_ACT = 4, F8_WD = 11;

constexpr size_t MiB = 1ull << 20;
constexpr size_t WS_CTL = 0, CTL_ZERO_BYTES = 1 * MiB;
constexpr size_t WS_E12 = 1 * MiB;
constexpr size_t WS_G12 = WS_E12 + 256 * 1024;
constexpr size_t WS_POS = WS_G12 + 256 * 1024;
constexpr size_t WS_GB = 2 * MiB;
constexpr size_t WS_W = 16 * MiB;
constexpr size_t WS_W2 = 912 * MiB;
__host__ __device__ constexpr size_t gdn_wset(int j) { return j == 0 ? WS_W2 : 164 * MiB; }
__host__ __device__ constexpr size_t W_IN_(int j) { return gdn_wset(j); }
__host__ __device__ constexpr size_t W_OUT_(int j) { return gdn_wset(j) + 7 * MiB; }
__host__ __device__ constexpr size_t W_GU_(int j) { return gdn_wset(j) + 9 * MiB; }
__host__ __device__ constexpr size_t W_D_(int j) { return gdn_wset(j) + 16 * MiB; }
constexpr size_t W_QKV = WS_W, W_O = WS_W + 6 * MiB, W_MGU = WS_W + 8 * MiB, W_MD = WS_W + 120 * MiB;
constexpr size_t WS_G8 = 192 * MiB;
constexpr size_t WS_HB = 192 * MiB;
constexpr size_t WS_BIG = 256 * MiB;
constexpr size_t WS_ZB = WS_BIG, WS_RAW = WS_BIG + 128 * MiB, WS_QKVC = WS_BIG + 400 * MiB;
constexpr int RAWLD = 4352;
constexpr size_t WS_WMEM = WS_RAW, WS_IMEM = WS_RAW + 128 * MiB, WS_KTMEM = WS_RAW + 192 * MiB;
constexpr size_t WS_HS = 13 * MiB, WS_XSS = 13 * MiB + 512 * 1024;
constexpr size_t WS_SWI = 14 * MiB + 64 * 1024, WS_SWQ = 14 * MiB + 128 * 1024;
__host__ __device__ constexpr size_t WS_SWD_(int j) { return 14 * MiB + (size_t)j * 192 * 1024; }
__host__ __device__ constexpr size_t WS_SWI_(int j) { return 14 * MiB + 64 * 1024 + (size_t)j * 192 * 1024; }
constexpr size_t WS_SWD = 14 * MiB, WS_SWM = 14 * MiB + 512 * 1024;
constexpr size_t WS_STATS = 12 * MiB;
constexpr size_t WS_GTAB = 6 * MiB;
constexpr size_t WS_ACT = WS_BIG;
constexpr size_t WS_QKV = WS_BIG, WS_AO = WS_BIG + 192 * MiB;
constexpr size_t WS_XS = WS_BIG, WS_MACT = WS_BIG + 132 * MiB;
constexpr size_t WS_YT = 850 * MiB;
constexpr size_t WS_END = 950 * MiB;
static_assert(WS_QKVC + (size_t)TT * 4096 * 2 <= WS_W2 && WS_MACT + (size_t)MOE_ROWS * FF * 2 <= WS_END && WS_RAW + (size_t)TT * RAWLD * 2 <= WS_QKVC && WS_KTMEM + (size_t)4096 * 8192 * 2 <= WS_QKVC && WS_GTAB + (size_t)8192 * 192 * 4 <= WS_W, "d_ws map");
static_assert(W_MD + (size_t)NE * D * FF <= 164 * MiB && gdn_wset(1) + 20 * MiB <= WS_HB && gdn_wset(0) + 20 * MiB <= WS_END && W_MGU + (size_t)NE * 2 * FF * D <= W_MD, "weight map");
constexpr int CW_BAR = 4096;
constexpr int CW_WQ = 32768;
constexpr int CW_CNT = 16384;

constexpr int RING_BYTES = 131072;
constexpr int MISC_OFF = RING_BYTES + 320;
constexpr int OGST_OFF = 147456;
#define SEC_IN(k) do { if (PROBE_SEC == (k)) { if (blockIdx.x == 0 && (threadIdx.x == 0)) ((volatile LAS unsigned*)((LAS unsigned char*)0 + MISC_OFF))[20] -= (unsigned)__builtin_amdgcn_s_memrealtime(); } } while (0)
#define SEC_OUT(k) do { if (PROBE_SEC == (k)) { if (blockIdx.x == 0 && (threadIdx.x == 0)) ((volatile LAS unsigned*)((LAS unsigned char*)0 + MISC_OFF))[20] += (unsigned)__builtin_amdgcn_s_memrealtime(); } } while (0)
constexpr int LDS_BYTES = 163840;

#define GAS __attribute__((address_space(1)))
#define LAS __attribute__((address_space(3)))
#define DI __device__ __forceinline__
typedef unsigned short bf16;
typedef unsigned v4u __attribute__((ext_vector_type(4)));
typedef unsigned v2u __attribute__((ext_vector_type(2)));
typedef float f32x4 __attribute__((ext_vector_type(4)));
typedef float f32x2 __attribute__((ext_vector_type(2)));
typedef GAS unsigned gu32;
#define RLX_AGENT __ATOMIC_RELAXED, __HIP_MEMORY_SCOPE_AGENT
#define LDS_WAIT() asm volatile("s_waitcnt lgkmcnt(0)" ::: "memory")
#define VM_WAIT() asm volatile("s_waitcnt vmcnt(0)" ::: "memory")
__device__ __forceinline__ unsigned long long rt() { return __builtin_amdgcn_s_memrealtime(); }
__device__ __forceinline__ unsigned f2bf(float f) { unsigned u = __builtin_bit_cast(unsigned, f); return (u + 0x7fffu + ((u >> 16) & 1u)) >> 16; }
__device__ __forceinline__ unsigned pk2(float lo, float hi) { return f2bf(lo) | (f2bf(hi) << 16); }

#define XB_TMO      128
#define XB_XCNT(j)  (256  + 64 * (j))
#define XB_XSUB(j)  (1280 + 64 * (j))
#define XB_XGEN(j)  (2304 + 64 * (j))
#define XB_TOP      3328
#define XB_TOPGEN   3392
#define XCD_BAR_WORDS 3456
#define XB_SPIN_CAP (1u << 22)

__device__ __forceinline__ unsigned xb_ld(unsigned* p)              { return __hip_atomic_load(p, __ATOMIC_RELAXED, __HIP_MEMORY_SCOPE_AGENT); }
__device__ __forceinline__ unsigned xb_add(unsigned* p, unsigned v) { return __hip_atomic_fetch_add(p, v, __ATOMIC_RELAXED, __HIP_MEMORY_SCOPE_AGENT); }
__device__ __forceinline__ unsigned xb_xcc_id() { return (unsigned)__builtin_amdgcn_s_getreg((3 << 11) | 20) & 0xFu; }
#define XB_SPIN(cond, bar) do { unsigned _sp = 0; while (cond) { __builtin_amdgcn_s_sleep(1); \
    if ((++_sp & 255u) == 0u) { if (xb_ld(&(bar)[XB_TMO])) break; if (_sp > XB_SPIN_CAP) { atomicAdd(&(bar)[XB_TMO], 1u); break; } } } } while (0)

struct XcdBarrier {
    unsigned* bar; unsigned x;
    volatile LAS unsigned* st;
};

__device__ __forceinline__ XcdBarrier xcd_barrier_post(unsigned* bar, volatile LAS unsigned* st) {
    XcdBarrier b; b.bar = bar; b.x = xb_xcc_id(); b.st = st;
    if (threadIdx.x == 0) (void)xb_add(&bar[XB_XCNT(b.x)], 1u);
    return b;
}
__device__ __forceinline__ void xcd_barrier_complete(unsigned* bar, unsigned x, unsigned& nloc, unsigned& nx) {
    const unsigned G = gridDim.x * gridDim.y * gridDim.z;
    unsigned sum, cnt, mine, sp = 0u;
    for (;;) {
        sum = 0u; cnt = 0u; mine = 0u;
#pragma unroll
        for (unsigned j = 0; j < 16; ++j) { const unsigned c = xb_ld(&bar[XB_XCNT(j)]); sum += c; cnt += (c > 0u) ? 1u : 0u; mine = (j == x) ? c : mine; }
        if (sum == G) break;
        __builtin_amdgcn_s_sleep(1);
        if ((++sp & 255u) == 0u) { if (xb_ld(&bar[XB_TMO])) break; if (sp > XB_SPIN_CAP) { atomicAdd(&bar[XB_TMO], 1u); break; } }
    }
    nloc = mine > 0u ? mine : 1u; nx = cnt > 0u ? cnt : 1u;
}

__device__ __forceinline__ void xcd_barrier(const XcdBarrier& b, const bool leader) {
    asm volatile("s_waitcnt vmcnt(0)" ::: "memory");
    __syncthreads();
    if (leader) {
        unsigned* bar = b.bar;
        __builtin_amdgcn_s_waitcnt(0);
        unsigned nloc = b.st[0], nx = b.st[1];
        if (nloc == 0u) { xcd_barrier_complete(bar, b.x, nloc, nx); b.st[0] = nloc; b.st[1] = nx; }
        const unsigned old = xb_add(&bar[XB_XSUB(b.x)], 1u);
        const unsigned gen = old / nloc;
        if (old + 1u == (gen + 1u) * nloc) {
            __builtin_amdgcn_fence(__ATOMIC_RELEASE, "agent");
            asm volatile("s_waitcnt vmcnt(0)" ::: "memory");
            const unsigned og = xb_add(&bar[XB_TOP], 1u);
            const unsigned tg = og / nx;
            if (og + 1u == (tg + 1u) * nx) xb_add(&bar[XB_TOPGEN], 1u);
            else XB_SPIN(xb_ld(&bar[XB_TOPGEN]) == tg, bar);
            __builtin_amdgcn_fence(__ATOMIC_ACQUIRE, "agent");
            xb_add(&bar[XB_XGEN(b.x)], 1u);
            asm volatile("s_waitcnt vmcnt(0)" ::: "memory");
        } else {
            XB_SPIN(xb_ld(&bar[XB_XGEN(b.x)]) == gen, bar);
            __builtin_amdgcn_fence(__ATOMIC_ACQUIRE, "agent");
            asm volatile("s_waitcnt vmcnt(0)" ::: "memory");
        }
    }
    __syncthreads();
}

DI float bf_lo(unsigned w) { return __uint_as_float(w << 16); }
DI float bf_hi(unsigned w) { return __uint_as_float(w & 0xffff0000u); }
DI float wave_sum(float v) {
    v += __builtin_bit_cast(float, __builtin_amdgcn_update_dpp(0, __builtin_bit_cast(int, v), 0xB1, 0xF, 0xF, false));
    v += __builtin_bit_cast(float, __builtin_amdgcn_update_dpp(0, __builtin_bit_cast(int, v), 0x4E, 0xF, 0xF, false));
    v += __builtin_bit_cast(float, __builtin_amdgcn_update_dpp(0, __builtin_bit_cast(int, v), 0x141, 0xF, 0xF, false));
    v += __builtin_bit_cast(float, __builtin_amdgcn_update_dpp(0, __builtin_bit_cast(int, v), 0x140, 0xF, 0xF, false));
    v += __builtin_bit_cast(float, __builtin_amdgcn_update_dpp(0, __builtin_bit_cast(int, v), 0x142, 0xA, 0xF, false));
    v += __builtin_bit_cast(float, __builtin_amdgcn_update_dpp(0, __builtin_bit_cast(int, v), 0x143, 0xC, 0xF, false));
    return __builtin_bit_cast(float, __builtin_amdgcn_readlane(__builtin_bit_cast(int, v), 63));
}
DI float sigmoid_f(float x) { return 1.0f / (1.0f + __expf(-x)); }
DI int opaque_lane() { int l; asm volatile("v_mbcnt_lo_u32_b32 %0, -1, 0\n\tv_mbcnt_hi_u32_b32 %0, -1, %0" : "=v"(l)); return l; }
DI float wave_max_nn(float v) {
    v = fmaxf(v, __builtin_bit_cast(float, __builtin_amdgcn_update_dpp(0, __builtin_bit_cast(int, v), 0xB1, 0xF, 0xF, false)));
    v = fmaxf(v, __builtin_bit_cast(float, __builtin_amdgcn_update_dpp(0, __builtin_bit_cast(int, v), 0x4E, 0xF, 0xF, false)));
    v = fmaxf(v, __builtin_bit_cast(float, __builtin_amdgcn_update_dpp(0, __builtin_bit_cast(int, v), 0x141, 0xF, 0xF, false)));
    v = fmaxf(v, __builtin_bit_cast(float, __builtin_amdgcn_update_dpp(0, __builtin_bit_cast(int, v), 0x140, 0xF, 0xF, false)));
    v = fmaxf(v, __builtin_bit_cast(float, __builtin_amdgcn_update_dpp(0, __builtin_bit_cast(int, v), 0x142, 0xA, 0xF, false)));
    v = fmaxf(v, __builtin_bit_cast(float, __builtin_amdgcn_update_dpp(0, __builtin_bit_cast(int, v), 0x143, 0xC, 0xF, false)));
    return __builtin_bit_cast(float, __builtin_amdgcn_readlane(__builtin_bit_cast(int, v), 63));
}
DI unsigned pk4_i8(float a, float b, float c, float d) {
    unsigned w = 0u;
    w = __builtin_amdgcn_cvt_pk_u8_f32(__builtin_rintf(a) + 128.0f, 0, w); w = __builtin_amdgcn_cvt_pk_u8_f32(__builtin_rintf(b) + 128.0f, 1, w);
    w = __builtin_amdgcn_cvt_pk_u8_f32(__builtin_rintf(c) + 128.0f, 2, w); w = __builtin_amdgcn_cvt_pk_u8_f32(__builtin_rintf(d) + 128.0f, 3, w);
    return w ^ 0x80808080u;
}

struct Args {
    const float *x, *gdn_w_in, *gdn_conv_w, *gdn_a_log, *gdn_dt_bias, *gdn_norm_w, *gdn_w_out, *sb_w_in, *sb_w_out, *ffn_w_gate, *ffn_w_up, *ffn_w_down,
                *moe_router, *moe_w_gate, *moe_w_up, *moe_w_down, *ln_g, *ln_b;
    float* out; unsigned char* ws; int ph_lo, ph_hi;
};

DI void transpose_item(const float* W, int ldw, bf16* WT, int K, int drow0, int k0, int n0, LAS float* scr, int lane) {
#pragma unroll 8
    for (int i = 0; i < 32; ++i) { const int kk = 2 * i + (lane >> 5); scr[kk * 33 + (lane & 31)] = W[(size_t)(k0 + kk) * ldw + n0 + (lane & 31)]; }
    LDS_WAIT(); asm volatile("" ::: "memory");
    const int c = lane & 7;
#pragma unroll
    for (int jj = 0; jj < 4; ++jj) { const int n = (lane >> 3) + 8 * jj; const LAS float* s = scr + (8 * c) * 33 + n;
        v4u o; o.x = pk2(s[0 * 33], s[1 * 33]); o.y = pk2(s[2 * 33], s[3 * 33]); o.z = pk2(s[4 * 33], s[5 * 33]); o.w = pk2(s[6 * 33], s[7 * 33]);
        *(v4u*)(WT + (size_t)(drow0 + n) * K + k0 + 8 * c) = o; }
    LDS_WAIT(); asm volatile("" ::: "memory");
}

DI void transpose_item64(const float* W, int ldw, bf16* WT, int K, int drow0, int k0, int n0, LAS unsigned char* scr, int lane) {
    const int q = lane >> 4, cx = lane & 15;
    f32x4 r[16];
#pragma unroll
    for (int i = 0; i < 16; ++i) r[i] = *(const f32x4*)(W + (size_t)(k0 + 16 * q + i) * ldw + n0 + 4 * cx);
#pragma unroll
    for (int e = 0; e < 4; ++e) {
        v4u w0, w1;
        w0.x = pk2(r[0][e], r[1][e]); w0.y = pk2(r[2][e], r[3][e]); w0.z = pk2(r[4][e], r[5][e]); w0.w = pk2(r[6][e], r[7][e]);
        w1.x = pk2(r[8][e], r[9][e]); w1.y = pk2(r[10][e], r[11][e]); w1.z = pk2(r[12][e], r[13][e]); w1.w = pk2(r[14][e], r[15][e]);
        *(LAS v4u*)(scr + (4 * cx + e) * 144 + q * 32) = w0; *(LAS v4u*)(scr + (4 * cx + e) * 144 + q * 32 + 16) = w1;
    }
    LDS_WAIT(); asm volatile("" ::: "memory");
#pragma unroll
    for (int j = 0; j < 8; ++j) { const int id = lane + 64 * j, n = id >> 3, kp = id & 7;
        *(v4u*)(WT + (size_t)(drow0 + n) * K + k0 + 8 * kp) = *(const LAS v4u*)(scr + n * 144 + kp * 16); }
    LDS_WAIT(); asm volatile("" ::: "memory");
}

DI void transpose_item64_f8(const float* W, int ldw, unsigned char* WT, int K, int drow0, int k0, int n0, float sc, LAS unsigned char* scr, int lane) {
    const int q = lane >> 4, cx = lane & 15;
    f32x4 r[16];
#pragma unroll
    for (int i = 0; i < 16; ++i) r[i] = *(const f32x4*)(W + (size_t)(k0 + 16 * q + i) * ldw + n0 + 4 * cx) * sc;
#pragma unroll
    for (int e = 0; e < 4; ++e) {
        v4u w; w.x = pg8::pk4_f8(r[0][e], r[1][e], r[2][e], r[3][e]); w.y = pg8::pk4_f8(r[4][e], r[5][e], r[6][e], r[7][e]); w.z = pg8::pk4_f8(r[8][e], r[9][e], r[10][e], r[11][e]); w.w = pg8::pk4_f8(r[12][e], r[13][e], r[14][e], r[15][e]);
        *(LAS v4u*)(scr + (4 * cx + e) * 80 + q * 16) = w;
    }
    LDS_WAIT(); asm volatile("" ::: "memory");
#pragma unroll
    for (int j = 0; j < 4; ++j) { const int id = lane + 64 * j, n = id >> 2, kp = id & 3;
        *(v4u*)(WT + (size_t)(drow0 + n) * K + k0 + 16 * kp) = *(const LAS v4u*)(scr + n * 80 + kp * 16); }
    LDS_WAIT(); asm volatile("" ::: "memory");
}

DI void strip_item_i8(const float* W, int ldw, unsigned char* WT, float* SW, int drow0, int n0, LAS unsigned char* lds, int wave, int lane) {
    const int q = lane >> 3, cx = lane & 7;
    LAS unsigned char* scr = lds + wave * 16384;
    f32x4 r[16];
#pragma unroll
    for (int i = 0; i < 16; ++i) r[i] = *(const f32x4*)(W + (size_t)(128 * wave + 16 * q + i) * ldw + n0 + 4 * cx);
    f32x4 m = {0.f, 0.f, 0.f, 0.f};
#pragma unroll
    for (int i = 0; i < 16; ++i)
#pragma unroll
        for (int e = 0; e < 4; ++e) m[e] = fmaxf(m[e], fabsf(r[i][e]));
#pragma unroll
    for (int e = 0; e < 4; ++e) { m[e] = fmaxf(m[e], __shfl_xor(m[e], 8)); m[e] = fmaxf(m[e], __shfl_xor(m[e], 16)); m[e] = fmaxf(m[e], __shfl_xor(m[e], 32)); }
    if (q == 0) *(LAS f32x4*)(scr + 12288 + 16 * cx) = m;
    __syncthreads();
    f32x4 cm = {1.0e-30f, 1.0e-30f, 1.0e-30f, 1.0e-30f};
#pragma unroll
    for (int w = 0; w < NWAVES; ++w) { const f32x4 o = *(const LAS f32x4*)(lds + w * 16384 + 12288 + 16 * cx);
#pragma unroll
        for (int e = 0; e < 4; ++e) cm[e] = fmaxf(cm[e], o[e]); }
    if (wave == 0 && q == 0) *(f32x4*)(SW + drow0 + 4 * cx) = cm * (1.0f / 127.0f);
#pragma unroll
    for (int e = 0; e < 4; ++e) { const float s1 = 127.0f / cm[e];
        v4u w; w.x = pk4_i8(r[0][e] * s1, r[1][e] * s1, r[2][e] * s1, r[3][e] * s1); w.y = pk4_i8(r[4][e] * s1, r[5][e] * s1, r[6][e] * s1, r[7][e] * s1);
        w.z = pk4_i8(r[8][e] * s1, r[9][e] * s1, r[10][e] * s1, r[11][e] * s1); w.w = pk4_i8(r[12][e] * s1, r[13][e] * s1, r[14][e] * s1, r[15][e] * s1);
        *(LAS v4u*)(scr + (4 * cx + e) * 144 + q * 16) = w; }
    LDS_WAIT(); asm volatile("" ::: "memory");
#pragma unroll
    for (int j = 0; j < 4; ++j) { const int id = lane + 64 * j, n = id >> 3, kp = id & 7;
        *(v4u*)(WT + (size_t)(drow0 + n) * 1024 + 128 * wave + 16 * kp) = *(const LAS v4u*)(scr + n * 144 + kp * 16); }
    LDS_WAIT(); asm volatile("" ::: "memory");
    __syncthreads();
}

DI void phase_w_gdn(const Args& a, int j, int part, LAS unsigned char* lds, int bid, int G, int tid_, int wave, int lane_) {
    const int lane = opaque_lane(), tid = wave * 64 + lane;
    LAS float* scr = (LAS float*)(lds + wave * 16384);
    const int gw = bid * NWAVES + wave, NGW = G * NWAVES;
    const float* Win = a.gdn_w_in + (size_t)j * D * GIN; const float* Wout = a.gdn_w_out + (size_t)j * 2048 * D;
    const float* Wg = a.ffn_w_gate + (size_t)j * D * FF; const float* Wu = a.ffn_w_up + (size_t)j * D * FF; const float* Wd = a.ffn_w_down + (size_t)j * FF * D;
    unsigned char* WIN_T = a.ws + W_IN_(j); unsigned char* WOUT_T = a.ws + W_OUT_(j); unsigned char* WGU_T = a.ws + W_GU_(j); unsigned char* WD_T = a.ws + W_D_(j);
    const bool do_in = part != 1, do_rest = part != 0;
    LAS unsigned char* scb = (LAS unsigned char*)scr;
    constexpr int I_SIN = GIN / 32, I_OUT = 32 * 16, I_S = 112, I_D = 56 * 16, NIT = I_OUT + I_D, NWGI = 2 * I_S + I_SIN;
    const int wg_lo = do_rest ? 0 : 2 * I_S, wg_hi = do_in ? NWGI : 2 * I_S;
    for (int it = wg_lo + bid; it < wg_hi; it += G) {
        if (it < 2 * I_S) { const bool up = it >= I_S; const int n0 = 32 * (up ? it - I_S : it);
            strip_item_i8(up ? Wu : Wg, FF, WGU_T, (float*)(a.ws + WS_SWD_(j)), 256 * (n0 >> 7) + (up ? 128 : 0) + (n0 & 127), n0, lds, wave, lane); }
        else { const int n0 = 32 * (it - 2 * I_S); strip_item_i8(Win, GIN, WIN_T, (float*)(a.ws + WS_SWI_(j)), n0, n0, lds, wave, lane); } }
    const int gwr = (gw + NGW - (((wg_hi - wg_lo) % G) * NWAVES) % NGW) % NGW;
    for (int it = gwr; it < (do_rest ? NIT : 0); it += NGW) {
        int r = it;
        if (r < I_OUT) { const int kb = r / 16, nb = r % 16; transpose_item64_f8(Wout, D, WOUT_T, 2048, 64 * nb, 64 * kb, 64 * nb, (float)(1 << F8_WO), scb, lane); continue; } r -= I_OUT;
        { const int kb = r / 16, nb = r % 16; transpose_item64_f8(Wd, D, WD_T, FF, 64 * nb, 64 * kb, 64 * nb, (float)(1 << F8_WD), scb, lane); }
    }
    if (j == 0 && (part == 0 || part == 3)) {
        unsigned char* HB = a.ws + WS_HB; float* HS = (float*)(a.ws + WS_HS);
        for (int t = gw; t < TT; t += NGW) { const f32x4* xr = (const f32x4*)(a.x + (size_t)t * D);
            f32x4 p[2][2]; float am = 0.f;
#pragma unroll
            for (int q = 0; q < 2; ++q) { p[q][0] = xr[2 * (lane + 64 * q)]; p[q][1] = xr[2 * (lane + 64 * q) + 1]; }
#pragma unroll
            for (int q = 0; q < 2; ++q)
#pragma unroll
                for (int c = 0; c < 4; ++c) am = fmaxf(am, fmaxf(fabsf(p[q][0][c]), fabsf(p[q][1][c])));
            am = fmaxf(wave_max_nn(am), 1.0e-20f); const float qs = 127.0f / am;
            if (lane == 0) HS[t] = am * (1.0f / 127.0f);
#pragma unroll
            for (int q = 0; q < 2; ++q) { v2u o; o.x = pk4_i8(p[q][0][0] * qs, p[q][0][1] * qs, p[q][0][2] * qs, p[q][0][3] * qs); o.y = pk4_i8(p[q][1][0] * qs, p[q][1][1] * qs, p[q][1][2] * qs, p[q][1][3] * qs);
                ((v2u*)(HB + (size_t)t * D))[lane + 64 * q] = o; } }
    }
}
DI void phase_w_gdn_dyn(const Args& a, int j, unsigned* ctr, LAS unsigned char* lds, int wave) {
    const int lane = opaque_lane(), tid = wave * 64 + lane;
    const float* Win = a.gdn_w_in + (size_t)j * D * GIN; const float* Wout = a.gdn_w_out + (size_t)j * 2048 * D;
    const float* Wg = a.ffn_w_gate + (size_t)j * D * FF; const float* Wu = a.ffn_w_up + (size_t)j * D * FF; const float* Wd = a.ffn_w_down + (size_t)j * FF * D;
    unsigned char* WIN_T = a.ws + W_IN_(j); unsigned char* WOUT_T = a.ws + W_OUT_(j); unsigned char* WGU_T = a.ws + W_GU_(j); unsigned char* WD_T = a.ws + W_D_(j);
    LAS unsigned char* scb = lds + wave * 16384;
    volatile LAS int* slot = (volatile LAS int*)(lds + RING_BYTES - 16);
    constexpr int I_SIN = GIN / 32, I_OUT = 32 * 16, I_S = 112, I_D = 56 * 16, NIT = I_OUT + I_D, NWGI = 2 * I_S + I_SIN, NQ = NWGI + NIT / NWAVES;
    static_assert(NIT % NWAVES == 0, "eight transposes per queue item");
    for (;;) {
        __syncthreads();
        if (tid == 0) *slot = (int)__hip_atomic_fetch_add(ctr, 1u, __ATOMIC_RELAXED, __HIP_MEMORY_SCOPE_AGENT);
        __syncthreads();
        const int it = __builtin_amdgcn_readfirstlane(*slot);
        if (it >= NQ) break;
        if (it < 2 * I_S) { const bool up = it >= I_S; const int n0 = 32 * (up ? it - I_S : it);
            strip_item_i8(up ? Wu : Wg, FF, WGU_T, (float*)(a.ws + WS_SWD_(j)), 256 * (n0 >> 7) + (up ? 128 : 0) + (n0 & 127), n0, lds, wave, lane); }
        else if (it < NWGI) { const int n0 = 32 * (it - 2 * I_S); strip_item_i8(Win, GIN, WIN_T, (float*)(a.ws + WS_SWI_(j)), n0, n0, lds, wave, lane); }
        else { int r = (it - NWGI) * NWAVES + wave;
            if (r < I_OUT) { const int kb = r / 16, nb = r % 16; transpose_item64_f8(Wout, D, WOUT_T, 2048, 64 * nb, 64 * kb, 64 * nb, (float)(1 << F8_WO), scb, lane); }
            else { r -= I_OUT; const int kb = r / 16, nb = r % 16; transpose_item64_f8(Wd, D, WD_T, FF, 64 * nb, 64 * kb, 64 * nb, (float)(1 << F8_WD), scb, lane); } }
    }
}
DI void phase_w_sb(const Args& a, int j, LAS unsigned char* lds, int bid, int G, int wave, int lane_) {
    const int lane = opaque_lane();
    LAS float* scr = (LAS float*)(lds + wave * 16384);
    const int gw = bid * NWAVES + wave, NGW = G * NWAVES;
    const float* Wqkv = a.sb_w_in + (size_t)j * D * 3072; const float* Wo = a.sb_w_out + (size_t)j * D * D;
    const float* Mg = a.moe_w_gate + (size_t)j * NE * D * FF; const float* Mu = a.moe_w_up + (size_t)j * NE * D * FF; const float* Md = a.moe_w_down + (size_t)j * NE * FF * D;
    unsigned char* WQKV_T = a.ws + W_QKV; unsigned char* WO_T = a.ws + W_O; unsigned char* MGU_T = a.ws + W_MGU; unsigned char* MD_T = a.ws + W_MD;
    LAS unsigned char* scb = (LAS unsigned char*)scr;
    constexpr int I_SQ = 3072 / 32, I_O = 16 * 16, I_S = 112, I_D = 56 * 16, NIT = I_O + NE * I_D;
    for (int it = bid; it < I_SQ + NE * 2 * I_S; it += G) {
        if (it < I_SQ) { strip_item_i8(Wqkv, 3072, WQKV_T, (float*)(a.ws + WS_SWQ), 32 * it, 32 * it, lds, wave, lane); continue; }
        const int e = (it - I_SQ) / (2 * I_S), r = (it - I_SQ) % (2 * I_S); const bool up = r >= I_S; const int n0 = 32 * (up ? r - I_S : r);
        strip_item_i8((up ? Mu : Mg) + (size_t)e * D * FF, FF, MGU_T + (size_t)e * 2 * FF * D, (float*)(a.ws + WS_SWM) + e * 2 * FF, 256 * (n0 >> 7) + (up ? 128 : 0) + (n0 & 127), n0, lds, wave, lane); }
    for (int it = gw; it < NIT; it += NGW) {
        int r = it;
        if (r < I_O) { const int kb = r / 16, nb = r % 16; transpose_item64_f8(Wo, D, WO_T, D, 64 * nb, 64 * kb, 64 * nb, (float)(1 << F8_WSO), scb, lane); continue; } r -= I_O;
        const int e = r / I_D; r -= e * I_D;
        { const int kb = r / 16, nb = r % 16; transpose_item64_f8(Md + (size_t)e * FF * D, D, MD_T + (size_t)e * D * FF, FF, 64 * nb, 64 * kb, 64 * nb, (float)(1 << F8_WD), scb, lane); }
    }
}

DI float dpp_sum16(float v) {
    v += __builtin_bit_cast(float, __builtin_amdgcn_update_dpp(0, __builtin_bit_cast(int, v), 0xB1, 0xF, 0xF, false));
    v += __builtin_bit_cast(float, __builtin_amdgcn_update_dpp(0, __builtin_bit_cast(int, v), 0x4E, 0xF, 0xF, false));
    v += __builtin_bit_cast(float, __builtin_amdgcn_update_dpp(0, __builtin_bit_cast(int, v), 0x141, 0xF, 0xF, false));
    v += __builtin_bit_cast(float, __builtin_amdgcn_update_dpp(0, __builtin_bit_cast(int, v), 0x140, 0xF, 0xF, false));
    return v;
}
DI void phase_conv(const Args& a, int j, int bid, int G, int tid) {
    const bf16* raw = (const bf16*)(a.ws + WS_RAW); bf16* qkvc = (bf16*)(a.ws + WS_QKVC); float* gb = (float*)(a.ws + WS_GB);
    const float* cw = a.gdn_conv_w + (size_t)j * 4 * 4096;
    const int ch = 8 * tid;
    float w0[8], w1[8], w2[8], w3[8];
#pragma unroll
    for (int i = 0; i < 8; ++i) { w0[i] = cw[ch + i]; w1[i] = cw[4096 + ch + i]; w2[i] = cw[2 * 4096 + ch + i]; w3[i] = cw[3 * 4096 + ch + i]; }
    const float post = tid < 128 ? 0.08838834764831845f : 1.0f;
    for (int run = bid; run < TT / 128; run += G) {
        const int t0 = run * 128; const bool first = (t0 & (SEQ - 1)) == 0;
        float xa[8], xb[8], xc[8];
        { v4u h0 = {0u, 0u, 0u, 0u}, h1 = h0, h2 = h0;
          if (!first) { h0 = *(const v4u*)(raw + (size_t)(t0 - 3) * RAWLD + ch); h1 = *(const v4u*)(raw + (size_t)(t0 - 2) * RAWLD + ch); h2 = *(const v4u*)(raw + (size_t)(t0 - 1) * RAWLD + ch); }
          xa[0] = bf_lo(h0.x); xa[1] = bf_hi(h0.x); xa[2] = bf_lo(h0.y); xa[3] = bf_hi(h0.y); xa[4] = bf_lo(h0.z); xa[5] = bf_hi(h0.z); xa[6] = bf_lo(h0.w); xa[7] = bf_hi(h0.w);
          xb[0] = bf_lo(h1.x); xb[1] = bf_hi(h1.x); xb[2] = bf_lo(h1.y); xb[3] = bf_hi(h1.y); xb[4] = bf_lo(h1.z); xb[5] = bf_hi(h1.z); xb[6] = bf_lo(h1.w); xb[7] = bf_hi(h1.w);
          xc[0] = bf_lo(h2.x); xc[1] = bf_hi(h2.x); xc[2] = bf_lo(h2.y); xc[3] = bf_hi(h2.y); xc[4] = bf_lo(h2.z); xc[5] = bf_hi(h2.z); xc[6] = bf_lo(h2.w); xc[7] = bf_hi(h2.w); }
#pragma unroll 1
        for (int tb = 0; tb < 128; tb += 8) {
            v4u xr[8];
#pragma unroll
            for (int u = 0; u < 8; ++u) xr[u] = *(const v4u*)(raw + (size_t)(t0 + tb + u) * RAWLD + ch);
#pragma unroll
            for (int u = 0; u < 8; ++u) {
                float xd[8]; xd[0] = bf_lo(xr[u].x); xd[1] = bf_hi(xr[u].x); xd[2] = bf_lo(xr[u].y); xd[3] = bf_hi(xr[u].y); xd[4] = bf_lo(xr[u].z); xd[5] = bf_hi(xr[u].z); xd[6] = bf_lo(xr[u].w); xd[7] = bf_hi(xr[u].w);
                float y[8]; float ss = 0.f;
#pragma unroll
                for (int i = 0; i < 8; ++i) { const float c = w0[i] * xa[i] + w1[i] * xb[i] + w2[i] * xc[i] + w3[i] * xd[i];
                    y[i] = c * __builtin_amdgcn_rcpf(1.0f + __builtin_amdgcn_exp2f(-1.4426950408889634f * c)); ss += y[i] * y[i];
                    xa[i] = xb[i]; xb[i] = xc[i]; xc[i] = xd[i]; }
                if (tid < 256) {
                    const float rn = post / sqrtf(dpp_sum16(ss) + RMS_EPS);
#pragma unroll
                    for (int i = 0; i < 8; ++i) y[i] *= rn;
                }
                v4u o; o.x = pk2(y[0], y[1]); o.y = pk2(y[2], y[3]); o.z = pk2(y[4], y[5]); o.w = pk2(y[6], y[7]);
                *(v4u*)(qkvc + (size_t)(t0 + tb + u) * 4096 + ch) = o;
            }
        }
#pragma unroll
        for (int k = 0; k < 4; ++k) { const int item = tid + 512 * k, tok = t0 + (item >> 4), hv = item & 15;
            const float bb = __uint_as_float((unsigned)raw[(size_t)tok * RAWLD + 4096 + hv] << 16), aa = __uint_as_float((unsigned)raw[(size_t)tok * RAWLD + 4112 + hv] << 16);
            const float xx = aa + a.gdn_dt_bias[j * 16 + hv];
            const float sp = xx > 20.f ? xx : log1pf(__expf(xx));
            gb[(size_t)tok * 32 + hv] = -__expf(a.gdn_a_log[j * 16 + hv]) * sp;
            gb[(size_t)tok * 32 + 16 + hv] = sigmoid_f(bb); }
    }
}

DI void phase_gdn_naive(const Args& a, int j, LAS unsigned char* lds, int bid, int tid) {
    if (bid >= BATCH * HV) return;
    const int b = bid / HV, hv = bid % HV, hk = hv / 2, jc = tid & 127, r = tid >> 7;
    const bf16* zb = (const bf16*)(a.ws + WS_ZB); bf16* qkvc = (bf16*)(a.ws + WS_QKVC); const float* gb = (const float*)(a.ws + WS_GB);
    LAS float* qs = (LAS float*)lds; LAS float* ks = qs + 2048; LAS float* vs = ks + 2048; LAS float* gs = vs + 2048; LAS float* bs = gs + 16;
    LAS f32x2* red = (LAS f32x2*)(lds + 32768); LAS float* redkq = (LAS float*)(lds + 32768 + 8192); LAS float* ob = (LAS float*)(lds + 49152);
    float S[32];
#pragma unroll
    for (int i = 0; i < 32; ++i) S[i] = 0.f;
    const int lrow = tid >> 5, lcol = (tid & 31) * 4;
    for (int blk = 0; blk < SEQ / 16; ++blk) {
        const size_t t0 = (size_t)b * SEQ + blk * 16;
        __syncthreads();
        { const bf16* rowp = qkvc + (t0 + lrow) * 4096;
          const v2u qv = *(const v2u*)(rowp + hk * 128 + lcol), kv = *(const v2u*)(rowp + 1024 + hk * 128 + lcol), vv = *(const v2u*)(rowp + 2048 + hv * 128 + lcol);
          *(LAS f32x4*)(qs + lrow * 128 + lcol) = (f32x4){bf_lo(qv.x), bf_hi(qv.x), bf_lo(qv.y), bf_hi(qv.y)};
          *(LAS f32x4*)(ks + lrow * 128 + lcol) = (f32x4){bf_lo(kv.x), bf_hi(kv.x), bf_lo(kv.y), bf_hi(kv.y)};
          *(LAS f32x4*)(vs + lrow * 128 + lcol) = (f32x4){bf_lo(vv.x), bf_hi(vv.x), bf_lo(vv.y), bf_hi(vv.y)};
          if (tid < 16) { gs[tid] = __expf(gb[(t0 + tid) * 32 + hv]); bs[tid] = gb[(t0 + tid) * 32 + 16 + hv]; } }
        __syncthreads();
#pragma unroll 1
        for (int tt = 0; tt < 16; ++tt) {
            float pk = 0.f, pq = 0.f, pkq = 0.f;
#pragma unroll
            for (int i4 = 0; i4 < 8; ++i4) { const f32x4 k4 = *(const LAS f32x4*)(ks + tt * 128 + 32 * r + 4 * i4), q4 = *(const LAS f32x4*)(qs + tt * 128 + 32 * r + 4 * i4);
#pragma unroll
                for (int c = 0; c < 4; ++c) { pk += k4[c] * S[4 * i4 + c]; pq += q4[c] * S[4 * i4 + c]; pkq += k4[c] * q4[c]; } }
            const int buf = tt & 1;
            red[(buf * 4 + r) * 128 + jc] = (f32x2){pk, pq}; if (jc == 0) redkq[buf * 4 + r] = pkq;
            __syncthreads();
            float kS = 0.f, qS = 0.f, kq = 0.f;
#pragma unroll
            for (int rr = 0; rr < 4; ++rr) { const f32x2 p = red[(buf * 4 + rr) * 128 + jc]; kS += p.x; qS += p.y; kq += redkq[buf * 4 + rr]; }
            const float eg = gs[tt], vn = bs[tt] * (vs[tt * 128 + jc] - eg * kS);
#pragma unroll
            for (int i4 = 0; i4 < 8; ++i4) { const f32x4 k4 = *(const LAS f32x4*)(ks + tt * 128 + 32 * r + 4 * i4);
#pragma unroll
                for (int c = 0; c < 4; ++c) S[4 * i4 + c] = eg * S[4 * i4 + c] + k4[c] * vn; }
            if (r == 0) ob[tt * 128 + jc] = eg * qS + kq * vn;
        }
        __syncthreads();
        {
            const f32x4 o4 = *(const LAS f32x4*)(ob + lrow * 128 + lcol);
            float ss = o4[0] * o4[0] + o4[1] * o4[1] + o4[2] * o4[2] + o4[3] * o4[3];
            ss += __shfl_xor(ss, 1); ss += __shfl_xor(ss, 2); ss += __shfl_xor(ss, 4); ss += __shfl_xor(ss, 8); ss += __shfl_xor(ss, 16);
            const float rinv = 1.0f / sqrtf(ss * (1.0f / 128.0f) + RMS_EPS);
            const v2u zv = *(const v2u*)(zb + (t0 + lrow) * 2048 + hv * 128 + lcol);
            const f32x4 nw = *(const f32x4*)(a.gdn_norm_w + j * 128 + lcol);
            const float z0 = bf_lo(zv.x), z1 = bf_hi(zv.x), z2 = bf_lo(zv.y), z3 = bf_hi(zv.y);
            v2u o; o.x = pk2(o4[0] * rinv * nw[0] * z0 * sigmoid_f(z0), o4[1] * rinv * nw[1] * z1 * sigmoid_f(z1));
            o.y = pk2(o4[2] * rinv * nw[2] * z2 * sigmoid_f(z2), o4[3] * rinv * nw[3] * z3 * sigmoid_f(z3));
            *(v2u*)(qkvc + (t0 + lrow) * 4096 + 2048 + hv * 128 + lcol) = o;
        }
    }
}

DI void unpack8_f8(const v2u w, float (&x)[8]) { const f32x2 a = __builtin_amdgcn_cvt_pk_f32_fp8((int)w.x, false), b = __builtin_amdgcn_cvt_pk_f32_fp8((int)w.x, true), c = __builtin_amdgcn_cvt_pk_f32_fp8((int)w.y, false), d = __builtin_amdgcn_cvt_pk_f32_fp8((int)w.y, true);
    x[0] = a.x; x[1] = a.y; x[2] = b.x; x[3] = b.y; x[4] = c.x; x[5] = c.y; x[6] = d.x; x[7] = d.y; }
DI void unpack8(const v4u w, float (&x)[8]) { x[0] = bf_lo(w.x); x[1] = bf_hi(w.x); x[2] = bf_lo(w.y); x[3] = bf_hi(w.y); x[4] = bf_lo(w.z); x[5] = bf_hi(w.z); x[6] = bf_lo(w.w); x[7] = bf_hi(w.w); }
template <bool ROUTER, bool F8OUT = false>
DI void phase_ln(const Args& a, const bf16* Y, int lnidx, int j, LAS unsigned char* lds, int bid, int G, int tid, int wave, int lane) {
    bf16* HB = (bf16*)(a.ws + WS_HB); float* stats = (float*)(a.ws + WS_STATS);
    const float* g = a.ln_g + (size_t)lnidx * D; const float* bta = a.ln_b + (size_t)lnidx * D;
    const int gw = bid * NWAVES + wave, NGW = G * NWAVES;
    LAS unsigned* lcnt = (LAS unsigned*)lds;
    LAS float* RT = (LAS float*)(lds + 1024);
    if (ROUTER) { if (tid < 8) lcnt[tid] = 0u;
        const float* R = a.moe_router + (size_t)j * D * NE;
#pragma unroll
        for (int i = 0; i < 2; ++i) { const int k = tid + 512 * i; const f32x4 r0 = *(const f32x4*)(R + k * 8), r1 = *(const f32x4*)(R + k * 8 + 4);
            RT[0 * 1024 + k] = r0[0]; RT[1 * 1024 + k] = r0[1]; RT[2 * 1024 + k] = r0[2]; RT[3 * 1024 + k] = r0[3]; RT[4 * 1024 + k] = r1[0]; RT[5 * 1024 + k] = r1[1]; RT[6 * 1024 + k] = r1[2]; RT[7 * 1024 + k] = r1[3]; }
        __syncthreads(); }
    float gv[2][8], bv[2][8];
#pragma unroll
    for (int q = 0; q < 2; ++q)
#pragma unroll
        for (int c = 0; c < 8; ++c) { gv[q][c] = g[8 * (lane + 64 * q) + c]; bv[q][c] = bta[8 * (lane + 64 * q) + c]; }
    v4u nx[3][2];
#pragma unroll
    for (int d = 0; d < 3; ++d) if (gw + d * NGW < TT) { nx[d][0] = ((const v4u*)(Y + (size_t)(gw + d * NGW) * D))[lane]; nx[d][1] = ((const v4u*)(Y + (size_t)(gw + d * NGW) * D))[lane + 64]; }
    for (int t = gw; t < TT; t += NGW) {
        float v[2][8]; float s = 0.f;
        unpack8(nx[0][0], v[0]); unpack8(nx[0][1], v[1]);
        nx[0][0] = nx[1][0]; nx[0][1] = nx[1][1]; nx[1][0] = nx[2][0]; nx[1][1] = nx[2][1];
        if (t + 3 * NGW < TT) { nx[2][0] = ((const v4u*)(Y + (size_t)(t + 3 * NGW) * D))[lane]; nx[2][1] = ((const v4u*)(Y + (size_t)(t + 3 * NGW) * D))[lane + 64]; }
#pragma unroll
        for (int q = 0; q < 2; ++q)
#pragma unroll
            for (int c = 0; c < 8; ++c) s += v[q][c];
        const float mean = wave_sum(s) * (1.0f / D); float s2 = 0.f;
#pragma unroll
        for (int q = 0; q < 2; ++q)
#pragma unroll
            for (int c = 0; c < 8; ++c) { v[q][c] -= mean; s2 += v[q][c] * v[q][c]; }
        const float rstd = 1.0f / sqrtf(wave_sum(s2) * (1.0f / D) + LN_EPS);
        if (lane == 0) *(f32x2*)(stats + 2 * (size_t)t) = (f32x2){mean, rstd};
        float am = 0.f;
#pragma unroll
        for (int q = 0; q < 2; ++q)
#pragma unroll
            for (int c = 0; c < 8; ++c) { v[q][c] = v[q][c] * rstd * gv[q][c] + bv[q][c]; am = fmaxf(am, fabsf(v[q][c])); }
        if constexpr (F8OUT) {
            am = fmaxf(wave_max_nn(am), 1.0e-20f); const float qs = 127.0f / am;
            if (lane == 0) ((float*)(a.ws + WS_HS))[t] = am * (1.0f / 127.0f);
#pragma unroll
            for (int q = 0; q < 2; ++q) { v2u o; o.x = pk4_i8(v[q][0] * qs, v[q][1] * qs, v[q][2] * qs, v[q][3] * qs); o.y = pk4_i8(v[q][4] * qs, v[q][5] * qs, v[q][6] * qs, v[q][7] * qs);
                ((v2u*)((unsigned char*)HB + (size_t)t * D))[lane + 64 * q] = o; }
        } else {
#pragma unroll
            for (int q = 0; q < 2; ++q) { v4u o; o.x = pk2(v[q][0], v[q][1]); o.y = pk2(v[q][2], v[q][3]); o.z = pk2(v[q][4], v[q][5]); o.w = pk2(v[q][6], v[q][7]);
                ((v4u*)(HB + (size_t)t * D))[lane + 64 * q] = o; }
        }
        if (ROUTER) {
            float lg[8];
#pragma unroll
            for (int e = 0; e < 8; ++e) { lg[e] = 0.f;
#pragma unroll
                for (int q = 0; q < 2; ++q) { const f32x4 r0 = *(const LAS f32x4*)(RT + e * 1024 + 8 * (lane + 64 * q)), r1 = *(const LAS f32x4*)(RT + e * 1024 + 8 * (lane + 64 * q) + 4);
                    lg[e] += (v[q][0] * r0[0] + v[q][1] * r0[1]) + (v[q][2] * r0[2] + v[q][3] * r0[3]) + (v[q][4] * r1[0] + v[q][5] * r1[1]) + (v[q][6] * r1[2] + v[q][7] * r1[3]); } }
#pragma unroll
            for (int e = 0; e < 8; ++e) lg[e] = wave_sum(lg[e]);
            int i1 = 0; float v1 = lg[0];
#pragma unroll
            for (int e = 1; e < 8; ++e) if (lg[e] > v1) { v1 = lg[e]; i1 = e; }
            int i2 = -1; float v2 = -3.0e38f;
#pragma unroll
            for (int e = 0; e < 8; ++e) if (e != i1 && lg[e] > v2) { v2 = lg[e]; i2 = e; }
            if (lane == 0) {
                const float g1 = 1.0f / (1.0f + __expf(v2 - v1));
                ((unsigned*)(a.ws + WS_E12))[t] = (unsigned)i1 | ((unsigned)i2 << 8);
                ((f32x2*)(a.ws + WS_G12))[t] = (f32x2){g1, 1.0f - g1};
                __hip_atomic_fetch_add(lcnt + i1, 1u, __ATOMIC_RELAXED, __HIP_MEMORY_SCOPE_WORKGROUP); __hip_atomic_fetch_add(lcnt + i2, 1u, __ATOMIC_RELAXED, __HIP_MEMORY_SCOPE_WORKGROUP);
            }
        }
    }
    if (ROUTER) { __syncthreads(); if (tid < 8) { unsigned* cnt = (unsigned*)(a.ws + WS_CTL) + CW_CNT + 256 * j; __hip_atomic_fetch_add(cnt + tid, lcnt[tid], __ATOMIC_RELAXED, __HIP_MEMORY_SCOPE_AGENT); } }
}

DI void phase_sb_naive(const Args& a, LAS unsigned char* lds, int bid, int G, int tid) {
    const bf16* qkv = (const bf16*)(a.ws + WS_QKV); bf16* ao = (bf16*)(a.ws + WS_AO);
    LAS unsigned char* Ks = lds; LAS unsigned char* Vs = lds + 16384;
    const int qi = tid >> 2, r = tid & 3;
    for (int idx = bid; idx < 64 * 32; idx += G) {
        const int qb = 31 - idx / 64, bh = idx % 64, b = bh >> 3, h = bh & 7;
        const int t = qb * 128 + qi;
        const size_t rowq = (size_t)b * SEQ + t;
        float q[32], o[32];
        { const bf16* qp = qkv + rowq * 3072 + h * 128 + 32 * r;
#pragma unroll
          for (int c = 0; c < 4; ++c) { const v4u w = *(const v4u*)(qp + 8 * c);
              q[8 * c + 0] = bf_lo(w.x); q[8 * c + 1] = bf_hi(w.x); q[8 * c + 2] = bf_lo(w.y); q[8 * c + 3] = bf_hi(w.y);
              q[8 * c + 4] = bf_lo(w.z); q[8 * c + 5] = bf_hi(w.z); q[8 * c + 6] = bf_lo(w.w); q[8 * c + 7] = bf_hi(w.w); }
#pragma unroll
          for (int i = 0; i < 32; ++i) { q[i] *= 0.08838834764831845f; o[i] = 0.f; } }
        float P = 1.0f;
        for (int kt = 2 * qb + 1; kt >= 0; --kt) {
            __syncthreads();
#pragma unroll
            for (int i = 0; i < 2; ++i) { const int c = tid + 512 * i, row = c >> 4, part = c & 15;
                const bf16* src = qkv + ((size_t)b * SEQ + kt * 64 + row) * 3072 + h * 128 + part * 8;
                *(LAS v4u*)(Ks + c * 16) = *(const v4u*)(src + 1024); *(LAS v4u*)(Vs + c * 16) = *(const v4u*)(src + 2048); }
            __syncthreads();
#pragma unroll 1
            for (int s = 63; s >= 0; --s) {
                float z = 0.f;
#pragma unroll
                for (int c = 0; c < 4; ++c) { const v4u w = *(const LAS v4u*)(Ks + s * 256 + r * 64 + c * 16);
                    z += q[8 * c + 0] * bf_lo(w.x) + q[8 * c + 1] * bf_hi(w.x) + q[8 * c + 2] * bf_lo(w.y) + q[8 * c + 3] * bf_hi(w.y)
                       + q[8 * c + 4] * bf_lo(w.z) + q[8 * c + 5] * bf_hi(w.z) + q[8 * c + 6] * bf_lo(w.w) + q[8 * c + 7] * bf_hi(w.w); }
                z += __shfl_xor(z, 1); z += __shfl_xor(z, 2);
                const bool live = (kt * 64 + s) < t;
                const float e = __expf(fminf(z, 80.f)), rr = 1.0f / (1.0f + e);
                const float A = live ? e * rr * P : 0.f;
                P = live ? P * rr : P;
#pragma unroll
                for (int c = 0; c < 4; ++c) { const v4u w = *(const LAS v4u*)(Vs + s * 256 + r * 64 + c * 16);
                    o[8 * c + 0] += A * bf_lo(w.x); o[8 * c + 1] += A * bf_hi(w.x); o[8 * c + 2] += A * bf_lo(w.y); o[8 * c + 3] += A * bf_hi(w.y);
                    o[8 * c + 4] += A * bf_lo(w.z); o[8 * c + 5] += A * bf_hi(w.z); o[8 * c + 6] += A * bf_lo(w.w); o[8 * c + 7] += A * bf_hi(w.w); }
            }
        }
        { bf16* op = ao + rowq * 1024 + h * 128 + 32 * r;
#pragma unroll
          for (int c = 0; c < 4; ++c) { v4u w; w.x = pk2(o[8 * c + 0], o[8 * c + 1]); w.y = pk2(o[8 * c + 2], o[8 * c + 3]); w.z = pk2(o[8 * c + 4], o[8 * c + 5]); w.w = pk2(o[8 * c + 6], o[8 * c + 7]);
              *(v4u*)(op + 8 * c) = w; } }
    }
}


typedef float f2v_ __attribute__((ext_vector_type(2)));
typedef __bf16 b2v_ __attribute__((ext_vector_type(2)));
DI unsigned gdnpk(float a, float b) { const f2v_ v = {a, b}; const b2v_ r = __builtin_convertvector(v, b2v_); return __builtin_bit_cast(unsigned, r); }
namespace sba {
using bf16x8 = __attribute__((ext_vector_type(8))) short;
using s16x4  = __attribute__((ext_vector_type(4))) short;
using f32x16 = __attribute__((ext_vector_type(16))) float;
constexpr int SHM_V = 16384, KPITCH = 272, SHM_K = 64 * KPITCH, LDQ = 3072;
#define KSWZ(row, colB) ((row) * KPITCH + (colB))
#define SBAR() __builtin_amdgcn_sched_barrier(0)
DI int crow(int r, int hi) { return (r & 3) + 8 * (r >> 2) + 4 * hi; }
DI int v_st(int k, int c) { const int kk = (k & ~0xC) | ((k & 4) << 1) | ((k & 8) >> 1); return ((kk >> 3) * 4 + (c >> 5)) * 512 + ((kk & 7) * 32 + (c & 31)) * 2; }
DI int v_rd_base(int lane) { return ((lane & 3) << 3) | (((lane >> 2) & 3) << 6) | (((lane >> 4) & 1) << 5) | (((lane >> 5) & 1) << 8); }
constexpr int v_rd_off(int d0, int ks, int half) { return d0 * 512 + ks * 4096 + half * 2048; }
template <int OFF> DI s16x4 tr_read(int vb) { s16x4 r; asm volatile("ds_read_b64_tr_b16 %0, %1 offset:%2" : "=&v"(r) : "v"(vb), "i"(OFF) : "memory"); return r; }
template <int D0> DI void pv_one(f32x16& od, int vb, bf16x8 pa0, bf16x8 pa1, bf16x8 pa2, bf16x8 pa3) {
  const s16x4 l0 = tr_read<v_rd_off(D0, 0, 0)>(vb), h0 = tr_read<v_rd_off(D0, 0, 1)>(vb), l1 = tr_read<v_rd_off(D0, 1, 0)>(vb), h1 = tr_read<v_rd_off(D0, 1, 1)>(vb);
  const s16x4 l2 = tr_read<v_rd_off(D0, 2, 0)>(vb), h2 = tr_read<v_rd_off(D0, 2, 1)>(vb), l3 = tr_read<v_rd_off(D0, 3, 0)>(vb), h3 = tr_read<v_rd_off(D0, 3, 1)>(vb);
  asm volatile("s_waitcnt lgkmcnt(0)" ::: "memory"); SBAR();
#define PK(L, H) (bf16x8){L[0], L[1], L[2], L[3], H[0], H[1], H[2], H[3]}
  od = __builtin_amdgcn_mfma_f32_32x32x16_bf16(pa0, PK(l0, h0), od, 0, 0, 0);
  od = __builtin_amdgcn_mfma_f32_32x32x16_bf16(pa1, PK(l1, h1), od, 0, 0, 0);
  od = __builtin_amdgcn_mfma_f32_32x32x16_bf16(pa2, PK(l2, h2), od, 0, 0, 0);
  od = __builtin_amdgcn_mfma_f32_32x32x16_bf16(pa3, PK(l3, h3), od, 0, 0, 0);
#undef PK
}
template <int D0> DI void pv_one_T(f32x16& od, int vb, bf16x8 pa0, bf16x8 pa1, bf16x8 pa2, bf16x8 pa3) {
  const s16x4 l0 = tr_read<v_rd_off(D0, 0, 0)>(vb), h0 = tr_read<v_rd_off(D0, 0, 1)>(vb), l1 = tr_read<v_rd_off(D0, 1, 0)>(vb), h1 = tr_read<v_rd_off(D0, 1, 1)>(vb);
  const s16x4 l2 = tr_read<v_rd_off(D0, 2, 0)>(vb), h2 = tr_read<v_rd_off(D0, 2, 1)>(vb), l3 = tr_read<v_rd_off(D0, 3, 0)>(vb), h3 = tr_read<v_rd_off(D0, 3, 1)>(vb);
  asm volatile("s_waitcnt lgkmcnt(0)" ::: "memory"); SBAR();
#define PK(L, H) (bf16x8){L[0], L[1], L[2], L[3], H[0], H[1], H[2], H[3]}
  od = __builtin_amdgcn_mfma_f32_32x32x16_bf16(PK(l0, h0), pa0, od, 0, 0, 0);
  od = __builtin_amdgcn_mfma_f32_32x32x16_bf16(PK(l1, h1), pa1, od, 0, 0, 0);
  od = __builtin_amdgcn_mfma_f32_32x32x16_bf16(PK(l2, h2), pa2, od, 0, 0, 0);
  od = __builtin_amdgcn_mfma_f32_32x32x16_bf16(PK(l3, h3), pa3, od, 0, 0, 0);
#undef PK
}
DI void pv_split(f32x16& od, int vb, bf16x8 pa0, bf16x8 pa1, bf16x8 pa2, bf16x8 pa3) {
  const s16x4 l0 = tr_read<v_rd_off(0, 0, 0)>(vb), h0 = tr_read<v_rd_off(0, 0, 1)>(vb), l1 = tr_read<v_rd_off(0, 1, 0)>(vb), h1 = tr_read<v_rd_off(0, 1, 1)>(vb);
  const s16x4 l2 = tr_read<v_rd_off(0, 2, 0)>(vb), h2 = tr_read<v_rd_off(0, 2, 1)>(vb), l3 = tr_read<v_rd_off(0, 3, 0)>(vb), h3 = tr_read<v_rd_off(0, 3, 1)>(vb);
  asm volatile("s_waitcnt lgkmcnt(0)" ::: "memory"); SBAR();
#define PK(L, H) (bf16x8){L[0], L[1], L[2], L[3], H[0], H[1], H[2], H[3]}
  f32x16 ob = {};
  od = __builtin_amdgcn_mfma_f32_32x32x16_bf16(pa0, PK(l0, h0), od, 0, 0, 0); ob = __builtin_amdgcn_mfma_f32_32x32x16_bf16(pa2, PK(l2, h2), ob, 0, 0, 0);
  od = __builtin_amdgcn_mfma_f32_32x32x16_bf16(pa1, PK(l1, h1), od, 0, 0, 0); ob = __builtin_amdgcn_mfma_f32_32x32x16_bf16(pa3, PK(l3, h3), ob, 0, 0, 0);
  od = od + ob;
#undef PK
}
DI void pv_split_T(f32x16& od, int vb, bf16x8 pa0, bf16x8 pa1, bf16x8 pa2, bf16x8 pa3) {
  const s16x4 l0 = tr_read<v_rd_off(0, 0, 0)>(vb), h0 = tr_read<v_rd_off(0, 0, 1)>(vb), l1 = tr_read<v_rd_off(0, 1, 0)>(vb), h1 = tr_read<v_rd_off(0, 1, 1)>(vb);
  const s16x4 l2 = tr_read<v_rd_off(0, 2, 0)>(vb), h2 = tr_read<v_rd_off(0, 2, 1)>(vb), l3 = tr_read<v_rd_off(0, 3, 0)>(vb), h3 = tr_read<v_rd_off(0, 3, 1)>(vb);
  asm volatile("s_waitcnt lgkmcnt(0)" ::: "memory"); SBAR();
#define PK(L, H) (bf16x8){L[0], L[1], L[2], L[3], H[0], H[1], H[2], H[3]}
  f32x16 ob = {};
  od = __builtin_amdgcn_mfma_f32_32x32x16_bf16(PK(l0, h0), pa0, od, 0, 0, 0); ob = __builtin_amdgcn_mfma_f32_32x32x16_bf16(PK(l2, h2), pa2, ob, 0, 0, 0);
  od = __builtin_amdgcn_mfma_f32_32x32x16_bf16(PK(l1, h1), pa1, od, 0, 0, 0); ob = __builtin_amdgcn_mfma_f32_32x32x16_bf16(PK(l3, h3), pa3, ob, 0, 0, 0);
  od = od + ob;
#undef PK
}
DI void qkt(f32x16& p0, f32x16& p1, const LAS unsigned char* Ks, const bf16x8 (&qr)[8], int r32, int hi) {
  p0 = f32x16{}; p1 = f32x16{};
#pragma unroll
  for (int d0 = 0; d0 < 8; ++d0) { const int cb = (d0 * 16 + hi * 8) * 2;
    const bf16x8 b0 = *(const LAS bf16x8*)(Ks + KSWZ(r32, cb));
    const bf16x8 b1 = *(const LAS bf16x8*)(Ks + KSWZ(32 + r32, cb));
    p0 = __builtin_amdgcn_mfma_f32_32x32x16_bf16(b0, qr[d0], p0, 0, 0, 0);
    p1 = __builtin_amdgcn_mfma_f32_32x32x16_bf16(b1, qr[d0], p1, 0, 0, 0); }
}
template <bool MASK> DI void sb_half(f32x16& p, float& Pc, int hi, int kbase, int trow) {
  float kk[16];
#pragma unroll
  for (int r = 0; r < 16; ++r) {
    float z = p[r];
    if (MASK) z = (kbase + crow(r, hi) < trow) ? z : -__builtin_inff();
    kk[r] = __builtin_amdgcn_rcpf(1.0f + __builtin_amdgcn_exp2f(z));
  }
  float R0[4], R1[4];
#pragma unroll
  for (int g = 0; g < 4; ++g) {
    const float c2 = kk[4 * g + 3], c1 = c2 * kk[4 * g + 2], c0 = c1 * kk[4 * g + 1], R = c0 * kk[4 * g];
    p[4 * g + 3] = 1.0f - c2; p[4 * g + 2] = c2 - c1; p[4 * g + 1] = c1 - c0; p[4 * g] = c0 - R;
    const auto sw = __builtin_amdgcn_permlane32_swap(__float_as_uint(R), __float_as_uint(R), false, false);
    R0[g] = __uint_as_float(sw[0]); R1[g] = __uint_as_float(sw[1]);
  }
#pragma unroll
  for (int g = 3; g >= 0; --g) {
    const float Pin = hi ? Pc : Pc * R1[g];
    p[4 * g + 3] *= Pin; p[4 * g + 2] *= Pin; p[4 * g + 1] *= Pin; p[4 * g] *= Pin;
    Pc *= R0[g] * R1[g];
  }
}
DI unsigned cvtpk(float lo, float hi) { unsigned r; asm volatile("v_cvt_pk_bf16_f32 %0, %1, %2" : "=v"(r) : "v"(lo), "v"(hi)); return r; }
#define PK4(P, BASE, OUT) do { const unsigned a0 = cvtpk(P[BASE + 0], P[BASE + 1]), a1 = cvtpk(P[BASE + 2], P[BASE + 3]);   \
    const unsigned b0 = cvtpk(P[BASE + 4], P[BASE + 5]), b1 = cvtpk(P[BASE + 6], P[BASE + 7]);                              \
    const auto r0 = __builtin_amdgcn_permlane32_swap(a0, b0, false, false); const auto r1 = __builtin_amdgcn_permlane32_swap(a1, b1, false, false); \
    const v4u w = {r0[0], r1[0], r0[1], r1[1]}; OUT = __builtin_bit_cast(bf16x8, w); } while (0)

DI void unit(const bf16* qkv, unsigned char* ao, int b, int h, int qb, LAS unsigned char* lds, int tid) {
  const int wid = __builtin_amdgcn_readfirstlane(tid >> 6), lane = tid & 63, r32 = lane & 31, hi = lane >> 5;
  constexpr bool late = false;
  LAS unsigned char* V_lds = lds; LAS unsigned char* K_lds = lds + 3 * SHM_V;
  const size_t rowbase = (size_t)b * SEQ; const int q0 = qb * 256, t_lo = q0 + wid * 32, trow = t_lo + r32;
  bf16x8 qr[8];
  { const bf16* Qw = qkv + (rowbase + trow) * LDQ + h * 128 + hi * 8; constexpr float C = 0.08838834764831845f * 1.4426950408889634f;
#pragma unroll
    for (int d0 = 0; d0 < 8; ++d0) { const v4u w = *(const v4u*)(Qw + d0 * 16); v4u o;
      o.x = gdnpk(bf_lo(w.x) * C, bf_hi(w.x) * C); o.y = gdnpk(bf_lo(w.y) * C, bf_hi(w.y) * C); o.z = gdnpk(bf_lo(w.z) * C, bf_hi(w.z) * C); o.w = gdnpk(bf_lo(w.w) * C, bf_hi(w.w) * C);
      qr[d0] = __builtin_bit_cast(bf16x8, o); } }
  const bf16* Kh = qkv + rowbase * LDQ + 1024 + h * 128; const bf16* Vh = Kh + 1024;
  const int sr = tid >> 4, sc = (tid & 15) * 8, vst0 = v_st(sr, sc), vst1 = v_st(32 + sr, sc);
  const int vb0 = (int)(unsigned)(size_t)V_lds + v_rd_base(lane);
  bf16x8 vs0, vs1, ks0, ks1;
  const unsigned soff = (unsigned)(sr * LDQ + sc) * 2u;
#define SLOAD(k0) do { const char* kb_ = (const char*)(Kh + (size_t)(k0) * LDQ); const char* vb_ = (const char*)(Vh + (size_t)(k0) * LDQ); \
    vs0 = *(const bf16x8*)(vb_ + soff); vs1 = *(const bf16x8*)(vb_ + (size_t)32 * LDQ * 2 + soff); ks0 = *(const bf16x8*)(kb_ + soff); ks1 = *(const bf16x8*)(kb_ + (size_t)32 * LDQ * 2 + soff); } while (0)
#define SWRITE(bb) do { *(LAS bf16x8*)(V_lds + (bb) * SHM_V + vst0) = vs0; *(LAS bf16x8*)(V_lds + (bb) * SHM_V + vst1) = vs1; const int kc = sc * 2; \
    *(LAS bf16x8*)(K_lds + (bb) * SHM_K + KSWZ(sr, kc)) = ks0; *(LAS bf16x8*)(K_lds + (bb) * SHM_K + KSWZ(32 + sr, kc)) = ks1; } while (0)
  f32x16 o[4] = {}; float Pc = 1.0f;
  constexpr float SB_EPS = 1.0e-12f;
  LAS unsigned* aflag = (LAS unsigned*)(lds + 3 * SHM_V + 3 * SHM_K);
  f32x16 p0 = {}, p1 = {};
  const int NT = qb * 4 + 4;
  SLOAD((NT - 1) * 64);
  int bufc = 0, bufp = 0;
  for (int wi = 0; wi <= NT; ++wi) {
    const int kt = NT - 1 - wi, k0 = kt * 64;
    SEC_IN(4);
    if (wi < NT) { asm volatile("s_waitcnt vmcnt(0)" ::: "memory"); SWRITE(bufc); if (kt > 0) SLOAD(k0 - 64); }
    __syncthreads();
    SEC_OUT(4); SEC_IN(5);
    if (wi > 0) { const v4u f0 = *(const LAS v4u*)(aflag + ((wi - 1) & 1) * 8), f1 = *(const LAS v4u*)(aflag + ((wi - 1) & 1) * 8 + 4);
      if ((f0.x | f0.y | f0.z | f0.w | f1.x | f1.y | f1.z | f1.w) == 0u) break; }
    const bool wlive = __any(Pc >= SB_EPS);
    if (!late && wlive && wi < NT && k0 < t_lo + 31) { __builtin_amdgcn_s_setprio(1); qkt(p0, p1, K_lds + bufc * SHM_K, qr, r32, hi); __builtin_amdgcn_s_setprio(0); }
    { const int ka = late ? k0 + 64 : k0;
      const bool doit = wlive && (late ? (wi > 0 && ka < t_lo + 31) : (wi < NT && k0 < t_lo + 31));
      if (doit) {
        bf16x8 pa0, pa1, pa2, pa3;
        if (ka + 63 >= t_lo) { sb_half<true>(p1, Pc, hi, ka + 32, trow); PK4(p1, 0, pa2); PK4(p1, 8, pa3); SBAR(); sb_half<true>(p0, Pc, hi, ka, trow); }
        else { sb_half<false>(p1, Pc, hi, ka + 32, trow); PK4(p1, 0, pa2); PK4(p1, 8, pa3); SBAR(); sb_half<false>(p0, Pc, hi, ka, trow); }
        PK4(p0, 0, pa0); PK4(p0, 8, pa1);
        const int vb = vb0 + (late ? bufp : bufc) * SHM_V;
        __builtin_amdgcn_s_setprio(1);
        pv_one<0>(o[0], vb, pa0, pa1, pa2, pa3); pv_one<1>(o[1], vb, pa0, pa1, pa2, pa3); pv_one<2>(o[2], vb, pa0, pa1, pa2, pa3); pv_one<3>(o[3], vb, pa0, pa1, pa2, pa3);
        __builtin_amdgcn_s_setprio(0);
      } }
    if (late && wi < NT && k0 < t_lo + 31) { __builtin_amdgcn_s_setprio(1); qkt(p0, p1, K_lds + bufc * SHM_K, qr, r32, hi); __builtin_amdgcn_s_setprio(0); }
    { const bool act = __any(Pc >= SB_EPS); if (lane == 0) aflag[(wi & 1) * 8 + wid] = act ? 1u : 0u; }
    SEC_OUT(5);
    bufp = bufc; bufc = (bufc == 2) ? 0 : bufc + 1;
  }
  { unsigned char* Ob = ao + ((size_t)b * SEQ + qb * 256 + wid * 32) * 1024 + h * 128; const unsigned ooff = (unsigned)(4 * hi * 1024 + r32);
#pragma unroll
    for (int r = 0; r < 16; ++r)
#pragma unroll
      for (int d0 = 0; d0 < 4; ++d0) Ob[ooff + (unsigned)(((r & 3) + 8 * (r >> 2)) * 1024 + d0 * 32)] = (unsigned char)(__builtin_amdgcn_cvt_pk_fp8_f32(pg8::clamp_f8(o[d0][r] * (float)(1 << F8_AO)), 0.f, 0, false) & 0xff); }
#undef SLOAD
#undef SWRITE
}
#undef PK4
#undef KSWZ
#undef SBAR
}
DI void phase_sb_mfma(const Args& a, LAS unsigned char* lds, int bid, int G, int tid) {
    const bf16* qkv = (const bf16*)(a.ws + WS_QKV); unsigned char* ao = a.ws + WS_AO;
    const int vcu = (G % 8 == 0) ? (bid % 8) * (G / 8) + bid / 8 : bid;
    for (int pi = vcu; pi < 512; pi += G) {
        const int bh = pi >> 3, p = pi & 7, b = bh >> 3, h = bh & 7;
        sba::unit(qkv, ao, b, h, 15 - p, lds, tid);
        sba::unit(qkv, ao, b, h, p, lds, tid);
    }
}


namespace gdn {
using bf16x8 = __attribute__((ext_vector_type(8))) short;
using s16x4  = __attribute__((ext_vector_type(4))) short;
using f32x16 = __attribute__((ext_vector_type(16))) float;
typedef float f2v __attribute__((ext_vector_type(2)));
typedef __bf16 b2v __attribute__((ext_vector_type(2)));
DI unsigned pk(float a, float b) { const f2v v = {a, b}; const b2v r = __builtin_convertvector(v, b2v); return __builtin_bit_cast(unsigned, r); }
DI int crow(int r, int hi) { return (r & 3) + 8 * (r >> 2) + 4 * hi; }
DI int pi_slot(int x) { return 8 * ((x >> 2) & 3) + 4 * ((x >> 4) & 1) + (x & 3); }
DI bf16x8 pack_step(const f32x16& x, int s) {
    v4u w; w.x = pk(x[8 * s + 0], x[8 * s + 1]); w.y = pk(x[8 * s + 2], x[8 * s + 3]); w.z = pk(x[8 * s + 4], x[8 * s + 5]); w.w = pk(x[8 * s + 6], x[8 * s + 7]);
    return __builtin_bit_cast(bf16x8, w);
}
DI f32x16 mm(const f32x16& P, const f32x16& Q, f32x16 acc) {
    acc = __builtin_amdgcn_mfma_f32_32x32x16_bf16(pack_step(P, 0), pack_step(Q, 0), acc, 0, 0, 0);
    acc = __builtin_amdgcn_mfma_f32_32x32x16_bf16(pack_step(P, 1), pack_step(Q, 1), acc, 0, 0, 0);
    return acc;
}
#define GPK4(P, BASE, OUT) do { const unsigned a0 = pk(P[BASE + 0], P[BASE + 1]), a1 = pk(P[BASE + 2], P[BASE + 3]);   \
    const unsigned b0 = pk(P[BASE + 4], P[BASE + 5]), b1 = pk(P[BASE + 6], P[BASE + 7]);                              \
    const auto r0 = __builtin_amdgcn_permlane32_swap(a0, b0, false, false); const auto r1 = __builtin_amdgcn_permlane32_swap(a1, b1, false, false); \
    const v4u w_ = {r0[0], r1[0], r0[1], r1[1]}; OUT = __builtin_bit_cast(bf16x8, w_); } while (0)

DI void local_unit(const Args& a, int unit, LAS unsigned char* img, LAS float* tab, int lane, bool dry) {
    const int r32 = lane & 31, hi = lane >> 5;
    const int chunk = unit & 63, bh = unit >> 6, hv = bh & 15, b = bh >> 4, hk = hv >> 1;
    const size_t t0 = (size_t)b * SEQ + chunk * 64;
    bf16* qkvc = (bf16*)(a.ws + WS_QKVC); const float* gb = (const float*)(a.ws + WS_GB);
    bf16* wmem = (bf16*)(a.ws + WS_WMEM) + (size_t)unit * 8192; bf16* imem = (bf16*)(a.ws + WS_IMEM) + (size_t)unit * 4096;
    bf16* ktmem = (bf16*)(a.ws + WS_KTMEM) + (size_t)((b * HK + hk) * 64 + chunk) * 8192; float* gtab = (float*)(a.ws + WS_GTAB) + (size_t)unit * 192;
    SEC_IN(1);
    float gc = gb[(t0 + lane) * 32 + hv]; const float be = gb[(t0 + lane) * 32 + 16 + hv];
#pragma unroll
    for (int off = 1; off < 64; off <<= 1) { const float y = __shfl_up(gc, off); if (lane >= off) gc += y; }
    const float glast = __shfl(gc, 63);
    tab[lane] = gc; tab[64 + lane] = be; tab[128 + lane] = -be * __expf(gc);
    gtab[lane] = __expf(gc); gtab[64 + lane] = __expf(glast - gc); if (lane == 0) gtab[128] = __expf(glast);
    const bf16* kbase = qkvc + t0 * 4096 + 1024 + hk * 128; const bf16* qbase = qkvc + t0 * 4096 + hk * 128; bf16* vbase = qkvc + t0 * 4096 + 2048 + hv * 128;
#define GSB() __builtin_amdgcn_sched_barrier(0)
    {
        f32x16 IT00 = {}, IT11 = {}, IT01 = {};
#pragma unroll
        for (int s = 0; s < 8; ++s) {
            const bf16x8 k0 = *(const bf16x8*)(kbase + (size_t)r32 * 4096 + 16 * s + 8 * hi), k1 = *(const bf16x8*)(kbase + (size_t)(32 + r32) * 4096 + 16 * s + 8 * hi);
            const bf16x8 q0 = *(const bf16x8*)(qbase + (size_t)r32 * 4096 + 16 * s + 8 * hi), q1 = *(const bf16x8*)(qbase + (size_t)(32 + r32) * 4096 + 16 * s + 8 * hi);
            IT00 = __builtin_amdgcn_mfma_f32_32x32x16_bf16(k0, q0, IT00, 0, 0, 0); IT11 = __builtin_amdgcn_mfma_f32_32x32x16_bf16(k1, q1, IT11, 0, 0, 0);
            IT01 = __builtin_amdgcn_mfma_f32_32x32x16_bf16(k0, q1, IT01, 0, 0, 0);
        }
#pragma unroll
        for (int I = 0; I < 2; ++I) { const int c = 32 * I + r32; const float gcc = tab[c];
#pragma unroll
            for (int J = 0; J < 2; ++J)
#pragma unroll
                for (int g = 0; g < 4; ++g) { float v[4];
#pragma unroll
                    for (int i = 0; i < 4; ++i) { const int r = 4 * g + i, cp = 32 * J + crow(r, hi);
                        const float raw = (I == 0) ? (J == 0 ? IT00[r] : 0.f) : (J == 0 ? IT01[r] : IT11[r]);
                        const float val = raw * __expf(-fabsf(gcc - tab[cp])); v[i] = (c >= cp) ? val : 0.f; }
                    v2u o; o.x = pk(v[0], v[1]); o.y = pk(v[2], v[3]);
                    *(v2u*)(imem + (unsigned)((((I * 2 + J) * 4 + g) * 64 + lane) * 4)) = o; } }
    }
    GSB();
    SEC_OUT(1); SEC_IN(2);
    f32x16 T1, T1T, T2T, T21T;
    {
        f32x16 KK = {};
#pragma unroll
        for (int s = 0; s < 8; ++s) { const bf16x8 k0 = *(const bf16x8*)(kbase + (size_t)r32 * 4096 + 16 * s + 8 * hi); KK = __builtin_amdgcn_mfma_f32_32x32x16_bf16(k0, k0, KK, 0, 0, 0); }
        f32x16 M, MT;
        { const float gb0 = tab[r32], bb0 = tab[64 + r32];
#pragma unroll
        for (int r = 0; r < 16; ++r) { const int a0 = crow(r, hi), b0 = r32; const float ke = -KK[r] * __expf(-fabsf(tab[a0] - gb0));
            const float nv = ke * tab[64 + a0], ntv = ke * bb0;
            const float n = (a0 > b0) ? nv : 0.f, nt = (b0 > a0) ? ntv : 0.f, id = (a0 == b0) ? 1.f : 0.f;
            M[r] = n; MT[r] = nt; T1[r] = id + n; T1T[r] = id + nt; } }
#pragma unroll
        for (int it = 0; it < 4; ++it) { const f32x16 z = {};
            const f32x16 Mn = mm(MT, M, z), MTn = mm(M, MT, z);
            const f32x16 Tn = mm(T1T, Mn, T1);
            T1T = mm(Mn, T1T, T1T);
            T1 = Tn; M = Mn; MT = MTn; }
    }
    GSB();
    {
        f32x16 KK = {};
#pragma unroll
        for (int s = 0; s < 8; ++s) { const bf16x8 k1 = *(const bf16x8*)(kbase + (size_t)(32 + r32) * 4096 + 16 * s + 8 * hi); KK = __builtin_amdgcn_mfma_f32_32x32x16_bf16(k1, k1, KK, 0, 0, 0); }
        f32x16 M, MT;
        { const float gb0 = tab[32 + r32], bb0 = tab[96 + r32];
#pragma unroll
        for (int r = 0; r < 16; ++r) { const int a0 = crow(r, hi), b0 = r32; const float ke = -KK[r] * __expf(-fabsf(tab[32 + a0] - gb0));
            const float nv = ke * tab[96 + a0], ntv = ke * bb0;
            const float n = (a0 > b0) ? nv : 0.f, nt = (b0 > a0) ? ntv : 0.f, id = (a0 == b0) ? 1.f : 0.f;
            M[r] = n; MT[r] = nt; T2T[r] = id + nt; } }
#pragma unroll
        for (int it = 0; it < 4; ++it) { const f32x16 z = {};
            const f32x16 Mn = mm(MT, M, z), MTn = mm(M, MT, z);
            T2T = mm(Mn, T2T, T2T);
            M = Mn; MT = MTn; }
    }
    GSB();
    {
        f32x16 L21 = {};
#pragma unroll
        for (int s = 0; s < 8; ++s) { const bf16x8 k0 = *(const bf16x8*)(kbase + (size_t)r32 * 4096 + 16 * s + 8 * hi), k1 = *(const bf16x8*)(kbase + (size_t)(32 + r32) * 4096 + 16 * s + 8 * hi);
            L21 = __builtin_amdgcn_mfma_f32_32x32x16_bf16(k1, k0, L21, 0, 0, 0); }
#pragma unroll
        for (int r = 0; r < 16; ++r) { const int a0 = crow(r, hi); L21[r] = L21[r] * tab[96 + a0] * __expf(tab[32 + a0] - tab[r32]); }
        const f32x16 z = {}; const f32x16 Y = mm(L21, T2T, z); T21T = mm(T1, Y, z);
#pragma unroll
        for (int r = 0; r < 16; ++r) T21T[r] = -T21T[r];
    }
    GSB();
    SEC_OUT(2); SEC_IN(3);
    const int vb = (int)(unsigned)(size_t)img + sba::v_rd_base(lane);
    bf16* ubl = dry ? (bf16*)(a.ws + WS_END) + (size_t)(unit & 63) * 64 * 4096 : vbase;
#pragma unroll 1
    for (int mode = 0; mode < 2; ++mode) {
        const bf16* src = mode == 0 ? (const bf16*)vbase : kbase;
#pragma unroll 1
        for (int hb_ = 0; hb_ < 2; ++hb_) { v4u tl[8];
#pragma unroll
          for (int it = 0; it < 8; ++it) { const int row = (lane >> 4) + 4 * (it + 8 * hb_), col = (lane & 15) * 8; tl[it] = *(const v4u*)(src + (size_t)row * 4096 + col); }
#pragma unroll
          for (int it = 0; it < 8; ++it) { const int row = (lane >> 4) + 4 * (it + 8 * hb_), col = (lane & 15) * 8; *(LAS v4u*)(img + sba::v_st(row, col)) = tl[it]; } }
        LAS float* sc = tab + (mode == 0 ? 64 : 128);
#pragma unroll 1
        for (int I = 0; I < 2; ++I) {
            bf16x8 pa0, pa1, pa2, pa3;
            { f32x16 X;
#pragma unroll
              for (int r = 0; r < 16; ++r) X[r] = (I ? T21T[r] : T1T[r]) * sc[crow(r, hi)];
              GPK4(X, 0, pa0); GPK4(X, 8, pa1);
              { const float on = I ? 1.0f : 0.0f;
#pragma unroll
              for (int r = 0; r < 16; ++r) X[r] = T2T[r] * (sc[32 + crow(r, hi)] * on); }
              GPK4(X, 0, pa2); GPK4(X, 8, pa3); }
#pragma unroll 1
            for (int d0 = 0; d0 < 4; ++d0) {
                f32x16 od = {};
                if (mode == 0) { sba::pv_split(od, vb + d0 * 512, pa0, pa1, pa2, pa3);
                    const unsigned e0 = (unsigned)(((I * 32 + 8 * d0 + (lane >> 5)) * 4096) + (lane & 31) * 4);
#pragma unroll
                    for (int g = 0; g < 4; ++g) { v2u w; w.x = pk(od[4 * g + 0], od[4 * g + 1]); w.y = pk(od[4 * g + 2], od[4 * g + 3]); *(v2u*)(ubl + e0 + (unsigned)(g * 8192)) = w; }
                } else { sba::pv_split_T(od, vb + d0 * 512, pa0, pa1, pa2, pa3);
                    bf16* wp = wmem + (unsigned)((((I * 4 + d0) * 4) * 64 + lane) * 4);
#pragma unroll
                    for (int g = 0; g < 4; ++g) { v2u w; w.x = pk(od[4 * g + 0], od[4 * g + 1]); w.y = pk(od[4 * g + 2], od[4 * g + 3]); *(v2u*)(wp + g * 256) = w; }
                }
                GSB();
            }
        }
        if (mode == 1) {
            const int Ik = hv & 1;
            v4u idw0, idw1;
            { const int d0_ = r32 - 8 * hi, d1_ = r32 - 16 - 8 * hi;
              idw0.x = (d0_ == 0 ? 0x3f80u : 0u) | (d0_ == 1 ? 0x3f800000u : 0u); idw0.y = (d0_ == 2 ? 0x3f80u : 0u) | (d0_ == 3 ? 0x3f800000u : 0u);
              idw0.z = (d0_ == 4 ? 0x3f80u : 0u) | (d0_ == 5 ? 0x3f800000u : 0u); idw0.w = (d0_ == 6 ? 0x3f80u : 0u) | (d0_ == 7 ? 0x3f800000u : 0u);
              idw1.x = (d1_ == 0 ? 0x3f80u : 0u) | (d1_ == 1 ? 0x3f800000u : 0u); idw1.y = (d1_ == 2 ? 0x3f80u : 0u) | (d1_ == 3 ? 0x3f800000u : 0u);
              idw1.z = (d1_ == 4 ? 0x3f80u : 0u) | (d1_ == 5 ? 0x3f800000u : 0u); idw1.w = (d1_ == 6 ? 0x3f80u : 0u) | (d1_ == 7 ? 0x3f800000u : 0u); }
            const bf16x8 id0 = __builtin_bit_cast(bf16x8, idw0), id1 = __builtin_bit_cast(bf16x8, idw1), zf = (bf16x8){};
            const bf16x8 pa0 = Ik ? zf : id0, pa1 = Ik ? zf : id1, pa2 = Ik ? id0 : zf, pa3 = Ik ? id1 : zf;
#pragma unroll 1
            for (int d0 = 0; d0 < 4; ++d0) {
                f32x16 od = {}; sba::pv_split(od, vb + d0 * 512, pa0, pa1, pa2, pa3);
                bf16* kp = ktmem + (unsigned)((((Ik * 4 + d0) * 4) * 64 + lane) * 4);
#pragma unroll
                for (int g = 0; g < 4; ++g) { v2u w; w.x = pk(od[4 * g + 0], od[4 * g + 1]); w.y = pk(od[4 * g + 2], od[4 * g + 3]); *(v2u*)(kp + g * 256) = w; }
                GSB();
            }
        }
    }
    SEC_OUT(3);
#undef GSB
}
#undef GPK4
}
DI void phase_gdn_local(const Args& a, LAS unsigned char* lds, int bid, int G, int wave, int lane, bool dry) {
    LAS unsigned char* img = lds + wave * 16384; LAS float* tab = (LAS float*)(lds + RING_BYTES + 4096 + wave * 1024);
    const int gw = bid * NWAVES + wave, NGW = G * NWAVES;
    for (int unit = gw; unit < BATCH * HV * 64; unit += NGW) gdn::local_unit(a, unit, img, tab, lane, dry);
}
namespace gdn {
constexpr int PW = 272, PI = 144;
constexpr int L_W = 0, L_Q = 64 * PW, L_I = 2 * 64 * PW, L_K = L_I + 64 * PI, L_G = L_K + 128 * PI, L_BUF = L_G + 768;
constexpr int L_PART = 2 * L_BUF;
static_assert(L_PART + 4096 <= RING_BYTES, "scan LDS map");
}
DI void phase_gdn_scan(const Args& a, int j, LAS unsigned char* lds, int bid, int tid, bool dry) {
    if (bid >= BATCH * HV) return;
    using gdn::bf16x8; using gdn::pk; using namespace gdn;
    typedef float f4v __attribute__((ext_vector_type(4)));
    const int wave = __builtin_amdgcn_readfirstlane(tid >> 6), lane = tid & 63, n = lane & 15, kq = lane >> 4;
    const int b = bid / HV, hv = bid % HV, hk = hv >> 1;
    bf16* qkvc = (bf16*)(a.ws + WS_QKVC); const bf16* zb = (const bf16*)(a.ws + WS_ZB);
    LAS float* part = (LAS float*)(lds + L_PART); LAS unsigned char* stg = lds + OGST_OFF;
    const int unit0 = (b * HV + hv) * 64, hku0 = (b * HK + hk) * 64; const size_t tb0 = (size_t)b * SEQ;
    if (wave >= 4) {
        const int st = tid - 256;
        v4u rw[4], rq[4], ri[2], rk[4], rz[4]; float rg = 0.f;
        unsigned ow[4], ok_[4], oi[2], oq[4], oz[4];
#pragma unroll
        for (int k = 0; k < 4; ++k) { const int c = st + 256 * k;
            { const int row = c & 63, p = c >> 6, pp = p & 3; ow[k] = (unsigned)((((((row >> 5) * 4 + (p >> 2)) * 4 + (pp >> 1)) * 64 + (pp & 1) * 32 + (row & 31)) * 4) * 2); }
            { const int dk = c & 127, p = c >> 7, pp = p & 3; ok_[k] = (unsigned)((((((p >> 2) * 4 + (dk >> 5)) * 4 + (pp >> 1)) * 64 + (pp & 1) * 32 + (dk & 31)) * 4) * 2); }
            oq[k] = (unsigned)(((c >> 4) * 4096 + (c & 15) * 8) * 2); oz[k] = (unsigned)(((c >> 4) * 2048 + (c & 15) * 8) * 2); }
#pragma unroll
        for (int k = 0; k < 2; ++k) { const int c = st + 256 * k; const int row = c & 63, p = c >> 6, pp = p & 3; oi[k] = (unsigned)((((((row >> 5) * 2 + (p >> 2)) * 4 + (pp >> 1)) * 64 + (pp & 1) * 32 + (row & 31)) * 4) * 2); }
#define SV_RUN2(dst, base, ob_) do { const v2u a_ = *(const v2u*)((const char*)(base) + (ob_)), b_ = *(const v2u*)((const char*)(base) + (ob_) + 1024); dst = (v4u){a_.x, a_.y, b_.x, b_.y}; } while (0)
#define SV_LOAD(ch) do { const int u_ = unit0 + (ch); const size_t t_ = tb0 + (size_t)(ch) * 64; \
        const bf16* wm_ = (const bf16*)(a.ws + WS_WMEM) + (size_t)u_ * 8192; const bf16* im_ = (const bf16*)(a.ws + WS_IMEM) + (size_t)u_ * 4096; \
        const bf16* kt_ = (const bf16*)(a.ws + WS_KTMEM) + (size_t)(hku0 + (ch)) * 8192; const bf16* qb_ = qkvc + t_ * 4096 + hk * 128; const bf16* zr_ = zb + t_ * 2048 + hv * 128; \
        _Pragma("unroll") for (int k = 0; k < 4; ++k) { SV_RUN2(rw[k], wm_, ow[k]); SV_RUN2(rk[k], kt_, ok_[k]); rq[k] = *(const v4u*)((const char*)qb_ + oq[k]); if (k < 2) rz[k] = *(const v4u*)((const char*)zr_ + oz[k]); } \
        _Pragma("unroll") for (int k = 0; k < 2; ++k) { SV_RUN2(ri[k], im_, oi[k]); } \
        if (st < 192) rg = ((const float*)(a.ws + WS_GTAB))[(size_t)u_ * 192 + st]; } while (0)
#define SV_WRITE(bf) do { LAS unsigned char* B_ = lds + (bf) * L_BUF; \
        _Pragma("unroll") for (int k = 0; k < 4; ++k) { const int c = st + 256 * k; *(LAS v4u*)(B_ + L_W + (c & 63) * PW + (c >> 6) * 16) = rw[k]; \
            *(LAS v4u*)(B_ + L_Q + (c >> 4) * PW + (c & 15) * 16) = rq[k]; *(LAS v4u*)(B_ + L_K + (c & 127) * PI + (c >> 7) * 16) = rk[k]; } \
        _Pragma("unroll") for (int k = 0; k < 2; ++k) { const int c = st + 256 * k; *(LAS v4u*)(B_ + L_I + (c & 63) * PI + (c >> 6) * 16) = ri[k]; } \
        if (st < 192) *(LAS float*)(B_ + L_G + st * 4) = rg; } while (0)
        f32x4 nwa, nwb;
        { const float* nwp = a.gdn_norm_w + j * 128 + (st & 15) * 8; nwa = *(const f32x4*)nwp; nwb = *(const f32x4*)(nwp + 4); }
        volatile LAS unsigned* flag = (volatile LAS unsigned*)(lds + L_PART);
        SV_LOAD(0); SV_WRITE(0);
        v4u zc[2], zn[2];
#pragma unroll
        for (int k = 0; k < 2; ++k) zc[k] = rz[k];
        __syncthreads();
        SV_LOAD(1);
#pragma unroll 1
        for (int chunk = 0; chunk < 64; ++chunk) {
            if (chunk + 1 < 64) { SV_WRITE((chunk + 1) & 1);
#pragma unroll
                for (int k = 0; k < 2; ++k) zn[k] = rz[k]; }
            __syncthreads();
            v4u ov[2];
#pragma unroll
            for (int k = 0; k < 2; ++k) { const int c = st + 256 * k; ov[k] = *(const LAS v4u*)(stg + (c >> 4) * 256 + (c & 15) * 16); }
            asm volatile("s_waitcnt lgkmcnt(0)" ::: "memory");
            if (lane == 0) __hip_atomic_fetch_add((LAS unsigned*)(lds + L_PART), 1u, __ATOMIC_RELAXED, __HIP_MEMORY_SCOPE_WORKGROUP);
            if (chunk + 2 < 64) SV_LOAD(chunk + 2);
            __builtin_amdgcn_sched_barrier(0);
            unsigned char* ob = dry ? a.ws + WS_END + (size_t)bid * 64 * 128 : a.ws + WS_G8 + (tb0 + (size_t)chunk * 64) * 2048 + hv * 128;
#pragma unroll
            for (int k = 0; k < 2; ++k) {
                float o8[8]; o8[0] = bf_lo(ov[k].x); o8[1] = bf_hi(ov[k].x); o8[2] = bf_lo(ov[k].y); o8[3] = bf_hi(ov[k].y); o8[4] = bf_lo(ov[k].z); o8[5] = bf_hi(ov[k].z); o8[6] = bf_lo(ov[k].w); o8[7] = bf_hi(ov[k].w);
                float ss = 0.f;
#pragma unroll
                for (int e = 0; e < 8; ++e) ss += o8[e] * o8[e];
                const float rinv = __builtin_amdgcn_rsqf(dpp_sum16(ss) * (1.0f / 128.0f) + RMS_EPS);
                float z8[8]; z8[0] = bf_lo(zc[k].x); z8[1] = bf_hi(zc[k].x); z8[2] = bf_lo(zc[k].y); z8[3] = bf_hi(zc[k].y); z8[4] = bf_lo(zc[k].z); z8[5] = bf_hi(zc[k].z); z8[6] = bf_lo(zc[k].w); z8[7] = bf_hi(zc[k].w);
                float r8[8];
#pragma unroll
                for (int e = 0; e < 8; ++e) r8[e] = o8[e] * rinv * (e < 4 ? nwa[e] : nwb[e - 4]) * z8[e];
                constexpr float gs = (float)(1 << F8_GO); v2u w; w.x = pg8::pk4_f8(r8[0] * gs, r8[1] * gs, r8[2] * gs, r8[3] * gs); w.y = pg8::pk4_f8(r8[4] * gs, r8[5] * gs, r8[6] * gs, r8[7] * gs);
                *(v2u*)(ob + (dry ? (unsigned)(((st + 256 * k) >> 4) * 128 + ((st + 256 * k) & 15) * 8) : (oz[k] >> 1))) = w; }
#pragma unroll
            for (int k = 0; k < 2; ++k) zc[k] = zn[k];
        }
#undef SV_RUN2
#undef SV_LOAD
#undef SV_WRITE
        return;
    }
    f4v S[2][8];
#pragma unroll
    for (int g = 0; g < 2; ++g)
#pragma unroll
        for (int m = 0; m < 8; ++m) S[g][m] = (f4v){0.f, 0.f, 0.f, 0.f};
    v2u un[2][4];
#define CW_ULOAD(ch) do { const bf16* vb_ = qkvc + (tb0 + (size_t)(ch) * 64) * 4096 + 2048 + hv * 128; \
        _Pragma("unroll") for (int g = 0; g < 2; ++g) _Pragma("unroll") for (int mt = 0; mt < 4; ++mt) { \
            const int f = (((((mt >> 1) * 4 + wave) * 4 + 2 * (mt & 1) + (kq >> 1)) * 64) + (kq & 1) * 32 + 16 * g + n) * 4;     \
            un[g][mt] = *(const v2u*)(vb_ + (size_t)(f >> 7) * 4096 + (f & 127)); } } while (0)
    CW_ULOAD(0);
    if (tid == 0) *(volatile LAS unsigned*)(lds + L_PART) = 0u;
    __syncthreads();
#pragma unroll 1
    for (int chunk = 0; chunk < 64; ++chunk) {
        GSEC_ACC(8, -);
        const LAS unsigned char* B = lds + (chunk & 1) * L_BUF; const LAS float* gt = (const LAS float*)(B + L_G);
        f4v av[2][4], ao[2][4];
#pragma unroll
        for (int g = 0; g < 2; ++g)
#pragma unroll
            for (int mt = 0; mt < 4; ++mt) { const v2u u0 = un[g][mt]; av[g][mt] = (f4v){bf_lo(u0.x), bf_hi(u0.x), bf_lo(u0.y), bf_hi(u0.y)}; }
        v4u zq[2];
#pragma unroll
        for (int k = 0; k < 2; ++k) { const int c = tid + 512 + 256 * k; zq[k] = *(const v4u*)(zb + (tb0 + (size_t)chunk * 64 + (c >> 4)) * 2048 + hv * 128 + (c & 15) * 8); }
        if (chunk + 1 < 64) CW_ULOAD(chunk + 1);
        bf16x8 Sb[2][4];
#pragma unroll
        for (int g = 0; g < 2; ++g)
#pragma unroll
            for (int p = 0; p < 4; ++p) { v4u w; w.x = pk(S[g][2 * p][0], S[g][2 * p][1]); w.y = pk(S[g][2 * p][2], S[g][2 * p][3]); w.z = pk(S[g][2 * p + 1][0], S[g][2 * p + 1][1]); w.w = pk(S[g][2 * p + 1][2], S[g][2 * p + 1][3]);
                Sb[g][p] = __builtin_bit_cast(bf16x8, w); }
#pragma unroll
        for (int mt = 0; mt < 4; ++mt) { ao[0][mt] = (f4v){0.f, 0.f, 0.f, 0.f}; ao[1][mt] = (f4v){0.f, 0.f, 0.f, 0.f};
#pragma unroll
            for (int p = 0; p < 4; ++p) {
                const bf16x8 aw = *(const LAS bf16x8*)(B + L_W + (16 * mt + n) * PW + 64 * p + 16 * kq);
                const v2u q0 = *(const LAS v2u*)(B + L_Q + (16 * mt + n) * PW + 64 * p + 8 * kq), q1 = *(const LAS v2u*)(B + L_Q + (16 * mt + n) * PW + 64 * p + 32 + 8 * kq);
                const v4u qq = {q0.x, q0.y, q1.x, q1.y}; const bf16x8 aq = __builtin_bit_cast(bf16x8, qq);
                av[0][mt] = __builtin_amdgcn_mfma_f32_16x16x32_bf16(aw, Sb[0][p], av[0][mt], 0, 0, 0); av[1][mt] = __builtin_amdgcn_mfma_f32_16x16x32_bf16(aw, Sb[1][p], av[1][mt], 0, 0, 0);
                ao[0][mt] = __builtin_amdgcn_mfma_f32_16x16x32_bf16(aq, Sb[0][p], ao[0][mt], 0, 0, 0); ao[1][mt] = __builtin_amdgcn_mfma_f32_16x16x32_bf16(aq, Sb[1][p], ao[1][mt], 0, 0, 0); } }
        bf16x8 vbf[2][2], vbd[2][2];
#pragma unroll
        for (int pp = 0; pp < 2; ++pp) {
            const f4v d0 = *(const LAS f4v*)(gt + 64 + 32 * pp + 4 * kq), d1 = *(const LAS f4v*)(gt + 64 + 32 * pp + 16 + 4 * kq);
#pragma unroll
            for (int g = 0; g < 2; ++g) { const f4v x0 = av[g][2 * pp], x1 = av[g][2 * pp + 1];
                v4u w; w.x = pk(x0[0], x0[1]); w.y = pk(x0[2], x0[3]); w.z = pk(x1[0], x1[1]); w.w = pk(x1[2], x1[3]); vbf[g][pp] = __builtin_bit_cast(bf16x8, w);
                v4u y; y.x = pk(x0[0] * d0[0], x0[1] * d0[1]); y.y = pk(x0[2] * d0[2], x0[3] * d0[3]); y.z = pk(x1[0] * d1[0], x1[1] * d1[1]); y.w = pk(x1[2] * d1[2], x1[3] * d1[3]); vbd[g][pp] = __builtin_bit_cast(bf16x8, y); }
        }
#pragma unroll
        for (int mt = 0; mt < 4; ++mt) { const f4v eg = *(const LAS f4v*)(gt + 16 * mt + 4 * kq); ao[0][mt] = ao[0][mt] * eg; ao[1][mt] = ao[1][mt] * eg;
#pragma unroll
            for (int pp = 0; pp < 2; ++pp) { const bf16x8 ai = *(const LAS bf16x8*)(B + L_I + (16 * mt + n) * PI + 64 * pp + 16 * kq);
                ao[0][mt] = __builtin_amdgcn_mfma_f32_16x16x32_bf16(ai, vbf[0][pp], ao[0][mt], 0, 0, 0); ao[1][mt] = __builtin_amdgcn_mfma_f32_16x16x32_bf16(ai, vbf[1][pp], ao[1][mt], 0, 0, 0); } }
        { const float egl = gt[128];
#pragma unroll
          for (int m8 = 0; m8 < 8; ++m8) { S[0][m8] = S[0][m8] * egl; S[1][m8] = S[1][m8] * egl;
#pragma unroll
              for (int pp = 0; pp < 2; ++pp) { const bf16x8 ak = *(const LAS bf16x8*)(B + L_K + (16 * m8 + n) * PI + 64 * pp + 16 * kq);
                  S[0][m8] = __builtin_amdgcn_mfma_f32_16x16x32_bf16(ak, vbd[0][pp], S[0][m8], 0, 0, 0); S[1][m8] = __builtin_amdgcn_mfma_f32_16x16x32_bf16(ak, vbd[1][pp], S[1][m8], 0, 0, 0); } } }
        GSEC_ACC(8, +); GSEC_ACC(9, -);
        { unsigned spins = 0; while (*(volatile LAS unsigned*)(lds + L_PART) < 8u * (unsigned)chunk) { __builtin_amdgcn_s_sleep(1); if (++spins > (1u << 22)) break; } }
#pragma unroll
        for (int g = 0; g < 2; ++g)
#pragma unroll
            for (int mt = 0; mt < 4; ++mt)
#pragma unroll
                for (int i = 0; i < 4; ++i) *(LAS bf16*)(stg + (16 * mt + 4 * kq + i) * 256 + (32 * wave + 16 * g + n) * 2) = (bf16)(pk(ao[g][mt][i], 0.f) & 0xffffu);
        __syncthreads();
        GSEC_ACC(9, +);
        {
            v4u ov[2];
#pragma unroll
            for (int k = 0; k < 2; ++k) { const int c = tid + 512 + 256 * k; ov[k] = *(const LAS v4u*)(stg + (c >> 4) * 256 + (c & 15) * 16); }
            asm volatile("s_waitcnt lgkmcnt(0)" ::: "memory");
            if (lane == 0) __hip_atomic_fetch_add((LAS unsigned*)(lds + L_PART), 1u, __ATOMIC_RELAXED, __HIP_MEMORY_SCOPE_WORKGROUP);
            const f32x4 nwa = *(const f32x4*)(a.gdn_norm_w + j * 128 + (tid & 15) * 8), nwb = *(const f32x4*)(a.gdn_norm_w + j * 128 + (tid & 15) * 8 + 4);
            unsigned char* ob = a.ws + WS_G8 + (tb0 + (size_t)chunk * 64) * 2048 + hv * 128;
#pragma unroll
            for (int k = 0; k < 2; ++k) { const int c = tid + 512 + 256 * k;
                float o8[8]; unpack8(ov[k], o8); float ss = 0.f;
#pragma unroll
                for (int e = 0; e < 8; ++e) ss += o8[e] * o8[e];
                const float rinv = __builtin_amdgcn_rsqf(dpp_sum16(ss) * (1.0f / 128.0f) + RMS_EPS);
                float z8[8]; unpack8(zq[k], z8); float r8[8];
#pragma unroll
                for (int e = 0; e < 8; ++e) r8[e] = o8[e] * rinv * (e < 4 ? nwa[e] : nwb[e - 4]) * z8[e];
                constexpr float gs = (float)(1 << F8_GO); v2u w; w.x = pg8::pk4_f8(r8[0] * gs, r8[1] * gs, r8[2] * gs, r8[3] * gs); w.y = pg8::pk4_f8(r8[4] * gs, r8[5] * gs, r8[6] * gs, r8[7] * gs);
                *(v2u*)(ob + (size_t)(c >> 4) * 2048 + (c & 15) * 8) = w; }
        }
    }
#undef CW_ULOAD
}

DI void moe_offsets(const Args& a, int j, unsigned (&off)[9]) {
    unsigned* cnt = (unsigned*)(a.ws + WS_CTL) + CW_CNT + 256 * j; unsigned acc = 0u;
#pragma unroll
    for (int e = 0; e < 8; ++e) { off[e] = acc; const unsigned c = (unsigned)__builtin_amdgcn_readfirstlane((int)__hip_atomic_load(cnt + e, __ATOMIC_RELAXED, __HIP_MEMORY_SCOPE_AGENT)); acc += (c + 255u) & ~255u; }
    off[8] = acc;
}
DI void phase_scatter(const Args& a, int j, LAS unsigned char* lds, int bid, int G, int tid, int wave, int lane) {
    LAS unsigned* lc = (LAS unsigned*)lds; LAS unsigned* lb = lc + 8; LAS unsigned* loff = lc + 16; LAS int* lpos = (LAS int*)(lc + 32);
    const unsigned* E12 = (const unsigned*)(a.ws + WS_E12); int* POS = (int*)(a.ws + WS_POS);
    const unsigned char* HB = a.ws + WS_HB; unsigned char* XS = a.ws + WS_XS;
    unsigned* fill = (unsigned*)(a.ws + WS_CTL) + CW_CNT + 256 * j + 64;
    unsigned off[9]; moe_offsets(a, j, off);
    if (tid == 0) {
#pragma unroll
        for (int e = 0; e < 8; ++e) loff[e] = off[e]; }
    for (int ci = bid; ci < TT / 128; ci += G) {
        __syncthreads();
        if (tid < 8) lc[tid] = 0u;
        __syncthreads();
        unsigned e1 = 0, e2 = 0, r1 = 0, r2 = 0;
        if (tid < 128) { const unsigned w = E12[ci * 128 + tid]; e1 = w & 255u; e2 = (w >> 8) & 255u;
            r1 = __hip_atomic_fetch_add(lc + e1, 1u, __ATOMIC_RELAXED, __HIP_MEMORY_SCOPE_WORKGROUP); r2 = __hip_atomic_fetch_add(lc + e2, 1u, __ATOMIC_RELAXED, __HIP_MEMORY_SCOPE_WORKGROUP); }
        __syncthreads();
        if (tid < 8) lb[tid] = __hip_atomic_fetch_add(fill + tid, lc[tid], __ATOMIC_RELAXED, __HIP_MEMORY_SCOPE_AGENT);
        __syncthreads();
        if (tid < 128) { const int p1 = (int)(loff[e1] + lb[e1] + r1), p2 = (int)(loff[e2] + lb[e2] + r2);
            lpos[2 * tid] = p1; lpos[2 * tid + 1] = p2; POS[2 * (ci * 128 + tid)] = p1; POS[2 * (ci * 128 + tid) + 1] = p2;
            const float hs = ((const float*)(a.ws + WS_HS))[ci * 128 + tid]; float* XSS = (float*)(a.ws + WS_XSS); XSS[p1] = hs; XSS[p2] = hs; }
        __syncthreads();
        for (int tk = wave; tk < 128; tk += NWAVES) {
            const int p1 = lpos[2 * tk], p2 = lpos[2 * tk + 1];
            const v4u* src = (const v4u*)(HB + (size_t)(ci * 128 + tk) * D);
            const v4u x0 = src[lane];
            v4u* d1 = (v4u*)(XS + (size_t)p1 * D); v4u* d2 = (v4u*)(XS + (size_t)p2 * D);
            d1[lane] = x0; d2[lane] = x0;
        }
    }
}

template <bool FINAL>
DI void phase_combine_ln(const Args& a, const bf16* Yin, bf16* Yout, int lnprev, int lnidx, int bid, int G, int wave, int lane) {
    bf16* HB = (bf16*)(a.ws + WS_HB); const unsigned char* YE = a.ws + WS_XS; float* stats = (float*)(a.ws + WS_STATS);
    const int* POS = (const int*)(a.ws + WS_POS); const f32x2* G12 = (const f32x2*)(a.ws + WS_G12);
    const float* g = a.ln_g + (size_t)lnidx * D; const float* bta = a.ln_b + (size_t)lnidx * D;
    const float* gp = a.ln_g + (size_t)lnprev * D; const float* bp = a.ln_b + (size_t)lnprev * D;
    const int gw = bid * NWAVES + wave, NGW = G * NWAVES;
    float gv[2][8], bv[2][8], gq[2][8], bq[2][8];
#pragma unroll
    for (int q = 0; q < 2; ++q)
#pragma unroll
        for (int c = 0; c < 8; ++c) { const int col = 8 * (lane + 64 * q) + c; gv[q][c] = g[col]; bv[q][c] = bta[col]; gq[q][c] = gp[col] * ALPHA; bq[q][c] = bp[col] * ALPHA; }
    int pn1 = 0, pn2 = 0; f32x2 ggn = {0.f, 0.f}, stn = {0.f, 0.f}; v4u ny[2]; v2u ne1[2], ne2[2];
    if (gw < TT) { pn1 = POS[2 * gw]; pn2 = POS[2 * gw + 1]; ggn = G12[gw]; stn = *(const f32x2*)(stats + 2 * (size_t)gw);
#pragma unroll
        for (int q = 0; q < 2; ++q) { ny[q] = ((const v4u*)(Yin + (size_t)gw * D))[lane + 64 * q]; ne1[q] = ((const v2u*)(YE + (size_t)pn1 * D))[lane + 64 * q]; ne2[q] = ((const v2u*)(YE + (size_t)pn2 * D))[lane + 64 * q]; } }
    int pa1 = 0, pa2 = 0; if (gw + NGW < TT) { pa1 = POS[2 * (gw + NGW)]; pa2 = POS[2 * (gw + NGW) + 1]; }
    for (int t = gw; t < TT; t += NGW) {
        const f32x2 gg = ggn * (1.0f / (float)(1 << F8_YE)); const f32x2 st = stn;
        v4u cy[2]; v2u ce1[2], ce2[2];
#pragma unroll
        for (int q = 0; q < 2; ++q) { cy[q] = ny[q]; ce1[q] = ne1[q]; ce2[q] = ne2[q]; }
        if (t + NGW < TT) { const int tn = t + NGW; ggn = G12[tn]; stn = *(const f32x2*)(stats + 2 * (size_t)tn);
#pragma unroll
            for (int q = 0; q < 2; ++q) { ny[q] = ((const v4u*)(Yin + (size_t)tn * D))[lane + 64 * q]; ne1[q] = ((const v2u*)(YE + (size_t)pa1 * D))[lane + 64 * q]; ne2[q] = ((const v2u*)(YE + (size_t)pa2 * D))[lane + 64 * q]; } }
        if (t + 2 * NGW < TT) { pa1 = POS[2 * (t + 2 * NGW)]; pa2 = POS[2 * (t + 2 * NGW) + 1]; }
        float v[2][8]; float s = 0.f;
#pragma unroll
        for (int q = 0; q < 2; ++q) { float y[8], e1[8], e2[8];
            unpack8(cy[q], y); unpack8_f8(ce1[q], e1); unpack8_f8(ce2[q], e2);
#pragma unroll
            for (int c = 0; c < 8; ++c) { v[q][c] = (y[c] - st.x) * st.y * gq[q][c] + bq[q][c] + e1[c] * gg.x + e2[c] * gg.y; s += v[q][c]; } }
        const float mean = wave_sum(s) * (1.0f / D); float s2 = 0.f;
#pragma unroll
        for (int q = 0; q < 2; ++q)
#pragma unroll
            for (int c = 0; c < 8; ++c) { const float d = v[q][c] - mean; s2 += d * d; }
        const float rstd = 1.0f / sqrtf(wave_sum(s2) * (1.0f / D) + LN_EPS);
        if (!FINAL && lane == 0) *(f32x2*)(stats + 2 * (size_t)t) = (f32x2){mean, rstd};
        float hn[2][8]; float am = 0.f;
#pragma unroll
        for (int q = 0; q < 2; ++q)
#pragma unroll
            for (int c = 0; c < 8; ++c) { hn[q][c] = (v[q][c] - mean) * rstd * gv[q][c] + bv[q][c]; am = fmaxf(am, fabsf(hn[q][c])); }
        if (FINAL) {
#pragma unroll
            for (int q = 0; q < 2; ++q) { f32x4* orow = (f32x4*)(a.out + (size_t)t * D + 8 * (lane + 64 * q)); orow[0] = (f32x4){hn[q][0], hn[q][1], hn[q][2], hn[q][3]}; orow[1] = (f32x4){hn[q][4], hn[q][5], hn[q][6], hn[q][7]}; }
        } else {
            am = fmaxf(wave_max_nn(am), 1.0e-20f); const float qs = 127.0f / am;
            if (lane == 0) ((float*)(a.ws + WS_HS))[t] = am * (1.0f / 127.0f);
#pragma unroll
            for (int q = 0; q < 2; ++q) { v4u yo; yo.x = pk2(v[q][0], v[q][1]); yo.y = pk2(v[q][2], v[q][3]); yo.z = pk2(v[q][4], v[q][5]); yo.w = pk2(v[q][6], v[q][7]); ((v4u*)(Yout + (size_t)t * D))[lane + 64 * q] = yo;
                v2u o; o.x = pk4_i8(hn[q][0] * qs, hn[q][1] * qs, hn[q][2] * qs, hn[q][3] * qs); o.y = pk4_i8(hn[q][4] * qs, hn[q][5] * qs, hn[q][6] * qs, hn[q][7] * qs);
                ((v2u*)((unsigned char*)HB + (size_t)t * D))[lane + 64 * q] = o; }
        }
    }
}

constexpr int ARGS_OFF = RING_BYTES + 1024;
DI unsigned long long lds_u64(LAS unsigned char* p) { const v2u w = *(const volatile LAS v2u*)p; return ((unsigned long long)(unsigned)__builtin_amdgcn_readfirstlane((int)w.y) << 32) | (unsigned)__builtin_amdgcn_readfirstlane((int)w.x); }
DI Args load_args(LAS unsigned char* lds) {
    Args a; LAS unsigned char* p = lds + ARGS_OFF;
    a.x = (const float*)(const GAS float*)lds_u64(p + 0); a.gdn_w_in = (const float*)(const GAS float*)lds_u64(p + 8); a.gdn_conv_w = (const float*)(const GAS float*)lds_u64(p + 16); a.gdn_a_log = (const float*)(const GAS float*)lds_u64(p + 24);
    a.gdn_dt_bias = (const float*)(const GAS float*)lds_u64(p + 32); a.gdn_norm_w = (const float*)(const GAS float*)lds_u64(p + 40); a.gdn_w_out = (const float*)(const GAS float*)lds_u64(p + 48); a.sb_w_in = (const float*)(const GAS float*)lds_u64(p + 56);
    a.sb_w_out = (const float*)(const GAS float*)lds_u64(p + 64); a.ffn_w_gate = (const float*)(const GAS float*)lds_u64(p + 72); a.ffn_w_up = (const float*)(const GAS float*)lds_u64(p + 80); a.ffn_w_down = (const float*)(const GAS float*)lds_u64(p + 88);
    a.moe_router = (const float*)(const GAS float*)lds_u64(p + 96); a.moe_w_gate = (const float*)(const GAS float*)lds_u64(p + 104); a.moe_w_up = (const float*)(const GAS float*)lds_u64(p + 112); a.moe_w_down = (const float*)(const GAS float*)lds_u64(p + 120);
    a.ln_g = (const float*)(const GAS float*)lds_u64(p + 128); a.ln_b = (const float*)(const GAS float*)lds_u64(p + 136); a.out = (float*)(GAS float*)lds_u64(p + 144); a.ws = (unsigned char*)(GAS unsigned char*)lds_u64(p + 152);
    const v2u w = *(const volatile LAS v2u*)(p + 160); a.ph_lo = __builtin_amdgcn_readfirstlane((int)w.x); a.ph_hi = __builtin_amdgcn_readfirstlane((int)w.y);
    return a;
}
#ifdef PH_ONLY
#define IN(k) (((k) % NPH) == PH_ONLY && lo <= (k) && (k) < hi)
#else
#define IN(k) (lo <= (k) && (k) < hi)
#endif
#define SEAM(k) do { if ((k) + 1 < hi) xcd_barrier(bar, tid == 0); } while (0)
DI int fresh_lane() { int l; asm volatile("v_mbcnt_lo_u32_b32 %0, -1, 0\n\tv_mbcnt_hi_u32_b32 %0, -1, %0" : "=v"(l)); return l; }
#define YMOE ((bf16*)(j == 1 ? (void*)(args.ws + WS_YT) : (void*)args.out))
#define ARGS() const Args args = load_args(lds); const int lo = args.ph_lo, hi = args.ph_hi; const int lane = fresh_lane(), tid = wave * 64 + lane
#ifndef PROBE_REP_MASK
#define PROBE_REP_MASK 0
#endif
#ifndef PROBE_DELAY_MASK
#define PROBE_DELAY_MASK 0
#endif
#define PROBE_DELAY_MULT 4u
#define TICK_IN(k) do { if (((PROBE_DELAY_MASK) >> (k)) & 1) { if (bid == 0 && tid == 0) ((volatile LAS unsigned*)(lds + MISC_OFF))[20] -= (unsigned)__builtin_amdgcn_s_memrealtime(); } } while (0)
#define TICK_OUT(k) do { if (((PROBE_DELAY_MASK) >> (k)) & 1) { if (bid == 0 && tid == 0) ((volatile LAS unsigned*)(lds + MISC_OFF))[20] += (unsigned)__builtin_amdgcn_s_memrealtime(); } } while (0)
#define NREP(k) ((((PROBE_REP_MASK) >> (k)) & 1) ? 2 : 1)
template <int j>
DI void layer_pair(LAS unsigned char* lds, const XcdBarrier& bar, const int wave, const int G, const int bid) {
    constexpr int pb = j * NPH;
    if constexpr (j == 0) { ARGS(); if (IN(pb + 0)) { TICK_IN(0); _Pragma("unroll 1") for (int rep_ = 0; rep_ < NREP(0); ++rep_) { phase_w_gdn(args, j, 3, lds, bid, G, tid, wave, lane); } SEAM(pb + 0); TICK_OUT(0); } }
    { ARGS(); if (IN(pb + 1)) { TICK_IN(1); {
        pg8::Gemm g{(const bf16*)(args.ws + WS_HB), (const bf16*)(args.ws + W_IN_(j)), D / 2, D / 2}; pg8::StaticOrder S; S.init(TT, GINP, G, bid, NREP(1));
        pg8::EpiI8<pg8::EpiInProj> E{{(bf16*)(args.ws + WS_RAW), (bf16*)(args.ws + WS_ZB)}, (const float*)(args.ws + WS_HS), (const float*)(args.ws + WS_SWI_(j))};
        pg8::gemm_phase<pg8::EpiI8<pg8::EpiInProj>, pg8::StaticOrder, true, true, 2>(lds, g, S, E, wave);
        } SEAM(pb + 1); TICK_OUT(1); } }
    { ARGS(); if (IN(pb + 2)) { TICK_IN(2); _Pragma("unroll 1") for (int rep_ = 0; rep_ < NREP(2); ++rep_) { phase_conv(args, j, bid, G, tid); } SEAM(pb + 2); TICK_OUT(2); } }
#if GDN_NAIVE
    { ARGS(); if (IN(pb + 4)) { TICK_IN(4); _Pragma("unroll 1") for (int rep_ = 0; rep_ < NREP(4); ++rep_) { phase_gdn_naive(args, j, lds, bid, tid); } SEAM(pb + 4); TICK_OUT(4); } }
#else
    { ARGS(); if (IN(pb + 3)) { TICK_IN(3); _Pragma("unroll 1") for (int rep_ = 0; rep_ < NREP(3); ++rep_) { phase_gdn_local(args, lds, bid, G, wave, lane, rep_ + 1 < NREP(3)); } SEAM(pb + 3); TICK_OUT(3); } }
    { ARGS(); if (IN(pb + 4)) { TICK_IN(4); _Pragma("unroll 1") for (int rep_ = 0; rep_ < NREP(4); ++rep_) { if (bid >= BATCH * HV && G > BATCH * HV) phase_w_sb(args, j, lds, bid - BATCH * HV, G - BATCH * HV, wave, lane); else if (G <= BATCH * HV && rep_ == 0) phase_w_sb(args, j, lds, bid, G, wave, lane);
        phase_gdn_scan(args, j, lds, bid, tid, rep_ + 1 < NREP(4)); } SEAM(pb + 4); TICK_OUT(4); } }
#endif
    { ARGS(); if (IN(pb + 5)) { TICK_IN(5); {
        pg8::Gemm g{(const bf16*)(args.ws + WS_G8), (const bf16*)(args.ws + W_OUT_(j)), 1024, 1024}; pg8::StaticOrder S; S.init(TT, D, G, bid);
        pg8::EpiResid<(j > 0), F8_GO + F8_WO> E{j == 0 ? (const void*)args.x : (const void*)args.out, (bf16*)args.out, (const float*)(args.ws + WS_STATS), args.ln_g + (size_t)(4 * (j > 0 ? j - 1 : 0) + 3) * D, args.ln_b + (size_t)(4 * (j > 0 ? j - 1 : 0) + 3) * D};
        pg8::gemm_phase<pg8::EpiResid<(j > 0), F8_GO + F8_WO>, pg8::StaticOrder, true, true, 1>(lds, g, S, E, wave);
        } SEAM(pb + 5); TICK_OUT(5); } }
    { ARGS(); if (IN(pb + 6)) { TICK_IN(6); _Pragma("unroll 1") for (int rep_ = 0; rep_ < NREP(6); ++rep_) { phase_ln<false, true>(args, (const bf16*)args.out, (2 * j) * 2 + 0, j, lds, bid, G, tid, wave, lane); } SEAM(pb + 6); TICK_OUT(6); } }
    { ARGS(); if (IN(pb + 7)) { TICK_IN(7); {
        pg8::Gemm g{(const bf16*)(args.ws + WS_HB), (const bf16*)(args.ws + W_GU_(j)), D / 2, D / 2}; pg8::StaticOrder S; S.init(TT, 2 * FF, G, bid, NREP(7));
        pg8::EpiSwiGLUI8<F8_ACT> E{args.ws + WS_ACT, FF, 0, (const float*)(args.ws + WS_HS), (const float*)(args.ws + WS_SWD_(j))};
        pg8::gemm_phase<pg8::EpiSwiGLUI8<F8_ACT>, pg8::StaticOrder, true, true, 2>(lds, g, S, E, wave);
        } SEAM(pb + 7); TICK_OUT(7); } }
    { ARGS(); if (IN(pb + 8)) { TICK_IN(8); {
        pg8::Gemm g{(const bf16*)(args.ws + WS_ACT), (const bf16*)(args.ws + W_D_(j)), FF / 2, FF / 2}; pg8::StaticOrder S; S.init(TT, D, G, bid);
        pg8::EpiResid<true, F8_ACT + F8_WD> E{(const void*)args.out, (bf16*)args.out, (const float*)(args.ws + WS_STATS), args.ln_g + (size_t)(4 * j + 0) * D, args.ln_b + (size_t)(4 * j + 0) * D};
        pg8::gemm_phase<pg8::EpiResid<true, F8_ACT + F8_WD>, pg8::StaticOrder, true, true, 1>(lds, g, S, E, wave);
        } SEAM(pb + 8); TICK_OUT(8); } }
    { ARGS(); if (IN(pb + 9)) { TICK_IN(9); _Pragma("unroll 1") for (int rep_ = 0; rep_ < NREP(9); ++rep_) { phase_ln<false, true>(args, (const bf16*)args.out, (2 * j) * 2 + 1, j, lds, bid, G, tid, wave, lane); } SEAM(pb + 9); TICK_OUT(9); } }
    { ARGS(); if (IN(pb + 10)) { TICK_IN(10); {
        pg8::Gemm g{(const bf16*)(args.ws + WS_HB), (const bf16*)(args.ws + W_QKV), D / 2, D / 2}; pg8::StaticOrder S; S.init(TT, 3072, G, bid, NREP(10));
        pg8::EpiI8<pg8::EpiBf16> E{{(bf16*)(args.ws + WS_QKV), 3072, 0}, (const float*)(args.ws + WS_HS), (const float*)(args.ws + WS_SWQ)};
        pg8::gemm_phase<pg8::EpiI8<pg8::EpiBf16>, pg8::StaticOrder, true, true, 2>(lds, g, S, E, wave);
        } SEAM(pb + 10); TICK_OUT(10); } }
    #if SB_NAIVE
    { ARGS(); if (IN(pb + 11)) { TICK_IN(11); _Pragma("unroll 1") for (int rep_ = 0; rep_ < NREP(11); ++rep_) { phase_sb_naive(args, lds, bid, G, tid); } SEAM(pb + 11); TICK_OUT(11); } }
#else
    { ARGS(); if (IN(pb + 11)) { TICK_IN(11); _Pragma("unroll 1") for (int rep_ = 0; rep_ < NREP(11); ++rep_) { phase_sb_mfma(args, lds, bid, G, tid); } SEAM(pb + 11); TICK_OUT(11); } }
#endif
    { ARGS(); if (IN(pb + 12)) { TICK_IN(12); {
        pg8::Gemm g{(const bf16*)(args.ws + WS_AO), (const bf16*)(args.ws + W_O), D / 2, D / 2}; pg8::StaticOrder S; S.init(TT, D, G, bid);
        pg8::EpiResid<true, F8_AO + F8_WSO> E{(const void*)args.out, YMOE, (const float*)(args.ws + WS_STATS), args.ln_g + (size_t)(4 * j + 1) * D, args.ln_b + (size_t)(4 * j + 1) * D};
        pg8::gemm_phase<pg8::EpiResid<true, F8_AO + F8_WSO>, pg8::StaticOrder, true, true, 1>(lds, g, S, E, wave);
        } SEAM(pb + 12); TICK_OUT(12); } }
    { ARGS(); if (IN(pb + 13)) { TICK_IN(13); _Pragma("unroll 1") for (int rep_ = 0; rep_ < NREP(13); ++rep_) { phase_ln<true, true>(args, YMOE, (2 * j + 1) * 2 + 0, j, lds, bid, G, tid, wave, lane); } SEAM(pb + 13); TICK_OUT(13); } }
    { ARGS(); if (IN(pb + 14)) { TICK_IN(14); _Pragma("unroll 1") for (int rep_ = 0; rep_ < NREP(14); ++rep_) { phase_scatter(args, j, lds, bid, G, tid, wave, lane); } SEAM(pb + 14); TICK_OUT(14); } }
    { ARGS(); if (IN(pb + 15)) { TICK_IN(15); {
        unsigned off[9]; moe_offsets(args, j, off);
        pg8::MoeOrder S; S.nM = (int)(off[8] >> 8); S.G = G; S.c = bid; S.nN = 2 * FF / 256; S.nwg = S.nM * S.nN; S.rep = NREP(15);
        S.ps1 = (int)(off[1] >> 8); S.ps2 = (int)(off[2] >> 8); S.ps3 = (int)(off[3] >> 8); S.ps4 = (int)(off[4] >> 8); S.ps5 = (int)(off[5] >> 8); S.ps6 = (int)(off[6] >> 8); S.ps7 = (int)(off[7] >> 8);
        pg8::Gemm g{(const bf16*)(args.ws + WS_XS), (const bf16*)(args.ws + W_MGU), D / 2, D / 2};
        pg8::EpiSwiGLUI8<F8_ACT> E{args.ws + WS_MACT, FF, 2 * FF / 256, (const float*)(args.ws + WS_XSS), (const float*)(args.ws + WS_SWM)};
        pg8::gemm_phase<pg8::EpiSwiGLUI8<F8_ACT>, pg8::MoeOrder, true, true, 2>(lds, g, S, E, wave);
        } SEAM(pb + 15); TICK_OUT(15); } }
    { ARGS(); if (IN(pb + 16)) { TICK_IN(16); {
        unsigned off[9]; moe_offsets(args, j, off);
        pg8::MoeOrder S; S.nM = (int)(off[8] >> 8); S.G = G; S.c = bid; S.nN = D / 256; S.nwg = S.nM * S.nN; S.rep = NREP(16);
        S.ps1 = (int)(off[1] >> 8); S.ps2 = (int)(off[2] >> 8); S.ps3 = (int)(off[3] >> 8); S.ps4 = (int)(off[4] >> 8); S.ps5 = (int)(off[5] >> 8); S.ps6 = (int)(off[6] >> 8); S.ps7 = (int)(off[7] >> 8);
        pg8::Gemm g{(const bf16*)(args.ws + WS_MACT), (const bf16*)(args.ws + W_MD), FF / 2, FF / 2};
        pg8::EpiF8T<F8_ACT + F8_WD, F8_YE> E{args.ws + WS_XS, D, D / 256};
        pg8::gemm_phase<pg8::EpiF8T<F8_ACT + F8_WD, F8_YE>, pg8::MoeOrder, true, true, 1>(lds, g, S, E, wave);
        if constexpr (j == 0) phase_w_gdn_dyn(args, 1, (unsigned*)(args.ws + WS_CTL) + CW_WQ, lds, wave);
        } SEAM(pb + 16); TICK_OUT(16); } }
    { ARGS(); if (IN(pb + 17)) { TICK_IN(17); _Pragma("unroll 1") for (int rep_ = 0; rep_ < NREP(17); ++rep_) { phase_combine_ln<(j == 1)>(args, YMOE, (bf16*)args.out, 4 * j + 2, 4 * j + 3, bid, G, wave, lane); } SEAM(pb + 17); TICK_OUT(17); } }
}
__global__ void __launch_bounds__(NWAVES * 64, 2) fwd(Args kargs) {
    extern __shared__ __attribute__((aligned(16))) unsigned char lds_raw[];
    LAS unsigned char* lds = (LAS unsigned char*)lds_raw;
    volatile LAS unsigned* MISC = (volatile LAS unsigned*)(lds + MISC_OFF);
    const int tid = threadIdx.x, lane = tid & 63, wave = __builtin_amdgcn_readfirstlane(tid >> 6), G = gridDim.x, bid = blockIdx.x;
    for (int u = tid; u < (LDS_BYTES - RING_BYTES) / 4; u += NWAVES * 64) ((LAS unsigned*)(lds + RING_BYTES))[u] = 0u;
    __syncthreads();
    if (tid == 0) { LAS unsigned long long* pa = (LAS unsigned long long*)(lds + ARGS_OFF);
        pa[0] = (unsigned long long)kargs.x; pa[1] = (unsigned long long)kargs.gdn_w_in; pa[2] = (unsigned long long)kargs.gdn_conv_w; pa[3] = (unsigned long long)kargs.gdn_a_log;
        pa[4] = (unsigned long long)kargs.gdn_dt_bias; pa[5] = (unsigned long long)kargs.gdn_norm_w; pa[6] = (unsigned long long)kargs.gdn_w_out; pa[7] = (unsigned long long)kargs.sb_w_in;
        pa[8] = (unsigned long long)kargs.sb_w_out; pa[9] = (unsigned long long)kargs.ffn_w_gate; pa[10] = (unsigned long long)kargs.ffn_w_up; pa[11] = (unsigned long long)kargs.ffn_w_down;
        pa[12] = (unsigned long long)kargs.moe_router; pa[13] = (unsigned long long)kargs.moe_w_gate; pa[14] = (unsigned long long)kargs.moe_w_up; pa[15] = (unsigned long long)kargs.moe_w_down;
        pa[16] = (unsigned long long)kargs.ln_g; pa[17] = (unsigned long long)kargs.ln_b; pa[18] = (unsigned long long)kargs.out; pa[19] = (unsigned long long)kargs.ws;
        pa[20] = (unsigned long long)(unsigned)kargs.ph_lo | ((unsigned long long)(unsigned)kargs.ph_hi << 32); }
    XcdBarrier bar = xcd_barrier_post((unsigned*)(kargs.ws + WS_CTL) + CW_BAR, MISC + 8);
    __syncthreads();
    layer_pair<0>(lds, bar, wave, G, bid);
    layer_pair<1>(lds, bar, wave, G, bid);
    if (PROBE_DELAY_MASK || PROBE_SEC) { if (bid == 0 && threadIdx.x == 0) { const unsigned acc = ((volatile LAS unsigned*)(lds + MISC_OFF))[20] * PROBE_DELAY_MULT; const unsigned long long t0 = __builtin_amdgcn_s_memrealtime(); while ((unsigned)(__builtin_amdgcn_s_memrealtime() - t0) < acc) __builtin_amdgcn_s_sleep(8); } }
}
#undef IN
#undef SEAM
#undef ARGS

extern "C" void kernel_launch(void* const* d_in, const int* in_sizes, int n_in, void* d_out, int out_size, void* d_ws, size_t ws_size, hipStream_t stream) {
    static int grid = 0;
    if (grid == 0) {
        if (n_in != 18 || in_sizes[0] != TT * D || out_size != TT * D || ws_size < WS_END) { fprintf(stderr, "kernel_launch: unexpected shapes (n_in %d, in0 %d, out %d, ws %zu); nothing launched\n", n_in, n_in > 0 ? in_sizes[0] : -1, out_size, ws_size); grid = -1; return; }
        int dev = 0, cus = 0, per_cu = 0;
        if (hipGetDevice(&dev) != hipSuccess || hipDeviceGetAttribute(&cus, hipDeviceAttributeMultiprocessorCount, dev) != hipSuccess) { grid = -1; return; }
        if (hipFuncSetAttribute((const void*)fwd, hipFuncAttributeMaxDynamicSharedMemorySize, LDS_BYTES) != hipSuccess) { fprintf(stderr, "kernel_launch: hipFuncSetAttribute failed\n"); grid = -1; return; }
        if (hipOccupancyMaxActiveBlocksPerMultiprocessor(&per_cu, (const void*)fwd, NWAVES * 64, LDS_BYTES) != hipSuccess || per_cu < 1) { fprintf(stderr, "kernel_launch: occupancy query says %d blocks per CU\n", per_cu); (void)hipGetLastError(); grid = -1; return; }
        grid = cus;
    }
    if (grid < 0) return;
    if (hipMemsetAsync((char*)d_ws + WS_CTL, 0, CTL_ZERO_BYTES, stream) != hipSuccess) return;
    Args a{};
    a.x = (const float*)d_in[0]; a.gdn_w_in = (const float*)d_in[1]; a.gdn_conv_w = (const float*)d_in[2]; a.gdn_a_log = (const float*)d_in[3]; a.gdn_dt_bias = (const float*)d_in[4];
    a.gdn_norm_w = (const float*)d_in[5]; a.gdn_w_out = (const float*)d_in[6]; a.sb_w_in = (const float*)d_in[7]; a.sb_w_out = (const float*)d_in[8];
    a.ffn_w_gate = (const float*)d_in[9]; a.ffn_w_up = (const float*)d_in[10]; a.ffn_w_down = (const float*)d_in[11]; a.moe_router = (const float*)d_in[12];
    a.moe_w_gate = (const float*)d_in[13]; a.moe_w_up = (const float*)d_in[14]; a.moe_w_down = (const float*)d_in[15]; a.ln_g = (const float*)d_in[16]; a.ln_b = (const float*)d_in[17];
    a.out = (float*)d_out; a.ws = (unsigned char*)d_ws;
#if MK_ONE_LAUNCH
    a.ph_lo = 0; a.ph_hi = NPHASES;
    hipLaunchKernelGGL(fwd, dim3(grid), dim3(NWAVES * 64), LDS_BYTES, stream, a);
#else
    for (int p = 0; p < NPHASES; ++p) { a.ph_lo = p; a.ph_hi = p + 1; hipLaunchKernelGGL(fwd, dim3(grid), dim3(NWAVES * 64), LDS_BYTES, stream, a); }
#endif
}
```

```cpp
#include <hip/hip_runtime.h>
#include <cstdio>
#include <cstdint>
#ifndef GDN_NAIVE
#define GDN_NAIVE 0
#endif
#ifndef SB_NAIVE
#define SB_NAIVE 0
#endif
#ifndef MK_ONE_LAUNCH
#define MK_ONE_LAUNCH 1
#endif
#ifndef PROBE_SEC
#define PROBE_SEC 0
#endif
#define GSEC_ACC(k, sign) do { if (PROBE_SEC == (k)) { if (blockIdx.x == 0 && threadIdx.x == 0) { volatile __attribute__((address_space(3))) unsigned* p_ = (volatile __attribute__((address_space(3))) unsigned*)(131072 + 320 + 80); *p_ = *p_ sign (unsigned)__builtin_amdgcn_s_memrealtime(); } } } while (0)
namespace pg8 {
#define PG8_LAS __attribute__((address_space(3)))
typedef unsigned short bf16_t;
typedef short bf16x8 __attribute__((ext_vector_type(8)));
typedef float f32x4 __attribute__((ext_vector_type(4)));
typedef unsigned u32x4 __attribute__((ext_vector_type(4)));
constexpr int BM = 256, BK = 64, HALF = 128, HTB = HALF * BK * 2  , STAGE_BYTES = 8 * HTB, NXCD = 8, WGM = 8;

__host__ __device__ __forceinline__ int lds_byte(int r, int c) { const int st = (r >> 4) * 2 + (c >> 5), rr = r & 15, cc = c & 31, ob = rr * 64 + cc * 2; return st * 1024 + (ob ^ (((ob >> 9) & 1) << 5)); }
__host__ __device__ __forceinline__ void stage_rc(int b, int& R, int& C) { const int st = b / 1024, sb = b % 1024, swz = sb ^ (((sb >> 9) & 1) << 5); R = (st >> 1) * 16 + swz / 64; C = (st & 1) * 32 + (swz % 64) / 2; }
__host__ __device__ __forceinline__ int perm32(int rho) { const int n = rho >> 4, i = rho & 15; return 8 * (i >> 2) + 4 * n + (i & 3); }

struct Unit { int pm, pn; };
struct Gemm { const bf16_t* A; const bf16_t* Bt; int lda, K; };

struct StaticOrder {
    int nM, nN, nwg, G, c, rep;
    __host__ __device__ void init(int M, int N, int G_, int c_, int rep_ = 1) { nM = M / BM; nN = N / BM; nwg = nM * nN; G = G_; c = c_; rep = rep_; }
    __host__ __device__ bool next(int i, Unit& u) const {
        const int L = i * G + c; if (L >= rep * nwg) return false;
        int wgid = rep == 1 ? L : L % nwg; { const int q = nwg / NXCD, r = nwg % NXCD, xcd = wgid % NXCD, off = wgid / NXCD; wgid = (xcd < r ? xcd * (q + 1) : r * (q + 1) + (xcd - r) * q) + off; }
        const int nig = WGM * nN, gid = wgid / nig, fm = gid * WGM, gsz = (nM - fm) < WGM ? (nM - fm) : WGM;
        u.pm = fm + ((wgid % nig) % gsz); u.pn = (wgid % nig) / gsz; return true;
    }
    __device__ __forceinline__ void a_ready(const Unit&) const {}
    __device__ __forceinline__ void done(const Unit&) const {}
};

__device__ __forceinline__ unsigned cvt_pk_bf16(float lo, float hi) { unsigned r; asm volatile("v_cvt_pk_bf16_f32 %0, %1, %2" : "=v"(r) : "v"(lo), "v"(hi)); return r; }
template <int SCL2 = 0> struct EpiBf16T {
    static constexpr bool PERM = true, AFTER_DRAIN = false;
    bf16_t* O; int ldc; int nmod;
    __device__ __forceinline__ void operator()(const f32x4 (&acc)[2][2][4][2], const Unit& u, int wr, int wc, int fr, int fq) const {
        const int pnl = nmod ? (u.pn % nmod) : u.pn;
        const int row0 = u.pm * BM + wr * 64 + fr, col0 = pnl * BM + wc * 32 + 8 * fq;
#pragma unroll
        for (int ai = 0; ai < 2; ++ai)
#pragma unroll
            for (int m = 0; m < 4; ++m) { bf16_t* rowp = O + (size_t)(row0 + ai * HALF + m * 16) * ldc + col0;
#pragma unroll
                for (int bj = 0; bj < 2; ++bj) { constexpr float sc = 1.0f / (float)(1 << SCL2); const f32x4 v0 = acc[ai][bj][m][0] * sc, v1 = acc[ai][bj][m][1] * sc;
                    u32x4 w; w.x = cvt_pk_bf16(v0[0], v0[1]); w.y = cvt_pk_bf16(v0[2], v0[3]); w.z = cvt_pk_bf16(v1[0], v1[1]); w.w = cvt_pk_bf16(v1[2], v1[3]);
                    *(u32x4*)(rowp + bj * HALF) = w; } }
    }
};
typedef EpiBf16T<0> EpiBf16;
struct EpiInProj {
    static constexpr bool PERM = true, AFTER_DRAIN = false;
    bf16_t* RAW; bf16_t* ZB;
    __device__ __forceinline__ void operator()(const f32x4 (&acc)[2][2][4][2], const Unit& u, int wr, int wc, int fr, int fq) const {
        const bool isz = (u.pn >= 16 && u.pn < 24);
        bf16_t* O = isz ? ZB : RAW; const int ldc = isz ? 2048 : 4352; const int ct = isz ? (u.pn - 16) : (u.pn < 16 ? u.pn : 16);
        const int row0 = u.pm * BM + wr * 64 + fr, col0 = ct * BM + wc * 32 + 8 * fq;
#pragma unroll
        for (int ai = 0; ai < 2; ++ai)
#pragma unroll
            for (int m = 0; m < 4; ++m) { bf16_t* rowp = O + (size_t)(row0 + ai * HALF + m * 16) * ldc + col0;
#pragma unroll
                for (int bj = 0; bj < 2; ++bj) { f32x4 v0 = acc[ai][bj][m][0], v1 = acc[ai][bj][m][1];
                    if (isz) {
#pragma unroll
                        for (int e = 0; e < 4; ++e) { v0[e] = v0[e] * __builtin_amdgcn_rcpf(1.0f + __builtin_amdgcn_exp2f(-1.4426950408889634f * v0[e])); v1[e] = v1[e] * __builtin_amdgcn_rcpf(1.0f + __builtin_amdgcn_exp2f(-1.4426950408889634f * v1[e])); } }
                    u32x4 w; w.x = cvt_pk_bf16(v0[0], v0[1]); w.y = cvt_pk_bf16(v0[2], v0[3]); w.z = cvt_pk_bf16(v1[0], v1[1]); w.w = cvt_pk_bf16(v1[2], v1[3]);
                    *(u32x4*)(rowp + bj * HALF) = w; } }
    }
};
__device__ __forceinline__ float silu_f(float x) { return x * __builtin_amdgcn_rcpf(1.0f + __builtin_amdgcn_exp2f(-1.4426950408889634f * x)); }
struct EpiSwiGLU {
    static constexpr bool PERM = true, AFTER_DRAIN = false;
    bf16_t* O; int ldc; int nmod;
    __device__ __forceinline__ void operator()(const f32x4 (&acc)[2][2][4][2], const Unit& u, int wr, int wc, int fr, int fq) const {
        const int pnl = nmod ? (u.pn % nmod) : u.pn;
        const int row0 = u.pm * BM + wr * 64 + fr, col0 = pnl * HALF + wc * 32 + 8 * fq;
#pragma unroll
        for (int ai = 0; ai < 2; ++ai)
#pragma unroll
            for (int m = 0; m < 4; ++m) { bf16_t* rowp = O + (size_t)(row0 + ai * HALF + m * 16) * ldc + col0;
                const f32x4 g0 = acc[ai][0][m][0], g1 = acc[ai][0][m][1], u0 = acc[ai][1][m][0], u1 = acc[ai][1][m][1];
                u32x4 w;
                w.x = cvt_pk_bf16(silu_f(g0[0]) * u0[0], silu_f(g0[1]) * u0[1]); w.y = cvt_pk_bf16(silu_f(g0[2]) * u0[2], silu_f(g0[3]) * u0[3]);
                w.z = cvt_pk_bf16(silu_f(g1[0]) * u1[0], silu_f(g1[1]) * u1[1]); w.w = cvt_pk_bf16(silu_f(g1[2]) * u1[2], silu_f(g1[3]) * u1[3]);
                *(u32x4*)rowp = w; }
    }
};
__device__ __forceinline__ float clamp_f8(float x) { return __builtin_fminf(__builtin_fmaxf(x, -448.0f), 448.0f); }
__device__ __forceinline__ unsigned pk4_f8(float a, float b, float c, float d) { int w = 0; w = __builtin_amdgcn_cvt_pk_fp8_f32(clamp_f8(a), clamp_f8(b), w, false); w = __builtin_amdgcn_cvt_pk_fp8_f32(clamp_f8(c), clamp_f8(d), w, true); return (unsigned)w; }
typedef unsigned u32x2 __attribute__((ext_vector_type(2)));
template <int SCL2, int OSC2> struct EpiSwiGLU8 {
    static constexpr bool PERM = true, AFTER_DRAIN = false;
    unsigned char* O; int ldc; int nmod;
    __device__ __forceinline__ void operator()(const f32x4 (&acc)[2][2][4][2], const Unit& u, int wr, int wc, int fr, int fq) const {
        constexpr float cg = 1.0f / (float)(1 << SCL2), cu = cg * (float)(1 << OSC2);
        const int pnl = nmod ? (u.pn % nmod) : u.pn;
        const int row0 = u.pm * BM + wr * 64 + fr, col0 = pnl * HALF + wc * 32 + 8 * fq;
#pragma unroll
        for (int ai = 0; ai < 2; ++ai)
#pragma unroll
            for (int m = 0; m < 4; ++m) { unsigned char* rowp = O + (size_t)(row0 + ai * HALF + m * 16) * ldc + col0;
                const f32x4 g0 = acc[ai][0][m][0] * cg, g1 = acc[ai][0][m][1] * cg, u0 = acc[ai][1][m][0] * cu, u1 = acc[ai][1][m][1] * cu;
                u32x2 w;
                w.x = pk4_f8(silu_f(g0[0]) * u0[0], silu_f(g0[1]) * u0[1], silu_f(g0[2]) * u0[2], silu_f(g0[3]) * u0[3]);
                w.y = pk4_f8(silu_f(g1[0]) * u1[0], silu_f(g1[1]) * u1[1], silu_f(g1[2]) * u1[2], silu_f(g1[3]) * u1[3]);
                *(u32x2*)rowp = w; }
    }
};
template <int SCL2, int OSC2> struct EpiF8T {
    static constexpr bool PERM = true, AFTER_DRAIN = false;
    unsigned char* O; int ldc; int nmod;
    __device__ __forceinline__ void operator()(const f32x4 (&acc)[2][2][4][2], const Unit& u, int wr, int wc, int fr, int fq) const {
        constexpr float sc = OSC2 >= SCL2 ? (float)(1 << (OSC2 >= SCL2 ? OSC2 - SCL2 : 0)) : 1.0f / (float)(1 << (SCL2 > OSC2 ? SCL2 - OSC2 : 0));
        const int pnl = nmod ? (u.pn % nmod) : u.pn;
        const int row0 = u.pm * BM + wr * 64 + fr, col0 = pnl * BM + wc * 32 + 8 * fq;
#pragma unroll
        for (int ai = 0; ai < 2; ++ai)
#pragma unroll
            for (int m = 0; m < 4; ++m) { unsigned char* rowp = O + (size_t)(row0 + ai * HALF + m * 16) * ldc + col0;
#pragma unroll
                for (int bj = 0; bj < 2; ++bj) { const f32x4 v0 = acc[ai][bj][m][0] * sc, v1 = acc[ai][bj][m][1] * sc;
                    u32x2 w; w.x = pk4_f8(v0[0], v0[1], v0[2], v0[3]); w.y = pk4_f8(v1[0], v1[1], v1[2], v1[3]);
                    *(u32x2*)(rowp + bj * HALF) = w; } }
    }
};
__device__ __forceinline__ f32x4 cvt_i4(const f32x4 a) { typedef int i32x4e __attribute__((ext_vector_type(4))); return __builtin_convertvector(__builtin_bit_cast(i32x4e, a), f32x4); }
template <int OSC2> struct EpiSwiGLUI8 {
    static constexpr bool PERM = true, AFTER_DRAIN = false;
    unsigned char* O; int ldc; int nmod; const float* sa; const float* sw;
    __device__ __forceinline__ void operator()(const f32x4 (&acc)[2][2][4][2], const Unit& u, int wr, int wc, int fr, int fq) const {
        constexpr float os = (float)(1 << OSC2);
        const int pnl = nmod ? (u.pn % nmod) : u.pn;
        const int row0 = u.pm * BM + wr * 64 + fr, col0 = pnl * HALF + wc * 32 + 8 * fq;
        const float* swp = sw + (size_t)u.pn * BM + wc * 32 + 8 * fq;
        const f32x4 sg0 = *(const f32x4*)swp, sg1 = *(const f32x4*)(swp + 4), su0 = *(const f32x4*)(swp + HALF) * os, su1 = *(const f32x4*)(swp + HALF + 4) * os;
#pragma unroll
        for (int ai = 0; ai < 2; ++ai) {
            float sr[4];
#pragma unroll
            for (int m = 0; m < 4; ++m) sr[m] = sa[row0 + ai * HALF + m * 16];
#pragma unroll
            for (int m = 0; m < 4; ++m) { unsigned char* rowp = O + (size_t)(row0 + ai * HALF + m * 16) * ldc + col0;
                const f32x4 g0 = cvt_i4(acc[ai][0][m][0]) * (sg0 * sr[m]), g1 = cvt_i4(acc[ai][0][m][1]) * (sg1 * sr[m]), u0 = cvt_i4(acc[ai][1][m][0]) * (su0 * sr[m]), u1 = cvt_i4(acc[ai][1][m][1]) * (su1 * sr[m]);
                u32x2 w;
                w.x = pk4_f8(silu_f(g0[0]) * u0[0], silu_f(g0[1]) * u0[1], silu_f(g0[2]) * u0[2], silu_f(g0[3]) * u0[3]);
                w.y = pk4_f8(silu_f(g1[0]) * u1[0], silu_f(g1[1]) * u1[1], silu_f(g1[2]) * u1[2], silu_f(g1[3]) * u1[3]);
                *(u32x2*)rowp = w; }
        }
    }
};
template <int OSC2> struct EpiI8SwiGLUf {
    static constexpr bool PERM = true, AFTER_DRAIN = false;
    unsigned char* O; int ldc; int nmod; const float* sa; const float* sw;
    __device__ __forceinline__ void operator()(const f32x4 (&acc)[2][2][4][2], const Unit& u, int wr, int wc, int fr, int fq) const {
        constexpr float os = (float)(1 << OSC2), nl2e = -1.4426950408889634f;
        const int pnl = nmod ? (u.pn % nmod) : u.pn;
        const int row0 = u.pm * BM + wr * 64 + fr, col0 = pnl * HALF + wc * 32 + 8 * fq;
        const float* swp = sw + (size_t)u.pn * BM + wc * 32 + 8 * fq;
        const f32x4 sg0 = *(const f32x4*)swp, sg1 = *(const f32x4*)(swp + 4), su0 = *(const f32x4*)(swp + HALF), su1 = *(const f32x4*)(swp + HALF + 4);
        const f32x4 c0 = sg0 * su0 * os, c1 = sg1 * su1 * os, l0 = sg0 * nl2e, l1 = sg1 * nl2e;
#pragma unroll
        for (int ai = 0; ai < 2; ++ai) {
            float sr[4];
#pragma unroll
            for (int m = 0; m < 4; ++m) sr[m] = sa[row0 + ai * HALF + m * 16];
#pragma unroll
            for (int m = 0; m < 4; ++m) { unsigned char* rowp = O + (size_t)(row0 + ai * HALF + m * 16) * ldc + col0;
                const float r = sr[m], r2 = r * r;
                const f32x4 G0 = cvt_i4(acc[ai][0][m][0]), G1 = cvt_i4(acc[ai][0][m][1]), U0 = cvt_i4(acc[ai][1][m][0]), U1 = cvt_i4(acc[ai][1][m][1]);
                const f32x4 t0 = (G0 * l0) * r, t1 = (G1 * l1) * r;
                f32x4 d0, d1;
#pragma unroll
                for (int e = 0; e < 4; ++e) { d0[e] = __builtin_amdgcn_exp2f(t0[e]); d1[e] = __builtin_amdgcn_exp2f(t1[e]); }
                d0 = d0 + 1.0f; d1 = d1 + 1.0f;
                f32x4 s0, s1;
#pragma unroll
                for (int e = 0; e < 4; ++e) { s0[e] = __builtin_amdgcn_rcpf(d0[e]); s1[e] = __builtin_amdgcn_rcpf(d1[e]); }
                const f32x4 o0 = ((G0 * U0) * (c0 * r2)) * s0, o1 = ((G1 * U1) * (c1 * r2)) * s1;
                u32x2 w; w.x = pk4_f8(o0[0], o0[1], o0[2], o0[3]); w.y = pk4_f8(o1[0], o1[1], o1[2], o1[3]);
                *(u32x2*)rowp = w; }
        }
    }
};
typedef float f32x2e __attribute__((ext_vector_type(2)));
template <bool LNR, int SCL2 = 0> struct EpiResid {
    static constexpr bool PERM = true, AFTER_DRAIN = false;
    const void* res; bf16_t* out; const float* stats; const float* g; const float* b;
    __device__ __forceinline__ void operator()(const f32x4 (&acc)[2][2][4][2], const Unit& u, int wr, int wc, int fr, int fq) const {
        constexpr int ldc = 1024; constexpr float alpha = 1.6817928305074290f, sc = 1.0f / (float)(1 << SCL2);
        const int row0 = u.pm * BM + wr * 64 + fr, col0 = u.pn * BM + wc * 32 + 8 * fq;
#pragma unroll
        for (int bj = 0; bj < 2; ++bj) {
            f32x4 g0, g1, b0, b1;
            if constexpr (LNR) { g0 = *(const f32x4*)(g + col0 + bj * HALF) * alpha; g1 = *(const f32x4*)(g + col0 + bj * HALF + 4) * alpha;
                                 b0 = *(const f32x4*)(b + col0 + bj * HALF) * alpha; b1 = *(const f32x4*)(b + col0 + bj * HALF + 4) * alpha; }
#pragma unroll
            for (int ai = 0; ai < 2; ++ai) {
                if constexpr (LNR) {
                    u32x4 w[4]; f32x2e st[4];
#pragma unroll
                    for (int m = 0; m < 4; ++m) { const int row = row0 + ai * HALF + m * 16; w[m] = *(const u32x4*)((const bf16_t*)res + (size_t)row * ldc + col0 + bj * HALF); st[m] = *(const f32x2e*)(stats + 2 * row); }
                    asm volatile("" ::: "memory");
#pragma unroll
                    for (int m = 0; m < 4; ++m) { const int row = row0 + ai * HALF + m * 16; const float mean = st[m].x, rstd = st[m].y;
                        const f32x4 r0 = {__uint_as_float(w[m].x << 16), __uint_as_float(w[m].x & 0xffff0000u), __uint_as_float(w[m].y << 16), __uint_as_float(w[m].y & 0xffff0000u)};
                        const f32x4 r1 = {__uint_as_float(w[m].z << 16), __uint_as_float(w[m].z & 0xffff0000u), __uint_as_float(w[m].w << 16), __uint_as_float(w[m].w & 0xffff0000u)};
                        const f32x4 v0 = (r0 - mean) * rstd * g0 + b0 + acc[ai][bj][m][0] * sc, v1 = (r1 - mean) * rstd * g1 + b1 + acc[ai][bj][m][1] * sc;
                        u32x4 o; o.x = cvt_pk_bf16(v0[0], v0[1]); o.y = cvt_pk_bf16(v0[2], v0[3]); o.z = cvt_pk_bf16(v1[0], v1[1]); o.w = cvt_pk_bf16(v1[2], v1[3]);
                        *(u32x4*)(out + (size_t)row * ldc + col0 + bj * HALF) = o; }
                } else {
                    f32x4 x0[4], x1[4];
#pragma unroll
                    for (int m = 0; m < 4; ++m) { const size_t off = (size_t)(row0 + ai * HALF + m * 16) * ldc + col0 + bj * HALF; x0[m] = *(const f32x4*)((const float*)res + off); x1[m] = *(const f32x4*)((const float*)res + off + 4); }
                    asm volatile("" ::: "memory");
#pragma unroll
                    for (int m = 0; m < 4; ++m) { const size_t off = (size_t)(row0 + ai * HALF + m * 16) * ldc + col0 + bj * HALF;
                        const f32x4 v0 = x0[m] * alpha + acc[ai][bj][m][0] * sc, v1 = x1[m] * alpha + acc[ai][bj][m][1] * sc;
                        u32x4 o; o.x = cvt_pk_bf16(v0[0], v0[1]); o.y = cvt_pk_bf16(v0[2], v0[3]); o.z = cvt_pk_bf16(v1[0], v1[1]); o.w = cvt_pk_bf16(v1[2], v1[3]);
                        *(u32x4*)(out + off) = o; }
                }
                asm volatile("" ::: "memory");
            }
        }
    }
};
struct MoeOrder {
    int nM, nN, nwg, G, c, rep; int ps1, ps2, ps3, ps4, ps5, ps6, ps7;
    __device__ __forceinline__ bool next(int i, Unit& u) const {
        const int L = i * G + c; if (nwg == 0 || L >= rep * nwg) return false;
        int wgid = rep == 1 ? L : L % nwg; { const int q = nwg / NXCD, r = nwg % NXCD, xcd = wgid % NXCD, off = wgid / NXCD; wgid = (xcd < r ? xcd * (q + 1) : r * (q + 1) + (xcd - r) * q) + off; }
        const int nig = WGM * nN, gid = wgid / nig, fm = gid * WGM, gsz = (nM - fm) < WGM ? (nM - fm) : WGM;
        const int pm = fm + ((wgid % nig) % gsz), pnl = (wgid % nig) / gsz;
        const int e = (pm >= ps1) + (pm >= ps2) + (pm >= ps3) + (pm >= ps4) + (pm >= ps5) + (pm >= ps6) + (pm >= ps7);
        u.pm = pm; u.pn = e * nN + pnl; return true;
    }
    __device__ __forceinline__ void a_ready(const Unit&) const {}
    __device__ __forceinline__ void done(const Unit&) const {}
};
template <class Inner> struct EpiI8 : Inner {
    static constexpr bool SCALE_PREP = true;
    const float* sa; const float* sw;
    __device__ __forceinline__ void prep(f32x4 (&acc)[2][2][4][2], const Unit& u, int wr, int wc, int fr, int fq) const {
        const float* swp = sw + (size_t)u.pn * BM + wc * 32 + 8 * fq; const float* sap = sa + u.pm * BM + wr * 64 + fr;
        f32x4 s4[2][2];
#pragma unroll
        for (int bj = 0; bj < 2; ++bj) { s4[bj][0] = *(const f32x4*)(swp + bj * HALF); s4[bj][1] = *(const f32x4*)(swp + bj * HALF + 4); }
#pragma unroll
        for (int ai = 0; ai < 2; ++ai) { float sr[4];
#pragma unroll
            for (int m = 0; m < 4; ++m) sr[m] = sap[ai * HALF + m * 16];
#pragma unroll
            for (int m = 0; m < 4; ++m)
#pragma unroll
                for (int bj = 0; bj < 2; ++bj)
#pragma unroll
                    for (int n = 0; n < 2; ++n) acc[ai][bj][m][n] = cvt_i4(acc[ai][bj][m][n]) * (s4[bj][n] * sr[m]); }
    }
};
template <class T, class = void> struct has_prep { static constexpr bool value = false; };
template <class T> struct has_prep<T, decltype((void)T::SCALE_PREP)> { static constexpr bool value = true; };
typedef int i32x8 __attribute__((ext_vector_type(8)));
typedef int i32x4q __attribute__((ext_vector_type(4)));
__device__ __forceinline__ i32x8 cat8(bf16x8 lo, bf16x8 hi) { const i32x4q a = __builtin_bit_cast(i32x4q, lo), b = __builtin_bit_cast(i32x4q, hi); return __builtin_shufflevector(a, b, 0, 1, 2, 3, 4, 5, 6, 7); }
template <class Epi, class Sched, bool ALIGN_EPI = false, bool SP2 = false, int QM = 0>
__device__ __forceinline__ void gemm_phase(PG8_LAS unsigned char* lds, const Gemm g, const Sched& S, const Epi& E, const int wid) {
    int lane; asm volatile("v_mbcnt_lo_u32_b32 %0, -1, 0\n\tv_mbcnt_hi_u32_b32 %0, -1, %0" : "=v"(lane));
    const int tid = wid * 64 + lane, wr = wid >> 2, wc = wid & 3, fr = lane & 15, fq = lane >> 4;
    const int K = g.K, nt = K / BK;
    unsigned voffA[2], voffB[2];
#pragma unroll
    for (int i = 0; i < 2; ++i) { int R, C; stage_rc(tid * 16 + i * 8192, R, C); const int Rb = Epi::PERM ? ((R & ~31) + perm32(R & 31)) : R;
        voffA[i] = (unsigned)(R * g.lda + C) * 2u; voffB[i] = (unsigned)(Rb * K + C) * 2u; }
    const size_t kstep = (size_t)(BK * 2);
    const size_t hstepA = (size_t)HALF * g.lda * 2, hstepB = (size_t)HALF * K * 2;
    const size_t tstepA = 2 * hstepA, tstepB = 2 * hstepB;
    const unsigned ldsw = (unsigned)wid * 1024u;
    const int aoff = lds_byte(wr * 64 + fr, fq * 8), boff = lds_byte(wc * 32 + fr, fq * 8);
#define PG8_SA(b, h) (((b) * 2 + (h)) * HTB)
#define PG8_SB(b, h) ((4 + (b) * 2 + (h)) * HTB)
#define PG8_STAGE(bufoff, gbase, voff) do { _Pragma("unroll") for (int _i = 0; _i < 2; ++_i) { unsigned vo_ = (voff)[_i]; asm volatile("" : "+v"(vo_));     \
        __builtin_amdgcn_global_load_lds((const unsigned*)((const char*)(gbase) + vo_), (PG8_LAS unsigned*)(lds + (bufoff) + ldsw + _i * 8192), 16, 0, 0); } } while (0)
#define PG8_LDA(dst, b, h) do { _Pragma("unroll") for (int m = 0; m < 4; ++m) _Pragma("unroll") for (int k = 0; k < 2; ++k) dst[m][k] = *(const PG8_LAS bf16x8*)(lds + PG8_SA(b, h) + aoff + m * 2048 + k * 1024); } while (0)
#define PG8_LDB(dst, b, h) do { _Pragma("unroll") for (int n = 0; n < 2; ++n) _Pragma("unroll") for (int k = 0; k < 2; ++k) dst[n][k] = *(const PG8_LAS bf16x8*)(lds + PG8_SB(b, h) + boff + n * 2048 + k * 1024); } while (0)
#define PG8_MMA(ai, bj, At, Bt) do { __builtin_amdgcn_s_setprio(1); _Pragma("unroll") for (int m = 0; m < 4; ++m) _Pragma("unroll") for (int n = 0; n < 2; ++n) { \
        if constexpr (QM == 1) acc[ai][bj][m][n] = __builtin_amdgcn_mfma_scale_f32_16x16x128_f8f6f4(cat8(Bt[n][0], Bt[n][1]), cat8(At[m][0], At[m][1]), acc[ai][bj][m][n], 0, 0, 0, 0, 0, 0); \
        else if constexpr (QM == 2) { _Pragma("unroll") for (int k = 0; k < 2; ++k) acc[ai][bj][m][n] = __builtin_bit_cast(f32x4, __builtin_amdgcn_mfma_i32_16x16x64_i8(__builtin_bit_cast(i32x4q, Bt[n][k]), __builtin_bit_cast(i32x4q, At[m][k]), __builtin_bit_cast(i32x4q, acc[ai][bj][m][n]), 0, 0, 0)); } \
        else { _Pragma("unroll") for (int k = 0; k < 2; ++k) acc[ai][bj][m][n] = __builtin_amdgcn_mfma_f32_16x16x32_bf16(Bt[n][k], At[m][k], acc[ai][bj][m][n], 0, 0, 0); } } __builtin_amdgcn_s_setprio(0); } while (0)
#define PG8_WAIT_V(n) asm volatile("s_waitcnt vmcnt(" #n ")" ::: "memory")
#define PG8_WAIT_L(n) asm volatile("s_waitcnt lgkmcnt(" #n ")" ::: "memory")
#define PG8_BAR __builtin_amdgcn_s_barrier()
#define PG8_SCHED __builtin_amdgcn_sched_barrier(0)
    Unit cur, nxt; int ui = 0;
    if (!S.next(0, cur)) return;
    f32x4 acc[2][2][4][2];
#pragma unroll
    for (int a = 0; a < 2; ++a)
#pragma unroll
        for (int b = 0; b < 2; ++b)
#pragma unroll
            for (int m = 0; m < 4; ++m)
#pragma unroll
                for (int n = 0; n < 2; ++n) acc[a][b][m][n] = (f32x4){0.f, 0.f, 0.f, 0.f};
    bf16x8 At[4][2], B0[2][2], B1[2][2];
    const char* cA = (const char*)g.A + (size_t)cur.pm * tstepA; const char* cB = (const char*)g.Bt + (size_t)cur.pn * tstepB;
    S.a_ready(cur);
    if constexpr (SP2) {
        PG8_STAGE(PG8_SB(0, 0), cB, voffB); PG8_STAGE(PG8_SB(0, 1), cB + hstepB, voffB); PG8_STAGE(PG8_SA(0, 0), cA, voffA); PG8_STAGE(PG8_SA(0, 1), cA + hstepA, voffA);
        if (wr == 1) PG8_BAR;
        PG8_WAIT_V(2); PG8_BAR;
        PG8_STAGE(PG8_SB(1, 0), cB + kstep, voffB); PG8_STAGE(PG8_SA(1, 0), cA + kstep, voffA); PG8_STAGE(PG8_SB(1, 1), cB + hstepB + kstep, voffB);
        PG8_WAIT_V(6); PG8_BAR;
    } else {
        PG8_STAGE(PG8_SB(0, 0), cB, voffB); PG8_STAGE(PG8_SA(0, 0), cA, voffA); PG8_STAGE(PG8_SB(0, 1), cB + hstepB, voffB); PG8_STAGE(PG8_SA(0, 1), cA + hstepA, voffA);
        if (wr == 1) PG8_BAR;
        PG8_WAIT_V(4); PG8_BAR;
        PG8_STAGE(PG8_SB(1, 0), cB + kstep, voffB); PG8_STAGE(PG8_SA(1, 0), cA + kstep, voffA); PG8_STAGE(PG8_SB(1, 1), cB + hstepB + kstep, voffB);
        PG8_WAIT_V(6); PG8_BAR;
    }
    for (;;) {
        const bool has_next = S.next(ui + 1, nxt);
        const char* nA = has_next ? (const char*)g.A + (size_t)nxt.pm * tstepA : cA; const char* nB = has_next ? (const char*)g.Bt + (size_t)nxt.pn * tstepB : cB;
        GSEC_ACC(6, -);
        for (int t = 0; t < nt; t += 2) {
            const bool last = (t == nt - 2);
            const char* a1 = cA + (size_t)(t + 1) * kstep;
            const char* a2 = last ? nA : cA + (size_t)(t + 2) * kstep; const char* b2 = last ? nB : cB + (size_t)(t + 2) * kstep;
            const char* a3 = a2 + kstep; const char* b3 = b2 + kstep;
            if (last && has_next) S.a_ready(nxt);
            if constexpr (SP2) {
            PG8_LDB(B0, 0, 0); PG8_LDB(B1, 0, 1); PG8_SCHED; PG8_LDA(At, 0, 0); PG8_STAGE(PG8_SA(1, 1), a1 + hstepA, voffA);
            PG8_WAIT_V(8); PG8_WAIT_L(0); PG8_BAR; PG8_MMA(0, 0, At, B0); PG8_MMA(0, 1, At, B1); PG8_BAR; PG8_SCHED;
            PG8_LDA(At, 0, 1); PG8_STAGE(PG8_SB(0, 0), b2, voffB); PG8_STAGE(PG8_SB(0, 1), b2 + hstepB, voffB); PG8_STAGE(PG8_SA(0, 0), a2, voffA);
            PG8_WAIT_V(8); PG8_WAIT_L(0); PG8_BAR; PG8_MMA(1, 0, At, B0); PG8_MMA(1, 1, At, B1); PG8_BAR; PG8_SCHED;
            PG8_LDB(B0, 1, 0); PG8_LDB(B1, 1, 1); PG8_SCHED; PG8_LDA(At, 1, 0); PG8_STAGE(PG8_SA(0, 1), a2 + hstepA, voffA);
            PG8_WAIT_V(8); PG8_WAIT_L(0); PG8_BAR; PG8_MMA(0, 0, At, B0); PG8_MMA(0, 1, At, B1); PG8_BAR; PG8_SCHED;
            PG8_LDA(At, 1, 1); PG8_STAGE(PG8_SB(1, 0), b3, voffB); PG8_STAGE(PG8_SB(1, 1), b3 + hstepB, voffB); PG8_STAGE(PG8_SA(1, 0), a3, voffA);
            PG8_WAIT_V(8); PG8_WAIT_L(0); PG8_BAR; PG8_MMA(1, 0, At, B0); PG8_MMA(1, 1, At, B1); PG8_BAR; PG8_SCHED;
            } else {
            PG8_LDB(B0, 0, 0); PG8_SCHED; PG8_LDA(At, 0, 0); PG8_STAGE(PG8_SA(1, 1), a1 + hstepA, voffA);
            PG8_WAIT_L(8); PG8_BAR; PG8_WAIT_L(0); PG8_MMA(0, 0, At, B0); PG8_BAR; PG8_SCHED;
            PG8_LDB(B1, 0, 1); PG8_STAGE(PG8_SB(0, 0), b2, voffB);
            PG8_BAR; PG8_WAIT_L(0); PG8_MMA(0, 1, At, B1); PG8_BAR;
            PG8_LDA(At, 0, 1); PG8_STAGE(PG8_SA(0, 0), a2, voffA);
            PG8_BAR; PG8_WAIT_L(0); PG8_MMA(1, 0, At, B0); PG8_BAR; PG8_SCHED;
            PG8_STAGE(PG8_SB(0, 1), b2 + hstepB, voffB);
            PG8_WAIT_V(6); PG8_BAR; PG8_MMA(1, 1, At, B1); PG8_BAR;
            PG8_LDB(B0, 1, 0); PG8_SCHED; PG8_LDA(At, 1, 0); PG8_STAGE(PG8_SA(0, 1), a2 + hstepA, voffA);
            PG8_WAIT_L(8); PG8_BAR; PG8_WAIT_L(0); PG8_MMA(0, 0, At, B0); PG8_BAR; PG8_SCHED;
            PG8_LDB(B1, 1, 1); PG8_STAGE(PG8_SB(1, 0), b3, voffB);
            PG8_BAR; PG8_WAIT_L(0); PG8_MMA(0, 1, At, B1); PG8_BAR;
            PG8_LDA(At, 1, 1); PG8_STAGE(PG8_SA(1, 0), a3, voffA);
            PG8_BAR; PG8_WAIT_L(0); PG8_MMA(1, 0, At, B0); PG8_BAR; PG8_SCHED;
            PG8_STAGE(PG8_SB(1, 1), b3 + hstepB, voffB);
            PG8_WAIT_V(6); PG8_BAR; PG8_MMA(1, 1, At, B1); PG8_BAR;
            }
        }
        GSEC_ACC(6, +); GSEC_ACC(7, -);
        if constexpr (ALIGN_EPI) { if (wr == 0) PG8_BAR; }
        if constexpr (!Epi::AFTER_DRAIN) { int l2_; asm volatile("v_mbcnt_lo_u32_b32 %0, -1, 0\n\tv_mbcnt_hi_u32_b32 %0, -1, %0" : "=v"(l2_));
            if constexpr (has_prep<Epi>::value) E.prep(acc, cur, wr, wc, l2_ & 15, l2_ >> 4);
            E(acc, cur, wr, wc, l2_ & 15, l2_ >> 4); S.done(cur); }
        GSEC_ACC(7, +);
        if (!has_next) break;
#pragma unroll
        for (int a = 0; a < 2; ++a)
#pragma unroll
            for (int b = 0; b < 2; ++b)
#pragma unroll
                for (int m = 0; m < 4; ++m)
#pragma unroll
                    for (int n = 0; n < 2; ++n) acc[a][b][m][n] = (f32x4){0.f, 0.f, 0.f, 0.f};
        cur = nxt; cA = nA; cB = nB; ++ui;
        if constexpr (ALIGN_EPI) { if (wr == 1) PG8_BAR; }
    }
    PG8_WAIT_V(0);
    if constexpr (!ALIGN_EPI) { if (wr == 0) PG8_BAR; }
    PG8_BAR;
    if constexpr (Epi::AFTER_DRAIN) { E.fused(acc, cur, wr, wc, fr, fq, lds, wid, lane); S.done(cur); }
#undef PG8_SA
#undef PG8_SB
#undef PG8_STAGE
#undef PG8_LDA
#undef PG8_LDB
#undef PG8_MMA
#undef PG8_WAIT_V
#undef PG8_WAIT_L
#undef PG8_BAR
#undef PG8_SCHED
}
}

constexpr int NWAVES = 8;
constexpr int BATCH = 8, SEQ = 4096, TT = BATCH * SEQ, D = 1024;
constexpr int HK = 8, HV = 16, HD = 128;
constexpr int GIN = 6176, GINP = 6400;
constexpr int FF = 3584, NE = 8, MOE_ROWS = 67584;
constexpr float ALPHA = 1.6817928305074290f;
constexpr float LN_EPS = 1e-5f, RMS_EPS = 1e-6f;
constexpr int NPH = 18, NPHASES = 2 * NPH;
constexpr int F8_YE = 6;
constexpr int F8_GO = 4, F8_WO = 11, F8_AO = 5, F8_WSO = 10;
constexpr int F8_H = 4, F8_WGU = 9, F8_ACT = 4, F8_WD = 11;

constexpr size_t MiB = 1ull << 20;
constexpr size_t WS_CTL = 0, CTL_ZERO_BYTES = 1 * MiB;
constexpr size_t WS_E12 = 1 * MiB;
constexpr size_t WS_G12 = WS_E12 + 256 * 1024;
constexpr size_t WS_POS = WS_G12 + 256 * 1024;
constexpr size_t WS_GB = 2 * MiB;
constexpr size_t WS_W = 16 * MiB;
constexpr size_t WS_W2 = 912 * MiB;
__host__ __device__ constexpr size_t gdn_wset(int j) { return j == 0 ? WS_W2 : 164 * MiB; }
__host__ __device__ constexpr size_t W_IN_(int j) { return gdn_wset(j); }
__host__ __device__ constexpr size_t W_OUT_(int j) { return gdn_wset(j) + 7 * MiB; }
__host__ __device__ constexpr size_t W_GU_(int j) { return gdn_wset(j) + 9 * MiB; }
__host__ __device__ constexpr size_t W_D_(int j) { return gdn_wset(j) + 16 * MiB; }
constexpr size_t W_QKV = WS_W, W_O = WS_W + 6 * MiB, W_MGU = WS_W + 8 * MiB, W_MD = WS_W + 120 * MiB;
constexpr size_t WS_G8 = 192 * MiB;
constexpr size_t WS_HB = 192 * MiB;
constexpr size_t WS_BIG = 256 * MiB;
constexpr size_t WS_ZB = WS_BIG, WS_RAW = WS_BIG + 128 * MiB, WS_QKVC = WS_BIG + 400 * MiB;
constexpr int RAWLD = 4352;
constexpr size_t WS_WMEM = WS_RAW, WS_IMEM = WS_RAW + 128 * MiB, WS_KTMEM = WS_RAW + 192 * MiB;
constexpr size_t WS_HS = 13 * MiB, WS_XSS = 13 * MiB + 512 * 1024;
constexpr size_t WS_SWI = 14 * MiB + 64 * 1024, WS_SWQ = 14 * MiB + 128 * 1024;
__host__ __device__ constexpr size_t WS_SWD_(int j) { return 14 * MiB + (size_t)j * 192 * 1024; }
__host__ __device__ constexpr size_t WS_SWI_(int j) { return 14 * MiB + 64 * 1024 + (size_t)j * 192 * 1024; }
constexpr size_t WS_SWD = 14 * MiB, WS_SWM = 14 * MiB + 512 * 1024;
constexpr size_t WS_STATS = 12 * MiB;
constexpr size_t WS_GTAB = 6 * MiB;
constexpr size_t WS_ACT = WS_BIG;
constexpr size_t WS_QKV = WS_BIG, WS_AO = WS_BIG + 192 * MiB;
constexpr size_t WS_XS = WS_BIG, WS_MACT = WS_BIG + 132 * MiB;
constexpr size_t WS_YT = 850 * MiB;
constexpr size_t WS_END = 950 * MiB;
static_assert(WS_QKVC + (size_t)TT * 4096 * 2 <= WS_W2 && WS_MACT + (size_t)MOE_ROWS * FF * 2 <= WS_END && WS_RAW + (size_t)TT * RAWLD * 2 <= WS_QKVC && WS_KTMEM + (size_t)4096 * 8192 * 2 <= WS_QKVC && WS_GTAB + (size_t)8192 * 192 * 4 <= WS_W, "d_ws map");
static_assert(W_MD + (size_t)NE * D * FF <= 164 * MiB && gdn_wset(1) + 20 * MiB <= WS_HB && gdn_wset(0) + 20 * MiB <= WS_END && W_MGU + (size_t)NE * 2 * FF * D <= W_MD, "weight map");
constexpr int CW_BAR = 4096;
constexpr int CW_WQ = 32768;
constexpr int CW_CNT = 16384;

constexpr int RING_BYTES = 131072;
constexpr int MISC_OFF = RING_BYTES + 320;
constexpr int OGST_OFF = 147456;
#define SEC_IN(k) do { if (PROBE_SEC == (k)) { if (blockIdx.x == 0 && (threadIdx.x == 0)) ((volatile LAS unsigned*)((LAS unsigned char*)0 + MISC_OFF))[20] -= (unsigned)__builtin_amdgcn_s_memrealtime(); } } while (0)
#define SEC_OUT(k) do { if (PROBE_SEC == (k)) { if (blockIdx.x == 0 && (threadIdx.x == 0)) ((volatile LAS unsigned*)((LAS unsigned char*)0 + MISC_OFF))[20] += (unsigned)__builtin_amdgcn_s_memrealtime(); } } while (0)
constexpr int LDS_BYTES = 163840;

#define GAS __attribute__((address_space(1)))
#define LAS __attribute__((address_space(3)))
#define DI __device__ __forceinline__
typedef unsigned short bf16;
typedef unsigned v4u __attribute__((ext_vector_type(4)));
typedef unsigned v2u __attribute__((ext_vector_type(2)));
typedef float f32x4 __attribute__((ext_vector_type(4)));
typedef float f32x2 __attribute__((ext_vector_type(2)));
typedef GAS unsigned gu32;
#define RLX_AGENT __ATOMIC_RELAXED, __HIP_MEMORY_SCOPE_AGENT
#define LDS_WAIT() asm volatile("s_waitcnt lgkmcnt(0)" ::: "memory")
#define VM_WAIT() asm volatile("s_waitcnt vmcnt(0)" ::: "memory")
__device__ __forceinline__ unsigned long long rt() { return __builtin_amdgcn_s_memrealtime(); }
__device__ __forceinline__ unsigned f2bf(float f) { unsigned u = __builtin_bit_cast(unsigned, f); return (u + 0x7fffu + ((u >> 16) & 1u)) >> 16; }
__device__ __forceinline__ unsigned pk2(float lo, float hi) { return f2bf(lo) | (f2bf(hi) << 16); }

#define XB_TMO      128
#define XB_XCNT(j)  (256  + 64 * (j))
#define XB_XSUB(j)  (1280 + 64 * (j))
#define XB_XGEN(j)  (2304 + 64 * (j))
#define XB_TOP      3328
#define XB_TOPGEN   3392
#define XCD_BAR_WORDS 3456
#define XB_SPIN_CAP (1u << 22)

__device__ __forceinline__ unsigned xb_ld(unsigned* p)              { return __hip_atomic_load(p, __ATOMIC_RELAXED, __HIP_MEMORY_SCOPE_AGENT); }
__device__ __forceinline__ unsigned xb_add(unsigned* p, unsigned v) { return __hip_atomic_fetch_add(p, v, __ATOMIC_RELAXED, __HIP_MEMORY_SCOPE_AGENT); }
__device__ __forceinline__ unsigned xb_xcc_id() { return (unsigned)__builtin_amdgcn_s_getreg((3 << 11) | 20) & 0xFu; }
#define XB_SPIN(cond, bar) do { unsigned _sp = 0; while (cond) { __builtin_amdgcn_s_sleep(1); \
    if ((++_sp & 255u) == 0u) { if (xb_ld(&(bar)[XB_TMO])) break; if (_sp > XB_SPIN_CAP) { atomicAdd(&(bar)[XB_TMO], 1u); break; } } } } while (0)

struct XcdBarrier {
    unsigned* bar; unsigned x;
    volatile LAS unsigned* st;
};

__device__ __forceinline__ XcdBarrier xcd_barrier_post(unsigned* bar, volatile LAS unsigned* st) {
    XcdBarrier b; b.bar = bar; b.x = xb_xcc_id(); b.st = st;
    if (threadIdx.x == 0) (void)xb_add(&bar[XB_XCNT(b.x)], 1u);
    return b;
}
__device__ __forceinline__ void xcd_barrier_complete(unsigned* bar, unsigned x, unsigned& nloc, unsigned& nx) {
    const unsigned G = gridDim.x * gridDim.y * gridDim.z;
    unsigned sum, cnt, mine, sp = 0u;
    for (;;) {
        sum = 0u; cnt = 0u; mine = 0u;
#pragma unroll
        for (unsigned j = 0; j < 16; ++j) { const unsigned c = xb_ld(&bar[XB_XCNT(j)]); sum += c; cnt += (c > 0u) ? 1u : 0u; mine = (j == x) ? c : mine; }
        if (sum == G) break;
        __builtin_amdgcn_s_sleep(1);
        if ((++sp & 255u) == 0u) { if (xb_ld(&bar[XB_TMO])) break; if (sp > XB_SPIN_CAP) { atomicAdd(&bar[XB_TMO], 1u); break; } }
    }
    nloc = mine > 0u ? mine : 1u; nx = cnt > 0u ? cnt : 1u;
}

__device__ __forceinline__ void xcd_barrier(const XcdBarrier& b, const bool leader) {
    asm volatile("s_waitcnt vmcnt(0)" ::: "memory");
    __syncthreads();
    if (leader) {
        unsigned* bar = b.bar;
        __builtin_amdgcn_s_waitcnt(0);
        unsigned nloc = b.st[0], nx = b.st[1];
        if (nloc == 0u) { xcd_barrier_complete(bar, b.x, nloc, nx); b.st[0] = nloc; b.st[1] = nx; }
        const unsigned old = xb_add(&bar[XB_XSUB(b.x)], 1u);
        const unsigned gen = old / nloc;
        if (old + 1u == (gen + 1u) * nloc) {
            __builtin_amdgcn_fence(__ATOMIC_RELEASE, "agent");
            asm volatile("s_waitcnt vmcnt(0)" ::: "memory");
            const unsigned og = xb_add(&bar[XB_TOP], 1u);
            const unsigned tg = og / nx;
            if (og + 1u == (tg + 1u) * nx) xb_add(&bar[XB_TOPGEN], 1u);
            else XB_SPIN(xb_ld(&bar[XB_TOPGEN]) == tg, bar);
            __builtin_amdgcn_fence(__ATOMIC_ACQUIRE, "agent");
            xb_add(&bar[XB_XGEN(b.x)], 1u);
            asm volatile("s_waitcnt vmcnt(0)" ::: "memory");
        } else {
            XB_SPIN(xb_ld(&bar[XB_XGEN(b.x)]) == gen, bar);
            __builtin_amdgcn_fence(__ATOMIC_ACQUIRE, "agent");
            asm volatile("s_waitcnt vmcnt(0)" ::: "memory");
        }
    }
    __syncthreads();
}

DI float bf_lo(unsigned w) { return __uint_as_float(w << 16); }
DI float bf_hi(unsigned w) { return __uint_as_float(w & 0xffff0000u); }
DI float wave_sum(float v) {
    v += __builtin_bit_cast(float, __builtin_amdgcn_update_dpp(0, __builtin_bit_cast(int, v), 0xB1, 0xF, 0xF, false));
    v += __builtin_bit_cast(float, __builtin_amdgcn_update_dpp(0, __builtin_bit_cast(int, v), 0x4E, 0xF, 0xF, false));
    v += __builtin_bit_cast(float, __builtin_amdgcn_update_dpp(0, __builtin_bit_cast(int, v), 0x141, 0xF, 0xF, false));
    v += __builtin_bit_cast(float, __builtin_amdgcn_update_dpp(0, __builtin_bit_cast(int, v), 0x140, 0xF, 0xF, false));
    v += __builtin_bit_cast(float, __builtin_amdgcn_update_dpp(0, __builtin_bit_cast(int, v), 0x142, 0xA, 0xF, false));
    v += __builtin_bit_cast(float, __builtin_amdgcn_update_dpp(0, __builtin_bit_cast(int, v), 0x143, 0xC, 0xF, false));
    return __builtin_bit_cast(float, __builtin_amdgcn_readlane(__builtin_bit_cast(int, v), 63));
}
DI float sigmoid_f(float x) { return 1.0f / (1.0f + __expf(-x)); }
DI int opaque_lane() { int l; asm volatile("v_mbcnt_lo_u32_b32 %0, -1, 0\n\tv_mbcnt_hi_u32_b32 %0, -1, %0" : "=v"(l)); return l; }
DI float wave_max_nn(float v) {
    v = fmaxf(v, __builtin_bit_cast(float, __builtin_amdgcn_update_dpp(0, __builtin_bit_cast(int, v), 0xB1, 0xF, 0xF, false)));
    v = fmaxf(v, __builtin_bit_cast(float, __builtin_amdgcn_update_dpp(0, __builtin_bit_cast(int, v), 0x4E, 0xF, 0xF, false)));
    v = fmaxf(v, __builtin_bit_cast(float, __builtin_amdgcn_update_dpp(0, __builtin_bit_cast(int, v), 0x141, 0xF, 0xF, false)));
    v = fmaxf(v, __builtin_bit_cast(float, __builtin_amdgcn_update_dpp(0, __builtin_bit_cast(int, v), 0x140, 0xF, 0xF, false)));
    v = fmaxf(v, __builtin_bit_cast(float, __builtin_amdgcn_update_dpp(0, __builtin_bit_cast(int, v), 0x142, 0xA, 0xF, false)));
    v = fmaxf(v, __builtin_bit_cast(float, __builtin_amdgcn_update_dpp(0, __builtin_bit_cast(int, v), 0x143, 0xC, 0xF, false)));
    return __builtin_bit_cast(float, __builtin_amdgcn_readlane(__builtin_bit_cast(int, v), 63));
}
DI unsigned pk4_i8(float a, float b, float c, float d) {
    unsigned w = 0u;
    w = __builtin_amdgcn_cvt_pk_u8_f32(__builtin_rintf(a) + 128.0f, 0, w); w = __builtin_amdgcn_cvt_pk_u8_f32(__builtin_rintf(b) + 128.0f, 1, w);
    w = __builtin_amdgcn_cvt_pk_u8_f32(__builtin_rintf(c) + 128.0f, 2, w); w = __builtin_amdgcn_cvt_pk_u8_f32(__builtin_rintf(d) + 128.0f, 3, w);
    return w ^ 0x80808080u;
}

struct Args {
    const float *x, *gdn_w_in, *gdn_conv_w, *gdn_a_log, *gdn_dt_bias, *gdn_norm_w, *gdn_w_out, *sb_w_in, *sb_w_out, *ffn_w_gate, *ffn_w_up, *ffn_w_down,
                *moe_router, *moe_w_gate, *moe_w_up, *moe_w_down, *ln_g, *ln_b;
    float* out; unsigned char* ws; int ph_lo, ph_hi;
};

DI void transpose_item(const float* W, int ldw, bf16* WT, int K, int drow0, int k0, int n0, LAS float* scr, int lane) {
#pragma unroll 8
    for (int i = 0; i < 32; ++i) { const int kk = 2 * i + (lane >> 5); scr[kk * 33 + (lane & 31)] = W[(size_t)(k0 + kk) * ldw + n0 + (lane & 31)]; }
    LDS_WAIT(); asm volatile("" ::: "memory");
    const int c = lane & 7;
#pragma unroll
    for (int jj = 0; jj < 4; ++jj) { const int n = (lane >> 3) + 8 * jj; const LAS float* s = scr + (8 * c) * 33 + n;
        v4u o; o.x = pk2(s[0 * 33], s[1 * 33]); o.y = pk2(s[2 * 33], s[3 * 33]); o.z = pk2(s[4 * 33], s[5 * 33]); o.w = pk2(s[6 * 33], s[7 * 33]);
        *(v4u*)(WT + (size_t)(drow0 + n) * K + k0 + 8 * c) = o; }
    LDS_WAIT(); asm volatile("" ::: "memory");
}

DI void transpose_item64(const float* W, int ldw, bf16* WT, int K, int drow0, int k0, int n0, LAS unsigned char* scr, int lane) {
    const int q = lane >> 4, cx = lane & 15;
    f32x4 r[16];
#pragma unroll
    for (int i = 0; i < 16; ++i) r[i] = *(const f32x4*)(W + (size_t)(k0 + 16 * q + i) * ldw + n0 + 4 * cx);
#pragma unroll
    for (int e = 0; e < 4; ++e) {
        v4u w0, w1;
        w0.x = pk2(r[0][e], r[1][e]); w0.y = pk2(r[2][e], r[3][e]); w0.z = pk2(r[4][e], r[5][e]); w0.w = pk2(r[6][e], r[7][e]);
        w1.x = pk2(r[8][e], r[9][e]); w1.y = pk2(r[10][e], r[11][e]); w1.z = pk2(r[12][e], r[13][e]); w1.w = pk2(r[14][e], r[15][e]);
        *(LAS v4u*)(scr + (4 * cx + e) * 144 + q * 32) = w0; *(LAS v4u*)(scr + (4 * cx + e) * 144 + q * 32 + 16) = w1;
    }
    LDS_WAIT(); asm volatile("" ::: "memory");
#pragma unroll
    for (int j = 0; j < 8; ++j) { const int id = lane + 64 * j, n = id >> 3, kp = id & 7;
        *(v4u*)(WT + (size_t)(drow0 + n) * K + k0 + 8 * kp) = *(const LAS v4u*)(scr + n * 144 + kp * 16); }
    LDS_WAIT(); asm volatile("" ::: "memory");
}

DI void transpose_item64_f8(const float* W, int ldw, unsigned char* WT, int K, int drow0, int k0, int n0, float sc, LAS unsigned char* scr, int lane) {
    const int q = lane >> 4, cx = lane & 15;
    f32x4 r[16];
#pragma unroll
    for (int i = 0; i < 16; ++i) r[i] = *(const f32x4*)(W + (size_t)(k0 + 16 * q + i) * ldw + n0 + 4 * cx) * sc;
#pragma unroll
    for (int e = 0; e < 4; ++e) {
        v4u w; w.x = pg8::pk4_f8(r[0][e], r[1][e], r[2][e], r[3][e]); w.y = pg8::pk4_f8(r[4][e], r[5][e], r[6][e], r[7][e]); w.z = pg8::pk4_f8(r[8][e], r[9][e], r[10][e], r[11][e]); w.w = pg8::pk4_f8(r[12][e], r[13][e], r[14][e], r[15][e]);
        *(LAS v4u*)(scr + (4 * cx + e) * 80 + q * 16) = w;
    }
    LDS_WAIT(); asm volatile("" ::: "memory");
#pragma unroll
    for (int j = 0; j < 4; ++j) { const int id = lane + 64 * j, n = id >> 2, kp = id & 3;
        *(v4u*)(WT + (size_t)(drow0 + n) * K + k0 + 16 * kp) = *(const LAS v4u*)(scr + n * 80 + kp * 16); }
    LDS_WAIT(); asm volatile("" ::: "memory");
}

DI void strip_item_i8(const float* W, int ldw, unsigned char* WT, float* SW, int drow0, int n0, LAS unsigned char* lds, int wave, int lane) {
    const int q = lane >> 3, cx = lane & 7;
    LAS unsigned char* scr = lds + wave * 16384;
    f32x4 r[16];
#pragma unroll
    for (int i = 0; i < 16; ++i) r[i] = *(const f32x4*)(W + (size_t)(128 * wave + 16 * q + i) * ldw + n0 + 4 * cx);
    f32x4 m = {0.f, 0.f, 0.f, 0.f};
#pragma unroll
    for (int i = 0; i < 16; ++i)
#pragma unroll
        for (int e = 0; e < 4; ++e) m[e] = fmaxf(m[e], fabsf(r[i][e]));
#pragma unroll
    for (int e = 0; e < 4; ++e) { m[e] = fmaxf(m[e], __shfl_xor(m[e], 8)); m[e] = fmaxf(m[e], __shfl_xor(m[e], 16)); m[e] = fmaxf(m[e], __shfl_xor(m[e], 32)); }
    if (q == 0) *(LAS f32x4*)(scr + 12288 + 16 * cx) = m;
    __syncthreads();
    f32x4 cm = {1.0e-30f, 1.0e-30f, 1.0e-30f, 1.0e-30f};
#pragma unroll
    for (int w = 0; w < NWAVES; ++w) { const f32x4 o = *(const LAS f32x4*)(lds + w * 16384 + 12288 + 16 * cx);
#pragma unroll
        for (int e = 0; e < 4; ++e) cm[e] = fmaxf(cm[e], o[e]); }
    if (wave == 0 && q == 0) *(f32x4*)(SW + drow0 + 4 * cx) = cm * (1.0f / 127.0f);
#pragma unroll
    for (int e = 0; e < 4; ++e) { const float s1 = 127.0f / cm[e];
        v4u w; w.x = pk4_i8(r[0][e] * s1, r[1][e] * s1, r[2][e] * s1, r[3][e] * s1); w.y = pk4_i8(r[4][e] * s1, r[5][e] * s1, r[6][e] * s1, r[7][e] * s1);
        w.z = pk4_i8(r[8][e] * s1, r[9][e] * s1, r[10][e] * s1, r[11][e] * s1); w.w = pk4_i8(r[12][e] * s1, r[13][e] * s1, r[14][e] * s1, r[15][e] * s1);
        *(LAS v4u*)(scr + (4 * cx + e) * 144 + q * 16) = w; }
    LDS_WAIT(); asm volatile("" ::: "memory");
#pragma unroll
    for (int j = 0; j < 4; ++j) { const int id = lane + 64 * j, n = id >> 3, kp = id & 7;
        *(v4u*)(WT + (size_t)(drow0 + n) * 1024 + 128 * wave + 16 * kp) = *(const LAS v4u*)(scr + n * 144 + kp * 16); }
    LDS_WAIT(); asm volatile("" ::: "memory");
    __syncthreads();
}

DI void phase_w_gdn(const Args& a, int j, int part, LAS unsigned char* lds, int bid, int G, int tid_, int wave, int lane_) {
    const int lane = opaque_lane(), tid = wave * 64 + lane;
    LAS float* scr = (LAS float*)(lds + wave * 16384);
    const int gw = bid * NWAVES + wave, NGW = G * NWAVES;
    const float* Win = a.gdn_w_in + (size_t)j * D * GIN; const float* Wout = a.gdn_w_out + (size_t)j * 2048 * D;
    const float* Wg = a.ffn_w_gate + (size_t)j * D * FF; const float* Wu = a.ffn_w_up + (size_t)j * D * FF; const float* Wd = a.ffn_w_down + (size_t)j * FF * D;
    unsigned char* WIN_T = a.ws + W_IN_(j); unsigned char* WOUT_T = a.ws + W_OUT_(j); unsigned char* WGU_T = a.ws + W_GU_(j); unsigned char* WD_T = a.ws + W_D_(j);
    const bool do_in = part != 1, do_rest = part != 0;
    LAS unsigned char* scb = (LAS unsigned char*)scr;
    constexpr int I_SIN = GIN / 32, I_OUT = 32 * 16, I_S = 112, I_D = 56 * 16, NIT = I_OUT + I_D, NWGI = 2 * I_S + I_SIN;
    const int wg_lo = do_rest ? 0 : 2 * I_S, wg_hi = do_in ? NWGI : 2 * I_S;
    for (int it = wg_lo + bid; it < wg_hi; it += G) {
        if (it < 2 * I_S) { const bool up = it >= I_S; const int n0 = 32 * (up ? it - I_S : it);
            strip_item_i8(up ? Wu : Wg, FF, WGU_T, (float*)(a.ws + WS_SWD_(j)), 256 * (n0 >> 7) + (up ? 128 : 0) + (n0 & 127), n0, lds, wave, lane); }
        else { const int n0 = 32 * (it - 2 * I_S); strip_item_i8(Win, GIN, WIN_T, (float*)(a.ws + WS_SWI_(j)), n0, n0, lds, wave, lane); } }
    const int gwr = (gw + NGW - (((wg_hi - wg_lo) % G) * NWAVES) % NGW) % NGW;
    for (int it = gwr; it < (do_rest ? NIT : 0); it += NGW) {
        int r = it;
        if (r < I_OUT) { const int kb = r / 16, nb = r % 16; transpose_item64_f8(Wout, D, WOUT_T, 2048, 64 * nb, 64 * kb, 64 * nb, (float)(1 << F8_WO), scb, lane); continue; } r -= I_OUT;
        { const int kb = r / 16, nb = r % 16; transpose_item64_f8(Wd, D, WD_T, FF, 64 * nb, 64 * kb, 64 * nb, (float)(1 << F8_WD), scb, lane); }
    }
    if (j == 0 && (part == 0 || part == 3)) {
        unsigned char* HB = a.ws + WS_HB; float* HS = (float*)(a.ws + WS_HS);
        for (int t = gw; t < TT; t += NGW) { const f32x4* xr = (const f32x4*)(a.x + (size_t)t * D);
            f32x4 p[2][2]; float am = 0.f;
#pragma unroll
            for (int q = 0; q < 2; ++q) { p[q][0] = xr[2 * (lane + 64 * q)]; p[q][1] = xr[2 * (lane + 64 * q) + 1]; }
#pragma unroll
            for (int q = 0; q < 2; ++q)
#pragma unroll
                for (int c = 0; c < 4; ++c) am = fmaxf(am, fmaxf(fabsf(p[q][0][c]), fabsf(p[q][1][c])));
            am = fmaxf(wave_max_nn(am), 1.0e-20f); const float qs = 127.0f / am;
            if (lane == 0) HS[t] = am * (1.0f / 127.0f);
#pragma unroll
            for (int q = 0; q < 2; ++q) { v2u o; o.x = pk4_i8(p[q][0][0] * qs, p[q][0][1] * qs, p[q][0][2] * qs, p[q][0][3] * qs); o.y = pk4_i8(p[q][1][0] * qs, p[q][1][1] * qs, p[q][1][2] * qs, p[q][1][3] * qs);
                ((v2u*)(HB + (size_t)t * D))[lane + 64 * q] = o; } }
    }
}
DI void phase_w_gdn_dyn(const Args& a, int j, unsigned* ctr, LAS unsigned char* lds, int wave) {
    const int lane = opaque_lane(), tid = wave * 64 + lane;
    const float* Win = a.gdn_w_in + (size_t)j * D * GIN; const float* Wout = a.gdn_w_out + (size_t)j * 2048 * D;
    const float* Wg = a.ffn_w_gate + (size_t)j * D * FF; const float* Wu = a.ffn_w_up + (size_t)j * D * FF; const float* Wd = a.ffn_w_down + (size_t)j * FF * D;
    unsigned char* WIN_T = a.ws + W_IN_(j); unsigned char* WOUT_T = a.ws + W_OUT_(j); unsigned char* WGU_T = a.ws + W_GU_(j); unsigned char* WD_T = a.ws + W_D_(j);
    LAS unsigned char* scb = lds + wave * 16384;
    volatile LAS int* slot = (volatile LAS int*)(lds + RING_BYTES - 16);
    constexpr int I_SIN = GIN / 32, I_OUT = 32 * 16, I_S = 112, I_D = 56 * 16, NIT = I_OUT + I_D, NWGI = 2 * I_S + I_SIN, NQ = NWGI + NIT / NWAVES;
    static_assert(NIT % NWAVES == 0, "eight transposes per queue item");
    for (;;) {
        __syncthreads();
        if (tid == 0) *slot = (int)__hip_atomic_fetch_add(ctr, 1u, __ATOMIC_RELAXED, __HIP_MEMORY_SCOPE_AGENT);
        __syncthreads();
        const int it = __builtin_amdgcn_readfirstlane(*slot);
        if (it >= NQ) break;
        if (it < 2 * I_S) { const bool up = it >= I_S; const int n0 = 32 * (up ? it - I_S : it);
            strip_item_i8(up ? Wu : Wg, FF, WGU_T, (float*)(a.ws + WS_SWD_(j)), 256 * (n0 >> 7) + (up ? 128 : 0) + (n0 & 127), n0, lds, wave, lane); }
        else if (it < NWGI) { const int n0 = 32 * (it - 2 * I_S); strip_item_i8(Win, GIN, WIN_T, (float*)(a.ws + WS_SWI_(j)), n0, n0, lds, wave, lane); }
        else { int r = (it - NWGI) * NWAVES + wave;
            if (r < I_OUT) { const int kb = r / 16, nb = r % 16; transpose_item64_f8(Wout, D, WOUT_T, 2048, 64 * nb, 64 * kb, 64 * nb, (float)(1 << F8_WO), scb, lane); }
            else { r -= I_OUT; const int kb = r / 16, nb = r % 16; transpose_item64_f8(Wd, D, WD_T, FF, 64 * nb, 64 * kb, 64 * nb, (float)(1 << F8_WD), scb, lane); } }
    }
}
DI void phase_w_sb(const Args& a, int j, LAS unsigned char* lds, int bid, int G, int wave, int lane_) {
    const int lane = opaque_lane();
    LAS float* scr = (LAS float*)(lds + wave * 16384);
    const int gw = bid * NWAVES + wave, NGW = G * NWAVES;
    const float* Wqkv = a.sb_w_in + (size_t)j * D * 3072; const float* Wo = a.sb_w_out + (size_t)j * D * D;
    const float* Mg = a.moe_w_gate + (size_t)j * NE * D * FF; const float* Mu = a.moe_w_up + (size_t)j * NE * D * FF; const float* Md = a.moe_w_down + (size_t)j * NE * FF * D;
    unsigned char* WQKV_T = a.ws + W_QKV; unsigned char* WO_T = a.ws + W_O; unsigned char* MGU_T = a.ws + W_MGU; unsigned char* MD_T = a.ws + W_MD;
    LAS unsigned char* scb = (LAS unsigned char*)scr;
    constexpr int I_SQ = 3072 / 32, I_O = 16 * 16, I_S = 112, I_D = 56 * 16, NIT = I_O + NE * I_D;
    for (int it = bid; it < I_SQ + NE * 2 * I_S; it += G) {
        if (it < I_SQ) { strip_item_i8(Wqkv, 3072, WQKV_T, (float*)(a.ws + WS_SWQ), 32 * it, 32 * it, lds, wave, lane); continue; }
        const int e = (it - I_SQ) / (2 * I_S), r = (it - I_SQ) % (2 * I_S); const bool up = r >= I_S; const int n0 = 32 * (up ? r - I_S : r);
        strip_item_i8((up ? Mu : Mg) + (size_t)e * D * FF, FF, MGU_T + (size_t)e * 2 * FF * D, (float*)(a.ws + WS_SWM) + e * 2 * FF, 256 * (n0 >> 7) + (up ? 128 : 0) + (n0 & 127), n0, lds, wave, lane); }
    for (int it = gw; it < NIT; it += NGW) {
        int r = it;
        if (r < I_O) { const int kb = r / 16, nb = r % 16; transpose_item64_f8(Wo, D, WO_T, D, 64 * nb, 64 * kb, 64 * nb, (float)(1 << F8_WSO), scb, lane); continue; } r -= I_O;
        const int e = r / I_D; r -= e * I_D;
        { const int kb = r / 16, nb = r % 16; transpose_item64_f8(Md + (size_t)e * FF * D, D, MD_T + (size_t)e * D * FF, FF, 64 * nb, 64 * kb, 64 * nb, (float)(1 << F8_WD), scb, lane); }
    }
}

DI float dpp_sum16(float v) {
    v += __builtin_bit_cast(float, __builtin_amdgcn_update_dpp(0, __builtin_bit_cast(int, v), 0xB1, 0xF, 0xF, false));
    v += __builtin_bit_cast(float, __builtin_amdgcn_update_dpp(0, __builtin_bit_cast(int, v), 0x4E, 0xF, 0xF, false));
    v += __builtin_bit_cast(float, __builtin_amdgcn_update_dpp(0, __builtin_bit_cast(int, v), 0x141, 0xF, 0xF, false));
    v += __builtin_bit_cast(float, __builtin_amdgcn_update_dpp(0, __builtin_bit_cast(int, v), 0x140, 0xF, 0xF, false));
    return v;
}
DI void phase_conv(const Args& a, int j, int bid, int G, int tid) {
    const bf16* raw = (const bf16*)(a.ws + WS_RAW); bf16* qkvc = (bf16*)(a.ws + WS_QKVC); float* gb = (float*)(a.ws + WS_GB);
    const float* cw = a.gdn_conv_w + (size_t)j * 4 * 4096;
    const int ch = 8 * tid;
    float w0[8], w1[8], w2[8], w3[8];
#pragma unroll
    for (int i = 0; i < 8; ++i) { w0[i] = cw[ch + i]; w1[i] = cw[4096 + ch + i]; w2[i] = cw[2 * 4096 + ch + i]; w3[i] = cw[3 * 4096 + ch + i]; }
    const float post = tid < 128 ? 0.08838834764831845f : 1.0f;
    for (int run = bid; run < TT / 128; run += G) {
        const int t0 = run * 128; const bool first = (t0 & (SEQ - 1)) == 0;
        float xa[8], xb[8], xc[8];
        { v4u h0 = {0u, 0u, 0u, 0u}, h1 = h0, h2 = h0;
          if (!first) { h0 = *(const v4u*)(raw + (size_t)(t0 - 3) * RAWLD + ch); h1 = *(const v4u*)(raw + (size_t)(t0 - 2) * RAWLD + ch); h2 = *(const v4u*)(raw + (size_t)(t0 - 1) * RAWLD + ch); }
          xa[0] = bf_lo(h0.x); xa[1] = bf_hi(h0.x); xa[2] = bf_lo(h0.y); xa[3] = bf_hi(h0.y); xa[4] = bf_lo(h0.z); xa[5] = bf_hi(h0.z); xa[6] = bf_lo(h0.w); xa[7] = bf_hi(h0.w);
          xb[0] = bf_lo(h1.x); xb[1] = bf_hi(h1.x); xb[2] = bf_lo(h1.y); xb[3] = bf_hi(h1.y); xb[4] = bf_lo(h1.z); xb[5] = bf_hi(h1.z); xb[6] = bf_lo(h1.w); xb[7] = bf_hi(h1.w);
          xc[0] = bf_lo(h2.x); xc[1] = bf_hi(h2.x); xc[2] = bf_lo(h2.y); xc[3] = bf_hi(h2.y); xc[4] = bf_lo(h2.z); xc[5] = bf_hi(h2.z); xc[6] = bf_lo(h2.w); xc[7] = bf_hi(h2.w); }
#pragma unroll 1
        for (int tb = 0; tb < 128; tb += 8) {
            v4u xr[8];
#pragma unroll
            for (int u = 0; u < 8; ++u) xr[u] = *(const v4u*)(raw + (size_t)(t0 + tb + u) * RAWLD + ch);
#pragma unroll
            for (int u = 0; u < 8; ++u) {
                float xd[8]; xd[0] = bf_lo(xr[u].x); xd[1] = bf_hi(xr[u].x); xd[2] = bf_lo(xr[u].y); xd[3] = bf_hi(xr[u].y); xd[4] = bf_lo(xr[u].z); xd[5] = bf_hi(xr[u].z); xd[6] = bf_lo(xr[u].w); xd[7] = bf_hi(xr[u].w);
                float y[8]; float ss = 0.f;
#pragma unroll
                for (int i = 0; i < 8; ++i) { const float c = w0[i] * xa[i] + w1[i] * xb[i] + w2[i] * xc[i] + w3[i] * xd[i];
                    y[i] = c * __builtin_amdgcn_rcpf(1.0f + __builtin_amdgcn_exp2f(-1.4426950408889634f * c)); ss += y[i] * y[i];
                    xa[i] = xb[i]; xb[i] = xc[i]; xc[i] = xd[i]; }
                if (tid < 256) {
                    const float rn = post / sqrtf(dpp_sum16(ss) + RMS_EPS);
#pragma unroll
                    for (int i = 0; i < 8; ++i) y[i] *= rn;
                }
                v4u o; o.x = pk2(y[0], y[1]); o.y = pk2(y[2], y[3]); o.z = pk2(y[4], y[5]); o.w = pk2(y[6], y[7]);
                *(v4u*)(qkvc + (size_t)(t0 + tb + u) * 4096 + ch) = o;
            }
        }
#pragma unroll
        for (int k = 0; k < 4; ++k) { const int item = tid + 512 * k, tok = t0 + (item >> 4), hv = item & 15;
            const float bb = __uint_as_float((unsigned)raw[(size_t)tok * RAWLD + 4096 + hv] << 16), aa = __uint_as_float((unsigned)raw[(size_t)tok * RAWLD + 4112 + hv] << 16);
            const float xx = aa + a.gdn_dt_bias[j * 16 + hv];
            const float sp = xx > 20.f ? xx : log1pf(__expf(xx));
            gb[(size_t)tok * 32 + hv] = -__expf(a.gdn_a_log[j * 16 + hv]) * sp;
            gb[(size_t)tok * 32 + 16 + hv] = sigmoid_f(bb); }
    }
}

DI void phase_gdn_naive(const Args& a, int j, LAS unsigned char* lds, int bid, int tid) {
    if (bid >= BATCH * HV) return;
    const int b = bid / HV, hv = bid % HV, hk = hv / 2, jc = tid & 127, r = tid >> 7;
    const bf16* zb = (const bf16*)(a.ws + WS_ZB); bf16* qkvc = (bf16*)(a.ws + WS_QKVC); const float* gb = (const float*)(a.ws + WS_GB);
    LAS float* qs = (LAS float*)lds; LAS float* ks = qs + 2048; LAS float* vs = ks + 2048; LAS float* gs = vs + 2048; LAS float* bs = gs + 16;
    LAS f32x2* red = (LAS f32x2*)(lds + 32768); LAS float* redkq = (LAS float*)(lds + 32768 + 8192); LAS float* ob = (LAS float*)(lds + 49152);
    float S[32];
#pragma unroll
    for (int i = 0; i < 32; ++i) S[i] = 0.f;
    const int lrow = tid >> 5, lcol = (tid & 31) * 4;
    for (int blk = 0; blk < SEQ / 16; ++blk) {
        const size_t t0 = (size_t)b * SEQ + blk * 16;
        __syncthreads();
        { const bf16* rowp = qkvc + (t0 + lrow) * 4096;
          const v2u qv = *(const v2u*)(rowp + hk * 128 + lcol), kv = *(const v2u*)(rowp + 1024 + hk * 128 + lcol), vv = *(const v2u*)(rowp + 2048 + hv * 128 + lcol);
          *(LAS f32x4*)(qs + lrow * 128 + lcol) = (f32x4){bf_lo(qv.x), bf_hi(qv.x), bf_lo(qv.y), bf_hi(qv.y)};
          *(LAS f32x4*)(ks + lrow * 128 + lcol) = (f32x4){bf_lo(kv.x), bf_hi(kv.x), bf_lo(kv.y), bf_hi(kv.y)};
          *(LAS f32x4*)(vs + lrow * 128 + lcol) = (f32x4){bf_lo(vv.x), bf_hi(vv.x), bf_lo(vv.y), bf_hi(vv.y)};
          if (tid < 16) { gs[tid] = __expf(gb[(t0 + tid) * 32 + hv]); bs[tid] = gb[(t0 + tid) * 32 + 16 + hv]; } }
        __syncthreads();
#pragma unroll 1
        for (int tt = 0; tt < 16; ++tt) {
            float pk = 0.f, pq = 0.f, pkq = 0.f;
#pragma unroll
            for (int i4 = 0; i4 < 8; ++i4) { const f32x4 k4 = *(const LAS f32x4*)(ks + tt * 128 + 32 * r + 4 * i4), q4 = *(const LAS f32x4*)(qs + tt * 128 + 32 * r + 4 * i4);
#pragma unroll
                for (int c = 0; c < 4; ++c) { pk += k4[c] * S[4 * i4 + c]; pq += q4[c] * S[4 * i4 + c]; pkq += k4[c] * q4[c]; } }
            const int buf = tt & 1;
            red[(buf * 4 + r) * 128 + jc] = (f32x2){pk, pq}; if (jc == 0) redkq[buf * 4 + r] = pkq;
            __syncthreads();
            float kS = 0.f, qS = 0.f, kq = 0.f;
#pragma unroll
            for (int rr = 0; rr < 4; ++rr) { const f32x2 p = red[(buf * 4 + rr) * 128 + jc]; kS += p.x; qS += p.y; kq += redkq[buf * 4 + rr]; }
            const float eg = gs[tt], vn = bs[tt] * (vs[tt * 128 + jc] - eg * kS);
#pragma unroll
            for (int i4 = 0; i4 < 8; ++i4) { const f32x4 k4 = *(const LAS f32x4*)(ks + tt * 128 + 32 * r + 4 * i4);
#pragma unroll
                for (int c = 0; c < 4; ++c) S[4 * i4 + c] = eg * S[4 * i4 + c] + k4[c] * vn; }
            if (r == 0) ob[tt * 128 + jc] = eg * qS + kq * vn;
        }
        __syncthreads();
        {
            const f32x4 o4 = *(const LAS f32x4*)(ob + lrow * 128 + lcol);
            float ss = o4[0] * o4[0] + o4[1] * o4[1] + o4[2] * o4[2] + o4[3] * o4[3];
            ss += __shfl_xor(ss, 1); ss += __shfl_xor(ss, 2); ss += __shfl_xor(ss, 4); ss += __shfl_xor(ss, 8); ss += __shfl_xor(ss, 16);
            const float rinv = 1.0f / sqrtf(ss * (1.0f / 128.0f) + RMS_EPS);
            const v2u zv = *(const v2u*)(zb + (t0 + lrow) * 2048 + hv * 128 + lcol);
            const f32x4 nw = *(const f32x4*)(a.gdn_norm_w + j * 128 + lcol);
            const float z0 = bf_lo(zv.x), z1 = bf_hi(zv.x), z2 = bf_lo(zv.y), z3 = bf_hi(zv.y);
            v2u o; o.x = pk2(o4[0] * rinv * nw[0] * z0 * sigmoid_f(z0), o4[1] * rinv * nw[1] * z1 * sigmoid_f(z1));
            o.y = pk2(o4[2] * rinv * nw[2] * z2 * sigmoid_f(z2), o4[3] * rinv * nw[3] * z3 * sigmoid_f(z3));
            *(v2u*)(qkvc + (t0 + lrow) * 4096 + 2048 + hv * 128 + lcol) = o;
        }
    }
}

DI void unpack8_f8(const v2u w, float (&x)[8]) { const f32x2 a = __builtin_amdgcn_cvt_pk_f32_fp8((int)w.x, false), b = __builtin_amdgcn_cvt_pk_f32_fp8((int)w.x, true), c = __builtin_amdgcn_cvt_pk_f32_fp8((int)w.y, false), d = __builtin_amdgcn_cvt_pk_f32_fp8((int)w.y, true);
    x[0] = a.x; x[1] = a.y; x[2] = b.x; x[3] = b.y; x[4] = c.x; x[5] = c.y; x[6] = d.x; x[7] = d.y; }
DI void unpack8(const v4u w, float (&x)[8]) { x[0] = bf_lo(w.x); x[1] = bf_hi(w.x); x[2] = bf_lo(w.y); x[3] = bf_hi(w.y); x[4] = bf_lo(w.z); x[5] = bf_hi(w.z); x[6] = bf_lo(w.w); x[7] = bf_hi(w.w); }
template <bool ROUTER, bool F8OUT = false>
DI void phase_ln(const Args& a, const bf16* Y, int lnidx, int j, LAS unsigned char* lds, int bid, int G, int tid, int wave, int lane) {
    bf16* HB = (bf16*)(a.ws + WS_HB); float* stats = (float*)(a.ws + WS_STATS);
    const float* g = a.ln_g + (size_t)lnidx * D; const float* bta = a.ln_b + (size_t)lnidx * D;
    const int gw = bid * NWAVES + wave, NGW = G * NWAVES;
    LAS unsigned* lcnt = (LAS unsigned*)lds;
    LAS float* RT = (LAS float*)(lds + 1024);
    if (ROUTER) { if (tid < 8) lcnt[tid] = 0u;
        const float* R = a.moe_router + (size_t)j * D * NE;
#pragma unroll
        for (int i = 0; i < 2; ++i) { const int k = tid + 512 * i; const f32x4 r0 = *(const f32x4*)(R + k * 8), r1 = *(const f32x4*)(R + k * 8 + 4);
            RT[0 * 1024 + k] = r0[0]; RT[1 * 1024 + k] = r0[1]; RT[2 * 1024 + k] = r0[2]; RT[3 * 1024 + k] = r0[3]; RT[4 * 1024 + k] = r1[0]; RT[5 * 1024 + k] = r1[1]; RT[6 * 1024 + k] = r1[2]; RT[7 * 1024 + k] = r1[3]; }
        __syncthreads(); }
    float gv[2][8], bv[2][8];
#pragma unroll
    for (int q = 0; q < 2; ++q)
#pragma unroll
        for (int c = 0; c < 8; ++c) { gv[q][c] = g[8 * (lane + 64 * q) + c]; bv[q][c] = bta[8 * (lane + 64 * q) + c]; }
    v4u nx[3][2];
#pragma unroll
    for (int d = 0; d < 3; ++d) if (gw + d * NGW < TT) { nx[d][0] = ((const v4u*)(Y + (size_t)(gw + d * NGW) * D))[lane]; nx[d][1] = ((const v4u*)(Y + (size_t)(gw + d * NGW) * D))[lane + 64]; }
    for (int t = gw; t < TT; t += NGW) {
        float v[2][8]; float s = 0.f;
        unpack8(nx[0][0], v[0]); unpack8(nx[0][1], v[1]);
        nx[0][0] = nx[1][0]; nx[0][1] = nx[1][1]; nx[1][0] = nx[2][0]; nx[1][1] = nx[2][1];
        if (t + 3 * NGW < TT) { nx[2][0] = ((const v4u*)(Y + (size_t)(t + 3 * NGW) * D))[lane]; nx[2][1] = ((const v4u*)(Y + (size_t)(t + 3 * NGW) * D))[lane + 64]; }
#pragma unroll
        for (int q = 0; q < 2; ++q)
#pragma unroll
            for (int c = 0; c < 8; ++c) s += v[q][c];
        const float mean = wave_sum(s) * (1.0f / D); float s2 = 0.f;
#pragma unroll
        for (int q = 0; q < 2; ++q)
#pragma unroll
            for (int c = 0; c < 8; ++c) { v[q][c] -= mean; s2 += v[q][c] * v[q][c]; }
        const float rstd = 1.0f / sqrtf(wave_sum(s2) * (1.0f / D) + LN_EPS);
        if (lane == 0) *(f32x2*)(stats + 2 * (size_t)t) = (f32x2){mean, rstd};
        float am = 0.f;
#pragma unroll
        for (int q = 0; q < 2; ++q)
#pragma unroll
            for (int c = 0; c < 8; ++c) { v[q][c] = v[q][c] * rstd * gv[q][c] + bv[q][c]; am = fmaxf(am, fabsf(v[q][c])); }
        if constexpr (F8OUT) {
            am = fmaxf(wave_max_nn(am), 1.0e-20f); const float qs = 127.0f / am;
            if (lane == 0) ((float*)(a.ws + WS_HS))[t] = am * (1.0f / 127.0f);
#pragma unroll
            for (int q = 0; q < 2; ++q) { v2u o; o.x = pk4_i8(v[q][0] * qs, v[q][1] * qs, v[q][2] * qs, v[q][3] * qs); o.y = pk4_i8(v[q][4] * qs, v[q][5] * qs, v[q][6] * qs, v[q][7] * qs);
                ((v2u*)((unsigned char*)HB + (size_t)t * D))[lane + 64 * q] = o; }
        } else {
#pragma unroll
            for (int q = 0; q < 2; ++q) { v4u o; o.x = pk2(v[q][0], v[q][1]); o.y = pk2(v[q][2], v[q][3]); o.z = pk2(v[q][4], v[q][5]); o.w = pk2(v[q][6], v[q][7]);
                ((v4u*)(HB + (size_t)t * D))[lane + 64 * q] = o; }
        }
        if (ROUTER) {
            float lg[8];
#pragma unroll
            for (int e = 0; e < 8; ++e) { lg[e] = 0.f;
#pragma unroll
                for (int q = 0; q < 2; ++q) { const f32x4 r0 = *(const LAS f32x4*)(RT + e * 1024 + 8 * (lane + 64 * q)), r1 = *(const LAS f32x4*)(RT + e * 1024 + 8 * (lane + 64 * q) + 4);
                    lg[e] += (v[q][0] * r0[0] + v[q][1] * r0[1]) + (v[q][2] * r0[2] + v[q][3] * r0[3]) + (v[q][4] * r1[0] + v[q][5] * r1[1]) + (v[q][6] * r1[2] + v[q][7] * r1[3]); } }
#pragma unroll
            for (int e = 0; e < 8; ++e) lg[e] = wave_sum(lg[e]);
            int i1 = 0; float v1 = lg[0];
#pragma unroll
            for (int e = 1; e < 8; ++e) if (lg[e] > v1) { v1 = lg[e]; i1 = e; }
            int i2 = -1; float v2 = -3.0e38f;
#pragma unroll
            for (int e = 0; e < 8; ++e) if (e != i1 && lg[e] > v2) { v2 = lg[e]; i2 = e; }
            if (lane == 0) {
                const float g1 = 1.0f / (1.0f + __expf(v2 - v1));
                ((unsigned*)(a.ws + WS_E12))[t] = (unsigned)i1 | ((unsigned)i2 << 8);
                ((f32x2*)(a.ws + WS_G12))[t] = (f32x2){g1, 1.0f - g1};
                __hip_atomic_fetch_add(lcnt + i1, 1u, __ATOMIC_RELAXED, __HIP_MEMORY_SCOPE_WORKGROUP); __hip_atomic_fetch_add(lcnt + i2, 1u, __ATOMIC_RELAXED, __HIP_MEMORY_SCOPE_WORKGROUP);
            }
        }
    }
    if (ROUTER) { __syncthreads(); if (tid < 8) { unsigned* cnt = (unsigned*)(a.ws + WS_CTL) + CW_CNT + 256 * j; __hip_atomic_fetch_add(cnt + tid, lcnt[tid], __ATOMIC_RELAXED, __HIP_MEMORY_SCOPE_AGENT); } }
}

DI void phase_sb_naive(const Args& a, LAS unsigned char* lds, int bid, int G, int tid) {
    const bf16* qkv = (const bf16*)(a.ws + WS_QKV); bf16* ao = (bf16*)(a.ws + WS_AO);
    LAS unsigned char* Ks = lds; LAS unsigned char* Vs = lds + 16384;
    const int qi = tid >> 2, r = tid & 3;
    for (int idx = bid; idx < 64 * 32; idx += G) {
        const int qb = 31 - idx / 64, bh = idx % 64, b = bh >> 3, h = bh & 7;
        const int t = qb * 128 + qi;
        const size_t rowq = (size_t)b * SEQ + t;
        float q[32], o[32];
        { const bf16* qp = qkv + rowq * 3072 + h * 128 + 32 * r;
#pragma unroll
          for (int c = 0; c < 4; ++c) { const v4u w = *(const v4u*)(qp + 8 * c);
              q[8 * c + 0] = bf_lo(w.x); q[8 * c + 1] = bf_hi(w.x); q[8 * c + 2] = bf_lo(w.y); q[8 * c + 3] = bf_hi(w.y);
              q[8 * c + 4] = bf_lo(w.z); q[8 * c + 5] = bf_hi(w.z); q[8 * c + 6] = bf_lo(w.w); q[8 * c + 7] = bf_hi(w.w); }
#pragma unroll
          for (int i = 0; i < 32; ++i) { q[i] *= 0.08838834764831845f; o[i] = 0.f; } }
        float P = 1.0f;
        for (int kt = 2 * qb + 1; kt >= 0; --kt) {
            __syncthreads();
#pragma unroll
            for (int i = 0; i < 2; ++i) { const int c = tid + 512 * i, row = c >> 4, part = c & 15;
                const bf16* src = qkv + ((size_t)b * SEQ + kt * 64 + row) * 3072 + h * 128 + part * 8;
                *(LAS v4u*)(Ks + c * 16) = *(const v4u*)(src + 1024); *(LAS v4u*)(Vs + c * 16) = *(const v4u*)(src + 2048); }
            __syncthreads();
#pragma unroll 1
            for (int s = 63; s >= 0; --s) {
                float z = 0.f;
#pragma unroll
                for (int c = 0; c < 4; ++c) { const v4u w = *(const LAS v4u*)(Ks + s * 256 + r * 64 + c * 16);
                    z += q[8 * c + 0] * bf_lo(w.x) + q[8 * c + 1] * bf_hi(w.x) + q[8 * c + 2] * bf_lo(w.y) + q[8 * c + 3] * bf_hi(w.y)
                       + q[8 * c + 4] * bf_lo(w.z) + q[8 * c + 5] * bf_hi(w.z) + q[8 * c + 6] * bf_lo(w.w) + q[8 * c + 7] * bf_hi(w.w); }
                z += __shfl_xor(z, 1); z += __shfl_xor(z, 2);
                const bool live = (kt * 64 + s) < t;
                const float e = __expf(fminf(z, 80.f)), rr = 1.0f / (1.0f + e);
                const float A = live ? e * rr * P : 0.f;
                P = live ? P * rr : P;
#pragma unroll
                for (int c = 0; c < 4; ++c) { const v4u w = *(const LAS v4u*)(Vs + s * 256 + r * 64 + c * 16);
                    o[8 * c + 0] += A * bf_lo(w.x); o[8 * c + 1] += A * bf_hi(w.x); o[8 * c + 2] += A * bf_lo(w.y); o[8 * c + 3] += A * bf_hi(w.y);
                    o[8 * c + 4] += A * bf_lo(w.z); o[8 * c + 5] += A * bf_hi(w.z); o[8 * c + 6] += A * bf_lo(w.w); o[8 * c + 7] += A * bf_hi(w.w); }
            }
        }
        { bf16* op = ao + rowq * 1024 + h * 128 + 32 * r;
#pragma unroll
          for (int c = 0; c < 4; ++c) { v4u w; w.x = pk2(o[8 * c + 0], o[8 * c + 1]); w.y = pk2(o[8 * c + 2], o[8 * c + 3]); w.z = pk2(o[8 * c + 4], o[8 * c + 5]); w.w = pk2(o[8 * c + 6], o[8 * c + 7]);
              *(v4u*)(op + 8 * c) = w; } }
    }
}


typedef float f2v_ __attribute__((ext_vector_type(2)));
typedef __bf16 b2v_ __attribute__((ext_vector_type(2)));
DI unsigned gdnpk(float a, float b) { const f2v_ v = {a, b}; const b2v_ r = __builtin_convertvector(v, b2v_); return __builtin_bit_cast(unsigned, r); }
namespace sba {
using bf16x8 = __attribute__((ext_vector_type(8))) short;
using s16x4  = __attribute__((ext_vector_type(4))) short;
using f32x16 = __attribute__((ext_vector_type(16))) float;
constexpr int SHM_V = 16384, KPITCH = 272, SHM_K = 64 * KPITCH, LDQ = 3072;
#define KSWZ(row, colB) ((row) * KPITCH + (colB))
#define SBAR() __builtin_amdgcn_sched_barrier(0)
DI int crow(int r, int hi) { return (r & 3) + 8 * (r >> 2) + 4 * hi; }
DI int v_st(int k, int c) { const int kk = (k & ~0xC) | ((k & 4) << 1) | ((k & 8) >> 1); return ((kk >> 3) * 4 + (c >> 5)) * 512 + ((kk & 7) * 32 + (c & 31)) * 2; }
DI int v_rd_base(int lane) { return ((lane & 3) << 3) | (((lane >> 2) & 3) << 6) | (((lane >> 4) & 1) << 5) | (((lane >> 5) & 1) << 8); }
constexpr int v_rd_off(int d0, int ks, int half) { return d0 * 512 + ks * 4096 + half * 2048; }
template <int OFF> DI s16x4 tr_read(int vb) { s16x4 r; asm volatile("ds_read_b64_tr_b16 %0, %1 offset:%2" : "=&v"(r) : "v"(vb), "i"(OFF) : "memory"); return r; }
template <int D0> DI void pv_one(f32x16& od, int vb, bf16x8 pa0, bf16x8 pa1, bf16x8 pa2, bf16x8 pa3) {
  const s16x4 l0 = tr_read<v_rd_off(D0, 0, 0)>(vb), h0 = tr_read<v_rd_off(D0, 0, 1)>(vb), l1 = tr_read<v_rd_off(D0, 1, 0)>(vb), h1 = tr_read<v_rd_off(D0, 1, 1)>(vb);
  const s16x4 l2 = tr_read<v_rd_off(D0, 2, 0)>(vb), h2 = tr_read<v_rd_off(D0, 2, 1)>(vb), l3 = tr_read<v_rd_off(D0, 3, 0)>(vb), h3 = tr_read<v_rd_off(D0, 3, 1)>(vb);
  asm volatile("s_waitcnt lgkmcnt(0)" ::: "memory"); SBAR();
#define PK(L, H) (bf16x8){L[0], L[1], L[2], L[3], H[0], H[1], H[2], H[3]}
  od = __builtin_amdgcn_mfma_f32_32x32x16_bf16(pa0, PK(l0, h0), od, 0, 0, 0);
  od = __builtin_amdgcn_mfma_f32_32x32x16_bf16(pa1, PK(l1, h1), od, 0, 0, 0);
  od = __builtin_amdgcn_mfma_f32_32x32x16_bf16(pa2, PK(l2, h2), od, 0, 0, 0);
  od = __builtin_amdgcn_mfma_f32_32x32x16_bf16(pa3, PK(l3, h3), od, 0, 0, 0);
#undef PK
}
template <int D0> DI void pv_one_T(f32x16& od, int vb, bf16x8 pa0, bf16x8 pa1, bf16x8 pa2, bf16x8 pa3) {
  const s16x4 l0 = tr_read<v_rd_off(D0, 0, 0)>(vb), h0 = tr_read<v_rd_off(D0, 0, 1)>(vb), l1 = tr_read<v_rd_off(D0, 1, 0)>(vb), h1 = tr_read<v_rd_off(D0, 1, 1)>(vb);
  const s16x4 l2 = tr_read<v_rd_off(D0, 2, 0)>(vb), h2 = tr_read<v_rd_off(D0, 2, 1)>(vb), l3 = tr_read<v_rd_off(D0, 3, 0)>(vb), h3 = tr_read<v_rd_off(D0, 3, 1)>(vb);
  asm volatile("s_waitcnt lgkmcnt(0)" ::: "memory"); SBAR();
#define PK(L, H) (bf16x8){L[0], L[1], L[2], L[3], H[0], H[1], H[2], H[3]}
  od = __builtin_amdgcn_mfma_f32_32x32x16_bf16(PK(l0, h0), pa0, od, 0, 0, 0);
  od = __builtin_amdgcn_mfma_f32_32x32x16_bf16(PK(l1, h1), pa1, od, 0, 0, 0);
  od = __builtin_amdgcn_mfma_f32_32x32x16_bf16(PK(l2, h2), pa2, od, 0, 0, 0);
  od = __builtin_amdgcn_mfma_f32_32x32x16_bf16(PK(l3, h3), pa3, od, 0, 0, 0);
#undef PK
}
DI void pv_split(f32x16& od, int vb, bf16x8 pa0, bf16x8 pa1, bf16x8 pa2, bf16x8 pa3) {
  const s16x4 l0 = tr_read<v_rd_off(0, 0, 0)>(vb), h0 = tr_read<v_rd_off(0, 0, 1)>(vb), l1 = tr_read<v_rd_off(0, 1, 0)>(vb), h1 = tr_read<v_rd_off(0, 1, 1)>(vb);
  const s16x4 l2 = tr_read<v_rd_off(0, 2, 0)>(vb), h2 = tr_read<v_rd_off(0, 2, 1)>(vb), l3 = tr_read<v_rd_off(0, 3, 0)>(vb), h3 = tr_read<v_rd_off(0, 3, 1)>(vb);
  asm volatile("s_waitcnt lgkmcnt(0)" ::: "memory"); SBAR();
#define PK(L, H) (bf16x8){L[0], L[1], L[2], L[3], H[0], H[1], H[2], H[3]}
  f32x16 ob = {};
  od = __builtin_amdgcn_mfma_f32_32x32x16_bf16(pa0, PK(l0, h0), od, 0, 0, 0); ob = __builtin_amdgcn_mfma_f32_32x32x16_bf16(pa2, PK(l2, h2), ob, 0, 0, 0);
  od = __builtin_amdgcn_mfma_f32_32x32x16_bf16(pa1, PK(l1, h1), od, 0, 0, 0); ob = __builtin_amdgcn_mfma_f32_32x32x16_bf16(pa3, PK(l3, h3), ob, 0, 0, 0);
  od = od + ob;
#undef PK
}
DI void pv_split_T(f32x16& od, int vb, bf16x8 pa0, bf16x8 pa1, bf16x8 pa2, bf16x8 pa3) {
  const s16x4 l0 = tr_read<v_rd_off(0, 0, 0)>(vb), h0 = tr_read<v_rd_off(0, 0, 1)>(vb), l1 = tr_read<v_rd_off(0, 1, 0)>(vb), h1 = tr_read<v_rd_off(0, 1, 1)>(vb);
  const s16x4 l2 = tr_read<v_rd_off(0, 2, 0)>(vb), h2 = tr_read<v_rd_off(0, 2, 1)>(vb), l3 = tr_read<v_rd_off(0, 3, 0)>(vb), h3 = tr_read<v_rd_off(0, 3, 1)>(vb);
  asm volatile("s_waitcnt lgkmcnt(0)" ::: "memory"); SBAR();
#define PK(L, H) (bf16x8){L[0], L[1], L[2], L[3], H[0], H[1], H[2], H[3]}
  f32x16 ob = {};
  od = __builtin_amdgcn_mfma_f32_32x32x16_bf16(PK(l0, h0), pa0, od, 0, 0, 0); ob = __builtin_amdgcn_mfma_f32_32x32x16_bf16(PK(l2, h2), pa2, ob, 0, 0, 0);
  od = __builtin_amdgcn_mfma_f32_32x32x16_bf16(PK(l1, h1), pa1, od, 0, 0, 0); ob = __builtin_amdgcn_mfma_f32_32x32x16_bf16(PK(l3, h3), pa3, ob, 0, 0, 0);
  od = od + ob;
#undef PK
}
DI void qkt(f32x16& p0, f32x16& p1, const LAS unsigned char* Ks, const bf16x8 (&qr)[8], int r32, int hi) {
  p0 = f32x16{}; p1 = f32x16{};
#pragma unroll
  for (int d0 = 0; d0 < 8; ++d0) { const int cb = (d0 * 16 + hi * 8) * 2;
    const bf16x8 b0 = *(const LAS bf16x8*)(Ks + KSWZ(r32, cb));
    const bf16x8 b1 = *(const LAS bf16x8*)(Ks + KSWZ(32 + r32, cb));
    p0 = __builtin_amdgcn_mfma_f32_32x32x16_bf16(b0, qr[d0], p0, 0, 0, 0);
    p1 = __builtin_amdgcn_mfma_f32_32x32x16_bf16(b1, qr[d0], p1, 0, 0, 0); }
}
template <bool MASK> DI void sb_half(f32x16& p, float& Pc, int hi, int kbase, int trow) {
  float kk[16];
#pragma unroll
  for (int r = 0; r < 16; ++r) {
    float z = p[r];
    if (MASK) z = (kbase + crow(r, hi) < trow) ? z : -__builtin_inff();
    kk[r] = __builtin_amdgcn_rcpf(1.0f + __builtin_amdgcn_exp2f(z));
  }
  float R0[4], R1[4];
#pragma unroll
  for (int g = 0; g < 4; ++g) {
    const float c2 = kk[4 * g + 3], c1 = c2 * kk[4 * g + 2], c0 = c1 * kk[4 * g + 1], R = c0 * kk[4 * g];
    p[4 * g + 3] = 1.0f - c2; p[4 * g + 2] = c2 - c1; p[4 * g + 1] = c1 - c0; p[4 * g] = c0 - R;
    const auto sw = __builtin_amdgcn_permlane32_swap(__float_as_uint(R), __float_as_uint(R), false, false);
    R0[g] = __uint_as_float(sw[0]); R1[g] = __uint_as_float(sw[1]);
  }
#pragma unroll
  for (int g = 3; g >= 0; --g) {
    const float Pin = hi ? Pc : Pc * R1[g];
    p[4 * g + 3] *= Pin; p[4 * g + 2] *= Pin; p[4 * g + 1] *= Pin; p[4 * g] *= Pin;
    Pc *= R0[g] * R1[g];
  }
}
DI unsigned cvtpk(float lo, float hi) { unsigned r; asm volatile("v_cvt_pk_bf16_f32 %0, %1, %2" : "=v"(r) : "v"(lo), "v"(hi)); return r; }
#define PK4(P, BASE, OUT) do { const unsigned a0 = cvtpk(P[BASE + 0], P[BASE + 1]), a1 = cvtpk(P[BASE + 2], P[BASE + 3]);   \
    const unsigned b0 = cvtpk(P[BASE + 4], P[BASE + 5]), b1 = cvtpk(P[BASE + 6], P[BASE + 7]);                              \
    const auto r0 = __builtin_amdgcn_permlane32_swap(a0, b0, false, false); const auto r1 = __builtin_amdgcn_permlane32_swap(a1, b1, false, false); \
    const v4u w = {r0[0], r1[0], r0[1], r1[1]}; OUT = __builtin_bit_cast(bf16x8, w); } while (0)

DI void unit(const bf16* qkv, unsigned char* ao, int b, int h, int qb, LAS unsigned char* lds, int tid) {
  const int wid = __builtin_amdgcn_readfirstlane(tid >> 6), lane = tid & 63, r32 = lane & 31, hi = lane >> 5;
  constexpr bool late = false;
  LAS unsigned char* V_lds = lds; LAS unsigned char* K_lds = lds + 3 * SHM_V;
  const size_t rowbase = (size_t)b * SEQ; const int q0 = qb * 256, t_lo = q0 + wid * 32, trow = t_lo + r32;
  bf16x8 qr[8];
  { const bf16* Qw = qkv + (rowbase + trow) * LDQ + h * 128 + hi * 8; constexpr float C = 0.08838834764831845f * 1.4426950408889634f;
#pragma unroll
    for (int d0 = 0; d0 < 8; ++d0) { const v4u w = *(const v4u*)(Qw + d0 * 16); v4u o;
      o.x = gdnpk(bf_lo(w.x) * C, bf_hi(w.x) * C); o.y = gdnpk(bf_lo(w.y) * C, bf_hi(w.y) * C); o.z = gdnpk(bf_lo(w.z) * C, bf_hi(w.z) * C); o.w = gdnpk(bf_lo(w.w) * C, bf_hi(w.w) * C);
      qr[d0] = __builtin_bit_cast(bf16x8, o); } }
  const bf16* Kh = qkv + rowbase * LDQ + 1024 + h * 128; const bf16* Vh = Kh + 1024;
  const int sr = tid >> 4, sc = (tid & 15) * 8, vst0 = v_st(sr, sc), vst1 = v_st(32 + sr, sc);
  const int vb0 = (int)(unsigned)(size_t)V_lds + v_rd_base(lane);
  bf16x8 vs0, vs1, ks0, ks1;
  const unsigned soff = (unsigned)(sr * LDQ + sc) * 2u;
#define SLOAD(k0) do { const char* kb_ = (const char*)(Kh + (size_t)(k0) * LDQ); const char* vb_ = (const char*)(Vh + (size_t)(k0) * LDQ); \
    vs0 = *(const bf16x8*)(vb_ + soff); vs1 = *(const bf16x8*)(vb_ + (size_t)32 * LDQ * 2 + soff); ks0 = *(const bf16x8*)(kb_ + soff); ks1 = *(const bf16x8*)(kb_ + (size_t)32 * LDQ * 2 + soff); } while (0)
#define SWRITE(bb) do { *(LAS bf16x8*)(V_lds + (bb) * SHM_V + vst0) = vs0; *(LAS bf16x8*)(V_lds + (bb) * SHM_V + vst1) = vs1; const int kc = sc * 2; \
    *(LAS bf16x8*)(K_lds + (bb) * SHM_K + KSWZ(sr, kc)) = ks0; *(LAS bf16x8*)(K_lds + (bb) * SHM_K + KSWZ(32 + sr, kc)) = ks1; } while (0)
  f32x16 o[4] = {}; float Pc = 1.0f;
  constexpr float SB_EPS = 1.0e-12f;
  LAS unsigned* aflag = (LAS unsigned*)(lds + 3 * SHM_V + 3 * SHM_K);
  f32x16 p0 = {}, p1 = {};
  const int NT = qb * 4 + 4;
  SLOAD((NT - 1) * 64);
  int bufc = 0, bufp = 0;
  for (int wi = 0; wi <= NT; ++wi) {
    const int kt = NT - 1 - wi, k0 = kt * 64;
    SEC_IN(4);
    if (wi < NT) { asm volatile("s_waitcnt vmcnt(0)" ::: "memory"); SWRITE(bufc); if (kt > 0) SLOAD(k0 - 64); }
    __syncthreads();
    SEC_OUT(4); SEC_IN(5);
    if (wi > 0) { const v4u f0 = *(const LAS v4u*)(aflag + ((wi - 1) & 1) * 8), f1 = *(const LAS v4u*)(aflag + ((wi - 1) & 1) * 8 + 4);
      if ((f0.x | f0.y | f0.z | f0.w | f1.x | f1.y | f1.z | f1.w) == 0u) break; }
    const bool wlive = __any(Pc >= SB_EPS);
    if (!late && wlive && wi < NT && k0 < t_lo + 31) { __builtin_amdgcn_s_setprio(1); qkt(p0, p1, K_lds + bufc * SHM_K, qr, r32, hi); __builtin_amdgcn_s_setprio(0); }
    { const int ka = late ? k0 + 64 : k0;
      const bool doit = wlive && (late ? (wi > 0 && ka < t_lo + 31) : (wi < NT && k0 < t_lo + 31));
      if (doit) {
        bf16x8 pa0, pa1, pa2, pa3;
        if (ka + 63 >= t_lo) { sb_half<true>(p1, Pc, hi, ka + 32, trow); PK4(p1, 0, pa2); PK4(p1, 8, pa3); SBAR(); sb_half<true>(p0, Pc, hi, ka, trow); }
        else { sb_half<false>(p1, Pc, hi, ka + 32, trow); PK4(p1, 0, pa2); PK4(p1, 8, pa3); SBAR(); sb_half<false>(p0, Pc, hi, ka, trow); }
        PK4(p0, 0, pa0); PK4(p0, 8, pa1);
        const int vb = vb0 + (late ? bufp : bufc) * SHM_V;
        __builtin_amdgcn_s_setprio(1);
        pv_one<0>(o[0], vb, pa0, pa1, pa2, pa3); pv_one<1>(o[1], vb, pa0, pa1, pa2, pa3); pv_one<2>(o[2], vb, pa0, pa1, pa2, pa3); pv_one<3>(o[3], vb, pa0, pa1, pa2, pa3);
        __builtin_amdgcn_s_setprio(0);
      } }
    if (late && wi < NT && k0 < t_lo + 31) { __builtin_amdgcn_s_setprio(1); qkt(p0, p1, K_lds + bufc * SHM_K, qr, r32, hi); __builtin_amdgcn_s_setprio(0); }
    { const bool act = __any(Pc >= SB_EPS); if (lane == 0) aflag[(wi & 1) * 8 + wid] = act ? 1u : 0u; }
    SEC_OUT(5);
    bufp = bufc; bufc = (bufc == 2) ? 0 : bufc + 1;
  }
  { unsigned char* Ob = ao + ((size_t)b * SEQ + qb * 256 + wid * 32) * 1024 + h * 128; const unsigned ooff = (unsigned)(4 * hi * 1024 + r32);
#pragma unroll
    for (int r = 0; r < 16; ++r)
#pragma unroll
      for (int d0 = 0; d0 < 4; ++d0) Ob[ooff + (unsigned)(((r & 3) + 8 * (r >> 2)) * 1024 + d0 * 32)] = (unsigned char)(__builtin_amdgcn_cvt_pk_fp8_f32(pg8::clamp_f8(o[d0][r] * (float)(1 << F8_AO)), 0.f, 0, false) & 0xff); }
#undef SLOAD
#undef SWRITE
}
#undef PK4
#undef KSWZ
#undef SBAR
}
DI void phase_sb_mfma(const Args& a, LAS unsigned char* lds, int bid, int G, int tid) {
    const bf16* qkv = (const bf16*)(a.ws + WS_QKV); unsigned char* ao = a.ws + WS_AO;
    const int vcu = (G % 8 == 0) ? (bid % 8) * (G / 8) + bid / 8 : bid;
    for (int pi = vcu; pi < 512; pi += G) {
        const int bh = pi >> 3, p = pi & 7, b = bh >> 3, h = bh & 7;
        sba::unit(qkv, ao, b, h, 15 - p, lds, tid);
        sba::unit(qkv, ao, b, h, p, lds, tid);
    }
}


namespace gdn {
using bf16x8 = __attribute__((ext_vector_type(8))) short;
using s16x4  = __attribute__((ext_vector_type(4))) short;
using f32x16 = __attribute__((ext_vector_type(16))) float;
typedef float f2v __attribute__((ext_vector_type(2)));
typedef __bf16 b2v __attribute__((ext_vector_type(2)));
DI unsigned pk(float a, float b) { const f2v v = {a, b}; const b2v r = __builtin_convertvector(v, b2v); return __builtin_bit_cast(unsigned, r); }
DI int crow(int r, int hi) { return (r & 3) + 8 * (r >> 2) + 4 * hi; }
DI int pi_slot(int x) { return 8 * ((x >> 2) & 3) + 4 * ((x >> 4) & 1) + (x & 3); }
DI bf16x8 pack_step(const f32x16& x, int s) {
    v4u w; w.x = pk(x[8 * s + 0], x[8 * s + 1]); w.y = pk(x[8 * s + 2], x[8 * s + 3]); w.z = pk(x[8 * s + 4], x[8 * s + 5]); w.w = pk(x[8 * s + 6], x[8 * s + 7]);
    return __builtin_bit_cast(bf16x8, w);
}
DI f32x16 mm(const f32x16& P, const f32x16& Q, f32x16 acc) {
    acc = __builtin_amdgcn_mfma_f32_32x32x16_bf16(pack_step(P, 0), pack_step(Q, 0), acc, 0, 0, 0);
    acc = __builtin_amdgcn_mfma_f32_32x32x16_bf16(pack_step(P, 1), pack_step(Q, 1), acc, 0, 0, 0);
    return acc;
}
#define GPK4(P, BASE, OUT) do { const unsigned a0 = pk(P[BASE + 0], P[BASE + 1]), a1 = pk(P[BASE + 2], P[BASE + 3]);   \
    const unsigned b0 = pk(P[BASE + 4], P[BASE + 5]), b1 = pk(P[BASE + 6], P[BASE + 7]);                              \
    const auto r0 = __builtin_amdgcn_permlane32_swap(a0, b0, false, false); const auto r1 = __builtin_amdgcn_permlane32_swap(a1, b1, false, false); \
    const v4u w_ = {r0[0], r1[0], r0[1], r1[1]}; OUT = __builtin_bit_cast(bf16x8, w_); } while (0)

DI void local_unit(const Args& a, int unit, LAS unsigned char* img, LAS float* tab, int lane, bool dry) {
    const int r32 = lane & 31, hi = lane >> 5;
    const int chunk = unit & 63, bh = unit >> 6, hv = bh & 15, b = bh >> 4, hk = hv >> 1;
    const size_t t0 = (size_t)b * SEQ + chunk * 64;
    bf16* qkvc = (bf16*)(a.ws + WS_QKVC); const float* gb = (const float*)(a.ws + WS_GB);
    bf16* wmem = (bf16*)(a.ws + WS_WMEM) + (size_t)unit * 8192; bf16* imem = (bf16*)(a.ws + WS_IMEM) + (size_t)unit * 4096;
    bf16* ktmem = (bf16*)(a.ws + WS_KTMEM) + (size_t)((b * HK + hk) * 64 + chunk) * 8192; float* gtab = (float*)(a.ws + WS_GTAB) + (size_t)unit * 192;
    SEC_IN(1);
    float gc = gb[(t0 + lane) * 32 + hv]; const float be = gb[(t0 + lane) * 32 + 16 + hv];
#pragma unroll
    for (int off = 1; off < 64; off <<= 1) { const float y = __shfl_up(gc, off); if (lane >= off) gc += y; }
    const float glast = __shfl(gc, 63);
    tab[lane] = gc; tab[64 + lane] = be; tab[128 + lane] = -be * __expf(gc);
    gtab[lane] = __expf(gc); gtab[64 + lane] = __expf(glast - gc); if (lane == 0) gtab[128] = __expf(glast);
    const bf16* kbase = qkvc + t0 * 4096 + 1024 + hk * 128; const bf16* qbase = qkvc + t0 * 4096 + hk * 128; bf16* vbase = qkvc + t0 * 4096 + 2048 + hv * 128;
#define GSB() __builtin_amdgcn_sched_barrier(0)
    {
        f32x16 IT00 = {}, IT11 = {}, IT01 = {};
#pragma unroll
        for (int s = 0; s < 8; ++s) {
            const bf16x8 k0 = *(const bf16x8*)(kbase + (size_t)r32 * 4096 + 16 * s + 8 * hi), k1 = *(const bf16x8*)(kbase + (size_t)(32 + r32) * 4096 + 16 * s + 8 * hi);
            const bf16x8 q0 = *(const bf16x8*)(qbase + (size_t)r32 * 4096 + 16 * s + 8 * hi), q1 = *(const bf16x8*)(qbase + (size_t)(32 + r32) * 4096 + 16 * s + 8 * hi);
            IT00 = __builtin_amdgcn_mfma_f32_32x32x16_bf16(k0, q0, IT00, 0, 0, 0); IT11 = __builtin_amdgcn_mfma_f32_32x32x16_bf16(k1, q1, IT11, 0, 0, 0);
            IT01 = __builtin_amdgcn_mfma_f32_32x32x16_bf16(k0, q1, IT01, 0, 0, 0);
        }
#pragma unroll
        for (int I = 0; I < 2; ++I) { const int c = 32 * I + r32; const float gcc = tab[c];
#pragma unroll
            for (int J = 0; J < 2; ++J)
#pragma unroll
                for (int g = 0; g < 4; ++g) { float v[4];
#pragma unroll
                    for (int i = 0; i < 4; ++i) { const int r = 4 * g + i, cp = 32 * J + crow(r, hi);
                        const float raw = (I == 0) ? (J == 0 ? IT00[r] : 0.f) : (J == 0 ? IT01[r] : IT11[r]);
                        const float val = raw * __expf(-fabsf(gcc - tab[cp])); v[i] = (c >= cp) ? val : 0.f; }
                    v2u o; o.x = pk(v[0], v[1]); o.y = pk(v[2], v[3]);
                    *(v2u*)(imem + (unsigned)((((I * 2 + J) * 4 + g) * 64 + lane) * 4)) = o; } }
    }
    GSB();
    SEC_OUT(1); SEC_IN(2);
    f32x16 T1, T1T, T2T, T21T;
    {
        f32x16 KK = {};
#pragma unroll
        for (int s = 0; s < 8; ++s) { const bf16x8 k0 = *(const bf16x8*)(kbase + (size_t)r32 * 4096 + 16 * s + 8 * hi); KK = __builtin_amdgcn_mfma_f32_32x32x16_bf16(k0, k0, KK, 0, 0, 0); }
        f32x16 M, MT;
        { const float gb0 = tab[r32], bb0 = tab[64 + r32];
#pragma unroll
        for (int r = 0; r < 16; ++r) { const int a0 = crow(r, hi), b0 = r32; const float ke = -KK[r] * __expf(-fabsf(tab[a0] - gb0));
            const float nv = ke * tab[64 + a0], ntv = ke * bb0;
            const float n = (a0 > b0) ? nv : 0.f, nt = (b0 > a0) ? ntv : 0.f, id = (a0 == b0) ? 1.f : 0.f;
            M[r] = n; MT[r] = nt; T1[r] = id + n; T1T[r] = id + nt; } }
#pragma unroll
        for (int it = 0; it < 4; ++it) { const f32x16 z = {};
            const f32x16 Mn = mm(MT, M, z), MTn = mm(M, MT, z);
            const f32x16 Tn = mm(T1T, Mn, T1);
            T1T = mm(Mn, T1T, T1T);
            T1 = Tn; M = Mn; MT = MTn; }
    }
    GSB();
    {
        f32x16 KK = {};
#pragma unroll
        for (int s = 0; s < 8; ++s) { const bf16x8 k1 = *(const bf16x8*)(kbase + (size_t)(32 + r32) * 4096 + 16 * s + 8 * hi); KK = __builtin_amdgcn_mfma_f32_32x32x16_bf16(k1, k1, KK, 0, 0, 0); }
        f32x16 M, MT;
        { const float gb0 = tab[32 + r32], bb0 = tab[96 + r32];
#pragma unroll
        for (int r = 0; r < 16; ++r) { const int a0 = crow(r, hi), b0 = r32; const float ke = -KK[r] * __expf(-fabsf(tab[32 + a0] - gb0));
            const float nv = ke * tab[96 + a0], ntv = ke * bb0;
            const float n = (a0 > b0) ? nv : 0.f, nt = (b0 > a0) ? ntv : 0.f, id = (a0 == b0) ? 1.f : 0.f;
            M[r] = n; MT[r] = nt; T2T[r] = id + nt; } }
#pragma unroll
        for (int it = 0; it < 4; ++it) { const f32x16 z = {};
            const f32x16 Mn = mm(MT, M, z), MTn = mm(M, MT, z);
            T2T = mm(Mn, T2T, T2T);
            M = Mn; MT = MTn; }
    }
    GSB();
    {
        f32x16 L21 = {};
#pragma unroll
        for (int s = 0; s < 8; ++s) { const bf16x8 k0 = *(const bf16x8*)(kbase + (size_t)r32 * 4096 + 16 * s + 8 * hi), k1 = *(const bf16x8*)(kbase + (size_t)(32 + r32) * 4096 + 16 * s + 8 * hi);
            L21 = __builtin_amdgcn_mfma_f32_32x32x16_bf16(k1, k0, L21, 0, 0, 0); }
#pragma unroll
        for (int r = 0; r < 16; ++r) { const int a0 = crow(r, hi); L21[r] = L21[r] * tab[96 + a0] * __expf(tab[32 + a0] - tab[r32]); }
        const f32x16 z = {}; const f32x16 Y = mm(L21, T2T, z); T21T = mm(T1, Y, z);
#pragma unroll
        for (int r = 0; r < 16; ++r) T21T[r] = -T21T[r];
    }
    GSB();
    SEC_OUT(2); SEC_IN(3);
    const int vb = (int)(unsigned)(size_t)img + sba::v_rd_base(lane);
    bf16* ubl = dry ? (bf16*)(a.ws + WS_END) + (size_t)(unit & 63) * 64 * 4096 : vbase;
#pragma unroll 1
    for (int mode = 0; mode < 2; ++mode) {
        const bf16* src = mode == 0 ? (const bf16*)vbase : kbase;
#pragma unroll 1
        for (int hb_ = 0; hb_ < 2; ++hb_) { v4u tl[8];
#pragma unroll
          for (int it = 0; it < 8; ++it) { const int row = (lane >> 4) + 4 * (it + 8 * hb_), col = (lane & 15) * 8; tl[it] = *(const v4u*)(src + (size_t)row * 4096 + col); }
#pragma unroll
          for (int it = 0; it < 8; ++it) { const int row = (lane >> 4) + 4 * (it + 8 * hb_), col = (lane & 15) * 8; *(LAS v4u*)(img + sba::v_st(row, col)) = tl[it]; } }
        LAS float* sc = tab + (mode == 0 ? 64 : 128);
#pragma unroll 1
        for (int I = 0; I < 2; ++I) {
            bf16x8 pa0, pa1, pa2, pa3;
            { f32x16 X;
#pragma unroll
              for (int r = 0; r < 16; ++r) X[r] = (I ? T21T[r] : T1T[r]) * sc[crow(r, hi)];
              GPK4(X, 0, pa0); GPK4(X, 8, pa1);
              { const float on = I ? 1.0f : 0.0f;
#pragma unroll
              for (int r = 0; r < 16; ++r) X[r] = T2T[r] * (sc[32 + crow(r, hi)] * on); }
              GPK4(X, 0, pa2); GPK4(X, 8, pa3); }
#pragma unroll 1
            for (int d0 = 0; d0 < 4; ++d0) {
                f32x16 od = {};
                if (mode == 0) { sba::pv_split(od, vb + d0 * 512, pa0, pa1, pa2, pa3);
                    const unsigned e0 = (unsigned)(((I * 32 + 8 * d0 + (lane >> 5)) * 4096) + (lane & 31) * 4);
#pragma unroll
                    for (int g = 0; g < 4; ++g) { v2u w; w.x = pk(od[4 * g + 0], od[4 * g + 1]); w.y = pk(od[4 * g + 2], od[4 * g + 3]); *(v2u*)(ubl + e0 + (unsigned)(g * 8192)) = w; }
                } else { sba::pv_split_T(od, vb + d0 * 512, pa0, pa1, pa2, pa3);
                    bf16* wp = wmem + (unsigned)((((I * 4 + d0) * 4) * 64 + lane) * 4);
#pragma unroll
                    for (int g = 0; g < 4; ++g) { v2u w; w.x = pk(od[4 * g + 0], od[4 * g + 1]); w.y = pk(od[4 * g + 2], od[4 * g + 3]); *(v2u*)(wp + g * 256) = w; }
                }
                GSB();
            }
        }
        if (mode == 1) {
            const int Ik = hv & 1;
            v4u idw0, idw1;
            { const int d0_ = r32 - 8 * hi, d1_ = r32 - 16 - 8 * hi;
              idw0.x = (d0_ == 0 ? 0x3f80u : 0u) | (d0_ == 1 ? 0x3f800000u : 0u); idw0.y = (d0_ == 2 ? 0x3f80u : 0u) | (d0_ == 3 ? 0x3f800000u : 0u);
              idw0.z = (d0_ == 4 ? 0x3f80u : 0u) | (d0_ == 5 ? 0x3f800000u : 0u); idw0.w = (d0_ == 6 ? 0x3f80u : 0u) | (d0_ == 7 ? 0x3f800000u : 0u);
              idw1.x = (d1_ == 0 ? 0x3f80u : 0u) | (d1_ == 1 ? 0x3f800000u : 0u); idw1.y = (d1_ == 2 ? 0x3f80u : 0u) | (d1_ == 3 ? 0x3f800000u : 0u);
              idw1.z = (d1_ == 4 ? 0x3f80u : 0u) | (d1_ == 5 ? 0x3f800000u : 0u); idw1.w = (d1_ == 6 ? 0x3f80u : 0u) | (d1_ == 7 ? 0x3f800000u : 0u); }
            const bf16x8 id0 = __builtin_bit_cast(bf16x8, idw0), id1 = __builtin_bit_cast(bf16x8, idw1), zf = (bf16x8){};
            const bf16x8 pa0 = Ik ? zf : id0, pa1 = Ik ? zf : id1, pa2 = Ik ? id0 : zf, pa3 = Ik ? id1 : zf;
#pragma unroll 1
            for (int d0 = 0; d0 < 4; ++d0) {
                f32x16 od = {}; sba::pv_split(od, vb + d0 * 512, pa0, pa1, pa2, pa3);
                bf16* kp = ktmem + (unsigned)((((Ik * 4 + d0) * 4) * 64 + lane) * 4);
#pragma unroll
                for (int g = 0; g < 4; ++g) { v2u w; w.x = pk(od[4 * g + 0], od[4 * g + 1]); w.y = pk(od[4 * g + 2], od[4 * g + 3]); *(v2u*)(kp + g * 256) = w; }
                GSB();
            }
        }
    }
    SEC_OUT(3);
#undef GSB
}
#undef GPK4
}
DI void phase_gdn_local(const Args& a, LAS unsigned char* lds, int bid, int G, int wave, int lane, bool dry) {
    LAS unsigned char* img = lds + wave * 16384; LAS float* tab = (LAS float*)(lds + RING_BYTES + 4096 + wave * 1024);
    const int gw = bid * NWAVES + wave, NGW = G * NWAVES;
    for (int unit = gw; unit < BATCH * HV * 64; unit += NGW) gdn::local_unit(a, unit, img, tab, lane, dry);
}
namespace gdn {
constexpr int PW = 272, PI = 144;
constexpr int L_W = 0, L_Q = 64 * PW, L_I = 2 * 64 * PW, L_K = L_I + 64 * PI, L_G = L_K + 128 * PI, L_BUF = L_G + 768;
constexpr int L_PART = 2 * L_BUF;
static_assert(L_PART + 4096 <= RING_BYTES, "scan LDS map");
}
DI void phase_gdn_scan(const Args& a, int j, LAS unsigned char* lds, int bid, int tid, bool dry) {
    if (bid >= BATCH * HV) return;
    using gdn::bf16x8; using gdn::pk; using namespace gdn;
    typedef float f4v __attribute__((ext_vector_type(4)));
    const int wave = __builtin_amdgcn_readfirstlane(tid >> 6), lane = tid & 63, n = lane & 15, kq = lane >> 4;
    const int b = bid / HV, hv = bid % HV, hk = hv >> 1;
    bf16* qkvc = (bf16*)(a.ws + WS_QKVC); const bf16* zb = (const bf16*)(a.ws + WS_ZB);
    LAS float* part = (LAS float*)(lds + L_PART); LAS unsigned char* stg = lds + OGST_OFF;
    const int unit0 = (b * HV + hv) * 64, hku0 = (b * HK + hk) * 64; const size_t tb0 = (size_t)b * SEQ;
    if (wave >= 4) {
        const int st = tid - 256;
        v4u rw[4], rq[4], ri[2], rk[4], rz[4]; float rg = 0.f;
        unsigned ow[4], ok_[4], oi[2], oq[4], oz[4];
#pragma unroll
        for (int k = 0; k < 4; ++k) { const int c = st + 256 * k;
            { const int row = c & 63, p = c >> 6, pp = p & 3; ow[k] = (unsigned)((((((row >> 5) * 4 + (p >> 2)) * 4 + (pp >> 1)) * 64 + (pp & 1) * 32 + (row & 31)) * 4) * 2); }
            { const int dk = c & 127, p = c >> 7, pp = p & 3; ok_[k] = (unsigned)((((((p >> 2) * 4 + (dk >> 5)) * 4 + (pp >> 1)) * 64 + (pp & 1) * 32 + (dk & 31)) * 4) * 2); }
            oq[k] = (unsigned)(((c >> 4) * 4096 + (c & 15) * 8) * 2); oz[k] = (unsigned)(((c >> 4) * 2048 + (c & 15) * 8) * 2); }
#pragma unroll
        for (int k = 0; k < 2; ++k) { const int c = st + 256 * k; const int row = c & 63, p = c >> 6, pp = p & 3; oi[k] = (unsigned)((((((row >> 5) * 2 + (p >> 2)) * 4 + (pp >> 1)) * 64 + (pp & 1) * 32 + (row & 31)) * 4) * 2); }
#define SV_RUN2(dst, base, ob_) do { const v2u a_ = *(const v2u*)((const char*)(base) + (ob_)), b_ = *(const v2u*)((const char*)(base) + (ob_) + 1024); dst = (v4u){a_.x, a_.y, b_.x, b_.y}; } while (0)
#define SV_LOAD(ch) do { const int u_ = unit0 + (ch); const size_t t_ = tb0 + (size_t)(ch) * 64; \
        const bf16* wm_ = (const bf16*)(a.ws + WS_WMEM) + (size_t)u_ * 8192; const bf16* im_ = (const bf16*)(a.ws + WS_IMEM) + (size_t)u_ * 4096; \
        const bf16* kt_ = (const bf16*)(a.ws + WS_KTMEM) + (size_t)(hku0 + (ch)) * 8192; const bf16* qb_ = qkvc + t_ * 4096 + hk * 128; const bf16* zr_ = zb + t_ * 2048 + hv * 128; \
        _Pragma("unroll") for (int k = 0; k < 4; ++k) { SV_RUN2(rw[k], wm_, ow[k]); SV_RUN2(rk[k], kt_, ok_[k]); rq[k] = *(const v4u*)((const char*)qb_ + oq[k]); if (k < 2) rz[k] = *(const v4u*)((const char*)zr_ + oz[k]); } \
        _Pragma("unroll") for (int k = 0; k < 2; ++k) { SV_RUN2(ri[k], im_, oi[k]); } \
        if (st < 192) rg = ((const float*)(a.ws + WS_GTAB))[(size_t)u_ * 192 + st]; } while (0)
#define SV_WRITE(bf) do { LAS unsigned char* B_ = lds + (bf) * L_BUF; \
        _Pragma("unroll") for (int k = 0; k < 4; ++k) { const int c = st + 256 * k; *(LAS v4u*)(B_ + L_W + (c & 63) * PW + (c >> 6) * 16) = rw[k]; \
            *(LAS v4u*)(B_ + L_Q + (c >> 4) * PW + (c & 15) * 16) = rq[k]; *(LAS v4u*)(B_ + L_K + (c & 127) * PI + (c >> 7) * 16) = rk[k]; } \
        _Pragma("unroll") for (int k = 0; k < 2; ++k) { const int c = st + 256 * k; *(LAS v4u*)(B_ + L_I + (c & 63) * PI + (c >> 6) * 16) = ri[k]; } \
        if (st < 192) *(LAS float*)(B_ + L_G + st * 4) = rg; } while (0)
        f32x4 nwa, nwb;
        { const float* nwp = a.gdn_norm_w + j * 128 + (st & 15) * 8; nwa = *(const f32x4*)nwp; nwb = *(const f32x4*)(nwp + 4); }
        volatile LAS unsigned* flag = (volatile LAS unsigned*)(lds + L_PART);
        SV_LOAD(0); SV_WRITE(0);
        v4u zc[2], zn[2];
#pragma unroll
        for (int k = 0; k < 2; ++k) zc[k] = rz[k];
        __syncthreads();
        SV_LOAD(1);
#pragma unroll 1
        for (int chunk = 0; chunk < 64; ++chunk) {
            if (chunk + 1 < 64) { SV_WRITE((chunk + 1) & 1);
#pragma unroll
                for (int k = 0; k < 2; ++k) zn[k] = rz[k]; }
            __syncthreads();
            v4u ov[2];
#pragma unroll
            for (int k = 0; k < 2; ++k) { const int c = st + 256 * k; ov[k] = *(const LAS v4u*)(stg + (c >> 4) * 256 + (c & 15) * 16); }
            asm volatile("s_waitcnt lgkmcnt(0)" ::: "memory");
            if (lane == 0) __hip_atomic_fetch_add((LAS unsigned*)(lds + L_PART), 1u, __ATOMIC_RELAXED, __HIP_MEMORY_SCOPE_WORKGROUP);
            if (chunk + 2 < 64) SV_LOAD(chunk + 2);
            __builtin_amdgcn_sched_barrier(0);
            unsigned char* ob = dry ? a.ws + WS_END + (size_t)bid * 64 * 128 : a.ws + WS_G8 + (tb0 + (size_t)chunk * 64) * 2048 + hv * 128;
#pragma unroll
            for (int k = 0; k < 2; ++k) {
                float o8[8]; o8[0] = bf_lo(ov[k].x); o8[1] = bf_hi(ov[k].x); o8[2] = bf_lo(ov[k].y); o8[3] = bf_hi(ov[k].y); o8[4] = bf_lo(ov[k].z); o8[5] = bf_hi(ov[k].z); o8[6] = bf_lo(ov[k].w); o8[7] = bf_hi(ov[k].w);
                float ss = 0.f;
#pragma unroll
                for (int e = 0; e < 8; ++e) ss += o8[e] * o8[e];
                const float rinv = __builtin_amdgcn_rsqf(dpp_sum16(ss) * (1.0f / 128.0f) + RMS_EPS);
                float z8[8]; z8[0] = bf_lo(zc[k].x); z8[1] = bf_hi(zc[k].x); z8[2] = bf_lo(zc[k].y); z8[3] = bf_hi(zc[k].y); z8[4] = bf_lo(zc[k].z); z8[5] = bf_hi(zc[k].z); z8[6] = bf_lo(zc[k].w); z8[7] = bf_hi(zc[k].w);
                float r8[8];
#pragma unroll
                for (int e = 0; e < 8; ++e) r8[e] = o8[e] * rinv * (e < 4 ? nwa[e] : nwb[e - 4]) * z8[e];
                constexpr float gs = (float)(1 << F8_GO); v2u w; w.x = pg8::pk4_f8(r8[0] * gs, r8[1] * gs, r8[2] * gs, r8[3] * gs); w.y = pg8::pk4_f8(r8[4] * gs, r8[5] * gs, r8[6] * gs, r8[7] * gs);
                *(v2u*)(ob + (dry ? (unsigned)(((st + 256 * k) >> 4) * 128 + ((st + 256 * k) & 15) * 8) : (oz[k] >> 1))) = w; }
#pragma unroll
            for (int k = 0; k < 2; ++k) zc[k] = zn[k];
        }
#undef SV_RUN2
#undef SV_LOAD
#undef SV_WRITE
        return;
    }
    f4v S[2][8];
#pragma unroll
    for (int g = 0; g < 2; ++g)
#pragma unroll
        for (int m = 0; m < 8; ++m) S[g][m] = (f4v){0.f, 0.f, 0.f, 0.f};
    v2u un[2][4];
#define CW_ULOAD(ch) do { const bf16* vb_ = qkvc + (tb0 + (size_t)(ch) * 64) * 4096 + 2048 + hv * 128; \
        _Pragma("unroll") for (int g = 0; g < 2; ++g) _Pragma("unroll") for (int mt = 0; mt < 4; ++mt) { \
            const int f = (((((mt >> 1) * 4 + wave) * 4 + 2 * (mt & 1) + (kq >> 1)) * 64) + (kq & 1) * 32 + 16 * g + n) * 4;     \
            un[g][mt] = *(const v2u*)(vb_ + (size_t)(f >> 7) * 4096 + (f & 127)); } } while (0)
    CW_ULOAD(0);
    if (tid == 0) *(volatile LAS unsigned*)(lds + L_PART) = 0u;
    __syncthreads();
#pragma unroll 1
    for (int chunk = 0; chunk < 64; ++chunk) {
        GSEC_ACC(8, -);
        const LAS unsigned char* B = lds + (chunk & 1) * L_BUF; const LAS float* gt = (const LAS float*)(B + L_G);
        f4v av[2][4], ao[2][4];
#pragma unroll
        for (int g = 0; g < 2; ++g)
#pragma unroll
            for (int mt = 0; mt < 4; ++mt) { const v2u u0 = un[g][mt]; av[g][mt] = (f4v){bf_lo(u0.x), bf_hi(u0.x), bf_lo(u0.y), bf_hi(u0.y)}; }
        v4u zq[2];
#pragma unroll
        for (int k = 0; k < 2; ++k) { const int c = tid + 512 + 256 * k; zq[k] = *(const v4u*)(zb + (tb0 + (size_t)chunk * 64 + (c >> 4)) * 2048 + hv * 128 + (c & 15) * 8); }
        if (chunk + 1 < 64) CW_ULOAD(chunk + 1);
        bf16x8 Sb[2][4];
#pragma unroll
        for (int g = 0; g < 2; ++g)
#pragma unroll
            for (int p = 0; p < 4; ++p) { v4u w; w.x = pk(S[g][2 * p][0], S[g][2 * p][1]); w.y = pk(S[g][2 * p][2], S[g][2 * p][3]); w.z = pk(S[g][2 * p + 1][0], S[g][2 * p + 1][1]); w.w = pk(S[g][2 * p + 1][2], S[g][2 * p + 1][3]);
                Sb[g][p] = __builtin_bit_cast(bf16x8, w); }
#pragma unroll
        for (int mt = 0; mt < 4; ++mt) { ao[0][mt] = (f4v){0.f, 0.f, 0.f, 0.f}; ao[1][mt] = (f4v){0.f, 0.f, 0.f, 0.f};
#pragma unroll
            for (int p = 0; p < 4; ++p) {
                const bf16x8 aw = *(const LAS bf16x8*)(B + L_W + (16 * mt + n) * PW + 64 * p + 16 * kq);
                const v2u q0 = *(const LAS v2u*)(B + L_Q + (16 * mt + n) * PW + 64 * p + 8 * kq), q1 = *(const LAS v2u*)(B + L_Q + (16 * mt + n) * PW + 64 * p + 32 + 8 * kq);
                const v4u qq = {q0.x, q0.y, q1.x, q1.y}; const bf16x8 aq = __builtin_bit_cast(bf16x8, qq);
                av[0][mt] = __builtin_amdgcn_mfma_f32_16x16x32_bf16(aw, Sb[0][p], av[0][mt], 0, 0, 0); av[1][mt] = __builtin_amdgcn_mfma_f32_16x16x32_bf16(aw, Sb[1][p], av[1][mt], 0, 0, 0);
                ao[0][mt] = __builtin_amdgcn_mfma_f32_16x16x32_bf16(aq, Sb[0][p], ao[0][mt], 0, 0, 0); ao[1][mt] = __builtin_amdgcn_mfma_f32_16x16x32_bf16(aq, Sb[1][p], ao[1][mt], 0, 0, 0); } }
        bf16x8 vbf[2][2], vbd[2][2];
#pragma unroll
        for (int pp = 0; pp < 2; ++pp) {
            const f4v d0 = *(const LAS f4v*)(gt + 64 + 32 * pp + 4 * kq), d1 = *(const LAS f4v*)(gt + 64 + 32 * pp + 16 + 4 * kq);
#pragma unroll
            for (int g = 0; g < 2; ++g) { const f4v x0 = av[g][2 * pp], x1 = av[g][2 * pp + 1];
                v4u w; w.x = pk(x0[0], x0[1]); w.y = pk(x0[2], x0[3]); w.z = pk(x1[0], x1[1]); w.w = pk(x1[2], x1[3]); vbf[g][pp] = __builtin_bit_cast(bf16x8, w);
                v4u y; y.x = pk(x0[0] * d0[0], x0[1] * d0[1]); y.y = pk(x0[2] * d0[2], x0[3] * d0[3]); y.z = pk(x1[0] * d1[0], x1[1] * d1[1]); y.w = pk(x1[2] * d1[2], x1[3] * d1[3]); vbd[g][pp] = __builtin_bit_cast(bf16x8, y); }
        }
#pragma unroll
        for (int mt = 0; mt < 4; ++mt) { const f4v eg = *(const LAS f4v*)(gt + 16 * mt + 4 * kq); ao[0][mt] = ao[0][mt] * eg; ao[1][mt] = ao[1][mt] * eg;
#pragma unroll
            for (int pp = 0; pp < 2; ++pp) { const bf16x8 ai = *(const LAS bf16x8*)(B + L_I + (16 * mt + n) * PI + 64 * pp + 16 * kq);
                ao[0][mt] = __builtin_amdgcn_mfma_f32_16x16x32_bf16(ai, vbf[0][pp], ao[0][mt], 0, 0, 0); ao[1][mt] = __builtin_amdgcn_mfma_f32_16x16x32_bf16(ai, vbf[1][pp], ao[1][mt], 0, 0, 0); } }
        { const float egl = gt[128];
#pragma unroll
          for (int m8 = 0; m8 < 8; ++m8) { S[0][m8] = S[0][m8] * egl; S[1][m8] = S[1][m8] * egl;
#pragma unroll
              for (int pp = 0; pp < 2; ++pp) { const bf16x8 ak = *(const LAS bf16x8*)(B + L_K + (16 * m8 + n) * PI + 64 * pp + 16 * kq);
                  S[0][m8] = __builtin_amdgcn_mfma_f32_16x16x32_bf16(ak, vbd[0][pp], S[0][m8], 0, 0, 0); S[1][m8] = __builtin_amdgcn_mfma_f32_16x16x32_bf16(ak, vbd[1][pp], S[1][m8], 0, 0, 0); } } }
        GSEC_ACC(8, +); GSEC_ACC(9, -);
        { unsigned spins = 0; while (*(volatile LAS unsigned*)(lds + L_PART) < 8u * (unsigned)chunk) { __builtin_amdgcn_s_sleep(1); if (++spins > (1u << 22)) break; } }
#pragma unroll
        for (int g = 0; g < 2; ++g)
#pragma unroll
            for (int mt = 0; mt < 4; ++mt)
#pragma unroll
                for (int i = 0; i < 4; ++i) *(LAS bf16*)(stg + (16 * mt + 4 * kq + i) * 256 + (32 * wave + 16 * g + n) * 2) = (bf16)(pk(ao[g][mt][i], 0.f) & 0xffffu);
        __syncthreads();
        GSEC_ACC(9, +);
        {
            v4u ov[2];
#pragma unroll
            for (int k = 0; k < 2; ++k) { const int c = tid + 512 + 256 * k; ov[k] = *(const LAS v4u*)(stg + (c >> 4) * 256 + (c & 15) * 16); }
            asm volatile("s_waitcnt lgkmcnt(0)" ::: "memory");
            if (lane == 0) __hip_atomic_fetch_add((LAS unsigned*)(lds + L_PART), 1u, __ATOMIC_RELAXED, __HIP_MEMORY_SCOPE_WORKGROUP);
            const f32x4 nwa = *(const f32x4*)(a.gdn_norm_w + j * 128 + (tid & 15) * 8), nwb = *(const f32x4*)(a.gdn_norm_w + j * 128 + (tid & 15) * 8 + 4);
            unsigned char* ob = a.ws + WS_G8 + (tb0 + (size_t)chunk * 64) * 2048 + hv * 128;
#pragma unroll
            for (int k = 0; k < 2; ++k) { const int c = tid + 512 + 256 * k;
                float o8[8]; unpack8(ov[k], o8); float ss = 0.f;
#pragma unroll
                for (int e = 0; e < 8; ++e) ss += o8[e] * o8[e];
                const float rinv = __builtin_amdgcn_rsqf(dpp_sum16(ss) * (1.0f / 128.0f) + RMS_EPS);
                float z8[8]; unpack8(zq[k], z8); float r8[8];
#pragma unroll
                for (int e = 0; e < 8; ++e) r8[e] = o8[e] * rinv * (e < 4 ? nwa[e] : nwb[e - 4]) * z8[e];
                constexpr float gs = (float)(1 << F8_GO); v2u w; w.x = pg8::pk4_f8(r8[0] * gs, r8[1] * gs, r8[2] * gs, r8[3] * gs); w.y = pg8::pk4_f8(r8[4] * gs, r8[5] * gs, r8[6] * gs, r8[7] * gs);
                *(v2u*)(ob + (size_t)(c >> 4) * 2048 + (c & 15) * 8) = w; }
        }
    }
#undef CW_ULOAD
}

DI void moe_offsets(const Args& a, int j, unsigned (&off)[9]) {
    unsigned* cnt = (unsigned*)(a.ws + WS_CTL) + CW_CNT + 256 * j; unsigned acc = 0u;
#pragma unroll
    for (int e = 0; e < 8; ++e) { off[e] = acc; const unsigned c = (unsigned)__builtin_amdgcn_readfirstlane((int)__hip_atomic_load(cnt + e, __ATOMIC_RELAXED, __HIP_MEMORY_SCOPE_AGENT)); acc += (c + 255u) & ~255u; }
    off[8] = acc;
}
DI void phase_scatter(const Args& a, int j, LAS unsigned char* lds, int bid, int G, int tid, int wave, int lane) {
    LAS unsigned* lc = (LAS unsigned*)lds; LAS unsigned* lb = lc + 8; LAS unsigned* loff = lc + 16; LAS int* lpos = (LAS int*)(lc + 32);
    const unsigned* E12 = (const unsigned*)(a.ws + WS_E12); int* POS = (int*)(a.ws + WS_POS);
    const unsigned char* HB = a.ws + WS_HB; unsigned char* XS = a.ws + WS_XS;
    unsigned* fill = (unsigned*)(a.ws + WS_CTL) + CW_CNT + 256 * j + 64;
    unsigned off[9]; moe_offsets(a, j, off);
    if (tid == 0) {
#pragma unroll
        for (int e = 0; e < 8; ++e) loff[e] = off[e]; }
    for (int ci = bid; ci < TT / 128; ci += G) {
        __syncthreads();
        if (tid < 8) lc[tid] = 0u;
        __syncthreads();
        unsigned e1 = 0, e2 = 0, r1 = 0, r2 = 0;
        if (tid < 128) { const unsigned w = E12[ci * 128 + tid]; e1 = w & 255u; e2 = (w >> 8) & 255u;
            r1 = __hip_atomic_fetch_add(lc + e1, 1u, __ATOMIC_RELAXED, __HIP_MEMORY_SCOPE_WORKGROUP); r2 = __hip_atomic_fetch_add(lc + e2, 1u, __ATOMIC_RELAXED, __HIP_MEMORY_SCOPE_WORKGROUP); }
        __syncthreads();
        if (tid < 8) lb[tid] = __hip_atomic_fetch_add(fill + tid, lc[tid], __ATOMIC_RELAXED, __HIP_MEMORY_SCOPE_AGENT);
        __syncthreads();
        if (tid < 128) { const int p1 = (int)(loff[e1] + lb[e1] + r1), p2 = (int)(loff[e2] + lb[e2] + r2);
            lpos[2 * tid] = p1; lpos[2 * tid + 1] = p2; POS[2 * (ci * 128 + tid)] = p1; POS[2 * (ci * 128 + tid) + 1] = p2;
            const float hs = ((const float*)(a.ws + WS_HS))[ci * 128 + tid]; float* XSS = (float*)(a.ws + WS_XSS); XSS[p1] = hs; XSS[p2] = hs; }
        __syncthreads();
        for (int tk = wave; tk < 128; tk += NWAVES) {
            const int p1 = lpos[2 * tk], p2 = lpos[2 * tk + 1];
            const v4u* src = (const v4u*)(HB + (size_t)(ci * 128 + tk) * D);
            const v4u x0 = src[lane];
            v4u* d1 = (v4u*)(XS + (size_t)p1 * D); v4u* d2 = (v4u*)(XS + (size_t)p2 * D);
            d1[lane] = x0; d2[lane] = x0;
        }
    }
}

template <bool FINAL>
DI void phase_combine_ln(const Args& a, const bf16* Yin, bf16* Yout, int lnprev, int lnidx, int bid, int G, int wave, int lane) {
    bf16* HB = (bf16*)(a.ws + WS_HB); const unsigned char* YE = a.ws + WS_XS; float* stats = (float*)(a.ws + WS_STATS);
    const int* POS = (const int*)(a.ws + WS_POS); const f32x2* G12 = (const f32x2*)(a.ws + WS_G12);
    const float* g = a.ln_g + (size_t)lnidx * D; const float* bta = a.ln_b + (size_t)lnidx * D;
    const float* gp = a.ln_g + (size_t)lnprev * D; const float* bp = a.ln_b + (size_t)lnprev * D;
    const int gw = bid * NWAVES + wave, NGW = G * NWAVES;
    float gv[2][8], bv[2][8], gq[2][8], bq[2][8];
#pragma unroll
    for (int q = 0; q < 2; ++q)
#pragma unroll
        for (int c = 0; c < 8; ++c) { const int col = 8 * (lane + 64 * q) + c; gv[q][c] = g[col]; bv[q][c] = bta[col]; gq[q][c] = gp[col] * ALPHA; bq[q][c] = bp[col] * ALPHA; }
    int pn1 = 0, pn2 = 0; f32x2 ggn = {0.f, 0.f}, stn = {0.f, 0.f}; v4u ny[2]; v2u ne1[2], ne2[2];
    if (gw < TT) { pn1 = POS[2 * gw]; pn2 = POS[2 * gw + 1]; ggn = G12[gw]; stn = *(const f32x2*)(stats + 2 * (size_t)gw);
#pragma unroll
        for (int q = 0; q < 2; ++q) { ny[q] = ((const v4u*)(Yin + (size_t)gw * D))[lane + 64 * q]; ne1[q] = ((const v2u*)(YE + (size_t)pn1 * D))[lane + 64 * q]; ne2[q] = ((const v2u*)(YE + (size_t)pn2 * D))[lane + 64 * q]; } }
    int pa1 = 0, pa2 = 0; if (gw + NGW < TT) { pa1 = POS[2 * (gw + NGW)]; pa2 = POS[2 * (gw + NGW) + 1]; }
    for (int t = gw; t < TT; t += NGW) {
        const f32x2 gg = ggn * (1.0f / (float)(1 << F8_YE)); const f32x2 st = stn;
        v4u cy[2]; v2u ce1[2], ce2[2];
#pragma unroll
        for (int q = 0; q < 2; ++q) { cy[q] = ny[q]; ce1[q] = ne1[q]; ce2[q] = ne2[q]; }
        if (t + NGW < TT) { const int tn = t + NGW; ggn = G12[tn]; stn = *(const f32x2*)(stats + 2 * (size_t)tn);
#pragma unroll
            for (int q = 0; q < 2; ++q) { ny[q] = ((const v4u*)(Yin + (size_t)tn * D))[lane + 64 * q]; ne1[q] = ((const v2u*)(YE + (size_t)pa1 * D))[lane + 64 * q]; ne2[q] = ((const v2u*)(YE + (size_t)pa2 * D))[lane + 64 * q]; } }
        if (t + 2 * NGW < TT) { pa1 = POS[2 * (t + 2 * NGW)]; pa2 = POS[2 * (t + 2 * NGW) + 1]; }
        float v[2][8]; float s = 0.f;
#pragma unroll
        for (int q = 0; q < 2; ++q) { float y[8], e1[8], e2[8];
            unpack8(cy[q], y); unpack8_f8(ce1[q], e1); unpack8_f8(ce2[q], e2);
#pragma unroll
            for (int c = 0; c < 8; ++c) { v[q][c] = (y[c] - st.x) * st.y * gq[q][c] + bq[q][c] + e1[c] * gg.x + e2[c] * gg.y; s += v[q][c]; } }
        const float mean = wave_sum(s) * (1.0f / D); float s2 = 0.f;
#pragma unroll
        for (int q = 0; q < 2; ++q)
#pragma unroll
            for (int c = 0; c < 8; ++c) { const float d = v[q][c] - mean; s2 += d * d; }
        const float rstd = 1.0f / sqrtf(wave_sum(s2) * (1.0f / D) + LN_EPS);
        if (!FINAL && lane == 0) *(f32x2*)(stats + 2 * (size_t)t) = (f32x2){mean, rstd};
        float hn[2][8]; float am = 0.f;
#pragma unroll
        for (int q = 0; q < 2; ++q)
#pragma unroll
            for (int c = 0; c < 8; ++c) { hn[q][c] = (v[q][c] - mean) * rstd * gv[q][c] + bv[q][c]; am = fmaxf(am, fabsf(hn[q][c])); }
        if (FINAL) {
#pragma unroll
            for (int q = 0; q < 2; ++q) { f32x4* orow = (f32x4*)(a.out + (size_t)t * D + 8 * (lane + 64 * q)); orow[0] = (f32x4){hn[q][0], hn[q][1], hn[q][2], hn[q][3]}; orow[1] = (f32x4){hn[q][4], hn[q][5], hn[q][6], hn[q][7]}; }
        } else {
            am = fmaxf(wave_max_nn(am), 1.0e-20f); const float qs = 127.0f / am;
            if (lane == 0) ((float*)(a.ws + WS_HS))[t] = am * (1.0f / 127.0f);
#pragma unroll
            for (int q = 0; q < 2; ++q) { v4u yo; yo.x = pk2(v[q][0], v[q][1]); yo.y = pk2(v[q][2], v[q][3]); yo.z = pk2(v[q][4], v[q][5]); yo.w = pk2(v[q][6], v[q][7]); ((v4u*)(Yout + (size_t)t * D))[lane + 64 * q] = yo;
                v2u o; o.x = pk4_i8(hn[q][0] * qs, hn[q][1] * qs, hn[q][2] * qs, hn[q][3] * qs); o.y = pk4_i8(hn[q][4] * qs, hn[q][5] * qs, hn[q][6] * qs, hn[q][7] * qs);
                ((v2u*)((unsigned char*)HB + (size_t)t * D))[lane + 64 * q] = o; }
        }
    }
}

constexpr int ARGS_OFF = RING_BYTES + 1024;
DI unsigned long long lds_u64(LAS unsigned char* p) { const v2u w = *(const volatile LAS v2u*)p; return ((unsigned long long)(unsigned)__builtin_amdgcn_readfirstlane((int)w.y) << 32) | (unsigned)__builtin_amdgcn_readfirstlane((int)w.x); }
DI Args load_args(LAS unsigned char* lds) {
    Args a; LAS unsigned char* p = lds + ARGS_OFF;
    a.x = (const float*)(const GAS float*)lds_u64(p + 0); a.gdn_w_in = (const float*)(const GAS float*)lds_u64(p + 8); a.gdn_conv_w = (const float*)(const GAS float*)lds_u64(p + 16); a.gdn_a_log = (const float*)(const GAS float*)lds_u64(p + 24);
    a.gdn_dt_bias = (const float*)(const GAS float*)lds_u64(p + 32); a.gdn_norm_w = (const float*)(const GAS float*)lds_u64(p + 40); a.gdn_w_out = (const float*)(const GAS float*)lds_u64(p + 48); a.sb_w_in = (const float*)(const GAS float*)lds_u64(p + 56);
    a.sb_w_out = (const float*)(const GAS float*)lds_u64(p + 64); a.ffn_w_gate = (const float*)(const GAS float*)lds_u64(p + 72); a.ffn_w_up = (const float*)(const GAS float*)lds_u64(p + 80); a.ffn_w_down = (const float*)(const GAS float*)lds_u64(p + 88);
    a.moe_router = (const float*)(const GAS float*)lds_u64(p + 96); a.moe_w_gate = (const float*)(const GAS float*)lds_u64(p + 104); a.moe_w_up = (const float*)(const GAS float*)lds_u64(p + 112); a.moe_w_down = (const float*)(const GAS float*)lds_u64(p + 120);
    a.ln_g = (const float*)(const GAS float*)lds_u64(p + 128); a.ln_b = (const float*)(const GAS float*)lds_u64(p + 136); a.out = (float*)(GAS float*)lds_u64(p + 144); a.ws = (unsigned char*)(GAS unsigned char*)lds_u64(p + 152);
    const v2u w = *(const volatile LAS v2u*)(p + 160); a.ph_lo = __builtin_amdgcn_readfirstlane((int)w.x); a.ph_hi = __builtin_amdgcn_readfirstlane((int)w.y);
    return a;
}
#ifdef PH_ONLY
#define IN(k) (((k) % NPH) == PH_ONLY && lo <= (k) && (k) < hi)
#else
#define IN(k) (lo <= (k) && (k) < hi)
#endif
#define SEAM(k) do { if ((k) + 1 < hi) xcd_barrier(bar, tid == 0); } while (0)
DI int fresh_lane() { int l; asm volatile("v_mbcnt_lo_u32_b32 %0, -1, 0\n\tv_mbcnt_hi_u32_b32 %0, -1, %0" : "=v"(l)); return l; }
#define YMOE ((bf16*)(j == 1 ? (void*)(args.ws + WS_YT) : (void*)args.out))
#define ARGS() const Args args = load_args(lds); const int lo = args.ph_lo, hi = args.ph_hi; const int lane = fresh_lane(), tid = wave * 64 + lane
#ifndef PROBE_REP_MASK
#define PROBE_REP_MASK 0
#endif
#ifndef PROBE_DELAY_MASK
#define PROBE_DELAY_MASK 0
#endif
#define PROBE_DELAY_MULT 4u
#define TICK_IN(k) do { if (((PROBE_DELAY_MASK) >> (k)) & 1) { if (bid == 0 && tid == 0) ((volatile LAS unsigned*)(lds + MISC_OFF))[20] -= (unsigned)__builtin_amdgcn_s_memrealtime(); } } while (0)
#define TICK_OUT(k) do { if (((PROBE_DELAY_MASK) >> (k)) & 1) { if (bid == 0 && tid == 0) ((volatile LAS unsigned*)(lds + MISC_OFF))[20] += (unsigned)__builtin_amdgcn_s_memrealtime(); } } while (0)
#define NREP(k) ((((PROBE_REP_MASK) >> (k)) & 1) ? 2 : 1)
template <int j>
DI void layer_pair(LAS unsigned char* lds, const XcdBarrier& bar, const int wave, const int G, const int bid) {
    constexpr int pb = j * NPH;
    if constexpr (j == 0) { ARGS(); if (IN(pb + 0)) { TICK_IN(0); _Pragma("unroll 1") for (int rep_ = 0; rep_ < NREP(0); ++rep_) { phase_w_gdn(args, j, 3, lds, bid, G, tid, wave, lane); } SEAM(pb + 0); TICK_OUT(0); } }
    { ARGS(); if (IN(pb + 1)) { TICK_IN(1); {
        pg8::Gemm g{(const bf16*)(args.ws + WS_HB), (const bf16*)(args.ws + W_IN_(j)), D / 2, D / 2}; pg8::StaticOrder S; S.init(TT, GINP, G, bid, NREP(1));
        pg8::EpiI8<pg8::EpiInProj> E{{(bf16*)(args.ws + WS_RAW), (bf16*)(args.ws + WS_ZB)}, (const float*)(args.ws + WS_HS), (const float*)(args.ws + WS_SWI_(j))};
        pg8::gemm_phase<pg8::EpiI8<pg8::EpiInProj>, pg8::StaticOrder, true, true, 2>(lds, g, S, E, wave);
        } SEAM(pb + 1); TICK_OUT(1); } }
    { ARGS(); if (IN(pb + 2)) { TICK_IN(2); _Pragma("unroll 1") for (int rep_ = 0; rep_ < NREP(2); ++rep_) { phase_conv(args, j, bid, G, tid); } SEAM(pb + 2); TICK_OUT(2); } }
#if GDN_NAIVE
    { ARGS(); if (IN(pb + 4)) { TICK_IN(4); _Pragma("unroll 1") for (int rep_ = 0; rep_ < NREP(4); ++rep_) { phase_gdn_naive(args, j, lds, bid, tid); } SEAM(pb + 4); TICK_OUT(4); } }
#else
    { ARGS(); if (IN(pb + 3)) { TICK_IN(3); _Pragma("unroll 1") for (int rep_ = 0; rep_ < NREP(3); ++rep_) { phase_gdn_local(args, lds, bid, G, wave, lane, rep_ + 1 < NREP(3)); } SEAM(pb + 3); TICK_OUT(3); } }
    { ARGS(); if (IN(pb + 4)) { TICK_IN(4); _Pragma("unroll 1") for (int rep_ = 0; rep_ < NREP(4); ++rep_) { if (bid >= BATCH * HV && G > BATCH * HV) phase_w_sb(args, j, lds, bid - BATCH * HV, G - BATCH * HV, wave, lane); else if (G <= BATCH * HV && rep_ == 0) phase_w_sb(args, j, lds, bid, G, wave, lane);
        phase_gdn_scan(args, j, lds, bid, tid, rep_ + 1 < NREP(4)); } SEAM(pb + 4); TICK_OUT(4); } }
#endif
    { ARGS(); if (IN(pb + 5)) { TICK_IN(5); {
        pg8::Gemm g{(const bf16*)(args.ws + WS_G8), (const bf16*)(args.ws + W_OUT_(j)), 1024, 1024}; pg8::StaticOrder S; S.init(TT, D, G, bid);
        pg8::EpiResid<(j > 0), F8_GO + F8_WO> E{j == 0 ? (const void*)args.x : (const void*)args.out, (bf16*)args.out, (const float*)(args.ws + WS_STATS), args.ln_g + (size_t)(4 * (j > 0 ? j - 1 : 0) + 3) * D, args.ln_b + (size_t)(4 * (j > 0 ? j - 1 : 0) + 3) * D};
        pg8::gemm_phase<pg8::EpiResid<(j > 0), F8_GO + F8_WO>, pg8::StaticOrder, true, true, 1>(lds, g, S, E, wave);
        } SEAM(pb + 5); TICK_OUT(5); } }
    { ARGS(); if (IN(pb + 6)) { TICK_IN(6); _Pragma("unroll 1") for (int rep_ = 0; rep_ < NREP(6); ++rep_) { phase_ln<false, true>(args, (const bf16*)args.out, (2 * j) * 2 + 0, j, lds, bid, G, tid, wave, lane); } SEAM(pb + 6); TICK_OUT(6); } }
    { ARGS(); if (IN(pb + 7)) { TICK_IN(7); {
        pg8::Gemm g{(const bf16*)(args.ws + WS_HB), (const bf16*)(args.ws + W_GU_(j)), D / 2, D / 2}; pg8::StaticOrder S; S.init(TT, 2 * FF, G, bid, NREP(7));
        pg8::EpiI8SwiGLUf<F8_ACT> E{args.ws + WS_ACT, FF, 0, (const float*)(args.ws + WS_HS), (const float*)(args.ws + WS_SWD_(j))};
        pg8::gemm_phase<pg8::EpiI8SwiGLUf<F8_ACT>, pg8::StaticOrder, true, true, 2>(lds, g, S, E, wave);
        } SEAM(pb + 7); TICK_OUT(7); } }
    { ARGS(); if (IN(pb + 8)) { TICK_IN(8); {
        pg8::Gemm g{(const bf16*)(args.ws + WS_ACT), (const bf16*)(args.ws + W_D_(j)), FF / 2, FF / 2}; pg8::StaticOrder S; S.init(TT, D, G, bid);
        pg8::EpiResid<true, F8_ACT + F8_WD> E{(const void*)args.out, (bf16*)args.out, (const float*)(args.ws + WS_STATS), args.ln_g + (size_t)(4 * j + 0) * D, args.ln_b + (size_t)(4 * j + 0) * D};
        pg8::gemm_phase<pg8::EpiResid<true, F8_ACT + F8_WD>, pg8::StaticOrder, true, true, 1>(lds, g, S, E, wave);
        } SEAM(pb + 8); TICK_OUT(8); } }
    { ARGS(); if (IN(pb + 9)) { TICK_IN(9); _Pragma("unroll 1") for (int rep_ = 0; rep_ < NREP(9); ++rep_) { phase_ln<false, true>(args, (const bf16*)args.out, (2 * j) * 2 + 1, j, lds, bid, G, tid, wave, lane); } SEAM(pb + 9); TICK_OUT(9); } }
    { ARGS(); if (IN(pb + 10)) { TICK_IN(10); {
        pg8::Gemm g{(const bf16*)(args.ws + WS_HB), (const bf16*)(args.ws + W_QKV), D / 2, D / 2}; pg8::StaticOrder S; S.init(TT, 3072, G, bid, NREP(10));
        pg8::EpiI8<pg8::EpiBf16> E{{(bf16*)(args.ws + WS_QKV), 3072, 0}, (const float*)(args.ws + WS_HS), (const float*)(args.ws + WS_SWQ)};
        pg8::gemm_phase<pg8::EpiI8<pg8::EpiBf16>, pg8::StaticOrder, true, true, 2>(lds, g, S, E, wave);
        } SEAM(pb + 10); TICK_OUT(10); } }
    #if SB_NAIVE
    { ARGS(); if (IN(pb + 11)) { TICK_IN(11); _Pragma("unroll 1") for (int rep_ = 0; rep_ < NREP(11); ++rep_) { phase_sb_naive(args, lds, bid, G, tid); } SEAM(pb + 11); TICK_OUT(11); } }
#else
    { ARGS(); if (IN(pb + 11)) { TICK_IN(11); _Pragma("unroll 1") for (int rep_ = 0; rep_ < NREP(11); ++rep_) { phase_sb_mfma(args, lds, bid, G, tid); } SEAM(pb + 11); TICK_OUT(11); } }
#endif
    { ARGS(); if (IN(pb + 12)) { TICK_IN(12); {
        pg8::Gemm g{(const bf16*)(args.ws + WS_AO), (const bf16*)(args.ws + W_O), D / 2, D / 2}; pg8::StaticOrder S; S.init(TT, D, G, bid);
        pg8::EpiResid<true, F8_AO + F8_WSO> E{(const void*)args.out, YMOE, (const float*)(args.ws + WS_STATS), args.ln_g + (size_t)(4 * j + 1) * D, args.ln_b + (size_t)(4 * j + 1) * D};
        pg8::gemm_phase<pg8::EpiResid<true, F8_AO + F8_WSO>, pg8::StaticOrder, true, true, 1>(lds, g, S, E, wave);
        } SEAM(pb + 12); TICK_OUT(12); } }
    { ARGS(); if (IN(pb + 13)) { TICK_IN(13); _Pragma("unroll 1") for (int rep_ = 0; rep_ < NREP(13); ++rep_) { phase_ln<true, true>(args, YMOE, (2 * j + 1) * 2 + 0, j, lds, bid, G, tid, wave, lane); } SEAM(pb + 13); TICK_OUT(13); } }
    { ARGS(); if (IN(pb + 14)) { TICK_IN(14); _Pragma("unroll 1") for (int rep_ = 0; rep_ < NREP(14); ++rep_) { phase_scatter(args, j, lds, bid, G, tid, wave, lane); } SEAM(pb + 14); TICK_OUT(14); } }
    { ARGS(); if (IN(pb + 15)) { TICK_IN(15); {
        unsigned off[9]; moe_offsets(args, j, off);
        pg8::MoeOrder S; S.nM = (int)(off[8] >> 8); S.G = G; S.c = bid; S.nN = 2 * FF / 256; S.nwg = S.nM * S.nN; S.rep = NREP(15);
        S.ps1 = (int)(off[1] >> 8); S.ps2 = (int)(off[2] >> 8); S.ps3 = (int)(off[3] >> 8); S.ps4 = (int)(off[4] >> 8); S.ps5 = (int)(off[5] >> 8); S.ps6 = (int)(off[6] >> 8); S.ps7 = (int)(off[7] >> 8);
        pg8::Gemm g{(const bf16*)(args.ws + WS_XS), (const bf16*)(args.ws + W_MGU), D / 2, D / 2};
        pg8::EpiI8SwiGLUf<F8_ACT> E{args.ws + WS_MACT, FF, 2 * FF / 256, (const float*)(args.ws + WS_XSS), (const float*)(args.ws + WS_SWM)};
        pg8::gemm_phase<pg8::EpiI8SwiGLUf<F8_ACT>, pg8::MoeOrder, true, true, 2>(lds, g, S, E, wave);
        } SEAM(pb + 15); TICK_OUT(15); } }
    { ARGS(); if (IN(pb + 16)) { TICK_IN(16); {
        unsigned off[9]; moe_offsets(args, j, off);
        pg8::MoeOrder S; S.nM = (int)(off[8] >> 8); S.G = G; S.c = bid; S.nN = D / 256; S.nwg = S.nM * S.nN; S.rep = NREP(16);
        S.ps1 = (int)(off[1] >> 8); S.ps2 = (int)(off[2] >> 8); S.ps3 = (int)(off[3] >> 8); S.ps4 = (int)(off[4] >> 8); S.ps5 = (int)(off[5] >> 8); S.ps6 = (int)(off[6] >> 8); S.ps7 = (int)(off[7] >> 8);
        pg8::Gemm g{(const bf16*)(args.ws + WS_MACT), (const bf16*)(args.ws + W_MD), FF / 2, FF / 2};
        pg8::EpiF8T<F8_ACT + F8_WD, F8_YE> E{args.ws + WS_XS, D, D / 256};
        pg8::gemm_phase<pg8::EpiF8T<F8_ACT + F8_WD, F8_YE>, pg8::MoeOrder, true, true, 1>(lds, g, S, E, wave);
        if constexpr (j == 0) phase_w_gdn_dyn(args, 1, (unsigned*)(args.ws + WS_CTL) + CW_WQ, lds, wave);
        } SEAM(pb + 16); TICK_OUT(16); } }
    { ARGS(); if (IN(pb + 17)) { TICK_IN(17); _Pragma("unroll 1") for (int rep_ = 0; rep_ < NREP(17); ++rep_) { phase_combine_ln<(j == 1)>(args, YMOE, (bf16*)args.out, 4 * j + 2, 4 * j + 3, bid, G, wave, lane); } SEAM(pb + 17); TICK_OUT(17); } }
}
__global__ void __launch_bounds__(NWAVES * 64, 2) fwd(Args kargs) {
    extern __shared__ __attribute__((aligned(16))) unsigned char lds_raw[];
    LAS unsigned char* lds = (LAS unsigned char*)lds_raw;
    volatile LAS unsigned* MISC = (volatile LAS unsigned*)(lds + MISC_OFF);
    const int tid = threadIdx.x, lane = tid & 63, wave = __builtin_amdgcn_readfirstlane(tid >> 6), G = gridDim.x, bid = blockIdx.x;
    for (int u = tid; u < (LDS_BYTES - RING_BYTES) / 4; u += NWAVES * 64) ((LAS unsigned*)(lds + RING_BYTES))[u] = 0u;
    __syncthreads();
    if (tid == 0) { LAS unsigned long long* pa = (LAS unsigned long long*)(lds + ARGS_OFF);
        pa[0] = (unsigned long long)kargs.x; pa[1] = (unsigned long long)kargs.gdn_w_in; pa[2] = (unsigned long long)kargs.gdn_conv_w; pa[3] = (unsigned long long)kargs.gdn_a_log;
        pa[4] = (unsigned long long)kargs.gdn_dt_bias; pa[5] = (unsigned long long)kargs.gdn_norm_w; pa[6] = (unsigned long long)kargs.gdn_w_out; pa[7] = (unsigned long long)kargs.sb_w_in;
        pa[8] = (unsigned long long)kargs.sb_w_out; pa[9] = (unsigned long long)kargs.ffn_w_gate; pa[10] = (unsigned long long)kargs.ffn_w_up; pa[11] = (unsigned long long)kargs.ffn_w_down;
        pa[12] = (unsigned long long)kargs.moe_router; pa[13] = (unsigned long long)kargs.moe_w_gate; pa[14] = (unsigned long long)kargs.moe_w_up; pa[15] = (unsigned long long)kargs.moe_w_down;
        pa[16] = (unsigned long long)kargs.ln_g; pa[17] = (unsigned long long)kargs.ln_b; pa[18] = (unsigned long long)kargs.out; pa[19] = (unsigned long long)kargs.ws;
        pa[20] = (unsigned long long)(unsigned)kargs.ph_lo | ((unsigned long long)(unsigned)kargs.ph_hi << 32); }
    XcdBarrier bar = xcd_barrier_post((unsigned*)(kargs.ws + WS_CTL) + CW_BAR, MISC + 8);
    __syncthreads();
    layer_pair<0>(lds, bar, wave, G, bid);
    layer_pair<1>(lds, bar, wave, G, bid);
    if (PROBE_DELAY_MASK || PROBE_SEC) { if (bid == 0 && threadIdx.x == 0) { const unsigned acc = ((volatile LAS unsigned*)(lds + MISC_OFF))[20] * PROBE_DELAY_MULT; const unsigned long long t0 = __builtin_amdgcn_s_memrealtime(); while ((unsigned)(__builtin_amdgcn_s_memrealtime() - t0) < acc) __builtin_amdgcn_s_sleep(8); } }
}
#undef IN
#undef SEAM
#undef ARGS

extern "C" void kernel_launch(void* const* d_in, const int* in_sizes, int n_in, void* d_out, int out_size, void* d_ws, size_t ws_size, hipStream_t stream) {
    static int grid = 0;
    if (grid == 0) {
        if (n_in != 18 || in_sizes[0] != TT * D || out_size != TT * D || ws_size < WS_END) { fprintf(stderr, "kernel_launch: unexpected shapes (n_in %d, in0 %d, out %d, ws %zu); nothing launched\n", n_in, n_in > 0 ? in_sizes[0] : -1, out_size, ws_size); grid = -1; return; }
        int dev = 0, cus = 0, per_cu = 0;
        if (hipGetDevice(&dev) != hipSuccess || hipDeviceGetAttribute(&cus, hipDeviceAttributeMultiprocessorCount, dev) != hipSuccess) { grid = -1; return; }
        if (hipFuncSetAttribute((const void*)fwd, hipFuncAttributeMaxDynamicSharedMemorySize, LDS_BYTES) != hipSuccess) { fprintf(stderr, "kernel_launch: hipFuncSetAttribute failed\n"); grid = -1; return; }
        if (hipOccupancyMaxActiveBlocksPerMultiprocessor(&per_cu, (const void*)fwd, NWAVES * 64, LDS_BYTES) != hipSuccess || per_cu < 1) { fprintf(stderr, "kernel_launch: occupancy query says %d blocks per CU\n", per_cu); (void)hipGetLastError(); grid = -1; return; }
        grid = cus;
    }
    if (grid < 0) return;
    if (hipMemsetAsync((char*)d_ws + WS_CTL, 0, CTL_ZERO_BYTES, stream) != hipSuccess) return;
    Args a{};
    a.x = (const float*)d_in[0]; a.gdn_w_in = (const float*)d_in[1]; a.gdn_conv_w = (const float*)d_in[2]; a.gdn_a_log = (const float*)d_in[3]; a.gdn_dt_bias = (const float*)d_in[4];
    a.gdn_norm_w = (const float*)d_in[5]; a.gdn_w_out = (const float*)d_in[6]; a.sb_w_in = (const float*)d_in[7]; a.sb_w_out = (const float*)d_in[8];
    a.ffn_w_gate = (const float*)d_in[9]; a.ffn_w_up = (const float*)d_in[10]; a.ffn_w_down = (const float*)d_in[11]; a.moe_router = (const float*)d_in[12];
    a.moe_w_gate = (const float*)d_in[13]; a.moe_w_up = (const float*)d_in[14]; a.moe_w_down = (const float*)d_in[15]; a.ln_g = (const float*)d_in[16]; a.ln_b = (const float*)d_in[17];
    a.out = (float*)d_out; a.ws = (unsigned char*)d_ws;
#if MK_ONE_LAUNCH
    a.ph_lo = 0; a.ph_hi = NPHASES;
    hipLaunchKernelGGL(fwd, dim3(grid), dim3(NWAVES * 64), LDS_BYTES, stream, a);
#else
    for (int p = 0; p < NPHASES; ++p) { a.ph_lo = p; a.ph_hi = p + 1; hipLaunchKernelGGL(fwd, dim3(grid), dim3(NWAVES * 64), LDS_BYTES, stream, a); }
#endif
}
```

```cpp
#include <hip/hip_runtime.h>
#include <cstdio>
#include <cstdint>
#ifndef GDN_NAIVE
#define GDN_NAIVE 0
#endif
#ifndef SB_NAIVE
#define SB_NAIVE 0
#endif
#ifndef MK_ONE_LAUNCH
#define MK_ONE_LAUNCH 1
#endif
#ifndef PROBE_SEC
#define PROBE_SEC 0
#endif
#define GSEC_ACC(k, sign) do { if (PROBE_SEC == (k)) { if (blockIdx.x == 0 && threadIdx.x == 0) { volatile __attribute__((address_space(3))) unsigned* p_ = (volatile __attribute__((address_space(3))) unsigned*)(131072 + 320 + 80); *p_ = *p_ sign (unsigned)__builtin_amdgcn_s_memrealtime(); } } } while (0)
namespace pg8 {
#define PG8_LAS __attribute__((address_space(3)))
typedef unsigned short bf16_t;
typedef short bf16x8 __attribute__((ext_vector_type(8)));
typedef float f32x4 __attribute__((ext_vector_type(4)));
typedef unsigned u32x4 __attribute__((ext_vector_type(4)));
constexpr int BM = 256, BK = 64, HALF = 128, HTB = HALF * BK * 2  , STAGE_BYTES = 8 * HTB, NXCD = 8, WGM = 8;

__host__ __device__ __forceinline__ int lds_byte(int r, int c) { const int st = (r >> 4) * 2 + (c >> 5), rr = r & 15, cc = c & 31, ob = rr * 64 + cc * 2; return st * 1024 + (ob ^ (((ob >> 9) & 1) << 5)); }
__host__ __device__ __forceinline__ void stage_rc(int b, int& R, int& C) { const int st = b / 1024, sb = b % 1024, swz = sb ^ (((sb >> 9) & 1) << 5); R = (st >> 1) * 16 + swz / 64; C = (st & 1) * 32 + (swz % 64) / 2; }
__host__ __device__ __forceinline__ int perm32(int rho) { const int n = rho >> 4, i = rho & 15; return 8 * (i >> 2) + 4 * n + (i & 3); }

struct Unit { int pm, pn; };
struct Gemm { const bf16_t* A; const bf16_t* Bt; int lda, K; };

struct StaticOrder {
    int nM, nN, nwg, G, c, rep;
    __host__ __device__ void init(int M, int N, int G_, int c_, int rep_ = 1) { nM = M / BM; nN = N / BM; nwg = nM * nN; G = G_; c = c_; rep = rep_; }
    __host__ __device__ bool next(int i, Unit& u) const {
        const int L = i * G + c; if (L >= rep * nwg) return false;
        int wgid = rep == 1 ? L : L % nwg; { const int q = nwg / NXCD, r = nwg % NXCD, xcd = wgid % NXCD, off = wgid / NXCD; wgid = (xcd < r ? xcd * (q + 1) : r * (q + 1) + (xcd - r) * q) + off; }
        const int nig = WGM * nN, gid = wgid / nig, fm = gid * WGM, gsz = (nM - fm) < WGM ? (nM - fm) : WGM;
        u.pm = fm + ((wgid % nig) % gsz); u.pn = (wgid % nig) / gsz; return true;
    }
    __device__ __forceinline__ void a_ready(const Unit&) const {}
    __device__ __forceinline__ void done(const Unit&) const {}
};

__device__ __forceinline__ unsigned cvt_pk_bf16(float lo, float hi) { unsigned r; asm volatile("v_cvt_pk_bf16_f32 %0, %1, %2" : "=v"(r) : "v"(lo), "v"(hi)); return r; }
template <int SCL2 = 0> struct EpiBf16T {
    static constexpr bool PERM = true, AFTER_DRAIN = false;
    bf16_t* O; int ldc; int nmod;
    __device__ __forceinline__ void operator()(const f32x4 (&acc)[2][2][4][2], const Unit& u, int wr, int wc, int fr, int fq) const {
        const int pnl = nmod ? (u.pn % nmod) : u.pn;
        const int row0 = u.pm * BM + wr * 64 + fr, col0 = pnl * BM + wc * 32 + 8 * fq;
#pragma unroll
        for (int ai = 0; ai < 2; ++ai)
#pragma unroll
            for (int m = 0; m < 4; ++m) { bf16_t* rowp = O + (size_t)(row0 + ai * HALF + m * 16) * ldc + col0;
#pragma unroll
                for (int bj = 0; bj < 2; ++bj) { constexpr float sc = 1.0f / (float)(1 << SCL2); const f32x4 v0 = acc[ai][bj][m][0] * sc, v1 = acc[ai][bj][m][1] * sc;
                    u32x4 w; w.x = cvt_pk_bf16(v0[0], v0[1]); w.y = cvt_pk_bf16(v0[2], v0[3]); w.z = cvt_pk_bf16(v1[0], v1[1]); w.w = cvt_pk_bf16(v1[2], v1[3]);
                    *(u32x4*)(rowp + bj * HALF) = w; } }
    }
};
typedef EpiBf16T<0> EpiBf16;
struct EpiInProj {
    static constexpr bool PERM = true, AFTER_DRAIN = false;
    bf16_t* RAW; bf16_t* ZB;
    __device__ __forceinline__ void operator()(const f32x4 (&acc)[2][2][4][2], const Unit& u, int wr, int wc, int fr, int fq) const {
        const bool isz = (u.pn >= 16 && u.pn < 24);
        bf16_t* O = isz ? ZB : RAW; const int ldc = isz ? 2048 : 4352; const int ct = isz ? (u.pn - 16) : (u.pn < 16 ? u.pn : 16);
        const int row0 = u.pm * BM + wr * 64 + fr, col0 = ct * BM + wc * 32 + 8 * fq;
#pragma unroll
        for (int ai = 0; ai < 2; ++ai)
#pragma unroll
            for (int m = 0; m < 4; ++m) { bf16_t* rowp = O + (size_t)(row0 + ai * HALF + m * 16) * ldc + col0;
#pragma unroll
                for (int bj = 0; bj < 2; ++bj) { f32x4 v0 = acc[ai][bj][m][0], v1 = acc[ai][bj][m][1];
                    if (isz) {
#pragma unroll
                        for (int e = 0; e < 4; ++e) { v0[e] = v0[e] * __builtin_amdgcn_rcpf(1.0f + __builtin_amdgcn_exp2f(-1.4426950408889634f * v0[e])); v1[e] = v1[e] * __builtin_amdgcn_rcpf(1.0f + __builtin_amdgcn_exp2f(-1.4426950408889634f * v1[e])); } }
                    u32x4 w; w.x = cvt_pk_bf16(v0[0], v0[1]); w.y = cvt_pk_bf16(v0[2], v0[3]); w.z = cvt_pk_bf16(v1[0], v1[1]); w.w = cvt_pk_bf16(v1[2], v1[3]);
                    *(u32x4*)(rowp + bj * HALF) = w; } }
    }
};
__device__ __forceinline__ float silu_f(float x) { return x * __builtin_amdgcn_rcpf(1.0f + __builtin_amdgcn_exp2f(-1.4426950408889634f * x)); }
struct EpiSwiGLU {
    static constexpr bool PERM = true, AFTER_DRAIN = false;
    bf16_t* O; int ldc; int nmod;
    __device__ __forceinline__ void operator()(const f32x4 (&acc)[2][2][4][2], const Unit& u, int wr, int wc, int fr, int fq) const {
        const int pnl = nmod ? (u.pn % nmod) : u.pn;
        const int row0 = u.pm * BM + wr * 64 + fr, col0 = pnl * HALF + wc * 32 + 8 * fq;
#pragma unroll
        for (int ai = 0; ai < 2; ++ai)
#pragma unroll
            for (int m = 0; m < 4; ++m) { bf16_t* rowp = O + (size_t)(row0 + ai * HALF + m * 16) * ldc + col0;
                const f32x4 g0 = acc[ai][0][m][0], g1 = acc[ai][0][m][1], u0 = acc[ai][1][m][0], u1 = acc[ai][1][m][1];
                u32x4 w;
                w.x = cvt_pk_bf16(silu_f(g0[0]) * u0[0], silu_f(g0[1]) * u0[1]); w.y = cvt_pk_bf16(silu_f(g0[2]) * u0[2], silu_f(g0[3]) * u0[3]);
                w.z = cvt_pk_bf16(silu_f(g1[0]) * u1[0], silu_f(g1[1]) * u1[1]); w.w = cvt_pk_bf16(silu_f(g1[2]) * u1[2], silu_f(g1[3]) * u1[3]);
                *(u32x4*)rowp = w; }
    }
};
__device__ __forceinline__ float clamp_f8(float x) { return __builtin_fminf(__builtin_fmaxf(x, -448.0f), 448.0f); }
__device__ __forceinline__ unsigned pk4_f8(float a, float b, float c, float d) { int w = 0; w = __builtin_amdgcn_cvt_pk_fp8_f32(clamp_f8(a), clamp_f8(b), w, false); w = __builtin_amdgcn_cvt_pk_fp8_f32(clamp_f8(c), clamp_f8(d), w, true); return (unsigned)w; }
typedef unsigned u32x2 __attribute__((ext_vector_type(2)));
template <int SCL2, int OSC2> struct EpiSwiGLU8 {
    static constexpr bool PERM = true, AFTER_DRAIN = false;
    unsigned char* O; int ldc; int nmod;
    __device__ __forceinline__ void operator()(const f32x4 (&acc)[2][2][4][2], const Unit& u, int wr, int wc, int fr, int fq) const {
        constexpr float cg = 1.0f / (float)(1 << SCL2), cu = cg * (float)(1 << OSC2);
        const int pnl = nmod ? (u.pn % nmod) : u.pn;
        const int row0 = u.pm * BM + wr * 64 + fr, col0 = pnl * HALF + wc * 32 + 8 * fq;
#pragma unroll
        for (int ai = 0; ai < 2; ++ai)
#pragma unroll
            for (int m = 0; m < 4; ++m) { unsigned char* rowp = O + (size_t)(row0 + ai * HALF + m * 16) * ldc + col0;
                const f32x4 g0 = acc[ai][0][m][0] * cg, g1 = acc[ai][0][m][1] * cg, u0 = acc[ai][1][m][0] * cu, u1 = acc[ai][1][m][1] * cu;
                u32x2 w;
                w.x = pk4_f8(silu_f(g0[0]) * u0[0], silu_f(g0[1]) * u0[1], silu_f(g0[2]) * u0[2], silu_f(g0[3]) * u0[3]);
                w.y = pk4_f8(silu_f(g1[0]) * u1[0], silu_f(g1[1]) * u1[1], silu_f(g1[2]) * u1[2], silu_f(g1[3]) * u1[3]);
                *(u32x2*)rowp = w; }
    }
};
template <int SCL2, int OSC2> struct EpiF8T {
    static constexpr bool PERM = true, AFTER_DRAIN = false;
    unsigned char* O; int ldc; int nmod;
    __device__ __forceinline__ void operator()(const f32x4 (&acc)[2][2][4][2], const Unit& u, int wr, int wc, int fr, int fq) const {
        constexpr float sc = OSC2 >= SCL2 ? (float)(1 << (OSC2 >= SCL2 ? OSC2 - SCL2 : 0)) : 1.0f / (float)(1 << (SCL2 > OSC2 ? SCL2 - OSC2 : 0));
        const int pnl = nmod ? (u.pn % nmod) : u.pn;
        const int row0 = u.pm * BM + wr * 64 + fr, col0 = pnl * BM + wc * 32 + 8 * fq;
#pragma unroll
        for (int ai = 0; ai < 2; ++ai)
#pragma unroll
            for (int m = 0; m < 4; ++m) { unsigned char* rowp = O + (size_t)(row0 + ai * HALF + m * 16) * ldc + col0;
#pragma unroll
                for (int bj = 0; bj < 2; ++bj) { const f32x4 v0 = acc[ai][bj][m][0] * sc, v1 = acc[ai][bj][m][1] * sc;
                    u32x2 w; w.x = pk4_f8(v0[0], v0[1], v0[2], v0[3]); w.y = pk4_f8(v1[0], v1[1], v1[2], v1[3]);
                    *(u32x2*)(rowp + bj * HALF) = w; } }
    }
};
__device__ __forceinline__ f32x4 cvt_i4(const f32x4 a) { typedef int i32x4e __attribute__((ext_vector_type(4))); return __builtin_convertvector(__builtin_bit_cast(i32x4e, a), f32x4); }
template <int OSC2> struct EpiSwiGLUI8 {
    static constexpr bool PERM = true, AFTER_DRAIN = false;
    unsigned char* O; int ldc; int nmod; const float* sa; const float* sw;
    __device__ __forceinline__ void operator()(const f32x4 (&acc)[2][2][4][2], const Unit& u, int wr, int wc, int fr, int fq) const {
        constexpr float os = (float)(1 << OSC2);
        const int pnl = nmod ? (u.pn % nmod) : u.pn;
        const int row0 = u.pm * BM + wr * 64 + fr, col0 = pnl * HALF + wc * 32 + 8 * fq;
        const float* swp = sw + (size_t)u.pn * BM + wc * 32 + 8 * fq;
        const f32x4 sg0 = *(const f32x4*)swp, sg1 = *(const f32x4*)(swp + 4), su0 = *(const f32x4*)(swp + HALF) * os, su1 = *(const f32x4*)(swp + HALF + 4) * os;
#pragma unroll
        for (int ai = 0; ai < 2; ++ai) {
            float sr[4];
#pragma unroll
            for (int m = 0; m < 4; ++m) sr[m] = sa[row0 + ai * HALF + m * 16];
#pragma unroll
            for (int m = 0; m < 4; ++m) { unsigned char* rowp = O + (size_t)(row0 + ai * HALF + m * 16) * ldc + col0;
                const f32x4 g0 = cvt_i4(acc[ai][0][m][0]) * (sg0 * sr[m]), g1 = cvt_i4(acc[ai][0][m][1]) * (sg1 * sr[m]), u0 = cvt_i4(acc[ai][1][m][0]) * (su0 * sr[m]), u1 = cvt_i4(acc[ai][1][m][1]) * (su1 * sr[m]);
                u32x2 w;
                w.x = pk4_f8(silu_f(g0[0]) * u0[0], silu_f(g0[1]) * u0[1], silu_f(g0[2]) * u0[2], silu_f(g0[3]) * u0[3]);
                w.y = pk4_f8(silu_f(g1[0]) * u1[0], silu_f(g1[1]) * u1[1], silu_f(g1[2]) * u1[2], silu_f(g1[3]) * u1[3]);
                *(u32x2*)rowp = w; }
        }
    }
};
template <int OSC2> struct EpiI8SwiGLUf {
    static constexpr bool PERM = true, AFTER_DRAIN = false;
    unsigned char* O; int ldc; int nmod; const float* sa; const float* sw;
    __device__ __forceinline__ void operator()(const f32x4 (&acc)[2][2][4][2], const Unit& u, int wr, int wc, int fr, int fq) const {
        constexpr float os = (float)(1 << OSC2), nl2e = -1.4426950408889634f;
        const int pnl = nmod ? (u.pn % nmod) : u.pn;
        const int row0 = u.pm * BM + wr * 64 + fr, col0 = pnl * HALF + wc * 32 + 8 * fq;
        const float* swp = sw + (size_t)u.pn * BM + wc * 32 + 8 * fq;
        const f32x4 sg0 = *(const f32x4*)swp, sg1 = *(const f32x4*)(swp + 4), su0 = *(const f32x4*)(swp + HALF), su1 = *(const f32x4*)(swp + HALF + 4);
        const f32x4 c0 = sg0 * su0 * os, c1 = sg1 * su1 * os, l0 = sg0 * nl2e, l1 = sg1 * nl2e;
#pragma unroll
        for (int ai = 0; ai < 2; ++ai) {
            float sr[4];
#pragma unroll
            for (int m = 0; m < 4; ++m) sr[m] = sa[row0 + ai * HALF + m * 16];
#pragma unroll
            for (int m = 0; m < 4; ++m) { unsigned char* rowp = O + (size_t)(row0 + ai * HALF + m * 16) * ldc + col0;
                const float r = sr[m], r2 = r * r;
                const f32x4 G0 = cvt_i4(acc[ai][0][m][0]), G1 = cvt_i4(acc[ai][0][m][1]), U0 = cvt_i4(acc[ai][1][m][0]), U1 = cvt_i4(acc[ai][1][m][1]);
                const f32x4 t0 = (G0 * l0) * r, t1 = (G1 * l1) * r;
                f32x4 d0, d1;
#pragma unroll
                for (int e = 0; e < 4; ++e) { d0[e] = __builtin_amdgcn_exp2f(t0[e]); d1[e] = __builtin_amdgcn_exp2f(t1[e]); }
                d0 = d0 + 1.0f; d1 = d1 + 1.0f;
                f32x4 s0, s1;
#pragma unroll
                for (int e = 0; e < 4; ++e) { s0[e] = __builtin_amdgcn_rcpf(d0[e]); s1[e] = __builtin_amdgcn_rcpf(d1[e]); }
                const f32x4 o0 = ((G0 * U0) * (c0 * r2)) * s0, o1 = ((G1 * U1) * (c1 * r2)) * s1;
                u32x2 w; w.x = pk4_f8(o0[0], o0[1], o0[2], o0[3]); w.y = pk4_f8(o1[0], o1[1], o1[2], o1[3]);
                *(u32x2*)rowp = w; }
        }
    }
};
typedef float f32x2e __attribute__((ext_vector_type(2)));
template <bool LNR, int SCL2 = 0> struct EpiResid {
    static constexpr bool PERM = true, AFTER_DRAIN = false;
    const void* res; bf16_t* out; const float* stats; const float* g; const float* b;
    __device__ __forceinline__ void operator()(const f32x4 (&acc)[2][2][4][2], const Unit& u, int wr, int wc, int fr, int fq) const {
        constexpr int ldc = 1024; constexpr float alpha = 1.6817928305074290f, sc = 1.0f / (float)(1 << SCL2);
        const int row0 = u.pm * BM + wr * 64 + fr, col0 = u.pn * BM + wc * 32 + 8 * fq;
#pragma unroll
        for (int bj = 0; bj < 2; ++bj) {
            f32x4 g0, g1, b0, b1;
            if constexpr (LNR) { g0 = *(const f32x4*)(g + col0 + bj * HALF) * alpha; g1 = *(const f32x4*)(g + col0 + bj * HALF + 4) * alpha;
                                 b0 = *(const f32x4*)(b + col0 + bj * HALF) * alpha; b1 = *(const f32x4*)(b + col0 + bj * HALF + 4) * alpha; }
#pragma unroll
            for (int ai = 0; ai < 2; ++ai) {
                if constexpr (LNR) {
                    u32x4 w[4]; f32x2e st[4];
#pragma unroll
                    for (int m = 0; m < 4; ++m) { const int row = row0 + ai * HALF + m * 16; w[m] = *(const u32x4*)((const bf16_t*)res + (size_t)row * ldc + col0 + bj * HALF); st[m] = *(const f32x2e*)(stats + 2 * row); }
                    asm volatile("" ::: "memory");
#pragma unroll
                    for (int m = 0; m < 4; ++m) { const int row = row0 + ai * HALF + m * 16; const float mean = st[m].x, rstd = st[m].y;
                        const f32x4 r0 = {__uint_as_float(w[m].x << 16), __uint_as_float(w[m].x & 0xffff0000u), __uint_as_float(w[m].y << 16), __uint_as_float(w[m].y & 0xffff0000u)};
                        const f32x4 r1 = {__uint_as_float(w[m].z << 16), __uint_as_float(w[m].z & 0xffff0000u), __uint_as_float(w[m].w << 16), __uint_as_float(w[m].w & 0xffff0000u)};
                        const f32x4 v0 = (r0 - mean) * rstd * g0 + b0 + acc[ai][bj][m][0] * sc, v1 = (r1 - mean) * rstd * g1 + b1 + acc[ai][bj][m][1] * sc;
                        u32x4 o; o.x = cvt_pk_bf16(v0[0], v0[1]); o.y = cvt_pk_bf16(v0[2], v0[3]); o.z = cvt_pk_bf16(v1[0], v1[1]); o.w = cvt_pk_bf16(v1[2], v1[3]);
                        *(u32x4*)(out + (size_t)row * ldc + col0 + bj * HALF) = o; }
                } else {
                    f32x4 x0[4], x1[4];
#pragma unroll
                    for (int m = 0; m < 4; ++m) { const size_t off = (size_t)(row0 + ai * HALF + m * 16) * ldc + col0 + bj * HALF; x0[m] = *(const f32x4*)((const float*)res + off); x1[m] = *(const f32x4*)((const float*)res + off + 4); }
                    asm volatile("" ::: "memory");
#pragma unroll
                    for (int m = 0; m < 4; ++m) { const size_t off = (size_t)(row0 + ai * HALF + m * 16) * ldc + col0 + bj * HALF;
                        const f32x4 v0 = x0[m] * alpha + acc[ai][bj][m][0] * sc, v1 = x1[m] * alpha + acc[ai][bj][m][1] * sc;
                        u32x4 o; o.x = cvt_pk_bf16(v0[0], v0[1]); o.y = cvt_pk_bf16(v0[2], v0[3]); o.z = cvt_pk_bf16(v1[0], v1[1]); o.w = cvt_pk_bf16(v1[2], v1[3]);
                        *(u32x4*)(out + off) = o; }
                }
                asm volatile("" ::: "memory");
            }
        }
    }
};
struct MoeOrder {
    int nM, nN, nwg, G, c, rep; int ps1, ps2, ps3, ps4, ps5, ps6, ps7;
    __device__ __forceinline__ bool next(int i, Unit& u) const {
        const int L = i * G + c; if (nwg == 0 || L >= rep * nwg) return false;
        int wgid = rep == 1 ? L : L % nwg; { const int q = nwg / NXCD, r = nwg % NXCD, xcd = wgid % NXCD, off = wgid / NXCD; wgid = (xcd < r ? xcd * (q + 1) : r * (q + 1) + (xcd - r) * q) + off; }
        const int nig = WGM * nN, gid = wgid / nig, fm = gid * WGM, gsz = (nM - fm) < WGM ? (nM - fm) : WGM;
        const int pm = fm + ((wgid % nig) % gsz), pnl = (wgid % nig) / gsz;
        const int e = (pm >= ps1) + (pm >= ps2) + (pm >= ps3) + (pm >= ps4) + (pm >= ps5) + (pm >= ps6) + (pm >= ps7);
        u.pm = pm; u.pn = e * nN + pnl; return true;
    }
    __device__ __forceinline__ void a_ready(const Unit&) const {}
    __device__ __forceinline__ void done(const Unit&) const {}
};
template <class Inner> struct EpiI8 : Inner {
    static constexpr bool SCALE_PREP = true;
    const float* sa; const float* sw;
    __device__ __forceinline__ void prep(f32x4 (&acc)[2][2][4][2], const Unit& u, int wr, int wc, int fr, int fq) const {
        const float* swp = sw + (size_t)u.pn * BM + wc * 32 + 8 * fq; const float* sap = sa + u.pm * BM + wr * 64 + fr;
        f32x4 s4[2][2];
#pragma unroll
        for (int bj = 0; bj < 2; ++bj) { s4[bj][0] = *(const f32x4*)(swp + bj * HALF); s4[bj][1] = *(const f32x4*)(swp + bj * HALF + 4); }
#pragma unroll
        for (int ai = 0; ai < 2; ++ai) { float sr[4];
#pragma unroll
            for (int m = 0; m < 4; ++m) sr[m] = sap[ai * HALF + m * 16];
#pragma unroll
            for (int m = 0; m < 4; ++m)
#pragma unroll
                for (int bj = 0; bj < 2; ++bj)
#pragma unroll
                    for (int n = 0; n < 2; ++n) acc[ai][bj][m][n] = cvt_i4(acc[ai][bj][m][n]) * (s4[bj][n] * sr[m]); }
    }
};
template <class T, class = void> struct has_prep { static constexpr bool value = false; };
template <class T> struct has_prep<T, decltype((void)T::SCALE_PREP)> { static constexpr bool value = true; };
typedef int i32x8 __attribute__((ext_vector_type(8)));
typedef int i32x4q __attribute__((ext_vector_type(4)));
__device__ __forceinline__ i32x8 cat8(bf16x8 lo, bf16x8 hi) { const i32x4q a = __builtin_bit_cast(i32x4q, lo), b = __builtin_bit_cast(i32x4q, hi); return __builtin_shufflevector(a, b, 0, 1, 2, 3, 4, 5, 6, 7); }
template <class Epi, class Sched, bool ALIGN_EPI = false, bool SP2 = false, int QM = 0>
__device__ __forceinline__ void gemm_phase(PG8_LAS unsigned char* lds, const Gemm g, const Sched& S, const Epi& E, const int wid) {
    int lane; asm volatile("v_mbcnt_lo_u32_b32 %0, -1, 0\n\tv_mbcnt_hi_u32_b32 %0, -1, %0" : "=v"(lane));
    const int tid = wid * 64 + lane, wr = wid >> 2, wc = wid & 3, fr = lane & 15, fq = lane >> 4;
    const int K = g.K, nt = K / BK;
    unsigned voffA[2], voffB[2];
#pragma unroll
    for (int i = 0; i < 2; ++i) { int R, C; stage_rc(tid * 16 + i * 8192, R, C); const int Rb = Epi::PERM ? ((R & ~31) + perm32(R & 31)) : R;
        voffA[i] = (unsigned)(R * g.lda + C) * 2u; voffB[i] = (unsigned)(Rb * K + C) * 2u; }
    const size_t kstep = (size_t)(BK * 2);
    const size_t hstepA = (size_t)HALF * g.lda * 2, hstepB = (size_t)HALF * K * 2;
    const size_t tstepA = 2 * hstepA, tstepB = 2 * hstepB;
    const unsigned ldsw = (unsigned)wid * 1024u;
    const int aoff = lds_byte(wr * 64 + fr, fq * 8), boff = lds_byte(wc * 32 + fr, fq * 8);
#define PG8_SA(b, h) (((b) * 2 + (h)) * HTB)
#define PG8_SB(b, h) ((4 + (b) * 2 + (h)) * HTB)
#define PG8_STAGE(bufoff, gbase, voff) do { _Pragma("unroll") for (int _i = 0; _i < 2; ++_i) { unsigned vo_ = (voff)[_i]; asm volatile("" : "+v"(vo_));     \
        __builtin_amdgcn_global_load_lds((const unsigned*)((const char*)(gbase) + vo_), (PG8_LAS unsigned*)(lds + (bufoff) + ldsw + _i * 8192), 16, 0, 0); } } while (0)
#define PG8_LDA(dst, b, h) do { _Pragma("unroll") for (int m = 0; m < 4; ++m) _Pragma("unroll") for (int k = 0; k < 2; ++k) dst[m][k] = *(const PG8_LAS bf16x8*)(lds + PG8_SA(b, h) + aoff + m * 2048 + k * 1024); } while (0)
#define PG8_LDB(dst, b, h) do { _Pragma("unroll") for (int n = 0; n < 2; ++n) _Pragma("unroll") for (int k = 0; k < 2; ++k) dst[n][k] = *(const PG8_LAS bf16x8*)(lds + PG8_SB(b, h) + boff + n * 2048 + k * 1024); } while (0)
#define PG8_MMA(ai, bj, At, Bt) do { __builtin_amdgcn_s_setprio(1); _Pragma("unroll") for (int m = 0; m < 4; ++m) _Pragma("unroll") for (int n = 0; n < 2; ++n) { \
        if constexpr (QM == 1) acc[ai][bj][m][n] = __builtin_amdgcn_mfma_scale_f32_16x16x128_f8f6f4(cat8(Bt[n][0], Bt[n][1]), cat8(At[m][0], At[m][1]), acc[ai][bj][m][n], 0, 0, 0, 0, 0, 0); \
        else if constexpr (QM == 2) { _Pragma("unroll") for (int k = 0; k < 2; ++k) acc[ai][bj][m][n] = __builtin_bit_cast(f32x4, __builtin_amdgcn_mfma_i32_16x16x64_i8(__builtin_bit_cast(i32x4q, Bt[n][k]), __builtin_bit_cast(i32x4q, At[m][k]), __builtin_bit_cast(i32x4q, acc[ai][bj][m][n]), 0, 0, 0)); } \
        else { _Pragma("unroll") for (int k = 0; k < 2; ++k) acc[ai][bj][m][n] = __builtin_amdgcn_mfma_f32_16x16x32_bf16(Bt[n][k], At[m][k], acc[ai][bj][m][n], 0, 0, 0); } } __builtin_amdgcn_s_setprio(0); } while (0)
#define PG8_WAIT_V(n) asm volatile("s_waitcnt vmcnt(" #n ")" ::: "memory")
#define PG8_WAIT_L(n) asm volatile("s_waitcnt lgkmcnt(" #n ")" ::: "memory")
#define PG8_BAR __builtin_amdgcn_s_barrier()
#define PG8_SCHED __builtin_amdgcn_sched_barrier(0)
    Unit cur, nxt; int ui = 0;
    if (!S.next(0, cur)) return;
    f32x4 acc[2][2][4][2];
#pragma unroll
    for (int a = 0; a < 2; ++a)
#pragma unroll
        for (int b = 0; b < 2; ++b)
#pragma unroll
            for (int m = 0; m < 4; ++m)
#pragma unroll
                for (int n = 0; n < 2; ++n) acc[a][b][m][n] = (f32x4){0.f, 0.f, 0.f, 0.f};
    bf16x8 At[4][2], B0[2][2], B1[2][2];
    const char* cA = (const char*)g.A + (size_t)cur.pm * tstepA; const char* cB = (const char*)g.Bt + (size_t)cur.pn * tstepB;
    S.a_ready(cur);
    if constexpr (SP2) {
        PG8_STAGE(PG8_SB(0, 0), cB, voffB); PG8_STAGE(PG8_SB(0, 1), cB + hstepB, voffB); PG8_STAGE(PG8_SA(0, 0), cA, voffA); PG8_STAGE(PG8_SA(0, 1), cA + hstepA, voffA);
        if (wr == 1) PG8_BAR;
        PG8_WAIT_V(2); PG8_BAR;
        PG8_STAGE(PG8_SB(1, 0), cB + kstep, voffB); PG8_STAGE(PG8_SA(1, 0), cA + kstep, voffA); PG8_STAGE(PG8_SB(1, 1), cB + hstepB + kstep, voffB);
        PG8_WAIT_V(6); PG8_BAR;
    } else {
        PG8_STAGE(PG8_SB(0, 0), cB, voffB); PG8_STAGE(PG8_SA(0, 0), cA, voffA); PG8_STAGE(PG8_SB(0, 1), cB + hstepB, voffB); PG8_STAGE(PG8_SA(0, 1), cA + hstepA, voffA);
        if (wr == 1) PG8_BAR;
        PG8_WAIT_V(4); PG8_BAR;
        PG8_STAGE(PG8_SB(1, 0), cB + kstep, voffB); PG8_STAGE(PG8_SA(1, 0), cA + kstep, voffA); PG8_STAGE(PG8_SB(1, 1), cB + hstepB + kstep, voffB);
        PG8_WAIT_V(6); PG8_BAR;
    }
    for (;;) {
        const bool has_next = S.next(ui + 1, nxt);
        const char* nA = has_next ? (const char*)g.A + (size_t)nxt.pm * tstepA : cA; const char* nB = has_next ? (const char*)g.Bt + (size_t)nxt.pn * tstepB : cB;
        GSEC_ACC(6, -);
        for (int t = 0; t < nt; t += 2) {
            const bool last = (t == nt - 2);
            const char* a1 = cA + (size_t)(t + 1) * kstep;
            const char* a2 = last ? nA : cA + (size_t)(t + 2) * kstep; const char* b2 = last ? nB : cB + (size_t)(t + 2) * kstep;
            const char* a3 = a2 + kstep; const char* b3 = b2 + kstep;
            if (last && has_next) S.a_ready(nxt);
            if constexpr (SP2) {
            PG8_LDB(B0, 0, 0); PG8_LDB(B1, 0, 1); PG8_SCHED; PG8_LDA(At, 0, 0); PG8_STAGE(PG8_SA(1, 1), a1 + hstepA, voffA);
            PG8_WAIT_V(8); PG8_WAIT_L(0); PG8_BAR; PG8_MMA(0, 0, At, B0); PG8_MMA(0, 1, At, B1); PG8_BAR; PG8_SCHED;
            PG8_LDA(At, 0, 1); PG8_STAGE(PG8_SB(0, 0), b2, voffB); PG8_STAGE(PG8_SB(0, 1), b2 + hstepB, voffB); PG8_STAGE(PG8_SA(0, 0), a2, voffA);
            PG8_WAIT_V(8); PG8_WAIT_L(0); PG8_BAR; PG8_MMA(1, 0, At, B0); PG8_MMA(1, 1, At, B1); PG8_BAR; PG8_SCHED;
            PG8_LDB(B0, 1, 0); PG8_LDB(B1, 1, 1); PG8_SCHED; PG8_LDA(At, 1, 0); PG8_STAGE(PG8_SA(0, 1), a2 + hstepA, voffA);
            PG8_WAIT_V(8); PG8_WAIT_L(0); PG8_BAR; PG8_MMA(0, 0, At, B0); PG8_MMA(0, 1, At, B1); PG8_BAR; PG8_SCHED;
            PG8_LDA(At, 1, 1); PG8_STAGE(PG8_SB(1, 0), b3, voffB); PG8_STAGE(PG8_SB(1, 1), b3 + hstepB, voffB); PG8_STAGE(PG8_SA(1, 0), a3, voffA);
            PG8_WAIT_V(8); PG8_WAIT_L(0); PG8_BAR; PG8_MMA(1, 0, At, B0); PG8_MMA(1, 1, At, B1); PG8_BAR; PG8_SCHED;
            } else {
            PG8_LDB(B0, 0, 0); PG8_SCHED; PG8_LDA(At, 0, 0); PG8_STAGE(PG8_SA(1, 1), a1 + hstepA, voffA);
            PG8_WAIT_L(8); PG8_BAR; PG8_WAIT_L(0); PG8_MMA(0, 0, At, B0); PG8_BAR; PG8_SCHED;
            PG8_LDB(B1, 0, 1); PG8_STAGE(PG8_SB(0, 0), b2, voffB);
            PG8_BAR; PG8_WAIT_L(0); PG8_MMA(0, 1, At, B1); PG8_BAR;
            PG8_LDA(At, 0, 1); PG8_STAGE(PG8_SA(0, 0), a2, voffA);
            PG8_BAR; PG8_WAIT_L(0); PG8_MMA(1, 0, At, B0); PG8_BAR; PG8_SCHED;
            PG8_STAGE(PG8_SB(0, 1), b2 + hstepB, voffB);
            PG8_WAIT_V(6); PG8_BAR; PG8_MMA(1, 1, At, B1); PG8_BAR;
            PG8_LDB(B0, 1, 0); PG8_SCHED; PG8_LDA(At, 1, 0); PG8_STAGE(PG8_SA(0, 1), a2 + hstepA, voffA);
            PG8_WAIT_L(8); PG8_BAR; PG8_WAIT_L(0); PG8_MMA(0, 0, At, B0); PG8_BAR; PG8_SCHED;
            PG8_LDB(B1, 1, 1); PG8_STAGE(PG8_SB(1, 0), b3, voffB);
            PG8_BAR; PG8_WAIT_L(0); PG8_MMA(0, 1, At, B1); PG8_BAR;
            PG8_LDA(At, 1, 1); PG8_STAGE(PG8_SA(1, 0), a3, voffA);
            PG8_BAR; PG8_WAIT_L(0); PG8_MMA(1, 0, At, B0); PG8_BAR; PG8_SCHED;
            PG8_STAGE(PG8_SB(1, 1), b3 + hstepB, voffB);
            PG8_WAIT_V(6); PG8_BAR; PG8_MMA(1, 1, At, B1); PG8_BAR;
            }
        }
        GSEC_ACC(6, +); GSEC_ACC(7, -);
        if constexpr (ALIGN_EPI) { if (wr == 0) PG8_BAR; }
        if constexpr (!Epi::AFTER_DRAIN) { int l2_; asm volatile("v_mbcnt_lo_u32_b32 %0, -1, 0\n\tv_mbcnt_hi_u32_b32 %0, -1, %0" : "=v"(l2_));
            if constexpr (has_prep<Epi>::value) E.prep(acc, cur, wr, wc, l2_ & 15, l2_ >> 4);
            E(acc, cur, wr, wc, l2_ & 15, l2_ >> 4); S.done(cur); }
        GSEC_ACC(7, +);
        if (!has_next) break;
#pragma unroll
        for (int a = 0; a < 2; ++a)
#pragma unroll
            for (int b = 0; b < 2; ++b)
#pragma unroll
                for (int m = 0; m < 4; ++m)
#pragma unroll
                    for (int n = 0; n < 2; ++n) acc[a][b][m][n] = (f32x4){0.f, 0.f, 0.f, 0.f};
        cur = nxt; cA = nA; cB = nB; ++ui;
        if constexpr (ALIGN_EPI) { if (wr == 1) PG8_BAR; }
    }
    PG8_WAIT_V(0);
    if constexpr (!ALIGN_EPI) { if (wr == 0) PG8_BAR; }
    PG8_BAR;
    if constexpr (Epi::AFTER_DRAIN) { E.fused(acc, cur, wr, wc, fr, fq, lds, wid, lane); S.done(cur); }
#undef PG8_SA
#undef PG8_SB
#undef PG8_STAGE
#undef PG8_LDA
#undef PG8_LDB
#undef PG8_MMA
#undef PG8_WAIT_V
#undef PG8_WAIT_L
#undef PG8_BAR
#undef PG8_SCHED
}
}

constexpr int NWAVES = 8;
constexpr int BATCH = 8, SEQ = 4096, TT = BATCH * SEQ, D = 1024;
constexpr int HK = 8, HV = 16, HD = 128;
constexpr int GIN = 6176, GINP = 6400;
constexpr int FF = 3584, NE = 8, MOE_ROWS = 67584;
constexpr float ALPHA = 1.6817928305074290f;
constexpr float LN_EPS = 1e-5f, RMS_EPS = 1e-6f;
constexpr int NPH = 18, NPHASES = 2 * NPH;
constexpr int F8_YE = 6;
constexpr int F8_GO = 4, F8_WO = 11, F8_AO = 5, F8_WSO = 10;
constexpr int F8_H = 4, F8_WGU = 9, F8_ACT = 4, F8_WD = 11;

constexpr size_t MiB = 1ull << 20;
constexpr size_t WS_CTL = 0, CTL_ZERO_BYTES = 1 * MiB;
constexpr size_t WS_E12 = 1 * MiB;
constexpr size_t WS_G12 = WS_E12 + 256 * 1024;
constexpr size_t WS_POS = WS_G12 + 256 * 1024;
constexpr size_t WS_GB = 2 * MiB;
constexpr size_t WS_W = 16 * MiB;
constexpr size_t WS_W2 = 912 * MiB;
__host__ __device__ constexpr size_t gdn_wset(int j) { return j == 0 ? WS_W2 : 164 * MiB; }
__host__ __device__ constexpr size_t W_IN_(int j) { return gdn_wset(j); }
__host__ __device__ constexpr size_t W_OUT_(int j) { return gdn_wset(j) + 7 * MiB; }
__host__ __device__ constexpr size_t W_GU_(int j) { return gdn_wset(j) + 9 * MiB; }
__host__ __device__ constexpr size_t W_D_(int j) { return gdn_wset(j) + 16 * MiB; }
constexpr size_t W_QKV = WS_W, W_O = WS_W + 6 * MiB, W_MGU = WS_W + 8 * MiB, W_MD = WS_W + 120 * MiB;
constexpr size_t WS_G8 = 192 * MiB;
constexpr size_t WS_HB = 192 * MiB;
constexpr size_t WS_BIG = 256 * MiB;
constexpr size_t WS_ZB = WS_BIG, WS_RAW = WS_BIG + 128 * MiB, WS_QKVC = WS_BIG + 400 * MiB;
constexpr int RAWLD = 4352;
constexpr size_t WS_WMEM = WS_RAW, WS_IMEM = WS_RAW + 128 * MiB, WS_KTMEM = WS_RAW + 192 * MiB;
constexpr size_t WS_HS = 13 * MiB, WS_XSS = 13 * MiB + 512 * 1024;
constexpr size_t WS_SWI = 14 * MiB + 64 * 1024, WS_SWQ = 14 * MiB + 128 * 1024;
__host__ __device__ constexpr size_t WS_SWD_(int j) { return 14 * MiB + (size_t)j * 192 * 1024; }
__host__ __device__ constexpr size_t WS_SWI_(int j) { return 14 * MiB + 64 * 1024 + (size_t)j * 192 * 1024; }
constexpr size_t WS_SWD = 14 * MiB, WS_SWM = 14 * MiB + 512 * 1024;
constexpr size_t WS_STATS = 12 * MiB;
constexpr size_t WS_GTAB = 6 * MiB;
constexpr size_t WS_ACT = WS_BIG;
constexpr size_t WS_QKV = WS_BIG, WS_AO = WS_BIG + 192 * MiB;
constexpr size_t WS_XS = WS_BIG, WS_MACT = WS_BIG + 132 * MiB;
constexpr size_t WS_YT = 850 * MiB;
constexpr size_t WS_END = 950 * MiB;
static_assert(WS_QKVC + (size_t)TT * 4096 * 2 <= WS_W2 && WS_MACT + (size_t)MOE_ROWS * FF * 2 <= WS_END && WS_RAW + (size_t)TT * RAWLD * 2 <= WS_QKVC && WS_KTMEM + (size_t)4096 * 8192 * 2 <= WS_QKVC && WS_GTAB + (size_t)8192 * 192 * 4 <= WS_W, "d_ws map");
static_assert(W_MD + (size_t)NE * D * FF <= 164 * MiB && gdn_wset(1) + 20 * MiB <= WS_HB && gdn_wset(0) + 20 * MiB <= WS_END && W_MGU + (size_t)NE * 2 * FF * D <= W_MD, "weight map");
constexpr int CW_BAR = 4096;
constexpr int CW_WQ = 32768;
constexpr int CW_CNT = 16384;

constexpr int RING_BYTES = 131072;
constexpr int MISC_OFF = RING_BYTES + 320;
constexpr int OGST_OFF = 147456;
#define SEC_IN(k) do { if (PROBE_SEC == (k)) { if (blockIdx.x == 0 && (threadIdx.x == 0)) ((volatile LAS unsigned*)((LAS unsigned char*)0 + MISC_OFF))[20] -= (unsigned)__builtin_amdgcn_s_memrealtime(); } } while (0)
#define SEC_OUT(k) do { if (PROBE_SEC == (k)) { if (blockIdx.x == 0 && (threadIdx.x == 0)) ((volatile LAS unsigned*)((LAS unsigned char*)0 + MISC_OFF))[20] += (unsigned)__builtin_amdgcn_s_memrealtime(); } } while (0)
constexpr int LDS_BYTES = 163840;

#define GAS __attribute__((address_space(1)))
#define LAS __attribute__((address_space(3)))
#define DI __device__ __forceinline__
typedef unsigned short bf16;
typedef unsigned v4u __attribute__((ext_vector_type(4)));
typedef unsigned v2u __attribute__((ext_vector_type(2)));
typedef float f32x4 __attribute__((ext_vector_type(4)));
typedef float f32x2 __attribute__((ext_vector_type(2)));
typedef GAS unsigned gu32;
#define RLX_AGENT __ATOMIC_RELAXED, __HIP_MEMORY_SCOPE_AGENT
#define LDS_WAIT() asm volatile("s_waitcnt lgkmcnt(0)" ::: "memory")
#define VM_WAIT() asm volatile("s_waitcnt vmcnt(0)" ::: "memory")
__device__ __forceinline__ unsigned long long rt() { return __builtin_amdgcn_s_memrealtime(); }
__device__ __forceinline__ unsigned f2bf(float f) { unsigned u = __builtin_bit_cast(unsigned, f); return (u + 0x7fffu + ((u >> 16) & 1u)) >> 16; }
__device__ __forceinline__ unsigned pk2(float lo, float hi) { return f2bf(lo) | (f2bf(hi) << 16); }

#define XB_TMO      128
#define XB_XCNT(j)  (256  + 64 * (j))
#define XB_XSUB(j)  (1280 + 64 * (j))
#define XB_XGEN(j)  (2304 + 64 * (j))
#define XB_TOP      3328
#define XB_TOPGEN   3392
#define XCD_BAR_WORDS 3456
#define XB_SPIN_CAP (1u << 22)

__device__ __forceinline__ unsigned xb_ld(unsigned* p)              { return __hip_atomic_load(p, __ATOMIC_RELAXED, __HIP_MEMORY_SCOPE_AGENT); }
__device__ __forceinline__ unsigned xb_add(unsigned* p, unsigned v) { return __hip_atomic_fetch_add(p, v, __ATOMIC_RELAXED, __HIP_MEMORY_SCOPE_AGENT); }
__device__ __forceinline__ unsigned xb_xcc_id() { return (unsigned)__builtin_amdgcn_s_getreg((3 << 11) | 20) & 0xFu; }
#define XB_SPIN(cond, bar) do { unsigned _sp = 0; while (cond) { __builtin_amdgcn_s_sleep(1); \
    if ((++_sp & 255u) == 0u) { if (xb_ld(&(bar)[XB_TMO])) break; if (_sp > XB_SPIN_CAP) { atomicAdd(&(bar)[XB_TMO], 1u); break; } } } } while (0)

struct XcdBarrier {
    unsigned* bar; unsigned x;
    volatile LAS unsigned* st;
};

__device__ __forceinline__ XcdBarrier xcd_barrier_post(unsigned* bar, volatile LAS unsigned* st) {
    XcdBarrier b; b.bar = bar; b.x = xb_xcc_id(); b.st = st;
    if (threadIdx.x == 0) (void)xb_add(&bar[XB_XCNT(b.x)], 1u);
    return b;
}
__device__ __forceinline__ void xcd_barrier_complete(unsigned* bar, unsigned x, unsigned& nloc, unsigned& nx) {
    const unsigned G = gridDim.x * gridDim.y * gridDim.z;
    unsigned sum, cnt, mine, sp = 0u;
    for (;;) {
        sum = 0u; cnt = 0u; mine = 0u;
#pragma unroll
        for (unsigned j = 0; j < 16; ++j) { const unsigned c = xb_ld(&bar[XB_XCNT(j)]); sum += c; cnt += (c > 0u) ? 1u : 0u; mine = (j == x) ? c : mine; }
        if (sum == G) break;
        __builtin_amdgcn_s_sleep(1);
        if ((++sp & 255u) == 0u) { if (xb_ld(&bar[XB_TMO])) break; if (sp > XB_SPIN_CAP) { atomicAdd(&bar[XB_TMO], 1u); break; } }
    }
    nloc = mine > 0u ? mine : 1u; nx = cnt > 0u ? cnt : 1u;
}

__device__ __forceinline__ void xcd_barrier(const XcdBarrier& b, const bool leader) {
    asm volatile("s_waitcnt vmcnt(0)" ::: "memory");
    __syncthreads();
    if (leader) {
        unsigned* bar = b.bar;
        __builtin_amdgcn_s_waitcnt(0);
        unsigned nloc = b.st[0], nx = b.st[1];
        if (nloc == 0u) { xcd_barrier_complete(bar, b.x, nloc, nx); b.st[0] = nloc; b.st[1] = nx; }
        const unsigned old = xb_add(&bar[XB_XSUB(b.x)], 1u);
        const unsigned gen = old / nloc;
        if (old + 1u == (gen + 1u) * nloc) {
            __builtin_amdgcn_fence(__ATOMIC_RELEASE, "agent");
            asm volatile("s_waitcnt vmcnt(0)" ::: "memory");
            const unsigned og = xb_add(&bar[XB_TOP], 1u);
            const unsigned tg = og / nx;
            if (og + 1u == (tg + 1u) * nx) xb_add(&bar[XB_TOPGEN], 1u);
            else XB_SPIN(xb_ld(&bar[XB_TOPGEN]) == tg, bar);
            __builtin_amdgcn_fence(__ATOMIC_ACQUIRE, "agent");
            asm volatile("s_waitcnt vmcnt(0)" ::: "memory");
        } else {
            XB_SPIN(xb_ld(&bar[XB_TOPGEN]) == gen, bar);
            __builtin_amdgcn_fence(__ATOMIC_ACQUIRE, "agent");
            asm volatile("s_waitcnt vmcnt(0)" ::: "memory");
        }
    }
    __syncthreads();
}

DI float bf_lo(unsigned w) { return __uint_as_float(w << 16); }
DI float bf_hi(unsigned w) { return __uint_as_float(w & 0xffff0000u); }
DI float wave_sum(float v) {
    v += __builtin_bit_cast(float, __builtin_amdgcn_update_dpp(0, __builtin_bit_cast(int, v), 0xB1, 0xF, 0xF, false));
    v += __builtin_bit_cast(float, __builtin_amdgcn_update_dpp(0, __builtin_bit_cast(int, v), 0x4E, 0xF, 0xF, false));
    v += __builtin_bit_cast(float, __builtin_amdgcn_update_dpp(0, __builtin_bit_cast(int, v), 0x141, 0xF, 0xF, false));
    v += __builtin_bit_cast(float, __builtin_amdgcn_update_dpp(0, __builtin_bit_cast(int, v), 0x140, 0xF, 0xF, false));
    v += __builtin_bit_cast(float, __builtin_amdgcn_update_dpp(0, __builtin_bit_cast(int, v), 0x142, 0xA, 0xF, false));
    v += __builtin_bit_cast(float, __builtin_amdgcn_update_dpp(0, __builtin_bit_cast(int, v), 0x143, 0xC, 0xF, false));
    return __builtin_bit_cast(float, __builtin_amdgcn_readlane(__builtin_bit_cast(int, v), 63));
}
DI float sigmoid_f(float x) { return 1.0f / (1.0f + __expf(-x)); }
DI int opaque_lane() { int l; asm volatile("v_mbcnt_lo_u32_b32 %0, -1, 0\n\tv_mbcnt_hi_u32_b32 %0, -1, %0" : "=v"(l)); return l; }
DI float wave_max_nn(float v) {
    v = fmaxf(v, __builtin_bit_cast(float, __builtin_amdgcn_update_dpp(0, __builtin_bit_cast(int, v), 0xB1, 0xF, 0xF, false)));
    v = fmaxf(v, __builtin_bit_cast(float, __builtin_amdgcn_update_dpp(0, __builtin_bit_cast(int, v), 0x4E, 0xF, 0xF, false)));
    v = fmaxf(v, __builtin_bit_cast(float, __builtin_amdgcn_update_dpp(0, __builtin_bit_cast(int, v), 0x141, 0xF, 0xF, false)));
    v = fmaxf(v, __builtin_bit_cast(float, __builtin_amdgcn_update_dpp(0, __builtin_bit_cast(int, v), 0x140, 0xF, 0xF, false)));
    v = fmaxf(v, __builtin_bit_cast(float, __builtin_amdgcn_update_dpp(0, __builtin_bit_cast(int, v), 0x142, 0xA, 0xF, false)));
    v = fmaxf(v, __builtin_bit_cast(float, __builtin_amdgcn_update_dpp(0, __builtin_bit_cast(int, v), 0x143, 0xC, 0xF, false)));
    return __builtin_bit_cast(float, __builtin_amdgcn_readlane(__builtin_bit_cast(int, v), 63));
}
DI unsigned pk4_i8(float a, float b, float c, float d) {
    unsigned w = 0u;
    w = __builtin_amdgcn_cvt_pk_u8_f32(__builtin_rintf(a) + 128.0f, 0, w); w = __builtin_amdgcn_cvt_pk_u8_f32(__builtin_rintf(b) + 128.0f, 1, w);
    w = __builtin_amdgcn_cvt_pk_u8_f32(__builtin_rintf(c) + 128.0f, 2, w); w = __builtin_amdgcn_cvt_pk_u8_f32(__builtin_rintf(d) + 128.0f, 3, w);
    return w ^ 0x80808080u;
}

struct Args {
    const float *x, *gdn_w_in, *gdn_conv_w, *gdn_a_log, *gdn_dt_bias, *gdn_norm_w, *gdn_w_out, *sb_w_in, *sb_w_out, *ffn_w_gate, *ffn_w_up, *ffn_w_down,
                *moe_router, *moe_w_gate, *moe_w_up, *moe_w_down, *ln_g, *ln_b;
    float* out; unsigned char* ws; int ph_lo, ph_hi;
};

DI void transpose_item(const float* W, int ldw, bf16* WT, int K, int drow0, int k0, int n0, LAS float* scr, int lane) {
#pragma unroll 8
    for (int i = 0; i < 32; ++i) { const int kk = 2 * i + (lane >> 5); scr[kk * 33 + (lane & 31)] = W[(size_t)(k0 + kk) * ldw + n0 + (lane & 31)]; }
    LDS_WAIT(); asm volatile("" ::: "memory");
    const int c = lane & 7;
#pragma unroll
    for (int jj = 0; jj < 4; ++jj) { const int n = (lane >> 3) + 8 * jj; const LAS float* s = scr + (8 * c) * 33 + n;
        v4u o; o.x = pk2(s[0 * 33], s[1 * 33]); o.y = pk2(s[2 * 33], s[3 * 33]); o.z = pk2(s[4 * 33], s[5 * 33]); o.w = pk2(s[6 * 33], s[7 * 33]);
        *(v4u*)(WT + (size_t)(drow0 + n) * K + k0 + 8 * c) = o; }
    LDS_WAIT(); asm volatile("" ::: "memory");
}

DI void transpose_item64(const float* W, int ldw, bf16* WT, int K, int drow0, int k0, int n0, LAS unsigned char* scr, int lane) {
    const int q = lane >> 4, cx = lane & 15;
    f32x4 r[16];
#pragma unroll
    for (int i = 0; i < 16; ++i) r[i] = *(const f32x4*)(W + (size_t)(k0 + 16 * q + i) * ldw + n0 + 4 * cx);
#pragma unroll
    for (int e = 0; e < 4; ++e) {
        v4u w0, w1;
        w0.x = pk2(r[0][e], r[1][e]); w0.y = pk2(r[2][e], r[3][e]); w0.z = pk2(r[4][e], r[5][e]); w0.w = pk2(r[6][e], r[7][e]);
        w1.x = pk2(r[8][e], r[9][e]); w1.y = pk2(r[10][e], r[11][e]); w1.z = pk2(r[12][e], r[13][e]); w1.w = pk2(r[14][e], r[15][e]);
        *(LAS v4u*)(scr + (4 * cx + e) * 144 + q * 32) = w0; *(LAS v4u*)(scr + (4 * cx + e) * 144 + q * 32 + 16) = w1;
    }
    LDS_WAIT(); asm volatile("" ::: "memory");
#pragma unroll
    for (int j = 0; j < 8; ++j) { const int id = lane + 64 * j, n = id >> 3, kp = id & 7;
        *(v4u*)(WT + (size_t)(drow0 + n) * K + k0 + 8 * kp) = *(const LAS v4u*)(scr + n * 144 + kp * 16); }
    LDS_WAIT(); asm volatile("" ::: "memory");
}

DI void transpose_item64_f8(const float* W, int ldw, unsigned char* WT, int K, int drow0, int k0, int n0, float sc, LAS unsigned char* scr, int lane) {
    const int q = lane >> 4, cx = lane & 15;
    f32x4 r[16];
#pragma unroll
    for (int i = 0; i < 16; ++i) r[i] = *(const f32x4*)(W + (size_t)(k0 + 16 * q + i) * ldw + n0 + 4 * cx) * sc;
#pragma unroll
    for (int e = 0; e < 4; ++e) {
        v4u w; w.x = pg8::pk4_f8(r[0][e], r[1][e], r[2][e], r[3][e]); w.y = pg8::pk4_f8(r[4][e], r[5][e], r[6][e], r[7][e]); w.z = pg8::pk4_f8(r[8][e], r[9][e], r[10][e], r[11][e]); w.w = pg8::pk4_f8(r[12][e], r[13][e], r[14][e], r[15][e]);
        *(LAS v4u*)(scr + (4 * cx + e) * 80 + q * 16) = w;
    }
    LDS_WAIT(); asm volatile("" ::: "memory");
#pragma unroll
    for (int j = 0; j < 4; ++j) { const int id = lane + 64 * j, n = id >> 2, kp = id & 3;
        *(v4u*)(WT + (size_t)(drow0 + n) * K + k0 + 16 * kp) = *(const LAS v4u*)(scr + n * 80 + kp * 16); }
    LDS_WAIT(); asm volatile("" ::: "memory");
}

DI void strip_item_i8(const float* W, int ldw, unsigned char* WT, float* SW, int drow0, int n0, LAS unsigned char* lds, int wave, int lane) {
    const int q = lane >> 3, cx = lane & 7;
    LAS unsigned char* scr = lds + wave * 16384;
    f32x4 r[16];
#pragma unroll
    for (int i = 0; i < 16; ++i) r[i] = *(const f32x4*)(W + (size_t)(128 * wave + 16 * q + i) * ldw + n0 + 4 * cx);
    f32x4 m = {0.f, 0.f, 0.f, 0.f};
#pragma unroll
    for (int i = 0; i < 16; ++i)
#pragma unroll
        for (int e = 0; e < 4; ++e) m[e] = fmaxf(m[e], fabsf(r[i][e]));
#pragma unroll
    for (int e = 0; e < 4; ++e) { m[e] = fmaxf(m[e], __shfl_xor(m[e], 8)); m[e] = fmaxf(m[e], __shfl_xor(m[e], 16)); m[e] = fmaxf(m[e], __shfl_xor(m[e], 32)); }
    if (q == 0) *(LAS f32x4*)(scr + 12288 + 16 * cx) = m;
    __syncthreads();
    f32x4 cm = {1.0e-30f, 1.0e-30f, 1.0e-30f, 1.0e-30f};
#pragma unroll
    for (int w = 0; w < NWAVES; ++w) { const f32x4 o = *(const LAS f32x4*)(lds + w * 16384 + 12288 + 16 * cx);
#pragma unroll
        for (int e = 0; e < 4; ++e) cm[e] = fmaxf(cm[e], o[e]); }
    if (wave == 0 && q == 0) *(f32x4*)(SW + drow0 + 4 * cx) = cm * (1.0f / 127.0f);
#pragma unroll
    for (int e = 0; e < 4; ++e) { const float s1 = 127.0f / cm[e];
        v4u w; w.x = pk4_i8(r[0][e] * s1, r[1][e] * s1, r[2][e] * s1, r[3][e] * s1); w.y = pk4_i8(r[4][e] * s1, r[5][e] * s1, r[6][e] * s1, r[7][e] * s1);
        w.z = pk4_i8(r[8][e] * s1, r[9][e] * s1, r[10][e] * s1, r[11][e] * s1); w.w = pk4_i8(r[12][e] * s1, r[13][e] * s1, r[14][e] * s1, r[15][e] * s1);
        *(LAS v4u*)(scr + (4 * cx + e) * 144 + q * 16) = w; }
    LDS_WAIT(); asm volatile("" ::: "memory");
#pragma unroll
    for (int j = 0; j < 4; ++j) { const int id = lane + 64 * j, n = id >> 3, kp = id & 7;
        *(v4u*)(WT + (size_t)(drow0 + n) * 1024 + 128 * wave + 16 * kp) = *(const LAS v4u*)(scr + n * 144 + kp * 16); }
    LDS_WAIT(); asm volatile("" ::: "memory");
    __syncthreads();
}

DI void phase_w_gdn(const Args& a, int j, int part, LAS unsigned char* lds, int bid, int G, int tid_, int wave, int lane_) {
    const int lane = opaque_lane(), tid = wave * 64 + lane;
    LAS float* scr = (LAS float*)(lds + wave * 16384);
    const int gw = bid * NWAVES + wave, NGW = G * NWAVES;
    const float* Win = a.gdn_w_in + (size_t)j * D * GIN; const float* Wout = a.gdn_w_out + (size_t)j * 2048 * D;
    const float* Wg = a.ffn_w_gate + (size_t)j * D * FF; const float* Wu = a.ffn_w_up + (size_t)j * D * FF; const float* Wd = a.ffn_w_down + (size_t)j * FF * D;
    unsigned char* WIN_T = a.ws + W_IN_(j); unsigned char* WOUT_T = a.ws + W_OUT_(j); unsigned char* WGU_T = a.ws + W_GU_(j); unsigned char* WD_T = a.ws + W_D_(j);
    const bool do_in = part != 1, do_rest = part != 0;
    LAS unsigned char* scb = (LAS unsigned char*)scr;
    constexpr int I_SIN = GIN / 32, I_OUT = 32 * 16, I_S = 112, I_D = 56 * 16, NIT = I_OUT + I_D, NWGI = 2 * I_S + I_SIN;
    const int wg_lo = do_rest ? 0 : 2 * I_S, wg_hi = do_in ? NWGI : 2 * I_S;
    for (int it = wg_lo + bid; it < wg_hi; it += G) {
        if (it < 2 * I_S) { const bool up = it >= I_S; const int n0 = 32 * (up ? it - I_S : it);
            strip_item_i8(up ? Wu : Wg, FF, WGU_T, (float*)(a.ws + WS_SWD_(j)), 256 * (n0 >> 7) + (up ? 128 : 0) + (n0 & 127), n0, lds, wave, lane); }
        else { const int n0 = 32 * (it - 2 * I_S); strip_item_i8(Win, GIN, WIN_T, (float*)(a.ws + WS_SWI_(j)), n0, n0, lds, wave, lane); } }
    const int gwr = (gw + NGW - (((wg_hi - wg_lo) % G) * NWAVES) % NGW) % NGW;
    for (int it = gwr; it < (do_rest ? NIT : 0); it += NGW) {
        int r = it;
        if (r < I_OUT) { const int kb = r / 16, nb = r % 16; transpose_item64_f8(Wout, D, WOUT_T, 2048, 64 * nb, 64 * kb, 64 * nb, (float)(1 << F8_WO), scb, lane); continue; } r -= I_OUT;
        { const int kb = r / 16, nb = r % 16; transpose_item64_f8(Wd, D, WD_T, FF, 64 * nb, 64 * kb, 64 * nb, (float)(1 << F8_WD), scb, lane); }
    }
    if (j == 0 && (part == 0 || part == 3)) {
        unsigned char* HB = a.ws + WS_HB; float* HS = (float*)(a.ws + WS_HS);
        for (int t = gw; t < TT; t += NGW) { const f32x4* xr = (const f32x4*)(a.x + (size_t)t * D);
            f32x4 p[2][2]; float am = 0.f;
#pragma unroll
            for (int q = 0; q < 2; ++q) { p[q][0] = xr[2 * (lane + 64 * q)]; p[q][1] = xr[2 * (lane + 64 * q) + 1]; }
#pragma unroll
            for (int q = 0; q < 2; ++q)
#pragma unroll
                for (int c = 0; c < 4; ++c) am = fmaxf(am, fmaxf(fabsf(p[q][0][c]), fabsf(p[q][1][c])));
            am = fmaxf(wave_max_nn(am), 1.0e-20f); const float qs = 127.0f / am;
            if (lane == 0) HS[t] = am * (1.0f / 127.0f);
#pragma unroll
            for (int q = 0; q < 2; ++q) { v2u o; o.x = pk4_i8(p[q][0][0] * qs, p[q][0][1] * qs, p[q][0][2] * qs, p[q][0][3] * qs); o.y = pk4_i8(p[q][1][0] * qs, p[q][1][1] * qs, p[q][1][2] * qs, p[q][1][3] * qs);
                ((v2u*)(HB + (size_t)t * D))[lane + 64 * q] = o; } }
    }
}
DI void phase_w_gdn_dyn(const Args& a, int j, unsigned* ctr, LAS unsigned char* lds, int wave) {
    const int lane = opaque_lane(), tid = wave * 64 + lane;
    const float* Win = a.gdn_w_in + (size_t)j * D * GIN; const float* Wout = a.gdn_w_out + (size_t)j * 2048 * D;
    const float* Wg = a.ffn_w_gate + (size_t)j * D * FF; const float* Wu = a.ffn_w_up + (size_t)j * D * FF; const float* Wd = a.ffn_w_down + (size_t)j * FF * D;
    unsigned char* WIN_T = a.ws + W_IN_(j); unsigned char* WOUT_T = a.ws + W_OUT_(j); unsigned char* WGU_T = a.ws + W_GU_(j); unsigned char* WD_T = a.ws + W_D_(j);
    LAS unsigned char* scb = lds + wave * 16384;
    volatile LAS int* slot = (volatile LAS int*)(lds + RING_BYTES - 16);
    constexpr int I_SIN = GIN / 32, I_OUT = 32 * 16, I_S = 112, I_D = 56 * 16, NIT = I_OUT + I_D, NWGI = 2 * I_S + I_SIN, NQ = NWGI + NIT / NWAVES;
    static_assert(NIT % NWAVES == 0, "eight transposes per queue item");
    for (;;) {
        __syncthreads();
        if (tid == 0) *slot = (int)__hip_atomic_fetch_add(ctr, 1u, __ATOMIC_RELAXED, __HIP_MEMORY_SCOPE_AGENT);
        __syncthreads();
        const int it = __builtin_amdgcn_readfirstlane(*slot);
        if (it >= NQ) break;
        if (it < 2 * I_S) { const bool up = it >= I_S; const int n0 = 32 * (up ? it - I_S : it);
            strip_item_i8(up ? Wu : Wg, FF, WGU_T, (float*)(a.ws + WS_SWD_(j)), 256 * (n0 >> 7) + (up ? 128 : 0) + (n0 & 127), n0, lds, wave, lane); }
        else if (it < NWGI) { const int n0 = 32 * (it - 2 * I_S); strip_item_i8(Win, GIN, WIN_T, (float*)(a.ws + WS_SWI_(j)), n0, n0, lds, wave, lane); }
        else { int r = (it - NWGI) * NWAVES + wave;
            if (r < I_OUT) { const int kb = r / 16, nb = r % 16; transpose_item64_f8(Wout, D, WOUT_T, 2048, 64 * nb, 64 * kb, 64 * nb, (float)(1 << F8_WO), scb, lane); }
            else { r -= I_OUT; const int kb = r / 16, nb = r % 16; transpose_item64_f8(Wd, D, WD_T, FF, 64 * nb, 64 * kb, 64 * nb, (float)(1 << F8_WD), scb, lane); } }
    }
}
DI void phase_w_sb(const Args& a, int j, LAS unsigned char* lds, int bid, int G, int wave, int lane_) {
    const int lane = opaque_lane();
    LAS float* scr = (LAS float*)(lds + wave * 16384);
    const int gw = bid * NWAVES + wave, NGW = G * NWAVES;
    const float* Wqkv = a.sb_w_in + (size_t)j * D * 3072; const float* Wo = a.sb_w_out + (size_t)j * D * D;
    const float* Mg = a.moe_w_gate + (size_t)j * NE * D * FF; const float* Mu = a.moe_w_up + (size_t)j * NE * D * FF; const float* Md = a.moe_w_down + (size_t)j * NE * FF * D;
    unsigned char* WQKV_T = a.ws + W_QKV; unsigned char* WO_T = a.ws + W_O; unsigned char* MGU_T = a.ws + W_MGU; unsigned char* MD_T = a.ws + W_MD;
    LAS unsigned char* scb = (LAS unsigned char*)scr;
    constexpr int I_SQ = 3072 / 32, I_O = 16 * 16, I_S = 112, I_D = 56 * 16, NIT = I_O + NE * I_D;
    for (int it = bid; it < I_SQ + NE * 2 * I_S; it += G) {
        if (it < I_SQ) { strip_item_i8(Wqkv, 3072, WQKV_T, (float*)(a.ws + WS_SWQ), 32 * it, 32 * it, lds, wave, lane); continue; }
        const int e = (it - I_SQ) / (2 * I_S), r = (it - I_SQ) % (2 * I_S); const bool up = r >= I_S; const int n0 = 32 * (up ? r - I_S : r);
        strip_item_i8((up ? Mu : Mg) + (size_t)e * D * FF, FF, MGU_T + (size_t)e * 2 * FF * D, (float*)(a.ws + WS_SWM) + e * 2 * FF, 256 * (n0 >> 7) + (up ? 128 : 0) + (n0 & 127), n0, lds, wave, lane); }
    for (int it = gw; it < NIT; it += NGW) {
        int r = it;
        if (r < I_O) { const int kb = r / 16, nb = r % 16; transpose_item64_f8(Wo, D, WO_T, D, 64 * nb, 64 * kb, 64 * nb, (float)(1 << F8_WSO), scb, lane); continue; } r -= I_O;
        const int e = r / I_D; r -= e * I_D;
        { const int kb = r / 16, nb = r % 16; transpose_item64_f8(Md + (size_t)e * FF * D, D, MD_T + (size_t)e * D * FF, FF, 64 * nb, 64 * kb, 64 * nb, (float)(1 << F8_WD), scb, lane); }
    }
}

DI float dpp_sum16(float v) {
    v += __builtin_bit_cast(float, __builtin_amdgcn_update_dpp(0, __builtin_bit_cast(int, v), 0xB1, 0xF, 0xF, false));
    v += __builtin_bit_cast(float, __builtin_amdgcn_update_dpp(0, __builtin_bit_cast(int, v), 0x4E, 0xF, 0xF, false));
    v += __builtin_bit_cast(float, __builtin_amdgcn_update_dpp(0, __builtin_bit_cast(int, v), 0x141, 0xF, 0xF, false));
    v += __builtin_bit_cast(float, __builtin_amdgcn_update_dpp(0, __builtin_bit_cast(int, v), 0x140, 0xF, 0xF, false));
    return v;
}
DI void phase_conv(const Args& a, int j, int bid, int G, int tid) {
    const bf16* raw = (const bf16*)(a.ws + WS_RAW); bf16* qkvc = (bf16*)(a.ws + WS_QKVC); float* gb = (float*)(a.ws + WS_GB);
    const float* cw = a.gdn_conv_w + (size_t)j * 4 * 4096;
    const int ch = 8 * tid;
    float w0[8], w1[8], w2[8], w3[8];
#pragma unroll
    for (int i = 0; i < 8; ++i) { w0[i] = cw[ch + i]; w1[i] = cw[4096 + ch + i]; w2[i] = cw[2 * 4096 + ch + i]; w3[i] = cw[3 * 4096 + ch + i]; }
    const float post = tid < 128 ? 0.08838834764831845f : 1.0f;
    for (int run = bid; run < TT / 128; run += G) {
        const int t0 = run * 128; const bool first = (t0 & (SEQ - 1)) == 0;
        float xa[8], xb[8], xc[8];
        { v4u h0 = {0u, 0u, 0u, 0u}, h1 = h0, h2 = h0;
          if (!first) { h0 = *(const v4u*)(raw + (size_t)(t0 - 3) * RAWLD + ch); h1 = *(const v4u*)(raw + (size_t)(t0 - 2) * RAWLD + ch); h2 = *(const v4u*)(raw + (size_t)(t0 - 1) * RAWLD + ch); }
          xa[0] = bf_lo(h0.x); xa[1] = bf_hi(h0.x); xa[2] = bf_lo(h0.y); xa[3] = bf_hi(h0.y); xa[4] = bf_lo(h0.z); xa[5] = bf_hi(h0.z); xa[6] = bf_lo(h0.w); xa[7] = bf_hi(h0.w);
          xb[0] = bf_lo(h1.x); xb[1] = bf_hi(h1.x); xb[2] = bf_lo(h1.y); xb[3] = bf_hi(h1.y); xb[4] = bf_lo(h1.z); xb[5] = bf_hi(h1.z); xb[6] = bf_lo(h1.w); xb[7] = bf_hi(h1.w);
          xc[0] = bf_lo(h2.x); xc[1] = bf_hi(h2.x); xc[2] = bf_lo(h2.y); xc[3] = bf_hi(h2.y); xc[4] = bf_lo(h2.z); xc[5] = bf_hi(h2.z); xc[6] = bf_lo(h2.w); xc[7] = bf_hi(h2.w); }
#pragma unroll 1
        for (int tb = 0; tb < 128; tb += 8) {
            v4u xr[8];
#pragma unroll
            for (int u = 0; u < 8; ++u) xr[u] = *(const v4u*)(raw + (size_t)(t0 + tb + u) * RAWLD + ch);
#pragma unroll
            for (int u = 0; u < 8; ++u) {
                float xd[8]; xd[0] = bf_lo(xr[u].x); xd[1] = bf_hi(xr[u].x); xd[2] = bf_lo(xr[u].y); xd[3] = bf_hi(xr[u].y); xd[4] = bf_lo(xr[u].z); xd[5] = bf_hi(xr[u].z); xd[6] = bf_lo(xr[u].w); xd[7] = bf_hi(xr[u].w);
                float y[8]; float ss = 0.f;
#pragma unroll
                for (int i = 0; i < 8; ++i) { const float c = w0[i] * xa[i] + w1[i] * xb[i] + w2[i] * xc[i] + w3[i] * xd[i];
                    y[i] = c * __builtin_amdgcn_rcpf(1.0f + __builtin_amdgcn_exp2f(-1.4426950408889634f * c)); ss += y[i] * y[i];
                    xa[i] = xb[i]; xb[i] = xc[i]; xc[i] = xd[i]; }
                if (tid < 256) {
                    const float rn = post / sqrtf(dpp_sum16(ss) + RMS_EPS);
#pragma unroll
                    for (int i = 0; i < 8; ++i) y[i] *= rn;
                }
                v4u o; o.x = pk2(y[0], y[1]); o.y = pk2(y[2], y[3]); o.z = pk2(y[4], y[5]); o.w = pk2(y[6], y[7]);
                *(v4u*)(qkvc + (size_t)(t0 + tb + u) * 4096 + ch) = o;
            }
        }
#pragma unroll
        for (int k = 0; k < 4; ++k) { const int item = tid + 512 * k, tok = t0 + (item >> 4), hv = item & 15;
            const float bb = __uint_as_float((unsigned)raw[(size_t)tok * RAWLD + 4096 + hv] << 16), aa = __uint_as_float((unsigned)raw[(size_t)tok * RAWLD + 4112 + hv] << 16);
            const float xx = aa + a.gdn_dt_bias[j * 16 + hv];
            const float sp = xx > 20.f ? xx : log1pf(__expf(xx));
            gb[(size_t)tok * 32 + hv] = -__expf(a.gdn_a_log[j * 16 + hv]) * sp;
            gb[(size_t)tok * 32 + 16 + hv] = sigmoid_f(bb); }
    }
}

DI void phase_gdn_naive(const Args& a, int j, LAS unsigned char* lds, int bid, int tid) {
    if (bid >= BATCH * HV) return;
    const int b = bid / HV, hv = bid % HV, hk = hv / 2, jc = tid & 127, r = tid >> 7;
    const bf16* zb = (const bf16*)(a.ws + WS_ZB); bf16* qkvc = (bf16*)(a.ws + WS_QKVC); const float* gb = (const float*)(a.ws + WS_GB);
    LAS float* qs = (LAS float*)lds; LAS float* ks = qs + 2048; LAS float* vs = ks + 2048; LAS float* gs = vs + 2048; LAS float* bs = gs + 16;
    LAS f32x2* red = (LAS f32x2*)(lds + 32768); LAS float* redkq = (LAS float*)(lds + 32768 + 8192); LAS float* ob = (LAS float*)(lds + 49152);
    float S[32];
#pragma unroll
    for (int i = 0; i < 32; ++i) S[i] = 0.f;
    const int lrow = tid >> 5, lcol = (tid & 31) * 4;
    for (int blk = 0; blk < SEQ / 16; ++blk) {
        const size_t t0 = (size_t)b * SEQ + blk * 16;
        __syncthreads();
        { const bf16* rowp = qkvc + (t0 + lrow) * 4096;
          const v2u qv = *(const v2u*)(rowp + hk * 128 + lcol), kv = *(const v2u*)(rowp + 1024 + hk * 128 + lcol), vv = *(const v2u*)(rowp + 2048 + hv * 128 + lcol);
          *(LAS f32x4*)(qs + lrow * 128 + lcol) = (f32x4){bf_lo(qv.x), bf_hi(qv.x), bf_lo(qv.y), bf_hi(qv.y)};
          *(LAS f32x4*)(ks + lrow * 128 + lcol) = (f32x4){bf_lo(kv.x), bf_hi(kv.x), bf_lo(kv.y), bf_hi(kv.y)};
          *(LAS f32x4*)(vs + lrow * 128 + lcol) = (f32x4){bf_lo(vv.x), bf_hi(vv.x), bf_lo(vv.y), bf_hi(vv.y)};
          if (tid < 16) { gs[tid] = __expf(gb[(t0 + tid) * 32 + hv]); bs[tid] = gb[(t0 + tid) * 32 + 16 + hv]; } }
        __syncthreads();
#pragma unroll 1
        for (int tt = 0; tt < 16; ++tt) {
            float pk = 0.f, pq = 0.f, pkq = 0.f;
#pragma unroll
            for (int i4 = 0; i4 < 8; ++i4) { const f32x4 k4 = *(const LAS f32x4*)(ks + tt * 128 + 32 * r + 4 * i4), q4 = *(const LAS f32x4*)(qs + tt * 128 + 32 * r + 4 * i4);
#pragma unroll
                for (int c = 0; c < 4; ++c) { pk += k4[c] * S[4 * i4 + c]; pq += q4[c] * S[4 * i4 + c]; pkq += k4[c] * q4[c]; } }
            const int buf = tt & 1;
            red[(buf * 4 + r) * 128 + jc] = (f32x2){pk, pq}; if (jc == 0) redkq[buf * 4 + r] = pkq;
            __syncthreads();
            float kS = 0.f, qS = 0.f, kq = 0.f;
#pragma unroll
            for (int rr = 0; rr < 4; ++rr) { const f32x2 p = red[(buf * 4 + rr) * 128 + jc]; kS += p.x; qS += p.y; kq += redkq[buf * 4 + rr]; }
            const float eg = gs[tt], vn = bs[tt] * (vs[tt * 128 + jc] - eg * kS);
#pragma unroll
            for (int i4 = 0; i4 < 8; ++i4) { const f32x4 k4 = *(const LAS f32x4*)(ks + tt * 128 + 32 * r + 4 * i4);
#pragma unroll
                for (int c = 0; c < 4; ++c) S[4 * i4 + c] = eg * S[4 * i4 + c] + k4[c] * vn; }
            if (r == 0) ob[tt * 128 + jc] = eg * qS + kq * vn;
        }
        __syncthreads();
        {
            const f32x4 o4 = *(const LAS f32x4*)(ob + lrow * 128 + lcol);
            float ss = o4[0] * o4[0] + o4[1] * o4[1] + o4[2] * o4[2] + o4[3] * o4[3];
            ss += __shfl_xor(ss, 1); ss += __shfl_xor(ss, 2); ss += __shfl_xor(ss, 4); ss += __shfl_xor(ss, 8); ss += __shfl_xor(ss, 16);
            const float rinv = 1.0f / sqrtf(ss * (1.0f / 128.0f) + RMS_EPS);
            const v2u zv = *(const v2u*)(zb + (t0 + lrow) * 2048 + hv * 128 + lcol);
            const f32x4 nw = *(const f32x4*)(a.gdn_norm_w + j * 128 + lcol);
            const float z0 = bf_lo(zv.x), z1 = bf_hi(zv.x), z2 = bf_lo(zv.y), z3 = bf_hi(zv.y);
            v2u o; o.x = pk2(o4[0] * rinv * nw[0] * z0 * sigmoid_f(z0), o4[1] * rinv * nw[1] * z1 * sigmoid_f(z1));
            o.y = pk2(o4[2] * rinv * nw[2] * z2 * sigmoid_f(z2), o4[3] * rinv * nw[3] * z3 * sigmoid_f(z3));
            *(v2u*)(qkvc + (t0 + lrow) * 4096 + 2048 + hv * 128 + lcol) = o;
        }
    }
}

DI void unpack8_f8(const v2u w, float (&x)[8]) { const f32x2 a = __builtin_amdgcn_cvt_pk_f32_fp8((int)w.x, false), b = __builtin_amdgcn_cvt_pk_f32_fp8((int)w.x, true), c = __builtin_amdgcn_cvt_pk_f32_fp8((int)w.y, false), d = __builtin_amdgcn_cvt_pk_f32_fp8((int)w.y, true);
    x[0] = a.x; x[1] = a.y; x[2] = b.x; x[3] = b.y; x[4] = c.x; x[5] = c.y; x[6] = d.x; x[7] = d.y; }
DI void unpack8(const v4u w, float (&x)[8]) { x[0] = bf_lo(w.x); x[1] = bf_hi(w.x); x[2] = bf_lo(w.y); x[3] = bf_hi(w.y); x[4] = bf_lo(w.z); x[5] = bf_hi(w.z); x[6] = bf_lo(w.w); x[7] = bf_hi(w.w); }
template <bool ROUTER, bool F8OUT = false>
DI void phase_ln(const Args& a, const bf16* Y, int lnidx, int j, LAS unsigned char* lds, int bid, int G, int tid, int wave, int lane) {
    bf16* HB = (bf16*)(a.ws + WS_HB); float* stats = (float*)(a.ws + WS_STATS);
    const float* g = a.ln_g + (size_t)lnidx * D; const float* bta = a.ln_b + (size_t)lnidx * D;
    const int gw = bid * NWAVES + wave, NGW = G * NWAVES;
    LAS unsigned* lcnt = (LAS unsigned*)lds;
    LAS float* RT = (LAS float*)(lds + 1024);
    if (ROUTER) { if (tid < 8) lcnt[tid] = 0u;
        const float* R = a.moe_router + (size_t)j * D * NE;
#pragma unroll
        for (int i = 0; i < 2; ++i) { const int k = tid + 512 * i; const f32x4 r0 = *(const f32x4*)(R + k * 8), r1 = *(const f32x4*)(R + k * 8 + 4);
            RT[0 * 1024 + k] = r0[0]; RT[1 * 1024 + k] = r0[1]; RT[2 * 1024 + k] = r0[2]; RT[3 * 1024 + k] = r0[3]; RT[4 * 1024 + k] = r1[0]; RT[5 * 1024 + k] = r1[1]; RT[6 * 1024 + k] = r1[2]; RT[7 * 1024 + k] = r1[3]; }
        __syncthreads(); }
    float gv[2][8], bv[2][8];
#pragma unroll
    for (int q = 0; q < 2; ++q)
#pragma unroll
        for (int c = 0; c < 8; ++c) { gv[q][c] = g[8 * (lane + 64 * q) + c]; bv[q][c] = bta[8 * (lane + 64 * q) + c]; }
    v4u nx[3][2];
#pragma unroll
    for (int d = 0; d < 3; ++d) if (gw + d * NGW < TT) { nx[d][0] = ((const v4u*)(Y + (size_t)(gw + d * NGW) * D))[lane]; nx[d][1] = ((const v4u*)(Y + (size_t)(gw + d * NGW) * D))[lane + 64]; }
    for (int t = gw; t < TT; t += NGW) {
        float v[2][8]; float s = 0.f;
        unpack8(nx[0][0], v[0]); unpack8(nx[0][1], v[1]);
        nx[0][0] = nx[1][0]; nx[0][1] = nx[1][1]; nx[1][0] = nx[2][0]; nx[1][1] = nx[2][1];
        if (t + 3 * NGW < TT) { nx[2][0] = ((const v4u*)(Y + (size_t)(t + 3 * NGW) * D))[lane]; nx[2][1] = ((const v4u*)(Y + (size_t)(t + 3 * NGW) * D))[lane + 64]; }
#pragma unroll
        for (int q = 0; q < 2; ++q)
#pragma unroll
            for (int c = 0; c < 8; ++c) s += v[q][c];
        const float mean = wave_sum(s) * (1.0f / D); float s2 = 0.f;
#pragma unroll
        for (int q = 0; q < 2; ++q)
#pragma unroll
            for (int c = 0; c < 8; ++c) { v[q][c] -= mean; s2 += v[q][c] * v[q][c]; }
        const float rstd = 1.0f / sqrtf(wave_sum(s2) * (1.0f / D) + LN_EPS);
        if (lane == 0) *(f32x2*)(stats + 2 * (size_t)t) = (f32x2){mean, rstd};
        float am = 0.f;
#pragma unroll
        for (int q = 0; q < 2; ++q)
#pragma unroll
            for (int c = 0; c < 8; ++c) { v[q][c] = v[q][c] * rstd * gv[q][c] + bv[q][c]; am = fmaxf(am, fabsf(v[q][c])); }
        if constexpr (F8OUT) {
            am = fmaxf(wave_max_nn(am), 1.0e-20f); const float qs = 127.0f / am;
            if (lane == 0) ((float*)(a.ws + WS_HS))[t] = am * (1.0f / 127.0f);
#pragma unroll
            for (int q = 0; q < 2; ++q) { v2u o; o.x = pk4_i8(v[q][0] * qs, v[q][1] * qs, v[q][2] * qs, v[q][3] * qs); o.y = pk4_i8(v[q][4] * qs, v[q][5] * qs, v[q][6] * qs, v[q][7] * qs);
                ((v2u*)((unsigned char*)HB + (size_t)t * D))[lane + 64 * q] = o; }
        } else {
#pragma unroll
            for (int q = 0; q < 2; ++q) { v4u o; o.x = pk2(v[q][0], v[q][1]); o.y = pk2(v[q][2], v[q][3]); o.z = pk2(v[q][4], v[q][5]); o.w = pk2(v[q][6], v[q][7]);
                ((v4u*)(HB + (size_t)t * D))[lane + 64 * q] = o; }
        }
        if (ROUTER) {
            float lg[8];
#pragma unroll
            for (int e = 0; e < 8; ++e) { lg[e] = 0.f;
#pragma unroll
                for (int q = 0; q < 2; ++q) { const f32x4 r0 = *(const LAS f32x4*)(RT + e * 1024 + 8 * (lane + 64 * q)), r1 = *(const LAS f32x4*)(RT + e * 1024 + 8 * (lane + 64 * q) + 4);
                    lg[e] += (v[q][0] * r0[0] + v[q][1] * r0[1]) + (v[q][2] * r0[2] + v[q][3] * r0[3]) + (v[q][4] * r1[0] + v[q][5] * r1[1]) + (v[q][6] * r1[2] + v[q][7] * r1[3]); } }
#pragma unroll
            for (int e = 0; e < 8; ++e) lg[e] = wave_sum(lg[e]);
            int i1 = 0; float v1 = lg[0];
#pragma unroll
            for (int e = 1; e < 8; ++e) if (lg[e] > v1) { v1 = lg[e]; i1 = e; }
            int i2 = -1; float v2 = -3.0e38f;
#pragma unroll
            for (int e = 0; e < 8; ++e) if (e != i1 && lg[e] > v2) { v2 = lg[e]; i2 = e; }
            if (lane == 0) {
                const float g1 = 1.0f / (1.0f + __expf(v2 - v1));
                ((unsigned*)(a.ws + WS_E12))[t] = (unsigned)i1 | ((unsigned)i2 << 8);
                ((f32x2*)(a.ws + WS_G12))[t] = (f32x2){g1, 1.0f - g1};
                __hip_atomic_fetch_add(lcnt + i1, 1u, __ATOMIC_RELAXED, __HIP_MEMORY_SCOPE_WORKGROUP); __hip_atomic_fetch_add(lcnt + i2, 1u, __ATOMIC_RELAXED, __HIP_MEMORY_SCOPE_WORKGROUP);
            }
        }
    }
    if (ROUTER) { __syncthreads(); if (tid < 8) { unsigned* cnt = (unsigned*)(a.ws + WS_CTL) + CW_CNT + 256 * j; __hip_atomic_fetch_add(cnt + tid, lcnt[tid], __ATOMIC_RELAXED, __HIP_MEMORY_SCOPE_AGENT); } }
}

DI void phase_sb_naive(const Args& a, LAS unsigned char* lds, int bid, int G, int tid) {
    const bf16* qkv = (const bf16*)(a.ws + WS_QKV); bf16* ao = (bf16*)(a.ws + WS_AO);
    LAS unsigned char* Ks = lds; LAS unsigned char* Vs = lds + 16384;
    const int qi = tid >> 2, r = tid & 3;
    for (int idx = bid; idx < 64 * 32; idx += G) {
        const int qb = 31 - idx / 64, bh = idx % 64, b = bh >> 3, h = bh & 7;
        const int t = qb * 128 + qi;
        const size_t rowq = (size_t)b * SEQ + t;
        float q[32], o[32];
        { const bf16* qp = qkv + rowq * 3072 + h * 128 + 32 * r;
#pragma unroll
          for (int c = 0; c < 4; ++c) { const v4u w = *(const v4u*)(qp + 8 * c);
              q[8 * c + 0] = bf_lo(w.x); q[8 * c + 1] = bf_hi(w.x); q[8 * c + 2] = bf_lo(w.y); q[8 * c + 3] = bf_hi(w.y);
              q[8 * c + 4] = bf_lo(w.z); q[8 * c + 5] = bf_hi(w.z); q[8 * c + 6] = bf_lo(w.w); q[8 * c + 7] = bf_hi(w.w); }
#pragma unroll
          for (int i = 0; i < 32; ++i) { q[i] *= 0.08838834764831845f; o[i] = 0.f; } }
        float P = 1.0f;
        for (int kt = 2 * qb + 1; kt >= 0; --kt) {
            __syncthreads();
#pragma unroll
            for (int i = 0; i < 2; ++i) { const int c = tid + 512 * i, row = c >> 4, part = c & 15;
                const bf16* src = qkv + ((size_t)b * SEQ + kt * 64 + row) * 3072 + h * 128 + part * 8;
                *(LAS v4u*)(Ks + c * 16) = *(const v4u*)(src + 1024); *(LAS v4u*)(Vs + c * 16) = *(const v4u*)(src + 2048); }
            __syncthreads();
#pragma unroll 1
            for (int s = 63; s >= 0; --s) {
                float z = 0.f;
#pragma unroll
                for (int c = 0; c < 4; ++c) { const v4u w = *(const LAS v4u*)(Ks + s * 256 + r * 64 + c * 16);
                    z += q[8 * c + 0] * bf_lo(w.x) + q[8 * c + 1] * bf_hi(w.x) + q[8 * c + 2] * bf_lo(w.y) + q[8 * c + 3] * bf_hi(w.y)
                       + q[8 * c + 4] * bf_lo(w.z) + q[8 * c + 5] * bf_hi(w.z) + q[8 * c + 6] * bf_lo(w.w) + q[8 * c + 7] * bf_hi(w.w); }
                z += __shfl_xor(z, 1); z += __shfl_xor(z, 2);
                const bool live = (kt * 64 + s) < t;
                const float e = __expf(fminf(z, 80.f)), rr = 1.0f / (1.0f + e);
                const float A = live ? e * rr * P : 0.f;
                P = live ? P * rr : P;
#pragma unroll
                for (int c = 0; c < 4; ++c) { const v4u w = *(const LAS v4u*)(Vs + s * 256 + r * 64 + c * 16);
                    o[8 * c + 0] += A * bf_lo(w.x); o[8 * c + 1] += A * bf_hi(w.x); o[8 * c + 2] += A * bf_lo(w.y); o[8 * c + 3] += A * bf_hi(w.y);
                    o[8 * c + 4] += A * bf_lo(w.z); o[8 * c + 5] += A * bf_hi(w.z); o[8 * c + 6] += A * bf_lo(w.w); o[8 * c + 7] += A * bf_hi(w.w); }
            }
        }
        { bf16* op = ao + rowq * 1024 + h * 128 + 32 * r;
#pragma unroll
          for (int c = 0; c < 4; ++c) { v4u w; w.x = pk2(o[8 * c + 0], o[8 * c + 1]); w.y = pk2(o[8 * c + 2], o[8 * c + 3]); w.z = pk2(o[8 * c + 4], o[8 * c + 5]); w.w = pk2(o[8 * c + 6], o[8 * c + 7]);
              *(v4u*)(op + 8 * c) = w; } }
    }
}


typedef float f2v_ __attribute__((ext_vector_type(2)));
typedef __bf16 b2v_ __attribute__((ext_vector_type(2)));
DI unsigned gdnpk(float a, float b) { const f2v_ v = {a, b}; const b2v_ r = __builtin_convertvector(v, b2v_); return __builtin_bit_cast(unsigned, r); }
namespace sba {
using bf16x8 = __attribute__((ext_vector_type(8))) short;
using s16x4  = __attribute__((ext_vector_type(4))) short;
using f32x16 = __attribute__((ext_vector_type(16))) float;
constexpr int SHM_V = 16384, KPITCH = 272, SHM_K = 64 * KPITCH, LDQ = 3072;
#define KSWZ(row, colB) ((row) * KPITCH + (colB))
#define SBAR() __builtin_amdgcn_sched_barrier(0)
DI int crow(int r, int hi) { return (r & 3) + 8 * (r >> 2) + 4 * hi; }
DI int v_st(int k, int c) { const int kk = (k & ~0xC) | ((k & 4) << 1) | ((k & 8) >> 1); return ((kk >> 3) * 4 + (c >> 5)) * 512 + ((kk & 7) * 32 + (c & 31)) * 2; }
DI int v_rd_base(int lane) { return ((lane & 3) << 3) | (((lane >> 2) & 3) << 6) | (((lane >> 4) & 1) << 5) | (((lane >> 5) & 1) << 8); }
constexpr int v_rd_off(int d0, int ks, int half) { return d0 * 512 + ks * 4096 + half * 2048; }
template <int OFF> DI s16x4 tr_read(int vb) { s16x4 r; asm volatile("ds_read_b64_tr_b16 %0, %1 offset:%2" : "=&v"(r) : "v"(vb), "i"(OFF) : "memory"); return r; }
template <int D0> DI void pv_one(f32x16& od, int vb, bf16x8 pa0, bf16x8 pa1, bf16x8 pa2, bf16x8 pa3) {
  const s16x4 l0 = tr_read<v_rd_off(D0, 0, 0)>(vb), h0 = tr_read<v_rd_off(D0, 0, 1)>(vb), l1 = tr_read<v_rd_off(D0, 1, 0)>(vb), h1 = tr_read<v_rd_off(D0, 1, 1)>(vb);
  const s16x4 l2 = tr_read<v_rd_off(D0, 2, 0)>(vb), h2 = tr_read<v_rd_off(D0, 2, 1)>(vb), l3 = tr_read<v_rd_off(D0, 3, 0)>(vb), h3 = tr_read<v_rd_off(D0, 3, 1)>(vb);
  asm volatile("s_waitcnt lgkmcnt(0)" ::: "memory"); SBAR();
#define PK(L, H) (bf16x8){L[0], L[1], L[2], L[3], H[0], H[1], H[2], H[3]}
  od = __builtin_amdgcn_mfma_f32_32x32x16_bf16(pa0, PK(l0, h0), od, 0, 0, 0);
  od = __builtin_amdgcn_mfma_f32_32x32x16_bf16(pa1, PK(l1, h1), od, 0, 0, 0);
  od = __builtin_amdgcn_mfma_f32_32x32x16_bf16(pa2, PK(l2, h2), od, 0, 0, 0);
  od = __builtin_amdgcn_mfma_f32_32x32x16_bf16(pa3, PK(l3, h3), od, 0, 0, 0);
#undef PK
}
template <int D0> DI void pv_one_T(f32x16& od, int vb, bf16x8 pa0, bf16x8 pa1, bf16x8 pa2, bf16x8 pa3) {
  const s16x4 l0 = tr_read<v_rd_off(D0, 0, 0)>(vb), h0 = tr_read<v_rd_off(D0, 0, 1)>(vb), l1 = tr_read<v_rd_off(D0, 1, 0)>(vb), h1 = tr_read<v_rd_off(D0, 1, 1)>(vb);
  const s16x4 l2 = tr_read<v_rd_off(D0, 2, 0)>(vb), h2 = tr_read<v_rd_off(D0, 2, 1)>(vb), l3 = tr_read<v_rd_off(D0, 3, 0)>(vb), h3 = tr_read<v_rd_off(D0, 3, 1)>(vb);
  asm volatile("s_waitcnt lgkmcnt(0)" ::: "memory"); SBAR();
#define PK(L, H) (bf16x8){L[0], L[1], L[2], L[3], H[0], H[1], H[2], H[3]}
  od = __builtin_amdgcn_mfma_f32_32x32x16_bf16(PK(l0, h0), pa0, od, 0, 0, 0);
  od = __builtin_amdgcn_mfma_f32_32x32x16_bf16(PK(l1, h1), pa1, od, 0, 0, 0);
  od = __builtin_amdgcn_mfma_f32_32x32x16_bf16(PK(l2, h2), pa2, od, 0, 0, 0);
  od = __builtin_amdgcn_mfma_f32_32x32x16_bf16(PK(l3, h3), pa3, od, 0, 0, 0);
#undef PK
}
DI void pv_split(f32x16& od, int vb, bf16x8 pa0, bf16x8 pa1, bf16x8 pa2, bf16x8 pa3) {
  const s16x4 l0 = tr_read<v_rd_off(0, 0, 0)>(vb), h0 = tr_read<v_rd_off(0, 0, 1)>(vb), l1 = tr_read<v_rd_off(0, 1, 0)>(vb), h1 = tr_read<v_rd_off(0, 1, 1)>(vb);
  const s16x4 l2 = tr_read<v_rd_off(0, 2, 0)>(vb), h2 = tr_read<v_rd_off(0, 2, 1)>(vb), l3 = tr_read<v_rd_off(0, 3, 0)>(vb), h3 = tr_read<v_rd_off(0, 3, 1)>(vb);
  asm volatile("s_waitcnt lgkmcnt(0)" ::: "memory"); SBAR();
#define PK(L, H) (bf16x8){L[0], L[1], L[2], L[3], H[0], H[1], H[2], H[3]}
  f32x16 ob = {};
  od = __builtin_amdgcn_mfma_f32_32x32x16_bf16(pa0, PK(l0, h0), od, 0, 0, 0); ob = __builtin_amdgcn_mfma_f32_32x32x16_bf16(pa2, PK(l2, h2), ob, 0, 0, 0);
  od = __builtin_amdgcn_mfma_f32_32x32x16_bf16(pa1, PK(l1, h1), od, 0, 0, 0); ob = __builtin_amdgcn_mfma_f32_32x32x16_bf16(pa3, PK(l3, h3), ob, 0, 0, 0);
  od = od + ob;
#undef PK
}
DI void pv_split_T(f32x16& od, int vb, bf16x8 pa0, bf16x8 pa1, bf16x8 pa2, bf16x8 pa3) {
  const s16x4 l0 = tr_read<v_rd_off(0, 0, 0)>(vb), h0 = tr_read<v_rd_off(0, 0, 1)>(vb), l1 = tr_read<v_rd_off(0, 1, 0)>(vb), h1 = tr_read<v_rd_off(0, 1, 1)>(vb);
  const s16x4 l2 = tr_read<v_rd_off(0, 2, 0)>(vb), h2 = tr_read<v_rd_off(0, 2, 1)>(vb), l3 = tr_read<v_rd_off(0, 3, 0)>(vb), h3 = tr_read<v_rd_off(0, 3, 1)>(vb);
  asm volatile("s_waitcnt lgkmcnt(0)" ::: "memory"); SBAR();
#define PK(L, H) (bf16x8){L[0], L[1], L[2], L[3], H[0], H[1], H[2], H[3]}
  f32x16 ob = {};
  od = __builtin_amdgcn_mfma_f32_32x32x16_bf16(PK(l0, h0), pa0, od, 0, 0, 0); ob = __builtin_amdgcn_mfma_f32_32x32x16_bf16(PK(l2, h2), pa2, ob, 0, 0, 0);
  od = __builtin_amdgcn_mfma_f32_32x32x16_bf16(PK(l1, h1), pa1, od, 0, 0, 0); ob = __builtin_amdgcn_mfma_f32_32x32x16_bf16(PK(l3, h3), pa3, ob, 0, 0, 0);
  od = od + ob;
#undef PK
}
DI void qkt(f32x16& p0, f32x16& p1, const LAS unsigned char* Ks, const bf16x8 (&qr)[8], int r32, int hi) {
  p0 = f32x16{}; p1 = f32x16{};
#pragma unroll
  for (int d0 = 0; d0 < 8; ++d0) { const int cb = (d0 * 16 + hi * 8) * 2;
    const bf16x8 b0 = *(const LAS bf16x8*)(Ks + KSWZ(r32, cb));
    const bf16x8 b1 = *(const LAS bf16x8*)(Ks + KSWZ(32 + r32, cb));
    p0 = __builtin_amdgcn_mfma_f32_32x32x16_bf16(b0, qr[d0], p0, 0, 0, 0);
    p1 = __builtin_amdgcn_mfma_f32_32x32x16_bf16(b1, qr[d0], p1, 0, 0, 0); }
}
template <bool MASK> DI void sb_half(f32x16& p, float& Pc, int hi, int kbase, int trow) {
  float kk[16];
#pragma unroll
  for (int r = 0; r < 16; ++r) {
    float z = p[r];
    if (MASK) z = (kbase + crow(r, hi) < trow) ? z : -__builtin_inff();
    kk[r] = __builtin_amdgcn_rcpf(1.0f + __builtin_amdgcn_exp2f(z));
  }
  float R0[4], R1[4];
#pragma unroll
  for (int g = 0; g < 4; ++g) {
    const float c2 = kk[4 * g + 3], c1 = c2 * kk[4 * g + 2], c0 = c1 * kk[4 * g + 1], R = c0 * kk[4 * g];
    p[4 * g + 3] = 1.0f - c2; p[4 * g + 2] = c2 - c1; p[4 * g + 1] = c1 - c0; p[4 * g] = c0 - R;
    const auto sw = __builtin_amdgcn_permlane32_swap(__float_as_uint(R), __float_as_uint(R), false, false);
    R0[g] = __uint_as_float(sw[0]); R1[g] = __uint_as_float(sw[1]);
  }
#pragma unroll
  for (int g = 3; g >= 0; --g) {
    const float Pin = hi ? Pc : Pc * R1[g];
    p[4 * g + 3] *= Pin; p[4 * g + 2] *= Pin; p[4 * g + 1] *= Pin; p[4 * g] *= Pin;
    Pc *= R0[g] * R1[g];
  }
}
DI unsigned cvtpk(float lo, float hi) { unsigned r; asm volatile("v_cvt_pk_bf16_f32 %0, %1, %2" : "=v"(r) : "v"(lo), "v"(hi)); return r; }
#define PK4(P, BASE, OUT) do { const unsigned a0 = cvtpk(P[BASE + 0], P[BASE + 1]), a1 = cvtpk(P[BASE + 2], P[BASE + 3]);   \
    const unsigned b0 = cvtpk(P[BASE + 4], P[BASE + 5]), b1 = cvtpk(P[BASE + 6], P[BASE + 7]);                              \
    const auto r0 = __builtin_amdgcn_permlane32_swap(a0, b0, false, false); const auto r1 = __builtin_amdgcn_permlane32_swap(a1, b1, false, false); \
    const v4u w = {r0[0], r1[0], r0[1], r1[1]}; OUT = __builtin_bit_cast(bf16x8, w); } while (0)

DI void unit(const bf16* qkv, unsigned char* ao, int b, int h, int qb, LAS unsigned char* lds, int tid) {
  const int wid = __builtin_amdgcn_readfirstlane(tid >> 6), lane = tid & 63, r32 = lane & 31, hi = lane >> 5;
  constexpr bool late = false;
  LAS unsigned char* V_lds = lds; LAS unsigned char* K_lds = lds + 3 * SHM_V;
  const size_t rowbase = (size_t)b * SEQ; const int q0 = qb * 256, t_lo = q0 + wid * 32, trow = t_lo + r32;
  bf16x8 qr[8];
  { const bf16* Qw = qkv + (rowbase + trow) * LDQ + h * 128 + hi * 8; constexpr float C = 0.08838834764831845f * 1.4426950408889634f;
#pragma unroll
    for (int d0 = 0; d0 < 8; ++d0) { const v4u w = *(const v4u*)(Qw + d0 * 16); v4u o;
      o.x = gdnpk(bf_lo(w.x) * C, bf_hi(w.x) * C); o.y = gdnpk(bf_lo(w.y) * C, bf_hi(w.y) * C); o.z = gdnpk(bf_lo(w.z) * C, bf_hi(w.z) * C); o.w = gdnpk(bf_lo(w.w) * C, bf_hi(w.w) * C);
      qr[d0] = __builtin_bit_cast(bf16x8, o); } }
  const bf16* Kh = qkv + rowbase * LDQ + 1024 + h * 128; const bf16* Vh = Kh + 1024;
  const int sr = tid >> 4, sc = (tid & 15) * 8, vst0 = v_st(sr, sc), vst1 = v_st(32 + sr, sc);
  const int vb0 = (int)(unsigned)(size_t)V_lds + v_rd_base(lane);
  bf16x8 vs0, vs1, ks0, ks1;
  const unsigned soff = (unsigned)(sr * LDQ + sc) * 2u;
#define SLOAD(k0) do { const char* kb_ = (const char*)(Kh + (size_t)(k0) * LDQ); const char* vb_ = (const char*)(Vh + (size_t)(k0) * LDQ); \
    vs0 = *(const bf16x8*)(vb_ + soff); vs1 = *(const bf16x8*)(vb_ + (size_t)32 * LDQ * 2 + soff); ks0 = *(const bf16x8*)(kb_ + soff); ks1 = *(const bf16x8*)(kb_ + (size_t)32 * LDQ * 2 + soff); } while (0)
#define SWRITE(bb) do { *(LAS bf16x8*)(V_lds + (bb) * SHM_V + vst0) = vs0; *(LAS bf16x8*)(V_lds + (bb) * SHM_V + vst1) = vs1; const int kc = sc * 2; \
    *(LAS bf16x8*)(K_lds + (bb) * SHM_K + KSWZ(sr, kc)) = ks0; *(LAS bf16x8*)(K_lds + (bb) * SHM_K + KSWZ(32 + sr, kc)) = ks1; } while (0)
  f32x16 o[4] = {}; float Pc = 1.0f;
  constexpr float SB_EPS = 1.0e-12f;
  LAS unsigned* aflag = (LAS unsigned*)(lds + 3 * SHM_V + 3 * SHM_K);
  f32x16 p0 = {}, p1 = {};
  const int NT = qb * 4 + 4;
  SLOAD((NT - 1) * 64);
  int bufc = 0, bufp = 0;
  for (int wi = 0; wi <= NT; ++wi) {
    const int kt = NT - 1 - wi, k0 = kt * 64;
    SEC_IN(4);
    if (wi < NT) { asm volatile("s_waitcnt vmcnt(0)" ::: "memory"); SWRITE(bufc); if (kt > 0) SLOAD(k0 - 64); }
    __syncthreads();
    SEC_OUT(4); SEC_IN(5);
    if (wi > 0) { const v4u f0 = *(const LAS v4u*)(aflag + ((wi - 1) & 1) * 8), f1 = *(const LAS v4u*)(aflag + ((wi - 1) & 1) * 8 + 4);
      if ((f0.x | f0.y | f0.z | f0.w | f1.x | f1.y | f1.z | f1.w) == 0u) break; }
    const bool wlive = __any(Pc >= SB_EPS);
    if (!late && wlive && wi < NT && k0 < t_lo + 31) { __builtin_amdgcn_s_setprio(1); qkt(p0, p1, K_lds + bufc * SHM_K, qr, r32, hi); __builtin_amdgcn_s_setprio(0); }
    { const int ka = late ? k0 + 64 : k0;
      const bool doit = wlive && (late ? (wi > 0 && ka < t_lo + 31) : (wi < NT && k0 < t_lo + 31));
      if (doit) {
        bf16x8 pa0, pa1, pa2, pa3;
        if (ka + 63 >= t_lo) { sb_half<true>(p1, Pc, hi, ka + 32, trow); PK4(p1, 0, pa2); PK4(p1, 8, pa3); SBAR(); sb_half<true>(p0, Pc, hi, ka, trow); }
        else { sb_half<false>(p1, Pc, hi, ka + 32, trow); PK4(p1, 0, pa2); PK4(p1, 8, pa3); SBAR(); sb_half<false>(p0, Pc, hi, ka, trow); }
        PK4(p0, 0, pa0); PK4(p0, 8, pa1);
        const int vb = vb0 + (late ? bufp : bufc) * SHM_V;
        __builtin_amdgcn_s_setprio(1);
        pv_one<0>(o[0], vb, pa0, pa1, pa2, pa3); pv_one<1>(o[1], vb, pa0, pa1, pa2, pa3); pv_one<2>(o[2], vb, pa0, pa1, pa2, pa3); pv_one<3>(o[3], vb, pa0, pa1, pa2, pa3);
        __builtin_amdgcn_s_setprio(0);
      } }
    if (late && wi < NT && k0 < t_lo + 31) { __builtin_amdgcn_s_setprio(1); qkt(p0, p1, K_lds + bufc * SHM_K, qr, r32, hi); __builtin_amdgcn_s_setprio(0); }
    { const bool act = __any(Pc >= SB_EPS); if (lane == 0) aflag[(wi & 1) * 8 + wid] = act ? 1u : 0u; }
    SEC_OUT(5);
    bufp = bufc; bufc = (bufc == 2) ? 0 : bufc + 1;
  }
  { unsigned char* Ob = ao + ((size_t)b * SEQ + qb * 256 + wid * 32) * 1024 + h * 128; const unsigned ooff = (unsigned)(4 * hi * 1024 + r32);
#pragma unroll
    for (int r = 0; r < 16; ++r)
#pragma unroll
      for (int d0 = 0; d0 < 4; ++d0) Ob[ooff + (unsigned)(((r & 3) + 8 * (r >> 2)) * 1024 + d0 * 32)] = (unsigned char)(__builtin_amdgcn_cvt_pk_fp8_f32(pg8::clamp_f8(o[d0][r] * (float)(1 << F8_AO)), 0.f, 0, false) & 0xff); }
#undef SLOAD
#undef SWRITE
}
#undef PK4
#undef KSWZ
#undef SBAR
}
DI void phase_sb_mfma(const Args& a, LAS unsigned char* lds, int bid, int G, int tid) {
    const bf16* qkv = (const bf16*)(a.ws + WS_QKV); unsigned char* ao = a.ws + WS_AO;
    const int vcu = (G % 8 == 0) ? (bid % 8) * (G / 8) + bid / 8 : bid;
    for (int pi = vcu; pi < 512; pi += G) {
        const int bh = pi >> 3, p = pi & 7, b = bh >> 3, h = bh & 7;
        sba::unit(qkv, ao, b, h, 15 - p, lds, tid);
        sba::unit(qkv, ao, b, h, p, lds, tid);
    }
}


namespace gdn {
using bf16x8 = __attribute__((ext_vector_type(8))) short;
using s16x4  = __attribute__((ext_vector_type(4))) short;
using f32x16 = __attribute__((ext_vector_type(16))) float;
typedef float f2v __attribute__((ext_vector_type(2)));
typedef __bf16 b2v __attribute__((ext_vector_type(2)));
DI unsigned pk(float a, float b) { const f2v v = {a, b}; const b2v r = __builtin_convertvector(v, b2v); return __builtin_bit_cast(unsigned, r); }
DI int crow(int r, int hi) { return (r & 3) + 8 * (r >> 2) + 4 * hi; }
DI int pi_slot(int x) { return 8 * ((x >> 2) & 3) + 4 * ((x >> 4) & 1) + (x & 3); }
DI bf16x8 pack_step(const f32x16& x, int s) {
    v4u w; w.x = pk(x[8 * s + 0], x[8 * s + 1]); w.y = pk(x[8 * s + 2], x[8 * s + 3]); w.z = pk(x[8 * s + 4], x[8 * s + 5]); w.w = pk(x[8 * s + 6], x[8 * s + 7]);
    return __builtin_bit_cast(bf16x8, w);
}
DI f32x16 mm(const f32x16& P, const f32x16& Q, f32x16 acc) {
    acc = __builtin_amdgcn_mfma_f32_32x32x16_bf16(pack_step(P, 0), pack_step(Q, 0), acc, 0, 0, 0);
    acc = __builtin_amdgcn_mfma_f32_32x32x16_bf16(pack_step(P, 1), pack_step(Q, 1), acc, 0, 0, 0);
    return acc;
}
#define GPK4(P, BASE, OUT) do { const unsigned a0 = pk(P[BASE + 0], P[BASE + 1]), a1 = pk(P[BASE + 2], P[BASE + 3]);   \
    const unsigned b0 = pk(P[BASE + 4], P[BASE + 5]), b1 = pk(P[BASE + 6], P[BASE + 7]);                              \
    const auto r0 = __builtin_amdgcn_permlane32_swap(a0, b0, false, false); const auto r1 = __builtin_amdgcn_permlane32_swap(a1, b1, false, false); \
    const v4u w_ = {r0[0], r1[0], r0[1], r1[1]}; OUT = __builtin_bit_cast(bf16x8, w_); } while (0)

DI void local_unit(const Args& a, int unit, LAS unsigned char* img, LAS float* tab, int lane, bool dry) {
    const int r32 = lane & 31, hi = lane >> 5;
    const int chunk = unit & 63, bh = unit >> 6, hv = bh & 15, b = bh >> 4, hk = hv >> 1;
    const size_t t0 = (size_t)b * SEQ + chunk * 64;
    bf16* qkvc = (bf16*)(a.ws + WS_QKVC); const float* gb = (const float*)(a.ws + WS_GB);
    bf16* wmem = (bf16*)(a.ws + WS_WMEM) + (size_t)unit * 8192; bf16* imem = (bf16*)(a.ws + WS_IMEM) + (size_t)unit * 4096;
    bf16* ktmem = (bf16*)(a.ws + WS_KTMEM) + (size_t)((b * HK + hk) * 64 + chunk) * 8192; float* gtab = (float*)(a.ws + WS_GTAB) + (size_t)unit * 192;
    SEC_IN(1);
    float gc = gb[(t0 + lane) * 32 + hv]; const float be = gb[(t0 + lane) * 32 + 16 + hv];
#pragma unroll
    for (int off = 1; off < 64; off <<= 1) { const float y = __shfl_up(gc, off); if (lane >= off) gc += y; }
    const float glast = __shfl(gc, 63);
    tab[lane] = gc; tab[64 + lane] = be; tab[128 + lane] = -be * __expf(gc);
    gtab[lane] = __expf(gc); gtab[64 + lane] = __expf(glast - gc); if (lane == 0) gtab[128] = __expf(glast);
    const bf16* kbase = qkvc + t0 * 4096 + 1024 + hk * 128; const bf16* qbase = qkvc + t0 * 4096 + hk * 128; bf16* vbase = qkvc + t0 * 4096 + 2048 + hv * 128;
#define GSB() __builtin_amdgcn_sched_barrier(0)
    {
        f32x16 IT00 = {}, IT11 = {}, IT01 = {};
#pragma unroll
        for (int s = 0; s < 8; ++s) {
            const bf16x8 k0 = *(const bf16x8*)(kbase + (size_t)r32 * 4096 + 16 * s + 8 * hi), k1 = *(const bf16x8*)(kbase + (size_t)(32 + r32) * 4096 + 16 * s + 8 * hi);
            const bf16x8 q0 = *(const bf16x8*)(qbase + (size_t)r32 * 4096 + 16 * s + 8 * hi), q1 = *(const bf16x8*)(qbase + (size_t)(32 + r32) * 4096 + 16 * s + 8 * hi);
            IT00 = __builtin_amdgcn_mfma_f32_32x32x16_bf16(k0, q0, IT00, 0, 0, 0); IT11 = __builtin_amdgcn_mfma_f32_32x32x16_bf16(k1, q1, IT11, 0, 0, 0);
            IT01 = __builtin_amdgcn_mfma_f32_32x32x16_bf16(k0, q1, IT01, 0, 0, 0);
        }
#pragma unroll
        for (int I = 0; I < 2; ++I) { const int c = 32 * I + r32; const float gcc = tab[c];
#pragma unroll
            for (int J = 0; J < 2; ++J)
#pragma unroll
                for (int g = 0; g < 4; ++g) { float v[4];
#pragma unroll
                    for (int i = 0; i < 4; ++i) { const int r = 4 * g + i, cp = 32 * J + crow(r, hi);
                        const float raw = (I == 0) ? (J == 0 ? IT00[r] : 0.f) : (J == 0 ? IT01[r] : IT11[r]);
                        const float val = raw * __expf(-fabsf(gcc - tab[cp])); v[i] = (c >= cp) ? val : 0.f; }
                    v2u o; o.x = pk(v[0], v[1]); o.y = pk(v[2], v[3]);
                    *(v2u*)(imem + (unsigned)((((I * 2 + J) * 4 + g) * 64 + lane) * 4)) = o; } }
    }
    GSB();
    SEC_OUT(1); SEC_IN(2);
    f32x16 T1, T1T, T2T, T21T;
    {
        f32x16 KK = {};
#pragma unroll
        for (int s = 0; s < 8; ++s) { const bf16x8 k0 = *(const bf16x8*)(kbase + (size_t)r32 * 4096 + 16 * s + 8 * hi); KK = __builtin_amdgcn_mfma_f32_32x32x16_bf16(k0, k0, KK, 0, 0, 0); }
        f32x16 M, MT;
        { const float gb0 = tab[r32], bb0 = tab[64 + r32];
#pragma unroll
        for (int r = 0; r < 16; ++r) { const int a0 = crow(r, hi), b0 = r32; const float ke = -KK[r] * __expf(-fabsf(tab[a0] - gb0));
            const float nv = ke * tab[64 + a0], ntv = ke * bb0;
            const float n = (a0 > b0) ? nv : 0.f, nt = (b0 > a0) ? ntv : 0.f, id = (a0 == b0) ? 1.f : 0.f;
            M[r] = n; MT[r] = nt; T1[r] = id + n; T1T[r] = id + nt; } }
#pragma unroll
        for (int it = 0; it < 4; ++it) { const f32x16 z = {};
            const f32x16 Mn = mm(MT, M, z), MTn = mm(M, MT, z);
            const f32x16 Tn = mm(T1T, Mn, T1);
            T1T = mm(Mn, T1T, T1T);
            T1 = Tn; M = Mn; MT = MTn; }
    }
    GSB();
    {
        f32x16 KK = {};
#pragma unroll
        for (int s = 0; s < 8; ++s) { const bf16x8 k1 = *(const bf16x8*)(kbase + (size_t)(32 + r32) * 4096 + 16 * s + 8 * hi); KK = __builtin_amdgcn_mfma_f32_32x32x16_bf16(k1, k1, KK, 0, 0, 0); }
        f32x16 M, MT;
        { const float gb0 = tab[32 + r32], bb0 = tab[96 + r32];
#pragma unroll
        for (int r = 0; r < 16; ++r) { const int a0 = crow(r, hi), b0 = r32; const float ke = -KK[r] * __expf(-fabsf(tab[32 + a0] - gb0));
            const float nv = ke * tab[96 + a0], ntv = ke * bb0;
            const float n = (a0 > b0) ? nv : 0.f, nt = (b0 > a0) ? ntv : 0.f, id = (a0 == b0) ? 1.f : 0.f;
            M[r] = n; MT[r] = nt; T2T[r] = id + nt; } }
#pragma unroll
        for (int it = 0; it < 4; ++it) { const f32x16 z = {};
            const f32x16 Mn = mm(MT, M, z), MTn = mm(M, MT, z);
            T2T = mm(Mn, T2T, T2T);
            M = Mn; MT = MTn; }
    }
    GSB();
    {
        f32x16 L21 = {};
#pragma unroll
        for (int s = 0; s < 8; ++s) { const bf16x8 k0 = *(const bf16x8*)(kbase + (size_t)r32 * 4096 + 16 * s + 8 * hi), k1 = *(const bf16x8*)(kbase + (size_t)(32 + r32) * 4096 + 16 * s + 8 * hi);
            L21 = __builtin_amdgcn_mfma_f32_32x32x16_bf16(k1, k0, L21, 0, 0, 0); }
#pragma unroll
        for (int r = 0; r < 16; ++r) { const int a0 = crow(r, hi); L21[r] = L21[r] * tab[96 + a0] * __expf(tab[32 + a0] - tab[r32]); }
        const f32x16 z = {}; const f32x16 Y = mm(L21, T2T, z); T21T = mm(T1, Y, z);
#pragma unroll
        for (int r = 0; r < 16; ++r) T21T[r] = -T21T[r];
    }
    GSB();
    SEC_OUT(2); SEC_IN(3);
    const int vb = (int)(unsigned)(size_t)img + sba::v_rd_base(lane);
    bf16* ubl = dry ? (bf16*)(a.ws + WS_END) + (size_t)(unit & 63) * 64 * 4096 : vbase;
#pragma unroll 1
    for (int mode = 0; mode < 2; ++mode) {
        const bf16* src = mode == 0 ? (const bf16*)vbase : kbase;
#pragma unroll 1
        for (int hb_ = 0; hb_ < 2; ++hb_) { v4u tl[8];
#pragma unroll
          for (int it = 0; it < 8; ++it) { const int row = (lane >> 4) + 4 * (it + 8 * hb_), col = (lane & 15) * 8; tl[it] = *(const v4u*)(src + (size_t)row * 4096 + col); }
#pragma unroll
          for (int it = 0; it < 8; ++it) { const int row = (lane >> 4) + 4 * (it + 8 * hb_), col = (lane & 15) * 8; *(LAS v4u*)(img + sba::v_st(row, col)) = tl[it]; } }
        LAS float* sc = tab + (mode == 0 ? 64 : 128);
#pragma unroll 1
        for (int I = 0; I < 2; ++I) {
            bf16x8 pa0, pa1, pa2, pa3;
            { f32x16 X;
#pragma unroll
              for (int r = 0; r < 16; ++r) X[r] = (I ? T21T[r] : T1T[r]) * sc[crow(r, hi)];
              GPK4(X, 0, pa0); GPK4(X, 8, pa1);
              { const float on = I ? 1.0f : 0.0f;
#pragma unroll
              for (int r = 0; r < 16; ++r) X[r] = T2T[r] * (sc[32 + crow(r, hi)] * on); }
              GPK4(X, 0, pa2); GPK4(X, 8, pa3); }
#pragma unroll 1
            for (int d0 = 0; d0 < 4; ++d0) {
                f32x16 od = {};
                if (mode == 0) { sba::pv_split(od, vb + d0 * 512, pa0, pa1, pa2, pa3);
                    const unsigned e0 = (unsigned)(((I * 32 + 8 * d0 + (lane >> 5)) * 4096) + (lane & 31) * 4);
#pragma unroll
                    for (int g = 0; g < 4; ++g) { v2u w; w.x = pk(od[4 * g + 0], od[4 * g + 1]); w.y = pk(od[4 * g + 2], od[4 * g + 3]); *(v2u*)(ubl + e0 + (unsigned)(g * 8192)) = w; }
                } else { sba::pv_split_T(od, vb + d0 * 512, pa0, pa1, pa2, pa3);
                    bf16* wp = wmem + (unsigned)((((I * 4 + d0) * 4) * 64 + lane) * 4);
#pragma unroll
                    for (int g = 0; g < 4; ++g) { v2u w; w.x = pk(od[4 * g + 0], od[4 * g + 1]); w.y = pk(od[4 * g + 2], od[4 * g + 3]); *(v2u*)(wp + g * 256) = w; }
                }
                GSB();
            }
        }
        if (mode == 1) {
            const int Ik = hv & 1;
            v4u idw0, idw1;
            { const int d0_ = r32 - 8 * hi, d1_ = r32 - 16 - 8 * hi;
              idw0.x = (d0_ == 0 ? 0x3f80u : 0u) | (d0_ == 1 ? 0x3f800000u : 0u); idw0.y = (d0_ == 2 ? 0x3f80u : 0u) | (d0_ == 3 ? 0x3f800000u : 0u);
              idw0.z = (d0_ == 4 ? 0x3f80u : 0u) | (d0_ == 5 ? 0x3f800000u : 0u); idw0.w = (d0_ == 6 ? 0x3f80u : 0u) | (d0_ == 7 ? 0x3f800000u : 0u);
              idw1.x = (d1_ == 0 ? 0x3f80u : 0u) | (d1_ == 1 ? 0x3f800000u : 0u); idw1.y = (d1_ == 2 ? 0x3f80u : 0u) | (d1_ == 3 ? 0x3f800000u : 0u);
              idw1.z = (d1_ == 4 ? 0x3f80u : 0u) | (d1_ == 5 ? 0x3f800000u : 0u); idw1.w = (d1_ == 6 ? 0x3f80u : 0u) | (d1_ == 7 ? 0x3f800000u : 0u); }
            const bf16x8 id0 = __builtin_bit_cast(bf16x8, idw0), id1 = __builtin_bit_cast(bf16x8, idw1), zf = (bf16x8){};
            const bf16x8 pa0 = Ik ? zf : id0, pa1 = Ik ? zf : id1, pa2 = Ik ? id0 : zf, pa3 = Ik ? id1 : zf;
#pragma unroll 1
            for (int d0 = 0; d0 < 4; ++d0) {
                f32x16 od = {}; sba::pv_split(od, vb + d0 * 512, pa0, pa1, pa2, pa3);
                bf16* kp = ktmem + (unsigned)((((Ik * 4 + d0) * 4) * 64 + lane) * 4);
#pragma unroll
                for (int g = 0; g < 4; ++g) { v2u w; w.x = pk(od[4 * g + 0], od[4 * g + 1]); w.y = pk(od[4 * g + 2], od[4 * g + 3]); *(v2u*)(kp + g * 256) = w; }
                GSB();
            }
        }
    }
    SEC_OUT(3);
#undef GSB
}
#undef GPK4
}
DI void phase_gdn_local(const Args& a, LAS unsigned char* lds, int bid, int G, int wave, int lane, bool dry) {
    LAS unsigned char* img = lds + wave * 16384; LAS float* tab = (LAS float*)(lds + RING_BYTES + 4096 + wave * 1024);
    const int gw = bid * NWAVES + wave, NGW = G * NWAVES;
    for (int unit = gw; unit < BATCH * HV * 64; unit += NGW) gdn::local_unit(a, unit, img, tab, lane, dry);
}
namespace gdn {
constexpr int PW = 272, PI = 144;
constexpr int L_W = 0, L_Q = 64 * PW, L_I = 2 * 64 * PW, L_K = L_I + 64 * PI, L_G = L_K + 128 * PI, L_BUF = L_G + 768;
constexpr int L_PART = 2 * L_BUF;
static_assert(L_PART + 4096 <= RING_BYTES, "scan LDS map");
}
DI void phase_gdn_scan(const Args& a, int j, LAS unsigned char* lds, int bid, int tid, bool dry) {
    if (bid >= BATCH * HV) return;
    using gdn::bf16x8; using gdn::pk; using namespace gdn;
    typedef float f4v __attribute__((ext_vector_type(4)));
    const int wave = __builtin_amdgcn_readfirstlane(tid >> 6), lane = tid & 63, n = lane & 15, kq = lane >> 4;
    const int b = bid / HV, hv = bid % HV, hk = hv >> 1;
    bf16* qkvc = (bf16*)(a.ws + WS_QKVC); const bf16* zb = (const bf16*)(a.ws + WS_ZB);
    LAS float* part = (LAS float*)(lds + L_PART); LAS unsigned char* stg = lds + OGST_OFF;
    const int unit0 = (b * HV + hv) * 64, hku0 = (b * HK + hk) * 64; const size_t tb0 = (size_t)b * SEQ;
    if (wave >= 4) {
        const int st = tid - 256;
        v4u rw[4], rq[4], ri[2], rk[4], rz[4]; float rg = 0.f;
        unsigned ow[4], ok_[4], oi[2], oq[4], oz[4];
#pragma unroll
        for (int k = 0; k < 4; ++k) { const int c = st + 256 * k;
            { const int row = c & 63, p = c >> 6, pp = p & 3; ow[k] = (unsigned)((((((row >> 5) * 4 + (p >> 2)) * 4 + (pp >> 1)) * 64 + (pp & 1) * 32 + (row & 31)) * 4) * 2); }
            { const int dk = c & 127, p = c >> 7, pp = p & 3; ok_[k] = (unsigned)((((((p >> 2) * 4 + (dk >> 5)) * 4 + (pp >> 1)) * 64 + (pp & 1) * 32 + (dk & 31)) * 4) * 2); }
            oq[k] = (unsigned)(((c >> 4) * 4096 + (c & 15) * 8) * 2); oz[k] = (unsigned)(((c >> 4) * 2048 + (c & 15) * 8) * 2); }
#pragma unroll
        for (int k = 0; k < 2; ++k) { const int c = st + 256 * k; const int row = c & 63, p = c >> 6, pp = p & 3; oi[k] = (unsigned)((((((row >> 5) * 2 + (p >> 2)) * 4 + (pp >> 1)) * 64 + (pp & 1) * 32 + (row & 31)) * 4) * 2); }
#define SV_RUN2(dst, base, ob_) do { const v2u a_ = *(const v2u*)((const char*)(base) + (ob_)), b_ = *(const v2u*)((const char*)(base) + (ob_) + 1024); dst = (v4u){a_.x, a_.y, b_.x, b_.y}; } while (0)
#define SV_LOAD(ch) do { const int u_ = unit0 + (ch); const size_t t_ = tb0 + (size_t)(ch) * 64; \
        const bf16* wm_ = (const bf16*)(a.ws + WS_WMEM) + (size_t)u_ * 8192; const bf16* im_ = (const bf16*)(a.ws + WS_IMEM) + (size_t)u_ * 4096; \
        const bf16* kt_ = (const bf16*)(a.ws + WS_KTMEM) + (size_t)(hku0 + (ch)) * 8192; const bf16* qb_ = qkvc + t_ * 4096 + hk * 128; const bf16* zr_ = zb + t_ * 2048 + hv * 128; \
        _Pragma("unroll") for (int k = 0; k < 4; ++k) { SV_RUN2(rw[k], wm_, ow[k]); SV_RUN2(rk[k], kt_, ok_[k]); rq[k] = *(const v4u*)((const char*)qb_ + oq[k]); if (k < 2) rz[k] = *(const v4u*)((const char*)zr_ + oz[k]); } \
        _Pragma("unroll") for (int k = 0; k < 2; ++k) { SV_RUN2(ri[k], im_, oi[k]); } \
        if (st < 192) rg = ((const float*)(a.ws + WS_GTAB))[(size_t)u_ * 192 + st]; } while (0)
#define SV_WRITE(bf) do { LAS unsigned char* B_ = lds + (bf) * L_BUF; \
        _Pragma("unroll") for (int k = 0; k < 4; ++k) { const int c = st + 256 * k; *(LAS v4u*)(B_ + L_W + (c & 63) * PW + (c >> 6) * 16) = rw[k]; \
            *(LAS v4u*)(B_ + L_Q + (c >> 4) * PW + (c & 15) * 16) = rq[k]; *(LAS v4u*)(B_ + L_K + (c & 127) * PI + (c >> 7) * 16) = rk[k]; } \
        _Pragma("unroll") for (int k = 0; k < 2; ++k) { const int c = st + 256 * k; *(LAS v4u*)(B_ + L_I + (c & 63) * PI + (c >> 6) * 16) = ri[k]; } \
        if (st < 192) *(LAS float*)(B_ + L_G + st * 4) = rg; } while (0)
        f32x4 nwa, nwb;
        { const float* nwp = a.gdn_norm_w + j * 128 + (st & 15) * 8; nwa = *(const f32x4*)nwp; nwb = *(const f32x4*)(nwp + 4); }
        volatile LAS unsigned* flag = (volatile LAS unsigned*)(lds + L_PART);
        SV_LOAD(0); SV_WRITE(0);
        v4u zc[2], zn[2];
#pragma unroll
        for (int k = 0; k < 2; ++k) zc[k] = rz[k];
        __syncthreads();
        SV_LOAD(1);
#pragma unroll 1
        for (int chunk = 0; chunk < 64; ++chunk) {
            if (chunk + 1 < 64) { SV_WRITE((chunk + 1) & 1);
#pragma unroll
                for (int k = 0; k < 2; ++k) zn[k] = rz[k]; }
            __syncthreads();
            v4u ov[2];
#pragma unroll
            for (int k = 0; k < 2; ++k) { const int c = st + 256 * k; ov[k] = *(const LAS v4u*)(stg + (c >> 4) * 256 + (c & 15) * 16); }
            asm volatile("s_waitcnt lgkmcnt(0)" ::: "memory");
            if (lane == 0) __hip_atomic_fetch_add((LAS unsigned*)(lds + L_PART), 1u, __ATOMIC_RELAXED, __HIP_MEMORY_SCOPE_WORKGROUP);
            if (chunk + 2 < 64) SV_LOAD(chunk + 2);
            __builtin_amdgcn_sched_barrier(0);
            unsigned char* ob = dry ? a.ws + WS_END + (size_t)bid * 64 * 128 : a.ws + WS_G8 + (tb0 + (size_t)chunk * 64) * 2048 + hv * 128;
#pragma unroll
            for (int k = 0; k < 2; ++k) {
                float o8[8]; o8[0] = bf_lo(ov[k].x); o8[1] = bf_hi(ov[k].x); o8[2] = bf_lo(ov[k].y); o8[3] = bf_hi(ov[k].y); o8[4] = bf_lo(ov[k].z); o8[5] = bf_hi(ov[k].z); o8[6] = bf_lo(ov[k].w); o8[7] = bf_hi(ov[k].w);
                float ss = 0.f;
#pragma unroll
                for (int e = 0; e < 8; ++e) ss += o8[e] * o8[e];
                const float rinv = __builtin_amdgcn_rsqf(dpp_sum16(ss) * (1.0f / 128.0f) + RMS_EPS);
                float z8[8]; z8[0] = bf_lo(zc[k].x); z8[1] = bf_hi(zc[k].x); z8[2] = bf_lo(zc[k].y); z8[3] = bf_hi(zc[k].y); z8[4] = bf_lo(zc[k].z); z8[5] = bf_hi(zc[k].z); z8[6] = bf_lo(zc[k].w); z8[7] = bf_hi(zc[k].w);
                float r8[8];
#pragma unroll
                for (int e = 0; e < 8; ++e) r8[e] = o8[e] * rinv * (e < 4 ? nwa[e] : nwb[e - 4]) * z8[e];
                constexpr float gs = (float)(1 << F8_GO); v2u w; w.x = pg8::pk4_f8(r8[0] * gs, r8[1] * gs, r8[2] * gs, r8[3] * gs); w.y = pg8::pk4_f8(r8[4] * gs, r8[5] * gs, r8[6] * gs, r8[7] * gs);
                *(v2u*)(ob + (dry ? (unsigned)(((st + 256 * k) >> 4) * 128 + ((st + 256 * k) & 15) * 8) : (oz[k] >> 1))) = w; }
#pragma unroll
            for (int k = 0; k < 2; ++k) zc[k] = zn[k];
        }
#undef SV_RUN2
#undef SV_LOAD
#undef SV_WRITE
        return;
    }
    f4v S[2][8];
#pragma unroll
    for (int g = 0; g < 2; ++g)
#pragma unroll
        for (int m = 0; m < 8; ++m) S[g][m] = (f4v){0.f, 0.f, 0.f, 0.f};
    v2u un[2][4];
#define CW_ULOAD(ch) do { const bf16* vb_ = qkvc + (tb0 + (size_t)(ch) * 64) * 4096 + 2048 + hv * 128; \
        _Pragma("unroll") for (int g = 0; g < 2; ++g) _Pragma("unroll") for (int mt = 0; mt < 4; ++mt) { \
            const int f = (((((mt >> 1) * 4 + wave) * 4 + 2 * (mt & 1) + (kq >> 1)) * 64) + (kq & 1) * 32 + 16 * g + n) * 4;     \
            un[g][mt] = *(const v2u*)(vb_ + (size_t)(f >> 7) * 4096 + (f & 127)); } } while (0)
    CW_ULOAD(0);
    if (tid == 0) *(volatile LAS unsigned*)(lds + L_PART) = 0u;
    __syncthreads();
#pragma unroll 1
    for (int chunk = 0; chunk < 64; ++chunk) {
        GSEC_ACC(8, -);
        const LAS unsigned char* B = lds + (chunk & 1) * L_BUF; const LAS float* gt = (const LAS float*)(B + L_G);
        f4v av[2][4], ao[2][4];
#pragma unroll
        for (int g = 0; g < 2; ++g)
#pragma unroll
            for (int mt = 0; mt < 4; ++mt) { const v2u u0 = un[g][mt]; av[g][mt] = (f4v){bf_lo(u0.x), bf_hi(u0.x), bf_lo(u0.y), bf_hi(u0.y)}; }
        v4u zq[2];
#pragma unroll
        for (int k = 0; k < 2; ++k) { const int c = tid + 512 + 256 * k; zq[k] = *(const v4u*)(zb + (tb0 + (size_t)chunk * 64 + (c >> 4)) * 2048 + hv * 128 + (c & 15) * 8); }
        if (chunk + 1 < 64) CW_ULOAD(chunk + 1);
        bf16x8 Sb[2][4];
#pragma unroll
        for (int g = 0; g < 2; ++g)
#pragma unroll
            for (int p = 0; p < 4; ++p) { v4u w; w.x = pk(S[g][2 * p][0], S[g][2 * p][1]); w.y = pk(S[g][2 * p][2], S[g][2 * p][3]); w.z = pk(S[g][2 * p + 1][0], S[g][2 * p + 1][1]); w.w = pk(S[g][2 * p + 1][2], S[g][2 * p + 1][3]);
                Sb[g][p] = __builtin_bit_cast(bf16x8, w); }
#pragma unroll
        for (int mt = 0; mt < 4; ++mt) { ao[0][mt] = (f4v){0.f, 0.f, 0.f, 0.f}; ao[1][mt] = (f4v){0.f, 0.f, 0.f, 0.f};
#pragma unroll
            for (int p = 0; p < 4; ++p) {
                const bf16x8 aw = *(const LAS bf16x8*)(B + L_W + (16 * mt + n) * PW + 64 * p + 16 * kq);
                const v2u q0 = *(const LAS v2u*)(B + L_Q + (16 * mt + n) * PW + 64 * p + 8 * kq), q1 = *(const LAS v2u*)(B + L_Q + (16 * mt + n) * PW + 64 * p + 32 + 8 * kq);
                const v4u qq = {q0.x, q0.y, q1.x, q1.y}; const bf16x8 aq = __builtin_bit_cast(bf16x8, qq);
                av[0][mt] = __builtin_amdgcn_mfma_f32_16x16x32_bf16(aw, Sb[0][p], av[0][mt], 0, 0, 0); av[1][mt] = __builtin_amdgcn_mfma_f32_16x16x32_bf16(aw, Sb[1][p], av[1][mt], 0, 0, 0);
                ao[0][mt] = __builtin_amdgcn_mfma_f32_16x16x32_bf16(aq, Sb[0][p], ao[0][mt], 0, 0, 0); ao[1][mt] = __builtin_amdgcn_mfma_f32_16x16x32_bf16(aq, Sb[1][p], ao[1][mt], 0, 0, 0); } }
        bf16x8 vbf[2][2], vbd[2][2];
#pragma unroll
        for (int pp = 0; pp < 2; ++pp) {
            const f4v d0 = *(const LAS f4v*)(gt + 64 + 32 * pp + 4 * kq), d1 = *(const LAS f4v*)(gt + 64 + 32 * pp + 16 + 4 * kq);
#pragma unroll
            for (int g = 0; g < 2; ++g) { const f4v x0 = av[g][2 * pp], x1 = av[g][2 * pp + 1];
                v4u w; w.x = pk(x0[0], x0[1]); w.y = pk(x0[2], x0[3]); w.z = pk(x1[0], x1[1]); w.w = pk(x1[2], x1[3]); vbf[g][pp] = __builtin_bit_cast(bf16x8, w);
                v4u y; y.x = pk(x0[0] * d0[0], x0[1] * d0[1]); y.y = pk(x0[2] * d0[2], x0[3] * d0[3]); y.z = pk(x1[0] * d1[0], x1[1] * d1[1]); y.w = pk(x1[2] * d1[2], x1[3] * d1[3]); vbd[g][pp] = __builtin_bit_cast(bf16x8, y); }
        }
#pragma unroll
        for (int mt = 0; mt < 4; ++mt) { const f4v eg = *(const LAS f4v*)(gt + 16 * mt + 4 * kq); ao[0][mt] = ao[0][mt] * eg; ao[1][mt] = ao[1][mt] * eg;
#pragma unroll
            for (int pp = 0; pp < 2; ++pp) { const bf16x8 ai = *(const LAS bf16x8*)(B + L_I + (16 * mt + n) * PI + 64 * pp + 16 * kq);
                ao[0][mt] = __builtin_amdgcn_mfma_f32_16x16x32_bf16(ai, vbf[0][pp], ao[0][mt], 0, 0, 0); ao[1][mt] = __builtin_amdgcn_mfma_f32_16x16x32_bf16(ai, vbf[1][pp], ao[1][mt], 0, 0, 0); } }
        { const float egl = gt[128];
#pragma unroll
          for (int m8 = 0; m8 < 8; ++m8) { S[0][m8] = S[0][m8] * egl; S[1][m8] = S[1][m8] * egl;
#pragma unroll
              for (int pp = 0; pp < 2; ++pp) { const bf16x8 ak = *(const LAS bf16x8*)(B + L_K + (16 * m8 + n) * PI + 64 * pp + 16 * kq);
                  S[0][m8] = __builtin_amdgcn_mfma_f32_16x16x32_bf16(ak, vbd[0][pp], S[0][m8], 0, 0, 0); S[1][m8] = __builtin_amdgcn_mfma_f32_16x16x32_bf16(ak, vbd[1][pp], S[1][m8], 0, 0, 0); } } }
        GSEC_ACC(8, +); GSEC_ACC(9, -);
        { unsigned spins = 0; while (*(volatile LAS unsigned*)(lds + L_PART) < 8u * (unsigned)chunk) { __builtin_amdgcn_s_sleep(1); if (++spins > (1u << 22)) break; } }
#pragma unroll
        for (int g = 0; g < 2; ++g)
#pragma unroll
            for (int mt = 0; mt < 4; ++mt)
#pragma unroll
                for (int i = 0; i < 4; ++i) *(LAS bf16*)(stg + (16 * mt + 4 * kq + i) * 256 + (32 * wave + 16 * g + n) * 2) = (bf16)(pk(ao[g][mt][i], 0.f) & 0xffffu);
        __syncthreads();
        GSEC_ACC(9, +);
        {
            v4u ov[2];
#pragma unroll
            for (int k = 0; k < 2; ++k) { const int c = tid + 512 + 256 * k; ov[k] = *(const LAS v4u*)(stg + (c >> 4) * 256 + (c & 15) * 16); }
            asm volatile("s_waitcnt lgkmcnt(0)" ::: "memory");
            if (lane == 0) __hip_atomic_fetch_add((LAS unsigned*)(lds + L_PART), 1u, __ATOMIC_RELAXED, __HIP_MEMORY_SCOPE_WORKGROUP);
            const f32x4 nwa = *(const f32x4*)(a.gdn_norm_w + j * 128 + (tid & 15) * 8), nwb = *(const f32x4*)(a.gdn_norm_w + j * 128 + (tid & 15) * 8 + 4);
            unsigned char* ob = a.ws + WS_G8 + (tb0 + (size_t)chunk * 64) * 2048 + hv * 128;
#pragma unroll
            for (int k = 0; k < 2; ++k) { const int c = tid + 512 + 256 * k;
                float o8[8]; unpack8(ov[k], o8); float ss = 0.f;
#pragma unroll
                for (int e = 0; e < 8; ++e) ss += o8[e] * o8[e];
                const float rinv = __builtin_amdgcn_rsqf(dpp_sum16(ss) * (1.0f / 128.0f) + RMS_EPS);
                float z8[8]; unpack8(zq[k], z8); float r8[8];
#pragma unroll
                for (int e = 0; e < 8; ++e) r8[e] = o8[e] * rinv * (e < 4 ? nwa[e] : nwb[e - 4]) * z8[e];
                constexpr float gs = (float)(1 << F8_GO); v2u w; w.x = pg8::pk4_f8(r8[0] * gs, r8[1] * gs, r8[2] * gs, r8[3] * gs); w.y = pg8::pk4_f8(r8[4] * gs, r8[5] * gs, r8[6] * gs, r8[7] * gs);
                *(v2u*)(ob + (size_t)(c >> 4) * 2048 + (c & 15) * 8) = w; }
        }
    }
#undef CW_ULOAD
}

DI void moe_offsets(const Args& a, int j, unsigned (&off)[9]) {
    unsigned* cnt = (unsigned*)(a.ws + WS_CTL) + CW_CNT + 256 * j; unsigned acc = 0u;
#pragma unroll
    for (int e = 0; e < 8; ++e) { off[e] = acc; const unsigned c = (unsigned)__builtin_amdgcn_readfirstlane((int)__hip_atomic_load(cnt + e, __ATOMIC_RELAXED, __HIP_MEMORY_SCOPE_AGENT)); acc += (c + 255u) & ~255u; }
    off[8] = acc;
}
DI void phase_scatter(const Args& a, int j, LAS unsigned char* lds, int bid, int G, int tid, int wave, int lane) {
    LAS unsigned* lc = (LAS unsigned*)lds; LAS unsigned* lb = lc + 8; LAS unsigned* loff = lc + 16; LAS int* lpos = (LAS int*)(lc + 32);
    const unsigned* E12 = (const unsigned*)(a.ws + WS_E12); int* POS = (int*)(a.ws + WS_POS);
    const unsigned char* HB = a.ws + WS_HB; unsigned char* XS = a.ws + WS_XS;
    unsigned* fill = (unsigned*)(a.ws + WS_CTL) + CW_CNT + 256 * j + 64;
    unsigned off[9]; moe_offsets(a, j, off);
    if (tid == 0) {
#pragma unroll
        for (int e = 0; e < 8; ++e) loff[e] = off[e]; }
    for (int ci = bid; ci < TT / 128; ci += G) {
        __syncthreads();
        if (tid < 8) lc[tid] = 0u;
        __syncthreads();
        unsigned e1 = 0, e2 = 0, r1 = 0, r2 = 0;
        if (tid < 128) { const unsigned w = E12[ci * 128 + tid]; e1 = w & 255u; e2 = (w >> 8) & 255u;
            r1 = __hip_atomic_fetch_add(lc + e1, 1u, __ATOMIC_RELAXED, __HIP_MEMORY_SCOPE_WORKGROUP); r2 = __hip_atomic_fetch_add(lc + e2, 1u, __ATOMIC_RELAXED, __HIP_MEMORY_SCOPE_WORKGROUP); }
        __syncthreads();
        if (tid < 8) lb[tid] = __hip_atomic_fetch_add(fill + tid, lc[tid], __ATOMIC_RELAXED, __HIP_MEMORY_SCOPE_AGENT);
        __syncthreads();
        if (tid < 128) { const int p1 = (int)(loff[e1] + lb[e1] + r1), p2 = (int)(loff[e2] + lb[e2] + r2);
            lpos[2 * tid] = p1; lpos[2 * tid + 1] = p2; POS[2 * (ci * 128 + tid)] = p1; POS[2 * (ci * 128 + tid) + 1] = p2;
            const float hs = ((const float*)(a.ws + WS_HS))[ci * 128 + tid]; float* XSS = (float*)(a.ws + WS_XSS); XSS[p1] = hs; XSS[p2] = hs; }
        __syncthreads();
        {
            v4u xr[128 / NWAVES];
#pragma unroll
            for (int i = 0; i < 128 / NWAVES; ++i) xr[i] = ((const v4u*)(HB + (size_t)(ci * 128 + wave + NWAVES * i) * D))[lane];
#pragma unroll
            for (int i = 0; i < 128 / NWAVES; ++i) { const int tk = wave + NWAVES * i; const int p1 = lpos[2 * tk], p2 = lpos[2 * tk + 1];
                ((v4u*)(XS + (size_t)p1 * D))[lane] = xr[i]; ((v4u*)(XS + (size_t)p2 * D))[lane] = xr[i]; }
        }
    }
}

template <bool FINAL>
DI void phase_combine_ln(const Args& a, const bf16* Yin, bf16* Yout, int lnprev, int lnidx, int bid, int G, int wave, int lane) {
    bf16* HB = (bf16*)(a.ws + WS_HB); const unsigned char* YE = a.ws + WS_XS; float* stats = (float*)(a.ws + WS_STATS);
    const int* POS = (const int*)(a.ws + WS_POS); const f32x2* G12 = (const f32x2*)(a.ws + WS_G12);
    const float* g = a.ln_g + (size_t)lnidx * D; const float* bta = a.ln_b + (size_t)lnidx * D;
    const float* gp = a.ln_g + (size_t)lnprev * D; const float* bp = a.ln_b + (size_t)lnprev * D;
    const int gw = bid * NWAVES + wave, NGW = G * NWAVES;
    float gv[2][8], bv[2][8], gq[2][8], bq[2][8];
#pragma unroll
    for (int q = 0; q < 2; ++q)
#pragma unroll
        for (int c = 0; c < 8; ++c) { const int col = 8 * (lane + 64 * q) + c; gv[q][c] = g[col]; bv[q][c] = bta[col]; gq[q][c] = gp[col] * ALPHA; bq[q][c] = bp[col] * ALPHA; }
    int pn1 = 0, pn2 = 0; f32x2 ggn = {0.f, 0.f}, stn = {0.f, 0.f}; v4u ny[2]; v2u ne1[2], ne2[2];
    if (gw < TT) { pn1 = POS[2 * gw]; pn2 = POS[2 * gw + 1]; ggn = G12[gw]; stn = *(const f32x2*)(stats + 2 * (size_t)gw);
#pragma unroll
        for (int q = 0; q < 2; ++q) { ny[q] = ((const v4u*)(Yin + (size_t)gw * D))[lane + 64 * q]; ne1[q] = ((const v2u*)(YE + (size_t)pn1 * D))[lane + 64 * q]; ne2[q] = ((const v2u*)(YE + (size_t)pn2 * D))[lane + 64 * q]; } }
    int pa1 = 0, pa2 = 0; if (gw + NGW < TT) { pa1 = POS[2 * (gw + NGW)]; pa2 = POS[2 * (gw + NGW) + 1]; }
    for (int t = gw; t < TT; t += NGW) {
        const f32x2 gg = ggn * (1.0f / (float)(1 << F8_YE)); const f32x2 st = stn;
        v4u cy[2]; v2u ce1[2], ce2[2];
#pragma unroll
        for (int q = 0; q < 2; ++q) { cy[q] = ny[q]; ce1[q] = ne1[q]; ce2[q] = ne2[q]; }
        if (t + NGW < TT) { const int tn = t + NGW; ggn = G12[tn]; stn = *(const f32x2*)(stats + 2 * (size_t)tn);
#pragma unroll
            for (int q = 0; q < 2; ++q) { ny[q] = ((const v4u*)(Yin + (size_t)tn * D))[lane + 64 * q]; ne1[q] = ((const v2u*)(YE + (size_t)pa1 * D))[lane + 64 * q]; ne2[q] = ((const v2u*)(YE + (size_t)pa2 * D))[lane + 64 * q]; } }
        if (t + 2 * NGW < TT) { pa1 = POS[2 * (t + 2 * NGW)]; pa2 = POS[2 * (t + 2 * NGW) + 1]; }
        float v[2][8]; float s = 0.f;
#pragma unroll
        for (int q = 0; q < 2; ++q) { float y[8], e1[8], e2[8];
            unpack8(cy[q], y); unpack8_f8(ce1[q], e1); unpack8_f8(ce2[q], e2);
#pragma unroll
            for (int c = 0; c < 8; ++c) { v[q][c] = (y[c] - st.x) * st.y * gq[q][c] + bq[q][c] + e1[c] * gg.x + e2[c] * gg.y; s += v[q][c]; } }
        const float mean = wave_sum(s) * (1.0f / D); float s2 = 0.f;
#pragma unroll
        for (int q = 0; q < 2; ++q)
#pragma unroll
            for (int c = 0; c < 8; ++c) { const float d = v[q][c] - mean; s2 += d * d; }
        const float rstd = 1.0f / sqrtf(wave_sum(s2) * (1.0f / D) + LN_EPS);
        if (!FINAL && lane == 0) *(f32x2*)(stats + 2 * (size_t)t) = (f32x2){mean, rstd};
        float hn[2][8]; float am = 0.f;
#pragma unroll
        for (int q = 0; q < 2; ++q)
#pragma unroll
            for (int c = 0; c < 8; ++c) { hn[q][c] = (v[q][c] - mean) * rstd * gv[q][c] + bv[q][c]; am = fmaxf(am, fabsf(hn[q][c])); }
        if (FINAL) {
#pragma unroll
            for (int q = 0; q < 2; ++q) { f32x4* orow = (f32x4*)(a.out + (size_t)t * D + 8 * (lane + 64 * q)); orow[0] = (f32x4){hn[q][0], hn[q][1], hn[q][2], hn[q][3]}; orow[1] = (f32x4){hn[q][4], hn[q][5], hn[q][6], hn[q][7]}; }
        } else {
            am = fmaxf(wave_max_nn(am), 1.0e-20f); const float qs = 127.0f / am;
            if (lane == 0) ((float*)(a.ws + WS_HS))[t] = am * (1.0f / 127.0f);
#pragma unroll
            for (int q = 0; q < 2; ++q) { v4u yo; yo.x = pk2(v[q][0], v[q][1]); yo.y = pk2(v[q][2], v[q][3]); yo.z = pk2(v[q][4], v[q][5]); yo.w = pk2(v[q][6], v[q][7]); ((v4u*)(Yout + (size_t)t * D))[lane + 64 * q] = yo;
                v2u o; o.x = pk4_i8(hn[q][0] * qs, hn[q][1] * qs, hn[q][2] * qs, hn[q][3] * qs); o.y = pk4_i8(hn[q][4] * qs, hn[q][5] * qs, hn[q][6] * qs, hn[q][7] * qs);
                ((v2u*)((unsigned char*)HB + (size_t)t * D))[lane + 64 * q] = o; }
        }
    }
}

constexpr int ARGS_OFF = RING_BYTES + 1024;
DI unsigned long long lds_u64(LAS unsigned char* p) { const v2u w = *(const volatile LAS v2u*)p; return ((unsigned long long)(unsigned)__builtin_amdgcn_readfirstlane((int)w.y) << 32) | (unsigned)__builtin_amdgcn_readfirstlane((int)w.x); }
DI Args load_args(LAS unsigned char* lds) {
    Args a; LAS unsigned char* p = lds + ARGS_OFF;
    a.x = (const float*)(const GAS float*)lds_u64(p + 0); a.gdn_w_in = (const float*)(const GAS float*)lds_u64(p + 8); a.gdn_conv_w = (const float*)(const GAS float*)lds_u64(p + 16); a.gdn_a_log = (const float*)(const GAS float*)lds_u64(p + 24);
    a.gdn_dt_bias = (const float*)(const GAS float*)lds_u64(p + 32); a.gdn_norm_w = (const float*)(const GAS float*)lds_u64(p + 40); a.gdn_w_out = (const float*)(const GAS float*)lds_u64(p + 48); a.sb_w_in = (const float*)(const GAS float*)lds_u64(p + 56);
    a.sb_w_out = (const float*)(const GAS float*)lds_u64(p + 64); a.ffn_w_gate = (const float*)(const GAS float*)lds_u64(p + 72); a.ffn_w_up = (const float*)(const GAS float*)lds_u64(p + 80); a.ffn_w_down = (const float*)(const GAS float*)lds_u64(p + 88);
    a.moe_router = (const float*)(const GAS float*)lds_u64(p + 96); a.moe_w_gate = (const float*)(const GAS float*)lds_u64(p + 104); a.moe_w_up = (const float*)(const GAS float*)lds_u64(p + 112); a.moe_w_down = (const float*)(const GAS float*)lds_u64(p + 120);
    a.ln_g = (const float*)(const GAS float*)lds_u64(p + 128); a.ln_b = (const float*)(const GAS float*)lds_u64(p + 136); a.out = (float*)(GAS float*)lds_u64(p + 144); a.ws = (unsigned char*)(GAS unsigned char*)lds_u64(p + 152);
    const v2u w = *(const volatile LAS v2u*)(p + 160); a.ph_lo = __builtin_amdgcn_readfirstlane((int)w.x); a.ph_hi = __builtin_amdgcn_readfirstlane((int)w.y);
    return a;
}
#ifdef PH_ONLY
#define IN(k) (((k) % NPH) == PH_ONLY && lo <= (k) && (k) < hi)
#else
#define IN(k) (lo <= (k) && (k) < hi)
#endif
#define SEAM(k) do { if ((k) + 1 < hi) xcd_barrier(bar, tid == 0); } while (0)
DI int fresh_lane() { int l; asm volatile("v_mbcnt_lo_u32_b32 %0, -1, 0\n\tv_mbcnt_hi_u32_b32 %0, -1, %0" : "=v"(l)); return l; }
#define YMOE ((bf16*)(j == 1 ? (void*)(args.ws + WS_YT) : (void*)args.out))
#define ARGS() const Args args = load_args(lds); const int lo = args.ph_lo, hi = args.ph_hi; const int lane = fresh_lane(), tid = wave * 64 + lane
#ifndef PROBE_REP_MASK
#define PROBE_REP_MASK 0
#endif
#ifndef PROBE_DELAY_MASK
#define PROBE_DELAY_MASK 0
#endif
#define PROBE_DELAY_MULT 4u
#define TICK_IN(k) do { if (((PROBE_DELAY_MASK) >> (k)) & 1) { if (bid == 0 && tid == 0) ((volatile LAS unsigned*)(lds + MISC_OFF))[20] -= (unsigned)__builtin_amdgcn_s_memrealtime(); } } while (0)
#define TICK_OUT(k) do { if (((PROBE_DELAY_MASK) >> (k)) & 1) { if (bid == 0 && tid == 0) ((volatile LAS unsigned*)(lds + MISC_OFF))[20] += (unsigned)__builtin_amdgcn_s_memrealtime(); } } while (0)
#define NREP(k) ((((PROBE_REP_MASK) >> (k)) & 1) ? 2 : 1)
template <int j>
DI void layer_pair(LAS unsigned char* lds, const XcdBarrier& bar, const int wave, const int G, const int bid) {
    constexpr int pb = j * NPH;
    if constexpr (j == 0) { ARGS(); if (IN(pb + 0)) { TICK_IN(0); _Pragma("unroll 1") for (int rep_ = 0; rep_ < NREP(0); ++rep_) { phase_w_gdn(args, j, 3, lds, bid, G, tid, wave, lane); } SEAM(pb + 0); TICK_OUT(0); } }
    { ARGS(); if (IN(pb + 1)) { TICK_IN(1); {
        pg8::Gemm g{(const bf16*)(args.ws + WS_HB), (const bf16*)(args.ws + W_IN_(j)), D / 2, D / 2}; pg8::StaticOrder S; S.init(TT, GINP, G, bid, NREP(1));
        pg8::EpiI8<pg8::EpiInProj> E{{(bf16*)(args.ws + WS_RAW), (bf16*)(args.ws + WS_ZB)}, (const float*)(args.ws + WS_HS), (const float*)(args.ws + WS_SWI_(j))};
        pg8::gemm_phase<pg8::EpiI8<pg8::EpiInProj>, pg8::StaticOrder, true, true, 2>(lds, g, S, E, wave);
        } SEAM(pb + 1); TICK_OUT(1); } }
    { ARGS(); if (IN(pb + 2)) { TICK_IN(2); _Pragma("unroll 1") for (int rep_ = 0; rep_ < NREP(2); ++rep_) { phase_conv(args, j, bid, G, tid); } SEAM(pb + 2); TICK_OUT(2); } }
#if GDN_NAIVE
    { ARGS(); if (IN(pb + 4)) { TICK_IN(4); _Pragma("unroll 1") for (int rep_ = 0; rep_ < NREP(4); ++rep_) { phase_gdn_naive(args, j, lds, bid, tid); } SEAM(pb + 4); TICK_OUT(4); } }
#else
    { ARGS(); if (IN(pb + 3)) { TICK_IN(3); _Pragma("unroll 1") for (int rep_ = 0; rep_ < NREP(3); ++rep_) { phase_gdn_local(args, lds, bid, G, wave, lane, rep_ + 1 < NREP(3)); } SEAM(pb + 3); TICK_OUT(3); } }
    { ARGS(); if (IN(pb + 4)) { TICK_IN(4); _Pragma("unroll 1") for (int rep_ = 0; rep_ < NREP(4); ++rep_) { if (bid >= BATCH * HV && G > BATCH * HV) phase_w_sb(args, j, lds, bid - BATCH * HV, G - BATCH * HV, wave, lane); else if (G <= BATCH * HV && rep_ == 0) phase_w_sb(args, j, lds, bid, G, wave, lane);
        phase_gdn_scan(args, j, lds, bid, tid, rep_ + 1 < NREP(4)); } SEAM(pb + 4); TICK_OUT(4); } }
#endif
    { ARGS(); if (IN(pb + 5)) { TICK_IN(5); {
        pg8::Gemm g{(const bf16*)(args.ws + WS_G8), (const bf16*)(args.ws + W_OUT_(j)), 1024, 1024}; pg8::StaticOrder S; S.init(TT, D, G, bid);
        pg8::EpiResid<(j > 0), F8_GO + F8_WO> E{j == 0 ? (const void*)args.x : (const void*)args.out, (bf16*)args.out, (const float*)(args.ws + WS_STATS), args.ln_g + (size_t)(4 * (j > 0 ? j - 1 : 0) + 3) * D, args.ln_b + (size_t)(4 * (j > 0 ? j - 1 : 0) + 3) * D};
        pg8::gemm_phase<pg8::EpiResid<(j > 0), F8_GO + F8_WO>, pg8::StaticOrder, true, true, 1>(lds, g, S, E, wave);
        } SEAM(pb + 5); TICK_OUT(5); } }
    { ARGS(); if (IN(pb + 6)) { TICK_IN(6); _Pragma("unroll 1") for (int rep_ = 0; rep_ < NREP(6); ++rep_) { phase_ln<false, true>(args, (const bf16*)args.out, (2 * j) * 2 + 0, j, lds, bid, G, tid, wave, lane); } SEAM(pb + 6); TICK_OUT(6); } }
    { ARGS(); if (IN(pb + 7)) { TICK_IN(7); {
        pg8::Gemm g{(const bf16*)(args.ws + WS_HB), (const bf16*)(args.ws + W_GU_(j)), D / 2, D / 2}; pg8::StaticOrder S; S.init(TT, 2 * FF, G, bid, NREP(7));
        pg8::EpiI8SwiGLUf<F8_ACT> E{args.ws + WS_ACT, FF, 0, (const float*)(args.ws + WS_HS), (const float*)(args.ws + WS_SWD_(j))};
        pg8::gemm_phase<pg8::EpiI8SwiGLUf<F8_ACT>, pg8::StaticOrder, true, true, 2>(lds, g, S, E, wave);
        } SEAM(pb + 7); TICK_OUT(7); } }
    { ARGS(); if (IN(pb + 8)) { TICK_IN(8); {
        pg8::Gemm g{(const bf16*)(args.ws + WS_ACT), (const bf16*)(args.ws + W_D_(j)), FF / 2, FF / 2}; pg8::StaticOrder S; S.init(TT, D, G, bid);
        pg8::EpiResid<true, F8_ACT + F8_WD> E{(const void*)args.out, (bf16*)args.out, (const float*)(args.ws + WS_STATS), args.ln_g + (size_t)(4 * j + 0) * D, args.ln_b + (size_t)(4 * j + 0) * D};
        pg8::gemm_phase<pg8::EpiResid<true, F8_ACT + F8_WD>, pg8::StaticOrder, true, true, 1>(lds, g, S, E, wave);
        } SEAM(pb + 8); TICK_OUT(8); } }
    { ARGS(); if (IN(pb + 9)) { TICK_IN(9); _Pragma("unroll 1") for (int rep_ = 0; rep_ < NREP(9); ++rep_) { phase_ln<false, true>(args, (const bf16*)args.out, (2 * j) * 2 + 1, j, lds, bid, G, tid, wave, lane); } SEAM(pb + 9); TICK_OUT(9); } }
    { ARGS(); if (IN(pb + 10)) { TICK_IN(10); {
        pg8::Gemm g{(const bf16*)(args.ws + WS_HB), (const bf16*)(args.ws + W_QKV), D / 2, D / 2}; pg8::StaticOrder S; S.init(TT, 3072, G, bid, NREP(10));
        pg8::EpiI8<pg8::EpiBf16> E{{(bf16*)(args.ws + WS_QKV), 3072, 0}, (const float*)(args.ws + WS_HS), (const float*)(args.ws + WS_SWQ)};
        pg8::gemm_phase<pg8::EpiI8<pg8::EpiBf16>, pg8::StaticOrder, true, true, 2>(lds, g, S, E, wave);
        } SEAM(pb + 10); TICK_OUT(10); } }
    #if SB_NAIVE
    { ARGS(); if (IN(pb + 11)) { TICK_IN(11); _Pragma("unroll 1") for (int rep_ = 0; rep_ < NREP(11); ++rep_) { phase_sb_naive(args, lds, bid, G, tid); } SEAM(pb + 11); TICK_OUT(11); } }
#else
    { ARGS(); if (IN(pb + 11)) { TICK_IN(11); _Pragma("unroll 1") for (int rep_ = 0; rep_ < NREP(11); ++rep_) { phase_sb_mfma(args, lds, bid, G, tid); } SEAM(pb + 11); TICK_OUT(11); } }
#endif
    { ARGS(); if (IN(pb + 12)) { TICK_IN(12); {
        pg8::Gemm g{(const bf16*)(args.ws + WS_AO), (const bf16*)(args.ws + W_O), D / 2, D / 2}; pg8::StaticOrder S; S.init(TT, D, G, bid);
        pg8::EpiResid<true, F8_AO + F8_WSO> E{(const void*)args.out, YMOE, (const float*)(args.ws + WS_STATS), args.ln_g + (size_t)(4 * j + 1) * D, args.ln_b + (size_t)(4 * j + 1) * D};
        pg8::gemm_phase<pg8::EpiResid<true, F8_AO + F8_WSO>, pg8::StaticOrder, true, true, 1>(lds, g, S, E, wave);
        } SEAM(pb + 12); TICK_OUT(12); } }
    { ARGS(); if (IN(pb + 13)) { TICK_IN(13); _Pragma("unroll 1") for (int rep_ = 0; rep_ < NREP(13); ++rep_) { phase_ln<true, true>(args, YMOE, (2 * j + 1) * 2 + 0, j, lds, bid, G, tid, wave, lane); } SEAM(pb + 13); TICK_OUT(13); } }
    { ARGS(); if (IN(pb + 14)) { TICK_IN(14); _Pragma("unroll 1") for (int rep_ = 0; rep_ < NREP(14); ++rep_) { phase_scatter(args, j, lds, bid, G, tid, wave, lane); } SEAM(pb + 14); TICK_OUT(14); } }
    { ARGS(); if (IN(pb + 15)) { TICK_IN(15); {
        unsigned off[9]; moe_offsets(args, j, off);
        pg8::MoeOrder S; S.nM = (int)(off[8] >> 8); S.G = G; S.c = bid; S.nN = 2 * FF / 256; S.nwg = S.nM * S.nN; S.rep = NREP(15);
        S.ps1 = (int)(off[1] >> 8); S.ps2 = (int)(off[2] >> 8); S.ps3 = (int)(off[3] >> 8); S.ps4 = (int)(off[4] >> 8); S.ps5 = (int)(off[5] >> 8); S.ps6 = (int)(off[6] >> 8); S.ps7 = (int)(off[7] >> 8);
        pg8::Gemm g{(const bf16*)(args.ws + WS_XS), (const bf16*)(args.ws + W_MGU), D / 2, D / 2};
        pg8::EpiI8SwiGLUf<F8_ACT> E{args.ws + WS_MACT, FF, 2 * FF / 256, (const float*)(args.ws + WS_XSS), (const float*)(args.ws + WS_SWM)};
        pg8::gemm_phase<pg8::EpiI8SwiGLUf<F8_ACT>, pg8::MoeOrder, true, true, 2>(lds, g, S, E, wave);
        } SEAM(pb + 15); TICK_OUT(15); } }
    { ARGS(); if (IN(pb + 16)) { TICK_IN(16); {
        unsigned off[9]; moe_offsets(args, j, off);
        pg8::MoeOrder S; S.nM = (int)(off[8] >> 8); S.G = G; S.c = bid; S.nN = D / 256; S.nwg = S.nM * S.nN; S.rep = NREP(16);
        S.ps1 = (int)(off[1] >> 8); S.ps2 = (int)(off[2] >> 8); S.ps3 = (int)(off[3] >> 8); S.ps4 = (int)(off[4] >> 8); S.ps5 = (int)(off[5] >> 8); S.ps6 = (int)(off[6] >> 8); S.ps7 = (int)(off[7] >> 8);
        pg8::Gemm g{(const bf16*)(args.ws + WS_MACT), (const bf16*)(args.ws + W_MD), FF / 2, FF / 2};
        pg8::EpiF8T<F8_ACT + F8_WD, F8_YE> E{args.ws + WS_XS, D, D / 256};
        pg8::gemm_phase<pg8::EpiF8T<F8_ACT + F8_WD, F8_YE>, pg8::MoeOrder, true, true, 1>(lds, g, S, E, wave);
        if constexpr (j == 0) phase_w_gdn_dyn(args, 1, (unsigned*)(args.ws + WS_CTL) + CW_WQ, lds, wave);
        } SEAM(pb + 16); TICK_OUT(16); } }
    { ARGS(); if (IN(pb + 17)) { TICK_IN(17); _Pragma("unroll 1") for (int rep_ = 0; rep_ < NREP(17); ++rep_) { phase_combine_ln<(j == 1)>(args, YMOE, (bf16*)args.out, 4 * j + 2, 4 * j + 3, bid, G, wave, lane); } SEAM(pb + 17); TICK_OUT(17); } }
}
__global__ void __launch_bounds__(NWAVES * 64, 2) fwd(Args kargs) {
    extern __shared__ __attribute__((aligned(16))) unsigned char lds_raw[];
    LAS unsigned char* lds = (LAS unsigned char*)lds_raw;
    volatile LAS unsigned* MISC = (volatile LAS unsigned*)(lds + MISC_OFF);
    const int tid = threadIdx.x, lane = tid & 63, wave = __builtin_amdgcn_readfirstlane(tid >> 6), G = gridDim.x, bid = blockIdx.x;
    for (int u = tid; u < (LDS_BYTES - RING_BYTES) / 4; u += NWAVES * 64) ((LAS unsigned*)(lds + RING_BYTES))[u] = 0u;
    __syncthreads();
    if (tid == 0) { LAS unsigned long long* pa = (LAS unsigned long long*)(lds + ARGS_OFF);
        pa[0] = (unsigned long long)kargs.x; pa[1] = (unsigned long long)kargs.gdn_w_in; pa[2] = (unsigned long long)kargs.gdn_conv_w; pa[3] = (unsigned long long)kargs.gdn_a_log;
        pa[4] = (unsigned long long)kargs.gdn_dt_bias; pa[5] = (unsigned long long)kargs.gdn_norm_w; pa[6] = (unsigned long long)kargs.gdn_w_out; pa[7] = (unsigned long long)kargs.sb_w_in;
        pa[8] = (unsigned long long)kargs.sb_w_out; pa[9] = (unsigned long long)kargs.ffn_w_gate; pa[10] = (unsigned long long)kargs.ffn_w_up; pa[11] = (unsigned long long)kargs.ffn_w_down;
        pa[12] = (unsigned long long)kargs.moe_router; pa[13] = (unsigned long long)kargs.moe_w_gate; pa[14] = (unsigned long long)kargs.moe_w_up; pa[15] = (unsigned long long)kargs.moe_w_down;
        pa[16] = (unsigned long long)kargs.ln_g; pa[17] = (unsigned long long)kargs.ln_b; pa[18] = (unsigned long long)kargs.out; pa[19] = (unsigned long long)kargs.ws;
        pa[20] = (unsigned long long)(unsigned)kargs.ph_lo | ((unsigned long long)(unsigned)kargs.ph_hi << 32); }
    XcdBarrier bar = xcd_barrier_post((unsigned*)(kargs.ws + WS_CTL) + CW_BAR, MISC + 8);
    __syncthreads();
    layer_pair<0>(lds, bar, wave, G, bid);
    layer_pair<1>(lds, bar, wave, G, bid);
    if (PROBE_DELAY_MASK || PROBE_SEC) { if (bid == 0 && threadIdx.x == 0) { const unsigned acc = ((volatile LAS unsigned*)(lds + MISC_OFF))[20] * PROBE_DELAY_MULT; const unsigned long long t0 = __builtin_amdgcn_s_memrealtime(); while ((unsigned)(__builtin_amdgcn_s_memrealtime() - t0) < acc) __builtin_amdgcn_s_sleep(8); } }
}
#undef IN
#undef SEAM
#undef ARGS

extern "C" void kernel_launch(void* const* d_in, const int* in_sizes, int n_in, void* d_out, int out_size, void* d_ws, size_t ws_size, hipStream_t stream) {
    static int grid = 0;
    if (grid == 0) {
        if (n_in != 18 || in_sizes[0] != TT * D || out_size != TT * D || ws_size < WS_END) { fprintf(stderr, "kernel_launch: unexpected shapes (n_in %d, in0 %d, out %d, ws %zu); nothing launched\n", n_in, n_in > 0 ? in_sizes[0] : -1, out_size, ws_size); grid = -1; return; }
        int dev = 0, cus = 0, per_cu = 0;
        if (hipGetDevice(&dev) != hipSuccess || hipDeviceGetAttribute(&cus, hipDeviceAttributeMultiprocessorCount, dev) != hipSuccess) { grid = -1; return; }
        if (hipFuncSetAttribute((const void*)fwd, hipFuncAttributeMaxDynamicSharedMemorySize, LDS_BYTES) != hipSuccess) { fprintf(stderr, "kernel_launch: hipFuncSetAttribute failed\n"); grid = -1; return; }
        if (hipOccupancyMaxActiveBlocksPerMultiprocessor(&per_cu, (const void*)fwd, NWAVES * 64, LDS_BYTES) != hipSuccess || per_cu < 1) { fprintf(stderr, "kernel_launch: occupancy query says %d blocks per CU\n", per_cu); (void)hipGetLastError(); grid = -1; return; }
        grid = cus;
    }
    if (grid < 0) return;
    if (hipMemsetAsync((char*)d_ws + WS_CTL, 0, CTL_ZERO_BYTES, stream) != hipSuccess) return;
    Args a{};
    a.x = (const float*)d_in[0]; a.gdn_w_in = (const float*)d_in[1]; a.gdn_conv_w = (const float*)d_in[2]; a.gdn_a_log = (const float*)d_in[3]; a.gdn_dt_bias = (const float*)d_in[4];
    a.gdn_norm_w = (const float*)d_in[5]; a.gdn_w_out = (const float*)d_in[6]; a.sb_w_in = (const float*)d_in[7]; a.sb_w_out = (const float*)d_in[8];
    a.ffn_w_gate = (const float*)d_in[9]; a.ffn_w_up = (const float*)d_in[10]; a.ffn_w_down = (const float*)d_in[11]; a.moe_router = (const float*)d_in[12];
    a.moe_w_gate = (const float*)d_in[13]; a.moe_w_up = (const float*)d_in[14]; a.moe_w_down = (const float*)d_in[15]; a.ln_g = (const float*)d_in[16]; a.ln_b = (const float*)d_in[17];
    a.out = (float*)d_out; a.ws = (unsigned char*)d_ws;
#if MK_ONE_LAUNCH
    a.ph_lo = 0; a.ph_hi = NPHASES;
    hipLaunchKernelGGL(fwd, dim3(grid), dim3(NWAVES * 64), LDS_BYTES, stream, a);
#else
    for (int p = 0; p < NPHASES; ++p) { a.ph_lo = p; a.ph_hi = p + 1; hipLaunchKernelGGL(fwd, dim3(grid), dim3(NWAVES * 64), LDS_BYTES, stream, a); }
#endif
}
```
